# Optimizing an MI355X kernel written in HIP

```python
import jax
import jax.numpy as jnp
from jax import lax
import numpy as np

D_MODEL = 4096
BATCH = 2
SEQ = 8192
DEPTH = 2

CTX_LEN = 256
GRID_W = 64

N_GROUPS = 4
GROUP_W = D_MODEL // N_GROUPS
D_MIX = N_GROUPS * GROUP_W
D_FF = 4 * D_MODEL
BLOCK = 128

SWA_HEAD_DIM = 128
SWA_HEADS = GROUP_W // SWA_HEAD_DIM
SWA_KV_HEADS = SWA_HEADS // 4
SWA_GROUP = SWA_HEADS // SWA_KV_HEADS
WINDOW = 128

LRU_WIDTH = GROUP_W
LRU_BLOCKS = 8
LRU_BLOCK_W = LRU_WIDTH // LRU_BLOCKS
LRU_C = 8.0
CONV_W = 4

MLA_HEADS = 8
MLA_NOPE = 128
MLA_ROPE = 64
MLA_V = GROUP_W // MLA_HEADS
MLA_Q_RANK = GROUP_W
MLA_KV_RANK = D_MODEL // 8

RWKV_HEAD = 64
RWKV_HEADS = GROUP_W // RWKV_HEAD
RWKV_DECAY_LORA = 64
RWKV_A_LORA = 64
RWKV_GATE_LORA = 160
RWKV_GN_EPS = 64e-5

ROPE_BASE = 10000.0
LN_EPS = 1e-5
RMS_EPS = 1e-6
ALPHA = (2 * DEPTH) ** 0.25
BETA = (8 * DEPTH) ** -0.25

SWA_Q = SWA_HEADS * SWA_HEAD_DIM
SWA_KV = SWA_KV_HEADS * SWA_HEAD_DIM
RWKV_SIZES = (GROUP_W, GROUP_W, GROUP_W,
              RWKV_DECAY_LORA, RWKV_DECAY_LORA,
              RWKV_A_LORA, RWKV_A_LORA,
              RWKV_GATE_LORA)
RWKV_COLS = sum(RWKV_SIZES)
RWKV_SPLITS = tuple(int(v) for v in np.cumsum(RWKV_SIZES)[:-1])
COL_SIZES = (SWA_Q, SWA_KV, SWA_KV,
             LRU_WIDTH, LRU_WIDTH,
             MLA_Q_RANK, MLA_KV_RANK, MLA_ROPE,
             RWKV_COLS)
D_IN = sum(COL_SIZES)
COL_SPLITS = tuple(int(v) for v in np.cumsum(COL_SIZES)[:-1])

kernel_name = 'hybrid_parallel_groups_diffusion_block'


def layer_norm(x, g=None, b=None):
    xf = x.astype(jnp.float32)
    mu = jnp.mean(xf, -1, keepdims=True)
    var = jnp.mean(jnp.square(xf - mu), -1, keepdims=True)
    y = (xf - mu) * lax.rsqrt(var + LN_EPS)
    if g is not None:
        y = y * g + b
    return y.astype(x.dtype)


def rms_norm(x, g):
    xf = x.astype(jnp.float32)
    y = xf * lax.rsqrt(jnp.mean(jnp.square(xf), -1, keepdims=True) + RMS_EPS) * g
    return y.astype(x.dtype)


def modulate(x, shift, scale):
    return layer_norm(x) * (1.0 + scale) + shift


def rope_1d(x, pos):
    half = x.shape[-1] // 2
    inv = ROPE_BASE ** (-jnp.arange(half, dtype=jnp.float32) / half)
    ang = pos.astype(jnp.float32)[:, None] * inv[None, :]
    cos = jnp.cos(ang)[:, None, :]
    sin = jnp.sin(ang)[:, None, :]
    xf = x.astype(jnp.float32)
    x1, x2 = xf[..., :half], xf[..., half:]
    return jnp.concatenate([x1 * cos - x2 * sin, x2 * cos + x1 * sin], -1).astype(x.dtype)


def rope_2d(x, row, col):
    d = x.shape[-1] // 2
    return jnp.concatenate([rope_1d(x[..., :d], row), rope_1d(x[..., d:], col)], -1)


def dwconv_centred(x, w, b):
    k_w, ch = w.shape
    left = k_w // 2
    y = lax.conv_general_dilated(
        x,
        w[:, None, :].astype(x.dtype),
        window_strides=(1,),
        padding=[(left, k_w - 1 - left)],
        dimension_numbers=('NWC', 'WIO', 'NWC'),
        feature_group_count=ch,
    )
    return y + b


def token_shift(x, mu_prev, mu_next):
    zero = jnp.zeros_like(x[:, :1])
    x_prev = jnp.concatenate([zero, x[:, :-1]], 1)
    x_next = jnp.concatenate([x[:, 1:], zero], 1)
    return x + mu_prev * (x_prev - x) + mu_next * (x_next - x)


def dense_attn(q, k, v):
    s = jnp.einsum('bqhd,bkhd->bhqk', q, k).astype(jnp.float32) * (q.shape[-1] ** -0.5)
    p = jax.nn.softmax(s, -1).astype(v.dtype)
    return jnp.einsum('bhqk,bkhd->bqhd', p, v)


def band_blocks(t, nb):
    bsz, _, h, d = t.shape
    tp = jnp.pad(t, ((0, 0), (BLOCK, BLOCK), (0, 0), (0, 0))).reshape(bsz, nb + 2, BLOCK, h, d)
    return jnp.concatenate([tp[:, :-2], tp[:, 1:-1], tp[:, 2:]], axis=2)


def band_mask(nb, t_len):
    qi = jnp.arange(BLOCK)[:, None]
    kj = jnp.arange(3 * BLOCK)[None, :] - BLOCK
    band = jnp.abs(kj - qi) <= WINDOW
    kabs = jnp.arange(nb)[:, None] * BLOCK + kj
    valid = (kabs >= 0) & (kabs < t_len)
    return band[None] & valid[:, None, :]


def swa_mixer(q, k, v, qc, kc, vc, sink, row, col, with_ctx):
    bsz, t_len, _ = q.shape
    n_ctx = qc.shape[1]
    nb = t_len // BLOCK
    scale = SWA_HEAD_DIM ** -0.5

    q = rope_2d(q.reshape(bsz, t_len, SWA_HEADS, SWA_HEAD_DIM), row, col)
    k = rope_2d(k.reshape(bsz, t_len, SWA_KV_HEADS, SWA_HEAD_DIM), row, col)
    v = v.reshape(bsz, t_len, SWA_KV_HEADS, SWA_HEAD_DIM)
    kc = kc.reshape(bsz, n_ctx, SWA_KV_HEADS, SWA_HEAD_DIM)
    vc = vc.reshape(bsz, n_ctx, SWA_KV_HEADS, SWA_HEAD_DIM)

    qb = q.reshape(bsz, nb, BLOCK, SWA_KV_HEADS, SWA_GROUP, SWA_HEAD_DIM)
    kb = band_blocks(k, nb)
    vb = band_blocks(v, nb)

    s_loc = jnp.einsum('bnqhgd,bnkhd->bnhgqk', qb, kb).astype(jnp.float32) * scale
    s_loc = jnp.where(band_mask(nb, t_len)[None, :, None, None], s_loc, -jnp.inf)
    s_ctx = jnp.einsum('bnqhgd,bkhd->bnhgqk', qb, kc).astype(jnp.float32) * scale

    sink_hg = sink.astype(jnp.float32).reshape(SWA_KV_HEADS, SWA_GROUP)[:, :, None, None]
    sink_col = jnp.broadcast_to(sink_hg, s_loc.shape[:-1] + (1,))
    p = jax.nn.softmax(jnp.concatenate([s_loc, s_ctx, sink_col], -1), -1).astype(v.dtype)

    nk = 3 * BLOCK
    o = (jnp.einsum('bnhgqk,bnkhd->bnqhgd', p[..., :nk], vb)
         + jnp.einsum('bnhgqk,bkhd->bnqhgd', p[..., nk:nk + n_ctx], vc))
    o = o.reshape(bsz, t_len, SWA_HEADS * SWA_HEAD_DIM)

    o_c = None
    if with_ctx:
        qcg = qc.reshape(bsz, n_ctx, SWA_KV_HEADS, SWA_GROUP, SWA_HEAD_DIM)
        s = jnp.einsum('bqhgd,bkhd->bhgqk', qcg, kc).astype(jnp.float32) * scale
        s = jnp.concatenate([s, jnp.broadcast_to(sink_hg, s.shape[:-1] + (1,))], -1)
        pc = jax.nn.softmax(s, -1)[..., :n_ctx].astype(vc.dtype)
        o_c = jnp.einsum('bhgqk,bkhd->bqhgd', pc, vc).reshape(bsz, n_ctx, SWA_HEADS * SWA_HEAD_DIM)
    return o, o_c


def block_diag(x, w):
    bsz, t_len, ch = x.shape
    xr = x.reshape(bsz, t_len, LRU_BLOCKS, LRU_BLOCK_W)
    return jnp.einsum('btnc,ncd->btnd', xr, w).reshape(bsz, t_len, ch)


def rglru_coeffs(u, wa, ba, wi, bi, lam):
    r = jax.nn.sigmoid(block_diag(u, wa) + ba)
    i = jax.nn.sigmoid(block_diag(u, wi) + bi)
    log_a = -LRU_C * r * jax.nn.softplus(-lam)
    return jnp.exp(log_a), jnp.sqrt(-jnp.expm1(2.0 * log_a)) * (i * u)


def lin_combine(left, right):
    a_l, b_l = left
    a_r, b_r = right
    return a_l * a_r, a_r * b_l + b_r


def lru_scan(a, b, h0, reverse):
    first = -1 if reverse else 0
    b = b.at[:, first].add(a[:, first] * h0)
    _, h = lax.associative_scan(lin_combine, (a, b), reverse=reverse, axis=1)
    return h, h[:, first if reverse else -1]


def rglru_mixer(xb, yb, xbc, ybc, conv_w, conv_b, wa, ba, wi, bi, lam, with_ctx):
    u = dwconv_centred(xb, conv_w, conv_b).astype(jnp.float32)
    uc = dwconv_centred(xbc, conv_w, conv_b).astype(jnp.float32)

    h_sum = 0.0
    hc_sum = 0.0
    for d in range(2):
        rev = d == 1
        ac, bc = rglru_coeffs(uc, wa[d], ba[d], wi[d], bi[d], lam[d])
        hc, hc_last = lru_scan(ac, bc, jnp.zeros_like(uc[:, 0]), rev)
        al, bl = rglru_coeffs(u, wa[d], ba[d], wi[d], bi[d], lam[d])
        hl, _ = lru_scan(al, bl, hc_last, rev)
        h_sum = h_sum + hl
        hc_sum = hc_sum + hc

    o = (h_sum * jax.nn.gelu(yb.astype(jnp.float32))).astype(xb.dtype)
    o_c = (hc_sum * jax.nn.gelu(ybc.astype(jnp.float32))).astype(xb.dtype) if with_ctx else None
    return o, o_c


def mla_project(qa, kva, kr, q_norm, kv_norm, w_qb, w_kvb, row, col, rotate):
    bsz, t_len, _ = qa.shape
    q = (rms_norm(qa, q_norm) @ w_qb).reshape(bsz, t_len, MLA_HEADS, MLA_NOPE + MLA_ROPE)
    kv = (rms_norm(kva, kv_norm) @ w_kvb).reshape(bsz, t_len, MLA_HEADS, MLA_NOPE + MLA_V)
    q_nope, q_rope = q[..., :MLA_NOPE], q[..., MLA_NOPE:]
    k_nope, v = kv[..., :MLA_NOPE], kv[..., MLA_NOPE:]
    k_rope = kr[:, :, None, :]
    if rotate:
        q_rope = rope_2d(q_rope, row, col)
        k_rope = rope_2d(k_rope, row, col)
    k_rope = jnp.broadcast_to(k_rope, (bsz, t_len, MLA_HEADS, MLA_ROPE))
    return (jnp.concatenate([q_nope, q_rope], -1),
            jnp.concatenate([k_nope, k_rope], -1),
            v)


def mla_mixer(qa, kva, kr, qac, kvac, krc, q_norm, kv_norm, w_qb, w_kvb, row, col, with_ctx):
    bsz, t_len, _ = qa.shape
    n_ctx = qac.shape[1]
    nb = t_len // BLOCK

    q, k, v = mla_project(qa, kva, kr, q_norm, kv_norm, w_qb, w_kvb, row, col, True)
    qc, kc, vc = mla_project(qac, kvac, krc, q_norm, kv_norm, w_qb, w_kvb, row, col, False)

    k_all = jnp.concatenate([kc, k], 1)
    v_all = jnp.concatenate([vc, v], 1)
    q_blocks = jnp.moveaxis(q.reshape(bsz, nb, BLOCK, MLA_HEADS, MLA_NOPE + MLA_ROPE), 1, 0)
    o = lax.map(lambda qb: dense_attn(qb, k_all, v_all), q_blocks)
    o = jnp.moveaxis(o, 0, 1).reshape(bsz, t_len, MLA_HEADS * MLA_V)

    o_c = dense_attn(qc, kc, vc).reshape(bsz, n_ctx, MLA_HEADS * MLA_V) if with_ctx else None
    return o, o_c


def rwkv_features(pd, mu_prev, mu_next, w0, w2, a0, a2, g2, k_k, k_a, r_k):
    u = token_shift(pd.astype(jnp.float32), mu_prev, mu_next)
    r, k, v, dw_f, dw_b, da_f, da_b, dg = jnp.split(u, RWKV_SPLITS, axis=-1)
    bsz, t_len, _ = r.shape

    def heads(t):
        return t.reshape(bsz, t_len, RWKV_HEADS, RWKV_HEAD)

    kk = heads(k * k_k)
    kk = kk / jnp.maximum(jnp.sqrt(jnp.sum(jnp.square(kk), -1, keepdims=True)), 1e-12)
    g = jax.nn.sigmoid(dg) @ g2

    dirs = []
    for d, (dw, da) in enumerate(((dw_f, da_f), (dw_b, da_b))):
        w_log = -jax.nn.softplus(-(w0[d] + jnp.tanh(dw) @ w2[d])) - 0.5
        decay = jnp.exp(-jnp.exp(w_log))
        a = jax.nn.sigmoid(a0[d] + da @ a2[d])
        k_d = heads(k * (1.0 + (a - 1.0) * k_a))
        bonus = jnp.sum(heads(r) * k_d * r_k, -1, keepdims=True) * heads(v)
        dirs.append((heads(decay), k_d, kk * heads(a), bonus))
    return heads(r), heads(v), kk, g, dirs


def wkv7_scan(r, decay, k, v, kk, b, s0, reverse):
    def step(s, inp):
        r_t, w_t, k_t, v_t, kk_t, b_t = inp
        s_kk = jnp.einsum('bhvk,bhk->bhv', s, kk_t)
        s = (s * w_t[:, :, None, :]
             - s_kk[..., None] * b_t[:, :, None, :]
             + v_t[..., None] * k_t[:, :, None, :])
        return s, jnp.einsum('bhvk,bhk->bhv', s, r_t)

    xs = tuple(jnp.moveaxis(t, 1, 0) for t in (r, decay, k, v, kk, b))
    s_last, ys = lax.scan(step, s0, xs, reverse=reverse)
    return jnp.moveaxis(ys, 0, 1), s_last


def rwkv_output(y, bonus, g, ln_g, ln_b):
    bsz, t_len, h, n = y.shape
    mu = jnp.mean(y, -1, keepdims=True)
    var = jnp.mean(jnp.square(y - mu), -1, keepdims=True)
    yn = ((y - mu) * lax.rsqrt(var + RWKV_GN_EPS)).reshape(bsz, t_len, h * n) * ln_g + ln_b
    return (yn + bonus.reshape(bsz, t_len, h * n)) * g


def rwkv_mixer(pd, pdc, mu_prev, mu_next, w0, w2, a0, a2, g2, k_k, k_a, r_k, ln_g, ln_b, with_ctx):
    r, v, kk, g, dirs = rwkv_features(pd, mu_prev, mu_next, w0, w2, a0, a2, g2, k_k, k_a, r_k)
    rc, vc, kkc, gc, dirs_c = rwkv_features(pdc, mu_prev, mu_next, w0, w2, a0, a2, g2, k_k, k_a, r_k)
    s0 = jnp.zeros((pd.shape[0], RWKV_HEADS, RWKV_HEAD, RWKV_HEAD), jnp.float32)

    y = 0.0
    yc = 0.0
    bonus = 0.0
    bonus_c = 0.0
    for d in range(2):
        rev = d == 1
        dec_c, k_c, b_c, bo_c = dirs_c[d]
        yc_d, s_ctx = wkv7_scan(rc, dec_c, k_c, vc, kkc, b_c, s0, rev)
        dec, k_d, b_d, bo = dirs[d]
        y_d, _ = wkv7_scan(r, dec, k_d, v, kk, b_d, s_ctx, rev)
        y = y + y_d
        bonus = bonus + bo
        yc = yc + yc_d
        bonus_c = bonus_c + bo_c

    o = rwkv_output(y, bonus, g, ln_g, ln_b).astype(pd.dtype)
    o_c = rwkv_output(yc, bonus_c, gc, ln_g, ln_b).astype(pd.dtype) if with_ctx else None
    return o, o_c


def sq_relu_mlp(h, w1, w2):
    return jnp.square(jax.nn.relu(h @ w1)) @ w2


def setup_inputs(seed: int = 0) -> dict:
    key = jax.random.key(seed)
    ks = iter(jax.random.split(key, 48))

    def nrm(shape, std):
        return std * jax.random.normal(next(ks), shape, jnp.float32)

    def uni(shape, lo, hi):
        return jax.random.uniform(next(ks), shape, jnp.float32, lo, hi)

    L, D = DEPTH, D_MODEL
    lam_a = uni((L, 2, LRU_WIDTH), 0.9, 0.999) ** (1.0 / LRU_C)
    return {
        'x': nrm((BATCH, SEQ, D), 1.0),
        'c': nrm((BATCH, D), 1.0),
        'ctx': nrm((BATCH, CTX_LEN, D), 1.0),
        'c_ctx': nrm((D,), 1.0),
        'w_mod': nrm((L, D, 6 * D), 0.5 * D ** -0.5),
        'b_mod': nrm((L, 6 * D), 0.01),
        'w_in': nrm((L, D, D_IN), D ** -0.5),
        'w_out': nrm((L, D_MIX, D), BETA * D_MIX ** -0.5),
        'ln1_g': 1.0 + nrm((L, D), 0.02),
        'ln1_b': nrm((L, D), 0.02),
        'w_ff1': nrm((L, D, D_FF), D ** -0.5),
        'w_ff2': nrm((L, D_FF, D), BETA * D_FF ** -0.5),
        'ln2_g': 1.0 + nrm((L, D), 0.02),
        'ln2_b': nrm((L, D), 0.02),
        'swa_sink': nrm((L, SWA_HEADS), 0.5),
        'lru_conv_w': nrm((L, CONV_W, LRU_WIDTH), CONV_W ** -0.5),
        'lru_conv_b': nrm((L, LRU_WIDTH), 0.01),
        'lru_wa': nrm((L, 2, LRU_BLOCKS, LRU_BLOCK_W, LRU_BLOCK_W), LRU_BLOCK_W ** -0.5),
        'lru_ba': nrm((L, 2, LRU_WIDTH), 0.1),
        'lru_wi': nrm((L, 2, LRU_BLOCKS, LRU_BLOCK_W, LRU_BLOCK_W), LRU_BLOCK_W ** -0.5),
        'lru_bi': nrm((L, 2, LRU_WIDTH), 0.1),
        'lru_lam': jnp.log(lam_a) - jnp.log1p(-lam_a),
        'mla_q_norm': 1.0 + nrm((L, MLA_Q_RANK), 0.02),
        'mla_kv_norm': 1.0 + nrm((L, MLA_KV_RANK), 0.02),
        'mla_w_qb': nrm((L, MLA_Q_RANK, MLA_HEADS * (MLA_NOPE + MLA_ROPE)), MLA_Q_RANK ** -0.5),
        'mla_w_kvb': nrm((L, MLA_KV_RANK, MLA_HEADS * (MLA_NOPE + MLA_V)), MLA_KV_RANK ** -0.5),
        'rwkv_mu_prev': uni((L, RWKV_COLS), 0.0, 0.5),
        'rwkv_mu_next': uni((L, RWKV_COLS), 0.0, 0.5),
        'rwkv_w0': uni((L, 2, GROUP_W), -6.0, -1.0),
        'rwkv_w2': nrm((L, 2, RWKV_DECAY_LORA, GROUP_W), 0.1),
        'rwkv_a0': nrm((L, 2, GROUP_W), 0.1),
        'rwkv_a2': nrm((L, 2, RWKV_A_LORA, GROUP_W), 0.1),
        'rwkv_g2': nrm((L, RWKV_GATE_LORA, GROUP_W), RWKV_GATE_LORA ** -0.5),
        'rwkv_k_k': 0.85 + nrm((L, GROUP_W), 0.02),
        'rwkv_k_a': 1.0 + nrm((L, GROUP_W), 0.02),
        'rwkv_r_k': nrm((L, RWKV_HEADS, RWKV_HEAD), 0.1),
        'rwkv_ln_g': 1.0 + nrm((L, GROUP_W), 0.02),
        'rwkv_ln_b': nrm((L, GROUP_W), 0.02),
    }


def reference(x, c, ctx, c_ctx, w_mod, b_mod, w_in, w_out, ln1_g, ln1_b, w_ff1, w_ff2, ln2_g, ln2_b,
              swa_sink, lru_conv_w, lru_conv_b, lru_wa, lru_ba, lru_wi, lru_bi, lru_lam,
              mla_q_norm, mla_kv_norm, mla_w_qb, mla_w_kvb,
              rwkv_mu_prev, rwkv_mu_next, rwkv_w0, rwkv_w2, rwkv_a0, rwkv_a2, rwkv_g2,
              rwkv_k_k, rwkv_k_a, rwkv_r_k, rwkv_ln_g, rwkv_ln_b):
    n_lat = x.shape[1]
    rows = n_lat // GRID_W
    row = jnp.repeat(jnp.arange(rows, dtype=jnp.int32), GRID_W)
    col = jnp.arange(n_lat, dtype=jnp.int32) % GRID_W
    xc = ctx

    for l in range(DEPTH):
        with_ctx = l < DEPTH - 1

        mod = jax.nn.silu(c) @ w_mod[l] + b_mod[l]
        mod_c = jax.nn.silu(c_ctx) @ w_mod[l] + b_mod[l]
        sh1, sc1, ga1, sh2, sc2, ga2 = jnp.split(mod[:, None, :], 6, axis=-1)
        csh1, csc1, cga1, csh2, csc2, cga2 = jnp.split(mod_c, 6, axis=-1)

        p = jnp.split(modulate(x, sh1, sc1) @ w_in[l], COL_SPLITS, axis=-1)
        pc = jnp.split(modulate(xc, csh1, csc1) @ w_in[l], COL_SPLITS, axis=-1)

        o_swa, oc_swa = swa_mixer(p[0], p[1], p[2], pc[0], pc[1], pc[2],
                                  swa_sink[l], row, col, with_ctx)
        o_lru, oc_lru = rglru_mixer(p[3], p[4], pc[3], pc[4],
                                    lru_conv_w[l], lru_conv_b[l],
                                    lru_wa[l], lru_ba[l], lru_wi[l], lru_bi[l], lru_lam[l],
                                    with_ctx)
        o_mla, oc_mla = mla_mixer(p[5], p[6], p[7], pc[5], pc[6], pc[7],
                                  mla_q_norm[l], mla_kv_norm[l], mla_w_qb[l], mla_w_kvb[l],
                                  row, col, with_ctx)
        o_rwkv, oc_rwkv = rwkv_mixer(p[8], pc[8],
                                     rwkv_mu_prev[l], rwkv_mu_next[l],
                                     rwkv_w0[l], rwkv_w2[l], rwkv_a0[l], rwkv_a2[l], rwkv_g2[l],
                                     rwkv_k_k[l], rwkv_k_a[l], rwkv_r_k[l],
                                     rwkv_ln_g[l], rwkv_ln_b[l], with_ctx)

        mix = jnp.concatenate([o_swa, o_lru, o_mla, o_rwkv], -1) @ w_out[l]
        x = layer_norm(ALPHA * x + ga1 * mix, ln1_g[l], ln1_b[l])
        x = layer_norm(ALPHA * x + ga2 * sq_relu_mlp(modulate(x, sh2, sc2), w_ff1[l], w_ff2[l]),
                       ln2_g[l], ln2_b[l])

        if with_ctx:
            mix_c = jnp.concatenate([oc_swa, oc_lru, oc_mla, oc_rwkv], -1) @ w_out[l]
            xc = layer_norm(ALPHA * xc + cga1 * mix_c, ln1_g[l], ln1_b[l])
            xc = layer_norm(ALPHA * xc + cga2 * sq_relu_mlp(modulate(xc, csh2, csc2), w_ff1[l], w_ff2[l]),
                            ln2_g[l], ln2_b[l])
    return x
```

```cpp
#include <hip/hip_runtime.h>
#include <hip/hip_bf16.h>
#include <cstdio>
#include <cstdint>

namespace pg8 {
#define PG8_LAS __attribute__((address_space(3)))
typedef unsigned short bf16_t;
typedef short bf16x8 __attribute__((ext_vector_type(8)));
typedef float f32x4 __attribute__((ext_vector_type(4)));
typedef unsigned u32x4 __attribute__((ext_vector_type(4)));
constexpr int BM = 256, BK = 64, HALF = 128, HTB = HALF * BK * 2  , STAGE_BYTES = 8 * HTB, NXCD = 8, WGM = 8;

__host__ __device__ __forceinline__ int lds_byte(int r, int c) { const int st = (r >> 4) * 2 + (c >> 5), rr = r & 15, cc = c & 31, ob = rr * 64 + cc * 2; return st * 1024 + (ob ^ (((ob >> 9) & 1) << 5)); }
__host__ __device__ __forceinline__ void stage_rc(int b, int& R, int& C) { const int st = b / 1024, sb = b % 1024, swz = sb ^ (((sb >> 9) & 1) << 5); R = (st >> 1) * 16 + swz / 64; C = (st & 1) * 32 + (swz % 64) / 2; }
__host__ __device__ __forceinline__ int perm32(int rho) { const int n = rho >> 4, i = rho & 15; return 8 * (i >> 2) + 4 * n + (i & 3); }

struct Unit { int pm, pn; };
struct Gemm { const bf16_t* A; const bf16_t* Bt; int M, N, K, lda; };

struct StaticOrder {
    int nM, nN, nwg, G, c;
    __host__ __device__ void init(int M, int N, int G_, int c_) { nM = M / BM; nN = N / BM; nwg = nM * nN; G = G_; c = c_; }
    __host__ __device__ bool next(int i, Unit& u) const {
        const long L = (long)i * G + c; if (L >= nwg) return false;
        int wgid = (int)L; { const int q = nwg / NXCD, r = nwg % NXCD, xcd = wgid % NXCD, off = wgid / NXCD; wgid = (xcd < r ? xcd * (q + 1) : r * (q + 1) + (xcd - r) * q) + off; }
        const int nig = WGM * nN, gid = wgid / nig, fm = gid * WGM, gsz = (nM - fm) < WGM ? (nM - fm) : WGM;
        u.pm = fm + ((wgid % nig) % gsz); u.pn = (wgid % nig) / gsz; return true;
    }
    __device__ __forceinline__ void a_ready(const Unit&) const {}
    __device__ __forceinline__ void done(const Unit&) const {}
};

__device__ __forceinline__ unsigned cvt_pk_bf16(float lo, float hi) { unsigned r; asm volatile("v_cvt_pk_bf16_f32 %0, %1, %2" : "=v"(r) : "v"(lo), "v"(hi)); return r; }

struct EpiF32 {
    static constexpr bool PERM = false, AFTER_DRAIN = false;
    float* C; int ldc;
    __device__ __forceinline__ void operator()(const f32x4 (&acc)[2][2][4][2], const Unit& u, int wr, int wc, int fr, int fq) const {
        const int row0 = u.pm * BM + wr * 64 + fr, col0 = u.pn * BM + wc * 32 + 4 * fq;
#pragma unroll
        for (int ai = 0; ai < 2; ++ai)
#pragma unroll
            for (int m = 0; m < 4; ++m) { float* rowp = C + (size_t)(row0 + ai * HALF + m * 16) * ldc + col0;
#pragma unroll
                for (int bj = 0; bj < 2; ++bj)
#pragma unroll
                    for (int n = 0; n < 2; ++n) *(f32x4*)(rowp + bj * HALF + n * 16) = acc[ai][bj][m][n]; }
    }
};
template <int ACT> struct EpiBf16 {
    static constexpr bool PERM = true, AFTER_DRAIN = false;
    bf16_t* O; int ldc; const float* rowscale;
    __device__ __forceinline__ void operator()(const f32x4 (&acc)[2][2][4][2], const Unit& u, int wr, int wc, int fr, int fq) const {
        const int row0 = u.pm * BM + wr * 64 + fr; const int col0 = u.pn * BM + wc * 32 + 8 * fq;
#pragma unroll
        for (int ai = 0; ai < 2; ++ai)
#pragma unroll
            for (int m = 0; m < 4; ++m) { const int row = row0 + ai * HALF + m * 16; bf16_t* rowp = O + (size_t)row * ldc + col0;
                float rs = 1.f; if (ACT == 2) rs = rowscale[row];
#pragma unroll
                for (int bj = 0; bj < 2; ++bj) { f32x4 v0 = acc[ai][bj][m][0], v1 = acc[ai][bj][m][1];
                    if (ACT == 1) {
#pragma unroll
                        for (int j = 0; j < 4; ++j) { const float a = fmaxf(v0[j], 0.f), b = fmaxf(v1[j], 0.f); v0[j] = a * a; v1[j] = b * b; } }
                    if (ACT == 2) { v0 = v0 * rs; v1 = v1 * rs; }
                    u32x4 w; w.x = cvt_pk_bf16(v0[0], v0[1]); w.y = cvt_pk_bf16(v0[2], v0[3]); w.z = cvt_pk_bf16(v1[0], v1[1]); w.w = cvt_pk_bf16(v1[2], v1[3]);
                    *(u32x4*)(rowp + bj * HALF) = w; } }
    }
};

template <class Epi, class Sched, bool ALIGN_EPI = false, bool SP2 = false>
__device__ __forceinline__ void gemm_phase(PG8_LAS unsigned char* lds, const Gemm g, const Sched& S, const Epi& E) {
    int tid = threadIdx.x; asm volatile("" : "+v"(tid));
    const int wid = __builtin_amdgcn_readfirstlane(tid >> 6), lane = tid & 63, wr = wid >> 2, wc = wid & 3, fr = lane & 15, fq = lane >> 4;
    const int K = g.K, nt = K / BK, lda = g.lda;
    unsigned voffA[2], voffB[2];
#pragma unroll
    for (int i = 0; i < 2; ++i) { int R, C; stage_rc(tid * 16 + i * 8192, R, C); const int Rb = Epi::PERM ? ((R & ~31) + perm32(R & 31)) : R;
        voffA[i] = (unsigned)(R * lda + C) * 2u; voffB[i] = (unsigned)(Rb * K + C) * 2u; }
    const size_t kstep = (size_t)(BK * 2);
    const size_t hstepA = (size_t)HALF * lda * 2, hstepB = (size_t)HALF * K * 2;
    const size_t tstepA = 2 * hstepA, tstepB = 2 * hstepB;
    const unsigned ldsw = (unsigned)wid * 1024u;
    const int aoff = lds_byte(wr * 64 + fr, fq * 8), boff = lds_byte(wc * 32 + fr, fq * 8);
#define PG8_SA(b, h) (((b) * 2 + (h)) * HTB)
#define PG8_SB(b, h) ((4 + (b) * 2 + (h)) * HTB)
#define PG8_STAGE(bufoff, gbase, voff) do { _Pragma("unroll") for (int _i = 0; _i < 2; ++_i) \
        __builtin_amdgcn_global_load_lds((const unsigned*)((const char*)(gbase) + (voff)[_i]), (PG8_LAS unsigned*)(lds + (bufoff) + ldsw + _i * 8192), 16, 0, 0); } while (0)
#define PG8_LDA(dst, b, h) do { _Pragma("unroll") for (int m = 0; m < 4; ++m) _Pragma("unroll") for (int k = 0; k < 2; ++k) dst[m][k] = *(const PG8_LAS bf16x8*)(lds + PG8_SA(b, h) + aoff + m * 2048 + k * 1024); } while (0)
#define PG8_LDB(dst, b, h) do { _Pragma("unroll") for (int n = 0; n < 2; ++n) _Pragma("unroll") for (int k = 0; k < 2; ++k) dst[n][k] = *(const PG8_LAS bf16x8*)(lds + PG8_SB(b, h) + boff + n * 2048 + k * 1024); } while (0)
#define PG8_MMA(ai, bj, At, Bt) do { __builtin_amdgcn_s_setprio(1); _Pragma("unroll") for (int m = 0; m < 4; ++m) _Pragma("unroll") for (int n = 0; n < 2; ++n) _Pragma("unroll") for (int k = 0; k < 2; ++k) \
        acc[ai][bj][m][n] = __builtin_amdgcn_mfma_f32_16x16x32_bf16(Bt[n][k], At[m][k], acc[ai][bj][m][n], 0, 0, 0); __builtin_amdgcn_s_setprio(0); } while (0)
#define PG8_WAIT_V(n) asm volatile("s_waitcnt vmcnt(" #n ")" ::: "memory")
#define PG8_WAIT_L(n) asm volatile("s_waitcnt lgkmcnt(" #n ")" ::: "memory")
#define PG8_BAR __builtin_amdgcn_s_barrier()
#define PG8_SCHED __builtin_amdgcn_sched_barrier(0)
    Unit cur, nxt; int ui = 0;
    if (!S.next(0, cur)) return;
    f32x4 acc[2][2][4][2];
#pragma unroll
    for (int a = 0; a < 2; ++a)
#pragma unroll
        for (int b = 0; b < 2; ++b)
#pragma unroll
            for (int m = 0; m < 4; ++m)
#pragma unroll
                for (int n = 0; n < 2; ++n) acc[a][b][m][n] = (f32x4){0.f, 0.f, 0.f, 0.f};
    bf16x8 At[4][2], B0[2][2], B1[2][2];
    const char* cA = (const char*)g.A + (size_t)cur.pm * tstepA; const char* cB = (const char*)g.Bt + (size_t)cur.pn * tstepB;
    S.a_ready(cur);
    if constexpr (SP2) {
        PG8_STAGE(PG8_SB(0, 0), cB, voffB); PG8_STAGE(PG8_SB(0, 1), cB + hstepB, voffB); PG8_STAGE(PG8_SA(0, 0), cA, voffA); PG8_STAGE(PG8_SA(0, 1), cA + hstepA, voffA);
        if (wr == 1) PG8_BAR;
        PG8_WAIT_V(2); PG8_BAR;
        PG8_STAGE(PG8_SB(1, 0), cB + kstep, voffB); PG8_STAGE(PG8_SA(1, 0), cA + kstep, voffA); PG8_STAGE(PG8_SB(1, 1), cB + hstepB + kstep, voffB);
        PG8_WAIT_V(6); PG8_BAR;
    } else {
        PG8_STAGE(PG8_SB(0, 0), cB, voffB); PG8_STAGE(PG8_SA(0, 0), cA, voffA); PG8_STAGE(PG8_SB(0, 1), cB + hstepB, voffB); PG8_STAGE(PG8_SA(0, 1), cA + hstepA, voffA);
        if (wr == 1) PG8_BAR;
        PG8_WAIT_V(4); PG8_BAR;
        PG8_STAGE(PG8_SB(1, 0), cB + kstep, voffB); PG8_STAGE(PG8_SA(1, 0), cA + kstep, voffA); PG8_STAGE(PG8_SB(1, 1), cB + hstepB + kstep, voffB);
        PG8_WAIT_V(6); PG8_BAR;
    }
    for (;;) {
        const bool has_next = S.next(ui + 1, nxt);
        const char* nA = has_next ? (const char*)g.A + (size_t)nxt.pm * tstepA : cA; const char* nB = has_next ? (const char*)g.Bt + (size_t)nxt.pn * tstepB : cB;
        for (int t = 0; t < nt; t += 2) {
            const bool last = (t == nt - 2);
            const char* a1 = cA + (size_t)(t + 1) * kstep;
            const char* a2 = last ? nA : cA + (size_t)(t + 2) * kstep; const char* b2 = last ? nB : cB + (size_t)(t + 2) * kstep;
            const char* a3 = a2 + kstep; const char* b3 = b2 + kstep;
            if (last && has_next) S.a_ready(nxt);
            if constexpr (SP2) {
            PG8_LDB(B0, 0, 0); PG8_LDB(B1, 0, 1); PG8_SCHED; PG8_LDA(At, 0, 0); PG8_STAGE(PG8_SA(1, 1), a1 + hstepA, voffA);
            PG8_WAIT_V(8); PG8_WAIT_L(0); PG8_BAR; PG8_MMA(0, 0, At, B0); PG8_MMA(0, 1, At, B1); PG8_BAR; PG8_SCHED;
            PG8_LDA(At, 0, 1); PG8_STAGE(PG8_SB(0, 0), b2, voffB); PG8_STAGE(PG8_SB(0, 1), b2 + hstepB, voffB); PG8_STAGE(PG8_SA(0, 0), a2, voffA);
            PG8_WAIT_V(8); PG8_WAIT_L(0); PG8_BAR; PG8_MMA(1, 0, At, B0); PG8_MMA(1, 1, At, B1); PG8_BAR; PG8_SCHED;
            PG8_LDB(B0, 1, 0); PG8_LDB(B1, 1, 1); PG8_SCHED; PG8_LDA(At, 1, 0); PG8_STAGE(PG8_SA(0, 1), a2 + hstepA, voffA);
            PG8_WAIT_V(8); PG8_WAIT_L(0); PG8_BAR; PG8_MMA(0, 0, At, B0); PG8_MMA(0, 1, At, B1); PG8_BAR; PG8_SCHED;
            PG8_LDA(At, 1, 1); PG8_STAGE(PG8_SB(1, 0), b3, voffB); PG8_STAGE(PG8_SB(1, 1), b3 + hstepB, voffB); PG8_STAGE(PG8_SA(1, 0), a3, voffA);
            PG8_WAIT_V(8); PG8_WAIT_L(0); PG8_BAR; PG8_MMA(1, 0, At, B0); PG8_MMA(1, 1, At, B1); PG8_BAR; PG8_SCHED;
            } else {
            PG8_LDB(B0, 0, 0); PG8_SCHED; PG8_LDA(At, 0, 0); PG8_STAGE(PG8_SA(1, 1), a1 + hstepA, voffA);
            PG8_WAIT_L(8); PG8_BAR; PG8_WAIT_L(0); PG8_MMA(0, 0, At, B0); PG8_BAR; PG8_SCHED;
            PG8_LDB(B1, 0, 1); PG8_STAGE(PG8_SB(0, 0), b2, voffB);
            PG8_BAR; PG8_WAIT_L(0); PG8_MMA(0, 1, At, B1); PG8_BAR;
            PG8_LDA(At, 0, 1); PG8_STAGE(PG8_SA(0, 0), a2, voffA);
            PG8_BAR; PG8_WAIT_L(0); PG8_MMA(1, 0, At, B0); PG8_BAR; PG8_SCHED;
            PG8_STAGE(PG8_SB(0, 1), b2 + hstepB, voffB);
            PG8_WAIT_V(6); PG8_BAR; PG8_MMA(1, 1, At, B1); PG8_BAR;
            PG8_LDB(B0, 1, 0); PG8_SCHED; PG8_LDA(At, 1, 0); PG8_STAGE(PG8_SA(0, 1), a2 + hstepA, voffA);
            PG8_WAIT_L(8); PG8_BAR; PG8_WAIT_L(0); PG8_MMA(0, 0, At, B0); PG8_BAR; PG8_SCHED;
            PG8_LDB(B1, 1, 1); PG8_STAGE(PG8_SB(1, 0), b3, voffB);
            PG8_BAR; PG8_WAIT_L(0); PG8_MMA(0, 1, At, B1); PG8_BAR;
            PG8_LDA(At, 1, 1); PG8_STAGE(PG8_SA(1, 0), a3, voffA);
            PG8_BAR; PG8_WAIT_L(0); PG8_MMA(1, 0, At, B0); PG8_BAR; PG8_SCHED;
            PG8_STAGE(PG8_SB(1, 1), b3 + hstepB, voffB);
            PG8_WAIT_V(6); PG8_BAR; PG8_MMA(1, 1, At, B1); PG8_BAR;
            }
        }
        if constexpr (ALIGN_EPI) { if (wr == 0) PG8_BAR; }
        E(acc, cur, wr, wc, fr, fq); S.done(cur);
        if (!has_next) break;
#pragma unroll
        for (int a = 0; a < 2; ++a)
#pragma unroll
            for (int b = 0; b < 2; ++b)
#pragma unroll
                for (int m = 0; m < 4; ++m)
#pragma unroll
                    for (int n = 0; n < 2; ++n) acc[a][b][m][n] = (f32x4){0.f, 0.f, 0.f, 0.f};
        cur = nxt; cA = nA; cB = nB; ++ui;
        if constexpr (ALIGN_EPI) { if (wr == 1) PG8_BAR; }
    }
    PG8_WAIT_V(0);
    if constexpr (!ALIGN_EPI) { if (wr == 0) PG8_BAR; }
    PG8_BAR;
#undef PG8_SA
#undef PG8_SB
#undef PG8_STAGE
#undef PG8_LDA
#undef PG8_LDB
#undef PG8_MMA
#undef PG8_WAIT_V
#undef PG8_WAIT_L
#undef PG8_BAR
#undef PG8_SCHED
}
}

constexpr int NWAVES = 8, NTHR = 512;
constexpr int DM = 4096, NB = 2, SEQ = 8192, NCTX = 256, DFF = 16384;
constexpr int M_LAT = NB * SEQ, M_CTX = NB * NCTX, M_TOT = M_LAT + M_CTX;
constexpr int DIN = 8672, DINP = 8704;
constexpr int C_SWAQ = 0, C_SWAK = 1024, C_SWAV = 1280, C_LRUX = 1536, C_LRUY = 2560, C_QA = 3584, C_KVA = 4608, C_KR = 5120, C_RW = 5184;
constexpr int C_RWR = C_RW, C_RWK = C_RW + 1024, C_RWV = C_RW + 2048, C_RWL = C_RW + 3072;
constexpr int RWC = 3488;
constexpr float LN_EPS = 1e-5f, RMS_EPS = 1e-6f, GN_EPS = 64e-5f, ALPHA = 1.41421356237f;
constexpr int NCH = 264;

constexpr size_t MiB = 1u << 20;
constexpr size_t WS_CTL = 0, CTL_ZERO_BYTES = 1 * MiB;
constexpr size_t WS_MOD = 1 * MiB;
constexpr size_t WS_MODP = 2 * MiB;
constexpr size_t WS_SMALL = 20 * MiB;
constexpr size_t WS_RSQ = WS_SMALL;
constexpr size_t WS_RSKV = WS_RSQ + 128 * 1024;
constexpr size_t WS_SB = WS_RSKV + 128 * 1024;
constexpr size_t WS_CA = WS_SB + 2 * MiB;
constexpr size_t WS_CB = WS_CA + 5 * MiB;
constexpr size_t WS_HIN = WS_CB + 5 * MiB;
constexpr size_t WS_QUIRK = WS_HIN + 5 * MiB;
constexpr size_t WS_ROPE = WS_QUIRK + 8192;
static_assert(WS_ROPE + 16384 <= 40 * MiB, "small region");
constexpr size_t WS_W = 40 * MiB;
constexpr size_t WS_WIN = WS_W, WS_WOUT = WS_WIN + 68 * MiB, WS_WFF1 = WS_WOUT + 32 * MiB, WS_WFF2 = WS_WFF1 + 128 * MiB, WS_WQB = WS_WFF2 + 128 * MiB,
                 WS_WKVB = WS_WQB + 3 * MiB, WS_WLRU = WS_WKVB + 2 * MiB, WS_WLORA = WS_WLRU + 1 * MiB;
constexpr size_t WS_W2T = WS_WLORA, WS_A2T = WS_W2T + 256 * 1024, WS_G2T = WS_A2T + 256 * 1024;
constexpr size_t WS_X = 403 * MiB;
constexpr size_t WS_H = 667 * MiB;
constexpr size_t WS_MIX = 799 * MiB;
constexpr size_t WS_YS = 931 * MiB;
constexpr size_t WS_P = 1063 * MiB;
constexpr size_t WS_RWF = 1344 * MiB;
constexpr size_t RWF_STRIDE = (size_t)M_TOT * 1024 * 2;
constexpr size_t WS_Q = 1641 * MiB;
constexpr size_t WS_KV = 1691 * MiB;
constexpr size_t WS_KR = 1757 * MiB;
constexpr size_t WS_END = 1760 * MiB;
constexpr size_t WS_HID = WS_P;
constexpr size_t WS_Y1 = WS_P;
constexpr size_t WS_Y2 = WS_MIX;
static_assert(WS_WLORA + 1 * MiB <= WS_X && WS_P + (size_t)M_TOT * DINP * 2 <= WS_RWF && WS_RWF + 9 * RWF_STRIDE <= WS_Q, "ws map");
static_assert(WS_HID + (size_t)M_TOT * DFF * 2 <= WS_Q && WS_Y2 + (size_t)M_TOT * DM * 4 <= WS_P && WS_YS + 2 * (size_t)M_TOT * 1024 * 4 <= WS_P, "ws overlays");
static_assert(WS_KR + (size_t)M_TOT * 64 * 2 <= WS_END, "ws end");

constexpr int RING_BYTES = 131072;
constexpr int LDSCTL_OFF = RING_BYTES, MISC_OFF = LDSCTL_OFF + 320;
constexpr int LDS_BYTES = 147456;

#define GAS __attribute__((address_space(1)))
#define LAS __attribute__((address_space(3)))
typedef unsigned short bf16;
typedef unsigned v4u __attribute__((ext_vector_type(4)));
typedef unsigned v2u __attribute__((ext_vector_type(2)));
typedef float f32x4 __attribute__((ext_vector_type(4)));
typedef float f32x2 __attribute__((ext_vector_type(2)));
typedef float f32x16 __attribute__((ext_vector_type(16)));
typedef short bf16x8 __attribute__((ext_vector_type(8)));
typedef short s16x4 __attribute__((ext_vector_type(4)));
typedef GAS unsigned gu32;
typedef const GAS bf16* gcbf; typedef GAS bf16* gbfp; typedef const GAS float* gcfl; typedef GAS float* gflp;
#define LDS_WAIT() asm volatile("s_waitcnt lgkmcnt(0)" ::: "memory")
#define VM_WAIT() asm volatile("s_waitcnt vmcnt(0)" ::: "memory")
__device__ __forceinline__ unsigned f2bf(float f) { unsigned u = __builtin_bit_cast(unsigned, f); return (u + 0x7fffu + ((u >> 16) & 1u)) >> 16; }
__device__ __forceinline__ unsigned pk2(float lo, float hi) { return f2bf(lo) | (f2bf(hi) << 16); }
__device__ __forceinline__ float bflo(unsigned w) { return __builtin_bit_cast(float, w << 16); }
__device__ __forceinline__ float bfhi(unsigned w) { return __builtin_bit_cast(float, w & 0xffff0000u); }
__device__ __forceinline__ float bf2f(bf16 h) { return __builtin_bit_cast(float, (unsigned)h << 16); }
__device__ __forceinline__ float wave_sum(float v) {
#pragma unroll
    for (int o = 1; o < 64; o <<= 1) v += __shfl_xor(v, o);
    return v;
}
__device__ __forceinline__ float sigmoidf_(float x) { return 1.f / (1.f + __expf(-x)); }
__device__ __forceinline__ float softplusf_(float x) { return x > 20.f ? x : __logf(1.f + __expf(x)); }
__device__ __forceinline__ float tanhf_(float x) { const float e = __expf(2.f * x); return 1.f - 2.f / (e + 1.f); }
__device__ __forceinline__ int ltid() { int t = threadIdx.x; asm volatile("" : "+v"(t)); return t; }
template <class T> __device__ __forceinline__ T ldg(const void* base, unsigned byteoff) { return *(const T*)((const char*)base + byteoff); }
template <class T> __device__ __forceinline__ void stg(void* base, unsigned byteoff, T v) { *(T*)((char*)base + byteoff) = v; }

#define XB_TMO      128
#define XB_XCNT(j)  (256  + 64 * (j))
#define XB_XSUB(j)  (1280 + 64 * (j))
#define XB_XGEN(j)  (2304 + 64 * (j))
#define XB_TOP      3328
#define XB_TOPGEN   3392
#define XCD_BAR_WORDS 3456
#define XB_SPIN_CAP (1u << 18)

__device__ __forceinline__ unsigned xb_ld(unsigned* p)              { return __hip_atomic_load(p, __ATOMIC_RELAXED, __HIP_MEMORY_SCOPE_AGENT); }
__device__ __forceinline__ unsigned xb_add(unsigned* p, unsigned v) { return __hip_atomic_fetch_add(p, v, __ATOMIC_RELAXED, __HIP_MEMORY_SCOPE_AGENT); }
__device__ __forceinline__ unsigned xb_xcc_id() { return (unsigned)__builtin_amdgcn_s_getreg((3 << 11) | 20) & 0xFu; }
#define XB_SPIN(cond, bar) do { unsigned _sp = 0; while (cond) { __builtin_amdgcn_s_sleep(1); \
    if ((++_sp & 255u) == 0u) { if (xb_ld(&(bar)[XB_TMO])) break; if (_sp > XB_SPIN_CAP) { atomicAdd(&(bar)[XB_TMO], 1u); break; } } } } while (0)

struct XcdBarrier {
    unsigned* bar; unsigned x;
    volatile LAS unsigned* st;
};

__device__ __forceinline__ XcdBarrier xcd_barrier_post(unsigned* bar, volatile LAS unsigned* st) {
    XcdBarrier b; b.bar = bar; b.x = xb_xcc_id(); b.st = st;
    if (threadIdx.x == 0) (void)xb_add(&bar[XB_XCNT(b.x)], 1u);
    return b;
}
__device__ __forceinline__ void xcd_barrier_complete(unsigned* bar, unsigned x, unsigned& nloc, unsigned& nx) {
    const unsigned G = gridDim.x * gridDim.y * gridDim.z;
    unsigned sum, cnt, mine, sp = 0u;
    for (;;) {
        sum = 0u; cnt = 0u; mine = 0u;
#pragma unroll
        for (unsigned j = 0; j < 16; ++j) { const unsigned c = xb_ld(&bar[XB_XCNT(j)]); sum += c; cnt += (c > 0u) ? 1u : 0u; mine = (j == x) ? c : mine; }
        if (sum == G) break;
        __builtin_amdgcn_s_sleep(1);
        if ((++sp & 255u) == 0u) { if (xb_ld(&bar[XB_TMO])) break; if (sp > XB_SPIN_CAP) { atomicAdd(&bar[XB_TMO], 1u); break; } }
    }
    nloc = mine > 0u ? mine : 1u; nx = cnt > 0u ? cnt : 1u;
}

__device__ __forceinline__ void xcd_barrier(const XcdBarrier& b) {
    asm volatile("s_waitcnt vmcnt(0)" ::: "memory");
    __syncthreads();
    if (threadIdx.x == 0) {
        unsigned* bar = b.bar;
        __builtin_amdgcn_s_waitcnt(0);
        unsigned nloc = b.st[0], nx = b.st[1];
        if (nloc == 0u) { xcd_barrier_complete(bar, b.x, nloc, nx); b.st[0] = nloc; b.st[1] = nx; }
        const unsigned old = xb_add(&bar[XB_XSUB(b.x)], 1u);
        const unsigned gen = old / nloc;
        if (old + 1u == (gen + 1u) * nloc) {
            __builtin_amdgcn_fence(__ATOMIC_RELEASE, "agent");
            asm volatile("s_waitcnt vmcnt(0)" ::: "memory");
            const unsigned og = xb_add(&bar[XB_TOP], 1u);
            const unsigned tg = og / nx;
            if (og + 1u == (tg + 1u) * nx) xb_add(&bar[XB_TOPGEN], 1u);
            else XB_SPIN(xb_ld(&bar[XB_TOPGEN]) == tg, bar);
            __builtin_amdgcn_fence(__ATOMIC_ACQUIRE, "agent");
            xb_add(&bar[XB_XGEN(b.x)], 1u);
            asm volatile("s_waitcnt vmcnt(0)" ::: "memory");
        } else {
            XB_SPIN(xb_ld(&bar[XB_XGEN(b.x)]) == gen, bar);
            __builtin_amdgcn_fence(__ATOMIC_ACQUIRE, "agent");
            asm volatile("s_waitcnt vmcnt(0)" ::: "memory");
        }
    }
    __syncthreads();
}


namespace att {
constexpr int KVBLK = 64;
constexpr float THR = 8.f;
#define SBAR() __builtin_amdgcn_sched_barrier(0)
__device__ __forceinline__ int crow(int r, int hi) { return (r & 3) + 8 * (r >> 2) + 4 * hi; }
__device__ __forceinline__ unsigned cvtpk(float lo, float hi) { unsigned r; asm volatile("v_cvt_pk_bf16_f32 %0, %1, %2" : "=v"(r) : "v"(lo), "v"(hi)); return r; }
template <int DQK> __device__ __forceinline__ int kswz(int row, int cb) { return row * (DQK * 2 + 16) + cb; }

template <int DQK> __device__ __forceinline__ void partialSM(f32x16& p0, f32x16& p1, float& m_reg, float& mn, float& alpha) {
  constexpr float SCALE = DQK == 128 ? 0.088388347648318440f : 0.072168783648703220f;
  constexpr float C = SCALE * 1.4426950408889634f;
  float pmax = p0[0];
#pragma unroll
  for (int r = 1; r < 16; ++r) pmax = fmaxf(pmax, p0[r]);
#pragma unroll
  for (int r = 0; r < 16; ++r) pmax = fmaxf(pmax, p1[r]);
  { auto rr = __builtin_amdgcn_permlane32_swap(__float_as_uint(pmax), __float_as_uint(pmax), false, false);
    pmax = fmaxf(__uint_as_float(rr[0]), __uint_as_float(rr[1])); }
  if (__builtin_expect(__all(pmax - m_reg <= THR / SCALE), 1)) { mn = m_reg; alpha = 1.f; }
  else { mn = fmaxf(m_reg, pmax); alpha = __builtin_amdgcn_exp2f((m_reg - mn) * C); m_reg = mn; }
  const float mnC = -mn * C;
#pragma unroll
  for (int r = 0; r < 16; ++r) p0[r] = fmaf(p0[r], C, mnC);
#pragma unroll
  for (int r = 0; r < 16; ++r) p1[r] = fmaf(p1[r], C, mnC);
#pragma unroll
  for (int r = 0; r < 16; ++r) p0[r] = __builtin_amdgcn_exp2f(p0[r]);
}
__device__ __forceinline__ void finishSM(f32x16& p0, f32x16& p1, float alpha, float& l_reg, bf16x8& pa0, bf16x8& pa1, bf16x8& pa2, bf16x8& pa3) {
#pragma unroll
  for (int r = 0; r < 16; ++r) p1[r] = __builtin_amdgcn_exp2f(p1[r]);
  float ps = 0;
#pragma unroll
  for (int r = 0; r < 16; ++r) ps += p0[r];
#pragma unroll
  for (int r = 0; r < 16; ++r) ps += p1[r];
  { auto rr = __builtin_amdgcn_permlane32_swap(__float_as_uint(ps), __float_as_uint(ps), false, false);
    ps = __uint_as_float(rr[0]) + __uint_as_float(rr[1]); }
  l_reg = l_reg * alpha + ps;
#define PK4(P, BASE, OUT) do { unsigned a0 = cvtpk(P[BASE + 0], P[BASE + 1]), a1 = cvtpk(P[BASE + 2], P[BASE + 3]);   \
    unsigned b0 = cvtpk(P[BASE + 4], P[BASE + 5]), b1 = cvtpk(P[BASE + 6], P[BASE + 7]);                              \
    auto r0 = __builtin_amdgcn_permlane32_swap(a0, b0, false, false); auto r1 = __builtin_amdgcn_permlane32_swap(a1, b1, false, false); \
    v4u w = {r0[0], r1[0], r0[1], r1[1]}; OUT = __builtin_bit_cast(bf16x8, w); } while (0)
  PK4(p0, 0, pa0); PK4(p0, 8, pa1); PK4(p1, 0, pa2); PK4(p1, 8, pa3);
#undef PK4
}
template <int DQK> __device__ __forceinline__ void qkt(f32x16& p0, f32x16& p1, const LAS char* Ks, const bf16x8* qr, const LAS char* qx, int r32, int hi) {
  p0 = f32x16{}; p1 = f32x16{};
#pragma unroll
  for (int d0 = 0; d0 < DQK / 16; ++d0) { const int cb = (d0 * 16 + hi * 8) * 2;
    bf16x8 b0 = *(const LAS bf16x8*)(Ks + kswz<DQK>(r32, cb));
    bf16x8 b1 = *(const LAS bf16x8*)(Ks + kswz<DQK>(32 + r32, cb));
    bf16x8 q; if (d0 < 8) q = qr[d0]; else q = *(const LAS bf16x8*)(qx + (d0 - 8) * 32);
    p0 = __builtin_amdgcn_mfma_f32_32x32x16_bf16(b0, q, p0, 0, 0, 0);
    p1 = __builtin_amdgcn_mfma_f32_32x32x16_bf16(b1, q, p1, 0, 0, 0);
    if ((d0 & 3) == 3 && d0 + 1 < DQK / 16) SBAR(); }
}
__device__ __forceinline__ int v_st(int k, int c) { const int kk = (k & ~0xC) | ((k & 4) << 1) | ((k & 8) >> 1); return ((kk >> 3) * 4 + (c >> 5)) * 512 + ((kk & 7) * 32 + (c & 31)) * 2; }
__device__ __forceinline__ int v_rd_base(int lane) { return ((lane & 3) << 3) | (((lane >> 2) & 3) << 6) | (((lane >> 4) & 1) << 5) | (((lane >> 5) & 1) << 8); }
constexpr int v_rd_off(int d0, int ks, int half) { return d0 * 512 + ks * 4096 + half * 2048; }
template <int OFF> __device__ __forceinline__ s16x4 tr_read(int vb) {
  s16x4 r; asm volatile("ds_read_b64_tr_b16 %0, %1 offset:%2" : "=&v"(r) : "v"(vb), "i"(OFF) : "memory"); return r;
}
template <int D0> __device__ __forceinline__ void pv_one(f32x16& od, int vb, bf16x8 pa0, bf16x8 pa1, bf16x8 pa2, bf16x8 pa3) {
  const s16x4 l0 = tr_read<v_rd_off(D0, 0, 0)>(vb), h0 = tr_read<v_rd_off(D0, 0, 1)>(vb), l1 = tr_read<v_rd_off(D0, 1, 0)>(vb), h1 = tr_read<v_rd_off(D0, 1, 1)>(vb);
  const s16x4 l2 = tr_read<v_rd_off(D0, 2, 0)>(vb), h2 = tr_read<v_rd_off(D0, 2, 1)>(vb), l3 = tr_read<v_rd_off(D0, 3, 0)>(vb), h3 = tr_read<v_rd_off(D0, 3, 1)>(vb);
  asm volatile("s_waitcnt lgkmcnt(0)" ::: "memory"); SBAR();
#define PK(L, H) (bf16x8){L[0], L[1], L[2], L[3], H[0], H[1], H[2], H[3]}
  od = __builtin_amdgcn_mfma_f32_32x32x16_bf16(pa0, PK(l0, h0), od, 0, 0, 0);
  od = __builtin_amdgcn_mfma_f32_32x32x16_bf16(pa1, PK(l1, h1), od, 0, 0, 0);
  od = __builtin_amdgcn_mfma_f32_32x32x16_bf16(pa2, PK(l2, h2), od, 0, 0, 0);
  od = __builtin_amdgcn_mfma_f32_32x32x16_bf16(pa3, PK(l3, h3), od, 0, 0, 0);
#undef PK
}
__device__ __forceinline__ void pv_d0(f32x16* o, int vb, bf16x8 pa0, bf16x8 pa1, bf16x8 pa2, bf16x8 pa3) {
  pv_one<0>(o[0], vb, pa0, pa1, pa2, pa3); pv_one<1>(o[1], vb, pa0, pa1, pa2, pa3); pv_one<2>(o[2], vb, pa0, pa1, pa2, pa3); pv_one<3>(o[3], vb, pa0, pa1, pa2, pa3);
}
__device__ __forceinline__ void apply_mask(f32x16& p0, f32x16& p1, int mtype, int krel0, int qi, int hi) {
  if (mtype == 0) return;
  const float ninf = -__builtin_inff();
#pragma unroll
  for (int r = 0; r < 16; ++r) { const int k0 = krel0 + crow(r, hi), k1 = k0 + 32;
    const bool ok0 = (mtype == 1) ? (k0 >= qi - 128) : (k0 <= qi + 128), ok1 = (mtype == 1) ? (k1 >= qi - 128) : (k1 <= qi + 128);
    p0[r] = ok0 ? p0[r] : ninf; p1[r] = ok1 ? p1[r] : ninf; }
}
struct Tile { gcbf kn; gcbf kr; gcbf v; int mtype; int krel0; };

__device__ __forceinline__ void rope_pair(bf16x8& a, bf16x8& b, gcfl ct, gcfl st) {
  const f32x4 c0 = *(const GAS f32x4*)ct, c1 = *(const GAS f32x4*)(ct + 4), s0 = *(const GAS f32x4*)st, s1 = *(const GAS f32x4*)(st + 4);
  const float cs[8] = {c0[0], c0[1], c0[2], c0[3], c1[0], c1[1], c1[2], c1[3]}, sn[8] = {s0[0], s0[1], s0[2], s0[3], s1[0], s1[1], s1[2], s1[3]};
  v4u ua = __builtin_bit_cast(v4u, a), ub = __builtin_bit_cast(v4u, b); v4u oa, ob;
#pragma unroll
  for (int w = 0; w < 4; ++w) { const float x1[2] = {bflo(ua[w]), bfhi(ua[w])}, x2[2] = {bflo(ub[w]), bfhi(ub[w])}; float y1[2], y2[2];
#pragma unroll
    for (int e = 0; e < 2; ++e) { const float c = cs[2 * w + e], sv = sn[2 * w + e]; y1[e] = x1[e] * c - x2[e] * sv; y2[e] = x2[e] * c + x1[e] * sv; }
    oa[w] = pk2(y1[0], y1[1]); ob[w] = pk2(y2[0], y2[1]); }
  a = __builtin_bit_cast(bf16x8, oa); b = __builtin_bit_cast(bf16x8, ob);
}

template <int DQK, int LDKN, int LDV, bool MASK, bool SINK, int SDEPTH, class TS>
__device__ __forceinline__ void attn_body(gcbf Qw, int rope, int prow, int pcol, gcfl rtab, int qi, float sink_l2, const TS& ts, int NT, gbfp Ow, LAS char* lds) {
  constexpr float SCALE = DQK == 128 ? 0.088388347648318440f : 0.072168783648703220f;
  constexpr float C = SCALE * 1.4426950408889634f;
  constexpr int SHM_K = KVBLK * (DQK * 2 + 16), SHM_V = KVBLK * 128 * 2;
  int tid = threadIdx.x; asm volatile("" : "+v"(tid));
  const int wid = tid >> 6, lane = tid & 63, r32 = lane & 31, hi = lane >> 5;
  LAS char* V_lds = lds; LAS char* K_lds = lds + 2 * SHM_V;
  LAS float* wsl = (LAS float*)(lds + 2 * SHM_V + 2 * SHM_K) + wid * 64; LAS float* li_l = wsl; LAS float* al_l = wsl + 32;
  float m_reg = -1e30f, l_reg = 0; f32x16 o[4] = {}; bf16x8 qr[8];
#pragma unroll
  for (int d0 = 0; d0 < 8; ++d0) qr[d0] = *(const GAS bf16x8*)(Qw + d0 * 16 + hi * 8);
  const LAS char* qx = lds + 2 * SHM_V + 2 * SHM_K + 2048 + wid * 4608 + r32 * 144 + hi * 16;
  if constexpr (DQK == 192) {
    bf16x8 x0 = *(const GAS bf16x8*)(Qw + 128 + hi * 8), x1 = *(const GAS bf16x8*)(Qw + 144 + hi * 8), x2 = *(const GAS bf16x8*)(Qw + 160 + hi * 8), x3 = *(const GAS bf16x8*)(Qw + 176 + hi * 8);
    if (rope) {
      rope_pair(x0, x1, rtab + (size_t)prow * 16 + hi * 8, rtab + 2048 + (size_t)prow * 16 + hi * 8);
      rope_pair(x2, x3, rtab + (size_t)pcol * 16 + hi * 8, rtab + 2048 + (size_t)pcol * 16 + hi * 8); }
    LAS char* qw_ = (LAS char*)qx; *(LAS bf16x8*)(qw_) = x0; *(LAS bf16x8*)(qw_ + 32) = x1; *(LAS bf16x8*)(qw_ + 64) = x2; *(LAS bf16x8*)(qw_ + 96) = x3;
  }
  const int sr = tid >> 4, sc = (tid & 15) * 8, vst0 = v_st(sr, sc), vst1 = v_st(32 + sr, sc);
  const int rr_ = tid >> 3, rc_ = (tid & 7) * 8;
  const int vb0 = (int)(uintptr_t)V_lds + v_rd_base(lane);
  struct { bf16x8 vs0, vs1, ks0, ks1, kx; } sr_[SDEPTH];
#define SLOAD(i, jt) do { const Tile t_ = ts(jt); sr_[i].vs0 = *(const GAS bf16x8*)(t_.v + (size_t)sr * LDV + sc); sr_[i].vs1 = *(const GAS bf16x8*)(t_.v + (size_t)(32 + sr) * LDV + sc); \
    sr_[i].ks0 = *(const GAS bf16x8*)(t_.kn + (size_t)sr * LDKN + sc); sr_[i].ks1 = *(const GAS bf16x8*)(t_.kn + (size_t)(32 + sr) * LDKN + sc); \
    if constexpr (DQK == 192) sr_[i].kx = *(const GAS bf16x8*)(t_.kr + (size_t)rr_ * 64 + rc_); } while (0)
#define SWRITE(b, i) do { *(LAS bf16x8*)(V_lds + (b) * SHM_V + vst0) = sr_[i].vs0; *(LAS bf16x8*)(V_lds + (b) * SHM_V + vst1) = sr_[i].vs1; const int kc = sc * 2; \
    *(LAS bf16x8*)(K_lds + (b) * SHM_K + kswz<DQK>(sr, kc)) = sr_[i].ks0; *(LAS bf16x8*)(K_lds + (b) * SHM_K + kswz<DQK>(32 + sr, kc)) = sr_[i].ks1; \
    if constexpr (DQK == 192) *(LAS bf16x8*)(K_lds + (b) * SHM_K + kswz<DQK>(rr_, 256 + rc_ * 2)) = sr_[i].kx; } while (0)
#define SWAIT() do { if constexpr (SDEPTH == 2) { if constexpr (DQK == 192) asm volatile("s_waitcnt vmcnt(5)" ::: "memory"); else asm volatile("s_waitcnt vmcnt(4)" ::: "memory"); } \
    else asm volatile("s_waitcnt vmcnt(0)" ::: "memory"); } while (0)
#define RESC(a) do { if (__any((a) < 1.f)) { if (hi == 0) al_l[r32] = (a); asm volatile("s_waitcnt lgkmcnt(0)" ::: "memory"); \
    _Pragma("unroll") for (int d = 0; d < 4; ++d) _Pragma("unroll") for (int r = 0; r < 16; ++r) o[d][r] *= al_l[crow(r, hi)]; } } while (0)
#define MASKT(pa_, pb_, jt) do { if constexpr (MASK) { const Tile t_ = ts(jt); apply_mask(pa_, pb_, t_.mtype, t_.krel0, qi, hi); } } while (0)
  f32x16 pA0, pA1, pB0, pB1; float mnA, mnB, alA, alB; bf16x8 pa0, pa1, pa2, pa3;
  constexpr int SE = 0, SO = SDEPTH - 1;
  SLOAD(SE, 0); asm volatile("s_waitcnt vmcnt(0)" ::: "memory"); SWRITE(0, SE); __syncthreads();
  qkt<DQK>(pA0, pA1, K_lds, qr, qx, r32, hi); MASKT(pA0, pA1, 0); partialSM<DQK>(pA0, pA1, m_reg, mnA, alA);
  SLOAD(SO, 1); if constexpr (SDEPTH == 2) { if (2 < NT) SLOAD(SE, 2); }
  SWAIT(); SWRITE(1, SO); __syncthreads();
  for (int j = 1; j + 1 < NT; j += 2) {
    SBAR(); qkt<DQK>(pB0, pB1, K_lds + SHM_K, qr, qx, r32, hi); MASKT(pB0, pB1, j);
    finishSM(pA0, pA1, alA, l_reg, pa0, pa1, pa2, pa3); SBAR();
    SLOAD(SO, j + SDEPTH); SBAR();
    pv_d0(o, vb0, pa0, pa1, pa2, pa3); partialSM<DQK>(pB0, pB1, m_reg, mnB, alB);
    __syncthreads(); SWAIT(); SWRITE(0, SE);
    RESC(alB); __syncthreads();
    SBAR(); qkt<DQK>(pA0, pA1, K_lds, qr, qx, r32, hi); MASKT(pA0, pA1, j + 1);
    finishSM(pB0, pB1, alB, l_reg, pa0, pa1, pa2, pa3); SBAR();
    if (SDEPTH == 1 || j + 3 < NT) SLOAD(SE, j + 1 + SDEPTH); SBAR();
    pv_d0(o, vb0 + SHM_V, pa0, pa1, pa2, pa3); partialSM<DQK>(pA0, pA1, m_reg, mnA, alA);
    __syncthreads(); SWAIT(); SWRITE(1, SO);
    RESC(alA); __syncthreads();
  }
  SBAR(); qkt<DQK>(pB0, pB1, K_lds + SHM_K, qr, qx, r32, hi); MASKT(pB0, pB1, NT - 1);
  finishSM(pA0, pA1, alA, l_reg, pa0, pa1, pa2, pa3); SBAR();
  pv_d0(o, vb0, pa0, pa1, pa2, pa3); partialSM<DQK>(pB0, pB1, m_reg, mnB, alB);
  __syncthreads(); RESC(alB);
  finishSM(pB0, pB1, alB, l_reg, pa0, pa1, pa2, pa3); SBAR();
  pv_d0(o, vb0 + SHM_V, pa0, pa1, pa2, pa3);
  if constexpr (SINK) l_reg += __builtin_amdgcn_exp2f(sink_l2 - m_reg * C);
  if (hi == 0) li_l[r32] = l_reg; asm volatile("s_waitcnt lgkmcnt(0)" ::: "memory");
  float rli[16];
#pragma unroll
  for (int r = 0; r < 16; ++r) rli[r] = __builtin_amdgcn_rcpf(li_l[crow(r, hi)]);
  __syncthreads();
  LAS bf16* ost = (LAS bf16*)(lds + wid * 8704);
#pragma unroll
  for (int r = 0; r < 16; ++r) { const int orow = crow(r, hi);
#pragma unroll
    for (int d0 = 0; d0 < 4; ++d0) ost[orow * 136 + d0 * 32 + r32] = (bf16)f2bf(o[d0][r] * rli[r]); }
  asm volatile("s_waitcnt lgkmcnt(0)" ::: "memory");
#pragma unroll
  for (int i = 0; i < 8; ++i) { const int orow = i * 4 + (lane >> 4), ch = lane & 15;
    *(GAS v4u*)(Ow + (size_t)orow * 4096 + ch * 8) = *(const LAS v4u*)(ost + orow * 136 + ch * 8); }
  __syncthreads();
#undef SLOAD
#undef SWRITE
#undef SWAIT
#undef RESC
#undef MASKT
}
}

struct Args { const float* in[38]; float* out; unsigned char* ws; };
template <class T> __device__ __forceinline__ T launder(T p) { asm volatile("" : "+s"(p)); return p; }
template <class T> __device__ __forceinline__ T* launder_g(T* p) { asm volatile("" : "+s"(p)); return p; }
struct Frame {
    LAS unsigned char* lds;
    gu32* ctl;
    int tid, lane, wave;
    int vcu, G, gw, NGW;
    const __attribute__((address_space(4))) Args* A;
    float* out;
    unsigned char* ws;
};
enum { I_X = 0, I_C, I_CTX, I_CCTX, I_WMOD, I_BMOD, I_WIN, I_WOUT, I_LN1G, I_LN1B, I_WFF1, I_WFF2, I_LN2G, I_LN2B, I_SINK, I_CONVW, I_CONVB, I_LWA, I_LBA, I_LWI, I_LBI, I_LAM,
       I_QNORM, I_KVNORM, I_WQB, I_WKVB, I_MUP, I_MUN, I_W0, I_W2, I_A0, I_A2, I_G2, I_KK, I_KA, I_RK, I_LNG, I_LNB };
__device__ __forceinline__ int row_s(int row) { return row < SEQ ? 0 : (row < M_LAT ? 1 : 2); }
__device__ __forceinline__ const float* mod_ptr(const Frame& F, int l, int s, int chunk) { return (const float*)(F.ws + WS_MOD) + ((size_t)(l * 3 + s) * 6 + chunk) * DM; }

__device__ __forceinline__ void transpose_item(const float* W, int N, int Kvalid, bf16* WT, int ldt, const float* kscale, LAS float* scr, int k0, int n0, int lane) {
#pragma unroll 8
    for (int i = 0; i < 32; ++i) { const int kk = 2 * i + (lane >> 5); const int k = k0 + kk; float v = 0.f;
        if (k < Kvalid) { v = W[(size_t)k * N + n0 + (lane & 31)]; if (kscale) v *= kscale[k]; }
        scr[kk * 33 + (lane & 31)] = v; }
    LDS_WAIT(); asm volatile("" ::: "memory");
    const int c = lane & 7;
#pragma unroll
    for (int j = 0; j < 4; ++j) { const int n = (lane >> 3) + 8 * j; const LAS float* s = scr + (8 * c) * 33 + n;
        v4u o; o.x = pk2(s[0 * 33], s[1 * 33]); o.y = pk2(s[2 * 33], s[3 * 33]); o.z = pk2(s[4 * 33], s[5 * 33]); o.w = pk2(s[6 * 33], s[7 * 33]);
        *(v4u*)(WT + (size_t)(n0 + n) * ldt + k0 + 8 * c) = o; }
    LDS_WAIT(); asm volatile("" ::: "memory");
}
__device__ __forceinline__ void convert_weights(Frame& F, int l) {
    LAS float* scr = (LAS float*)(F.lds + F.wave * 16384);
    constexpr int I1 = 64 * 271, I2 = 64 * 128, I3 = 64 * 512, I4 = 256 * 128, I5 = 16 * 48, I6 = 8 * 64, I7 = 32 * 8, I8 = 2 * 32, I9 = 2 * 32, I10 = 3 * 32;
    constexpr int NIT = I1 + I2 + I3 + I4 + I5 + I6 + I7 + I8 + I9 + I10;
    unsigned char* ws = F.ws;
    for (int it = F.gw; it < NIT; it += F.NGW) {
        int r = it;
        if (r < I1) { transpose_item(F.A->in[I_WIN] + (size_t)l * DM * DIN, DIN, DM, (bf16*)(ws + WS_WIN), DM, nullptr, scr, 64 * (r / 271), 32 * (r % 271), F.lane); continue; } r -= I1;
        if (r < I2) { transpose_item(F.A->in[I_WOUT] + (size_t)l * DM * DM, DM, DM, (bf16*)(ws + WS_WOUT), DM, nullptr, scr, 64 * (r / 128), 32 * (r % 128), F.lane); continue; } r -= I2;
        if (r < I3) { transpose_item(F.A->in[I_WFF1] + (size_t)l * DM * DFF, DFF, DM, (bf16*)(ws + WS_WFF1), DM, nullptr, scr, 64 * (r / 512), 32 * (r % 512), F.lane); continue; } r -= I3;
        if (r < I4) { transpose_item(F.A->in[I_WFF2] + (size_t)l * DFF * DM, DM, DFF, (bf16*)(ws + WS_WFF2), DFF, nullptr, scr, 64 * (r / 128), 32 * (r % 128), F.lane); continue; } r -= I4;
        if (r < I5) { transpose_item(F.A->in[I_WQB] + (size_t)l * 1024 * 1536, 1536, 1024, (bf16*)(ws + WS_WQB), 1024, F.A->in[I_QNORM] + l * 1024, scr, 64 * (r / 48), 32 * (r % 48), F.lane); continue; } r -= I5;
        if (r < I6) { transpose_item(F.A->in[I_WKVB] + (size_t)l * 512 * 2048, 2048, 512, (bf16*)(ws + WS_WKVB), 512, F.A->in[I_KVNORM] + l * 512, scr, 64 * (r / 64), 32 * (r % 64), F.lane); continue; } r -= I6;
        if (r < I7) { const int mat = r >> 3, sub = r & 7, gate = mat & 1, dn = mat >> 1;
            const int d = dn >> 3, n = dn & 7;
            const float* src = (gate ? F.A->in[I_LWI] : F.A->in[I_LWA]) + ((size_t)(l * 2 + d) * 8 + n) * 128 * 128;
            bf16* dst = (bf16*)(ws + WS_WLRU) + ((size_t)(d * 2 + gate) * 8 + n) * 128 * 128;
            transpose_item(src, 128, 128, dst, 128, nullptr, scr, 64 * (sub >> 2), 32 * (sub & 3), F.lane); continue; } r -= I7;
        if (r < I8) { const int d = r >> 5; transpose_item(F.A->in[I_W2] + (size_t)(l * 2 + d) * 64 * 1024, 1024, 64, (bf16*)(ws + WS_W2T) + (size_t)d * 1024 * 64, 64, nullptr, scr, 0, 32 * (r & 31), F.lane); continue; } r -= I8;
        if (r < I9) { const int d = r >> 5; transpose_item(F.A->in[I_A2] + (size_t)(l * 2 + d) * 64 * 1024, 1024, 64, (bf16*)(ws + WS_A2T) + (size_t)d * 1024 * 64, 64, nullptr, scr, 0, 32 * (r & 31), F.lane); continue; } r -= I9;
        transpose_item(F.A->in[I_G2] + (size_t)l * 160 * 1024, 1024, 160, (bf16*)(ws + WS_G2T), 192, nullptr, scr, 64 * (r / 32), 32 * (r % 32), F.lane);
    }
    { unsigned zz = 0u; asm volatile("" : "+v"(zz)); v4u z = {zz, zz, zz, zz}; v4u* p = (v4u*)((bf16*)(ws + WS_WIN) + (size_t)DIN * DM);
      for (int i = F.gw * 64 + F.lane; i < 32 * DM / 8; i += F.NGW * 64) p[i] = z; }
}

__device__ __forceinline__ void mod_partials(Frame& F) {
    LAS float* sl = (LAS float*)F.lds;
    for (int it = F.vcu; it < 2 * 32 * 12; it += F.G) {
        const int l = it / 384, ks = (it / 12) % 32, cc = it % 12;
        __syncthreads();
        if (F.tid < 384) { const int s = F.tid >> 7, k = ks * 128 + (F.tid & 127); const float c = s < 2 ? F.A->in[I_C][s * DM + k] : F.A->in[I_CCTX][k]; sl[F.tid] = c / (1.f + __expf(-c)); }
        __syncthreads();
        const float* wp = F.A->in[I_WMOD] + ((size_t)l * DM + ks * 128) * 24576 + cc * 2048 + F.tid * 4;
        f32x4 a0 = {0.f, 0.f, 0.f, 0.f}, a1 = a0, a2 = a0;
#pragma unroll 8
        for (int k = 0; k < 128; ++k) { const f32x4 w = *(const f32x4*)(wp + (size_t)k * 24576); a0 += w * sl[k]; a1 += w * sl[128 + k]; a2 += w * sl[256 + k]; }
        float* op = (float*)(F.ws + WS_MODP) + ((size_t)(l * 32 + ks) * 3) * 24576 + cc * 2048 + F.tid * 4;
        *(f32x4*)(op) = a0; *(f32x4*)(op + 24576) = a1; *(f32x4*)(op + 2 * 24576) = a2;
    }
    __syncthreads();
}
__device__ __forceinline__ void mod_reduce(Frame& F) {
    for (int i = F.vcu * NTHR + F.tid; i < 2 * 3 * 24576; i += F.G * NTHR) {
        const int l = i / (3 * 24576), s = (i / 24576) % 3, n = i % 24576;
        float a = F.A->in[I_BMOD][l * 24576 + n];
        const float* pp = (const float*)(F.ws + WS_MODP) + ((size_t)(l * 32) * 3 + s) * 24576 + n;
#pragma unroll 8
        for (int ks = 0; ks < 32; ++ks) a += pp[(size_t)ks * 3 * 24576];
        ((float*)(F.ws + WS_MOD))[i] = a;
    }
}

template <int MODE>
__device__ __forceinline__ void ln_row(const Frame& F, const float* xsrc, const float* Y, const float* ga, const float* lg, const float* lb, float* xdst,
                                       bool domod, const float* sc, const float* sh, bf16* hrow) {
    f32x4 v[16]; float s = 0.f;
#pragma unroll
    for (int j = 0; j < 16; ++j) { const int c = 4 * F.lane + 256 * j; v[j] = *(const f32x4*)(xsrc + c);
        if (MODE == 1) { const f32x4 y = *(const f32x4*)(Y + c), g = *(const f32x4*)(ga + c); v[j] = v[j] * ALPHA + g * y; }
        s += (v[j].x + v[j].y) + (v[j].z + v[j].w); }
    float mean = wave_sum(s) * (1.f / DM), s2 = 0.f;
#pragma unroll
    for (int j = 0; j < 16; ++j) { v[j] = v[j] - mean; s2 += (v[j].x * v[j].x + v[j].y * v[j].y) + (v[j].z * v[j].z + v[j].w * v[j].w); }
    float rstd = 1.f / sqrtf(wave_sum(s2) * (1.f / DM) + LN_EPS);
    if (MODE == 1) {
        s = 0.f;
#pragma unroll
        for (int j = 0; j < 16; ++j) { const int c = 4 * F.lane + 256 * j; const f32x4 g = *(const f32x4*)(lg + c), b = *(const f32x4*)(lb + c); v[j] = v[j] * rstd * g + b;
            *(f32x4*)(xdst + c) = v[j]; s += (v[j].x + v[j].y) + (v[j].z + v[j].w); }
        if (!domod) return;
        mean = wave_sum(s) * (1.f / DM); s2 = 0.f;
#pragma unroll
        for (int j = 0; j < 16; ++j) { v[j] = v[j] - mean; s2 += (v[j].x * v[j].x + v[j].y * v[j].y) + (v[j].z * v[j].z + v[j].w * v[j].w); }
        rstd = 1.f / sqrtf(wave_sum(s2) * (1.f / DM) + LN_EPS);
    }
#pragma unroll
    for (int j = 0; j < 16; ++j) { const int c = 4 * F.lane + 256 * j; const f32x4 a = *(const f32x4*)(sc + c), b = *(const f32x4*)(sh + c);
        const f32x4 o = v[j] * rstd * (a + 1.f) + b; v2u w; w.x = pk2(o.x, o.y); w.y = pk2(o.z, o.w); *(v2u*)(hrow + c) = w; }
}

__device__ __forceinline__ void shift4(const bf16* P, unsigned eo, bool hp, bool hn, const float* mup, const float* mun, unsigned mo, float (&u)[4]) {
    const v2u xc = ldg<v2u>(P, eo * 2u); v2u xp = {0u, 0u}, xn = {0u, 0u};
    if (hp) xp = ldg<v2u>(P, (eo - DINP) * 2u); if (hn) xn = ldg<v2u>(P, (eo + DINP) * 2u);
    const f32x4 mp = ldg<f32x4>(mup, mo * 4u), mn = ldg<f32x4>(mun, mo * 4u);
    const float c[4] = {bflo(xc.x), bfhi(xc.x), bflo(xc.y), bfhi(xc.y)}, p[4] = {bflo(xp.x), bfhi(xp.x), bflo(xp.y), bfhi(xp.y)}, n[4] = {bflo(xn.x), bfhi(xn.x), bflo(xn.y), bfhi(xn.y)};
#pragma unroll
    for (int e = 0; e < 4; ++e) u[e] = c[e] + mp[e] * (p[e] - c[e]) + mn[e] * (n[e] - c[e]);
}
__device__ __forceinline__ void st4bf(void* base, unsigned eo, float a, float b, float c, float d) { v2u w; w.x = pk2(a, b); w.y = pk2(c, d); stg<v2u>(base, eo * 2u, w); }

__device__ __forceinline__ void rwkv_feat_item(Frame& F, int l, int item) {
    int row0, seq_lo, seq_hi;
    if (item < 16) { const int b = item >> 3; seq_lo = M_LAT + b * NCTX; seq_hi = seq_lo + NCTX; row0 = seq_lo + (item & 7) * 32; }
    else { const int it = item - 16, b = it >> 8; seq_lo = b * SEQ; seq_hi = seq_lo + SEQ; row0 = seq_lo + (it & 255) * 32; }
    const bf16* P = (const bf16*)(F.ws + WS_P);
    LAS bf16* ACT = (LAS bf16*)F.lds;
    const float* mup = F.A->in[I_MUP] + l * RWC; const float* mun = F.A->in[I_MUN] + l * RWC;
    __syncthreads();
    { const int tok = F.tid >> 4, jc = F.tid & 15, row = row0 + tok; const bool hp = row > seq_lo, hn = row + 1 < seq_hi;
      const bf16* pr = P + (size_t)row * DINP + C_RWL;
      for (int i = 0; i < 13; ++i) { const int j = jc * 2 + 32 * i;
          const unsigned xc = *(const unsigned*)(pr + j), xp = hp ? *(const unsigned*)(pr - DINP + j) : 0u, xn = hn ? *(const unsigned*)(pr + DINP + j) : 0u;
          float u[2];
#pragma unroll
          for (int e = 0; e < 2; ++e) { const float c = e ? bfhi(xc) : bflo(xc), p = e ? bfhi(xp) : bflo(xp), n = e ? bfhi(xn) : bflo(xn);
              float v = c + mup[3072 + j + e] * (p - c) + mun[3072 + j + e] * (n - c);
              if (j < 128) v = tanhf_(v); else if (j >= 256) v = sigmoidf_(v);
              u[e] = v; }
          *(LAS unsigned*)(ACT + tok * 424 + j) = pk2(u[0], u[1]); } }
    __syncthreads();
    const int tok = F.lane & 31, hi = F.lane >> 5, row = row0 + tok; const bool hp = row > seq_lo, hn = row + 1 < seq_hi;
    const unsigned prow = (unsigned)row * DINP;
    const bf16* W2T = (const bf16*)(F.ws + WS_W2T); const bf16* A2T = (const bf16*)(F.ws + WS_A2T); const bf16* G2T = (const bf16*)(F.ws + WS_G2T);
    bf16* RWF = (bf16*)(F.ws + WS_RWF); const size_t RS = (size_t)M_TOT * 1024;
    const float* kkv = F.A->in[I_KK] + l * 1024; const float* kav = F.A->in[I_KA] + l * 1024; const float* rkv = F.A->in[I_RK] + l * 1024;
    const float* w0f = F.A->in[I_W0] + (size_t)(l * 2) * 1024; const float* a0f = F.A->in[I_A0] + (size_t)(l * 2) * 1024;
    const LAS bf16* actl = ACT + tok * 424 + hi * 8;
#pragma unroll 1
    for (int hh = 0; hh < 2; ++hh) {
        const int h = 2 * F.wave + hh, cbase = h * 64;
        float ssq = 0.f;
#pragma unroll
        for (int bg = 0; bg < 8; ++bg) { const unsigned c4 = cbase + (bg >> 2) * 32 + 8 * (bg & 3) + 4 * hi; float uk[4];
            shift4(P, prow + C_RWK + c4, hp, hn, mup, mun, 1024 + c4, uk); const f32x4 k4 = ldg<f32x4>(kkv, c4 * 4u);
#pragma unroll
            for (int e = 0; e < 4; ++e) { const float q = uk[e] * k4[e]; ssq += q * q; } }
        ssq += __shfl_xor(ssq, 32);
        const float rn = 1.f / fmaxf(sqrtf(ssq), 1e-12f);
        float sb = 0.f;
#pragma unroll 1
        for (int blk = 0; blk < 2; ++blk) {
            const unsigned cblk = cbase + blk * 32, cha = cblk + tok;
            const unsigned ob = (unsigned)row * 1024 + cblk + 4 * hi;
#pragma unroll 1
            for (int d = 0; d < 2; ++d) { f32x16 aw = {};
#pragma unroll
                for (int ks = 0; ks < 4; ++ks) { const bf16x8 bw = *(const LAS bf16x8*)(actl + d * 64 + ks * 16); const bf16x8 w_ = ldg<bf16x8>(W2T, ((d * 1024 + cha) * 64 + ks * 16 + hi * 8) * 2u);
                    aw = __builtin_amdgcn_mfma_f32_32x32x16_bf16(w_, bw, aw, 0, 0, 0); }
#pragma unroll
                for (int g = 0; g < 4; ++g) { const f32x4 w0 = ldg<f32x4>(w0f, (d * 1024 + cblk + 8 * g + 4 * hi) * 4u); float e4[4];
#pragma unroll
                    for (int e = 0; e < 4; ++e) e4[e] = __expf(-softplusf_(-(w0[e] + aw[4 * g + e])) - 0.5f);
                    st4bf(RWF + (4 + d) * RS, ob + 8 * g, e4[0], e4[1], e4[2], e4[3]); } }
            { f32x16 ag = {};
#pragma unroll
              for (int ks = 0; ks < 10; ++ks) { const bf16x8 bg_ = *(const LAS bf16x8*)(actl + 256 + ks * 16); const bf16x8 g_ = ldg<bf16x8>(G2T, (cha * 192 + ks * 16 + hi * 8) * 2u);
                  ag = __builtin_amdgcn_mfma_f32_32x32x16_bf16(g_, bg_, ag, 0, 0, 0); }
#pragma unroll
              for (int g = 0; g < 4; ++g) st4bf(RWF + 8 * RS, ob + 8 * g, ag[4 * g], ag[4 * g + 1], ag[4 * g + 2], ag[4 * g + 3]); }
            { f32x16 aaf = {}, aab = {};
#pragma unroll
              for (int ks = 0; ks < 4; ++ks) { const bf16x8 baf = *(const LAS bf16x8*)(actl + 128 + ks * 16), bab = *(const LAS bf16x8*)(actl + 192 + ks * 16);
                  const bf16x8 a_f = ldg<bf16x8>(A2T, (cha * 64 + ks * 16 + hi * 8) * 2u), a_b = ldg<bf16x8>(A2T, ((1024 + cha) * 64 + ks * 16 + hi * 8) * 2u);
                  aaf = __builtin_amdgcn_mfma_f32_32x32x16_bf16(a_f, baf, aaf, 0, 0, 0); aab = __builtin_amdgcn_mfma_f32_32x32x16_bf16(a_b, bab, aab, 0, 0, 0); }
#pragma unroll
              for (int g = 0; g < 4; ++g) { const unsigned c4 = cblk + 8 * g + 4 * hi; float ur[4], uk[4], uv[4];
                  shift4(P, prow + C_RWR + c4, hp, hn, mup, mun, c4, ur);
                  shift4(P, prow + C_RWK + c4, hp, hn, mup, mun, 1024 + c4, uk);
                  shift4(P, prow + C_RWV + c4, hp, hn, mup, mun, 2048 + c4, uv);
                  const f32x4 a0a = ldg<f32x4>(a0f, c4 * 4u), a0b = ldg<f32x4>(a0f, (1024 + c4) * 4u), kk4 = ldg<f32x4>(kkv, c4 * 4u), ka4 = ldg<f32x4>(kav, c4 * 4u), rk4 = ldg<f32x4>(rkv, c4 * 4u);
                  float af[4], ab[4], kk[4];
#pragma unroll
                  for (int e = 0; e < 4; ++e) { const int r = 4 * g + e;
                      af[e] = sigmoidf_(a0a[e] + aaf[r]); ab[e] = sigmoidf_(a0b[e] + aab[r]); kk[e] = uk[e] * kk4[e] * rn;
                      const float kdf = uk[e] * (1.f + (af[e] - 1.f) * ka4[e]), kdb = uk[e] * (1.f + (ab[e] - 1.f) * ka4[e]);
                      sb += ur[e] * rk4[e] * (kdf + kdb); }
                  const unsigned o = ob + 8 * g;
                  st4bf(RWF + 0 * RS, o, ur[0], ur[1], ur[2], ur[3]); st4bf(RWF + 1 * RS, o, uk[0], uk[1], uk[2], uk[3]); st4bf(RWF + 2 * RS, o, uv[0], uv[1], uv[2], uv[3]);
                  st4bf(RWF + 3 * RS, o, kk[0], kk[1], kk[2], kk[3]); st4bf(RWF + 6 * RS, o, af[0], af[1], af[2], af[3]); st4bf(RWF + 7 * RS, o, ab[0], ab[1], ab[2], ab[3]);
                  asm volatile("" ::: "memory"); } }
        }
        sb += __shfl_xor(sb, 32);
        if (hi == 0) ((float*)(F.ws + WS_SB))[(size_t)row * 16 + h] = sb;
    }
}

__device__ __forceinline__ float gelu_tanh(float x) { return 0.5f * x * (1.f + tanhf(0.7978845608028654f * (x + 0.044715f * x * x * x))); }
template <bool PASS3>
__device__ __forceinline__ void lru_item(Frame& F, int l, int item) {
    const int sc = item >> 3, nb = item & 7, b = sc / NCH, ch = sc % NCH;
    int row0, seq_lo, seq_hi;
    if (ch < 8) { seq_lo = M_LAT + b * NCTX; seq_hi = seq_lo + NCTX; row0 = seq_lo + ch * 32; }
    else { seq_lo = b * SEQ; seq_hi = seq_lo + SEQ; row0 = seq_lo + (ch - 8) * 32; }
    const bf16* P = (const bf16*)(F.ws + WS_P);
    LAS float* U = (LAS float*)F.lds;
    LAS bf16* UA = (LAS bf16*)(F.lds + 16384);
    LAS float* AB = (LAS float*)(F.lds + 32768);
    __syncthreads();
    { const int tok = F.tid >> 4, c8 = (F.tid & 15) * 8, cg = nb * 128 + c8; float acc[8];
      const float* cb = F.A->in[I_CONVB] + l * 1024 + cg;
#pragma unroll
      for (int e = 0; e < 8; ++e) acc[e] = cb[e];
#pragma unroll
      for (int j = 0; j < 4; ++j) { const int r = row0 + tok - 2 + j;
          if (r >= seq_lo && r < seq_hi) { const v4u x = *(const v4u*)(P + (size_t)r * DINP + C_LRUX + cg); const float* cw = F.A->in[I_CONVW] + (size_t)(l * 4 + j) * 1024 + cg;
#pragma unroll
              for (int w = 0; w < 4; ++w) { acc[2 * w] += cw[2 * w] * bflo(x[w]); acc[2 * w + 1] += cw[2 * w + 1] * bfhi(x[w]); } } }
      *(LAS f32x4*)(U + tok * 128 + c8) = (f32x4){acc[0], acc[1], acc[2], acc[3]}; *(LAS f32x4*)(U + tok * 128 + c8 + 4) = (f32x4){acc[4], acc[5], acc[6], acc[7]};
      v4u o; o.x = pk2(acc[0], acc[1]); o.y = pk2(acc[2], acc[3]); o.z = pk2(acc[4], acc[5]); o.w = pk2(acc[6], acc[7]);
      *(LAS v4u*)(UA + tok * 136 + c8) = o; }
    __syncthreads();
    { const int dir = F.wave >> 2, cq = F.wave & 3, l32 = F.lane & 31, hi = F.lane >> 5, chn = cq * 32 + l32, cg = nb * 128 + chn;
      const bf16* Wr = (const bf16*)(F.ws + WS_WLRU) + ((size_t)(dir * 2 + 0) * 8 + nb) * 16384 + (size_t)chn * 128;
      const bf16* Wi = (const bf16*)(F.ws + WS_WLRU) + ((size_t)(dir * 2 + 1) * 8 + nb) * 16384 + (size_t)chn * 128;
      f32x16 accr = {}, acci = {};
#pragma unroll
      for (int ks = 0; ks < 8; ++ks) { const int ko = ks * 16 + hi * 8;
          const bf16x8 a = *(const LAS bf16x8*)(UA + l32 * 136 + ko); const bf16x8 br = *(const bf16x8*)(Wr + ko), bi = *(const bf16x8*)(Wi + ko);
          accr = __builtin_amdgcn_mfma_f32_32x32x16_bf16(a, br, accr, 0, 0, 0); acci = __builtin_amdgcn_mfma_f32_32x32x16_bf16(a, bi, acci, 0, 0, 0); }
      const float ba = F.A->in[I_LBA][(l * 2 + dir) * 1024 + cg], bi_ = F.A->in[I_LBI][(l * 2 + dir) * 1024 + cg], sp = softplusf_(-F.A->in[I_LAM][(l * 2 + dir) * 1024 + cg]);
#pragma unroll
      for (int r = 0; r < 16; ++r) { const int tok = att::crow(r, hi); const float u = U[tok * 128 + chn];
          const float rg = sigmoidf_(accr[r] + ba), ig = sigmoidf_(acci[r] + bi_), la = -8.f * rg * sp, a = __expf(la), bc = sqrtf(-expm1f(2.f * la)) * (ig * u);
          AB[(dir * 2 + 0) * 4096 + tok * 128 + chn] = a; AB[(dir * 2 + 1) * 4096 + tok * 128 + chn] = bc; } }
    __syncthreads();
    if (F.tid < 256) { const int dir = F.tid >> 7, chn = F.tid & 127, cg = nb * 128 + chn; const size_t ci = ((size_t)(dir * 2 + b) * NCH + ch) * 1024 + cg;
        LAS float* Aa = AB + (dir * 2) * 4096 + chn; LAS float* Bb = AB + (dir * 2 + 1) * 4096 + chn;
        if (!PASS3) { float h = 0.f, ap = 1.f;
#pragma unroll 8
            for (int s = 0; s < 32; ++s) { const int tok = dir ? 31 - s : s; const float a = Aa[tok * 128]; h = a * h + Bb[tok * 128]; ap *= a;
                if (s == 0 && dir == 1 && ch == 7) ((float*)(F.ws + WS_QUIRK))[b * 1024 + cg] = h; }
            ((float*)(F.ws + WS_CA))[ci] = ap; ((float*)(F.ws + WS_CB))[ci] = h;
        } else { float h = ((const float*)(F.ws + WS_HIN))[ci];
#pragma unroll 8
            for (int s = 0; s < 32; ++s) { const int tok = dir ? 31 - s : s; h = Aa[tok * 128] * h + Bb[tok * 128]; Bb[tok * 128] = h; } } }
    if (PASS3) { __syncthreads();
        const int tok = F.tid >> 4, c8 = (F.tid & 15) * 8, cg = nb * 128 + c8, row = row0 + tok;
        const v4u y = *(const v4u*)(P + (size_t)row * DINP + C_LRUY + cg); float o[8];
#pragma unroll
        for (int w = 0; w < 4; ++w) { const float h0 = AB[4096 + tok * 128 + c8 + 2 * w] + AB[3 * 4096 + tok * 128 + c8 + 2 * w], h1 = AB[4096 + tok * 128 + c8 + 2 * w + 1] + AB[3 * 4096 + tok * 128 + c8 + 2 * w + 1];
            o[2 * w] = h0 * gelu_tanh(bflo(y[w])); o[2 * w + 1] = h1 * gelu_tanh(bfhi(y[w])); }
        v4u ov; ov.x = pk2(o[0], o[1]); ov.y = pk2(o[2], o[3]); ov.z = pk2(o[4], o[5]); ov.w = pk2(o[6], o[7]);
        *(v4u*)((bf16*)(F.ws + WS_MIX) + (size_t)row * DM + 1024 + cg) = ov; }
}
__device__ __forceinline__ void lru_carry(Frame& F) {
    const int gid = F.vcu * NTHR + F.tid; if (gid >= 4096) return;
    const int dir = gid >> 11, b = (gid >> 10) & 1, cg = gid & 1023;
    const float* CA = (const float*)(F.ws + WS_CA) + ((size_t)(dir * 2 + b) * NCH) * 1024 + cg; const float* CB = (const float*)(F.ws + WS_CB) + ((size_t)(dir * 2 + b) * NCH) * 1024 + cg;
    float* HIN = (float*)(F.ws + WS_HIN) + ((size_t)(dir * 2 + b) * NCH) * 1024 + cg;
    float h = 0.f;
    if (dir == 0) {
#pragma unroll 8
        for (int c = 0; c < NCH; ++c) { HIN[(size_t)c * 1024] = h; h = CA[(size_t)c * 1024] * h + CB[(size_t)c * 1024]; }
    } else {
        for (int c = 7; c >= 0; --c) { HIN[(size_t)c * 1024] = h; h = CA[(size_t)c * 1024] * h + CB[(size_t)c * 1024]; }
        h = ((const float*)(F.ws + WS_QUIRK))[b * 1024 + cg];
#pragma unroll 8
        for (int c = NCH - 1; c >= 8; --c) { HIN[(size_t)c * 1024] = h; h = CA[(size_t)c * 1024] * h + CB[(size_t)c * 1024]; }
    }
}

__device__ __forceinline__ void rope_table(Frame& F) {
    const int i = F.vcu * NTHR + F.tid; if (i >= 2048) return;
    const int pos = i >> 4, f = i & 15; float s, c; sincosf((float)pos * exp2f(-(float)f * (13.287712379549449f / 16.f)), &s, &c);
    float* t = (float*)(F.ws + WS_ROPE); t[i] = c; t[2048 + i] = s;
}
__device__ __forceinline__ void row_prep(Frame& F, int row) {
    bf16* pr = (bf16*)(F.ws + WS_P) + (size_t)row * DINP; const int lane = F.lane;
    const bool lat = row < M_LAT; const int t = row & (SEQ - 1); const float prow = (float)(t >> 6), pcol = (float)(t & 63);
    { const v4u a = *(const v4u*)(pr + C_QA + lane * 16), b = *(const v4u*)(pr + C_QA + lane * 16 + 8); float ss = 0.f;
#pragma unroll
      for (int w = 0; w < 4; ++w) { const float x0 = bflo(a[w]), x1 = bfhi(a[w]), x2 = bflo(b[w]), x3 = bfhi(b[w]); ss += x0 * x0 + x1 * x1 + x2 * x2 + x3 * x3; }
      ss = wave_sum(ss); if (lane == 0) ((float*)(F.ws + WS_RSQ))[row] = 1.f / sqrtf(ss * (1.f / 1024.f) + RMS_EPS); }
    { const v4u a = *(const v4u*)(pr + C_KVA + lane * 8); float ss = 0.f;
#pragma unroll
      for (int w = 0; w < 4; ++w) { const float x0 = bflo(a[w]), x1 = bfhi(a[w]); ss += x0 * x0 + x1 * x1; }
      ss = wave_sum(ss); if (lane == 0) ((float*)(F.ws + WS_RSKV))[row] = 1.f / sqrtf(ss * (1.f / 512.f) + RMS_EPS); }
    bf16* kr = (bf16*)(F.ws + WS_KR) + (size_t)row * 64;
    if (lat) {
        { const int part = lane >> 5, sub = lane & 31;
          const float inv = exp2f(-(float)sub * (13.287712379549449f / 32.f)); float sn, cs; sincosf((part ? pcol : prow) * inv, &sn, &cs);
#pragma unroll
          for (int hd = 0; hd < 10; ++hd) { bf16* qb = pr + (hd < 8 ? C_SWAQ + hd * 128 : C_SWAK + (hd - 8) * 128) + part * 64;
              const float x1 = bf2f(qb[sub]), x2 = bf2f(qb[sub + 32]); qb[sub] = (bf16)f2bf(x1 * cs - x2 * sn); qb[sub + 32] = (bf16)f2bf(x2 * cs + x1 * sn); } }
        if (lane < 32) { const int part = lane >> 4, i = lane & 15; const bf16* src = pr + C_KR + part * 32;
          const float inv = exp2f(-(float)i * (13.287712379549449f / 16.f)); float s, c; sincosf((part ? pcol : prow) * inv, &s, &c);
          const float x1 = bf2f(src[i]), x2 = bf2f(src[i + 16]);
          kr[part * 32 + i] = (bf16)f2bf(x1 * c - x2 * s); kr[part * 32 + i + 16] = (bf16)f2bf(x2 * c + x1 * s); }
    } else kr[lane] = pr[C_KR + lane];
}

__device__ __forceinline__ float allred16(float x) {
    x += __builtin_bit_cast(float, __builtin_amdgcn_update_dpp(0, __builtin_bit_cast(int, x), 0x128, 0xf, 0xf, false));
    x += __builtin_bit_cast(float, __builtin_amdgcn_update_dpp(0, __builtin_bit_cast(int, x), 0x124, 0xf, 0xf, false));
    x += __builtin_bit_cast(float, __builtin_amdgcn_update_dpp(0, __builtin_bit_cast(int, x), 0x122, 0xf, 0xf, false));
    x += __builtin_bit_cast(float, __builtin_amdgcn_update_dpp(0, __builtin_bit_cast(int, x), 0x121, 0xf, 0xf, false));
    return x;
}
__device__ __forceinline__ int scan_row(int s, int dir, int b) {
    if (s < NCTX) return M_LAT + b * NCTX + (dir ? NCTX - 1 - s : s);
    const int t = s - NCTX; return b * SEQ + (dir ? SEQ - 1 - t : t);
}
__device__ __forceinline__ void rwkv_scan(Frame& F, int l, int chain) {
    const int dir = chain >> 5, b = (chain >> 4) & 1, h = chain & 15;
    constexpr int CT = 32, NCHK = (NCTX + SEQ) / CT, BUFB = CT * 6 * 64 * 4;
    LAS float* buf = (LAS float*)F.lds; LAS float* ybuf = (LAS float*)(F.lds + 2 * BUFB);
    gcbf RWF = (gcbf)(F.ws + WS_RWF); const size_t RS = (size_t)M_TOT * 1024;
    gflp YS = (gflp)(F.ws + WS_YS) + (size_t)dir * M_TOT * 1024;
    const int lst = F.tid >> 4, lq = F.tid & 15, lc = h * 64 + 4 * lq;
    const f32x4 ka4 = *(const GAS f32x4*)((gcfl)F.A->in[I_KA] + l * 1024 + lc);
    v2u gr, gk, gv, gkk, ge, ga;
#define RW_LOAD(c) do { const size_t o_ = (size_t)scan_row((c) * CT + lst, dir, b) * 1024 + lc; gr = *(const GAS v2u*)(RWF + 0 * RS + o_); gk = *(const GAS v2u*)(RWF + 1 * RS + o_); gv = *(const GAS v2u*)(RWF + 2 * RS + o_); \
        gkk = *(const GAS v2u*)(RWF + 3 * RS + o_); ge = *(const GAS v2u*)(RWF + (4 + dir) * RS + o_); ga = *(const GAS v2u*)(RWF + (6 + dir) * RS + o_); } while (0)
#define RW_WRITE(bi) do { LAS float* d_ = buf + (bi) * (BUFB / 4) + lst * 384 + 4 * lq; \
        const float r_[4] = {bflo(gr.x), bfhi(gr.x), bflo(gr.y), bfhi(gr.y)}, k_[4] = {bflo(gk.x), bfhi(gk.x), bflo(gk.y), bfhi(gk.y)}, v_[4] = {bflo(gv.x), bfhi(gv.x), bflo(gv.y), bfhi(gv.y)}; \
        const float q_[4] = {bflo(gkk.x), bfhi(gkk.x), bflo(gkk.y), bfhi(gkk.y)}, e_[4] = {bflo(ge.x), bfhi(ge.x), bflo(ge.y), bfhi(ge.y)}, a_[4] = {bflo(ga.x), bfhi(ga.x), bflo(ga.y), bfhi(ga.y)}; \
        f32x4 w4, kd4, kk4, b4, r4, v4; _Pragma("unroll") for (int e = 0; e < 4; ++e) { w4[e] = __expf(-e_[e]); kd4[e] = k_[e] * (1.f + (a_[e] - 1.f) * ka4[e]); kk4[e] = q_[e]; b4[e] = q_[e] * a_[e]; r4[e] = r_[e]; v4[e] = v_[e]; } \
        *(LAS f32x4*)(d_) = w4; *(LAS f32x4*)(d_ + 64) = kd4; *(LAS f32x4*)(d_ + 128) = kk4; *(LAS f32x4*)(d_ + 192) = b4; *(LAS f32x4*)(d_ + 256) = r4; *(LAS f32x4*)(d_ + 320) = v4; } while (0)
    __syncthreads();
    RW_LOAD(0); RW_WRITE(0); RW_LOAD(1); RW_WRITE(1);
    __syncthreads();
    const int kg = F.lane & 15, rg = F.lane >> 4, r0 = 8 * F.wave + 2 * rg;
    float S0[4] = {0.f, 0.f, 0.f, 0.f}, S1[4] = {0.f, 0.f, 0.f, 0.f};
    for (int c = 0; c < NCHK; ++c) {
        if (c + 2 < NCHK) RW_LOAD(c + 2);
        const LAS float* bb = buf + (c & 1) * (BUFB / 4) + 4 * kg; const LAS float* vb = buf + (c & 1) * (BUFB / 4) + 320 + r0;
        f32x4 w4 = *(const LAS f32x4*)(bb), kd4 = *(const LAS f32x4*)(bb + 64), kk4 = *(const LAS f32x4*)(bb + 128), b4 = *(const LAS f32x4*)(bb + 192), r4 = *(const LAS f32x4*)(bb + 256); f32x2 v2 = *(const LAS f32x2*)(vb);
#pragma unroll 4
        for (int st = 0; st < CT; ++st) {
            const int sn = st + 1 < CT ? st + 1 : st;
            const f32x4 nw4 = *(const LAS f32x4*)(bb + sn * 384), nkd4 = *(const LAS f32x4*)(bb + sn * 384 + 64), nkk4 = *(const LAS f32x4*)(bb + sn * 384 + 128), nb4 = *(const LAS f32x4*)(bb + sn * 384 + 192), nr4 = *(const LAS f32x4*)(bb + sn * 384 + 256);
            const f32x2 nv2 = *(const LAS f32x2*)(vb + sn * 384);
            float p0 = (S0[0] * kk4[0] + S0[1] * kk4[1]) + (S0[2] * kk4[2] + S0[3] * kk4[3]);
            float p1 = (S1[0] * kk4[0] + S1[1] * kk4[1]) + (S1[2] * kk4[2] + S1[3] * kk4[3]);
            p0 = allred16(p0); p1 = allred16(p1);
#pragma unroll
            for (int i = 0; i < 4; ++i) { S0[i] = S0[i] * w4[i] + v2[0] * kd4[i] - p0 * b4[i]; S1[i] = S1[i] * w4[i] + v2[1] * kd4[i] - p1 * b4[i]; }
            float y0 = (S0[0] * r4[0] + S0[1] * r4[1]) + (S0[2] * r4[2] + S0[3] * r4[3]);
            float y1 = (S1[0] * r4[0] + S1[1] * r4[1]) + (S1[2] * r4[2] + S1[3] * r4[3]);
            y0 = allred16(y0); y1 = allred16(y1);
            if (kg == 0) *(LAS f32x2*)(ybuf + st * 64 + r0) = (f32x2){y0, y1};
            w4 = nw4; kd4 = nkd4; kk4 = nkk4; b4 = nb4; r4 = nr4; v2 = nv2;
        }
        __syncthreads();
        { const f32x4 y = *(const LAS f32x4*)(ybuf + lst * 64 + 4 * lq); *(GAS f32x4*)(YS + (size_t)scan_row(c * CT + lst, dir, b) * 1024 + lc) = y; }
        if (c + 2 < NCHK) RW_WRITE(c & 1);
        __syncthreads();
    }
#undef RW_LOAD
#undef RW_WRITE
}
__device__ __forceinline__ void rwkv_out_row(Frame& F, int l, int row) {
    const int c0 = F.lane * 16; const float* yf = (const float*)(F.ws + WS_YS) + (size_t)row * 1024 + c0; const float* yb = yf + (size_t)M_TOT * 1024;
    float y[16]; float s = 0.f;
#pragma unroll
    for (int j = 0; j < 4; ++j) { const f32x4 a = *(const f32x4*)(yf + 4 * j), b = *(const f32x4*)(yb + 4 * j);
#pragma unroll
        for (int e = 0; e < 4; ++e) { y[4 * j + e] = a[e] + b[e]; s += y[4 * j + e]; } }
    s += __shfl_xor(s, 1); s += __shfl_xor(s, 2); const float mu = s * (1.f / 64.f); float q = 0.f;
#pragma unroll
    for (int e = 0; e < 16; ++e) { y[e] -= mu; q += y[e] * y[e]; }
    q += __shfl_xor(q, 1); q += __shfl_xor(q, 2); const float rstd = 1.f / sqrtf(q * (1.f / 64.f) + GN_EPS);
    const bf16* RWF = (const bf16*)(F.ws + WS_RWF); const size_t RS = (size_t)M_TOT * 1024, o = (size_t)row * 1024 + c0;
    const float sbv = ((const float*)(F.ws + WS_SB))[(size_t)row * 16 + (F.lane >> 2)];
    const float* lg = F.A->in[I_LNG] + l * 1024 + c0; const float* lb = F.A->in[I_LNB] + l * 1024 + c0;
    bf16* dst = (bf16*)(F.ws + WS_MIX) + (size_t)row * DM + 3072 + c0;
#pragma unroll
    for (int hf = 0; hf < 2; ++hf) { const v4u vv = *(const v4u*)(RWF + 2 * RS + o + 8 * hf), gg = *(const v4u*)(RWF + 8 * RS + o + 8 * hf); float r[8];
#pragma unroll
        for (int w = 0; w < 4; ++w) { const int e = 8 * hf + 2 * w;
            r[2 * w] = (y[e] * rstd * lg[e] + lb[e] + sbv * bflo(vv[w])) * bflo(gg[w]); r[2 * w + 1] = (y[e + 1] * rstd * lg[e + 1] + lb[e + 1] + sbv * bfhi(vv[w])) * bfhi(gg[w]); }
        v4u ov; ov.x = pk2(r[0], r[1]); ov.y = pk2(r[2], r[3]); ov.z = pk2(r[4], r[5]); ov.w = pk2(r[6], r[7]); *(v4u*)(dst + 8 * hf) = ov; }
}

struct MlaTiles { gcbf KV; gcbf KR; int ctx_row0, lat_row0, h;
    __device__ __forceinline__ att::Tile operator()(int j) const { const int row = j < 4 ? ctx_row0 + 64 * j : lat_row0 + 64 * (j - 4);
        att::Tile t; t.kn = KV + (size_t)row * 2048 + h * 256; t.v = t.kn + 128; t.kr = KR + (size_t)row * 64; t.mtype = 0; t.krel0 = 0; return t; } };
struct SwaTiles { gcbf P; int blk_row0, ctx_row0, kvh, nwin, has_prev, has_next;
    __device__ __forceinline__ att::Tile operator()(int j) const { att::Tile t; int row; t.mtype = 0; t.krel0 = 0;
        if (j >= nwin) row = ctx_row0 + 64 * (j - nwin);
        else if (j < 2) row = blk_row0 + 64 * j;
        else if (has_prev && j < 4) { row = blk_row0 - 128 + 64 * (j - 2); t.mtype = 1; t.krel0 = -128 + 64 * (j - 2); }
        else { const int sub = j - 2 - 2 * has_prev; row = blk_row0 + 128 + 64 * sub; t.mtype = 2; t.krel0 = 128 + 64 * sub; }
        t.kn = P + (size_t)row * DINP + C_SWAK + kvh * 128; t.v = P + (size_t)row * DINP + C_SWAV + kvh * 128; t.kr = nullptr; return t; } };

#ifndef MLA_SDEPTH
#define MLA_SDEPTH 1
#endif
__device__ __forceinline__ void mla_item(Frame& F, int b, int h, int qb, bool ctxq) {
    const int r32 = F.lane & 31; const int t = qb * 256 + F.wave * 32 + r32;
    const int roww0 = ctxq ? M_LAT + b * NCTX + F.wave * 32 : b * SEQ + qb * 256 + F.wave * 32;
    gcbf Qw = (gcbf)(F.ws + WS_Q) + (size_t)(roww0 + r32) * 1536 + h * 192;
    MlaTiles ts{(gcbf)(F.ws + WS_KV), (gcbf)(F.ws + WS_KR), M_LAT + b * NCTX, b * SEQ, h};
    gbfp Ow = (gbfp)(F.ws + WS_MIX) + (size_t)roww0 * DM + 2048 + h * 128;
    att::attn_body<192, 2048, 2048, false, false, MLA_SDEPTH>(Qw, ctxq ? 0 : 1, t >> 6, t & 63, (gcfl)(F.ws + WS_ROPE), 0, 0.f, ts, ctxq ? 4 : 132, Ow, (LAS char*)F.lds);
}
__device__ __forceinline__ void swa_item(Frame& F, int l, int b, int n, int kvh, int half, bool ctxq, int hq_ctx) {
    const int r32 = F.lane & 31; gcbf P = (gcbf)(F.ws + WS_P);
    int hq, qi, roww0, t;
    if (ctxq) { hq = hq_ctx; kvh = hq >> 2; qi = 0; roww0 = M_LAT + b * NCTX + F.wave * 32; t = 0; }
    else { hq = kvh * 4 + 2 * half + (F.wave >> 2); qi = (F.wave & 3) * 32 + r32; roww0 = b * SEQ + n * 128 + (F.wave & 3) * 32; t = n * 128 + qi; }
    gcbf Qw = P + (size_t)(roww0 + r32) * DINP + C_SWAQ + hq * 128;
    SwaTiles ts; ts.P = P; ts.blk_row0 = b * SEQ + n * 128; ts.ctx_row0 = M_LAT + b * NCTX; ts.kvh = kvh;
    ts.has_prev = (!ctxq && n > 0) ? 1 : 0; ts.has_next = (!ctxq && n < SEQ / 128 - 1) ? 1 : 0; ts.nwin = ctxq ? 0 : 2 + 2 * ts.has_prev + 2 * ts.has_next;
    gbfp Ow = (gbfp)(F.ws + WS_MIX) + (size_t)roww0 * DM + hq * 128;
    const float sink_l2 = F.A->in[I_SINK][l * 8 + hq] * 1.4426950408889634f;
    att::attn_body<128, DINP, DINP, true, true, 2>(Qw, 0, 0, 0, (gcfl)nullptr, qi, sink_l2, ts, ts.nwin + 4, Ow, (LAS char*)F.lds);
}

#ifndef DBG_PHASES
#define DBG_PHASES 0xfffff
#endif
#define PH(n) ((DBG_PHASES >> (n)) & 1)
__global__ void __launch_bounds__(NTHR, 2) mk_fwd(Args args) {
    extern __shared__ __attribute__((aligned(16))) unsigned char lds[];
    Frame F;
    F.lds = (LAS unsigned char*)lds;
    F.tid = threadIdx.x; F.lane = F.tid & 63; F.wave = __builtin_amdgcn_readfirstlane(F.tid >> 6);
    F.G = gridDim.x; { const int bx = blockIdx.x; F.vcu = (F.G % 8 == 0) ? (bx % 8) * (F.G / 8) + bx / 8 : bx; }
    F.gw = F.vcu * NWAVES + F.wave; F.NGW = F.G * NWAVES;
    F.ws = args.ws; F.out = args.out; F.ctl = (gu32*)(args.ws + WS_CTL);
    F.A = (const __attribute__((address_space(4))) Args*)__builtin_amdgcn_kernarg_segment_ptr();
    for (int u = F.tid; u < (LDS_BYTES - LDSCTL_OFF) / 4; u += NTHR) ((LAS unsigned*)(F.lds + LDSCTL_OFF))[u] = 0u;
    __syncthreads();
    XcdBarrier bar = xcd_barrier_post((unsigned*)(args.ws + WS_CTL) + 4096, (volatile LAS unsigned*)(F.lds + MISC_OFF) + 8);
#define GRID_BAR() do { bar.bar = launder(bar.bar); bar.x = launder(bar.x); xcd_barrier(bar); F.ws = launder_g(F.ws); F.A = launder(F.A); F.tid = ltid(); F.lane = F.tid & 63; } while (0)
    const int bx = blockIdx.x;
    bf16* H = (bf16*)(F.ws + WS_H); float* X = (float*)(F.ws + WS_X);

    if (PH(0)) { mod_partials(F);
    convert_weights(F, 0); }
    GRID_BAR();
    if (PH(1)) { mod_reduce(F); rope_table(F); }
    GRID_BAR();

#pragma unroll 1
    for (int l = 0; l < 2; ++l) {
        const bool wctx = (l == 0);
        const int MO = wctx ? M_TOT : M_LAT;
        if (PH(2) && l == 0) {
            for (int row = F.gw; row < M_TOT; row += F.NGW) { const int s = row_s(row);
                const float* xs = row < M_LAT ? F.A->in[I_X] + (size_t)row * DM : F.A->in[I_CTX] + (size_t)(row - M_LAT) * DM;
                ln_row<0>(F, xs, nullptr, nullptr, nullptr, nullptr, nullptr, true, mod_ptr(F, 0, s, 1), mod_ptr(F, 0, s, 0), H + (size_t)row * DM); }
        }
        GRID_BAR();
        if (PH(3)) { pg8::Gemm g{H, (const bf16*)(F.ws + WS_WIN), M_TOT, DINP, DM, DM}; pg8::StaticOrder S; S.init(M_TOT, DINP, F.G, bx);
          pg8::EpiBf16<0> E{(bf16*)(F.ws + WS_P), DINP, nullptr};
          pg8::gemm_phase<pg8::EpiBf16<0>, pg8::StaticOrder, true, true>(F.lds, g, S, E); }
        GRID_BAR();
        if (PH(4)) for (int it = F.vcu; it < 528; it += F.G) rwkv_feat_item(F, l, it);
        if (PH(5)) for (int it = F.vcu; it < 2 * NCH * 8; it += F.G) lru_item<false>(F, l, it);
        __syncthreads();
        if (PH(6)) for (int row = F.gw; row < M_TOT; row += F.NGW) row_prep(F, row);
        GRID_BAR();
        if (PH(7)) lru_carry(F);
        if (PH(7)) { pg8::Gemm g{(const bf16*)(F.ws + WS_P) + C_QA, (const bf16*)(F.ws + WS_WQB), M_TOT, 1536, 1024, DINP}; pg8::StaticOrder S; S.init(M_TOT, 1536, F.G, bx);
          pg8::EpiBf16<2> E{(bf16*)(F.ws + WS_Q), 1536, (const float*)(F.ws + WS_RSQ)};
          pg8::gemm_phase<pg8::EpiBf16<2>, pg8::StaticOrder, true, true>(F.lds, g, S, E); }
        if (PH(7)) { pg8::Gemm g{(const bf16*)(F.ws + WS_P) + C_KVA, (const bf16*)(F.ws + WS_WKVB), M_TOT, 2048, 512, DINP}; pg8::StaticOrder S; S.init(M_TOT, 2048, F.G, bx);
          pg8::EpiBf16<2> E{(bf16*)(F.ws + WS_KV), 2048, (const float*)(F.ws + WS_RSKV)};
          pg8::gemm_phase<pg8::EpiBf16<2>, pg8::StaticOrder, true, true>(F.lds, g, S, E); }
        GRID_BAR();
        if ((bx & 3) == 0) { const int nrw = (F.G + 3) >> 2; if (PH(8)) for (int chain = bx >> 2; chain < 64; chain += nrw) rwkv_scan(F, l, chain); }
        else { const int aw = (bx >> 2) * 3 + (bx & 3) - 1, naw = F.G - ((F.G + 3) >> 2);
            if (PH(9)) for (int it = aw; it < 512; it += naw) mla_item(F, it >> 8, (it >> 5) & 7, it & 31, false);
            if (PH(9) && wctx) for (int it = aw; it < 16; it += naw) mla_item(F, it >> 3, it & 7, 0, true);
            if (PH(10)) for (int it = aw; it < 512; it += naw) swa_item(F, l, it >> 8, (it >> 2) & 63, (it >> 1) & 1, it & 1, false, 0);
            if (PH(10) && wctx) for (int it = aw; it < 16; it += naw) swa_item(F, l, it >> 3, 0, 0, 0, true, it & 7);
            if (PH(11)) for (int it = aw; it < 2 * NCH * 8; it += naw) { if (!wctx && ((it >> 3) % NCH) < 8) continue; lru_item<true>(F, l, it); }
        }
        GRID_BAR();
        if (PH(12)) for (int row = F.gw; row < MO; row += F.NGW) rwkv_out_row(F, l, row);
        GRID_BAR();
        if (PH(13)) { pg8::Gemm g{(const bf16*)(F.ws + WS_MIX), (const bf16*)(F.ws + WS_WOUT), MO, DM, DM, DM}; pg8::StaticOrder S; S.init(MO, DM, F.G, bx);
          pg8::EpiF32 E{(float*)(F.ws + WS_Y1), DM};
          pg8::gemm_phase<pg8::EpiF32, pg8::StaticOrder, true, true>(F.lds, g, S, E); }
        GRID_BAR();
        if (PH(14)) for (int row = F.gw; row < MO; row += F.NGW) { const int s = row_s(row);
            const float* xs = (l == 0) ? (row < M_LAT ? F.A->in[I_X] + (size_t)row * DM : F.A->in[I_CTX] + (size_t)(row - M_LAT) * DM) : X + (size_t)row * DM;
            ln_row<1>(F, xs, (const float*)(F.ws + WS_Y1) + (size_t)row * DM, mod_ptr(F, l, s, 2), F.A->in[I_LN1G] + l * DM, F.A->in[I_LN1B] + l * DM, X + (size_t)row * DM,
                      true, mod_ptr(F, l, s, 4), mod_ptr(F, l, s, 3), H + (size_t)row * DM); }
        GRID_BAR();
        if (PH(15)) { pg8::Gemm g{H, (const bf16*)(F.ws + WS_WFF1), MO, DFF, DM, DM}; pg8::StaticOrder S; S.init(MO, DFF, F.G, bx);
          pg8::EpiBf16<1> E{(bf16*)(F.ws + WS_HID), DFF, nullptr};
          pg8::gemm_phase<pg8::EpiBf16<1>, pg8::StaticOrder, true, true>(F.lds, g, S, E); }
        GRID_BAR();
        if (PH(16)) { pg8::Gemm g{(const bf16*)(F.ws + WS_HID), (const bf16*)(F.ws + WS_WFF2), MO, DM, DFF, DFF}; pg8::StaticOrder S; S.init(MO, DM, F.G, bx);
          pg8::EpiF32 E{(float*)(F.ws + WS_Y2), DM};
          pg8::gemm_phase<pg8::EpiF32, pg8::StaticOrder, true, true>(F.lds, g, S, E); }
        GRID_BAR();
        if (!PH(17)) {} else if (l == 0) {
            for (int row = F.gw; row < M_TOT; row += F.NGW) { const int s = row_s(row);
                ln_row<1>(F, X + (size_t)row * DM, (const float*)(F.ws + WS_Y2) + (size_t)row * DM, mod_ptr(F, 0, s, 5), F.A->in[I_LN2G], F.A->in[I_LN2B], X + (size_t)row * DM,
                          true, mod_ptr(F, 1, s, 1), mod_ptr(F, 1, s, 0), H + (size_t)row * DM); }
            __syncthreads();
            convert_weights(F, 1);
        } else {
            for (int row = F.gw; row < M_LAT; row += F.NGW) { const int s = row_s(row);
                ln_row<1>(F, X + (size_t)row * DM, (const float*)(F.ws + WS_Y2) + (size_t)row * DM, mod_ptr(F, 1, s, 5), F.A->in[I_LN2G] + DM, F.A->in[I_LN2B] + DM, F.out + (size_t)row * DM,
                          false, nullptr, nullptr, nullptr); }
        }
    }
}

extern "C" void kernel_launch(void* const* d_in, const int* in_sizes, int n_in, void* d_out, int out_size, void* d_ws, size_t ws_size, hipStream_t stream) {
    static int grid = 0;
    if (grid == 0) {
        if (n_in != 38 || out_size != M_LAT * DM || ws_size < WS_END) { fprintf(stderr, "kernel_launch: unexpected shapes: n_in %d out %d ws %zu (need %zu)\n", n_in, out_size, ws_size, (size_t)WS_END); grid = -1; return; }
        int dev = 0, cus = 0, per_cu = 0;
        if (hipGetDevice(&dev) != hipSuccess || hipDeviceGetAttribute(&cus, hipDeviceAttributeMultiprocessorCount, dev) != hipSuccess) { grid = -1; return; }
        if (hipFuncSetAttribute((const void*)mk_fwd, hipFuncAttributeMaxDynamicSharedMemorySize, LDS_BYTES) != hipSuccess) { fprintf(stderr, "kernel_launch: hipFuncSetAttribute failed\n"); grid = -1; return; }
        if (hipOccupancyMaxActiveBlocksPerMultiprocessor(&per_cu, (const void*)mk_fwd, NTHR, LDS_BYTES) != hipSuccess || per_cu < 1) fprintf(stderr, "kernel_launch: occupancy query says %d\n", per_cu);
        (void)hipGetLastError();
        grid = cus;
    }
    if (grid < 0) return;
    if (hipMemsetAsync((char*)d_ws + WS_CTL, 0, CTL_ZERO_BYTES, stream) != hipSuccess) return;
    Args a{};
    for (int i = 0; i < 38; ++i) a.in[i] = (const float*)d_in[i];
    a.out = (float*)d_out; a.ws = (unsigned char*)d_ws;
    hipLaunchKernelGGL(mk_fwd, dim3(grid), dim3(NTHR), LDS_BYTES, stream, a);
    const hipError_t le = hipPeekAtLastError();
    if (le != hipSuccess) fprintf(stderr, "kernel_launch: launch failed: %s\n", hipGetErrorName(le));
}
```

```cpp
#include <hip/hip_runtime.h>
#include <hip/hip_bf16.h>
#include <cstdio>
#include <cstdint>

namespace pg8 {
#define PG8_LAS __attribute__((address_space(3)))
typedef unsigned short bf16_t;
typedef short bf16x8 __attribute__((ext_vector_type(8)));
typedef float f32x4 __attribute__((ext_vector_type(4)));
typedef unsigned u32x4 __attribute__((ext_vector_type(4)));
constexpr int BM = 256, BK = 64, HALF = 128, HTB = HALF * BK * 2  , STAGE_BYTES = 8 * HTB, NXCD = 8, WGM = 8;

__host__ __device__ __forceinline__ int lds_byte(int r, int c) { const int st = (r >> 4) * 2 + (c >> 5), rr = r & 15, cc = c & 31, ob = rr * 64 + cc * 2; return st * 1024 + (ob ^ (((ob >> 9) & 1) << 5)); }
__host__ __device__ __forceinline__ void stage_rc(int b, int& R, int& C) { const int st = b / 1024, sb = b % 1024, swz = sb ^ (((sb >> 9) & 1) << 5); R = (st >> 1) * 16 + swz / 64; C = (st & 1) * 32 + (swz % 64) / 2; }
__host__ __device__ __forceinline__ int perm32(int rho) { const int n = rho >> 4, i = rho & 15; return 8 * (i >> 2) + 4 * n + (i & 3); }

struct Unit { int pm, pn; };
struct Gemm { const bf16_t* A; const bf16_t* Bt; int M, N, K, lda; };

struct StaticOrder {
    int nM, nN, nwg, G, c;
    __host__ __device__ void init(int M, int N, int G_, int c_) { nM = M / BM; nN = N / BM; nwg = nM * nN; G = G_; c = c_; }
    __host__ __device__ bool next(int i, Unit& u) const {
        const long L = (long)i * G + c; if (L >= nwg) return false;
        int wgid = (int)L; { const int q = nwg / NXCD, r = nwg % NXCD, xcd = wgid % NXCD, off = wgid / NXCD; wgid = (xcd < r ? xcd * (q + 1) : r * (q + 1) + (xcd - r) * q) + off; }
        const int nig = WGM * nN, gid = wgid / nig, fm = gid * WGM, gsz = (nM - fm) < WGM ? (nM - fm) : WGM;
        u.pm = fm + ((wgid % nig) % gsz); u.pn = (wgid % nig) / gsz; return true;
    }
    __device__ __forceinline__ void a_ready(const Unit&) const {}
    __device__ __forceinline__ void done(const Unit&) const {}
};

__device__ __forceinline__ unsigned cvt_pk_bf16(float lo, float hi) { unsigned r; asm volatile("v_cvt_pk_bf16_f32 %0, %1, %2" : "=v"(r) : "v"(lo), "v"(hi)); return r; }

struct EpiF32 {
    static constexpr bool PERM = false, AFTER_DRAIN = false;
    float* C; int ldc;
    __device__ __forceinline__ void operator()(const f32x4 (&acc)[2][2][4][2], const Unit& u, int wr, int wc, int fr, int fq) const {
        const int row0 = u.pm * BM + wr * 64 + fr, col0 = u.pn * BM + wc * 32 + 4 * fq;
#pragma unroll
        for (int ai = 0; ai < 2; ++ai)
#pragma unroll
            for (int m = 0; m < 4; ++m) { float* rowp = C + (size_t)(row0 + ai * HALF + m * 16) * ldc + col0;
#pragma unroll
                for (int bj = 0; bj < 2; ++bj)
#pragma unroll
                    for (int n = 0; n < 2; ++n) *(f32x4*)(rowp + bj * HALF + n * 16) = acc[ai][bj][m][n]; }
    }
};
template <int ACT> struct EpiBf16 {
    static constexpr bool PERM = true, AFTER_DRAIN = false;
    bf16_t* O; int ldc; const float* rowscale;
    __device__ __forceinline__ void operator()(const f32x4 (&acc)[2][2][4][2], const Unit& u, int wr, int wc, int fr, int fq) const {
        const int row0 = u.pm * BM + wr * 64 + fr; const int col0 = u.pn * BM + wc * 32 + 8 * fq;
#pragma unroll
        for (int ai = 0; ai < 2; ++ai)
#pragma unroll
            for (int m = 0; m < 4; ++m) { const int row = row0 + ai * HALF + m * 16; bf16_t* rowp = O + (size_t)row * ldc + col0;
                float rs = 1.f; if (ACT == 2) rs = rowscale[row];
#pragma unroll
                for (int bj = 0; bj < 2; ++bj) { f32x4 v0 = acc[ai][bj][m][0], v1 = acc[ai][bj][m][1];
                    if (ACT == 1) {
#pragma unroll
                        for (int j = 0; j < 4; ++j) { const float a = fmaxf(v0[j], 0.f), b = fmaxf(v1[j], 0.f); v0[j] = a * a; v1[j] = b * b; } }
                    if (ACT == 2) { v0 = v0 * rs; v1 = v1 * rs; }
                    u32x4 w; w.x = cvt_pk_bf16(v0[0], v0[1]); w.y = cvt_pk_bf16(v0[2], v0[3]); w.z = cvt_pk_bf16(v1[0], v1[1]); w.w = cvt_pk_bf16(v1[2], v1[3]);
                    *(u32x4*)(rowp + bj * HALF) = w; } }
    }
};

template <class Epi, class Sched, bool ALIGN_EPI = false, bool SP2 = false>
__device__ __forceinline__ void gemm_phase(PG8_LAS unsigned char* lds, const Gemm g, const Sched& S, const Epi& E) {
    int tid = threadIdx.x; asm volatile("" : "+v"(tid));
    const int wid = __builtin_amdgcn_readfirstlane(tid >> 6), lane = tid & 63, wr = wid >> 2, wc = wid & 3, fr = lane & 15, fq = lane >> 4;
    const int K = g.K, nt = K / BK, lda = g.lda;
    unsigned voffA[2], voffB[2];
#pragma unroll
    for (int i = 0; i < 2; ++i) { int R, C; stage_rc(tid * 16 + i * 8192, R, C); const int Rb = Epi::PERM ? ((R & ~31) + perm32(R & 31)) : R;
        voffA[i] = (unsigned)(R * lda + C) * 2u; voffB[i] = (unsigned)(Rb * K + C) * 2u; }
    const size_t kstep = (size_t)(BK * 2);
    const size_t hstepA = (size_t)HALF * lda * 2, hstepB = (size_t)HALF * K * 2;
    const size_t tstepA = 2 * hstepA, tstepB = 2 * hstepB;
    const unsigned ldsw = (unsigned)wid * 1024u;
    const int aoff = lds_byte(wr * 64 + fr, fq * 8), boff = lds_byte(wc * 32 + fr, fq * 8);
#define PG8_SA(b, h) (((b) * 2 + (h)) * HTB)
#define PG8_SB(b, h) ((4 + (b) * 2 + (h)) * HTB)
#define PG8_STAGE(bufoff, gbase, voff) do { _Pragma("unroll") for (int _i = 0; _i < 2; ++_i) \
        __builtin_amdgcn_global_load_lds((const unsigned*)((const char*)(gbase) + (voff)[_i]), (PG8_LAS unsigned*)(lds + (bufoff) + ldsw + _i * 8192), 16, 0, 0); } while (0)
#define PG8_LDA(dst, b, h) do { _Pragma("unroll") for (int m = 0; m < 4; ++m) _Pragma("unroll") for (int k = 0; k < 2; ++k) dst[m][k] = *(const PG8_LAS bf16x8*)(lds + PG8_SA(b, h) + aoff + m * 2048 + k * 1024); } while (0)
#define PG8_LDB(dst, b, h) do { _Pragma("unroll") for (int n = 0; n < 2; ++n) _Pragma("unroll") for (int k = 0; k < 2; ++k) dst[n][k] = *(const PG8_LAS bf16x8*)(lds + PG8_SB(b, h) + boff + n * 2048 + k * 1024); } while (0)
#define PG8_MMA(ai, bj, At, Bt) do { __builtin_amdgcn_s_setprio(1); _Pragma("unroll") for (int m = 0; m < 4; ++m) _Pragma("unroll") for (int n = 0; n < 2; ++n) _Pragma("unroll") for (int k = 0; k < 2; ++k) \
        acc[ai][bj][m][n] = __builtin_amdgcn_mfma_f32_16x16x32_bf16(Bt[n][k], At[m][k], acc[ai][bj][m][n], 0, 0, 0); __builtin_amdgcn_s_setprio(0); } while (0)
#define PG8_WAIT_V(n) asm volatile("s_waitcnt vmcnt(" #n ")" ::: "memory")
#define PG8_WAIT_L(n) asm volatile("s_waitcnt lgkmcnt(" #n ")" ::: "memory")
#define PG8_BAR __builtin_amdgcn_s_barrier()
#define PG8_SCHED __builtin_amdgcn_sched_barrier(0)
    Unit cur, nxt; int ui = 0;
    if (!S.next(0, cur)) return;
    f32x4 acc[2][2][4][2];
#pragma unroll
    for (int a = 0; a < 2; ++a)
#pragma unroll
        for (int b = 0; b < 2; ++b)
#pragma unroll
            for (int m = 0; m < 4; ++m)
#pragma unroll
                for (int n = 0; n < 2; ++n) acc[a][b][m][n] = (f32x4){0.f, 0.f, 0.f, 0.f};
    bf16x8 At[4][2], B0[2][2], B1[2][2];
    const char* cA = (const char*)g.A + (size_t)cur.pm * tstepA; const char* cB = (const char*)g.Bt + (size_t)cur.pn * tstepB;
    S.a_ready(cur);
    if constexpr (SP2) {
        PG8_STAGE(PG8_SB(0, 0), cB, voffB); PG8_STAGE(PG8_SB(0, 1), cB + hstepB, voffB); PG8_STAGE(PG8_SA(0, 0), cA, voffA); PG8_STAGE(PG8_SA(0, 1), cA + hstepA, voffA);
        if (wr == 1) PG8_BAR;
        PG8_WAIT_V(2); PG8_BAR;
        PG8_STAGE(PG8_SB(1, 0), cB + kstep, voffB); PG8_STAGE(PG8_SA(1, 0), cA + kstep, voffA); PG8_STAGE(PG8_SB(1, 1), cB + hstepB + kstep, voffB);
        PG8_WAIT_V(6); PG8_BAR;
    } else {
        PG8_STAGE(PG8_SB(0, 0), cB, voffB); PG8_STAGE(PG8_SA(0, 0), cA, voffA); PG8_STAGE(PG8_SB(0, 1), cB + hstepB, voffB); PG8_STAGE(PG8_SA(0, 1), cA + hstepA, voffA);
        if (wr == 1) PG8_BAR;
        PG8_WAIT_V(4); PG8_BAR;
        PG8_STAGE(PG8_SB(1, 0), cB + kstep, voffB); PG8_STAGE(PG8_SA(1, 0), cA + kstep, voffA); PG8_STAGE(PG8_SB(1, 1), cB + hstepB + kstep, voffB);
        PG8_WAIT_V(6); PG8_BAR;
    }
    for (;;) {
        const bool has_next = S.next(ui + 1, nxt);
        const char* nA = has_next ? (const char*)g.A + (size_t)nxt.pm * tstepA : cA; const char* nB = has_next ? (const char*)g.Bt + (size_t)nxt.pn * tstepB : cB;
        for (int t = 0; t < nt; t += 2) {
            const bool last = (t == nt - 2);
            const char* a1 = cA + (size_t)(t + 1) * kstep;
            const char* a2 = last ? nA : cA + (size_t)(t + 2) * kstep; const char* b2 = last ? nB : cB + (size_t)(t + 2) * kstep;
            const char* a3 = a2 + kstep; const char* b3 = b2 + kstep;
            if (last && has_next) S.a_ready(nxt);
            if constexpr (SP2) {
            PG8_LDB(B0, 0, 0); PG8_LDB(B1, 0, 1); PG8_SCHED; PG8_LDA(At, 0, 0); PG8_STAGE(PG8_SA(1, 1), a1 + hstepA, voffA);
            PG8_WAIT_V(8); PG8_WAIT_L(0); PG8_BAR; PG8_MMA(0, 0, At, B0); PG8_MMA(0, 1, At, B1); PG8_BAR; PG8_SCHED;
            PG8_LDA(At, 0, 1); PG8_STAGE(PG8_SB(0, 0), b2, voffB); PG8_STAGE(PG8_SB(0, 1), b2 + hstepB, voffB); PG8_STAGE(PG8_SA(0, 0), a2, voffA);
            PG8_WAIT_V(8); PG8_WAIT_L(0); PG8_BAR; PG8_MMA(1, 0, At, B0); PG8_MMA(1, 1, At, B1); PG8_BAR; PG8_SCHED;
            PG8_LDB(B0, 1, 0); PG8_LDB(B1, 1, 1); PG8_SCHED; PG8_LDA(At, 1, 0); PG8_STAGE(PG8_SA(0, 1), a2 + hstepA, voffA);
            PG8_WAIT_V(8); PG8_WAIT_L(0); PG8_BAR; PG8_MMA(0, 0, At, B0); PG8_MMA(0, 1, At, B1); PG8_BAR; PG8_SCHED;
            PG8_LDA(At, 1, 1); PG8_STAGE(PG8_SB(1, 0), b3, voffB); PG8_STAGE(PG8_SB(1, 1), b3 + hstepB, voffB); PG8_STAGE(PG8_SA(1, 0), a3, voffA);
            PG8_WAIT_V(8); PG8_WAIT_L(0); PG8_BAR; PG8_MMA(1, 0, At, B0); PG8_MMA(1, 1, At, B1); PG8_BAR; PG8_SCHED;
            } else {
            PG8_LDB(B0, 0, 0); PG8_SCHED; PG8_LDA(At, 0, 0); PG8_STAGE(PG8_SA(1, 1), a1 + hstepA, voffA);
            PG8_WAIT_L(8); PG8_BAR; PG8_WAIT_L(0); PG8_MMA(0, 0, At, B0); PG8_BAR; PG8_SCHED;
            PG8_LDB(B1, 0, 1); PG8_STAGE(PG8_SB(0, 0), b2, voffB);
            PG8_BAR; PG8_WAIT_L(0); PG8_MMA(0, 1, At, B1); PG8_BAR;
            PG8_LDA(At, 0, 1); PG8_STAGE(PG8_SA(0, 0), a2, voffA);
            PG8_BAR; PG8_WAIT_L(0); PG8_MMA(1, 0, At, B0); PG8_BAR; PG8_SCHED;
            PG8_STAGE(PG8_SB(0, 1), b2 + hstepB, voffB);
            PG8_WAIT_V(6); PG8_BAR; PG8_MMA(1, 1, At, B1); PG8_BAR;
            PG8_LDB(B0, 1, 0); PG8_SCHED; PG8_LDA(At, 1, 0); PG8_STAGE(PG8_SA(0, 1), a2 + hstepA, voffA);
            PG8_WAIT_L(8); PG8_BAR; PG8_WAIT_L(0); PG8_MMA(0, 0, At, B0); PG8_BAR; PG8_SCHED;
            PG8_LDB(B1, 1, 1); PG8_STAGE(PG8_SB(1, 0), b3, voffB);
            PG8_BAR; PG8_WAIT_L(0); PG8_MMA(0, 1, At, B1); PG8_BAR;
            PG8_LDA(At, 1, 1); PG8_STAGE(PG8_SA(1, 0), a3, voffA);
            PG8_BAR; PG8_WAIT_L(0); PG8_MMA(1, 0, At, B0); PG8_BAR; PG8_SCHED;
            PG8_STAGE(PG8_SB(1, 1), b3 + hstepB, voffB);
            PG8_WAIT_V(6); PG8_BAR; PG8_MMA(1, 1, At, B1); PG8_BAR;
            }
        }
        if constexpr (ALIGN_EPI) { if (wr == 0) PG8_BAR; }
        E(acc, cur, wr, wc, fr, fq); S.done(cur);
        if (!has_next) break;
#pragma unroll
        for (int a = 0; a < 2; ++a)
#pragma unroll
            for (int b = 0; b < 2; ++b)
#pragma unroll
                for (int m = 0; m < 4; ++m)
#pragma unroll
                    for (int n = 0; n < 2; ++n) acc[a][b][m][n] = (f32x4){0.f, 0.f, 0.f, 0.f};
        cur = nxt; cA = nA; cB = nB; ++ui;
        if constexpr (ALIGN_EPI) { if (wr == 1) PG8_BAR; }
    }
    PG8_WAIT_V(0);
    if constexpr (!ALIGN_EPI) { if (wr == 0) PG8_BAR; }
    PG8_BAR;
#undef PG8_SA
#undef PG8_SB
#undef PG8_STAGE
#undef PG8_LDA
#undef PG8_LDB
#undef PG8_MMA
#undef PG8_WAIT_V
#undef PG8_WAIT_L
#undef PG8_BAR
#undef PG8_SCHED
}
}

constexpr int NWAVES = 8, NTHR = 512;
constexpr int DM = 4096, NB = 2, SEQ = 8192, NCTX = 256, DFF = 16384;
constexpr int M_LAT = NB * SEQ, M_CTX = NB * NCTX, M_TOT = M_LAT + M_CTX;
constexpr int DIN = 8672, DINP = 8704;
constexpr int C_SWAQ = 0, C_SWAK = 1024, C_SWAV = 1280, C_LRUX = 1536, C_LRUY = 2560, C_QA = 3584, C_KVA = 4608, C_KR = 5120, C_RW = 5184;
constexpr int C_RWR = C_RW, C_RWK = C_RW + 1024, C_RWV = C_RW + 2048, C_RWL = C_RW + 3072;
constexpr int RWC = 3488;
constexpr float LN_EPS = 1e-5f, RMS_EPS = 1e-6f, GN_EPS = 64e-5f, ALPHA = 1.41421356237f;
constexpr int NCH = 264;

constexpr size_t MiB = 1u << 20;
constexpr size_t WS_CTL = 0, CTL_ZERO_BYTES = 1 * MiB;
constexpr size_t WS_MOD = 1 * MiB;
constexpr size_t WS_MODP = 2 * MiB;
constexpr size_t WS_SMALL = 20 * MiB;
constexpr size_t WS_RSQ = WS_SMALL;
constexpr size_t WS_RSKV = WS_RSQ + 128 * 1024;
constexpr size_t WS_SB = WS_RSKV + 128 * 1024;
constexpr size_t WS_CA = WS_SB + 2 * MiB;
constexpr size_t WS_CB = WS_CA + 5 * MiB;
constexpr size_t WS_HIN = WS_CB + 5 * MiB;
constexpr size_t WS_QUIRK = WS_HIN + 5 * MiB;
constexpr size_t WS_ROPE = WS_QUIRK + 8192;
static_assert(WS_ROPE + 16384 <= 40 * MiB, "small region");
constexpr size_t WS_W = 40 * MiB;
constexpr size_t WS_WIN = WS_W, WS_WOUT = WS_WIN + 68 * MiB, WS_WFF1 = WS_WOUT + 32 * MiB, WS_WFF2 = WS_WFF1 + 128 * MiB, WS_WQB = WS_WFF2 + 128 * MiB,
                 WS_WKVB = WS_WQB + 3 * MiB, WS_WLRU = WS_WKVB + 2 * MiB, WS_WLORA = WS_WLRU + 1 * MiB;
constexpr size_t WS_W2T = WS_WLORA, WS_A2T = WS_W2T + 256 * 1024, WS_G2T = WS_A2T + 256 * 1024;
constexpr size_t WS_X = 403 * MiB;
constexpr size_t WS_H = 667 * MiB;
constexpr size_t WS_MIX = 799 * MiB;
constexpr size_t WS_YS = 931 * MiB;
constexpr size_t WS_P = 1063 * MiB;
constexpr size_t WS_RWF = 1344 * MiB;
constexpr size_t RWF_STRIDE = (size_t)M_TOT * 1024 * 2;
constexpr size_t WS_Q = 1641 * MiB;
constexpr size_t WS_KV = 1691 * MiB;
constexpr size_t WS_KR = 1757 * MiB;
constexpr size_t WS_END = 1760 * MiB;
constexpr size_t WS_HID = WS_P;
constexpr size_t WS_Y1 = WS_P;
constexpr size_t WS_Y2 = WS_MIX;
static_assert(WS_WLORA + 1 * MiB <= WS_X && WS_P + (size_t)M_TOT * DINP * 2 <= WS_RWF && WS_RWF + 9 * RWF_STRIDE <= WS_Q, "ws map");
static_assert(WS_HID + (size_t)M_TOT * DFF * 2 <= WS_Q && WS_Y2 + (size_t)M_TOT * DM * 4 <= WS_P && WS_YS + 2 * (size_t)M_TOT * 1024 * 4 <= WS_P, "ws overlays");
static_assert(WS_KR + (size_t)M_TOT * 64 * 2 <= WS_END, "ws end");

constexpr int RING_BYTES = 131072;
constexpr int LDSCTL_OFF = RING_BYTES, MISC_OFF = LDSCTL_OFF + 320;
constexpr int LDS_BYTES = 147456;

#define GAS __attribute__((address_space(1)))
#define LAS __attribute__((address_space(3)))
typedef unsigned short bf16;
typedef unsigned v4u __attribute__((ext_vector_type(4)));
typedef unsigned v2u __attribute__((ext_vector_type(2)));
typedef float f32x4 __attribute__((ext_vector_type(4)));
typedef float f32x2 __attribute__((ext_vector_type(2)));
typedef float f32x16 __attribute__((ext_vector_type(16)));
typedef short bf16x8 __attribute__((ext_vector_type(8)));
typedef short s16x4 __attribute__((ext_vector_type(4)));
typedef GAS unsigned gu32;
typedef const GAS bf16* gcbf; typedef GAS bf16* gbfp; typedef const GAS float* gcfl; typedef GAS float* gflp;
#define LDS_WAIT() asm volatile("s_waitcnt lgkmcnt(0)" ::: "memory")
#define VM_WAIT() asm volatile("s_waitcnt vmcnt(0)" ::: "memory")
__device__ __forceinline__ unsigned f2bf(float f) { unsigned u = __builtin_bit_cast(unsigned, f); return (u + 0x7fffu + ((u >> 16) & 1u)) >> 16; }
__device__ __forceinline__ unsigned pk2(float lo, float hi) { return f2bf(lo) | (f2bf(hi) << 16); }
__device__ __forceinline__ float bflo(unsigned w) { return __builtin_bit_cast(float, w << 16); }
__device__ __forceinline__ float bfhi(unsigned w) { return __builtin_bit_cast(float, w & 0xffff0000u); }
__device__ __forceinline__ float bf2f(bf16 h) { return __builtin_bit_cast(float, (unsigned)h << 16); }
#define DPP_ADD(x, ctrl) ((x) + __builtin_bit_cast(float, __builtin_amdgcn_update_dpp(0, __builtin_bit_cast(int, (x)), (ctrl), 0xf, 0xf, false)))
__device__ __forceinline__ float row_sum16(float x) { x = DPP_ADD(x, 0x128); x = DPP_ADD(x, 0x124); x = DPP_ADD(x, 0x122); x = DPP_ADD(x, 0x121); return x; }
#ifdef OLD_SUMS
__device__ __forceinline__ float wave_sum(float v) {
#pragma unroll
    for (int o = 1; o < 64; o <<= 1) v += __shfl_xor(v, o);
    return v;
}
__device__ __forceinline__ float half_swap_sum(float x) { return x + __shfl_xor(x, 32); }
__device__ __forceinline__ float quad_sum(float x) { x += __shfl_xor(x, 1); x += __shfl_xor(x, 2); return x; }
#else
__device__ __forceinline__ float wave_sum(float v) {
    const float r = row_sum16(v);
    const float a = __builtin_bit_cast(float, __builtin_amdgcn_readlane(__builtin_bit_cast(int, r), 0)), b = __builtin_bit_cast(float, __builtin_amdgcn_readlane(__builtin_bit_cast(int, r), 16));
    const float c = __builtin_bit_cast(float, __builtin_amdgcn_readlane(__builtin_bit_cast(int, r), 32)), d = __builtin_bit_cast(float, __builtin_amdgcn_readlane(__builtin_bit_cast(int, r), 48));
    return (a + b) + (c + d);
}
__device__ __forceinline__ float half_swap_sum(float x) {
    unsigned a = __builtin_bit_cast(unsigned, x), b = a; asm volatile("" : "+v"(b));
    auto rr = __builtin_amdgcn_permlane32_swap(a, b, false, false);
    const float lo = __uint_as_float(rr[0]), hi = __uint_as_float(rr[1]); return lo + hi;
}
__device__ __forceinline__ float quad_sum(float x) { x = DPP_ADD(x, 0xB1); x = DPP_ADD(x, 0x4E); return x; }
#endif
__device__ __forceinline__ float sigmoidf_(float x) { return 1.f / (1.f + __expf(-x)); }
__device__ __forceinline__ float softplusf_(float x) { return x > 20.f ? x : __logf(1.f + __expf(x)); }
__device__ __forceinline__ float tanhf_(float x) { const float e = __expf(2.f * x); return 1.f - 2.f / (e + 1.f); }
__device__ __forceinline__ int ltid() { int t = threadIdx.x; asm volatile("" : "+v"(t)); return t; }
template <class T> __device__ __forceinline__ T ldg(const void* base, unsigned byteoff) { return *(const T*)((const char*)base + byteoff); }
template <class T> __device__ __forceinline__ void stg(void* base, unsigned byteoff, T v) { *(T*)((char*)base + byteoff) = v; }

#define XB_TMO      128
#define XB_XCNT(j)  (256  + 64 * (j))
#define XB_XSUB(j)  (1280 + 64 * (j))
#define XB_XGEN(j)  (2304 + 64 * (j))
#define XB_TOP      3328
#define XB_TOPGEN   3392
#define XCD_BAR_WORDS 3456
#define XB_SPIN_CAP (1u << 18)

__device__ __forceinline__ unsigned xb_ld(unsigned* p)              { return __hip_atomic_load(p, __ATOMIC_RELAXED, __HIP_MEMORY_SCOPE_AGENT); }
__device__ __forceinline__ unsigned xb_add(unsigned* p, unsigned v) { return __hip_atomic_fetch_add(p, v, __ATOMIC_RELAXED, __HIP_MEMORY_SCOPE_AGENT); }
__device__ __forceinline__ unsigned xb_xcc_id() { return (unsigned)__builtin_amdgcn_s_getreg((3 << 11) | 20) & 0xFu; }
#define XB_SPIN(cond, bar) do { unsigned _sp = 0; while (cond) { __builtin_amdgcn_s_sleep(1); \
    if ((++_sp & 255u) == 0u) { if (xb_ld(&(bar)[XB_TMO])) break; if (_sp > XB_SPIN_CAP) { atomicAdd(&(bar)[XB_TMO], 1u); break; } } } } while (0)

struct XcdBarrier {
    unsigned* bar; unsigned x;
    volatile LAS unsigned* st;
};

__device__ __forceinline__ XcdBarrier xcd_barrier_post(unsigned* bar, volatile LAS unsigned* st) {
    XcdBarrier b; b.bar = bar; b.x = xb_xcc_id(); b.st = st;
    if (threadIdx.x == 0) (void)xb_add(&bar[XB_XCNT(b.x)], 1u);
    return b;
}
__device__ __forceinline__ void xcd_barrier_complete(unsigned* bar, unsigned x, unsigned& nloc, unsigned& nx) {
    const unsigned G = gridDim.x * gridDim.y * gridDim.z;
    unsigned sum, cnt, mine, sp = 0u;
    for (;;) {
        sum = 0u; cnt = 0u; mine = 0u;
#pragma unroll
        for (unsigned j = 0; j < 16; ++j) { const unsigned c = xb_ld(&bar[XB_XCNT(j)]); sum += c; cnt += (c > 0u) ? 1u : 0u; mine = (j == x) ? c : mine; }
        if (sum == G) break;
        __builtin_amdgcn_s_sleep(1);
        if ((++sp & 255u) == 0u) { if (xb_ld(&bar[XB_TMO])) break; if (sp > XB_SPIN_CAP) { atomicAdd(&bar[XB_TMO], 1u); break; } }
    }
    nloc = mine > 0u ? mine : 1u; nx = cnt > 0u ? cnt : 1u;
}

__device__ __forceinline__ void xcd_barrier(const XcdBarrier& b) {
    asm volatile("s_waitcnt vmcnt(0)" ::: "memory");
    __syncthreads();
    if (threadIdx.x == 0) {
        unsigned* bar = b.bar;
        __builtin_amdgcn_s_waitcnt(0);
        unsigned nloc = b.st[0], nx = b.st[1];
        if (nloc == 0u) { xcd_barrier_complete(bar, b.x, nloc, nx); b.st[0] = nloc; b.st[1] = nx; }
        const unsigned old = xb_add(&bar[XB_XSUB(b.x)], 1u);
        const unsigned gen = old / nloc;
        if (old + 1u == (gen + 1u) * nloc) {
            __builtin_amdgcn_fence(__ATOMIC_RELEASE, "agent");
            asm volatile("s_waitcnt vmcnt(0)" ::: "memory");
            const unsigned og = xb_add(&bar[XB_TOP], 1u);
            const unsigned tg = og / nx;
            if (og + 1u == (tg + 1u) * nx) xb_add(&bar[XB_TOPGEN], 1u);
            else XB_SPIN(xb_ld(&bar[XB_TOPGEN]) == tg, bar);
            __builtin_amdgcn_fence(__ATOMIC_ACQUIRE, "agent");
            xb_add(&bar[XB_XGEN(b.x)], 1u);
            asm volatile("s_waitcnt vmcnt(0)" ::: "memory");
        } else {
            XB_SPIN(xb_ld(&bar[XB_XGEN(b.x)]) == gen, bar);
            __builtin_amdgcn_fence(__ATOMIC_ACQUIRE, "agent");
            asm volatile("s_waitcnt vmcnt(0)" ::: "memory");
        }
    }
    __syncthreads();
}


namespace att {
constexpr int KVBLK = 64;
constexpr float THR = 8.f;
#define SBAR() __builtin_amdgcn_sched_barrier(0)
__device__ __forceinline__ int crow(int r, int hi) { return (r & 3) + 8 * (r >> 2) + 4 * hi; }
__device__ __forceinline__ unsigned cvtpk(float lo, float hi) { unsigned r; asm volatile("v_cvt_pk_bf16_f32 %0, %1, %2" : "=v"(r) : "v"(lo), "v"(hi)); return r; }
template <int DQK> __device__ __forceinline__ int kswz(int row, int cb) { return row * (DQK * 2 + 16) + cb; }

template <int DQK> __device__ __forceinline__ void partialSM(f32x16& p0, f32x16& p1, float& m_reg, float& mn, float& alpha) {
  constexpr float SCALE = DQK == 128 ? 0.088388347648318440f : 0.072168783648703220f;
  constexpr float C = SCALE * 1.4426950408889634f;
  float pmax = p0[0];
#pragma unroll
  for (int r = 1; r < 16; ++r) pmax = fmaxf(pmax, p0[r]);
#pragma unroll
  for (int r = 0; r < 16; ++r) pmax = fmaxf(pmax, p1[r]);
  { auto rr = __builtin_amdgcn_permlane32_swap(__float_as_uint(pmax), __float_as_uint(pmax), false, false);
    pmax = fmaxf(__uint_as_float(rr[0]), __uint_as_float(rr[1])); }
  if (__builtin_expect(__all(pmax - m_reg <= THR / SCALE), 1)) { mn = m_reg; alpha = 1.f; }
  else { mn = fmaxf(m_reg, pmax); alpha = __builtin_amdgcn_exp2f((m_reg - mn) * C); m_reg = mn; }
  const float mnC = -mn * C;
#pragma unroll
  for (int r = 0; r < 16; ++r) p0[r] = fmaf(p0[r], C, mnC);
#pragma unroll
  for (int r = 0; r < 16; ++r) p1[r] = fmaf(p1[r], C, mnC);
#pragma unroll
  for (int r = 0; r < 16; ++r) p0[r] = __builtin_amdgcn_exp2f(p0[r]);
}
__device__ __forceinline__ void finishSM(f32x16& p0, f32x16& p1, float alpha, float& l_reg, bf16x8& pa0, bf16x8& pa1, bf16x8& pa2, bf16x8& pa3) {
#pragma unroll
  for (int r = 0; r < 16; ++r) p1[r] = __builtin_amdgcn_exp2f(p1[r]);
  float ps = 0;
#pragma unroll
  for (int r = 0; r < 16; ++r) ps += p0[r];
#pragma unroll
  for (int r = 0; r < 16; ++r) ps += p1[r];
  { auto rr = __builtin_amdgcn_permlane32_swap(__float_as_uint(ps), __float_as_uint(ps), false, false);
    ps = __uint_as_float(rr[0]) + __uint_as_float(rr[1]); }
  l_reg = l_reg * alpha + ps;
#define PK4(P, BASE, OUT) do { unsigned a0 = cvtpk(P[BASE + 0], P[BASE + 1]), a1 = cvtpk(P[BASE + 2], P[BASE + 3]);   \
    unsigned b0 = cvtpk(P[BASE + 4], P[BASE + 5]), b1 = cvtpk(P[BASE + 6], P[BASE + 7]);                              \
    auto r0 = __builtin_amdgcn_permlane32_swap(a0, b0, false, false); auto r1 = __builtin_amdgcn_permlane32_swap(a1, b1, false, false); \
    v4u w = {r0[0], r1[0], r0[1], r1[1]}; OUT = __builtin_bit_cast(bf16x8, w); } while (0)
  PK4(p0, 0, pa0); PK4(p0, 8, pa1); PK4(p1, 0, pa2); PK4(p1, 8, pa3);
#undef PK4
}
template <int DQK> __device__ __forceinline__ void qkt(f32x16& p0, f32x16& p1, const LAS char* Ks, const bf16x8* qr, const LAS char* qx, int r32, int hi) {
  p0 = f32x16{}; p1 = f32x16{};
#pragma unroll
  for (int d0 = 0; d0 < DQK / 16; ++d0) { const int cb = (d0 * 16 + hi * 8) * 2;
    bf16x8 b0 = *(const LAS bf16x8*)(Ks + kswz<DQK>(r32, cb));
    bf16x8 b1 = *(const LAS bf16x8*)(Ks + kswz<DQK>(32 + r32, cb));
    bf16x8 q; if (d0 < 8) q = qr[d0]; else q = *(const LAS bf16x8*)(qx + (d0 - 8) * 32);
    p0 = __builtin_amdgcn_mfma_f32_32x32x16_bf16(b0, q, p0, 0, 0, 0);
    p1 = __builtin_amdgcn_mfma_f32_32x32x16_bf16(b1, q, p1, 0, 0, 0);
    if ((d0 & 3) == 3 && d0 + 1 < DQK / 16) SBAR(); }
}
__device__ __forceinline__ int v_st(int k, int c) { const int kk = (k & ~0xC) | ((k & 4) << 1) | ((k & 8) >> 1); return ((kk >> 3) * 4 + (c >> 5)) * 512 + ((kk & 7) * 32 + (c & 31)) * 2; }
__device__ __forceinline__ int v_rd_base(int lane) { return ((lane & 3) << 3) | (((lane >> 2) & 3) << 6) | (((lane >> 4) & 1) << 5) | (((lane >> 5) & 1) << 8); }
constexpr int v_rd_off(int d0, int ks, int half) { return d0 * 512 + ks * 4096 + half * 2048; }
template <int OFF> __device__ __forceinline__ s16x4 tr_read(int vb) {
  s16x4 r; asm volatile("ds_read_b64_tr_b16 %0, %1 offset:%2" : "=&v"(r) : "v"(vb), "i"(OFF) : "memory"); return r;
}
template <int D0> __device__ __forceinline__ void pv_one(f32x16& od, int vb, bf16x8 pa0, bf16x8 pa1, bf16x8 pa2, bf16x8 pa3) {
  const s16x4 l0 = tr_read<v_rd_off(D0, 0, 0)>(vb), h0 = tr_read<v_rd_off(D0, 0, 1)>(vb), l1 = tr_read<v_rd_off(D0, 1, 0)>(vb), h1 = tr_read<v_rd_off(D0, 1, 1)>(vb);
  const s16x4 l2 = tr_read<v_rd_off(D0, 2, 0)>(vb), h2 = tr_read<v_rd_off(D0, 2, 1)>(vb), l3 = tr_read<v_rd_off(D0, 3, 0)>(vb), h3 = tr_read<v_rd_off(D0, 3, 1)>(vb);
  asm volatile("s_waitcnt lgkmcnt(0)" ::: "memory"); SBAR();
#define PK(L, H) (bf16x8){L[0], L[1], L[2], L[3], H[0], H[1], H[2], H[3]}
  od = __builtin_amdgcn_mfma_f32_32x32x16_bf16(pa0, PK(l0, h0), od, 0, 0, 0);
  od = __builtin_amdgcn_mfma_f32_32x32x16_bf16(pa1, PK(l1, h1), od, 0, 0, 0);
  od = __builtin_amdgcn_mfma_f32_32x32x16_bf16(pa2, PK(l2, h2), od, 0, 0, 0);
  od = __builtin_amdgcn_mfma_f32_32x32x16_bf16(pa3, PK(l3, h3), od, 0, 0, 0);
#undef PK
}
__device__ __forceinline__ void pv_d0(f32x16* o, int vb, bf16x8 pa0, bf16x8 pa1, bf16x8 pa2, bf16x8 pa3) {
  pv_one<0>(o[0], vb, pa0, pa1, pa2, pa3); pv_one<1>(o[1], vb, pa0, pa1, pa2, pa3); pv_one<2>(o[2], vb, pa0, pa1, pa2, pa3); pv_one<3>(o[3], vb, pa0, pa1, pa2, pa3);
}
__device__ __forceinline__ void apply_mask(f32x16& p0, f32x16& p1, int mtype, int krel0, int qi, int hi) {
  if (mtype == 0) return;
  const float ninf = -__builtin_inff();
#pragma unroll
  for (int r = 0; r < 16; ++r) { const int k0 = krel0 + crow(r, hi), k1 = k0 + 32;
    const bool ok0 = (mtype == 1) ? (k0 >= qi - 128) : (k0 <= qi + 128), ok1 = (mtype == 1) ? (k1 >= qi - 128) : (k1 <= qi + 128);
    p0[r] = ok0 ? p0[r] : ninf; p1[r] = ok1 ? p1[r] : ninf; }
}
struct Tile { gcbf kn; gcbf kr; gcbf v; int mtype; int krel0; };

__device__ __forceinline__ void rope_pair(bf16x8& a, bf16x8& b, gcfl ct, gcfl st) {
  const f32x4 c0 = *(const GAS f32x4*)ct, c1 = *(const GAS f32x4*)(ct + 4), s0 = *(const GAS f32x4*)st, s1 = *(const GAS f32x4*)(st + 4);
  const float cs[8] = {c0[0], c0[1], c0[2], c0[3], c1[0], c1[1], c1[2], c1[3]}, sn[8] = {s0[0], s0[1], s0[2], s0[3], s1[0], s1[1], s1[2], s1[3]};
  v4u ua = __builtin_bit_cast(v4u, a), ub = __builtin_bit_cast(v4u, b); v4u oa, ob;
#pragma unroll
  for (int w = 0; w < 4; ++w) { const float x1[2] = {bflo(ua[w]), bfhi(ua[w])}, x2[2] = {bflo(ub[w]), bfhi(ub[w])}; float y1[2], y2[2];
#pragma unroll
    for (int e = 0; e < 2; ++e) { const float c = cs[2 * w + e], sv = sn[2 * w + e]; y1[e] = x1[e] * c - x2[e] * sv; y2[e] = x2[e] * c + x1[e] * sv; }
    oa[w] = pk2(y1[0], y1[1]); ob[w] = pk2(y2[0], y2[1]); }
  a = __builtin_bit_cast(bf16x8, oa); b = __builtin_bit_cast(bf16x8, ob);
}

template <int DQK, int LDKN, int LDV, bool MASK, bool SINK, int SDEPTH, class TS>
__device__ __forceinline__ void attn_body(gcbf Qw, int rope, int prow, int pcol, gcfl rtab, int qi, float sink_l2, const TS& ts, int NT, gbfp Ow, LAS char* lds) {
  constexpr float SCALE = DQK == 128 ? 0.088388347648318440f : 0.072168783648703220f;
  constexpr float C = SCALE * 1.4426950408889634f;
  constexpr int SHM_K = KVBLK * (DQK * 2 + 16), SHM_V = KVBLK * 128 * 2;
  int tid = threadIdx.x; asm volatile("" : "+v"(tid));
  const int wid = tid >> 6, lane = tid & 63, r32 = lane & 31, hi = lane >> 5;
  LAS char* V_lds = lds; LAS char* K_lds = lds + 2 * SHM_V;
  LAS float* wsl = (LAS float*)(lds + 2 * SHM_V + 2 * SHM_K) + wid * 64; LAS float* li_l = wsl; LAS float* al_l = wsl + 32;
  float m_reg = -1e30f, l_reg = 0; f32x16 o[4] = {}; bf16x8 qr[8];
#pragma unroll
  for (int d0 = 0; d0 < 8; ++d0) qr[d0] = *(const GAS bf16x8*)(Qw + d0 * 16 + hi * 8);
  const LAS char* qx = lds + 2 * SHM_V + 2 * SHM_K + 2048 + wid * 4608 + r32 * 144 + hi * 16;
  if constexpr (DQK == 192) {
    bf16x8 x0 = *(const GAS bf16x8*)(Qw + 128 + hi * 8), x1 = *(const GAS bf16x8*)(Qw + 144 + hi * 8), x2 = *(const GAS bf16x8*)(Qw + 160 + hi * 8), x3 = *(const GAS bf16x8*)(Qw + 176 + hi * 8);
    if (rope) {
      rope_pair(x0, x1, rtab + (size_t)prow * 16 + hi * 8, rtab + 2048 + (size_t)prow * 16 + hi * 8);
      rope_pair(x2, x3, rtab + (size_t)pcol * 16 + hi * 8, rtab + 2048 + (size_t)pcol * 16 + hi * 8); }
    LAS char* qw_ = (LAS char*)qx; *(LAS bf16x8*)(qw_) = x0; *(LAS bf16x8*)(qw_ + 32) = x1; *(LAS bf16x8*)(qw_ + 64) = x2; *(LAS bf16x8*)(qw_ + 96) = x3;
  }
  const int sr = tid >> 4, sc = (tid & 15) * 8, vst0 = v_st(sr, sc), vst1 = v_st(32 + sr, sc);
  const int rr_ = tid >> 3, rc_ = (tid & 7) * 8;
  const int vb0 = (int)(uintptr_t)V_lds + v_rd_base(lane);
  struct { bf16x8 vs0, vs1, ks0, ks1, kx; } sr_[SDEPTH];
#define SLOAD(i, jt) do { const Tile t_ = ts(jt); sr_[i].vs0 = *(const GAS bf16x8*)(t_.v + (size_t)sr * LDV + sc); sr_[i].vs1 = *(const GAS bf16x8*)(t_.v + (size_t)(32 + sr) * LDV + sc); \
    sr_[i].ks0 = *(const GAS bf16x8*)(t_.kn + (size_t)sr * LDKN + sc); sr_[i].ks1 = *(const GAS bf16x8*)(t_.kn + (size_t)(32 + sr) * LDKN + sc); \
    if constexpr (DQK == 192) sr_[i].kx = *(const GAS bf16x8*)(t_.kr + (size_t)rr_ * 64 + rc_); } while (0)
#define SWRITE(b, i) do { *(LAS bf16x8*)(V_lds + (b) * SHM_V + vst0) = sr_[i].vs0; *(LAS bf16x8*)(V_lds + (b) * SHM_V + vst1) = sr_[i].vs1; const int kc = sc * 2; \
    *(LAS bf16x8*)(K_lds + (b) * SHM_K + kswz<DQK>(sr, kc)) = sr_[i].ks0; *(LAS bf16x8*)(K_lds + (b) * SHM_K + kswz<DQK>(32 + sr, kc)) = sr_[i].ks1; \
    if constexpr (DQK == 192) *(LAS bf16x8*)(K_lds + (b) * SHM_K + kswz<DQK>(rr_, 256 + rc_ * 2)) = sr_[i].kx; } while (0)
#define SWAIT() do { if constexpr (SDEPTH == 2) { if constexpr (DQK == 192) asm volatile("s_waitcnt vmcnt(5)" ::: "memory"); else asm volatile("s_waitcnt vmcnt(4)" ::: "memory"); } \
    else asm volatile("s_waitcnt vmcnt(0)" ::: "memory"); } while (0)
#define RESC(a) do { if (__any((a) < 1.f)) { if (hi == 0) al_l[r32] = (a); asm volatile("s_waitcnt lgkmcnt(0)" ::: "memory"); \
    _Pragma("unroll") for (int d = 0; d < 4; ++d) _Pragma("unroll") for (int r = 0; r < 16; ++r) o[d][r] *= al_l[crow(r, hi)]; } } while (0)
#define MASKT(pa_, pb_, jt) do { if constexpr (MASK) { const Tile t_ = ts(jt); apply_mask(pa_, pb_, t_.mtype, t_.krel0, qi, hi); } } while (0)
  f32x16 pA0, pA1, pB0, pB1; float mnA, mnB, alA, alB; bf16x8 pa0, pa1, pa2, pa3;
  constexpr int SE = 0, SO = SDEPTH - 1;
  SLOAD(SE, 0); asm volatile("s_waitcnt vmcnt(0)" ::: "memory"); SWRITE(0, SE); __syncthreads();
  qkt<DQK>(pA0, pA1, K_lds, qr, qx, r32, hi); MASKT(pA0, pA1, 0); partialSM<DQK>(pA0, pA1, m_reg, mnA, alA);
  SLOAD(SO, 1); if constexpr (SDEPTH == 2) { if (2 < NT) SLOAD(SE, 2); }
  SWAIT(); SWRITE(1, SO); __syncthreads();
  for (int j = 1; j + 1 < NT; j += 2) {
    SBAR(); qkt<DQK>(pB0, pB1, K_lds + SHM_K, qr, qx, r32, hi); MASKT(pB0, pB1, j);
    finishSM(pA0, pA1, alA, l_reg, pa0, pa1, pa2, pa3); SBAR();
    SLOAD(SO, j + SDEPTH); SBAR();
    pv_d0(o, vb0, pa0, pa1, pa2, pa3); partialSM<DQK>(pB0, pB1, m_reg, mnB, alB);
    __syncthreads(); SWAIT(); SWRITE(0, SE);
    RESC(alB); __syncthreads();
    SBAR(); qkt<DQK>(pA0, pA1, K_lds, qr, qx, r32, hi); MASKT(pA0, pA1, j + 1);
    finishSM(pB0, pB1, alB, l_reg, pa0, pa1, pa2, pa3); SBAR();
    if (SDEPTH == 1 || j + 3 < NT) SLOAD(SE, j + 1 + SDEPTH); SBAR();
    pv_d0(o, vb0 + SHM_V, pa0, pa1, pa2, pa3); partialSM<DQK>(pA0, pA1, m_reg, mnA, alA);
    __syncthreads(); SWAIT(); SWRITE(1, SO);
    RESC(alA); __syncthreads();
  }
  SBAR(); qkt<DQK>(pB0, pB1, K_lds + SHM_K, qr, qx, r32, hi); MASKT(pB0, pB1, NT - 1);
  finishSM(pA0, pA1, alA, l_reg, pa0, pa1, pa2, pa3); SBAR();
  pv_d0(o, vb0, pa0, pa1, pa2, pa3); partialSM<DQK>(pB0, pB1, m_reg, mnB, alB);
  __syncthreads(); RESC(alB);
  finishSM(pB0, pB1, alB, l_reg, pa0, pa1, pa2, pa3); SBAR();
  pv_d0(o, vb0 + SHM_V, pa0, pa1, pa2, pa3);
  if constexpr (SINK) l_reg += __builtin_amdgcn_exp2f(sink_l2 - m_reg * C);
  if (hi == 0) li_l[r32] = l_reg; asm volatile("s_waitcnt lgkmcnt(0)" ::: "memory");
  float rli[16];
#pragma unroll
  for (int r = 0; r < 16; ++r) rli[r] = __builtin_amdgcn_rcpf(li_l[crow(r, hi)]);
  __syncthreads();
  LAS bf16* ost = (LAS bf16*)(lds + wid * 8704);
#pragma unroll
  for (int r = 0; r < 16; ++r) { const int orow = crow(r, hi);
#pragma unroll
    for (int d0 = 0; d0 < 4; ++d0) ost[orow * 136 + d0 * 32 + r32] = (bf16)f2bf(o[d0][r] * rli[r]); }
  asm volatile("s_waitcnt lgkmcnt(0)" ::: "memory");
#pragma unroll
  for (int i = 0; i < 8; ++i) { const int orow = i * 4 + (lane >> 4), ch = lane & 15;
    *(GAS v4u*)(Ow + (size_t)orow * 4096 + ch * 8) = *(const LAS v4u*)(ost + orow * 136 + ch * 8); }
  __syncthreads();
#undef SLOAD
#undef SWRITE
#undef SWAIT
#undef RESC
#undef MASKT
}
}

struct Args { const float* in[38]; float* out; unsigned char* ws; };
template <class T> __device__ __forceinline__ T launder(T p) { asm volatile("" : "+s"(p)); return p; }
template <class T> __device__ __forceinline__ T* launder_g(T* p) { asm volatile("" : "+s"(p)); return p; }
struct Frame {
    LAS unsigned char* lds;
    gu32* ctl;
    int tid, lane, wave;
    int vcu, G, gw, NGW;
    const __attribute__((address_space(4))) Args* A;
    float* out;
    unsigned char* ws;
};
enum { I_X = 0, I_C, I_CTX, I_CCTX, I_WMOD, I_BMOD, I_WIN, I_WOUT, I_LN1G, I_LN1B, I_WFF1, I_WFF2, I_LN2G, I_LN2B, I_SINK, I_CONVW, I_CONVB, I_LWA, I_LBA, I_LWI, I_LBI, I_LAM,
       I_QNORM, I_KVNORM, I_WQB, I_WKVB, I_MUP, I_MUN, I_W0, I_W2, I_A0, I_A2, I_G2, I_KK, I_KA, I_RK, I_LNG, I_LNB };
__device__ __forceinline__ int row_s(int row) { return row < SEQ ? 0 : (row < M_LAT ? 1 : 2); }
__device__ __forceinline__ const float* mod_ptr(const Frame& F, int l, int s, int chunk) { return (const float*)(F.ws + WS_MOD) + ((size_t)(l * 3 + s) * 6 + chunk) * DM; }

__device__ __forceinline__ void transpose_item(const float* W, int N, int Kvalid, bf16* WT, int ldt, const float* kscale, LAS float* scr, int k0, int n0, int lane) {
#pragma unroll
    for (int i = 0; i < 32; ++i) { const int kk = 2 * i + (lane >> 5); const int k = k0 + kk; float v = 0.f;
        if (k < Kvalid) { v = W[(size_t)k * N + n0 + (lane & 31)]; if (kscale) v *= kscale[k]; }
        scr[kk * 33 + (lane & 31)] = v; }
    LDS_WAIT(); asm volatile("" ::: "memory");
    const int c = lane & 7;
#pragma unroll
    for (int j = 0; j < 4; ++j) { const int n = (lane >> 3) + 8 * j; const LAS float* s = scr + (8 * c) * 33 + n;
        v4u o; o.x = pk2(s[0 * 33], s[1 * 33]); o.y = pk2(s[2 * 33], s[3 * 33]); o.z = pk2(s[4 * 33], s[5 * 33]); o.w = pk2(s[6 * 33], s[7 * 33]);
        *(v4u*)(WT + (size_t)(n0 + n) * ldt + k0 + 8 * c) = o; }
    LDS_WAIT(); asm volatile("" ::: "memory");
}
__device__ __forceinline__ void convert_weights(Frame& F, int l) {
    LAS float* scr = (LAS float*)(F.lds + F.wave * 16384);
    constexpr int I1 = 64 * 271, I2 = 64 * 128, I3 = 64 * 512, I4 = 256 * 128, I5 = 16 * 48, I6 = 8 * 64, I7 = 32 * 8, I8 = 2 * 32, I9 = 2 * 32, I10 = 3 * 32;
    constexpr int NIT = I1 + I2 + I3 + I4 + I5 + I6 + I7 + I8 + I9 + I10;
    unsigned char* ws = F.ws;
    for (int it = F.gw; it < NIT; it += F.NGW) {
        int r = it;
        if (r < I1) { transpose_item(F.A->in[I_WIN] + (size_t)l * DM * DIN, DIN, DM, (bf16*)(ws + WS_WIN), DM, nullptr, scr, 64 * (r / 271), 32 * (r % 271), F.lane); continue; } r -= I1;
        if (r < I2) { transpose_item(F.A->in[I_WOUT] + (size_t)l * DM * DM, DM, DM, (bf16*)(ws + WS_WOUT), DM, nullptr, scr, 64 * (r / 128), 32 * (r % 128), F.lane); continue; } r -= I2;
        if (r < I3) { transpose_item(F.A->in[I_WFF1] + (size_t)l * DM * DFF, DFF, DM, (bf16*)(ws + WS_WFF1), DM, nullptr, scr, 64 * (r / 512), 32 * (r % 512), F.lane); continue; } r -= I3;
        if (r < I4) { transpose_item(F.A->in[I_WFF2] + (size_t)l * DFF * DM, DM, DFF, (bf16*)(ws + WS_WFF2), DFF, nullptr, scr, 64 * (r / 128), 32 * (r % 128), F.lane); continue; } r -= I4;
        if (r < I5) { transpose_item(F.A->in[I_WQB] + (size_t)l * 1024 * 1536, 1536, 1024, (bf16*)(ws + WS_WQB), 1024, F.A->in[I_QNORM] + l * 1024, scr, 64 * (r / 48), 32 * (r % 48), F.lane); continue; } r -= I5;
        if (r < I6) { transpose_item(F.A->in[I_WKVB] + (size_t)l * 512 * 2048, 2048, 512, (bf16*)(ws + WS_WKVB), 512, F.A->in[I_KVNORM] + l * 512, scr, 64 * (r / 64), 32 * (r % 64), F.lane); continue; } r -= I6;
        if (r < I7) { const int mat = r >> 3, sub = r & 7, gate = mat & 1, dn = mat >> 1;
            const int d = dn >> 3, n = dn & 7;
            const float* src = (gate ? F.A->in[I_LWI] : F.A->in[I_LWA]) + ((size_t)(l * 2 + d) * 8 + n) * 128 * 128;
            bf16* dst = (bf16*)(ws + WS_WLRU) + ((size_t)(d * 2 + gate) * 8 + n) * 128 * 128;
            transpose_item(src, 128, 128, dst, 128, nullptr, scr, 64 * (sub >> 2), 32 * (sub & 3), F.lane); continue; } r -= I7;
        if (r < I8) { const int d = r >> 5; transpose_item(F.A->in[I_W2] + (size_t)(l * 2 + d) * 64 * 1024, 1024, 64, (bf16*)(ws + WS_W2T) + (size_t)d * 1024 * 64, 64, nullptr, scr, 0, 32 * (r & 31), F.lane); continue; } r -= I8;
        if (r < I9) { const int d = r >> 5; transpose_item(F.A->in[I_A2] + (size_t)(l * 2 + d) * 64 * 1024, 1024, 64, (bf16*)(ws + WS_A2T) + (size_t)d * 1024 * 64, 64, nullptr, scr, 0, 32 * (r & 31), F.lane); continue; } r -= I9;
        transpose_item(F.A->in[I_G2] + (size_t)l * 160 * 1024, 1024, 160, (bf16*)(ws + WS_G2T), 192, nullptr, scr, 64 * (r / 32), 32 * (r % 32), F.lane);
    }
    { unsigned zz = 0u; asm volatile("" : "+v"(zz)); v4u z = {zz, zz, zz, zz}; v4u* p = (v4u*)((bf16*)(ws + WS_WIN) + (size_t)DIN * DM);
      for (int i = F.gw * 64 + F.lane; i < 32 * DM / 8; i += F.NGW * 64) p[i] = z; }
}

__device__ __forceinline__ void mod_partials(Frame& F) {
    LAS float* sl = (LAS float*)F.lds;
    for (int it = F.vcu; it < 2 * 32 * 12; it += F.G) {
        const int l = it / 384, ks = (it / 12) % 32, cc = it % 12;
        __syncthreads();
        if (F.tid < 384) { const int s = F.tid >> 7, k = ks * 128 + (F.tid & 127); const float c = s < 2 ? F.A->in[I_C][s * DM + k] : F.A->in[I_CCTX][k]; sl[F.tid] = c / (1.f + __expf(-c)); }
        __syncthreads();
        const float* wp = F.A->in[I_WMOD] + ((size_t)l * DM + ks * 128) * 24576 + cc * 2048 + F.tid * 4;
        f32x4 a0 = {0.f, 0.f, 0.f, 0.f}, a1 = a0, a2 = a0;
#pragma unroll 8
        for (int k = 0; k < 128; ++k) { const f32x4 w = *(const f32x4*)(wp + (size_t)k * 24576); a0 += w * sl[k]; a1 += w * sl[128 + k]; a2 += w * sl[256 + k]; }
        float* op = (float*)(F.ws + WS_MODP) + ((size_t)(l * 32 + ks) * 3) * 24576 + cc * 2048 + F.tid * 4;
        *(f32x4*)(op) = a0; *(f32x4*)(op + 24576) = a1; *(f32x4*)(op + 2 * 24576) = a2;
    }
    __syncthreads();
}
__device__ __forceinline__ void mod_reduce(Frame& F) {
    for (int i = F.vcu * NTHR + F.tid; i < 2 * 3 * 24576; i += F.G * NTHR) {
        const int l = i / (3 * 24576), s = (i / 24576) % 3, n = i % 24576;
        float a = F.A->in[I_BMOD][l * 24576 + n];
        const float* pp = (const float*)(F.ws + WS_MODP) + ((size_t)(l * 32) * 3 + s) * 24576 + n;
#pragma unroll 8
        for (int ks = 0; ks < 32; ++ks) a += pp[(size_t)ks * 3 * 24576];
        ((float*)(F.ws + WS_MOD))[i] = a;
    }
}

template <int MODE>
__device__ __forceinline__ void ln_row(const Frame& F, const float* xsrc, const float* Y, const float* ga, const float* lg, const float* lb, float* xdst,
                                       bool domod, const float* sc, const float* sh, bf16* hrow) {
    f32x4 v[16]; float s = 0.f;
#pragma unroll
    for (int j = 0; j < 16; ++j) { const int c = 4 * F.lane + 256 * j; v[j] = *(const f32x4*)(xsrc + c);
        if (MODE == 1) { const f32x4 y = *(const f32x4*)(Y + c), g = *(const f32x4*)(ga + c); v[j] = v[j] * ALPHA + g * y; }
        s += (v[j].x + v[j].y) + (v[j].z + v[j].w); }
    float mean = wave_sum(s) * (1.f / DM), s2 = 0.f;
#pragma unroll
    for (int j = 0; j < 16; ++j) { v[j] = v[j] - mean; s2 += (v[j].x * v[j].x + v[j].y * v[j].y) + (v[j].z * v[j].z + v[j].w * v[j].w); }
    float rstd = 1.f / sqrtf(wave_sum(s2) * (1.f / DM) + LN_EPS);
    if (MODE == 1) {
        s = 0.f;
#pragma unroll
        for (int j = 0; j < 16; ++j) { const int c = 4 * F.lane + 256 * j; const f32x4 g = *(const f32x4*)(lg + c), b = *(const f32x4*)(lb + c); v[j] = v[j] * rstd * g + b;
            *(f32x4*)(xdst + c) = v[j]; s += (v[j].x + v[j].y) + (v[j].z + v[j].w); }
        if (!domod) return;
        mean = wave_sum(s) * (1.f / DM); s2 = 0.f;
#pragma unroll
        for (int j = 0; j < 16; ++j) { v[j] = v[j] - mean; s2 += (v[j].x * v[j].x + v[j].y * v[j].y) + (v[j].z * v[j].z + v[j].w * v[j].w); }
        rstd = 1.f / sqrtf(wave_sum(s2) * (1.f / DM) + LN_EPS);
    }
#pragma unroll
    for (int j = 0; j < 16; ++j) { const int c = 4 * F.lane + 256 * j; const f32x4 a = *(const f32x4*)(sc + c), b = *(const f32x4*)(sh + c);
        const f32x4 o = v[j] * rstd * (a + 1.f) + b; v2u w; w.x = pk2(o.x, o.y); w.y = pk2(o.z, o.w); *(v2u*)(hrow + c) = w; }
}

__device__ __forceinline__ void shift4(const bf16* P, unsigned eo, bool hp, bool hn, const float* mup, const float* mun, unsigned mo, float (&u)[4]) {
    const v2u xc = ldg<v2u>(P, eo * 2u); v2u xp = {0u, 0u}, xn = {0u, 0u};
    if (hp) xp = ldg<v2u>(P, (eo - DINP) * 2u); if (hn) xn = ldg<v2u>(P, (eo + DINP) * 2u);
    const f32x4 mp = ldg<f32x4>(mup, mo * 4u), mn = ldg<f32x4>(mun, mo * 4u);
    const float c[4] = {bflo(xc.x), bfhi(xc.x), bflo(xc.y), bfhi(xc.y)}, p[4] = {bflo(xp.x), bfhi(xp.x), bflo(xp.y), bfhi(xp.y)}, n[4] = {bflo(xn.x), bfhi(xn.x), bflo(xn.y), bfhi(xn.y)};
#pragma unroll
    for (int e = 0; e < 4; ++e) u[e] = c[e] + mp[e] * (p[e] - c[e]) + mn[e] * (n[e] - c[e]);
}
__device__ __forceinline__ void st4bf(void* base, unsigned eo, float a, float b, float c, float d) { v2u w; w.x = pk2(a, b); w.y = pk2(c, d); stg<v2u>(base, eo * 2u, w); }

__device__ __forceinline__ void rwkv_feat_item(Frame& F, int l, int item) {
    F.tid = ltid(); F.lane = F.tid & 63;
    int row0, seq_lo, seq_hi;
    if (item < 16) { const int b = item >> 3; seq_lo = M_LAT + b * NCTX; seq_hi = seq_lo + NCTX; row0 = seq_lo + (item & 7) * 32; }
    else { const int it = item - 16, b = it >> 8; seq_lo = b * SEQ; seq_hi = seq_lo + SEQ; row0 = seq_lo + (it & 255) * 32; }
    const bf16* P = (const bf16*)(F.ws + WS_P);
    LAS bf16* ACT = (LAS bf16*)F.lds;
    const float* mup = F.A->in[I_MUP] + l * RWC; const float* mun = F.A->in[I_MUN] + l * RWC;
    __syncthreads();
    { const int tok = F.tid >> 4, jc = F.tid & 15, row = row0 + tok; const bool hp = row > seq_lo, hn = row + 1 < seq_hi;
      const bf16* pr = P + (size_t)row * DINP + C_RWL;
      for (int i = 0; i < 13; ++i) { const int j = jc * 2 + 32 * i;
          const unsigned xc = *(const unsigned*)(pr + j), xp = hp ? *(const unsigned*)(pr - DINP + j) : 0u, xn = hn ? *(const unsigned*)(pr + DINP + j) : 0u;
          float u[2];
#pragma unroll
          for (int e = 0; e < 2; ++e) { const float c = e ? bfhi(xc) : bflo(xc), p = e ? bfhi(xp) : bflo(xp), n = e ? bfhi(xn) : bflo(xn);
              float v = c + mup[3072 + j + e] * (p - c) + mun[3072 + j + e] * (n - c);
              if (j < 128) v = tanhf_(v); else if (j >= 256) v = sigmoidf_(v);
              u[e] = v; }
          *(LAS unsigned*)(ACT + tok * 424 + j) = pk2(u[0], u[1]); } }
    __syncthreads();
    const int tok = F.lane & 31, hi = F.lane >> 5, row = row0 + tok; const bool hp = row > seq_lo, hn = row + 1 < seq_hi;
    const unsigned prow = (unsigned)row * DINP;
    const bf16* W2T = (const bf16*)(F.ws + WS_W2T); const bf16* A2T = (const bf16*)(F.ws + WS_A2T); const bf16* G2T = (const bf16*)(F.ws + WS_G2T);
    bf16* RWF = (bf16*)(F.ws + WS_RWF); const size_t RS = (size_t)M_TOT * 1024;
    const float* kkv = F.A->in[I_KK] + l * 1024; const float* kav = F.A->in[I_KA] + l * 1024; const float* rkv = F.A->in[I_RK] + l * 1024;
    const float* w0f = F.A->in[I_W0] + (size_t)(l * 2) * 1024; const float* a0f = F.A->in[I_A0] + (size_t)(l * 2) * 1024;
    const LAS bf16* actl = ACT + tok * 424 + hi * 8;
#pragma unroll 1
    for (int hh = 0; hh < 2; ++hh) {
        const int h = 2 * F.wave + hh, cbase = h * 64;
        float ssq = 0.f;
#pragma unroll
        for (int bg = 0; bg < 8; ++bg) { const unsigned c4 = cbase + (bg >> 2) * 32 + 8 * (bg & 3) + 4 * hi; float uk[4];
            shift4(P, prow + C_RWK + c4, hp, hn, mup, mun, 1024 + c4, uk); const f32x4 k4 = ldg<f32x4>(kkv, c4 * 4u);
#pragma unroll
            for (int e = 0; e < 4; ++e) { const float q = uk[e] * k4[e]; ssq += q * q; } }
        ssq = half_swap_sum(ssq);
        const float rn = 1.f / fmaxf(sqrtf(ssq), 1e-12f);
        float sb = 0.f;
#pragma unroll 1
        for (int blk = 0; blk < 2; ++blk) {
            const unsigned cblk = cbase + blk * 32, cha = cblk + tok;
            const unsigned ob = (unsigned)row * 1024 + cblk + 4 * hi;
#pragma unroll 1
            for (int d = 0; d < 2; ++d) { f32x16 aw = {};
#pragma unroll
                for (int ks = 0; ks < 4; ++ks) { const bf16x8 bw = *(const LAS bf16x8*)(actl + d * 64 + ks * 16); const bf16x8 w_ = ldg<bf16x8>(W2T, ((d * 1024 + cha) * 64 + ks * 16 + hi * 8) * 2u);
                    aw = __builtin_amdgcn_mfma_f32_32x32x16_bf16(w_, bw, aw, 0, 0, 0); }
#pragma unroll
                for (int g = 0; g < 4; ++g) { const f32x4 w0 = ldg<f32x4>(w0f, (d * 1024 + cblk + 8 * g + 4 * hi) * 4u); float e4[4];
#pragma unroll
                    for (int e = 0; e < 4; ++e) e4[e] = __expf(-softplusf_(-(w0[e] + aw[4 * g + e])) - 0.5f);
                    st4bf(RWF + (4 + d) * RS, ob + 8 * g, e4[0], e4[1], e4[2], e4[3]); } }
            { f32x16 ag = {};
#pragma unroll
              for (int ks = 0; ks < 10; ++ks) { const bf16x8 bg_ = *(const LAS bf16x8*)(actl + 256 + ks * 16); const bf16x8 g_ = ldg<bf16x8>(G2T, (cha * 192 + ks * 16 + hi * 8) * 2u);
                  ag = __builtin_amdgcn_mfma_f32_32x32x16_bf16(g_, bg_, ag, 0, 0, 0); }
#pragma unroll
              for (int g = 0; g < 4; ++g) st4bf(RWF + 8 * RS, ob + 8 * g, ag[4 * g], ag[4 * g + 1], ag[4 * g + 2], ag[4 * g + 3]); }
            { f32x16 aaf = {}, aab = {};
#pragma unroll
              for (int ks = 0; ks < 4; ++ks) { const bf16x8 baf = *(const LAS bf16x8*)(actl + 128 + ks * 16), bab = *(const LAS bf16x8*)(actl + 192 + ks * 16);
                  const bf16x8 a_f = ldg<bf16x8>(A2T, (cha * 64 + ks * 16 + hi * 8) * 2u), a_b = ldg<bf16x8>(A2T, ((1024 + cha) * 64 + ks * 16 + hi * 8) * 2u);
                  aaf = __builtin_amdgcn_mfma_f32_32x32x16_bf16(a_f, baf, aaf, 0, 0, 0); aab = __builtin_amdgcn_mfma_f32_32x32x16_bf16(a_b, bab, aab, 0, 0, 0); }
#pragma unroll
              for (int g = 0; g < 4; ++g) { const unsigned c4 = cblk + 8 * g + 4 * hi; float ur[4], uk[4], uv[4];
                  shift4(P, prow + C_RWR + c4, hp, hn, mup, mun, c4, ur);
                  shift4(P, prow + C_RWK + c4, hp, hn, mup, mun, 1024 + c4, uk);
                  shift4(P, prow + C_RWV + c4, hp, hn, mup, mun, 2048 + c4, uv);
                  const f32x4 a0a = ldg<f32x4>(a0f, c4 * 4u), a0b = ldg<f32x4>(a0f, (1024 + c4) * 4u), kk4 = ldg<f32x4>(kkv, c4 * 4u), ka4 = ldg<f32x4>(kav, c4 * 4u), rk4 = ldg<f32x4>(rkv, c4 * 4u);
                  float af[4], ab[4], kk[4];
#pragma unroll
                  for (int e = 0; e < 4; ++e) { const int r = 4 * g + e;
                      af[e] = sigmoidf_(a0a[e] + aaf[r]); ab[e] = sigmoidf_(a0b[e] + aab[r]); kk[e] = uk[e] * kk4[e] * rn;
                      const float kdf = uk[e] * (1.f + (af[e] - 1.f) * ka4[e]), kdb = uk[e] * (1.f + (ab[e] - 1.f) * ka4[e]);
                      sb += ur[e] * rk4[e] * (kdf + kdb); }
                  const unsigned o = ob + 8 * g;
                  st4bf(RWF + 0 * RS, o, ur[0], ur[1], ur[2], ur[3]); st4bf(RWF + 1 * RS, o, uk[0], uk[1], uk[2], uk[3]); st4bf(RWF + 2 * RS, o, uv[0], uv[1], uv[2], uv[3]);
                  st4bf(RWF + 3 * RS, o, kk[0], kk[1], kk[2], kk[3]); st4bf(RWF + 6 * RS, o, af[0], af[1], af[2], af[3]); st4bf(RWF + 7 * RS, o, ab[0], ab[1], ab[2], ab[3]);
                  asm volatile("" ::: "memory"); } }
        }
        sb = half_swap_sum(sb);
        if (hi == 0) ((float*)(F.ws + WS_SB))[(size_t)row * 16 + h] = sb;
    }
}

__device__ __forceinline__ float gelu_tanh(float x) { return 0.5f * x * (1.f + tanhf(0.7978845608028654f * (x + 0.044715f * x * x * x))); }
template <bool PASS3>
__device__ __forceinline__ void lru_item(Frame& F, int l, int item) {
    F.tid = ltid(); F.lane = F.tid & 63;
    const int sc = item >> 3, nb = item & 7, b = sc / NCH, ch = sc % NCH;
    int row0, seq_lo, seq_hi;
    if (ch < 8) { seq_lo = M_LAT + b * NCTX; seq_hi = seq_lo + NCTX; row0 = seq_lo + ch * 32; }
    else { seq_lo = b * SEQ; seq_hi = seq_lo + SEQ; row0 = seq_lo + (ch - 8) * 32; }
    const bf16* P = (const bf16*)(F.ws + WS_P);
    LAS float* U = (LAS float*)F.lds;
    LAS bf16* UA = (LAS bf16*)(F.lds + 16384);
    LAS float* AB = (LAS float*)(F.lds + 32768);
    __syncthreads();
    { const int tok = F.tid >> 4, c8 = (F.tid & 15) * 8, cg = nb * 128 + c8; float acc[8];
      const float* cb = F.A->in[I_CONVB] + l * 1024 + cg;
#pragma unroll
      for (int e = 0; e < 8; ++e) acc[e] = cb[e];
#pragma unroll
      for (int j = 0; j < 4; ++j) { const int r = row0 + tok - 2 + j;
          if (r >= seq_lo && r < seq_hi) { const v4u x = *(const v4u*)(P + (size_t)r * DINP + C_LRUX + cg); const float* cw = F.A->in[I_CONVW] + (size_t)(l * 4 + j) * 1024 + cg;
#pragma unroll
              for (int w = 0; w < 4; ++w) { acc[2 * w] += cw[2 * w] * bflo(x[w]); acc[2 * w + 1] += cw[2 * w + 1] * bfhi(x[w]); } } }
      *(LAS f32x4*)(U + tok * 128 + c8) = (f32x4){acc[0], acc[1], acc[2], acc[3]}; *(LAS f32x4*)(U + tok * 128 + c8 + 4) = (f32x4){acc[4], acc[5], acc[6], acc[7]};
      v4u o; o.x = pk2(acc[0], acc[1]); o.y = pk2(acc[2], acc[3]); o.z = pk2(acc[4], acc[5]); o.w = pk2(acc[6], acc[7]);
      *(LAS v4u*)(UA + tok * 136 + c8) = o; }
    __syncthreads();
    { const int dir = F.wave >> 2, cq = F.wave & 3, l32 = F.lane & 31, hi = F.lane >> 5, chn = cq * 32 + l32, cg = nb * 128 + chn;
      const bf16* Wr = (const bf16*)(F.ws + WS_WLRU) + ((size_t)(dir * 2 + 0) * 8 + nb) * 16384 + (size_t)chn * 128;
      const bf16* Wi = (const bf16*)(F.ws + WS_WLRU) + ((size_t)(dir * 2 + 1) * 8 + nb) * 16384 + (size_t)chn * 128;
      f32x16 accr = {}, acci = {};
#pragma unroll
      for (int ks = 0; ks < 8; ++ks) { const int ko = ks * 16 + hi * 8;
          const bf16x8 a = *(const LAS bf16x8*)(UA + l32 * 136 + ko); const bf16x8 br = *(const bf16x8*)(Wr + ko), bi = *(const bf16x8*)(Wi + ko);
          accr = __builtin_amdgcn_mfma_f32_32x32x16_bf16(a, br, accr, 0, 0, 0); acci = __builtin_amdgcn_mfma_f32_32x32x16_bf16(a, bi, acci, 0, 0, 0); }
      const float ba = F.A->in[I_LBA][(l * 2 + dir) * 1024 + cg], bi_ = F.A->in[I_LBI][(l * 2 + dir) * 1024 + cg], sp = softplusf_(-F.A->in[I_LAM][(l * 2 + dir) * 1024 + cg]);
#pragma unroll
      for (int r = 0; r < 16; ++r) { const int tok = att::crow(r, hi); const float u = U[tok * 128 + chn];
          const float rg = sigmoidf_(accr[r] + ba), ig = sigmoidf_(acci[r] + bi_), la = -8.f * rg * sp, a = __expf(la), bc = sqrtf(-expm1f(2.f * la)) * (ig * u);
          AB[(dir * 2 + 0) * 4096 + tok * 128 + chn] = a; AB[(dir * 2 + 1) * 4096 + tok * 128 + chn] = bc; } }
    __syncthreads();
    if (F.tid < 256) { const int dir = F.tid >> 7, chn = F.tid & 127, cg = nb * 128 + chn; const size_t ci = ((size_t)(dir * 2 + b) * NCH + ch) * 1024 + cg;
        LAS float* Aa = AB + (dir * 2) * 4096 + chn; LAS float* Bb = AB + (dir * 2 + 1) * 4096 + chn;
        if (!PASS3) { float h = 0.f, ap = 1.f;
#pragma unroll 8
            for (int s = 0; s < 32; ++s) { const int tok = dir ? 31 - s : s; const float a = Aa[tok * 128]; h = a * h + Bb[tok * 128]; ap *= a;
                if (s == 0 && dir == 1 && ch == 7) ((float*)(F.ws + WS_QUIRK))[b * 1024 + cg] = h; }
            ((float*)(F.ws + WS_CA))[ci] = ap; ((float*)(F.ws + WS_CB))[ci] = h;
        } else { float h = ((const float*)(F.ws + WS_HIN))[ci];
#pragma unroll 8
            for (int s = 0; s < 32; ++s) { const int tok = dir ? 31 - s : s; h = Aa[tok * 128] * h + Bb[tok * 128]; Bb[tok * 128] = h; } } }
    if (PASS3) { __syncthreads();
        const int tok = F.tid >> 4, c8 = (F.tid & 15) * 8, cg = nb * 128 + c8, row = row0 + tok;
        const v4u y = *(const v4u*)(P + (size_t)row * DINP + C_LRUY + cg); float o[8];
#pragma unroll
        for (int w = 0; w < 4; ++w) { const float h0 = AB[4096 + tok * 128 + c8 + 2 * w] + AB[3 * 4096 + tok * 128 + c8 + 2 * w], h1 = AB[4096 + tok * 128 + c8 + 2 * w + 1] + AB[3 * 4096 + tok * 128 + c8 + 2 * w + 1];
            o[2 * w] = h0 * gelu_tanh(bflo(y[w])); o[2 * w + 1] = h1 * gelu_tanh(bfhi(y[w])); }
        v4u ov; ov.x = pk2(o[0], o[1]); ov.y = pk2(o[2], o[3]); ov.z = pk2(o[4], o[5]); ov.w = pk2(o[6], o[7]);
        *(v4u*)((bf16*)(F.ws + WS_MIX) + (size_t)row * DM + 1024 + cg) = ov; }
}
__device__ __forceinline__ void lru_carry(Frame& F) {
    F.tid = ltid(); F.lane = F.tid & 63;
    const int gid = F.vcu * NTHR + F.tid; if (gid >= 4096) return;
    const int dir = gid >> 11, b = (gid >> 10) & 1, cg = gid & 1023;
    const float* CA = (const float*)(F.ws + WS_CA) + ((size_t)(dir * 2 + b) * NCH) * 1024 + cg; const float* CB = (const float*)(F.ws + WS_CB) + ((size_t)(dir * 2 + b) * NCH) * 1024 + cg;
    float* HIN = (float*)(F.ws + WS_HIN) + ((size_t)(dir * 2 + b) * NCH) * 1024 + cg;
    float h = 0.f;
    if (dir == 0) {
#pragma unroll 8
        for (int c = 0; c < NCH; ++c) { HIN[(size_t)c * 1024] = h; h = CA[(size_t)c * 1024] * h + CB[(size_t)c * 1024]; }
    } else {
        for (int c = 7; c >= 0; --c) { HIN[(size_t)c * 1024] = h; h = CA[(size_t)c * 1024] * h + CB[(size_t)c * 1024]; }
        h = ((const float*)(F.ws + WS_QUIRK))[b * 1024 + cg];
#pragma unroll 8
        for (int c = NCH - 1; c >= 8; --c) { HIN[(size_t)c * 1024] = h; h = CA[(size_t)c * 1024] * h + CB[(size_t)c * 1024]; }
    }
}

__device__ __forceinline__ void rope_table(Frame& F) {
    const int i = F.vcu * NTHR + F.tid; if (i >= 2048) return;
    const int pos = i >> 4, f = i & 15; float s, c; sincosf((float)pos * exp2f(-(float)f * (13.287712379549449f / 16.f)), &s, &c);
    float* t = (float*)(F.ws + WS_ROPE); t[i] = c; t[2048 + i] = s;
}
__device__ __forceinline__ void row_prep(Frame& F, int row) {
    F.tid = ltid(); F.lane = F.tid & 63;
    bf16* pr = (bf16*)(F.ws + WS_P) + (size_t)row * DINP; const int lane = F.lane;
    const bool lat = row < M_LAT; const int t = row & (SEQ - 1); const float prow = (float)(t >> 6), pcol = (float)(t & 63);
    { const v4u a = *(const v4u*)(pr + C_QA + lane * 16), b = *(const v4u*)(pr + C_QA + lane * 16 + 8); float ss = 0.f;
#pragma unroll
      for (int w = 0; w < 4; ++w) { const float x0 = bflo(a[w]), x1 = bfhi(a[w]), x2 = bflo(b[w]), x3 = bfhi(b[w]); ss += x0 * x0 + x1 * x1 + x2 * x2 + x3 * x3; }
      ss = wave_sum(ss); if (lane == 0) ((float*)(F.ws + WS_RSQ))[row] = 1.f / sqrtf(ss * (1.f / 1024.f) + RMS_EPS); }
    { const v4u a = *(const v4u*)(pr + C_KVA + lane * 8); float ss = 0.f;
#pragma unroll
      for (int w = 0; w < 4; ++w) { const float x0 = bflo(a[w]), x1 = bfhi(a[w]); ss += x0 * x0 + x1 * x1; }
      ss = wave_sum(ss); if (lane == 0) ((float*)(F.ws + WS_RSKV))[row] = 1.f / sqrtf(ss * (1.f / 512.f) + RMS_EPS); }
    bf16* kr = (bf16*)(F.ws + WS_KR) + (size_t)row * 64;
    if (lat) {
        { const int part = lane >> 5, sub = lane & 31;
          const float inv = exp2f(-(float)sub * (13.287712379549449f / 32.f)); float sn, cs; sincosf((part ? pcol : prow) * inv, &sn, &cs);
#pragma unroll
          for (int hd = 0; hd < 10; ++hd) { bf16* qb = pr + (hd < 8 ? C_SWAQ + hd * 128 : C_SWAK + (hd - 8) * 128) + part * 64;
              const float x1 = bf2f(qb[sub]), x2 = bf2f(qb[sub + 32]); qb[sub] = (bf16)f2bf(x1 * cs - x2 * sn); qb[sub + 32] = (bf16)f2bf(x2 * cs + x1 * sn); } }
        if (lane < 32) { const int part = lane >> 4, i = lane & 15; const bf16* src = pr + C_KR + part * 32;
          const float inv = exp2f(-(float)i * (13.287712379549449f / 16.f)); float s, c; sincosf((part ? pcol : prow) * inv, &s, &c);
          const float x1 = bf2f(src[i]), x2 = bf2f(src[i + 16]);
          kr[part * 32 + i] = (bf16)f2bf(x1 * c - x2 * s); kr[part * 32 + i + 16] = (bf16)f2bf(x2 * c + x1 * s); }
    } else kr[lane] = pr[C_KR + lane];
}

__device__ __forceinline__ float allred16(float x) { return row_sum16(x); }
__device__ __forceinline__ int scan_row(int s, int dir, int b) {
    if (s < NCTX) return M_LAT + b * NCTX + (dir ? NCTX - 1 - s : s);
    const int t = s - NCTX; return b * SEQ + (dir ? SEQ - 1 - t : t);
}
__device__ __forceinline__ void rwkv_scan(Frame& F, int l, int chain) {
    F.tid = ltid(); F.lane = F.tid & 63;
    const int dir = chain >> 5, b = (chain >> 4) & 1, h = chain & 15;
    constexpr int CT = 32, NCHK = (NCTX + SEQ) / CT, BUFB = CT * 6 * 64 * 4;
    LAS float* buf = (LAS float*)F.lds; LAS float* ybuf = (LAS float*)(F.lds + 2 * BUFB);
    gcbf RWF = (gcbf)(F.ws + WS_RWF); const size_t RS = (size_t)M_TOT * 1024;
    gflp YS = (gflp)(F.ws + WS_YS) + (size_t)dir * M_TOT * 1024;
    const int lst = F.tid >> 4, lq = F.tid & 15, lc = h * 64 + 4 * lq;
    const f32x4 ka4 = *(const GAS f32x4*)((gcfl)F.A->in[I_KA] + l * 1024 + lc);
    v2u gr, gk, gv, gkk, ge, ga;
#define RW_LOAD(c) do { const size_t o_ = (size_t)scan_row((c) * CT + lst, dir, b) * 1024 + lc; gr = *(const GAS v2u*)(RWF + 0 * RS + o_); gk = *(const GAS v2u*)(RWF + 1 * RS + o_); gv = *(const GAS v2u*)(RWF + 2 * RS + o_); \
        gkk = *(const GAS v2u*)(RWF + 3 * RS + o_); ge = *(const GAS v2u*)(RWF + (4 + dir) * RS + o_); ga = *(const GAS v2u*)(RWF + (6 + dir) * RS + o_); } while (0)
#define RW_WRITE(bi) do { LAS float* d_ = buf + (bi) * (BUFB / 4) + lst * 384 + 4 * lq; \
        const float r_[4] = {bflo(gr.x), bfhi(gr.x), bflo(gr.y), bfhi(gr.y)}, k_[4] = {bflo(gk.x), bfhi(gk.x), bflo(gk.y), bfhi(gk.y)}, v_[4] = {bflo(gv.x), bfhi(gv.x), bflo(gv.y), bfhi(gv.y)}; \
        const float q_[4] = {bflo(gkk.x), bfhi(gkk.x), bflo(gkk.y), bfhi(gkk.y)}, e_[4] = {bflo(ge.x), bfhi(ge.x), bflo(ge.y), bfhi(ge.y)}, a_[4] = {bflo(ga.x), bfhi(ga.x), bflo(ga.y), bfhi(ga.y)}; \
        f32x4 w4, kd4, kk4, b4, r4, v4; _Pragma("unroll") for (int e = 0; e < 4; ++e) { w4[e] = __expf(-e_[e]); kd4[e] = k_[e] * (1.f + (a_[e] - 1.f) * ka4[e]); kk4[e] = q_[e]; b4[e] = q_[e] * a_[e]; r4[e] = r_[e]; v4[e] = v_[e]; } \
        *(LAS f32x4*)(d_) = w4; *(LAS f32x4*)(d_ + 64) = kd4; *(LAS f32x4*)(d_ + 128) = kk4; *(LAS f32x4*)(d_ + 192) = b4; *(LAS f32x4*)(d_ + 256) = r4; *(LAS f32x4*)(d_ + 320) = v4; } while (0)
    __syncthreads();
    RW_LOAD(0); RW_WRITE(0); RW_LOAD(1); RW_WRITE(1);
    __syncthreads();
    const int kg = F.lane & 15, rg = F.lane >> 4, r0 = 8 * F.wave + 2 * rg;
    float S0[4] = {0.f, 0.f, 0.f, 0.f}, S1[4] = {0.f, 0.f, 0.f, 0.f};
    for (int c = 0; c < NCHK; ++c) {
        if (c + 2 < NCHK) RW_LOAD(c + 2);
        const LAS float* bb = buf + (c & 1) * (BUFB / 4) + 4 * kg; const LAS float* vb = buf + (c & 1) * (BUFB / 4) + 320 + r0;
        f32x4 w4 = *(const LAS f32x4*)(bb), kd4 = *(const LAS f32x4*)(bb + 64), kk4 = *(const LAS f32x4*)(bb + 128), b4 = *(const LAS f32x4*)(bb + 192), r4 = *(const LAS f32x4*)(bb + 256); f32x2 v2 = *(const LAS f32x2*)(vb);
#pragma unroll 4
        for (int st = 0; st < CT; ++st) {
            const int sn = st + 1 < CT ? st + 1 : st;
            const f32x4 nw4 = *(const LAS f32x4*)(bb + sn * 384), nkd4 = *(const LAS f32x4*)(bb + sn * 384 + 64), nkk4 = *(const LAS f32x4*)(bb + sn * 384 + 128), nb4 = *(const LAS f32x4*)(bb + sn * 384 + 192), nr4 = *(const LAS f32x4*)(bb + sn * 384 + 256);
            const f32x2 nv2 = *(const LAS f32x2*)(vb + sn * 384);
            float p0 = (S0[0] * kk4[0] + S0[1] * kk4[1]) + (S0[2] * kk4[2] + S0[3] * kk4[3]);
            float p1 = (S1[0] * kk4[0] + S1[1] * kk4[1]) + (S1[2] * kk4[2] + S1[3] * kk4[3]);
            p0 = allred16(p0); p1 = allred16(p1);
#pragma unroll
            for (int i = 0; i < 4; ++i) { S0[i] = S0[i] * w4[i] + v2[0] * kd4[i] - p0 * b4[i]; S1[i] = S1[i] * w4[i] + v2[1] * kd4[i] - p1 * b4[i]; }
            float y0 = (S0[0] * r4[0] + S0[1] * r4[1]) + (S0[2] * r4[2] + S0[3] * r4[3]);
            float y1 = (S1[0] * r4[0] + S1[1] * r4[1]) + (S1[2] * r4[2] + S1[3] * r4[3]);
            y0 = allred16(y0); y1 = allred16(y1);
            if (kg == 0) *(LAS f32x2*)(ybuf + st * 64 + r0) = (f32x2){y0, y1};
            w4 = nw4; kd4 = nkd4; kk4 = nkk4; b4 = nb4; r4 = nr4; v2 = nv2;
        }
        __syncthreads();
        { const f32x4 y = *(const LAS f32x4*)(ybuf + lst * 64 + 4 * lq); *(GAS f32x4*)(YS + (size_t)scan_row(c * CT + lst, dir, b) * 1024 + lc) = y; }
        if (c + 2 < NCHK) RW_WRITE(c & 1);
        __syncthreads();
    }
#undef RW_LOAD
#undef RW_WRITE
}
__device__ __forceinline__ void rwkv_out_row(Frame& F, int l, int row) {
    F.tid = ltid(); F.lane = F.tid & 63;
    const int c0 = F.lane * 16; const float* yf = (const float*)(F.ws + WS_YS) + (size_t)row * 1024 + c0; const float* yb = yf + (size_t)M_TOT * 1024;
    float y[16]; float s = 0.f;
#pragma unroll
    for (int j = 0; j < 4; ++j) { const f32x4 a = *(const f32x4*)(yf + 4 * j), b = *(const f32x4*)(yb + 4 * j);
#pragma unroll
        for (int e = 0; e < 4; ++e) { y[4 * j + e] = a[e] + b[e]; s += y[4 * j + e]; } }
    s = quad_sum(s); const float mu = s * (1.f / 64.f); float q = 0.f;
#pragma unroll
    for (int e = 0; e < 16; ++e) { y[e] -= mu; q += y[e] * y[e]; }
    q = quad_sum(q); const float rstd = 1.f / sqrtf(q * (1.f / 64.f) + GN_EPS);
    const bf16* RWF = (const bf16*)(F.ws + WS_RWF); const size_t RS = (size_t)M_TOT * 1024, o = (size_t)row * 1024 + c0;
    const float sbv = ((const float*)(F.ws + WS_SB))[(size_t)row * 16 + (F.lane >> 2)];
    const float* lg = F.A->in[I_LNG] + l * 1024 + c0; const float* lb = F.A->in[I_LNB] + l * 1024 + c0;
    bf16* dst = (bf16*)(F.ws + WS_MIX) + (size_t)row * DM + 3072 + c0;
#pragma unroll
    for (int hf = 0; hf < 2; ++hf) { const v4u vv = *(const v4u*)(RWF + 2 * RS + o + 8 * hf), gg = *(const v4u*)(RWF + 8 * RS + o + 8 * hf); float r[8];
#pragma unroll
        for (int w = 0; w < 4; ++w) { const int e = 8 * hf + 2 * w;
            r[2 * w] = (y[e] * rstd * lg[e] + lb[e] + sbv * bflo(vv[w])) * bflo(gg[w]); r[2 * w + 1] = (y[e + 1] * rstd * lg[e + 1] + lb[e + 1] + sbv * bfhi(vv[w])) * bfhi(gg[w]); }
        v4u ov; ov.x = pk2(r[0], r[1]); ov.y = pk2(r[2], r[3]); ov.z = pk2(r[4], r[5]); ov.w = pk2(r[6], r[7]); *(v4u*)(dst + 8 * hf) = ov; }
}

struct MlaTiles { gcbf KV; gcbf KR; int ctx_row0, lat_row0, h;
    __device__ __forceinline__ att::Tile operator()(int j) const { const int row = j < 4 ? ctx_row0 + 64 * j : lat_row0 + 64 * (j - 4);
        att::Tile t; t.kn = KV + (size_t)row * 2048 + h * 256; t.v = t.kn + 128; t.kr = KR + (size_t)row * 64; t.mtype = 0; t.krel0 = 0; return t; } };
struct SwaTiles { gcbf P; int blk_row0, ctx_row0, kvh, nwin, has_prev, has_next;
    __device__ __forceinline__ att::Tile operator()(int j) const { att::Tile t; int row; t.mtype = 0; t.krel0 = 0;
        if (j >= nwin) row = ctx_row0 + 64 * (j - nwin);
        else if (j < 2) row = blk_row0 + 64 * j;
        else if (has_prev && j < 4) { row = blk_row0 - 128 + 64 * (j - 2); t.mtype = 1; t.krel0 = -128 + 64 * (j - 2); }
        else { const int sub = j - 2 - 2 * has_prev; row = blk_row0 + 128 + 64 * sub; t.mtype = 2; t.krel0 = 128 + 64 * sub; }
        t.kn = P + (size_t)row * DINP + C_SWAK + kvh * 128; t.v = P + (size_t)row * DINP + C_SWAV + kvh * 128; t.kr = nullptr; return t; } };

#ifndef MLA_SDEPTH
#define MLA_SDEPTH 1
#endif
__device__ __forceinline__ void mla_item(Frame& F, int b, int h, int qb, bool ctxq) {
    F.tid = ltid(); F.lane = F.tid & 63;
    const int r32 = F.lane & 31; const int t = qb * 256 + F.wave * 32 + r32;
    const int roww0 = ctxq ? M_LAT + b * NCTX + F.wave * 32 : b * SEQ + qb * 256 + F.wave * 32;
    gcbf Qw = (gcbf)(F.ws + WS_Q) + (size_t)(roww0 + r32) * 1536 + h * 192;
    MlaTiles ts{(gcbf)(F.ws + WS_KV), (gcbf)(F.ws + WS_KR), M_LAT + b * NCTX, b * SEQ, h};
    gbfp Ow = (gbfp)(F.ws + WS_MIX) + (size_t)roww0 * DM + 2048 + h * 128;
    att::attn_body<192, 2048, 2048, false, false, MLA_SDEPTH>(Qw, ctxq ? 0 : 1, t >> 6, t & 63, (gcfl)(F.ws + WS_ROPE), 0, 0.f, ts, ctxq ? 4 : 132, Ow, (LAS char*)F.lds);
}
__device__ __forceinline__ void swa_item(Frame& F, int l, int b, int n, int kvh, int half, bool ctxq, int hq_ctx) {
    F.tid = ltid(); F.lane = F.tid & 63;
    const int r32 = F.lane & 31; gcbf P = (gcbf)(F.ws + WS_P);
    int hq, qi, roww0, t;
    if (ctxq) { hq = hq_ctx; kvh = hq >> 2; qi = 0; roww0 = M_LAT + b * NCTX + F.wave * 32; t = 0; }
    else { hq = kvh * 4 + 2 * half + (F.wave >> 2); qi = (F.wave & 3) * 32 + r32; roww0 = b * SEQ + n * 128 + (F.wave & 3) * 32; t = n * 128 + qi; }
    gcbf Qw = P + (size_t)(roww0 + r32) * DINP + C_SWAQ + hq * 128;
    SwaTiles ts; ts.P = P; ts.blk_row0 = b * SEQ + n * 128; ts.ctx_row0 = M_LAT + b * NCTX; ts.kvh = kvh;
    ts.has_prev = (!ctxq && n > 0) ? 1 : 0; ts.has_next = (!ctxq && n < SEQ / 128 - 1) ? 1 : 0; ts.nwin = ctxq ? 0 : 2 + 2 * ts.has_prev + 2 * ts.has_next;
    gbfp Ow = (gbfp)(F.ws + WS_MIX) + (size_t)roww0 * DM + hq * 128;
    const float sink_l2 = F.A->in[I_SINK][l * 8 + hq] * 1.4426950408889634f;
    att::attn_body<128, DINP, DINP, true, true, 2>(Qw, 0, 0, 0, (gcfl)nullptr, qi, sink_l2, ts, ts.nwin + 4, Ow, (LAS char*)F.lds);
}

#ifndef DBG_PHASES
#define DBG_PHASES 0xfffff
#endif
#define PH(n) ((DBG_PHASES >> (n)) & 1)
#ifndef DUP_PHASES
#define DUP_PHASES 0
#endif
#define REP(n) _Pragma("unroll") for (int rep_ = 0; rep_ < (((DUP_PHASES >> (n)) & 1) ? 2 : 1); ++rep_)
__global__ void __launch_bounds__(NTHR, 2) mk_fwd(Args args) {
    extern __shared__ __attribute__((aligned(16))) unsigned char lds[];
    Frame F;
    F.lds = (LAS unsigned char*)lds;
    F.tid = threadIdx.x; F.lane = F.tid & 63; F.wave = __builtin_amdgcn_readfirstlane(F.tid >> 6);
    F.G = gridDim.x; { const int bx = blockIdx.x; F.vcu = (F.G % 8 == 0) ? (bx % 8) * (F.G / 8) + bx / 8 : bx; }
    F.gw = F.vcu * NWAVES + F.wave; F.NGW = F.G * NWAVES;
    F.ws = args.ws; F.out = args.out; F.ctl = (gu32*)(args.ws + WS_CTL);
    F.A = (const __attribute__((address_space(4))) Args*)__builtin_amdgcn_kernarg_segment_ptr();
    for (int u = F.tid; u < (LDS_BYTES - LDSCTL_OFF) / 4; u += NTHR) ((LAS unsigned*)(F.lds + LDSCTL_OFF))[u] = 0u;
    __syncthreads();
    XcdBarrier bar = xcd_barrier_post((unsigned*)(args.ws + WS_CTL) + 4096, (volatile LAS unsigned*)(F.lds + MISC_OFF) + 8);
#define GRID_BAR() do { bar.bar = launder(bar.bar); bar.x = launder(bar.x); xcd_barrier(bar); F.ws = launder_g(F.ws); F.A = launder(F.A); F.tid = ltid(); F.lane = F.tid & 63; } while (0)
    const int bx = blockIdx.x;
    bf16* H = (bf16*)(F.ws + WS_H); float* X = (float*)(F.ws + WS_X);

    REP(0) if (PH(0)) { mod_partials(F);
    convert_weights(F, 0); }
    GRID_BAR();
    if (PH(1)) { mod_reduce(F); rope_table(F); }
    GRID_BAR();

#pragma unroll 1
    for (int l = 0; l < 2; ++l) {
        const bool wctx = (l == 0);
        const int MO = wctx ? M_TOT : M_LAT;
        if (PH(2) && l == 0) {
            for (int row = F.gw; row < M_TOT; row += F.NGW) { const int s = row_s(row);
                const float* xs = row < M_LAT ? F.A->in[I_X] + (size_t)row * DM : F.A->in[I_CTX] + (size_t)(row - M_LAT) * DM;
                ln_row<0>(F, xs, nullptr, nullptr, nullptr, nullptr, nullptr, true, mod_ptr(F, 0, s, 1), mod_ptr(F, 0, s, 0), H + (size_t)row * DM); }
        }
        GRID_BAR();
        REP(3) if (PH(3)) { pg8::Gemm g{H, (const bf16*)(F.ws + WS_WIN), M_TOT, DINP, DM, DM}; pg8::StaticOrder S; S.init(M_TOT, DINP, F.G, bx);
          pg8::EpiBf16<0> E{(bf16*)(F.ws + WS_P), DINP, nullptr};
          pg8::gemm_phase<pg8::EpiBf16<0>, pg8::StaticOrder, true, true>(F.lds, g, S, E); }
        GRID_BAR();
        REP(4) if (PH(4)) for (int it = F.vcu; it < 528; it += F.G) rwkv_feat_item(F, l, it);
        REP(5) if (PH(5)) for (int it = F.vcu; it < 2 * NCH * 8; it += F.G) lru_item<false>(F, l, it);
        __syncthreads();
        if (PH(6)) for (int row = F.gw; row < M_TOT; row += F.NGW) row_prep(F, row);
        GRID_BAR();
        if (PH(7)) lru_carry(F);
        REP(7) if (PH(7)) { pg8::Gemm g{(const bf16*)(F.ws + WS_P) + C_QA, (const bf16*)(F.ws + WS_WQB), M_TOT, 1536, 1024, DINP}; pg8::StaticOrder S; S.init(M_TOT, 1536, F.G, bx);
          pg8::EpiBf16<2> E{(bf16*)(F.ws + WS_Q), 1536, (const float*)(F.ws + WS_RSQ)};
          pg8::gemm_phase<pg8::EpiBf16<2>, pg8::StaticOrder, true, true>(F.lds, g, S, E); }
        REP(7) if (PH(7)) { pg8::Gemm g{(const bf16*)(F.ws + WS_P) + C_KVA, (const bf16*)(F.ws + WS_WKVB), M_TOT, 2048, 512, DINP}; pg8::StaticOrder S; S.init(M_TOT, 2048, F.G, bx);
          pg8::EpiBf16<2> E{(bf16*)(F.ws + WS_KV), 2048, (const float*)(F.ws + WS_RSKV)};
          pg8::gemm_phase<pg8::EpiBf16<2>, pg8::StaticOrder, true, true>(F.lds, g, S, E); }
        GRID_BAR();
        REP(8) if ((bx & 3) == 0) { const int nrw = (F.G + 3) >> 2; if (PH(8)) for (int chain = bx >> 2; chain < 64; chain += nrw) rwkv_scan(F, l, chain); }
        else { const int aw = (bx >> 2) * 3 + (bx & 3) - 1, naw = F.G - ((F.G + 3) >> 2);
            if (PH(9)) for (int it = aw; it < 512; it += naw) mla_item(F, it >> 8, (it >> 5) & 7, it & 31, false);
            if (PH(9) && wctx) for (int it = aw; it < 16; it += naw) mla_item(F, it >> 3, it & 7, 0, true);
            if (PH(10)) for (int it = aw; it < 512; it += naw) swa_item(F, l, it >> 8, (it >> 2) & 63, (it >> 1) & 1, it & 1, false, 0);
            if (PH(10) && wctx) for (int it = aw; it < 16; it += naw) swa_item(F, l, it >> 3, 0, 0, 0, true, it & 7);
            if (PH(11)) for (int it = aw; it < 2 * NCH * 8; it += naw) { if (!wctx && ((it >> 3) % NCH) < 8) continue; lru_item<true>(F, l, it); }
        }
        GRID_BAR();
        REP(12) if (PH(12)) for (int row = F.gw; row < MO; row += F.NGW) rwkv_out_row(F, l, row);
        GRID_BAR();
        REP(13) if (PH(13)) { pg8::Gemm g{(const bf16*)(F.ws + WS_MIX), (const bf16*)(F.ws + WS_WOUT), MO, DM, DM, DM}; pg8::StaticOrder S; S.init(MO, DM, F.G, bx);
          pg8::EpiF32 E{(float*)(F.ws + WS_Y1), DM};
          pg8::gemm_phase<pg8::EpiF32, pg8::StaticOrder, true, true>(F.lds, g, S, E); }
        GRID_BAR();
        if (PH(14)) for (int row = F.gw; row < MO; row += F.NGW) { const int s = row_s(row);
            const float* xs = (l == 0) ? (row < M_LAT ? F.A->in[I_X] + (size_t)row * DM : F.A->in[I_CTX] + (size_t)(row - M_LAT) * DM) : X + (size_t)row * DM;
            ln_row<1>(F, xs, (const float*)(F.ws + WS_Y1) + (size_t)row * DM, mod_ptr(F, l, s, 2), F.A->in[I_LN1G] + l * DM, F.A->in[I_LN1B] + l * DM, X + (size_t)row * DM,
                      true, mod_ptr(F, l, s, 4), mod_ptr(F, l, s, 3), H + (size_t)row * DM); }
        GRID_BAR();
        REP(15) if (PH(15)) { pg8::Gemm g{H, (const bf16*)(F.ws + WS_WFF1), MO, DFF, DM, DM}; pg8::StaticOrder S; S.init(MO, DFF, F.G, bx);
          pg8::EpiBf16<1> E{(bf16*)(F.ws + WS_HID), DFF, nullptr};
          pg8::gemm_phase<pg8::EpiBf16<1>, pg8::StaticOrder, true, true>(F.lds, g, S, E); }
        GRID_BAR();
        REP(16) if (PH(16)) { pg8::Gemm g{(const bf16*)(F.ws + WS_HID), (const bf16*)(F.ws + WS_WFF2), MO, DM, DFF, DFF}; pg8::StaticOrder S; S.init(MO, DM, F.G, bx);
          pg8::EpiF32 E{(float*)(F.ws + WS_Y2), DM};
          pg8::gemm_phase<pg8::EpiF32, pg8::StaticOrder, true, true>(F.lds, g, S, E); }
        GRID_BAR();
        if (!PH(17)) {} else if (l == 0) {
            for (int row = F.gw; row < M_TOT; row += F.NGW) { const int s = row_s(row);
                ln_row<1>(F, X + (size_t)row * DM, (const float*)(F.ws + WS_Y2) + (size_t)row * DM, mod_ptr(F, 0, s, 5), F.A->in[I_LN2G], F.A->in[I_LN2B], X + (size_t)row * DM,
                          true, mod_ptr(F, 1, s, 1), mod_ptr(F, 1, s, 0), H + (size_t)row * DM); }
            __syncthreads();
            convert_weights(F, 1);
        } else {
            for (int row = F.gw; row < M_LAT; row += F.NGW) { const int s = row_s(row);
                ln_row<1>(F, X + (size_t)row * DM, (const float*)(F.ws + WS_Y2) + (size_t)row * DM, mod_ptr(F, 1, s, 5), F.A->in[I_LN2G] + DM, F.A->in[I_LN2B] + DM, F.out + (size_t)row * DM,
                          false, nullptr, nullptr, nullptr); }
        }
    }
}

extern "C" void kernel_launch(void* const* d_in, const int* in_sizes, int n_in, void* d_out, int out_size, void* d_ws, size_t ws_size, hipStream_t stream) {
    static int grid = 0;
    if (grid == 0) {
        if (n_in != 38 || out_size != M_LAT * DM || ws_size < WS_END) { fprintf(stderr, "kernel_launch: unexpected shapes: n_in %d out %d ws %zu (need %zu)\n", n_in, out_size, ws_size, (size_t)WS_END); grid = -1; return; }
        int dev = 0, cus = 0, per_cu = 0;
        if (hipGetDevice(&dev) != hipSuccess || hipDeviceGetAttribute(&cus, hipDeviceAttributeMultiprocessorCount, dev) != hipSuccess) { grid = -1; return; }
        if (hipFuncSetAttribute((const void*)mk_fwd, hipFuncAttributeMaxDynamicSharedMemorySize, LDS_BYTES) != hipSuccess) { fprintf(stderr, "kernel_launch: hipFuncSetAttribute failed\n"); grid = -1; return; }
        if (hipOccupancyMaxActiveBlocksPerMultiprocessor(&per_cu, (const void*)mk_fwd, NTHR, LDS_BYTES) != hipSuccess || per_cu < 1) fprintf(stderr, "kernel_launch: occupancy query says %d\n", per_cu);
        (void)hipGetLastError();
        grid = cus;
    }
    if (grid < 0) return;
    if (hipMemsetAsync((char*)d_ws + WS_CTL, 0, CTL_ZERO_BYTES, stream) != hipSuccess) return;
    Args a{};
    for (int i = 0; i < 38; ++i) a.in[i] = (const float*)d_in[i];
    a.out = (float*)d_out; a.ws = (unsigned char*)d_ws;
    hipLaunchKernelGGL(mk_fwd, dim3(grid), dim3(NTHR), LDS_BYTES, stream, a);
    const hipError_t le = hipPeekAtLastError();
    if (le != hipSuccess) fprintf(stderr, "kernel_launch: launch failed: %s\n", hipGetErrorName(le));
}
```

```cpp
#include <hip/hip_runtime.h>
#include <hip/hip_bf16.h>
#include <cstdio>
#include <cstdint>

namespace pg8 {
#define PG8_LAS __attribute__((address_space(3)))
typedef unsigned short bf16_t;
typedef short bf16x8 __attribute__((ext_vector_type(8)));
typedef float f32x4 __attribute__((ext_vector_type(4)));
typedef unsigned u32x4 __attribute__((ext_vector_type(4)));
constexpr int BM = 256, BK = 64, HALF = 128, HTB = HALF * BK * 2  , STAGE_BYTES = 8 * HTB, NXCD = 8, WGM = 8;

__host__ __device__ __forceinline__ int lds_byte(int r, int c) { const int st = (r >> 4) * 2 + (c >> 5), rr = r & 15, cc = c & 31, ob = rr * 64 + cc * 2; return st * 1024 + (ob ^ (((ob >> 9) & 1) << 5)); }
__host__ __device__ __forceinline__ void stage_rc(int b, int& R, int& C) { const int st = b / 1024, sb = b % 1024, swz = sb ^ (((sb >> 9) & 1) << 5); R = (st >> 1) * 16 + swz / 64; C = (st & 1) * 32 + (swz % 64) / 2; }
__host__ __device__ __forceinline__ int perm32(int rho) { const int n = rho >> 4, i = rho & 15; return 8 * (i >> 2) + 4 * n + (i & 3); }

struct Unit { int pm, pn; };
struct Gemm { const bf16_t* A; const bf16_t* Bt; int M, N, K, lda; };

struct StaticOrder {
    int nM, nN, nwg, G, c;
    __host__ __device__ void init(int M, int N, int G_, int c_) { nM = M / BM; nN = N / BM; nwg = nM * nN; G = G_; c = c_; }
    __host__ __device__ bool next(int i, Unit& u) const {
        const long L = (long)i * G + c; if (L >= nwg) return false;
        int wgid = (int)L; { const int q = nwg / NXCD, r = nwg % NXCD, xcd = wgid % NXCD, off = wgid / NXCD; wgid = (xcd < r ? xcd * (q + 1) : r * (q + 1) + (xcd - r) * q) + off; }
        const int nig = WGM * nN, gid = wgid / nig, fm = gid * WGM, gsz = (nM - fm) < WGM ? (nM - fm) : WGM;
        u.pm = fm + ((wgid % nig) % gsz); u.pn = (wgid % nig) / gsz; return true;
    }
    __device__ __forceinline__ void a_ready(const Unit&) const {}
    __device__ __forceinline__ void done(const Unit&) const {}
};

__device__ __forceinline__ unsigned cvt_pk_bf16(float lo, float hi) { unsigned r; asm volatile("v_cvt_pk_bf16_f32 %0, %1, %2" : "=v"(r) : "v"(lo), "v"(hi)); return r; }

struct EpiF32 {
    static constexpr bool PERM = false, AFTER_DRAIN = false;
    float* C; int ldc;
    __device__ __forceinline__ void operator()(const f32x4 (&acc)[2][2][4][2], const Unit& u, int wr, int wc, int fr, int fq) const {
        const int row0 = u.pm * BM + wr * 64 + fr, col0 = u.pn * BM + wc * 32 + 4 * fq;
#pragma unroll
        for (int ai = 0; ai < 2; ++ai)
#pragma unroll
            for (int m = 0; m < 4; ++m) { float* rowp = C + (size_t)(row0 + ai * HALF + m * 16) * ldc + col0;
#pragma unroll
                for (int bj = 0; bj < 2; ++bj)
#pragma unroll
                    for (int n = 0; n < 2; ++n) *(f32x4*)(rowp + bj * HALF + n * 16) = acc[ai][bj][m][n]; }
    }
};
template <int ACT> struct EpiBf16 {
    static constexpr bool PERM = true, AFTER_DRAIN = false;
    bf16_t* O; int ldc; const float* rowscale;
    __device__ __forceinline__ void operator()(const f32x4 (&acc)[2][2][4][2], const Unit& u, int wr, int wc, int fr, int fq) const {
        const int row0 = u.pm * BM + wr * 64 + fr; const int col0 = u.pn * BM + wc * 32 + 8 * fq;
#pragma unroll
        for (int ai = 0; ai < 2; ++ai)
#pragma unroll
            for (int m = 0; m < 4; ++m) { const int row = row0 + ai * HALF + m * 16; bf16_t* rowp = O + (size_t)row * ldc + col0;
                float rs = 1.f; if (ACT == 2) rs = rowscale[row];
#pragma unroll
                for (int bj = 0; bj < 2; ++bj) { f32x4 v0 = acc[ai][bj][m][0], v1 = acc[ai][bj][m][1];
                    if (ACT == 1) {
#pragma unroll
                        for (int j = 0; j < 4; ++j) { const float a = fmaxf(v0[j], 0.f), b = fmaxf(v1[j], 0.f); v0[j] = a * a; v1[j] = b * b; } }
                    if (ACT == 2) { v0 = v0 * rs; v1 = v1 * rs; }
                    u32x4 w; w.x = cvt_pk_bf16(v0[0], v0[1]); w.y = cvt_pk_bf16(v0[2], v0[3]); w.z = cvt_pk_bf16(v1[0], v1[1]); w.w = cvt_pk_bf16(v1[2], v1[3]);
                    *(u32x4*)(rowp + bj * HALF) = w; } }
    }
};

template <class Epi, class Sched, bool ALIGN_EPI = false, bool SP2 = false>
__device__ __forceinline__ void gemm_phase(PG8_LAS unsigned char* lds, const Gemm g, const Sched& S, const Epi& E) {
    int tid = threadIdx.x; asm volatile("" : "+v"(tid));
    const int wid = __builtin_amdgcn_readfirstlane(tid >> 6), lane = tid & 63, wr = wid >> 2, wc = wid & 3, fr = lane & 15, fq = lane >> 4;
    const int K = g.K, nt = K / BK, lda = g.lda;
    unsigned voffA[2], voffB[2];
#pragma unroll
    for (int i = 0; i < 2; ++i) { int R, C; stage_rc(tid * 16 + i * 8192, R, C); const int Rb = Epi::PERM ? ((R & ~31) + perm32(R & 31)) : R;
        voffA[i] = (unsigned)(R * lda + C) * 2u; voffB[i] = (unsigned)(Rb * K + C) * 2u; }
    const size_t kstep = (size_t)(BK * 2);
    const size_t hstepA = (size_t)HALF * lda * 2, hstepB = (size_t)HALF * K * 2;
    const size_t tstepA = 2 * hstepA, tstepB = 2 * hstepB;
    const unsigned ldsw = (unsigned)wid * 1024u;
    const int aoff = lds_byte(wr * 64 + fr, fq * 8), boff = lds_byte(wc * 32 + fr, fq * 8);
#define PG8_SA(b, h) (((b) * 2 + (h)) * HTB)
#define PG8_SB(b, h) ((4 + (b) * 2 + (h)) * HTB)
#define PG8_STAGE(bufoff, gbase, voff) do { _Pragma("unroll") for (int _i = 0; _i < 2; ++_i) \
        __builtin_amdgcn_global_load_lds((const unsigned*)((const char*)(gbase) + (voff)[_i]), (PG8_LAS unsigned*)(lds + (bufoff) + ldsw + _i * 8192), 16, 0, 0); } while (0)
#define PG8_LDA(dst, b, h) do { _Pragma("unroll") for (int m = 0; m < 4; ++m) _Pragma("unroll") for (int k = 0; k < 2; ++k) dst[m][k] = *(const PG8_LAS bf16x8*)(lds + PG8_SA(b, h) + aoff + m * 2048 + k * 1024); } while (0)
#define PG8_LDB(dst, b, h) do { _Pragma("unroll") for (int n = 0; n < 2; ++n) _Pragma("unroll") for (int k = 0; k < 2; ++k) dst[n][k] = *(const PG8_LAS bf16x8*)(lds + PG8_SB(b, h) + boff + n * 2048 + k * 1024); } while (0)
#define PG8_MMA(ai, bj, At, Bt) do { __builtin_amdgcn_s_setprio(1); _Pragma("unroll") for (int m = 0; m < 4; ++m) _Pragma("unroll") for (int n = 0; n < 2; ++n) _Pragma("unroll") for (int k = 0; k < 2; ++k) \
        acc[ai][bj][m][n] = __builtin_amdgcn_mfma_f32_16x16x32_bf16(Bt[n][k], At[m][k], acc[ai][bj][m][n], 0, 0, 0); __builtin_amdgcn_s_setprio(0); } while (0)
#define PG8_WAIT_V(n) asm volatile("s_waitcnt vmcnt(" #n ")" ::: "memory")
#define PG8_WAIT_L(n) asm volatile("s_waitcnt lgkmcnt(" #n ")" ::: "memory")
#define PG8_BAR __builtin_amdgcn_s_barrier()
#define PG8_SCHED __builtin_amdgcn_sched_barrier(0)
    Unit cur, nxt; int ui = 0;
    if (!S.next(0, cur)) return;
    f32x4 acc[2][2][4][2];
#pragma unroll
    for (int a = 0; a < 2; ++a)
#pragma unroll
        for (int b = 0; b < 2; ++b)
#pragma unroll
            for (int m = 0; m < 4; ++m)
#pragma unroll
                for (int n = 0; n < 2; ++n) acc[a][b][m][n] = (f32x4){0.f, 0.f, 0.f, 0.f};
    bf16x8 At[4][2], B0[2][2], B1[2][2];
    const char* cA = (const char*)g.A + (size_t)cur.pm * tstepA; const char* cB = (const char*)g.Bt + (size_t)cur.pn * tstepB;
    S.a_ready(cur);
    if constexpr (SP2) {
        PG8_STAGE(PG8_SB(0, 0), cB, voffB); PG8_STAGE(PG8_SB(0, 1), cB + hstepB, voffB); PG8_STAGE(PG8_SA(0, 0), cA, voffA); PG8_STAGE(PG8_SA(0, 1), cA + hstepA, voffA);
        if (wr == 1) PG8_BAR;
        PG8_WAIT_V(2); PG8_BAR;
        PG8_STAGE(PG8_SB(1, 0), cB + kstep, voffB); PG8_STAGE(PG8_SA(1, 0), cA + kstep, voffA); PG8_STAGE(PG8_SB(1, 1), cB + hstepB + kstep, voffB);
        PG8_WAIT_V(6); PG8_BAR;
    } else {
        PG8_STAGE(PG8_SB(0, 0), cB, voffB); PG8_STAGE(PG8_SA(0, 0), cA, voffA); PG8_STAGE(PG8_SB(0, 1), cB + hstepB, voffB); PG8_STAGE(PG8_SA(0, 1), cA + hstepA, voffA);
        if (wr == 1) PG8_BAR;
        PG8_WAIT_V(4); PG8_BAR;
        PG8_STAGE(PG8_SB(1, 0), cB + kstep, voffB); PG8_STAGE(PG8_SA(1, 0), cA + kstep, voffA); PG8_STAGE(PG8_SB(1, 1), cB + hstepB + kstep, voffB);
        PG8_WAIT_V(6); PG8_BAR;
    }
    for (;;) {
        const bool has_next = S.next(ui + 1, nxt);
        const char* nA = has_next ? (const char*)g.A + (size_t)nxt.pm * tstepA : cA; const char* nB = has_next ? (const char*)g.Bt + (size_t)nxt.pn * tstepB : cB;
        for (int t = 0; t < nt; t += 2) {
            const bool last = (t == nt - 2);
            const char* a1 = cA + (size_t)(t + 1) * kstep;
            const char* a2 = last ? nA : cA + (size_t)(t + 2) * kstep; const char* b2 = last ? nB : cB + (size_t)(t + 2) * kstep;
            const char* a3 = a2 + kstep; const char* b3 = b2 + kstep;
            if (last && has_next) S.a_ready(nxt);
            if constexpr (SP2) {
            PG8_LDB(B0, 0, 0); PG8_LDB(B1, 0, 1); PG8_SCHED; PG8_LDA(At, 0, 0); PG8_STAGE(PG8_SA(1, 1), a1 + hstepA, voffA);
            PG8_WAIT_V(8); PG8_WAIT_L(0); PG8_BAR; PG8_MMA(0, 0, At, B0); PG8_MMA(0, 1, At, B1); PG8_BAR; PG8_SCHED;
            PG8_LDA(At, 0, 1); PG8_STAGE(PG8_SB(0, 0), b2, voffB); PG8_STAGE(PG8_SB(0, 1), b2 + hstepB, voffB); PG8_STAGE(PG8_SA(0, 0), a2, voffA);
            PG8_WAIT_V(8); PG8_WAIT_L(0); PG8_BAR; PG8_MMA(1, 0, At, B0); PG8_MMA(1, 1, At, B1); PG8_BAR; PG8_SCHED;
            PG8_LDB(B0, 1, 0); PG8_LDB(B1, 1, 1); PG8_SCHED; PG8_LDA(At, 1, 0); PG8_STAGE(PG8_SA(0, 1), a2 + hstepA, voffA);
            PG8_WAIT_V(8); PG8_WAIT_L(0); PG8_BAR; PG8_MMA(0, 0, At, B0); PG8_MMA(0, 1, At, B1); PG8_BAR; PG8_SCHED;
            PG8_LDA(At, 1, 1); PG8_STAGE(PG8_SB(1, 0), b3, voffB); PG8_STAGE(PG8_SB(1, 1), b3 + hstepB, voffB); PG8_STAGE(PG8_SA(1, 0), a3, voffA);
            PG8_WAIT_V(8); PG8_WAIT_L(0); PG8_BAR; PG8_MMA(1, 0, At, B0); PG8_MMA(1, 1, At, B1); PG8_BAR; PG8_SCHED;
            } else {
            PG8_LDB(B0, 0, 0); PG8_SCHED; PG8_LDA(At, 0, 0); PG8_STAGE(PG8_SA(1, 1), a1 + hstepA, voffA);
            PG8_WAIT_L(8); PG8_BAR; PG8_WAIT_L(0); PG8_MMA(0, 0, At, B0); PG8_BAR; PG8_SCHED;
            PG8_LDB(B1, 0, 1); PG8_STAGE(PG8_SB(0, 0), b2, voffB);
            PG8_BAR; PG8_WAIT_L(0); PG8_MMA(0, 1, At, B1); PG8_BAR;
            PG8_LDA(At, 0, 1); PG8_STAGE(PG8_SA(0, 0), a2, voffA);
            PG8_BAR; PG8_WAIT_L(0); PG8_MMA(1, 0, At, B0); PG8_BAR; PG8_SCHED;
            PG8_STAGE(PG8_SB(0, 1), b2 + hstepB, voffB);
            PG8_WAIT_V(6); PG8_BAR; PG8_MMA(1, 1, At, B1); PG8_BAR;
            PG8_LDB(B0, 1, 0); PG8_SCHED; PG8_LDA(At, 1, 0); PG8_STAGE(PG8_SA(0, 1), a2 + hstepA, voffA);
            PG8_WAIT_L(8); PG8_BAR; PG8_WAIT_L(0); PG8_MMA(0, 0, At, B0); PG8_BAR; PG8_SCHED;
            PG8_LDB(B1, 1, 1); PG8_STAGE(PG8_SB(1, 0), b3, voffB);
            PG8_BAR; PG8_WAIT_L(0); PG8_MMA(0, 1, At, B1); PG8_BAR;
            PG8_LDA(At, 1, 1); PG8_STAGE(PG8_SA(1, 0), a3, voffA);
            PG8_BAR; PG8_WAIT_L(0); PG8_MMA(1, 0, At, B0); PG8_BAR; PG8_SCHED;
            PG8_STAGE(PG8_SB(1, 1), b3 + hstepB, voffB);
            PG8_WAIT_V(6); PG8_BAR; PG8_MMA(1, 1, At, B1); PG8_BAR;
            }
        }
        if constexpr (ALIGN_EPI) { if (wr == 0) PG8_BAR; }
        E(acc, cur, wr, wc, fr, fq); S.done(cur);
        if (!has_next) break;
#pragma unroll
        for (int a = 0; a < 2; ++a)
#pragma unroll
            for (int b = 0; b < 2; ++b)
#pragma unroll
                for (int m = 0; m < 4; ++m)
#pragma unroll
                    for (int n = 0; n < 2; ++n) acc[a][b][m][n] = (f32x4){0.f, 0.f, 0.f, 0.f};
        cur = nxt; cA = nA; cB = nB; ++ui;
        if constexpr (ALIGN_EPI) { if (wr == 1) PG8_BAR; }
    }
    PG8_WAIT_V(0);
    if constexpr (!ALIGN_EPI) { if (wr == 0) PG8_BAR; }
    PG8_BAR;
#undef PG8_SA
#undef PG8_SB
#undef PG8_STAGE
#undef PG8_LDA
#undef PG8_LDB
#undef PG8_MMA
#undef PG8_WAIT_V
#undef PG8_WAIT_L
#undef PG8_BAR
#undef PG8_SCHED
}
}

constexpr int NWAVES = 8, NTHR = 512;
constexpr int DM = 4096, NB = 2, SEQ = 8192, NCTX = 256, DFF = 16384;
constexpr int M_LAT = NB * SEQ, M_CTX = NB * NCTX, M_TOT = M_LAT + M_CTX;
constexpr int DIN = 8672, DINP = 8704;
constexpr int C_SWAQ = 0, C_SWAK = 1024, C_SWAV = 1280, C_LRUX = 1536, C_LRUY = 2560, C_QA = 3584, C_KVA = 4608, C_KR = 5120, C_RW = 5184;
constexpr int C_RWR = C_RW, C_RWK = C_RW + 1024, C_RWV = C_RW + 2048, C_RWL = C_RW + 3072;
constexpr int RWC = 3488;
constexpr float LN_EPS = 1e-5f, RMS_EPS = 1e-6f, GN_EPS = 64e-5f, ALPHA = 1.41421356237f;
constexpr int NCH = 264;

constexpr size_t MiB = 1u << 20;
constexpr size_t WS_CTL = 0, CTL_ZERO_BYTES = 1 * MiB;
constexpr size_t WS_MOD = 1 * MiB;
constexpr size_t WS_MODP = 2 * MiB;
constexpr size_t WS_SMALL = 20 * MiB;
constexpr size_t WS_RSQ = WS_SMALL;
constexpr size_t WS_RSKV = WS_RSQ + 128 * 1024;
constexpr size_t WS_SB = WS_RSKV + 128 * 1024;
constexpr size_t WS_CA = WS_SB + 2 * MiB;
constexpr size_t WS_CB = WS_CA + 5 * MiB;
constexpr size_t WS_HIN = WS_CB + 5 * MiB;
constexpr size_t WS_QUIRK = WS_HIN + 5 * MiB;
constexpr size_t WS_ROPE = WS_QUIRK + 8192;
static_assert(WS_ROPE + 16384 <= 40 * MiB, "small region");
constexpr size_t WS_W = 40 * MiB;
constexpr size_t WS_WIN = WS_W, WS_WOUT = WS_WIN + 68 * MiB, WS_WFF1 = WS_WOUT + 32 * MiB, WS_WFF2 = WS_WFF1 + 128 * MiB, WS_WQB = WS_WFF2 + 128 * MiB,
                 WS_WKVB = WS_WQB + 3 * MiB, WS_WLRU = WS_WKVB + 2 * MiB, WS_WLORA = WS_WLRU + 1 * MiB;
constexpr size_t WS_W2T = WS_WLORA, WS_A2T = WS_W2T + 256 * 1024, WS_G2T = WS_A2T + 256 * 1024;
constexpr size_t WS_X = 403 * MiB;
constexpr size_t WS_H = 667 * MiB;
constexpr size_t WS_MIX = 799 * MiB;
constexpr size_t WS_YS = 931 * MiB;
constexpr size_t WS_P = 1063 * MiB;
constexpr size_t WS_RWF = 1344 * MiB;
constexpr size_t RWF_STRIDE = (size_t)M_TOT * 1024 * 2;
constexpr size_t WS_Q = 1641 * MiB;
constexpr size_t WS_KV = 1691 * MiB;
constexpr size_t WS_KR = 1757 * MiB;
constexpr size_t WS_SET2 = 1760 * MiB;
constexpr size_t WSET_STRIDE = WS_SET2 - WS_W;
constexpr size_t WS_END = WS_SET2 + 363 * MiB;
constexpr size_t WS_HID = WS_P;
constexpr size_t WS_Y1 = WS_P;
constexpr size_t WS_Y2 = WS_MIX;
static_assert(WS_WLORA + 1 * MiB <= WS_X && WS_P + (size_t)M_TOT * DINP * 2 <= WS_RWF && WS_RWF + 9 * RWF_STRIDE <= WS_Q, "ws map");
static_assert(WS_HID + (size_t)M_TOT * DFF * 2 <= WS_Q && WS_Y2 + (size_t)M_TOT * DM * 4 <= WS_P && WS_YS + 2 * (size_t)M_TOT * 1024 * 4 <= WS_P, "ws overlays");
static_assert(WS_KR + (size_t)M_TOT * 64 * 2 <= WS_SET2, "ws end");

constexpr int RING_BYTES = 131072;
constexpr int LDSCTL_OFF = RING_BYTES, MISC_OFF = LDSCTL_OFF + 320;
constexpr int LDS_BYTES = 147456;

#define GAS __attribute__((address_space(1)))
#define LAS __attribute__((address_space(3)))
typedef unsigned short bf16;
typedef unsigned v4u __attribute__((ext_vector_type(4)));
typedef unsigned v2u __attribute__((ext_vector_type(2)));
typedef float f32x4 __attribute__((ext_vector_type(4)));
typedef float f32x2 __attribute__((ext_vector_type(2)));
typedef float f32x16 __attribute__((ext_vector_type(16)));
typedef short bf16x8 __attribute__((ext_vector_type(8)));
typedef short s16x4 __attribute__((ext_vector_type(4)));
typedef GAS unsigned gu32;
typedef const GAS bf16* gcbf; typedef GAS bf16* gbfp; typedef const GAS float* gcfl; typedef GAS float* gflp;
#define LDS_WAIT() asm volatile("s_waitcnt lgkmcnt(0)" ::: "memory")
#define VM_WAIT() asm volatile("s_waitcnt vmcnt(0)" ::: "memory")
__device__ __forceinline__ unsigned f2bf(float f) { unsigned u = __builtin_bit_cast(unsigned, f); return (u + 0x7fffu + ((u >> 16) & 1u)) >> 16; }
__device__ __forceinline__ unsigned pk2(float lo, float hi) { return f2bf(lo) | (f2bf(hi) << 16); }
__device__ __forceinline__ float bflo(unsigned w) { return __builtin_bit_cast(float, w << 16); }
__device__ __forceinline__ float bfhi(unsigned w) { return __builtin_bit_cast(float, w & 0xffff0000u); }
__device__ __forceinline__ float bf2f(bf16 h) { return __builtin_bit_cast(float, (unsigned)h << 16); }
#define DPP_ADD(x, ctrl) ((x) + __builtin_bit_cast(float, __builtin_amdgcn_update_dpp(0, __builtin_bit_cast(int, (x)), (ctrl), 0xf, 0xf, false)))
__device__ __forceinline__ float row_sum16(float x) { x = DPP_ADD(x, 0x128); x = DPP_ADD(x, 0x124); x = DPP_ADD(x, 0x122); x = DPP_ADD(x, 0x121); return x; }
#ifdef OLD_SUMS
__device__ __forceinline__ float wave_sum(float v) {
#pragma unroll
    for (int o = 1; o < 64; o <<= 1) v += __shfl_xor(v, o);
    return v;
}
__device__ __forceinline__ float half_swap_sum(float x) { return x + __shfl_xor(x, 32); }
__device__ __forceinline__ float quad_sum(float x) { x += __shfl_xor(x, 1); x += __shfl_xor(x, 2); return x; }
#else
__device__ __forceinline__ float wave_sum(float v) {
    const float r = row_sum16(v);
    const float a = __builtin_bit_cast(float, __builtin_amdgcn_readlane(__builtin_bit_cast(int, r), 0)), b = __builtin_bit_cast(float, __builtin_amdgcn_readlane(__builtin_bit_cast(int, r), 16));
    const float c = __builtin_bit_cast(float, __builtin_amdgcn_readlane(__builtin_bit_cast(int, r), 32)), d = __builtin_bit_cast(float, __builtin_amdgcn_readlane(__builtin_bit_cast(int, r), 48));
    return (a + b) + (c + d);
}
__device__ __forceinline__ float half_swap_sum(float x) {
    unsigned a = __builtin_bit_cast(unsigned, x), b = a; asm volatile("" : "+v"(b));
    auto rr = __builtin_amdgcn_permlane32_swap(a, b, false, false);
    const float lo = __uint_as_float(rr[0]), hi = __uint_as_float(rr[1]); return lo + hi;
}
__device__ __forceinline__ float quad_sum(float x) { x = DPP_ADD(x, 0xB1); x = DPP_ADD(x, 0x4E); return x; }
#endif
__device__ __forceinline__ float sigmoidf_(float x) { return 1.f / (1.f + __expf(-x)); }
__device__ __forceinline__ float softplusf_(float x) { return x > 20.f ? x : __logf(1.f + __expf(x)); }
__device__ __forceinline__ float tanhf_(float x) { const float e = __expf(2.f * x); return 1.f - 2.f / (e + 1.f); }
__device__ __forceinline__ int ltid() { int t = threadIdx.x; asm volatile("" : "+v"(t)); return t; }
template <class T> __device__ __forceinline__ T ldg(const void* base, unsigned byteoff) { return *(const T*)((const char*)base + byteoff); }
template <class T> __device__ __forceinline__ void stg(void* base, unsigned byteoff, T v) { *(T*)((char*)base + byteoff) = v; }

#define XB_TMO      128
#define XB_XCNT(j)  (256  + 64 * (j))
#define XB_XSUB(j)  (1280 + 64 * (j))
#define XB_XGEN(j)  (2304 + 64 * (j))
#define XB_TOP      3328
#define XB_TOPGEN   3392
#define XCD_BAR_WORDS 3456
#define XB_SPIN_CAP (1u << 18)

__device__ __forceinline__ unsigned xb_ld(unsigned* p)              { return __hip_atomic_load(p, __ATOMIC_RELAXED, __HIP_MEMORY_SCOPE_AGENT); }
__device__ __forceinline__ unsigned xb_add(unsigned* p, unsigned v) { return __hip_atomic_fetch_add(p, v, __ATOMIC_RELAXED, __HIP_MEMORY_SCOPE_AGENT); }
__device__ __forceinline__ unsigned xb_xcc_id() { return (unsigned)__builtin_amdgcn_s_getreg((3 << 11) | 20) & 0xFu; }
#define XB_SPIN(cond, bar) do { unsigned _sp = 0; while (cond) { __builtin_amdgcn_s_sleep(1); \
    if ((++_sp & 255u) == 0u) { if (xb_ld(&(bar)[XB_TMO])) break; if (_sp > XB_SPIN_CAP) { atomicAdd(&(bar)[XB_TMO], 1u); break; } } } } while (0)

struct XcdBarrier {
    unsigned* bar; unsigned x;
    volatile LAS unsigned* st;
};

__device__ __forceinline__ XcdBarrier xcd_barrier_post(unsigned* bar, volatile LAS unsigned* st) {
    XcdBarrier b; b.bar = bar; b.x = xb_xcc_id(); b.st = st;
    if (threadIdx.x == 0) (void)xb_add(&bar[XB_XCNT(b.x)], 1u);
    return b;
}
__device__ __forceinline__ void xcd_barrier_complete(unsigned* bar, unsigned x, unsigned& nloc, unsigned& nx) {
    const unsigned G = gridDim.x * gridDim.y * gridDim.z;
    unsigned sum, cnt, mine, sp = 0u;
    for (;;) {
        sum = 0u; cnt = 0u; mine = 0u;
#pragma unroll
        for (unsigned j = 0; j < 16; ++j) { const unsigned c = xb_ld(&bar[XB_XCNT(j)]); sum += c; cnt += (c > 0u) ? 1u : 0u; mine = (j == x) ? c : mine; }
        if (sum == G) break;
        __builtin_amdgcn_s_sleep(1);
        if ((++sp & 255u) == 0u) { if (xb_ld(&bar[XB_TMO])) break; if (sp > XB_SPIN_CAP) { atomicAdd(&bar[XB_TMO], 1u); break; } }
    }
    nloc = mine > 0u ? mine : 1u; nx = cnt > 0u ? cnt : 1u;
}

__device__ __forceinline__ void xcd_barrier(const XcdBarrier& b) {
    asm volatile("s_waitcnt vmcnt(0)" ::: "memory");
    __syncthreads();
    if (threadIdx.x == 0) {
        unsigned* bar = b.bar;
        __builtin_amdgcn_s_waitcnt(0);
        unsigned nloc = b.st[0], nx = b.st[1];
        if (nloc == 0u) { xcd_barrier_complete(bar, b.x, nloc, nx); b.st[0] = nloc; b.st[1] = nx; }
        const unsigned old = xb_add(&bar[XB_XSUB(b.x)], 1u);
        const unsigned gen = old / nloc;
        if (old + 1u == (gen + 1u) * nloc) {
            __builtin_amdgcn_fence(__ATOMIC_RELEASE, "agent");
            asm volatile("s_waitcnt vmcnt(0)" ::: "memory");
            const unsigned og = xb_add(&bar[XB_TOP], 1u);
            const unsigned tg = og / nx;
            if (og + 1u == (tg + 1u) * nx) xb_add(&bar[XB_TOPGEN], 1u);
            else XB_SPIN(xb_ld(&bar[XB_TOPGEN]) == tg, bar);
            __builtin_amdgcn_fence(__ATOMIC_ACQUIRE, "agent");
            xb_add(&bar[XB_XGEN(b.x)], 1u);
            asm volatile("s_waitcnt vmcnt(0)" ::: "memory");
        } else {
            XB_SPIN(xb_ld(&bar[XB_XGEN(b.x)]) == gen, bar);
            __builtin_amdgcn_fence(__ATOMIC_ACQUIRE, "agent");
            asm volatile("s_waitcnt vmcnt(0)" ::: "memory");
        }
    }
    __syncthreads();
}


namespace att {
constexpr int KVBLK = 64;
constexpr float THR = 8.f;
#define SBAR() __builtin_amdgcn_sched_barrier(0)
__device__ __forceinline__ int crow(int r, int hi) { return (r & 3) + 8 * (r >> 2) + 4 * hi; }
__device__ __forceinline__ unsigned cvtpk(float lo, float hi) { unsigned r; asm volatile("v_cvt_pk_bf16_f32 %0, %1, %2" : "=v"(r) : "v"(lo), "v"(hi)); return r; }
template <int DQK> __device__ __forceinline__ int kswz(int row, int cb) { return row * (DQK * 2 + 16) + cb; }

template <int DQK> __device__ __forceinline__ void partialSM(f32x16& p0, f32x16& p1, float& m_reg, float& mn, float& alpha) {
  constexpr float SCALE = DQK == 128 ? 0.088388347648318440f : 0.072168783648703220f;
  constexpr float C = SCALE * 1.4426950408889634f;
  float pmax = p0[0];
#pragma unroll
  for (int r = 1; r < 16; ++r) pmax = fmaxf(pmax, p0[r]);
#pragma unroll
  for (int r = 0; r < 16; ++r) pmax = fmaxf(pmax, p1[r]);
  { auto rr = __builtin_amdgcn_permlane32_swap(__float_as_uint(pmax), __float_as_uint(pmax), false, false);
    pmax = fmaxf(__uint_as_float(rr[0]), __uint_as_float(rr[1])); }
  if (__builtin_expect(__all(pmax - m_reg <= THR / SCALE), 1)) { mn = m_reg; alpha = 1.f; }
  else { mn = fmaxf(m_reg, pmax); alpha = __builtin_amdgcn_exp2f((m_reg - mn) * C); m_reg = mn; }
  const float mnC = -mn * C;
#pragma unroll
  for (int r = 0; r < 16; ++r) p0[r] = fmaf(p0[r], C, mnC);
#pragma unroll
  for (int r = 0; r < 16; ++r) p1[r] = fmaf(p1[r], C, mnC);
#pragma unroll
  for (int r = 0; r < 16; ++r) p0[r] = __builtin_amdgcn_exp2f(p0[r]);
}
__device__ __forceinline__ void finishSM(f32x16& p0, f32x16& p1, float alpha, float& l_reg, bf16x8& pa0, bf16x8& pa1, bf16x8& pa2, bf16x8& pa3) {
#pragma unroll
  for (int r = 0; r < 16; ++r) p1[r] = __builtin_amdgcn_exp2f(p1[r]);
  float ps = 0;
#pragma unroll
  for (int r = 0; r < 16; ++r) ps += p0[r];
#pragma unroll
  for (int r = 0; r < 16; ++r) ps += p1[r];
  { auto rr = __builtin_amdgcn_permlane32_swap(__float_as_uint(ps), __float_as_uint(ps), false, false);
    ps = __uint_as_float(rr[0]) + __uint_as_float(rr[1]); }
  l_reg = l_reg * alpha + ps;
#define PK4(P, BASE, OUT) do { unsigned a0 = cvtpk(P[BASE + 0], P[BASE + 1]), a1 = cvtpk(P[BASE + 2], P[BASE + 3]);   \
    unsigned b0 = cvtpk(P[BASE + 4], P[BASE + 5]), b1 = cvtpk(P[BASE + 6], P[BASE + 7]);                              \
    auto r0 = __builtin_amdgcn_permlane32_swap(a0, b0, false, false); auto r1 = __builtin_amdgcn_permlane32_swap(a1, b1, false, false); \
    v4u w = {r0[0], r1[0], r0[1], r1[1]}; OUT = __builtin_bit_cast(bf16x8, w); } while (0)
  PK4(p0, 0, pa0); PK4(p0, 8, pa1); PK4(p1, 0, pa2); PK4(p1, 8, pa3);
#undef PK4
}
template <int DQK> __device__ __forceinline__ void qkt(f32x16& p0, f32x16& p1, const LAS char* Ks, const bf16x8* qr, const LAS char* qx, int r32, int hi) {
  p0 = f32x16{}; p1 = f32x16{};
#pragma unroll
  for (int d0 = 0; d0 < DQK / 16; ++d0) { const int cb = (d0 * 16 + hi * 8) * 2;
    bf16x8 b0 = *(const LAS bf16x8*)(Ks + kswz<DQK>(r32, cb));
    bf16x8 b1 = *(const LAS bf16x8*)(Ks + kswz<DQK>(32 + r32, cb));
    bf16x8 q; if (d0 < 8) q = qr[d0]; else q = *(const LAS bf16x8*)(qx + (d0 - 8) * 32);
    p0 = __builtin_amdgcn_mfma_f32_32x32x16_bf16(b0, q, p0, 0, 0, 0);
    p1 = __builtin_amdgcn_mfma_f32_32x32x16_bf16(b1, q, p1, 0, 0, 0);
    if ((d0 & 3) == 3 && d0 + 1 < DQK / 16) SBAR(); }
}
__device__ __forceinline__ int v_st(int k, int c) { const int kk = (k & ~0xC) | ((k & 4) << 1) | ((k & 8) >> 1); return ((kk >> 3) * 4 + (c >> 5)) * 512 + ((kk & 7) * 32 + (c & 31)) * 2; }
__device__ __forceinline__ int v_rd_base(int lane) { return ((lane & 3) << 3) | (((lane >> 2) & 3) << 6) | (((lane >> 4) & 1) << 5) | (((lane >> 5) & 1) << 8); }
constexpr int v_rd_off(int d0, int ks, int half) { return d0 * 512 + ks * 4096 + half * 2048; }
template <int OFF> __device__ __forceinline__ s16x4 tr_read(int vb) {
  s16x4 r; asm volatile("ds_read_b64_tr_b16 %0, %1 offset:%2" : "=&v"(r) : "v"(vb), "i"(OFF) : "memory"); return r;
}
template <int D0> __device__ __forceinline__ void pv_one(f32x16& od, int vb, bf16x8 pa0, bf16x8 pa1, bf16x8 pa2, bf16x8 pa3) {
  const s16x4 l0 = tr_read<v_rd_off(D0, 0, 0)>(vb), h0 = tr_read<v_rd_off(D0, 0, 1)>(vb), l1 = tr_read<v_rd_off(D0, 1, 0)>(vb), h1 = tr_read<v_rd_off(D0, 1, 1)>(vb);
  const s16x4 l2 = tr_read<v_rd_off(D0, 2, 0)>(vb), h2 = tr_read<v_rd_off(D0, 2, 1)>(vb), l3 = tr_read<v_rd_off(D0, 3, 0)>(vb), h3 = tr_read<v_rd_off(D0, 3, 1)>(vb);
  asm volatile("s_waitcnt lgkmcnt(0)" ::: "memory"); SBAR();
#define PK(L, H) (bf16x8){L[0], L[1], L[2], L[3], H[0], H[1], H[2], H[3]}
  od = __builtin_amdgcn_mfma_f32_32x32x16_bf16(pa0, PK(l0, h0), od, 0, 0, 0);
  od = __builtin_amdgcn_mfma_f32_32x32x16_bf16(pa1, PK(l1, h1), od, 0, 0, 0);
  od = __builtin_amdgcn_mfma_f32_32x32x16_bf16(pa2, PK(l2, h2), od, 0, 0, 0);
  od = __builtin_amdgcn_mfma_f32_32x32x16_bf16(pa3, PK(l3, h3), od, 0, 0, 0);
#undef PK
}
__device__ __forceinline__ void pv_d0(f32x16* o, int vb, bf16x8 pa0, bf16x8 pa1, bf16x8 pa2, bf16x8 pa3) {
  pv_one<0>(o[0], vb, pa0, pa1, pa2, pa3); pv_one<1>(o[1], vb, pa0, pa1, pa2, pa3); pv_one<2>(o[2], vb, pa0, pa1, pa2, pa3); pv_one<3>(o[3], vb, pa0, pa1, pa2, pa3);
}
__device__ __forceinline__ void apply_mask(f32x16& p0, f32x16& p1, int mtype, int krel0, int qi, int hi) {
  if (mtype == 0) return;
  const float ninf = -__builtin_inff();
#pragma unroll
  for (int r = 0; r < 16; ++r) { const int k0 = krel0 + crow(r, hi), k1 = k0 + 32;
    const bool ok0 = (mtype == 1) ? (k0 >= qi - 128) : (k0 <= qi + 128), ok1 = (mtype == 1) ? (k1 >= qi - 128) : (k1 <= qi + 128);
    p0[r] = ok0 ? p0[r] : ninf; p1[r] = ok1 ? p1[r] : ninf; }
}
struct Tile { gcbf kn; gcbf kr; gcbf v; int mtype; int krel0; };

__device__ __forceinline__ void rope_pair(bf16x8& a, bf16x8& b, gcfl ct, gcfl st) {
  const f32x4 c0 = *(const GAS f32x4*)ct, c1 = *(const GAS f32x4*)(ct + 4), s0 = *(const GAS f32x4*)st, s1 = *(const GAS f32x4*)(st + 4);
  const float cs[8] = {c0[0], c0[1], c0[2], c0[3], c1[0], c1[1], c1[2], c1[3]}, sn[8] = {s0[0], s0[1], s0[2], s0[3], s1[0], s1[1], s1[2], s1[3]};
  v4u ua = __builtin_bit_cast(v4u, a), ub = __builtin_bit_cast(v4u, b); v4u oa, ob;
#pragma unroll
  for (int w = 0; w < 4; ++w) { const float x1[2] = {bflo(ua[w]), bfhi(ua[w])}, x2[2] = {bflo(ub[w]), bfhi(ub[w])}; float y1[2], y2[2];
#pragma unroll
    for (int e = 0; e < 2; ++e) { const float c = cs[2 * w + e], sv = sn[2 * w + e]; y1[e] = x1[e] * c - x2[e] * sv; y2[e] = x2[e] * c + x1[e] * sv; }
    oa[w] = pk2(y1[0], y1[1]); ob[w] = pk2(y2[0], y2[1]); }
  a = __builtin_bit_cast(bf16x8, oa); b = __builtin_bit_cast(bf16x8, ob);
}

template <int DQK, int LDKN, int LDV, bool MASK, bool SINK, int SDEPTH, class TS>
__device__ __forceinline__ void attn_body(gcbf Qw, int rope, int prow, int pcol, gcfl rtab, int qi, float sink_l2, const TS& ts, int NT, gbfp Ow, LAS char* lds) {
  constexpr float SCALE = DQK == 128 ? 0.088388347648318440f : 0.072168783648703220f;
  constexpr float C = SCALE * 1.4426950408889634f;
  constexpr int SHM_K = KVBLK * (DQK * 2 + 16), SHM_V = KVBLK * 128 * 2;
  int tid = threadIdx.x; asm volatile("" : "+v"(tid));
  const int wid = tid >> 6, lane = tid & 63, r32 = lane & 31, hi = lane >> 5;
  LAS char* V_lds = lds; LAS char* K_lds = lds + 2 * SHM_V;
  LAS float* wsl = (LAS float*)(lds + 2 * SHM_V + 2 * SHM_K) + wid * 64; LAS float* li_l = wsl; LAS float* al_l = wsl + 32;
  float m_reg = -1e30f, l_reg = 0; f32x16 o[4] = {}; bf16x8 qr[8];
#pragma unroll
  for (int d0 = 0; d0 < 8; ++d0) qr[d0] = *(const GAS bf16x8*)(Qw + d0 * 16 + hi * 8);
  const LAS char* qx = lds + 2 * SHM_V + 2 * SHM_K + 2048 + wid * 4608 + r32 * 144 + hi * 16;
  if constexpr (DQK == 192) {
    bf16x8 x0 = *(const GAS bf16x8*)(Qw + 128 + hi * 8), x1 = *(const GAS bf16x8*)(Qw + 144 + hi * 8), x2 = *(const GAS bf16x8*)(Qw + 160 + hi * 8), x3 = *(const GAS bf16x8*)(Qw + 176 + hi * 8);
    if (rope) {
      rope_pair(x0, x1, rtab + (size_t)prow * 16 + hi * 8, rtab + 2048 + (size_t)prow * 16 + hi * 8);
      rope_pair(x2, x3, rtab + (size_t)pcol * 16 + hi * 8, rtab + 2048 + (size_t)pcol * 16 + hi * 8); }
    LAS char* qw_ = (LAS char*)qx; *(LAS bf16x8*)(qw_) = x0; *(LAS bf16x8*)(qw_ + 32) = x1; *(LAS bf16x8*)(qw_ + 64) = x2; *(LAS bf16x8*)(qw_ + 96) = x3;
  }
  const int sr = tid >> 4, sc = (tid & 15) * 8, vst0 = v_st(sr, sc), vst1 = v_st(32 + sr, sc);
  const int rr_ = tid >> 3, rc_ = (tid & 7) * 8;
  const int vb0 = (int)(uintptr_t)V_lds + v_rd_base(lane);
  struct { bf16x8 vs0, vs1, ks0, ks1, kx; } sr_[SDEPTH];
#define SLOAD(i, jt) do { const Tile t_ = ts(jt); sr_[i].vs0 = *(const GAS bf16x8*)(t_.v + (size_t)sr * LDV + sc); sr_[i].vs1 = *(const GAS bf16x8*)(t_.v + (size_t)(32 + sr) * LDV + sc); \
    sr_[i].ks0 = *(const GAS bf16x8*)(t_.kn + (size_t)sr * LDKN + sc); sr_[i].ks1 = *(const GAS bf16x8*)(t_.kn + (size_t)(32 + sr) * LDKN + sc); \
    if constexpr (DQK == 192) sr_[i].kx = *(const GAS bf16x8*)(t_.kr + (size_t)rr_ * 64 + rc_); } while (0)
#define SWRITE(b, i) do { *(LAS bf16x8*)(V_lds + (b) * SHM_V + vst0) = sr_[i].vs0; *(LAS bf16x8*)(V_lds + (b) * SHM_V + vst1) = sr_[i].vs1; const int kc = sc * 2; \
    *(LAS bf16x8*)(K_lds + (b) * SHM_K + kswz<DQK>(sr, kc)) = sr_[i].ks0; *(LAS bf16x8*)(K_lds + (b) * SHM_K + kswz<DQK>(32 + sr, kc)) = sr_[i].ks1; \
    if constexpr (DQK == 192) *(LAS bf16x8*)(K_lds + (b) * SHM_K + kswz<DQK>(rr_, 256 + rc_ * 2)) = sr_[i].kx; } while (0)
#define SWAIT() do { if constexpr (SDEPTH == 2) { if constexpr (DQK == 192) asm volatile("s_waitcnt vmcnt(5)" ::: "memory"); else asm volatile("s_waitcnt vmcnt(4)" ::: "memory"); } \
    else asm volatile("s_waitcnt vmcnt(0)" ::: "memory"); } while (0)
#define RESC(a) do { if (__any((a) < 1.f)) { if (hi == 0) al_l[r32] = (a); asm volatile("s_waitcnt lgkmcnt(0)" ::: "memory"); \
    _Pragma("unroll") for (int d = 0; d < 4; ++d) _Pragma("unroll") for (int r = 0; r < 16; ++r) o[d][r] *= al_l[crow(r, hi)]; } } while (0)
#define MASKT(pa_, pb_, jt) do { if constexpr (MASK) { const Tile t_ = ts(jt); apply_mask(pa_, pb_, t_.mtype, t_.krel0, qi, hi); } } while (0)
  f32x16 pA0, pA1, pB0, pB1; float mnA, mnB, alA, alB; bf16x8 pa0, pa1, pa2, pa3;
  constexpr int SE = 0, SO = SDEPTH - 1;
  SLOAD(SE, 0); asm volatile("s_waitcnt vmcnt(0)" ::: "memory"); SWRITE(0, SE); __syncthreads();
  qkt<DQK>(pA0, pA1, K_lds, qr, qx, r32, hi); MASKT(pA0, pA1, 0); partialSM<DQK>(pA0, pA1, m_reg, mnA, alA);
  SLOAD(SO, 1); if constexpr (SDEPTH == 2) { if (2 < NT) SLOAD(SE, 2); }
  SWAIT(); SWRITE(1, SO); __syncthreads();
  for (int j = 1; j + 1 < NT; j += 2) {
    SBAR(); qkt<DQK>(pB0, pB1, K_lds + SHM_K, qr, qx, r32, hi); MASKT(pB0, pB1, j);
    finishSM(pA0, pA1, alA, l_reg, pa0, pa1, pa2, pa3); SBAR();
    SLOAD(SO, j + SDEPTH); SBAR();
    pv_d0(o, vb0, pa0, pa1, pa2, pa3); partialSM<DQK>(pB0, pB1, m_reg, mnB, alB);
    __syncthreads(); SWAIT(); SWRITE(0, SE);
    RESC(alB); __syncthreads();
    SBAR(); qkt<DQK>(pA0, pA1, K_lds, qr, qx, r32, hi); MASKT(pA0, pA1, j + 1);
    finishSM(pB0, pB1, alB, l_reg, pa0, pa1, pa2, pa3); SBAR();
    if (SDEPTH == 1 || j + 3 < NT) SLOAD(SE, j + 1 + SDEPTH); SBAR();
    pv_d0(o, vb0 + SHM_V, pa0, pa1, pa2, pa3); partialSM<DQK>(pA0, pA1, m_reg, mnA, alA);
    __syncthreads(); SWAIT(); SWRITE(1, SO);
    RESC(alA); __syncthreads();
  }
  SBAR(); qkt<DQK>(pB0, pB1, K_lds + SHM_K, qr, qx, r32, hi); MASKT(pB0, pB1, NT - 1);
  finishSM(pA0, pA1, alA, l_reg, pa0, pa1, pa2, pa3); SBAR();
  pv_d0(o, vb0, pa0, pa1, pa2, pa3); partialSM<DQK>(pB0, pB1, m_reg, mnB, alB);
  __syncthreads(); RESC(alB);
  finishSM(pB0, pB1, alB, l_reg, pa0, pa1, pa2, pa3); SBAR();
  pv_d0(o, vb0 + SHM_V, pa0, pa1, pa2, pa3);
  if constexpr (SINK) l_reg += __builtin_amdgcn_exp2f(sink_l2 - m_reg * C);
  if (hi == 0) li_l[r32] = l_reg; asm volatile("s_waitcnt lgkmcnt(0)" ::: "memory");
  float rli[16];
#pragma unroll
  for (int r = 0; r < 16; ++r) rli[r] = __builtin_amdgcn_rcpf(li_l[crow(r, hi)]);
  __syncthreads();
  LAS bf16* ost = (LAS bf16*)(lds + wid * 8704);
#pragma unroll
  for (int r = 0; r < 16; ++r) { const int orow = crow(r, hi);
#pragma unroll
    for (int d0 = 0; d0 < 4; ++d0) ost[orow * 136 + d0 * 32 + r32] = (bf16)f2bf(o[d0][r] * rli[r]); }
  asm volatile("s_waitcnt lgkmcnt(0)" ::: "memory");
#pragma unroll
  for (int i = 0; i < 8; ++i) { const int orow = i * 4 + (lane >> 4), ch = lane & 15;
    *(GAS v4u*)(Ow + (size_t)orow * 4096 + ch * 8) = *(const LAS v4u*)(ost + orow * 136 + ch * 8); }
  __syncthreads();
#undef SLOAD
#undef SWRITE
#undef SWAIT
#undef RESC
#undef MASKT
}
}

struct Args { const float* in[38]; float* out; unsigned char* ws; };
template <class T> __device__ __forceinline__ T launder(T p) { asm volatile("" : "+s"(p)); return p; }
template <class T> __device__ __forceinline__ T* launder_g(T* p) { asm volatile("" : "+s"(p)); return p; }
struct Frame {
    LAS unsigned char* lds;
    gu32* ctl;
    int tid, lane, wave;
    int vcu, G, gw, NGW;
    const __attribute__((address_space(4))) Args* A;
    float* out;
    unsigned char* ws;
    unsigned char* wsw;
};
enum { I_X = 0, I_C, I_CTX, I_CCTX, I_WMOD, I_BMOD, I_WIN, I_WOUT, I_LN1G, I_LN1B, I_WFF1, I_WFF2, I_LN2G, I_LN2B, I_SINK, I_CONVW, I_CONVB, I_LWA, I_LBA, I_LWI, I_LBI, I_LAM,
       I_QNORM, I_KVNORM, I_WQB, I_WKVB, I_MUP, I_MUN, I_W0, I_W2, I_A0, I_A2, I_G2, I_KK, I_KA, I_RK, I_LNG, I_LNB };
__device__ __forceinline__ int row_s(int row) { return row < SEQ ? 0 : (row < M_LAT ? 1 : 2); }
__device__ __forceinline__ const float* mod_ptr(const Frame& F, int l, int s, int chunk) { return (const float*)(F.ws + WS_MOD) + ((size_t)(l * 3 + s) * 6 + chunk) * DM; }

__device__ __forceinline__ void transpose_item(const float* W, int N, int Kvalid, bf16* WT, int ldt, const float* kscale, LAS float* scr, int k0, int n0, int lane) {
#pragma unroll
    for (int i = 0; i < 32; ++i) { const int kk = 2 * i + (lane >> 5); const int k = k0 + kk; float v = 0.f;
        if (k < Kvalid) { v = W[(size_t)k * N + n0 + (lane & 31)]; if (kscale) v *= kscale[k]; }
        scr[kk * 33 + (lane & 31)] = v; }
    LDS_WAIT(); asm volatile("" ::: "memory");
    const int c = lane & 7;
#pragma unroll
    for (int j = 0; j < 4; ++j) { const int n = (lane >> 3) + 8 * j; const LAS float* s = scr + (8 * c) * 33 + n;
        v4u o; o.x = pk2(s[0 * 33], s[1 * 33]); o.y = pk2(s[2 * 33], s[3 * 33]); o.z = pk2(s[4 * 33], s[5 * 33]); o.w = pk2(s[6 * 33], s[7 * 33]);
        *(v4u*)(WT + (size_t)(n0 + n) * ldt + k0 + 8 * c) = o; }
    LDS_WAIT(); asm volatile("" ::: "memory");
}
__device__ __forceinline__ void convert_weights(Frame& F, int l, int widx, int nw) {
    LAS float* scr = (LAS float*)(F.lds + F.wave * 16384);
    constexpr int I1 = 64 * 271, I2 = 64 * 128, I3 = 64 * 512, I4 = 256 * 128, I5 = 16 * 48, I6 = 8 * 64, I7 = 32 * 8, I8 = 2 * 32, I9 = 2 * 32, I10 = 3 * 32;
    constexpr int NIT = I1 + I2 + I3 + I4 + I5 + I6 + I7 + I8 + I9 + I10;
    unsigned char* ws = F.ws + (l ? WSET_STRIDE : 0);
    for (int it = widx; it < NIT; it += nw) {
        int r = it;
        if (r < I1) { transpose_item(F.A->in[I_WIN] + (size_t)l * DM * DIN, DIN, DM, (bf16*)(ws + WS_WIN), DM, nullptr, scr, 64 * (r / 271), 32 * (r % 271), F.lane); continue; } r -= I1;
        if (r < I2) { transpose_item(F.A->in[I_WOUT] + (size_t)l * DM * DM, DM, DM, (bf16*)(ws + WS_WOUT), DM, nullptr, scr, 64 * (r / 128), 32 * (r % 128), F.lane); continue; } r -= I2;
        if (r < I3) { transpose_item(F.A->in[I_WFF1] + (size_t)l * DM * DFF, DFF, DM, (bf16*)(ws + WS_WFF1), DM, nullptr, scr, 64 * (r / 512), 32 * (r % 512), F.lane); continue; } r -= I3;
        if (r < I4) { transpose_item(F.A->in[I_WFF2] + (size_t)l * DFF * DM, DM, DFF, (bf16*)(ws + WS_WFF2), DFF, nullptr, scr, 64 * (r / 128), 32 * (r % 128), F.lane); continue; } r -= I4;
        if (r < I5) { transpose_item(F.A->in[I_WQB] + (size_t)l * 1024 * 1536, 1536, 1024, (bf16*)(ws + WS_WQB), 1024, F.A->in[I_QNORM] + l * 1024, scr, 64 * (r / 48), 32 * (r % 48), F.lane); continue; } r -= I5;
        if (r < I6) { transpose_item(F.A->in[I_WKVB] + (size_t)l * 512 * 2048, 2048, 512, (bf16*)(ws + WS_WKVB), 512, F.A->in[I_KVNORM] + l * 512, scr, 64 * (r / 64), 32 * (r % 64), F.lane); continue; } r -= I6;
        if (r < I7) { const int mat = r >> 3, sub = r & 7, gate = mat & 1, dn = mat >> 1;
            const int d = dn >> 3, n = dn & 7;
            const float* src = (gate ? F.A->in[I_LWI] : F.A->in[I_LWA]) + ((size_t)(l * 2 + d) * 8 + n) * 128 * 128;
            bf16* dst = (bf16*)(ws + WS_WLRU) + ((size_t)(d * 2 + gate) * 8 + n) * 128 * 128;
            transpose_item(src, 128, 128, dst, 128, nullptr, scr, 64 * (sub >> 2), 32 * (sub & 3), F.lane); continue; } r -= I7;
        if (r < I8) { const int d = r >> 5; transpose_item(F.A->in[I_W2] + (size_t)(l * 2 + d) * 64 * 1024, 1024, 64, (bf16*)(ws + WS_W2T) + (size_t)d * 1024 * 64, 64, nullptr, scr, 0, 32 * (r & 31), F.lane); continue; } r -= I8;
        if (r < I9) { const int d = r >> 5; transpose_item(F.A->in[I_A2] + (size_t)(l * 2 + d) * 64 * 1024, 1024, 64, (bf16*)(ws + WS_A2T) + (size_t)d * 1024 * 64, 64, nullptr, scr, 0, 32 * (r & 31), F.lane); continue; } r -= I9;
        transpose_item(F.A->in[I_G2] + (size_t)l * 160 * 1024, 1024, 160, (bf16*)(ws + WS_G2T), 192, nullptr, scr, 64 * (r / 32), 32 * (r % 32), F.lane);
    }
    { unsigned zz = 0u; asm volatile("" : "+v"(zz)); v4u z = {zz, zz, zz, zz}; v4u* p = (v4u*)((bf16*)(ws + WS_WIN) + (size_t)DIN * DM);
      for (int i = widx * 64 + F.lane; i < 32 * DM / 8; i += nw * 64) p[i] = z; }
}

__device__ __forceinline__ void mod_partials(Frame& F) {
    LAS float* sl = (LAS float*)F.lds;
    for (int it = F.vcu; it < 2 * 32 * 12; it += F.G) {
        const int l = it / 384, ks = (it / 12) % 32, cc = it % 12;
        __syncthreads();
        if (F.tid < 384) { const int s = F.tid >> 7, k = ks * 128 + (F.tid & 127); const float c = s < 2 ? F.A->in[I_C][s * DM + k] : F.A->in[I_CCTX][k]; sl[F.tid] = c / (1.f + __expf(-c)); }
        __syncthreads();
        const float* wp = F.A->in[I_WMOD] + ((size_t)l * DM + ks * 128) * 24576 + cc * 2048 + F.tid * 4;
        f32x4 a0 = {0.f, 0.f, 0.f, 0.f}, a1 = a0, a2 = a0;
#pragma unroll 8
        for (int k = 0; k < 128; ++k) { const f32x4 w = *(const f32x4*)(wp + (size_t)k * 24576); a0 += w * sl[k]; a1 += w * sl[128 + k]; a2 += w * sl[256 + k]; }
        float* op = (float*)(F.ws + WS_MODP) + ((size_t)(l * 32 + ks) * 3) * 24576 + cc * 2048 + F.tid * 4;
        *(f32x4*)(op) = a0; *(f32x4*)(op + 24576) = a1; *(f32x4*)(op + 2 * 24576) = a2;
    }
    __syncthreads();
}
__device__ __forceinline__ void mod_reduce(Frame& F) {
    for (int i = F.vcu * NTHR + F.tid; i < 2 * 3 * 24576; i += F.G * NTHR) {
        const int l = i / (3 * 24576), s = (i / 24576) % 3, n = i % 24576;
        float a = F.A->in[I_BMOD][l * 24576 + n];
        const float* pp = (const float*)(F.ws + WS_MODP) + ((size_t)(l * 32) * 3 + s) * 24576 + n;
#pragma unroll 8
        for (int ks = 0; ks < 32; ++ks) a += pp[(size_t)ks * 3 * 24576];
        ((float*)(F.ws + WS_MOD))[i] = a;
    }
}

template <int MODE>
__device__ __forceinline__ void ln_row(const Frame& F, const float* xsrc, const float* Y, const float* ga, const float* lg, const float* lb, float* xdst,
                                       bool domod, const float* sc, const float* sh, bf16* hrow) {
    f32x4 v[16]; float s = 0.f;
#pragma unroll
    for (int j = 0; j < 16; ++j) { const int c = 4 * F.lane + 256 * j; v[j] = *(const f32x4*)(xsrc + c);
        if (MODE == 1) { const f32x4 y = *(const f32x4*)(Y + c), g = *(const f32x4*)(ga + c); v[j] = v[j] * ALPHA + g * y; }
        s += (v[j].x + v[j].y) + (v[j].z + v[j].w); }
    float mean = wave_sum(s) * (1.f / DM), s2 = 0.f;
#pragma unroll
    for (int j = 0; j < 16; ++j) { v[j] = v[j] - mean; s2 += (v[j].x * v[j].x + v[j].y * v[j].y) + (v[j].z * v[j].z + v[j].w * v[j].w); }
    float rstd = 1.f / sqrtf(wave_sum(s2) * (1.f / DM) + LN_EPS);
    if (MODE == 1) {
        s = 0.f;
#pragma unroll
        for (int j = 0; j < 16; ++j) { const int c = 4 * F.lane + 256 * j; const f32x4 g = *(const f32x4*)(lg + c), b = *(const f32x4*)(lb + c); v[j] = v[j] * rstd * g + b;
            *(f32x4*)(xdst + c) = v[j]; s += (v[j].x + v[j].y) + (v[j].z + v[j].w); }
        if (!domod) return;
        mean = wave_sum(s) * (1.f / DM); s2 = 0.f;
#pragma unroll
        for (int j = 0; j < 16; ++j) { v[j] = v[j] - mean; s2 += (v[j].x * v[j].x + v[j].y * v[j].y) + (v[j].z * v[j].z + v[j].w * v[j].w); }
        rstd = 1.f / sqrtf(wave_sum(s2) * (1.f / DM) + LN_EPS);
    }
#pragma unroll
    for (int j = 0; j < 16; ++j) { const int c = 4 * F.lane + 256 * j; const f32x4 a = *(const f32x4*)(sc + c), b = *(const f32x4*)(sh + c);
        const f32x4 o = v[j] * rstd * (a + 1.f) + b; v2u w; w.x = pk2(o.x, o.y); w.y = pk2(o.z, o.w); *(v2u*)(hrow + c) = w; }
}

__device__ __forceinline__ void shift4(const bf16* P, unsigned eo, bool hp, bool hn, const float* mup, const float* mun, unsigned mo, float (&u)[4]) {
    const v2u xc = ldg<v2u>(P, eo * 2u); v2u xp = {0u, 0u}, xn = {0u, 0u};
    if (hp) xp = ldg<v2u>(P, (eo - DINP) * 2u); if (hn) xn = ldg<v2u>(P, (eo + DINP) * 2u);
    const f32x4 mp = ldg<f32x4>(mup, mo * 4u), mn = ldg<f32x4>(mun, mo * 4u);
    const float c[4] = {bflo(xc.x), bfhi(xc.x), bflo(xc.y), bfhi(xc.y)}, p[4] = {bflo(xp.x), bfhi(xp.x), bflo(xp.y), bfhi(xp.y)}, n[4] = {bflo(xn.x), bfhi(xn.x), bflo(xn.y), bfhi(xn.y)};
#pragma unroll
    for (int e = 0; e < 4; ++e) u[e] = c[e] + mp[e] * (p[e] - c[e]) + mn[e] * (n[e] - c[e]);
}
__device__ __forceinline__ void st4bf(void* base, unsigned eo, float a, float b, float c, float d) { v2u w; w.x = pk2(a, b); w.y = pk2(c, d); stg<v2u>(base, eo * 2u, w); }

__device__ __forceinline__ void rwkv_feat_item(Frame& F, int l, int item) {
    F.tid = ltid(); F.lane = F.tid & 63;
    int row0, seq_lo, seq_hi;
    if (item < 16) { const int b = item >> 3; seq_lo = M_LAT + b * NCTX; seq_hi = seq_lo + NCTX; row0 = seq_lo + (item & 7) * 32; }
    else { const int it = item - 16, b = it >> 8; seq_lo = b * SEQ; seq_hi = seq_lo + SEQ; row0 = seq_lo + (it & 255) * 32; }
    const bf16* P = (const bf16*)(F.ws + WS_P);
    LAS bf16* ACT = (LAS bf16*)F.lds;
    const float* mup = F.A->in[I_MUP] + l * RWC; const float* mun = F.A->in[I_MUN] + l * RWC;
    __syncthreads();
    { const int tok = F.tid >> 4, jc = F.tid & 15, row = row0 + tok; const bool hp = row > seq_lo, hn = row + 1 < seq_hi;
      const bf16* pr = P + (size_t)row * DINP + C_RWL;
      for (int i = 0; i < 13; ++i) { const int j = jc * 2 + 32 * i;
          const unsigned xc = *(const unsigned*)(pr + j), xp = hp ? *(const unsigned*)(pr - DINP + j) : 0u, xn = hn ? *(const unsigned*)(pr + DINP + j) : 0u;
          float u[2];
#pragma unroll
          for (int e = 0; e < 2; ++e) { const float c = e ? bfhi(xc) : bflo(xc), p = e ? bfhi(xp) : bflo(xp), n = e ? bfhi(xn) : bflo(xn);
              float v = c + mup[3072 + j + e] * (p - c) + mun[3072 + j + e] * (n - c);
              if (j < 128) v = tanhf_(v); else if (j >= 256) v = sigmoidf_(v);
              u[e] = v; }
          *(LAS unsigned*)(ACT + tok * 424 + j) = pk2(u[0], u[1]); } }
    __syncthreads();
    const int tok = F.lane & 31, hi = F.lane >> 5, row = row0 + tok; const bool hp = row > seq_lo, hn = row + 1 < seq_hi;
    const unsigned prow = (unsigned)row * DINP;
    const bf16* W2T = (const bf16*)(F.wsw + WS_W2T); const bf16* A2T = (const bf16*)(F.wsw + WS_A2T); const bf16* G2T = (const bf16*)(F.wsw + WS_G2T);
    bf16* RWF = (bf16*)(F.ws + WS_RWF); const size_t RS = (size_t)M_TOT * 1024;
    const float* kkv = F.A->in[I_KK] + l * 1024; const float* kav = F.A->in[I_KA] + l * 1024; const float* rkv = F.A->in[I_RK] + l * 1024;
    const float* w0f = F.A->in[I_W0] + (size_t)(l * 2) * 1024; const float* a0f = F.A->in[I_A0] + (size_t)(l * 2) * 1024;
    const LAS bf16* actl = ACT + tok * 424 + hi * 8;
#pragma unroll 1
    for (int hh = 0; hh < 2; ++hh) {
        const int h = 2 * F.wave + hh, cbase = h * 64;
        float ssq = 0.f;
#pragma unroll
        for (int bg = 0; bg < 8; ++bg) { const unsigned c4 = cbase + (bg >> 2) * 32 + 8 * (bg & 3) + 4 * hi; float uk[4];
            shift4(P, prow + C_RWK + c4, hp, hn, mup, mun, 1024 + c4, uk); const f32x4 k4 = ldg<f32x4>(kkv, c4 * 4u);
#pragma unroll
            for (int e = 0; e < 4; ++e) { const float q = uk[e] * k4[e]; ssq += q * q; } }
        ssq = half_swap_sum(ssq);
        const float rn = 1.f / fmaxf(sqrtf(ssq), 1e-12f);
        float sb = 0.f;
#pragma unroll 1
        for (int blk = 0; blk < 2; ++blk) {
            const unsigned cblk = cbase + blk * 32, cha = cblk + tok;
            const unsigned ob = (unsigned)row * 1024 + cblk + 4 * hi;
#pragma unroll 1
            for (int d = 0; d < 2; ++d) { f32x16 aw = {};
#pragma unroll
                for (int ks = 0; ks < 4; ++ks) { const bf16x8 bw = *(const LAS bf16x8*)(actl + d * 64 + ks * 16); const bf16x8 w_ = ldg<bf16x8>(W2T, ((d * 1024 + cha) * 64 + ks * 16 + hi * 8) * 2u);
                    aw = __builtin_amdgcn_mfma_f32_32x32x16_bf16(w_, bw, aw, 0, 0, 0); }
#pragma unroll
                for (int g = 0; g < 4; ++g) { const f32x4 w0 = ldg<f32x4>(w0f, (d * 1024 + cblk + 8 * g + 4 * hi) * 4u); float e4[4];
#pragma unroll
                    for (int e = 0; e < 4; ++e) e4[e] = __expf(-softplusf_(-(w0[e] + aw[4 * g + e])) - 0.5f);
                    st4bf(RWF + (4 + d) * RS, ob + 8 * g, e4[0], e4[1], e4[2], e4[3]); } }
            { f32x16 ag = {};
#pragma unroll
              for (int ks = 0; ks < 10; ++ks) { const bf16x8 bg_ = *(const LAS bf16x8*)(actl + 256 + ks * 16); const bf16x8 g_ = ldg<bf16x8>(G2T, (cha * 192 + ks * 16 + hi * 8) * 2u);
                  ag = __builtin_amdgcn_mfma_f32_32x32x16_bf16(g_, bg_, ag, 0, 0, 0); }
#pragma unroll
              for (int g = 0; g < 4; ++g) st4bf(RWF + 8 * RS, ob + 8 * g, ag[4 * g], ag[4 * g + 1], ag[4 * g + 2], ag[4 * g + 3]); }
            { f32x16 aaf = {}, aab = {};
#pragma unroll
              for (int ks = 0; ks < 4; ++ks) { const bf16x8 baf = *(const LAS bf16x8*)(actl + 128 + ks * 16), bab = *(const LAS bf16x8*)(actl + 192 + ks * 16);
                  const bf16x8 a_f = ldg<bf16x8>(A2T, (cha * 64 + ks * 16 + hi * 8) * 2u), a_b = ldg<bf16x8>(A2T, ((1024 + cha) * 64 + ks * 16 + hi * 8) * 2u);
                  aaf = __builtin_amdgcn_mfma_f32_32x32x16_bf16(a_f, baf, aaf, 0, 0, 0); aab = __builtin_amdgcn_mfma_f32_32x32x16_bf16(a_b, bab, aab, 0, 0, 0); }
#pragma unroll
              for (int g = 0; g < 4; ++g) { const unsigned c4 = cblk + 8 * g + 4 * hi; float ur[4], uk[4], uv[4];
                  shift4(P, prow + C_RWR + c4, hp, hn, mup, mun, c4, ur);
                  shift4(P, prow + C_RWK + c4, hp, hn, mup, mun, 1024 + c4, uk);
                  shift4(P, prow + C_RWV + c4, hp, hn, mup, mun, 2048 + c4, uv);
                  const f32x4 a0a = ldg<f32x4>(a0f, c4 * 4u), a0b = ldg<f32x4>(a0f, (1024 + c4) * 4u), kk4 = ldg<f32x4>(kkv, c4 * 4u), ka4 = ldg<f32x4>(kav, c4 * 4u), rk4 = ldg<f32x4>(rkv, c4 * 4u);
                  float af[4], ab[4], kk[4];
#pragma unroll
                  for (int e = 0; e < 4; ++e) { const int r = 4 * g + e;
                      af[e] = sigmoidf_(a0a[e] + aaf[r]); ab[e] = sigmoidf_(a0b[e] + aab[r]); kk[e] = uk[e] * kk4[e] * rn;
                      const float kdf = uk[e] * (1.f + (af[e] - 1.f) * ka4[e]), kdb = uk[e] * (1.f + (ab[e] - 1.f) * ka4[e]);
                      sb += ur[e] * rk4[e] * (kdf + kdb); }
                  const unsigned o = ob + 8 * g;
                  st4bf(RWF + 0 * RS, o, ur[0], ur[1], ur[2], ur[3]); st4bf(RWF + 1 * RS, o, uk[0], uk[1], uk[2], uk[3]); st4bf(RWF + 2 * RS, o, uv[0], uv[1], uv[2], uv[3]);
                  st4bf(RWF + 3 * RS, o, kk[0], kk[1], kk[2], kk[3]); st4bf(RWF + 6 * RS, o, af[0], af[1], af[2], af[3]); st4bf(RWF + 7 * RS, o, ab[0], ab[1], ab[2], ab[3]);
                  asm volatile("" ::: "memory"); } }
        }
        sb = half_swap_sum(sb);
        if (hi == 0) ((float*)(F.ws + WS_SB))[(size_t)row * 16 + h] = sb;
    }
}

__device__ __forceinline__ float gelu_tanh(float x) { return 0.5f * x * (1.f + tanhf(0.7978845608028654f * (x + 0.044715f * x * x * x))); }
template <bool PASS3>
__device__ __forceinline__ void lru_item(Frame& F, int l, int item) {
    F.tid = ltid(); F.lane = F.tid & 63;
    const int sc = item >> 3, nb = item & 7, b = sc / NCH, ch = sc % NCH;
    int row0, seq_lo, seq_hi;
    if (ch < 8) { seq_lo = M_LAT + b * NCTX; seq_hi = seq_lo + NCTX; row0 = seq_lo + ch * 32; }
    else { seq_lo = b * SEQ; seq_hi = seq_lo + SEQ; row0 = seq_lo + (ch - 8) * 32; }
    const bf16* P = (const bf16*)(F.ws + WS_P);
    LAS float* U = (LAS float*)F.lds;
    LAS bf16* UA = (LAS bf16*)(F.lds + 16384);
    LAS float* AB = (LAS float*)(F.lds + 32768);
    __syncthreads();
    { const int tok = F.tid >> 4, c8 = (F.tid & 15) * 8, cg = nb * 128 + c8; float acc[8];
      const float* cb = F.A->in[I_CONVB] + l * 1024 + cg;
#pragma unroll
      for (int e = 0; e < 8; ++e) acc[e] = cb[e];
#pragma unroll
      for (int j = 0; j < 4; ++j) { const int r = row0 + tok - 2 + j;
          if (r >= seq_lo && r < seq_hi) { const v4u x = *(const v4u*)(P + (size_t)r * DINP + C_LRUX + cg); const float* cw = F.A->in[I_CONVW] + (size_t)(l * 4 + j) * 1024 + cg;
#pragma unroll
              for (int w = 0; w < 4; ++w) { acc[2 * w] += cw[2 * w] * bflo(x[w]); acc[2 * w + 1] += cw[2 * w + 1] * bfhi(x[w]); } } }
      *(LAS f32x4*)(U + tok * 128 + c8) = (f32x4){acc[0], acc[1], acc[2], acc[3]}; *(LAS f32x4*)(U + tok * 128 + c8 + 4) = (f32x4){acc[4], acc[5], acc[6], acc[7]};
      v4u o; o.x = pk2(acc[0], acc[1]); o.y = pk2(acc[2], acc[3]); o.z = pk2(acc[4], acc[5]); o.w = pk2(acc[6], acc[7]);
      *(LAS v4u*)(UA + tok * 136 + c8) = o; }
    __syncthreads();
    { const int dir = F.wave >> 2, cq = F.wave & 3, l32 = F.lane & 31, hi = F.lane >> 5, chn = cq * 32 + l32, cg = nb * 128 + chn;
      const bf16* Wr = (const bf16*)(F.wsw + WS_WLRU) + ((size_t)(dir * 2 + 0) * 8 + nb) * 16384 + (size_t)chn * 128;
      const bf16* Wi = (const bf16*)(F.wsw + WS_WLRU) + ((size_t)(dir * 2 + 1) * 8 + nb) * 16384 + (size_t)chn * 128;
      f32x16 accr = {}, acci = {};
#pragma unroll
      for (int ks = 0; ks < 8; ++ks) { const int ko = ks * 16 + hi * 8;
          const bf16x8 a = *(const LAS bf16x8*)(UA + l32 * 136 + ko); const bf16x8 br = *(const bf16x8*)(Wr + ko), bi = *(const bf16x8*)(Wi + ko);
          accr = __builtin_amdgcn_mfma_f32_32x32x16_bf16(a, br, accr, 0, 0, 0); acci = __builtin_amdgcn_mfma_f32_32x32x16_bf16(a, bi, acci, 0, 0, 0); }
      const float ba = F.A->in[I_LBA][(l * 2 + dir) * 1024 + cg], bi_ = F.A->in[I_LBI][(l * 2 + dir) * 1024 + cg], sp = softplusf_(-F.A->in[I_LAM][(l * 2 + dir) * 1024 + cg]);
#pragma unroll
      for (int r = 0; r < 16; ++r) { const int tok = att::crow(r, hi); const float u = U[tok * 128 + chn];
          const float rg = sigmoidf_(accr[r] + ba), ig = sigmoidf_(acci[r] + bi_), la = -8.f * rg * sp, a = __expf(la), bc = sqrtf(-expm1f(2.f * la)) * (ig * u);
          AB[(dir * 2 + 0) * 4096 + tok * 128 + chn] = a; AB[(dir * 2 + 1) * 4096 + tok * 128 + chn] = bc; } }
    __syncthreads();
    if (F.tid < 256) { const int dir = F.tid >> 7, chn = F.tid & 127, cg = nb * 128 + chn; const size_t ci = ((size_t)(dir * 2 + b) * NCH + ch) * 1024 + cg;
        LAS float* Aa = AB + (dir * 2) * 4096 + chn; LAS float* Bb = AB + (dir * 2 + 1) * 4096 + chn;
        if (!PASS3) { float h = 0.f, ap = 1.f;
#pragma unroll 8
            for (int s = 0; s < 32; ++s) { const int tok = dir ? 31 - s : s; const float a = Aa[tok * 128]; h = a * h + Bb[tok * 128]; ap *= a;
                if (s == 0 && dir == 1 && ch == 7) ((float*)(F.ws + WS_QUIRK))[b * 1024 + cg] = h; }
            ((float*)(F.ws + WS_CA))[ci] = ap; ((float*)(F.ws + WS_CB))[ci] = h;
        } else { float h = ((const float*)(F.ws + WS_HIN))[ci];
#pragma unroll 8
            for (int s = 0; s < 32; ++s) { const int tok = dir ? 31 - s : s; h = Aa[tok * 128] * h + Bb[tok * 128]; Bb[tok * 128] = h; } } }
    if (PASS3) { __syncthreads();
        const int tok = F.tid >> 4, c8 = (F.tid & 15) * 8, cg = nb * 128 + c8, row = row0 + tok;
        const v4u y = *(const v4u*)(P + (size_t)row * DINP + C_LRUY + cg); float o[8];
#pragma unroll
        for (int w = 0; w < 4; ++w) { const float h0 = AB[4096 + tok * 128 + c8 + 2 * w] + AB[3 * 4096 + tok * 128 + c8 + 2 * w], h1 = AB[4096 + tok * 128 + c8 + 2 * w + 1] + AB[3 * 4096 + tok * 128 + c8 + 2 * w + 1];
            o[2 * w] = h0 * gelu_tanh(bflo(y[w])); o[2 * w + 1] = h1 * gelu_tanh(bfhi(y[w])); }
        v4u ov; ov.x = pk2(o[0], o[1]); ov.y = pk2(o[2], o[3]); ov.z = pk2(o[4], o[5]); ov.w = pk2(o[6], o[7]);
        *(v4u*)((bf16*)(F.ws + WS_MIX) + (size_t)row * DM + 1024 + cg) = ov; }
}
__device__ __forceinline__ void lru_carry(Frame& F) {
    F.tid = ltid(); F.lane = F.tid & 63;
    const int gid = F.vcu * NTHR + F.tid; if (gid >= 4096) return;
    const int dir = gid >> 11, b = (gid >> 10) & 1, cg = gid & 1023;
    const float* CA = (const float*)(F.ws + WS_CA) + ((size_t)(dir * 2 + b) * NCH) * 1024 + cg; const float* CB = (const float*)(F.ws + WS_CB) + ((size_t)(dir * 2 + b) * NCH) * 1024 + cg;
    float* HIN = (float*)(F.ws + WS_HIN) + ((size_t)(dir * 2 + b) * NCH) * 1024 + cg;
    float h = 0.f;
    if (dir == 0) {
#pragma unroll 8
        for (int c = 0; c < NCH; ++c) { HIN[(size_t)c * 1024] = h; h = CA[(size_t)c * 1024] * h + CB[(size_t)c * 1024]; }
    } else {
        for (int c = 7; c >= 0; --c) { HIN[(size_t)c * 1024] = h; h = CA[(size_t)c * 1024] * h + CB[(size_t)c * 1024]; }
        h = ((const float*)(F.ws + WS_QUIRK))[b * 1024 + cg];
#pragma unroll 8
        for (int c = NCH - 1; c >= 8; --c) { HIN[(size_t)c * 1024] = h; h = CA[(size_t)c * 1024] * h + CB[(size_t)c * 1024]; }
    }
}

__device__ __forceinline__ void rope_table(Frame& F) {
    const int i = F.vcu * NTHR + F.tid; if (i >= 2048) return;
    const int pos = i >> 4, f = i & 15; float s, c; sincosf((float)pos * exp2f(-(float)f * (13.287712379549449f / 16.f)), &s, &c);
    float* t = (float*)(F.ws + WS_ROPE); t[i] = c; t[2048 + i] = s;
}
__device__ __forceinline__ void row_prep(Frame& F, int row) {
    F.tid = ltid(); F.lane = F.tid & 63;
    bf16* pr = (bf16*)(F.ws + WS_P) + (size_t)row * DINP; const int lane = F.lane;
    const bool lat = row < M_LAT; const int t = row & (SEQ - 1); const float prow = (float)(t >> 6), pcol = (float)(t & 63);
    { const v4u a = *(const v4u*)(pr + C_QA + lane * 16), b = *(const v4u*)(pr + C_QA + lane * 16 + 8); float ss = 0.f;
#pragma unroll
      for (int w = 0; w < 4; ++w) { const float x0 = bflo(a[w]), x1 = bfhi(a[w]), x2 = bflo(b[w]), x3 = bfhi(b[w]); ss += x0 * x0 + x1 * x1 + x2 * x2 + x3 * x3; }
      ss = wave_sum(ss); if (lane == 0) ((float*)(F.ws + WS_RSQ))[row] = 1.f / sqrtf(ss * (1.f / 1024.f) + RMS_EPS); }
    { const v4u a = *(const v4u*)(pr + C_KVA + lane * 8); float ss = 0.f;
#pragma unroll
      for (int w = 0; w < 4; ++w) { const float x0 = bflo(a[w]), x1 = bfhi(a[w]); ss += x0 * x0 + x1 * x1; }
      ss = wave_sum(ss); if (lane == 0) ((float*)(F.ws + WS_RSKV))[row] = 1.f / sqrtf(ss * (1.f / 512.f) + RMS_EPS); }
    bf16* kr = (bf16*)(F.ws + WS_KR) + (size_t)row * 64;
    if (lat) {
        { const int part = lane >> 5, sub = lane & 31;
          const float inv = exp2f(-(float)sub * (13.287712379549449f / 32.f)); float sn, cs; sincosf((part ? pcol : prow) * inv, &sn, &cs);
#pragma unroll
          for (int hd = 0; hd < 10; ++hd) { bf16* qb = pr + (hd < 8 ? C_SWAQ + hd * 128 : C_SWAK + (hd - 8) * 128) + part * 64;
              const float x1 = bf2f(qb[sub]), x2 = bf2f(qb[sub + 32]); qb[sub] = (bf16)f2bf(x1 * cs - x2 * sn); qb[sub + 32] = (bf16)f2bf(x2 * cs + x1 * sn); } }
        if (lane < 32) { const int part = lane >> 4, i = lane & 15; const bf16* src = pr + C_KR + part * 32;
          const float inv = exp2f(-(float)i * (13.287712379549449f / 16.f)); float s, c; sincosf((part ? pcol : prow) * inv, &s, &c);
          const float x1 = bf2f(src[i]), x2 = bf2f(src[i + 16]);
          kr[part * 32 + i] = (bf16)f2bf(x1 * c - x2 * s); kr[part * 32 + i + 16] = (bf16)f2bf(x2 * c + x1 * s); }
    } else kr[lane] = pr[C_KR + lane];
}

__device__ __forceinline__ float allred16(float x) { return row_sum16(x); }
__device__ __forceinline__ int scan_row(int s, int dir, int b) {
    if (s < NCTX) return M_LAT + b * NCTX + (dir ? NCTX - 1 - s : s);
    const int t = s - NCTX; return b * SEQ + (dir ? SEQ - 1 - t : t);
}
__device__ __forceinline__ void rwkv_scan(Frame& F, int l, int chain) {
    F.tid = ltid(); F.lane = F.tid & 63;
    const int dir = chain >> 5, b = (chain >> 4) & 1, h = chain & 15;
    constexpr int CT = 16, NCHK = (NCTX + SEQ) / CT, STEPF = 392, BUFF = CT * STEPF;
    LAS float* buf = (LAS float*)F.lds; LAS float* ybuf = (LAS float*)(F.lds + 3 * BUFF * 4);
    gcbf RWF = (gcbf)(F.ws + WS_RWF); const size_t RS = (size_t)M_TOT * 1024;
    gflp YS = (gflp)(F.ws + WS_YS) + (size_t)dir * M_TOT * 1024;
    const bool ldr = F.tid < 256; const int lst = (F.tid >> 4) & 15, lq = F.tid & 15, lc = h * 64 + 4 * lq;
    const f32x4 ka4 = *(const GAS f32x4*)((gcfl)F.A->in[I_KA] + l * 1024 + lc);
    v2u gr = {0u, 0u}, gk = gr, gv = gr, gkk = gr, ge = gr, ga = gr;
#define RW_LOAD(c) do { if (ldr) { const size_t o_ = (size_t)scan_row((c) * CT + lst, dir, b) * 1024 + lc; gr = *(const GAS v2u*)(RWF + 0 * RS + o_); gk = *(const GAS v2u*)(RWF + 1 * RS + o_); gv = *(const GAS v2u*)(RWF + 2 * RS + o_); \
        gkk = *(const GAS v2u*)(RWF + 3 * RS + o_); ge = *(const GAS v2u*)(RWF + (4 + dir) * RS + o_); ga = *(const GAS v2u*)(RWF + (6 + dir) * RS + o_); } } while (0)
#define RW_WRITE(bi) do { if (ldr) { LAS float* d_ = buf + (bi) * BUFF + lst * STEPF + 4 * lq; \
        const float r_[4] = {bflo(gr.x), bfhi(gr.x), bflo(gr.y), bfhi(gr.y)}, k_[4] = {bflo(gk.x), bfhi(gk.x), bflo(gk.y), bfhi(gk.y)}, v_[4] = {bflo(gv.x), bfhi(gv.x), bflo(gv.y), bfhi(gv.y)}; \
        const float q_[4] = {bflo(gkk.x), bfhi(gkk.x), bflo(gkk.y), bfhi(gkk.y)}, e_[4] = {bflo(ge.x), bfhi(ge.x), bflo(ge.y), bfhi(ge.y)}, a_[4] = {bflo(ga.x), bfhi(ga.x), bflo(ga.y), bfhi(ga.y)}; \
        f32x4 w4, kd4, kk4, b4, wr4, v4; float sbr = 0.f, skr = 0.f; \
        _Pragma("unroll") for (int e = 0; e < 4; ++e) { w4[e] = __expf(-e_[e]); kd4[e] = k_[e] * (1.f + (a_[e] - 1.f) * ka4[e]); kk4[e] = q_[e]; b4[e] = q_[e] * a_[e]; wr4[e] = w4[e] * r_[e]; v4[e] = v_[e]; sbr += b4[e] * r_[e]; skr += kd4[e] * r_[e]; } \
        sbr = row_sum16(sbr); skr = row_sum16(skr); \
        *(LAS f32x4*)(d_) = w4; *(LAS f32x4*)(d_ + 64) = kd4; *(LAS f32x4*)(d_ + 128) = kk4; *(LAS f32x4*)(d_ + 192) = b4; *(LAS f32x4*)(d_ + 256) = wr4; *(LAS f32x4*)(d_ + 320) = v4; \
        if (lq == 0) *(LAS f32x2*)(buf + (bi) * BUFF + lst * STEPF + 384) = (f32x2){sbr, skr}; } } while (0)
#define RW_FLUSH(c) do { if (ldr) { const f32x4 y_ = *(const LAS f32x4*)(ybuf + ((c) & 1) * (CT * 64) + lst * 64 + 4 * lq); *(GAS f32x4*)(YS + (size_t)scan_row((c) * CT + lst, dir, b) * 1024 + lc) = y_; } } while (0)
    __syncthreads();
    RW_LOAD(0); RW_WRITE(0); RW_LOAD(1); RW_WRITE(1); RW_LOAD(2);
    __syncthreads();
    const int kg = F.lane & 15, rg = F.lane >> 4, r0 = 8 * F.wave + 2 * rg;
    f32x2 St[4] = {{0.f, 0.f}, {0.f, 0.f}, {0.f, 0.f}, {0.f, 0.f}};
    int bc = 0, bw = 2;
#pragma unroll 1
    for (int c = 0; c < NCHK; ++c) {
        if (c + 2 < NCHK) { RW_WRITE(bw); if (c + 3 < NCHK) RW_LOAD(c + 3); }
        if (c > 0) RW_FLUSH(c - 1);
        const LAS float* bb = buf + bc * BUFF + 4 * kg; const LAS float* vb = buf + bc * BUFF + 320 + r0; const LAS float* sb = buf + bc * BUFF + 384;
        LAS float* yb = ybuf + (c & 1) * (CT * 64) + r0;
        f32x4 w4 = *(const LAS f32x4*)(bb), kd4 = *(const LAS f32x4*)(bb + 64), kk4 = *(const LAS f32x4*)(bb + 128), b4 = *(const LAS f32x4*)(bb + 192), wr4 = *(const LAS f32x4*)(bb + 256);
        f32x2 v2 = *(const LAS f32x2*)(vb), s2 = *(const LAS f32x2*)(sb);
#pragma unroll 4
        for (int st = 0; st < CT; ++st) {
            const int sn = (st + 1 < CT ? st + 1 : st) * STEPF;
            const f32x4 nw4 = *(const LAS f32x4*)(bb + sn), nkd4 = *(const LAS f32x4*)(bb + sn + 64), nkk4 = *(const LAS f32x4*)(bb + sn + 128), nb4 = *(const LAS f32x4*)(bb + sn + 192), nwr4 = *(const LAS f32x4*)(bb + sn + 256);
            const f32x2 nv2 = *(const LAS f32x2*)(vb + sn), ns2 = *(const LAS f32x2*)(sb + sn);
            f32x2 p = St[0] * kk4[0], z = St[0] * wr4[0];
            p = St[1] * kk4[1] + p; z = St[1] * wr4[1] + z; p = St[2] * kk4[2] + p; z = St[2] * wr4[2] + z; p = St[3] * kk4[3] + p; z = St[3] * wr4[3] + z;
            float p0 = p.x, p1 = p.y, z0 = z.x, z1 = z.y;
            asm volatile("s_nop 1\n\t"
                "v_add_f32_dpp %0, %0, %0 row_ror:8 row_mask:0xf bank_mask:0xf\n\tv_add_f32_dpp %1, %1, %1 row_ror:8 row_mask:0xf bank_mask:0xf\n\tv_add_f32_dpp %2, %2, %2 row_ror:8 row_mask:0xf bank_mask:0xf\n\tv_add_f32_dpp %3, %3, %3 row_ror:8 row_mask:0xf bank_mask:0xf\n\t"
                "v_add_f32_dpp %0, %0, %0 row_ror:4 row_mask:0xf bank_mask:0xf\n\tv_add_f32_dpp %1, %1, %1 row_ror:4 row_mask:0xf bank_mask:0xf\n\tv_add_f32_dpp %2, %2, %2 row_ror:4 row_mask:0xf bank_mask:0xf\n\tv_add_f32_dpp %3, %3, %3 row_ror:4 row_mask:0xf bank_mask:0xf\n\t"
                "v_add_f32_dpp %0, %0, %0 row_ror:2 row_mask:0xf bank_mask:0xf\n\tv_add_f32_dpp %1, %1, %1 row_ror:2 row_mask:0xf bank_mask:0xf\n\tv_add_f32_dpp %2, %2, %2 row_ror:2 row_mask:0xf bank_mask:0xf\n\tv_add_f32_dpp %3, %3, %3 row_ror:2 row_mask:0xf bank_mask:0xf\n\t"
                "v_add_f32_dpp %0, %0, %0 row_ror:1 row_mask:0xf bank_mask:0xf\n\tv_add_f32_dpp %1, %1, %1 row_ror:1 row_mask:0xf bank_mask:0xf\n\tv_add_f32_dpp %2, %2, %2 row_ror:1 row_mask:0xf bank_mask:0xf\n\tv_add_f32_dpp %3, %3, %3 row_ror:1 row_mask:0xf bank_mask:0xf\n\t"
                "s_nop 1"
                : "+v"(p0), "+v"(p1), "+v"(z0), "+v"(z1));
            const f32x2 pp = {p0, p1}, zz = {z0, z1};
            *(LAS f32x2*)(yb + st * 64) = zz - pp * s2.x + v2 * s2.y;
#pragma unroll
            for (int i = 0; i < 4; ++i) { const f32x2 vk = v2 * kd4[i]; St[i] = (St[i] * w4[i] + vk) - pp * b4[i]; }
            w4 = nw4; kd4 = nkd4; kk4 = nkk4; b4 = nb4; wr4 = nwr4; v2 = nv2; s2 = ns2;
        }
        __syncthreads();
        bc = bc == 2 ? 0 : bc + 1; bw = bw == 2 ? 0 : bw + 1;
    }
    RW_FLUSH(NCHK - 1);
#undef RW_LOAD
#undef RW_WRITE
#undef RW_FLUSH
}
__device__ __forceinline__ void rwkv_out_row(Frame& F, int l, int row) {
    F.tid = ltid(); F.lane = F.tid & 63;
    const int c0 = F.lane * 16; const float* yf = (const float*)(F.ws + WS_YS) + (size_t)row * 1024 + c0; const float* yb = yf + (size_t)M_TOT * 1024;
    float y[16]; float s = 0.f;
#pragma unroll
    for (int j = 0; j < 4; ++j) { const f32x4 a = *(const f32x4*)(yf + 4 * j), b = *(const f32x4*)(yb + 4 * j);
#pragma unroll
        for (int e = 0; e < 4; ++e) { y[4 * j + e] = a[e] + b[e]; s += y[4 * j + e]; } }
    s = quad_sum(s); const float mu = s * (1.f / 64.f); float q = 0.f;
#pragma unroll
    for (int e = 0; e < 16; ++e) { y[e] -= mu; q += y[e] * y[e]; }
    q = quad_sum(q); const float rstd = 1.f / sqrtf(q * (1.f / 64.f) + GN_EPS);
    const bf16* RWF = (const bf16*)(F.ws + WS_RWF); const size_t RS = (size_t)M_TOT * 1024, o = (size_t)row * 1024 + c0;
    const float sbv = ((const float*)(F.ws + WS_SB))[(size_t)row * 16 + (F.lane >> 2)];
    const float* lg = F.A->in[I_LNG] + l * 1024 + c0; const float* lb = F.A->in[I_LNB] + l * 1024 + c0;
    bf16* dst = (bf16*)(F.ws + WS_MIX) + (size_t)row * DM + 3072 + c0;
#pragma unroll
    for (int hf = 0; hf < 2; ++hf) { const v4u vv = *(const v4u*)(RWF + 2 * RS + o + 8 * hf), gg = *(const v4u*)(RWF + 8 * RS + o + 8 * hf); float r[8];
#pragma unroll
        for (int w = 0; w < 4; ++w) { const int e = 8 * hf + 2 * w;
            r[2 * w] = (y[e] * rstd * lg[e] + lb[e] + sbv * bflo(vv[w])) * bflo(gg[w]); r[2 * w + 1] = (y[e + 1] * rstd * lg[e + 1] + lb[e + 1] + sbv * bfhi(vv[w])) * bfhi(gg[w]); }
        v4u ov; ov.x = pk2(r[0], r[1]); ov.y = pk2(r[2], r[3]); ov.z = pk2(r[4], r[5]); ov.w = pk2(r[6], r[7]); *(v4u*)(dst + 8 * hf) = ov; }
}

struct MlaTiles { gcbf KV; gcbf KR; int ctx_row0, lat_row0, h;
    __device__ __forceinline__ att::Tile operator()(int j) const { const int row = j < 4 ? ctx_row0 + 64 * j : lat_row0 + 64 * (j - 4);
        att::Tile t; t.kn = KV + (size_t)row * 2048 + h * 256; t.v = t.kn + 128; t.kr = KR + (size_t)row * 64; t.mtype = 0; t.krel0 = 0; return t; } };
struct SwaTiles { gcbf P; int blk_row0, ctx_row0, kvh, nwin, has_prev, has_next;
    __device__ __forceinline__ att::Tile operator()(int j) const { att::Tile t; int row; t.mtype = 0; t.krel0 = 0;
        if (j >= nwin) row = ctx_row0 + 64 * (j - nwin);
        else if (j < 2) row = blk_row0 + 64 * j;
        else if (has_prev && j < 4) { row = blk_row0 - 128 + 64 * (j - 2); t.mtype = 1; t.krel0 = -128 + 64 * (j - 2); }
        else { const int sub = j - 2 - 2 * has_prev; row = blk_row0 + 128 + 64 * sub; t.mtype = 2; t.krel0 = 128 + 64 * sub; }
        t.kn = P + (size_t)row * DINP + C_SWAK + kvh * 128; t.v = P + (size_t)row * DINP + C_SWAV + kvh * 128; t.kr = nullptr; return t; } };

#ifndef MLA_SDEPTH
#define MLA_SDEPTH 1
#endif
__device__ __forceinline__ void mla_item(Frame& F, int b, int h, int qb, bool ctxq) {
    F.tid = ltid(); F.lane = F.tid & 63;
    const int r32 = F.lane & 31; const int t = qb * 256 + F.wave * 32 + r32;
    const int roww0 = ctxq ? M_LAT + b * NCTX + F.wave * 32 : b * SEQ + qb * 256 + F.wave * 32;
    gcbf Qw = (gcbf)(F.ws + WS_Q) + (size_t)(roww0 + r32) * 1536 + h * 192;
    MlaTiles ts{(gcbf)(F.ws + WS_KV), (gcbf)(F.ws + WS_KR), M_LAT + b * NCTX, b * SEQ, h};
    gbfp Ow = (gbfp)(F.ws + WS_MIX) + (size_t)roww0 * DM + 2048 + h * 128;
    att::attn_body<192, 2048, 2048, false, false, MLA_SDEPTH>(Qw, ctxq ? 0 : 1, t >> 6, t & 63, (gcfl)(F.ws + WS_ROPE), 0, 0.f, ts, ctxq ? 4 : 132, Ow, (LAS char*)F.lds);
}
__device__ __forceinline__ void swa_item(Frame& F, int l, int b, int n, int kvh, int half, bool ctxq, int hq_ctx) {
    F.tid = ltid(); F.lane = F.tid & 63;
    const int r32 = F.lane & 31; gcbf P = (gcbf)(F.ws + WS_P);
    int hq, qi, roww0, t;
    if (ctxq) { hq = hq_ctx; kvh = hq >> 2; qi = 0; roww0 = M_LAT + b * NCTX + F.wave * 32; t = 0; }
    else { hq = kvh * 4 + 2 * half + (F.wave >> 2); qi = (F.wave & 3) * 32 + r32; roww0 = b * SEQ + n * 128 + (F.wave & 3) * 32; t = n * 128 + qi; }
    gcbf Qw = P + (size_t)(roww0 + r32) * DINP + C_SWAQ + hq * 128;
    SwaTiles ts; ts.P = P; ts.blk_row0 = b * SEQ + n * 128; ts.ctx_row0 = M_LAT + b * NCTX; ts.kvh = kvh;
    ts.has_prev = (!ctxq && n > 0) ? 1 : 0; ts.has_next = (!ctxq && n < SEQ / 128 - 1) ? 1 : 0; ts.nwin = ctxq ? 0 : 2 + 2 * ts.has_prev + 2 * ts.has_next;
    gbfp Ow = (gbfp)(F.ws + WS_MIX) + (size_t)roww0 * DM + hq * 128;
    const float sink_l2 = F.A->in[I_SINK][l * 8 + hq] * 1.4426950408889634f;
    att::attn_body<128, DINP, DINP, true, true, 2>(Qw, 0, 0, 0, (gcfl)nullptr, qi, sink_l2, ts, ts.nwin + 4, Ow, (LAS char*)F.lds);
}

#ifndef DBG_PHASES
#define DBG_PHASES 0xfffff
#endif
#define PH(n) ((DBG_PHASES >> (n)) & 1)
#ifndef DUP_PHASES
#define DUP_PHASES 0
#endif
#define REP(n) _Pragma("unroll") for (int rep_ = 0; rep_ < (((DUP_PHASES >> (n)) & 1) ? 2 : 1); ++rep_)
__global__ void __launch_bounds__(NTHR, 2) mk_fwd(Args args) {
    extern __shared__ __attribute__((aligned(16))) unsigned char lds[];
    Frame F;
    F.lds = (LAS unsigned char*)lds;
    F.tid = threadIdx.x; F.lane = F.tid & 63; F.wave = __builtin_amdgcn_readfirstlane(F.tid >> 6);
    F.G = gridDim.x; { const int bx = blockIdx.x; F.vcu = (F.G % 8 == 0) ? (bx % 8) * (F.G / 8) + bx / 8 : bx; }
    F.gw = F.vcu * NWAVES + F.wave; F.NGW = F.G * NWAVES;
    F.ws = args.ws; F.out = args.out; F.ctl = (gu32*)(args.ws + WS_CTL);
    F.A = (const __attribute__((address_space(4))) Args*)__builtin_amdgcn_kernarg_segment_ptr();
    for (int u = F.tid; u < (LDS_BYTES - LDSCTL_OFF) / 4; u += NTHR) ((LAS unsigned*)(F.lds + LDSCTL_OFF))[u] = 0u;
    __syncthreads();
    XcdBarrier bar = xcd_barrier_post((unsigned*)(args.ws + WS_CTL) + 4096, (volatile LAS unsigned*)(F.lds + MISC_OFF) + 8);
#define GRID_BAR() do { bar.bar = launder(bar.bar); bar.x = launder(bar.x); xcd_barrier(bar); F.ws = launder_g(F.ws); F.wsw = F.ws + (size_t)lcur * WSET_STRIDE; F.A = launder(F.A); F.tid = ltid(); F.lane = F.tid & 63; } while (0)
    const int bx = blockIdx.x; int lcur = 0; F.wsw = F.ws;
    bf16* H = (bf16*)(F.ws + WS_H); float* X = (float*)(F.ws + WS_X);

    REP(0) if (PH(0)) { mod_partials(F);
    convert_weights(F, 0, F.gw, F.NGW); }
    GRID_BAR();
    if (PH(1)) { mod_reduce(F); rope_table(F); }
    GRID_BAR();

#pragma unroll 1
    for (int l = 0; l < 2; ++l) {
        lcur = l; F.wsw = F.ws + (size_t)l * WSET_STRIDE;
        const bool wctx = (l == 0);
        const int MO = wctx ? M_TOT : M_LAT;
        if (PH(2) && l == 0) {
            for (int row = F.gw; row < M_TOT; row += F.NGW) { const int s = row_s(row);
                const float* xs = row < M_LAT ? F.A->in[I_X] + (size_t)row * DM : F.A->in[I_CTX] + (size_t)(row - M_LAT) * DM;
                ln_row<0>(F, xs, nullptr, nullptr, nullptr, nullptr, nullptr, true, mod_ptr(F, 0, s, 1), mod_ptr(F, 0, s, 0), H + (size_t)row * DM); }
        }
        GRID_BAR();
        REP(3) if (PH(3)) { pg8::Gemm g{H, (const bf16*)(F.wsw + WS_WIN), M_TOT, DINP, DM, DM}; pg8::StaticOrder S; S.init(M_TOT, DINP, F.G, bx);
          pg8::EpiBf16<0> E{(bf16*)(F.ws + WS_P), DINP, nullptr};
          pg8::gemm_phase<pg8::EpiBf16<0>, pg8::StaticOrder, true, true>(F.lds, g, S, E); }
        GRID_BAR();
        REP(4) if (PH(4)) for (int it = F.vcu; it < 528; it += F.G) rwkv_feat_item(F, l, it);
        REP(5) if (PH(5)) for (int it = F.vcu; it < 2 * NCH * 8; it += F.G) lru_item<false>(F, l, it);
        __syncthreads();
        if (PH(6)) for (int row = F.gw; row < M_TOT; row += F.NGW) row_prep(F, row);
        GRID_BAR();
        if (PH(7)) lru_carry(F);
        REP(7) if (PH(7)) { pg8::Gemm g{(const bf16*)(F.ws + WS_P) + C_QA, (const bf16*)(F.wsw + WS_WQB), M_TOT, 1536, 1024, DINP}; pg8::StaticOrder S; S.init(M_TOT, 1536, F.G, bx);
          pg8::EpiBf16<2> E{(bf16*)(F.ws + WS_Q), 1536, (const float*)(F.ws + WS_RSQ)};
          pg8::gemm_phase<pg8::EpiBf16<2>, pg8::StaticOrder, true, true>(F.lds, g, S, E); }
        REP(7) if (PH(7)) { pg8::Gemm g{(const bf16*)(F.ws + WS_P) + C_KVA, (const bf16*)(F.wsw + WS_WKVB), M_TOT, 2048, 512, DINP}; pg8::StaticOrder S; S.init(M_TOT, 2048, F.G, bx);
          pg8::EpiBf16<2> E{(bf16*)(F.ws + WS_KV), 2048, (const float*)(F.ws + WS_RSKV)};
          pg8::gemm_phase<pg8::EpiBf16<2>, pg8::StaticOrder, true, true>(F.lds, g, S, E); }
        GRID_BAR();
        REP(8) if ((bx & 3) == 0) { const int nrw = (F.G + 3) >> 2; REP(18) if (PH(8)) for (int chain = bx >> 2; chain < 64; chain += nrw) rwkv_scan(F, l, chain); }
        else REP(19) { const int aw = (bx >> 2) * 3 + (bx & 3) - 1, naw = F.G - ((F.G + 3) >> 2);
            if (PH(9)) for (int it = aw; it < 512; it += naw) mla_item(F, it >> 8, (it >> 5) & 7, it & 31, false);
            if (PH(9) && wctx) for (int it = aw; it < 16; it += naw) mla_item(F, it >> 3, it & 7, 0, true);
            if (PH(10)) for (int it = aw; it < 512; it += naw) swa_item(F, l, it >> 8, (it >> 2) & 63, (it >> 1) & 1, it & 1, false, 0);
            if (PH(10) && wctx) for (int it = aw; it < 16; it += naw) swa_item(F, l, it >> 3, 0, 0, 0, true, it & 7);
            if (PH(11)) for (int it = aw; it < 2 * NCH * 8; it += naw) { if (!wctx && ((it >> 3) % NCH) < 8) continue; lru_item<true>(F, l, it); }
            if (l == 0) { __syncthreads(); convert_weights(F, 1, aw * NWAVES + F.wave, naw * NWAVES); }
        }
        GRID_BAR();
        REP(12) if (PH(12)) for (int row = F.gw; row < MO; row += F.NGW) rwkv_out_row(F, l, row);
        GRID_BAR();
        REP(13) if (PH(13)) { pg8::Gemm g{(const bf16*)(F.ws + WS_MIX), (const bf16*)(F.wsw + WS_WOUT), MO, DM, DM, DM}; pg8::StaticOrder S; S.init(MO, DM, F.G, bx);
          pg8::EpiF32 E{(float*)(F.ws + WS_Y1), DM};
          pg8::gemm_phase<pg8::EpiF32, pg8::StaticOrder, true, true>(F.lds, g, S, E); }
        GRID_BAR();
        if (PH(14)) for (int row = F.gw; row < MO; row += F.NGW) { const int s = row_s(row);
            const float* xs = (l == 0) ? (row < M_LAT ? F.A->in[I_X] + (size_t)row * DM : F.A->in[I_CTX] + (size_t)(row - M_LAT) * DM) : X + (size_t)row * DM;
            ln_row<1>(F, xs, (const float*)(F.ws + WS_Y1) + (size_t)row * DM, mod_ptr(F, l, s, 2), F.A->in[I_LN1G] + l * DM, F.A->in[I_LN1B] + l * DM, X + (size_t)row * DM,
                      true, mod_ptr(F, l, s, 4), mod_ptr(F, l, s, 3), H + (size_t)row * DM); }
        GRID_BAR();
        REP(15) if (PH(15)) { pg8::Gemm g{H, (const bf16*)(F.wsw + WS_WFF1), MO, DFF, DM, DM}; pg8::StaticOrder S; S.init(MO, DFF, F.G, bx);
          pg8::EpiBf16<1> E{(bf16*)(F.ws + WS_HID), DFF, nullptr};
          pg8::gemm_phase<pg8::EpiBf16<1>, pg8::StaticOrder, true, true>(F.lds, g, S, E); }
        GRID_BAR();
        REP(16) if (PH(16)) { pg8::Gemm g{(const bf16*)(F.ws + WS_HID), (const bf16*)(F.wsw + WS_WFF2), MO, DM, DFF, DFF}; pg8::StaticOrder S; S.init(MO, DM, F.G, bx);
          pg8::EpiF32 E{(float*)(F.ws + WS_Y2), DM};
          pg8::gemm_phase<pg8::EpiF32, pg8::StaticOrder, true, true>(F.lds, g, S, E); }
        GRID_BAR();
        if (!PH(17)) {} else if (l == 0) {
            for (int row = F.gw; row < M_TOT; row += F.NGW) { const int s = row_s(row);
                ln_row<1>(F, X + (size_t)row * DM, (const float*)(F.ws + WS_Y2) + (size_t)row * DM, mod_ptr(F, 0, s, 5), F.A->in[I_LN2G], F.A->in[I_LN2B], X + (size_t)row * DM,
                          true, mod_ptr(F, 1, s, 1), mod_ptr(F, 1, s, 0), H + (size_t)row * DM); }
        } else {
            for (int row = F.gw; row < M_LAT; row += F.NGW) { const int s = row_s(row);
                ln_row<1>(F, X + (size_t)row * DM, (const float*)(F.ws + WS_Y2) + (size_t)row * DM, mod_ptr(F, 1, s, 5), F.A->in[I_LN2G] + DM, F.A->in[I_LN2B] + DM, F.out + (size_t)row * DM,
                          false, nullptr, nullptr, nullptr); }
        }
    }
}

extern "C" void kernel_launch(void* const* d_in, const int* in_sizes, int n_in, void* d_out, int out_size, void* d_ws, size_t ws_size, hipStream_t stream) {
    static int grid = 0;
    if (grid == 0) {
        if (n_in != 38 || out_size != M_LAT * DM || ws_size < WS_END) { fprintf(stderr, "kernel_launch: unexpected shapes: n_in %d out %d ws %zu (need %zu)\n", n_in, out_size, ws_size, (size_t)WS_END); grid = -1; return; }
        int dev = 0, cus = 0, per_cu = 0;
        if (hipGetDevice(&dev) != hipSuccess || hipDeviceGetAttribute(&cus, hipDeviceAttributeMultiprocessorCount, dev) != hipSuccess) { grid = -1; return; }
        if (hipFuncSetAttribute((const void*)mk_fwd, hipFuncAttributeMaxDynamicSharedMemorySize, LDS_BYTES) != hipSuccess) { fprintf(stderr, "kernel_launch: hipFuncSetAttribute failed\n"); grid = -1; return; }
        if (hipOccupancyMaxActiveBlocksPerMultiprocessor(&per_cu, (const void*)mk_fwd, NTHR, LDS_BYTES) != hipSuccess || per_cu < 1) fprintf(stderr, "kernel_launch: occupancy query says %d\n", per_cu);
        (void)hipGetLastError();
        grid = cus;
    }
    if (grid < 0) return;
    if (hipMemsetAsync((char*)d_ws + WS_CTL, 0, CTL_ZERO_BYTES, stream) != hipSuccess) return;
    Args a{};
    for (int i = 0; i < 38; ++i) a.in[i] = (const float*)d_in[i];
    a.out = (float*)d_out; a.ws = (unsigned char*)d_ws;
    hipLaunchKernelGGL(mk_fwd, dim3(grid), dim3(NTHR), LDS_BYTES, stream, a);
    const hipError_t le = hipPeekAtLastError();
    if (le != hipSuccess) fprintf(stderr, "kernel_launch: launch failed: %s\n", hipGetErrorName(le));
}
```

```cpp
#include <hip/hip_runtime.h>
#include <hip/hip_bf16.h>
#include <cstdio>
#include <cstdint>

namespace pg8 {
#define PG8_LAS __attribute__((address_space(3)))
typedef unsigned short bf16_t;
typedef short bf16x8 __attribute__((ext_vector_type(8)));
typedef float f32x4 __attribute__((ext_vector_type(4)));
typedef unsigned u32x4 __attribute__((ext_vector_type(4)));
constexpr int BM = 256, BK = 64, HALF = 128, HTB = HALF * BK * 2  , STAGE_BYTES = 8 * HTB, NXCD = 8, WGM = 8;

__host__ __device__ __forceinline__ int lds_byte(int r, int c) { const int st = (r >> 4) * 2 + (c >> 5), rr = r & 15, cc = c & 31, ob = rr * 64 + cc * 2; return st * 1024 + (ob ^ (((ob >> 9) & 1) << 5)); }
__host__ __device__ __forceinline__ void stage_rc(int b, int& R, int& C) { const int st = b / 1024, sb = b % 1024, swz = sb ^ (((sb >> 9) & 1) << 5); R = (st >> 1) * 16 + swz / 64; C = (st & 1) * 32 + (swz % 64) / 2; }
__host__ __device__ __forceinline__ int perm32(int rho) { const int n = rho >> 4, i = rho & 15; return 8 * (i >> 2) + 4 * n + (i & 3); }

struct Unit { int pm, pn, ko, ks; };
struct Gemm { const bf16_t* A; const bf16_t* Bt; int M, N, K, lda, ldb; };

struct StaticOrder {
    int nM, nN, nwg, G, c;
    __host__ __device__ void init(int M, int N, int G_, int c_) { nM = M / BM; nN = N / BM; nwg = nM * nN; G = G_; c = c_; }
    __host__ __device__ bool next(int i, Unit& u) const {
        const long L = (long)i * G + c; if (L >= nwg) return false;
        int wgid = (int)L; { const int q = nwg / NXCD, r = nwg % NXCD, xcd = wgid % NXCD, off = wgid / NXCD; wgid = (xcd < r ? xcd * (q + 1) : r * (q + 1) + (xcd - r) * q) + off; }
        const int nig = WGM * nN, gid = wgid / nig, fm = gid * WGM, gsz = (nM - fm) < WGM ? (nM - fm) : WGM;
        u.pm = fm + ((wgid % nig) % gsz); u.pn = (wgid % nig) / gsz; u.ko = 0; u.ks = 0; return true;
    }
    __device__ __forceinline__ void a_ready(const Unit&) const {}
    __device__ __forceinline__ void done(const Unit&) const {}
};
struct SplitOrder {
    int nN, nitems, kslice, c;
    __host__ __device__ void init(int M, int N, int Kslice, int c_) { nN = N / BM; nitems = (M / BM) * nN * 8; kslice = Kslice; c = c_; }
    __host__ __device__ bool next(int i, Unit& u) const { if (i > 0 || c >= nitems) return false; u.ks = c & 7; u.ko = u.ks * kslice; u.pn = (c >> 3) % nN; u.pm = (c >> 3) / nN; return true; }
    __device__ __forceinline__ void a_ready(const Unit&) const {}
    __device__ __forceinline__ void done(const Unit&) const {}
};

__device__ __forceinline__ unsigned cvt_pk_bf16(float lo, float hi) { unsigned r; asm volatile("v_cvt_pk_bf16_f32 %0, %1, %2" : "=v"(r) : "v"(lo), "v"(hi)); return r; }

struct EpiF32 {
    static constexpr bool PERM = false, AFTER_DRAIN = false;
    float* C; int ldc; size_t split_stride;
    __device__ __forceinline__ void operator()(const f32x4 (&acc)[2][2][4][2], const Unit& u, int wr, int wc, int fr, int fq) const {
        const int row0 = u.pm * BM + wr * 64 + fr, col0 = u.pn * BM + wc * 32 + 4 * fq; float* Cb = C + (size_t)u.ks * split_stride;
#pragma unroll
        for (int ai = 0; ai < 2; ++ai)
#pragma unroll
            for (int m = 0; m < 4; ++m) { float* rowp = Cb + (size_t)(row0 + ai * HALF + m * 16) * ldc + col0;
#pragma unroll
                for (int bj = 0; bj < 2; ++bj)
#pragma unroll
                    for (int n = 0; n < 2; ++n) *(f32x4*)(rowp + bj * HALF + n * 16) = acc[ai][bj][m][n]; }
    }
};
template <int ACT> struct EpiBf16 {
    static constexpr bool PERM = true, AFTER_DRAIN = false;
    bf16_t* O; int ldc; const float* rowscale;
    __device__ __forceinline__ void operator()(const f32x4 (&acc)[2][2][4][2], const Unit& u, int wr, int wc, int fr, int fq) const {
        const int row0 = u.pm * BM + wr * 64 + fr; const int col0 = u.pn * BM + wc * 32 + 8 * fq;
#pragma unroll
        for (int ai = 0; ai < 2; ++ai)
#pragma unroll
            for (int m = 0; m < 4; ++m) { const int row = row0 + ai * HALF + m * 16; bf16_t* rowp = O + (size_t)row * ldc + col0;
                float rs = 1.f; if (ACT == 2) rs = rowscale[row];
#pragma unroll
                for (int bj = 0; bj < 2; ++bj) { f32x4 v0 = acc[ai][bj][m][0], v1 = acc[ai][bj][m][1];
                    if (ACT == 1) {
#pragma unroll
                        for (int j = 0; j < 4; ++j) { const float a = fmaxf(v0[j], 0.f), b = fmaxf(v1[j], 0.f); v0[j] = a * a; v1[j] = b * b; } }
                    if (ACT == 2) { v0 = v0 * rs; v1 = v1 * rs; }
                    u32x4 w; w.x = cvt_pk_bf16(v0[0], v0[1]); w.y = cvt_pk_bf16(v0[2], v0[3]); w.z = cvt_pk_bf16(v1[0], v1[1]); w.w = cvt_pk_bf16(v1[2], v1[3]);
                    *(u32x4*)(rowp + bj * HALF) = w; } }
    }
};

template <class Epi, class Sched, bool ALIGN_EPI = false, bool SP2 = false>
__device__ __forceinline__ void gemm_phase(PG8_LAS unsigned char* lds, const Gemm g, const Sched& S, const Epi& E) {
    int tid = threadIdx.x; asm volatile("" : "+v"(tid));
    const int wid = __builtin_amdgcn_readfirstlane(tid >> 6), lane = tid & 63, wr = wid >> 2, wc = wid & 3, fr = lane & 15, fq = lane >> 4;
    const int K = g.K, nt = K / BK, lda = g.lda, ldb = g.ldb;
    unsigned voffA[2], voffB[2];
#pragma unroll
    for (int i = 0; i < 2; ++i) { int R, C; stage_rc(tid * 16 + i * 8192, R, C); const int Rb = Epi::PERM ? ((R & ~31) + perm32(R & 31)) : R;
        voffA[i] = (unsigned)(R * lda + C) * 2u; voffB[i] = (unsigned)(Rb * ldb + C) * 2u; }
    const size_t kstep = (size_t)(BK * 2);
    const size_t hstepA = (size_t)HALF * lda * 2, hstepB = (size_t)HALF * ldb * 2;
    const size_t tstepA = 2 * hstepA, tstepB = 2 * hstepB;
    const unsigned ldsw = (unsigned)wid * 1024u;
    const int aoff = lds_byte(wr * 64 + fr, fq * 8), boff = lds_byte(wc * 32 + fr, fq * 8);
#define PG8_SA(b, h) (((b) * 2 + (h)) * HTB)
#define PG8_SB(b, h) ((4 + (b) * 2 + (h)) * HTB)
#define PG8_STAGE(bufoff, gbase, voff) do { _Pragma("unroll") for (int _i = 0; _i < 2; ++_i) \
        __builtin_amdgcn_global_load_lds((const unsigned*)((const char*)(gbase) + (voff)[_i]), (PG8_LAS unsigned*)(lds + (bufoff) + ldsw + _i * 8192), 16, 0, 0); } while (0)
#define PG8_LDA(dst, b, h) do { _Pragma("unroll") for (int m = 0; m < 4; ++m) _Pragma("unroll") for (int k = 0; k < 2; ++k) dst[m][k] = *(const PG8_LAS bf16x8*)(lds + PG8_SA(b, h) + aoff + m * 2048 + k * 1024); } while (0)
#define PG8_LDB(dst, b, h) do { _Pragma("unroll") for (int n = 0; n < 2; ++n) _Pragma("unroll") for (int k = 0; k < 2; ++k) dst[n][k] = *(const PG8_LAS bf16x8*)(lds + PG8_SB(b, h) + boff + n * 2048 + k * 1024); } while (0)
#define PG8_MMA(ai, bj, At, Bt) do { __builtin_amdgcn_s_setprio(1); _Pragma("unroll") for (int m = 0; m < 4; ++m) _Pragma("unroll") for (int n = 0; n < 2; ++n) _Pragma("unroll") for (int k = 0; k < 2; ++k) \
        acc[ai][bj][m][n] = __builtin_amdgcn_mfma_f32_16x16x32_bf16(Bt[n][k], At[m][k], acc[ai][bj][m][n], 0, 0, 0); __builtin_amdgcn_s_setprio(0); } while (0)
#define PG8_WAIT_V(n) asm volatile("s_waitcnt vmcnt(" #n ")" ::: "memory")
#define PG8_WAIT_L(n) asm volatile("s_waitcnt lgkmcnt(" #n ")" ::: "memory")
#define PG8_BAR __builtin_amdgcn_s_barrier()
#define PG8_SCHED __builtin_amdgcn_sched_barrier(0)
    Unit cur, nxt; int ui = 0;
    if (!S.next(0, cur)) return;
    f32x4 acc[2][2][4][2];
#pragma unroll
    for (int a = 0; a < 2; ++a)
#pragma unroll
        for (int b = 0; b < 2; ++b)
#pragma unroll
            for (int m = 0; m < 4; ++m)
#pragma unroll
                for (int n = 0; n < 2; ++n) acc[a][b][m][n] = (f32x4){0.f, 0.f, 0.f, 0.f};
    bf16x8 At[4][2], B0[2][2], B1[2][2];
    const char* cA = (const char*)g.A + (size_t)cur.pm * tstepA + (size_t)cur.ko * 2; const char* cB = (const char*)g.Bt + (size_t)cur.pn * tstepB + (size_t)cur.ko * 2;
    S.a_ready(cur);
    if constexpr (SP2) {
        PG8_STAGE(PG8_SB(0, 0), cB, voffB); PG8_STAGE(PG8_SB(0, 1), cB + hstepB, voffB); PG8_STAGE(PG8_SA(0, 0), cA, voffA); PG8_STAGE(PG8_SA(0, 1), cA + hstepA, voffA);
        if (wr == 1) PG8_BAR;
        PG8_WAIT_V(2); PG8_BAR;
        PG8_STAGE(PG8_SB(1, 0), cB + kstep, voffB); PG8_STAGE(PG8_SA(1, 0), cA + kstep, voffA); PG8_STAGE(PG8_SB(1, 1), cB + hstepB + kstep, voffB);
        PG8_WAIT_V(6); PG8_BAR;
    } else {
        PG8_STAGE(PG8_SB(0, 0), cB, voffB); PG8_STAGE(PG8_SA(0, 0), cA, voffA); PG8_STAGE(PG8_SB(0, 1), cB + hstepB, voffB); PG8_STAGE(PG8_SA(0, 1), cA + hstepA, voffA);
        if (wr == 1) PG8_BAR;
        PG8_WAIT_V(4); PG8_BAR;
        PG8_STAGE(PG8_SB(1, 0), cB + kstep, voffB); PG8_STAGE(PG8_SA(1, 0), cA + kstep, voffA); PG8_STAGE(PG8_SB(1, 1), cB + hstepB + kstep, voffB);
        PG8_WAIT_V(6); PG8_BAR;
    }
    for (;;) {
        const bool has_next = S.next(ui + 1, nxt);
        const char* nA = has_next ? (const char*)g.A + (size_t)nxt.pm * tstepA + (size_t)nxt.ko * 2 : cA; const char* nB = has_next ? (const char*)g.Bt + (size_t)nxt.pn * tstepB + (size_t)nxt.ko * 2 : cB;
        for (int t = 0; t < nt; t += 2) {
            const bool last = (t == nt - 2);
            const char* a1 = cA + (size_t)(t + 1) * kstep;
            const char* a2 = last ? nA : cA + (size_t)(t + 2) * kstep; const char* b2 = last ? nB : cB + (size_t)(t + 2) * kstep;
            const char* a3 = a2 + kstep; const char* b3 = b2 + kstep;
            if (last && has_next) S.a_ready(nxt);
            if constexpr (SP2) {
            PG8_LDB(B0, 0, 0); PG8_LDB(B1, 0, 1); PG8_SCHED; PG8_LDA(At, 0, 0); PG8_STAGE(PG8_SA(1, 1), a1 + hstepA, voffA);
            PG8_WAIT_V(8); PG8_WAIT_L(0); PG8_BAR; PG8_MMA(0, 0, At, B0); PG8_MMA(0, 1, At, B1); PG8_BAR; PG8_SCHED;
            PG8_LDA(At, 0, 1); PG8_STAGE(PG8_SB(0, 0), b2, voffB); PG8_STAGE(PG8_SB(0, 1), b2 + hstepB, voffB); PG8_STAGE(PG8_SA(0, 0), a2, voffA);
            PG8_WAIT_V(8); PG8_WAIT_L(0); PG8_BAR; PG8_MMA(1, 0, At, B0); PG8_MMA(1, 1, At, B1); PG8_BAR; PG8_SCHED;
            PG8_LDB(B0, 1, 0); PG8_LDB(B1, 1, 1); PG8_SCHED; PG8_LDA(At, 1, 0); PG8_STAGE(PG8_SA(0, 1), a2 + hstepA, voffA);
            PG8_WAIT_V(8); PG8_WAIT_L(0); PG8_BAR; PG8_MMA(0, 0, At, B0); PG8_MMA(0, 1, At, B1); PG8_BAR; PG8_SCHED;
            PG8_LDA(At, 1, 1); PG8_STAGE(PG8_SB(1, 0), b3, voffB); PG8_STAGE(PG8_SB(1, 1), b3 + hstepB, voffB); PG8_STAGE(PG8_SA(1, 0), a3, voffA);
            PG8_WAIT_V(8); PG8_WAIT_L(0); PG8_BAR; PG8_MMA(1, 0, At, B0); PG8_MMA(1, 1, At, B1); PG8_BAR; PG8_SCHED;
            } else {
            PG8_LDB(B0, 0, 0); PG8_SCHED; PG8_LDA(At, 0, 0); PG8_STAGE(PG8_SA(1, 1), a1 + hstepA, voffA);
            PG8_WAIT_L(8); PG8_BAR; PG8_WAIT_L(0); PG8_MMA(0, 0, At, B0); PG8_BAR; PG8_SCHED;
            PG8_LDB(B1, 0, 1); PG8_STAGE(PG8_SB(0, 0), b2, voffB);
            PG8_BAR; PG8_WAIT_L(0); PG8_MMA(0, 1, At, B1); PG8_BAR;
            PG8_LDA(At, 0, 1); PG8_STAGE(PG8_SA(0, 0), a2, voffA);
            PG8_BAR; PG8_WAIT_L(0); PG8_MMA(1, 0, At, B0); PG8_BAR; PG8_SCHED;
            PG8_STAGE(PG8_SB(0, 1), b2 + hstepB, voffB);
            PG8_WAIT_V(6); PG8_BAR; PG8_MMA(1, 1, At, B1); PG8_BAR;
            PG8_LDB(B0, 1, 0); PG8_SCHED; PG8_LDA(At, 1, 0); PG8_STAGE(PG8_SA(0, 1), a2 + hstepA, voffA);
            PG8_WAIT_L(8); PG8_BAR; PG8_WAIT_L(0); PG8_MMA(0, 0, At, B0); PG8_BAR; PG8_SCHED;
            PG8_LDB(B1, 1, 1); PG8_STAGE(PG8_SB(1, 0), b3, voffB);
            PG8_BAR; PG8_WAIT_L(0); PG8_MMA(0, 1, At, B1); PG8_BAR;
            PG8_LDA(At, 1, 1); PG8_STAGE(PG8_SA(1, 0), a3, voffA);
            PG8_BAR; PG8_WAIT_L(0); PG8_MMA(1, 0, At, B0); PG8_BAR; PG8_SCHED;
            PG8_STAGE(PG8_SB(1, 1), b3 + hstepB, voffB);
            PG8_WAIT_V(6); PG8_BAR; PG8_MMA(1, 1, At, B1); PG8_BAR;
            }
        }
        if constexpr (ALIGN_EPI) { if (wr == 0) PG8_BAR; }
        E(acc, cur, wr, wc, fr, fq); S.done(cur);
        if (!has_next) break;
#pragma unroll
        for (int a = 0; a < 2; ++a)
#pragma unroll
            for (int b = 0; b < 2; ++b)
#pragma unroll
                for (int m = 0; m < 4; ++m)
#pragma unroll
                    for (int n = 0; n < 2; ++n) acc[a][b][m][n] = (f32x4){0.f, 0.f, 0.f, 0.f};
        cur = nxt; cA = nA; cB = nB; ++ui;
        if constexpr (ALIGN_EPI) { if (wr == 1) PG8_BAR; }
    }
    PG8_WAIT_V(0);
    if constexpr (!ALIGN_EPI) { if (wr == 0) PG8_BAR; }
    PG8_BAR;
#undef PG8_SA
#undef PG8_SB
#undef PG8_STAGE
#undef PG8_LDA
#undef PG8_LDB
#undef PG8_MMA
#undef PG8_WAIT_V
#undef PG8_WAIT_L
#undef PG8_BAR
#undef PG8_SCHED
}
}

constexpr int NWAVES = 8, NTHR = 512;
constexpr int DM = 4096, NB = 2, SEQ = 8192, NCTX = 256, DFF = 16384;
constexpr int M_LAT = NB * SEQ, M_CTX = NB * NCTX, M_TOT = M_LAT + M_CTX;
constexpr int DIN = 8672, DINP = 8704;
constexpr int C_SWAQ = 0, C_SWAK = 1024, C_SWAV = 1280, C_LRUX = 1536, C_LRUY = 2560, C_QA = 3584, C_KVA = 4608, C_KR = 5120, C_RW = 5184;
constexpr int C_RWR = C_RW, C_RWK = C_RW + 1024, C_RWV = C_RW + 2048, C_RWL = C_RW + 3072;
constexpr int RWC = 3488;
constexpr float LN_EPS = 1e-5f, RMS_EPS = 1e-6f, GN_EPS = 64e-5f, ALPHA = 1.41421356237f;
constexpr int NCH = 264;

constexpr size_t MiB = 1u << 20;
constexpr size_t WS_CTL = 0, CTL_ZERO_BYTES = 1 * MiB;
constexpr size_t WS_MOD = 1 * MiB;
constexpr size_t WS_MODP = 2 * MiB;
constexpr size_t WS_SMALL = 20 * MiB;
constexpr size_t WS_RSQ = WS_SMALL;
constexpr size_t WS_RSKV = WS_RSQ + 128 * 1024;
constexpr size_t WS_SB = WS_RSKV + 128 * 1024;
constexpr size_t WS_CA = WS_SB + 2 * MiB;
constexpr size_t WS_CB = WS_CA + 5 * MiB;
constexpr size_t WS_HIN = WS_CB + 5 * MiB;
constexpr size_t WS_QUIRK = WS_HIN + 5 * MiB;
constexpr size_t WS_ROPE = WS_QUIRK + 8192;
static_assert(WS_ROPE + 16384 <= 40 * MiB, "small region");
constexpr size_t WS_W = 40 * MiB;
constexpr size_t WS_WIN = WS_W, WS_WOUT = WS_WIN + 68 * MiB, WS_WFF1 = WS_WOUT + 32 * MiB, WS_WFF2 = WS_WFF1 + 128 * MiB, WS_WQB = WS_WFF2 + 128 * MiB,
                 WS_WKVB = WS_WQB + 3 * MiB, WS_WLRU = WS_WKVB + 2 * MiB, WS_WLORA = WS_WLRU + 1 * MiB;
constexpr size_t WS_W2T = WS_WLORA, WS_A2T = WS_W2T + 256 * 1024, WS_G2T = WS_A2T + 256 * 1024;
constexpr size_t WS_X = 403 * MiB;
constexpr size_t WS_H = 667 * MiB;
constexpr size_t WS_MIX = 799 * MiB;
constexpr size_t WS_YS = 931 * MiB;
constexpr size_t WS_P = 1063 * MiB;
constexpr size_t WS_RWF = 1344 * MiB;
constexpr size_t RWF_STRIDE = (size_t)M_TOT * 1024 * 2;
constexpr size_t WS_Q = 1641 * MiB;
constexpr size_t WS_KV = 1691 * MiB;
constexpr size_t WS_KR = 1757 * MiB;
constexpr size_t WS_SET2 = 1760 * MiB;
constexpr size_t WSET_STRIDE = WS_SET2 - WS_W;
constexpr size_t WS_END = WS_SET2 + 363 * MiB;
constexpr size_t WS_YP = WS_Q;
constexpr size_t WS_HID = WS_P;
constexpr size_t WS_Y1 = WS_P;
constexpr size_t WS_Y2 = WS_MIX;
static_assert(WS_WLORA + 1 * MiB <= WS_X && WS_P + (size_t)M_TOT * DINP * 2 <= WS_RWF && WS_RWF + 9 * RWF_STRIDE <= WS_Q, "ws map");
static_assert(WS_HID + (size_t)M_TOT * DFF * 2 <= WS_Q && WS_Y2 + (size_t)M_TOT * DM * 4 <= WS_P && WS_YS + 2 * (size_t)M_TOT * 1024 * 4 <= WS_P, "ws overlays");
static_assert(WS_KR + (size_t)M_TOT * 64 * 2 <= WS_SET2 && WS_YP + 8 * (size_t)M_CTX * DM * 4 <= WS_KR, "ws end");

constexpr int RING_BYTES = 131072;
constexpr int LDSCTL_OFF = RING_BYTES, MISC_OFF = LDSCTL_OFF + 320;
constexpr int LDS_BYTES = 147456;

#define GAS __attribute__((address_space(1)))
#define LAS __attribute__((address_space(3)))
typedef unsigned short bf16;
typedef unsigned v4u __attribute__((ext_vector_type(4)));
typedef unsigned v2u __attribute__((ext_vector_type(2)));
typedef float f32x4 __attribute__((ext_vector_type(4)));
typedef float f32x2 __attribute__((ext_vector_type(2)));
typedef float f32x16 __attribute__((ext_vector_type(16)));
typedef short bf16x8 __attribute__((ext_vector_type(8)));
typedef short s16x4 __attribute__((ext_vector_type(4)));
typedef GAS unsigned gu32;
typedef const GAS bf16* gcbf; typedef GAS bf16* gbfp; typedef const GAS float* gcfl; typedef GAS float* gflp;
#define LDS_WAIT() asm volatile("s_waitcnt lgkmcnt(0)" ::: "memory")
#define VM_WAIT() asm volatile("s_waitcnt vmcnt(0)" ::: "memory")
__device__ __forceinline__ unsigned f2bf(float f) { unsigned u = __builtin_bit_cast(unsigned, f); return (u + 0x7fffu + ((u >> 16) & 1u)) >> 16; }
__device__ __forceinline__ unsigned pk2(float lo, float hi) { return f2bf(lo) | (f2bf(hi) << 16); }
__device__ __forceinline__ float bflo(unsigned w) { return __builtin_bit_cast(float, w << 16); }
__device__ __forceinline__ float bfhi(unsigned w) { return __builtin_bit_cast(float, w & 0xffff0000u); }
__device__ __forceinline__ float bf2f(bf16 h) { return __builtin_bit_cast(float, (unsigned)h << 16); }
#define DPP_ADD(x, ctrl) ((x) + __builtin_bit_cast(float, __builtin_amdgcn_update_dpp(0, __builtin_bit_cast(int, (x)), (ctrl), 0xf, 0xf, false)))
__device__ __forceinline__ float row_sum16(float x) { x = DPP_ADD(x, 0x128); x = DPP_ADD(x, 0x124); x = DPP_ADD(x, 0x122); x = DPP_ADD(x, 0x121); return x; }
#ifdef OLD_SUMS
__device__ __forceinline__ float wave_sum(float v) {
#pragma unroll
    for (int o = 1; o < 64; o <<= 1) v += __shfl_xor(v, o);
    return v;
}
__device__ __forceinline__ float half_swap_sum(float x) { return x + __shfl_xor(x, 32); }
__device__ __forceinline__ float quad_sum(float x) { x += __shfl_xor(x, 1); x += __shfl_xor(x, 2); return x; }
#else
__device__ __forceinline__ float wave_sum(float v) {
    const float r = row_sum16(v);
    const float a = __builtin_bit_cast(float, __builtin_amdgcn_readlane(__builtin_bit_cast(int, r), 0)), b = __builtin_bit_cast(float, __builtin_amdgcn_readlane(__builtin_bit_cast(int, r), 16));
    const float c = __builtin_bit_cast(float, __builtin_amdgcn_readlane(__builtin_bit_cast(int, r), 32)), d = __builtin_bit_cast(float, __builtin_amdgcn_readlane(__builtin_bit_cast(int, r), 48));
    return (a + b) + (c + d);
}
__device__ __forceinline__ float half_swap_sum(float x) {
    unsigned a = __builtin_bit_cast(unsigned, x), b = a; asm volatile("" : "+v"(b));
    auto rr = __builtin_amdgcn_permlane32_swap(a, b, false, false);
    const float lo = __uint_as_float(rr[0]), hi = __uint_as_float(rr[1]); return lo + hi;
}
__device__ __forceinline__ float quad_sum(float x) { x = DPP_ADD(x, 0xB1); x = DPP_ADD(x, 0x4E); return x; }
#endif
__device__ __forceinline__ float sigmoidf_(float x) { return 1.f / (1.f + __expf(-x)); }
__device__ __forceinline__ float softplusf_(float x) { return x > 20.f ? x : __logf(1.f + __expf(x)); }
__device__ __forceinline__ float tanhf_(float x) { const float e = __expf(2.f * x); return 1.f - 2.f / (e + 1.f); }
__device__ __forceinline__ int ltid() { int t = threadIdx.x; asm volatile("" : "+v"(t)); return t; }
template <class T> __device__ __forceinline__ T ldg(const void* base, unsigned byteoff) { return *(const T*)((const char*)base + byteoff); }
template <class T> __device__ __forceinline__ void stg(void* base, unsigned byteoff, T v) { *(T*)((char*)base + byteoff) = v; }

#define XB_TMO      128
#define XB_XCNT(j)  (256  + 64 * (j))
#define XB_XSUB(j)  (1280 + 64 * (j))
#define XB_XGEN(j)  (2304 + 64 * (j))
#define XB_TOP      3328
#define XB_TOPGEN   3392
#define XCD_BAR_WORDS 3456
#define XB_SPIN_CAP (1u << 18)

__device__ __forceinline__ unsigned xb_ld(unsigned* p)              { return __hip_atomic_load(p, __ATOMIC_RELAXED, __HIP_MEMORY_SCOPE_AGENT); }
__device__ __forceinline__ unsigned xb_add(unsigned* p, unsigned v) { return __hip_atomic_fetch_add(p, v, __ATOMIC_RELAXED, __HIP_MEMORY_SCOPE_AGENT); }
__device__ __forceinline__ unsigned xb_xcc_id() { return (unsigned)__builtin_amdgcn_s_getreg((3 << 11) | 20) & 0xFu; }
#define XB_SPIN(cond, bar) do { unsigned _sp = 0; while (cond) { __builtin_amdgcn_s_sleep(1); \
    if ((++_sp & 255u) == 0u) { if (xb_ld(&(bar)[XB_TMO])) break; if (_sp > XB_SPIN_CAP) { atomicAdd(&(bar)[XB_TMO], 1u); break; } } } } while (0)

struct XcdBarrier {
    unsigned* bar; unsigned x;
    volatile LAS unsigned* st;
};

__device__ __forceinline__ XcdBarrier xcd_barrier_post(unsigned* bar, volatile LAS unsigned* st) {
    XcdBarrier b; b.bar = bar; b.x = xb_xcc_id(); b.st = st;
    if (threadIdx.x == 0) (void)xb_add(&bar[XB_XCNT(b.x)], 1u);
    return b;
}
__device__ __forceinline__ void xcd_barrier_complete(unsigned* bar, unsigned x, unsigned& nloc, unsigned& nx) {
    const unsigned G = gridDim.x * gridDim.y * gridDim.z;
    unsigned sum, cnt, mine, sp = 0u;
    for (;;) {
        sum = 0u; cnt = 0u; mine = 0u;
#pragma unroll
        for (unsigned j = 0; j < 16; ++j) { const unsigned c = xb_ld(&bar[XB_XCNT(j)]); sum += c; cnt += (c > 0u) ? 1u : 0u; mine = (j == x) ? c : mine; }
        if (sum == G) break;
        __builtin_amdgcn_s_sleep(1);
        if ((++sp & 255u) == 0u) { if (xb_ld(&bar[XB_TMO])) break; if (sp > XB_SPIN_CAP) { atomicAdd(&bar[XB_TMO], 1u); break; } }
    }
    nloc = mine > 0u ? mine : 1u; nx = cnt > 0u ? cnt : 1u;
}

__device__ __forceinline__ void xcd_barrier(const XcdBarrier& b) {
    asm volatile("s_waitcnt vmcnt(0)" ::: "memory");
    __syncthreads();
    if (threadIdx.x == 0) {
        unsigned* bar = b.bar;
        __builtin_amdgcn_s_waitcnt(0);
        unsigned nloc = b.st[0], nx = b.st[1];
        if (nloc == 0u) { xcd_barrier_complete(bar, b.x, nloc, nx); b.st[0] = nloc; b.st[1] = nx; }
        const unsigned old = xb_add(&bar[XB_XSUB(b.x)], 1u);
        const unsigned gen = old / nloc;
        if (old + 1u == (gen + 1u) * nloc) {
            __builtin_amdgcn_fence(__ATOMIC_RELEASE, "agent");
            asm volatile("s_waitcnt vmcnt(0)" ::: "memory");
            const unsigned og = xb_add(&bar[XB_TOP], 1u);
            const unsigned tg = og / nx;
            if (og + 1u == (tg + 1u) * nx) xb_add(&bar[XB_TOPGEN], 1u);
            else XB_SPIN(xb_ld(&bar[XB_TOPGEN]) == tg, bar);
            __builtin_amdgcn_fence(__ATOMIC_ACQUIRE, "agent");
            xb_add(&bar[XB_XGEN(b.x)], 1u);
            asm volatile("s_waitcnt vmcnt(0)" ::: "memory");
        } else {
            XB_SPIN(xb_ld(&bar[XB_XGEN(b.x)]) == gen, bar);
            __builtin_amdgcn_fence(__ATOMIC_ACQUIRE, "agent");
            asm volatile("s_waitcnt vmcnt(0)" ::: "memory");
        }
    }
    __syncthreads();
}


namespace att {
constexpr int KVBLK = 64;
constexpr float THR = 8.f;
#define SBAR() __builtin_amdgcn_sched_barrier(0)
__device__ __forceinline__ int crow(int r, int hi) { return (r & 3) + 8 * (r >> 2) + 4 * hi; }
__device__ __forceinline__ unsigned cvtpk(float lo, float hi) { unsigned r; asm volatile("v_cvt_pk_bf16_f32 %0, %1, %2" : "=v"(r) : "v"(lo), "v"(hi)); return r; }
template <int DQK> __device__ __forceinline__ int kswz(int row, int cb) { return row * (DQK * 2 + 16) + cb; }

template <int DQK> __device__ __forceinline__ void partialSM(f32x16& p0, f32x16& p1, float& m_reg, float& mn, float& alpha) {
  constexpr float SCALE = DQK == 128 ? 0.088388347648318440f : 0.072168783648703220f;
  constexpr float C = SCALE * 1.4426950408889634f;
  float pmax = p0[0];
#pragma unroll
  for (int r = 1; r < 16; ++r) pmax = fmaxf(pmax, p0[r]);
#pragma unroll
  for (int r = 0; r < 16; ++r) pmax = fmaxf(pmax, p1[r]);
  { auto rr = __builtin_amdgcn_permlane32_swap(__float_as_uint(pmax), __float_as_uint(pmax), false, false);
    pmax = fmaxf(__uint_as_float(rr[0]), __uint_as_float(rr[1])); }
  if (__builtin_expect(__all(pmax - m_reg <= THR / SCALE), 1)) { mn = m_reg; alpha = 1.f; }
  else { mn = fmaxf(m_reg, pmax); alpha = __builtin_amdgcn_exp2f((m_reg - mn) * C); m_reg = mn; }
  const float mnC = -mn * C;
#pragma unroll
  for (int r = 0; r < 16; ++r) p0[r] = fmaf(p0[r], C, mnC);
#pragma unroll
  for (int r = 0; r < 16; ++r) p1[r] = fmaf(p1[r], C, mnC);
#pragma unroll
  for (int r = 0; r < 16; ++r) p0[r] = __builtin_amdgcn_exp2f(p0[r]);
}
__device__ __forceinline__ void finishSM(f32x16& p0, f32x16& p1, float alpha, float& l_reg, bf16x8& pa0, bf16x8& pa1, bf16x8& pa2, bf16x8& pa3) {
#pragma unroll
  for (int r = 0; r < 16; ++r) p1[r] = __builtin_amdgcn_exp2f(p1[r]);
  float ps = 0;
#pragma unroll
  for (int r = 0; r < 16; ++r) ps += p0[r];
#pragma unroll
  for (int r = 0; r < 16; ++r) ps += p1[r];
  { auto rr = __builtin_amdgcn_permlane32_swap(__float_as_uint(ps), __float_as_uint(ps), false, false);
    ps = __uint_as_float(rr[0]) + __uint_as_float(rr[1]); }
  l_reg = l_reg * alpha + ps;
#define PK4(P, BASE, OUT) do { unsigned a0 = cvtpk(P[BASE + 0], P[BASE + 1]), a1 = cvtpk(P[BASE + 2], P[BASE + 3]);   \
    unsigned b0 = cvtpk(P[BASE + 4], P[BASE + 5]), b1 = cvtpk(P[BASE + 6], P[BASE + 7]);                              \
    auto r0 = __builtin_amdgcn_permlane32_swap(a0, b0, false, false); auto r1 = __builtin_amdgcn_permlane32_swap(a1, b1, false, false); \
    v4u w = {r0[0], r1[0], r0[1], r1[1]}; OUT = __builtin_bit_cast(bf16x8, w); } while (0)
  PK4(p0, 0, pa0); PK4(p0, 8, pa1); PK4(p1, 0, pa2); PK4(p1, 8, pa3);
#undef PK4
}
template <int DQK> __device__ __forceinline__ void qkt(f32x16& p0, f32x16& p1, const LAS char* Ks, const bf16x8* qr, const LAS char* qx, int r32, int hi) {
  p0 = f32x16{}; p1 = f32x16{};
#pragma unroll
  for (int d0 = 0; d0 < DQK / 16; ++d0) { const int cb = (d0 * 16 + hi * 8) * 2;
    bf16x8 b0 = *(const LAS bf16x8*)(Ks + kswz<DQK>(r32, cb));
    bf16x8 b1 = *(const LAS bf16x8*)(Ks + kswz<DQK>(32 + r32, cb));
    bf16x8 q; if (d0 < 8) q = qr[d0]; else q = *(const LAS bf16x8*)(qx + (d0 - 8) * 32);
    p0 = __builtin_amdgcn_mfma_f32_32x32x16_bf16(b0, q, p0, 0, 0, 0);
    p1 = __builtin_amdgcn_mfma_f32_32x32x16_bf16(b1, q, p1, 0, 0, 0);
    if ((d0 & 3) == 3 && d0 + 1 < DQK / 16) SBAR(); }
}
__device__ __forceinline__ int v_st(int k, int c) { const int kk = (k & ~0xC) | ((k & 4) << 1) | ((k & 8) >> 1); return ((kk >> 3) * 4 + (c >> 5)) * 512 + ((kk & 7) * 32 + (c & 31)) * 2; }
__device__ __forceinline__ int v_rd_base(int lane) { return ((lane & 3) << 3) | (((lane >> 2) & 3) << 6) | (((lane >> 4) & 1) << 5) | (((lane >> 5) & 1) << 8); }
constexpr int v_rd_off(int d0, int ks, int half) { return d0 * 512 + ks * 4096 + half * 2048; }
template <int OFF> __device__ __forceinline__ s16x4 tr_read(int vb) {
  s16x4 r; asm volatile("ds_read_b64_tr_b16 %0, %1 offset:%2" : "=&v"(r) : "v"(vb), "i"(OFF) : "memory"); return r;
}
template <int D0> __device__ __forceinline__ void pv_one(f32x16& od, int vb, bf16x8 pa0, bf16x8 pa1, bf16x8 pa2, bf16x8 pa3) {
  const s16x4 l0 = tr_read<v_rd_off(D0, 0, 0)>(vb), h0 = tr_read<v_rd_off(D0, 0, 1)>(vb), l1 = tr_read<v_rd_off(D0, 1, 0)>(vb), h1 = tr_read<v_rd_off(D0, 1, 1)>(vb);
  const s16x4 l2 = tr_read<v_rd_off(D0, 2, 0)>(vb), h2 = tr_read<v_rd_off(D0, 2, 1)>(vb), l3 = tr_read<v_rd_off(D0, 3, 0)>(vb), h3 = tr_read<v_rd_off(D0, 3, 1)>(vb);
  asm volatile("s_waitcnt lgkmcnt(0)" ::: "memory"); SBAR();
#define PK(L, H) (bf16x8){L[0], L[1], L[2], L[3], H[0], H[1], H[2], H[3]}
  od = __builtin_amdgcn_mfma_f32_32x32x16_bf16(pa0, PK(l0, h0), od, 0, 0, 0);
  od = __builtin_amdgcn_mfma_f32_32x32x16_bf16(pa1, PK(l1, h1), od, 0, 0, 0);
  od = __builtin_amdgcn_mfma_f32_32x32x16_bf16(pa2, PK(l2, h2), od, 0, 0, 0);
  od = __builtin_amdgcn_mfma_f32_32x32x16_bf16(pa3, PK(l3, h3), od, 0, 0, 0);
#undef PK
}
__device__ __forceinline__ void pv_d0(f32x16* o, int vb, bf16x8 pa0, bf16x8 pa1, bf16x8 pa2, bf16x8 pa3) {
  pv_one<0>(o[0], vb, pa0, pa1, pa2, pa3); pv_one<1>(o[1], vb, pa0, pa1, pa2, pa3); pv_one<2>(o[2], vb, pa0, pa1, pa2, pa3); pv_one<3>(o[3], vb, pa0, pa1, pa2, pa3);
}
__device__ __forceinline__ void apply_mask(f32x16& p0, f32x16& p1, int mtype, int krel0, int qi, int hi) {
  if (mtype == 0) return;
  const float ninf = -__builtin_inff();
#pragma unroll
  for (int r = 0; r < 16; ++r) { const int k0 = krel0 + crow(r, hi), k1 = k0 + 32;
    const bool ok0 = (mtype == 1) ? (k0 >= qi - 128) : (k0 <= qi + 128), ok1 = (mtype == 1) ? (k1 >= qi - 128) : (k1 <= qi + 128);
    p0[r] = ok0 ? p0[r] : ninf; p1[r] = ok1 ? p1[r] : ninf; }
}
struct Tile { gcbf kn; gcbf kr; gcbf v; int mtype; int krel0; };

__device__ __forceinline__ void rope_pair(bf16x8& a, bf16x8& b, gcfl ct, gcfl st) {
  const f32x4 c0 = *(const GAS f32x4*)ct, c1 = *(const GAS f32x4*)(ct + 4), s0 = *(const GAS f32x4*)st, s1 = *(const GAS f32x4*)(st + 4);
  const float cs[8] = {c0[0], c0[1], c0[2], c0[3], c1[0], c1[1], c1[2], c1[3]}, sn[8] = {s0[0], s0[1], s0[2], s0[3], s1[0], s1[1], s1[2], s1[3]};
  v4u ua = __builtin_bit_cast(v4u, a), ub = __builtin_bit_cast(v4u, b); v4u oa, ob;
#pragma unroll
  for (int w = 0; w < 4; ++w) { const float x1[2] = {bflo(ua[w]), bfhi(ua[w])}, x2[2] = {bflo(ub[w]), bfhi(ub[w])}; float y1[2], y2[2];
#pragma unroll
    for (int e = 0; e < 2; ++e) { const float c = cs[2 * w + e], sv = sn[2 * w + e]; y1[e] = x1[e] * c - x2[e] * sv; y2[e] = x2[e] * c + x1[e] * sv; }
    oa[w] = pk2(y1[0], y1[1]); ob[w] = pk2(y2[0], y2[1]); }
  a = __builtin_bit_cast(bf16x8, oa); b = __builtin_bit_cast(bf16x8, ob);
}

template <int DQK, int LDKN, int LDV, bool MASK, bool SINK, int SDEPTH, class TS>
__device__ __forceinline__ void attn_body(gcbf Qw, int rope, int prow, int pcol, gcfl rtab, int qi, float sink_l2, const TS& ts, int NT, gbfp Ow, LAS char* lds) {
  constexpr float SCALE = DQK == 128 ? 0.088388347648318440f : 0.072168783648703220f;
  constexpr float C = SCALE * 1.4426950408889634f;
  constexpr int SHM_K = KVBLK * (DQK * 2 + 16), SHM_V = KVBLK * 128 * 2;
  int tid = threadIdx.x; asm volatile("" : "+v"(tid));
  const int wid = tid >> 6, lane = tid & 63, r32 = lane & 31, hi = lane >> 5;
  LAS char* V_lds = lds; LAS char* K_lds = lds + 2 * SHM_V;
  LAS float* wsl = (LAS float*)(lds + 2 * SHM_V + 2 * SHM_K) + wid * 64; LAS float* li_l = wsl; LAS float* al_l = wsl + 32;
  float m_reg = -1e30f, l_reg = 0; f32x16 o[4] = {}; bf16x8 qr[8];
#pragma unroll
  for (int d0 = 0; d0 < 8; ++d0) qr[d0] = *(const GAS bf16x8*)(Qw + d0 * 16 + hi * 8);
  const LAS char* qx = lds + 2 * SHM_V + 2 * SHM_K + 2048 + wid * 4608 + r32 * 144 + hi * 16;
  if constexpr (DQK == 192) {
    bf16x8 x0 = *(const GAS bf16x8*)(Qw + 128 + hi * 8), x1 = *(const GAS bf16x8*)(Qw + 144 + hi * 8), x2 = *(const GAS bf16x8*)(Qw + 160 + hi * 8), x3 = *(const GAS bf16x8*)(Qw + 176 + hi * 8);
    if (rope) {
      rope_pair(x0, x1, rtab + (size_t)prow * 16 + hi * 8, rtab + 2048 + (size_t)prow * 16 + hi * 8);
      rope_pair(x2, x3, rtab + (size_t)pcol * 16 + hi * 8, rtab + 2048 + (size_t)pcol * 16 + hi * 8); }
    LAS char* qw_ = (LAS char*)qx; *(LAS bf16x8*)(qw_) = x0; *(LAS bf16x8*)(qw_ + 32) = x1; *(LAS bf16x8*)(qw_ + 64) = x2; *(LAS bf16x8*)(qw_ + 96) = x3;
  }
  const int sr = tid >> 4, sc = (tid & 15) * 8, vst0 = v_st(sr, sc), vst1 = v_st(32 + sr, sc);
  const int rr_ = tid >> 3, rc_ = (tid & 7) * 8;
  const int vb0 = (int)(uintptr_t)V_lds + v_rd_base(lane);
  struct { bf16x8 vs0, vs1, ks0, ks1, kx; } sr_[SDEPTH];
#define SLOAD(i, jt) do { const Tile t_ = ts(jt); sr_[i].vs0 = *(const GAS bf16x8*)(t_.v + (size_t)sr * LDV + sc); sr_[i].vs1 = *(const GAS bf16x8*)(t_.v + (size_t)(32 + sr) * LDV + sc); \
    sr_[i].ks0 = *(const GAS bf16x8*)(t_.kn + (size_t)sr * LDKN + sc); sr_[i].ks1 = *(const GAS bf16x8*)(t_.kn + (size_t)(32 + sr) * LDKN + sc); \
    if constexpr (DQK == 192) sr_[i].kx = *(const GAS bf16x8*)(t_.kr + (size_t)rr_ * 64 + rc_); } while (0)
#define SWRITE(b, i) do { *(LAS bf16x8*)(V_lds + (b) * SHM_V + vst0) = sr_[i].vs0; *(LAS bf16x8*)(V_lds + (b) * SHM_V + vst1) = sr_[i].vs1; const int kc = sc * 2; \
    *(LAS bf16x8*)(K_lds + (b) * SHM_K + kswz<DQK>(sr, kc)) = sr_[i].ks0; *(LAS bf16x8*)(K_lds + (b) * SHM_K + kswz<DQK>(32 + sr, kc)) = sr_[i].ks1; \
    if constexpr (DQK == 192) *(LAS bf16x8*)(K_lds + (b) * SHM_K + kswz<DQK>(rr_, 256 + rc_ * 2)) = sr_[i].kx; } while (0)
#define SWAIT() do { if constexpr (SDEPTH == 2) { if constexpr (DQK == 192) asm volatile("s_waitcnt vmcnt(5)" ::: "memory"); else asm volatile("s_waitcnt vmcnt(4)" ::: "memory"); } \
    else asm volatile("s_waitcnt vmcnt(0)" ::: "memory"); } while (0)
#define RESC(a) do { if (__any((a) < 1.f)) { if (hi == 0) al_l[r32] = (a); asm volatile("s_waitcnt lgkmcnt(0)" ::: "memory"); \
    _Pragma("unroll") for (int d = 0; d < 4; ++d) _Pragma("unroll") for (int r = 0; r < 16; ++r) o[d][r] *= al_l[crow(r, hi)]; } } while (0)
#define MASKT(pa_, pb_, jt) do { if constexpr (MASK) { const Tile t_ = ts(jt); apply_mask(pa_, pb_, t_.mtype, t_.krel0, qi, hi); } } while (0)
  f32x16 pA0, pA1, pB0, pB1; float mnA, mnB, alA, alB; bf16x8 pa0, pa1, pa2, pa3;
  constexpr int SE = 0, SO = SDEPTH - 1;
  SLOAD(SE, 0); asm volatile("s_waitcnt vmcnt(0)" ::: "memory"); SWRITE(0, SE); __syncthreads();
  qkt<DQK>(pA0, pA1, K_lds, qr, qx, r32, hi); MASKT(pA0, pA1, 0); partialSM<DQK>(pA0, pA1, m_reg, mnA, alA);
  SLOAD(SO, 1); if constexpr (SDEPTH == 2) { if (2 < NT) SLOAD(SE, 2); }
  SWAIT(); SWRITE(1, SO); __syncthreads();
  for (int j = 1; j + 1 < NT; j += 2) {
    SBAR(); qkt<DQK>(pB0, pB1, K_lds + SHM_K, qr, qx, r32, hi); MASKT(pB0, pB1, j);
    finishSM(pA0, pA1, alA, l_reg, pa0, pa1, pa2, pa3); SBAR();
    SLOAD(SO, j + SDEPTH); SBAR();
    pv_d0(o, vb0, pa0, pa1, pa2, pa3); partialSM<DQK>(pB0, pB1, m_reg, mnB, alB);
    __syncthreads(); SWAIT(); SWRITE(0, SE);
    RESC(alB); __syncthreads();
    SBAR(); qkt<DQK>(pA0, pA1, K_lds, qr, qx, r32, hi); MASKT(pA0, pA1, j + 1);
    finishSM(pB0, pB1, alB, l_reg, pa0, pa1, pa2, pa3); SBAR();
    if (SDEPTH == 1 || j + 3 < NT) SLOAD(SE, j + 1 + SDEPTH); SBAR();
    pv_d0(o, vb0 + SHM_V, pa0, pa1, pa2, pa3); partialSM<DQK>(pA0, pA1, m_reg, mnA, alA);
    __syncthreads(); SWAIT(); SWRITE(1, SO);
    RESC(alA); __syncthreads();
  }
  SBAR(); qkt<DQK>(pB0, pB1, K_lds + SHM_K, qr, qx, r32, hi); MASKT(pB0, pB1, NT - 1);
  finishSM(pA0, pA1, alA, l_reg, pa0, pa1, pa2, pa3); SBAR();
  pv_d0(o, vb0, pa0, pa1, pa2, pa3); partialSM<DQK>(pB0, pB1, m_reg, mnB, alB);
  __syncthreads(); RESC(alB);
  finishSM(pB0, pB1, alB, l_reg, pa0, pa1, pa2, pa3); SBAR();
  pv_d0(o, vb0 + SHM_V, pa0, pa1, pa2, pa3);
  if constexpr (SINK) l_reg += __builtin_amdgcn_exp2f(sink_l2 - m_reg * C);
  if (hi == 0) li_l[r32] = l_reg; asm volatile("s_waitcnt lgkmcnt(0)" ::: "memory");
  float rli[16];
#pragma unroll
  for (int r = 0; r < 16; ++r) rli[r] = __builtin_amdgcn_rcpf(li_l[crow(r, hi)]);
  __syncthreads();
  LAS bf16* ost = (LAS bf16*)(lds + wid * 8704);
#pragma unroll
  for (int r = 0; r < 16; ++r) { const int orow = crow(r, hi);
#pragma unroll
    for (int d0 = 0; d0 < 4; ++d0) ost[orow * 136 + d0 * 32 + r32] = (bf16)f2bf(o[d0][r] * rli[r]); }
  asm volatile("s_waitcnt lgkmcnt(0)" ::: "memory");
#pragma unroll
  for (int i = 0; i < 8; ++i) { const int orow = i * 4 + (lane >> 4), ch = lane & 15;
    *(GAS v4u*)(Ow + (size_t)orow * 4096 + ch * 8) = *(const LAS v4u*)(ost + orow * 136 + ch * 8); }
  __syncthreads();
#undef SLOAD
#undef SWRITE
#undef SWAIT
#undef RESC
#undef MASKT
}
}

struct Args { const float* in[38]; float* out; unsigned char* ws; };
template <class T> __device__ __forceinline__ T launder(T p) { asm volatile("" : "+s"(p)); return p; }
template <class T> __device__ __forceinline__ T* launder_g(T* p) { asm volatile("" : "+s"(p)); return p; }
struct Frame {
    LAS unsigned char* lds;
    gu32* ctl;
    int tid, lane, wave;
    int vcu, G, gw, NGW;
    const __attribute__((address_space(4))) Args* A;
    float* out;
    unsigned char* ws;
    unsigned char* wsw;
};
enum { I_X = 0, I_C, I_CTX, I_CCTX, I_WMOD, I_BMOD, I_WIN, I_WOUT, I_LN1G, I_LN1B, I_WFF1, I_WFF2, I_LN2G, I_LN2B, I_SINK, I_CONVW, I_CONVB, I_LWA, I_LBA, I_LWI, I_LBI, I_LAM,
       I_QNORM, I_KVNORM, I_WQB, I_WKVB, I_MUP, I_MUN, I_W0, I_W2, I_A0, I_A2, I_G2, I_KK, I_KA, I_RK, I_LNG, I_LNB };
__device__ __forceinline__ int row_s(int row) { return row < SEQ ? 0 : (row < M_LAT ? 1 : 2); }
__device__ __forceinline__ const float* mod_ptr(const Frame& F, int l, int s, int chunk) { return (const float*)(F.ws + WS_MOD) + ((size_t)(l * 3 + s) * 6 + chunk) * DM; }

__device__ __forceinline__ void transpose_item(const float* W, int N, int Kvalid, bf16* WT, int ldt, const float* kscale, LAS float* scr, int k0, int n0, int lane) {
#pragma unroll
    for (int i = 0; i < 32; ++i) { const int kk = 2 * i + (lane >> 5); const int k = k0 + kk; float v = 0.f;
        if (k < Kvalid) { v = W[(size_t)k * N + n0 + (lane & 31)]; if (kscale) v *= kscale[k]; }
        scr[kk * 33 + (lane & 31)] = v; }
    LDS_WAIT(); asm volatile("" ::: "memory");
    const int c = lane & 7;
#pragma unroll
    for (int j = 0; j < 4; ++j) { const int n = (lane >> 3) + 8 * j; const LAS float* s = scr + (8 * c) * 33 + n;
        v4u o; o.x = pk2(s[0 * 33], s[1 * 33]); o.y = pk2(s[2 * 33], s[3 * 33]); o.z = pk2(s[4 * 33], s[5 * 33]); o.w = pk2(s[6 * 33], s[7 * 33]);
        *(v4u*)(WT + (size_t)(n0 + n) * ldt + k0 + 8 * c) = o; }
    LDS_WAIT(); asm volatile("" ::: "memory");
}
__device__ __forceinline__ void convert_weights(Frame& F, int l, int widx, int nw) {
    LAS float* scr = (LAS float*)(F.lds + F.wave * 16384);
    constexpr int I1 = 64 * 271, I2 = 64 * 128, I3 = 64 * 512, I4 = 256 * 128, I5 = 16 * 48, I6 = 8 * 64, I7 = 32 * 8, I8 = 2 * 32, I9 = 2 * 32, I10 = 3 * 32;
    constexpr int NIT = I1 + I2 + I3 + I4 + I5 + I6 + I7 + I8 + I9 + I10;
    unsigned char* ws = F.ws + (l ? WSET_STRIDE : 0);
    for (int it = widx; it < NIT; it += nw) {
        int r = it;
        if (r < I1) { transpose_item(F.A->in[I_WIN] + (size_t)l * DM * DIN, DIN, DM, (bf16*)(ws + WS_WIN), DM, nullptr, scr, 64 * (r / 271), 32 * (r % 271), F.lane); continue; } r -= I1;
        if (r < I2) { transpose_item(F.A->in[I_WOUT] + (size_t)l * DM * DM, DM, DM, (bf16*)(ws + WS_WOUT), DM, nullptr, scr, 64 * (r / 128), 32 * (r % 128), F.lane); continue; } r -= I2;
        if (r < I3) { transpose_item(F.A->in[I_WFF1] + (size_t)l * DM * DFF, DFF, DM, (bf16*)(ws + WS_WFF1), DM, nullptr, scr, 64 * (r / 512), 32 * (r % 512), F.lane); continue; } r -= I3;
        if (r < I4) { transpose_item(F.A->in[I_WFF2] + (size_t)l * DFF * DM, DM, DFF, (bf16*)(ws + WS_WFF2), DFF, nullptr, scr, 64 * (r / 128), 32 * (r % 128), F.lane); continue; } r -= I4;
        if (r < I5) { transpose_item(F.A->in[I_WQB] + (size_t)l * 1024 * 1536, 1536, 1024, (bf16*)(ws + WS_WQB), 1024, F.A->in[I_QNORM] + l * 1024, scr, 64 * (r / 48), 32 * (r % 48), F.lane); continue; } r -= I5;
        if (r < I6) { transpose_item(F.A->in[I_WKVB] + (size_t)l * 512 * 2048, 2048, 512, (bf16*)(ws + WS_WKVB), 512, F.A->in[I_KVNORM] + l * 512, scr, 64 * (r / 64), 32 * (r % 64), F.lane); continue; } r -= I6;
        if (r < I7) { const int mat = r >> 3, sub = r & 7, gate = mat & 1, dn = mat >> 1;
            const int d = dn >> 3, n = dn & 7;
            const float* src = (gate ? F.A->in[I_LWI] : F.A->in[I_LWA]) + ((size_t)(l * 2 + d) * 8 + n) * 128 * 128;
            bf16* dst = (bf16*)(ws + WS_WLRU) + ((size_t)(d * 2 + gate) * 8 + n) * 128 * 128;
            transpose_item(src, 128, 128, dst, 128, nullptr, scr, 64 * (sub >> 2), 32 * (sub & 3), F.lane); continue; } r -= I7;
        if (r < I8) { const int d = r >> 5; transpose_item(F.A->in[I_W2] + (size_t)(l * 2 + d) * 64 * 1024, 1024, 64, (bf16*)(ws + WS_W2T) + (size_t)d * 1024 * 64, 64, nullptr, scr, 0, 32 * (r & 31), F.lane); continue; } r -= I8;
        if (r < I9) { const int d = r >> 5; transpose_item(F.A->in[I_A2] + (size_t)(l * 2 + d) * 64 * 1024, 1024, 64, (bf16*)(ws + WS_A2T) + (size_t)d * 1024 * 64, 64, nullptr, scr, 0, 32 * (r & 31), F.lane); continue; } r -= I9;
        transpose_item(F.A->in[I_G2] + (size_t)l * 160 * 1024, 1024, 160, (bf16*)(ws + WS_G2T), 192, nullptr, scr, 64 * (r / 32), 32 * (r % 32), F.lane);
    }
    { unsigned zz = 0u; asm volatile("" : "+v"(zz)); v4u z = {zz, zz, zz, zz}; v4u* p = (v4u*)((bf16*)(ws + WS_WIN) + (size_t)DIN * DM);
      for (int i = widx * 64 + F.lane; i < 32 * DM / 8; i += nw * 64) p[i] = z; }
}

__device__ __forceinline__ void mod_partials(Frame& F) {
    LAS float* sl = (LAS float*)F.lds;
    for (int it = F.vcu; it < 2 * 32 * 12; it += F.G) {
        const int l = it / 384, ks = (it / 12) % 32, cc = it % 12;
        __syncthreads();
        if (F.tid < 384) { const int s = F.tid >> 7, k = ks * 128 + (F.tid & 127); const float c = s < 2 ? F.A->in[I_C][s * DM + k] : F.A->in[I_CCTX][k]; sl[F.tid] = c / (1.f + __expf(-c)); }
        __syncthreads();
        const float* wp = F.A->in[I_WMOD] + ((size_t)l * DM + ks * 128) * 24576 + cc * 2048 + F.tid * 4;
        f32x4 a0 = {0.f, 0.f, 0.f, 0.f}, a1 = a0, a2 = a0;
#pragma unroll 8
        for (int k = 0; k < 128; ++k) { const f32x4 w = *(const f32x4*)(wp + (size_t)k * 24576); a0 += w * sl[k]; a1 += w * sl[128 + k]; a2 += w * sl[256 + k]; }
        float* op = (float*)(F.ws + WS_MODP) + ((size_t)(l * 32 + ks) * 3) * 24576 + cc * 2048 + F.tid * 4;
        *(f32x4*)(op) = a0; *(f32x4*)(op + 24576) = a1; *(f32x4*)(op + 2 * 24576) = a2;
    }
    __syncthreads();
}
__device__ __forceinline__ void mod_reduce(Frame& F) {
    for (int i = F.vcu * NTHR + F.tid; i < 2 * 3 * 24576; i += F.G * NTHR) {
        const int l = i / (3 * 24576), s = (i / 24576) % 3, n = i % 24576;
        float a = F.A->in[I_BMOD][l * 24576 + n];
        const float* pp = (const float*)(F.ws + WS_MODP) + ((size_t)(l * 32) * 3 + s) * 24576 + n;
#pragma unroll 8
        for (int ks = 0; ks < 32; ++ks) a += pp[(size_t)ks * 3 * 24576];
        ((float*)(F.ws + WS_MOD))[i] = a;
    }
}

__device__ __forceinline__ void sum_partials_row(const Frame& F, const float* yp, size_t stride, bf16* ydst) {
    int lane = F.lane; asm volatile("" : "+v"(lane));
#pragma unroll 2
    for (int j = 0; j < 16; ++j) { const int c = 4 * lane + 256 * j; f32x4 y = *(const f32x4*)(yp + c);
#pragma unroll
        for (int sp = 1; sp < 8; ++sp) y += *(const f32x4*)(yp + sp * stride + c);
        v2u w; w.x = pk2(y.x, y.y); w.y = pk2(y.z, y.w); *(v2u*)(ydst + c) = w; }
}
template <int MODE>
__device__ __forceinline__ void ln_row(const Frame& F, const float* xsrc, const bf16* Y, const float* ga, const float* lg, const float* lb, float* xdst,
                                       bool domod, const float* sc, const float* sh, bf16* hrow) {
    f32x4 v[16]; float s = 0.f;
#pragma unroll
    for (int j = 0; j < 16; ++j) { const int c = 4 * F.lane + 256 * j; v[j] = *(const f32x4*)(xsrc + c);
        if (MODE == 1) { const v2u yw = *(const v2u*)(Y + c); const f32x4 y = {bflo(yw.x), bfhi(yw.x), bflo(yw.y), bfhi(yw.y)}, g = *(const f32x4*)(ga + c); v[j] = v[j] * ALPHA + g * y; }
        s += (v[j].x + v[j].y) + (v[j].z + v[j].w);
        if ((j & 7) == 7) asm volatile("" ::: "memory"); }
    float mean = wave_sum(s) * (1.f / DM), s2 = 0.f;
#pragma unroll
    for (int j = 0; j < 16; ++j) { v[j] = v[j] - mean; s2 += (v[j].x * v[j].x + v[j].y * v[j].y) + (v[j].z * v[j].z + v[j].w * v[j].w); }
    float rstd = 1.f / sqrtf(wave_sum(s2) * (1.f / DM) + LN_EPS);
    if (MODE == 1) {
        s = 0.f;
#pragma unroll
        for (int j = 0; j < 16; ++j) { const int c = 4 * F.lane + 256 * j; const f32x4 g = *(const f32x4*)(lg + c), b = *(const f32x4*)(lb + c); v[j] = v[j] * rstd * g + b;
            *(f32x4*)(xdst + c) = v[j]; s += (v[j].x + v[j].y) + (v[j].z + v[j].w);
            if ((j & 7) == 7) asm volatile("" ::: "memory"); }
        if (!domod) return;
        mean = wave_sum(s) * (1.f / DM); s2 = 0.f;
#pragma unroll
        for (int j = 0; j < 16; ++j) { v[j] = v[j] - mean; s2 += (v[j].x * v[j].x + v[j].y * v[j].y) + (v[j].z * v[j].z + v[j].w * v[j].w); }
        rstd = 1.f / sqrtf(wave_sum(s2) * (1.f / DM) + LN_EPS);
    }
#pragma unroll
    for (int j = 0; j < 16; ++j) { const int c = 4 * F.lane + 256 * j; const f32x4 a = *(const f32x4*)(sc + c), b = *(const f32x4*)(sh + c);
        const f32x4 o = v[j] * rstd * (a + 1.f) + b; v2u w; w.x = pk2(o.x, o.y); w.y = pk2(o.z, o.w); *(v2u*)(hrow + c) = w; }
}

__device__ __forceinline__ void shift4(const bf16* P, unsigned eo, bool hp, bool hn, const float* mup, const float* mun, unsigned mo, float (&u)[4]) {
    const v2u xc = ldg<v2u>(P, eo * 2u); v2u xp = {0u, 0u}, xn = {0u, 0u};
    if (hp) xp = ldg<v2u>(P, (eo - DINP) * 2u); if (hn) xn = ldg<v2u>(P, (eo + DINP) * 2u);
    const f32x4 mp = ldg<f32x4>(mup, mo * 4u), mn = ldg<f32x4>(mun, mo * 4u);
    const float c[4] = {bflo(xc.x), bfhi(xc.x), bflo(xc.y), bfhi(xc.y)}, p[4] = {bflo(xp.x), bfhi(xp.x), bflo(xp.y), bfhi(xp.y)}, n[4] = {bflo(xn.x), bfhi(xn.x), bflo(xn.y), bfhi(xn.y)};
#pragma unroll
    for (int e = 0; e < 4; ++e) u[e] = c[e] + mp[e] * (p[e] - c[e]) + mn[e] * (n[e] - c[e]);
}
__device__ __forceinline__ void st4bf(void* base, unsigned eo, float a, float b, float c, float d) { v2u w; w.x = pk2(a, b); w.y = pk2(c, d); stg<v2u>(base, eo * 2u, w); }

__device__ __forceinline__ void rwkv_feat_item(Frame& F, int l, int item) {
    F.tid = ltid(); F.lane = F.tid & 63;
    int row0, seq_lo, seq_hi;
    if (item < 16) { const int b = item >> 3; seq_lo = M_LAT + b * NCTX; seq_hi = seq_lo + NCTX; row0 = seq_lo + (item & 7) * 32; }
    else { const int it = item - 16, b = it >> 8; seq_lo = b * SEQ; seq_hi = seq_lo + SEQ; row0 = seq_lo + (it & 255) * 32; }
    const bf16* P = (const bf16*)(F.ws + WS_P);
    LAS bf16* ACT = (LAS bf16*)F.lds;
    const float* mup = F.A->in[I_MUP] + l * RWC; const float* mun = F.A->in[I_MUN] + l * RWC;
    __syncthreads();
    { const int tok = F.tid >> 4, jc = F.tid & 15, row = row0 + tok; const bool hp = row > seq_lo, hn = row + 1 < seq_hi;
      const bf16* pr = P + (size_t)row * DINP + C_RWL;
#pragma unroll
      for (int i = 0; i < 13; ++i) { const int j = jc * 2 + 32 * i;
          const unsigned xc = *(const unsigned*)(pr + j), xp = hp ? *(const unsigned*)(pr - DINP + j) : 0u, xn = hn ? *(const unsigned*)(pr + DINP + j) : 0u;
          float u[2];
#pragma unroll
          for (int e = 0; e < 2; ++e) { const float c = e ? bfhi(xc) : bflo(xc), p = e ? bfhi(xp) : bflo(xp), n = e ? bfhi(xn) : bflo(xn);
              float v = c + mup[3072 + j + e] * (p - c) + mun[3072 + j + e] * (n - c);
              if (j < 128) v = tanhf_(v); else if (j >= 256) v = sigmoidf_(v);
              u[e] = v; }
          *(LAS unsigned*)(ACT + tok * 424 + j) = pk2(u[0], u[1]); } }
    __syncthreads();
    const int tok = F.lane & 31, hi = F.lane >> 5, row = row0 + tok;
    const bf16* W2T = (const bf16*)(F.wsw + WS_W2T); const bf16* A2T = (const bf16*)(F.wsw + WS_A2T); const bf16* G2T = (const bf16*)(F.wsw + WS_G2T);
    bf16* RWF = (bf16*)(F.ws + WS_RWF); const size_t RS = (size_t)M_TOT * 1024;
    const float* kkv = F.A->in[I_KK] + l * 1024; const float* kav = F.A->in[I_KA] + l * 1024; const float* rkv = F.A->in[I_RK] + l * 1024;
    const float* w0f = F.A->in[I_W0] + (size_t)(l * 2) * 1024; const float* a0f = F.A->in[I_A0] + (size_t)(l * 2) * 1024;
    const LAS bf16* actl = ACT + tok * 424 + hi * 8;
    LAS unsigned char* TI = F.lds + 27136 + F.wave * 10752; LAS unsigned char* TO = TI + 3 * 2720;
#define RF_LOADTILE(ti, colbase) do { _Pragma("unroll") for (int i_ = 0; i_ < 3; ++i_) { const int p_ = F.lane + 64 * i_; if (p_ < 136) { const int rr_ = p_ >> 2, cp_ = p_ & 3, gr_ = row0 - 1 + rr_; \
        v4u v_ = {0u, 0u, 0u, 0u}; if (gr_ >= seq_lo && gr_ < seq_hi) v_ = ldg<v4u>(P, ((unsigned)gr_ * DINP + (colbase) + 8 * cp_) * 2u); *(LAS v4u*)(TI + (ti) * 2720 + rr_ * 80 + cp_ * 16) = v_; } } } while (0)
#define RF_SHIFT4(ti, g_, mo_, u_) do { const LAS unsigned char* q_ = TI + (ti) * 2720 + (tok + 1) * 80 + (8 * (g_) + 4 * hi) * 2; const v2u xc_ = *(const LAS v2u*)q_, xp_ = *(const LAS v2u*)(q_ - 80), xn_ = *(const LAS v2u*)(q_ + 80); \
        const f32x4 mp_ = ldg<f32x4>(mup, (mo_) * 4u), mn_ = ldg<f32x4>(mun, (mo_) * 4u); \
        const float c_[4] = {bflo(xc_.x), bfhi(xc_.x), bflo(xc_.y), bfhi(xc_.y)}, pp_[4] = {bflo(xp_.x), bfhi(xp_.x), bflo(xp_.y), bfhi(xp_.y)}, nn_[4] = {bflo(xn_.x), bfhi(xn_.x), bflo(xn_.y), bfhi(xn_.y)}; \
        _Pragma("unroll") for (int e_ = 0; e_ < 4; ++e_) u_[e_] = c_[e_] + mp_[e_] * (pp_[e_] - c_[e_]) + mn_[e_] * (nn_[e_] - c_[e_]); } while (0)
#define RF_FLUSH(arr_, cblk_, o_) do { _Pragma("unroll") for (int g_ = 0; g_ < 4; ++g_) *(LAS v2u*)(TO + tok * 80 + (8 * g_ + 4 * hi) * 2) = o_[g_]; \
        asm volatile("s_waitcnt lgkmcnt(0)" ::: "memory"); \
        _Pragma("unroll") for (int i_ = 0; i_ < 2; ++i_) { const int p_ = F.lane + 64 * i_, rr_ = p_ >> 2, cp_ = p_ & 3; const v4u v_ = *(const LAS v4u*)(TO + rr_ * 80 + cp_ * 16); \
            stg<v4u>(RWF + (arr_) * RS, ((unsigned)(row0 + rr_) * 1024u + (cblk_) + 8 * cp_) * 2u, v_); } \
        asm volatile("s_waitcnt lgkmcnt(0)" ::: "memory"); } while (0)
#pragma unroll 1
    for (int hh = 0; hh < 2; ++hh) {
        const int h = 2 * F.wave + hh, cbase = h * 64;
        float ssq = 0.f;
        RF_LOADTILE(0, C_RWK + cbase); RF_LOADTILE(1, C_RWK + cbase + 32);
        asm volatile("s_waitcnt lgkmcnt(0)" ::: "memory");
#pragma unroll
        for (int bg = 0; bg < 8; ++bg) { const unsigned c4 = cbase + (bg >> 2) * 32 + 8 * (bg & 3) + 4 * hi; float uk[4];
            RF_SHIFT4(bg >> 2, bg & 3, 1024 + c4, uk); const f32x4 k4 = ldg<f32x4>(kkv, c4 * 4u);
#pragma unroll
            for (int e = 0; e < 4; ++e) { const float q = uk[e] * k4[e]; ssq += q * q; } }
        ssq = half_swap_sum(ssq);
        const float rn = 1.f / fmaxf(sqrtf(ssq), 1e-12f);
        float sb = 0.f;
#pragma unroll 1
        for (int blk = 0; blk < 2; ++blk) {
            const unsigned cblk = cbase + blk * 32, cha = cblk + tok;
            RF_LOADTILE(0, C_RWR + cblk); RF_LOADTILE(1, C_RWK + cblk); RF_LOADTILE(2, C_RWV + cblk);
#pragma unroll 1
            for (int d = 0; d < 2; ++d) { f32x16 aw = {};
#pragma unroll
                for (int ks = 0; ks < 4; ++ks) { const bf16x8 bw = *(const LAS bf16x8*)(actl + d * 64 + ks * 16); const bf16x8 w_ = ldg<bf16x8>(W2T, ((d * 1024 + cha) * 64 + ks * 16 + hi * 8) * 2u);
                    aw = __builtin_amdgcn_mfma_f32_32x32x16_bf16(w_, bw, aw, 0, 0, 0); }
                v2u o[4];
#pragma unroll
                for (int g = 0; g < 4; ++g) { const f32x4 w0 = ldg<f32x4>(w0f, (d * 1024 + cblk + 8 * g + 4 * hi) * 4u); float e4[4];
#pragma unroll
                    for (int e = 0; e < 4; ++e) e4[e] = __expf(-softplusf_(-(w0[e] + aw[4 * g + e])) - 0.5f);
                    o[g].x = pk2(e4[0], e4[1]); o[g].y = pk2(e4[2], e4[3]); }
                RF_FLUSH(4 + d, cblk, o); }
            { f32x16 ag = {};
#pragma unroll
              for (int ks = 0; ks < 10; ++ks) { const bf16x8 bg_ = *(const LAS bf16x8*)(actl + 256 + ks * 16); const bf16x8 g_ = ldg<bf16x8>(G2T, (cha * 192 + ks * 16 + hi * 8) * 2u);
                  ag = __builtin_amdgcn_mfma_f32_32x32x16_bf16(g_, bg_, ag, 0, 0, 0); }
              v2u o[4];
#pragma unroll
              for (int g = 0; g < 4; ++g) { o[g].x = pk2(ag[4 * g], ag[4 * g + 1]); o[g].y = pk2(ag[4 * g + 2], ag[4 * g + 3]); }
              RF_FLUSH(8, cblk, o); }
            { f32x16 aaf = {}, aab = {};
#pragma unroll
              for (int ks = 0; ks < 4; ++ks) { const bf16x8 baf = *(const LAS bf16x8*)(actl + 128 + ks * 16), bab = *(const LAS bf16x8*)(actl + 192 + ks * 16);
                  const bf16x8 a_f = ldg<bf16x8>(A2T, (cha * 64 + ks * 16 + hi * 8) * 2u), a_b = ldg<bf16x8>(A2T, ((1024 + cha) * 64 + ks * 16 + hi * 8) * 2u);
                  aaf = __builtin_amdgcn_mfma_f32_32x32x16_bf16(a_f, baf, aaf, 0, 0, 0); aab = __builtin_amdgcn_mfma_f32_32x32x16_bf16(a_b, bab, aab, 0, 0, 0); }
              v2u oR[4], oK[4], oV[4], oKK[4], oAF[4], oAB[4];
#pragma unroll
              for (int g = 0; g < 4; ++g) { const unsigned c4 = cblk + 8 * g + 4 * hi; float ur[4], uk[4], uv[4];
                  RF_SHIFT4(0, g, c4, ur); RF_SHIFT4(1, g, 1024 + c4, uk); RF_SHIFT4(2, g, 2048 + c4, uv);
                  const f32x4 a0a = ldg<f32x4>(a0f, c4 * 4u), a0b = ldg<f32x4>(a0f, (1024 + c4) * 4u), kk4 = ldg<f32x4>(kkv, c4 * 4u), ka4 = ldg<f32x4>(kav, c4 * 4u), rk4 = ldg<f32x4>(rkv, c4 * 4u);
                  float af[4], ab[4], kk[4];
#pragma unroll
                  for (int e = 0; e < 4; ++e) { const int r = 4 * g + e;
                      af[e] = sigmoidf_(a0a[e] + aaf[r]); ab[e] = sigmoidf_(a0b[e] + aab[r]); kk[e] = uk[e] * kk4[e] * rn;
                      const float kdf = uk[e] * (1.f + (af[e] - 1.f) * ka4[e]), kdb = uk[e] * (1.f + (ab[e] - 1.f) * ka4[e]);
                      sb += ur[e] * rk4[e] * (kdf + kdb); }
                  oR[g].x = pk2(ur[0], ur[1]); oR[g].y = pk2(ur[2], ur[3]); oK[g].x = pk2(uk[0], uk[1]); oK[g].y = pk2(uk[2], uk[3]); oV[g].x = pk2(uv[0], uv[1]); oV[g].y = pk2(uv[2], uv[3]);
                  oKK[g].x = pk2(kk[0], kk[1]); oKK[g].y = pk2(kk[2], kk[3]); oAF[g].x = pk2(af[0], af[1]); oAF[g].y = pk2(af[2], af[3]); oAB[g].x = pk2(ab[0], ab[1]); oAB[g].y = pk2(ab[2], ab[3]); }
              RF_FLUSH(0, cblk, oR); RF_FLUSH(1, cblk, oK); RF_FLUSH(2, cblk, oV); RF_FLUSH(3, cblk, oKK); RF_FLUSH(6, cblk, oAF); RF_FLUSH(7, cblk, oAB); }
        }
        sb = half_swap_sum(sb);
        if (hi == 0) ((float*)(F.ws + WS_SB))[(size_t)row * 16 + h] = sb;
    }
#undef RF_LOADTILE
#undef RF_SHIFT4
#undef RF_FLUSH
}

__device__ __forceinline__ float gelu_tanh(float x) { return 0.5f * x * (1.f + tanhf(0.7978845608028654f * (x + 0.044715f * x * x * x))); }
template <bool PASS3>
__device__ __forceinline__ void lru_item(Frame& F, int l, int item) {
    F.tid = ltid(); F.lane = F.tid & 63;
    const int sc = item >> 3, nb = item & 7, b = sc / NCH, ch = sc % NCH;
    int row0, seq_lo, seq_hi;
    if (ch < 8) { seq_lo = M_LAT + b * NCTX; seq_hi = seq_lo + NCTX; row0 = seq_lo + ch * 32; }
    else { seq_lo = b * SEQ; seq_hi = seq_lo + SEQ; row0 = seq_lo + (ch - 8) * 32; }
    const bf16* P = (const bf16*)(F.ws + WS_P);
    LAS float* U = (LAS float*)F.lds;
    LAS bf16* UA = (LAS bf16*)(F.lds + 16384);
    LAS float* AB = (LAS float*)(F.lds + 32768);
    __syncthreads();
    { const int tok = F.tid >> 4, c8 = (F.tid & 15) * 8, cg = nb * 128 + c8; float acc[8];
      const float* cb = F.A->in[I_CONVB] + l * 1024 + cg;
#pragma unroll
      for (int e = 0; e < 8; ++e) acc[e] = cb[e];
#pragma unroll
      for (int j = 0; j < 4; ++j) { const int r = row0 + tok - 2 + j;
          if (r >= seq_lo && r < seq_hi) { const v4u x = *(const v4u*)(P + (size_t)r * DINP + C_LRUX + cg); const float* cw = F.A->in[I_CONVW] + (size_t)(l * 4 + j) * 1024 + cg;
#pragma unroll
              for (int w = 0; w < 4; ++w) { acc[2 * w] += cw[2 * w] * bflo(x[w]); acc[2 * w + 1] += cw[2 * w + 1] * bfhi(x[w]); } } }
      *(LAS f32x4*)(U + tok * 128 + c8) = (f32x4){acc[0], acc[1], acc[2], acc[3]}; *(LAS f32x4*)(U + tok * 128 + c8 + 4) = (f32x4){acc[4], acc[5], acc[6], acc[7]};
      v4u o; o.x = pk2(acc[0], acc[1]); o.y = pk2(acc[2], acc[3]); o.z = pk2(acc[4], acc[5]); o.w = pk2(acc[6], acc[7]);
      *(LAS v4u*)(UA + tok * 136 + c8) = o; }
    __syncthreads();
    { const int dir = F.wave >> 2, cq = F.wave & 3, l32 = F.lane & 31, hi = F.lane >> 5, chn = cq * 32 + l32, cg = nb * 128 + chn;
      const bf16* Wr = (const bf16*)(F.wsw + WS_WLRU) + ((size_t)(dir * 2 + 0) * 8 + nb) * 16384 + (size_t)chn * 128;
      const bf16* Wi = (const bf16*)(F.wsw + WS_WLRU) + ((size_t)(dir * 2 + 1) * 8 + nb) * 16384 + (size_t)chn * 128;
      f32x16 accr = {}, acci = {};
#pragma unroll
      for (int ks = 0; ks < 8; ++ks) { const int ko = ks * 16 + hi * 8;
          const bf16x8 a = *(const LAS bf16x8*)(UA + l32 * 136 + ko); const bf16x8 br = *(const bf16x8*)(Wr + ko), bi = *(const bf16x8*)(Wi + ko);
          accr = __builtin_amdgcn_mfma_f32_32x32x16_bf16(a, br, accr, 0, 0, 0); acci = __builtin_amdgcn_mfma_f32_32x32x16_bf16(a, bi, acci, 0, 0, 0); }
      const float ba = F.A->in[I_LBA][(l * 2 + dir) * 1024 + cg], bi_ = F.A->in[I_LBI][(l * 2 + dir) * 1024 + cg], sp = softplusf_(-F.A->in[I_LAM][(l * 2 + dir) * 1024 + cg]);
#pragma unroll
      for (int r = 0; r < 16; ++r) { const int tok = att::crow(r, hi); const float u = U[tok * 128 + chn];
          const float rg = sigmoidf_(accr[r] + ba), ig = sigmoidf_(acci[r] + bi_), la = -8.f * rg * sp, a = __expf(la), bc = sqrtf(-expm1f(2.f * la)) * (ig * u);
          AB[(dir * 2 + 0) * 4096 + tok * 128 + chn] = a; AB[(dir * 2 + 1) * 4096 + tok * 128 + chn] = bc; } }
    __syncthreads();
    if (F.tid < 256) { const int dir = F.tid >> 7, chn = F.tid & 127, cg = nb * 128 + chn; const size_t ci = ((size_t)(dir * 2 + b) * NCH + ch) * 1024 + cg;
        LAS float* Aa = AB + (dir * 2) * 4096 + chn; LAS float* Bb = AB + (dir * 2 + 1) * 4096 + chn;
        if (!PASS3) { float h = 0.f, ap = 1.f;
#pragma unroll 8
            for (int s = 0; s < 32; ++s) { const int tok = dir ? 31 - s : s; const float a = Aa[tok * 128]; h = a * h + Bb[tok * 128]; ap *= a;
                if (s == 0 && dir == 1 && ch == 7) ((float*)(F.ws + WS_QUIRK))[b * 1024 + cg] = h; }
            ((float*)(F.ws + WS_CA))[ci] = ap; ((float*)(F.ws + WS_CB))[ci] = h;
        } else { float h = ((const float*)(F.ws + WS_HIN))[ci];
#pragma unroll 8
            for (int s = 0; s < 32; ++s) { const int tok = dir ? 31 - s : s; h = Aa[tok * 128] * h + Bb[tok * 128]; Bb[tok * 128] = h; } } }
    if (PASS3) { __syncthreads();
        const int tok = F.tid >> 4, c8 = (F.tid & 15) * 8, cg = nb * 128 + c8, row = row0 + tok;
        const v4u y = *(const v4u*)(P + (size_t)row * DINP + C_LRUY + cg); float o[8];
#pragma unroll
        for (int w = 0; w < 4; ++w) { const float h0 = AB[4096 + tok * 128 + c8 + 2 * w] + AB[3 * 4096 + tok * 128 + c8 + 2 * w], h1 = AB[4096 + tok * 128 + c8 + 2 * w + 1] + AB[3 * 4096 + tok * 128 + c8 + 2 * w + 1];
            o[2 * w] = h0 * gelu_tanh(bflo(y[w])); o[2 * w + 1] = h1 * gelu_tanh(bfhi(y[w])); }
        v4u ov; ov.x = pk2(o[0], o[1]); ov.y = pk2(o[2], o[3]); ov.z = pk2(o[4], o[5]); ov.w = pk2(o[6], o[7]);
        *(v4u*)((bf16*)(F.ws + WS_MIX) + (size_t)row * DM + 1024 + cg) = ov; }
}
__device__ __forceinline__ void lru_carry(Frame& F) {
    F.tid = ltid(); F.lane = F.tid & 63;
    const int gid = F.vcu * NTHR + F.tid; if (gid >= 4096) return;
    const int dir = gid >> 11, b = (gid >> 10) & 1, cg = gid & 1023;
    const float* CA = (const float*)(F.ws + WS_CA) + ((size_t)(dir * 2 + b) * NCH) * 1024 + cg; const float* CB = (const float*)(F.ws + WS_CB) + ((size_t)(dir * 2 + b) * NCH) * 1024 + cg;
    float* HIN = (float*)(F.ws + WS_HIN) + ((size_t)(dir * 2 + b) * NCH) * 1024 + cg;
    float h = 0.f;
    if (dir == 0) {
#pragma unroll 8
        for (int c = 0; c < NCH; ++c) { HIN[(size_t)c * 1024] = h; h = CA[(size_t)c * 1024] * h + CB[(size_t)c * 1024]; }
    } else {
        for (int c = 7; c >= 0; --c) { HIN[(size_t)c * 1024] = h; h = CA[(size_t)c * 1024] * h + CB[(size_t)c * 1024]; }
        h = ((const float*)(F.ws + WS_QUIRK))[b * 1024 + cg];
#pragma unroll 8
        for (int c = NCH - 1; c >= 8; --c) { HIN[(size_t)c * 1024] = h; h = CA[(size_t)c * 1024] * h + CB[(size_t)c * 1024]; }
    }
}

__device__ __forceinline__ void rope_table(Frame& F) {
    const int i = F.vcu * NTHR + F.tid; if (i >= 2048) return;
    const int pos = i >> 4, f = i & 15; float s, c; sincosf((float)pos * exp2f(-(float)f * (13.287712379549449f / 16.f)), &s, &c);
    float* t = (float*)(F.ws + WS_ROPE); t[i] = c; t[2048 + i] = s;
}
__device__ __forceinline__ void row_prep(Frame& F, int row) {
    F.tid = ltid(); F.lane = F.tid & 63;
    bf16* pr = (bf16*)(F.ws + WS_P) + (size_t)row * DINP; const int lane = F.lane;
    const bool lat = row < M_LAT; const int t = row & (SEQ - 1); const float prow = (float)(t >> 6), pcol = (float)(t & 63);
    { const v4u a = *(const v4u*)(pr + C_QA + lane * 16), b = *(const v4u*)(pr + C_QA + lane * 16 + 8); float ss = 0.f;
#pragma unroll
      for (int w = 0; w < 4; ++w) { const float x0 = bflo(a[w]), x1 = bfhi(a[w]), x2 = bflo(b[w]), x3 = bfhi(b[w]); ss += x0 * x0 + x1 * x1 + x2 * x2 + x3 * x3; }
      ss = wave_sum(ss); if (lane == 0) ((float*)(F.ws + WS_RSQ))[row] = 1.f / sqrtf(ss * (1.f / 1024.f) + RMS_EPS); }
    { const v4u a = *(const v4u*)(pr + C_KVA + lane * 8); float ss = 0.f;
#pragma unroll
      for (int w = 0; w < 4; ++w) { const float x0 = bflo(a[w]), x1 = bfhi(a[w]); ss += x0 * x0 + x1 * x1; }
      ss = wave_sum(ss); if (lane == 0) ((float*)(F.ws + WS_RSKV))[row] = 1.f / sqrtf(ss * (1.f / 512.f) + RMS_EPS); }
    bf16* kr = (bf16*)(F.ws + WS_KR) + (size_t)row * 64;
    if (lat) {
        { const int part = lane >> 5, sub = lane & 31;
          const float inv = exp2f(-(float)sub * (13.287712379549449f / 32.f)); float sn, cs; sincosf((part ? pcol : prow) * inv, &sn, &cs);
#pragma unroll
          for (int hd = 0; hd < 10; ++hd) { bf16* qb = pr + (hd < 8 ? C_SWAQ + hd * 128 : C_SWAK + (hd - 8) * 128) + part * 64;
              const float x1 = bf2f(qb[sub]), x2 = bf2f(qb[sub + 32]); qb[sub] = (bf16)f2bf(x1 * cs - x2 * sn); qb[sub + 32] = (bf16)f2bf(x2 * cs + x1 * sn); } }
        if (lane < 32) { const int part = lane >> 4, i = lane & 15; const bf16* src = pr + C_KR + part * 32;
          const float inv = exp2f(-(float)i * (13.287712379549449f / 16.f)); float s, c; sincosf((part ? pcol : prow) * inv, &s, &c);
          const float x1 = bf2f(src[i]), x2 = bf2f(src[i + 16]);
          kr[part * 32 + i] = (bf16)f2bf(x1 * c - x2 * s); kr[part * 32 + i + 16] = (bf16)f2bf(x2 * c + x1 * s); }
    } else kr[lane] = pr[C_KR + lane];
}

__device__ __forceinline__ float allred16(float x) { return row_sum16(x); }
__device__ __forceinline__ int scan_row(int s, int dir, int b) {
    if (s < NCTX) return M_LAT + b * NCTX + (dir ? NCTX - 1 - s : s);
    const int t = s - NCTX; return b * SEQ + (dir ? SEQ - 1 - t : t);
}
__device__ __forceinline__ void rwkv_scan(Frame& F, int l, int chain) {
    F.tid = ltid(); F.lane = F.tid & 63;
    const int dir = chain >> 5, b = (chain >> 4) & 1, h = chain & 15;
    constexpr int CT = 16, NCHK = (NCTX + SEQ) / CT, STEPF = 392, BUFF = CT * STEPF;
    LAS float* buf = (LAS float*)F.lds; LAS float* ybuf = (LAS float*)(F.lds + 3 * BUFF * 4);
    gcbf RWF = (gcbf)(F.ws + WS_RWF); const size_t RS = (size_t)M_TOT * 1024;
    gflp YS = (gflp)(F.ws + WS_YS) + (size_t)dir * M_TOT * 1024;
    const bool ldr = F.tid < 256; const int lst = (F.tid >> 4) & 15, lq = F.tid & 15, lc = h * 64 + 4 * lq;
    const f32x4 ka4 = *(const GAS f32x4*)((gcfl)F.A->in[I_KA] + l * 1024 + lc);
    v2u gr = {0u, 0u}, gk = gr, gv = gr, gkk = gr, ge = gr, ga = gr;
#define RW_LOAD(c) do { if (ldr) { const size_t o_ = (size_t)scan_row((c) * CT + lst, dir, b) * 1024 + lc; gr = *(const GAS v2u*)(RWF + 0 * RS + o_); gk = *(const GAS v2u*)(RWF + 1 * RS + o_); gv = *(const GAS v2u*)(RWF + 2 * RS + o_); \
        gkk = *(const GAS v2u*)(RWF + 3 * RS + o_); ge = *(const GAS v2u*)(RWF + (4 + dir) * RS + o_); ga = *(const GAS v2u*)(RWF + (6 + dir) * RS + o_); } } while (0)
#define RW_WRITE(bi) do { if (ldr) { LAS float* d_ = buf + (bi) * BUFF + lst * STEPF + 4 * lq; \
        const float r_[4] = {bflo(gr.x), bfhi(gr.x), bflo(gr.y), bfhi(gr.y)}, k_[4] = {bflo(gk.x), bfhi(gk.x), bflo(gk.y), bfhi(gk.y)}, v_[4] = {bflo(gv.x), bfhi(gv.x), bflo(gv.y), bfhi(gv.y)}; \
        const float q_[4] = {bflo(gkk.x), bfhi(gkk.x), bflo(gkk.y), bfhi(gkk.y)}, e_[4] = {bflo(ge.x), bfhi(ge.x), bflo(ge.y), bfhi(ge.y)}, a_[4] = {bflo(ga.x), bfhi(ga.x), bflo(ga.y), bfhi(ga.y)}; \
        f32x4 w4, kd4, kk4, b4, wr4, v4; float sbr = 0.f, skr = 0.f; \
        _Pragma("unroll") for (int e = 0; e < 4; ++e) { w4[e] = __expf(-e_[e]); kd4[e] = k_[e] * (1.f + (a_[e] - 1.f) * ka4[e]); kk4[e] = q_[e]; b4[e] = q_[e] * a_[e]; wr4[e] = w4[e] * r_[e]; v4[e] = v_[e]; sbr += b4[e] * r_[e]; skr += kd4[e] * r_[e]; } \
        sbr = row_sum16(sbr); skr = row_sum16(skr); \
        *(LAS f32x4*)(d_) = w4; *(LAS f32x4*)(d_ + 64) = kd4; *(LAS f32x4*)(d_ + 128) = kk4; *(LAS f32x4*)(d_ + 192) = b4; *(LAS f32x4*)(d_ + 256) = wr4; *(LAS f32x4*)(d_ + 320) = v4; \
        if (lq == 0) *(LAS f32x2*)(buf + (bi) * BUFF + lst * STEPF + 384) = (f32x2){sbr, skr}; } } while (0)
#define RW_FLUSH(c) do { if (ldr) { const f32x4 y_ = *(const LAS f32x4*)(ybuf + ((c) & 1) * (CT * 64) + lst * 64 + 4 * lq); *(GAS f32x4*)(YS + (size_t)scan_row((c) * CT + lst, dir, b) * 1024 + lc) = y_; } } while (0)
    __syncthreads();
    RW_LOAD(0); RW_WRITE(0); RW_LOAD(1); RW_WRITE(1); RW_LOAD(2);
    __syncthreads();
    const int kg = F.lane & 15, rg = F.lane >> 4, r0 = 8 * F.wave + 2 * rg;
    f32x2 St[4] = {{0.f, 0.f}, {0.f, 0.f}, {0.f, 0.f}, {0.f, 0.f}};
    int bc = 0, bw = 2;
#pragma unroll 1
    for (int c = 0; c < NCHK; ++c) {
        if (c + 2 < NCHK) { RW_WRITE(bw); if (c + 3 < NCHK) RW_LOAD(c + 3); }
        if (c > 0) RW_FLUSH(c - 1);
        const LAS float* bb = buf + bc * BUFF + 4 * kg; const LAS float* vb = buf + bc * BUFF + 320 + r0; const LAS float* sb = buf + bc * BUFF + 384;
        LAS float* yb = ybuf + (c & 1) * (CT * 64) + r0;
        f32x4 w4 = *(const LAS f32x4*)(bb), kd4 = *(const LAS f32x4*)(bb + 64), kk4 = *(const LAS f32x4*)(bb + 128), b4 = *(const LAS f32x4*)(bb + 192), wr4 = *(const LAS f32x4*)(bb + 256);
        f32x2 v2 = *(const LAS f32x2*)(vb), s2 = *(const LAS f32x2*)(sb);
#pragma unroll 4
        for (int st = 0; st < CT; ++st) {
            const int sn = (st + 1 < CT ? st + 1 : st) * STEPF;
            const f32x4 nw4 = *(const LAS f32x4*)(bb + sn), nkd4 = *(const LAS f32x4*)(bb + sn + 64), nkk4 = *(const LAS f32x4*)(bb + sn + 128), nb4 = *(const LAS f32x4*)(bb + sn + 192), nwr4 = *(const LAS f32x4*)(bb + sn + 256);
            const f32x2 nv2 = *(const LAS f32x2*)(vb + sn), ns2 = *(const LAS f32x2*)(sb + sn);
            f32x2 p = St[0] * kk4[0], z = St[0] * wr4[0];
            p = St[1] * kk4[1] + p; z = St[1] * wr4[1] + z; p = St[2] * kk4[2] + p; z = St[2] * wr4[2] + z; p = St[3] * kk4[3] + p; z = St[3] * wr4[3] + z;
            float p0 = p.x, p1 = p.y, z0 = z.x, z1 = z.y;
            asm volatile("s_nop 1\n\t"
                "v_add_f32_dpp %0, %0, %0 row_ror:8 row_mask:0xf bank_mask:0xf\n\tv_add_f32_dpp %1, %1, %1 row_ror:8 row_mask:0xf bank_mask:0xf\n\tv_add_f32_dpp %2, %2, %2 row_ror:8 row_mask:0xf bank_mask:0xf\n\tv_add_f32_dpp %3, %3, %3 row_ror:8 row_mask:0xf bank_mask:0xf\n\t"
                "v_add_f32_dpp %0, %0, %0 row_ror:4 row_mask:0xf bank_mask:0xf\n\tv_add_f32_dpp %1, %1, %1 row_ror:4 row_mask:0xf bank_mask:0xf\n\tv_add_f32_dpp %2, %2, %2 row_ror:4 row_mask:0xf bank_mask:0xf\n\tv_add_f32_dpp %3, %3, %3 row_ror:4 row_mask:0xf bank_mask:0xf\n\t"
                "v_add_f32_dpp %0, %0, %0 row_ror:2 row_mask:0xf bank_mask:0xf\n\tv_add_f32_dpp %1, %1, %1 row_ror:2 row_mask:0xf bank_mask:0xf\n\tv_add_f32_dpp %2, %2, %2 row_ror:2 row_mask:0xf bank_mask:0xf\n\tv_add_f32_dpp %3, %3, %3 row_ror:2 row_mask:0xf bank_mask:0xf\n\t"
                "v_add_f32_dpp %0, %0, %0 row_ror:1 row_mask:0xf bank_mask:0xf\n\tv_add_f32_dpp %1, %1, %1 row_ror:1 row_mask:0xf bank_mask:0xf\n\tv_add_f32_dpp %2, %2, %2 row_ror:1 row_mask:0xf bank_mask:0xf\n\tv_add_f32_dpp %3, %3, %3 row_ror:1 row_mask:0xf bank_mask:0xf\n\t"
                "s_nop 1"
                : "+v"(p0), "+v"(p1), "+v"(z0), "+v"(z1));
            const f32x2 pp = {p0, p1}, zz = {z0, z1};
            *(LAS f32x2*)(yb + st * 64) = zz - pp * s2.x + v2 * s2.y;
#pragma unroll
            for (int i = 0; i < 4; ++i) { const f32x2 vk = v2 * kd4[i]; St[i] = (St[i] * w4[i] + vk) - pp * b4[i]; }
            w4 = nw4; kd4 = nkd4; kk4 = nkk4; b4 = nb4; wr4 = nwr4; v2 = nv2; s2 = ns2;
        }
        __syncthreads();
        bc = bc == 2 ? 0 : bc + 1; bw = bw == 2 ? 0 : bw + 1;
    }
    RW_FLUSH(NCHK - 1);
#undef RW_LOAD
#undef RW_WRITE
#undef RW_FLUSH
}
__device__ __forceinline__ void rwkv_out_row(Frame& F, int l, int row) {
    F.tid = ltid(); F.lane = F.tid & 63;
    const int c0 = F.lane * 16; const float* yf = (const float*)(F.ws + WS_YS) + (size_t)row * 1024 + c0; const float* yb = yf + (size_t)M_TOT * 1024;
    float y[16]; float s = 0.f;
#pragma unroll
    for (int j = 0; j < 4; ++j) { const f32x4 a = *(const f32x4*)(yf + 4 * j), b = *(const f32x4*)(yb + 4 * j);
#pragma unroll
        for (int e = 0; e < 4; ++e) { y[4 * j + e] = a[e] + b[e]; s += y[4 * j + e]; } }
    s = quad_sum(s); const float mu = s * (1.f / 64.f); float q = 0.f;
#pragma unroll
    for (int e = 0; e < 16; ++e) { y[e] -= mu; q += y[e] * y[e]; }
    q = quad_sum(q); const float rstd = 1.f / sqrtf(q * (1.f / 64.f) + GN_EPS);
    const bf16* RWF = (const bf16*)(F.ws + WS_RWF); const size_t RS = (size_t)M_TOT * 1024, o = (size_t)row * 1024 + c0;
    const float sbv = ((const float*)(F.ws + WS_SB))[(size_t)row * 16 + (F.lane >> 2)];
    const float* lg = F.A->in[I_LNG] + l * 1024 + c0; const float* lb = F.A->in[I_LNB] + l * 1024 + c0;
    bf16* dst = (bf16*)(F.ws + WS_MIX) + (size_t)row * DM + 3072 + c0;
#pragma unroll
    for (int hf = 0; hf < 2; ++hf) { const v4u vv = *(const v4u*)(RWF + 2 * RS + o + 8 * hf), gg = *(const v4u*)(RWF + 8 * RS + o + 8 * hf); float r[8];
#pragma unroll
        for (int w = 0; w < 4; ++w) { const int e = 8 * hf + 2 * w;
            r[2 * w] = (y[e] * rstd * lg[e] + lb[e] + sbv * bflo(vv[w])) * bflo(gg[w]); r[2 * w + 1] = (y[e + 1] * rstd * lg[e + 1] + lb[e + 1] + sbv * bfhi(vv[w])) * bfhi(gg[w]); }
        v4u ov; ov.x = pk2(r[0], r[1]); ov.y = pk2(r[2], r[3]); ov.z = pk2(r[4], r[5]); ov.w = pk2(r[6], r[7]); *(v4u*)(dst + 8 * hf) = ov; }
}

struct MlaTiles { gcbf KV; gcbf KR; int ctx_row0, lat_row0, h;
    __device__ __forceinline__ att::Tile operator()(int j) const { const int row = j < 4 ? ctx_row0 + 64 * j : lat_row0 + 64 * (j - 4);
        att::Tile t; t.kn = KV + (size_t)row * 2048 + h * 256; t.v = t.kn + 128; t.kr = KR + (size_t)row * 64; t.mtype = 0; t.krel0 = 0; return t; } };
struct SwaTiles { gcbf P; int blk_row0, ctx_row0, kvh, nwin, has_prev, has_next;
    __device__ __forceinline__ att::Tile operator()(int j) const { att::Tile t; int row; t.mtype = 0; t.krel0 = 0;
        if (j >= nwin) row = ctx_row0 + 64 * (j - nwin);
        else if (j < 2) row = blk_row0 + 64 * j;
        else if (has_prev && j < 4) { row = blk_row0 - 128 + 64 * (j - 2); t.mtype = 1; t.krel0 = -128 + 64 * (j - 2); }
        else { const int sub = j - 2 - 2 * has_prev; row = blk_row0 + 128 + 64 * sub; t.mtype = 2; t.krel0 = 128 + 64 * sub; }
        t.kn = P + (size_t)row * DINP + C_SWAK + kvh * 128; t.v = P + (size_t)row * DINP + C_SWAV + kvh * 128; t.kr = nullptr; return t; } };

#ifndef MLA_SDEPTH
#define MLA_SDEPTH 1
#endif
__device__ __forceinline__ void mla_item(Frame& F, int b, int h, int qb, bool ctxq) {
    F.tid = ltid(); F.lane = F.tid & 63;
    const int r32 = F.lane & 31; const int t = qb * 256 + F.wave * 32 + r32;
    const int roww0 = ctxq ? M_LAT + b * NCTX + F.wave * 32 : b * SEQ + qb * 256 + F.wave * 32;
    gcbf Qw = (gcbf)(F.ws + WS_Q) + (size_t)(roww0 + r32) * 1536 + h * 192;
    MlaTiles ts{(gcbf)(F.ws + WS_KV), (gcbf)(F.ws + WS_KR), M_LAT + b * NCTX, b * SEQ, h};
    gbfp Ow = (gbfp)(F.ws + WS_MIX) + (size_t)roww0 * DM + 2048 + h * 128;
    att::attn_body<192, 2048, 2048, false, false, MLA_SDEPTH>(Qw, ctxq ? 0 : 1, t >> 6, t & 63, (gcfl)(F.ws + WS_ROPE), 0, 0.f, ts, ctxq ? 4 : 132, Ow, (LAS char*)F.lds);
}
__device__ __forceinline__ void swa_item(Frame& F, int l, int b, int n, int kvh, int half, bool ctxq, int hq_ctx) {
    F.tid = ltid(); F.lane = F.tid & 63;
    const int r32 = F.lane & 31; gcbf P = (gcbf)(F.ws + WS_P);
    int hq, qi, roww0, t;
    if (ctxq) { hq = hq_ctx; kvh = hq >> 2; qi = 0; roww0 = M_LAT + b * NCTX + F.wave * 32; t = 0; }
    else { hq = kvh * 4 + 2 * half + (F.wave >> 2); qi = (F.wave & 3) * 32 + r32; roww0 = b * SEQ + n * 128 + (F.wave & 3) * 32; t = n * 128 + qi; }
    gcbf Qw = P + (size_t)(roww0 + r32) * DINP + C_SWAQ + hq * 128;
    SwaTiles ts; ts.P = P; ts.blk_row0 = b * SEQ + n * 128; ts.ctx_row0 = M_LAT + b * NCTX; ts.kvh = kvh;
    ts.has_prev = (!ctxq && n > 0) ? 1 : 0; ts.has_next = (!ctxq && n < SEQ / 128 - 1) ? 1 : 0; ts.nwin = ctxq ? 0 : 2 + 2 * ts.has_prev + 2 * ts.has_next;
    gbfp Ow = (gbfp)(F.ws + WS_MIX) + (size_t)roww0 * DM + hq * 128;
    const float sink_l2 = F.A->in[I_SINK][l * 8 + hq] * 1.4426950408889634f;
    att::attn_body<128, DINP, DINP, true, true, 2>(Qw, 0, 0, 0, (gcfl)nullptr, qi, sink_l2, ts, ts.nwin + 4, Ow, (LAS char*)F.lds);
}

#ifndef DBG_PHASES
#define DBG_PHASES 0xfffff
#endif
#define PH(n) ((DBG_PHASES >> (n)) & 1)
#ifndef DUP_PHASES
#define DUP_PHASES 0
#endif
#define REP(n) _Pragma("unroll") for (int rep_ = 0; rep_ < (((DUP_PHASES >> (n)) & 1) ? 2 : 1); ++rep_)
__global__ void __launch_bounds__(NTHR, 2) mk_fwd(Args args) {
    extern __shared__ __attribute__((aligned(16))) unsigned char lds[];
    Frame F;
    F.lds = (LAS unsigned char*)lds;
    F.tid = threadIdx.x; F.lane = F.tid & 63; F.wave = __builtin_amdgcn_readfirstlane(F.tid >> 6);
    F.G = gridDim.x; { const int bx = blockIdx.x; F.vcu = (F.G % 8 == 0) ? (bx % 8) * (F.G / 8) + bx / 8 : bx; }
    F.gw = F.vcu * NWAVES + F.wave; F.NGW = F.G * NWAVES;
    F.ws = args.ws; F.out = args.out; F.ctl = (gu32*)(args.ws + WS_CTL);
    F.A = (const __attribute__((address_space(4))) Args*)__builtin_amdgcn_kernarg_segment_ptr();
    for (int u = F.tid; u < (LDS_BYTES - LDSCTL_OFF) / 4; u += NTHR) ((LAS unsigned*)(F.lds + LDSCTL_OFF))[u] = 0u;
    __syncthreads();
    XcdBarrier bar = xcd_barrier_post((unsigned*)(args.ws + WS_CTL) + 4096, (volatile LAS unsigned*)(F.lds + MISC_OFF) + 8);
#define GRID_BAR() do { bar.bar = launder(bar.bar); bar.x = launder(bar.x); xcd_barrier(bar); F.ws = launder_g(F.ws); F.wsw = F.ws + (size_t)lcur * WSET_STRIDE; F.A = launder(F.A); F.tid = ltid(); F.lane = F.tid & 63; } while (0)
    const int bx = blockIdx.x; int lcur = 0; F.wsw = F.ws;
    bf16* H = (bf16*)(F.ws + WS_H); float* X = (float*)(F.ws + WS_X);

    REP(0) if (PH(0)) { mod_partials(F);
    convert_weights(F, 0, F.gw, F.NGW); }
    GRID_BAR();
    if (PH(1)) { mod_reduce(F); rope_table(F); }
    GRID_BAR();

#pragma unroll 1
    for (int l = 0; l < 2; ++l) {
        lcur = l; F.wsw = F.ws + (size_t)l * WSET_STRIDE;
        const bool wctx = (l == 0);
        const int MO = wctx ? M_TOT : M_LAT;
        if (PH(2) && l == 0) {
            for (int row = F.gw; row < M_TOT; row += F.NGW) { const int s = row_s(row);
                const float* xs = row < M_LAT ? F.A->in[I_X] + (size_t)row * DM : F.A->in[I_CTX] + (size_t)(row - M_LAT) * DM;
                ln_row<0>(F, xs, nullptr, nullptr, nullptr, nullptr, nullptr, true, mod_ptr(F, 0, s, 1), mod_ptr(F, 0, s, 0), H + (size_t)row * DM); }
        }
        GRID_BAR();
        REP(3) if (PH(3)) { pg8::Gemm g{H, (const bf16*)(F.wsw + WS_WIN), M_TOT, DINP, DM, DM, DM}; pg8::StaticOrder S; S.init(M_TOT, DINP, F.G, bx);
          pg8::EpiBf16<0> E{(bf16*)(F.ws + WS_P), DINP, nullptr};
          pg8::gemm_phase<pg8::EpiBf16<0>, pg8::StaticOrder, true, true>(F.lds, g, S, E); }
        GRID_BAR();
        REP(4) if (PH(4)) for (int it = F.vcu; it < 528; it += F.G) rwkv_feat_item(F, l, it);
        REP(5) if (PH(5)) for (int it = F.vcu; it < 2 * NCH * 8; it += F.G) lru_item<false>(F, l, it);
        __syncthreads();
        if (PH(6)) for (int row = F.gw; row < M_TOT; row += F.NGW) row_prep(F, row);
        GRID_BAR();
        if (PH(7)) lru_carry(F);
        REP(7) if (PH(7)) { pg8::Gemm g{(const bf16*)(F.ws + WS_P) + C_QA, (const bf16*)(F.wsw + WS_WQB), M_TOT, 1536, 1024, DINP, 1024}; pg8::StaticOrder S; S.init(M_TOT, 1536, F.G, bx);
          pg8::EpiBf16<2> E{(bf16*)(F.ws + WS_Q), 1536, (const float*)(F.ws + WS_RSQ)};
          pg8::gemm_phase<pg8::EpiBf16<2>, pg8::StaticOrder, true, true>(F.lds, g, S, E); }
        REP(7) if (PH(7)) { pg8::Gemm g{(const bf16*)(F.ws + WS_P) + C_KVA, (const bf16*)(F.wsw + WS_WKVB), M_TOT, 2048, 512, DINP, 512}; pg8::StaticOrder S; S.init(M_TOT, 2048, F.G, bx);
          pg8::EpiBf16<2> E{(bf16*)(F.ws + WS_KV), 2048, (const float*)(F.ws + WS_RSKV)};
          pg8::gemm_phase<pg8::EpiBf16<2>, pg8::StaticOrder, true, true>(F.lds, g, S, E); }
        GRID_BAR();
        REP(8) if ((bx & 3) == 0) { const int nrw = (F.G + 3) >> 2; REP(18) if (PH(8)) for (int chain = bx >> 2; chain < 64; chain += nrw) rwkv_scan(F, l, chain); }
        else REP(19) { const int aw = (bx >> 2) * 3 + (bx & 3) - 1, naw = F.G - ((F.G + 3) >> 2);
            if (PH(9)) for (int it = aw; it < 512; it += naw) mla_item(F, it >> 8, (it >> 5) & 7, it & 31, false);
            if (PH(9) && wctx) for (int it = aw; it < 16; it += naw) mla_item(F, it >> 3, it & 7, 0, true);
            if (PH(10)) for (int it = aw; it < 512; it += naw) swa_item(F, l, it >> 8, (it >> 2) & 63, (it >> 1) & 1, it & 1, false, 0);
            if (PH(10) && wctx) for (int it = aw; it < 16; it += naw) swa_item(F, l, it >> 3, 0, 0, 0, true, it & 7);
            if (PH(11)) for (int it = aw; it < 2 * NCH * 8; it += naw) { if (!wctx && ((it >> 3) % NCH) < 8) continue; lru_item<true>(F, l, it); }
            if (l == 0) { __syncthreads(); convert_weights(F, 1, aw * NWAVES + F.wave, naw * NWAVES); }
        }
        GRID_BAR();
        REP(12) if (PH(12)) for (int row = F.gw; row < MO; row += F.NGW) rwkv_out_row(F, l, row);
        GRID_BAR();
        REP(13) if (PH(13)) { pg8::Gemm g{(const bf16*)(F.ws + WS_MIX), (const bf16*)(F.wsw + WS_WOUT), M_LAT, DM, DM, DM, DM}; pg8::StaticOrder S; S.init(M_LAT, DM, F.G, bx);
          pg8::EpiBf16<0> E{(bf16*)(F.ws + WS_Y1), DM, nullptr};
          pg8::gemm_phase<pg8::EpiBf16<0>, pg8::StaticOrder, true, true>(F.lds, g, S, E);
          if (wctx) {
              pg8::Gemm g2{(const bf16*)(F.ws + WS_MIX) + (size_t)M_LAT * DM, (const bf16*)(F.wsw + WS_WOUT), M_CTX, DM, DM / 8, DM, DM}; pg8::SplitOrder S2; S2.init(M_CTX, DM, DM / 8, bx);
              pg8::EpiF32 E2{(float*)(F.ws + WS_YP), DM, (size_t)M_CTX * DM};
              pg8::gemm_phase<pg8::EpiF32, pg8::SplitOrder, true, true>(F.lds, g2, S2, E2); } }
        GRID_BAR();
        if (PH(14)) for (int row = F.gw; row < MO; row += F.NGW) { const int s = row_s(row);
            const float* xs = (l == 0) ? (row < M_LAT ? F.A->in[I_X] + (size_t)row * DM : F.A->in[I_CTX] + (size_t)(row - M_LAT) * DM) : X + (size_t)row * DM;
            bf16* yrow = (bf16*)(F.ws + WS_Y1) + (size_t)row * DM;
            if (row >= M_LAT) sum_partials_row(F, (const float*)(F.ws + WS_YP) + (size_t)(row - M_LAT) * DM, (size_t)M_CTX * DM, yrow);
            ln_row<1>(F, xs, yrow, mod_ptr(F, l, s, 2), F.A->in[I_LN1G] + l * DM, F.A->in[I_LN1B] + l * DM, X + (size_t)row * DM,
                      true, mod_ptr(F, l, s, 4), mod_ptr(F, l, s, 3), H + (size_t)row * DM); }
        GRID_BAR();
        REP(15) if (PH(15)) { pg8::Gemm g{H, (const bf16*)(F.wsw + WS_WFF1), MO, DFF, DM, DM, DM}; pg8::StaticOrder S; S.init(MO, DFF, F.G, bx);
          pg8::EpiBf16<1> E{(bf16*)(F.ws + WS_HID), DFF, nullptr};
          pg8::gemm_phase<pg8::EpiBf16<1>, pg8::StaticOrder, true, true>(F.lds, g, S, E); }
        GRID_BAR();
        REP(16) if (PH(16)) { pg8::Gemm g{(const bf16*)(F.ws + WS_HID), (const bf16*)(F.wsw + WS_WFF2), M_LAT, DM, DFF, DFF, DFF}; pg8::StaticOrder S; S.init(M_LAT, DM, F.G, bx);
          pg8::EpiBf16<0> E{(bf16*)(F.ws + WS_Y2), DM, nullptr};
          pg8::gemm_phase<pg8::EpiBf16<0>, pg8::StaticOrder, true, true>(F.lds, g, S, E);
          if (wctx) {
              pg8::Gemm g2{(const bf16*)(F.ws + WS_HID) + (size_t)M_LAT * DFF, (const bf16*)(F.wsw + WS_WFF2), M_CTX, DM, DFF / 8, DFF, DFF}; pg8::SplitOrder S2; S2.init(M_CTX, DM, DFF / 8, bx);
              pg8::EpiF32 E2{(float*)(F.ws + WS_YP), DM, (size_t)M_CTX * DM};
              pg8::gemm_phase<pg8::EpiF32, pg8::SplitOrder, true, true>(F.lds, g2, S2, E2); } }
        GRID_BAR();
        if (!PH(17)) {} else if (l == 0) {
            for (int row = F.gw; row < M_TOT; row += F.NGW) { const int s = row_s(row);
                bf16* yrow = (bf16*)(F.ws + WS_Y2) + (size_t)row * DM;
                if (row >= M_LAT) sum_partials_row(F, (const float*)(F.ws + WS_YP) + (size_t)(row - M_LAT) * DM, (size_t)M_CTX * DM, yrow);
                ln_row<1>(F, X + (size_t)row * DM, yrow, mod_ptr(F, 0, s, 5), F.A->in[I_LN2G], F.A->in[I_LN2B], X + (size_t)row * DM,
                          true, mod_ptr(F, 1, s, 1), mod_ptr(F, 1, s, 0), H + (size_t)row * DM); }
        } else {
            for (int row = F.gw; row < M_LAT; row += F.NGW) { const int s = row_s(row);
                ln_row<1>(F, X + (size_t)row * DM, (const bf16*)(F.ws + WS_Y2) + (size_t)row * DM, mod_ptr(F, 1, s, 5), F.A->in[I_LN2G] + DM, F.A->in[I_LN2B] + DM, F.out + (size_t)row * DM,
                          false, nullptr, nullptr, nullptr); }
        }
    }
}

extern "C" void kernel_launch(void* const* d_in, const int* in_sizes, int n_in, void* d_out, int out_size, void* d_ws, size_t ws_size, hipStream_t stream) {
    static int grid = 0;
    if (grid == 0) {
        if (n_in != 38 || out_size != M_LAT * DM || ws_size < WS_END) { fprintf(stderr, "kernel_launch: unexpected shapes: n_in %d out %d ws %zu (need %zu)\n", n_in, out_size, ws_size, (size_t)WS_END); grid = -1; return; }
        int dev = 0, cus = 0, per_cu = 0;
        if (hipGetDevice(&dev) != hipSuccess || hipDeviceGetAttribute(&cus, hipDeviceAttributeMultiprocessorCount, dev) != hipSuccess) { grid = -1; return; }
        if (hipFuncSetAttribute((const void*)mk_fwd, hipFuncAttributeMaxDynamicSharedMemorySize, LDS_BYTES) != hipSuccess) { fprintf(stderr, "kernel_launch: hipFuncSetAttribute failed\n"); grid = -1; return; }
        if (hipOccupancyMaxActiveBlocksPerMultiprocessor(&per_cu, (const void*)mk_fwd, NTHR, LDS_BYTES) != hipSuccess || per_cu < 1) fprintf(stderr, "kernel_launch: occupancy query says %d\n", per_cu);
        (void)hipGetLastError();
        grid = cus;
    }
    if (grid < 0) return;
    if (hipMemsetAsync((char*)d_ws + WS_CTL, 0, CTL_ZERO_BYTES, stream) != hipSuccess) return;
    Args a{};
    for (int i = 0; i < 38; ++i) a.in[i] = (const float*)d_in[i];
    a.out = (float*)d_out; a.ws = (unsigned char*)d_ws;
    hipLaunchKernelGGL(mk_fwd, dim3(grid), dim3(NTHR), LDS_BYTES, stream, a);
    const hipError_t le = hipPeekAtLastError();
    if (le != hipSuccess) fprintf(stderr, "kernel_launch: launch failed: %s\n", hipGetErrorName(le));
}
```

```cpp
#include <hip/hip_runtime.h>
#include <hip/hip_bf16.h>
#include <cstdio>
#include <cstdint>

namespace pg8 {
#define PG8_LAS __attribute__((address_space(3)))
typedef unsigned short bf16_t;
typedef short bf16x8 __attribute__((ext_vector_type(8)));
typedef float f32x4 __attribute__((ext_vector_type(4)));
typedef unsigned u32x4 __attribute__((ext_vector_type(4)));
constexpr int BM = 256, BK = 64, HALF = 128, HTB = HALF * BK * 2  , STAGE_BYTES = 8 * HTB, NXCD = 8, WGM = 8;

__host__ __device__ __forceinline__ int lds_byte(int r, int c) { const int st = (r >> 4) * 2 + (c >> 5), rr = r & 15, cc = c & 31, ob = rr * 64 + cc * 2; return st * 1024 + (ob ^ (((ob >> 9) & 1) << 5)); }
__host__ __device__ __forceinline__ void stage_rc(int b, int& R, int& C) { const int st = b / 1024, sb = b % 1024, swz = sb ^ (((sb >> 9) & 1) << 5); R = (st >> 1) * 16 + swz / 64; C = (st & 1) * 32 + (swz % 64) / 2; }
__host__ __device__ __forceinline__ int perm32(int rho) { const int n = rho >> 4, i = rho & 15; return 8 * (i >> 2) + 4 * n + (i & 3); }

struct Unit { int pm, pn, ko, ks; };
struct Gemm { const bf16_t* A; const bf16_t* Bt; int M, N, K, lda, ldb; };

struct StaticOrder {
    int nM, nN, nwg, G, c;
    __host__ __device__ void init(int M, int N, int G_, int c_) { nM = M / BM; nN = N / BM; nwg = nM * nN; G = G_; c = c_; }
    __host__ __device__ bool next(int i, Unit& u) const {
        const long L = (long)i * G + c; if (L >= nwg) return false;
        int wgid = (int)L; { const int q = nwg / NXCD, r = nwg % NXCD, xcd = wgid % NXCD, off = wgid / NXCD; wgid = (xcd < r ? xcd * (q + 1) : r * (q + 1) + (xcd - r) * q) + off; }
        const int nig = WGM * nN, gid = wgid / nig, fm = gid * WGM, gsz = (nM - fm) < WGM ? (nM - fm) : WGM;
        u.pm = fm + ((wgid % nig) % gsz); u.pn = (wgid % nig) / gsz; u.ko = 0; u.ks = 0; return true;
    }
    __device__ __forceinline__ void a_ready(const Unit&) const {}
    __device__ __forceinline__ void done(const Unit&) const {}
};
struct SplitOrder {
    int nN, nitems, kslice, c;
    __host__ __device__ void init(int M, int N, int Kslice, int c_) { nN = N / BM; nitems = (M / BM) * nN * 8; kslice = Kslice; c = c_; }
    __host__ __device__ bool next(int i, Unit& u) const { if (i > 0 || c >= nitems) return false; u.ks = c & 7; u.ko = u.ks * kslice; u.pn = (c >> 3) % nN; u.pm = (c >> 3) / nN; return true; }
    __device__ __forceinline__ void a_ready(const Unit&) const {}
    __device__ __forceinline__ void done(const Unit&) const {}
};

__device__ __forceinline__ unsigned cvt_pk_bf16(float lo, float hi) { unsigned r; asm volatile("v_cvt_pk_bf16_f32 %0, %1, %2" : "=v"(r) : "v"(lo), "v"(hi)); return r; }

struct EpiF32 {
    static constexpr bool PERM = false, AFTER_DRAIN = false;
    float* C; int ldc; size_t split_stride;
    __device__ __forceinline__ void operator()(const f32x4 (&acc)[2][2][4][2], const Unit& u, int wr, int wc, int fr, int fq) const {
        const int row0 = u.pm * BM + wr * 64 + fr, col0 = u.pn * BM + wc * 32 + 4 * fq; float* Cb = C + (size_t)u.ks * split_stride;
#pragma unroll
        for (int ai = 0; ai < 2; ++ai)
#pragma unroll
            for (int m = 0; m < 4; ++m) { float* rowp = Cb + (size_t)(row0 + ai * HALF + m * 16) * ldc + col0;
#pragma unroll
                for (int bj = 0; bj < 2; ++bj)
#pragma unroll
                    for (int n = 0; n < 2; ++n) *(f32x4*)(rowp + bj * HALF + n * 16) = acc[ai][bj][m][n]; }
    }
};
template <int ACT> struct EpiBf16 {
    static constexpr bool PERM = true, AFTER_DRAIN = false;
    bf16_t* O; int ldc; const float* rowscale;
    __device__ __forceinline__ void operator()(const f32x4 (&acc)[2][2][4][2], const Unit& u, int wr, int wc, int fr, int fq) const {
        const int row0 = u.pm * BM + wr * 64 + fr; const int col0 = u.pn * BM + wc * 32 + 8 * fq;
#pragma unroll
        for (int ai = 0; ai < 2; ++ai)
#pragma unroll
            for (int m = 0; m < 4; ++m) { const int row = row0 + ai * HALF + m * 16; bf16_t* rowp = O + (size_t)row * ldc + col0;
                float rs = 1.f; if (ACT == 2) rs = rowscale[row];
#pragma unroll
                for (int bj = 0; bj < 2; ++bj) { f32x4 v0 = acc[ai][bj][m][0], v1 = acc[ai][bj][m][1];
                    if (ACT == 1) {
#pragma unroll
                        for (int j = 0; j < 4; ++j) { const float a = fmaxf(v0[j], 0.f), b = fmaxf(v1[j], 0.f); v0[j] = a * a; v1[j] = b * b; } }
                    if (ACT == 2) { v0 = v0 * rs; v1 = v1 * rs; }
                    if (ACT == 3) { const u32x4 o = *(const u32x4*)(rowp + bj * HALF);
                        v0[0] += __builtin_bit_cast(float, o.x << 16); v0[1] += __builtin_bit_cast(float, o.x & 0xffff0000u); v0[2] += __builtin_bit_cast(float, o.y << 16); v0[3] += __builtin_bit_cast(float, o.y & 0xffff0000u);
                        v1[0] += __builtin_bit_cast(float, o.z << 16); v1[1] += __builtin_bit_cast(float, o.z & 0xffff0000u); v1[2] += __builtin_bit_cast(float, o.w << 16); v1[3] += __builtin_bit_cast(float, o.w & 0xffff0000u); }
                    u32x4 w; w.x = cvt_pk_bf16(v0[0], v0[1]); w.y = cvt_pk_bf16(v0[2], v0[3]); w.z = cvt_pk_bf16(v1[0], v1[1]); w.w = cvt_pk_bf16(v1[2], v1[3]);
                    *(u32x4*)(rowp + bj * HALF) = w; } }
    }
};

template <class Epi, class Sched, bool ALIGN_EPI = false, bool SP2 = false>
__device__ __forceinline__ void gemm_phase(PG8_LAS unsigned char* lds, const Gemm g, const Sched& S, const Epi& E) {
    int tid = threadIdx.x; asm volatile("" : "+v"(tid));
    const int wid = __builtin_amdgcn_readfirstlane(tid >> 6), lane = tid & 63, wr = wid >> 2, wc = wid & 3, fr = lane & 15, fq = lane >> 4;
    const int K = g.K, nt = K / BK, lda = g.lda, ldb = g.ldb;
    unsigned voffA[2], voffB[2];
#pragma unroll
    for (int i = 0; i < 2; ++i) { int R, C; stage_rc(tid * 16 + i * 8192, R, C); const int Rb = Epi::PERM ? ((R & ~31) + perm32(R & 31)) : R;
        voffA[i] = (unsigned)(R * lda + C) * 2u; voffB[i] = (unsigned)(Rb * ldb + C) * 2u; }
    const size_t kstep = (size_t)(BK * 2);
    const size_t hstepA = (size_t)HALF * lda * 2, hstepB = (size_t)HALF * ldb * 2;
    const size_t tstepA = 2 * hstepA, tstepB = 2 * hstepB;
    const unsigned ldsw = (unsigned)wid * 1024u;
    const int aoff = lds_byte(wr * 64 + fr, fq * 8), boff = lds_byte(wc * 32 + fr, fq * 8);
#define PG8_SA(b, h) (((b) * 2 + (h)) * HTB)
#define PG8_SB(b, h) ((4 + (b) * 2 + (h)) * HTB)
#define PG8_STAGE(bufoff, gbase, voff) do { _Pragma("unroll") for (int _i = 0; _i < 2; ++_i) \
        __builtin_amdgcn_global_load_lds((const unsigned*)((const char*)(gbase) + (voff)[_i]), (PG8_LAS unsigned*)(lds + (bufoff) + ldsw + _i * 8192), 16, 0, 0); } while (0)
#define PG8_LDA(dst, b, h) do { _Pragma("unroll") for (int m = 0; m < 4; ++m) _Pragma("unroll") for (int k = 0; k < 2; ++k) dst[m][k] = *(const PG8_LAS bf16x8*)(lds + PG8_SA(b, h) + aoff + m * 2048 + k * 1024); } while (0)
#define PG8_LDB(dst, b, h) do { _Pragma("unroll") for (int n = 0; n < 2; ++n) _Pragma("unroll") for (int k = 0; k < 2; ++k) dst[n][k] = *(const PG8_LAS bf16x8*)(lds + PG8_SB(b, h) + boff + n * 2048 + k * 1024); } while (0)
#define PG8_MMA(ai, bj, At, Bt) do { __builtin_amdgcn_s_setprio(1); _Pragma("unroll") for (int m = 0; m < 4; ++m) _Pragma("unroll") for (int n = 0; n < 2; ++n) _Pragma("unroll") for (int k = 0; k < 2; ++k) \
        acc[ai][bj][m][n] = __builtin_amdgcn_mfma_f32_16x16x32_bf16(Bt[n][k], At[m][k], acc[ai][bj][m][n], 0, 0, 0); __builtin_amdgcn_s_setprio(0); } while (0)
#define PG8_WAIT_V(n) asm volatile("s_waitcnt vmcnt(" #n ")" ::: "memory")
#define PG8_WAIT_L(n) asm volatile("s_waitcnt lgkmcnt(" #n ")" ::: "memory")
#define PG8_BAR __builtin_amdgcn_s_barrier()
#define PG8_SCHED __builtin_amdgcn_sched_barrier(0)
    Unit cur, nxt; int ui = 0;
    if (!S.next(0, cur)) return;
    f32x4 acc[2][2][4][2];
#pragma unroll
    for (int a = 0; a < 2; ++a)
#pragma unroll
        for (int b = 0; b < 2; ++b)
#pragma unroll
            for (int m = 0; m < 4; ++m)
#pragma unroll
                for (int n = 0; n < 2; ++n) acc[a][b][m][n] = (f32x4){0.f, 0.f, 0.f, 0.f};
    bf16x8 At[4][2], B0[2][2], B1[2][2];
    const char* cA = (const char*)g.A + (size_t)cur.pm * tstepA + (size_t)cur.ko * 2; const char* cB = (const char*)g.Bt + (size_t)cur.pn * tstepB + (size_t)cur.ko * 2;
    S.a_ready(cur);
    if constexpr (SP2) {
        PG8_STAGE(PG8_SB(0, 0), cB, voffB); PG8_STAGE(PG8_SB(0, 1), cB + hstepB, voffB); PG8_STAGE(PG8_SA(0, 0), cA, voffA); PG8_STAGE(PG8_SA(0, 1), cA + hstepA, voffA);
        if (wr == 1) PG8_BAR;
        PG8_WAIT_V(2); PG8_BAR;
        PG8_STAGE(PG8_SB(1, 0), cB + kstep, voffB); PG8_STAGE(PG8_SA(1, 0), cA + kstep, voffA); PG8_STAGE(PG8_SB(1, 1), cB + hstepB + kstep, voffB);
        PG8_WAIT_V(6); PG8_BAR;
    } else {
        PG8_STAGE(PG8_SB(0, 0), cB, voffB); PG8_STAGE(PG8_SA(0, 0), cA, voffA); PG8_STAGE(PG8_SB(0, 1), cB + hstepB, voffB); PG8_STAGE(PG8_SA(0, 1), cA + hstepA, voffA);
        if (wr == 1) PG8_BAR;
        PG8_WAIT_V(4); PG8_BAR;
        PG8_STAGE(PG8_SB(1, 0), cB + kstep, voffB); PG8_STAGE(PG8_SA(1, 0), cA + kstep, voffA); PG8_STAGE(PG8_SB(1, 1), cB + hstepB + kstep, voffB);
        PG8_WAIT_V(6); PG8_BAR;
    }
    for (;;) {
        const bool has_next = S.next(ui + 1, nxt);
        const char* nA = has_next ? (const char*)g.A + (size_t)nxt.pm * tstepA + (size_t)nxt.ko * 2 : cA; const char* nB = has_next ? (const char*)g.Bt + (size_t)nxt.pn * tstepB + (size_t)nxt.ko * 2 : cB;
        for (int t = 0; t < nt; t += 2) {
            const bool last = (t == nt - 2);
            const char* a1 = cA + (size_t)(t + 1) * kstep;
            const char* a2 = last ? nA : cA + (size_t)(t + 2) * kstep; const char* b2 = last ? nB : cB + (size_t)(t + 2) * kstep;
            const char* a3 = a2 + kstep; const char* b3 = b2 + kstep;
            if (last && has_next) S.a_ready(nxt);
            if constexpr (SP2) {
            PG8_LDB(B0, 0, 0); PG8_LDB(B1, 0, 1); PG8_SCHED; PG8_LDA(At, 0, 0); PG8_STAGE(PG8_SA(1, 1), a1 + hstepA, voffA);
            PG8_WAIT_V(8); PG8_WAIT_L(0); PG8_BAR; PG8_MMA(0, 0, At, B0); PG8_MMA(0, 1, At, B1); PG8_BAR; PG8_SCHED;
            PG8_LDA(At, 0, 1); PG8_STAGE(PG8_SB(0, 0), b2, voffB); PG8_STAGE(PG8_SB(0, 1), b2 + hstepB, voffB); PG8_STAGE(PG8_SA(0, 0), a2, voffA);
            PG8_WAIT_V(8); PG8_WAIT_L(0); PG8_BAR; PG8_MMA(1, 0, At, B0); PG8_MMA(1, 1, At, B1); PG8_BAR; PG8_SCHED;
            PG8_LDB(B0, 1, 0); PG8_LDB(B1, 1, 1); PG8_SCHED; PG8_LDA(At, 1, 0); PG8_STAGE(PG8_SA(0, 1), a2 + hstepA, voffA);
            PG8_WAIT_V(8); PG8_WAIT_L(0); PG8_BAR; PG8_MMA(0, 0, At, B0); PG8_MMA(0, 1, At, B1); PG8_BAR; PG8_SCHED;
            PG8_LDA(At, 1, 1); PG8_STAGE(PG8_SB(1, 0), b3, voffB); PG8_STAGE(PG8_SB(1, 1), b3 + hstepB, voffB); PG8_STAGE(PG8_SA(1, 0), a3, voffA);
            PG8_WAIT_V(8); PG8_WAIT_L(0); PG8_BAR; PG8_MMA(1, 0, At, B0); PG8_MMA(1, 1, At, B1); PG8_BAR; PG8_SCHED;
            } else {
            PG8_LDB(B0, 0, 0); PG8_SCHED; PG8_LDA(At, 0, 0); PG8_STAGE(PG8_SA(1, 1), a1 + hstepA, voffA);
            PG8_WAIT_L(8); PG8_BAR; PG8_WAIT_L(0); PG8_MMA(0, 0, At, B0); PG8_BAR; PG8_SCHED;
            PG8_LDB(B1, 0, 1); PG8_STAGE(PG8_SB(0, 0), b2, voffB);
            PG8_BAR; PG8_WAIT_L(0); PG8_MMA(0, 1, At, B1); PG8_BAR;
            PG8_LDA(At, 0, 1); PG8_STAGE(PG8_SA(0, 0), a2, voffA);
            PG8_BAR; PG8_WAIT_L(0); PG8_MMA(1, 0, At, B0); PG8_BAR; PG8_SCHED;
            PG8_STAGE(PG8_SB(0, 1), b2 + hstepB, voffB);
            PG8_WAIT_V(6); PG8_BAR; PG8_MMA(1, 1, At, B1); PG8_BAR;
            PG8_LDB(B0, 1, 0); PG8_SCHED; PG8_LDA(At, 1, 0); PG8_STAGE(PG8_SA(0, 1), a2 + hstepA, voffA);
            PG8_WAIT_L(8); PG8_BAR; PG8_WAIT_L(0); PG8_MMA(0, 0, At, B0); PG8_BAR; PG8_SCHED;
            PG8_LDB(B1, 1, 1); PG8_STAGE(PG8_SB(1, 0), b3, voffB);
            PG8_BAR; PG8_WAIT_L(0); PG8_MMA(0, 1, At, B1); PG8_BAR;
            PG8_LDA(At, 1, 1); PG8_STAGE(PG8_SA(1, 0), a3, voffA);
            PG8_BAR; PG8_WAIT_L(0); PG8_MMA(1, 0, At, B0); PG8_BAR; PG8_SCHED;
            PG8_STAGE(PG8_SB(1, 1), b3 + hstepB, voffB);
            PG8_WAIT_V(6); PG8_BAR; PG8_MMA(1, 1, At, B1); PG8_BAR;
            }
        }
        if constexpr (ALIGN_EPI) { if (wr == 0) PG8_BAR; }
        E(acc, cur, wr, wc, fr, fq); S.done(cur);
        if (!has_next) break;
#pragma unroll
        for (int a = 0; a < 2; ++a)
#pragma unroll
            for (int b = 0; b < 2; ++b)
#pragma unroll
                for (int m = 0; m < 4; ++m)
#pragma unroll
                    for (int n = 0; n < 2; ++n) acc[a][b][m][n] = (f32x4){0.f, 0.f, 0.f, 0.f};
        cur = nxt; cA = nA; cB = nB; ++ui;
        if constexpr (ALIGN_EPI) { if (wr == 1) PG8_BAR; }
    }
    PG8_WAIT_V(0);
    if constexpr (!ALIGN_EPI) { if (wr == 0) PG8_BAR; }
    PG8_BAR;
#undef PG8_SA
#undef PG8_SB
#undef PG8_STAGE
#undef PG8_LDA
#undef PG8_LDB
#undef PG8_MMA
#undef PG8_WAIT_V
#undef PG8_WAIT_L
#undef PG8_BAR
#undef PG8_SCHED
}
}

constexpr int NWAVES = 8, NTHR = 512;
constexpr int DM = 4096, NB = 2, SEQ = 8192, NCTX = 256, DFF = 16384;
constexpr int M_LAT = NB * SEQ, M_CTX = NB * NCTX, M_TOT = M_LAT + M_CTX;
constexpr int DIN = 8672, DINP = 8704;
constexpr int C_SWAQ = 0, C_SWAK = 1024, C_SWAV = 1280, C_LRUX = 1536, C_LRUY = 2560, C_QA = 3584, C_KVA = 4608, C_KR = 5120, C_RW = 5184;
constexpr int C_RWR = C_RW, C_RWK = C_RW + 1024, C_RWV = C_RW + 2048, C_RWL = C_RW + 3072;
constexpr int RWC = 3488;
constexpr float LN_EPS = 1e-5f, RMS_EPS = 1e-6f, GN_EPS = 64e-5f, ALPHA = 1.41421356237f;
constexpr int NCH = 264;

constexpr size_t MiB = 1u << 20;
constexpr size_t WS_CTL = 0, CTL_ZERO_BYTES = 1 * MiB;
constexpr size_t WS_MOD = 1 * MiB;
constexpr size_t WS_MODP = 2 * MiB;
constexpr size_t WS_SMALL = 20 * MiB;
constexpr size_t WS_RSQ = WS_SMALL;
constexpr size_t WS_RSKV = WS_RSQ + 128 * 1024;
constexpr size_t WS_SB = WS_RSKV + 128 * 1024;
constexpr size_t WS_CA = WS_SB + 2 * MiB;
constexpr size_t WS_CB = WS_CA + 5 * MiB;
constexpr size_t WS_HIN = WS_CB + 5 * MiB;
constexpr size_t WS_QUIRK = WS_HIN + 5 * MiB;
constexpr size_t WS_ROPE = WS_QUIRK + 8192;
static_assert(WS_ROPE + 16384 <= 40 * MiB, "small region");
constexpr size_t WS_W = 40 * MiB;
constexpr size_t WS_WIN = WS_W, WS_WOUT = WS_WIN + 68 * MiB, WS_WFF1 = WS_WOUT + 32 * MiB, WS_WFF2 = WS_WFF1 + 128 * MiB, WS_WQB = WS_WFF2 + 128 * MiB,
                 WS_WKVB = WS_WQB + 3 * MiB, WS_WLRU = WS_WKVB + 2 * MiB, WS_WLORA = WS_WLRU + 1 * MiB;
constexpr size_t WS_W2T = WS_WLORA, WS_A2T = WS_W2T + 256 * 1024, WS_G2T = WS_A2T + 256 * 1024;
constexpr size_t WS_X = 403 * MiB;
constexpr size_t WS_H = 667 * MiB;
constexpr size_t WS_MIX = 799 * MiB;
constexpr size_t WS_YS = 931 * MiB;
constexpr size_t WS_P = 1063 * MiB;
constexpr size_t WS_RWF = 1344 * MiB;
constexpr size_t RWF_STRIDE = (size_t)M_TOT * 1024 * 2;
constexpr size_t WS_Q = 1641 * MiB;
constexpr size_t WS_KV = 1691 * MiB;
constexpr size_t WS_KR = 1757 * MiB;
constexpr size_t WS_SET2 = 1760 * MiB;
constexpr size_t WSET_STRIDE = WS_SET2 - WS_W;
constexpr size_t WS_END = WS_SET2 + 363 * MiB;
constexpr size_t WS_YP = WS_Q;
constexpr size_t WS_HID = WS_P;
constexpr size_t WS_Y1 = WS_P;
constexpr size_t WS_Y2 = WS_MIX;
static_assert(WS_WLORA + 1 * MiB <= WS_X && WS_P + (size_t)M_TOT * DINP * 2 <= WS_RWF && WS_RWF + 9 * RWF_STRIDE <= WS_Q, "ws map");
static_assert(WS_HID + (size_t)M_TOT * DFF * 2 <= WS_Q && WS_Y2 + (size_t)M_TOT * DM * 4 <= WS_P && WS_YS + 2 * (size_t)M_TOT * 1024 * 4 <= WS_P, "ws overlays");
static_assert(WS_KR + (size_t)M_TOT * 64 * 2 <= WS_SET2 && WS_YP + 8 * (size_t)M_CTX * DM * 4 <= WS_KR, "ws end");

constexpr int RING_BYTES = 131072;
constexpr int LDSCTL_OFF = RING_BYTES, MISC_OFF = LDSCTL_OFF + 320;
constexpr int LDS_BYTES = 147456;

#define GAS __attribute__((address_space(1)))
#define LAS __attribute__((address_space(3)))
typedef unsigned short bf16;
typedef unsigned v4u __attribute__((ext_vector_type(4)));
typedef unsigned v2u __attribute__((ext_vector_type(2)));
typedef float f32x4 __attribute__((ext_vector_type(4)));
typedef float f32x2 __attribute__((ext_vector_type(2)));
typedef float f32x16 __attribute__((ext_vector_type(16)));
typedef short bf16x8 __attribute__((ext_vector_type(8)));
typedef short s16x4 __attribute__((ext_vector_type(4)));
typedef GAS unsigned gu32;
typedef const GAS bf16* gcbf; typedef GAS bf16* gbfp; typedef const GAS float* gcfl; typedef GAS float* gflp;
#define LDS_WAIT() asm volatile("s_waitcnt lgkmcnt(0)" ::: "memory")
#define VM_WAIT() asm volatile("s_waitcnt vmcnt(0)" ::: "memory")
__device__ __forceinline__ unsigned f2bf(float f) { unsigned u = __builtin_bit_cast(unsigned, f); return (u + 0x7fffu + ((u >> 16) & 1u)) >> 16; }
__device__ __forceinline__ unsigned pk2(float lo, float hi) { return f2bf(lo) | (f2bf(hi) << 16); }
__device__ __forceinline__ float bflo(unsigned w) { return __builtin_bit_cast(float, w << 16); }
__device__ __forceinline__ float bfhi(unsigned w) { return __builtin_bit_cast(float, w & 0xffff0000u); }
__device__ __forceinline__ float bf2f(bf16 h) { return __builtin_bit_cast(float, (unsigned)h << 16); }
#define DPP_ADD(x, ctrl) ((x) + __builtin_bit_cast(float, __builtin_amdgcn_update_dpp(0, __builtin_bit_cast(int, (x)), (ctrl), 0xf, 0xf, false)))
__device__ __forceinline__ float row_sum16(float x) { x = DPP_ADD(x, 0x128); x = DPP_ADD(x, 0x124); x = DPP_ADD(x, 0x122); x = DPP_ADD(x, 0x121); return x; }
#ifdef OLD_SUMS
__device__ __forceinline__ float wave_sum(float v) {
#pragma unroll
    for (int o = 1; o < 64; o <<= 1) v += __shfl_xor(v, o);
    return v;
}
__device__ __forceinline__ float half_swap_sum(float x) { return x + __shfl_xor(x, 32); }
__device__ __forceinline__ float quad_sum(float x) { x += __shfl_xor(x, 1); x += __shfl_xor(x, 2); return x; }
#else
__device__ __forceinline__ float wave_sum(float v) {
    const float r = row_sum16(v);
    const float a = __builtin_bit_cast(float, __builtin_amdgcn_readlane(__builtin_bit_cast(int, r), 0)), b = __builtin_bit_cast(float, __builtin_amdgcn_readlane(__builtin_bit_cast(int, r), 16));
    const float c = __builtin_bit_cast(float, __builtin_amdgcn_readlane(__builtin_bit_cast(int, r), 32)), d = __builtin_bit_cast(float, __builtin_amdgcn_readlane(__builtin_bit_cast(int, r), 48));
    return (a + b) + (c + d);
}
__device__ __forceinline__ float half_swap_sum(float x) {
    unsigned a = __builtin_bit_cast(unsigned, x), b = a; asm volatile("" : "+v"(b));
    auto rr = __builtin_amdgcn_permlane32_swap(a, b, false, false);
    const float lo = __uint_as_float(rr[0]), hi = __uint_as_float(rr[1]); return lo + hi;
}
__device__ __forceinline__ float quad_sum(float x) { x = DPP_ADD(x, 0xB1); x = DPP_ADD(x, 0x4E); return x; }
#endif
__device__ __forceinline__ float sigmoidf_(float x) { return 1.f / (1.f + __expf(-x)); }
__device__ __forceinline__ float softplusf_(float x) { return x > 20.f ? x : __logf(1.f + __expf(x)); }
__device__ __forceinline__ float tanhf_(float x) { const float e = __expf(2.f * x); return 1.f - 2.f / (e + 1.f); }
__device__ __forceinline__ int ltid() { int t = threadIdx.x; asm volatile("" : "+v"(t)); return t; }
template <class T> __device__ __forceinline__ T ldg(const void* base, unsigned byteoff) { return *(const T*)((const char*)base + byteoff); }
template <class T> __device__ __forceinline__ void stg(void* base, unsigned byteoff, T v) { *(T*)((char*)base + byteoff) = v; }

#define XB_TMO      128
#define XB_XCNT(j)  (256  + 64 * (j))
#define XB_XSUB(j)  (1280 + 64 * (j))
#define XB_XGEN(j)  (2304 + 64 * (j))
#define XB_TOP      3328
#define XB_TOPGEN   3392
#define XCD_BAR_WORDS 3456
#define XB_SPIN_CAP (1u << 18)

__device__ __forceinline__ unsigned xb_ld(unsigned* p)              { return __hip_atomic_load(p, __ATOMIC_RELAXED, __HIP_MEMORY_SCOPE_AGENT); }
__device__ __forceinline__ unsigned xb_add(unsigned* p, unsigned v) { return __hip_atomic_fetch_add(p, v, __ATOMIC_RELAXED, __HIP_MEMORY_SCOPE_AGENT); }
__device__ __forceinline__ unsigned xb_xcc_id() { return (unsigned)__builtin_amdgcn_s_getreg((3 << 11) | 20) & 0xFu; }
#define XB_SPIN(cond, bar) do { unsigned _sp = 0; while (cond) { __builtin_amdgcn_s_sleep(1); \
    if ((++_sp & 255u) == 0u) { if (xb_ld(&(bar)[XB_TMO])) break; if (_sp > XB_SPIN_CAP) { atomicAdd(&(bar)[XB_TMO], 1u); break; } } } } while (0)

struct XcdBarrier {
    unsigned* bar; unsigned x;
    unsigned nparts;
    volatile LAS unsigned* st;
};

__device__ __forceinline__ XcdBarrier xcd_barrier_post(unsigned* bar, volatile LAS unsigned* st) {
    XcdBarrier b; b.bar = bar; b.x = xb_xcc_id(); b.st = st; b.nparts = 0u;
    if (threadIdx.x == 0) (void)xb_add(&bar[XB_XCNT(b.x)], 1u);
    return b;
}
__device__ __forceinline__ void xcd_barrier_complete(unsigned* bar, unsigned x, unsigned& nloc, unsigned& nx, unsigned nparts) {
    const unsigned G = nparts ? nparts : gridDim.x * gridDim.y * gridDim.z;
    unsigned sum, cnt, mine, sp = 0u;
    for (;;) {
        sum = 0u; cnt = 0u; mine = 0u;
#pragma unroll
        for (unsigned j = 0; j < 16; ++j) { const unsigned c = xb_ld(&bar[XB_XCNT(j)]); sum += c; cnt += (c > 0u) ? 1u : 0u; mine = (j == x) ? c : mine; }
        if (sum == G) break;
        __builtin_amdgcn_s_sleep(1);
        if ((++sp & 255u) == 0u) { if (xb_ld(&bar[XB_TMO])) break; if (sp > XB_SPIN_CAP) { atomicAdd(&bar[XB_TMO], 1u); break; } }
    }
    nloc = mine > 0u ? mine : 1u; nx = cnt > 0u ? cnt : 1u;
}

__device__ __forceinline__ void xcd_barrier(const XcdBarrier& b) {
    asm volatile("s_waitcnt vmcnt(0)" ::: "memory");
    __syncthreads();
    if (threadIdx.x == 0) {
        unsigned* bar = b.bar;
        __builtin_amdgcn_s_waitcnt(0);
        unsigned nloc = b.st[0], nx = b.st[1];
        if (nloc == 0u) { xcd_barrier_complete(bar, b.x, nloc, nx, b.nparts); b.st[0] = nloc; b.st[1] = nx; }
        const unsigned old = xb_add(&bar[XB_XSUB(b.x)], 1u);
        const unsigned gen = old / nloc;
        if (old + 1u == (gen + 1u) * nloc) {
            __builtin_amdgcn_fence(__ATOMIC_RELEASE, "agent");
            asm volatile("s_waitcnt vmcnt(0)" ::: "memory");
            const unsigned og = xb_add(&bar[XB_TOP], 1u);
            const unsigned tg = og / nx;
            if (og + 1u == (tg + 1u) * nx) xb_add(&bar[XB_TOPGEN], 1u);
            else XB_SPIN(xb_ld(&bar[XB_TOPGEN]) == tg, bar);
            __builtin_amdgcn_fence(__ATOMIC_ACQUIRE, "agent");
            xb_add(&bar[XB_XGEN(b.x)], 1u);
            asm volatile("s_waitcnt vmcnt(0)" ::: "memory");
        } else {
            XB_SPIN(xb_ld(&bar[XB_XGEN(b.x)]) == gen, bar);
            __builtin_amdgcn_fence(__ATOMIC_ACQUIRE, "agent");
            asm volatile("s_waitcnt vmcnt(0)" ::: "memory");
        }
    }
    __syncthreads();
}


namespace att {
constexpr int KVBLK = 64;
constexpr float THR = 8.f;
#define SBAR() __builtin_amdgcn_sched_barrier(0)
__device__ __forceinline__ int crow(int r, int hi) { return (r & 3) + 8 * (r >> 2) + 4 * hi; }
__device__ __forceinline__ unsigned cvtpk(float lo, float hi) { unsigned r; asm volatile("v_cvt_pk_bf16_f32 %0, %1, %2" : "=v"(r) : "v"(lo), "v"(hi)); return r; }
template <int DQK> __device__ __forceinline__ int kswz(int row, int cb) { return row * (DQK * 2 + 16) + cb; }

template <int DQK> __device__ __forceinline__ void partialSM(f32x16& p0, f32x16& p1, float& m_reg, float& mn, float& alpha) {
  constexpr float SCALE = DQK == 128 ? 0.088388347648318440f : 0.072168783648703220f;
  constexpr float C = SCALE * 1.4426950408889634f;
  float pmax = p0[0];
#pragma unroll
  for (int r = 1; r < 16; ++r) pmax = fmaxf(pmax, p0[r]);
#pragma unroll
  for (int r = 0; r < 16; ++r) pmax = fmaxf(pmax, p1[r]);
  { auto rr = __builtin_amdgcn_permlane32_swap(__float_as_uint(pmax), __float_as_uint(pmax), false, false);
    pmax = fmaxf(__uint_as_float(rr[0]), __uint_as_float(rr[1])); }
  if (__builtin_expect(__all(pmax - m_reg <= THR / SCALE), 1)) { mn = m_reg; alpha = 1.f; }
  else { mn = fmaxf(m_reg, pmax); alpha = __builtin_amdgcn_exp2f((m_reg - mn) * C); m_reg = mn; }
  const float mnC = -mn * C;
#pragma unroll
  for (int r = 0; r < 16; ++r) p0[r] = fmaf(p0[r], C, mnC);
#pragma unroll
  for (int r = 0; r < 16; ++r) p1[r] = fmaf(p1[r], C, mnC);
#pragma unroll
  for (int r = 0; r < 16; ++r) p0[r] = __builtin_amdgcn_exp2f(p0[r]);
}
__device__ __forceinline__ void finishSM(f32x16& p0, f32x16& p1, float alpha, float& l_reg, bf16x8& pa0, bf16x8& pa1, bf16x8& pa2, bf16x8& pa3) {
#pragma unroll
  for (int r = 0; r < 16; ++r) p1[r] = __builtin_amdgcn_exp2f(p1[r]);
  float ps = 0;
#pragma unroll
  for (int r = 0; r < 16; ++r) ps += p0[r];
#pragma unroll
  for (int r = 0; r < 16; ++r) ps += p1[r];
  { auto rr = __builtin_amdgcn_permlane32_swap(__float_as_uint(ps), __float_as_uint(ps), false, false);
    ps = __uint_as_float(rr[0]) + __uint_as_float(rr[1]); }
  l_reg = l_reg * alpha + ps;
#define PK4(P, BASE, OUT) do { unsigned a0 = cvtpk(P[BASE + 0], P[BASE + 1]), a1 = cvtpk(P[BASE + 2], P[BASE + 3]);   \
    unsigned b0 = cvtpk(P[BASE + 4], P[BASE + 5]), b1 = cvtpk(P[BASE + 6], P[BASE + 7]);                              \
    auto r0 = __builtin_amdgcn_permlane32_swap(a0, b0, false, false); auto r1 = __builtin_amdgcn_permlane32_swap(a1, b1, false, false); \
    v4u w = {r0[0], r1[0], r0[1], r1[1]}; OUT = __builtin_bit_cast(bf16x8, w); } while (0)
  PK4(p0, 0, pa0); PK4(p0, 8, pa1); PK4(p1, 0, pa2); PK4(p1, 8, pa3);
#undef PK4
}
template <int DQK> __device__ __forceinline__ void qkt(f32x16& p0, f32x16& p1, const LAS char* Ks, const bf16x8* qr, const LAS char* qx, int r32, int hi) {
  p0 = f32x16{}; p1 = f32x16{};
#pragma unroll
  for (int d0 = 0; d0 < DQK / 16; ++d0) { const int cb = (d0 * 16 + hi * 8) * 2;
    bf16x8 b0 = *(const LAS bf16x8*)(Ks + kswz<DQK>(r32, cb));
    bf16x8 b1 = *(const LAS bf16x8*)(Ks + kswz<DQK>(32 + r32, cb));
    bf16x8 q; if (d0 < 8) q = qr[d0]; else q = *(const LAS bf16x8*)(qx + (d0 - 8) * 32);
    p0 = __builtin_amdgcn_mfma_f32_32x32x16_bf16(b0, q, p0, 0, 0, 0);
    p1 = __builtin_amdgcn_mfma_f32_32x32x16_bf16(b1, q, p1, 0, 0, 0);
    if ((d0 & 3) == 3 && d0 + 1 < DQK / 16) SBAR(); }
}
__device__ __forceinline__ int v_st(int k, int c) { const int kk = (k & ~0xC) | ((k & 4) << 1) | ((k & 8) >> 1); return ((kk >> 3) * 4 + (c >> 5)) * 512 + ((kk & 7) * 32 + (c & 31)) * 2; }
__device__ __forceinline__ int v_rd_base(int lane) { return ((lane & 3) << 3) | (((lane >> 2) & 3) << 6) | (((lane >> 4) & 1) << 5) | (((lane >> 5) & 1) << 8); }
constexpr int v_rd_off(int d0, int ks, int half) { return d0 * 512 + ks * 4096 + half * 2048; }
template <int OFF> __device__ __forceinline__ s16x4 tr_read(int vb) {
  s16x4 r; asm volatile("ds_read_b64_tr_b16 %0, %1 offset:%2" : "=&v"(r) : "v"(vb), "i"(OFF) : "memory"); return r;
}
template <int D0> __device__ __forceinline__ void pv_one(f32x16& od, int vb, bf16x8 pa0, bf16x8 pa1, bf16x8 pa2, bf16x8 pa3) {
  const s16x4 l0 = tr_read<v_rd_off(D0, 0, 0)>(vb), h0 = tr_read<v_rd_off(D0, 0, 1)>(vb), l1 = tr_read<v_rd_off(D0, 1, 0)>(vb), h1 = tr_read<v_rd_off(D0, 1, 1)>(vb);
  const s16x4 l2 = tr_read<v_rd_off(D0, 2, 0)>(vb), h2 = tr_read<v_rd_off(D0, 2, 1)>(vb), l3 = tr_read<v_rd_off(D0, 3, 0)>(vb), h3 = tr_read<v_rd_off(D0, 3, 1)>(vb);
  asm volatile("s_waitcnt lgkmcnt(0)" ::: "memory"); SBAR();
#define PK(L, H) (bf16x8){L[0], L[1], L[2], L[3], H[0], H[1], H[2], H[3]}
  od = __builtin_amdgcn_mfma_f32_32x32x16_bf16(pa0, PK(l0, h0), od, 0, 0, 0);
  od = __builtin_amdgcn_mfma_f32_32x32x16_bf16(pa1, PK(l1, h1), od, 0, 0, 0);
  od = __builtin_amdgcn_mfma_f32_32x32x16_bf16(pa2, PK(l2, h2), od, 0, 0, 0);
  od = __builtin_amdgcn_mfma_f32_32x32x16_bf16(pa3, PK(l3, h3), od, 0, 0, 0);
#undef PK
}
__device__ __forceinline__ void pv_d0(f32x16* o, int vb, bf16x8 pa0, bf16x8 pa1, bf16x8 pa2, bf16x8 pa3) {
  pv_one<0>(o[0], vb, pa0, pa1, pa2, pa3); pv_one<1>(o[1], vb, pa0, pa1, pa2, pa3); pv_one<2>(o[2], vb, pa0, pa1, pa2, pa3); pv_one<3>(o[3], vb, pa0, pa1, pa2, pa3);
}
__device__ __forceinline__ void apply_mask(f32x16& p0, f32x16& p1, int mtype, int krel0, int qi, int hi) {
  if (mtype == 0) return;
  const float ninf = -__builtin_inff();
#pragma unroll
  for (int r = 0; r < 16; ++r) { const int k0 = krel0 + crow(r, hi), k1 = k0 + 32;
    const bool ok0 = (mtype == 1) ? (k0 >= qi - 128) : (k0 <= qi + 128), ok1 = (mtype == 1) ? (k1 >= qi - 128) : (k1 <= qi + 128);
    p0[r] = ok0 ? p0[r] : ninf; p1[r] = ok1 ? p1[r] : ninf; }
}
struct Tile { gcbf kn; gcbf kr; gcbf v; int mtype; int krel0; };

__device__ __forceinline__ void rope_pair(bf16x8& a, bf16x8& b, gcfl ct, gcfl st) {
  const f32x4 c0 = *(const GAS f32x4*)ct, c1 = *(const GAS f32x4*)(ct + 4), s0 = *(const GAS f32x4*)st, s1 = *(const GAS f32x4*)(st + 4);
  const float cs[8] = {c0[0], c0[1], c0[2], c0[3], c1[0], c1[1], c1[2], c1[3]}, sn[8] = {s0[0], s0[1], s0[2], s0[3], s1[0], s1[1], s1[2], s1[3]};
  v4u ua = __builtin_bit_cast(v4u, a), ub = __builtin_bit_cast(v4u, b); v4u oa, ob;
#pragma unroll
  for (int w = 0; w < 4; ++w) { const float x1[2] = {bflo(ua[w]), bfhi(ua[w])}, x2[2] = {bflo(ub[w]), bfhi(ub[w])}; float y1[2], y2[2];
#pragma unroll
    for (int e = 0; e < 2; ++e) { const float c = cs[2 * w + e], sv = sn[2 * w + e]; y1[e] = x1[e] * c - x2[e] * sv; y2[e] = x2[e] * c + x1[e] * sv; }
    oa[w] = pk2(y1[0], y1[1]); ob[w] = pk2(y2[0], y2[1]); }
  a = __builtin_bit_cast(bf16x8, oa); b = __builtin_bit_cast(bf16x8, ob);
}

template <int DQK, int LDKN, int LDV, bool MASK, bool SINK, int SDEPTH, class TS>
__device__ __forceinline__ void attn_body(gcbf Qw, int rope, int prow, int pcol, gcfl rtab, int qi, float sink_l2, const TS& ts, int NT, gbfp Ow, LAS char* lds) {
  constexpr float SCALE = DQK == 128 ? 0.088388347648318440f : 0.072168783648703220f;
  constexpr float C = SCALE * 1.4426950408889634f;
  constexpr int SHM_K = KVBLK * (DQK * 2 + 16), SHM_V = KVBLK * 128 * 2;
  int tid = threadIdx.x; asm volatile("" : "+v"(tid));
  const int wid = tid >> 6, lane = tid & 63, r32 = lane & 31, hi = lane >> 5;
  LAS char* V_lds = lds; LAS char* K_lds = lds + 2 * SHM_V;
  LAS float* wsl = (LAS float*)(lds + 2 * SHM_V + 2 * SHM_K) + wid * 64; LAS float* li_l = wsl; LAS float* al_l = wsl + 32;
  float m_reg = -1e30f, l_reg = 0; f32x16 o[4] = {}; bf16x8 qr[8];
#pragma unroll
  for (int d0 = 0; d0 < 8; ++d0) qr[d0] = *(const GAS bf16x8*)(Qw + d0 * 16 + hi * 8);
  const LAS char* qx = lds + 2 * SHM_V + 2 * SHM_K + 2048 + wid * 4608 + r32 * 144 + hi * 16;
  if constexpr (DQK == 192) {
    bf16x8 x0 = *(const GAS bf16x8*)(Qw + 128 + hi * 8), x1 = *(const GAS bf16x8*)(Qw + 144 + hi * 8), x2 = *(const GAS bf16x8*)(Qw + 160 + hi * 8), x3 = *(const GAS bf16x8*)(Qw + 176 + hi * 8);
    if (rope) {
      rope_pair(x0, x1, rtab + (size_t)prow * 16 + hi * 8, rtab + 2048 + (size_t)prow * 16 + hi * 8);
      rope_pair(x2, x3, rtab + (size_t)pcol * 16 + hi * 8, rtab + 2048 + (size_t)pcol * 16 + hi * 8); }
    LAS char* qw_ = (LAS char*)qx; *(LAS bf16x8*)(qw_) = x0; *(LAS bf16x8*)(qw_ + 32) = x1; *(LAS bf16x8*)(qw_ + 64) = x2; *(LAS bf16x8*)(qw_ + 96) = x3;
  }
  const int sr = tid >> 4, sc = (tid & 15) * 8, vst0 = v_st(sr, sc), vst1 = v_st(32 + sr, sc);
  const int rr_ = tid >> 3, rc_ = (tid & 7) * 8;
  const int vb0 = (int)(uintptr_t)V_lds + v_rd_base(lane);
  struct { bf16x8 vs0, vs1, ks0, ks1, kx; } sr_[SDEPTH];
#define SLOAD(i, jt) do { const Tile t_ = ts(jt); sr_[i].vs0 = *(const GAS bf16x8*)(t_.v + (size_t)sr * LDV + sc); sr_[i].vs1 = *(const GAS bf16x8*)(t_.v + (size_t)(32 + sr) * LDV + sc); \
    sr_[i].ks0 = *(const GAS bf16x8*)(t_.kn + (size_t)sr * LDKN + sc); sr_[i].ks1 = *(const GAS bf16x8*)(t_.kn + (size_t)(32 + sr) * LDKN + sc); \
    if constexpr (DQK == 192) sr_[i].kx = *(const GAS bf16x8*)(t_.kr + (size_t)rr_ * 64 + rc_); } while (0)
#define SWRITE(b, i) do { *(LAS bf16x8*)(V_lds + (b) * SHM_V + vst0) = sr_[i].vs0; *(LAS bf16x8*)(V_lds + (b) * SHM_V + vst1) = sr_[i].vs1; const int kc = sc * 2; \
    *(LAS bf16x8*)(K_lds + (b) * SHM_K + kswz<DQK>(sr, kc)) = sr_[i].ks0; *(LAS bf16x8*)(K_lds + (b) * SHM_K + kswz<DQK>(32 + sr, kc)) = sr_[i].ks1; \
    if constexpr (DQK == 192) *(LAS bf16x8*)(K_lds + (b) * SHM_K + kswz<DQK>(rr_, 256 + rc_ * 2)) = sr_[i].kx; } while (0)
#define SWAIT() do { if constexpr (SDEPTH == 2) { if constexpr (DQK == 192) asm volatile("s_waitcnt vmcnt(5)" ::: "memory"); else asm volatile("s_waitcnt vmcnt(4)" ::: "memory"); } \
    else asm volatile("s_waitcnt vmcnt(0)" ::: "memory"); } while (0)
#define RESC(a) do { if (__any((a) < 1.f)) { if (hi == 0) al_l[r32] = (a); asm volatile("s_waitcnt lgkmcnt(0)" ::: "memory"); \
    _Pragma("unroll") for (int d = 0; d < 4; ++d) _Pragma("unroll") for (int r = 0; r < 16; ++r) o[d][r] *= al_l[crow(r, hi)]; } } while (0)
#define MASKT(pa_, pb_, jt) do { if constexpr (MASK) { const Tile t_ = ts(jt); apply_mask(pa_, pb_, t_.mtype, t_.krel0, qi, hi); } } while (0)
  f32x16 pA0, pA1, pB0, pB1; float mnA, mnB, alA, alB; bf16x8 pa0, pa1, pa2, pa3;
  constexpr int SE = 0, SO = SDEPTH - 1;
  SLOAD(SE, 0); asm volatile("s_waitcnt vmcnt(0)" ::: "memory"); SWRITE(0, SE); __syncthreads();
  qkt<DQK>(pA0, pA1, K_lds, qr, qx, r32, hi); MASKT(pA0, pA1, 0); partialSM<DQK>(pA0, pA1, m_reg, mnA, alA);
  SLOAD(SO, 1); if constexpr (SDEPTH == 2) { if (2 < NT) SLOAD(SE, 2); }
  SWAIT(); SWRITE(1, SO); __syncthreads();
  for (int j = 1; j + 1 < NT; j += 2) {
    SBAR(); qkt<DQK>(pB0, pB1, K_lds + SHM_K, qr, qx, r32, hi); MASKT(pB0, pB1, j);
    finishSM(pA0, pA1, alA, l_reg, pa0, pa1, pa2, pa3); SBAR();
    SLOAD(SO, j + SDEPTH); SBAR();
    pv_d0(o, vb0, pa0, pa1, pa2, pa3); partialSM<DQK>(pB0, pB1, m_reg, mnB, alB);
    __syncthreads(); SWAIT(); SWRITE(0, SE);
    RESC(alB); __syncthreads();
    SBAR(); qkt<DQK>(pA0, pA1, K_lds, qr, qx, r32, hi); MASKT(pA0, pA1, j + 1);
    finishSM(pB0, pB1, alB, l_reg, pa0, pa1, pa2, pa3); SBAR();
    if (SDEPTH == 1 || j + 3 < NT) SLOAD(SE, j + 1 + SDEPTH); SBAR();
    pv_d0(o, vb0 + SHM_V, pa0, pa1, pa2, pa3); partialSM<DQK>(pA0, pA1, m_reg, mnA, alA);
    __syncthreads(); SWAIT(); SWRITE(1, SO);
    RESC(alA); __syncthreads();
  }
  SBAR(); qkt<DQK>(pB0, pB1, K_lds + SHM_K, qr, qx, r32, hi); MASKT(pB0, pB1, NT - 1);
  finishSM(pA0, pA1, alA, l_reg, pa0, pa1, pa2, pa3); SBAR();
  pv_d0(o, vb0, pa0, pa1, pa2, pa3); partialSM<DQK>(pB0, pB1, m_reg, mnB, alB);
  __syncthreads(); RESC(alB);
  finishSM(pB0, pB1, alB, l_reg, pa0, pa1, pa2, pa3); SBAR();
  pv_d0(o, vb0 + SHM_V, pa0, pa1, pa2, pa3);
  if constexpr (SINK) l_reg += __builtin_amdgcn_exp2f(sink_l2 - m_reg * C);
  if (hi == 0) li_l[r32] = l_reg; asm volatile("s_waitcnt lgkmcnt(0)" ::: "memory");
  float rli[16];
#pragma unroll
  for (int r = 0; r < 16; ++r) rli[r] = __builtin_amdgcn_rcpf(li_l[crow(r, hi)]);
  __syncthreads();
  LAS bf16* ost = (LAS bf16*)(lds + wid * 8704);
#pragma unroll
  for (int r = 0; r < 16; ++r) { const int orow = crow(r, hi);
#pragma unroll
    for (int d0 = 0; d0 < 4; ++d0) ost[orow * 136 + d0 * 32 + r32] = (bf16)f2bf(o[d0][r] * rli[r]); }
  asm volatile("s_waitcnt lgkmcnt(0)" ::: "memory");
#pragma unroll
  for (int i = 0; i < 8; ++i) { const int orow = i * 4 + (lane >> 4), ch = lane & 15;
    *(GAS v4u*)(Ow + (size_t)orow * 4096 + ch * 8) = *(const LAS v4u*)(ost + orow * 136 + ch * 8); }
  __syncthreads();
#undef SLOAD
#undef SWRITE
#undef SWAIT
#undef RESC
#undef MASKT
}
}

struct Args { const float* in[38]; float* out; unsigned char* ws; };
template <class T> __device__ __forceinline__ T launder(T p) { asm volatile("" : "+s"(p)); return p; }
template <class T> __device__ __forceinline__ T* launder_g(T* p) { asm volatile("" : "+s"(p)); return p; }
struct Frame {
    LAS unsigned char* lds;
    gu32* ctl;
    int tid, lane, wave;
    int vcu, G, gw, NGW;
    const __attribute__((address_space(4))) Args* A;
    float* out;
    unsigned char* ws;
    unsigned char* wsw;
};
enum { I_X = 0, I_C, I_CTX, I_CCTX, I_WMOD, I_BMOD, I_WIN, I_WOUT, I_LN1G, I_LN1B, I_WFF1, I_WFF2, I_LN2G, I_LN2B, I_SINK, I_CONVW, I_CONVB, I_LWA, I_LBA, I_LWI, I_LBI, I_LAM,
       I_QNORM, I_KVNORM, I_WQB, I_WKVB, I_MUP, I_MUN, I_W0, I_W2, I_A0, I_A2, I_G2, I_KK, I_KA, I_RK, I_LNG, I_LNB };
__device__ __forceinline__ int row_s(int row) { return row < SEQ ? 0 : (row < M_LAT ? 1 : 2); }
__device__ __forceinline__ const float* mod_ptr(const Frame& F, int l, int s, int chunk) { return (const float*)(F.ws + WS_MOD) + ((size_t)(l * 3 + s) * 6 + chunk) * DM; }

__device__ __forceinline__ void transpose_item(const float* W, int N, int Kvalid, bf16* WT, int ldt, const float* kscale, LAS float* scr, int k0, int n0, int lane) {
#pragma unroll
    for (int i = 0; i < 32; ++i) { const int kk = 2 * i + (lane >> 5); const int k = k0 + kk; float v = 0.f;
        if (k < Kvalid) { v = W[(size_t)k * N + n0 + (lane & 31)]; if (kscale) v *= kscale[k]; }
        scr[kk * 33 + (lane & 31)] = v; }
    LDS_WAIT(); asm volatile("" ::: "memory");
    const int c = lane & 7;
#pragma unroll
    for (int j = 0; j < 4; ++j) { const int n = (lane >> 3) + 8 * j; const LAS float* s = scr + (8 * c) * 33 + n;
        v4u o; o.x = pk2(s[0 * 33], s[1 * 33]); o.y = pk2(s[2 * 33], s[3 * 33]); o.z = pk2(s[4 * 33], s[5 * 33]); o.w = pk2(s[6 * 33], s[7 * 33]);
        *(v4u*)(WT + (size_t)(n0 + n) * ldt + k0 + 8 * c) = o; }
    LDS_WAIT(); asm volatile("" ::: "memory");
}
__device__ __forceinline__ void convert_weights(Frame& F, int l, int widx, int nw) {
    LAS float* scr = (LAS float*)(F.lds + F.wave * 16384);
    constexpr int I1 = 64 * 271, I2 = 64 * 128, I3 = 64 * 512, I4 = 256 * 128, I5 = 16 * 48, I6 = 8 * 64, I7 = 32 * 8, I8 = 2 * 32, I9 = 2 * 32, I10 = 3 * 32;
    constexpr int NIT = I1 + I2 + I3 + I4 + I5 + I6 + I7 + I8 + I9 + I10;
    unsigned char* ws = F.ws + (l ? WSET_STRIDE : 0);
    for (int it = widx; it < NIT; it += nw) {
        int r = it;
        if (r < I1) { transpose_item(F.A->in[I_WIN] + (size_t)l * DM * DIN, DIN, DM, (bf16*)(ws + WS_WIN), DM, nullptr, scr, 64 * (r / 271), 32 * (r % 271), F.lane); continue; } r -= I1;
        if (r < I2) { transpose_item(F.A->in[I_WOUT] + (size_t)l * DM * DM, DM, DM, (bf16*)(ws + WS_WOUT), DM, nullptr, scr, 64 * (r / 128), 32 * (r % 128), F.lane); continue; } r -= I2;
        if (r < I3) { transpose_item(F.A->in[I_WFF1] + (size_t)l * DM * DFF, DFF, DM, (bf16*)(ws + WS_WFF1), DM, nullptr, scr, 64 * (r / 512), 32 * (r % 512), F.lane); continue; } r -= I3;
        if (r < I4) { transpose_item(F.A->in[I_WFF2] + (size_t)l * DFF * DM, DM, DFF, (bf16*)(ws + WS_WFF2), DFF, nullptr, scr, 64 * (r / 128), 32 * (r % 128), F.lane); continue; } r -= I4;
        if (r < I5) { transpose_item(F.A->in[I_WQB] + (size_t)l * 1024 * 1536, 1536, 1024, (bf16*)(ws + WS_WQB), 1024, F.A->in[I_QNORM] + l * 1024, scr, 64 * (r / 48), 32 * (r % 48), F.lane); continue; } r -= I5;
        if (r < I6) { transpose_item(F.A->in[I_WKVB] + (size_t)l * 512 * 2048, 2048, 512, (bf16*)(ws + WS_WKVB), 512, F.A->in[I_KVNORM] + l * 512, scr, 64 * (r / 64), 32 * (r % 64), F.lane); continue; } r -= I6;
        if (r < I7) { const int mat = r >> 3, sub = r & 7, gate = mat & 1, dn = mat >> 1;
            const int d = dn >> 3, n = dn & 7;
            const float* src = (gate ? F.A->in[I_LWI] : F.A->in[I_LWA]) + ((size_t)(l * 2 + d) * 8 + n) * 128 * 128;
            bf16* dst = (bf16*)(ws + WS_WLRU) + ((size_t)(d * 2 + gate) * 8 + n) * 128 * 128;
            transpose_item(src, 128, 128, dst, 128, nullptr, scr, 64 * (sub >> 2), 32 * (sub & 3), F.lane); continue; } r -= I7;
        if (r < I8) { const int d = r >> 5; transpose_item(F.A->in[I_W2] + (size_t)(l * 2 + d) * 64 * 1024, 1024, 64, (bf16*)(ws + WS_W2T) + (size_t)d * 1024 * 64, 64, nullptr, scr, 0, 32 * (r & 31), F.lane); continue; } r -= I8;
        if (r < I9) { const int d = r >> 5; transpose_item(F.A->in[I_A2] + (size_t)(l * 2 + d) * 64 * 1024, 1024, 64, (bf16*)(ws + WS_A2T) + (size_t)d * 1024 * 64, 64, nullptr, scr, 0, 32 * (r & 31), F.lane); continue; } r -= I9;
        transpose_item(F.A->in[I_G2] + (size_t)l * 160 * 1024, 1024, 160, (bf16*)(ws + WS_G2T), 192, nullptr, scr, 64 * (r / 32), 32 * (r % 32), F.lane);
    }
    { unsigned zz = 0u; asm volatile("" : "+v"(zz)); v4u z = {zz, zz, zz, zz}; v4u* p = (v4u*)((bf16*)(ws + WS_WIN) + (size_t)DIN * DM);
      for (int i = widx * 64 + F.lane; i < 32 * DM / 8; i += nw * 64) p[i] = z; }
}

__device__ __forceinline__ void mod_partials(Frame& F) {
    LAS float* sl = (LAS float*)F.lds;
    for (int it = F.vcu; it < 2 * 32 * 12; it += F.G) {
        const int l = it / 384, ks = (it / 12) % 32, cc = it % 12;
        __syncthreads();
        if (F.tid < 384) { const int s = F.tid >> 7, k = ks * 128 + (F.tid & 127); const float c = s < 2 ? F.A->in[I_C][s * DM + k] : F.A->in[I_CCTX][k]; sl[F.tid] = c / (1.f + __expf(-c)); }
        __syncthreads();
        const float* wp = F.A->in[I_WMOD] + ((size_t)l * DM + ks * 128) * 24576 + cc * 2048 + F.tid * 4;
        f32x4 a0 = {0.f, 0.f, 0.f, 0.f}, a1 = a0, a2 = a0;
#pragma unroll 8
        for (int k = 0; k < 128; ++k) { const f32x4 w = *(const f32x4*)(wp + (size_t)k * 24576); a0 += w * sl[k]; a1 += w * sl[128 + k]; a2 += w * sl[256 + k]; }
        float* op = (float*)(F.ws + WS_MODP) + ((size_t)(l * 32 + ks) * 3) * 24576 + cc * 2048 + F.tid * 4;
        *(f32x4*)(op) = a0; *(f32x4*)(op + 24576) = a1; *(f32x4*)(op + 2 * 24576) = a2;
    }
    __syncthreads();
}
__device__ __forceinline__ void mod_reduce(Frame& F) {
    for (int i = F.vcu * NTHR + F.tid; i < 2 * 3 * 24576; i += F.G * NTHR) {
        const int l = i / (3 * 24576), s = (i / 24576) % 3, n = i % 24576;
        float a = F.A->in[I_BMOD][l * 24576 + n];
        const float* pp = (const float*)(F.ws + WS_MODP) + ((size_t)(l * 32) * 3 + s) * 24576 + n;
#pragma unroll 8
        for (int ks = 0; ks < 32; ++ks) a += pp[(size_t)ks * 3 * 24576];
        ((float*)(F.ws + WS_MOD))[i] = a;
    }
}

__device__ __forceinline__ void sum_partials_row(const Frame& F, const float* yp, size_t stride, bf16* ydst) {
    int lane = F.lane; asm volatile("" : "+v"(lane));
#pragma unroll 2
    for (int j = 0; j < 16; ++j) { const int c = 4 * lane + 256 * j; f32x4 y = *(const f32x4*)(yp + c);
#pragma unroll
        for (int sp = 1; sp < 8; ++sp) y += *(const f32x4*)(yp + sp * stride + c);
        v2u w; w.x = pk2(y.x, y.y); w.y = pk2(y.z, y.w); *(v2u*)(ydst + c) = w; }
}
template <int MODE>
__device__ __forceinline__ void ln_row(const Frame& F, const float* xsrc, const bf16* Y, const float* ga, const float* lg, const float* lb, float* xdst,
                                       bool domod, const float* sc, const float* sh, bf16* hrow) {
    f32x4 v[16]; float s = 0.f;
#pragma unroll
    for (int j = 0; j < 16; ++j) { const int c = 4 * F.lane + 256 * j; v[j] = *(const f32x4*)(xsrc + c);
        if (MODE == 1) { const v2u yw = *(const v2u*)(Y + c); const f32x4 y = {bflo(yw.x), bfhi(yw.x), bflo(yw.y), bfhi(yw.y)}, g = *(const f32x4*)(ga + c); v[j] = v[j] * ALPHA + g * y; }
        s += (v[j].x + v[j].y) + (v[j].z + v[j].w);
        if ((j & 7) == 7) asm volatile("" ::: "memory"); }
    float mean = wave_sum(s) * (1.f / DM), s2 = 0.f;
#pragma unroll
    for (int j = 0; j < 16; ++j) { v[j] = v[j] - mean; s2 += (v[j].x * v[j].x + v[j].y * v[j].y) + (v[j].z * v[j].z + v[j].w * v[j].w); }
    float rstd = 1.f / sqrtf(wave_sum(s2) * (1.f / DM) + LN_EPS);
    if (MODE == 1) {
        s = 0.f;
#pragma unroll
        for (int j = 0; j < 16; ++j) { const int c = 4 * F.lane + 256 * j; const f32x4 g = *(const f32x4*)(lg + c), b = *(const f32x4*)(lb + c); v[j] = v[j] * rstd * g + b;
            *(f32x4*)(xdst + c) = v[j]; s += (v[j].x + v[j].y) + (v[j].z + v[j].w);
            if ((j & 7) == 7) asm volatile("" ::: "memory"); }
        if (!domod) return;
        mean = wave_sum(s) * (1.f / DM); s2 = 0.f;
#pragma unroll
        for (int j = 0; j < 16; ++j) { v[j] = v[j] - mean; s2 += (v[j].x * v[j].x + v[j].y * v[j].y) + (v[j].z * v[j].z + v[j].w * v[j].w); }
        rstd = 1.f / sqrtf(wave_sum(s2) * (1.f / DM) + LN_EPS);
    }
#pragma unroll
    for (int j = 0; j < 16; ++j) { const int c = 4 * F.lane + 256 * j; const f32x4 a = *(const f32x4*)(sc + c), b = *(const f32x4*)(sh + c);
        const f32x4 o = v[j] * rstd * (a + 1.f) + b; v2u w; w.x = pk2(o.x, o.y); w.y = pk2(o.z, o.w); *(v2u*)(hrow + c) = w; }
}

__device__ __forceinline__ void shift4(const bf16* P, unsigned eo, bool hp, bool hn, const float* mup, const float* mun, unsigned mo, float (&u)[4]) {
    const v2u xc = ldg<v2u>(P, eo * 2u); v2u xp = {0u, 0u}, xn = {0u, 0u};
    if (hp) xp = ldg<v2u>(P, (eo - DINP) * 2u); if (hn) xn = ldg<v2u>(P, (eo + DINP) * 2u);
    const f32x4 mp = ldg<f32x4>(mup, mo * 4u), mn = ldg<f32x4>(mun, mo * 4u);
    const float c[4] = {bflo(xc.x), bfhi(xc.x), bflo(xc.y), bfhi(xc.y)}, p[4] = {bflo(xp.x), bfhi(xp.x), bflo(xp.y), bfhi(xp.y)}, n[4] = {bflo(xn.x), bfhi(xn.x), bflo(xn.y), bfhi(xn.y)};
#pragma unroll
    for (int e = 0; e < 4; ++e) u[e] = c[e] + mp[e] * (p[e] - c[e]) + mn[e] * (n[e] - c[e]);
}
__device__ __forceinline__ void st4bf(void* base, unsigned eo, float a, float b, float c, float d) { v2u w; w.x = pk2(a, b); w.y = pk2(c, d); stg<v2u>(base, eo * 2u, w); }

__device__ __forceinline__ void rwkv_feat_item(Frame& F, int l, int item) {
    F.tid = ltid(); F.lane = F.tid & 63;
    int row0, seq_lo, seq_hi;
    if (item < 16) { const int b = item >> 3; seq_lo = M_LAT + b * NCTX; seq_hi = seq_lo + NCTX; row0 = seq_lo + (item & 7) * 32; }
    else { const int it = item - 16, b = it >> 8; seq_lo = b * SEQ; seq_hi = seq_lo + SEQ; row0 = seq_lo + (it & 255) * 32; }
    const bf16* P = (const bf16*)(F.ws + WS_P);
    LAS bf16* ACT = (LAS bf16*)F.lds;
    const float* mup = F.A->in[I_MUP] + l * RWC; const float* mun = F.A->in[I_MUN] + l * RWC;
    __syncthreads();
    { const int tok = F.tid >> 4, jc = F.tid & 15, row = row0 + tok; const bool hp = row > seq_lo, hn = row + 1 < seq_hi;
      const bf16* pr = P + (size_t)row * DINP + C_RWL;
#pragma unroll
      for (int i = 0; i < 13; ++i) { const int j = jc * 2 + 32 * i;
          const unsigned xc = *(const unsigned*)(pr + j), xp = hp ? *(const unsigned*)(pr - DINP + j) : 0u, xn = hn ? *(const unsigned*)(pr + DINP + j) : 0u;
          float u[2];
#pragma unroll
          for (int e = 0; e < 2; ++e) { const float c = e ? bfhi(xc) : bflo(xc), p = e ? bfhi(xp) : bflo(xp), n = e ? bfhi(xn) : bflo(xn);
              float v = c + mup[3072 + j + e] * (p - c) + mun[3072 + j + e] * (n - c);
              if (j < 128) v = tanhf_(v); else if (j >= 256) v = sigmoidf_(v);
              u[e] = v; }
          *(LAS unsigned*)(ACT + tok * 424 + j) = pk2(u[0], u[1]); } }
    __syncthreads();
    const int tok = F.lane & 31, hi = F.lane >> 5, row = row0 + tok;
    const bf16* W2T = (const bf16*)(F.wsw + WS_W2T); const bf16* A2T = (const bf16*)(F.wsw + WS_A2T); const bf16* G2T = (const bf16*)(F.wsw + WS_G2T);
    bf16* RWF = (bf16*)(F.ws + WS_RWF); const size_t RS = (size_t)M_TOT * 1024;
    const float* kkv = F.A->in[I_KK] + l * 1024; const float* kav = F.A->in[I_KA] + l * 1024; const float* rkv = F.A->in[I_RK] + l * 1024;
    const float* w0f = F.A->in[I_W0] + (size_t)(l * 2) * 1024; const float* a0f = F.A->in[I_A0] + (size_t)(l * 2) * 1024;
    const LAS bf16* actl = ACT + tok * 424 + hi * 8;
    LAS unsigned char* TI = F.lds + 27136 + F.wave * 10752; LAS unsigned char* TO = TI + 3 * 2720;
#define RF_LOADTILE(ti, colbase) do { _Pragma("unroll") for (int i_ = 0; i_ < 3; ++i_) { const int p_ = F.lane + 64 * i_; if (p_ < 136) { const int rr_ = p_ >> 2, cp_ = p_ & 3, gr_ = row0 - 1 + rr_; \
        v4u v_ = {0u, 0u, 0u, 0u}; if (gr_ >= seq_lo && gr_ < seq_hi) v_ = ldg<v4u>(P, ((unsigned)gr_ * DINP + (colbase) + 8 * cp_) * 2u); *(LAS v4u*)(TI + (ti) * 2720 + rr_ * 80 + cp_ * 16) = v_; } } } while (0)
#define RF_SHIFT4(ti, g_, mo_, u_) do { const LAS unsigned char* q_ = TI + (ti) * 2720 + (tok + 1) * 80 + (8 * (g_) + 4 * hi) * 2; const v2u xc_ = *(const LAS v2u*)q_, xp_ = *(const LAS v2u*)(q_ - 80), xn_ = *(const LAS v2u*)(q_ + 80); \
        const f32x4 mp_ = ldg<f32x4>(mup, (mo_) * 4u), mn_ = ldg<f32x4>(mun, (mo_) * 4u); \
        const float c_[4] = {bflo(xc_.x), bfhi(xc_.x), bflo(xc_.y), bfhi(xc_.y)}, pp_[4] = {bflo(xp_.x), bfhi(xp_.x), bflo(xp_.y), bfhi(xp_.y)}, nn_[4] = {bflo(xn_.x), bfhi(xn_.x), bflo(xn_.y), bfhi(xn_.y)}; \
        _Pragma("unroll") for (int e_ = 0; e_ < 4; ++e_) u_[e_] = c_[e_] + mp_[e_] * (pp_[e_] - c_[e_]) + mn_[e_] * (nn_[e_] - c_[e_]); } while (0)
#define RF_FLUSH(arr_, cblk_, o_) do { _Pragma("unroll") for (int g_ = 0; g_ < 4; ++g_) *(LAS v2u*)(TO + tok * 80 + (8 * g_ + 4 * hi) * 2) = o_[g_]; \
        asm volatile("s_waitcnt lgkmcnt(0)" ::: "memory"); \
        _Pragma("unroll") for (int i_ = 0; i_ < 2; ++i_) { const int p_ = F.lane + 64 * i_, rr_ = p_ >> 2, cp_ = p_ & 3; const v4u v_ = *(const LAS v4u*)(TO + rr_ * 80 + cp_ * 16); \
            stg<v4u>(RWF + (arr_) * RS, ((unsigned)(row0 + rr_) * 1024u + (cblk_) + 8 * cp_) * 2u, v_); } \
        asm volatile("s_waitcnt lgkmcnt(0)" ::: "memory"); } while (0)
#pragma unroll 1
    for (int hh = 0; hh < 2; ++hh) {
        const int h = 2 * F.wave + hh, cbase = h * 64;
        float ssq = 0.f;
        RF_LOADTILE(0, C_RWK + cbase); RF_LOADTILE(1, C_RWK + cbase + 32);
        asm volatile("s_waitcnt lgkmcnt(0)" ::: "memory");
#pragma unroll
        for (int bg = 0; bg < 8; ++bg) { const unsigned c4 = cbase + (bg >> 2) * 32 + 8 * (bg & 3) + 4 * hi; float uk[4];
            RF_SHIFT4(bg >> 2, bg & 3, 1024 + c4, uk); const f32x4 k4 = ldg<f32x4>(kkv, c4 * 4u);
#pragma unroll
            for (int e = 0; e < 4; ++e) { const float q = uk[e] * k4[e]; ssq += q * q; } }
        ssq = half_swap_sum(ssq);
        const float rn = 1.f / fmaxf(sqrtf(ssq), 1e-12f);
        float sb = 0.f;
#pragma unroll 1
        for (int blk = 0; blk < 2; ++blk) {
            const unsigned cblk = cbase + blk * 32, cha = cblk + tok;
            RF_LOADTILE(0, C_RWR + cblk); RF_LOADTILE(1, C_RWK + cblk); RF_LOADTILE(2, C_RWV + cblk);
#pragma unroll 1
            for (int d = 0; d < 2; ++d) { f32x16 aw = {};
#pragma unroll
                for (int ks = 0; ks < 4; ++ks) { const bf16x8 bw = *(const LAS bf16x8*)(actl + d * 64 + ks * 16); const bf16x8 w_ = ldg<bf16x8>(W2T, ((d * 1024 + cha) * 64 + ks * 16 + hi * 8) * 2u);
                    aw = __builtin_amdgcn_mfma_f32_32x32x16_bf16(w_, bw, aw, 0, 0, 0); }
                v2u o[4];
#pragma unroll
                for (int g = 0; g < 4; ++g) { const f32x4 w0 = ldg<f32x4>(w0f, (d * 1024 + cblk + 8 * g + 4 * hi) * 4u); float e4[4];
#pragma unroll
                    for (int e = 0; e < 4; ++e) e4[e] = __expf(-softplusf_(-(w0[e] + aw[4 * g + e])) - 0.5f);
                    o[g].x = pk2(e4[0], e4[1]); o[g].y = pk2(e4[2], e4[3]); }
                RF_FLUSH(4 + d, cblk, o); }
            { f32x16 ag = {};
#pragma unroll
              for (int ks = 0; ks < 10; ++ks) { const bf16x8 bg_ = *(const LAS bf16x8*)(actl + 256 + ks * 16); const bf16x8 g_ = ldg<bf16x8>(G2T, (cha * 192 + ks * 16 + hi * 8) * 2u);
                  ag = __builtin_amdgcn_mfma_f32_32x32x16_bf16(g_, bg_, ag, 0, 0, 0); }
              v2u o[4];
#pragma unroll
              for (int g = 0; g < 4; ++g) { o[g].x = pk2(ag[4 * g], ag[4 * g + 1]); o[g].y = pk2(ag[4 * g + 2], ag[4 * g + 3]); }
              RF_FLUSH(8, cblk, o); }
            { f32x16 aaf = {}, aab = {};
#pragma unroll
              for (int ks = 0; ks < 4; ++ks) { const bf16x8 baf = *(const LAS bf16x8*)(actl + 128 + ks * 16), bab = *(const LAS bf16x8*)(actl + 192 + ks * 16);
                  const bf16x8 a_f = ldg<bf16x8>(A2T, (cha * 64 + ks * 16 + hi * 8) * 2u), a_b = ldg<bf16x8>(A2T, ((1024 + cha) * 64 + ks * 16 + hi * 8) * 2u);
                  aaf = __builtin_amdgcn_mfma_f32_32x32x16_bf16(a_f, baf, aaf, 0, 0, 0); aab = __builtin_amdgcn_mfma_f32_32x32x16_bf16(a_b, bab, aab, 0, 0, 0); }
              v2u oR[4], oK[4], oV[4], oKK[4], oAF[4], oAB[4];
#pragma unroll
              for (int g = 0; g < 4; ++g) { const unsigned c4 = cblk + 8 * g + 4 * hi; float ur[4], uk[4], uv[4];
                  RF_SHIFT4(0, g, c4, ur); RF_SHIFT4(1, g, 1024 + c4, uk); RF_SHIFT4(2, g, 2048 + c4, uv);
                  const f32x4 a0a = ldg<f32x4>(a0f, c4 * 4u), a0b = ldg<f32x4>(a0f, (1024 + c4) * 4u), kk4 = ldg<f32x4>(kkv, c4 * 4u), ka4 = ldg<f32x4>(kav, c4 * 4u), rk4 = ldg<f32x4>(rkv, c4 * 4u);
                  float af[4], ab[4], kk[4];
#pragma unroll
                  for (int e = 0; e < 4; ++e) { const int r = 4 * g + e;
                      af[e] = sigmoidf_(a0a[e] + aaf[r]); ab[e] = sigmoidf_(a0b[e] + aab[r]); kk[e] = uk[e] * kk4[e] * rn;
                      const float kdf = uk[e] * (1.f + (af[e] - 1.f) * ka4[e]), kdb = uk[e] * (1.f + (ab[e] - 1.f) * ka4[e]);
                      sb += ur[e] * rk4[e] * (kdf + kdb); }
                  oR[g].x = pk2(ur[0], ur[1]); oR[g].y = pk2(ur[2], ur[3]); oK[g].x = pk2(uk[0], uk[1]); oK[g].y = pk2(uk[2], uk[3]); oV[g].x = pk2(uv[0], uv[1]); oV[g].y = pk2(uv[2], uv[3]);
                  oKK[g].x = pk2(kk[0], kk[1]); oKK[g].y = pk2(kk[2], kk[3]); oAF[g].x = pk2(af[0], af[1]); oAF[g].y = pk2(af[2], af[3]); oAB[g].x = pk2(ab[0], ab[1]); oAB[g].y = pk2(ab[2], ab[3]); }
              RF_FLUSH(0, cblk, oR); RF_FLUSH(1, cblk, oK); RF_FLUSH(2, cblk, oV); RF_FLUSH(3, cblk, oKK); RF_FLUSH(6, cblk, oAF); RF_FLUSH(7, cblk, oAB); }
        }
        sb = half_swap_sum(sb);
        if (hi == 0) ((float*)(F.ws + WS_SB))[(size_t)row * 16 + h] = sb;
    }
#undef RF_LOADTILE
#undef RF_SHIFT4
#undef RF_FLUSH
}

__device__ __forceinline__ float gelu_tanh(float x) { return 0.5f * x * (1.f + tanhf_(0.7978845608028654f * (x + 0.044715f * x * x * x))); }
template <bool PASS3>
__device__ __forceinline__ void lru_item(Frame& F, int l, int item) {
    F.tid = ltid(); F.lane = F.tid & 63;
    const int sc = item >> 3, nb = item & 7, b = sc / NCH, ch = sc % NCH;
    int row0, seq_lo, seq_hi;
    if (ch < 8) { seq_lo = M_LAT + b * NCTX; seq_hi = seq_lo + NCTX; row0 = seq_lo + ch * 32; }
    else { seq_lo = b * SEQ; seq_hi = seq_lo + SEQ; row0 = seq_lo + (ch - 8) * 32; }
    const bf16* P = (const bf16*)(F.ws + WS_P);
    LAS float* U = (LAS float*)F.lds;
    LAS bf16* UA = (LAS bf16*)(F.lds + 16384);
    LAS float* AB = (LAS float*)(F.lds + 32768);
    __syncthreads();
    { const int tok = F.tid >> 4, c8 = (F.tid & 15) * 8, cg = nb * 128 + c8; float acc[8];
      const float* cb = F.A->in[I_CONVB] + l * 1024 + cg;
#pragma unroll
      for (int e = 0; e < 8; ++e) acc[e] = cb[e];
#pragma unroll
      for (int j = 0; j < 4; ++j) { const int r = row0 + tok - 2 + j;
          if (r >= seq_lo && r < seq_hi) { const v4u x = *(const v4u*)(P + (size_t)r * DINP + C_LRUX + cg); const float* cw = F.A->in[I_CONVW] + (size_t)(l * 4 + j) * 1024 + cg;
#pragma unroll
              for (int w = 0; w < 4; ++w) { acc[2 * w] += cw[2 * w] * bflo(x[w]); acc[2 * w + 1] += cw[2 * w + 1] * bfhi(x[w]); } } }
      *(LAS f32x4*)(U + tok * 128 + c8) = (f32x4){acc[0], acc[1], acc[2], acc[3]}; *(LAS f32x4*)(U + tok * 128 + c8 + 4) = (f32x4){acc[4], acc[5], acc[6], acc[7]};
      v4u o; o.x = pk2(acc[0], acc[1]); o.y = pk2(acc[2], acc[3]); o.z = pk2(acc[4], acc[5]); o.w = pk2(acc[6], acc[7]);
      *(LAS v4u*)(UA + tok * 136 + c8) = o; }
    __syncthreads();
    { const int dir = F.wave >> 2, cq = F.wave & 3, l32 = F.lane & 31, hi = F.lane >> 5, chn = cq * 32 + l32, cg = nb * 128 + chn;
      const bf16* Wr = (const bf16*)(F.wsw + WS_WLRU) + ((size_t)(dir * 2 + 0) * 8 + nb) * 16384 + (size_t)chn * 128;
      const bf16* Wi = (const bf16*)(F.wsw + WS_WLRU) + ((size_t)(dir * 2 + 1) * 8 + nb) * 16384 + (size_t)chn * 128;
      f32x16 accr = {}, acci = {};
#pragma unroll
      for (int ks = 0; ks < 8; ++ks) { const int ko = ks * 16 + hi * 8;
          const bf16x8 a = *(const LAS bf16x8*)(UA + l32 * 136 + ko); const bf16x8 br = *(const bf16x8*)(Wr + ko), bi = *(const bf16x8*)(Wi + ko);
          accr = __builtin_amdgcn_mfma_f32_32x32x16_bf16(a, br, accr, 0, 0, 0); acci = __builtin_amdgcn_mfma_f32_32x32x16_bf16(a, bi, acci, 0, 0, 0); }
      const float ba = F.A->in[I_LBA][(l * 2 + dir) * 1024 + cg], bi_ = F.A->in[I_LBI][(l * 2 + dir) * 1024 + cg], sp = softplusf_(-F.A->in[I_LAM][(l * 2 + dir) * 1024 + cg]);
#pragma unroll
      for (int r = 0; r < 16; ++r) { const int tok = att::crow(r, hi); const float u = U[tok * 128 + chn];
          const float rg = sigmoidf_(accr[r] + ba), ig = sigmoidf_(acci[r] + bi_), la = -8.f * rg * sp, a = __expf(la), x2 = 2.f * la;
          const float em = x2 * (1.f + x2 * (0.5f + x2 * (0.16666667f + x2 * (0.041666668f + x2 * (0.0083333338f + x2 * 0.0013888889f)))));
          const float bc = __builtin_amdgcn_sqrtf(x2 < -0.5f ? 1.f - a * a : -em) * (ig * u);
          AB[(dir * 2 + 0) * 4096 + tok * 128 + chn] = a; AB[(dir * 2 + 1) * 4096 + tok * 128 + chn] = bc; } }
    __syncthreads();
    if (F.tid < 256) { const int dir = F.tid >> 7, chn = F.tid & 127, cg = nb * 128 + chn; const size_t ci = ((size_t)(dir * 2 + b) * NCH + ch) * 1024 + cg;
        LAS float* Aa = AB + (dir * 2) * 4096 + chn; LAS float* Bb = AB + (dir * 2 + 1) * 4096 + chn;
        if (!PASS3) { float h = 0.f, ap = 1.f;
#pragma unroll 8
            for (int s = 0; s < 32; ++s) { const int tok = dir ? 31 - s : s; const float a = Aa[tok * 128]; h = a * h + Bb[tok * 128]; ap *= a;
                if (s == 0 && dir == 1 && ch == 7) ((float*)(F.ws + WS_QUIRK))[b * 1024 + cg] = h; }
            ((float*)(F.ws + WS_CA))[ci] = ap; ((float*)(F.ws + WS_CB))[ci] = h;
        } else { float h = ((const float*)(F.ws + WS_HIN))[ci];
#pragma unroll 8
            for (int s = 0; s < 32; ++s) { const int tok = dir ? 31 - s : s; h = Aa[tok * 128] * h + Bb[tok * 128]; Bb[tok * 128] = h; } } }
    if (PASS3) { __syncthreads();
        const int tok = F.tid >> 4, c8 = (F.tid & 15) * 8, cg = nb * 128 + c8, row = row0 + tok;
        const v4u y = *(const v4u*)(P + (size_t)row * DINP + C_LRUY + cg); float o[8];
#pragma unroll
        for (int w = 0; w < 4; ++w) { const float h0 = AB[4096 + tok * 128 + c8 + 2 * w] + AB[3 * 4096 + tok * 128 + c8 + 2 * w], h1 = AB[4096 + tok * 128 + c8 + 2 * w + 1] + AB[3 * 4096 + tok * 128 + c8 + 2 * w + 1];
            o[2 * w] = h0 * gelu_tanh(bflo(y[w])); o[2 * w + 1] = h1 * gelu_tanh(bfhi(y[w])); }
        v4u ov; ov.x = pk2(o[0], o[1]); ov.y = pk2(o[2], o[3]); ov.z = pk2(o[4], o[5]); ov.w = pk2(o[6], o[7]);
        *(v4u*)((bf16*)(F.ws + WS_MIX) + (size_t)row * DM + 1024 + cg) = ov; }
}
__device__ __forceinline__ void lru_carry(Frame& F, int blk) {
    F.tid = ltid(); F.lane = F.tid & 63;
    const int gid = blk * NTHR + F.tid; if (gid >= 4096) return;
    const int dir = gid >> 11, b = (gid >> 10) & 1, cg = gid & 1023;
    const float* CA = (const float*)(F.ws + WS_CA) + ((size_t)(dir * 2 + b) * NCH) * 1024 + cg; const float* CB = (const float*)(F.ws + WS_CB) + ((size_t)(dir * 2 + b) * NCH) * 1024 + cg;
    float* HIN = (float*)(F.ws + WS_HIN) + ((size_t)(dir * 2 + b) * NCH) * 1024 + cg;
    float h = 0.f;
    if (dir == 0) {
#pragma unroll 8
        for (int c = 0; c < NCH; ++c) { HIN[(size_t)c * 1024] = h; h = CA[(size_t)c * 1024] * h + CB[(size_t)c * 1024]; }
    } else {
        for (int c = 7; c >= 0; --c) { HIN[(size_t)c * 1024] = h; h = CA[(size_t)c * 1024] * h + CB[(size_t)c * 1024]; }
        h = ((const float*)(F.ws + WS_QUIRK))[b * 1024 + cg];
#pragma unroll 8
        for (int c = NCH - 1; c >= 8; --c) { HIN[(size_t)c * 1024] = h; h = CA[(size_t)c * 1024] * h + CB[(size_t)c * 1024]; }
    }
}

__device__ __forceinline__ void rope_table(Frame& F) {
    const int i = F.vcu * NTHR + F.tid; if (i >= 2048) return;
    const int pos = i >> 4, f = i & 15; float s, c; sincosf((float)pos * exp2f(-(float)f * (13.287712379549449f / 16.f)), &s, &c);
    float* t = (float*)(F.ws + WS_ROPE); t[i] = c; t[2048 + i] = s;
}
__device__ __forceinline__ void row_prep(Frame& F, int row) {
    F.tid = ltid(); F.lane = F.tid & 63;
    bf16* pr = (bf16*)(F.ws + WS_P) + (size_t)row * DINP; const int lane = F.lane;
    const bool lat = row < M_LAT; const int t = row & (SEQ - 1); const float prow = (float)(t >> 6), pcol = (float)(t & 63);
    { const v4u a = *(const v4u*)(pr + C_QA + lane * 16), b = *(const v4u*)(pr + C_QA + lane * 16 + 8); float ss = 0.f;
#pragma unroll
      for (int w = 0; w < 4; ++w) { const float x0 = bflo(a[w]), x1 = bfhi(a[w]), x2 = bflo(b[w]), x3 = bfhi(b[w]); ss += x0 * x0 + x1 * x1 + x2 * x2 + x3 * x3; }
      ss = wave_sum(ss); if (lane == 0) ((float*)(F.ws + WS_RSQ))[row] = 1.f / sqrtf(ss * (1.f / 1024.f) + RMS_EPS); }
    { const v4u a = *(const v4u*)(pr + C_KVA + lane * 8); float ss = 0.f;
#pragma unroll
      for (int w = 0; w < 4; ++w) { const float x0 = bflo(a[w]), x1 = bfhi(a[w]); ss += x0 * x0 + x1 * x1; }
      ss = wave_sum(ss); if (lane == 0) ((float*)(F.ws + WS_RSKV))[row] = 1.f / sqrtf(ss * (1.f / 512.f) + RMS_EPS); }
    bf16* kr = (bf16*)(F.ws + WS_KR) + (size_t)row * 64;
    if (lat) {
        { const int part = lane >> 5, sub = lane & 31;
          const float inv = exp2f(-(float)sub * (13.287712379549449f / 32.f)); float sn, cs; sincosf((part ? pcol : prow) * inv, &sn, &cs);
#pragma unroll
          for (int hd = 0; hd < 10; ++hd) { bf16* qb = pr + (hd < 8 ? C_SWAQ + hd * 128 : C_SWAK + (hd - 8) * 128) + part * 64;
              const float x1 = bf2f(qb[sub]), x2 = bf2f(qb[sub + 32]); qb[sub] = (bf16)f2bf(x1 * cs - x2 * sn); qb[sub + 32] = (bf16)f2bf(x2 * cs + x1 * sn); } }
        if (lane < 32) { const int part = lane >> 4, i = lane & 15; const bf16* src = pr + C_KR + part * 32;
          const float inv = exp2f(-(float)i * (13.287712379549449f / 16.f)); float s, c; sincosf((part ? pcol : prow) * inv, &s, &c);
          const float x1 = bf2f(src[i]), x2 = bf2f(src[i + 16]);
          kr[part * 32 + i] = (bf16)f2bf(x1 * c - x2 * s); kr[part * 32 + i + 16] = (bf16)f2bf(x2 * c + x1 * s); }
    } else kr[lane] = pr[C_KR + lane];
}

__device__ __forceinline__ float allred16(float x) { return row_sum16(x); }
__device__ __forceinline__ int scan_row(int s, int dir, int b) {
    if (s < NCTX) return M_LAT + b * NCTX + (dir ? NCTX - 1 - s : s);
    const int t = s - NCTX; return b * SEQ + (dir ? SEQ - 1 - t : t);
}
__device__ __forceinline__ void rwkv_scan(Frame& F, int l, int chain) {
    F.tid = ltid(); F.lane = F.tid & 63;
    const int dir = chain >> 5, b = (chain >> 4) & 1, h = chain & 15;
    constexpr int CT = 16, NCHK = (NCTX + SEQ) / CT, STEPF = 392, BUFF = CT * STEPF;
    LAS float* buf = (LAS float*)F.lds; LAS float* ybuf = (LAS float*)(F.lds + 3 * BUFF * 4);
    gcbf RWF = (gcbf)(F.ws + WS_RWF); const size_t RS = (size_t)M_TOT * 1024;
    gflp YS = (gflp)(F.ws + WS_YS) + (size_t)dir * M_TOT * 1024;
    const bool ldr = F.tid < 256; const int lst = (F.tid >> 4) & 15, lq = F.tid & 15, lc = h * 64 + 4 * lq;
    const f32x4 ka4 = *(const GAS f32x4*)((gcfl)F.A->in[I_KA] + l * 1024 + lc);
    v2u gr = {0u, 0u}, gk = gr, gv = gr, gkk = gr, ge = gr, ga = gr;
#define RW_LOAD(c) do { if (ldr) { const size_t o_ = (size_t)scan_row((c) * CT + lst, dir, b) * 1024 + lc; gr = *(const GAS v2u*)(RWF + 0 * RS + o_); gk = *(const GAS v2u*)(RWF + 1 * RS + o_); gv = *(const GAS v2u*)(RWF + 2 * RS + o_); \
        gkk = *(const GAS v2u*)(RWF + 3 * RS + o_); ge = *(const GAS v2u*)(RWF + (4 + dir) * RS + o_); ga = *(const GAS v2u*)(RWF + (6 + dir) * RS + o_); } } while (0)
#define RW_WRITE(bi) do { if (ldr) { LAS float* d_ = buf + (bi) * BUFF + lst * STEPF + 4 * lq; \
        const float r_[4] = {bflo(gr.x), bfhi(gr.x), bflo(gr.y), bfhi(gr.y)}, k_[4] = {bflo(gk.x), bfhi(gk.x), bflo(gk.y), bfhi(gk.y)}, v_[4] = {bflo(gv.x), bfhi(gv.x), bflo(gv.y), bfhi(gv.y)}; \
        const float q_[4] = {bflo(gkk.x), bfhi(gkk.x), bflo(gkk.y), bfhi(gkk.y)}, e_[4] = {bflo(ge.x), bfhi(ge.x), bflo(ge.y), bfhi(ge.y)}, a_[4] = {bflo(ga.x), bfhi(ga.x), bflo(ga.y), bfhi(ga.y)}; \
        f32x4 w4, kd4, kk4, b4, wr4, v4; float sbr = 0.f, skr = 0.f; \
        _Pragma("unroll") for (int e = 0; e < 4; ++e) { w4[e] = __expf(-e_[e]); kd4[e] = k_[e] * (1.f + (a_[e] - 1.f) * ka4[e]); kk4[e] = q_[e]; b4[e] = q_[e] * a_[e]; wr4[e] = w4[e] * r_[e]; v4[e] = v_[e]; sbr += b4[e] * r_[e]; skr += kd4[e] * r_[e]; } \
        sbr = row_sum16(sbr); skr = row_sum16(skr); \
        *(LAS f32x4*)(d_) = w4; *(LAS f32x4*)(d_ + 64) = kd4; *(LAS f32x4*)(d_ + 128) = kk4; *(LAS f32x4*)(d_ + 192) = b4; *(LAS f32x4*)(d_ + 256) = wr4; *(LAS f32x4*)(d_ + 320) = v4; \
        if (lq == 0) *(LAS f32x2*)(buf + (bi) * BUFF + lst * STEPF + 384) = (f32x2){sbr, skr}; } } while (0)
#define RW_FLUSH(c) do { if (ldr) { const f32x4 y_ = *(const LAS f32x4*)(ybuf + ((c) & 1) * (CT * 64) + lst * 64 + 4 * lq); *(GAS f32x4*)(YS + (size_t)scan_row((c) * CT + lst, dir, b) * 1024 + lc) = y_; } } while (0)
    __syncthreads();
    RW_LOAD(0); RW_WRITE(0); RW_LOAD(1); RW_WRITE(1); RW_LOAD(2);
    __syncthreads();
    const int kg = F.lane & 15, rg = F.lane >> 4, r0 = 8 * F.wave + 2 * rg;
    f32x2 St[4] = {{0.f, 0.f}, {0.f, 0.f}, {0.f, 0.f}, {0.f, 0.f}};
    int bc = 0, bw = 2;
#pragma unroll 1
    for (int c = 0; c < NCHK; ++c) {
        if (c + 2 < NCHK) { RW_WRITE(bw); if (c + 3 < NCHK) RW_LOAD(c + 3); }
        if (c > 0) RW_FLUSH(c - 1);
        const LAS float* bb = buf + bc * BUFF + 4 * kg; const LAS float* vb = buf + bc * BUFF + 320 + r0; const LAS float* sb = buf + bc * BUFF + 384;
        LAS float* yb = ybuf + (c & 1) * (CT * 64) + r0;
        f32x4 w4 = *(const LAS f32x4*)(bb), kd4 = *(const LAS f32x4*)(bb + 64), kk4 = *(const LAS f32x4*)(bb + 128), b4 = *(const LAS f32x4*)(bb + 192), wr4 = *(const LAS f32x4*)(bb + 256);
        f32x2 v2 = *(const LAS f32x2*)(vb), s2 = *(const LAS f32x2*)(sb);
#pragma unroll 4
        for (int st = 0; st < CT; ++st) {
            const int sn = (st + 1 < CT ? st + 1 : st) * STEPF;
            const f32x4 nw4 = *(const LAS f32x4*)(bb + sn), nkd4 = *(const LAS f32x4*)(bb + sn + 64), nkk4 = *(const LAS f32x4*)(bb + sn + 128), nb4 = *(const LAS f32x4*)(bb + sn + 192), nwr4 = *(const LAS f32x4*)(bb + sn + 256);
            const f32x2 nv2 = *(const LAS f32x2*)(vb + sn), ns2 = *(const LAS f32x2*)(sb + sn);
            f32x2 p = St[0] * kk4[0], z = St[0] * wr4[0];
            p = St[1] * kk4[1] + p; z = St[1] * wr4[1] + z; p = St[2] * kk4[2] + p; z = St[2] * wr4[2] + z; p = St[3] * kk4[3] + p; z = St[3] * wr4[3] + z;
            float p0 = p.x, p1 = p.y, z0 = z.x, z1 = z.y;
            asm volatile("s_nop 1\n\t"
                "v_add_f32_dpp %0, %0, %0 row_ror:8 row_mask:0xf bank_mask:0xf\n\tv_add_f32_dpp %1, %1, %1 row_ror:8 row_mask:0xf bank_mask:0xf\n\tv_add_f32_dpp %2, %2, %2 row_ror:8 row_mask:0xf bank_mask:0xf\n\tv_add_f32_dpp %3, %3, %3 row_ror:8 row_mask:0xf bank_mask:0xf\n\t"
                "v_add_f32_dpp %0, %0, %0 row_ror:4 row_mask:0xf bank_mask:0xf\n\tv_add_f32_dpp %1, %1, %1 row_ror:4 row_mask:0xf bank_mask:0xf\n\tv_add_f32_dpp %2, %2, %2 row_ror:4 row_mask:0xf bank_mask:0xf\n\tv_add_f32_dpp %3, %3, %3 row_ror:4 row_mask:0xf bank_mask:0xf\n\t"
                "v_add_f32_dpp %0, %0, %0 row_ror:2 row_mask:0xf bank_mask:0xf\n\tv_add_f32_dpp %1, %1, %1 row_ror:2 row_mask:0xf bank_mask:0xf\n\tv_add_f32_dpp %2, %2, %2 row_ror:2 row_mask:0xf bank_mask:0xf\n\tv_add_f32_dpp %3, %3, %3 row_ror:2 row_mask:0xf bank_mask:0xf\n\t"
                "v_add_f32_dpp %0, %0, %0 row_ror:1 row_mask:0xf bank_mask:0xf\n\tv_add_f32_dpp %1, %1, %1 row_ror:1 row_mask:0xf bank_mask:0xf\n\tv_add_f32_dpp %2, %2, %2 row_ror:1 row_mask:0xf bank_mask:0xf\n\tv_add_f32_dpp %3, %3, %3 row_ror:1 row_mask:0xf bank_mask:0xf\n\t"
                "s_nop 1"
                : "+v"(p0), "+v"(p1), "+v"(z0), "+v"(z1));
            const f32x2 pp = {p0, p1}, zz = {z0, z1};
            *(LAS f32x2*)(yb + st * 64) = zz - pp * s2.x + v2 * s2.y;
#pragma unroll
            for (int i = 0; i < 4; ++i) { const f32x2 vk = v2 * kd4[i]; St[i] = (St[i] * w4[i] + vk) - pp * b4[i]; }
            w4 = nw4; kd4 = nkd4; kk4 = nkk4; b4 = nb4; wr4 = nwr4; v2 = nv2; s2 = ns2;
        }
        __syncthreads();
        bc = bc == 2 ? 0 : bc + 1; bw = bw == 2 ? 0 : bw + 1;
    }
    RW_FLUSH(NCHK - 1);
#undef RW_LOAD
#undef RW_WRITE
#undef RW_FLUSH
}
__device__ __forceinline__ void rwkv_out_row(Frame& F, int l, int row) {
    F.tid = ltid(); F.lane = F.tid & 63;
    const int c0 = F.lane * 16; const float* yf = (const float*)(F.ws + WS_YS) + (size_t)row * 1024 + c0; const float* yb = yf + (size_t)M_TOT * 1024;
    float y[16]; float s = 0.f;
#pragma unroll
    for (int j = 0; j < 4; ++j) { const f32x4 a = *(const f32x4*)(yf + 4 * j), b = *(const f32x4*)(yb + 4 * j);
#pragma unroll
        for (int e = 0; e < 4; ++e) { y[4 * j + e] = a[e] + b[e]; s += y[4 * j + e]; } }
    s = quad_sum(s); const float mu = s * (1.f / 64.f); float q = 0.f;
#pragma unroll
    for (int e = 0; e < 16; ++e) { y[e] -= mu; q += y[e] * y[e]; }
    q = quad_sum(q); const float rstd = 1.f / sqrtf(q * (1.f / 64.f) + GN_EPS);
    const bf16* RWF = (const bf16*)(F.ws + WS_RWF); const size_t RS = (size_t)M_TOT * 1024, o = (size_t)row * 1024 + c0;
    const float sbv = ((const float*)(F.ws + WS_SB))[(size_t)row * 16 + (F.lane >> 2)];
    const float* lg = F.A->in[I_LNG] + l * 1024 + c0; const float* lb = F.A->in[I_LNB] + l * 1024 + c0;
    bf16* dst = (bf16*)(F.ws + WS_MIX) + (size_t)row * DM + 3072 + c0;
#pragma unroll
    for (int hf = 0; hf < 2; ++hf) { const v4u vv = *(const v4u*)(RWF + 2 * RS + o + 8 * hf), gg = *(const v4u*)(RWF + 8 * RS + o + 8 * hf); float r[8];
#pragma unroll
        for (int w = 0; w < 4; ++w) { const int e = 8 * hf + 2 * w;
            r[2 * w] = (y[e] * rstd * lg[e] + lb[e] + sbv * bflo(vv[w])) * bflo(gg[w]); r[2 * w + 1] = (y[e + 1] * rstd * lg[e + 1] + lb[e + 1] + sbv * bfhi(vv[w])) * bfhi(gg[w]); }
        v4u ov; ov.x = pk2(r[0], r[1]); ov.y = pk2(r[2], r[3]); ov.z = pk2(r[4], r[5]); ov.w = pk2(r[6], r[7]); *(v4u*)(dst + 8 * hf) = ov; }
}

struct MlaTiles { gcbf KV; gcbf KR; int ctx_row0, lat_row0, h;
    __device__ __forceinline__ att::Tile operator()(int j) const { const int row = j < 4 ? ctx_row0 + 64 * j : lat_row0 + 64 * (j - 4);
        att::Tile t; t.kn = KV + (size_t)row * 2048 + h * 256; t.v = t.kn + 128; t.kr = KR + (size_t)row * 64; t.mtype = 0; t.krel0 = 0; return t; } };
struct SwaTiles { gcbf P; int blk_row0, ctx_row0, kvh, nwin, has_prev, has_next;
    __device__ __forceinline__ att::Tile operator()(int j) const { att::Tile t; int row; t.mtype = 0; t.krel0 = 0;
        if (j >= nwin) row = ctx_row0 + 64 * (j - nwin);
        else if (j < 2) row = blk_row0 + 64 * j;
        else if (has_prev && j < 4) { row = blk_row0 - 128 + 64 * (j - 2); t.mtype = 1; t.krel0 = -128 + 64 * (j - 2); }
        else { const int sub = j - 2 - 2 * has_prev; row = blk_row0 + 128 + 64 * sub; t.mtype = 2; t.krel0 = 128 + 64 * sub; }
        t.kn = P + (size_t)row * DINP + C_SWAK + kvh * 128; t.v = P + (size_t)row * DINP + C_SWAV + kvh * 128; t.kr = nullptr; return t; } };

#ifndef MLA_SDEPTH
#define MLA_SDEPTH 1
#endif
__device__ __forceinline__ void mla_item(Frame& F, int b, int h, int qb, bool ctxq) {
    F.tid = ltid(); F.lane = F.tid & 63;
    const int r32 = F.lane & 31; const int t = qb * 256 + F.wave * 32 + r32;
    const int roww0 = ctxq ? M_LAT + b * NCTX + F.wave * 32 : b * SEQ + qb * 256 + F.wave * 32;
    gcbf Qw = (gcbf)(F.ws + WS_Q) + (size_t)(roww0 + r32) * 1536 + h * 192;
    MlaTiles ts{(gcbf)(F.ws + WS_KV), (gcbf)(F.ws + WS_KR), M_LAT + b * NCTX, b * SEQ, h};
    gbfp Ow = (gbfp)(F.ws + WS_MIX) + (size_t)roww0 * DM + 2048 + h * 128;
    att::attn_body<192, 2048, 2048, false, false, MLA_SDEPTH>(Qw, ctxq ? 0 : 1, t >> 6, t & 63, (gcfl)(F.ws + WS_ROPE), 0, 0.f, ts, ctxq ? 4 : 132, Ow, (LAS char*)F.lds);
}
__device__ __forceinline__ void swa_item(Frame& F, int l, int b, int n, int kvh, int half, bool ctxq, int hq_ctx) {
    F.tid = ltid(); F.lane = F.tid & 63;
    const int r32 = F.lane & 31; gcbf P = (gcbf)(F.ws + WS_P);
    int hq, qi, roww0, t;
    if (ctxq) { hq = hq_ctx; kvh = hq >> 2; qi = 0; roww0 = M_LAT + b * NCTX + F.wave * 32; t = 0; }
    else { hq = kvh * 4 + 2 * half + (F.wave >> 2); qi = (F.wave & 3) * 32 + r32; roww0 = b * SEQ + n * 128 + (F.wave & 3) * 32; t = n * 128 + qi; }
    gcbf Qw = P + (size_t)(roww0 + r32) * DINP + C_SWAQ + hq * 128;
    SwaTiles ts; ts.P = P; ts.blk_row0 = b * SEQ + n * 128; ts.ctx_row0 = M_LAT + b * NCTX; ts.kvh = kvh;
    ts.has_prev = (!ctxq && n > 0) ? 1 : 0; ts.has_next = (!ctxq && n < SEQ / 128 - 1) ? 1 : 0; ts.nwin = ctxq ? 0 : 2 + 2 * ts.has_prev + 2 * ts.has_next;
    gbfp Ow = (gbfp)(F.ws + WS_MIX) + (size_t)roww0 * DM + hq * 128;
    const float sink_l2 = F.A->in[I_SINK][l * 8 + hq] * 1.4426950408889634f;
    att::attn_body<128, DINP, DINP, true, true, 2>(Qw, 0, 0, 0, (gcfl)nullptr, qi, sink_l2, ts, ts.nwin + 4, Ow, (LAS char*)F.lds);
}

#ifndef DBG_PHASES
#define DBG_PHASES 0xfffff
#endif
#define PH(n) ((DBG_PHASES >> (n)) & 1)
#ifndef DUP_PHASES
#define DUP_PHASES 0
#endif
#define REP(n) _Pragma("unroll") for (int rep_ = 0; rep_ < (((DUP_PHASES >> (n)) & 1) ? 2 : 1); ++rep_)
__global__ void __launch_bounds__(NTHR, 2) mk_fwd(Args args) {
    extern __shared__ __attribute__((aligned(16))) unsigned char lds[];
    Frame F;
    F.lds = (LAS unsigned char*)lds;
    F.tid = threadIdx.x; F.lane = F.tid & 63; F.wave = __builtin_amdgcn_readfirstlane(F.tid >> 6);
    F.G = gridDim.x; { const int bx = blockIdx.x; F.vcu = (F.G % 8 == 0) ? (bx % 8) * (F.G / 8) + bx / 8 : bx; }
    F.gw = F.vcu * NWAVES + F.wave; F.NGW = F.G * NWAVES;
    F.ws = args.ws; F.out = args.out; F.ctl = (gu32*)(args.ws + WS_CTL);
    F.A = (const __attribute__((address_space(4))) Args*)__builtin_amdgcn_kernarg_segment_ptr();
    for (int u = F.tid; u < (LDS_BYTES - LDSCTL_OFF) / 4; u += NTHR) ((LAS unsigned*)(F.lds + LDSCTL_OFF))[u] = 0u;
    __syncthreads();
    XcdBarrier bar = xcd_barrier_post((unsigned*)(args.ws + WS_CTL) + 4096, (volatile LAS unsigned*)(F.lds + MISC_OFF) + 8);
    const bool rwkv_blk = (blockIdx.x & 3) == 0;
    XcdBarrier bar2; bar2.bar = (unsigned*)(args.ws + WS_CTL) + 8192; bar2.x = 0; bar2.st = (volatile LAS unsigned*)(F.lds + MISC_OFF) + 12; bar2.nparts = gridDim.x - ((gridDim.x + 3) >> 2);
    if (!rwkv_blk) { const unsigned np_ = bar2.nparts; bar2 = xcd_barrier_post((unsigned*)(args.ws + WS_CTL) + 8192, (volatile LAS unsigned*)(F.lds + MISC_OFF) + 12); bar2.nparts = np_; }
#define SUB_BAR() do { bar2.bar = launder(bar2.bar); bar2.x = launder(bar2.x); xcd_barrier(bar2); F.ws = launder_g(F.ws); F.wsw = F.ws + (size_t)lcur * WSET_STRIDE; F.A = launder(F.A); F.tid = ltid(); F.lane = F.tid & 63; } while (0)
#define GRID_BAR() do { bar.bar = launder(bar.bar); bar.x = launder(bar.x); xcd_barrier(bar); F.ws = launder_g(F.ws); F.wsw = F.ws + (size_t)lcur * WSET_STRIDE; F.A = launder(F.A); F.tid = ltid(); F.lane = F.tid & 63; } while (0)
    const int bx = blockIdx.x; int lcur = 0; F.wsw = F.ws;
    bf16* H = (bf16*)(F.ws + WS_H); float* X = (float*)(F.ws + WS_X);

    REP(0) if (PH(0)) { mod_partials(F);
    convert_weights(F, 0, F.gw, F.NGW); }
    GRID_BAR();
    if (PH(1)) { mod_reduce(F); rope_table(F); }
    GRID_BAR();

#pragma unroll 1
    for (int l = 0; l < 2; ++l) {
        lcur = l; F.wsw = F.ws + (size_t)l * WSET_STRIDE;
        const bool wctx = (l == 0);
        const int MO = wctx ? M_TOT : M_LAT;
        if (PH(2) && l == 0) {
            for (int row = F.gw; row < M_TOT; row += F.NGW) { const int s = row_s(row);
                const float* xs = row < M_LAT ? F.A->in[I_X] + (size_t)row * DM : F.A->in[I_CTX] + (size_t)(row - M_LAT) * DM;
                ln_row<0>(F, xs, nullptr, nullptr, nullptr, nullptr, nullptr, true, mod_ptr(F, 0, s, 1), mod_ptr(F, 0, s, 0), H + (size_t)row * DM); }
        }
        GRID_BAR();
        REP(3) if (PH(3)) { pg8::Gemm g{H, (const bf16*)(F.wsw + WS_WIN), M_TOT, DINP, DM, DM, DM}; pg8::StaticOrder S; S.init(M_TOT, DINP, F.G, bx);
          pg8::EpiBf16<0> E{(bf16*)(F.ws + WS_P), DINP, nullptr};
          pg8::gemm_phase<pg8::EpiBf16<0>, pg8::StaticOrder, true, true>(F.lds, g, S, E); }
        GRID_BAR();
        REP(4) if (PH(4)) for (int it = F.vcu; it < 528; it += F.G) rwkv_feat_item(F, l, it);
        REP(5) if (PH(5)) for (int it = F.vcu; it < 2 * NCH * 8; it += F.G) lru_item<false>(F, l, it);
        __syncthreads();
        if (PH(6)) for (int row = F.gw; row < M_TOT; row += F.NGW) row_prep(F, row);
        GRID_BAR();
        REP(8) if (rwkv_blk) { const int nrw = (F.G + 3) >> 2; REP(18) if (PH(8)) for (int chain = bx >> 2; chain < 64; chain += nrw) rwkv_scan(F, l, chain); }
        else REP(19) { const int aw = (bx >> 2) * 3 + (bx & 3) - 1, naw = F.G - ((F.G + 3) >> 2);
            if (PH(7) && aw < 8) lru_carry(F, aw);
            if (PH(7)) { pg8::Gemm g{(const bf16*)(F.ws + WS_P) + C_QA, (const bf16*)(F.wsw + WS_WQB), M_TOT, 1536, 1024, DINP, 1024}; pg8::StaticOrder S; S.init(M_TOT, 1536, naw, aw);
              pg8::EpiBf16<2> E{(bf16*)(F.ws + WS_Q), 1536, (const float*)(F.ws + WS_RSQ)};
              pg8::gemm_phase<pg8::EpiBf16<2>, pg8::StaticOrder, true, true>(F.lds, g, S, E); }
            if (PH(7)) { pg8::Gemm g{(const bf16*)(F.ws + WS_P) + C_KVA, (const bf16*)(F.wsw + WS_WKVB), M_TOT, 2048, 512, DINP, 512}; pg8::StaticOrder S; S.init(M_TOT, 2048, naw, aw);
              pg8::EpiBf16<2> E{(bf16*)(F.ws + WS_KV), 2048, (const float*)(F.ws + WS_RSKV)};
              pg8::gemm_phase<pg8::EpiBf16<2>, pg8::StaticOrder, true, true>(F.lds, g, S, E); }
            SUB_BAR();
            if (PH(9)) for (int it = aw; it < 512; it += naw) mla_item(F, it >> 8, (it >> 5) & 7, it & 31, false);
            if (PH(9) && wctx) for (int it = aw; it < 16; it += naw) mla_item(F, it >> 3, it & 7, 0, true);
            if (PH(10)) for (int it = aw; it < 512; it += naw) swa_item(F, l, it >> 8, (it >> 2) & 63, (it >> 1) & 1, it & 1, false, 0);
            if (PH(10) && wctx) for (int it = aw; it < 16; it += naw) swa_item(F, l, it >> 3, 0, 0, 0, true, it & 7);
            if (PH(11)) for (int it = aw; it < 2 * NCH * 8; it += naw) { if (!wctx && ((it >> 3) % NCH) < 8) continue; lru_item<true>(F, l, it); }
            if (l == 0) { __syncthreads(); convert_weights(F, 1, aw * NWAVES + F.wave, naw * NWAVES); }
            else { SUB_BAR();
                pg8::Gemm g{(const bf16*)(F.ws + WS_MIX), (const bf16*)(F.wsw + WS_WOUT), M_LAT, DM, 3072, DM, DM}; pg8::StaticOrder S; S.init(M_LAT, DM, naw, aw);
                pg8::EpiBf16<0> E{(bf16*)(F.ws + WS_Y1), DM, nullptr};
                pg8::gemm_phase<pg8::EpiBf16<0>, pg8::StaticOrder, true, true>(F.lds, g, S, E); }
        }
        GRID_BAR();
        REP(12) if (PH(12)) for (int row = F.gw; row < MO; row += F.NGW) rwkv_out_row(F, l, row);
        GRID_BAR();
        REP(13) if (PH(13)) {
          if (l == 0) { pg8::Gemm g{(const bf16*)(F.ws + WS_MIX), (const bf16*)(F.wsw + WS_WOUT), M_LAT, DM, DM, DM, DM}; pg8::StaticOrder S; S.init(M_LAT, DM, F.G, bx);
            pg8::EpiBf16<0> E{(bf16*)(F.ws + WS_Y1), DM, nullptr};
            pg8::gemm_phase<pg8::EpiBf16<0>, pg8::StaticOrder, true, true>(F.lds, g, S, E); }
          else { pg8::Gemm g{(const bf16*)(F.ws + WS_MIX) + 3072, (const bf16*)(F.wsw + WS_WOUT) + 3072, M_LAT, DM, 1024, DM, DM}; pg8::StaticOrder S; S.init(M_LAT, DM, F.G, bx);
            pg8::EpiBf16<3> E{(bf16*)(F.ws + WS_Y1), DM, nullptr};
            pg8::gemm_phase<pg8::EpiBf16<3>, pg8::StaticOrder, true, true>(F.lds, g, S, E); }
          if (wctx) {
              pg8::Gemm g2{(const bf16*)(F.ws + WS_MIX) + (size_t)M_LAT * DM, (const bf16*)(F.wsw + WS_WOUT), M_CTX, DM, DM / 8, DM, DM}; pg8::SplitOrder S2; S2.init(M_CTX, DM, DM / 8, bx);
              pg8::EpiF32 E2{(float*)(F.ws + WS_YP), DM, (size_t)M_CTX * DM};
              pg8::gemm_phase<pg8::EpiF32, pg8::SplitOrder, true, true>(F.lds, g2, S2, E2); } }
        GRID_BAR();
        if (PH(14)) for (int row = F.gw; row < MO; row += F.NGW) { const int s = row_s(row);
            const float* xs = (l == 0) ? (row < M_LAT ? F.A->in[I_X] + (size_t)row * DM : F.A->in[I_CTX] + (size_t)(row - M_LAT) * DM) : X + (size_t)row * DM;
            bf16* yrow = (bf16*)(F.ws + WS_Y1) + (size_t)row * DM;
            if (row >= M_LAT) sum_partials_row(F, (const float*)(F.ws + WS_YP) + (size_t)(row - M_LAT) * DM, (size_t)M_CTX * DM, yrow);
            ln_row<1>(F, xs, yrow, mod_ptr(F, l, s, 2), F.A->in[I_LN1G] + l * DM, F.A->in[I_LN1B] + l * DM, X + (size_t)row * DM,
                      true, mod_ptr(F, l, s, 4), mod_ptr(F, l, s, 3), H + (size_t)row * DM); }
        GRID_BAR();
        REP(15) if (PH(15)) { pg8::Gemm g{H, (const bf16*)(F.wsw + WS_WFF1), MO, DFF, DM, DM, DM}; pg8::StaticOrder S; S.init(MO, DFF, F.G, bx);
          pg8::EpiBf16<1> E{(bf16*)(F.ws + WS_HID), DFF, nullptr};
          pg8::gemm_phase<pg8::EpiBf16<1>, pg8::StaticOrder, true, true>(F.lds, g, S, E); }
        GRID_BAR();
        REP(16) if (PH(16)) { pg8::Gemm g{(const bf16*)(F.ws + WS_HID), (const bf16*)(F.wsw + WS_WFF2), M_LAT, DM, DFF, DFF, DFF}; pg8::StaticOrder S; S.init(M_LAT, DM, F.G, bx);
          pg8::EpiBf16<0> E{(bf16*)(F.ws + WS_Y2), DM, nullptr};
          pg8::gemm_phase<pg8::EpiBf16<0>, pg8::StaticOrder, true, true>(F.lds, g, S, E);
          if (wctx) {
              pg8::Gemm g2{(const bf16*)(F.ws + WS_HID) + (size_t)M_LAT * DFF, (const bf16*)(F.wsw + WS_WFF2), M_CTX, DM, DFF / 8, DFF, DFF}; pg8::SplitOrder S2; S2.init(M_CTX, DM, DFF / 8, bx);
              pg8::EpiF32 E2{(float*)(F.ws + WS_YP), DM, (size_t)M_CTX * DM};
              pg8::gemm_phase<pg8::EpiF32, pg8::SplitOrder, true, true>(F.lds, g2, S2, E2); } }
        GRID_BAR();
        if (!PH(17)) {} else if (l == 0) {
            for (int row = F.gw; row < M_TOT; row += F.NGW) { const int s = row_s(row);
                bf16* yrow = (bf16*)(F.ws + WS_Y2) + (size_t)row * DM;
                if (row >= M_LAT) sum_partials_row(F, (const float*)(F.ws + WS_YP) + (size_t)(row - M_LAT) * DM, (size_t)M_CTX * DM, yrow);
                ln_row<1>(F, X + (size_t)row * DM, yrow, mod_ptr(F, 0, s, 5), F.A->in[I_LN2G], F.A->in[I_LN2B], X + (size_t)row * DM,
                          true, mod_ptr(F, 1, s, 1), mod_ptr(F, 1, s, 0), H + (size_t)row * DM); }
        } else {
            for (int row = F.gw; row < M_LAT; row += F.NGW) { const int s = row_s(row);
                ln_row<1>(F, X + (size_t)row * DM, (const bf16*)(F.ws + WS_Y2) + (size_t)row * DM, mod_ptr(F, 1, s, 5), F.A->in[I_LN2G] + DM, F.A->in[I_LN2B] + DM, F.out + (size_t)row * DM,
                          false, nullptr, nullptr, nullptr); }
        }
    }
}

extern "C" void kernel_launch(void* const* d_in, const int* in_sizes, int n_in, void* d_out, int out_size, void* d_ws, size_t ws_size, hipStream_t stream) {
    static int grid = 0;
    if (grid == 0) {
        if (n_in != 38 || out_size != M_LAT * DM || ws_size < WS_END) { fprintf(stderr, "kernel_launch: unexpected shapes: n_in %d out %d ws %zu (need %zu)\n", n_in, out_size, ws_size, (size_t)WS_END); grid = -1; return; }
        int dev = 0, cus = 0, per_cu = 0;
        if (hipGetDevice(&dev) != hipSuccess || hipDeviceGetAttribute(&cus, hipDeviceAttributeMultiprocessorCount, dev) != hipSuccess) { grid = -1; return; }
        if (hipFuncSetAttribute((const void*)mk_fwd, hipFuncAttributeMaxDynamicSharedMemorySize, LDS_BYTES) != hipSuccess) { fprintf(stderr, "kernel_launch: hipFuncSetAttribute failed\n"); grid = -1; return; }
        if (hipOccupancyMaxActiveBlocksPerMultiprocessor(&per_cu, (const void*)mk_fwd, NTHR, LDS_BYTES) != hipSuccess || per_cu < 1) fprintf(stderr, "kernel_launch: occupancy query says %d\n", per_cu);
        (void)hipGetLastError();
        grid = cus;
    }
    if (grid < 0) return;
    if (hipMemsetAsync((char*)d_ws + WS_CTL, 0, CTL_ZERO_BYTES, stream) != hipSuccess) return;
    Args a{};
    for (int i = 0; i < 38; ++i) a.in[i] = (const float*)d_in[i];
    a.out = (float*)d_out; a.ws = (unsigned char*)d_ws;
    hipLaunchKernelGGL(mk_fwd, dim3(grid), dim3(NTHR), LDS_BYTES, stream, a);
    const hipError_t le = hipPeekAtLastError();
    if (le != hipSuccess) fprintf(stderr, "kernel_launch: launch failed: %s\n", hipGetErrorName(le));
}
```

```cpp
#include <hip/hip_runtime.h>
#include <hip/hip_bf16.h>
#include <cstdio>
#include <cstdint>

namespace pg8 {
#define PG8_LAS __attribute__((address_space(3)))
typedef unsigned short bf16_t;
typedef short bf16x8 __attribute__((ext_vector_type(8)));
typedef float f32x4 __attribute__((ext_vector_type(4)));
typedef unsigned u32x4 __attribute__((ext_vector_type(4)));
constexpr int BM = 256, BK = 64, HALF = 128, HTB = HALF * BK * 2  , STAGE_BYTES = 8 * HTB, NXCD = 8, WGM = 8;

__host__ __device__ __forceinline__ int lds_byte(int r, int c) { const int st = (r >> 4) * 2 + (c >> 5), rr = r & 15, cc = c & 31, ob = rr * 64 + cc * 2; return st * 1024 + (ob ^ (((ob >> 9) & 1) << 5)); }
__host__ __device__ __forceinline__ void stage_rc(int b, int& R, int& C) { const int st = b / 1024, sb = b % 1024, swz = sb ^ (((sb >> 9) & 1) << 5); R = (st >> 1) * 16 + swz / 64; C = (st & 1) * 32 + (swz % 64) / 2; }
__host__ __device__ __forceinline__ int perm32(int rho) { const int n = rho >> 4, i = rho & 15; return 8 * (i >> 2) + 4 * n + (i & 3); }

struct Unit { int pm, pn, ko, ks; };
struct Gemm { const bf16_t* A; const bf16_t* Bt; int M, N, K, lda, ldb; };

struct StaticOrder {
    int nM, nN, nwg, G, c;
    __host__ __device__ void init(int M, int N, int G_, int c_) { nM = M / BM; nN = N / BM; nwg = nM * nN; G = G_; c = c_; }
    __host__ __device__ bool next(int i, Unit& u) const {
        const long L = (long)i * G + c; if (L >= nwg) return false;
        int wgid = (int)L; { const int q = nwg / NXCD, r = nwg % NXCD, xcd = wgid % NXCD, off = wgid / NXCD; wgid = (xcd < r ? xcd * (q + 1) : r * (q + 1) + (xcd - r) * q) + off; }
        const int nig = WGM * nN, gid = wgid / nig, fm = gid * WGM, gsz = (nM - fm) < WGM ? (nM - fm) : WGM;
        u.pm = fm + ((wgid % nig) % gsz); u.pn = (wgid % nig) / gsz; u.ko = 0; u.ks = 0; return true;
    }
    __device__ __forceinline__ void a_ready(const Unit&) const {}
    __device__ __forceinline__ void done(const Unit&) const {}
};
struct SplitOrder {
    int nN, nitems, kslice, c;
    __host__ __device__ void init(int M, int N, int Kslice, int c_) { nN = N / BM; nitems = (M / BM) * nN * 8; kslice = Kslice; c = c_; }
    __host__ __device__ bool next(int i, Unit& u) const { if (i > 0 || c >= nitems) return false; u.ks = c & 7; u.ko = u.ks * kslice; u.pn = (c >> 3) % nN; u.pm = (c >> 3) / nN; return true; }
    __device__ __forceinline__ void a_ready(const Unit&) const {}
    __device__ __forceinline__ void done(const Unit&) const {}
};

__device__ __forceinline__ unsigned cvt_pk_bf16(float lo, float hi) { unsigned r; asm volatile("v_cvt_pk_bf16_f32 %0, %1, %2" : "=v"(r) : "v"(lo), "v"(hi)); return r; }

struct EpiF32 {
    static constexpr bool PERM = false, AFTER_DRAIN = false;
    float* C; int ldc; size_t split_stride;
    __device__ __forceinline__ void operator()(const f32x4 (&acc)[2][2][4][2], const Unit& u, int wr, int wc, int fr, int fq) const {
        const int row0 = u.pm * BM + wr * 64 + fr, col0 = u.pn * BM + wc * 32 + 4 * fq; float* Cb = C + (size_t)u.ks * split_stride;
#pragma unroll
        for (int ai = 0; ai < 2; ++ai)
#pragma unroll
            for (int m = 0; m < 4; ++m) { float* rowp = Cb + (size_t)(row0 + ai * HALF + m * 16) * ldc + col0;
#pragma unroll
                for (int bj = 0; bj < 2; ++bj)
#pragma unroll
                    for (int n = 0; n < 2; ++n) *(f32x4*)(rowp + bj * HALF + n * 16) = acc[ai][bj][m][n]; }
    }
};
template <int ACT> struct EpiBf16 {
    static constexpr bool PERM = true, AFTER_DRAIN = false;
    bf16_t* O; int ldc; const float* rowscale;
    __device__ __forceinline__ void operator()(const f32x4 (&acc)[2][2][4][2], const Unit& u, int wr, int wc, int fr, int fq) const {
        const int row0 = u.pm * BM + wr * 64 + fr; const int col0 = u.pn * BM + wc * 32 + 8 * fq;
#pragma unroll
        for (int ai = 0; ai < 2; ++ai)
#pragma unroll
            for (int m = 0; m < 4; ++m) { const int row = row0 + ai * HALF + m * 16; bf16_t* rowp = O + (size_t)row * ldc + col0;
                float rs = 1.f; if (ACT == 2) rs = rowscale[row];
#pragma unroll
                for (int bj = 0; bj < 2; ++bj) { f32x4 v0 = acc[ai][bj][m][0], v1 = acc[ai][bj][m][1];
                    if (ACT == 1) {
#pragma unroll
                        for (int j = 0; j < 4; ++j) { const float a = fmaxf(v0[j], 0.f), b = fmaxf(v1[j], 0.f); v0[j] = a * a; v1[j] = b * b; } }
                    if (ACT == 2) { v0 = v0 * rs; v1 = v1 * rs; }
                    if (ACT == 3) { const u32x4 o = *(const u32x4*)(rowp + bj * HALF);
                        v0[0] += __builtin_bit_cast(float, o.x << 16); v0[1] += __builtin_bit_cast(float, o.x & 0xffff0000u); v0[2] += __builtin_bit_cast(float, o.y << 16); v0[3] += __builtin_bit_cast(float, o.y & 0xffff0000u);
                        v1[0] += __builtin_bit_cast(float, o.z << 16); v1[1] += __builtin_bit_cast(float, o.z & 0xffff0000u); v1[2] += __builtin_bit_cast(float, o.w << 16); v1[3] += __builtin_bit_cast(float, o.w & 0xffff0000u); }
                    u32x4 w; w.x = cvt_pk_bf16(v0[0], v0[1]); w.y = cvt_pk_bf16(v0[2], v0[3]); w.z = cvt_pk_bf16(v1[0], v1[1]); w.w = cvt_pk_bf16(v1[2], v1[3]);
                    *(u32x4*)(rowp + bj * HALF) = w; } }
    }
};

template <class Epi, class Sched, bool ALIGN_EPI = false, bool SP2 = false>
__device__ __forceinline__ void gemm_phase(PG8_LAS unsigned char* lds, const Gemm g, const Sched& S, const Epi& E) {
    int tid = threadIdx.x; asm volatile("" : "+v"(tid));
    const int wid = __builtin_amdgcn_readfirstlane(tid >> 6), lane = tid & 63, wr = wid >> 2, wc = wid & 3, fr = lane & 15, fq = lane >> 4;
    const int K = g.K, nt = K / BK, lda = g.lda, ldb = g.ldb;
    unsigned voffA[2], voffB[2];
#pragma unroll
    for (int i = 0; i < 2; ++i) { int R, C; stage_rc(tid * 16 + i * 8192, R, C); const int Rb = Epi::PERM ? ((R & ~31) + perm32(R & 31)) : R;
        voffA[i] = (unsigned)(R * lda + C) * 2u; voffB[i] = (unsigned)(Rb * ldb + C) * 2u; }
    const size_t kstep = (size_t)(BK * 2);
    const size_t hstepA = (size_t)HALF * lda * 2, hstepB = (size_t)HALF * ldb * 2;
    const size_t tstepA = 2 * hstepA, tstepB = 2 * hstepB;
    const unsigned ldsw = (unsigned)wid * 1024u;
    const int aoff = lds_byte(wr * 64 + fr, fq * 8), boff = lds_byte(wc * 32 + fr, fq * 8);
#define PG8_SA(b, h) (((b) * 2 + (h)) * HTB)
#define PG8_SB(b, h) ((4 + (b) * 2 + (h)) * HTB)
#define PG8_STAGE(bufoff, gbase, voff) do { _Pragma("unroll") for (int _i = 0; _i < 2; ++_i) \
        __builtin_amdgcn_global_load_lds((const unsigned*)((const char*)(gbase) + (voff)[_i]), (PG8_LAS unsigned*)(lds + (bufoff) + ldsw + _i * 8192), 16, 0, 0); } while (0)
#define PG8_LDA(dst, b, h) do { _Pragma("unroll") for (int m = 0; m < 4; ++m) _Pragma("unroll") for (int k = 0; k < 2; ++k) dst[m][k] = *(const PG8_LAS bf16x8*)(lds + PG8_SA(b, h) + aoff + m * 2048 + k * 1024); } while (0)
#define PG8_LDB(dst, b, h) do { _Pragma("unroll") for (int n = 0; n < 2; ++n) _Pragma("unroll") for (int k = 0; k < 2; ++k) dst[n][k] = *(const PG8_LAS bf16x8*)(lds + PG8_SB(b, h) + boff + n * 2048 + k * 1024); } while (0)
#define PG8_MMA(ai, bj, At, Bt) do { __builtin_amdgcn_s_setprio(1); _Pragma("unroll") for (int m = 0; m < 4; ++m) _Pragma("unroll") for (int n = 0; n < 2; ++n) _Pragma("unroll") for (int k = 0; k < 2; ++k) \
        acc[ai][bj][m][n] = __builtin_amdgcn_mfma_f32_16x16x32_bf16(Bt[n][k], At[m][k], acc[ai][bj][m][n], 0, 0, 0); __builtin_amdgcn_s_setprio(0); } while (0)
#define PG8_WAIT_V(n) asm volatile("s_waitcnt vmcnt(" #n ")" ::: "memory")
#define PG8_WAIT_L(n) asm volatile("s_waitcnt lgkmcnt(" #n ")" ::: "memory")
#define PG8_BAR __builtin_amdgcn_s_barrier()
#define PG8_SCHED __builtin_amdgcn_sched_barrier(0)
    Unit cur, nxt; int ui = 0;
    if (!S.next(0, cur)) return;
    f32x4 acc[2][2][4][2];
#pragma unroll
    for (int a = 0; a < 2; ++a)
#pragma unroll
        for (int b = 0; b < 2; ++b)
#pragma unroll
            for (int m = 0; m < 4; ++m)
#pragma unroll
                for (int n = 0; n < 2; ++n) acc[a][b][m][n] = (f32x4){0.f, 0.f, 0.f, 0.f};
    bf16x8 At[4][2], B0[2][2], B1[2][2];
    const char* cA = (const char*)g.A + (size_t)cur.pm * tstepA + (size_t)cur.ko * 2; const char* cB = (const char*)g.Bt + (size_t)cur.pn * tstepB + (size_t)cur.ko * 2;
    S.a_ready(cur);
    if constexpr (SP2) {
        PG8_STAGE(PG8_SB(0, 0), cB, voffB); PG8_STAGE(PG8_SB(0, 1), cB + hstepB, voffB); PG8_STAGE(PG8_SA(0, 0), cA, voffA); PG8_STAGE(PG8_SA(0, 1), cA + hstepA, voffA);
        if (wr == 1) PG8_BAR;
        PG8_WAIT_V(2); PG8_BAR;
        PG8_STAGE(PG8_SB(1, 0), cB + kstep, voffB); PG8_STAGE(PG8_SA(1, 0), cA + kstep, voffA); PG8_STAGE(PG8_SB(1, 1), cB + hstepB + kstep, voffB);
        PG8_WAIT_V(6); PG8_BAR;
    } else {
        PG8_STAGE(PG8_SB(0, 0), cB, voffB); PG8_STAGE(PG8_SA(0, 0), cA, voffA); PG8_STAGE(PG8_SB(0, 1), cB + hstepB, voffB); PG8_STAGE(PG8_SA(0, 1), cA + hstepA, voffA);
        if (wr == 1) PG8_BAR;
        PG8_WAIT_V(4); PG8_BAR;
        PG8_STAGE(PG8_SB(1, 0), cB + kstep, voffB); PG8_STAGE(PG8_SA(1, 0), cA + kstep, voffA); PG8_STAGE(PG8_SB(1, 1), cB + hstepB + kstep, voffB);
        PG8_WAIT_V(6); PG8_BAR;
    }
    for (;;) {
        const bool has_next = S.next(ui + 1, nxt);
        const char* nA = has_next ? (const char*)g.A + (size_t)nxt.pm * tstepA + (size_t)nxt.ko * 2 : cA; const char* nB = has_next ? (const char*)g.Bt + (size_t)nxt.pn * tstepB + (size_t)nxt.ko * 2 : cB;
        for (int t = 0; t < nt; t += 2) {
            const bool last = (t == nt - 2);
            const char* a1 = cA + (size_t)(t + 1) * kstep;
            const char* a2 = last ? nA : cA + (size_t)(t + 2) * kstep; const char* b2 = last ? nB : cB + (size_t)(t + 2) * kstep;
            const char* a3 = a2 + kstep; const char* b3 = b2 + kstep;
            if (last && has_next) S.a_ready(nxt);
            if constexpr (SP2) {
            PG8_LDB(B0, 0, 0); PG8_LDB(B1, 0, 1); PG8_SCHED; PG8_LDA(At, 0, 0); PG8_STAGE(PG8_SA(1, 1), a1 + hstepA, voffA);
            PG8_WAIT_V(8); PG8_WAIT_L(0); PG8_BAR; PG8_MMA(0, 0, At, B0); PG8_MMA(0, 1, At, B1); PG8_BAR; PG8_SCHED;
            PG8_LDA(At, 0, 1); PG8_STAGE(PG8_SB(0, 0), b2, voffB); PG8_STAGE(PG8_SB(0, 1), b2 + hstepB, voffB); PG8_STAGE(PG8_SA(0, 0), a2, voffA);
            PG8_WAIT_V(8); PG8_WAIT_L(0); PG8_BAR; PG8_MMA(1, 0, At, B0); PG8_MMA(1, 1, At, B1); PG8_BAR; PG8_SCHED;
            PG8_LDB(B0, 1, 0); PG8_LDB(B1, 1, 1); PG8_SCHED; PG8_LDA(At, 1, 0); PG8_STAGE(PG8_SA(0, 1), a2 + hstepA, voffA);
            PG8_WAIT_V(8); PG8_WAIT_L(0); PG8_BAR; PG8_MMA(0, 0, At, B0); PG8_MMA(0, 1, At, B1); PG8_BAR; PG8_SCHED;
            PG8_LDA(At, 1, 1); PG8_STAGE(PG8_SB(1, 0), b3, voffB); PG8_STAGE(PG8_SB(1, 1), b3 + hstepB, voffB); PG8_STAGE(PG8_SA(1, 0), a3, voffA);
            PG8_WAIT_V(8); PG8_WAIT_L(0); PG8_BAR; PG8_MMA(1, 0, At, B0); PG8_MMA(1, 1, At, B1); PG8_BAR; PG8_SCHED;
            } else {
            PG8_LDB(B0, 0, 0); PG8_SCHED; PG8_LDA(At, 0, 0); PG8_STAGE(PG8_SA(1, 1), a1 + hstepA, voffA);
            PG8_WAIT_L(8); PG8_BAR; PG8_WAIT_L(0); PG8_MMA(0, 0, At, B0); PG8_BAR; PG8_SCHED;
            PG8_LDB(B1, 0, 1); PG8_STAGE(PG8_SB(0, 0), b2, voffB);
            PG8_BAR; PG8_WAIT_L(0); PG8_MMA(0, 1, At, B1); PG8_BAR;
            PG8_LDA(At, 0, 1); PG8_STAGE(PG8_SA(0, 0), a2, voffA);
            PG8_BAR; PG8_WAIT_L(0); PG8_MMA(1, 0, At, B0); PG8_BAR; PG8_SCHED;
            PG8_STAGE(PG8_SB(0, 1), b2 + hstepB, voffB);
            PG8_WAIT_V(6); PG8_BAR; PG8_MMA(1, 1, At, B1); PG8_BAR;
            PG8_LDB(B0, 1, 0); PG8_SCHED; PG8_LDA(At, 1, 0); PG8_STAGE(PG8_SA(0, 1), a2 + hstepA, voffA);
            PG8_WAIT_L(8); PG8_BAR; PG8_WAIT_L(0); PG8_MMA(0, 0, At, B0); PG8_BAR; PG8_SCHED;
            PG8_LDB(B1, 1, 1); PG8_STAGE(PG8_SB(1, 0), b3, voffB);
            PG8_BAR; PG8_WAIT_L(0); PG8_MMA(0, 1, At, B1); PG8_BAR;
            PG8_LDA(At, 1, 1); PG8_STAGE(PG8_SA(1, 0), a3, voffA);
            PG8_BAR; PG8_WAIT_L(0); PG8_MMA(1, 0, At, B0); PG8_BAR; PG8_SCHED;
            PG8_STAGE(PG8_SB(1, 1), b3 + hstepB, voffB);
            PG8_WAIT_V(6); PG8_BAR; PG8_MMA(1, 1, At, B1); PG8_BAR;
            }
        }
        if constexpr (ALIGN_EPI) { if (wr == 0) PG8_BAR; }
        E(acc, cur, wr, wc, fr, fq); S.done(cur);
        if (!has_next) break;
#pragma unroll
        for (int a = 0; a < 2; ++a)
#pragma unroll
            for (int b = 0; b < 2; ++b)
#pragma unroll
                for (int m = 0; m < 4; ++m)
#pragma unroll
                    for (int n = 0; n < 2; ++n) acc[a][b][m][n] = (f32x4){0.f, 0.f, 0.f, 0.f};
        cur = nxt; cA = nA; cB = nB; ++ui;
        if constexpr (ALIGN_EPI) { if (wr == 1) PG8_BAR; }
    }
    PG8_WAIT_V(0);
    if constexpr (!ALIGN_EPI) { if (wr == 0) PG8_BAR; }
    PG8_BAR;
#undef PG8_SA
#undef PG8_SB
#undef PG8_STAGE
#undef PG8_LDA
#undef PG8_LDB
#undef PG8_MMA
#undef PG8_WAIT_V
#undef PG8_WAIT_L
#undef PG8_BAR
#undef PG8_SCHED
}
}

constexpr int NWAVES = 8, NTHR = 512;
constexpr int DM = 4096, NB = 2, SEQ = 8192, NCTX = 256, DFF = 16384;
constexpr int M_LAT = NB * SEQ, M_CTX = NB * NCTX, M_TOT = M_LAT + M_CTX;
constexpr int DIN = 8672, DINP = 8704;
constexpr int C_SWAQ = 0, C_SWAK = 1024, C_SWAV = 1280, C_LRUX = 1536, C_LRUY = 2560, C_QA = 3584, C_KVA = 4608, C_KR = 5120, C_RW = 5184;
constexpr int C_RWR = C_RW, C_RWK = C_RW + 1024, C_RWV = C_RW + 2048, C_RWL = C_RW + 3072;
constexpr int RWC = 3488;
constexpr float LN_EPS = 1e-5f, RMS_EPS = 1e-6f, GN_EPS = 64e-5f, ALPHA = 1.41421356237f;
constexpr int NCH = 264;

constexpr size_t MiB = 1u << 20;
constexpr size_t WS_CTL = 0, CTL_ZERO_BYTES = 1 * MiB;
constexpr size_t WS_MOD = 1 * MiB;
constexpr size_t WS_MODP = 2 * MiB;
constexpr size_t WS_SMALL = 20 * MiB;
constexpr size_t WS_RSQ = WS_SMALL;
constexpr size_t WS_RSKV = WS_RSQ + 128 * 1024;
constexpr size_t WS_SB = WS_RSKV + 128 * 1024;
constexpr size_t WS_CA = WS_SB + 2 * MiB;
constexpr size_t WS_CB = WS_CA + 5 * MiB;
constexpr size_t WS_HIN = WS_CB + 5 * MiB;
constexpr size_t WS_QUIRK = WS_HIN + 5 * MiB;
constexpr size_t WS_ROPE = WS_QUIRK + 8192;
static_assert(WS_ROPE + 16384 <= 40 * MiB, "small region");
constexpr size_t WS_W = 40 * MiB;
constexpr size_t WS_WIN = WS_W, WS_WOUT = WS_WIN + 68 * MiB, WS_WFF1 = WS_WOUT + 32 * MiB, WS_WFF2 = WS_WFF1 + 128 * MiB, WS_WQB = WS_WFF2 + 128 * MiB,
                 WS_WKVB = WS_WQB + 3 * MiB, WS_WLRU = WS_WKVB + 2 * MiB, WS_WLORA = WS_WLRU + 1 * MiB;
constexpr size_t WS_W2T = WS_WLORA, WS_A2T = WS_W2T + 256 * 1024, WS_G2T = WS_A2T + 256 * 1024;
constexpr size_t WS_X = 403 * MiB;
constexpr size_t WS_H = 667 * MiB;
constexpr size_t WS_MIX = 799 * MiB;
constexpr size_t WS_YS = 931 * MiB;
constexpr size_t WS_P = 1063 * MiB;
constexpr size_t WS_RWF = 1344 * MiB;
constexpr size_t RWF_STRIDE = (size_t)M_TOT * 1024 * 2;
constexpr size_t WS_Q = 1641 * MiB;
constexpr size_t WS_KV = 1691 * MiB;
constexpr size_t WS_KR = 1757 * MiB;
constexpr size_t WS_SET2 = 1760 * MiB;
constexpr size_t WSET_STRIDE = WS_SET2 - WS_W;
constexpr size_t WS_END = WS_SET2 + 363 * MiB;
constexpr size_t WS_YP = WS_Q;
constexpr size_t WS_HID = WS_P;
constexpr size_t WS_Y1 = WS_P;
constexpr size_t WS_Y2 = WS_MIX;
static_assert(WS_WLORA + 1 * MiB <= WS_X && WS_P + (size_t)M_TOT * DINP * 2 <= WS_RWF && WS_RWF + 9 * RWF_STRIDE <= WS_Q, "ws map");
static_assert(WS_HID + (size_t)M_TOT * DFF * 2 <= WS_Q && WS_Y2 + (size_t)M_TOT * DM * 4 <= WS_P && WS_YS + 2 * (size_t)M_TOT * 1024 * 4 <= WS_P, "ws overlays");
static_assert(WS_KR + (size_t)M_TOT * 64 * 2 <= WS_SET2 && WS_YP + 8 * (size_t)M_CTX * DM * 4 <= WS_KR, "ws end");

constexpr int RING_BYTES = 131072;
constexpr int LDSCTL_OFF = RING_BYTES, MISC_OFF = LDSCTL_OFF + 320;
constexpr int LDS_BYTES = 147456;

#define GAS __attribute__((address_space(1)))
#define LAS __attribute__((address_space(3)))
typedef unsigned short bf16;
typedef unsigned v4u __attribute__((ext_vector_type(4)));
typedef unsigned v2u __attribute__((ext_vector_type(2)));
typedef float f32x4 __attribute__((ext_vector_type(4)));
typedef float f32x2 __attribute__((ext_vector_type(2)));
typedef float f32x16 __attribute__((ext_vector_type(16)));
typedef short bf16x8 __attribute__((ext_vector_type(8)));
typedef short s16x4 __attribute__((ext_vector_type(4)));
typedef GAS unsigned gu32;
typedef const GAS bf16* gcbf; typedef GAS bf16* gbfp; typedef const GAS float* gcfl; typedef GAS float* gflp;
#define LDS_WAIT() asm volatile("s_waitcnt lgkmcnt(0)" ::: "memory")
#define VM_WAIT() asm volatile("s_waitcnt vmcnt(0)" ::: "memory")
__device__ __forceinline__ unsigned f2bf(float f) { unsigned u = __builtin_bit_cast(unsigned, f); return (u + 0x7fffu + ((u >> 16) & 1u)) >> 16; }
__device__ __forceinline__ unsigned pk2(float lo, float hi) { return f2bf(lo) | (f2bf(hi) << 16); }
__device__ __forceinline__ float bflo(unsigned w) { return __builtin_bit_cast(float, w << 16); }
__device__ __forceinline__ float bfhi(unsigned w) { return __builtin_bit_cast(float, w & 0xffff0000u); }
__device__ __forceinline__ float bf2f(bf16 h) { return __builtin_bit_cast(float, (unsigned)h << 16); }
#define DPP_ADD(x, ctrl) ((x) + __builtin_bit_cast(float, __builtin_amdgcn_update_dpp(0, __builtin_bit_cast(int, (x)), (ctrl), 0xf, 0xf, false)))
__device__ __forceinline__ float row_sum16(float x) { x = DPP_ADD(x, 0x128); x = DPP_ADD(x, 0x124); x = DPP_ADD(x, 0x122); x = DPP_ADD(x, 0x121); return x; }
#ifdef OLD_SUMS
__device__ __forceinline__ float wave_sum(float v) {
#pragma unroll
    for (int o = 1; o < 64; o <<= 1) v += __shfl_xor(v, o);
    return v;
}
__device__ __forceinline__ float half_swap_sum(float x) { return x + __shfl_xor(x, 32); }
__device__ __forceinline__ float quad_sum(float x) { x += __shfl_xor(x, 1); x += __shfl_xor(x, 2); return x; }
#else
__device__ __forceinline__ float wave_sum(float v) {
    const float r = row_sum16(v);
    const float a = __builtin_bit_cast(float, __builtin_amdgcn_readlane(__builtin_bit_cast(int, r), 0)), b = __builtin_bit_cast(float, __builtin_amdgcn_readlane(__builtin_bit_cast(int, r), 16));
    const float c = __builtin_bit_cast(float, __builtin_amdgcn_readlane(__builtin_bit_cast(int, r), 32)), d = __builtin_bit_cast(float, __builtin_amdgcn_readlane(__builtin_bit_cast(int, r), 48));
    return (a + b) + (c + d);
}
__device__ __forceinline__ float half_swap_sum(float x) {
    unsigned a = __builtin_bit_cast(unsigned, x), b = a; asm volatile("" : "+v"(b));
    auto rr = __builtin_amdgcn_permlane32_swap(a, b, false, false);
    const float lo = __uint_as_float(rr[0]), hi = __uint_as_float(rr[1]); return lo + hi;
}
__device__ __forceinline__ float quad_sum(float x) { x = DPP_ADD(x, 0xB1); x = DPP_ADD(x, 0x4E); return x; }
#endif
__device__ __forceinline__ float sigmoidf_(float x) { return 1.f / (1.f + __expf(-x)); }
__device__ __forceinline__ float softplusf_(float x) { return x > 20.f ? x : __logf(1.f + __expf(x)); }
__device__ __forceinline__ float tanhf_(float x) { const float e = __expf(2.f * x); return 1.f - 2.f / (e + 1.f); }
__device__ __forceinline__ int ltid() { int t = threadIdx.x; asm volatile("" : "+v"(t)); return t; }
template <class T> __device__ __forceinline__ T ldg(const void* base, unsigned byteoff) { return *(const T*)((const char*)base + byteoff); }
template <class T> __device__ __forceinline__ void stg(void* base, unsigned byteoff, T v) { *(T*)((char*)base + byteoff) = v; }

#define XB_TMO      128
#define XB_XCNT(j)  (256  + 64 * (j))
#define XB_XSUB(j)  (1280 + 64 * (j))
#define XB_XGEN(j)  (2304 + 64 * (j))
#define XB_TOP      3328
#define XB_TOPGEN   3392
#define XCD_BAR_WORDS 3456
#define XB_SPIN_CAP (1u << 18)

__device__ __forceinline__ unsigned xb_ld(unsigned* p)              { return __hip_atomic_load(p, __ATOMIC_RELAXED, __HIP_MEMORY_SCOPE_AGENT); }
__device__ __forceinline__ unsigned xb_add(unsigned* p, unsigned v) { return __hip_atomic_fetch_add(p, v, __ATOMIC_RELAXED, __HIP_MEMORY_SCOPE_AGENT); }
__device__ __forceinline__ unsigned xb_xcc_id() { return (unsigned)__builtin_amdgcn_s_getreg((3 << 11) | 20) & 0xFu; }
#define XB_SPIN(cond, bar) do { unsigned _sp = 0; while (cond) { __builtin_amdgcn_s_sleep(1); \
    if ((++_sp & 255u) == 0u) { if (xb_ld(&(bar)[XB_TMO])) break; if (_sp > XB_SPIN_CAP) { atomicAdd(&(bar)[XB_TMO], 1u); break; } } } } while (0)

struct XcdBarrier {
    unsigned* bar; unsigned x;
    unsigned nparts;
    volatile LAS unsigned* st;
};

__device__ __forceinline__ XcdBarrier xcd_barrier_post(unsigned* bar, volatile LAS unsigned* st) {
    XcdBarrier b; b.bar = bar; b.x = xb_xcc_id(); b.st = st; b.nparts = 0u;
    if (threadIdx.x == 0) (void)xb_add(&bar[XB_XCNT(b.x)], 1u);
    return b;
}
__device__ __forceinline__ void xcd_barrier_complete(unsigned* bar, unsigned x, unsigned& nloc, unsigned& nx, unsigned nparts) {
    const unsigned G = nparts ? nparts : gridDim.x * gridDim.y * gridDim.z;
    unsigned sum, cnt, mine, sp = 0u;
    for (;;) {
        sum = 0u; cnt = 0u; mine = 0u;
#pragma unroll
        for (unsigned j = 0; j < 16; ++j) { const unsigned c = xb_ld(&bar[XB_XCNT(j)]); sum += c; cnt += (c > 0u) ? 1u : 0u; mine = (j == x) ? c : mine; }
        if (sum == G) break;
        __builtin_amdgcn_s_sleep(1);
        if ((++sp & 255u) == 0u) { if (xb_ld(&bar[XB_TMO])) break; if (sp > XB_SPIN_CAP) { atomicAdd(&bar[XB_TMO], 1u); break; } }
    }
    nloc = mine > 0u ? mine : 1u; nx = cnt > 0u ? cnt : 1u;
}

__device__ __forceinline__ void xcd_barrier(const XcdBarrier& b) {
    asm volatile("s_waitcnt vmcnt(0)" ::: "memory");
    __syncthreads();
    if (threadIdx.x == 0) {
        unsigned* bar = b.bar;
        __builtin_amdgcn_s_waitcnt(0);
        unsigned nloc = b.st[0], nx = b.st[1];
        if (nloc == 0u) { xcd_barrier_complete(bar, b.x, nloc, nx, b.nparts); b.st[0] = nloc; b.st[1] = nx; }
        const unsigned old = xb_add(&bar[XB_XSUB(b.x)], 1u);
        const unsigned gen = old / nloc;
        if (old + 1u == (gen + 1u) * nloc) {
            __builtin_amdgcn_fence(__ATOMIC_RELEASE, "agent");
            asm volatile("s_waitcnt vmcnt(0)" ::: "memory");
            const unsigned og = xb_add(&bar[XB_TOP], 1u);
            const unsigned tg = og / nx;
            if (og + 1u == (tg + 1u) * nx) xb_add(&bar[XB_TOPGEN], 1u);
            else XB_SPIN(xb_ld(&bar[XB_TOPGEN]) == tg, bar);
            __builtin_amdgcn_fence(__ATOMIC_ACQUIRE, "agent");
            xb_add(&bar[XB_XGEN(b.x)], 1u);
            asm volatile("s_waitcnt vmcnt(0)" ::: "memory");
        } else {
            XB_SPIN(xb_ld(&bar[XB_XGEN(b.x)]) == gen, bar);
            __builtin_amdgcn_fence(__ATOMIC_ACQUIRE, "agent");
            asm volatile("s_waitcnt vmcnt(0)" ::: "memory");
        }
    }
    __syncthreads();
}


namespace att {
constexpr int KVBLK = 64;
constexpr float THR = 8.f;
#define SBAR() __builtin_amdgcn_sched_barrier(0)
__device__ __forceinline__ int crow(int r, int hi) { return (r & 3) + 8 * (r >> 2) + 4 * hi; }
__device__ __forceinline__ unsigned cvtpk(float lo, float hi) { unsigned r; asm volatile("v_cvt_pk_bf16_f32 %0, %1, %2" : "=v"(r) : "v"(lo), "v"(hi)); return r; }
template <int DQK> __device__ __forceinline__ int kswz(int row, int cb) { return row * (DQK * 2 + 16) + cb; }

template <int DQK> __device__ __forceinline__ void partialSM(f32x16& p0, f32x16& p1, float& m_reg, float& mn, float& alpha) {
  constexpr float SCALE = DQK == 128 ? 0.088388347648318440f : 0.072168783648703220f;
  constexpr float C = SCALE * 1.4426950408889634f;
  float pmax = p0[0];
#pragma unroll
  for (int r = 1; r < 16; ++r) pmax = fmaxf(pmax, p0[r]);
#pragma unroll
  for (int r = 0; r < 16; ++r) pmax = fmaxf(pmax, p1[r]);
  { auto rr = __builtin_amdgcn_permlane32_swap(__float_as_uint(pmax), __float_as_uint(pmax), false, false);
    pmax = fmaxf(__uint_as_float(rr[0]), __uint_as_float(rr[1])); }
  if (__builtin_expect(__all(pmax - m_reg <= THR / SCALE), 1)) { mn = m_reg; alpha = 1.f; }
  else { mn = fmaxf(m_reg, pmax); alpha = __builtin_amdgcn_exp2f((m_reg - mn) * C); m_reg = mn; }
  const float mnC = -mn * C;
#pragma unroll
  for (int r = 0; r < 16; ++r) p0[r] = fmaf(p0[r], C, mnC);
#pragma unroll
  for (int r = 0; r < 16; ++r) p1[r] = fmaf(p1[r], C, mnC);
#pragma unroll
  for (int r = 0; r < 16; ++r) p0[r] = __builtin_amdgcn_exp2f(p0[r]);
}
__device__ __forceinline__ void finishSM(f32x16& p0, f32x16& p1, float alpha, float& l_reg, bf16x8& pa0, bf16x8& pa1, bf16x8& pa2, bf16x8& pa3) {
#pragma unroll
  for (int r = 0; r < 16; ++r) p1[r] = __builtin_amdgcn_exp2f(p1[r]);
  float ps = 0;
#pragma unroll
  for (int r = 0; r < 16; ++r) ps += p0[r];
#pragma unroll
  for (int r = 0; r < 16; ++r) ps += p1[r];
  { auto rr = __builtin_amdgcn_permlane32_swap(__float_as_uint(ps), __float_as_uint(ps), false, false);
    ps = __uint_as_float(rr[0]) + __uint_as_float(rr[1]); }
  l_reg = l_reg * alpha + ps;
#define PK4(P, BASE, OUT) do { unsigned a0 = cvtpk(P[BASE + 0], P[BASE + 1]), a1 = cvtpk(P[BASE + 2], P[BASE + 3]);   \
    unsigned b0 = cvtpk(P[BASE + 4], P[BASE + 5]), b1 = cvtpk(P[BASE + 6], P[BASE + 7]);                              \
    auto r0 = __builtin_amdgcn_permlane32_swap(a0, b0, false, false); auto r1 = __builtin_amdgcn_permlane32_swap(a1, b1, false, false); \
    v4u w = {r0[0], r1[0], r0[1], r1[1]}; OUT = __builtin_bit_cast(bf16x8, w); } while (0)
  PK4(p0, 0, pa0); PK4(p0, 8, pa1); PK4(p1, 0, pa2); PK4(p1, 8, pa3);
#undef PK4
}
template <int DQK> __device__ __forceinline__ void qkt(f32x16& p0, f32x16& p1, const LAS char* Ks, const bf16x8* qr, const LAS char* qx, int r32, int hi) {
  p0 = f32x16{}; p1 = f32x16{};
#pragma unroll
  for (int d0 = 0; d0 < DQK / 16; ++d0) { const int cb = (d0 * 16 + hi * 8) * 2;
    bf16x8 b0 = *(const LAS bf16x8*)(Ks + kswz<DQK>(r32, cb));
    bf16x8 b1 = *(const LAS bf16x8*)(Ks + kswz<DQK>(32 + r32, cb));
    bf16x8 q; if (d0 < 8) q = qr[d0]; else q = *(const LAS bf16x8*)(qx + (d0 - 8) * 32);
    p0 = __builtin_amdgcn_mfma_f32_32x32x16_bf16(b0, q, p0, 0, 0, 0);
    p1 = __builtin_amdgcn_mfma_f32_32x32x16_bf16(b1, q, p1, 0, 0, 0);
    if ((d0 & 3) == 3 && d0 + 1 < DQK / 16) SBAR(); }
}
__device__ __forceinline__ int v_st(int k, int c) { const int kk = (k & ~0xC) | ((k & 4) << 1) | ((k & 8) >> 1); return ((kk >> 3) * 4 + (c >> 5)) * 512 + ((kk & 7) * 32 + (c & 31)) * 2; }
__device__ __forceinline__ int v_rd_base(int lane) { return ((lane & 3) << 3) | (((lane >> 2) & 3) << 6) | (((lane >> 4) & 1) << 5) | (((lane >> 5) & 1) << 8); }
constexpr int v_rd_off(int d0, int ks, int half) { return d0 * 512 + ks * 4096 + half * 2048; }
template <int OFF> __device__ __forceinline__ s16x4 tr_read(int vb) {
  s16x4 r; asm volatile("ds_read_b64_tr_b16 %0, %1 offset:%2" : "=&v"(r) : "v"(vb), "i"(OFF) : "memory"); return r;
}
template <int D0> __device__ __forceinline__ void pv_one(f32x16& od, int vb, bf16x8 pa0, bf16x8 pa1, bf16x8 pa2, bf16x8 pa3) {
  const s16x4 l0 = tr_read<v_rd_off(D0, 0, 0)>(vb), h0 = tr_read<v_rd_off(D0, 0, 1)>(vb), l1 = tr_read<v_rd_off(D0, 1, 0)>(vb), h1 = tr_read<v_rd_off(D0, 1, 1)>(vb);
  const s16x4 l2 = tr_read<v_rd_off(D0, 2, 0)>(vb), h2 = tr_read<v_rd_off(D0, 2, 1)>(vb), l3 = tr_read<v_rd_off(D0, 3, 0)>(vb), h3 = tr_read<v_rd_off(D0, 3, 1)>(vb);
  asm volatile("s_waitcnt lgkmcnt(0)" ::: "memory"); SBAR();
#define PK(L, H) (bf16x8){L[0], L[1], L[2], L[3], H[0], H[1], H[2], H[3]}
  od = __builtin_amdgcn_mfma_f32_32x32x16_bf16(pa0, PK(l0, h0), od, 0, 0, 0);
  od = __builtin_amdgcn_mfma_f32_32x32x16_bf16(pa1, PK(l1, h1), od, 0, 0, 0);
  od = __builtin_amdgcn_mfma_f32_32x32x16_bf16(pa2, PK(l2, h2), od, 0, 0, 0);
  od = __builtin_amdgcn_mfma_f32_32x32x16_bf16(pa3, PK(l3, h3), od, 0, 0, 0);
#undef PK
}
__device__ __forceinline__ void pv_d0(f32x16* o, int vb, bf16x8 pa0, bf16x8 pa1, bf16x8 pa2, bf16x8 pa3) {
  pv_one<0>(o[0], vb, pa0, pa1, pa2, pa3); pv_one<1>(o[1], vb, pa0, pa1, pa2, pa3); pv_one<2>(o[2], vb, pa0, pa1, pa2, pa3); pv_one<3>(o[3], vb, pa0, pa1, pa2, pa3);
}
__device__ __forceinline__ void apply_mask(f32x16& p0, f32x16& p1, int mtype, int krel0, int qi, int hi) {
  if (mtype == 0) return;
  const float ninf = -__builtin_inff();
#pragma unroll
  for (int r = 0; r < 16; ++r) { const int k0 = krel0 + crow(r, hi), k1 = k0 + 32;
    const bool ok0 = (mtype == 1) ? (k0 >= qi - 128) : (k0 <= qi + 128), ok1 = (mtype == 1) ? (k1 >= qi - 128) : (k1 <= qi + 128);
    p0[r] = ok0 ? p0[r] : ninf; p1[r] = ok1 ? p1[r] : ninf; }
}
struct Tile { gcbf kn; gcbf kr; gcbf v; int mtype; int krel0; };

__device__ __forceinline__ void rope_pair(bf16x8& a, bf16x8& b, gcfl ct, gcfl st) {
  const f32x4 c0 = *(const GAS f32x4*)ct, c1 = *(const GAS f32x4*)(ct + 4), s0 = *(const GAS f32x4*)st, s1 = *(const GAS f32x4*)(st + 4);
  const float cs[8] = {c0[0], c0[1], c0[2], c0[3], c1[0], c1[1], c1[2], c1[3]}, sn[8] = {s0[0], s0[1], s0[2], s0[3], s1[0], s1[1], s1[2], s1[3]};
  v4u ua = __builtin_bit_cast(v4u, a), ub = __builtin_bit_cast(v4u, b); v4u oa, ob;
#pragma unroll
  for (int w = 0; w < 4; ++w) { const float x1[2] = {bflo(ua[w]), bfhi(ua[w])}, x2[2] = {bflo(ub[w]), bfhi(ub[w])}; float y1[2], y2[2];
#pragma unroll
    for (int e = 0; e < 2; ++e) { const float c = cs[2 * w + e], sv = sn[2 * w + e]; y1[e] = x1[e] * c - x2[e] * sv; y2[e] = x2[e] * c + x1[e] * sv; }
    oa[w] = pk2(y1[0], y1[1]); ob[w] = pk2(y2[0], y2[1]); }
  a = __builtin_bit_cast(bf16x8, oa); b = __builtin_bit_cast(bf16x8, ob);
}

template <int DQK, int LDKN, int LDV, bool MASK, bool SINK, int SDEPTH, class TS>
__device__ __forceinline__ void attn_body(gcbf Qw, int rope, int prow, int pcol, gcfl rtab, int qi, float sink_l2, const TS& ts, int NT, gbfp Ow, LAS char* lds) {
  constexpr float SCALE = DQK == 128 ? 0.088388347648318440f : 0.072168783648703220f;
  constexpr float C = SCALE * 1.4426950408889634f;
  constexpr int SHM_K = KVBLK * (DQK * 2 + 16), SHM_V = KVBLK * 128 * 2;
  int tid = threadIdx.x; asm volatile("" : "+v"(tid));
  const int wid = tid >> 6, lane = tid & 63, r32 = lane & 31, hi = lane >> 5;
  LAS char* V_lds = lds; LAS char* K_lds = lds + 2 * SHM_V;
  LAS float* wsl = (LAS float*)(lds + 2 * SHM_V + 2 * SHM_K) + wid * 64; LAS float* li_l = wsl; LAS float* al_l = wsl + 32;
  float m_reg = -1e30f, l_reg = 0; f32x16 o[4] = {}; bf16x8 qr[8];
#pragma unroll
  for (int d0 = 0; d0 < 8; ++d0) qr[d0] = *(const GAS bf16x8*)(Qw + d0 * 16 + hi * 8);
  const LAS char* qx = lds + 2 * SHM_V + 2 * SHM_K + 2048 + wid * 4608 + r32 * 144 + hi * 16;
  if constexpr (DQK == 192) {
    bf16x8 x0 = *(const GAS bf16x8*)(Qw + 128 + hi * 8), x1 = *(const GAS bf16x8*)(Qw + 144 + hi * 8), x2 = *(const GAS bf16x8*)(Qw + 160 + hi * 8), x3 = *(const GAS bf16x8*)(Qw + 176 + hi * 8);
    if (rope) {
      rope_pair(x0, x1, rtab + (size_t)prow * 16 + hi * 8, rtab + 2048 + (size_t)prow * 16 + hi * 8);
      rope_pair(x2, x3, rtab + (size_t)pcol * 16 + hi * 8, rtab + 2048 + (size_t)pcol * 16 + hi * 8); }
    LAS char* qw_ = (LAS char*)qx; *(LAS bf16x8*)(qw_) = x0; *(LAS bf16x8*)(qw_ + 32) = x1; *(LAS bf16x8*)(qw_ + 64) = x2; *(LAS bf16x8*)(qw_ + 96) = x3;
  }
  const int sr = tid >> 4, sc = (tid & 15) * 8, vst0 = v_st(sr, sc), vst1 = v_st(32 + sr, sc);
  const int rr_ = tid >> 3, rc_ = (tid & 7) * 8;
  const int vb0 = (int)(uintptr_t)V_lds + v_rd_base(lane);
  struct { bf16x8 vs0, vs1, ks0, ks1, kx; } sr_[SDEPTH];
#define SLOAD(i, jt) do { const Tile t_ = ts(jt); sr_[i].vs0 = *(const GAS bf16x8*)(t_.v + (size_t)sr * LDV + sc); sr_[i].vs1 = *(const GAS bf16x8*)(t_.v + (size_t)(32 + sr) * LDV + sc); \
    sr_[i].ks0 = *(const GAS bf16x8*)(t_.kn + (size_t)sr * LDKN + sc); sr_[i].ks1 = *(const GAS bf16x8*)(t_.kn + (size_t)(32 + sr) * LDKN + sc); \
    if constexpr (DQK == 192) sr_[i].kx = *(const GAS bf16x8*)(t_.kr + (size_t)rr_ * 64 + rc_); } while (0)
#define SWRITE(b, i) do { *(LAS bf16x8*)(V_lds + (b) * SHM_V + vst0) = sr_[i].vs0; *(LAS bf16x8*)(V_lds + (b) * SHM_V + vst1) = sr_[i].vs1; const int kc = sc * 2; \
    *(LAS bf16x8*)(K_lds + (b) * SHM_K + kswz<DQK>(sr, kc)) = sr_[i].ks0; *(LAS bf16x8*)(K_lds + (b) * SHM_K + kswz<DQK>(32 + sr, kc)) = sr_[i].ks1; \
    if constexpr (DQK == 192) *(LAS bf16x8*)(K_lds + (b) * SHM_K + kswz<DQK>(rr_, 256 + rc_ * 2)) = sr_[i].kx; } while (0)
#define SWAIT() do { if constexpr (SDEPTH == 2) { if constexpr (DQK == 192) asm volatile("s_waitcnt vmcnt(5)" ::: "memory"); else asm volatile("s_waitcnt vmcnt(4)" ::: "memory"); } \
    else asm volatile("s_waitcnt vmcnt(0)" ::: "memory"); } while (0)
#define RESC(a) do { if (__any((a) < 1.f)) { if (hi == 0) al_l[r32] = (a); asm volatile("s_waitcnt lgkmcnt(0)" ::: "memory"); \
    _Pragma("unroll") for (int d = 0; d < 4; ++d) _Pragma("unroll") for (int r = 0; r < 16; ++r) o[d][r] *= al_l[crow(r, hi)]; } } while (0)
#define MASKT(pa_, pb_, jt) do { if constexpr (MASK) { const Tile t_ = ts(jt); apply_mask(pa_, pb_, t_.mtype, t_.krel0, qi, hi); } } while (0)
  f32x16 pA0, pA1, pB0, pB1; float mnA, mnB, alA, alB; bf16x8 pa0, pa1, pa2, pa3;
  constexpr int SE = 0, SO = SDEPTH - 1;
  SLOAD(SE, 0); asm volatile("s_waitcnt vmcnt(0)" ::: "memory"); SWRITE(0, SE); __syncthreads();
  qkt<DQK>(pA0, pA1, K_lds, qr, qx, r32, hi); MASKT(pA0, pA1, 0); partialSM<DQK>(pA0, pA1, m_reg, mnA, alA);
  SLOAD(SO, 1); if constexpr (SDEPTH == 2) { if (2 < NT) SLOAD(SE, 2); }
  SWAIT(); SWRITE(1, SO); __syncthreads();
  for (int j = 1; j + 1 < NT; j += 2) {
    SBAR(); qkt<DQK>(pB0, pB1, K_lds + SHM_K, qr, qx, r32, hi); MASKT(pB0, pB1, j);
    finishSM(pA0, pA1, alA, l_reg, pa0, pa1, pa2, pa3); SBAR();
    SLOAD(SO, j + SDEPTH); SBAR();
    pv_d0(o, vb0, pa0, pa1, pa2, pa3); partialSM<DQK>(pB0, pB1, m_reg, mnB, alB);
    __syncthreads(); SWAIT(); SWRITE(0, SE);
    RESC(alB); __syncthreads();
    SBAR(); qkt<DQK>(pA0, pA1, K_lds, qr, qx, r32, hi); MASKT(pA0, pA1, j + 1);
    finishSM(pB0, pB1, alB, l_reg, pa0, pa1, pa2, pa3); SBAR();
    if (SDEPTH == 1 || j + 3 < NT) SLOAD(SE, j + 1 + SDEPTH); SBAR();
    pv_d0(o, vb0 + SHM_V, pa0, pa1, pa2, pa3); partialSM<DQK>(pA0, pA1, m_reg, mnA, alA);
    __syncthreads(); SWAIT(); SWRITE(1, SO);
    RESC(alA); __syncthreads();
  }
  SBAR(); qkt<DQK>(pB0, pB1, K_lds + SHM_K, qr, qx, r32, hi); MASKT(pB0, pB1, NT - 1);
  finishSM(pA0, pA1, alA, l_reg, pa0, pa1, pa2, pa3); SBAR();
  pv_d0(o, vb0, pa0, pa1, pa2, pa3); partialSM<DQK>(pB0, pB1, m_reg, mnB, alB);
  __syncthreads(); RESC(alB);
  finishSM(pB0, pB1, alB, l_reg, pa0, pa1, pa2, pa3); SBAR();
  pv_d0(o, vb0 + SHM_V, pa0, pa1, pa2, pa3);
  if constexpr (SINK) l_reg += __builtin_amdgcn_exp2f(sink_l2 - m_reg * C);
  if (hi == 0) li_l[r32] = l_reg; asm volatile("s_waitcnt lgkmcnt(0)" ::: "memory");
  float rli[16];
#pragma unroll
  for (int r = 0; r < 16; ++r) rli[r] = __builtin_amdgcn_rcpf(li_l[crow(r, hi)]);
  __syncthreads();
  LAS bf16* ost = (LAS bf16*)(lds + wid * 8704);
#pragma unroll
  for (int r = 0; r < 16; ++r) { const int orow = crow(r, hi);
#pragma unroll
    for (int d0 = 0; d0 < 4; ++d0) ost[orow * 136 + d0 * 32 + r32] = (bf16)f2bf(o[d0][r] * rli[r]); }
  asm volatile("s_waitcnt lgkmcnt(0)" ::: "memory");
#pragma unroll
  for (int i = 0; i < 8; ++i) { const int orow = i * 4 + (lane >> 4), ch = lane & 15;
    *(GAS v4u*)(Ow + (size_t)orow * 4096 + ch * 8) = *(const LAS v4u*)(ost + orow * 136 + ch * 8); }
  __syncthreads();
#undef SLOAD
#undef SWRITE
#undef SWAIT
#undef RESC
#undef MASKT
}
}

struct Args { const float* in[38]; float* out; unsigned char* ws; };
template <class T> __device__ __forceinline__ T launder(T p) { asm volatile("" : "+s"(p)); return p; }
template <class T> __device__ __forceinline__ T* launder_g(T* p) { asm volatile("" : "+s"(p)); return p; }
struct Frame {
    LAS unsigned char* lds;
    gu32* ctl;
    int tid, lane, wave;
    int vcu, G, gw, NGW;
    const __attribute__((address_space(4))) Args* A;
    float* out;
    unsigned char* ws;
    unsigned char* wsw;
};
enum { I_X = 0, I_C, I_CTX, I_CCTX, I_WMOD, I_BMOD, I_WIN, I_WOUT, I_LN1G, I_LN1B, I_WFF1, I_WFF2, I_LN2G, I_LN2B, I_SINK, I_CONVW, I_CONVB, I_LWA, I_LBA, I_LWI, I_LBI, I_LAM,
       I_QNORM, I_KVNORM, I_WQB, I_WKVB, I_MUP, I_MUN, I_W0, I_W2, I_A0, I_A2, I_G2, I_KK, I_KA, I_RK, I_LNG, I_LNB };
__device__ __forceinline__ int row_s(int row) { return row < SEQ ? 0 : (row < M_LAT ? 1 : 2); }
__device__ __forceinline__ const float* mod_ptr(const Frame& F, int l, int s, int chunk) { return (const float*)(F.ws + WS_MOD) + ((size_t)(l * 3 + s) * 6 + chunk) * DM; }

__device__ __forceinline__ void transpose_item(const float* W, int N, int Kvalid, bf16* WT, int ldt, const float* kscale, LAS float* scr, int k0, int n0, int lane) {
    { const int kr = lane >> 3, c4 = (lane & 7) * 4;
#pragma unroll
      for (int i = 0; i < 8; ++i) { const int kk = 8 * i + kr, k = k0 + kk; f32x4 v = {0.f, 0.f, 0.f, 0.f};
          if (k < Kvalid) { v = *(const f32x4*)(W + (size_t)k * N + n0 + c4); if (kscale) v = v * kscale[k]; }
          scr[kk * 33 + c4] = v.x; scr[kk * 33 + c4 + 1] = v.y; scr[kk * 33 + c4 + 2] = v.z; scr[kk * 33 + c4 + 3] = v.w; } }
    LDS_WAIT(); asm volatile("" ::: "memory");
    const int c = lane & 7;
#pragma unroll
    for (int j = 0; j < 4; ++j) { const int n = (lane >> 3) + 8 * j; const LAS float* s = scr + (8 * c) * 33 + n;
        v4u o; o.x = pk2(s[0 * 33], s[1 * 33]); o.y = pk2(s[2 * 33], s[3 * 33]); o.z = pk2(s[4 * 33], s[5 * 33]); o.w = pk2(s[6 * 33], s[7 * 33]);
        *(v4u*)(WT + (size_t)(n0 + n) * ldt + k0 + 8 * c) = o; }
    LDS_WAIT(); asm volatile("" ::: "memory");
}
__device__ __forceinline__ void convert_weights(Frame& F, int l, int widx, int nw) {
    LAS float* scr = (LAS float*)(F.lds + F.wave * 16384);
    constexpr int I1 = 64 * 271, I2 = 64 * 128, I3 = 64 * 512, I4 = 256 * 128, I5 = 16 * 48, I6 = 8 * 64, I7 = 32 * 8, I8 = 2 * 32, I9 = 2 * 32, I10 = 3 * 32;
    constexpr int NIT = I1 + I2 + I3 + I4 + I5 + I6 + I7 + I8 + I9 + I10;
    unsigned char* ws = F.ws + (l ? WSET_STRIDE : 0);
    for (int it = widx; it < NIT; it += nw) {
        int r = it;
        if (r < I1) { transpose_item(F.A->in[I_WIN] + (size_t)l * DM * DIN, DIN, DM, (bf16*)(ws + WS_WIN), DM, nullptr, scr, 64 * (r / 271), 32 * (r % 271), F.lane); continue; } r -= I1;
        if (r < I2) { transpose_item(F.A->in[I_WOUT] + (size_t)l * DM * DM, DM, DM, (bf16*)(ws + WS_WOUT), DM, nullptr, scr, 64 * (r / 128), 32 * (r % 128), F.lane); continue; } r -= I2;
        if (r < I3) { transpose_item(F.A->in[I_WFF1] + (size_t)l * DM * DFF, DFF, DM, (bf16*)(ws + WS_WFF1), DM, nullptr, scr, 64 * (r / 512), 32 * (r % 512), F.lane); continue; } r -= I3;
        if (r < I4) { transpose_item(F.A->in[I_WFF2] + (size_t)l * DFF * DM, DM, DFF, (bf16*)(ws + WS_WFF2), DFF, nullptr, scr, 64 * (r / 128), 32 * (r % 128), F.lane); continue; } r -= I4;
        if (r < I5) { transpose_item(F.A->in[I_WQB] + (size_t)l * 1024 * 1536, 1536, 1024, (bf16*)(ws + WS_WQB), 1024, F.A->in[I_QNORM] + l * 1024, scr, 64 * (r / 48), 32 * (r % 48), F.lane); continue; } r -= I5;
        if (r < I6) { transpose_item(F.A->in[I_WKVB] + (size_t)l * 512 * 2048, 2048, 512, (bf16*)(ws + WS_WKVB), 512, F.A->in[I_KVNORM] + l * 512, scr, 64 * (r / 64), 32 * (r % 64), F.lane); continue; } r -= I6;
        if (r < I7) { const int mat = r >> 3, sub = r & 7, gate = mat & 1, dn = mat >> 1;
            const int d = dn >> 3, n = dn & 7;
            const float* src = (gate ? F.A->in[I_LWI] : F.A->in[I_LWA]) + ((size_t)(l * 2 + d) * 8 + n) * 128 * 128;
            bf16* dst = (bf16*)(ws + WS_WLRU) + ((size_t)(d * 2 + gate) * 8 + n) * 128 * 128;
            transpose_item(src, 128, 128, dst, 128, nullptr, scr, 64 * (sub >> 2), 32 * (sub & 3), F.lane); continue; } r -= I7;
        if (r < I8) { const int d = r >> 5; transpose_item(F.A->in[I_W2] + (size_t)(l * 2 + d) * 64 * 1024, 1024, 64, (bf16*)(ws + WS_W2T) + (size_t)d * 1024 * 64, 64, nullptr, scr, 0, 32 * (r & 31), F.lane); continue; } r -= I8;
        if (r < I9) { const int d = r >> 5; transpose_item(F.A->in[I_A2] + (size_t)(l * 2 + d) * 64 * 1024, 1024, 64, (bf16*)(ws + WS_A2T) + (size_t)d * 1024 * 64, 64, nullptr, scr, 0, 32 * (r & 31), F.lane); continue; } r -= I9;
        transpose_item(F.A->in[I_G2] + (size_t)l * 160 * 1024, 1024, 160, (bf16*)(ws + WS_G2T), 192, nullptr, scr, 64 * (r / 32), 32 * (r % 32), F.lane);
    }
    { unsigned zz = 0u; asm volatile("" : "+v"(zz)); v4u z = {zz, zz, zz, zz}; v4u* p = (v4u*)((bf16*)(ws + WS_WIN) + (size_t)DIN * DM);
      for (int i = widx * 64 + F.lane; i < 32 * DM / 8; i += nw * 64) p[i] = z; }
}

__device__ __forceinline__ void mod_partials(Frame& F) {
    LAS float* sl = (LAS float*)F.lds;
    for (int it = F.vcu; it < 2 * 32 * 12; it += F.G) {
        const int l = it / 384, ks = (it / 12) % 32, cc = it % 12;
        __syncthreads();
        if (F.tid < 384) { const int s = F.tid >> 7, k = ks * 128 + (F.tid & 127); const float c = s < 2 ? F.A->in[I_C][s * DM + k] : F.A->in[I_CCTX][k]; sl[F.tid] = c / (1.f + __expf(-c)); }
        __syncthreads();
        const float* wp = F.A->in[I_WMOD] + ((size_t)l * DM + ks * 128) * 24576 + cc * 2048 + F.tid * 4;
        f32x4 a0 = {0.f, 0.f, 0.f, 0.f}, a1 = a0, a2 = a0;
#pragma unroll 8
        for (int k = 0; k < 128; ++k) { const f32x4 w = *(const f32x4*)(wp + (size_t)k * 24576); a0 += w * sl[k]; a1 += w * sl[128 + k]; a2 += w * sl[256 + k]; }
        float* op = (float*)(F.ws + WS_MODP) + ((size_t)(l * 32 + ks) * 3) * 24576 + cc * 2048 + F.tid * 4;
        *(f32x4*)(op) = a0; *(f32x4*)(op + 24576) = a1; *(f32x4*)(op + 2 * 24576) = a2;
    }
    __syncthreads();
}
__device__ __forceinline__ void mod_reduce(Frame& F) {
    for (int i = F.vcu * NTHR + F.tid; i < 2 * 3 * 24576; i += F.G * NTHR) {
        const int l = i / (3 * 24576), s = (i / 24576) % 3, n = i % 24576;
        float a = F.A->in[I_BMOD][l * 24576 + n];
        const float* pp = (const float*)(F.ws + WS_MODP) + ((size_t)(l * 32) * 3 + s) * 24576 + n;
#pragma unroll 8
        for (int ks = 0; ks < 32; ++ks) a += pp[(size_t)ks * 3 * 24576];
        ((float*)(F.ws + WS_MOD))[i] = a;
    }
}

__device__ __forceinline__ void sum_partials_row(const Frame& F, const float* yp, size_t stride, bf16* ydst) {
    int lane = F.lane; asm volatile("" : "+v"(lane));
#pragma unroll 2
    for (int j = 0; j < 16; ++j) { const int c = 4 * lane + 256 * j; f32x4 y = *(const f32x4*)(yp + c);
#pragma unroll
        for (int sp = 1; sp < 8; ++sp) y += *(const f32x4*)(yp + sp * stride + c);
        v2u w; w.x = pk2(y.x, y.y); w.y = pk2(y.z, y.w); *(v2u*)(ydst + c) = w; }
}
template <int MODE>
__device__ __forceinline__ void ln_row(const Frame& F, const float* xsrc, const bf16* Y, const float* ga, const float* lg, const float* lb, float* xdst,
                                       bool domod, const float* sc, const float* sh, bf16* hrow) {
    f32x4 v[16]; float s = 0.f;
#pragma unroll
    for (int j = 0; j < 16; ++j) { const int c = 4 * F.lane + 256 * j; v[j] = *(const f32x4*)(xsrc + c);
        if (MODE == 1) { const v2u yw = *(const v2u*)(Y + c); const f32x4 y = {bflo(yw.x), bfhi(yw.x), bflo(yw.y), bfhi(yw.y)}, g = *(const f32x4*)(ga + c); v[j] = v[j] * ALPHA + g * y; }
        s += (v[j].x + v[j].y) + (v[j].z + v[j].w);
        if ((j & 7) == 7) asm volatile("" ::: "memory"); }
    float mean = wave_sum(s) * (1.f / DM), s2 = 0.f;
#pragma unroll
    for (int j = 0; j < 16; ++j) { v[j] = v[j] - mean; s2 += (v[j].x * v[j].x + v[j].y * v[j].y) + (v[j].z * v[j].z + v[j].w * v[j].w); }
    float rstd = 1.f / sqrtf(wave_sum(s2) * (1.f / DM) + LN_EPS);
    if (MODE == 1) {
        s = 0.f;
#pragma unroll
        for (int j = 0; j < 16; ++j) { const int c = 4 * F.lane + 256 * j; const f32x4 g = *(const f32x4*)(lg + c), b = *(const f32x4*)(lb + c); v[j] = v[j] * rstd * g + b;
            *(f32x4*)(xdst + c) = v[j]; s += (v[j].x + v[j].y) + (v[j].z + v[j].w);
            if ((j & 7) == 7) asm volatile("" ::: "memory"); }
        if (!domod) return;
        mean = wave_sum(s) * (1.f / DM); s2 = 0.f;
#pragma unroll
        for (int j = 0; j < 16; ++j) { v[j] = v[j] - mean; s2 += (v[j].x * v[j].x + v[j].y * v[j].y) + (v[j].z * v[j].z + v[j].w * v[j].w); }
        rstd = 1.f / sqrtf(wave_sum(s2) * (1.f / DM) + LN_EPS);
    }
#pragma unroll
    for (int j = 0; j < 16; ++j) { const int c = 4 * F.lane + 256 * j; const f32x4 a = *(const f32x4*)(sc + c), b = *(const f32x4*)(sh + c);
        const f32x4 o = v[j] * rstd * (a + 1.f) + b; v2u w; w.x = pk2(o.x, o.y); w.y = pk2(o.z, o.w); *(v2u*)(hrow + c) = w; }
}

__device__ __forceinline__ void shift4(const bf16* P, unsigned eo, bool hp, bool hn, const float* mup, const float* mun, unsigned mo, float (&u)[4]) {
    const v2u xc = ldg<v2u>(P, eo * 2u); v2u xp = {0u, 0u}, xn = {0u, 0u};
    if (hp) xp = ldg<v2u>(P, (eo - DINP) * 2u); if (hn) xn = ldg<v2u>(P, (eo + DINP) * 2u);
    const f32x4 mp = ldg<f32x4>(mup, mo * 4u), mn = ldg<f32x4>(mun, mo * 4u);
    const float c[4] = {bflo(xc.x), bfhi(xc.x), bflo(xc.y), bfhi(xc.y)}, p[4] = {bflo(xp.x), bfhi(xp.x), bflo(xp.y), bfhi(xp.y)}, n[4] = {bflo(xn.x), bfhi(xn.x), bflo(xn.y), bfhi(xn.y)};
#pragma unroll
    for (int e = 0; e < 4; ++e) u[e] = c[e] + mp[e] * (p[e] - c[e]) + mn[e] * (n[e] - c[e]);
}
__device__ __forceinline__ void st4bf(void* base, unsigned eo, float a, float b, float c, float d) { v2u w; w.x = pk2(a, b); w.y = pk2(c, d); stg<v2u>(base, eo * 2u, w); }

__device__ __forceinline__ void rwkv_feat_item(Frame& F, int l, int item) {
    F.tid = ltid(); F.lane = F.tid & 63;
    int row0, seq_lo, seq_hi;
    if (item < 16) { const int b = item >> 3; seq_lo = M_LAT + b * NCTX; seq_hi = seq_lo + NCTX; row0 = seq_lo + (item & 7) * 32; }
    else { const int it = item - 16, b = it >> 8; seq_lo = b * SEQ; seq_hi = seq_lo + SEQ; row0 = seq_lo + (it & 255) * 32; }
    const bf16* P = (const bf16*)(F.ws + WS_P);
    LAS bf16* ACT = (LAS bf16*)F.lds;
    const float* mup = F.A->in[I_MUP] + l * RWC; const float* mun = F.A->in[I_MUN] + l * RWC;
    __syncthreads();
    { const int tok = F.tid >> 4, jc = F.tid & 15, row = row0 + tok; const bool hp = row > seq_lo, hn = row + 1 < seq_hi;
      const bf16* pr = P + (size_t)row * DINP + C_RWL;
#pragma unroll
      for (int i = 0; i < 13; ++i) { const int j = jc * 2 + 32 * i;
          const unsigned xc = *(const unsigned*)(pr + j), xp = hp ? *(const unsigned*)(pr - DINP + j) : 0u, xn = hn ? *(const unsigned*)(pr + DINP + j) : 0u;
          float u[2];
#pragma unroll
          for (int e = 0; e < 2; ++e) { const float c = e ? bfhi(xc) : bflo(xc), p = e ? bfhi(xp) : bflo(xp), n = e ? bfhi(xn) : bflo(xn);
              float v = c + mup[3072 + j + e] * (p - c) + mun[3072 + j + e] * (n - c);
              if (j < 128) v = tanhf_(v); else if (j >= 256) v = sigmoidf_(v);
              u[e] = v; }
          *(LAS unsigned*)(ACT + tok * 424 + j) = pk2(u[0], u[1]); } }
    __syncthreads();
    const int tok = F.lane & 31, hi = F.lane >> 5, row = row0 + tok;
    const bf16* W2T = (const bf16*)(F.wsw + WS_W2T); const bf16* A2T = (const bf16*)(F.wsw + WS_A2T); const bf16* G2T = (const bf16*)(F.wsw + WS_G2T);
    bf16* RWF = (bf16*)(F.ws + WS_RWF); const size_t RS = (size_t)M_TOT * 1024;
    const float* kkv = F.A->in[I_KK] + l * 1024; const float* kav = F.A->in[I_KA] + l * 1024; const float* rkv = F.A->in[I_RK] + l * 1024;
    const float* w0f = F.A->in[I_W0] + (size_t)(l * 2) * 1024; const float* a0f = F.A->in[I_A0] + (size_t)(l * 2) * 1024;
    const LAS bf16* actl = ACT + tok * 424 + hi * 8;
    LAS unsigned char* TI = F.lds + 27136 + F.wave * 10752; LAS unsigned char* TO = TI + 3 * 2720;
#define RF_LOADTILE(ti, colbase) do { _Pragma("unroll") for (int i_ = 0; i_ < 3; ++i_) { const int p_ = F.lane + 64 * i_; if (p_ < 136) { const int rr_ = p_ >> 2, cp_ = p_ & 3, gr_ = row0 - 1 + rr_; \
        v4u v_ = {0u, 0u, 0u, 0u}; if (gr_ >= seq_lo && gr_ < seq_hi) v_ = ldg<v4u>(P, ((unsigned)gr_ * DINP + (colbase) + 8 * cp_) * 2u); *(LAS v4u*)(TI + (ti) * 2720 + rr_ * 80 + cp_ * 16) = v_; } } } while (0)
#define RF_SHIFT4(ti, g_, mo_, u_) do { const LAS unsigned char* q_ = TI + (ti) * 2720 + (tok + 1) * 80 + (8 * (g_) + 4 * hi) * 2; const v2u xc_ = *(const LAS v2u*)q_, xp_ = *(const LAS v2u*)(q_ - 80), xn_ = *(const LAS v2u*)(q_ + 80); \
        const f32x4 mp_ = ldg<f32x4>(mup, (mo_) * 4u), mn_ = ldg<f32x4>(mun, (mo_) * 4u); \
        const float c_[4] = {bflo(xc_.x), bfhi(xc_.x), bflo(xc_.y), bfhi(xc_.y)}, pp_[4] = {bflo(xp_.x), bfhi(xp_.x), bflo(xp_.y), bfhi(xp_.y)}, nn_[4] = {bflo(xn_.x), bfhi(xn_.x), bflo(xn_.y), bfhi(xn_.y)}; \
        _Pragma("unroll") for (int e_ = 0; e_ < 4; ++e_) u_[e_] = c_[e_] + mp_[e_] * (pp_[e_] - c_[e_]) + mn_[e_] * (nn_[e_] - c_[e_]); } while (0)
#define RF_FLUSH(arr_, cblk_, o_) do { _Pragma("unroll") for (int g_ = 0; g_ < 4; ++g_) *(LAS v2u*)(TO + tok * 80 + (8 * g_ + 4 * hi) * 2) = o_[g_]; \
        asm volatile("s_waitcnt lgkmcnt(0)" ::: "memory"); \
        _Pragma("unroll") for (int i_ = 0; i_ < 2; ++i_) { const int p_ = F.lane + 64 * i_, rr_ = p_ >> 2, cp_ = p_ & 3; const v4u v_ = *(const LAS v4u*)(TO + rr_ * 80 + cp_ * 16); \
            stg<v4u>(RWF + (arr_) * RS, ((unsigned)(row0 + rr_) * 1024u + (cblk_) + 8 * cp_) * 2u, v_); } \
        asm volatile("s_waitcnt lgkmcnt(0)" ::: "memory"); } while (0)
#pragma unroll 1
    for (int hh = 0; hh < 2; ++hh) {
        const int h = 2 * F.wave + hh, cbase = h * 64;
        float ssq = 0.f;
        RF_LOADTILE(0, C_RWK + cbase); RF_LOADTILE(1, C_RWK + cbase + 32);
        asm volatile("s_waitcnt lgkmcnt(0)" ::: "memory");
#pragma unroll
        for (int bg = 0; bg < 8; ++bg) { const unsigned c4 = cbase + (bg >> 2) * 32 + 8 * (bg & 3) + 4 * hi; float uk[4];
            RF_SHIFT4(bg >> 2, bg & 3, 1024 + c4, uk); const f32x4 k4 = ldg<f32x4>(kkv, c4 * 4u);
#pragma unroll
            for (int e = 0; e < 4; ++e) { const float q = uk[e] * k4[e]; ssq += q * q; } }
        ssq = half_swap_sum(ssq);
        const float rn = 1.f / fmaxf(sqrtf(ssq), 1e-12f);
        float sb = 0.f;
#pragma unroll 1
        for (int blk = 0; blk < 2; ++blk) {
            const unsigned cblk = cbase + blk * 32, cha = cblk + tok;
            RF_LOADTILE(0, C_RWR + cblk); RF_LOADTILE(1, C_RWK + cblk); RF_LOADTILE(2, C_RWV + cblk);
#pragma unroll 1
            for (int d = 0; d < 2; ++d) { f32x16 aw = {};
#pragma unroll
                for (int ks = 0; ks < 4; ++ks) { const bf16x8 bw = *(const LAS bf16x8*)(actl + d * 64 + ks * 16); const bf16x8 w_ = ldg<bf16x8>(W2T, ((d * 1024 + cha) * 64 + ks * 16 + hi * 8) * 2u);
                    aw = __builtin_amdgcn_mfma_f32_32x32x16_bf16(w_, bw, aw, 0, 0, 0); }
                v2u o[4];
#pragma unroll
                for (int g = 0; g < 4; ++g) { const f32x4 w0 = ldg<f32x4>(w0f, (d * 1024 + cblk + 8 * g + 4 * hi) * 4u); float e4[4];
#pragma unroll
                    for (int e = 0; e < 4; ++e) e4[e] = __expf(-softplusf_(-(w0[e] + aw[4 * g + e])) - 0.5f);
                    o[g].x = pk2(e4[0], e4[1]); o[g].y = pk2(e4[2], e4[3]); }
                RF_FLUSH(4 + d, cblk, o); }
            { f32x16 ag = {};
#pragma unroll
              for (int ks = 0; ks < 10; ++ks) { const bf16x8 bg_ = *(const LAS bf16x8*)(actl + 256 + ks * 16); const bf16x8 g_ = ldg<bf16x8>(G2T, (cha * 192 + ks * 16 + hi * 8) * 2u);
                  ag = __builtin_amdgcn_mfma_f32_32x32x16_bf16(g_, bg_, ag, 0, 0, 0); }
              v2u o[4];
#pragma unroll
              for (int g = 0; g < 4; ++g) { o[g].x = pk2(ag[4 * g], ag[4 * g + 1]); o[g].y = pk2(ag[4 * g + 2], ag[4 * g + 3]); }
              RF_FLUSH(8, cblk, o); }
            { f32x16 aaf = {}, aab = {};
#pragma unroll
              for (int ks = 0; ks < 4; ++ks) { const bf16x8 baf = *(const LAS bf16x8*)(actl + 128 + ks * 16), bab = *(const LAS bf16x8*)(actl + 192 + ks * 16);
                  const bf16x8 a_f = ldg<bf16x8>(A2T, (cha * 64 + ks * 16 + hi * 8) * 2u), a_b = ldg<bf16x8>(A2T, ((1024 + cha) * 64 + ks * 16 + hi * 8) * 2u);
                  aaf = __builtin_amdgcn_mfma_f32_32x32x16_bf16(a_f, baf, aaf, 0, 0, 0); aab = __builtin_amdgcn_mfma_f32_32x32x16_bf16(a_b, bab, aab, 0, 0, 0); }
              v2u oR[4], oK[4], oV[4], oKK[4], oAF[4], oAB[4];
#pragma unroll
              for (int g = 0; g < 4; ++g) { const unsigned c4 = cblk + 8 * g + 4 * hi; float ur[4], uk[4], uv[4];
                  RF_SHIFT4(0, g, c4, ur); RF_SHIFT4(1, g, 1024 + c4, uk); RF_SHIFT4(2, g, 2048 + c4, uv);
                  const f32x4 a0a = ldg<f32x4>(a0f, c4 * 4u), a0b = ldg<f32x4>(a0f, (1024 + c4) * 4u), kk4 = ldg<f32x4>(kkv, c4 * 4u), ka4 = ldg<f32x4>(kav, c4 * 4u), rk4 = ldg<f32x4>(rkv, c4 * 4u);
                  float af[4], ab[4], kk[4];
#pragma unroll
                  for (int e = 0; e < 4; ++e) { const int r = 4 * g + e;
                      af[e] = sigmoidf_(a0a[e] + aaf[r]); ab[e] = sigmoidf_(a0b[e] + aab[r]); kk[e] = uk[e] * kk4[e] * rn;
                      const float kdf = uk[e] * (1.f + (af[e] - 1.f) * ka4[e]), kdb = uk[e] * (1.f + (ab[e] - 1.f) * ka4[e]);
                      sb += ur[e] * rk4[e] * (kdf + kdb); }
                  oR[g].x = pk2(ur[0], ur[1]); oR[g].y = pk2(ur[2], ur[3]); oK[g].x = pk2(uk[0], uk[1]); oK[g].y = pk2(uk[2], uk[3]); oV[g].x = pk2(uv[0], uv[1]); oV[g].y = pk2(uv[2], uv[3]);
                  oKK[g].x = pk2(kk[0], kk[1]); oKK[g].y = pk2(kk[2], kk[3]); oAF[g].x = pk2(af[0], af[1]); oAF[g].y = pk2(af[2], af[3]); oAB[g].x = pk2(ab[0], ab[1]); oAB[g].y = pk2(ab[2], ab[3]); }
              RF_FLUSH(0, cblk, oR); RF_FLUSH(1, cblk, oK); RF_FLUSH(2, cblk, oV); RF_FLUSH(3, cblk, oKK); RF_FLUSH(6, cblk, oAF); RF_FLUSH(7, cblk, oAB); }
        }
        sb = half_swap_sum(sb);
        if (hi == 0) ((float*)(F.ws + WS_SB))[(size_t)row * 16 + h] = sb;
    }
#undef RF_LOADTILE
#undef RF_SHIFT4
#undef RF_FLUSH
}

__device__ __forceinline__ float gelu_tanh(float x) { return 0.5f * x * (1.f + tanhf_(0.7978845608028654f * (x + 0.044715f * x * x * x))); }
template <bool PASS3>
__device__ __forceinline__ void lru_item(Frame& F, int l, int item) {
    F.tid = ltid(); F.lane = F.tid & 63;
    const int sc = item >> 3, nb = item & 7, b = sc / NCH, ch = sc % NCH;
    int row0, seq_lo, seq_hi;
    if (ch < 8) { seq_lo = M_LAT + b * NCTX; seq_hi = seq_lo + NCTX; row0 = seq_lo + ch * 32; }
    else { seq_lo = b * SEQ; seq_hi = seq_lo + SEQ; row0 = seq_lo + (ch - 8) * 32; }
    const bf16* P = (const bf16*)(F.ws + WS_P);
    LAS float* U = (LAS float*)F.lds;
    LAS bf16* UA = (LAS bf16*)(F.lds + 16384);
    LAS float* AB = (LAS float*)(F.lds + 32768);
    __syncthreads();
    { const int tok = F.tid >> 4, c8 = (F.tid & 15) * 8, cg = nb * 128 + c8; float acc[8];
      const float* cb = F.A->in[I_CONVB] + l * 1024 + cg;
#pragma unroll
      for (int e = 0; e < 8; ++e) acc[e] = cb[e];
#pragma unroll
      for (int j = 0; j < 4; ++j) { const int r = row0 + tok - 2 + j;
          if (r >= seq_lo && r < seq_hi) { const v4u x = *(const v4u*)(P + (size_t)r * DINP + C_LRUX + cg); const float* cw = F.A->in[I_CONVW] + (size_t)(l * 4 + j) * 1024 + cg;
#pragma unroll
              for (int w = 0; w < 4; ++w) { acc[2 * w] += cw[2 * w] * bflo(x[w]); acc[2 * w + 1] += cw[2 * w + 1] * bfhi(x[w]); } } }
      *(LAS f32x4*)(U + tok * 128 + c8) = (f32x4){acc[0], acc[1], acc[2], acc[3]}; *(LAS f32x4*)(U + tok * 128 + c8 + 4) = (f32x4){acc[4], acc[5], acc[6], acc[7]};
      v4u o; o.x = pk2(acc[0], acc[1]); o.y = pk2(acc[2], acc[3]); o.z = pk2(acc[4], acc[5]); o.w = pk2(acc[6], acc[7]);
      *(LAS v4u*)(UA + tok * 136 + c8) = o; }
    __syncthreads();
    { const int dir = F.wave >> 2, cq = F.wave & 3, l32 = F.lane & 31, hi = F.lane >> 5, chn = cq * 32 + l32, cg = nb * 128 + chn;
      const bf16* Wr = (const bf16*)(F.wsw + WS_WLRU) + ((size_t)(dir * 2 + 0) * 8 + nb) * 16384 + (size_t)chn * 128;
      const bf16* Wi = (const bf16*)(F.wsw + WS_WLRU) + ((size_t)(dir * 2 + 1) * 8 + nb) * 16384 + (size_t)chn * 128;
      f32x16 accr = {}, acci = {};
#pragma unroll
      for (int ks = 0; ks < 8; ++ks) { const int ko = ks * 16 + hi * 8;
          const bf16x8 a = *(const LAS bf16x8*)(UA + l32 * 136 + ko); const bf16x8 br = *(const bf16x8*)(Wr + ko), bi = *(const bf16x8*)(Wi + ko);
          accr = __builtin_amdgcn_mfma_f32_32x32x16_bf16(a, br, accr, 0, 0, 0); acci = __builtin_amdgcn_mfma_f32_32x32x16_bf16(a, bi, acci, 0, 0, 0); }
      const float ba = F.A->in[I_LBA][(l * 2 + dir) * 1024 + cg], bi_ = F.A->in[I_LBI][(l * 2 + dir) * 1024 + cg], sp = softplusf_(-F.A->in[I_LAM][(l * 2 + dir) * 1024 + cg]);
#pragma unroll
      for (int r = 0; r < 16; ++r) { const int tok = att::crow(r, hi); const float u = U[tok * 128 + chn];
          const float rg = sigmoidf_(accr[r] + ba), ig = sigmoidf_(acci[r] + bi_), la = -8.f * rg * sp, a = __expf(la), x2 = 2.f * la;
          const float em = x2 * (1.f + x2 * (0.5f + x2 * (0.16666667f + x2 * (0.041666668f + x2 * (0.0083333338f + x2 * 0.0013888889f)))));
          const float bc = __builtin_amdgcn_sqrtf(x2 < -0.5f ? 1.f - a * a : -em) * (ig * u);
          AB[(dir * 2 + 0) * 4096 + tok * 128 + chn] = a; AB[(dir * 2 + 1) * 4096 + tok * 128 + chn] = bc; } }
    __syncthreads();
    if (F.tid < 256) { const int dir = F.tid >> 7, chn = F.tid & 127, cg = nb * 128 + chn; const size_t ci = ((size_t)(dir * 2 + b) * NCH + ch) * 1024 + cg;
        LAS float* Aa = AB + (dir * 2) * 4096 + chn; LAS float* Bb = AB + (dir * 2 + 1) * 4096 + chn;
        if (!PASS3) { float h = 0.f, ap = 1.f;
#pragma unroll 8
            for (int s = 0; s < 32; ++s) { const int tok = dir ? 31 - s : s; const float a = Aa[tok * 128]; h = a * h + Bb[tok * 128]; ap *= a;
                if (s == 0 && dir == 1 && ch == 7) ((float*)(F.ws + WS_QUIRK))[b * 1024 + cg] = h; }
            ((float*)(F.ws + WS_CA))[ci] = ap; ((float*)(F.ws + WS_CB))[ci] = h;
        } else { float h = ((const float*)(F.ws + WS_HIN))[ci];
#pragma unroll 8
            for (int s = 0; s < 32; ++s) { const int tok = dir ? 31 - s : s; h = Aa[tok * 128] * h + Bb[tok * 128]; Bb[tok * 128] = h; } } }
    if (PASS3) { __syncthreads();
        const int tok = F.tid >> 4, c8 = (F.tid & 15) * 8, cg = nb * 128 + c8, row = row0 + tok;
        const v4u y = *(const v4u*)(P + (size_t)row * DINP + C_LRUY + cg); float o[8];
#pragma unroll
        for (int w = 0; w < 4; ++w) { const float h0 = AB[4096 + tok * 128 + c8 + 2 * w] + AB[3 * 4096 + tok * 128 + c8 + 2 * w], h1 = AB[4096 + tok * 128 + c8 + 2 * w + 1] + AB[3 * 4096 + tok * 128 + c8 + 2 * w + 1];
            o[2 * w] = h0 * gelu_tanh(bflo(y[w])); o[2 * w + 1] = h1 * gelu_tanh(bfhi(y[w])); }
        v4u ov; ov.x = pk2(o[0], o[1]); ov.y = pk2(o[2], o[3]); ov.z = pk2(o[4], o[5]); ov.w = pk2(o[6], o[7]);
        *(v4u*)((bf16*)(F.ws + WS_MIX) + (size_t)row * DM + 1024 + cg) = ov; }
}
__device__ __forceinline__ void lru_carry(Frame& F, int blk) {
    F.tid = ltid(); F.lane = F.tid & 63;
    const int gid = blk * NTHR + F.tid; if (gid >= 4096) return;
    const int dir = gid >> 11, b = (gid >> 10) & 1, cg = gid & 1023;
    const float* CA = (const float*)(F.ws + WS_CA) + ((size_t)(dir * 2 + b) * NCH) * 1024 + cg; const float* CB = (const float*)(F.ws + WS_CB) + ((size_t)(dir * 2 + b) * NCH) * 1024 + cg;
    float* HIN = (float*)(F.ws + WS_HIN) + ((size_t)(dir * 2 + b) * NCH) * 1024 + cg;
    float h = 0.f;
    if (dir == 0) {
#pragma unroll 8
        for (int c = 0; c < NCH; ++c) { HIN[(size_t)c * 1024] = h; h = CA[(size_t)c * 1024] * h + CB[(size_t)c * 1024]; }
    } else {
        for (int c = 7; c >= 0; --c) { HIN[(size_t)c * 1024] = h; h = CA[(size_t)c * 1024] * h + CB[(size_t)c * 1024]; }
        h = ((const float*)(F.ws + WS_QUIRK))[b * 1024 + cg];
#pragma unroll 8
        for (int c = NCH - 1; c >= 8; --c) { HIN[(size_t)c * 1024] = h; h = CA[(size_t)c * 1024] * h + CB[(size_t)c * 1024]; }
    }
}

__device__ __forceinline__ void rope_table(Frame& F) {
    const int i = F.vcu * NTHR + F.tid; if (i >= 2048) return;
    const int pos = i >> 4, f = i & 15; float s, c; sincosf((float)pos * exp2f(-(float)f * (13.287712379549449f / 16.f)), &s, &c);
    float* t = (float*)(F.ws + WS_ROPE); t[i] = c; t[2048 + i] = s;
}
__device__ __forceinline__ void row_prep(Frame& F, int row) {
    F.tid = ltid(); F.lane = F.tid & 63;
    bf16* pr = (bf16*)(F.ws + WS_P) + (size_t)row * DINP; const int lane = F.lane;
    const bool lat = row < M_LAT; const int t = row & (SEQ - 1); const float prow = (float)(t >> 6), pcol = (float)(t & 63);
    { const v4u a = *(const v4u*)(pr + C_QA + lane * 16), b = *(const v4u*)(pr + C_QA + lane * 16 + 8); float ss = 0.f;
#pragma unroll
      for (int w = 0; w < 4; ++w) { const float x0 = bflo(a[w]), x1 = bfhi(a[w]), x2 = bflo(b[w]), x3 = bfhi(b[w]); ss += x0 * x0 + x1 * x1 + x2 * x2 + x3 * x3; }
      ss = wave_sum(ss); if (lane == 0) ((float*)(F.ws + WS_RSQ))[row] = 1.f / sqrtf(ss * (1.f / 1024.f) + RMS_EPS); }
    { const v4u a = *(const v4u*)(pr + C_KVA + lane * 8); float ss = 0.f;
#pragma unroll
      for (int w = 0; w < 4; ++w) { const float x0 = bflo(a[w]), x1 = bfhi(a[w]); ss += x0 * x0 + x1 * x1; }
      ss = wave_sum(ss); if (lane == 0) ((float*)(F.ws + WS_RSKV))[row] = 1.f / sqrtf(ss * (1.f / 512.f) + RMS_EPS); }
    bf16* kr = (bf16*)(F.ws + WS_KR) + (size_t)row * 64;
    if (lat) {
        { const int part = lane >> 5, sub = lane & 31;
          const float inv = exp2f(-(float)sub * (13.287712379549449f / 32.f)); float sn, cs; sincosf((part ? pcol : prow) * inv, &sn, &cs);
#pragma unroll
          for (int hd = 0; hd < 10; ++hd) { bf16* qb = pr + (hd < 8 ? C_SWAQ + hd * 128 : C_SWAK + (hd - 8) * 128) + part * 64;
              const float x1 = bf2f(qb[sub]), x2 = bf2f(qb[sub + 32]); qb[sub] = (bf16)f2bf(x1 * cs - x2 * sn); qb[sub + 32] = (bf16)f2bf(x2 * cs + x1 * sn); } }
        if (lane < 32) { const int part = lane >> 4, i = lane & 15; const bf16* src = pr + C_KR + part * 32;
          const float inv = exp2f(-(float)i * (13.287712379549449f / 16.f)); float s, c; sincosf((part ? pcol : prow) * inv, &s, &c);
          const float x1 = bf2f(src[i]), x2 = bf2f(src[i + 16]);
          kr[part * 32 + i] = (bf16)f2bf(x1 * c - x2 * s); kr[part * 32 + i + 16] = (bf16)f2bf(x2 * c + x1 * s); }
    } else kr[lane] = pr[C_KR + lane];
}

__device__ __forceinline__ float allred16(float x) { return row_sum16(x); }
__device__ __forceinline__ int scan_row(int s, int dir, int b) {
    if (s < NCTX) return M_LAT + b * NCTX + (dir ? NCTX - 1 - s : s);
    const int t = s - NCTX; return b * SEQ + (dir ? SEQ - 1 - t : t);
}
__device__ __forceinline__ void rwkv_scan(Frame& F, int l, int chain) {
    F.tid = ltid(); F.lane = F.tid & 63;
    const int dir = chain >> 5, b = (chain >> 4) & 1, h = chain & 15;
    constexpr int CT = 24, NCHK = (NCTX + SEQ) / CT, STEPF = 392, BUFF = CT * STEPF;
    LAS float* buf = (LAS float*)F.lds; LAS float* ybuf = (LAS float*)(F.lds + 3 * BUFF * 4);
    gcbf RWF = (gcbf)(F.ws + WS_RWF); const size_t RS = (size_t)M_TOT * 1024;
    gflp YS = (gflp)(F.ws + WS_YS) + (size_t)dir * M_TOT * 1024;
    const bool ldr = F.tid < 384, flr = F.tid >= 128; const int lst = F.tid >> 4, lq = F.tid & 15, lc = h * 64 + 4 * lq, fst = (F.tid - 128) >> 4;
    const f32x4 ka4 = *(const GAS f32x4*)((gcfl)F.A->in[I_KA] + l * 1024 + lc);
    v2u gr = {0u, 0u}, gk = gr, gv = gr, gkk = gr, ge = gr, ga = gr;
#define RW_LOAD(c) do { if (ldr) { const size_t o_ = (size_t)scan_row((c) * CT + lst, dir, b) * 1024 + lc; gr = *(const GAS v2u*)(RWF + 0 * RS + o_); gk = *(const GAS v2u*)(RWF + 1 * RS + o_); gv = *(const GAS v2u*)(RWF + 2 * RS + o_); \
        gkk = *(const GAS v2u*)(RWF + 3 * RS + o_); ge = *(const GAS v2u*)(RWF + (4 + dir) * RS + o_); ga = *(const GAS v2u*)(RWF + (6 + dir) * RS + o_); } } while (0)
#define RW_WRITE(bi) do { if (ldr) { LAS float* d_ = buf + (bi) * BUFF + lst * STEPF + 4 * lq; \
        const float r_[4] = {bflo(gr.x), bfhi(gr.x), bflo(gr.y), bfhi(gr.y)}, k_[4] = {bflo(gk.x), bfhi(gk.x), bflo(gk.y), bfhi(gk.y)}, v_[4] = {bflo(gv.x), bfhi(gv.x), bflo(gv.y), bfhi(gv.y)}; \
        const float q_[4] = {bflo(gkk.x), bfhi(gkk.x), bflo(gkk.y), bfhi(gkk.y)}, e_[4] = {bflo(ge.x), bfhi(ge.x), bflo(ge.y), bfhi(ge.y)}, a_[4] = {bflo(ga.x), bfhi(ga.x), bflo(ga.y), bfhi(ga.y)}; \
        f32x4 w4, kd4, kk4, b4, wr4, v4; float sbr = 0.f, skr = 0.f; \
        _Pragma("unroll") for (int e = 0; e < 4; ++e) { w4[e] = __expf(-e_[e]); kd4[e] = k_[e] * (1.f + (a_[e] - 1.f) * ka4[e]); kk4[e] = q_[e]; b4[e] = q_[e] * a_[e]; wr4[e] = w4[e] * r_[e]; v4[e] = v_[e]; sbr += b4[e] * r_[e]; skr += kd4[e] * r_[e]; } \
        sbr = row_sum16(sbr); skr = row_sum16(skr); \
        *(LAS f32x4*)(d_) = w4; *(LAS f32x4*)(d_ + 64) = kd4; *(LAS f32x4*)(d_ + 128) = kk4; *(LAS f32x4*)(d_ + 192) = b4; *(LAS f32x4*)(d_ + 256) = wr4; *(LAS f32x4*)(d_ + 320) = v4; \
        if (lq == 0) *(LAS f32x2*)(buf + (bi) * BUFF + lst * STEPF + 384) = (f32x2){sbr, skr}; } } while (0)
#define RW_FLUSH(c) do { if (flr) { const f32x4 y_ = *(const LAS f32x4*)(ybuf + ((c) & 1) * (CT * 64) + fst * 64 + 4 * lq); *(GAS f32x4*)(YS + (size_t)scan_row((c) * CT + fst, dir, b) * 1024 + lc) = y_; } } while (0)
    __syncthreads();
    RW_LOAD(0); RW_WRITE(0); RW_LOAD(1); RW_WRITE(1); RW_LOAD(2);
    __syncthreads();
    const int kg = F.lane & 15, rg = F.lane >> 4, r0 = 8 * F.wave + 2 * rg;
    f32x2 St[4] = {{0.f, 0.f}, {0.f, 0.f}, {0.f, 0.f}, {0.f, 0.f}};
    int bc = 0, bw = 2;
#pragma unroll 1
    for (int c = 0; c < NCHK; ++c) {
        if (c + 2 < NCHK) { RW_WRITE(bw); if (c + 3 < NCHK) RW_LOAD(c + 3); }
        if (c > 0) RW_FLUSH(c - 1);
        const LAS float* bb = buf + bc * BUFF + 4 * kg; const LAS float* vb = buf + bc * BUFF + 320 + r0; const LAS float* sb = buf + bc * BUFF + 384;
        LAS float* yb = ybuf + (c & 1) * (CT * 64) + r0;
        f32x4 w4 = *(const LAS f32x4*)(bb), kd4 = *(const LAS f32x4*)(bb + 64), kk4 = *(const LAS f32x4*)(bb + 128), b4 = *(const LAS f32x4*)(bb + 192), wr4 = *(const LAS f32x4*)(bb + 256);
        f32x2 v2 = *(const LAS f32x2*)(vb), s2 = *(const LAS f32x2*)(sb);
#pragma unroll
        for (int st = 0; st < CT; ++st) {
            const int sn = (st + 1 < CT ? st + 1 : st) * STEPF;
            const f32x4 nw4 = *(const LAS f32x4*)(bb + sn), nkd4 = *(const LAS f32x4*)(bb + sn + 64), nkk4 = *(const LAS f32x4*)(bb + sn + 128), nb4 = *(const LAS f32x4*)(bb + sn + 192), nwr4 = *(const LAS f32x4*)(bb + sn + 256);
            const f32x2 nv2 = *(const LAS f32x2*)(vb + sn), ns2 = *(const LAS f32x2*)(sb + sn);
            f32x2 p = St[0] * kk4[0], z = St[0] * wr4[0];
            p = St[1] * kk4[1] + p; z = St[1] * wr4[1] + z; p = St[2] * kk4[2] + p; z = St[2] * wr4[2] + z; p = St[3] * kk4[3] + p; z = St[3] * wr4[3] + z;
            float p0 = p.x, p1 = p.y, z0 = z.x, z1 = z.y;
            asm volatile("s_nop 1\n\t"
                "v_add_f32_dpp %0, %0, %0 row_ror:8 row_mask:0xf bank_mask:0xf\n\tv_add_f32_dpp %1, %1, %1 row_ror:8 row_mask:0xf bank_mask:0xf\n\tv_add_f32_dpp %2, %2, %2 row_ror:8 row_mask:0xf bank_mask:0xf\n\tv_add_f32_dpp %3, %3, %3 row_ror:8 row_mask:0xf bank_mask:0xf\n\t"
                "v_add_f32_dpp %0, %0, %0 row_ror:4 row_mask:0xf bank_mask:0xf\n\tv_add_f32_dpp %1, %1, %1 row_ror:4 row_mask:0xf bank_mask:0xf\n\tv_add_f32_dpp %2, %2, %2 row_ror:4 row_mask:0xf bank_mask:0xf\n\tv_add_f32_dpp %3, %3, %3 row_ror:4 row_mask:0xf bank_mask:0xf\n\t"
                "v_add_f32_dpp %0, %0, %0 row_ror:2 row_mask:0xf bank_mask:0xf\n\tv_add_f32_dpp %1, %1, %1 row_ror:2 row_mask:0xf bank_mask:0xf\n\tv_add_f32_dpp %2, %2, %2 row_ror:2 row_mask:0xf bank_mask:0xf\n\tv_add_f32_dpp %3, %3, %3 row_ror:2 row_mask:0xf bank_mask:0xf\n\t"
                "v_add_f32_dpp %0, %0, %0 row_ror:1 row_mask:0xf bank_mask:0xf\n\tv_add_f32_dpp %1, %1, %1 row_ror:1 row_mask:0xf bank_mask:0xf\n\tv_add_f32_dpp %2, %2, %2 row_ror:1 row_mask:0xf bank_mask:0xf\n\tv_add_f32_dpp %3, %3, %3 row_ror:1 row_mask:0xf bank_mask:0xf"
                : "+v"(p0), "+v"(p1), "+v"(z0), "+v"(z1));
            const f32x2 pp = {p0, p1}, zz = {z0, z1};
            *(LAS f32x2*)(yb + st * 64) = zz - pp * s2.x + v2 * s2.y;
#pragma unroll
            for (int i = 0; i < 4; ++i) { const f32x2 vk = v2 * kd4[i]; St[i] = (St[i] * w4[i] + vk) - pp * b4[i]; }
            w4 = nw4; kd4 = nkd4; kk4 = nkk4; b4 = nb4; wr4 = nwr4; v2 = nv2; s2 = ns2;
        }
        __syncthreads();
        bc = bc == 2 ? 0 : bc + 1; bw = bw == 2 ? 0 : bw + 1;
    }
    RW_FLUSH(NCHK - 1);
#undef RW_LOAD
#undef RW_WRITE
#undef RW_FLUSH
}
__device__ __forceinline__ void rwkv_out_row(Frame& F, int l, int row) {
    F.tid = ltid(); F.lane = F.tid & 63;
    const int c0 = F.lane * 16; const float* yf = (const float*)(F.ws + WS_YS) + (size_t)row * 1024 + c0; const float* yb = yf + (size_t)M_TOT * 1024;
    float y[16]; float s = 0.f;
#pragma unroll
    for (int j = 0; j < 4; ++j) { const f32x4 a = *(const f32x4*)(yf + 4 * j), b = *(const f32x4*)(yb + 4 * j);
#pragma unroll
        for (int e = 0; e < 4; ++e) { y[4 * j + e] = a[e] + b[e]; s += y[4 * j + e]; } }
    s = quad_sum(s); const float mu = s * (1.f / 64.f); float q = 0.f;
#pragma unroll
    for (int e = 0; e < 16; ++e) { y[e] -= mu; q += y[e] * y[e]; }
    q = quad_sum(q); const float rstd = 1.f / sqrtf(q * (1.f / 64.f) + GN_EPS);
    const bf16* RWF = (const bf16*)(F.ws + WS_RWF); const size_t RS = (size_t)M_TOT * 1024, o = (size_t)row * 1024 + c0;
    const float sbv = ((const float*)(F.ws + WS_SB))[(size_t)row * 16 + (F.lane >> 2)];
    const float* lg = F.A->in[I_LNG] + l * 1024 + c0; const float* lb = F.A->in[I_LNB] + l * 1024 + c0;
    bf16* dst = (bf16*)(F.ws + WS_MIX) + (size_t)row * DM + 3072 + c0;
#pragma unroll
    for (int hf = 0; hf < 2; ++hf) { const v4u vv = *(const v4u*)(RWF + 2 * RS + o + 8 * hf), gg = *(const v4u*)(RWF + 8 * RS + o + 8 * hf); float r[8];
#pragma unroll
        for (int w = 0; w < 4; ++w) { const int e = 8 * hf + 2 * w;
            r[2 * w] = (y[e] * rstd * lg[e] + lb[e] + sbv * bflo(vv[w])) * bflo(gg[w]); r[2 * w + 1] = (y[e + 1] * rstd * lg[e + 1] + lb[e + 1] + sbv * bfhi(vv[w])) * bfhi(gg[w]); }
        v4u ov; ov.x = pk2(r[0], r[1]); ov.y = pk2(r[2], r[3]); ov.z = pk2(r[4], r[5]); ov.w = pk2(r[6], r[7]); *(v4u*)(dst + 8 * hf) = ov; }
}

#ifndef W_OUT_K1
#define W_OUT_K1 2560
#endif
struct MlaTiles { gcbf KV; gcbf KR; int ctx_row0, lat_row0, h;
    __device__ __forceinline__ att::Tile operator()(int j) const { const int row = j < 4 ? ctx_row0 + 64 * j : lat_row0 + 64 * (j - 4);
        att::Tile t; t.kn = KV + (size_t)row * 2048 + h * 256; t.v = t.kn + 128; t.kr = KR + (size_t)row * 64; t.mtype = 0; t.krel0 = 0; return t; } };
struct SwaTiles { gcbf P; int blk_row0, ctx_row0, kvh, nwin, has_prev, has_next;
    __device__ __forceinline__ att::Tile operator()(int j) const { att::Tile t; int row; t.mtype = 0; t.krel0 = 0;
        if (j >= nwin) row = ctx_row0 + 64 * (j - nwin);
        else if (j < 2) row = blk_row0 + 64 * j;
        else if (has_prev && j < 4) { row = blk_row0 - 128 + 64 * (j - 2); t.mtype = 1; t.krel0 = -128 + 64 * (j - 2); }
        else { const int sub = j - 2 - 2 * has_prev; row = blk_row0 + 128 + 64 * sub; t.mtype = 2; t.krel0 = 128 + 64 * sub; }
        t.kn = P + (size_t)row * DINP + C_SWAK + kvh * 128; t.v = P + (size_t)row * DINP + C_SWAV + kvh * 128; t.kr = nullptr; return t; } };

#ifndef MLA_SDEPTH
#define MLA_SDEPTH 1
#endif
__device__ __forceinline__ void mla_item(Frame& F, int b, int h, int qb, bool ctxq) {
    F.tid = ltid(); F.lane = F.tid & 63;
    const int r32 = F.lane & 31; const int t = qb * 256 + F.wave * 32 + r32;
    const int roww0 = ctxq ? M_LAT + b * NCTX + F.wave * 32 : b * SEQ + qb * 256 + F.wave * 32;
    gcbf Qw = (gcbf)(F.ws + WS_Q) + (size_t)(roww0 + r32) * 1536 + h * 192;
    MlaTiles ts{(gcbf)(F.ws + WS_KV), (gcbf)(F.ws + WS_KR), M_LAT + b * NCTX, b * SEQ, h};
    gbfp Ow = (gbfp)(F.ws + WS_MIX) + (size_t)roww0 * DM + 2048 + h * 128;
    att::attn_body<192, 2048, 2048, false, false, MLA_SDEPTH>(Qw, ctxq ? 0 : 1, t >> 6, t & 63, (gcfl)(F.ws + WS_ROPE), 0, 0.f, ts, ctxq ? 4 : 132, Ow, (LAS char*)F.lds);
}
__device__ __forceinline__ void swa_item(Frame& F, int l, int b, int n, int kvh, int half, bool ctxq, int hq_ctx) {
    F.tid = ltid(); F.lane = F.tid & 63;
    const int r32 = F.lane & 31; gcbf P = (gcbf)(F.ws + WS_P);
    int hq, qi, roww0, t;
    if (ctxq) { hq = hq_ctx; kvh = hq >> 2; qi = 0; roww0 = M_LAT + b * NCTX + F.wave * 32; t = 0; }
    else { hq = kvh * 4 + 2 * half + (F.wave >> 2); qi = (F.wave & 3) * 32 + r32; roww0 = b * SEQ + n * 128 + (F.wave & 3) * 32; t = n * 128 + qi; }
    gcbf Qw = P + (size_t)(roww0 + r32) * DINP + C_SWAQ + hq * 128;
    SwaTiles ts; ts.P = P; ts.blk_row0 = b * SEQ + n * 128; ts.ctx_row0 = M_LAT + b * NCTX; ts.kvh = kvh;
    ts.has_prev = (!ctxq && n > 0) ? 1 : 0; ts.has_next = (!ctxq && n < SEQ / 128 - 1) ? 1 : 0; ts.nwin = ctxq ? 0 : 2 + 2 * ts.has_prev + 2 * ts.has_next;
    gbfp Ow = (gbfp)(F.ws + WS_MIX) + (size_t)roww0 * DM + hq * 128;
    const float sink_l2 = F.A->in[I_SINK][l * 8 + hq] * 1.4426950408889634f;
    att::attn_body<128, DINP, DINP, true, true, 2>(Qw, 0, 0, 0, (gcfl)nullptr, qi, sink_l2, ts, ts.nwin + 4, Ow, (LAS char*)F.lds);
}

#ifndef DBG_PHASES
#define DBG_PHASES 0xfffff
#endif
#define PH(n) ((DBG_PHASES >> (n)) & 1)
#ifndef DUP_PHASES
#define DUP_PHASES 0
#endif
#define REP(n) _Pragma("unroll") for (int rep_ = 0; rep_ < (((DUP_PHASES >> (n)) & 1) ? 2 : 1); ++rep_)
__global__ void __launch_bounds__(NTHR, 2) mk_fwd(Args args) {
    extern __shared__ __attribute__((aligned(16))) unsigned char lds[];
    Frame F;
    F.lds = (LAS unsigned char*)lds;
    F.tid = threadIdx.x; F.lane = F.tid & 63; F.wave = __builtin_amdgcn_readfirstlane(F.tid >> 6);
    F.G = gridDim.x; { const int bx = blockIdx.x; F.vcu = (F.G % 8 == 0) ? (bx % 8) * (F.G / 8) + bx / 8 : bx; }
    F.gw = F.vcu * NWAVES + F.wave; F.NGW = F.G * NWAVES;
    F.ws = args.ws; F.out = args.out; F.ctl = (gu32*)(args.ws + WS_CTL);
    F.A = (const __attribute__((address_space(4))) Args*)__builtin_amdgcn_kernarg_segment_ptr();
    for (int u = F.tid; u < (LDS_BYTES - LDSCTL_OFF) / 4; u += NTHR) ((LAS unsigned*)(F.lds + LDSCTL_OFF))[u] = 0u;
    __syncthreads();
    XcdBarrier bar = xcd_barrier_post((unsigned*)(args.ws + WS_CTL) + 4096, (volatile LAS unsigned*)(F.lds + MISC_OFF) + 8);
    const bool rwkv_blk = (blockIdx.x & 3) == 0;
    XcdBarrier bar2; bar2.bar = (unsigned*)(args.ws + WS_CTL) + 8192; bar2.x = 0; bar2.st = (volatile LAS unsigned*)(F.lds + MISC_OFF) + 12; bar2.nparts = gridDim.x - ((gridDim.x + 3) >> 2);
    if (!rwkv_blk) { const unsigned np_ = bar2.nparts; bar2 = xcd_barrier_post((unsigned*)(args.ws + WS_CTL) + 8192, (volatile LAS unsigned*)(F.lds + MISC_OFF) + 12); bar2.nparts = np_; }
#define SUB_BAR() do { bar2.bar = launder(bar2.bar); bar2.x = launder(bar2.x); xcd_barrier(bar2); F.ws = launder_g(F.ws); F.wsw = F.ws + (size_t)lcur * WSET_STRIDE; F.A = launder(F.A); F.tid = ltid(); F.lane = F.tid & 63; } while (0)
#define GRID_BAR() do { bar.bar = launder(bar.bar); bar.x = launder(bar.x); xcd_barrier(bar); F.ws = launder_g(F.ws); F.wsw = F.ws + (size_t)lcur * WSET_STRIDE; F.A = launder(F.A); F.tid = ltid(); F.lane = F.tid & 63; } while (0)
    const int bx = blockIdx.x; int lcur = 0; F.wsw = F.ws;
    bf16* H = (bf16*)(F.ws + WS_H); float* X = (float*)(F.ws + WS_X);

    REP(0) if (PH(0)) { mod_partials(F);
    convert_weights(F, 0, F.gw, F.NGW); }
    GRID_BAR();
    if (PH(1)) { mod_reduce(F); rope_table(F); }
    GRID_BAR();

#pragma unroll 1
    for (int l = 0; l < 2; ++l) {
        lcur = l; F.wsw = F.ws + (size_t)l * WSET_STRIDE;
        const bool wctx = (l == 0);
        const int MO = wctx ? M_TOT : M_LAT;
        if (PH(2) && l == 0) {
            for (int row = F.gw; row < M_TOT; row += F.NGW) { const int s = row_s(row);
                const float* xs = row < M_LAT ? F.A->in[I_X] + (size_t)row * DM : F.A->in[I_CTX] + (size_t)(row - M_LAT) * DM;
                ln_row<0>(F, xs, nullptr, nullptr, nullptr, nullptr, nullptr, true, mod_ptr(F, 0, s, 1), mod_ptr(F, 0, s, 0), H + (size_t)row * DM); }
        }
        GRID_BAR();
        REP(3) if (PH(3)) { pg8::Gemm g{H, (const bf16*)(F.wsw + WS_WIN), M_TOT, DINP, DM, DM, DM}; pg8::StaticOrder S; S.init(M_TOT, DINP, F.G, bx);
          pg8::EpiBf16<0> E{(bf16*)(F.ws + WS_P), DINP, nullptr};
          pg8::gemm_phase<pg8::EpiBf16<0>, pg8::StaticOrder, true, true>(F.lds, g, S, E); }
        GRID_BAR();
        REP(4) if (PH(4)) for (int it = F.vcu; it < 528; it += F.G) rwkv_feat_item(F, l, it);
        REP(5) if (PH(5)) { if (F.G == 256) { if (F.vcu < 16) { for (int it = F.vcu; it < 64; it += 16) lru_item<false>(F, l, it); }
                                              else { for (int it = 64 + F.vcu - 16; it < 2 * NCH * 8; it += 240) lru_item<false>(F, l, it); } }
                            else for (int it = F.vcu; it < 2 * NCH * 8; it += F.G) lru_item<false>(F, l, it); }
        __syncthreads();
        if (PH(6)) for (int row = F.gw; row < M_TOT; row += F.NGW) row_prep(F, row);
        GRID_BAR();
        REP(8) if (rwkv_blk) { const int nrw = (F.G + 3) >> 2; REP(18) if (PH(8)) for (int chain = bx >> 2; chain < 64; chain += nrw) rwkv_scan(F, l, chain); }
        else REP(19) { const int aw = (bx >> 2) * 3 + (bx & 3) - 1, naw = F.G - ((F.G + 3) >> 2);
            if (PH(7) && aw < 8) lru_carry(F, aw);
            if (PH(7)) { pg8::Gemm g{(const bf16*)(F.ws + WS_P) + C_QA, (const bf16*)(F.wsw + WS_WQB), M_TOT, 1536, 1024, DINP, 1024}; pg8::StaticOrder S; S.init(M_TOT, 1536, naw, aw);
              pg8::EpiBf16<2> E{(bf16*)(F.ws + WS_Q), 1536, (const float*)(F.ws + WS_RSQ)};
              pg8::gemm_phase<pg8::EpiBf16<2>, pg8::StaticOrder, true, true>(F.lds, g, S, E); }
            if (PH(7)) { pg8::Gemm g{(const bf16*)(F.ws + WS_P) + C_KVA, (const bf16*)(F.wsw + WS_WKVB), M_TOT, 2048, 512, DINP, 512}; pg8::StaticOrder S; S.init(M_TOT, 2048, naw, aw);
              pg8::EpiBf16<2> E{(bf16*)(F.ws + WS_KV), 2048, (const float*)(F.ws + WS_RSKV)};
              pg8::gemm_phase<pg8::EpiBf16<2>, pg8::StaticOrder, true, true>(F.lds, g, S, E); }
            SUB_BAR();
            if (PH(9)) for (int it = aw; it < 512; it += naw) mla_item(F, it >> 8, (it >> 5) & 7, it & 31, false);
            if (PH(9) && wctx) for (int it = aw; it < 16; it += naw) mla_item(F, it >> 3, it & 7, 0, true);
            if (PH(10)) for (int it = aw; it < 512; it += naw) swa_item(F, l, it >> 8, (it >> 2) & 63, (it >> 1) & 1, it & 1, false, 0);
            if (PH(10) && wctx) for (int it = aw; it < 16; it += naw) swa_item(F, l, it >> 3, 0, 0, 0, true, it & 7);
            if (PH(11)) for (int it = aw; it < 2 * NCH * 8; it += naw) { if (!wctx && ((it >> 3) % NCH) < 8) continue; lru_item<true>(F, l, it); }
            if (l == 0) { __syncthreads(); convert_weights(F, 1, aw * NWAVES + F.wave, naw * NWAVES); }
            else { SUB_BAR();
                pg8::Gemm g{(const bf16*)(F.ws + WS_MIX), (const bf16*)(F.wsw + WS_WOUT), M_LAT, DM, W_OUT_K1, DM, DM}; pg8::StaticOrder S; S.init(M_LAT, DM, naw, aw);
                pg8::EpiBf16<0> E{(bf16*)(F.ws + WS_Y1), DM, nullptr};
                pg8::gemm_phase<pg8::EpiBf16<0>, pg8::StaticOrder, true, true>(F.lds, g, S, E); }
        }
        GRID_BAR();
        REP(12) if (PH(12)) for (int row = F.gw; row < MO; row += F.NGW) rwkv_out_row(F, l, row);
        GRID_BAR();
        REP(13) if (PH(13)) {
          if (l == 0) { pg8::Gemm g{(const bf16*)(F.ws + WS_MIX), (const bf16*)(F.wsw + WS_WOUT), M_LAT, DM, DM, DM, DM}; pg8::StaticOrder S; S.init(M_LAT, DM, F.G, bx);
            pg8::EpiBf16<0> E{(bf16*)(F.ws + WS_Y1), DM, nullptr};
            pg8::gemm_phase<pg8::EpiBf16<0>, pg8::StaticOrder, true, true>(F.lds, g, S, E); }
          else { pg8::Gemm g{(const bf16*)(F.ws + WS_MIX) + W_OUT_K1, (const bf16*)(F.wsw + WS_WOUT) + W_OUT_K1, M_LAT, DM, DM - W_OUT_K1, DM, DM}; pg8::StaticOrder S; S.init(M_LAT, DM, F.G, bx);
            pg8::EpiBf16<3> E{(bf16*)(F.ws + WS_Y1), DM, nullptr};
            pg8::gemm_phase<pg8::EpiBf16<3>, pg8::StaticOrder, true, true>(F.lds, g, S, E); }
          if (wctx) {
              pg8::Gemm g2{(const bf16*)(F.ws + WS_MIX) + (size_t)M_LAT * DM, (const bf16*)(F.wsw + WS_WOUT), M_CTX, DM, DM / 8, DM, DM}; pg8::SplitOrder S2; S2.init(M_CTX, DM, DM / 8, bx);
              pg8::EpiF32 E2{(float*)(F.ws + WS_YP), DM, (size_t)M_CTX * DM};
              pg8::gemm_phase<pg8::EpiF32, pg8::SplitOrder, true, true>(F.lds, g2, S2, E2); } }
        GRID_BAR();
        if (PH(14)) for (int row = F.gw; row < MO; row += F.NGW) { const int s = row_s(row);
            const float* xs = (l == 0) ? (row < M_LAT ? F.A->in[I_X] + (size_t)row * DM : F.A->in[I_CTX] + (size_t)(row - M_LAT) * DM) : X + (size_t)row * DM;
            bf16* yrow = (bf16*)(F.ws + WS_Y1) + (size_t)row * DM;
            if (row >= M_LAT) sum_partials_row(F, (const float*)(F.ws + WS_YP) + (size_t)(row - M_LAT) * DM, (size_t)M_CTX * DM, yrow);
            ln_row<1>(F, xs, yrow, mod_ptr(F, l, s, 2), F.A->in[I_LN1G] + l * DM, F.A->in[I_LN1B] + l * DM, X + (size_t)row * DM,
                      true, mod_ptr(F, l, s, 4), mod_ptr(F, l, s, 3), H + (size_t)row * DM); }
        GRID_BAR();
        REP(15) if (PH(15)) { pg8::Gemm g{H, (const bf16*)(F.wsw + WS_WFF1), MO, DFF, DM, DM, DM}; pg8::StaticOrder S; S.init(MO, DFF, F.G, bx);
          pg8::EpiBf16<1> E{(bf16*)(F.ws + WS_HID), DFF, nullptr};
          pg8::gemm_phase<pg8::EpiBf16<1>, pg8::StaticOrder, true, true>(F.lds, g, S, E); }
        GRID_BAR();
        REP(16) if (PH(16)) { pg8::Gemm g{(const bf16*)(F.ws + WS_HID), (const bf16*)(F.wsw + WS_WFF2), M_LAT, DM, DFF, DFF, DFF}; pg8::StaticOrder S; S.init(M_LAT, DM, F.G, bx);
          pg8::EpiBf16<0> E{(bf16*)(F.ws + WS_Y2), DM, nullptr};
          pg8::gemm_phase<pg8::EpiBf16<0>, pg8::StaticOrder, true, true>(F.lds, g, S, E);
          if (wctx) {
              pg8::Gemm g2{(const bf16*)(F.ws + WS_HID) + (size_t)M_LAT * DFF, (const bf16*)(F.wsw + WS_WFF2), M_CTX, DM, DFF / 8, DFF, DFF}; pg8::SplitOrder S2; S2.init(M_CTX, DM, DFF / 8, bx);
              pg8::EpiF32 E2{(float*)(F.ws + WS_YP), DM, (size_t)M_CTX * DM};
              pg8::gemm_phase<pg8::EpiF32, pg8::SplitOrder, true, true>(F.lds, g2, S2, E2); } }
        GRID_BAR();
        if (!PH(17)) {} else if (l == 0) {
            for (int row = F.gw; row < M_TOT; row += F.NGW) { const int s = row_s(row);
                bf16* yrow = (bf16*)(F.ws + WS_Y2) + (size_t)row * DM;
                if (row >= M_LAT) sum_partials_row(F, (const float*)(F.ws + WS_YP) + (size_t)(row - M_LAT) * DM, (size_t)M_CTX * DM, yrow);
                ln_row<1>(F, X + (size_t)row * DM, yrow, mod_ptr(F, 0, s, 5), F.A->in[I_LN2G], F.A->in[I_LN2B], X + (size_t)row * DM,
                          true, mod_ptr(F, 1, s, 1), mod_ptr(F, 1, s, 0), H + (size_t)row * DM); }
        } else {
            for (int row = F.gw; row < M_LAT; row += F.NGW) { const int s = row_s(row);
                ln_row<1>(F, X + (size_t)row * DM, (const bf16*)(F.ws + WS_Y2) + (size_t)row * DM, mod_ptr(F, 1, s, 5), F.A->in[I_LN2G] + DM, F.A->in[I_LN2B] + DM, F.out + (size_t)row * DM,
                          false, nullptr, nullptr, nullptr); }
        }
    }
}

extern "C" void kernel_launch(void* const* d_in, const int* in_sizes, int n_in, void* d_out, int out_size, void* d_ws, size_t ws_size, hipStream_t stream) {
    static int grid = 0;
    if (grid == 0) {
        if (n_in != 38 || out_size != M_LAT * DM || ws_size < WS_END) { fprintf(stderr, "kernel_launch: unexpected shapes: n_in %d out %d ws %zu (need %zu)\n", n_in, out_size, ws_size, (size_t)WS_END); grid = -1; return; }
        int dev = 0, cus = 0, per_cu = 0;
        if (hipGetDevice(&dev) != hipSuccess || hipDeviceGetAttribute(&cus, hipDeviceAttributeMultiprocessorCount, dev) != hipSuccess) { grid = -1; return; }
        if (hipFuncSetAttribute((const void*)mk_fwd, hipFuncAttributeMaxDynamicSharedMemorySize, LDS_BYTES) != hipSuccess) { fprintf(stderr, "kernel_launch: hipFuncSetAttribute failed\n"); grid = -1; return; }
        if (hipOccupancyMaxActiveBlocksPerMultiprocessor(&per_cu, (const void*)mk_fwd, NTHR, LDS_BYTES) != hipSuccess || per_cu < 1) fprintf(stderr, "kernel_launch: occupancy query says %d\n", per_cu);
        (void)hipGetLastError();
        grid = cus;
    }
    if (grid < 0) return;
    if (hipMemsetAsync((char*)d_ws + WS_CTL, 0, CTL_ZERO_BYTES, stream) != hipSuccess) return;
    Args a{};
    for (int i = 0; i < 38; ++i) a.in[i] = (const float*)d_in[i];
    a.out = (float*)d_out; a.ws = (unsigned char*)d_ws;
    hipLaunchKernelGGL(mk_fwd, dim3(grid), dim3(NTHR), LDS_BYTES, stream, a);
    const hipError_t le = hipPeekAtLastError();
    if (le != hipSuccess) fprintf(stderr, "kernel_launch: launch failed: %s\n", hipGetErrorName(le));
}
```

```cpp
#include <hip/hip_runtime.h>
#include <hip/hip_bf16.h>
#include <cstdio>
#include <cstdint>

namespace pg8 {
#define PG8_LAS __attribute__((address_space(3)))
typedef unsigned short bf16_t;
typedef short bf16x8 __attribute__((ext_vector_type(8)));
typedef float f32x4 __attribute__((ext_vector_type(4)));
typedef unsigned u32x4 __attribute__((ext_vector_type(4)));
constexpr int BM = 256, BK = 64, HALF = 128, HTB = HALF * BK * 2  , STAGE_BYTES = 8 * HTB, NXCD = 8, WGM = 8;

__host__ __device__ __forceinline__ int lds_byte(int r, int c) { const int st = (r >> 4) * 2 + (c >> 5), rr = r & 15, cc = c & 31, ob = rr * 64 + cc * 2; return st * 1024 + (ob ^ (((ob >> 9) & 1) << 5)); }
__host__ __device__ __forceinline__ void stage_rc(int b, int& R, int& C) { const int st = b / 1024, sb = b % 1024, swz = sb ^ (((sb >> 9) & 1) << 5); R = (st >> 1) * 16 + swz / 64; C = (st & 1) * 32 + (swz % 64) / 2; }
__host__ __device__ __forceinline__ int perm32(int rho) { const int n = rho >> 4, i = rho & 15; return 8 * (i >> 2) + 4 * n + (i & 3); }

struct Unit { int pm, pn, ko, ks; };
struct Gemm { const bf16_t* A; const bf16_t* Bt; int M, N, K, lda, ldb; };

struct StaticOrder {
    int nM, nN, nwg, G, c;
    __host__ __device__ void init(int M, int N, int G_, int c_) { nM = M / BM; nN = N / BM; nwg = nM * nN; G = G_; c = c_; }
    __host__ __device__ bool next(int i, Unit& u) const {
        const long L = (long)i * G + c; if (L >= nwg) return false;
        int wgid = (int)L; { const int q = nwg / NXCD, r = nwg % NXCD, xcd = wgid % NXCD, off = wgid / NXCD; wgid = (xcd < r ? xcd * (q + 1) : r * (q + 1) + (xcd - r) * q) + off; }
        const int nig = WGM * nN, gid = wgid / nig, fm = gid * WGM, gsz = (nM - fm) < WGM ? (nM - fm) : WGM;
        u.pm = fm + ((wgid % nig) % gsz); u.pn = (wgid % nig) / gsz; u.ko = 0; u.ks = 0; return true;
    }
    __device__ __forceinline__ void a_ready(const Unit&) const {}
    __device__ __forceinline__ void done(const Unit&) const {}
};
struct SplitOrder {
    int nN, nitems, kslice, c;
    __host__ __device__ void init(int M, int N, int Kslice, int c_) { nN = N / BM; nitems = (M / BM) * nN * 8; kslice = Kslice; c = c_; }
    __host__ __device__ bool next(int i, Unit& u) const { if (i > 0 || c >= nitems) return false; u.ks = c & 7; u.ko = u.ks * kslice; u.pn = (c >> 3) % nN; u.pm = (c >> 3) / nN; return true; }
    __device__ __forceinline__ void a_ready(const Unit&) const {}
    __device__ __forceinline__ void done(const Unit&) const {}
};

__device__ __forceinline__ unsigned cvt_pk_bf16(float lo, float hi) { unsigned r; asm volatile("v_cvt_pk_bf16_f32 %0, %1, %2" : "=v"(r) : "v"(lo), "v"(hi)); return r; }

struct EpiF32 {
    static constexpr bool PERM = false, AFTER_DRAIN = false;
    float* C; int ldc; size_t split_stride;
    __device__ __forceinline__ void operator()(const f32x4 (&acc)[2][2][4][2], const Unit& u, int wr, int wc, int fr, int fq) const {
        const int row0 = u.pm * BM + wr * 64 + fr, col0 = u.pn * BM + wc * 32 + 4 * fq; float* Cb = C + (size_t)u.ks * split_stride;
#pragma unroll
        for (int ai = 0; ai < 2; ++ai)
#pragma unroll
            for (int m = 0; m < 4; ++m) { float* rowp = Cb + (size_t)(row0 + ai * HALF + m * 16) * ldc + col0;
#pragma unroll
                for (int bj = 0; bj < 2; ++bj)
#pragma unroll
                    for (int n = 0; n < 2; ++n) *(f32x4*)(rowp + bj * HALF + n * 16) = acc[ai][bj][m][n]; }
    }
};
template <int ACT> struct EpiBf16 {
    static constexpr bool PERM = true, AFTER_DRAIN = false;
    bf16_t* O; int ldc; const float* rowscale;
    __device__ __forceinline__ void operator()(const f32x4 (&acc)[2][2][4][2], const Unit& u, int wr, int wc, int fr, int fq) const {
        const int row0 = u.pm * BM + wr * 64 + fr; const int col0 = u.pn * BM + wc * 32 + 8 * fq;
#pragma unroll
        for (int ai = 0; ai < 2; ++ai)
#pragma unroll
            for (int m = 0; m < 4; ++m) { const int row = row0 + ai * HALF + m * 16; bf16_t* rowp = O + (size_t)row * ldc + col0;
                float rs = 1.f; if (ACT == 2) rs = rowscale[row];
#pragma unroll
                for (int bj = 0; bj < 2; ++bj) { f32x4 v0 = acc[ai][bj][m][0], v1 = acc[ai][bj][m][1];
                    if (ACT == 1) {
#pragma unroll
                        for (int j = 0; j < 4; ++j) { const float a = fmaxf(v0[j], 0.f), b = fmaxf(v1[j], 0.f); v0[j] = a * a; v1[j] = b * b; } }
                    if (ACT == 2) { v0 = v0 * rs; v1 = v1 * rs; }
                    if (ACT == 3) { const u32x4 o = *(const u32x4*)(rowp + bj * HALF);
                        v0[0] += __builtin_bit_cast(float, o.x << 16); v0[1] += __builtin_bit_cast(float, o.x & 0xffff0000u); v0[2] += __builtin_bit_cast(float, o.y << 16); v0[3] += __builtin_bit_cast(float, o.y & 0xffff0000u);
                        v1[0] += __builtin_bit_cast(float, o.z << 16); v1[1] += __builtin_bit_cast(float, o.z & 0xffff0000u); v1[2] += __builtin_bit_cast(float, o.w << 16); v1[3] += __builtin_bit_cast(float, o.w & 0xffff0000u); }
                    u32x4 w; w.x = cvt_pk_bf16(v0[0], v0[1]); w.y = cvt_pk_bf16(v0[2], v0[3]); w.z = cvt_pk_bf16(v1[0], v1[1]); w.w = cvt_pk_bf16(v1[2], v1[3]);
                    *(u32x4*)(rowp + bj * HALF) = w; } }
    }
};

template <class Epi, class Sched, bool ALIGN_EPI = false, bool SP2 = false>
__device__ __forceinline__ void gemm_phase(PG8_LAS unsigned char* lds, const Gemm g, const Sched& S, const Epi& E) {
    int tid = threadIdx.x; asm volatile("" : "+v"(tid));
    const int wid = __builtin_amdgcn_readfirstlane(tid >> 6), lane = tid & 63, wr = wid >> 2, wc = wid & 3, fr = lane & 15, fq = lane >> 4;
    const int K = g.K, nt = K / BK, lda = g.lda, ldb = g.ldb;
    unsigned voffA[2], voffB[2];
#pragma unroll
    for (int i = 0; i < 2; ++i) { int R, C; stage_rc(tid * 16 + i * 8192, R, C); const int Rb = Epi::PERM ? ((R & ~31) + perm32(R & 31)) : R;
        voffA[i] = (unsigned)(R * lda + C) * 2u; voffB[i] = (unsigned)(Rb * ldb + C) * 2u; }
    const size_t kstep = (size_t)(BK * 2);
    const size_t hstepA = (size_t)HALF * lda * 2, hstepB = (size_t)HALF * ldb * 2;
    const size_t tstepA = 2 * hstepA, tstepB = 2 * hstepB;
    const unsigned ldsw = (unsigned)wid * 1024u;
    const int aoff = lds_byte(wr * 64 + fr, fq * 8), boff = lds_byte(wc * 32 + fr, fq * 8);
#define PG8_SA(b, h) (((b) * 2 + (h)) * HTB)
#define PG8_SB(b, h) ((4 + (b) * 2 + (h)) * HTB)
#define PG8_STAGE(bufoff, gbase, voff) do { _Pragma("unroll") for (int _i = 0; _i < 2; ++_i) \
        __builtin_amdgcn_global_load_lds((const unsigned*)((const char*)(gbase) + (voff)[_i]), (PG8_LAS unsigned*)(lds + (bufoff) + ldsw + _i * 8192), 16, 0, 0); } while (0)
#define PG8_LDA(dst, b, h) do { _Pragma("unroll") for (int m = 0; m < 4; ++m) _Pragma("unroll") for (int k = 0; k < 2; ++k) dst[m][k] = *(const PG8_LAS bf16x8*)(lds + PG8_SA(b, h) + aoff + m * 2048 + k * 1024); } while (0)
#define PG8_LDB(dst, b, h) do { _Pragma("unroll") for (int n = 0; n < 2; ++n) _Pragma("unroll") for (int k = 0; k < 2; ++k) dst[n][k] = *(const PG8_LAS bf16x8*)(lds + PG8_SB(b, h) + boff + n * 2048 + k * 1024); } while (0)
#define PG8_MMA(ai, bj, At, Bt) do { __builtin_amdgcn_s_setprio(1); _Pragma("unroll") for (int m = 0; m < 4; ++m) _Pragma("unroll") for (int n = 0; n < 2; ++n) _Pragma("unroll") for (int k = 0; k < 2; ++k) \
        acc[ai][bj][m][n] = __builtin_amdgcn_mfma_f32_16x16x32_bf16(Bt[n][k], At[m][k], acc[ai][bj][m][n], 0, 0, 0); __builtin_amdgcn_s_setprio(0); } while (0)
#define PG8_WAIT_V(n) asm volatile("s_waitcnt vmcnt(" #n ")" ::: "memory")
#define PG8_WAIT_L(n) asm volatile("s_waitcnt lgkmcnt(" #n ")" ::: "memory")
#define PG8_BAR __builtin_amdgcn_s_barrier()
#define PG8_SCHED __builtin_amdgcn_sched_barrier(0)
    Unit cur, nxt; int ui = 0;
    if (!S.next(0, cur)) return;
    f32x4 acc[2][2][4][2];
#pragma unroll
    for (int a = 0; a < 2; ++a)
#pragma unroll
        for (int b = 0; b < 2; ++b)
#pragma unroll
            for (int m = 0; m < 4; ++m)
#pragma unroll
                for (int n = 0; n < 2; ++n) acc[a][b][m][n] = (f32x4){0.f, 0.f, 0.f, 0.f};
    bf16x8 At[4][2], B0[2][2], B1[2][2];
    const char* cA = (const char*)g.A + (size_t)cur.pm * tstepA + (size_t)cur.ko * 2; const char* cB = (const char*)g.Bt + (size_t)cur.pn * tstepB + (size_t)cur.ko * 2;
    S.a_ready(cur);
    if constexpr (SP2) {
        PG8_STAGE(PG8_SB(0, 0), cB, voffB); PG8_STAGE(PG8_SB(0, 1), cB + hstepB, voffB); PG8_STAGE(PG8_SA(0, 0), cA, voffA); PG8_STAGE(PG8_SA(0, 1), cA + hstepA, voffA);
        if (wr == 1) PG8_BAR;
        PG8_WAIT_V(2); PG8_BAR;
        PG8_STAGE(PG8_SB(1, 0), cB + kstep, voffB); PG8_STAGE(PG8_SA(1, 0), cA + kstep, voffA); PG8_STAGE(PG8_SB(1, 1), cB + hstepB + kstep, voffB);
        PG8_WAIT_V(6); PG8_BAR;
    } else {
        PG8_STAGE(PG8_SB(0, 0), cB, voffB); PG8_STAGE(PG8_SA(0, 0), cA, voffA); PG8_STAGE(PG8_SB(0, 1), cB + hstepB, voffB); PG8_STAGE(PG8_SA(0, 1), cA + hstepA, voffA);
        if (wr == 1) PG8_BAR;
        PG8_WAIT_V(4); PG8_BAR;
        PG8_STAGE(PG8_SB(1, 0), cB + kstep, voffB); PG8_STAGE(PG8_SA(1, 0), cA + kstep, voffA); PG8_STAGE(PG8_SB(1, 1), cB + hstepB + kstep, voffB);
        PG8_WAIT_V(6); PG8_BAR;
    }
    for (;;) {
        const bool has_next = S.next(ui + 1, nxt);
        const char* nA = has_next ? (const char*)g.A + (size_t)nxt.pm * tstepA + (size_t)nxt.ko * 2 : cA; const char* nB = has_next ? (const char*)g.Bt + (size_t)nxt.pn * tstepB + (size_t)nxt.ko * 2 : cB;
        for (int t = 0; t < nt; t += 2) {
            const bool last = (t == nt - 2);
            const char* a1 = cA + (size_t)(t + 1) * kstep;
            const char* a2 = last ? nA : cA + (size_t)(t + 2) * kstep; const char* b2 = last ? nB : cB + (size_t)(t + 2) * kstep;
            const char* a3 = a2 + kstep; const char* b3 = b2 + kstep;
            if (last && has_next) S.a_ready(nxt);
            if constexpr (SP2) {
            PG8_LDB(B0, 0, 0); PG8_LDB(B1, 0, 1); PG8_SCHED; PG8_LDA(At, 0, 0); PG8_STAGE(PG8_SA(1, 1), a1 + hstepA, voffA);
            PG8_WAIT_V(8); PG8_WAIT_L(0); PG8_BAR; PG8_MMA(0, 0, At, B0); PG8_MMA(0, 1, At, B1); PG8_BAR; PG8_SCHED;
            PG8_LDA(At, 0, 1); PG8_STAGE(PG8_SB(0, 0), b2, voffB); PG8_STAGE(PG8_SB(0, 1), b2 + hstepB, voffB); PG8_STAGE(PG8_SA(0, 0), a2, voffA);
            PG8_WAIT_V(8); PG8_WAIT_L(0); PG8_BAR; PG8_MMA(1, 0, At, B0); PG8_MMA(1, 1, At, B1); PG8_BAR; PG8_SCHED;
            PG8_LDB(B0, 1, 0); PG8_LDB(B1, 1, 1); PG8_SCHED; PG8_LDA(At, 1, 0); PG8_STAGE(PG8_SA(0, 1), a2 + hstepA, voffA);
            PG8_WAIT_V(8); PG8_WAIT_L(0); PG8_BAR; PG8_MMA(0, 0, At, B0); PG8_MMA(0, 1, At, B1); PG8_BAR; PG8_SCHED;
            PG8_LDA(At, 1, 1); PG8_STAGE(PG8_SB(1, 0), b3, voffB); PG8_STAGE(PG8_SB(1, 1), b3 + hstepB, voffB); PG8_STAGE(PG8_SA(1, 0), a3, voffA);
            PG8_WAIT_V(8); PG8_WAIT_L(0); PG8_BAR; PG8_MMA(1, 0, At, B0); PG8_MMA(1, 1, At, B1); PG8_BAR; PG8_SCHED;
            } else {
            PG8_LDB(B0, 0, 0); PG8_SCHED; PG8_LDA(At, 0, 0); PG8_STAGE(PG8_SA(1, 1), a1 + hstepA, voffA);
            PG8_WAIT_L(8); PG8_BAR; PG8_WAIT_L(0); PG8_MMA(0, 0, At, B0); PG8_BAR; PG8_SCHED;
            PG8_LDB(B1, 0, 1); PG8_STAGE(PG8_SB(0, 0), b2, voffB);
            PG8_BAR; PG8_WAIT_L(0); PG8_MMA(0, 1, At, B1); PG8_BAR;
            PG8_LDA(At, 0, 1); PG8_STAGE(PG8_SA(0, 0), a2, voffA);
            PG8_BAR; PG8_WAIT_L(0); PG8_MMA(1, 0, At, B0); PG8_BAR; PG8_SCHED;
            PG8_STAGE(PG8_SB(0, 1), b2 + hstepB, voffB);
            PG8_WAIT_V(6); PG8_BAR; PG8_MMA(1, 1, At, B1); PG8_BAR;
            PG8_LDB(B0, 1, 0); PG8_SCHED; PG8_LDA(At, 1, 0); PG8_STAGE(PG8_SA(0, 1), a2 + hstepA, voffA);
            PG8_WAIT_L(8); PG8_BAR; PG8_WAIT_L(0); PG8_MMA(0, 0, At, B0); PG8_BAR; PG8_SCHED;
            PG8_LDB(B1, 1, 1); PG8_STAGE(PG8_SB(1, 0), b3, voffB);
            PG8_BAR; PG8_WAIT_L(0); PG8_MMA(0, 1, At, B1); PG8_BAR;
            PG8_LDA(At, 1, 1); PG8_STAGE(PG8_SA(1, 0), a3, voffA);
            PG8_BAR; PG8_WAIT_L(0); PG8_MMA(1, 0, At, B0); PG8_BAR; PG8_SCHED;
            PG8_STAGE(PG8_SB(1, 1), b3 + hstepB, voffB);
            PG8_WAIT_V(6); PG8_BAR; PG8_MMA(1, 1, At, B1); PG8_BAR;
            }
        }
        if constexpr (ALIGN_EPI) { if (wr == 0) PG8_BAR; }
        E(acc, cur, wr, wc, fr, fq); S.done(cur);
        if (!has_next) break;
#pragma unroll
        for (int a = 0; a < 2; ++a)
#pragma unroll
            for (int b = 0; b < 2; ++b)
#pragma unroll
                for (int m = 0; m < 4; ++m)
#pragma unroll
                    for (int n = 0; n < 2; ++n) acc[a][b][m][n] = (f32x4){0.f, 0.f, 0.f, 0.f};
        cur = nxt; cA = nA; cB = nB; ++ui;
        if constexpr (ALIGN_EPI) { if (wr == 1) PG8_BAR; }
    }
    PG8_WAIT_V(0);
    if constexpr (!ALIGN_EPI) { if (wr == 0) PG8_BAR; }
    PG8_BAR;
#undef PG8_SA
#undef PG8_SB
#undef PG8_STAGE
#undef PG8_LDA
#undef PG8_LDB
#undef PG8_MMA
#undef PG8_WAIT_V
#undef PG8_WAIT_L
#undef PG8_BAR
#undef PG8_SCHED
}
}

constexpr int NWAVES = 8, NTHR = 512;
constexpr int DM = 4096, NB = 2, SEQ = 8192, NCTX = 256, DFF = 16384;
constexpr int M_LAT = NB * SEQ, M_CTX = NB * NCTX, M_TOT = M_LAT + M_CTX;
constexpr int DIN = 8672, DINP = 8704;
constexpr int C_SWAQ = 0, C_SWAK = 1024, C_SWAV = 1280, C_LRUX = 1536, C_LRUY = 2560, C_QA = 3584, C_KVA = 4608, C_KR = 5120, C_RW = 5184;
constexpr int C_RWR = C_RW, C_RWK = C_RW + 1024, C_RWV = C_RW + 2048, C_RWL = C_RW + 3072;
constexpr int RWC = 3488;
constexpr float LN_EPS = 1e-5f, RMS_EPS = 1e-6f, GN_EPS = 64e-5f, ALPHA = 1.41421356237f;
constexpr int NCH = 264;

constexpr size_t MiB = 1u << 20;
constexpr size_t WS_CTL = 0, CTL_ZERO_BYTES = 1 * MiB;
constexpr size_t WS_MOD = 1 * MiB;
constexpr size_t WS_MODP = 2 * MiB;
constexpr size_t WS_SMALL = 20 * MiB;
constexpr size_t WS_RSQ = WS_SMALL;
constexpr size_t WS_RSKV = WS_RSQ + 128 * 1024;
constexpr size_t WS_SB = WS_RSKV + 128 * 1024;
constexpr size_t WS_CA = WS_SB + 2 * MiB;
constexpr size_t WS_CB = WS_CA + 5 * MiB;
constexpr size_t WS_HIN = WS_CB + 5 * MiB;
constexpr size_t WS_QUIRK = WS_HIN + 5 * MiB;
constexpr size_t WS_ROPE = WS_QUIRK + 8192;
static_assert(WS_ROPE + 16384 <= 40 * MiB, "small region");
constexpr size_t WS_W = 40 * MiB;
constexpr size_t WS_WIN = WS_W, WS_WOUT = WS_WIN + 68 * MiB, WS_WFF1 = WS_WOUT + 32 * MiB, WS_WFF2 = WS_WFF1 + 128 * MiB, WS_WQB = WS_WFF2 + 128 * MiB,
                 WS_WKVB = WS_WQB + 3 * MiB, WS_WLRU = WS_WKVB + 2 * MiB, WS_WLORA = WS_WLRU + 1 * MiB;
constexpr size_t WS_W2T = WS_WLORA, WS_A2T = WS_W2T + 256 * 1024, WS_G2T = WS_A2T + 256 * 1024;
constexpr size_t WS_X = 403 * MiB;
constexpr size_t WS_H = 667 * MiB;
constexpr size_t WS_MIX = 799 * MiB;
constexpr size_t WS_YS = 931 * MiB;
constexpr size_t WS_P = 1063 * MiB;
constexpr size_t WS_RWF = 1344 * MiB;
constexpr size_t RWF_STRIDE = (size_t)M_TOT * 1024 * 2;
constexpr size_t WS_Q = 1641 * MiB;
constexpr size_t WS_KV = 1691 * MiB;
constexpr size_t WS_KR = 1757 * MiB;
constexpr size_t WS_SET2 = 1760 * MiB;
constexpr size_t WSET_STRIDE = WS_SET2 - WS_W;
constexpr size_t WS_END = WS_SET2 + 363 * MiB;
constexpr size_t WS_YP = WS_Q;
constexpr size_t WS_HID = WS_P;
constexpr size_t WS_Y1 = WS_P;
constexpr size_t WS_Y2 = WS_MIX;
static_assert(WS_WLORA + 1 * MiB <= WS_X && WS_P + (size_t)M_TOT * DINP * 2 <= WS_RWF && WS_RWF + 9 * RWF_STRIDE <= WS_Q, "ws map");
static_assert(WS_HID + (size_t)M_TOT * DFF * 2 <= WS_Q && WS_Y2 + (size_t)M_TOT * DM * 4 <= WS_P && WS_YS + 2 * (size_t)M_TOT * 1024 * 4 <= WS_P, "ws overlays");
static_assert(WS_KR + (size_t)M_TOT * 64 * 2 <= WS_SET2 && WS_YP + 8 * (size_t)M_CTX * DM * 4 <= WS_KR, "ws end");

constexpr int RING_BYTES = 131072;
constexpr int LDSCTL_OFF = RING_BYTES, MISC_OFF = LDSCTL_OFF + 320;
constexpr int LDS_BYTES = 147456;

#define GAS __attribute__((address_space(1)))
#define LAS __attribute__((address_space(3)))
typedef unsigned short bf16;
typedef unsigned v4u __attribute__((ext_vector_type(4)));
typedef unsigned v2u __attribute__((ext_vector_type(2)));
typedef float f32x4 __attribute__((ext_vector_type(4)));
typedef float f32x2 __attribute__((ext_vector_type(2)));
typedef float f32x16 __attribute__((ext_vector_type(16)));
typedef short bf16x8 __attribute__((ext_vector_type(8)));
typedef short s16x4 __attribute__((ext_vector_type(4)));
typedef GAS unsigned gu32;
typedef const GAS bf16* gcbf; typedef GAS bf16* gbfp; typedef const GAS float* gcfl; typedef GAS float* gflp;
#define LDS_WAIT() asm volatile("s_waitcnt lgkmcnt(0)" ::: "memory")
#define VM_WAIT() asm volatile("s_waitcnt vmcnt(0)" ::: "memory")
__device__ __forceinline__ unsigned f2bf(float f) { unsigned u = __builtin_bit_cast(unsigned, f); return (u + 0x7fffu + ((u >> 16) & 1u)) >> 16; }
__device__ __forceinline__ unsigned pk2(float lo, float hi) { return f2bf(lo) | (f2bf(hi) << 16); }
__device__ __forceinline__ float bflo(unsigned w) { return __builtin_bit_cast(float, w << 16); }
__device__ __forceinline__ float bfhi(unsigned w) { return __builtin_bit_cast(float, w & 0xffff0000u); }
__device__ __forceinline__ float bf2f(bf16 h) { return __builtin_bit_cast(float, (unsigned)h << 16); }
#define DPP_ADD(x, ctrl) ((x) + __builtin_bit_cast(float, __builtin_amdgcn_update_dpp(0, __builtin_bit_cast(int, (x)), (ctrl), 0xf, 0xf, false)))
__device__ __forceinline__ float row_sum16(float x) { x = DPP_ADD(x, 0x128); x = DPP_ADD(x, 0x124); x = DPP_ADD(x, 0x122); x = DPP_ADD(x, 0x121); return x; }
#ifdef OLD_SUMS
__device__ __forceinline__ float wave_sum(float v) {
#pragma unroll
    for (int o = 1; o < 64; o <<= 1) v += __shfl_xor(v, o);
    return v;
}
__device__ __forceinline__ float half_swap_sum(float x) { return x + __shfl_xor(x, 32); }
__device__ __forceinline__ float quad_sum(float x) { x += __shfl_xor(x, 1); x += __shfl_xor(x, 2); return x; }
#else
__device__ __forceinline__ float wave_sum(float v) {
    const float r = row_sum16(v);
    const float a = __builtin_bit_cast(float, __builtin_amdgcn_readlane(__builtin_bit_cast(int, r), 0)), b = __builtin_bit_cast(float, __builtin_amdgcn_readlane(__builtin_bit_cast(int, r), 16));
    const float c = __builtin_bit_cast(float, __builtin_amdgcn_readlane(__builtin_bit_cast(int, r), 32)), d = __builtin_bit_cast(float, __builtin_amdgcn_readlane(__builtin_bit_cast(int, r), 48));
    return (a + b) + (c + d);
}
__device__ __forceinline__ float half_swap_sum(float x) {
    unsigned a = __builtin_bit_cast(unsigned, x), b = a; asm volatile("" : "+v"(b));
    auto rr = __builtin_amdgcn_permlane32_swap(a, b, false, false);
    const float lo = __uint_as_float(rr[0]), hi = __uint_as_float(rr[1]); return lo + hi;
}
__device__ __forceinline__ float quad_sum(float x) { x = DPP_ADD(x, 0xB1); x = DPP_ADD(x, 0x4E); return x; }
#endif
__device__ __forceinline__ float sigmoidf_(float x) { return 1.f / (1.f + __expf(-x)); }
__device__ __forceinline__ float softplusf_(float x) { return x > 20.f ? x : __logf(1.f + __expf(x)); }
__device__ __forceinline__ float tanhf_(float x) { const float e = __expf(2.f * x); return 1.f - 2.f / (e + 1.f); }
__device__ __forceinline__ int ltid() { int t = threadIdx.x; asm volatile("" : "+v"(t)); return t; }
template <class T> __device__ __forceinline__ T ldg(const void* base, unsigned byteoff) { return *(const T*)((const char*)base + byteoff); }
template <class T> __device__ __forceinline__ void stg(void* base, unsigned byteoff, T v) { *(T*)((char*)base + byteoff) = v; }

#define XB_TMO      128
#define XB_XCNT(j)  (256  + 64 * (j))
#define XB_XSUB(j)  (1280 + 64 * (j))
#define XB_XGEN(j)  (2304 + 64 * (j))
#define XB_TOP      3328
#define XB_TOPGEN   3392
#define XCD_BAR_WORDS 3456
#define XB_SPIN_CAP (1u << 18)

__device__ __forceinline__ unsigned xb_ld(unsigned* p)              { return __hip_atomic_load(p, __ATOMIC_RELAXED, __HIP_MEMORY_SCOPE_AGENT); }
__device__ __forceinline__ unsigned xb_add(unsigned* p, unsigned v) { return __hip_atomic_fetch_add(p, v, __ATOMIC_RELAXED, __HIP_MEMORY_SCOPE_AGENT); }
__device__ __forceinline__ unsigned xb_xcc_id() { return (unsigned)__builtin_amdgcn_s_getreg((3 << 11) | 20) & 0xFu; }
#define XB_SPIN(cond, bar) do { unsigned _sp = 0; while (cond) { __builtin_amdgcn_s_sleep(1); \
    if ((++_sp & 255u) == 0u) { if (xb_ld(&(bar)[XB_TMO])) break; if (_sp > XB_SPIN_CAP) { atomicAdd(&(bar)[XB_TMO], 1u); break; } } } } while (0)

struct XcdBarrier {
    unsigned* bar; unsigned x;
    unsigned nparts;
    volatile LAS unsigned* st;
};

__device__ __forceinline__ XcdBarrier xcd_barrier_post(unsigned* bar, volatile LAS unsigned* st) {
    XcdBarrier b; b.bar = bar; b.x = xb_xcc_id(); b.st = st; b.nparts = 0u;
    if (threadIdx.x == 0) (void)xb_add(&bar[XB_XCNT(b.x)], 1u);
    return b;
}
__device__ __forceinline__ void xcd_barrier_complete(unsigned* bar, unsigned x, unsigned& nloc, unsigned& nx, unsigned nparts) {
    const unsigned G = nparts ? nparts : gridDim.x * gridDim.y * gridDim.z;
    unsigned sum, cnt, mine, sp = 0u;
    for (;;) {
        sum = 0u; cnt = 0u; mine = 0u;
#pragma unroll
        for (unsigned j = 0; j < 16; ++j) { const unsigned c = xb_ld(&bar[XB_XCNT(j)]); sum += c; cnt += (c > 0u) ? 1u : 0u; mine = (j == x) ? c : mine; }
        if (sum == G) break;
        __builtin_amdgcn_s_sleep(1);
        if ((++sp & 255u) == 0u) { if (xb_ld(&bar[XB_TMO])) break; if (sp > XB_SPIN_CAP) { atomicAdd(&bar[XB_TMO], 1u); break; } }
    }
    nloc = mine > 0u ? mine : 1u; nx = cnt > 0u ? cnt : 1u;
}

__device__ __forceinline__ void xcd_barrier(const XcdBarrier& b) {
    asm volatile("s_waitcnt vmcnt(0)" ::: "memory");
    __syncthreads();
    if (threadIdx.x == 0) {
        unsigned* bar = b.bar;
        __builtin_amdgcn_s_waitcnt(0);
        unsigned nloc = b.st[0], nx = b.st[1];
        if (nloc == 0u) { xcd_barrier_complete(bar, b.x, nloc, nx, b.nparts); b.st[0] = nloc; b.st[1] = nx; }
        const unsigned old = xb_add(&bar[XB_XSUB(b.x)], 1u);
        const unsigned gen = old / nloc;
        if (old + 1u == (gen + 1u) * nloc) {
            __builtin_amdgcn_fence(__ATOMIC_RELEASE, "agent");
            asm volatile("s_waitcnt vmcnt(0)" ::: "memory");
            const unsigned og = xb_add(&bar[XB_TOP], 1u);
            const unsigned tg = og / nx;
            if (og + 1u == (tg + 1u) * nx) xb_add(&bar[XB_TOPGEN], 1u);
            else XB_SPIN(xb_ld(&bar[XB_TOPGEN]) == tg, bar);
            __builtin_amdgcn_fence(__ATOMIC_ACQUIRE, "agent");
            xb_add(&bar[XB_XGEN(b.x)], 1u);
            asm volatile("s_waitcnt vmcnt(0)" ::: "memory");
        } else {
            XB_SPIN(xb_ld(&bar[XB_XGEN(b.x)]) == gen, bar);
            __builtin_amdgcn_fence(__ATOMIC_ACQUIRE, "agent");
            asm volatile("s_waitcnt vmcnt(0)" ::: "memory");
        }
    }
    __syncthreads();
}


namespace att {
constexpr int KVBLK = 64;
constexpr float THR = 8.f;
#define SBAR() __builtin_amdgcn_sched_barrier(0)
__device__ __forceinline__ int crow(int r, int hi) { return (r & 3) + 8 * (r >> 2) + 4 * hi; }
__device__ __forceinline__ unsigned cvtpk(float lo, float hi) { unsigned r; asm volatile("v_cvt_pk_bf16_f32 %0, %1, %2" : "=v"(r) : "v"(lo), "v"(hi)); return r; }
template <int DQK> __device__ __forceinline__ int kswz(int row, int cb) { return row * (DQK * 2 + 16) + cb; }

template <int DQK> __device__ __forceinline__ void partialSM(f32x16& p0, f32x16& p1, float& m_reg, float& mn, float& alpha) {
  constexpr float SCALE = DQK == 128 ? 0.088388347648318440f : 0.072168783648703220f;
  constexpr float C = SCALE * 1.4426950408889634f;
  float pmax = p0[0];
#pragma unroll
  for (int r = 1; r < 16; ++r) pmax = fmaxf(pmax, p0[r]);
#pragma unroll
  for (int r = 0; r < 16; ++r) pmax = fmaxf(pmax, p1[r]);
  { auto rr = __builtin_amdgcn_permlane32_swap(__float_as_uint(pmax), __float_as_uint(pmax), false, false);
    pmax = fmaxf(__uint_as_float(rr[0]), __uint_as_float(rr[1])); }
  if (__builtin_expect(__all(pmax - m_reg <= THR / SCALE), 1)) { mn = m_reg; alpha = 1.f; }
  else { mn = fmaxf(m_reg, pmax); alpha = __builtin_amdgcn_exp2f((m_reg - mn) * C); m_reg = mn; }
  const float mnC = -mn * C;
#pragma unroll
  for (int r = 0; r < 16; ++r) p0[r] = fmaf(p0[r], C, mnC);
#pragma unroll
  for (int r = 0; r < 16; ++r) p1[r] = fmaf(p1[r], C, mnC);
#pragma unroll
  for (int r = 0; r < 16; ++r) p0[r] = __builtin_amdgcn_exp2f(p0[r]);
}
__device__ __forceinline__ void finishSM(f32x16& p0, f32x16& p1, float alpha, float& l_reg, bf16x8& pa0, bf16x8& pa1, bf16x8& pa2, bf16x8& pa3) {
#pragma unroll
  for (int r = 0; r < 16; ++r) p1[r] = __builtin_amdgcn_exp2f(p1[r]);
  float ps = 0;
#pragma unroll
  for (int r = 0; r < 16; ++r) ps += p0[r];
#pragma unroll
  for (int r = 0; r < 16; ++r) ps += p1[r];
  { auto rr = __builtin_amdgcn_permlane32_swap(__float_as_uint(ps), __float_as_uint(ps), false, false);
    ps = __uint_as_float(rr[0]) + __uint_as_float(rr[1]); }
  l_reg = l_reg * alpha + ps;
#define PK4(P, BASE, OUT) do { unsigned a0 = cvtpk(P[BASE + 0], P[BASE + 1]), a1 = cvtpk(P[BASE + 2], P[BASE + 3]);   \
    unsigned b0 = cvtpk(P[BASE + 4], P[BASE + 5]), b1 = cvtpk(P[BASE + 6], P[BASE + 7]);                              \
    auto r0 = __builtin_amdgcn_permlane32_swap(a0, b0, false, false); auto r1 = __builtin_amdgcn_permlane32_swap(a1, b1, false, false); \
    v4u w = {r0[0], r1[0], r0[1], r1[1]}; OUT = __builtin_bit_cast(bf16x8, w); } while (0)
  PK4(p0, 0, pa0); PK4(p0, 8, pa1); PK4(p1, 0, pa2); PK4(p1, 8, pa3);
#undef PK4
}
template <int DQK> __device__ __forceinline__ void qkt(f32x16& p0, f32x16& p1, const LAS char* Ks, const bf16x8* qr, const LAS char* qx, int r32, int hi) {
  p0 = f32x16{}; p1 = f32x16{};
#pragma unroll
  for (int d0 = 0; d0 < DQK / 16; ++d0) { const int cb = (d0 * 16 + hi * 8) * 2;
    bf16x8 b0 = *(const LAS bf16x8*)(Ks + kswz<DQK>(r32, cb));
    bf16x8 b1 = *(const LAS bf16x8*)(Ks + kswz<DQK>(32 + r32, cb));
    bf16x8 q; if (d0 < 8) q = qr[d0]; else q = *(const LAS bf16x8*)(qx + (d0 - 8) * 32);
    p0 = __builtin_amdgcn_mfma_f32_32x32x16_bf16(b0, q, p0, 0, 0, 0);
    p1 = __builtin_amdgcn_mfma_f32_32x32x16_bf16(b1, q, p1, 0, 0, 0);
    if ((d0 & 3) == 3 && d0 + 1 < DQK / 16) SBAR(); }
}
__device__ __forceinline__ int v_st(int k, int c) { const int kk = (k & ~0xC) | ((k & 4) << 1) | ((k & 8) >> 1); return ((kk >> 3) * 4 + (c >> 5)) * 512 + ((kk & 7) * 32 + (c & 31)) * 2; }
__device__ __forceinline__ int v_rd_base(int lane) { return ((lane & 3) << 3) | (((lane >> 2) & 3) << 6) | (((lane >> 4) & 1) << 5) | (((lane >> 5) & 1) << 8); }
constexpr int v_rd_off(int d0, int ks, int half) { return d0 * 512 + ks * 4096 + half * 2048; }
template <int OFF> __device__ __forceinline__ s16x4 tr_read(int vb) {
  s16x4 r; asm volatile("ds_read_b64_tr_b16 %0, %1 offset:%2" : "=&v"(r) : "v"(vb), "i"(OFF) : "memory"); return r;
}
template <int D0> __device__ __forceinline__ void pv_one(f32x16& od, int vb, bf16x8 pa0, bf16x8 pa1, bf16x8 pa2, bf16x8 pa3) {
  const s16x4 l0 = tr_read<v_rd_off(D0, 0, 0)>(vb), h0 = tr_read<v_rd_off(D0, 0, 1)>(vb), l1 = tr_read<v_rd_off(D0, 1, 0)>(vb), h1 = tr_read<v_rd_off(D0, 1, 1)>(vb);
  const s16x4 l2 = tr_read<v_rd_off(D0, 2, 0)>(vb), h2 = tr_read<v_rd_off(D0, 2, 1)>(vb), l3 = tr_read<v_rd_off(D0, 3, 0)>(vb), h3 = tr_read<v_rd_off(D0, 3, 1)>(vb);
  asm volatile("s_waitcnt lgkmcnt(0)" ::: "memory"); SBAR();
#define PK(L, H) (bf16x8){L[0], L[1], L[2], L[3], H[0], H[1], H[2], H[3]}
  od = __builtin_amdgcn_mfma_f32_32x32x16_bf16(pa0, PK(l0, h0), od, 0, 0, 0);
  od = __builtin_amdgcn_mfma_f32_32x32x16_bf16(pa1, PK(l1, h1), od, 0, 0, 0);
  od = __builtin_amdgcn_mfma_f32_32x32x16_bf16(pa2, PK(l2, h2), od, 0, 0, 0);
  od = __builtin_amdgcn_mfma_f32_32x32x16_bf16(pa3, PK(l3, h3), od, 0, 0, 0);
#undef PK
}
__device__ __forceinline__ void pv_d0(f32x16* o, int vb, bf16x8 pa0, bf16x8 pa1, bf16x8 pa2, bf16x8 pa3) {
  pv_one<0>(o[0], vb, pa0, pa1, pa2, pa3); pv_one<1>(o[1], vb, pa0, pa1, pa2, pa3); pv_one<2>(o[2], vb, pa0, pa1, pa2, pa3); pv_one<3>(o[3], vb, pa0, pa1, pa2, pa3);
}
__device__ __forceinline__ void apply_mask(f32x16& p0, f32x16& p1, int mtype, int krel0, int qi, int hi) {
  if (mtype == 0) return;
  const float ninf = -__builtin_inff();
#pragma unroll
  for (int r = 0; r < 16; ++r) { const int k0 = krel0 + crow(r, hi), k1 = k0 + 32;
    const bool ok0 = (mtype == 1) ? (k0 >= qi - 128) : (k0 <= qi + 128), ok1 = (mtype == 1) ? (k1 >= qi - 128) : (k1 <= qi + 128);
    p0[r] = ok0 ? p0[r] : ninf; p1[r] = ok1 ? p1[r] : ninf; }
}
struct Tile { gcbf kn; gcbf kr; gcbf v; int mtype; int krel0; };

__device__ __forceinline__ void rope_pair(bf16x8& a, bf16x8& b, gcfl ct, gcfl st) {
  const f32x4 c0 = *(const GAS f32x4*)ct, c1 = *(const GAS f32x4*)(ct + 4), s0 = *(const GAS f32x4*)st, s1 = *(const GAS f32x4*)(st + 4);
  const float cs[8] = {c0[0], c0[1], c0[2], c0[3], c1[0], c1[1], c1[2], c1[3]}, sn[8] = {s0[0], s0[1], s0[2], s0[3], s1[0], s1[1], s1[2], s1[3]};
  v4u ua = __builtin_bit_cast(v4u, a), ub = __builtin_bit_cast(v4u, b); v4u oa, ob;
#pragma unroll
  for (int w = 0; w < 4; ++w) { const float x1[2] = {bflo(ua[w]), bfhi(ua[w])}, x2[2] = {bflo(ub[w]), bfhi(ub[w])}; float y1[2], y2[2];
#pragma unroll
    for (int e = 0; e < 2; ++e) { const float c = cs[2 * w + e], sv = sn[2 * w + e]; y1[e] = x1[e] * c - x2[e] * sv; y2[e] = x2[e] * c + x1[e] * sv; }
    oa[w] = pk2(y1[0], y1[1]); ob[w] = pk2(y2[0], y2[1]); }
  a = __builtin_bit_cast(bf16x8, oa); b = __builtin_bit_cast(bf16x8, ob);
}

template <int DQK, int LDKN, int LDV, bool MASK, bool SINK, int SDEPTH, class TS>
__device__ __forceinline__ void attn_body(gcbf Qw, int rope, int prow, int pcol, gcfl rtab, int qi, float sink_l2, const TS& ts, int NT, gbfp Ow, LAS char* lds) {
  constexpr float SCALE = DQK == 128 ? 0.088388347648318440f : 0.072168783648703220f;
  constexpr float C = SCALE * 1.4426950408889634f;
  constexpr int SHM_K = KVBLK * (DQK * 2 + 16), SHM_V = KVBLK * 128 * 2;
  int tid = threadIdx.x; asm volatile("" : "+v"(tid));
  const int wid = tid >> 6, lane = tid & 63, r32 = lane & 31, hi = lane >> 5;
  LAS char* V_lds = lds; LAS char* K_lds = lds + 2 * SHM_V;
  LAS float* wsl = (LAS float*)(lds + 2 * SHM_V + 2 * SHM_K) + wid * 64; LAS float* li_l = wsl; LAS float* al_l = wsl + 32;
  float m_reg = -1e30f, l_reg = 0; f32x16 o[4] = {}; bf16x8 qr[8];
#pragma unroll
  for (int d0 = 0; d0 < 8; ++d0) qr[d0] = *(const GAS bf16x8*)(Qw + d0 * 16 + hi * 8);
  const LAS char* qx = lds + 2 * SHM_V + 2 * SHM_K + 2048 + wid * 4608 + r32 * 144 + hi * 16;
  if constexpr (DQK == 192) {
    bf16x8 x0 = *(const GAS bf16x8*)(Qw + 128 + hi * 8), x1 = *(const GAS bf16x8*)(Qw + 144 + hi * 8), x2 = *(const GAS bf16x8*)(Qw + 160 + hi * 8), x3 = *(const GAS bf16x8*)(Qw + 176 + hi * 8);
    if (rope) {
      rope_pair(x0, x1, rtab + (size_t)prow * 16 + hi * 8, rtab + 2048 + (size_t)prow * 16 + hi * 8);
      rope_pair(x2, x3, rtab + (size_t)pcol * 16 + hi * 8, rtab + 2048 + (size_t)pcol * 16 + hi * 8); }
    LAS char* qw_ = (LAS char*)qx; *(LAS bf16x8*)(qw_) = x0; *(LAS bf16x8*)(qw_ + 32) = x1; *(LAS bf16x8*)(qw_ + 64) = x2; *(LAS bf16x8*)(qw_ + 96) = x3;
  }
  const int sr = tid >> 4, sc = (tid & 15) * 8, vst0 = v_st(sr, sc), vst1 = v_st(32 + sr, sc);
  const int rr_ = tid >> 3, rc_ = (tid & 7) * 8;
  const int vb0 = (int)(uintptr_t)V_lds + v_rd_base(lane);
  struct { bf16x8 vs0, vs1, ks0, ks1, kx; } sr_[SDEPTH];
#define SLOAD(i, jt) do { const Tile t_ = ts(jt); sr_[i].vs0 = *(const GAS bf16x8*)(t_.v + (size_t)sr * LDV + sc); sr_[i].vs1 = *(const GAS bf16x8*)(t_.v + (size_t)(32 + sr) * LDV + sc); \
    sr_[i].ks0 = *(const GAS bf16x8*)(t_.kn + (size_t)sr * LDKN + sc); sr_[i].ks1 = *(const GAS bf16x8*)(t_.kn + (size_t)(32 + sr) * LDKN + sc); \
    if constexpr (DQK == 192) sr_[i].kx = *(const GAS bf16x8*)(t_.kr + (size_t)rr_ * 64 + rc_); } while (0)
#define SWRITE(b, i) do { *(LAS bf16x8*)(V_lds + (b) * SHM_V + vst0) = sr_[i].vs0; *(LAS bf16x8*)(V_lds + (b) * SHM_V + vst1) = sr_[i].vs1; const int kc = sc * 2; \
    *(LAS bf16x8*)(K_lds + (b) * SHM_K + kswz<DQK>(sr, kc)) = sr_[i].ks0; *(LAS bf16x8*)(K_lds + (b) * SHM_K + kswz<DQK>(32 + sr, kc)) = sr_[i].ks1; \
    if constexpr (DQK == 192) *(LAS bf16x8*)(K_lds + (b) * SHM_K + kswz<DQK>(rr_, 256 + rc_ * 2)) = sr_[i].kx; } while (0)
#define SWAIT() do { if constexpr (SDEPTH == 2) { if constexpr (DQK == 192) asm volatile("s_waitcnt vmcnt(5)" ::: "memory"); else asm volatile("s_waitcnt vmcnt(4)" ::: "memory"); } \
    else asm volatile("s_waitcnt vmcnt(0)" ::: "memory"); } while (0)
#define RESC(a) do { if (__any((a) < 1.f)) { if (hi == 0) al_l[r32] = (a); asm volatile("s_waitcnt lgkmcnt(0)" ::: "memory"); \
    _Pragma("unroll") for (int d = 0; d < 4; ++d) _Pragma("unroll") for (int r = 0; r < 16; ++r) o[d][r] *= al_l[crow(r, hi)]; } } while (0)
#define MASKT(pa_, pb_, jt) do { if constexpr (MASK) { const Tile t_ = ts(jt); apply_mask(pa_, pb_, t_.mtype, t_.krel0, qi, hi); } } while (0)
  f32x16 pA0, pA1, pB0, pB1; float mnA, mnB, alA, alB; bf16x8 pa0, pa1, pa2, pa3;
  constexpr int SE = 0, SO = SDEPTH - 1;
  SLOAD(SE, 0); asm volatile("s_waitcnt vmcnt(0)" ::: "memory"); SWRITE(0, SE); __syncthreads();
  qkt<DQK>(pA0, pA1, K_lds, qr, qx, r32, hi); MASKT(pA0, pA1, 0); partialSM<DQK>(pA0, pA1, m_reg, mnA, alA);
  SLOAD(SO, 1); if constexpr (SDEPTH == 2) { if (2 < NT) SLOAD(SE, 2); }
  SWAIT(); SWRITE(1, SO); __syncthreads();
  for (int j = 1; j + 1 < NT; j += 2) {
    SBAR(); qkt<DQK>(pB0, pB1, K_lds + SHM_K, qr, qx, r32, hi); MASKT(pB0, pB1, j);
    finishSM(pA0, pA1, alA, l_reg, pa0, pa1, pa2, pa3); SBAR();
    SLOAD(SO, j + SDEPTH); SBAR();
    pv_d0(o, vb0, pa0, pa1, pa2, pa3); partialSM<DQK>(pB0, pB1, m_reg, mnB, alB);
    __syncthreads(); SWAIT(); SWRITE(0, SE);
    RESC(alB); __syncthreads();
    SBAR(); qkt<DQK>(pA0, pA1, K_lds, qr, qx, r32, hi); MASKT(pA0, pA1, j + 1);
    finishSM(pB0, pB1, alB, l_reg, pa0, pa1, pa2, pa3); SBAR();
    if (SDEPTH == 1 || j + 3 < NT) SLOAD(SE, j + 1 + SDEPTH); SBAR();
    pv_d0(o, vb0 + SHM_V, pa0, pa1, pa2, pa3); partialSM<DQK>(pA0, pA1, m_reg, mnA, alA);
    __syncthreads(); SWAIT(); SWRITE(1, SO);
    RESC(alA); __syncthreads();
  }
  SBAR(); qkt<DQK>(pB0, pB1, K_lds + SHM_K, qr, qx, r32, hi); MASKT(pB0, pB1, NT - 1);
  finishSM(pA0, pA1, alA, l_reg, pa0, pa1, pa2, pa3); SBAR();
  pv_d0(o, vb0, pa0, pa1, pa2, pa3); partialSM<DQK>(pB0, pB1, m_reg, mnB, alB);
  __syncthreads(); RESC(alB);
  finishSM(pB0, pB1, alB, l_reg, pa0, pa1, pa2, pa3); SBAR();
  pv_d0(o, vb0 + SHM_V, pa0, pa1, pa2, pa3);
  if constexpr (SINK) l_reg += __builtin_amdgcn_exp2f(sink_l2 - m_reg * C);
  if (hi == 0) li_l[r32] = l_reg; asm volatile("s_waitcnt lgkmcnt(0)" ::: "memory");
  float rli[16];
#pragma unroll
  for (int r = 0; r < 16; ++r) rli[r] = __builtin_amdgcn_rcpf(li_l[crow(r, hi)]);
  __syncthreads();
  LAS bf16* ost = (LAS bf16*)(lds + wid * 8704);
#pragma unroll
  for (int r = 0; r < 16; ++r) { const int orow = crow(r, hi);
#pragma unroll
    for (int d0 = 0; d0 < 4; ++d0) ost[orow * 136 + d0 * 32 + r32] = (bf16)f2bf(o[d0][r] * rli[r]); }
  asm volatile("s_waitcnt lgkmcnt(0)" ::: "memory");
#pragma unroll
  for (int i = 0; i < 8; ++i) { const int orow = i * 4 + (lane >> 4), ch = lane & 15;
    *(GAS v4u*)(Ow + (size_t)orow * 4096 + ch * 8) = *(const LAS v4u*)(ost + orow * 136 + ch * 8); }
  __syncthreads();
#undef SLOAD
#undef SWRITE
#undef SWAIT
#undef RESC
#undef MASKT
}
}

struct Args { const float* in[38]; float* out; unsigned char* ws; };
template <class T> __device__ __forceinline__ T launder(T p) { asm volatile("" : "+s"(p)); return p; }
template <class T> __device__ __forceinline__ T* launder_g(T* p) { asm volatile("" : "+s"(p)); return p; }
struct Frame {
    LAS unsigned char* lds;
    gu32* ctl;
    int tid, lane, wave;
    int vcu, G, gw, NGW;
    const __attribute__((address_space(4))) Args* A;
    float* out;
    unsigned char* ws;
    unsigned char* wsw;
};
enum { I_X = 0, I_C, I_CTX, I_CCTX, I_WMOD, I_BMOD, I_WIN, I_WOUT, I_LN1G, I_LN1B, I_WFF1, I_WFF2, I_LN2G, I_LN2B, I_SINK, I_CONVW, I_CONVB, I_LWA, I_LBA, I_LWI, I_LBI, I_LAM,
       I_QNORM, I_KVNORM, I_WQB, I_WKVB, I_MUP, I_MUN, I_W0, I_W2, I_A0, I_A2, I_G2, I_KK, I_KA, I_RK, I_LNG, I_LNB };
__device__ __forceinline__ int row_s(int row) { return row < SEQ ? 0 : (row < M_LAT ? 1 : 2); }
__device__ __forceinline__ const float* mod_ptr(const Frame& F, int l, int s, int chunk) { return (const float*)(F.ws + WS_MOD) + ((size_t)(l * 3 + s) * 6 + chunk) * DM; }

__device__ __forceinline__ void transpose_item(const float* W, int N, int Kvalid, bf16* WT, int ldt, const float* kscale, LAS float* scr, int k0, int n0, int lane) {
    { const int kr = lane >> 3, c4 = (lane & 7) * 4;
#pragma unroll
      for (int i = 0; i < 8; ++i) { const int kk = 8 * i + kr, k = k0 + kk; f32x4 v = {0.f, 0.f, 0.f, 0.f};
          if (k < Kvalid) { v = *(const f32x4*)(W + (size_t)k * N + n0 + c4); if (kscale) v = v * kscale[k]; }
          scr[kk * 33 + c4] = v.x; scr[kk * 33 + c4 + 1] = v.y; scr[kk * 33 + c4 + 2] = v.z; scr[kk * 33 + c4 + 3] = v.w; } }
    LDS_WAIT(); asm volatile("" ::: "memory");
    const int c = lane & 7;
#pragma unroll
    for (int j = 0; j < 4; ++j) { const int n = (lane >> 3) + 8 * j; const LAS float* s = scr + (8 * c) * 33 + n;
        v4u o; o.x = pk2(s[0 * 33], s[1 * 33]); o.y = pk2(s[2 * 33], s[3 * 33]); o.z = pk2(s[4 * 33], s[5 * 33]); o.w = pk2(s[6 * 33], s[7 * 33]);
        *(v4u*)(WT + (size_t)(n0 + n) * ldt + k0 + 8 * c) = o; }
    LDS_WAIT(); asm volatile("" ::: "memory");
}
__device__ __forceinline__ void convert_weights(Frame& F, int l, int widx, int nw) {
    LAS float* scr = (LAS float*)(F.lds + F.wave * 16384);
    constexpr int I1 = 64 * 271, I2 = 64 * 128, I3 = 64 * 512, I4 = 256 * 128, I5 = 16 * 48, I6 = 8 * 64, I7 = 32 * 8, I8 = 2 * 32, I9 = 2 * 32, I10 = 3 * 32;
    constexpr int NIT = I1 + I2 + I3 + I4 + I5 + I6 + I7 + I8 + I9 + I10;
    unsigned char* ws = F.ws + (l ? WSET_STRIDE : 0);
    for (int it = widx; it < NIT; it += nw) {
        int r = it;
        if (r < I1) { transpose_item(F.A->in[I_WIN] + (size_t)l * DM * DIN, DIN, DM, (bf16*)(ws + WS_WIN), DM, nullptr, scr, 64 * (r / 271), 32 * (r % 271), F.lane); continue; } r -= I1;
        if (r < I2) { transpose_item(F.A->in[I_WOUT] + (size_t)l * DM * DM, DM, DM, (bf16*)(ws + WS_WOUT), DM, nullptr, scr, 64 * (r / 128), 32 * (r % 128), F.lane); continue; } r -= I2;
        if (r < I3) { transpose_item(F.A->in[I_WFF1] + (size_t)l * DM * DFF, DFF, DM, (bf16*)(ws + WS_WFF1), DM, nullptr, scr, 64 * (r / 512), 32 * (r % 512), F.lane); continue; } r -= I3;
        if (r < I4) { transpose_item(F.A->in[I_WFF2] + (size_t)l * DFF * DM, DM, DFF, (bf16*)(ws + WS_WFF2), DFF, nullptr, scr, 64 * (r / 128), 32 * (r % 128), F.lane); continue; } r -= I4;
        if (r < I5) { transpose_item(F.A->in[I_WQB] + (size_t)l * 1024 * 1536, 1536, 1024, (bf16*)(ws + WS_WQB), 1024, F.A->in[I_QNORM] + l * 1024, scr, 64 * (r / 48), 32 * (r % 48), F.lane); continue; } r -= I5;
        if (r < I6) { transpose_item(F.A->in[I_WKVB] + (size_t)l * 512 * 2048, 2048, 512, (bf16*)(ws + WS_WKVB), 512, F.A->in[I_KVNORM] + l * 512, scr, 64 * (r / 64), 32 * (r % 64), F.lane); continue; } r -= I6;
        if (r < I7) { const int mat = r >> 3, sub = r & 7, gate = mat & 1, dn = mat >> 1;
            const int d = dn >> 3, n = dn & 7;
            const float* src = (gate ? F.A->in[I_LWI] : F.A->in[I_LWA]) + ((size_t)(l * 2 + d) * 8 + n) * 128 * 128;
            bf16* dst = (bf16*)(ws + WS_WLRU) + ((size_t)(d * 2 + gate) * 8 + n) * 128 * 128;
            transpose_item(src, 128, 128, dst, 128, nullptr, scr, 64 * (sub >> 2), 32 * (sub & 3), F.lane); continue; } r -= I7;
        if (r < I8) { const int d = r >> 5; transpose_item(F.A->in[I_W2] + (size_t)(l * 2 + d) * 64 * 1024, 1024, 64, (bf16*)(ws + WS_W2T) + (size_t)d * 1024 * 64, 64, nullptr, scr, 0, 32 * (r & 31), F.lane); continue; } r -= I8;
        if (r < I9) { const int d = r >> 5; transpose_item(F.A->in[I_A2] + (size_t)(l * 2 + d) * 64 * 1024, 1024, 64, (bf16*)(ws + WS_A2T) + (size_t)d * 1024 * 64, 64, nullptr, scr, 0, 32 * (r & 31), F.lane); continue; } r -= I9;
        transpose_item(F.A->in[I_G2] + (size_t)l * 160 * 1024, 1024, 160, (bf16*)(ws + WS_G2T), 192, nullptr, scr, 64 * (r / 32), 32 * (r % 32), F.lane);
    }
    { unsigned zz = 0u; asm volatile("" : "+v"(zz)); v4u z = {zz, zz, zz, zz}; v4u* p = (v4u*)((bf16*)(ws + WS_WIN) + (size_t)DIN * DM);
      for (int i = widx * 64 + F.lane; i < 32 * DM / 8; i += nw * 64) p[i] = z; }
}

__device__ __forceinline__ void mod_partials(Frame& F) {
    LAS float* sl = (LAS float*)F.lds;
    for (int it = F.vcu; it < 2 * 32 * 12; it += F.G) {
        const int l = it / 384, ks = (it / 12) % 32, cc = it % 12;
        __syncthreads();
        if (F.tid < 384) { const int s = F.tid >> 7, k = ks * 128 + (F.tid & 127); const float c = s < 2 ? F.A->in[I_C][s * DM + k] : F.A->in[I_CCTX][k]; sl[F.tid] = c / (1.f + __expf(-c)); }
        __syncthreads();
        const float* wp = F.A->in[I_WMOD] + ((size_t)l * DM + ks * 128) * 24576 + cc * 2048 + F.tid * 4;
        f32x4 a0 = {0.f, 0.f, 0.f, 0.f}, a1 = a0, a2 = a0;
#pragma unroll 8
        for (int k = 0; k < 128; ++k) { const f32x4 w = *(const f32x4*)(wp + (size_t)k * 24576); a0 += w * sl[k]; a1 += w * sl[128 + k]; a2 += w * sl[256 + k]; }
        float* op = (float*)(F.ws + WS_MODP) + ((size_t)(l * 32 + ks) * 3) * 24576 + cc * 2048 + F.tid * 4;
        *(f32x4*)(op) = a0; *(f32x4*)(op + 24576) = a1; *(f32x4*)(op + 2 * 24576) = a2;
    }
    __syncthreads();
}
__device__ __forceinline__ void mod_reduce(Frame& F) {
    for (int i = F.vcu * NTHR + F.tid; i < 2 * 3 * 24576; i += F.G * NTHR) {
        const int l = i / (3 * 24576), s = (i / 24576) % 3, n = i % 24576;
        float a = F.A->in[I_BMOD][l * 24576 + n];
        const float* pp = (const float*)(F.ws + WS_MODP) + ((size_t)(l * 32) * 3 + s) * 24576 + n;
#pragma unroll 8
        for (int ks = 0; ks < 32; ++ks) a += pp[(size_t)ks * 3 * 24576];
        ((float*)(F.ws + WS_MOD))[i] = a;
    }
}

__device__ __forceinline__ void sum_partials_row(const Frame& F, const float* yp, size_t stride, bf16* ydst) {
    int lane = F.lane; asm volatile("" : "+v"(lane));
#pragma unroll 2
    for (int j = 0; j < 16; ++j) { const int c = 4 * lane + 256 * j; f32x4 y = *(const f32x4*)(yp + c);
#pragma unroll
        for (int sp = 1; sp < 8; ++sp) y += *(const f32x4*)(yp + sp * stride + c);
        v2u w; w.x = pk2(y.x, y.y); w.y = pk2(y.z, y.w); *(v2u*)(ydst + c) = w; }
}
template <int MODE>
__device__ __forceinline__ void ln_row(const Frame& F, const float* xsrc, const bf16* Y, const float* ga, const float* lg, const float* lb, float* xdst,
                                       bool domod, const float* sc, const float* sh, bf16* hrow) {
    f32x4 v[16]; float s = 0.f;
#pragma unroll
    for (int j = 0; j < 16; ++j) { const int c = 4 * F.lane + 256 * j; v[j] = *(const f32x4*)(xsrc + c);
        if (MODE == 1) { const v2u yw = *(const v2u*)(Y + c); const f32x4 y = {bflo(yw.x), bfhi(yw.x), bflo(yw.y), bfhi(yw.y)}, g = *(const f32x4*)(ga + c); v[j] = v[j] * ALPHA + g * y; }
        s += (v[j].x + v[j].y) + (v[j].z + v[j].w);
        if ((j & 7) == 7) asm volatile("" ::: "memory"); }
    float mean = wave_sum(s) * (1.f / DM), s2 = 0.f;
#pragma unroll
    for (int j = 0; j < 16; ++j) { v[j] = v[j] - mean; s2 += (v[j].x * v[j].x + v[j].y * v[j].y) + (v[j].z * v[j].z + v[j].w * v[j].w); }
    float rstd = 1.f / sqrtf(wave_sum(s2) * (1.f / DM) + LN_EPS);
    if (MODE == 1) {
        s = 0.f;
#pragma unroll
        for (int j = 0; j < 16; ++j) { const int c = 4 * F.lane + 256 * j; const f32x4 g = *(const f32x4*)(lg + c), b = *(const f32x4*)(lb + c); v[j] = v[j] * rstd * g + b;
            *(f32x4*)(xdst + c) = v[j]; s += (v[j].x + v[j].y) + (v[j].z + v[j].w);
            if ((j & 7) == 7) asm volatile("" ::: "memory"); }
        if (!domod) return;
        mean = wave_sum(s) * (1.f / DM); s2 = 0.f;
#pragma unroll
        for (int j = 0; j < 16; ++j) { v[j] = v[j] - mean; s2 += (v[j].x * v[j].x + v[j].y * v[j].y) + (v[j].z * v[j].z + v[j].w * v[j].w); }
        rstd = 1.f / sqrtf(wave_sum(s2) * (1.f / DM) + LN_EPS);
    }
#pragma unroll
    for (int j = 0; j < 16; ++j) { const int c = 4 * F.lane + 256 * j; const f32x4 a = *(const f32x4*)(sc + c), b = *(const f32x4*)(sh + c);
        const f32x4 o = v[j] * rstd * (a + 1.f) + b; v2u w; w.x = pk2(o.x, o.y); w.y = pk2(o.z, o.w); *(v2u*)(hrow + c) = w; }
}

__device__ __forceinline__ void shift4(const bf16* P, unsigned eo, bool hp, bool hn, const float* mup, const float* mun, unsigned mo, float (&u)[4]) {
    const v2u xc = ldg<v2u>(P, eo * 2u); v2u xp = {0u, 0u}, xn = {0u, 0u};
    if (hp) xp = ldg<v2u>(P, (eo - DINP) * 2u); if (hn) xn = ldg<v2u>(P, (eo + DINP) * 2u);
    const f32x4 mp = ldg<f32x4>(mup, mo * 4u), mn = ldg<f32x4>(mun, mo * 4u);
    const float c[4] = {bflo(xc.x), bfhi(xc.x), bflo(xc.y), bfhi(xc.y)}, p[4] = {bflo(xp.x), bfhi(xp.x), bflo(xp.y), bfhi(xp.y)}, n[4] = {bflo(xn.x), bfhi(xn.x), bflo(xn.y), bfhi(xn.y)};
#pragma unroll
    for (int e = 0; e < 4; ++e) u[e] = c[e] + mp[e] * (p[e] - c[e]) + mn[e] * (n[e] - c[e]);
}
__device__ __forceinline__ void st4bf(void* base, unsigned eo, float a, float b, float c, float d) { v2u w; w.x = pk2(a, b); w.y = pk2(c, d); stg<v2u>(base, eo * 2u, w); }

__device__ __forceinline__ void rwkv_feat_item(Frame& F, int l, int item) {
    F.tid = ltid(); F.lane = F.tid & 63;
    int row0, seq_lo, seq_hi;
    if (item < 16) { const int b = item >> 3; seq_lo = M_LAT + b * NCTX; seq_hi = seq_lo + NCTX; row0 = seq_lo + (item & 7) * 32; }
    else { const int it = item - 16, b = it >> 8; seq_lo = b * SEQ; seq_hi = seq_lo + SEQ; row0 = seq_lo + (it & 255) * 32; }
    const bf16* P = (const bf16*)(F.ws + WS_P);
    LAS bf16* ACT = (LAS bf16*)F.lds;
    const float* mup = F.A->in[I_MUP] + l * RWC; const float* mun = F.A->in[I_MUN] + l * RWC;
    __syncthreads();
    { const int tok = F.tid >> 4, jc = F.tid & 15, row = row0 + tok; const bool hp = row > seq_lo, hn = row + 1 < seq_hi;
      const bf16* pr = P + (size_t)row * DINP + C_RWL;
#pragma unroll
      for (int i = 0; i < 13; ++i) { const int j = jc * 2 + 32 * i;
          const unsigned xc = *(const unsigned*)(pr + j), xp = hp ? *(const unsigned*)(pr - DINP + j) : 0u, xn = hn ? *(const unsigned*)(pr + DINP + j) : 0u;
          float u[2];
#pragma unroll
          for (int e = 0; e < 2; ++e) { const float c = e ? bfhi(xc) : bflo(xc), p = e ? bfhi(xp) : bflo(xp), n = e ? bfhi(xn) : bflo(xn);
              float v = c + mup[3072 + j + e] * (p - c) + mun[3072 + j + e] * (n - c);
              if (j < 128) v = tanhf_(v); else if (j >= 256) v = sigmoidf_(v);
              u[e] = v; }
          *(LAS unsigned*)(ACT + tok * 424 + j) = pk2(u[0], u[1]); } }
    __syncthreads();
    const int tok = F.lane & 31, hi = F.lane >> 5, row = row0 + tok;
    const bf16* W2T = (const bf16*)(F.wsw + WS_W2T); const bf16* A2T = (const bf16*)(F.wsw + WS_A2T); const bf16* G2T = (const bf16*)(F.wsw + WS_G2T);
    bf16* RWF = (bf16*)(F.ws + WS_RWF); const size_t RS = (size_t)M_TOT * 1024;
    const float* kkv = F.A->in[I_KK] + l * 1024; const float* kav = F.A->in[I_KA] + l * 1024; const float* rkv = F.A->in[I_RK] + l * 1024;
    const float* w0f = F.A->in[I_W0] + (size_t)(l * 2) * 1024; const float* a0f = F.A->in[I_A0] + (size_t)(l * 2) * 1024;
    const LAS bf16* actl = ACT + tok * 424 + hi * 8;
    LAS unsigned char* TI = F.lds + 27136 + F.wave * 10752; LAS unsigned char* TO = TI + 3 * 2720;
#define RF_LOADTILE(ti, colbase) do { _Pragma("unroll") for (int i_ = 0; i_ < 3; ++i_) { const int p_ = F.lane + 64 * i_; if (p_ < 136) { const int rr_ = p_ >> 2, cp_ = p_ & 3, gr_ = row0 - 1 + rr_; \
        v4u v_ = {0u, 0u, 0u, 0u}; if (gr_ >= seq_lo && gr_ < seq_hi) v_ = ldg<v4u>(P, ((unsigned)gr_ * DINP + (colbase) + 8 * cp_) * 2u); *(LAS v4u*)(TI + (ti) * 2720 + rr_ * 80 + cp_ * 16) = v_; } } } while (0)
#define RF_SHIFT4(ti, g_, mo_, u_) do { const LAS unsigned char* q_ = TI + (ti) * 2720 + (tok + 1) * 80 + (8 * (g_) + 4 * hi) * 2; const v2u xc_ = *(const LAS v2u*)q_, xp_ = *(const LAS v2u*)(q_ - 80), xn_ = *(const LAS v2u*)(q_ + 80); \
        const f32x4 mp_ = ldg<f32x4>(mup, (mo_) * 4u), mn_ = ldg<f32x4>(mun, (mo_) * 4u); \
        const float c_[4] = {bflo(xc_.x), bfhi(xc_.x), bflo(xc_.y), bfhi(xc_.y)}, pp_[4] = {bflo(xp_.x), bfhi(xp_.x), bflo(xp_.y), bfhi(xp_.y)}, nn_[4] = {bflo(xn_.x), bfhi(xn_.x), bflo(xn_.y), bfhi(xn_.y)}; \
        _Pragma("unroll") for (int e_ = 0; e_ < 4; ++e_) u_[e_] = c_[e_] + mp_[e_] * (pp_[e_] - c_[e_]) + mn_[e_] * (nn_[e_] - c_[e_]); } while (0)
#define RF_FLUSH(arr_, cblk_, o_) do { _Pragma("unroll") for (int g_ = 0; g_ < 4; ++g_) *(LAS v2u*)(TO + tok * 80 + (8 * g_ + 4 * hi) * 2) = o_[g_]; \
        asm volatile("s_waitcnt lgkmcnt(0)" ::: "memory"); \
        _Pragma("unroll") for (int i_ = 0; i_ < 2; ++i_) { const int p_ = F.lane + 64 * i_, rr_ = p_ >> 2, cp_ = p_ & 3; const v4u v_ = *(const LAS v4u*)(TO + rr_ * 80 + cp_ * 16); \
            stg<v4u>(RWF + (arr_) * RS, ((unsigned)(row0 + rr_) * 1024u + (cblk_) + 8 * cp_) * 2u, v_); } \
        asm volatile("s_waitcnt lgkmcnt(0)" ::: "memory"); } while (0)
#pragma unroll 1
    for (int hh = 0; hh < 2; ++hh) {
        const int h = 2 * F.wave + hh, cbase = h * 64;
        float ssq = 0.f;
        RF_LOADTILE(0, C_RWK + cbase); RF_LOADTILE(1, C_RWK + cbase + 32);
        asm volatile("s_waitcnt lgkmcnt(0)" ::: "memory");
#pragma unroll
        for (int bg = 0; bg < 8; ++bg) { const unsigned c4 = cbase + (bg >> 2) * 32 + 8 * (bg & 3) + 4 * hi; float uk[4];
            RF_SHIFT4(bg >> 2, bg & 3, 1024 + c4, uk); const f32x4 k4 = ldg<f32x4>(kkv, c4 * 4u);
#pragma unroll
            for (int e = 0; e < 4; ++e) { const float q = uk[e] * k4[e]; ssq += q * q; } }
        ssq = half_swap_sum(ssq);
        const float rn = 1.f / fmaxf(sqrtf(ssq), 1e-12f);
        float sb = 0.f;
#pragma unroll 1
        for (int blk = 0; blk < 2; ++blk) {
            const unsigned cblk = cbase + blk * 32, cha = cblk + tok;
            RF_LOADTILE(0, C_RWR + cblk); RF_LOADTILE(1, C_RWK + cblk); RF_LOADTILE(2, C_RWV + cblk);
#pragma unroll 1
            for (int d = 0; d < 2; ++d) { f32x16 aw = {};
#pragma unroll
                for (int ks = 0; ks < 4; ++ks) { const bf16x8 bw = *(const LAS bf16x8*)(actl + d * 64 + ks * 16); const bf16x8 w_ = ldg<bf16x8>(W2T, ((d * 1024 + cha) * 64 + ks * 16 + hi * 8) * 2u);
                    aw = __builtin_amdgcn_mfma_f32_32x32x16_bf16(w_, bw, aw, 0, 0, 0); }
                v2u o[4];
#pragma unroll
                for (int g = 0; g < 4; ++g) { const f32x4 w0 = ldg<f32x4>(w0f, (d * 1024 + cblk + 8 * g + 4 * hi) * 4u); float e4[4];
#pragma unroll
                    for (int e = 0; e < 4; ++e) e4[e] = __expf(-softplusf_(-(w0[e] + aw[4 * g + e])) - 0.5f);
                    o[g].x = pk2(e4[0], e4[1]); o[g].y = pk2(e4[2], e4[3]); }
                RF_FLUSH(4 + d, cblk, o); }
            { f32x16 ag = {};
#pragma unroll
              for (int ks = 0; ks < 10; ++ks) { const bf16x8 bg_ = *(const LAS bf16x8*)(actl + 256 + ks * 16); const bf16x8 g_ = ldg<bf16x8>(G2T, (cha * 192 + ks * 16 + hi * 8) * 2u);
                  ag = __builtin_amdgcn_mfma_f32_32x32x16_bf16(g_, bg_, ag, 0, 0, 0); }
              v2u o[4];
#pragma unroll
              for (int g = 0; g < 4; ++g) { o[g].x = pk2(ag[4 * g], ag[4 * g + 1]); o[g].y = pk2(ag[4 * g + 2], ag[4 * g + 3]); }
              RF_FLUSH(8, cblk, o); }
            { f32x16 aaf = {}, aab = {};
#pragma unroll
              for (int ks = 0; ks < 4; ++ks) { const bf16x8 baf = *(const LAS bf16x8*)(actl + 128 + ks * 16), bab = *(const LAS bf16x8*)(actl + 192 + ks * 16);
                  const bf16x8 a_f = ldg<bf16x8>(A2T, (cha * 64 + ks * 16 + hi * 8) * 2u), a_b = ldg<bf16x8>(A2T, ((1024 + cha) * 64 + ks * 16 + hi * 8) * 2u);
                  aaf = __builtin_amdgcn_mfma_f32_32x32x16_bf16(a_f, baf, aaf, 0, 0, 0); aab = __builtin_amdgcn_mfma_f32_32x32x16_bf16(a_b, bab, aab, 0, 0, 0); }
              v2u oR[4], oK[4], oV[4], oKK[4], oAF[4], oAB[4];
#pragma unroll
              for (int g = 0; g < 4; ++g) { const unsigned c4 = cblk + 8 * g + 4 * hi; float ur[4], uk[4], uv[4];
                  RF_SHIFT4(0, g, c4, ur); RF_SHIFT4(1, g, 1024 + c4, uk); RF_SHIFT4(2, g, 2048 + c4, uv);
                  const f32x4 a0a = ldg<f32x4>(a0f, c4 * 4u), a0b = ldg<f32x4>(a0f, (1024 + c4) * 4u), kk4 = ldg<f32x4>(kkv, c4 * 4u), ka4 = ldg<f32x4>(kav, c4 * 4u), rk4 = ldg<f32x4>(rkv, c4 * 4u);
                  float af[4], ab[4], kk[4];
#pragma unroll
                  for (int e = 0; e < 4; ++e) { const int r = 4 * g + e;
                      af[e] = sigmoidf_(a0a[e] + aaf[r]); ab[e] = sigmoidf_(a0b[e] + aab[r]); kk[e] = uk[e] * kk4[e] * rn;
                      const float kdf = uk[e] * (1.f + (af[e] - 1.f) * ka4[e]), kdb = uk[e] * (1.f + (ab[e] - 1.f) * ka4[e]);
                      sb += ur[e] * rk4[e] * (kdf + kdb); }
                  oR[g].x = pk2(ur[0], ur[1]); oR[g].y = pk2(ur[2], ur[3]); oK[g].x = pk2(uk[0], uk[1]); oK[g].y = pk2(uk[2], uk[3]); oV[g].x = pk2(uv[0], uv[1]); oV[g].y = pk2(uv[2], uv[3]);
                  oKK[g].x = pk2(kk[0], kk[1]); oKK[g].y = pk2(kk[2], kk[3]); oAF[g].x = pk2(af[0], af[1]); oAF[g].y = pk2(af[2], af[3]); oAB[g].x = pk2(ab[0], ab[1]); oAB[g].y = pk2(ab[2], ab[3]); }
              RF_FLUSH(0, cblk, oR); RF_FLUSH(1, cblk, oK); RF_FLUSH(2, cblk, oV); RF_FLUSH(3, cblk, oKK); RF_FLUSH(6, cblk, oAF); RF_FLUSH(7, cblk, oAB); }
        }
        sb = half_swap_sum(sb);
        if (hi == 0) ((float*)(F.ws + WS_SB))[(size_t)row * 16 + h] = sb;
    }
#undef RF_LOADTILE
#undef RF_SHIFT4
#undef RF_FLUSH
}

__device__ __forceinline__ float gelu_tanh(float x) { return 0.5f * x * (1.f + tanhf_(0.7978845608028654f * (x + 0.044715f * x * x * x))); }
template <bool PASS3>
__device__ __forceinline__ void lru_item(Frame& F, int l, int item) {
    F.tid = ltid(); F.lane = F.tid & 63;
    const int sc = item >> 3, nb = item & 7, b = sc / NCH, ch = sc % NCH;
    int row0, seq_lo, seq_hi;
    if (ch < 8) { seq_lo = M_LAT + b * NCTX; seq_hi = seq_lo + NCTX; row0 = seq_lo + ch * 32; }
    else { seq_lo = b * SEQ; seq_hi = seq_lo + SEQ; row0 = seq_lo + (ch - 8) * 32; }
    const bf16* P = (const bf16*)(F.ws + WS_P);
    LAS float* U = (LAS float*)F.lds;
    LAS bf16* UA = (LAS bf16*)(F.lds + 16384);
    LAS float* AB = (LAS float*)(F.lds + 32768);
    __syncthreads();
    { const int tok = F.tid >> 4, c8 = (F.tid & 15) * 8, cg = nb * 128 + c8; float acc[8];
      const float* cb = F.A->in[I_CONVB] + l * 1024 + cg;
#pragma unroll
      for (int e = 0; e < 8; ++e) acc[e] = cb[e];
#pragma unroll
      for (int j = 0; j < 4; ++j) { const int r = row0 + tok - 2 + j;
          if (r >= seq_lo && r < seq_hi) { const v4u x = *(const v4u*)(P + (size_t)r * DINP + C_LRUX + cg); const float* cw = F.A->in[I_CONVW] + (size_t)(l * 4 + j) * 1024 + cg;
#pragma unroll
              for (int w = 0; w < 4; ++w) { acc[2 * w] += cw[2 * w] * bflo(x[w]); acc[2 * w + 1] += cw[2 * w + 1] * bfhi(x[w]); } } }
      *(LAS f32x4*)(U + tok * 128 + c8) = (f32x4){acc[0], acc[1], acc[2], acc[3]}; *(LAS f32x4*)(U + tok * 128 + c8 + 4) = (f32x4){acc[4], acc[5], acc[6], acc[7]};
      v4u o; o.x = pk2(acc[0], acc[1]); o.y = pk2(acc[2], acc[3]); o.z = pk2(acc[4], acc[5]); o.w = pk2(acc[6], acc[7]);
      *(LAS v4u*)(UA + tok * 136 + c8) = o; }
    __syncthreads();
    { const int dir = F.wave >> 2, cq = F.wave & 3, l32 = F.lane & 31, hi = F.lane >> 5, chn = cq * 32 + l32, cg = nb * 128 + chn;
      const bf16* Wr = (const bf16*)(F.wsw + WS_WLRU) + ((size_t)(dir * 2 + 0) * 8 + nb) * 16384 + (size_t)chn * 128;
      const bf16* Wi = (const bf16*)(F.wsw + WS_WLRU) + ((size_t)(dir * 2 + 1) * 8 + nb) * 16384 + (size_t)chn * 128;
      f32x16 accr = {}, acci = {};
#pragma unroll
      for (int ks = 0; ks < 8; ++ks) { const int ko = ks * 16 + hi * 8;
          const bf16x8 a = *(const LAS bf16x8*)(UA + l32 * 136 + ko); const bf16x8 br = *(const bf16x8*)(Wr + ko), bi = *(const bf16x8*)(Wi + ko);
          accr = __builtin_amdgcn_mfma_f32_32x32x16_bf16(a, br, accr, 0, 0, 0); acci = __builtin_amdgcn_mfma_f32_32x32x16_bf16(a, bi, acci, 0, 0, 0); }
      const float ba = F.A->in[I_LBA][(l * 2 + dir) * 1024 + cg], bi_ = F.A->in[I_LBI][(l * 2 + dir) * 1024 + cg], sp = softplusf_(-F.A->in[I_LAM][(l * 2 + dir) * 1024 + cg]);
#pragma unroll
      for (int r = 0; r < 16; ++r) { const int tok = att::crow(r, hi); const float u = U[tok * 128 + chn];
          const float rg = sigmoidf_(accr[r] + ba), ig = sigmoidf_(acci[r] + bi_), la = -8.f * rg * sp, a = __expf(la), x2 = 2.f * la;
          const float em = x2 * (1.f + x2 * (0.5f + x2 * (0.16666667f + x2 * (0.041666668f + x2 * (0.0083333338f + x2 * 0.0013888889f)))));
          const float bc = __builtin_amdgcn_sqrtf(x2 < -0.5f ? 1.f - a * a : -em) * (ig * u);
          AB[(dir * 2 + 0) * 4096 + tok * 128 + chn] = a; AB[(dir * 2 + 1) * 4096 + tok * 128 + chn] = bc; } }
    __syncthreads();
    if (F.tid < 256) { const int dir = F.tid >> 7, chn = F.tid & 127, cg = nb * 128 + chn; const size_t ci = ((size_t)(dir * 2 + b) * NCH + ch) * 1024 + cg;
        LAS float* Aa = AB + (dir * 2) * 4096 + chn; LAS float* Bb = AB + (dir * 2 + 1) * 4096 + chn;
        if (!PASS3) { float h = 0.f, ap = 1.f;
#pragma unroll 8
            for (int s = 0; s < 32; ++s) { const int tok = dir ? 31 - s : s; const float a = Aa[tok * 128]; h = a * h + Bb[tok * 128]; ap *= a;
                if (s == 0 && dir == 1 && ch == 7) ((float*)(F.ws + WS_QUIRK))[b * 1024 + cg] = h; }
            ((float*)(F.ws + WS_CA))[ci] = ap; ((float*)(F.ws + WS_CB))[ci] = h;
        } else { float h = ((const float*)(F.ws + WS_HIN))[ci];
#pragma unroll 8
            for (int s = 0; s < 32; ++s) { const int tok = dir ? 31 - s : s; h = Aa[tok * 128] * h + Bb[tok * 128]; Bb[tok * 128] = h; } } }
    if (PASS3) { __syncthreads();
        const int tok = F.tid >> 4, c8 = (F.tid & 15) * 8, cg = nb * 128 + c8, row = row0 + tok;
        const v4u y = *(const v4u*)(P + (size_t)row * DINP + C_LRUY + cg); float o[8];
#pragma unroll
        for (int w = 0; w < 4; ++w) { const float h0 = AB[4096 + tok * 128 + c8 + 2 * w] + AB[3 * 4096 + tok * 128 + c8 + 2 * w], h1 = AB[4096 + tok * 128 + c8 + 2 * w + 1] + AB[3 * 4096 + tok * 128 + c8 + 2 * w + 1];
            o[2 * w] = h0 * gelu_tanh(bflo(y[w])); o[2 * w + 1] = h1 * gelu_tanh(bfhi(y[w])); }
        v4u ov; ov.x = pk2(o[0], o[1]); ov.y = pk2(o[2], o[3]); ov.z = pk2(o[4], o[5]); ov.w = pk2(o[6], o[7]);
        *(v4u*)((bf16*)(F.ws + WS_MIX) + (size_t)row * DM + 1024 + cg) = ov; }
}
__device__ __forceinline__ void lru_carry(Frame& F, int blk) {
    F.tid = ltid(); F.lane = F.tid & 63;
    const int gid = blk * NTHR + F.tid; if (gid >= 4096) return;
    const int dir = gid >> 11, b = (gid >> 10) & 1, cg = gid & 1023;
    const float* CA = (const float*)(F.ws + WS_CA) + ((size_t)(dir * 2 + b) * NCH) * 1024 + cg; const float* CB = (const float*)(F.ws + WS_CB) + ((size_t)(dir * 2 + b) * NCH) * 1024 + cg;
    float* HIN = (float*)(F.ws + WS_HIN) + ((size_t)(dir * 2 + b) * NCH) * 1024 + cg;
    float h = 0.f;
    if (dir == 0) {
#pragma unroll 8
        for (int c = 0; c < NCH; ++c) { HIN[(size_t)c * 1024] = h; h = CA[(size_t)c * 1024] * h + CB[(size_t)c * 1024]; }
    } else {
        for (int c = 7; c >= 0; --c) { HIN[(size_t)c * 1024] = h; h = CA[(size_t)c * 1024] * h + CB[(size_t)c * 1024]; }
        h = ((const float*)(F.ws + WS_QUIRK))[b * 1024 + cg];
#pragma unroll 8
        for (int c = NCH - 1; c >= 8; --c) { HIN[(size_t)c * 1024] = h; h = CA[(size_t)c * 1024] * h + CB[(size_t)c * 1024]; }
    }
}

__device__ __forceinline__ void rope_table(Frame& F) {
    const int i = F.vcu * NTHR + F.tid; if (i >= 2048) return;
    const int pos = i >> 4, f = i & 15; float s, c; sincosf((float)pos * exp2f(-(float)f * (13.287712379549449f / 16.f)), &s, &c);
    float* t = (float*)(F.ws + WS_ROPE); t[i] = c; t[2048 + i] = s;
}
__device__ __forceinline__ void row_prep(Frame& F, int row) {
    F.tid = ltid(); F.lane = F.tid & 63;
    bf16* pr = (bf16*)(F.ws + WS_P) + (size_t)row * DINP; const int lane = F.lane;
    const bool lat = row < M_LAT; const int t = row & (SEQ - 1); const float prow = (float)(t >> 6), pcol = (float)(t & 63);
    { const v4u a = *(const v4u*)(pr + C_QA + lane * 16), b = *(const v4u*)(pr + C_QA + lane * 16 + 8); float ss = 0.f;
#pragma unroll
      for (int w = 0; w < 4; ++w) { const float x0 = bflo(a[w]), x1 = bfhi(a[w]), x2 = bflo(b[w]), x3 = bfhi(b[w]); ss += x0 * x0 + x1 * x1 + x2 * x2 + x3 * x3; }
      ss = wave_sum(ss); if (lane == 0) ((float*)(F.ws + WS_RSQ))[row] = 1.f / sqrtf(ss * (1.f / 1024.f) + RMS_EPS); }
    { const v4u a = *(const v4u*)(pr + C_KVA + lane * 8); float ss = 0.f;
#pragma unroll
      for (int w = 0; w < 4; ++w) { const float x0 = bflo(a[w]), x1 = bfhi(a[w]); ss += x0 * x0 + x1 * x1; }
      ss = wave_sum(ss); if (lane == 0) ((float*)(F.ws + WS_RSKV))[row] = 1.f / sqrtf(ss * (1.f / 512.f) + RMS_EPS); }
    bf16* kr = (bf16*)(F.ws + WS_KR) + (size_t)row * 64;
    if (lat) {
        { const int part = lane >> 5, sub = lane & 31;
          const float inv = exp2f(-(float)sub * (13.287712379549449f / 32.f)); float sn, cs; sincosf((part ? pcol : prow) * inv, &sn, &cs);
#pragma unroll
          for (int hd = 0; hd < 10; ++hd) { bf16* qb = pr + (hd < 8 ? C_SWAQ + hd * 128 : C_SWAK + (hd - 8) * 128) + part * 64;
              const float x1 = bf2f(qb[sub]), x2 = bf2f(qb[sub + 32]); qb[sub] = (bf16)f2bf(x1 * cs - x2 * sn); qb[sub + 32] = (bf16)f2bf(x2 * cs + x1 * sn); } }
        if (lane < 32) { const int part = lane >> 4, i = lane & 15; const bf16* src = pr + C_KR + part * 32;
          const float inv = exp2f(-(float)i * (13.287712379549449f / 16.f)); float s, c; sincosf((part ? pcol : prow) * inv, &s, &c);
          const float x1 = bf2f(src[i]), x2 = bf2f(src[i + 16]);
          kr[part * 32 + i] = (bf16)f2bf(x1 * c - x2 * s); kr[part * 32 + i + 16] = (bf16)f2bf(x2 * c + x1 * s); }
    } else kr[lane] = pr[C_KR + lane];
}

__device__ __forceinline__ float allred16(float x) { return row_sum16(x); }
__device__ __forceinline__ int scan_row(int s, int dir, int b) {
    if (s < NCTX) return M_LAT + b * NCTX + (dir ? NCTX - 1 - s : s);
    const int t = s - NCTX; return b * SEQ + (dir ? SEQ - 1 - t : t);
}
__device__ __forceinline__ void rwkv_scan(Frame& F, int l, int chain) {
    F.tid = ltid(); F.lane = F.tid & 63;
    const int dir = chain >> 5, b = (chain >> 4) & 1, h = chain & 15;
    constexpr int CT = 24, NCHK = (NCTX + SEQ) / CT, STEPF = 392, BUFF = CT * STEPF;
    LAS float* buf = (LAS float*)F.lds; LAS float* ybuf = (LAS float*)(F.lds + 3 * BUFF * 4);
    gcbf RWF = (gcbf)(F.ws + WS_RWF); const size_t RS = (size_t)M_TOT * 1024;
    gflp YS = (gflp)(F.ws + WS_YS) + (size_t)dir * M_TOT * 1024;
    const bool cmp = F.wave < 4; const int lt = F.tid - 256, lst = lt >> 4, lq = lt & 15, lc = h * 64 + 4 * lq;
    const f32x4 ka4 = *(const GAS f32x4*)((gcfl)F.A->in[I_KA] + l * 1024 + (cmp ? 0 : lc));
    v2u gr[2], gk[2], gv[2], gkk[2], ge[2], ga[2];
#pragma unroll
    for (int u = 0; u < 2; ++u) { gr[u] = (v2u){0u, 0u}; gk[u] = gr[u]; gv[u] = gr[u]; gkk[u] = gr[u]; ge[u] = gr[u]; ga[u] = gr[u]; }
#define RW_LOAD(c) do { if (!cmp) { _Pragma("unroll") for (int u_ = 0; u_ < 2; ++u_) { const int s_ = lst + 16 * u_; if (s_ < CT) { const size_t o_ = (size_t)scan_row((c) * CT + s_, dir, b) * 1024 + lc; \
        gr[u_] = *(const GAS v2u*)(RWF + 0 * RS + o_); gk[u_] = *(const GAS v2u*)(RWF + 1 * RS + o_); gv[u_] = *(const GAS v2u*)(RWF + 2 * RS + o_); \
        gkk[u_] = *(const GAS v2u*)(RWF + 3 * RS + o_); ge[u_] = *(const GAS v2u*)(RWF + (4 + dir) * RS + o_); ga[u_] = *(const GAS v2u*)(RWF + (6 + dir) * RS + o_); } } } } while (0)
#define RW_WRITE(bi) do { if (!cmp) { _Pragma("unroll") for (int u_ = 0; u_ < 2; ++u_) { const int s_ = lst + 16 * u_; if (s_ < CT) { LAS float* d_ = buf + (bi) * BUFF + s_ * STEPF + 4 * lq; \
        const float r_[4] = {bflo(gr[u_].x), bfhi(gr[u_].x), bflo(gr[u_].y), bfhi(gr[u_].y)}, k_[4] = {bflo(gk[u_].x), bfhi(gk[u_].x), bflo(gk[u_].y), bfhi(gk[u_].y)}, v_[4] = {bflo(gv[u_].x), bfhi(gv[u_].x), bflo(gv[u_].y), bfhi(gv[u_].y)}; \
        const float q_[4] = {bflo(gkk[u_].x), bfhi(gkk[u_].x), bflo(gkk[u_].y), bfhi(gkk[u_].y)}, e_[4] = {bflo(ge[u_].x), bfhi(ge[u_].x), bflo(ge[u_].y), bfhi(ge[u_].y)}, a_[4] = {bflo(ga[u_].x), bfhi(ga[u_].x), bflo(ga[u_].y), bfhi(ga[u_].y)}; \
        f32x4 w4, kd4, kk4, b4, wr4, v4; float sbr = 0.f, skr = 0.f; \
        _Pragma("unroll") for (int e = 0; e < 4; ++e) { w4[e] = __expf(-e_[e]); kd4[e] = k_[e] * (1.f + (a_[e] - 1.f) * ka4[e]); kk4[e] = q_[e]; b4[e] = q_[e] * a_[e]; wr4[e] = w4[e] * r_[e]; v4[e] = v_[e]; sbr += b4[e] * r_[e]; skr += kd4[e] * r_[e]; } \
        sbr = row_sum16(sbr); skr = row_sum16(skr); \
        *(LAS f32x4*)(d_) = w4; *(LAS f32x4*)(d_ + 64) = kd4; *(LAS f32x4*)(d_ + 128) = kk4; *(LAS f32x4*)(d_ + 192) = b4; *(LAS f32x4*)(d_ + 256) = wr4; *(LAS f32x4*)(d_ + 320) = v4; \
        if (lq == 0) *(LAS f32x2*)(buf + (bi) * BUFF + s_ * STEPF + 384) = (f32x2){sbr, skr}; } } } } while (0)
#define RW_FLUSH(c) do { if (!cmp) { _Pragma("unroll") for (int u_ = 0; u_ < 2; ++u_) { const int s_ = lst + 16 * u_; if (s_ < CT) { const f32x4 y_ = *(const LAS f32x4*)(ybuf + ((c) & 1) * (CT * 64) + s_ * 64 + 4 * lq); \
        *(GAS f32x4*)(YS + (size_t)scan_row((c) * CT + s_, dir, b) * 1024 + lc) = y_; } } } } while (0)
    __syncthreads();
    RW_LOAD(0); RW_WRITE(0); RW_LOAD(1); RW_WRITE(1); RW_LOAD(2);
    __syncthreads();
    const int kg = F.lane & 7, rg = F.lane >> 3, r0 = 16 * (F.wave & 3) + 2 * rg;
    f32x2 St[8];
#pragma unroll
    for (int i = 0; i < 8; ++i) St[i] = (f32x2){0.f, 0.f};
    int bc = 0, bw = 2;
#pragma unroll 1
    for (int c = 0; c < NCHK; ++c) {
        if (c + 2 < NCHK) { RW_WRITE(bw); if (c + 3 < NCHK) RW_LOAD(c + 3); }
        if (c > 0) RW_FLUSH(c - 1);
        if (cmp) {
        const LAS float* bb = buf + bc * BUFF + 8 * kg; const LAS float* vb = buf + bc * BUFF + 320 + r0; const LAS float* sb = buf + bc * BUFF + 384;
        LAS float* yb = ybuf + (c & 1) * (CT * 64) + r0;
        f32x4 w4[2], kd4[2], kk4[2], b4[2], wr4[2];
#pragma unroll
        for (int q = 0; q < 2; ++q) { w4[q] = *(const LAS f32x4*)(bb + 4 * q); kd4[q] = *(const LAS f32x4*)(bb + 64 + 4 * q); kk4[q] = *(const LAS f32x4*)(bb + 128 + 4 * q); b4[q] = *(const LAS f32x4*)(bb + 192 + 4 * q); wr4[q] = *(const LAS f32x4*)(bb + 256 + 4 * q); }
        f32x2 v2 = *(const LAS f32x2*)(vb), s2 = *(const LAS f32x2*)(sb);
#pragma unroll
        for (int st = 0; st < CT; ++st) {
            const int sn = (st + 1 < CT ? st + 1 : st) * STEPF;
            f32x4 nw4[2], nkd4[2], nkk4[2], nb4[2], nwr4[2];
#pragma unroll
            for (int q = 0; q < 2; ++q) { nw4[q] = *(const LAS f32x4*)(bb + sn + 4 * q); nkd4[q] = *(const LAS f32x4*)(bb + sn + 64 + 4 * q); nkk4[q] = *(const LAS f32x4*)(bb + sn + 128 + 4 * q); nb4[q] = *(const LAS f32x4*)(bb + sn + 192 + 4 * q); nwr4[q] = *(const LAS f32x4*)(bb + sn + 256 + 4 * q); }
            const f32x2 nv2 = *(const LAS f32x2*)(vb + sn), ns2 = *(const LAS f32x2*)(sb + sn);
            f32x2 pa = St[0] * kk4[0][0], za = St[0] * wr4[0][0], pb = St[4] * kk4[1][0], zb = St[4] * wr4[1][0];
#pragma unroll
            for (int i = 1; i < 4; ++i) { pa = St[i] * kk4[0][i] + pa; za = St[i] * wr4[0][i] + za; pb = St[4 + i] * kk4[1][i] + pb; zb = St[4 + i] * wr4[1][i] + zb; }
            const f32x2 p = pa + pb, z = za + zb;
            float p0 = p.x, p1 = p.y, z0 = z.x, z1 = z.y;
#define D4(ctl) "v_add_f32_dpp %0, %0, %0 " ctl " row_mask:0xf bank_mask:0xf\n\tv_add_f32_dpp %1, %1, %1 " ctl " row_mask:0xf bank_mask:0xf\n\tv_add_f32_dpp %2, %2, %2 " ctl " row_mask:0xf bank_mask:0xf\n\tv_add_f32_dpp %3, %3, %3 " ctl " row_mask:0xf bank_mask:0xf\n\t"
            asm volatile("s_nop 1\n\t" D4("quad_perm:[1,0,3,2]") D4("quad_perm:[2,3,0,1]") D4("row_half_mirror") "s_nop 0"
                : "+v"(p0), "+v"(p1), "+v"(z0), "+v"(z1));
#undef D4
            const f32x2 pp = {p0, p1}, zz = {z0, z1};
            *(LAS f32x2*)(yb + st * 64) = zz - pp * s2.x + v2 * s2.y;
#pragma unroll
            for (int i = 0; i < 8; ++i) St[i] = (St[i] * w4[i >> 2][i & 3] + v2 * kd4[i >> 2][i & 3]) - pp * b4[i >> 2][i & 3];
#pragma unroll
            for (int q = 0; q < 2; ++q) { w4[q] = nw4[q]; kd4[q] = nkd4[q]; kk4[q] = nkk4[q]; b4[q] = nb4[q]; wr4[q] = nwr4[q]; }
            v2 = nv2; s2 = ns2;
        }
        }
        __syncthreads();
        bc = bc == 2 ? 0 : bc + 1; bw = bw == 2 ? 0 : bw + 1;
    }
    RW_FLUSH(NCHK - 1);
#undef RW_LOAD
#undef RW_WRITE
#undef RW_FLUSH
}
__device__ __forceinline__ void rwkv_out_row(Frame& F, int l, int row) {
    F.tid = ltid(); F.lane = F.tid & 63;
    const int c0 = F.lane * 16; const float* yf = (const float*)(F.ws + WS_YS) + (size_t)row * 1024 + c0; const float* yb = yf + (size_t)M_TOT * 1024;
    float y[16]; float s = 0.f;
#pragma unroll
    for (int j = 0; j < 4; ++j) { const f32x4 a = *(const f32x4*)(yf + 4 * j), b = *(const f32x4*)(yb + 4 * j);
#pragma unroll
        for (int e = 0; e < 4; ++e) { y[4 * j + e] = a[e] + b[e]; s += y[4 * j + e]; } }
    s = quad_sum(s); const float mu = s * (1.f / 64.f); float q = 0.f;
#pragma unroll
    for (int e = 0; e < 16; ++e) { y[e] -= mu; q += y[e] * y[e]; }
    q = quad_sum(q); const float rstd = 1.f / sqrtf(q * (1.f / 64.f) + GN_EPS);
    const bf16* RWF = (const bf16*)(F.ws + WS_RWF); const size_t RS = (size_t)M_TOT * 1024, o = (size_t)row * 1024 + c0;
    const float sbv = ((const float*)(F.ws + WS_SB))[(size_t)row * 16 + (F.lane >> 2)];
    const float* lg = F.A->in[I_LNG] + l * 1024 + c0; const float* lb = F.A->in[I_LNB] + l * 1024 + c0;
    bf16* dst = (bf16*)(F.ws + WS_MIX) + (size_t)row * DM + 3072 + c0;
#pragma unroll
    for (int hf = 0; hf < 2; ++hf) { const v4u vv = *(const v4u*)(RWF + 2 * RS + o + 8 * hf), gg = *(const v4u*)(RWF + 8 * RS + o + 8 * hf); float r[8];
#pragma unroll
        for (int w = 0; w < 4; ++w) { const int e = 8 * hf + 2 * w;
            r[2 * w] = (y[e] * rstd * lg[e] + lb[e] + sbv * bflo(vv[w])) * bflo(gg[w]); r[2 * w + 1] = (y[e + 1] * rstd * lg[e + 1] + lb[e + 1] + sbv * bfhi(vv[w])) * bfhi(gg[w]); }
        v4u ov; ov.x = pk2(r[0], r[1]); ov.y = pk2(r[2], r[3]); ov.z = pk2(r[4], r[5]); ov.w = pk2(r[6], r[7]); *(v4u*)(dst + 8 * hf) = ov; }
}

#ifndef W_OUT_K1
#define W_OUT_K1 2560
#endif
struct MlaTiles { gcbf KV; gcbf KR; int ctx_row0, lat_row0, h;
    __device__ __forceinline__ att::Tile operator()(int j) const { const int row = j < 4 ? ctx_row0 + 64 * j : lat_row0 + 64 * (j - 4);
        att::Tile t; t.kn = KV + (size_t)row * 2048 + h * 256; t.v = t.kn + 128; t.kr = KR + (size_t)row * 64; t.mtype = 0; t.krel0 = 0; return t; } };
struct SwaTiles { gcbf P; int blk_row0, ctx_row0, kvh, nwin, has_prev, has_next;
    __device__ __forceinline__ att::Tile operator()(int j) const { att::Tile t; int row; t.mtype = 0; t.krel0 = 0;
        if (j >= nwin) row = ctx_row0 + 64 * (j - nwin);
        else if (j < 2) row = blk_row0 + 64 * j;
        else if (has_prev && j < 4) { row = blk_row0 - 128 + 64 * (j - 2); t.mtype = 1; t.krel0 = -128 + 64 * (j - 2); }
        else { const int sub = j - 2 - 2 * has_prev; row = blk_row0 + 128 + 64 * sub; t.mtype = 2; t.krel0 = 128 + 64 * sub; }
        t.kn = P + (size_t)row * DINP + C_SWAK + kvh * 128; t.v = P + (size_t)row * DINP + C_SWAV + kvh * 128; t.kr = nullptr; return t; } };

#ifndef MLA_SDEPTH
#define MLA_SDEPTH 1
#endif
__device__ __forceinline__ void mla_item(Frame& F, int b, int h, int qb, bool ctxq) {
    F.tid = ltid(); F.lane = F.tid & 63;
    const int r32 = F.lane & 31; const int t = qb * 256 + F.wave * 32 + r32;
    const int roww0 = ctxq ? M_LAT + b * NCTX + F.wave * 32 : b * SEQ + qb * 256 + F.wave * 32;
    gcbf Qw = (gcbf)(F.ws + WS_Q) + (size_t)(roww0 + r32) * 1536 + h * 192;
    MlaTiles ts{(gcbf)(F.ws + WS_KV), (gcbf)(F.ws + WS_KR), M_LAT + b * NCTX, b * SEQ, h};
    gbfp Ow = (gbfp)(F.ws + WS_MIX) + (size_t)roww0 * DM + 2048 + h * 128;
    att::attn_body<192, 2048, 2048, false, false, MLA_SDEPTH>(Qw, ctxq ? 0 : 1, t >> 6, t & 63, (gcfl)(F.ws + WS_ROPE), 0, 0.f, ts, ctxq ? 4 : 132, Ow, (LAS char*)F.lds);
}
__device__ __forceinline__ void swa_item(Frame& F, int l, int b, int n, int kvh, int half, bool ctxq, int hq_ctx) {
    F.tid = ltid(); F.lane = F.tid & 63;
    const int r32 = F.lane & 31; gcbf P = (gcbf)(F.ws + WS_P);
    int hq, qi, roww0, t;
    if (ctxq) { hq = hq_ctx; kvh = hq >> 2; qi = 0; roww0 = M_LAT + b * NCTX + F.wave * 32; t = 0; }
    else { hq = kvh * 4 + 2 * half + (F.wave >> 2); qi = (F.wave & 3) * 32 + r32; roww0 = b * SEQ + n * 128 + (F.wave & 3) * 32; t = n * 128 + qi; }
    gcbf Qw = P + (size_t)(roww0 + r32) * DINP + C_SWAQ + hq * 128;
    SwaTiles ts; ts.P = P; ts.blk_row0 = b * SEQ + n * 128; ts.ctx_row0 = M_LAT + b * NCTX; ts.kvh = kvh;
    ts.has_prev = (!ctxq && n > 0) ? 1 : 0; ts.has_next = (!ctxq && n < SEQ / 128 - 1) ? 1 : 0; ts.nwin = ctxq ? 0 : 2 + 2 * ts.has_prev + 2 * ts.has_next;
    gbfp Ow = (gbfp)(F.ws + WS_MIX) + (size_t)roww0 * DM + hq * 128;
    const float sink_l2 = F.A->in[I_SINK][l * 8 + hq] * 1.4426950408889634f;
    att::attn_body<128, DINP, DINP, true, true, 2>(Qw, 0, 0, 0, (gcfl)nullptr, qi, sink_l2, ts, ts.nwin + 4, Ow, (LAS char*)F.lds);
}

#ifndef DBG_PHASES
#define DBG_PHASES 0xfffff
#endif
#define PH(n) ((DBG_PHASES >> (n)) & 1)
#ifndef DUP_PHASES
#define DUP_PHASES 0
#endif
#define REP(n) _Pragma("unroll") for (int rep_ = 0; rep_ < (((DUP_PHASES >> (n)) & 1) ? 2 : 1); ++rep_)
__global__ void __launch_bounds__(NTHR, 2) mk_fwd(Args args) {
    extern __shared__ __attribute__((aligned(16))) unsigned char lds[];
    Frame F;
    F.lds = (LAS unsigned char*)lds;
    F.tid = threadIdx.x; F.lane = F.tid & 63; F.wave = __builtin_amdgcn_readfirstlane(F.tid >> 6);
    F.G = gridDim.x; { const int bx = blockIdx.x; F.vcu = (F.G % 8 == 0) ? (bx % 8) * (F.G / 8) + bx / 8 : bx; }
    F.gw = F.vcu * NWAVES + F.wave; F.NGW = F.G * NWAVES;
    F.ws = args.ws; F.out = args.out; F.ctl = (gu32*)(args.ws + WS_CTL);
    F.A = (const __attribute__((address_space(4))) Args*)__builtin_amdgcn_kernarg_segment_ptr();
    for (int u = F.tid; u < (LDS_BYTES - LDSCTL_OFF) / 4; u += NTHR) ((LAS unsigned*)(F.lds + LDSCTL_OFF))[u] = 0u;
    __syncthreads();
    XcdBarrier bar = xcd_barrier_post((unsigned*)(args.ws + WS_CTL) + 4096, (volatile LAS unsigned*)(F.lds + MISC_OFF) + 8);
    const bool rwkv_blk = (blockIdx.x & 3) == 0;
    XcdBarrier bar2; bar2.bar = (unsigned*)(args.ws + WS_CTL) + 8192; bar2.x = 0; bar2.st = (volatile LAS unsigned*)(F.lds + MISC_OFF) + 12; bar2.nparts = gridDim.x - ((gridDim.x + 3) >> 2);
    if (!rwkv_blk) { const unsigned np_ = bar2.nparts; bar2 = xcd_barrier_post((unsigned*)(args.ws + WS_CTL) + 8192, (volatile LAS unsigned*)(F.lds + MISC_OFF) + 12); bar2.nparts = np_; }
#define SUB_BAR() do { bar2.bar = launder(bar2.bar); bar2.x = launder(bar2.x); xcd_barrier(bar2); F.ws = launder_g(F.ws); F.wsw = F.ws + (size_t)lcur * WSET_STRIDE; F.A = launder(F.A); F.tid = ltid(); F.lane = F.tid & 63; } while (0)
#define GRID_BAR() do { bar.bar = launder(bar.bar); bar.x = launder(bar.x); xcd_barrier(bar); F.ws = launder_g(F.ws); F.wsw = F.ws + (size_t)lcur * WSET_STRIDE; F.A = launder(F.A); F.tid = ltid(); F.lane = F.tid & 63; } while (0)
    const int bx = blockIdx.x; int lcur = 0; F.wsw = F.ws;
    bf16* H = (bf16*)(F.ws + WS_H); float* X = (float*)(F.ws + WS_X);

    REP(0) if (PH(0)) { mod_partials(F);
    convert_weights(F, 0, F.gw, F.NGW); }
    GRID_BAR();
    if (PH(1)) { mod_reduce(F); rope_table(F); }
    GRID_BAR();

#pragma unroll 1
    for (int l = 0; l < 2; ++l) {
        lcur = l; F.wsw = F.ws + (size_t)l * WSET_STRIDE;
        const bool wctx = (l == 0);
        const int MO = wctx ? M_TOT : M_LAT;
        if (PH(2) && l == 0) {
            for (int row = F.gw; row < M_TOT; row += F.NGW) { const int s = row_s(row);
                const float* xs = row < M_LAT ? F.A->in[I_X] + (size_t)row * DM : F.A->in[I_CTX] + (size_t)(row - M_LAT) * DM;
                ln_row<0>(F, xs, nullptr, nullptr, nullptr, nullptr, nullptr, true, mod_ptr(F, 0, s, 1), mod_ptr(F, 0, s, 0), H + (size_t)row * DM); }
        }
        GRID_BAR();
        REP(3) if (PH(3)) { pg8::Gemm g{H, (const bf16*)(F.wsw + WS_WIN), M_TOT, DINP, DM, DM, DM}; pg8::StaticOrder S; S.init(M_TOT, DINP, F.G, bx);
          pg8::EpiBf16<0> E{(bf16*)(F.ws + WS_P), DINP, nullptr};
          pg8::gemm_phase<pg8::EpiBf16<0>, pg8::StaticOrder, true, true>(F.lds, g, S, E); }
        GRID_BAR();
        REP(4) if (PH(4)) for (int it = F.vcu; it < 528; it += F.G) rwkv_feat_item(F, l, it);
        REP(5) if (PH(5)) { if (F.G == 256) { if (F.vcu < 16) { for (int it = F.vcu; it < 64; it += 16) lru_item<false>(F, l, it); }
                                              else { for (int it = 64 + F.vcu - 16; it < 2 * NCH * 8; it += 240) lru_item<false>(F, l, it); } }
                            else for (int it = F.vcu; it < 2 * NCH * 8; it += F.G) lru_item<false>(F, l, it); }
        __syncthreads();
        if (PH(6)) for (int row = F.gw; row < M_TOT; row += F.NGW) row_prep(F, row);
        GRID_BAR();
        REP(8) if (rwkv_blk) { const int nrw = (F.G + 3) >> 2; REP(18) if (PH(8)) for (int chain = bx >> 2; chain < 64; chain += nrw) rwkv_scan(F, l, chain); }
        else REP(19) { const int aw = (bx >> 2) * 3 + (bx & 3) - 1, naw = F.G - ((F.G + 3) >> 2);
            if (PH(7) && aw < 8) lru_carry(F, aw);
            if (PH(7)) { pg8::Gemm g{(const bf16*)(F.ws + WS_P) + C_QA, (const bf16*)(F.wsw + WS_WQB), M_TOT, 1536, 1024, DINP, 1024}; pg8::StaticOrder S; S.init(M_TOT, 1536, naw, aw);
              pg8::EpiBf16<2> E{(bf16*)(F.ws + WS_Q), 1536, (const float*)(F.ws + WS_RSQ)};
              pg8::gemm_phase<pg8::EpiBf16<2>, pg8::StaticOrder, true, true>(F.lds, g, S, E); }
            if (PH(7)) { pg8::Gemm g{(const bf16*)(F.ws + WS_P) + C_KVA, (const bf16*)(F.wsw + WS_WKVB), M_TOT, 2048, 512, DINP, 512}; pg8::StaticOrder S; S.init(M_TOT, 2048, naw, aw);
              pg8::EpiBf16<2> E{(bf16*)(F.ws + WS_KV), 2048, (const float*)(F.ws + WS_RSKV)};
              pg8::gemm_phase<pg8::EpiBf16<2>, pg8::StaticOrder, true, true>(F.lds, g, S, E); }
            SUB_BAR();
            if (PH(9)) for (int it = aw; it < 512; it += naw) mla_item(F, it >> 8, (it >> 5) & 7, it & 31, false);
            if (PH(9) && wctx) for (int it = aw; it < 16; it += naw) mla_item(F, it >> 3, it & 7, 0, true);
            if (PH(10)) for (int it = aw; it < 512; it += naw) swa_item(F, l, it >> 8, (it >> 2) & 63, (it >> 1) & 1, it & 1, false, 0);
            if (PH(10) && wctx) for (int it = aw; it < 16; it += naw) swa_item(F, l, it >> 3, 0, 0, 0, true, it & 7);
            if (PH(11)) for (int it = aw; it < 2 * NCH * 8; it += naw) { if (!wctx && ((it >> 3) % NCH) < 8) continue; lru_item<true>(F, l, it); }
            if (l == 0) { __syncthreads(); convert_weights(F, 1, aw * NWAVES + F.wave, naw * NWAVES); }
            else { SUB_BAR();
                pg8::Gemm g{(const bf16*)(F.ws + WS_MIX), (const bf16*)(F.wsw + WS_WOUT), M_LAT, DM, W_OUT_K1, DM, DM}; pg8::StaticOrder S; S.init(M_LAT, DM, naw, aw);
                pg8::EpiBf16<0> E{(bf16*)(F.ws + WS_Y1), DM, nullptr};
                pg8::gemm_phase<pg8::EpiBf16<0>, pg8::StaticOrder, true, true>(F.lds, g, S, E); }
        }
        GRID_BAR();
        REP(12) if (PH(12)) for (int row = F.gw; row < MO; row += F.NGW) rwkv_out_row(F, l, row);
        GRID_BAR();
        REP(13) if (PH(13)) {
          if (l == 0) { pg8::Gemm g{(const bf16*)(F.ws + WS_MIX), (const bf16*)(F.wsw + WS_WOUT), M_LAT, DM, DM, DM, DM}; pg8::StaticOrder S; S.init(M_LAT, DM, F.G, bx);
            pg8::EpiBf16<0> E{(bf16*)(F.ws + WS_Y1), DM, nullptr};
            pg8::gemm_phase<pg8::EpiBf16<0>, pg8::StaticOrder, true, true>(F.lds, g, S, E); }
          else { pg8::Gemm g{(const bf16*)(F.ws + WS_MIX) + W_OUT_K1, (const bf16*)(F.wsw + WS_WOUT) + W_OUT_K1, M_LAT, DM, DM - W_OUT_K1, DM, DM}; pg8::StaticOrder S; S.init(M_LAT, DM, F.G, bx);
            pg8::EpiBf16<3> E{(bf16*)(F.ws + WS_Y1), DM, nullptr};
            pg8::gemm_phase<pg8::EpiBf16<3>, pg8::StaticOrder, true, true>(F.lds, g, S, E); }
          if (wctx) {
              pg8::Gemm g2{(const bf16*)(F.ws + WS_MIX) + (size_t)M_LAT * DM, (const bf16*)(F.wsw + WS_WOUT), M_CTX, DM, DM / 8, DM, DM}; pg8::SplitOrder S2; S2.init(M_CTX, DM, DM / 8, bx);
              pg8::EpiF32 E2{(float*)(F.ws + WS_YP), DM, (size_t)M_CTX * DM};
              pg8::gemm_phase<pg8::EpiF32, pg8::SplitOrder, true, true>(F.lds, g2, S2, E2); } }
        GRID_BAR();
        if (PH(14)) for (int row = F.gw; row < MO; row += F.NGW) { const int s = row_s(row);
            const float* xs = (l == 0) ? (row < M_LAT ? F.A->in[I_X] + (size_t)row * DM : F.A->in[I_CTX] + (size_t)(row - M_LAT) * DM) : X + (size_t)row * DM;
            bf16* yrow = (bf16*)(F.ws + WS_Y1) + (size_t)row * DM;
            if (row >= M_LAT) sum_partials_row(F, (const float*)(F.ws + WS_YP) + (size_t)(row - M_LAT) * DM, (size_t)M_CTX * DM, yrow);
            ln_row<1>(F, xs, yrow, mod_ptr(F, l, s, 2), F.A->in[I_LN1G] + l * DM, F.A->in[I_LN1B] + l * DM, X + (size_t)row * DM,
                      true, mod_ptr(F, l, s, 4), mod_ptr(F, l, s, 3), H + (size_t)row * DM); }
        GRID_BAR();
        REP(15) if (PH(15)) { pg8::Gemm g{H, (const bf16*)(F.wsw + WS_WFF1), MO, DFF, DM, DM, DM}; pg8::StaticOrder S; S.init(MO, DFF, F.G, bx);
          pg8::EpiBf16<1> E{(bf16*)(F.ws + WS_HID), DFF, nullptr};
          pg8::gemm_phase<pg8::EpiBf16<1>, pg8::StaticOrder, true, true>(F.lds, g, S, E); }
        GRID_BAR();
        REP(16) if (PH(16)) { pg8::Gemm g{(const bf16*)(F.ws + WS_HID), (const bf16*)(F.wsw + WS_WFF2), M_LAT, DM, DFF, DFF, DFF}; pg8::StaticOrder S; S.init(M_LAT, DM, F.G, bx);
          pg8::EpiBf16<0> E{(bf16*)(F.ws + WS_Y2), DM, nullptr};
          pg8::gemm_phase<pg8::EpiBf16<0>, pg8::StaticOrder, true, true>(F.lds, g, S, E);
          if (wctx) {
              pg8::Gemm g2{(const bf16*)(F.ws + WS_HID) + (size_t)M_LAT * DFF, (const bf16*)(F.wsw + WS_WFF2), M_CTX, DM, DFF / 8, DFF, DFF}; pg8::SplitOrder S2; S2.init(M_CTX, DM, DFF / 8, bx);
              pg8::EpiF32 E2{(float*)(F.ws + WS_YP), DM, (size_t)M_CTX * DM};
              pg8::gemm_phase<pg8::EpiF32, pg8::SplitOrder, true, true>(F.lds, g2, S2, E2); } }
        GRID_BAR();
        if (!PH(17)) {} else if (l == 0) {
            for (int row = F.gw; row < M_TOT; row += F.NGW) { const int s = row_s(row);
                bf16* yrow = (bf16*)(F.ws + WS_Y2) + (size_t)row * DM;
                if (row >= M_LAT) sum_partials_row(F, (const float*)(F.ws + WS_YP) + (size_t)(row - M_LAT) * DM, (size_t)M_CTX * DM, yrow);
                ln_row<1>(F, X + (size_t)row * DM, yrow, mod_ptr(F, 0, s, 5), F.A->in[I_LN2G], F.A->in[I_LN2B], X + (size_t)row * DM,
                          true, mod_ptr(F, 1, s, 1), mod_ptr(F, 1, s, 0), H + (size_t)row * DM); }
        } else {
            for (int row = F.gw; row < M_LAT; row += F.NGW) { const int s = row_s(row);
                ln_row<1>(F, X + (size_t)row * DM, (const bf16*)(F.ws + WS_Y2) + (size_t)row * DM, mod_ptr(F, 1, s, 5), F.A->in[I_LN2G] + DM, F.A->in[I_LN2B] + DM, F.out + (size_t)row * DM,
                          false, nullptr, nullptr, nullptr); }
        }
    }
}

extern "C" void kernel_launch(void* const* d_in, const int* in_sizes, int n_in, void* d_out, int out_size, void* d_ws, size_t ws_size, hipStream_t stream) {
    static int grid = 0;
    if (grid == 0) {
        if (n_in != 38 || out_size != M_LAT * DM || ws_size < WS_END) { fprintf(stderr, "kernel_launch: unexpected shapes: n_in %d out %d ws %zu (need %zu)\n", n_in, out_size, ws_size, (size_t)WS_END); grid = -1; return; }
        int dev = 0, cus = 0, per_cu = 0;
        if (hipGetDevice(&dev) != hipSuccess || hipDeviceGetAttribute(&cus, hipDeviceAttributeMultiprocessorCount, dev) != hipSuccess) { grid = -1; return; }
        if (hipFuncSetAttribute((const void*)mk_fwd, hipFuncAttributeMaxDynamicSharedMemorySize, LDS_BYTES) != hipSuccess) { fprintf(stderr, "kernel_launch: hipFuncSetAttribute failed\n"); grid = -1; return; }
        if (hipOccupancyMaxActiveBlocksPerMultiprocessor(&per_cu, (const void*)mk_fwd, NTHR, LDS_BYTES) != hipSuccess || per_cu < 1) fprintf(stderr, "kernel_launch: occupancy query says %d\n", per_cu);
        (void)hipGetLastError();
        grid = cus;
    }
    if (grid < 0) return;
    if (hipMemsetAsync((char*)d_ws + WS_CTL, 0, CTL_ZERO_BYTES, stream) != hipSuccess) return;
    Args a{};
    for (int i = 0; i < 38; ++i) a.in[i] = (const float*)d_in[i];
    a.out = (float*)d_out; a.ws = (unsigned char*)d_ws;
    hipLaunchKernelGGL(mk_fwd, dim3(grid), dim3(NTHR), LDS_BYTES, stream, a);
    const hipError_t le = hipPeekAtLastError();
    if (le != hipSuccess) fprintf(stderr, "kernel_launch: launch failed: %s\n", hipGetErrorName(le));
}
```

```cpp
#include <hip/hip_runtime.h>
#include <hip/hip_bf16.h>
#include <cstdio>
#include <cstdint>

namespace pg8 {
#define PG8_LAS __attribute__((address_space(3)))
typedef unsigned short bf16_t;
typedef short bf16x8 __attribute__((ext_vector_type(8)));
typedef float f32x4 __attribute__((ext_vector_type(4)));
typedef unsigned u32x4 __attribute__((ext_vector_type(4)));
constexpr int BM = 256, BK = 64, HALF = 128, HTB = HALF * BK * 2  , STAGE_BYTES = 8 * HTB, NXCD = 8, WGM = 8;

__host__ __device__ __forceinline__ int lds_byte(int r, int c) { const int st = (r >> 4) * 2 + (c >> 5), rr = r & 15, cc = c & 31, ob = rr * 64 + cc * 2; return st * 1024 + (ob ^ (((ob >> 9) & 1) << 5)); }
__host__ __device__ __forceinline__ void stage_rc(int b, int& R, int& C) { const int st = b / 1024, sb = b % 1024, swz = sb ^ (((sb >> 9) & 1) << 5); R = (st >> 1) * 16 + swz / 64; C = (st & 1) * 32 + (swz % 64) / 2; }
__host__ __device__ __forceinline__ int perm32(int rho) { const int n = rho >> 4, i = rho & 15; return 8 * (i >> 2) + 4 * n + (i & 3); }

struct Unit { int pm, pn, ko, ks; };
struct Gemm { const bf16_t* A; const bf16_t* Bt; int M, N, K, lda, ldb; };

struct StaticOrder {
    int nM, nN, nwg, G, c;
    __host__ __device__ void init(int M, int N, int G_, int c_) { nM = M / BM; nN = N / BM; nwg = nM * nN; G = G_; c = c_; }
    __host__ __device__ bool next(int i, Unit& u) const {
        const long L = (long)i * G + c; if (L >= nwg) return false;
        int wgid = (int)L; { const int q = nwg / NXCD, r = nwg % NXCD, xcd = wgid % NXCD, off = wgid / NXCD; wgid = (xcd < r ? xcd * (q + 1) : r * (q + 1) + (xcd - r) * q) + off; }
        const int nig = WGM * nN, gid = wgid / nig, fm = gid * WGM, gsz = (nM - fm) < WGM ? (nM - fm) : WGM;
        u.pm = fm + ((wgid % nig) % gsz); u.pn = (wgid % nig) / gsz; u.ko = 0; u.ks = 0; return true;
    }
    __device__ __forceinline__ void a_ready(const Unit&) const {}
    __device__ __forceinline__ void done(const Unit&) const {}
};
struct SplitOrder {
    int nN, nitems, kslice, c;
    __host__ __device__ void init(int M, int N, int Kslice, int c_) { nN = N / BM; nitems = (M / BM) * nN * 8; kslice = Kslice; c = c_; }
    __host__ __device__ bool next(int i, Unit& u) const { if (i > 0 || c >= nitems) return false; u.ks = c & 7; u.ko = u.ks * kslice; u.pn = (c >> 3) % nN; u.pm = (c >> 3) / nN; return true; }
    __device__ __forceinline__ void a_ready(const Unit&) const {}
    __device__ __forceinline__ void done(const Unit&) const {}
};

__device__ __forceinline__ unsigned cvt_pk_bf16(float lo, float hi) { unsigned r; asm volatile("v_cvt_pk_bf16_f32 %0, %1, %2" : "=v"(r) : "v"(lo), "v"(hi)); return r; }

struct EpiF32 {
    static constexpr bool PERM = false, AFTER_DRAIN = false;
    float* C; int ldc; size_t split_stride;
    __device__ __forceinline__ void operator()(const f32x4 (&acc)[2][2][4][2], const Unit& u, int wr, int wc, int fr, int fq) const {
        const int row0 = u.pm * BM + wr * 64 + fr, col0 = u.pn * BM + wc * 32 + 4 * fq; float* Cb = C + (size_t)u.ks * split_stride;
#pragma unroll
        for (int ai = 0; ai < 2; ++ai)
#pragma unroll
            for (int m = 0; m < 4; ++m) { float* rowp = Cb + (size_t)(row0 + ai * HALF + m * 16) * ldc + col0;
#pragma unroll
                for (int bj = 0; bj < 2; ++bj)
#pragma unroll
                    for (int n = 0; n < 2; ++n) *(f32x4*)(rowp + bj * HALF + n * 16) = acc[ai][bj][m][n]; }
    }
};
template <int ACT> struct EpiBf16 {
    static constexpr bool PERM = true, AFTER_DRAIN = false;
    bf16_t* O; int ldc; const float* rowscale;
    __device__ __forceinline__ void operator()(const f32x4 (&acc)[2][2][4][2], const Unit& u, int wr, int wc, int fr, int fq) const {
        const int row0 = u.pm * BM + wr * 64 + fr; const int col0 = u.pn * BM + wc * 32 + 8 * fq;
#pragma unroll
        for (int ai = 0; ai < 2; ++ai)
#pragma unroll
            for (int m = 0; m < 4; ++m) { const int row = row0 + ai * HALF + m * 16; bf16_t* rowp = O + (size_t)row * ldc + col0;
                float rs = 1.f; if (ACT == 2) rs = rowscale[row];
#pragma unroll
                for (int bj = 0; bj < 2; ++bj) { f32x4 v0 = acc[ai][bj][m][0], v1 = acc[ai][bj][m][1];
                    if (ACT == 1) {
#pragma unroll
                        for (int j = 0; j < 4; ++j) { const float a = fmaxf(v0[j], 0.f), b = fmaxf(v1[j], 0.f); v0[j] = a * a; v1[j] = b * b; } }
                    if (ACT == 2) { v0 = v0 * rs; v1 = v1 * rs; }
                    if (ACT == 3) { const u32x4 o = *(const u32x4*)(rowp + bj * HALF);
                        v0[0] += __builtin_bit_cast(float, o.x << 16); v0[1] += __builtin_bit_cast(float, o.x & 0xffff0000u); v0[2] += __builtin_bit_cast(float, o.y << 16); v0[3] += __builtin_bit_cast(float, o.y & 0xffff0000u);
                        v1[0] += __builtin_bit_cast(float, o.z << 16); v1[1] += __builtin_bit_cast(float, o.z & 0xffff0000u); v1[2] += __builtin_bit_cast(float, o.w << 16); v1[3] += __builtin_bit_cast(float, o.w & 0xffff0000u); }
                    u32x4 w; w.x = cvt_pk_bf16(v0[0], v0[1]); w.y = cvt_pk_bf16(v0[2], v0[3]); w.z = cvt_pk_bf16(v1[0], v1[1]); w.w = cvt_pk_bf16(v1[2], v1[3]);
                    *(u32x4*)(rowp + bj * HALF) = w; } }
    }
};

template <class Epi, class Sched, bool ALIGN_EPI = false, bool SP2 = false>
__device__ __forceinline__ void gemm_phase(PG8_LAS unsigned char* lds, const Gemm g, const Sched& S, const Epi& E) {
    int tid = threadIdx.x; asm volatile("" : "+v"(tid));
    const int wid = __builtin_amdgcn_readfirstlane(tid >> 6), lane = tid & 63, wr = wid >> 2, wc = wid & 3, fr = lane & 15, fq = lane >> 4;
    const int K = g.K, nt = K / BK, lda = g.lda, ldb = g.ldb;
    unsigned voffA[2], voffB[2];
#pragma unroll
    for (int i = 0; i < 2; ++i) { int R, C; stage_rc(tid * 16 + i * 8192, R, C); const int Rb = Epi::PERM ? ((R & ~31) + perm32(R & 31)) : R;
        voffA[i] = (unsigned)(R * lda + C) * 2u; voffB[i] = (unsigned)(Rb * ldb + C) * 2u; }
    const size_t kstep = (size_t)(BK * 2);
    const size_t hstepA = (size_t)HALF * lda * 2, hstepB = (size_t)HALF * ldb * 2;
    const size_t tstepA = 2 * hstepA, tstepB = 2 * hstepB;
    const unsigned ldsw = (unsigned)wid * 1024u;
    const int aoff = lds_byte(wr * 64 + fr, fq * 8), boff = lds_byte(wc * 32 + fr, fq * 8);
#define PG8_SA(b, h) (((b) * 2 + (h)) * HTB)
#define PG8_SB(b, h) ((4 + (b) * 2 + (h)) * HTB)
#define PG8_STAGE(bufoff, gbase, voff) do { _Pragma("unroll") for (int _i = 0; _i < 2; ++_i) \
        __builtin_amdgcn_global_load_lds((const unsigned*)((const char*)(gbase) + (voff)[_i]), (PG8_LAS unsigned*)(lds + (bufoff) + ldsw + _i * 8192), 16, 0, 0); } while (0)
#define PG8_LDA(dst, b, h) do { _Pragma("unroll") for (int m = 0; m < 4; ++m) _Pragma("unroll") for (int k = 0; k < 2; ++k) dst[m][k] = *(const PG8_LAS bf16x8*)(lds + PG8_SA(b, h) + aoff + m * 2048 + k * 1024); } while (0)
#define PG8_LDB(dst, b, h) do { _Pragma("unroll") for (int n = 0; n < 2; ++n) _Pragma("unroll") for (int k = 0; k < 2; ++k) dst[n][k] = *(const PG8_LAS bf16x8*)(lds + PG8_SB(b, h) + boff + n * 2048 + k * 1024); } while (0)
#define PG8_MMA(ai, bj, At, Bt) do { __builtin_amdgcn_s_setprio(1); _Pragma("unroll") for (int m = 0; m < 4; ++m) _Pragma("unroll") for (int n = 0; n < 2; ++n) _Pragma("unroll") for (int k = 0; k < 2; ++k) \
        acc[ai][bj][m][n] = __builtin_amdgcn_mfma_f32_16x16x32_bf16(Bt[n][k], At[m][k], acc[ai][bj][m][n], 0, 0, 0); __builtin_amdgcn_s_setprio(0); } while (0)
#define PG8_WAIT_V(n) asm volatile("s_waitcnt vmcnt(" #n ")" ::: "memory")
#define PG8_WAIT_L(n) asm volatile("s_waitcnt lgkmcnt(" #n ")" ::: "memory")
#define PG8_BAR __builtin_amdgcn_s_barrier()
#define PG8_SCHED __builtin_amdgcn_sched_barrier(0)
    Unit cur, nxt; int ui = 0;
    if (!S.next(0, cur)) return;
    f32x4 acc[2][2][4][2];
#pragma unroll
    for (int a = 0; a < 2; ++a)
#pragma unroll
        for (int b = 0; b < 2; ++b)
#pragma unroll
            for (int m = 0; m < 4; ++m)
#pragma unroll
                for (int n = 0; n < 2; ++n) acc[a][b][m][n] = (f32x4){0.f, 0.f, 0.f, 0.f};
    bf16x8 At[4][2], B0[2][2], B1[2][2];
    const char* cA = (const char*)g.A + (size_t)cur.pm * tstepA + (size_t)cur.ko * 2; const char* cB = (const char*)g.Bt + (size_t)cur.pn * tstepB + (size_t)cur.ko * 2;
    S.a_ready(cur);
    if constexpr (SP2) {
        PG8_STAGE(PG8_SB(0, 0), cB, voffB); PG8_STAGE(PG8_SB(0, 1), cB + hstepB, voffB); PG8_STAGE(PG8_SA(0, 0), cA, voffA); PG8_STAGE(PG8_SA(0, 1), cA + hstepA, voffA);
        if (wr == 1) PG8_BAR;
        PG8_WAIT_V(2); PG8_BAR;
        PG8_STAGE(PG8_SB(1, 0), cB + kstep, voffB); PG8_STAGE(PG8_SA(1, 0), cA + kstep, voffA); PG8_STAGE(PG8_SB(1, 1), cB + hstepB + kstep, voffB);
        PG8_WAIT_V(6); PG8_BAR;
    } else {
        PG8_STAGE(PG8_SB(0, 0), cB, voffB); PG8_STAGE(PG8_SA(0, 0), cA, voffA); PG8_STAGE(PG8_SB(0, 1), cB + hstepB, voffB); PG8_STAGE(PG8_SA(0, 1), cA + hstepA, voffA);
        if (wr == 1) PG8_BAR;
        PG8_WAIT_V(4); PG8_BAR;
        PG8_STAGE(PG8_SB(1, 0), cB + kstep, voffB); PG8_STAGE(PG8_SA(1, 0), cA + kstep, voffA); PG8_STAGE(PG8_SB(1, 1), cB + hstepB + kstep, voffB);
        PG8_WAIT_V(6); PG8_BAR;
    }
    for (;;) {
        const bool has_next = S.next(ui + 1, nxt);
        const char* nA = has_next ? (const char*)g.A + (size_t)nxt.pm * tstepA + (size_t)nxt.ko * 2 : cA; const char* nB = has_next ? (const char*)g.Bt + (size_t)nxt.pn * tstepB + (size_t)nxt.ko * 2 : cB;
        for (int t = 0; t < nt; t += 2) {
            const bool last = (t == nt - 2);
            const char* a1 = cA + (size_t)(t + 1) * kstep;
            const char* a2 = last ? nA : cA + (size_t)(t + 2) * kstep; const char* b2 = last ? nB : cB + (size_t)(t + 2) * kstep;
            const char* a3 = a2 + kstep; const char* b3 = b2 + kstep;
            if (last && has_next) S.a_ready(nxt);
            if constexpr (SP2) {
            PG8_LDB(B0, 0, 0); PG8_LDB(B1, 0, 1); PG8_SCHED; PG8_LDA(At, 0, 0); PG8_STAGE(PG8_SA(1, 1), a1 + hstepA, voffA);
            PG8_WAIT_V(8); PG8_WAIT_L(0); PG8_BAR; PG8_MMA(0, 0, At, B0); PG8_MMA(0, 1, At, B1); PG8_BAR; PG8_SCHED;
            PG8_LDA(At, 0, 1); PG8_STAGE(PG8_SB(0, 0), b2, voffB); PG8_STAGE(PG8_SB(0, 1), b2 + hstepB, voffB); PG8_STAGE(PG8_SA(0, 0), a2, voffA);
            PG8_WAIT_V(8); PG8_WAIT_L(0); PG8_BAR; PG8_MMA(1, 0, At, B0); PG8_MMA(1, 1, At, B1); PG8_BAR; PG8_SCHED;
            PG8_LDB(B0, 1, 0); PG8_LDB(B1, 1, 1); PG8_SCHED; PG8_LDA(At, 1, 0); PG8_STAGE(PG8_SA(0, 1), a2 + hstepA, voffA);
            PG8_WAIT_V(8); PG8_WAIT_L(0); PG8_BAR; PG8_MMA(0, 0, At, B0); PG8_MMA(0, 1, At, B1); PG8_BAR; PG8_SCHED;
            PG8_LDA(At, 1, 1); PG8_STAGE(PG8_SB(1, 0), b3, voffB); PG8_STAGE(PG8_SB(1, 1), b3 + hstepB, voffB); PG8_STAGE(PG8_SA(1, 0), a3, voffA);
            PG8_WAIT_V(8); PG8_WAIT_L(0); PG8_BAR; PG8_MMA(1, 0, At, B0); PG8_MMA(1, 1, At, B1); PG8_BAR; PG8_SCHED;
            } else {
            PG8_LDB(B0, 0, 0); PG8_SCHED; PG8_LDA(At, 0, 0); PG8_STAGE(PG8_SA(1, 1), a1 + hstepA, voffA);
            PG8_WAIT_L(8); PG8_BAR; PG8_WAIT_L(0); PG8_MMA(0, 0, At, B0); PG8_BAR; PG8_SCHED;
            PG8_LDB(B1, 0, 1); PG8_STAGE(PG8_SB(0, 0), b2, voffB);
            PG8_BAR; PG8_WAIT_L(0); PG8_MMA(0, 1, At, B1); PG8_BAR;
            PG8_LDA(At, 0, 1); PG8_STAGE(PG8_SA(0, 0), a2, voffA);
            PG8_BAR; PG8_WAIT_L(0); PG8_MMA(1, 0, At, B0); PG8_BAR; PG8_SCHED;
            PG8_STAGE(PG8_SB(0, 1), b2 + hstepB, voffB);
            PG8_WAIT_V(6); PG8_BAR; PG8_MMA(1, 1, At, B1); PG8_BAR;
            PG8_LDB(B0, 1, 0); PG8_SCHED; PG8_LDA(At, 1, 0); PG8_STAGE(PG8_SA(0, 1), a2 + hstepA, voffA);
            PG8_WAIT_L(8); PG8_BAR; PG8_WAIT_L(0); PG8_MMA(0, 0, At, B0); PG8_BAR; PG8_SCHED;
            PG8_LDB(B1, 1, 1); PG8_STAGE(PG8_SB(1, 0), b3, voffB);
            PG8_BAR; PG8_WAIT_L(0); PG8_MMA(0, 1, At, B1); PG8_BAR;
            PG8_LDA(At, 1, 1); PG8_STAGE(PG8_SA(1, 0), a3, voffA);
            PG8_BAR; PG8_WAIT_L(0); PG8_MMA(1, 0, At, B0); PG8_BAR; PG8_SCHED;
            PG8_STAGE(PG8_SB(1, 1), b3 + hstepB, voffB);
            PG8_WAIT_V(6); PG8_BAR; PG8_MMA(1, 1, At, B1); PG8_BAR;
            }
        }
        if constexpr (ALIGN_EPI) { if (wr == 0) PG8_BAR; }
        E(acc, cur, wr, wc, fr, fq); S.done(cur);
        if (!has_next) break;
#pragma unroll
        for (int a = 0; a < 2; ++a)
#pragma unroll
            for (int b = 0; b < 2; ++b)
#pragma unroll
                for (int m = 0; m < 4; ++m)
#pragma unroll
                    for (int n = 0; n < 2; ++n) acc[a][b][m][n] = (f32x4){0.f, 0.f, 0.f, 0.f};
        cur = nxt; cA = nA; cB = nB; ++ui;
        if constexpr (ALIGN_EPI) { if (wr == 1) PG8_BAR; }
    }
    PG8_WAIT_V(0);
    if constexpr (!ALIGN_EPI) { if (wr == 0) PG8_BAR; }
    PG8_BAR;
#undef PG8_SA
#undef PG8_SB
#undef PG8_STAGE
#undef PG8_LDA
#undef PG8_LDB
#undef PG8_MMA
#undef PG8_WAIT_V
#undef PG8_WAIT_L
#undef PG8_BAR
#undef PG8_SCHED
}
}

constexpr int NWAVES = 8, NTHR = 512;
constexpr int DM = 4096, NB = 2, SEQ = 8192, NCTX = 256, DFF = 16384;
constexpr int M_LAT = NB * SEQ, M_CTX = NB * NCTX, M_TOT = M_LAT + M_CTX;
constexpr int DIN = 8672, DINP = 8704;
constexpr int C_SWAQ = 0, C_SWAK = 1024, C_SWAV = 1280, C_LRUX = 1536, C_LRUY = 2560, C_QA = 3584, C_KVA = 4608, C_KR = 5120, C_RW = 5184;
constexpr int C_RWR = C_RW, C_RWK = C_RW + 1024, C_RWV = C_RW + 2048, C_RWL = C_RW + 3072;
constexpr int RWC = 3488;
constexpr float LN_EPS = 1e-5f, RMS_EPS = 1e-6f, GN_EPS = 64e-5f, ALPHA = 1.41421356237f;
constexpr int NCH = 264;

constexpr size_t MiB = 1u << 20;
constexpr size_t WS_CTL = 0, CTL_ZERO_BYTES = 1 * MiB;
constexpr size_t WS_MOD = 1 * MiB;
constexpr size_t WS_MODP = 2 * MiB;
constexpr size_t WS_SMALL = 20 * MiB;
constexpr size_t WS_RSQ = WS_SMALL;
constexpr size_t WS_RSKV = WS_RSQ + 128 * 1024;
constexpr size_t WS_SB = WS_RSKV + 128 * 1024;
constexpr size_t WS_CA = WS_SB + 2 * MiB;
constexpr size_t WS_CB = WS_CA + 5 * MiB;
constexpr size_t WS_HIN = WS_CB + 5 * MiB;
constexpr size_t WS_QUIRK = WS_HIN + 5 * MiB;
constexpr size_t WS_ROPE = WS_QUIRK + 8192;
static_assert(WS_ROPE + 16384 <= 40 * MiB, "small region");
constexpr size_t WS_W = 40 * MiB;
constexpr size_t WS_WIN = WS_W, WS_WOUT = WS_WIN + 68 * MiB, WS_WFF1 = WS_WOUT + 32 * MiB, WS_WFF2 = WS_WFF1 + 128 * MiB, WS_WQB = WS_WFF2 + 128 * MiB,
                 WS_WKVB = WS_WQB + 3 * MiB, WS_WLRU = WS_WKVB + 2 * MiB, WS_WLORA = WS_WLRU + 1 * MiB;
constexpr size_t WS_W2T = WS_WLORA, WS_A2T = WS_W2T + 256 * 1024, WS_G2T = WS_A2T + 256 * 1024;
constexpr size_t WS_X = 403 * MiB;
constexpr size_t WS_H = 667 * MiB;
constexpr size_t WS_MIX = 799 * MiB;
constexpr size_t WS_YS = 931 * MiB;
constexpr size_t WS_P = 1063 * MiB;
constexpr size_t WS_RWF = 1344 * MiB;
constexpr size_t RWF_STRIDE = (size_t)M_TOT * 1024 * 2;
constexpr size_t WS_Q = 1641 * MiB;
constexpr size_t WS_KV = 1691 * MiB;
constexpr size_t WS_KR = 1757 * MiB;
constexpr size_t WS_SET2 = 1760 * MiB;
constexpr size_t WSET_STRIDE = WS_SET2 - WS_W;
constexpr size_t WS_END = WS_SET2 + 363 * MiB;
constexpr size_t WS_YP = WS_Q;
constexpr size_t WS_HID = WS_P;
constexpr size_t WS_Y1 = WS_P;
constexpr size_t WS_Y2 = WS_MIX;
static_assert(WS_WLORA + 1 * MiB <= WS_X && WS_P + (size_t)M_TOT * DINP * 2 <= WS_RWF && WS_RWF + 9 * RWF_STRIDE <= WS_Q, "ws map");
static_assert(WS_HID + (size_t)M_TOT * DFF * 2 <= WS_Q && WS_Y2 + (size_t)M_TOT * DM * 4 <= WS_P && WS_YS + 2 * (size_t)M_TOT * 1024 * 4 <= WS_P, "ws overlays");
static_assert(WS_KR + (size_t)M_TOT * 64 * 2 <= WS_SET2 && WS_YP + 8 * (size_t)M_CTX * DM * 4 <= WS_KR, "ws end");

constexpr int RING_BYTES = 131072;
constexpr int LDSCTL_OFF = RING_BYTES, MISC_OFF = LDSCTL_OFF + 320;
constexpr int LDS_BYTES = 147456;

#define GAS __attribute__((address_space(1)))
#define LAS __attribute__((address_space(3)))
typedef unsigned short bf16;
typedef unsigned v4u __attribute__((ext_vector_type(4)));
typedef unsigned v2u __attribute__((ext_vector_type(2)));
typedef float f32x4 __attribute__((ext_vector_type(4)));
typedef float f32x2 __attribute__((ext_vector_type(2)));
typedef float f32x16 __attribute__((ext_vector_type(16)));
typedef short bf16x8 __attribute__((ext_vector_type(8)));
typedef short s16x4 __attribute__((ext_vector_type(4)));
typedef GAS unsigned gu32;
typedef const GAS bf16* gcbf; typedef GAS bf16* gbfp; typedef const GAS float* gcfl; typedef GAS float* gflp;
#define LDS_WAIT() asm volatile("s_waitcnt lgkmcnt(0)" ::: "memory")
#define VM_WAIT() asm volatile("s_waitcnt vmcnt(0)" ::: "memory")
__device__ __forceinline__ unsigned f2bf(float f) { unsigned u = __builtin_bit_cast(unsigned, f); return (u + 0x7fffu + ((u >> 16) & 1u)) >> 16; }
__device__ __forceinline__ unsigned pk2(float lo, float hi) { return f2bf(lo) | (f2bf(hi) << 16); }
__device__ __forceinline__ float bflo(unsigned w) { return __builtin_bit_cast(float, w << 16); }
__device__ __forceinline__ float bfhi(unsigned w) { return __builtin_bit_cast(float, w & 0xffff0000u); }
__device__ __forceinline__ float bf2f(bf16 h) { return __builtin_bit_cast(float, (unsigned)h << 16); }
#define DPP_ADD(x, ctrl) ((x) + __builtin_bit_cast(float, __builtin_amdgcn_update_dpp(0, __builtin_bit_cast(int, (x)), (ctrl), 0xf, 0xf, false)))
__device__ __forceinline__ float row_sum16(float x) { x = DPP_ADD(x, 0x128); x = DPP_ADD(x, 0x124); x = DPP_ADD(x, 0x122); x = DPP_ADD(x, 0x121); return x; }
#ifdef OLD_SUMS
__device__ __forceinline__ float wave_sum(float v) {
#pragma unroll
    for (int o = 1; o < 64; o <<= 1) v += __shfl_xor(v, o);
    return v;
}
__device__ __forceinline__ float half_swap_sum(float x) { return x + __shfl_xor(x, 32); }
__device__ __forceinline__ float quad_sum(float x) { x += __shfl_xor(x, 1); x += __shfl_xor(x, 2); return x; }
#else
__device__ __forceinline__ float wave_sum(float v) {
    const float r = row_sum16(v);
    const float a = __builtin_bit_cast(float, __builtin_amdgcn_readlane(__builtin_bit_cast(int, r), 0)), b = __builtin_bit_cast(float, __builtin_amdgcn_readlane(__builtin_bit_cast(int, r), 16));
    const float c = __builtin_bit_cast(float, __builtin_amdgcn_readlane(__builtin_bit_cast(int, r), 32)), d = __builtin_bit_cast(float, __builtin_amdgcn_readlane(__builtin_bit_cast(int, r), 48));
    return (a + b) + (c + d);
}
__device__ __forceinline__ float half_swap_sum(float x) {
    unsigned a = __builtin_bit_cast(unsigned, x), b = a; asm volatile("" : "+v"(b));
    auto rr = __builtin_amdgcn_permlane32_swap(a, b, false, false);
    const float lo = __uint_as_float(rr[0]), hi = __uint_as_float(rr[1]); return lo + hi;
}
__device__ __forceinline__ float quad_sum(float x) { x = DPP_ADD(x, 0xB1); x = DPP_ADD(x, 0x4E); return x; }
#endif
__device__ __forceinline__ float sigmoidf_(float x) { return 1.f / (1.f + __expf(-x)); }
__device__ __forceinline__ float softplusf_(float x) { return x > 20.f ? x : __logf(1.f + __expf(x)); }
__device__ __forceinline__ float tanhf_(float x) { const float e = __expf(2.f * x); return 1.f - 2.f / (e + 1.f); }
__device__ __forceinline__ int ltid() { int t = threadIdx.x; asm volatile("" : "+v"(t)); return t; }
template <class T> __device__ __forceinline__ T ldg(const void* base, unsigned byteoff) { return *(const T*)((const char*)base + byteoff); }
template <class T> __device__ __forceinline__ void stg(void* base, unsigned byteoff, T v) { *(T*)((char*)base + byteoff) = v; }

#define XB_TMO      128
#define XB_XCNT(j)  (256  + 64 * (j))
#define XB_XSUB(j)  (1280 + 64 * (j))
#define XB_XGEN(j)  (2304 + 64 * (j))
#define XB_TOP      3328
#define XB_TOPGEN   3392
#define XCD_BAR_WORDS 3456
#define XB_SPIN_CAP (1u << 18)

__device__ __forceinline__ unsigned xb_ld(unsigned* p)              { return __hip_atomic_load(p, __ATOMIC_RELAXED, __HIP_MEMORY_SCOPE_AGENT); }
__device__ __forceinline__ unsigned xb_add(unsigned* p, unsigned v) { return __hip_atomic_fetch_add(p, v, __ATOMIC_RELAXED, __HIP_MEMORY_SCOPE_AGENT); }
__device__ __forceinline__ unsigned xb_xcc_id() { return (unsigned)__builtin_amdgcn_s_getreg((3 << 11) | 20) & 0xFu; }
#define XB_SPIN(cond, bar) do { unsigned _sp = 0; while (cond) { __builtin_amdgcn_s_sleep(1); \
    if ((++_sp & 255u) == 0u) { if (xb_ld(&(bar)[XB_TMO])) break; if (_sp > XB_SPIN_CAP) { atomicAdd(&(bar)[XB_TMO], 1u); break; } } } } while (0)

struct XcdBarrier {
    unsigned* bar; unsigned x;
    unsigned nparts;
    volatile LAS unsigned* st;
};

__device__ __forceinline__ XcdBarrier xcd_barrier_post(unsigned* bar, volatile LAS unsigned* st) {
    XcdBarrier b; b.bar = bar; b.x = xb_xcc_id(); b.st = st; b.nparts = 0u;
    if (threadIdx.x == 0) (void)xb_add(&bar[XB_XCNT(b.x)], 1u);
    return b;
}
__device__ __forceinline__ void xcd_barrier_complete(unsigned* bar, unsigned x, unsigned& nloc, unsigned& nx, unsigned nparts) {
    const unsigned G = nparts ? nparts : gridDim.x * gridDim.y * gridDim.z;
    unsigned sum, cnt, mine, sp = 0u;
    for (;;) {
        sum = 0u; cnt = 0u; mine = 0u;
#pragma unroll
        for (unsigned j = 0; j < 16; ++j) { const unsigned c = xb_ld(&bar[XB_XCNT(j)]); sum += c; cnt += (c > 0u) ? 1u : 0u; mine = (j == x) ? c : mine; }
        if (sum == G) break;
        __builtin_amdgcn_s_sleep(1);
        if ((++sp & 255u) == 0u) { if (xb_ld(&bar[XB_TMO])) break; if (sp > XB_SPIN_CAP) { atomicAdd(&bar[XB_TMO], 1u); break; } }
    }
    nloc = mine > 0u ? mine : 1u; nx = cnt > 0u ? cnt : 1u;
}

__device__ __forceinline__ void xcd_barrier(const XcdBarrier& b) {
    asm volatile("s_waitcnt vmcnt(0)" ::: "memory");
    __syncthreads();
    if (threadIdx.x == 0) {
        unsigned* bar = b.bar;
        __builtin_amdgcn_s_waitcnt(0);
        unsigned nloc = b.st[0], nx = b.st[1];
        if (nloc == 0u) { xcd_barrier_complete(bar, b.x, nloc, nx, b.nparts); b.st[0] = nloc; b.st[1] = nx; }
        const unsigned old = xb_add(&bar[XB_XSUB(b.x)], 1u);
        const unsigned gen = old / nloc;
        if (old + 1u == (gen + 1u) * nloc) {
            __builtin_amdgcn_fence(__ATOMIC_RELEASE, "agent");
            asm volatile("s_waitcnt vmcnt(0)" ::: "memory");
            const unsigned og = xb_add(&bar[XB_TOP], 1u);
            const unsigned tg = og / nx;
            if (og + 1u == (tg + 1u) * nx) xb_add(&bar[XB_TOPGEN], 1u);
            else XB_SPIN(xb_ld(&bar[XB_TOPGEN]) == tg, bar);
            __builtin_amdgcn_fence(__ATOMIC_ACQUIRE, "agent");
            xb_add(&bar[XB_XGEN(b.x)], 1u);
            asm volatile("s_waitcnt vmcnt(0)" ::: "memory");
        } else {
            XB_SPIN(xb_ld(&bar[XB_XGEN(b.x)]) == gen, bar);
            __builtin_amdgcn_fence(__ATOMIC_ACQUIRE, "agent");
            asm volatile("s_waitcnt vmcnt(0)" ::: "memory");
        }
    }
    __syncthreads();
}


namespace att {
constexpr int KVBLK = 64;
constexpr float THR = 8.f;
#define SBAR() __builtin_amdgcn_sched_barrier(0)
__device__ __forceinline__ int crow(int r, int hi) { return (r & 3) + 8 * (r >> 2) + 4 * hi; }
__device__ __forceinline__ unsigned cvtpk(float lo, float hi) { unsigned r; asm volatile("v_cvt_pk_bf16_f32 %0, %1, %2" : "=v"(r) : "v"(lo), "v"(hi)); return r; }
template <int DQK> __device__ __forceinline__ int kswz(int row, int cb) { return row * (DQK * 2 + 16) + cb; }

template <int DQK> __device__ __forceinline__ void partialSM(f32x16& p0, f32x16& p1, float& m_reg, float& mn, float& alpha) {
  constexpr float SCALE = DQK == 128 ? 0.088388347648318440f : 0.072168783648703220f;
  constexpr float C = SCALE * 1.4426950408889634f;
  float pmax = p0[0];
#pragma unroll
  for (int r = 1; r < 16; ++r) pmax = fmaxf(pmax, p0[r]);
#pragma unroll
  for (int r = 0; r < 16; ++r) pmax = fmaxf(pmax, p1[r]);
  { auto rr = __builtin_amdgcn_permlane32_swap(__float_as_uint(pmax), __float_as_uint(pmax), false, false);
    pmax = fmaxf(__uint_as_float(rr[0]), __uint_as_float(rr[1])); }
  if (__builtin_expect(__all(pmax - m_reg <= THR / SCALE), 1)) { mn = m_reg; alpha = 1.f; }
  else { mn = fmaxf(m_reg, pmax); alpha = __builtin_amdgcn_exp2f((m_reg - mn) * C); m_reg = mn; }
  const float mnC = -mn * C;
#pragma unroll
  for (int r = 0; r < 16; ++r) p0[r] = fmaf(p0[r], C, mnC);
#pragma unroll
  for (int r = 0; r < 16; ++r) p1[r] = fmaf(p1[r], C, mnC);
#pragma unroll
  for (int r = 0; r < 16; ++r) p0[r] = __builtin_amdgcn_exp2f(p0[r]);
}
__device__ __forceinline__ void finishSM(f32x16& p0, f32x16& p1, float alpha, float& l_reg, bf16x8& pa0, bf16x8& pa1, bf16x8& pa2, bf16x8& pa3) {
#pragma unroll
  for (int r = 0; r < 16; ++r) p1[r] = __builtin_amdgcn_exp2f(p1[r]);
  float ps = 0;
#pragma unroll
  for (int r = 0; r < 16; ++r) ps += p0[r];
#pragma unroll
  for (int r = 0; r < 16; ++r) ps += p1[r];
  { auto rr = __builtin_amdgcn_permlane32_swap(__float_as_uint(ps), __float_as_uint(ps), false, false);
    ps = __uint_as_float(rr[0]) + __uint_as_float(rr[1]); }
  l_reg = l_reg * alpha + ps;
#define PK4(P, BASE, OUT) do { unsigned a0 = cvtpk(P[BASE + 0], P[BASE + 1]), a1 = cvtpk(P[BASE + 2], P[BASE + 3]);   \
    unsigned b0 = cvtpk(P[BASE + 4], P[BASE + 5]), b1 = cvtpk(P[BASE + 6], P[BASE + 7]);                              \
    auto r0 = __builtin_amdgcn_permlane32_swap(a0, b0, false, false); auto r1 = __builtin_amdgcn_permlane32_swap(a1, b1, false, false); \
    v4u w = {r0[0], r1[0], r0[1], r1[1]}; OUT = __builtin_bit_cast(bf16x8, w); } while (0)
  PK4(p0, 0, pa0); PK4(p0, 8, pa1); PK4(p1, 0, pa2); PK4(p1, 8, pa3);
#undef PK4
}
template <int DQK> __device__ __forceinline__ void qkt(f32x16& p0, f32x16& p1, const LAS char* Ks, const bf16x8* qr, const LAS char* qx, int r32, int hi) {
  p0 = f32x16{}; p1 = f32x16{};
#pragma unroll
  for (int d0 = 0; d0 < DQK / 16; ++d0) { const int cb = (d0 * 16 + hi * 8) * 2;
    bf16x8 b0 = *(const LAS bf16x8*)(Ks + kswz<DQK>(r32, cb));
    bf16x8 b1 = *(const LAS bf16x8*)(Ks + kswz<DQK>(32 + r32, cb));
    bf16x8 q; if (d0 < 8) q = qr[d0]; else q = *(const LAS bf16x8*)(qx + (d0 - 8) * 32);
    p0 = __builtin_amdgcn_mfma_f32_32x32x16_bf16(b0, q, p0, 0, 0, 0);
    p1 = __builtin_amdgcn_mfma_f32_32x32x16_bf16(b1, q, p1, 0, 0, 0);
    if ((d0 & 3) == 3 && d0 + 1 < DQK / 16) SBAR(); }
}
__device__ __forceinline__ int v_st(int k, int c) { const int kk = (k & ~0xC) | ((k & 4) << 1) | ((k & 8) >> 1); return ((kk >> 3) * 4 + (c >> 5)) * 512 + ((kk & 7) * 32 + (c & 31)) * 2; }
__device__ __forceinline__ int v_rd_base(int lane) { return ((lane & 3) << 3) | (((lane >> 2) & 3) << 6) | (((lane >> 4) & 1) << 5) | (((lane >> 5) & 1) << 8); }
constexpr int v_rd_off(int d0, int ks, int half) { return d0 * 512 + ks * 4096 + half * 2048; }
template <int OFF> __device__ __forceinline__ s16x4 tr_read(int vb) {
  s16x4 r; asm volatile("ds_read_b64_tr_b16 %0, %1 offset:%2" : "=&v"(r) : "v"(vb), "i"(OFF) : "memory"); return r;
}
template <int D0> __device__ __forceinline__ void pv_one(f32x16& od, int vb, bf16x8 pa0, bf16x8 pa1, bf16x8 pa2, bf16x8 pa3) {
  const s16x4 l0 = tr_read<v_rd_off(D0, 0, 0)>(vb), h0 = tr_read<v_rd_off(D0, 0, 1)>(vb), l1 = tr_read<v_rd_off(D0, 1, 0)>(vb), h1 = tr_read<v_rd_off(D0, 1, 1)>(vb);
  const s16x4 l2 = tr_read<v_rd_off(D0, 2, 0)>(vb), h2 = tr_read<v_rd_off(D0, 2, 1)>(vb), l3 = tr_read<v_rd_off(D0, 3, 0)>(vb), h3 = tr_read<v_rd_off(D0, 3, 1)>(vb);
  asm volatile("s_waitcnt lgkmcnt(0)" ::: "memory"); SBAR();
#define PK(L, H) (bf16x8){L[0], L[1], L[2], L[3], H[0], H[1], H[2], H[3]}
  od = __builtin_amdgcn_mfma_f32_32x32x16_bf16(pa0, PK(l0, h0), od, 0, 0, 0);
  od = __builtin_amdgcn_mfma_f32_32x32x16_bf16(pa1, PK(l1, h1), od, 0, 0, 0);
  od = __builtin_amdgcn_mfma_f32_32x32x16_bf16(pa2, PK(l2, h2), od, 0, 0, 0);
  od = __builtin_amdgcn_mfma_f32_32x32x16_bf16(pa3, PK(l3, h3), od, 0, 0, 0);
#undef PK
}
__device__ __forceinline__ void pv_d0(f32x16* o, int vb, bf16x8 pa0, bf16x8 pa1, bf16x8 pa2, bf16x8 pa3) {
  pv_one<0>(o[0], vb, pa0, pa1, pa2, pa3); pv_one<1>(o[1], vb, pa0, pa1, pa2, pa3); pv_one<2>(o[2], vb, pa0, pa1, pa2, pa3); pv_one<3>(o[3], vb, pa0, pa1, pa2, pa3);
}
__device__ __forceinline__ void apply_mask(f32x16& p0, f32x16& p1, int mtype, int krel0, int qi, int hi) {
  if (mtype == 0) return;
  const float ninf = -__builtin_inff();
#pragma unroll
  for (int r = 0; r < 16; ++r) { const int k0 = krel0 + crow(r, hi), k1 = k0 + 32;
    const bool ok0 = (mtype == 1) ? (k0 >= qi - 128) : (k0 <= qi + 128), ok1 = (mtype == 1) ? (k1 >= qi - 128) : (k1 <= qi + 128);
    p0[r] = ok0 ? p0[r] : ninf; p1[r] = ok1 ? p1[r] : ninf; }
}
struct Tile { gcbf kn; gcbf kr; gcbf v; int mtype; int krel0; };

__device__ __forceinline__ void rope_pair(bf16x8& a, bf16x8& b, gcfl ct, gcfl st) {
  const f32x4 c0 = *(const GAS f32x4*)ct, c1 = *(const GAS f32x4*)(ct + 4), s0 = *(const GAS f32x4*)st, s1 = *(const GAS f32x4*)(st + 4);
  const float cs[8] = {c0[0], c0[1], c0[2], c0[3], c1[0], c1[1], c1[2], c1[3]}, sn[8] = {s0[0], s0[1], s0[2], s0[3], s1[0], s1[1], s1[2], s1[3]};
  v4u ua = __builtin_bit_cast(v4u, a), ub = __builtin_bit_cast(v4u, b); v4u oa, ob;
#pragma unroll
  for (int w = 0; w < 4; ++w) { const float x1[2] = {bflo(ua[w]), bfhi(ua[w])}, x2[2] = {bflo(ub[w]), bfhi(ub[w])}; float y1[2], y2[2];
#pragma unroll
    for (int e = 0; e < 2; ++e) { const float c = cs[2 * w + e], sv = sn[2 * w + e]; y1[e] = x1[e] * c - x2[e] * sv; y2[e] = x2[e] * c + x1[e] * sv; }
    oa[w] = pk2(y1[0], y1[1]); ob[w] = pk2(y2[0], y2[1]); }
  a = __builtin_bit_cast(bf16x8, oa); b = __builtin_bit_cast(bf16x8, ob);
}

template <int DQK, int LDKN, int LDV, bool MASK, bool SINK, int SDEPTH, class TS>
__device__ __forceinline__ void attn_body(gcbf Qw, int rope, int prow, int pcol, gcfl rtab, int qi, float sink_l2, const TS& ts, int NT, gbfp Ow, LAS char* lds) {
  constexpr float SCALE = DQK == 128 ? 0.088388347648318440f : 0.072168783648703220f;
  constexpr float C = SCALE * 1.4426950408889634f;
  constexpr int SHM_K = KVBLK * (DQK * 2 + 16), SHM_V = KVBLK * 128 * 2;
  int tid = threadIdx.x; asm volatile("" : "+v"(tid));
  const int wid = tid >> 6, lane = tid & 63, r32 = lane & 31, hi = lane >> 5;
  LAS char* V_lds = lds; LAS char* K_lds = lds + 2 * SHM_V;
  LAS float* wsl = (LAS float*)(lds + 2 * SHM_V + 2 * SHM_K) + wid * 64; LAS float* li_l = wsl; LAS float* al_l = wsl + 32;
  float m_reg = -1e30f, l_reg = 0; f32x16 o[4] = {}; bf16x8 qr[8];
#pragma unroll
  for (int d0 = 0; d0 < 8; ++d0) qr[d0] = *(const GAS bf16x8*)(Qw + d0 * 16 + hi * 8);
  const LAS char* qx = lds + 2 * SHM_V + 2 * SHM_K + 2048 + wid * 4608 + r32 * 144 + hi * 16;
  if constexpr (DQK == 192) {
    bf16x8 x0 = *(const GAS bf16x8*)(Qw + 128 + hi * 8), x1 = *(const GAS bf16x8*)(Qw + 144 + hi * 8), x2 = *(const GAS bf16x8*)(Qw + 160 + hi * 8), x3 = *(const GAS bf16x8*)(Qw + 176 + hi * 8);
    if (rope) {
      rope_pair(x0, x1, rtab + (size_t)prow * 16 + hi * 8, rtab + 2048 + (size_t)prow * 16 + hi * 8);
      rope_pair(x2, x3, rtab + (size_t)pcol * 16 + hi * 8, rtab + 2048 + (size_t)pcol * 16 + hi * 8); }
    LAS char* qw_ = (LAS char*)qx; *(LAS bf16x8*)(qw_) = x0; *(LAS bf16x8*)(qw_ + 32) = x1; *(LAS bf16x8*)(qw_ + 64) = x2; *(LAS bf16x8*)(qw_ + 96) = x3;
  }
  const int sr = tid >> 4, sc = (tid & 15) * 8, vst0 = v_st(sr, sc), vst1 = v_st(32 + sr, sc);
  const int rr_ = tid >> 3, rc_ = (tid & 7) * 8;
  const int vb0 = (int)(uintptr_t)V_lds + v_rd_base(lane);
  struct { bf16x8 vs0, vs1, ks0, ks1, kx; } sr_[SDEPTH];
#define SLOAD(i, jt) do { const Tile t_ = ts(jt); sr_[i].vs0 = *(const GAS bf16x8*)(t_.v + (size_t)sr * LDV + sc); sr_[i].vs1 = *(const GAS bf16x8*)(t_.v + (size_t)(32 + sr) * LDV + sc); \
    sr_[i].ks0 = *(const GAS bf16x8*)(t_.kn + (size_t)sr * LDKN + sc); sr_[i].ks1 = *(const GAS bf16x8*)(t_.kn + (size_t)(32 + sr) * LDKN + sc); \
    if constexpr (DQK == 192) sr_[i].kx = *(const GAS bf16x8*)(t_.kr + (size_t)rr_ * 64 + rc_); } while (0)
#define SWRITE(b, i) do { *(LAS bf16x8*)(V_lds + (b) * SHM_V + vst0) = sr_[i].vs0; *(LAS bf16x8*)(V_lds + (b) * SHM_V + vst1) = sr_[i].vs1; const int kc = sc * 2; \
    *(LAS bf16x8*)(K_lds + (b) * SHM_K + kswz<DQK>(sr, kc)) = sr_[i].ks0; *(LAS bf16x8*)(K_lds + (b) * SHM_K + kswz<DQK>(32 + sr, kc)) = sr_[i].ks1; \
    if constexpr (DQK == 192) *(LAS bf16x8*)(K_lds + (b) * SHM_K + kswz<DQK>(rr_, 256 + rc_ * 2)) = sr_[i].kx; } while (0)
#define SWAIT() do { if constexpr (SDEPTH == 2) { if constexpr (DQK == 192) asm volatile("s_waitcnt vmcnt(5)" ::: "memory"); else asm volatile("s_waitcnt vmcnt(4)" ::: "memory"); } \
    else asm volatile("s_waitcnt vmcnt(0)" ::: "memory"); } while (0)
#define RESC(a) do { if (__any((a) < 1.f)) { if (hi == 0) al_l[r32] = (a); asm volatile("s_waitcnt lgkmcnt(0)" ::: "memory"); \
    _Pragma("unroll") for (int d = 0; d < 4; ++d) _Pragma("unroll") for (int r = 0; r < 16; ++r) o[d][r] *= al_l[crow(r, hi)]; } } while (0)
#define MASKT(pa_, pb_, jt) do { if constexpr (MASK) { const Tile t_ = ts(jt); apply_mask(pa_, pb_, t_.mtype, t_.krel0, qi, hi); } } while (0)
  f32x16 pA0, pA1, pB0, pB1; float mnA, mnB, alA, alB; bf16x8 pa0, pa1, pa2, pa3;
  constexpr int SE = 0, SO = SDEPTH - 1;
  SLOAD(SE, 0); asm volatile("s_waitcnt vmcnt(0)" ::: "memory"); SWRITE(0, SE); __syncthreads();
  qkt<DQK>(pA0, pA1, K_lds, qr, qx, r32, hi); MASKT(pA0, pA1, 0); partialSM<DQK>(pA0, pA1, m_reg, mnA, alA);
  SLOAD(SO, 1); if constexpr (SDEPTH == 2) { if (2 < NT) SLOAD(SE, 2); }
  SWAIT(); SWRITE(1, SO); __syncthreads();
  for (int j = 1; j + 1 < NT; j += 2) {
    SBAR(); qkt<DQK>(pB0, pB1, K_lds + SHM_K, qr, qx, r32, hi); MASKT(pB0, pB1, j);
    finishSM(pA0, pA1, alA, l_reg, pa0, pa1, pa2, pa3); SBAR();
    SLOAD(SO, j + SDEPTH); SBAR();
    pv_d0(o, vb0, pa0, pa1, pa2, pa3); partialSM<DQK>(pB0, pB1, m_reg, mnB, alB);
    __syncthreads(); SWAIT(); SWRITE(0, SE);
    RESC(alB); __syncthreads();
    SBAR(); qkt<DQK>(pA0, pA1, K_lds, qr, qx, r32, hi); MASKT(pA0, pA1, j + 1);
    finishSM(pB0, pB1, alB, l_reg, pa0, pa1, pa2, pa3); SBAR();
    if (SDEPTH == 1 || j + 3 < NT) SLOAD(SE, j + 1 + SDEPTH); SBAR();
    pv_d0(o, vb0 + SHM_V, pa0, pa1, pa2, pa3); partialSM<DQK>(pA0, pA1, m_reg, mnA, alA);
    __syncthreads(); SWAIT(); SWRITE(1, SO);
    RESC(alA); __syncthreads();
  }
  SBAR(); qkt<DQK>(pB0, pB1, K_lds + SHM_K, qr, qx, r32, hi); MASKT(pB0, pB1, NT - 1);
  finishSM(pA0, pA1, alA, l_reg, pa0, pa1, pa2, pa3); SBAR();
  pv_d0(o, vb0, pa0, pa1, pa2, pa3); partialSM<DQK>(pB0, pB1, m_reg, mnB, alB);
  __syncthreads(); RESC(alB);
  finishSM(pB0, pB1, alB, l_reg, pa0, pa1, pa2, pa3); SBAR();
  pv_d0(o, vb0 + SHM_V, pa0, pa1, pa2, pa3);
  if constexpr (SINK) l_reg += __builtin_amdgcn_exp2f(sink_l2 - m_reg * C);
  if (hi == 0) li_l[r32] = l_reg; asm volatile("s_waitcnt lgkmcnt(0)" ::: "memory");
  float rli[16];
#pragma unroll
  for (int r = 0; r < 16; ++r) rli[r] = __builtin_amdgcn_rcpf(li_l[crow(r, hi)]);
  __syncthreads();
  LAS bf16* ost = (LAS bf16*)(lds + wid * 8704);
#pragma unroll
  for (int r = 0; r < 16; ++r) { const int orow = crow(r, hi);
#pragma unroll
    for (int d0 = 0; d0 < 4; ++d0) ost[orow * 136 + d0 * 32 + r32] = (bf16)f2bf(o[d0][r] * rli[r]); }
  asm volatile("s_waitcnt lgkmcnt(0)" ::: "memory");
#pragma unroll
  for (int i = 0; i < 8; ++i) { const int orow = i * 4 + (lane >> 4), ch = lane & 15;
    *(GAS v4u*)(Ow + (size_t)orow * 4096 + ch * 8) = *(const LAS v4u*)(ost + orow * 136 + ch * 8); }
  __syncthreads();
#undef SLOAD
#undef SWRITE
#undef SWAIT
#undef RESC
#undef MASKT
}
}

struct Args { const float* in[38]; float* out; unsigned char* ws; };
template <class T> __device__ __forceinline__ T launder(T p) { asm volatile("" : "+s"(p)); return p; }
template <class T> __device__ __forceinline__ T* launder_g(T* p) { asm volatile("" : "+s"(p)); return p; }
struct Frame {
    LAS unsigned char* lds;
    gu32* ctl;
    int tid, lane, wave;
    int vcu, G, gw, NGW;
    const __attribute__((address_space(4))) Args* A;
    float* out;
    unsigned char* ws;
    unsigned char* wsw;
};
enum { I_X = 0, I_C, I_CTX, I_CCTX, I_WMOD, I_BMOD, I_WIN, I_WOUT, I_LN1G, I_LN1B, I_WFF1, I_WFF2, I_LN2G, I_LN2B, I_SINK, I_CONVW, I_CONVB, I_LWA, I_LBA, I_LWI, I_LBI, I_LAM,
       I_QNORM, I_KVNORM, I_WQB, I_WKVB, I_MUP, I_MUN, I_W0, I_W2, I_A0, I_A2, I_G2, I_KK, I_KA, I_RK, I_LNG, I_LNB };
__device__ __forceinline__ int row_s(int row) { return row < SEQ ? 0 : (row < M_LAT ? 1 : 2); }
__device__ __forceinline__ const float* mod_ptr(const Frame& F, int l, int s, int chunk) { return (const float*)(F.ws + WS_MOD) + ((size_t)(l * 3 + s) * 6 + chunk) * DM; }

__device__ __forceinline__ void transpose_item(const float* W, int N, int Kvalid, bf16* WT, int ldt, const float* kscale, LAS float* scr, int k0, int n0, int lane) {
    { const int kr = lane >> 3, c4 = (lane & 7) * 4;
#pragma unroll
      for (int i = 0; i < 8; ++i) { const int kk = 8 * i + kr, k = k0 + kk; f32x4 v = {0.f, 0.f, 0.f, 0.f};
          if (k < Kvalid) { v = *(const f32x4*)(W + (size_t)k * N + n0 + c4); if (kscale) v = v * kscale[k]; }
          scr[kk * 33 + c4] = v.x; scr[kk * 33 + c4 + 1] = v.y; scr[kk * 33 + c4 + 2] = v.z; scr[kk * 33 + c4 + 3] = v.w; } }
    LDS_WAIT(); asm volatile("" ::: "memory");
    const int c = lane & 7;
#pragma unroll
    for (int j = 0; j < 4; ++j) { const int n = (lane >> 3) + 8 * j; const LAS float* s = scr + (8 * c) * 33 + n;
        v4u o; o.x = pk2(s[0 * 33], s[1 * 33]); o.y = pk2(s[2 * 33], s[3 * 33]); o.z = pk2(s[4 * 33], s[5 * 33]); o.w = pk2(s[6 * 33], s[7 * 33]);
        *(v4u*)(WT + (size_t)(n0 + n) * ldt + k0 + 8 * c) = o; }
    LDS_WAIT(); asm volatile("" ::: "memory");
}
__device__ __forceinline__ void convert_weights(Frame& F, int l, int widx, int nw) {
    LAS float* scr = (LAS float*)(F.lds + F.wave * 16384);
    constexpr int I1 = 64 * 271, I2 = 64 * 128, I3 = 64 * 512, I4 = 256 * 128, I5 = 16 * 48, I6 = 8 * 64, I7 = 32 * 8, I8 = 2 * 32, I9 = 2 * 32, I10 = 3 * 32;
    constexpr int NIT = I1 + I2 + I3 + I4 + I5 + I6 + I7 + I8 + I9 + I10;
    unsigned char* ws = F.ws + (l ? WSET_STRIDE : 0);
    for (int it = widx; it < NIT; it += nw) {
        int r = it;
        if (r < I1) { transpose_item(F.A->in[I_WIN] + (size_t)l * DM * DIN, DIN, DM, (bf16*)(ws + WS_WIN), DM, nullptr, scr, 64 * (r / 271), 32 * (r % 271), F.lane); continue; } r -= I1;
        if (r < I2) { transpose_item(F.A->in[I_WOUT] + (size_t)l * DM * DM, DM, DM, (bf16*)(ws + WS_WOUT), DM, nullptr, scr, 64 * (r / 128), 32 * (r % 128), F.lane); continue; } r -= I2;
        if (r < I3) { transpose_item(F.A->in[I_WFF1] + (size_t)l * DM * DFF, DFF, DM, (bf16*)(ws + WS_WFF1), DM, nullptr, scr, 64 * (r / 512), 32 * (r % 512), F.lane); continue; } r -= I3;
        if (r < I4) { transpose_item(F.A->in[I_WFF2] + (size_t)l * DFF * DM, DM, DFF, (bf16*)(ws + WS_WFF2), DFF, nullptr, scr, 64 * (r / 128), 32 * (r % 128), F.lane); continue; } r -= I4;
        if (r < I5) { transpose_item(F.A->in[I_WQB] + (size_t)l * 1024 * 1536, 1536, 1024, (bf16*)(ws + WS_WQB), 1024, F.A->in[I_QNORM] + l * 1024, scr, 64 * (r / 48), 32 * (r % 48), F.lane); continue; } r -= I5;
        if (r < I6) { transpose_item(F.A->in[I_WKVB] + (size_t)l * 512 * 2048, 2048, 512, (bf16*)(ws + WS_WKVB), 512, F.A->in[I_KVNORM] + l * 512, scr, 64 * (r / 64), 32 * (r % 64), F.lane); continue; } r -= I6;
        if (r < I7) { const int mat = r >> 3, sub = r & 7, gate = mat & 1, dn = mat >> 1;
            const int d = dn >> 3, n = dn & 7;
            const float* src = (gate ? F.A->in[I_LWI] : F.A->in[I_LWA]) + ((size_t)(l * 2 + d) * 8 + n) * 128 * 128;
            bf16* dst = (bf16*)(ws + WS_WLRU) + ((size_t)(d * 2 + gate) * 8 + n) * 128 * 128;
            transpose_item(src, 128, 128, dst, 128, nullptr, scr, 64 * (sub >> 2), 32 * (sub & 3), F.lane); continue; } r -= I7;
        if (r < I8) { const int d = r >> 5; transpose_item(F.A->in[I_W2] + (size_t)(l * 2 + d) * 64 * 1024, 1024, 64, (bf16*)(ws + WS_W2T) + (size_t)d * 1024 * 64, 64, nullptr, scr, 0, 32 * (r & 31), F.lane); continue; } r -= I8;
        if (r < I9) { const int d = r >> 5; transpose_item(F.A->in[I_A2] + (size_t)(l * 2 + d) * 64 * 1024, 1024, 64, (bf16*)(ws + WS_A2T) + (size_t)d * 1024 * 64, 64, nullptr, scr, 0, 32 * (r & 31), F.lane); continue; } r -= I9;
        transpose_item(F.A->in[I_G2] + (size_t)l * 160 * 1024, 1024, 160, (bf16*)(ws + WS_G2T), 192, nullptr, scr, 64 * (r / 32), 32 * (r % 32), F.lane);
    }
    { unsigned zz = 0u; asm volatile("" : "+v"(zz)); v4u z = {zz, zz, zz, zz}; v4u* p = (v4u*)((bf16*)(ws + WS_WIN) + (size_t)DIN * DM);
      for (int i = widx * 64 + F.lane; i < 32 * DM / 8; i += nw * 64) p[i] = z; }
}

__device__ __forceinline__ void mod_partials(Frame& F) {
    LAS float* sl = (LAS float*)F.lds;
    for (int it = F.vcu; it < 2 * 32 * 12; it += F.G) {
        const int l = it / 384, ks = (it / 12) % 32, cc = it % 12;
        __syncthreads();
        if (F.tid < 384) { const int s = F.tid >> 7, k = ks * 128 + (F.tid & 127); const float c = s < 2 ? F.A->in[I_C][s * DM + k] : F.A->in[I_CCTX][k]; sl[F.tid] = c / (1.f + __expf(-c)); }
        __syncthreads();
        const float* wp = F.A->in[I_WMOD] + ((size_t)l * DM + ks * 128) * 24576 + cc * 2048 + F.tid * 4;
        f32x4 a0 = {0.f, 0.f, 0.f, 0.f}, a1 = a0, a2 = a0;
#pragma unroll 8
        for (int k = 0; k < 128; ++k) { const f32x4 w = *(const f32x4*)(wp + (size_t)k * 24576); a0 += w * sl[k]; a1 += w * sl[128 + k]; a2 += w * sl[256 + k]; }
        float* op = (float*)(F.ws + WS_MODP) + ((size_t)(l * 32 + ks) * 3) * 24576 + cc * 2048 + F.tid * 4;
        *(f32x4*)(op) = a0; *(f32x4*)(op + 24576) = a1; *(f32x4*)(op + 2 * 24576) = a2;
    }
    __syncthreads();
}
__device__ __forceinline__ void mod_reduce(Frame& F) {
    for (int i = F.vcu * NTHR + F.tid; i < 2 * 3 * 24576; i += F.G * NTHR) {
        const int l = i / (3 * 24576), s = (i / 24576) % 3, n = i % 24576;
        float a = F.A->in[I_BMOD][l * 24576 + n];
        const float* pp = (const float*)(F.ws + WS_MODP) + ((size_t)(l * 32) * 3 + s) * 24576 + n;
#pragma unroll 8
        for (int ks = 0; ks < 32; ++ks) a += pp[(size_t)ks * 3 * 24576];
        ((float*)(F.ws + WS_MOD))[i] = a;
    }
}

__device__ __forceinline__ void sum_partials_row(const Frame& F, const float* yp, size_t stride, bf16* ydst) {
    int lane = F.lane; asm volatile("" : "+v"(lane));
#pragma unroll 2
    for (int j = 0; j < 16; ++j) { const int c = 4 * lane + 256 * j; f32x4 y = *(const f32x4*)(yp + c);
#pragma unroll
        for (int sp = 1; sp < 8; ++sp) y += *(const f32x4*)(yp + sp * stride + c);
        v2u w; w.x = pk2(y.x, y.y); w.y = pk2(y.z, y.w); *(v2u*)(ydst + c) = w; }
}
template <int MODE>
__device__ __forceinline__ void ln_row(const Frame& F, const float* xsrc, const bf16* Y, const float* ga, const float* lg, const float* lb, float* xdst,
                                       bool domod, const float* sc, const float* sh, bf16* hrow) {
    f32x4 v[16]; float s = 0.f;
#pragma unroll
    for (int j = 0; j < 16; ++j) { const int c = 4 * F.lane + 256 * j; v[j] = *(const f32x4*)(xsrc + c);
        if (MODE == 1) { const v2u yw = *(const v2u*)(Y + c); const f32x4 y = {bflo(yw.x), bfhi(yw.x), bflo(yw.y), bfhi(yw.y)}, g = *(const f32x4*)(ga + c); v[j] = v[j] * ALPHA + g * y; }
        s += (v[j].x + v[j].y) + (v[j].z + v[j].w);
        if ((j & 7) == 7) asm volatile("" ::: "memory"); }
    float mean = wave_sum(s) * (1.f / DM), s2 = 0.f;
#pragma unroll
    for (int j = 0; j < 16; ++j) { v[j] = v[j] - mean; s2 += (v[j].x * v[j].x + v[j].y * v[j].y) + (v[j].z * v[j].z + v[j].w * v[j].w); }
    float rstd = 1.f / sqrtf(wave_sum(s2) * (1.f / DM) + LN_EPS);
    if (MODE == 1) {
        s = 0.f;
#pragma unroll
        for (int j = 0; j < 16; ++j) { const int c = 4 * F.lane + 256 * j; const f32x4 g = *(const f32x4*)(lg + c), b = *(const f32x4*)(lb + c); v[j] = v[j] * rstd * g + b;
            *(f32x4*)(xdst + c) = v[j]; s += (v[j].x + v[j].y) + (v[j].z + v[j].w);
            if ((j & 7) == 7) asm volatile("" ::: "memory"); }
        if (!domod) return;
        mean = wave_sum(s) * (1.f / DM); s2 = 0.f;
#pragma unroll
        for (int j = 0; j < 16; ++j) { v[j] = v[j] - mean; s2 += (v[j].x * v[j].x + v[j].y * v[j].y) + (v[j].z * v[j].z + v[j].w * v[j].w); }
        rstd = 1.f / sqrtf(wave_sum(s2) * (1.f / DM) + LN_EPS);
    }
#pragma unroll
    for (int j = 0; j < 16; ++j) { const int c = 4 * F.lane + 256 * j; const f32x4 a = *(const f32x4*)(sc + c), b = *(const f32x4*)(sh + c);
        const f32x4 o = v[j] * rstd * (a + 1.f) + b; v2u w; w.x = pk2(o.x, o.y); w.y = pk2(o.z, o.w); *(v2u*)(hrow + c) = w; }
}

__device__ __forceinline__ void shift4(const bf16* P, unsigned eo, bool hp, bool hn, const float* mup, const float* mun, unsigned mo, float (&u)[4]) {
    const v2u xc = ldg<v2u>(P, eo * 2u); v2u xp = {0u, 0u}, xn = {0u, 0u};
    if (hp) xp = ldg<v2u>(P, (eo - DINP) * 2u); if (hn) xn = ldg<v2u>(P, (eo + DINP) * 2u);
    const f32x4 mp = ldg<f32x4>(mup, mo * 4u), mn = ldg<f32x4>(mun, mo * 4u);
    const float c[4] = {bflo(xc.x), bfhi(xc.x), bflo(xc.y), bfhi(xc.y)}, p[4] = {bflo(xp.x), bfhi(xp.x), bflo(xp.y), bfhi(xp.y)}, n[4] = {bflo(xn.x), bfhi(xn.x), bflo(xn.y), bfhi(xn.y)};
#pragma unroll
    for (int e = 0; e < 4; ++e) u[e] = c[e] + mp[e] * (p[e] - c[e]) + mn[e] * (n[e] - c[e]);
}
__device__ __forceinline__ void st4bf(void* base, unsigned eo, float a, float b, float c, float d) { v2u w; w.x = pk2(a, b); w.y = pk2(c, d); stg<v2u>(base, eo * 2u, w); }

__device__ __forceinline__ void rwkv_feat_item(Frame& F, int l, int item) {
    F.tid = ltid(); F.lane = F.tid & 63;
    int row0, seq_lo, seq_hi;
    if (item < 16) { const int b = item >> 3; seq_lo = M_LAT + b * NCTX; seq_hi = seq_lo + NCTX; row0 = seq_lo + (item & 7) * 32; }
    else { const int it = item - 16, b = it >> 8; seq_lo = b * SEQ; seq_hi = seq_lo + SEQ; row0 = seq_lo + (it & 255) * 32; }
    const bf16* P = (const bf16*)(F.ws + WS_P);
    LAS bf16* ACT = (LAS bf16*)F.lds;
    const float* mup = F.A->in[I_MUP] + l * RWC; const float* mun = F.A->in[I_MUN] + l * RWC;
    __syncthreads();
    { const int tok = F.tid >> 4, jc = F.tid & 15, row = row0 + tok; const bool hp = row > seq_lo, hn = row + 1 < seq_hi;
      const bf16* pr = P + (size_t)row * DINP + C_RWL;
#pragma unroll
      for (int i = 0; i < 13; ++i) { const int j = jc * 2 + 32 * i;
          const unsigned xc = *(const unsigned*)(pr + j), xp = hp ? *(const unsigned*)(pr - DINP + j) : 0u, xn = hn ? *(const unsigned*)(pr + DINP + j) : 0u;
          float u[2];
#pragma unroll
          for (int e = 0; e < 2; ++e) { const float c = e ? bfhi(xc) : bflo(xc), p = e ? bfhi(xp) : bflo(xp), n = e ? bfhi(xn) : bflo(xn);
              float v = c + mup[3072 + j + e] * (p - c) + mun[3072 + j + e] * (n - c);
              if (j < 128) v = tanhf_(v); else if (j >= 256) v = sigmoidf_(v);
              u[e] = v; }
          *(LAS unsigned*)(ACT + tok * 424 + j) = pk2(u[0], u[1]); } }
    __syncthreads();
    const int tok = F.lane & 31, hi = F.lane >> 5, row = row0 + tok;
    const bf16* W2T = (const bf16*)(F.wsw + WS_W2T); const bf16* A2T = (const bf16*)(F.wsw + WS_A2T); const bf16* G2T = (const bf16*)(F.wsw + WS_G2T);
    bf16* RWF = (bf16*)(F.ws + WS_RWF); const size_t RS = (size_t)M_TOT * 1024;
    const float* kkv = F.A->in[I_KK] + l * 1024; const float* kav = F.A->in[I_KA] + l * 1024; const float* rkv = F.A->in[I_RK] + l * 1024;
    const float* w0f = F.A->in[I_W0] + (size_t)(l * 2) * 1024; const float* a0f = F.A->in[I_A0] + (size_t)(l * 2) * 1024;
    const LAS bf16* actl = ACT + tok * 424 + hi * 8;
    LAS unsigned char* TI = F.lds + 27136 + F.wave * 10752; LAS unsigned char* TO = TI + 3 * 2720;
#define RF_LOADTILE(ti, colbase) do { _Pragma("unroll") for (int i_ = 0; i_ < 3; ++i_) { const int p_ = F.lane + 64 * i_; if (p_ < 136) { const int rr_ = p_ >> 2, cp_ = p_ & 3, gr_ = row0 - 1 + rr_; \
        v4u v_ = {0u, 0u, 0u, 0u}; if (gr_ >= seq_lo && gr_ < seq_hi) v_ = ldg<v4u>(P, ((unsigned)gr_ * DINP + (colbase) + 8 * cp_) * 2u); *(LAS v4u*)(TI + (ti) * 2720 + rr_ * 80 + cp_ * 16) = v_; } } } while (0)
#define RF_SHIFT4(ti, g_, mo_, u_) do { const LAS unsigned char* q_ = TI + (ti) * 2720 + (tok + 1) * 80 + (8 * (g_) + 4 * hi) * 2; const v2u xc_ = *(const LAS v2u*)q_, xp_ = *(const LAS v2u*)(q_ - 80), xn_ = *(const LAS v2u*)(q_ + 80); \
        const f32x4 mp_ = ldg<f32x4>(mup, (mo_) * 4u), mn_ = ldg<f32x4>(mun, (mo_) * 4u); \
        const float c_[4] = {bflo(xc_.x), bfhi(xc_.x), bflo(xc_.y), bfhi(xc_.y)}, pp_[4] = {bflo(xp_.x), bfhi(xp_.x), bflo(xp_.y), bfhi(xp_.y)}, nn_[4] = {bflo(xn_.x), bfhi(xn_.x), bflo(xn_.y), bfhi(xn_.y)}; \
        _Pragma("unroll") for (int e_ = 0; e_ < 4; ++e_) u_[e_] = c_[e_] + mp_[e_] * (pp_[e_] - c_[e_]) + mn_[e_] * (nn_[e_] - c_[e_]); } while (0)
#define RF_FLUSH(arr_, cblk_, o_) do { _Pragma("unroll") for (int g_ = 0; g_ < 4; ++g_) *(LAS v2u*)(TO + tok * 80 + (8 * g_ + 4 * hi) * 2) = o_[g_]; \
        asm volatile("s_waitcnt lgkmcnt(0)" ::: "memory"); \
        _Pragma("unroll") for (int i_ = 0; i_ < 2; ++i_) { const int p_ = F.lane + 64 * i_, rr_ = p_ >> 2, cp_ = p_ & 3; const v4u v_ = *(const LAS v4u*)(TO + rr_ * 80 + cp_ * 16); \
            stg<v4u>(RWF + (arr_) * RS, ((unsigned)(row0 + rr_) * 1024u + (cblk_) + 8 * cp_) * 2u, v_); } \
        asm volatile("s_waitcnt lgkmcnt(0)" ::: "memory"); } while (0)
#pragma unroll 1
    for (int hh = 0; hh < 2; ++hh) {
        const int h = 2 * F.wave + hh, cbase = h * 64;
        float ssq = 0.f;
        RF_LOADTILE(0, C_RWK + cbase); RF_LOADTILE(1, C_RWK + cbase + 32);
        asm volatile("s_waitcnt lgkmcnt(0)" ::: "memory");
#pragma unroll
        for (int bg = 0; bg < 8; ++bg) { const unsigned c4 = cbase + (bg >> 2) * 32 + 8 * (bg & 3) + 4 * hi; float uk[4];
            RF_SHIFT4(bg >> 2, bg & 3, 1024 + c4, uk); const f32x4 k4 = ldg<f32x4>(kkv, c4 * 4u);
#pragma unroll
            for (int e = 0; e < 4; ++e) { const float q = uk[e] * k4[e]; ssq += q * q; } }
        ssq = half_swap_sum(ssq);
        const float rn = 1.f / fmaxf(sqrtf(ssq), 1e-12f);
        float sb = 0.f;
#pragma unroll 1
        for (int blk = 0; blk < 2; ++blk) {
            const unsigned cblk = cbase + blk * 32, cha = cblk + tok;
            RF_LOADTILE(0, C_RWR + cblk); RF_LOADTILE(1, C_RWK + cblk); RF_LOADTILE(2, C_RWV + cblk);
#pragma unroll 1
            for (int d = 0; d < 2; ++d) { f32x16 aw = {};
#pragma unroll
                for (int ks = 0; ks < 4; ++ks) { const bf16x8 bw = *(const LAS bf16x8*)(actl + d * 64 + ks * 16); const bf16x8 w_ = ldg<bf16x8>(W2T, ((d * 1024 + cha) * 64 + ks * 16 + hi * 8) * 2u);
                    aw = __builtin_amdgcn_mfma_f32_32x32x16_bf16(w_, bw, aw, 0, 0, 0); }
                v2u o[4];
#pragma unroll
                for (int g = 0; g < 4; ++g) { const f32x4 w0 = ldg<f32x4>(w0f, (d * 1024 + cblk + 8 * g + 4 * hi) * 4u); float e4[4];
#pragma unroll
                    for (int e = 0; e < 4; ++e) e4[e] = __expf(-softplusf_(-(w0[e] + aw[4 * g + e])) - 0.5f);
                    o[g].x = pk2(e4[0], e4[1]); o[g].y = pk2(e4[2], e4[3]); }
                RF_FLUSH(4 + d, cblk, o); }
            { f32x16 ag = {};
#pragma unroll
              for (int ks = 0; ks < 10; ++ks) { const bf16x8 bg_ = *(const LAS bf16x8*)(actl + 256 + ks * 16); const bf16x8 g_ = ldg<bf16x8>(G2T, (cha * 192 + ks * 16 + hi * 8) * 2u);
                  ag = __builtin_amdgcn_mfma_f32_32x32x16_bf16(g_, bg_, ag, 0, 0, 0); }
              v2u o[4];
#pragma unroll
              for (int g = 0; g < 4; ++g) { o[g].x = pk2(ag[4 * g], ag[4 * g + 1]); o[g].y = pk2(ag[4 * g + 2], ag[4 * g + 3]); }
              RF_FLUSH(8, cblk, o); }
            { f32x16 aaf = {}, aab = {};
#pragma unroll
              for (int ks = 0; ks < 4; ++ks) { const bf16x8 baf = *(const LAS bf16x8*)(actl + 128 + ks * 16), bab = *(const LAS bf16x8*)(actl + 192 + ks * 16);
                  const bf16x8 a_f = ldg<bf16x8>(A2T, (cha * 64 + ks * 16 + hi * 8) * 2u), a_b = ldg<bf16x8>(A2T, ((1024 + cha) * 64 + ks * 16 + hi * 8) * 2u);
                  aaf = __builtin_amdgcn_mfma_f32_32x32x16_bf16(a_f, baf, aaf, 0, 0, 0); aab = __builtin_amdgcn_mfma_f32_32x32x16_bf16(a_b, bab, aab, 0, 0, 0); }
              v2u oR[4], oK[4], oV[4], oKK[4], oAF[4], oAB[4];
#pragma unroll
              for (int g = 0; g < 4; ++g) { const unsigned c4 = cblk + 8 * g + 4 * hi; float ur[4], uk[4], uv[4];
                  RF_SHIFT4(0, g, c4, ur); RF_SHIFT4(1, g, 1024 + c4, uk); RF_SHIFT4(2, g, 2048 + c4, uv);
                  const f32x4 a0a = ldg<f32x4>(a0f, c4 * 4u), a0b = ldg<f32x4>(a0f, (1024 + c4) * 4u), kk4 = ldg<f32x4>(kkv, c4 * 4u), ka4 = ldg<f32x4>(kav, c4 * 4u), rk4 = ldg<f32x4>(rkv, c4 * 4u);
                  float af[4], ab[4], kk[4];
#pragma unroll
                  for (int e = 0; e < 4; ++e) { const int r = 4 * g + e;
                      af[e] = sigmoidf_(a0a[e] + aaf[r]); ab[e] = sigmoidf_(a0b[e] + aab[r]); kk[e] = uk[e] * kk4[e] * rn;
                      const float kdf = uk[e] * (1.f + (af[e] - 1.f) * ka4[e]), kdb = uk[e] * (1.f + (ab[e] - 1.f) * ka4[e]);
                      sb += ur[e] * rk4[e] * (kdf + kdb); }
                  oR[g].x = pk2(ur[0], ur[1]); oR[g].y = pk2(ur[2], ur[3]); oK[g].x = pk2(uk[0], uk[1]); oK[g].y = pk2(uk[2], uk[3]); oV[g].x = pk2(uv[0], uv[1]); oV[g].y = pk2(uv[2], uv[3]);
                  oKK[g].x = pk2(kk[0], kk[1]); oKK[g].y = pk2(kk[2], kk[3]); oAF[g].x = pk2(af[0], af[1]); oAF[g].y = pk2(af[2], af[3]); oAB[g].x = pk2(ab[0], ab[1]); oAB[g].y = pk2(ab[2], ab[3]); }
              RF_FLUSH(0, cblk, oR); RF_FLUSH(1, cblk, oK); RF_FLUSH(2, cblk, oV); RF_FLUSH(3, cblk, oKK); RF_FLUSH(6, cblk, oAF); RF_FLUSH(7, cblk, oAB); }
        }
        sb = half_swap_sum(sb);
        if (hi == 0) ((float*)(F.ws + WS_SB))[(size_t)row * 16 + h] = sb;
    }
#undef RF_LOADTILE
#undef RF_SHIFT4
#undef RF_FLUSH
}

__device__ __forceinline__ float gelu_tanh(float x) { return 0.5f * x * (1.f + tanhf_(0.7978845608028654f * (x + 0.044715f * x * x * x))); }
template <bool PASS3>
__device__ __forceinline__ void lru_item(Frame& F, int l, int item) {
    F.tid = ltid(); F.lane = F.tid & 63;
    const int sc = item >> 3, nb = item & 7, b = sc / NCH, ch = sc % NCH;
    int row0, seq_lo, seq_hi;
    if (ch < 8) { seq_lo = M_LAT + b * NCTX; seq_hi = seq_lo + NCTX; row0 = seq_lo + ch * 32; }
    else { seq_lo = b * SEQ; seq_hi = seq_lo + SEQ; row0 = seq_lo + (ch - 8) * 32; }
    const bf16* P = (const bf16*)(F.ws + WS_P);
    LAS float* U = (LAS float*)F.lds;
    LAS bf16* UA = (LAS bf16*)(F.lds + 16384);
    LAS float* AB = (LAS float*)(F.lds + 32768);
    __syncthreads();
    { const int tok = F.tid >> 4, c8 = (F.tid & 15) * 8, cg = nb * 128 + c8; float acc[8];
      const float* cb = F.A->in[I_CONVB] + l * 1024 + cg;
#pragma unroll
      for (int e = 0; e < 8; ++e) acc[e] = cb[e];
#pragma unroll
      for (int j = 0; j < 4; ++j) { const int r = row0 + tok - 2 + j;
          if (r >= seq_lo && r < seq_hi) { const v4u x = *(const v4u*)(P + (size_t)r * DINP + C_LRUX + cg); const float* cw = F.A->in[I_CONVW] + (size_t)(l * 4 + j) * 1024 + cg;
#pragma unroll
              for (int w = 0; w < 4; ++w) { acc[2 * w] += cw[2 * w] * bflo(x[w]); acc[2 * w + 1] += cw[2 * w + 1] * bfhi(x[w]); } } }
      *(LAS f32x4*)(U + tok * 128 + c8) = (f32x4){acc[0], acc[1], acc[2], acc[3]}; *(LAS f32x4*)(U + tok * 128 + c8 + 4) = (f32x4){acc[4], acc[5], acc[6], acc[7]};
      v4u o; o.x = pk2(acc[0], acc[1]); o.y = pk2(acc[2], acc[3]); o.z = pk2(acc[4], acc[5]); o.w = pk2(acc[6], acc[7]);
      *(LAS v4u*)(UA + tok * 136 + c8) = o; }
    __syncthreads();
    { const int dir = F.wave >> 2, cq = F.wave & 3, l32 = F.lane & 31, hi = F.lane >> 5, chn = cq * 32 + l32, cg = nb * 128 + chn;
      const bf16* Wr = (const bf16*)(F.wsw + WS_WLRU) + ((size_t)(dir * 2 + 0) * 8 + nb) * 16384 + (size_t)chn * 128;
      const bf16* Wi = (const bf16*)(F.wsw + WS_WLRU) + ((size_t)(dir * 2 + 1) * 8 + nb) * 16384 + (size_t)chn * 128;
      f32x16 accr = {}, acci = {};
#pragma unroll
      for (int ks = 0; ks < 8; ++ks) { const int ko = ks * 16 + hi * 8;
          const bf16x8 a = *(const LAS bf16x8*)(UA + l32 * 136 + ko); const bf16x8 br = *(const bf16x8*)(Wr + ko), bi = *(const bf16x8*)(Wi + ko);
          accr = __builtin_amdgcn_mfma_f32_32x32x16_bf16(a, br, accr, 0, 0, 0); acci = __builtin_amdgcn_mfma_f32_32x32x16_bf16(a, bi, acci, 0, 0, 0); }
      const float ba = F.A->in[I_LBA][(l * 2 + dir) * 1024 + cg], bi_ = F.A->in[I_LBI][(l * 2 + dir) * 1024 + cg], sp = softplusf_(-F.A->in[I_LAM][(l * 2 + dir) * 1024 + cg]);
#pragma unroll
      for (int r = 0; r < 16; ++r) { const int tok = att::crow(r, hi); const float u = U[tok * 128 + chn];
          const float rg = sigmoidf_(accr[r] + ba), ig = sigmoidf_(acci[r] + bi_), la = -8.f * rg * sp, a = __expf(la), x2 = 2.f * la;
          const float em = x2 * (1.f + x2 * (0.5f + x2 * (0.16666667f + x2 * (0.041666668f + x2 * (0.0083333338f + x2 * 0.0013888889f)))));
          const float bc = __builtin_amdgcn_sqrtf(x2 < -0.5f ? 1.f - a * a : -em) * (ig * u);
          AB[(dir * 2 + 0) * 4096 + tok * 128 + chn] = a; AB[(dir * 2 + 1) * 4096 + tok * 128 + chn] = bc; } }
    __syncthreads();
    if (F.tid < 256) { const int dir = F.tid >> 7, chn = F.tid & 127, cg = nb * 128 + chn; const size_t ci = ((size_t)(dir * 2 + b) * NCH + ch) * 1024 + cg;
        LAS float* Aa = AB + (dir * 2) * 4096 + chn; LAS float* Bb = AB + (dir * 2 + 1) * 4096 + chn;
        if (!PASS3) { float h = 0.f, ap = 1.f;
#pragma unroll 8
            for (int s = 0; s < 32; ++s) { const int tok = dir ? 31 - s : s; const float a = Aa[tok * 128]; h = a * h + Bb[tok * 128]; ap *= a;
                if (s == 0 && dir == 1 && ch == 7) ((float*)(F.ws + WS_QUIRK))[b * 1024 + cg] = h; }
            ((float*)(F.ws + WS_CA))[ci] = ap; ((float*)(F.ws + WS_CB))[ci] = h;
        } else { float h = ((const float*)(F.ws + WS_HIN))[ci];
#pragma unroll 8
            for (int s = 0; s < 32; ++s) { const int tok = dir ? 31 - s : s; h = Aa[tok * 128] * h + Bb[tok * 128]; Bb[tok * 128] = h; } } }
    if (PASS3) { __syncthreads();
        const int tok = F.tid >> 4, c8 = (F.tid & 15) * 8, cg = nb * 128 + c8, row = row0 + tok;
        const v4u y = *(const v4u*)(P + (size_t)row * DINP + C_LRUY + cg); float o[8];
#pragma unroll
        for (int w = 0; w < 4; ++w) { const float h0 = AB[4096 + tok * 128 + c8 + 2 * w] + AB[3 * 4096 + tok * 128 + c8 + 2 * w], h1 = AB[4096 + tok * 128 + c8 + 2 * w + 1] + AB[3 * 4096 + tok * 128 + c8 + 2 * w + 1];
            o[2 * w] = h0 * gelu_tanh(bflo(y[w])); o[2 * w + 1] = h1 * gelu_tanh(bfhi(y[w])); }
        v4u ov; ov.x = pk2(o[0], o[1]); ov.y = pk2(o[2], o[3]); ov.z = pk2(o[4], o[5]); ov.w = pk2(o[6], o[7]);
        *(v4u*)((bf16*)(F.ws + WS_MIX) + (size_t)row * DM + 1024 + cg) = ov; }
}
__device__ __forceinline__ void lru_carry(Frame& F, int blk) {
    F.tid = ltid(); F.lane = F.tid & 63;
    const int gid = blk * NTHR + F.tid; if (gid >= 4096) return;
    const int dir = gid >> 11, b = (gid >> 10) & 1, cg = gid & 1023;
    const float* CA = (const float*)(F.ws + WS_CA) + ((size_t)(dir * 2 + b) * NCH) * 1024 + cg; const float* CB = (const float*)(F.ws + WS_CB) + ((size_t)(dir * 2 + b) * NCH) * 1024 + cg;
    float* HIN = (float*)(F.ws + WS_HIN) + ((size_t)(dir * 2 + b) * NCH) * 1024 + cg;
    float h = 0.f;
    if (dir == 0) {
#pragma unroll 8
        for (int c = 0; c < NCH; ++c) { HIN[(size_t)c * 1024] = h; h = CA[(size_t)c * 1024] * h + CB[(size_t)c * 1024]; }
    } else {
        for (int c = 7; c >= 0; --c) { HIN[(size_t)c * 1024] = h; h = CA[(size_t)c * 1024] * h + CB[(size_t)c * 1024]; }
        h = ((const float*)(F.ws + WS_QUIRK))[b * 1024 + cg];
#pragma unroll 8
        for (int c = NCH - 1; c >= 8; --c) { HIN[(size_t)c * 1024] = h; h = CA[(size_t)c * 1024] * h + CB[(size_t)c * 1024]; }
    }
}

__device__ __forceinline__ void rope_table(Frame& F) {
    const int i = F.vcu * NTHR + F.tid; if (i >= 2048) return;
    const int pos = i >> 4, f = i & 15; float s, c; sincosf((float)pos * exp2f(-(float)f * (13.287712379549449f / 16.f)), &s, &c);
    float* t = (float*)(F.ws + WS_ROPE); t[i] = c; t[2048 + i] = s;
}
__device__ __forceinline__ void row_prep(Frame& F, int row) {
    F.tid = ltid(); F.lane = F.tid & 63;
    bf16* pr = (bf16*)(F.ws + WS_P) + (size_t)row * DINP; const int lane = F.lane;
    const bool lat = row < M_LAT; const int t = row & (SEQ - 1); const float prow = (float)(t >> 6), pcol = (float)(t & 63);
    { const v4u a = *(const v4u*)(pr + C_QA + lane * 16), b = *(const v4u*)(pr + C_QA + lane * 16 + 8); float ss = 0.f;
#pragma unroll
      for (int w = 0; w < 4; ++w) { const float x0 = bflo(a[w]), x1 = bfhi(a[w]), x2 = bflo(b[w]), x3 = bfhi(b[w]); ss += x0 * x0 + x1 * x1 + x2 * x2 + x3 * x3; }
      ss = wave_sum(ss); if (lane == 0) ((float*)(F.ws + WS_RSQ))[row] = 1.f / sqrtf(ss * (1.f / 1024.f) + RMS_EPS); }
    { const v4u a = *(const v4u*)(pr + C_KVA + lane * 8); float ss = 0.f;
#pragma unroll
      for (int w = 0; w < 4; ++w) { const float x0 = bflo(a[w]), x1 = bfhi(a[w]); ss += x0 * x0 + x1 * x1; }
      ss = wave_sum(ss); if (lane == 0) ((float*)(F.ws + WS_RSKV))[row] = 1.f / sqrtf(ss * (1.f / 512.f) + RMS_EPS); }
    bf16* kr = (bf16*)(F.ws + WS_KR) + (size_t)row * 64;
    if (lat) {
        { const int part = lane >> 5, sub = lane & 31;
          const float inv = exp2f(-(float)sub * (13.287712379549449f / 32.f)); float sn, cs; sincosf((part ? pcol : prow) * inv, &sn, &cs);
#pragma unroll
          for (int hd = 0; hd < 10; ++hd) { bf16* qb = pr + (hd < 8 ? C_SWAQ + hd * 128 : C_SWAK + (hd - 8) * 128) + part * 64;
              const float x1 = bf2f(qb[sub]), x2 = bf2f(qb[sub + 32]); qb[sub] = (bf16)f2bf(x1 * cs - x2 * sn); qb[sub + 32] = (bf16)f2bf(x2 * cs + x1 * sn); } }
        if (lane < 32) { const int part = lane >> 4, i = lane & 15; const bf16* src = pr + C_KR + part * 32;
          const float inv = exp2f(-(float)i * (13.287712379549449f / 16.f)); float s, c; sincosf((part ? pcol : prow) * inv, &s, &c);
          const float x1 = bf2f(src[i]), x2 = bf2f(src[i + 16]);
          kr[part * 32 + i] = (bf16)f2bf(x1 * c - x2 * s); kr[part * 32 + i + 16] = (bf16)f2bf(x2 * c + x1 * s); }
    } else kr[lane] = pr[C_KR + lane];
}

__device__ __forceinline__ float allred16(float x) { return row_sum16(x); }
__device__ __forceinline__ int scan_row(int s, int dir, int b) {
    if (s < NCTX) return M_LAT + b * NCTX + (dir ? NCTX - 1 - s : s);
    const int t = s - NCTX; return b * SEQ + (dir ? SEQ - 1 - t : t);
}
__device__ __forceinline__ void rwkv_scan(Frame& F, int l, int chain) {
    F.tid = ltid(); F.lane = F.tid & 63;
    const int dir = chain >> 5, b = (chain >> 4) & 1, h = chain & 15;
    constexpr int CT = 24, NCHK = (NCTX + SEQ) / CT, STEPF = 392, BUFF = CT * STEPF;
    LAS float* buf = (LAS float*)F.lds; LAS float* ybuf = (LAS float*)(F.lds + 3 * BUFF * 4);
    gcbf RWF = (gcbf)(F.ws + WS_RWF); const size_t RS = (size_t)M_TOT * 1024;
    gflp YS = (gflp)(F.ws + WS_YS) + (size_t)dir * M_TOT * 1024;
    const bool cmp = F.wave < 4; const int lt = F.tid - 256, lst = lt >> 4, lq = lt & 15, lc = h * 64 + 4 * lq;
    const f32x4 ka4 = *(const GAS f32x4*)((gcfl)F.A->in[I_KA] + l * 1024 + (cmp ? 0 : lc));
    v2u gr[2], gk[2], gv[2], gkk[2], ge[2], ga[2];
#pragma unroll
    for (int u = 0; u < 2; ++u) { gr[u] = (v2u){0u, 0u}; gk[u] = gr[u]; gv[u] = gr[u]; gkk[u] = gr[u]; ge[u] = gr[u]; ga[u] = gr[u]; }
#define RW_LOAD(c) do { if (!cmp) { _Pragma("unroll") for (int u_ = 0; u_ < 2; ++u_) { const int s_ = lst + 16 * u_; if (s_ < CT) { const size_t o_ = (size_t)scan_row((c) * CT + s_, dir, b) * 1024 + lc; \
        gr[u_] = *(const GAS v2u*)(RWF + 0 * RS + o_); gk[u_] = *(const GAS v2u*)(RWF + 1 * RS + o_); gv[u_] = *(const GAS v2u*)(RWF + 2 * RS + o_); \
        gkk[u_] = *(const GAS v2u*)(RWF + 3 * RS + o_); ge[u_] = *(const GAS v2u*)(RWF + (4 + dir) * RS + o_); ga[u_] = *(const GAS v2u*)(RWF + (6 + dir) * RS + o_); } } } } while (0)
#define RW_WRITE(bi) do { if (!cmp) { _Pragma("unroll") for (int u_ = 0; u_ < 2; ++u_) { const int s_ = lst + 16 * u_; if (s_ < CT) { LAS float* d_ = buf + (bi) * BUFF + s_ * STEPF + 4 * lq; \
        const float r_[4] = {bflo(gr[u_].x), bfhi(gr[u_].x), bflo(gr[u_].y), bfhi(gr[u_].y)}, k_[4] = {bflo(gk[u_].x), bfhi(gk[u_].x), bflo(gk[u_].y), bfhi(gk[u_].y)}, v_[4] = {bflo(gv[u_].x), bfhi(gv[u_].x), bflo(gv[u_].y), bfhi(gv[u_].y)}; \
        const float q_[4] = {bflo(gkk[u_].x), bfhi(gkk[u_].x), bflo(gkk[u_].y), bfhi(gkk[u_].y)}, e_[4] = {bflo(ge[u_].x), bfhi(ge[u_].x), bflo(ge[u_].y), bfhi(ge[u_].y)}, a_[4] = {bflo(ga[u_].x), bfhi(ga[u_].x), bflo(ga[u_].y), bfhi(ga[u_].y)}; \
        f32x4 w4, kd4, kk4, b4, wr4, v4; float sbr = 0.f, skr = 0.f; \
        _Pragma("unroll") for (int e = 0; e < 4; ++e) { w4[e] = __expf(-e_[e]); kd4[e] = k_[e] * (1.f + (a_[e] - 1.f) * ka4[e]); kk4[e] = q_[e]; b4[e] = q_[e] * a_[e]; wr4[e] = w4[e] * r_[e]; v4[e] = v_[e]; sbr += b4[e] * r_[e]; skr += kd4[e] * r_[e]; } \
        sbr = row_sum16(sbr); skr = row_sum16(skr); \
        *(LAS f32x4*)(d_) = w4; *(LAS f32x4*)(d_ + 64) = kd4; *(LAS f32x4*)(d_ + 128) = kk4; *(LAS f32x4*)(d_ + 192) = b4; *(LAS f32x4*)(d_ + 256) = wr4; *(LAS f32x4*)(d_ + 320) = v4; \
        if (lq == 0) *(LAS f32x2*)(buf + (bi) * BUFF + s_ * STEPF + 384) = (f32x2){sbr, skr}; } } } } while (0)
#define RW_FLUSH(c) do { if (!cmp) { _Pragma("unroll") for (int u_ = 0; u_ < 2; ++u_) { const int s_ = lst + 16 * u_; if (s_ < CT) { const f32x4 y_ = *(const LAS f32x4*)(ybuf + ((c) & 1) * (CT * 64) + s_ * 64 + 4 * lq); \
        *(GAS f32x4*)(YS + (size_t)scan_row((c) * CT + s_, dir, b) * 1024 + lc) = y_; } } } } while (0)
    __syncthreads();
    RW_LOAD(0); RW_WRITE(0); RW_LOAD(1); RW_WRITE(1); RW_LOAD(2);
    __syncthreads();
    const int kg = F.lane & 7, rg = F.lane >> 3, r0 = 16 * (F.wave & 3) + 2 * rg;
    f32x2 St[8];
#pragma unroll
    for (int i = 0; i < 8; ++i) St[i] = (f32x2){0.f, 0.f};
    int bc = 0, bw = 2;
#pragma unroll 1
    for (int c = 0; c < NCHK; ++c) {
        if (c + 2 < NCHK) { RW_WRITE(bw); if (c + 3 < NCHK) RW_LOAD(c + 3); }
        if (c > 0) RW_FLUSH(c - 1);
        if (cmp) {
        const LAS float* bb = buf + bc * BUFF + 8 * kg; const LAS float* vb = buf + bc * BUFF + 320 + r0; const LAS float* sb = buf + bc * BUFF + 384;
        LAS float* yb = ybuf + (c & 1) * (CT * 64) + r0;
        f32x4 w4[2], kd4[2], kk4[2], b4[2], wr4[2];
#pragma unroll
        for (int q = 0; q < 2; ++q) { w4[q] = *(const LAS f32x4*)(bb + 4 * q); kd4[q] = *(const LAS f32x4*)(bb + 64 + 4 * q); kk4[q] = *(const LAS f32x4*)(bb + 128 + 4 * q); b4[q] = *(const LAS f32x4*)(bb + 192 + 4 * q); wr4[q] = *(const LAS f32x4*)(bb + 256 + 4 * q); }
        f32x2 v2 = *(const LAS f32x2*)(vb), s2 = *(const LAS f32x2*)(sb);
#pragma unroll
        for (int st = 0; st < CT; ++st) {
            const int sn = (st + 1 < CT ? st + 1 : st) * STEPF;
            f32x4 nw4[2], nkd4[2], nkk4[2], nb4[2], nwr4[2];
#pragma unroll
            for (int q = 0; q < 2; ++q) { nw4[q] = *(const LAS f32x4*)(bb + sn + 4 * q); nkd4[q] = *(const LAS f32x4*)(bb + sn + 64 + 4 * q); nkk4[q] = *(const LAS f32x4*)(bb + sn + 128 + 4 * q); nb4[q] = *(const LAS f32x4*)(bb + sn + 192 + 4 * q); nwr4[q] = *(const LAS f32x4*)(bb + sn + 256 + 4 * q); }
            const f32x2 nv2 = *(const LAS f32x2*)(vb + sn), ns2 = *(const LAS f32x2*)(sb + sn);
#define PKH(x, i) ((i) & 1 ? (f32x2){(x)[2], (x)[3]} : (f32x2){(x)[0], (x)[1]})
#define PK_MUL(d, a, bp, i) do { if ((i) & 1) asm("v_pk_mul_f32 %0, %1, %2 op_sel:[0,1] op_sel_hi:[1,1]" : "=v"(d) : "v"(a), "v"(bp)); else asm("v_pk_mul_f32 %0, %1, %2 op_sel:[0,0] op_sel_hi:[1,0]" : "=v"(d) : "v"(a), "v"(bp)); } while (0)
#define PK_FMA(d, a, bp, i, c) do { if ((i) & 1) asm("v_pk_fma_f32 %0, %1, %2, %3 op_sel:[0,1,0] op_sel_hi:[1,1,1]" : "=v"(d) : "v"(a), "v"(bp), "v"(c)); else asm("v_pk_fma_f32 %0, %1, %2, %3 op_sel:[0,0,0] op_sel_hi:[1,0,1]" : "=v"(d) : "v"(a), "v"(bp), "v"(c)); } while (0)
#define PK_FNMA(d, a, bp, i, c) do { if ((i) & 1) asm("v_pk_fma_f32 %0, %1, %2, %3 op_sel:[0,1,0] op_sel_hi:[1,1,1] neg_lo:[1,0,0] neg_hi:[1,0,0]" : "=v"(d) : "v"(a), "v"(bp), "v"(c)); \
        else asm("v_pk_fma_f32 %0, %1, %2, %3 op_sel:[0,0,0] op_sel_hi:[1,0,1] neg_lo:[1,0,0] neg_hi:[1,0,0]" : "=v"(d) : "v"(a), "v"(bp), "v"(c)); } while (0)
#define OPP(x, e) PKH((x)[(e) >> 2], ((e) >> 1) & 1)
            f32x2 pa, za, pb, zb;
            PK_MUL(pa, St[0], OPP(kk4, 0), 0); PK_MUL(za, St[0], OPP(wr4, 0), 0); PK_MUL(pb, St[4], OPP(kk4, 4), 4); PK_MUL(zb, St[4], OPP(wr4, 4), 4);
#pragma unroll
            for (int i = 1; i < 4; ++i) { PK_FMA(pa, St[i], OPP(kk4, i), i, pa); PK_FMA(za, St[i], OPP(wr4, i), i, za); PK_FMA(pb, St[4 + i], OPP(kk4, 4 + i), 4 + i, pb); PK_FMA(zb, St[4 + i], OPP(wr4, 4 + i), 4 + i, zb); }
            const f32x2 p = pa + pb, z = za + zb;
            float p0 = p.x, p1 = p.y, z0 = z.x, z1 = z.y;
#define D4(ctl) "v_add_f32_dpp %0, %0, %0 " ctl " row_mask:0xf bank_mask:0xf\n\tv_add_f32_dpp %1, %1, %1 " ctl " row_mask:0xf bank_mask:0xf\n\tv_add_f32_dpp %2, %2, %2 " ctl " row_mask:0xf bank_mask:0xf\n\tv_add_f32_dpp %3, %3, %3 " ctl " row_mask:0xf bank_mask:0xf\n\t"
            asm volatile("s_nop 1\n\t" D4("quad_perm:[1,0,3,2]") D4("quad_perm:[2,3,0,1]") D4("row_half_mirror") "s_nop 0"
                : "+v"(p0), "+v"(p1), "+v"(z0), "+v"(z1));
#undef D4
            const f32x2 pp = {p0, p1}, zz = {z0, z1};
            { f32x2 y; PK_FNMA(y, pp, s2, 0, zz); PK_FMA(y, v2, s2, 1, y); *(LAS f32x2*)(yb + st * 64) = y; }
#pragma unroll
            for (int i = 0; i < 8; ++i) { f32x2 t; PK_MUL(t, v2, OPP(kd4, i), i); PK_FMA(t, St[i], OPP(w4, i), i, t); PK_FNMA(St[i], pp, OPP(b4, i), i, t); }
#undef OPP
#undef PKH
#undef PK_MUL
#undef PK_FMA
#undef PK_FNMA
#pragma unroll
            for (int q = 0; q < 2; ++q) { w4[q] = nw4[q]; kd4[q] = nkd4[q]; kk4[q] = nkk4[q]; b4[q] = nb4[q]; wr4[q] = nwr4[q]; }
            v2 = nv2; s2 = ns2;
        }
        }
        __syncthreads();
        bc = bc == 2 ? 0 : bc + 1; bw = bw == 2 ? 0 : bw + 1;
    }
    RW_FLUSH(NCHK - 1);
#undef RW_LOAD
#undef RW_WRITE
#undef RW_FLUSH
}
__device__ __forceinline__ void rwkv_out_row(Frame& F, int l, int row) {
    F.tid = ltid(); F.lane = F.tid & 63;
    const int c0 = F.lane * 16; const float* yf = (const float*)(F.ws + WS_YS) + (size_t)row * 1024 + c0; const float* yb = yf + (size_t)M_TOT * 1024;
    float y[16]; float s = 0.f;
#pragma unroll
    for (int j = 0; j < 4; ++j) { const f32x4 a = *(const f32x4*)(yf + 4 * j), b = *(const f32x4*)(yb + 4 * j);
#pragma unroll
        for (int e = 0; e < 4; ++e) { y[4 * j + e] = a[e] + b[e]; s += y[4 * j + e]; } }
    s = quad_sum(s); const float mu = s * (1.f / 64.f); float q = 0.f;
#pragma unroll
    for (int e = 0; e < 16; ++e) { y[e] -= mu; q += y[e] * y[e]; }
    q = quad_sum(q); const float rstd = 1.f / sqrtf(q * (1.f / 64.f) + GN_EPS);
    const bf16* RWF = (const bf16*)(F.ws + WS_RWF); const size_t RS = (size_t)M_TOT * 1024, o = (size_t)row * 1024 + c0;
    const float sbv = ((const float*)(F.ws + WS_SB))[(size_t)row * 16 + (F.lane >> 2)];
    const float* lg = F.A->in[I_LNG] + l * 1024 + c0; const float* lb = F.A->in[I_LNB] + l * 1024 + c0;
    bf16* dst = (bf16*)(F.ws + WS_MIX) + (size_t)row * DM + 3072 + c0;
#pragma unroll
    for (int hf = 0; hf < 2; ++hf) { const v4u vv = *(const v4u*)(RWF + 2 * RS + o + 8 * hf), gg = *(const v4u*)(RWF + 8 * RS + o + 8 * hf); float r[8];
#pragma unroll
        for (int w = 0; w < 4; ++w) { const int e = 8 * hf + 2 * w;
            r[2 * w] = (y[e] * rstd * lg[e] + lb[e] + sbv * bflo(vv[w])) * bflo(gg[w]); r[2 * w + 1] = (y[e + 1] * rstd * lg[e + 1] + lb[e + 1] + sbv * bfhi(vv[w])) * bfhi(gg[w]); }
        v4u ov; ov.x = pk2(r[0], r[1]); ov.y = pk2(r[2], r[3]); ov.z = pk2(r[4], r[5]); ov.w = pk2(r[6], r[7]); *(v4u*)(dst + 8 * hf) = ov; }
}

#ifndef W_OUT_K1
#define W_OUT_K1 2048
#endif
struct MlaTiles { gcbf KV; gcbf KR; int ctx_row0, lat_row0, h;
    __device__ __forceinline__ att::Tile operator()(int j) const { const int row = j < 4 ? ctx_row0 + 64 * j : lat_row0 + 64 * (j - 4);
        att::Tile t; t.kn = KV + (size_t)row * 2048 + h * 256; t.v = t.kn + 128; t.kr = KR + (size_t)row * 64; t.mtype = 0; t.krel0 = 0; return t; } };
struct SwaTiles { gcbf P; int blk_row0, ctx_row0, kvh, nwin, has_prev, has_next;
    __device__ __forceinline__ att::Tile operator()(int j) const { att::Tile t; int row; t.mtype = 0; t.krel0 = 0;
        if (j >= nwin) row = ctx_row0 + 64 * (j - nwin);
        else if (j < 2) row = blk_row0 + 64 * j;
        else if (has_prev && j < 4) { row = blk_row0 - 128 + 64 * (j - 2); t.mtype = 1; t.krel0 = -128 + 64 * (j - 2); }
        else { const int sub = j - 2 - 2 * has_prev; row = blk_row0 + 128 + 64 * sub; t.mtype = 2; t.krel0 = 128 + 64 * sub; }
        t.kn = P + (size_t)row * DINP + C_SWAK + kvh * 128; t.v = P + (size_t)row * DINP + C_SWAV + kvh * 128; t.kr = nullptr; return t; } };

#ifndef MLA_SDEPTH
#define MLA_SDEPTH 1
#endif
__device__ __forceinline__ void mla_item(Frame& F, int b, int h, int qb, bool ctxq) {
    F.tid = ltid(); F.lane = F.tid & 63;
    const int r32 = F.lane & 31; const int t = qb * 256 + F.wave * 32 + r32;
    const int roww0 = ctxq ? M_LAT + b * NCTX + F.wave * 32 : b * SEQ + qb * 256 + F.wave * 32;
    gcbf Qw = (gcbf)(F.ws + WS_Q) + (size_t)(roww0 + r32) * 1536 + h * 192;
    MlaTiles ts{(gcbf)(F.ws + WS_KV), (gcbf)(F.ws + WS_KR), M_LAT + b * NCTX, b * SEQ, h};
    gbfp Ow = (gbfp)(F.ws + WS_MIX) + (size_t)roww0 * DM + 2048 + h * 128;
    att::attn_body<192, 2048, 2048, false, false, MLA_SDEPTH>(Qw, ctxq ? 0 : 1, t >> 6, t & 63, (gcfl)(F.ws + WS_ROPE), 0, 0.f, ts, ctxq ? 4 : 132, Ow, (LAS char*)F.lds);
}
__device__ __forceinline__ void swa_item(Frame& F, int l, int b, int n, int kvh, int half, bool ctxq, int hq_ctx) {
    F.tid = ltid(); F.lane = F.tid & 63;
    const int r32 = F.lane & 31; gcbf P = (gcbf)(F.ws + WS_P);
    int hq, qi, roww0, t;
    if (ctxq) { hq = hq_ctx; kvh = hq >> 2; qi = 0; roww0 = M_LAT + b * NCTX + F.wave * 32; t = 0; }
    else { hq = kvh * 4 + 2 * half + (F.wave >> 2); qi = (F.wave & 3) * 32 + r32; roww0 = b * SEQ + n * 128 + (F.wave & 3) * 32; t = n * 128 + qi; }
    gcbf Qw = P + (size_t)(roww0 + r32) * DINP + C_SWAQ + hq * 128;
    SwaTiles ts; ts.P = P; ts.blk_row0 = b * SEQ + n * 128; ts.ctx_row0 = M_LAT + b * NCTX; ts.kvh = kvh;
    ts.has_prev = (!ctxq && n > 0) ? 1 : 0; ts.has_next = (!ctxq && n < SEQ / 128 - 1) ? 1 : 0; ts.nwin = ctxq ? 0 : 2 + 2 * ts.has_prev + 2 * ts.has_next;
    gbfp Ow = (gbfp)(F.ws + WS_MIX) + (size_t)roww0 * DM + hq * 128;
    const float sink_l2 = F.A->in[I_SINK][l * 8 + hq] * 1.4426950408889634f;
    att::attn_body<128, DINP, DINP, true, true, 2>(Qw, 0, 0, 0, (gcfl)nullptr, qi, sink_l2, ts, ts.nwin + 4, Ow, (LAS char*)F.lds);
}

#ifndef DBG_PHASES
#define DBG_PHASES 0xfffff
#endif
#define PH(n) ((DBG_PHASES >> (n)) & 1)
#ifndef DUP_PHASES
#define DUP_PHASES 0
#endif
#define REP(n) _Pragma("unroll") for (int rep_ = 0; rep_ < (((DUP_PHASES >> (n)) & 1) ? 2 : 1); ++rep_)
__global__ void __launch_bounds__(NTHR, 2) mk_fwd(Args args) {
    extern __shared__ __attribute__((aligned(16))) unsigned char lds[];
    Frame F;
    F.lds = (LAS unsigned char*)lds;
    F.tid = threadIdx.x; F.lane = F.tid & 63; F.wave = __builtin_amdgcn_readfirstlane(F.tid >> 6);
    F.G = gridDim.x; { const int bx = blockIdx.x; F.vcu = (F.G % 8 == 0) ? (bx % 8) * (F.G / 8) + bx / 8 : bx; }
    F.gw = F.vcu * NWAVES + F.wave; F.NGW = F.G * NWAVES;
    F.ws = args.ws; F.out = args.out; F.ctl = (gu32*)(args.ws + WS_CTL);
    F.A = (const __attribute__((address_space(4))) Args*)__builtin_amdgcn_kernarg_segment_ptr();
    for (int u = F.tid; u < (LDS_BYTES - LDSCTL_OFF) / 4; u += NTHR) ((LAS unsigned*)(F.lds + LDSCTL_OFF))[u] = 0u;
    __syncthreads();
    XcdBarrier bar = xcd_barrier_post((unsigned*)(args.ws + WS_CTL) + 4096, (volatile LAS unsigned*)(F.lds + MISC_OFF) + 8);
    const bool rwkv_blk = (blockIdx.x & 3) == 0;
    XcdBarrier bar2; bar2.bar = (unsigned*)(args.ws + WS_CTL) + 8192; bar2.x = 0; bar2.st = (volatile LAS unsigned*)(F.lds + MISC_OFF) + 12; bar2.nparts = gridDim.x - ((gridDim.x + 3) >> 2);
    if (!rwkv_blk) { const unsigned np_ = bar2.nparts; bar2 = xcd_barrier_post((unsigned*)(args.ws + WS_CTL) + 8192, (volatile LAS unsigned*)(F.lds + MISC_OFF) + 12); bar2.nparts = np_; }
#define SUB_BAR() do { bar2.bar = launder(bar2.bar); bar2.x = launder(bar2.x); xcd_barrier(bar2); F.ws = launder_g(F.ws); F.wsw = F.ws + (size_t)lcur * WSET_STRIDE; F.A = launder(F.A); F.tid = ltid(); F.lane = F.tid & 63; } while (0)
#define GRID_BAR() do { bar.bar = launder(bar.bar); bar.x = launder(bar.x); xcd_barrier(bar); F.ws = launder_g(F.ws); F.wsw = F.ws + (size_t)lcur * WSET_STRIDE; F.A = launder(F.A); F.tid = ltid(); F.lane = F.tid & 63; } while (0)
    const int bx = blockIdx.x; int lcur = 0; F.wsw = F.ws;
    bf16* H = (bf16*)(F.ws + WS_H); float* X = (float*)(F.ws + WS_X);

    REP(0) if (PH(0)) { mod_partials(F);
    convert_weights(F, 0, F.gw, F.NGW); }
    GRID_BAR();
    if (PH(1)) { mod_reduce(F); rope_table(F); }
    GRID_BAR();

#pragma unroll 1
    for (int l = 0; l < 2; ++l) {
        lcur = l; F.wsw = F.ws + (size_t)l * WSET_STRIDE;
        const bool wctx = (l == 0);
        const int MO = wctx ? M_TOT : M_LAT;
        if (PH(2) && l == 0) {
            for (int row = F.gw; row < M_TOT; row += F.NGW) { const int s = row_s(row);
                const float* xs = row < M_LAT ? F.A->in[I_X] + (size_t)row * DM : F.A->in[I_CTX] + (size_t)(row - M_LAT) * DM;
                ln_row<0>(F, xs, nullptr, nullptr, nullptr, nullptr, nullptr, true, mod_ptr(F, 0, s, 1), mod_ptr(F, 0, s, 0), H + (size_t)row * DM); }
        }
        GRID_BAR();
        REP(3) if (PH(3)) { pg8::Gemm g{H, (const bf16*)(F.wsw + WS_WIN), M_TOT, DINP, DM, DM, DM}; pg8::StaticOrder S; S.init(M_TOT, DINP, F.G, bx);
          pg8::EpiBf16<0> E{(bf16*)(F.ws + WS_P), DINP, nullptr};
          pg8::gemm_phase<pg8::EpiBf16<0>, pg8::StaticOrder, true, true>(F.lds, g, S, E); }
        GRID_BAR();
        REP(4) if (PH(4)) for (int it = F.vcu; it < 528; it += F.G) rwkv_feat_item(F, l, it);
        REP(5) if (PH(5)) { if (F.G == 256) { if (F.vcu < 16) { for (int it = F.vcu; it < 64; it += 16) lru_item<false>(F, l, it); }
                                              else { for (int it = 64 + F.vcu - 16; it < 2 * NCH * 8; it += 240) lru_item<false>(F, l, it); } }
                            else for (int it = F.vcu; it < 2 * NCH * 8; it += F.G) lru_item<false>(F, l, it); }
        __syncthreads();
        if (PH(6)) for (int row = F.gw; row < M_TOT; row += F.NGW) row_prep(F, row);
        GRID_BAR();
        REP(8) if (rwkv_blk) { const int nrw = (F.G + 3) >> 2; REP(18) if (PH(8)) for (int chain = bx >> 2; chain < 64; chain += nrw) rwkv_scan(F, l, chain); }
        else REP(19) { const int aw = (bx >> 2) * 3 + (bx & 3) - 1, naw = F.G - ((F.G + 3) >> 2);
            if (PH(7) && aw < 8) lru_carry(F, aw);
            if (PH(7)) { pg8::Gemm g{(const bf16*)(F.ws + WS_P) + C_QA, (const bf16*)(F.wsw + WS_WQB), M_TOT, 1536, 1024, DINP, 1024}; pg8::StaticOrder S; S.init(M_TOT, 1536, naw, aw);
              pg8::EpiBf16<2> E{(bf16*)(F.ws + WS_Q), 1536, (const float*)(F.ws + WS_RSQ)};
              pg8::gemm_phase<pg8::EpiBf16<2>, pg8::StaticOrder, true, true>(F.lds, g, S, E); }
            if (PH(7)) { pg8::Gemm g{(const bf16*)(F.ws + WS_P) + C_KVA, (const bf16*)(F.wsw + WS_WKVB), M_TOT, 2048, 512, DINP, 512}; pg8::StaticOrder S; S.init(M_TOT, 2048, naw, aw);
              pg8::EpiBf16<2> E{(bf16*)(F.ws + WS_KV), 2048, (const float*)(F.ws + WS_RSKV)};
              pg8::gemm_phase<pg8::EpiBf16<2>, pg8::StaticOrder, true, true>(F.lds, g, S, E); }
            SUB_BAR();
            if (PH(9)) for (int it = aw; it < 512; it += naw) mla_item(F, it >> 8, (it >> 5) & 7, it & 31, false);
            if (PH(9) && wctx) for (int it = aw; it < 16; it += naw) mla_item(F, it >> 3, it & 7, 0, true);
            if (PH(10)) for (int it = aw; it < 512; it += naw) swa_item(F, l, it >> 8, (it >> 2) & 63, (it >> 1) & 1, it & 1, false, 0);
            if (PH(10) && wctx) for (int it = aw; it < 16; it += naw) swa_item(F, l, it >> 3, 0, 0, 0, true, it & 7);
            if (PH(11)) for (int it = aw; it < 2 * NCH * 8; it += naw) { if (!wctx && ((it >> 3) % NCH) < 8) continue; lru_item<true>(F, l, it); }
            if (l == 0) { __syncthreads(); convert_weights(F, 1, aw * NWAVES + F.wave, naw * NWAVES); }
            else { SUB_BAR();
                pg8::Gemm g{(const bf16*)(F.ws + WS_MIX), (const bf16*)(F.wsw + WS_WOUT), M_LAT, DM, W_OUT_K1, DM, DM}; pg8::StaticOrder S; S.init(M_LAT, DM, naw, aw);
                pg8::EpiBf16<0> E{(bf16*)(F.ws + WS_Y1), DM, nullptr};
                pg8::gemm_phase<pg8::EpiBf16<0>, pg8::StaticOrder, true, true>(F.lds, g, S, E); }
        }
        GRID_BAR();
        REP(12) if (PH(12)) for (int row = F.gw; row < MO; row += F.NGW) rwkv_out_row(F, l, row);
        GRID_BAR();
        REP(13) if (PH(13)) {
          if (l == 0) { pg8::Gemm g{(const bf16*)(F.ws + WS_MIX), (const bf16*)(F.wsw + WS_WOUT), M_LAT, DM, DM, DM, DM}; pg8::StaticOrder S; S.init(M_LAT, DM, F.G, bx);
            pg8::EpiBf16<0> E{(bf16*)(F.ws + WS_Y1), DM, nullptr};
            pg8::gemm_phase<pg8::EpiBf16<0>, pg8::StaticOrder, true, true>(F.lds, g, S, E); }
          else { pg8::Gemm g{(const bf16*)(F.ws + WS_MIX) + W_OUT_K1, (const bf16*)(F.wsw + WS_WOUT) + W_OUT_K1, M_LAT, DM, DM - W_OUT_K1, DM, DM}; pg8::StaticOrder S; S.init(M_LAT, DM, F.G, bx);
            pg8::EpiBf16<3> E{(bf16*)(F.ws + WS_Y1), DM, nullptr};
            pg8::gemm_phase<pg8::EpiBf16<3>, pg8::StaticOrder, true, true>(F.lds, g, S, E); }
          if (wctx) {
              pg8::Gemm g2{(const bf16*)(F.ws + WS_MIX) + (size_t)M_LAT * DM, (const bf16*)(F.wsw + WS_WOUT), M_CTX, DM, DM / 8, DM, DM}; pg8::SplitOrder S2; S2.init(M_CTX, DM, DM / 8, bx);
              pg8::EpiF32 E2{(float*)(F.ws + WS_YP), DM, (size_t)M_CTX * DM};
              pg8::gemm_phase<pg8::EpiF32, pg8::SplitOrder, true, true>(F.lds, g2, S2, E2); } }
        GRID_BAR();
        if (PH(14)) for (int row = F.gw; row < MO; row += F.NGW) { const int s = row_s(row);
            const float* xs = (l == 0) ? (row < M_LAT ? F.A->in[I_X] + (size_t)row * DM : F.A->in[I_CTX] + (size_t)(row - M_LAT) * DM) : X + (size_t)row * DM;
            bf16* yrow = (bf16*)(F.ws + WS_Y1) + (size_t)row * DM;
            if (row >= M_LAT) sum_partials_row(F, (const float*)(F.ws + WS_YP) + (size_t)(row - M_LAT) * DM, (size_t)M_CTX * DM, yrow);
            ln_row<1>(F, xs, yrow, mod_ptr(F, l, s, 2), F.A->in[I_LN1G] + l * DM, F.A->in[I_LN1B] + l * DM, X + (size_t)row * DM,
                      true, mod_ptr(F, l, s, 4), mod_ptr(F, l, s, 3), H + (size_t)row * DM); }
        GRID_BAR();
        REP(15) if (PH(15)) { pg8::Gemm g{H, (const bf16*)(F.wsw + WS_WFF1), MO, DFF, DM, DM, DM}; pg8::StaticOrder S; S.init(MO, DFF, F.G, bx);
          pg8::EpiBf16<1> E{(bf16*)(F.ws + WS_HID), DFF, nullptr};
          pg8::gemm_phase<pg8::EpiBf16<1>, pg8::StaticOrder, true, true>(F.lds, g, S, E); }
        GRID_BAR();
        REP(16) if (PH(16)) { pg8::Gemm g{(const bf16*)(F.ws + WS_HID), (const bf16*)(F.wsw + WS_WFF2), M_LAT, DM, DFF, DFF, DFF}; pg8::StaticOrder S; S.init(M_LAT, DM, F.G, bx);
          pg8::EpiBf16<0> E{(bf16*)(F.ws + WS_Y2), DM, nullptr};
          pg8::gemm_phase<pg8::EpiBf16<0>, pg8::StaticOrder, true, true>(F.lds, g, S, E);
          if (wctx) {
              pg8::Gemm g2{(const bf16*)(F.ws + WS_HID) + (size_t)M_LAT * DFF, (const bf16*)(F.wsw + WS_WFF2), M_CTX, DM, DFF / 8, DFF, DFF}; pg8::SplitOrder S2; S2.init(M_CTX, DM, DFF / 8, bx);
              pg8::EpiF32 E2{(float*)(F.ws + WS_YP), DM, (size_t)M_CTX * DM};
              pg8::gemm_phase<pg8::EpiF32, pg8::SplitOrder, true, true>(F.lds, g2, S2, E2); } }
        GRID_BAR();
        if (!PH(17)) {} else if (l == 0) {
            for (int row = F.gw; row < M_TOT; row += F.NGW) { const int s = row_s(row);
                bf16* yrow = (bf16*)(F.ws + WS_Y2) + (size_t)row * DM;
                if (row >= M_LAT) sum_partials_row(F, (const float*)(F.ws + WS_YP) + (size_t)(row - M_LAT) * DM, (size_t)M_CTX * DM, yrow);
                ln_row<1>(F, X + (size_t)row * DM, yrow, mod_ptr(F, 0, s, 5), F.A->in[I_LN2G], F.A->in[I_LN2B], X + (size_t)row * DM,
                          true, mod_ptr(F, 1, s, 1), mod_ptr(F, 1, s, 0), H + (size_t)row * DM); }
        } else {
            for (int row = F.gw; row < M_LAT; row += F.NGW) { const int s = row_s(row);
                ln_row<1>(F, X + (size_t)row * DM, (const bf16*)(F.ws + WS_Y2) + (size_t)row * DM, mod_ptr(F, 1, s, 5), F.A->in[I_LN2G] + DM, F.A->in[I_LN2B] + DM, F.out + (size_t)row * DM,
                          false, nullptr, nullptr, nullptr); }
        }
    }
}

extern "C" void kernel_launch(void* const* d_in, const int* in_sizes, int n_in, void* d_out, int out_size, void* d_ws, size_t ws_size, hipStream_t stream) {
    static int grid = 0;
    if (grid == 0) {
        if (n_in != 38 || out_size != M_LAT * DM || ws_size < WS_END) { fprintf(stderr, "kernel_launch: unexpected shapes: n_in %d out %d ws %zu (need %zu)\n", n_in, out_size, ws_size, (size_t)WS_END); grid = -1; return; }
        int dev = 0, cus = 0, per_cu = 0;
        if (hipGetDevice(&dev) != hipSuccess || hipDeviceGetAttribute(&cus, hipDeviceAttributeMultiprocessorCount, dev) != hipSuccess) { grid = -1; return; }
        if (hipFuncSetAttribute((const void*)mk_fwd, hipFuncAttributeMaxDynamicSharedMemorySize, LDS_BYTES) != hipSuccess) { fprintf(stderr, "kernel_launch: hipFuncSetAttribute failed\n"); grid = -1; return; }
        if (hipOccupancyMaxActiveBlocksPerMultiprocessor(&per_cu, (const void*)mk_fwd, NTHR, LDS_BYTES) != hipSuccess || per_cu < 1) fprintf(stderr, "kernel_launch: occupancy query says %d\n", per_cu);
        (void)hipGetLastError();
        grid = cus;
    }
    if (grid < 0) return;
    if (hipMemsetAsync((char*)d_ws + WS_CTL, 0, CTL_ZERO_BYTES, stream) != hipSuccess) return;
    Args a{};
    for (int i = 0; i < 38; ++i) a.in[i] = (const float*)d_in[i];
    a.out = (float*)d_out; a.ws = (unsigned char*)d_ws;
    hipLaunchKernelGGL(mk_fwd, dim3(grid), dim3(NTHR), LDS_BYTES, stream, a);
    const hipError_t le = hipPeekAtLastError();
    if (le != hipSuccess) fprintf(stderr, "kernel_launch: launch failed: %s\n", hipGetErrorName(le));
}
```

```cpp
#include <hip/hip_runtime.h>
#include <hip/hip_bf16.h>
#include <cstdio>
#include <cstdint>

namespace pg8 {
#define PG8_LAS __attribute__((address_space(3)))
typedef unsigned short bf16_t;
typedef short bf16x8 __attribute__((ext_vector_type(8)));
typedef float f32x4 __attribute__((ext_vector_type(4)));
typedef unsigned u32x4 __attribute__((ext_vector_type(4)));
constexpr int BM = 256, BK = 64, HALF = 128, HTB = HALF * BK * 2  , STAGE_BYTES = 8 * HTB, NXCD = 8, WGM = 8;

__host__ __device__ __forceinline__ int lds_byte(int r, int c) { const int st = (r >> 4) * 2 + (c >> 5), rr = r & 15, cc = c & 31, ob = rr * 64 + cc * 2; return st * 1024 + (ob ^ (((ob >> 9) & 1) << 5)); }
__host__ __device__ __forceinline__ void stage_rc(int b, int& R, int& C) { const int st = b / 1024, sb = b % 1024, swz = sb ^ (((sb >> 9) & 1) << 5); R = (st >> 1) * 16 + swz / 64; C = (st & 1) * 32 + (swz % 64) / 2; }
__host__ __device__ __forceinline__ int perm32(int rho) { const int n = rho >> 4, i = rho & 15; return 8 * (i >> 2) + 4 * n + (i & 3); }

struct Unit { int pm, pn, ko, ks; };
struct Gemm { const bf16_t* A; const bf16_t* Bt; int M, N, K, lda, ldb; };

struct StaticOrder {
    int nM, nN, nwg, G, c;
    __host__ __device__ void init(int M, int N, int G_, int c_) { nM = M / BM; nN = N / BM; nwg = nM * nN; G = G_; c = c_; }
    __host__ __device__ bool next(int i, Unit& u) const {
        const long L = (long)i * G + c; if (L >= nwg) return false;
        int wgid = (int)L; { const int q = nwg / NXCD, r = nwg % NXCD, xcd = wgid % NXCD, off = wgid / NXCD; wgid = (xcd < r ? xcd * (q + 1) : r * (q + 1) + (xcd - r) * q) + off; }
        const int nig = WGM * nN, gid = wgid / nig, fm = gid * WGM, gsz = (nM - fm) < WGM ? (nM - fm) : WGM;
        u.pm = fm + ((wgid % nig) % gsz); u.pn = (wgid % nig) / gsz; u.ko = 0; u.ks = 0; return true;
    }
    __device__ __forceinline__ void a_ready(const Unit&) const {}
    __device__ __forceinline__ void done(const Unit&) const {}
};
struct SplitOrder {
    int nN, nitems, kslice, c;
    __host__ __device__ void init(int M, int N, int Kslice, int c_) { nN = N / BM; nitems = (M / BM) * nN * 8; kslice = Kslice; c = c_; }
    __host__ __device__ bool next(int i, Unit& u) const { if (i > 0 || c >= nitems) return false; u.ks = c & 7; u.ko = u.ks * kslice; u.pn = (c >> 3) % nN; u.pm = (c >> 3) / nN; return true; }
    __device__ __forceinline__ void a_ready(const Unit&) const {}
    __device__ __forceinline__ void done(const Unit&) const {}
};

__device__ __forceinline__ unsigned cvt_pk_bf16(float lo, float hi) { unsigned r; asm volatile("v_cvt_pk_bf16_f32 %0, %1, %2" : "=v"(r) : "v"(lo), "v"(hi)); return r; }

struct EpiF32 {
    static constexpr bool PERM = false, AFTER_DRAIN = false;
    float* C; int ldc; size_t split_stride;
    __device__ __forceinline__ void operator()(const f32x4 (&acc)[2][2][4][2], const Unit& u, int wr, int wc, int fr, int fq) const {
        const int row0 = u.pm * BM + wr * 64 + fr, col0 = u.pn * BM + wc * 32 + 4 * fq; float* Cb = C + (size_t)u.ks * split_stride;
#pragma unroll
        for (int ai = 0; ai < 2; ++ai)
#pragma unroll
            for (int m = 0; m < 4; ++m) { float* rowp = Cb + (size_t)(row0 + ai * HALF + m * 16) * ldc + col0;
#pragma unroll
                for (int bj = 0; bj < 2; ++bj)
#pragma unroll
                    for (int n = 0; n < 2; ++n) *(f32x4*)(rowp + bj * HALF + n * 16) = acc[ai][bj][m][n]; }
    }
};
template <int ACT> struct EpiBf16 {
    static constexpr bool PERM = true, AFTER_DRAIN = false;
    bf16_t* O; int ldc; const float* rowscale;
    __device__ __forceinline__ void operator()(const f32x4 (&acc)[2][2][4][2], const Unit& u, int wr, int wc, int fr, int fq) const {
        const int row0 = u.pm * BM + wr * 64 + fr; const int col0 = u.pn * BM + wc * 32 + 8 * fq;
#pragma unroll
        for (int ai = 0; ai < 2; ++ai)
#pragma unroll
            for (int m = 0; m < 4; ++m) { const int row = row0 + ai * HALF + m * 16; bf16_t* rowp = O + (size_t)row * ldc + col0;
                float rs = 1.f; if (ACT == 2) rs = rowscale[row];
#pragma unroll
                for (int bj = 0; bj < 2; ++bj) { f32x4 v0 = acc[ai][bj][m][0], v1 = acc[ai][bj][m][1];
                    if (ACT == 1) {
#pragma unroll
                        for (int j = 0; j < 4; ++j) { const float a = fmaxf(v0[j], 0.f), b = fmaxf(v1[j], 0.f); v0[j] = a * a; v1[j] = b * b; } }
                    if (ACT == 2) { v0 = v0 * rs; v1 = v1 * rs; }
                    if (ACT == 3) { const u32x4 o = *(const u32x4*)(rowp + bj * HALF);
                        v0[0] += __builtin_bit_cast(float, o.x << 16); v0[1] += __builtin_bit_cast(float, o.x & 0xffff0000u); v0[2] += __builtin_bit_cast(float, o.y << 16); v0[3] += __builtin_bit_cast(float, o.y & 0xffff0000u);
                        v1[0] += __builtin_bit_cast(float, o.z << 16); v1[1] += __builtin_bit_cast(float, o.z & 0xffff0000u); v1[2] += __builtin_bit_cast(float, o.w << 16); v1[3] += __builtin_bit_cast(float, o.w & 0xffff0000u); }
                    u32x4 w; w.x = cvt_pk_bf16(v0[0], v0[1]); w.y = cvt_pk_bf16(v0[2], v0[3]); w.z = cvt_pk_bf16(v1[0], v1[1]); w.w = cvt_pk_bf16(v1[2], v1[3]);
                    *(u32x4*)(rowp + bj * HALF) = w; } }
    }
};

template <class Epi, class Sched, bool ALIGN_EPI = false, bool SP2 = false>
__device__ __forceinline__ void gemm_phase(PG8_LAS unsigned char* lds, const Gemm g, const Sched& S, const Epi& E) {
    int tid = threadIdx.x; asm volatile("" : "+v"(tid));
    const int wid = __builtin_amdgcn_readfirstlane(tid >> 6), lane = tid & 63, wr = wid >> 2, wc = wid & 3, fr = lane & 15, fq = lane >> 4;
    const int K = g.K, nt = K / BK, lda = g.lda, ldb = g.ldb;
    unsigned voffA[2], voffB[2];
#pragma unroll
    for (int i = 0; i < 2; ++i) { int R, C; stage_rc(tid * 16 + i * 8192, R, C); const int Rb = Epi::PERM ? ((R & ~31) + perm32(R & 31)) : R;
        voffA[i] = (unsigned)(R * lda + C) * 2u; voffB[i] = (unsigned)(Rb * ldb + C) * 2u; }
    const size_t kstep = (size_t)(BK * 2);
    const size_t hstepA = (size_t)HALF * lda * 2, hstepB = (size_t)HALF * ldb * 2;
    const size_t tstepA = 2 * hstepA, tstepB = 2 * hstepB;
    const unsigned ldsw = (unsigned)wid * 1024u;
    const int aoff = lds_byte(wr * 64 + fr, fq * 8), boff = lds_byte(wc * 32 + fr, fq * 8);
#define PG8_SA(b, h) (((b) * 2 + (h)) * HTB)
#define PG8_SB(b, h) ((4 + (b) * 2 + (h)) * HTB)
#define PG8_STAGE(bufoff, gbase, voff) do { _Pragma("unroll") for (int _i = 0; _i < 2; ++_i) \
        __builtin_amdgcn_global_load_lds((const unsigned*)((const char*)(gbase) + (voff)[_i]), (PG8_LAS unsigned*)(lds + (bufoff) + ldsw + _i * 8192), 16, 0, 0); } while (0)
#define PG8_LDA(dst, b, h) do { _Pragma("unroll") for (int m = 0; m < 4; ++m) _Pragma("unroll") for (int k = 0; k < 2; ++k) dst[m][k] = *(const PG8_LAS bf16x8*)(lds + PG8_SA(b, h) + aoff + m * 2048 + k * 1024); } while (0)
#define PG8_LDB(dst, b, h) do { _Pragma("unroll") for (int n = 0; n < 2; ++n) _Pragma("unroll") for (int k = 0; k < 2; ++k) dst[n][k] = *(const PG8_LAS bf16x8*)(lds + PG8_SB(b, h) + boff + n * 2048 + k * 1024); } while (0)
#define PG8_MMA(ai, bj, At, Bt) do { __builtin_amdgcn_s_setprio(1); _Pragma("unroll") for (int m = 0; m < 4; ++m) _Pragma("unroll") for (int n = 0; n < 2; ++n) _Pragma("unroll") for (int k = 0; k < 2; ++k) \
        acc[ai][bj][m][n] = __builtin_amdgcn_mfma_f32_16x16x32_bf16(Bt[n][k], At[m][k], acc[ai][bj][m][n], 0, 0, 0); __builtin_amdgcn_s_setprio(0); } while (0)
#define PG8_WAIT_V(n) asm volatile("s_waitcnt vmcnt(" #n ")" ::: "memory")
#define PG8_WAIT_L(n) asm volatile("s_waitcnt lgkmcnt(" #n ")" ::: "memory")
#define PG8_BAR __builtin_amdgcn_s_barrier()
#define PG8_SCHED __builtin_amdgcn_sched_barrier(0)
    Unit cur, nxt; int ui = 0;
    if (!S.next(0, cur)) return;
    f32x4 acc[2][2][4][2];
#pragma unroll
    for (int a = 0; a < 2; ++a)
#pragma unroll
        for (int b = 0; b < 2; ++b)
#pragma unroll
            for (int m = 0; m < 4; ++m)
#pragma unroll
                for (int n = 0; n < 2; ++n) acc[a][b][m][n] = (f32x4){0.f, 0.f, 0.f, 0.f};
    bf16x8 At[4][2], B0[2][2], B1[2][2];
    const char* cA = (const char*)g.A + (size_t)cur.pm * tstepA + (size_t)cur.ko * 2; const char* cB = (const char*)g.Bt + (size_t)cur.pn * tstepB + (size_t)cur.ko * 2;
    S.a_ready(cur);
    if constexpr (SP2) {
        PG8_STAGE(PG8_SB(0, 0), cB, voffB); PG8_STAGE(PG8_SB(0, 1), cB + hstepB, voffB); PG8_STAGE(PG8_SA(0, 0), cA, voffA); PG8_STAGE(PG8_SA(0, 1), cA + hstepA, voffA);
        if (wr == 1) PG8_BAR;
        PG8_WAIT_V(2); PG8_BAR;
        PG8_STAGE(PG8_SB(1, 0), cB + kstep, voffB); PG8_STAGE(PG8_SA(1, 0), cA + kstep, voffA); PG8_STAGE(PG8_SB(1, 1), cB + hstepB + kstep, voffB);
        PG8_WAIT_V(6); PG8_BAR;
    } else {
        PG8_STAGE(PG8_SB(0, 0), cB, voffB); PG8_STAGE(PG8_SA(0, 0), cA, voffA); PG8_STAGE(PG8_SB(0, 1), cB + hstepB, voffB); PG8_STAGE(PG8_SA(0, 1), cA + hstepA, voffA);
        if (wr == 1) PG8_BAR;
        PG8_WAIT_V(4); PG8_BAR;
        PG8_STAGE(PG8_SB(1, 0), cB + kstep, voffB); PG8_STAGE(PG8_SA(1, 0), cA + kstep, voffA); PG8_STAGE(PG8_SB(1, 1), cB + hstepB + kstep, voffB);
        PG8_WAIT_V(6); PG8_BAR;
    }
    for (;;) {
        const bool has_next = S.next(ui + 1, nxt);
        const char* nA = has_next ? (const char*)g.A + (size_t)nxt.pm * tstepA + (size_t)nxt.ko * 2 : cA; const char* nB = has_next ? (const char*)g.Bt + (size_t)nxt.pn * tstepB + (size_t)nxt.ko * 2 : cB;
        for (int t = 0; t < nt; t += 2) {
            const bool last = (t == nt - 2);
            const char* a1 = cA + (size_t)(t + 1) * kstep;
            const char* a2 = last ? nA : cA + (size_t)(t + 2) * kstep; const char* b2 = last ? nB : cB + (size_t)(t + 2) * kstep;
            const char* a3 = a2 + kstep; const char* b3 = b2 + kstep;
            if (last && has_next) S.a_ready(nxt);
            if constexpr (SP2) {
            PG8_LDB(B0, 0, 0); PG8_LDB(B1, 0, 1); PG8_SCHED; PG8_LDA(At, 0, 0); PG8_STAGE(PG8_SA(1, 1), a1 + hstepA, voffA);
            PG8_WAIT_V(8); PG8_WAIT_L(0); PG8_BAR; PG8_MMA(0, 0, At, B0); PG8_MMA(0, 1, At, B1); PG8_BAR; PG8_SCHED;
            PG8_LDA(At, 0, 1); PG8_STAGE(PG8_SB(0, 0), b2, voffB); PG8_STAGE(PG8_SB(0, 1), b2 + hstepB, voffB); PG8_STAGE(PG8_SA(0, 0), a2, voffA);
            PG8_WAIT_V(8); PG8_WAIT_L(0); PG8_BAR; PG8_MMA(1, 0, At, B0); PG8_MMA(1, 1, At, B1); PG8_BAR; PG8_SCHED;
            PG8_LDB(B0, 1, 0); PG8_LDB(B1, 1, 1); PG8_SCHED; PG8_LDA(At, 1, 0); PG8_STAGE(PG8_SA(0, 1), a2 + hstepA, voffA);
            PG8_WAIT_V(8); PG8_WAIT_L(0); PG8_BAR; PG8_MMA(0, 0, At, B0); PG8_MMA(0, 1, At, B1); PG8_BAR; PG8_SCHED;
            PG8_LDA(At, 1, 1); PG8_STAGE(PG8_SB(1, 0), b3, voffB); PG8_STAGE(PG8_SB(1, 1), b3 + hstepB, voffB); PG8_STAGE(PG8_SA(1, 0), a3, voffA);
            PG8_WAIT_V(8); PG8_WAIT_L(0); PG8_BAR; PG8_MMA(1, 0, At, B0); PG8_MMA(1, 1, At, B1); PG8_BAR; PG8_SCHED;
            } else {
            PG8_LDB(B0, 0, 0); PG8_SCHED; PG8_LDA(At, 0, 0); PG8_STAGE(PG8_SA(1, 1), a1 + hstepA, voffA);
            PG8_WAIT_L(8); PG8_BAR; PG8_WAIT_L(0); PG8_MMA(0, 0, At, B0); PG8_BAR; PG8_SCHED;
            PG8_LDB(B1, 0, 1); PG8_STAGE(PG8_SB(0, 0), b2, voffB);
            PG8_BAR; PG8_WAIT_L(0); PG8_MMA(0, 1, At, B1); PG8_BAR;
            PG8_LDA(At, 0, 1); PG8_STAGE(PG8_SA(0, 0), a2, voffA);
            PG8_BAR; PG8_WAIT_L(0); PG8_MMA(1, 0, At, B0); PG8_BAR; PG8_SCHED;
            PG8_STAGE(PG8_SB(0, 1), b2 + hstepB, voffB);
            PG8_WAIT_V(6); PG8_BAR; PG8_MMA(1, 1, At, B1); PG8_BAR;
            PG8_LDB(B0, 1, 0); PG8_SCHED; PG8_LDA(At, 1, 0); PG8_STAGE(PG8_SA(0, 1), a2 + hstepA, voffA);
            PG8_WAIT_L(8); PG8_BAR; PG8_WAIT_L(0); PG8_MMA(0, 0, At, B0); PG8_BAR; PG8_SCHED;
            PG8_LDB(B1, 1, 1); PG8_STAGE(PG8_SB(1, 0), b3, voffB);
            PG8_BAR; PG8_WAIT_L(0); PG8_MMA(0, 1, At, B1); PG8_BAR;
            PG8_LDA(At, 1, 1); PG8_STAGE(PG8_SA(1, 0), a3, voffA);
            PG8_BAR; PG8_WAIT_L(0); PG8_MMA(1, 0, At, B0); PG8_BAR; PG8_SCHED;
            PG8_STAGE(PG8_SB(1, 1), b3 + hstepB, voffB);
            PG8_WAIT_V(6); PG8_BAR; PG8_MMA(1, 1, At, B1); PG8_BAR;
            }
        }
        if constexpr (ALIGN_EPI) { if (wr == 0) PG8_BAR; }
        E(acc, cur, wr, wc, fr, fq); S.done(cur);
        if (!has_next) break;
#pragma unroll
        for (int a = 0; a < 2; ++a)
#pragma unroll
            for (int b = 0; b < 2; ++b)
#pragma unroll
                for (int m = 0; m < 4; ++m)
#pragma unroll
                    for (int n = 0; n < 2; ++n) acc[a][b][m][n] = (f32x4){0.f, 0.f, 0.f, 0.f};
        cur = nxt; cA = nA; cB = nB; ++ui;
        if constexpr (ALIGN_EPI) { if (wr == 1) PG8_BAR; }
    }
    PG8_WAIT_V(0);
    if constexpr (!ALIGN_EPI) { if (wr == 0) PG8_BAR; }
    PG8_BAR;
#undef PG8_SA
#undef PG8_SB
#undef PG8_STAGE
#undef PG8_LDA
#undef PG8_LDB
#undef PG8_MMA
#undef PG8_WAIT_V
#undef PG8_WAIT_L
#undef PG8_BAR
#undef PG8_SCHED
}
}

constexpr int NWAVES = 8, NTHR = 512;
constexpr int DM = 4096, NB = 2, SEQ = 8192, NCTX = 256, DFF = 16384;
constexpr int M_LAT = NB * SEQ, M_CTX = NB * NCTX, M_TOT = M_LAT + M_CTX;
constexpr int DIN = 8672, DINP = 8704;
constexpr int C_SWAQ = 0, C_SWAK = 1024, C_SWAV = 1280, C_LRUX = 1536, C_LRUY = 2560, C_QA = 3584, C_KVA = 4608, C_KR = 5120, C_RW = 5184;
constexpr int C_RWR = C_RW, C_RWK = C_RW + 1024, C_RWV = C_RW + 2048, C_RWL = C_RW + 3072;
constexpr int RWC = 3488;
constexpr float LN_EPS = 1e-5f, RMS_EPS = 1e-6f, GN_EPS = 64e-5f, ALPHA = 1.41421356237f;
constexpr int NCH = 264;

constexpr size_t MiB = 1u << 20;
constexpr size_t WS_CTL = 0, CTL_ZERO_BYTES = 1 * MiB;
constexpr size_t WS_MOD = 1 * MiB;
constexpr size_t WS_MODP = 2 * MiB;
constexpr size_t WS_SMALL = 20 * MiB;
constexpr size_t WS_RSQ = WS_SMALL;
constexpr size_t WS_RSKV = WS_RSQ + 128 * 1024;
constexpr size_t WS_SB = WS_RSKV + 128 * 1024;
constexpr size_t WS_CA = WS_SB + 2 * MiB;
constexpr size_t WS_CB = WS_CA + 5 * MiB;
constexpr size_t WS_HIN = WS_CB + 5 * MiB;
constexpr size_t WS_QUIRK = WS_HIN + 5 * MiB;
constexpr size_t WS_ROPE = WS_QUIRK + 8192;
static_assert(WS_ROPE + 16384 <= 40 * MiB, "small region");
constexpr size_t WS_W = 40 * MiB;
constexpr size_t WS_WIN = WS_W, WS_WOUT = WS_WIN + 68 * MiB, WS_WFF1 = WS_WOUT + 32 * MiB, WS_WFF2 = WS_WFF1 + 128 * MiB, WS_WQB = WS_WFF2 + 128 * MiB,
                 WS_WKVB = WS_WQB + 3 * MiB, WS_WLRU = WS_WKVB + 2 * MiB, WS_WLORA = WS_WLRU + 1 * MiB;
constexpr size_t WS_W2T = WS_WLORA, WS_A2T = WS_W2T + 256 * 1024, WS_G2T = WS_A2T + 256 * 1024;
constexpr size_t WS_X = 403 * MiB;
constexpr size_t WS_H = 667 * MiB;
constexpr size_t WS_MIX = 799 * MiB;
constexpr size_t WS_YS = 931 * MiB;
constexpr size_t WS_P = 1063 * MiB;
constexpr size_t WS_RWF = 1344 * MiB;
constexpr size_t RWF_STRIDE = (size_t)M_TOT * 1024 * 2;
constexpr size_t WS_Q = 1641 * MiB;
constexpr size_t WS_KV = 1691 * MiB;
constexpr size_t WS_KR = 1757 * MiB;
constexpr size_t WS_SET2 = 1760 * MiB;
constexpr size_t WSET_STRIDE = WS_SET2 - WS_W;
constexpr size_t WS_END = WS_SET2 + 363 * MiB;
constexpr size_t WS_YP = WS_Q;
constexpr size_t WS_HID = WS_P;
constexpr size_t WS_Y1 = WS_P;
constexpr size_t WS_Y2 = WS_MIX;
static_assert(WS_WLORA + 1 * MiB <= WS_X && WS_P + (size_t)M_TOT * DINP * 2 <= WS_RWF && WS_RWF + 9 * RWF_STRIDE <= WS_Q, "ws map");
static_assert(WS_HID + (size_t)M_TOT * DFF * 2 <= WS_Q && WS_Y2 + (size_t)M_TOT * DM * 4 <= WS_P && WS_YS + 2 * (size_t)M_TOT * 1024 * 4 <= WS_P, "ws overlays");
static_assert(WS_KR + (size_t)M_TOT * 64 * 2 <= WS_SET2 && WS_YP + 8 * (size_t)M_CTX * DM * 4 <= WS_KR, "ws end");

constexpr int RING_BYTES = 131072;
constexpr int LDSCTL_OFF = RING_BYTES, MISC_OFF = LDSCTL_OFF + 320;
constexpr int LDS_BYTES = 147456;

#define GAS __attribute__((address_space(1)))
#define LAS __attribute__((address_space(3)))
typedef unsigned short bf16;
typedef unsigned v4u __attribute__((ext_vector_type(4)));
typedef unsigned v2u __attribute__((ext_vector_type(2)));
typedef float f32x4 __attribute__((ext_vector_type(4)));
typedef float f32x2 __attribute__((ext_vector_type(2)));
typedef float f32x16 __attribute__((ext_vector_type(16)));
typedef short bf16x8 __attribute__((ext_vector_type(8)));
typedef short s16x4 __attribute__((ext_vector_type(4)));
typedef GAS unsigned gu32;
typedef const GAS bf16* gcbf; typedef GAS bf16* gbfp; typedef const GAS float* gcfl; typedef GAS float* gflp;
#define LDS_WAIT() asm volatile("s_waitcnt lgkmcnt(0)" ::: "memory")
#define VM_WAIT() asm volatile("s_waitcnt vmcnt(0)" ::: "memory")
__device__ __forceinline__ unsigned f2bf(float f) { unsigned u = __builtin_bit_cast(unsigned, f); return (u + 0x7fffu + ((u >> 16) & 1u)) >> 16; }
__device__ __forceinline__ unsigned pk2(float lo, float hi) { return f2bf(lo) | (f2bf(hi) << 16); }
__device__ __forceinline__ float bflo(unsigned w) { return __builtin_bit_cast(float, w << 16); }
__device__ __forceinline__ float bfhi(unsigned w) { return __builtin_bit_cast(float, w & 0xffff0000u); }
__device__ __forceinline__ float bf2f(bf16 h) { return __builtin_bit_cast(float, (unsigned)h << 16); }
#define DPP_ADD(x, ctrl) ((x) + __builtin_bit_cast(float, __builtin_amdgcn_update_dpp(0, __builtin_bit_cast(int, (x)), (ctrl), 0xf, 0xf, false)))
__device__ __forceinline__ float row_sum16(float x) { x = DPP_ADD(x, 0x128); x = DPP_ADD(x, 0x124); x = DPP_ADD(x, 0x122); x = DPP_ADD(x, 0x121); return x; }
#ifdef OLD_SUMS
__device__ __forceinline__ float wave_sum(float v) {
#pragma unroll
    for (int o = 1; o < 64; o <<= 1) v += __shfl_xor(v, o);
    return v;
}
__device__ __forceinline__ float half_swap_sum(float x) { return x + __shfl_xor(x, 32); }
__device__ __forceinline__ float quad_sum(float x) { x += __shfl_xor(x, 1); x += __shfl_xor(x, 2); return x; }
#else
__device__ __forceinline__ float wave_sum(float v) {
    const float r = row_sum16(v);
    const float a = __builtin_bit_cast(float, __builtin_amdgcn_readlane(__builtin_bit_cast(int, r), 0)), b = __builtin_bit_cast(float, __builtin_amdgcn_readlane(__builtin_bit_cast(int, r), 16));
    const float c = __builtin_bit_cast(float, __builtin_amdgcn_readlane(__builtin_bit_cast(int, r), 32)), d = __builtin_bit_cast(float, __builtin_amdgcn_readlane(__builtin_bit_cast(int, r), 48));
    return (a + b) + (c + d);
}
__device__ __forceinline__ float half_swap_sum(float x) {
    unsigned a = __builtin_bit_cast(unsigned, x), b = a; asm volatile("" : "+v"(b));
    auto rr = __builtin_amdgcn_permlane32_swap(a, b, false, false);
    const float lo = __uint_as_float(rr[0]), hi = __uint_as_float(rr[1]); return lo + hi;
}
__device__ __forceinline__ float quad_sum(float x) { x = DPP_ADD(x, 0xB1); x = DPP_ADD(x, 0x4E); return x; }
#endif
__device__ __forceinline__ float sigmoidf_(float x) { return __builtin_amdgcn_rcpf(1.f + __expf(-x)); }
__device__ __forceinline__ float softplusf_(float x) { return x > 20.f ? x : __logf(1.f + __expf(x)); }
__device__ __forceinline__ float tanhf_(float x) { const float e = __expf(2.f * x); return 1.f - 2.f * __builtin_amdgcn_rcpf(e + 1.f); }
__device__ __forceinline__ int ltid() { int t = threadIdx.x; asm volatile("" : "+v"(t)); return t; }
template <class T> __device__ __forceinline__ T ldg(const void* base, unsigned byteoff) { return *(const T*)((const char*)base + byteoff); }
template <class T> __device__ __forceinline__ void stg(void* base, unsigned byteoff, T v) { *(T*)((char*)base + byteoff) = v; }

#define XB_TMO      128
#define XB_XCNT(j)  (256  + 64 * (j))
#define XB_XSUB(j)  (1280 + 64 * (j))
#define XB_XGEN(j)  (2304 + 64 * (j))
#define XB_TOP      3328
#define XB_TOPGEN   3392
#define XCD_BAR_WORDS 3456
#define XB_SPIN_CAP (1u << 18)

__device__ __forceinline__ unsigned xb_ld(unsigned* p)              { return __hip_atomic_load(p, __ATOMIC_RELAXED, __HIP_MEMORY_SCOPE_AGENT); }
__device__ __forceinline__ unsigned xb_add(unsigned* p, unsigned v) { return __hip_atomic_fetch_add(p, v, __ATOMIC_RELAXED, __HIP_MEMORY_SCOPE_AGENT); }
__device__ __forceinline__ unsigned xb_xcc_id() { return (unsigned)__builtin_amdgcn_s_getreg((3 << 11) | 20) & 0xFu; }
#define XB_SPIN(cond, bar) do { unsigned _sp = 0; while (cond) { __builtin_amdgcn_s_sleep(1); \
    if ((++_sp & 255u) == 0u) { if (xb_ld(&(bar)[XB_TMO])) break; if (_sp > XB_SPIN_CAP) { atomicAdd(&(bar)[XB_TMO], 1u); break; } } } } while (0)

struct XcdBarrier {
    unsigned* bar; unsigned x;
    unsigned nparts;
    volatile LAS unsigned* st;
};

__device__ __forceinline__ XcdBarrier xcd_barrier_post(unsigned* bar, volatile LAS unsigned* st) {
    XcdBarrier b; b.bar = bar; b.x = xb_xcc_id(); b.st = st; b.nparts = 0u;
    if (threadIdx.x == 0) (void)xb_add(&bar[XB_XCNT(b.x)], 1u);
    return b;
}
__device__ __forceinline__ void xcd_barrier_complete(unsigned* bar, unsigned x, unsigned& nloc, unsigned& nx, unsigned nparts) {
    const unsigned G = nparts ? nparts : gridDim.x * gridDim.y * gridDim.z;
    unsigned sum, cnt, mine, sp = 0u;
    for (;;) {
        sum = 0u; cnt = 0u; mine = 0u;
#pragma unroll
        for (unsigned j = 0; j < 16; ++j) { const unsigned c = xb_ld(&bar[XB_XCNT(j)]); sum += c; cnt += (c > 0u) ? 1u : 0u; mine = (j == x) ? c : mine; }
        if (sum == G) break;
        __builtin_amdgcn_s_sleep(1);
        if ((++sp & 255u) == 0u) { if (xb_ld(&bar[XB_TMO])) break; if (sp > XB_SPIN_CAP) { atomicAdd(&bar[XB_TMO], 1u); break; } }
    }
    nloc = mine > 0u ? mine : 1u; nx = cnt > 0u ? cnt : 1u;
}

__device__ __forceinline__ void xcd_barrier(const XcdBarrier& b) {
    asm volatile("s_waitcnt vmcnt(0)" ::: "memory");
    __syncthreads();
    if (threadIdx.x == 0) {
        unsigned* bar = b.bar;
        __builtin_amdgcn_s_waitcnt(0);
        unsigned nloc = b.st[0], nx = b.st[1];
        if (nloc == 0u) { xcd_barrier_complete(bar, b.x, nloc, nx, b.nparts); b.st[0] = nloc; b.st[1] = nx; }
        const unsigned old = xb_add(&bar[XB_XSUB(b.x)], 1u);
        const unsigned gen = old / nloc;
        if (old + 1u == (gen + 1u) * nloc) {
            __builtin_amdgcn_fence(__ATOMIC_RELEASE, "agent");
            asm volatile("s_waitcnt vmcnt(0)" ::: "memory");
            const unsigned og = xb_add(&bar[XB_TOP], 1u);
            const unsigned tg = og / nx;
            if (og + 1u == (tg + 1u) * nx) xb_add(&bar[XB_TOPGEN], 1u);
            else XB_SPIN(xb_ld(&bar[XB_TOPGEN]) == tg, bar);
            __builtin_amdgcn_fence(__ATOMIC_ACQUIRE, "agent");
            xb_add(&bar[XB_XGEN(b.x)], 1u);
            asm volatile("s_waitcnt vmcnt(0)" ::: "memory");
        } else {
            XB_SPIN(xb_ld(&bar[XB_XGEN(b.x)]) == gen, bar);
            __builtin_amdgcn_fence(__ATOMIC_ACQUIRE, "agent");
            asm volatile("s_waitcnt vmcnt(0)" ::: "memory");
        }
    }
    __syncthreads();
}


namespace att {
constexpr int KVBLK = 64;
constexpr float THR = 8.f;
#define SBAR() __builtin_amdgcn_sched_barrier(0)
__device__ __forceinline__ int crow(int r, int hi) { return (r & 3) + 8 * (r >> 2) + 4 * hi; }
__device__ __forceinline__ unsigned cvtpk(float lo, float hi) { unsigned r; asm volatile("v_cvt_pk_bf16_f32 %0, %1, %2" : "=v"(r) : "v"(lo), "v"(hi)); return r; }
template <int DQK> __device__ __forceinline__ int kswz(int row, int cb) { return row * (DQK * 2 + 16) + cb; }

template <int DQK> __device__ __forceinline__ void partialSM(f32x16& p0, f32x16& p1, float& m_reg, float& mn, float& alpha) {
  constexpr float SCALE = DQK == 128 ? 0.088388347648318440f : 0.072168783648703220f;
  constexpr float C = SCALE * 1.4426950408889634f;
  float pmax = p0[0];
#pragma unroll
  for (int r = 1; r < 16; ++r) pmax = fmaxf(pmax, p0[r]);
#pragma unroll
  for (int r = 0; r < 16; ++r) pmax = fmaxf(pmax, p1[r]);
  { auto rr = __builtin_amdgcn_permlane32_swap(__float_as_uint(pmax), __float_as_uint(pmax), false, false);
    pmax = fmaxf(__uint_as_float(rr[0]), __uint_as_float(rr[1])); }
  if (__builtin_expect(__all(pmax - m_reg <= THR / SCALE), 1)) { mn = m_reg; alpha = 1.f; }
  else { mn = fmaxf(m_reg, pmax); alpha = __builtin_amdgcn_exp2f((m_reg - mn) * C); m_reg = mn; }
  const float mnC = -mn * C;
#pragma unroll
  for (int r = 0; r < 16; ++r) p0[r] = fmaf(p0[r], C, mnC);
#pragma unroll
  for (int r = 0; r < 16; ++r) p1[r] = fmaf(p1[r], C, mnC);
#pragma unroll
  for (int r = 0; r < 16; ++r) p0[r] = __builtin_amdgcn_exp2f(p0[r]);
}
__device__ __forceinline__ void finishSM(f32x16& p0, f32x16& p1, float alpha, float& l_reg, bf16x8& pa0, bf16x8& pa1, bf16x8& pa2, bf16x8& pa3) {
#pragma unroll
  for (int r = 0; r < 16; ++r) p1[r] = __builtin_amdgcn_exp2f(p1[r]);
  float ps = 0;
#pragma unroll
  for (int r = 0; r < 16; ++r) ps += p0[r];
#pragma unroll
  for (int r = 0; r < 16; ++r) ps += p1[r];
  { auto rr = __builtin_amdgcn_permlane32_swap(__float_as_uint(ps), __float_as_uint(ps), false, false);
    ps = __uint_as_float(rr[0]) + __uint_as_float(rr[1]); }
  l_reg = l_reg * alpha + ps;
#define PK4(P, BASE, OUT) do { unsigned a0 = cvtpk(P[BASE + 0], P[BASE + 1]), a1 = cvtpk(P[BASE + 2], P[BASE + 3]);   \
    unsigned b0 = cvtpk(P[BASE + 4], P[BASE + 5]), b1 = cvtpk(P[BASE + 6], P[BASE + 7]);                              \
    auto r0 = __builtin_amdgcn_permlane32_swap(a0, b0, false, false); auto r1 = __builtin_amdgcn_permlane32_swap(a1, b1, false, false); \
    v4u w = {r0[0], r1[0], r0[1], r1[1]}; OUT = __builtin_bit_cast(bf16x8, w); } while (0)
  PK4(p0, 0, pa0); PK4(p0, 8, pa1); PK4(p1, 0, pa2); PK4(p1, 8, pa3);
#undef PK4
}
template <int DQK> __device__ __forceinline__ void qkt(f32x16& p0, f32x16& p1, const LAS char* Ks, const bf16x8* qr, const LAS char* qx, int r32, int hi) {
  p0 = f32x16{}; p1 = f32x16{};
#pragma unroll
  for (int d0 = 0; d0 < DQK / 16; ++d0) { const int cb = (d0 * 16 + hi * 8) * 2;
    bf16x8 b0 = *(const LAS bf16x8*)(Ks + kswz<DQK>(r32, cb));
    bf16x8 b1 = *(const LAS bf16x8*)(Ks + kswz<DQK>(32 + r32, cb));
    bf16x8 q; if (d0 < 8) q = qr[d0]; else q = *(const LAS bf16x8*)(qx + (d0 - 8) * 32);
    p0 = __builtin_amdgcn_mfma_f32_32x32x16_bf16(b0, q, p0, 0, 0, 0);
    p1 = __builtin_amdgcn_mfma_f32_32x32x16_bf16(b1, q, p1, 0, 0, 0);
    if ((d0 & 3) == 3 && d0 + 1 < DQK / 16) SBAR(); }
}
__device__ __forceinline__ int v_st(int k, int c) { const int kk = (k & ~0xC) | ((k & 4) << 1) | ((k & 8) >> 1); return ((kk >> 3) * 4 + (c >> 5)) * 512 + ((kk & 7) * 32 + (c & 31)) * 2; }
__device__ __forceinline__ int v_rd_base(int lane) { return ((lane & 3) << 3) | (((lane >> 2) & 3) << 6) | (((lane >> 4) & 1) << 5) | (((lane >> 5) & 1) << 8); }
constexpr int v_rd_off(int d0, int ks, int half) { return d0 * 512 + ks * 4096 + half * 2048; }
template <int OFF> __device__ __forceinline__ s16x4 tr_read(int vb) {
  s16x4 r; asm volatile("ds_read_b64_tr_b16 %0, %1 offset:%2" : "=&v"(r) : "v"(vb), "i"(OFF) : "memory"); return r;
}
template <int D0> __device__ __forceinline__ void pv_one(f32x16& od, int vb, bf16x8 pa0, bf16x8 pa1, bf16x8 pa2, bf16x8 pa3) {
  const s16x4 l0 = tr_read<v_rd_off(D0, 0, 0)>(vb), h0 = tr_read<v_rd_off(D0, 0, 1)>(vb), l1 = tr_read<v_rd_off(D0, 1, 0)>(vb), h1 = tr_read<v_rd_off(D0, 1, 1)>(vb);
  const s16x4 l2 = tr_read<v_rd_off(D0, 2, 0)>(vb), h2 = tr_read<v_rd_off(D0, 2, 1)>(vb), l3 = tr_read<v_rd_off(D0, 3, 0)>(vb), h3 = tr_read<v_rd_off(D0, 3, 1)>(vb);
  asm volatile("s_waitcnt lgkmcnt(0)" ::: "memory"); SBAR();
#define PK(L, H) (bf16x8){L[0], L[1], L[2], L[3], H[0], H[1], H[2], H[3]}
  od = __builtin_amdgcn_mfma_f32_32x32x16_bf16(pa0, PK(l0, h0), od, 0, 0, 0);
  od = __builtin_amdgcn_mfma_f32_32x32x16_bf16(pa1, PK(l1, h1), od, 0, 0, 0);
  od = __builtin_amdgcn_mfma_f32_32x32x16_bf16(pa2, PK(l2, h2), od, 0, 0, 0);
  od = __builtin_amdgcn_mfma_f32_32x32x16_bf16(pa3, PK(l3, h3), od, 0, 0, 0);
#undef PK
}
__device__ __forceinline__ void pv_d0(f32x16* o, int vb, bf16x8 pa0, bf16x8 pa1, bf16x8 pa2, bf16x8 pa3) {
  pv_one<0>(o[0], vb, pa0, pa1, pa2, pa3); pv_one<1>(o[1], vb, pa0, pa1, pa2, pa3); pv_one<2>(o[2], vb, pa0, pa1, pa2, pa3); pv_one<3>(o[3], vb, pa0, pa1, pa2, pa3);
}
__device__ __forceinline__ void apply_mask(f32x16& p0, f32x16& p1, int mtype, int krel0, int qi, int hi) {
  if (mtype == 0) return;
  const float ninf = -__builtin_inff();
#pragma unroll
  for (int r = 0; r < 16; ++r) { const int k0 = krel0 + crow(r, hi), k1 = k0 + 32;
    const bool ok0 = (mtype == 1) ? (k0 >= qi - 128) : (k0 <= qi + 128), ok1 = (mtype == 1) ? (k1 >= qi - 128) : (k1 <= qi + 128);
    p0[r] = ok0 ? p0[r] : ninf; p1[r] = ok1 ? p1[r] : ninf; }
}
struct Tile { gcbf kn; gcbf kr; gcbf v; int mtype; int krel0; };

__device__ __forceinline__ void rope_pair(bf16x8& a, bf16x8& b, gcfl ct, gcfl st) {
  const f32x4 c0 = *(const GAS f32x4*)ct, c1 = *(const GAS f32x4*)(ct + 4), s0 = *(const GAS f32x4*)st, s1 = *(const GAS f32x4*)(st + 4);
  const float cs[8] = {c0[0], c0[1], c0[2], c0[3], c1[0], c1[1], c1[2], c1[3]}, sn[8] = {s0[0], s0[1], s0[2], s0[3], s1[0], s1[1], s1[2], s1[3]};
  v4u ua = __builtin_bit_cast(v4u, a), ub = __builtin_bit_cast(v4u, b); v4u oa, ob;
#pragma unroll
  for (int w = 0; w < 4; ++w) { const float x1[2] = {bflo(ua[w]), bfhi(ua[w])}, x2[2] = {bflo(ub[w]), bfhi(ub[w])}; float y1[2], y2[2];
#pragma unroll
    for (int e = 0; e < 2; ++e) { const float c = cs[2 * w + e], sv = sn[2 * w + e]; y1[e] = x1[e] * c - x2[e] * sv; y2[e] = x2[e] * c + x1[e] * sv; }
    oa[w] = pk2(y1[0], y1[1]); ob[w] = pk2(y2[0], y2[1]); }
  a = __builtin_bit_cast(bf16x8, oa); b = __builtin_bit_cast(bf16x8, ob);
}

template <int DQK, int LDKN, int LDV, bool MASK, bool SINK, int SDEPTH, class TS>
__device__ __forceinline__ void attn_body(gcbf Qw, int rope, int prow, int pcol, gcfl rtab, int qi, float sink_l2, const TS& ts, int NT, gbfp Ow, LAS char* lds) {
  constexpr float SCALE = DQK == 128 ? 0.088388347648318440f : 0.072168783648703220f;
  constexpr float C = SCALE * 1.4426950408889634f;
  constexpr int SHM_K = KVBLK * (DQK * 2 + 16), SHM_V = KVBLK * 128 * 2;
  int tid = threadIdx.x; asm volatile("" : "+v"(tid));
  const int wid = tid >> 6, lane = tid & 63, r32 = lane & 31, hi = lane >> 5;
  LAS char* V_lds = lds; LAS char* K_lds = lds + 2 * SHM_V;
  LAS float* wsl = (LAS float*)(lds + 2 * SHM_V + 2 * SHM_K) + wid * 64; LAS float* li_l = wsl; LAS float* al_l = wsl + 32;
  float m_reg = -1e30f, l_reg = 0; f32x16 o[4] = {}; bf16x8 qr[8];
#pragma unroll
  for (int d0 = 0; d0 < 8; ++d0) qr[d0] = *(const GAS bf16x8*)(Qw + d0 * 16 + hi * 8);
  const LAS char* qx = lds + 2 * SHM_V + 2 * SHM_K + 2048 + wid * 4608 + r32 * 144 + hi * 16;
  if constexpr (DQK == 192) {
    bf16x8 x0 = *(const GAS bf16x8*)(Qw + 128 + hi * 8), x1 = *(const GAS bf16x8*)(Qw + 144 + hi * 8), x2 = *(const GAS bf16x8*)(Qw + 160 + hi * 8), x3 = *(const GAS bf16x8*)(Qw + 176 + hi * 8);
    if (rope) {
      rope_pair(x0, x1, rtab + (size_t)prow * 16 + hi * 8, rtab + 2048 + (size_t)prow * 16 + hi * 8);
      rope_pair(x2, x3, rtab + (size_t)pcol * 16 + hi * 8, rtab + 2048 + (size_t)pcol * 16 + hi * 8); }
    LAS char* qw_ = (LAS char*)qx; *(LAS bf16x8*)(qw_) = x0; *(LAS bf16x8*)(qw_ + 32) = x1; *(LAS bf16x8*)(qw_ + 64) = x2; *(LAS bf16x8*)(qw_ + 96) = x3;
  }
  const int sr = tid >> 4, sc = (tid & 15) * 8, vst0 = v_st(sr, sc), vst1 = v_st(32 + sr, sc);
  const int rr_ = tid >> 3, rc_ = (tid & 7) * 8;
  const int vb0 = (int)(uintptr_t)V_lds + v_rd_base(lane);
  struct { bf16x8 vs0, vs1, ks0, ks1, kx; } sr_[SDEPTH];
#define SLOAD(i, jt) do { const Tile t_ = ts(jt); sr_[i].vs0 = *(const GAS bf16x8*)(t_.v + (size_t)sr * LDV + sc); sr_[i].vs1 = *(const GAS bf16x8*)(t_.v + (size_t)(32 + sr) * LDV + sc); \
    sr_[i].ks0 = *(const GAS bf16x8*)(t_.kn + (size_t)sr * LDKN + sc); sr_[i].ks1 = *(const GAS bf16x8*)(t_.kn + (size_t)(32 + sr) * LDKN + sc); \
    if constexpr (DQK == 192) sr_[i].kx = *(const GAS bf16x8*)(t_.kr + (size_t)rr_ * 64 + rc_); } while (0)
#define SWRITE(b, i) do { *(LAS bf16x8*)(V_lds + (b) * SHM_V + vst0) = sr_[i].vs0; *(LAS bf16x8*)(V_lds + (b) * SHM_V + vst1) = sr_[i].vs1; const int kc = sc * 2; \
    *(LAS bf16x8*)(K_lds + (b) * SHM_K + kswz<DQK>(sr, kc)) = sr_[i].ks0; *(LAS bf16x8*)(K_lds + (b) * SHM_K + kswz<DQK>(32 + sr, kc)) = sr_[i].ks1; \
    if constexpr (DQK == 192) *(LAS bf16x8*)(K_lds + (b) * SHM_K + kswz<DQK>(rr_, 256 + rc_ * 2)) = sr_[i].kx; } while (0)
#define SWAIT() do { if constexpr (SDEPTH == 2) { if constexpr (DQK == 192) asm volatile("s_waitcnt vmcnt(5)" ::: "memory"); else asm volatile("s_waitcnt vmcnt(4)" ::: "memory"); } \
    else asm volatile("s_waitcnt vmcnt(0)" ::: "memory"); } while (0)
#define RESC(a) do { if (__any((a) < 1.f)) { if (hi == 0) al_l[r32] = (a); asm volatile("s_waitcnt lgkmcnt(0)" ::: "memory"); \
    _Pragma("unroll") for (int d = 0; d < 4; ++d) _Pragma("unroll") for (int r = 0; r < 16; ++r) o[d][r] *= al_l[crow(r, hi)]; } } while (0)
#define MASKT(pa_, pb_, jt) do { if constexpr (MASK) { const Tile t_ = ts(jt); apply_mask(pa_, pb_, t_.mtype, t_.krel0, qi, hi); } } while (0)
  f32x16 pA0, pA1, pB0, pB1; float mnA, mnB, alA, alB; bf16x8 pa0, pa1, pa2, pa3;
  constexpr int SE = 0, SO = SDEPTH - 1;
  SLOAD(SE, 0); asm volatile("s_waitcnt vmcnt(0)" ::: "memory"); SWRITE(0, SE); __syncthreads();
  qkt<DQK>(pA0, pA1, K_lds, qr, qx, r32, hi); MASKT(pA0, pA1, 0); partialSM<DQK>(pA0, pA1, m_reg, mnA, alA);
  SLOAD(SO, 1); if constexpr (SDEPTH == 2) { if (2 < NT) SLOAD(SE, 2); }
  SWAIT(); SWRITE(1, SO); __syncthreads();
  for (int j = 1; j + 1 < NT; j += 2) {
    SBAR(); qkt<DQK>(pB0, pB1, K_lds + SHM_K, qr, qx, r32, hi); MASKT(pB0, pB1, j);
    finishSM(pA0, pA1, alA, l_reg, pa0, pa1, pa2, pa3); SBAR();
    SLOAD(SO, j + SDEPTH); SBAR();
    pv_d0(o, vb0, pa0, pa1, pa2, pa3); partialSM<DQK>(pB0, pB1, m_reg, mnB, alB);
    __syncthreads(); SWAIT(); SWRITE(0, SE);
    RESC(alB); __syncthreads();
    SBAR(); qkt<DQK>(pA0, pA1, K_lds, qr, qx, r32, hi); MASKT(pA0, pA1, j + 1);
    finishSM(pB0, pB1, alB, l_reg, pa0, pa1, pa2, pa3); SBAR();
    if (SDEPTH == 1 || j + 3 < NT) SLOAD(SE, j + 1 + SDEPTH); SBAR();
    pv_d0(o, vb0 + SHM_V, pa0, pa1, pa2, pa3); partialSM<DQK>(pA0, pA1, m_reg, mnA, alA);
    __syncthreads(); SWAIT(); SWRITE(1, SO);
    RESC(alA); __syncthreads();
  }
  SBAR(); qkt<DQK>(pB0, pB1, K_lds + SHM_K, qr, qx, r32, hi); MASKT(pB0, pB1, NT - 1);
  finishSM(pA0, pA1, alA, l_reg, pa0, pa1, pa2, pa3); SBAR();
  pv_d0(o, vb0, pa0, pa1, pa2, pa3); partialSM<DQK>(pB0, pB1, m_reg, mnB, alB);
  __syncthreads(); RESC(alB);
  finishSM(pB0, pB1, alB, l_reg, pa0, pa1, pa2, pa3); SBAR();
  pv_d0(o, vb0 + SHM_V, pa0, pa1, pa2, pa3);
  if constexpr (SINK) l_reg += __builtin_amdgcn_exp2f(sink_l2 - m_reg * C);
  if (hi == 0) li_l[r32] = l_reg; asm volatile("s_waitcnt lgkmcnt(0)" ::: "memory");
  float rli[16];
#pragma unroll
  for (int r = 0; r < 16; ++r) rli[r] = __builtin_amdgcn_rcpf(li_l[crow(r, hi)]);
  __syncthreads();
  LAS bf16* ost = (LAS bf16*)(lds + wid * 8704);
#pragma unroll
  for (int r = 0; r < 16; ++r) { const int orow = crow(r, hi);
#pragma unroll
    for (int d0 = 0; d0 < 4; ++d0) ost[orow * 136 + d0 * 32 + r32] = (bf16)f2bf(o[d0][r] * rli[r]); }
  asm volatile("s_waitcnt lgkmcnt(0)" ::: "memory");
#pragma unroll
  for (int i = 0; i < 8; ++i) { const int orow = i * 4 + (lane >> 4), ch = lane & 15;
    *(GAS v4u*)(Ow + (size_t)orow * 4096 + ch * 8) = *(const LAS v4u*)(ost + orow * 136 + ch * 8); }
  __syncthreads();
#undef SLOAD
#undef SWRITE
#undef SWAIT
#undef RESC
#undef MASKT
}
}

struct Args { const float* in[38]; float* out; unsigned char* ws; };
template <class T> __device__ __forceinline__ T launder(T p) { asm volatile("" : "+s"(p)); return p; }
template <class T> __device__ __forceinline__ T* launder_g(T* p) { asm volatile("" : "+s"(p)); return p; }
struct Frame {
    LAS unsigned char* lds;
    gu32* ctl;
    int tid, lane, wave;
    int vcu, G, gw, NGW;
    const __attribute__((address_space(4))) Args* A;
    float* out;
    unsigned char* ws;
    unsigned char* wsw;
};
enum { I_X = 0, I_C, I_CTX, I_CCTX, I_WMOD, I_BMOD, I_WIN, I_WOUT, I_LN1G, I_LN1B, I_WFF1, I_WFF2, I_LN2G, I_LN2B, I_SINK, I_CONVW, I_CONVB, I_LWA, I_LBA, I_LWI, I_LBI, I_LAM,
       I_QNORM, I_KVNORM, I_WQB, I_WKVB, I_MUP, I_MUN, I_W0, I_W2, I_A0, I_A2, I_G2, I_KK, I_KA, I_RK, I_LNG, I_LNB };
__device__ __forceinline__ int row_s(int row) { return row < SEQ ? 0 : (row < M_LAT ? 1 : 2); }
__device__ __forceinline__ const float* mod_ptr(const Frame& F, int l, int s, int chunk) { return (const float*)(F.ws + WS_MOD) + ((size_t)(l * 3 + s) * 6 + chunk) * DM; }

__device__ __forceinline__ void transpose_item(const float* W, int N, int Kvalid, bf16* WT, int ldt, const float* kscale, LAS float* scr, int k0, int n0, int lane) {
    { const int kr = lane >> 3, c4 = (lane & 7) * 4;
#pragma unroll
      for (int i = 0; i < 8; ++i) { const int kk = 8 * i + kr, k = k0 + kk; f32x4 v = {0.f, 0.f, 0.f, 0.f};
          if (k < Kvalid) { v = *(const f32x4*)(W + (size_t)k * N + n0 + c4); if (kscale) v = v * kscale[k]; }
          scr[kk * 33 + c4] = v.x; scr[kk * 33 + c4 + 1] = v.y; scr[kk * 33 + c4 + 2] = v.z; scr[kk * 33 + c4 + 3] = v.w; } }
    LDS_WAIT(); asm volatile("" ::: "memory");
    const int c = lane & 7;
#pragma unroll
    for (int j = 0; j < 4; ++j) { const int n = (lane >> 3) + 8 * j; const LAS float* s = scr + (8 * c) * 33 + n;
        v4u o; o.x = pk2(s[0 * 33], s[1 * 33]); o.y = pk2(s[2 * 33], s[3 * 33]); o.z = pk2(s[4 * 33], s[5 * 33]); o.w = pk2(s[6 * 33], s[7 * 33]);
        *(v4u*)(WT + (size_t)(n0 + n) * ldt + k0 + 8 * c) = o; }
    LDS_WAIT(); asm volatile("" ::: "memory");
}
__device__ __forceinline__ void convert_weights(Frame& F, int l, int widx, int nw) {
    LAS float* scr = (LAS float*)(F.lds + F.wave * 16384);
    constexpr int I1 = 64 * 271, I2 = 64 * 128, I3 = 64 * 512, I4 = 256 * 128, I5 = 16 * 48, I6 = 8 * 64, I7 = 32 * 8, I8 = 2 * 32, I9 = 2 * 32, I10 = 3 * 32;
    constexpr int NIT = I1 + I2 + I3 + I4 + I5 + I6 + I7 + I8 + I9 + I10;
    unsigned char* ws = F.ws + (l ? WSET_STRIDE : 0);
    for (int it = widx; it < NIT; it += nw) {
        int r = it;
        if (r < I1) { transpose_item(F.A->in[I_WIN] + (size_t)l * DM * DIN, DIN, DM, (bf16*)(ws + WS_WIN), DM, nullptr, scr, 64 * (r / 271), 32 * (r % 271), F.lane); continue; } r -= I1;
        if (r < I2) { transpose_item(F.A->in[I_WOUT] + (size_t)l * DM * DM, DM, DM, (bf16*)(ws + WS_WOUT), DM, nullptr, scr, 64 * (r / 128), 32 * (r % 128), F.lane); continue; } r -= I2;
        if (r < I3) { transpose_item(F.A->in[I_WFF1] + (size_t)l * DM * DFF, DFF, DM, (bf16*)(ws + WS_WFF1), DM, nullptr, scr, 64 * (r / 512), 32 * (r % 512), F.lane); continue; } r -= I3;
        if (r < I4) { transpose_item(F.A->in[I_WFF2] + (size_t)l * DFF * DM, DM, DFF, (bf16*)(ws + WS_WFF2), DFF, nullptr, scr, 64 * (r / 128), 32 * (r % 128), F.lane); continue; } r -= I4;
        if (r < I5) { transpose_item(F.A->in[I_WQB] + (size_t)l * 1024 * 1536, 1536, 1024, (bf16*)(ws + WS_WQB), 1024, F.A->in[I_QNORM] + l * 1024, scr, 64 * (r / 48), 32 * (r % 48), F.lane); continue; } r -= I5;
        if (r < I6) { transpose_item(F.A->in[I_WKVB] + (size_t)l * 512 * 2048, 2048, 512, (bf16*)(ws + WS_WKVB), 512, F.A->in[I_KVNORM] + l * 512, scr, 64 * (r / 64), 32 * (r % 64), F.lane); continue; } r -= I6;
        if (r < I7) { const int mat = r >> 3, sub = r & 7, gate = mat & 1, dn = mat >> 1;
            const int d = dn >> 3, n = dn & 7;
            const float* src = (gate ? F.A->in[I_LWI] : F.A->in[I_LWA]) + ((size_t)(l * 2 + d) * 8 + n) * 128 * 128;
            bf16* dst = (bf16*)(ws + WS_WLRU) + ((size_t)(d * 2 + gate) * 8 + n) * 128 * 128;
            transpose_item(src, 128, 128, dst, 128, nullptr, scr, 64 * (sub >> 2), 32 * (sub & 3), F.lane); continue; } r -= I7;
        if (r < I8) { const int d = r >> 5; transpose_item(F.A->in[I_W2] + (size_t)(l * 2 + d) * 64 * 1024, 1024, 64, (bf16*)(ws + WS_W2T) + (size_t)d * 1024 * 64, 64, nullptr, scr, 0, 32 * (r & 31), F.lane); continue; } r -= I8;
        if (r < I9) { const int d = r >> 5; transpose_item(F.A->in[I_A2] + (size_t)(l * 2 + d) * 64 * 1024, 1024, 64, (bf16*)(ws + WS_A2T) + (size_t)d * 1024 * 64, 64, nullptr, scr, 0, 32 * (r & 31), F.lane); continue; } r -= I9;
        transpose_item(F.A->in[I_G2] + (size_t)l * 160 * 1024, 1024, 160, (bf16*)(ws + WS_G2T), 192, nullptr, scr, 64 * (r / 32), 32 * (r % 32), F.lane);
    }
    { unsigned zz = 0u; asm volatile("" : "+v"(zz)); v4u z = {zz, zz, zz, zz}; v4u* p = (v4u*)((bf16*)(ws + WS_WIN) + (size_t)DIN * DM);
      for (int i = widx * 64 + F.lane; i < 32 * DM / 8; i += nw * 64) p[i] = z; }
}

__device__ __forceinline__ void mod_partials(Frame& F) {
    LAS float* sl = (LAS float*)F.lds;
    for (int it = F.vcu; it < 2 * 32 * 12; it += F.G) {
        const int l = it / 384, ks = (it / 12) % 32, cc = it % 12;
        __syncthreads();
        if (F.tid < 384) { const int s = F.tid >> 7, k = ks * 128 + (F.tid & 127); const float c = s < 2 ? F.A->in[I_C][s * DM + k] : F.A->in[I_CCTX][k]; sl[F.tid] = c / (1.f + __expf(-c)); }
        __syncthreads();
        const float* wp = F.A->in[I_WMOD] + ((size_t)l * DM + ks * 128) * 24576 + cc * 2048 + F.tid * 4;
        f32x4 a0 = {0.f, 0.f, 0.f, 0.f}, a1 = a0, a2 = a0;
#pragma unroll 8
        for (int k = 0; k < 128; ++k) { const f32x4 w = *(const f32x4*)(wp + (size_t)k * 24576); a0 += w * sl[k]; a1 += w * sl[128 + k]; a2 += w * sl[256 + k]; }
        float* op = (float*)(F.ws + WS_MODP) + ((size_t)(l * 32 + ks) * 3) * 24576 + cc * 2048 + F.tid * 4;
        *(f32x4*)(op) = a0; *(f32x4*)(op + 24576) = a1; *(f32x4*)(op + 2 * 24576) = a2;
    }
    __syncthreads();
}
__device__ __forceinline__ void mod_reduce(Frame& F) {
    for (int i = F.vcu * NTHR + F.tid; i < 2 * 3 * 24576; i += F.G * NTHR) {
        const int l = i / (3 * 24576), s = (i / 24576) % 3, n = i % 24576;
        float a = F.A->in[I_BMOD][l * 24576 + n];
        const float* pp = (const float*)(F.ws + WS_MODP) + ((size_t)(l * 32) * 3 + s) * 24576 + n;
#pragma unroll 8
        for (int ks = 0; ks < 32; ++ks) a += pp[(size_t)ks * 3 * 24576];
        ((float*)(F.ws + WS_MOD))[i] = a;
    }
}

__device__ __forceinline__ void sum_partials_row(const Frame& F, const float* yp, size_t stride, bf16* ydst) {
    int lane = F.lane; asm volatile("" : "+v"(lane));
#pragma unroll 2
    for (int j = 0; j < 16; ++j) { const int c = 4 * lane + 256 * j; f32x4 y = *(const f32x4*)(yp + c);
#pragma unroll
        for (int sp = 1; sp < 8; ++sp) y += *(const f32x4*)(yp + sp * stride + c);
        v2u w; w.x = pk2(y.x, y.y); w.y = pk2(y.z, y.w); *(v2u*)(ydst + c) = w; }
}
template <int MODE>
__device__ __forceinline__ void ln_row(const Frame& F, const float* xsrc, const bf16* Y, const float* ga, const float* lg, const float* lb, float* xdst,
                                       bool domod, const float* sc, const float* sh, bf16* hrow) {
    f32x4 v[16]; float s = 0.f;
#pragma unroll
    for (int j = 0; j < 16; ++j) { const int c = 4 * F.lane + 256 * j; v[j] = *(const f32x4*)(xsrc + c);
        if (MODE == 1) { const v2u yw = *(const v2u*)(Y + c); const f32x4 y = {bflo(yw.x), bfhi(yw.x), bflo(yw.y), bfhi(yw.y)}, g = *(const f32x4*)(ga + c); v[j] = v[j] * ALPHA + g * y; }
        s += (v[j].x + v[j].y) + (v[j].z + v[j].w);
        if ((j & 7) == 7) asm volatile("" ::: "memory"); }
    float mean = wave_sum(s) * (1.f / DM), s2 = 0.f;
#pragma unroll
    for (int j = 0; j < 16; ++j) { v[j] = v[j] - mean; s2 += (v[j].x * v[j].x + v[j].y * v[j].y) + (v[j].z * v[j].z + v[j].w * v[j].w); }
    float rstd = 1.f / sqrtf(wave_sum(s2) * (1.f / DM) + LN_EPS);
    if (MODE == 1) {
        s = 0.f;
#pragma unroll
        for (int j = 0; j < 16; ++j) { const int c = 4 * F.lane + 256 * j; const f32x4 g = *(const f32x4*)(lg + c), b = *(const f32x4*)(lb + c); v[j] = v[j] * rstd * g + b;
            *(f32x4*)(xdst + c) = v[j]; s += (v[j].x + v[j].y) + (v[j].z + v[j].w);
            if ((j & 7) == 7) asm volatile("" ::: "memory"); }
        if (!domod) return;
        mean = wave_sum(s) * (1.f / DM); s2 = 0.f;
#pragma unroll
        for (int j = 0; j < 16; ++j) { v[j] = v[j] - mean; s2 += (v[j].x * v[j].x + v[j].y * v[j].y) + (v[j].z * v[j].z + v[j].w * v[j].w); }
        rstd = 1.f / sqrtf(wave_sum(s2) * (1.f / DM) + LN_EPS);
    }
#pragma unroll
    for (int j = 0; j < 16; ++j) { const int c = 4 * F.lane + 256 * j; const f32x4 a = *(const f32x4*)(sc + c), b = *(const f32x4*)(sh + c);
        const f32x4 o = v[j] * rstd * (a + 1.f) + b; v2u w; w.x = pk2(o.x, o.y); w.y = pk2(o.z, o.w); *(v2u*)(hrow + c) = w; }
}

__device__ __forceinline__ void shift4(const bf16* P, unsigned eo, bool hp, bool hn, const float* mup, const float* mun, unsigned mo, float (&u)[4]) {
    const v2u xc = ldg<v2u>(P, eo * 2u); v2u xp = {0u, 0u}, xn = {0u, 0u};
    if (hp) xp = ldg<v2u>(P, (eo - DINP) * 2u); if (hn) xn = ldg<v2u>(P, (eo + DINP) * 2u);
    const f32x4 mp = ldg<f32x4>(mup, mo * 4u), mn = ldg<f32x4>(mun, mo * 4u);
    const float c[4] = {bflo(xc.x), bfhi(xc.x), bflo(xc.y), bfhi(xc.y)}, p[4] = {bflo(xp.x), bfhi(xp.x), bflo(xp.y), bfhi(xp.y)}, n[4] = {bflo(xn.x), bfhi(xn.x), bflo(xn.y), bfhi(xn.y)};
#pragma unroll
    for (int e = 0; e < 4; ++e) u[e] = c[e] + mp[e] * (p[e] - c[e]) + mn[e] * (n[e] - c[e]);
}
__device__ __forceinline__ void st4bf(void* base, unsigned eo, float a, float b, float c, float d) { v2u w; w.x = pk2(a, b); w.y = pk2(c, d); stg<v2u>(base, eo * 2u, w); }

__device__ __forceinline__ void rwkv_feat_item(Frame& F, int l, int item) {
    F.tid = ltid(); F.lane = F.tid & 63;
    int row0, seq_lo, seq_hi;
    if (item < 16) { const int b = item >> 3; seq_lo = M_LAT + b * NCTX; seq_hi = seq_lo + NCTX; row0 = seq_lo + (item & 7) * 32; }
    else { const int it = item - 16, b = it >> 8; seq_lo = b * SEQ; seq_hi = seq_lo + SEQ; row0 = seq_lo + (it & 255) * 32; }
    const bf16* P = (const bf16*)(F.ws + WS_P);
    LAS bf16* ACT = (LAS bf16*)F.lds;
    const float* mup = F.A->in[I_MUP] + l * RWC; const float* mun = F.A->in[I_MUN] + l * RWC;
    __syncthreads();
    { const int tok = F.tid >> 4, jc = F.tid & 15, row = row0 + tok; const bool hp = row > seq_lo, hn = row + 1 < seq_hi;
      const bf16* pr = P + (size_t)row * DINP + C_RWL;
#pragma unroll
      for (int i = 0; i < 13; ++i) { const int j = jc * 2 + 32 * i;
          const unsigned xc = *(const unsigned*)(pr + j), xp = hp ? *(const unsigned*)(pr - DINP + j) : 0u, xn = hn ? *(const unsigned*)(pr + DINP + j) : 0u;
          float u[2];
#pragma unroll
          for (int e = 0; e < 2; ++e) { const float c = e ? bfhi(xc) : bflo(xc), p = e ? bfhi(xp) : bflo(xp), n = e ? bfhi(xn) : bflo(xn);
              float v = c + mup[3072 + j + e] * (p - c) + mun[3072 + j + e] * (n - c);
              if (j < 128) v = tanhf_(v); else if (j >= 256) v = sigmoidf_(v);
              u[e] = v; }
          *(LAS unsigned*)(ACT + tok * 424 + j) = pk2(u[0], u[1]); } }
    __syncthreads();
    const int tok = F.lane & 31, hi = F.lane >> 5, row = row0 + tok;
    const bf16* W2T = (const bf16*)(F.wsw + WS_W2T); const bf16* A2T = (const bf16*)(F.wsw + WS_A2T); const bf16* G2T = (const bf16*)(F.wsw + WS_G2T);
    bf16* RWF = (bf16*)(F.ws + WS_RWF); const size_t RS = (size_t)M_TOT * 1024;
    const float* kkv = F.A->in[I_KK] + l * 1024; const float* kav = F.A->in[I_KA] + l * 1024; const float* rkv = F.A->in[I_RK] + l * 1024;
    const float* w0f = F.A->in[I_W0] + (size_t)(l * 2) * 1024; const float* a0f = F.A->in[I_A0] + (size_t)(l * 2) * 1024;
    const LAS bf16* actl = ACT + tok * 424 + hi * 8;
    LAS unsigned char* TB = F.lds + 27136 + F.wave * 10880;
#define RF_LOADG(reg_, colbase) do { _Pragma("unroll") for (int i_ = 0; i_ < 3; ++i_) { const int p_ = F.lane + 64 * i_; reg_[i_] = (v4u){0u, 0u, 0u, 0u}; if (p_ < 136) { const int rr_ = p_ >> 2, cp_ = p_ & 3, gr_ = row0 - 1 + rr_; \
        if (gr_ >= seq_lo && gr_ < seq_hi) reg_[i_] = ldg<v4u>(P, ((unsigned)gr_ * DINP + (colbase) + 8 * cp_) * 2u); } } } while (0)
#define RF_STORET(ti, reg_) do { _Pragma("unroll") for (int i_ = 0; i_ < 3; ++i_) { const int p_ = F.lane + 64 * i_; if (p_ < 136) { const int rr_ = p_ >> 2, cp_ = p_ & 3; *(LAS v4u*)(TB + (ti) * 2720 + rr_ * 80 + cp_ * 16) = reg_[i_]; } } } while (0)
#define RF_SHIFT4(ti, g_, mo_, u_) do { const LAS unsigned char* q_ = TB + (ti) * 2720 + (tok + 1) * 80 + (8 * (g_) + 4 * hi) * 2; const v2u xc_ = *(const LAS v2u*)q_, xp_ = *(const LAS v2u*)(q_ - 80), xn_ = *(const LAS v2u*)(q_ + 80); \
        const f32x4 mp_ = ldg<f32x4>(mup, (mo_) * 4u), mn_ = ldg<f32x4>(mun, (mo_) * 4u); \
        const float c_[4] = {bflo(xc_.x), bfhi(xc_.x), bflo(xc_.y), bfhi(xc_.y)}, pp_[4] = {bflo(xp_.x), bfhi(xp_.x), bflo(xp_.y), bfhi(xp_.y)}, nn_[4] = {bflo(xn_.x), bfhi(xn_.x), bflo(xn_.y), bfhi(xn_.y)}; \
        _Pragma("unroll") for (int e_ = 0; e_ < 4; ++e_) u_[e_] = c_[e_] + mp_[e_] * (pp_[e_] - c_[e_]) + mn_[e_] * (nn_[e_] - c_[e_]); } while (0)
#define RF_PUT(ti, o_) do { _Pragma("unroll") for (int g_ = 0; g_ < 4; ++g_) *(LAS v2u*)(TB + (ti) * 2720 + tok * 80 + (8 * g_ + 4 * hi) * 2) = o_[g_]; } while (0)
#define RF_FLUSH3(a0_, a1_, a2_, cblk_) do { asm volatile("s_waitcnt lgkmcnt(0)" ::: "memory"); \
        _Pragma("unroll") for (int t_ = 0; t_ < 3; ++t_) { const int arr_ = t_ == 0 ? (a0_) : (t_ == 1 ? (a1_) : (a2_)); \
            _Pragma("unroll") for (int i_ = 0; i_ < 2; ++i_) { const int p_ = F.lane + 64 * i_, rr_ = p_ >> 2, cp_ = p_ & 3; const v4u v_ = *(const LAS v4u*)(TB + t_ * 2720 + rr_ * 80 + cp_ * 16); \
                stg<v4u>(RWF + arr_ * RS, ((unsigned)(row0 + rr_) * 1024u + (cblk_) + 8 * cp_) * 2u, v_); } } \
        asm volatile("s_waitcnt lgkmcnt(0)" ::: "memory"); } while (0)
#pragma unroll 1
    for (int hh = 0; hh < 2; ++hh) {
        const int h = 2 * F.wave + hh, cbase = h * 64;
        float ssq = 0.f;
        { v4u t0[3], t1[3]; RF_LOADG(t0, C_RWK + cbase); RF_LOADG(t1, C_RWK + cbase + 32); RF_STORET(0, t0); RF_STORET(1, t1); }
        asm volatile("s_waitcnt lgkmcnt(0)" ::: "memory");
#pragma unroll
        for (int bg = 0; bg < 8; ++bg) { const unsigned c4 = cbase + (bg >> 2) * 32 + 8 * (bg & 3) + 4 * hi; float uk[4];
            RF_SHIFT4(bg >> 2, bg & 3, 1024 + c4, uk); const f32x4 k4 = ldg<f32x4>(kkv, c4 * 4u);
#pragma unroll
            for (int e = 0; e < 4; ++e) { const float q = uk[e] * k4[e]; ssq += q * q; } }
        ssq = half_swap_sum(ssq);
        const float rn = 1.f / fmaxf(sqrtf(ssq), 1e-12f);
        float sb = 0.f;
        asm volatile("s_waitcnt lgkmcnt(0)" ::: "memory");
#pragma unroll 1
        for (int blk = 0; blk < 2; ++blk) {
            const unsigned cblk = cbase + blk * 32, cha = cblk + tok;
            v4u gR[3], gK[3], gV[3];
            RF_LOADG(gR, C_RWR + cblk); RF_LOADG(gK, C_RWK + cblk); RF_LOADG(gV, C_RWV + cblk);
#pragma unroll
            for (int d = 0; d < 2; ++d) { f32x16 aw = {};
#pragma unroll
                for (int ks = 0; ks < 4; ++ks) { const bf16x8 bw = *(const LAS bf16x8*)(actl + d * 64 + ks * 16); const bf16x8 w_ = ldg<bf16x8>(W2T, ((d * 1024 + cha) * 64 + ks * 16 + hi * 8) * 2u);
                    aw = __builtin_amdgcn_mfma_f32_32x32x16_bf16(w_, bw, aw, 0, 0, 0); }
                v2u o[4];
#pragma unroll
                for (int g = 0; g < 4; ++g) { const f32x4 w0 = ldg<f32x4>(w0f, (d * 1024 + cblk + 8 * g + 4 * hi) * 4u); float e4[4];
#pragma unroll
                    for (int e = 0; e < 4; ++e) e4[e] = __expf(-softplusf_(-(w0[e] + aw[4 * g + e])) - 0.5f);
                    o[g].x = pk2(e4[0], e4[1]); o[g].y = pk2(e4[2], e4[3]); }
                RF_PUT(d, o); }
            { f32x16 ag = {};
#pragma unroll
              for (int ks = 0; ks < 10; ++ks) { const bf16x8 bg_ = *(const LAS bf16x8*)(actl + 256 + ks * 16); const bf16x8 g_ = ldg<bf16x8>(G2T, (cha * 192 + ks * 16 + hi * 8) * 2u);
                  ag = __builtin_amdgcn_mfma_f32_32x32x16_bf16(g_, bg_, ag, 0, 0, 0); }
              v2u o[4];
#pragma unroll
              for (int g = 0; g < 4; ++g) { o[g].x = pk2(ag[4 * g], ag[4 * g + 1]); o[g].y = pk2(ag[4 * g + 2], ag[4 * g + 3]); }
              RF_PUT(2, o); }
            RF_FLUSH3(4, 5, 8, cblk);
            RF_STORET(0, gR); RF_STORET(1, gK); RF_STORET(2, gV);
            { f32x16 aaf = {}, aab = {};
#pragma unroll
              for (int ks = 0; ks < 4; ++ks) { const bf16x8 baf = *(const LAS bf16x8*)(actl + 128 + ks * 16), bab = *(const LAS bf16x8*)(actl + 192 + ks * 16);
                  const bf16x8 a_f = ldg<bf16x8>(A2T, (cha * 64 + ks * 16 + hi * 8) * 2u), a_b = ldg<bf16x8>(A2T, ((1024 + cha) * 64 + ks * 16 + hi * 8) * 2u);
                  aaf = __builtin_amdgcn_mfma_f32_32x32x16_bf16(a_f, baf, aaf, 0, 0, 0); aab = __builtin_amdgcn_mfma_f32_32x32x16_bf16(a_b, bab, aab, 0, 0, 0); }
              v2u oR[4], oK[4], oV[4], oKK[4], oAF[4], oAB[4];
              asm volatile("s_waitcnt lgkmcnt(0)" ::: "memory");
#pragma unroll
              for (int g = 0; g < 4; ++g) { const unsigned c4 = cblk + 8 * g + 4 * hi; float ur[4], uk[4], uv[4];
                  RF_SHIFT4(0, g, c4, ur); RF_SHIFT4(1, g, 1024 + c4, uk); RF_SHIFT4(2, g, 2048 + c4, uv);
                  const f32x4 a0a = ldg<f32x4>(a0f, c4 * 4u), a0b = ldg<f32x4>(a0f, (1024 + c4) * 4u), kk4 = ldg<f32x4>(kkv, c4 * 4u), ka4 = ldg<f32x4>(kav, c4 * 4u), rk4 = ldg<f32x4>(rkv, c4 * 4u);
                  float af[4], ab[4], kk[4];
#pragma unroll
                  for (int e = 0; e < 4; ++e) { const int r = 4 * g + e;
                      af[e] = sigmoidf_(a0a[e] + aaf[r]); ab[e] = sigmoidf_(a0b[e] + aab[r]); kk[e] = uk[e] * kk4[e] * rn;
                      const float kdf = uk[e] * (1.f + (af[e] - 1.f) * ka4[e]), kdb = uk[e] * (1.f + (ab[e] - 1.f) * ka4[e]);
                      sb += ur[e] * rk4[e] * (kdf + kdb); }
                  oR[g].x = pk2(ur[0], ur[1]); oR[g].y = pk2(ur[2], ur[3]); oK[g].x = pk2(uk[0], uk[1]); oK[g].y = pk2(uk[2], uk[3]); oV[g].x = pk2(uv[0], uv[1]); oV[g].y = pk2(uv[2], uv[3]);
                  oKK[g].x = pk2(kk[0], kk[1]); oKK[g].y = pk2(kk[2], kk[3]); oAF[g].x = pk2(af[0], af[1]); oAF[g].y = pk2(af[2], af[3]); oAB[g].x = pk2(ab[0], ab[1]); oAB[g].y = pk2(ab[2], ab[3]); }
              asm volatile("s_waitcnt lgkmcnt(0)" ::: "memory");
              RF_PUT(0, oR); RF_PUT(1, oK); RF_PUT(2, oV); RF_FLUSH3(0, 1, 2, cblk);
              RF_PUT(0, oKK); RF_PUT(1, oAF); RF_PUT(2, oAB); RF_FLUSH3(3, 6, 7, cblk); }
        }
        sb = half_swap_sum(sb);
        if (hi == 0) ((float*)(F.ws + WS_SB))[(size_t)row * 16 + h] = sb;
    }
#undef RF_LOADG
#undef RF_STORET
#undef RF_SHIFT4
#undef RF_PUT
#undef RF_FLUSH3
}

__device__ __forceinline__ float gelu_tanh(float x) { return 0.5f * x * (1.f + tanhf_(0.7978845608028654f * (x + 0.044715f * x * x * x))); }
template <bool PASS3>
__device__ __forceinline__ void lru_item(Frame& F, int l, int item) {
    F.tid = ltid(); F.lane = F.tid & 63;
    const int sc = item >> 3, nb = item & 7, b = sc / NCH, ch = sc % NCH;
    int row0, seq_lo, seq_hi;
    if (ch < 8) { seq_lo = M_LAT + b * NCTX; seq_hi = seq_lo + NCTX; row0 = seq_lo + ch * 32; }
    else { seq_lo = b * SEQ; seq_hi = seq_lo + SEQ; row0 = seq_lo + (ch - 8) * 32; }
    const bf16* P = (const bf16*)(F.ws + WS_P);
    LAS float* U = (LAS float*)F.lds;
    LAS bf16* UA = (LAS bf16*)(F.lds + 16384);
    LAS float* AB = (LAS float*)(F.lds + 32768);
    __syncthreads();
    { const int tok = F.tid >> 4, c8 = (F.tid & 15) * 8, cg = nb * 128 + c8; float acc[8];
      const float* cb = F.A->in[I_CONVB] + l * 1024 + cg;
#pragma unroll
      for (int e = 0; e < 8; ++e) acc[e] = cb[e];
#pragma unroll
      for (int j = 0; j < 4; ++j) { const int r = row0 + tok - 2 + j;
          if (r >= seq_lo && r < seq_hi) { const v4u x = *(const v4u*)(P + (size_t)r * DINP + C_LRUX + cg); const float* cw = F.A->in[I_CONVW] + (size_t)(l * 4 + j) * 1024 + cg;
#pragma unroll
              for (int w = 0; w < 4; ++w) { acc[2 * w] += cw[2 * w] * bflo(x[w]); acc[2 * w + 1] += cw[2 * w + 1] * bfhi(x[w]); } } }
      *(LAS f32x4*)(U + tok * 128 + c8) = (f32x4){acc[0], acc[1], acc[2], acc[3]}; *(LAS f32x4*)(U + tok * 128 + c8 + 4) = (f32x4){acc[4], acc[5], acc[6], acc[7]};
      v4u o; o.x = pk2(acc[0], acc[1]); o.y = pk2(acc[2], acc[3]); o.z = pk2(acc[4], acc[5]); o.w = pk2(acc[6], acc[7]);
      *(LAS v4u*)(UA + tok * 136 + c8) = o; }
    __syncthreads();
    { const int dir = F.wave >> 2, cq = F.wave & 3, l32 = F.lane & 31, hi = F.lane >> 5, chn = cq * 32 + l32, cg = nb * 128 + chn;
      const bf16* Wr = (const bf16*)(F.wsw + WS_WLRU) + ((size_t)(dir * 2 + 0) * 8 + nb) * 16384 + (size_t)chn * 128;
      const bf16* Wi = (const bf16*)(F.wsw + WS_WLRU) + ((size_t)(dir * 2 + 1) * 8 + nb) * 16384 + (size_t)chn * 128;
      f32x16 accr = {}, acci = {};
#pragma unroll
      for (int ks = 0; ks < 8; ++ks) { const int ko = ks * 16 + hi * 8;
          const bf16x8 a = *(const LAS bf16x8*)(UA + l32 * 136 + ko); const bf16x8 br = *(const bf16x8*)(Wr + ko), bi = *(const bf16x8*)(Wi + ko);
          accr = __builtin_amdgcn_mfma_f32_32x32x16_bf16(a, br, accr, 0, 0, 0); acci = __builtin_amdgcn_mfma_f32_32x32x16_bf16(a, bi, acci, 0, 0, 0); }
      const float ba = F.A->in[I_LBA][(l * 2 + dir) * 1024 + cg], bi_ = F.A->in[I_LBI][(l * 2 + dir) * 1024 + cg], sp = softplusf_(-F.A->in[I_LAM][(l * 2 + dir) * 1024 + cg]);
#pragma unroll
      for (int r = 0; r < 16; ++r) { const int tok = att::crow(r, hi); const float u = U[tok * 128 + chn];
          const float rg = sigmoidf_(accr[r] + ba), ig = sigmoidf_(acci[r] + bi_), la = -8.f * rg * sp, a = __expf(la), x2 = 2.f * la;
          const float em = x2 * (1.f + x2 * (0.5f + x2 * (0.16666667f + x2 * (0.041666668f + x2 * (0.0083333338f + x2 * 0.0013888889f)))));
          const float bc = __builtin_amdgcn_sqrtf(x2 < -0.5f ? 1.f - a * a : -em) * (ig * u);
          AB[(dir * 2 + 0) * 4096 + tok * 128 + chn] = a; AB[(dir * 2 + 1) * 4096 + tok * 128 + chn] = bc; } }
    __syncthreads();
    if (F.tid < 256) { const int dir = F.tid >> 7, chn = F.tid & 127, cg = nb * 128 + chn; const size_t ci = ((size_t)(dir * 2 + b) * NCH + ch) * 1024 + cg;
        LAS float* Aa = AB + (dir * 2) * 4096 + chn; LAS float* Bb = AB + (dir * 2 + 1) * 4096 + chn;
        if (!PASS3) { float h = 0.f, ap = 1.f;
#pragma unroll 8
            for (int s = 0; s < 32; ++s) { const int tok = dir ? 31 - s : s; const float a = Aa[tok * 128]; h = a * h + Bb[tok * 128]; ap *= a;
                if (s == 0 && dir == 1 && ch == 7) ((float*)(F.ws + WS_QUIRK))[b * 1024 + cg] = h; }
            ((float*)(F.ws + WS_CA))[ci] = ap; ((float*)(F.ws + WS_CB))[ci] = h;
        } else { float h = ((const float*)(F.ws + WS_HIN))[ci];
#pragma unroll 8
            for (int s = 0; s < 32; ++s) { const int tok = dir ? 31 - s : s; h = Aa[tok * 128] * h + Bb[tok * 128]; Bb[tok * 128] = h; } } }
    if (PASS3) { __syncthreads();
        const int tok = F.tid >> 4, c8 = (F.tid & 15) * 8, cg = nb * 128 + c8, row = row0 + tok;
        const v4u y = *(const v4u*)(P + (size_t)row * DINP + C_LRUY + cg); float o[8];
#pragma unroll
        for (int w = 0; w < 4; ++w) { const float h0 = AB[4096 + tok * 128 + c8 + 2 * w] + AB[3 * 4096 + tok * 128 + c8 + 2 * w], h1 = AB[4096 + tok * 128 + c8 + 2 * w + 1] + AB[3 * 4096 + tok * 128 + c8 + 2 * w + 1];
            o[2 * w] = h0 * gelu_tanh(bflo(y[w])); o[2 * w + 1] = h1 * gelu_tanh(bfhi(y[w])); }
        v4u ov; ov.x = pk2(o[0], o[1]); ov.y = pk2(o[2], o[3]); ov.z = pk2(o[4], o[5]); ov.w = pk2(o[6], o[7]);
        *(v4u*)((bf16*)(F.ws + WS_MIX) + (size_t)row * DM + 1024 + cg) = ov; }
}
__device__ __forceinline__ void lru_carry(Frame& F, int blk) {
    F.tid = ltid(); F.lane = F.tid & 63;
    const int gid = blk * NTHR + F.tid; if (gid >= 4096) return;
    const int dir = gid >> 11, b = (gid >> 10) & 1, cg = gid & 1023;
    const float* CA = (const float*)(F.ws + WS_CA) + ((size_t)(dir * 2 + b) * NCH) * 1024 + cg; const float* CB = (const float*)(F.ws + WS_CB) + ((size_t)(dir * 2 + b) * NCH) * 1024 + cg;
    float* HIN = (float*)(F.ws + WS_HIN) + ((size_t)(dir * 2 + b) * NCH) * 1024 + cg;
    float h = 0.f;
    if (dir == 0) {
#pragma unroll 8
        for (int c = 0; c < NCH; ++c) { HIN[(size_t)c * 1024] = h; h = CA[(size_t)c * 1024] * h + CB[(size_t)c * 1024]; }
    } else {
        for (int c = 7; c >= 0; --c) { HIN[(size_t)c * 1024] = h; h = CA[(size_t)c * 1024] * h + CB[(size_t)c * 1024]; }
        h = ((const float*)(F.ws + WS_QUIRK))[b * 1024 + cg];
#pragma unroll 8
        for (int c = NCH - 1; c >= 8; --c) { HIN[(size_t)c * 1024] = h; h = CA[(size_t)c * 1024] * h + CB[(size_t)c * 1024]; }
    }
}

__device__ __forceinline__ void rope_table(Frame& F) {
    const int i = F.vcu * NTHR + F.tid; if (i >= 2048) return;
    const int pos = i >> 4, f = i & 15; float s, c; sincosf((float)pos * exp2f(-(float)f * (13.287712379549449f / 16.f)), &s, &c);
    float* t = (float*)(F.ws + WS_ROPE); t[i] = c; t[2048 + i] = s;
}
__device__ __forceinline__ void row_prep(Frame& F, int row) {
    F.tid = ltid(); F.lane = F.tid & 63;
    bf16* pr = (bf16*)(F.ws + WS_P) + (size_t)row * DINP; const int lane = F.lane;
    const bool lat = row < M_LAT; const int t = row & (SEQ - 1); const float prow = (float)(t >> 6), pcol = (float)(t & 63);
    { const v4u a = *(const v4u*)(pr + C_QA + lane * 16), b = *(const v4u*)(pr + C_QA + lane * 16 + 8); float ss = 0.f;
#pragma unroll
      for (int w = 0; w < 4; ++w) { const float x0 = bflo(a[w]), x1 = bfhi(a[w]), x2 = bflo(b[w]), x3 = bfhi(b[w]); ss += x0 * x0 + x1 * x1 + x2 * x2 + x3 * x3; }
      ss = wave_sum(ss); if (lane == 0) ((float*)(F.ws + WS_RSQ))[row] = 1.f / sqrtf(ss * (1.f / 1024.f) + RMS_EPS); }
    { const v4u a = *(const v4u*)(pr + C_KVA + lane * 8); float ss = 0.f;
#pragma unroll
      for (int w = 0; w < 4; ++w) { const float x0 = bflo(a[w]), x1 = bfhi(a[w]); ss += x0 * x0 + x1 * x1; }
      ss = wave_sum(ss); if (lane == 0) ((float*)(F.ws + WS_RSKV))[row] = 1.f / sqrtf(ss * (1.f / 512.f) + RMS_EPS); }
    bf16* kr = (bf16*)(F.ws + WS_KR) + (size_t)row * 64;
    if (lat) {
        { const int part = lane >> 5, sub = lane & 31;
          const float inv = exp2f(-(float)sub * (13.287712379549449f / 32.f)); float sn, cs; sincosf((part ? pcol : prow) * inv, &sn, &cs);
#pragma unroll
          for (int hd = 0; hd < 10; ++hd) { bf16* qb = pr + (hd < 8 ? C_SWAQ + hd * 128 : C_SWAK + (hd - 8) * 128) + part * 64;
              const float x1 = bf2f(qb[sub]), x2 = bf2f(qb[sub + 32]); qb[sub] = (bf16)f2bf(x1 * cs - x2 * sn); qb[sub + 32] = (bf16)f2bf(x2 * cs + x1 * sn); } }
        if (lane < 32) { const int part = lane >> 4, i = lane & 15; const bf16* src = pr + C_KR + part * 32;
          const float inv = exp2f(-(float)i * (13.287712379549449f / 16.f)); float s, c; sincosf((part ? pcol : prow) * inv, &s, &c);
          const float x1 = bf2f(src[i]), x2 = bf2f(src[i + 16]);
          kr[part * 32 + i] = (bf16)f2bf(x1 * c - x2 * s); kr[part * 32 + i + 16] = (bf16)f2bf(x2 * c + x1 * s); }
    } else kr[lane] = pr[C_KR + lane];
}

__device__ __forceinline__ float allred16(float x) { return row_sum16(x); }
__device__ __forceinline__ int scan_row(int s, int dir, int b) {
    if (s < NCTX) return M_LAT + b * NCTX + (dir ? NCTX - 1 - s : s);
    const int t = s - NCTX; return b * SEQ + (dir ? SEQ - 1 - t : t);
}
__device__ __forceinline__ void rwkv_scan(Frame& F, int l, int chain) {
    F.tid = ltid(); F.lane = F.tid & 63;
    const int dir = chain >> 5, b = (chain >> 4) & 1, h = chain & 15;
    constexpr int CT = 24, NCHK = (NCTX + SEQ) / CT, STEPF = 392, BUFF = CT * STEPF;
    LAS float* buf = (LAS float*)F.lds; LAS float* ybuf = (LAS float*)(F.lds + 3 * BUFF * 4);
    gcbf RWF = (gcbf)(F.ws + WS_RWF); const size_t RS = (size_t)M_TOT * 1024;
    gflp YS = (gflp)(F.ws + WS_YS) + (size_t)dir * M_TOT * 1024;
    const bool cmp = F.wave < 4; const int lt = F.tid - 256, lst = lt >> 4, lq = lt & 15, lc = h * 64 + 4 * lq;
    const f32x4 ka4 = *(const GAS f32x4*)((gcfl)F.A->in[I_KA] + l * 1024 + (cmp ? 0 : lc));
    v2u gr[2], gk[2], gv[2], gkk[2], ge[2], ga[2];
#pragma unroll
    for (int u = 0; u < 2; ++u) { gr[u] = (v2u){0u, 0u}; gk[u] = gr[u]; gv[u] = gr[u]; gkk[u] = gr[u]; ge[u] = gr[u]; ga[u] = gr[u]; }
#define RW_LOAD(c) do { if (!cmp) { _Pragma("unroll") for (int u_ = 0; u_ < 2; ++u_) { const int s_ = lst + 16 * u_; if (s_ < CT) { const size_t o_ = (size_t)scan_row((c) * CT + s_, dir, b) * 1024 + lc; \
        gr[u_] = *(const GAS v2u*)(RWF + 0 * RS + o_); gk[u_] = *(const GAS v2u*)(RWF + 1 * RS + o_); gv[u_] = *(const GAS v2u*)(RWF + 2 * RS + o_); \
        gkk[u_] = *(const GAS v2u*)(RWF + 3 * RS + o_); ge[u_] = *(const GAS v2u*)(RWF + (4 + dir) * RS + o_); ga[u_] = *(const GAS v2u*)(RWF + (6 + dir) * RS + o_); } } } } while (0)
#define RW_WRITE(bi) do { if (!cmp) { _Pragma("unroll") for (int u_ = 0; u_ < 2; ++u_) { const int s_ = lst + 16 * u_; if (s_ < CT) { LAS float* d_ = buf + (bi) * BUFF + s_ * STEPF + 4 * lq; \
        const float r_[4] = {bflo(gr[u_].x), bfhi(gr[u_].x), bflo(gr[u_].y), bfhi(gr[u_].y)}, k_[4] = {bflo(gk[u_].x), bfhi(gk[u_].x), bflo(gk[u_].y), bfhi(gk[u_].y)}, v_[4] = {bflo(gv[u_].x), bfhi(gv[u_].x), bflo(gv[u_].y), bfhi(gv[u_].y)}; \
        const float q_[4] = {bflo(gkk[u_].x), bfhi(gkk[u_].x), bflo(gkk[u_].y), bfhi(gkk[u_].y)}, e_[4] = {bflo(ge[u_].x), bfhi(ge[u_].x), bflo(ge[u_].y), bfhi(ge[u_].y)}, a_[4] = {bflo(ga[u_].x), bfhi(ga[u_].x), bflo(ga[u_].y), bfhi(ga[u_].y)}; \
        f32x4 w4, kd4, kk4, b4, wr4, v4; float sbr = 0.f, skr = 0.f; \
        _Pragma("unroll") for (int e = 0; e < 4; ++e) { w4[e] = __expf(-e_[e]); kd4[e] = k_[e] * (1.f + (a_[e] - 1.f) * ka4[e]); kk4[e] = q_[e]; b4[e] = q_[e] * a_[e]; wr4[e] = w4[e] * r_[e]; v4[e] = v_[e]; sbr += b4[e] * r_[e]; skr += kd4[e] * r_[e]; } \
        sbr = row_sum16(sbr); skr = row_sum16(skr); \
        *(LAS f32x4*)(d_) = w4; *(LAS f32x4*)(d_ + 64) = kd4; *(LAS f32x4*)(d_ + 128) = kk4; *(LAS f32x4*)(d_ + 192) = b4; *(LAS f32x4*)(d_ + 256) = wr4; *(LAS f32x4*)(d_ + 320) = v4; \
        if (lq == 0) *(LAS f32x2*)(buf + (bi) * BUFF + s_ * STEPF + 384) = (f32x2){sbr, skr}; } } } } while (0)
#define RW_FLUSH(c) do { if (!cmp) { _Pragma("unroll") for (int u_ = 0; u_ < 2; ++u_) { const int s_ = lst + 16 * u_; if (s_ < CT) { const f32x4 y_ = *(const LAS f32x4*)(ybuf + ((c) & 1) * (CT * 64) + s_ * 64 + 4 * lq); \
        *(GAS f32x4*)(YS + (size_t)scan_row((c) * CT + s_, dir, b) * 1024 + lc) = y_; } } } } while (0)
    __syncthreads();
    RW_LOAD(0); RW_WRITE(0); RW_LOAD(1); RW_WRITE(1); RW_LOAD(2);
    __syncthreads();
    const int kg = F.lane & 7, rg = F.lane >> 3, r0 = 16 * (F.wave & 3) + 2 * rg;
    f32x2 St[8];
#pragma unroll
    for (int i = 0; i < 8; ++i) St[i] = (f32x2){0.f, 0.f};
    int bc = 0, bw = 2;
#pragma unroll 1
    for (int c = 0; c < NCHK; ++c) {
        if (c + 2 < NCHK) { RW_WRITE(bw); if (c + 3 < NCHK) RW_LOAD(c + 3); }
        if (c > 0) RW_FLUSH(c - 1);
        if (cmp) {
        const LAS float* bb = buf + bc * BUFF + 8 * kg; const LAS float* vb = buf + bc * BUFF + 320 + r0; const LAS float* sb = buf + bc * BUFF + 384;
        LAS float* yb = ybuf + (c & 1) * (CT * 64) + r0;
        f32x4 w4[2], kd4[2], kk4[2], b4[2], wr4[2];
#pragma unroll
        for (int q = 0; q < 2; ++q) { w4[q] = *(const LAS f32x4*)(bb + 4 * q); kd4[q] = *(const LAS f32x4*)(bb + 64 + 4 * q); kk4[q] = *(const LAS f32x4*)(bb + 128 + 4 * q); b4[q] = *(const LAS f32x4*)(bb + 192 + 4 * q); wr4[q] = *(const LAS f32x4*)(bb + 256 + 4 * q); }
        f32x2 v2 = *(const LAS f32x2*)(vb), s2 = *(const LAS f32x2*)(sb);
#pragma unroll
        for (int st = 0; st < CT; ++st) {
            const int sn = (st + 1 < CT ? st + 1 : st) * STEPF;
            f32x4 nw4[2], nkd4[2], nkk4[2], nb4[2], nwr4[2];
#pragma unroll
            for (int q = 0; q < 2; ++q) { nw4[q] = *(const LAS f32x4*)(bb + sn + 4 * q); nkd4[q] = *(const LAS f32x4*)(bb + sn + 64 + 4 * q); nkk4[q] = *(const LAS f32x4*)(bb + sn + 128 + 4 * q); nb4[q] = *(const LAS f32x4*)(bb + sn + 192 + 4 * q); nwr4[q] = *(const LAS f32x4*)(bb + sn + 256 + 4 * q); }
            const f32x2 nv2 = *(const LAS f32x2*)(vb + sn), ns2 = *(const LAS f32x2*)(sb + sn);
#define PKH(x, i) ((i) & 1 ? (f32x2){(x)[2], (x)[3]} : (f32x2){(x)[0], (x)[1]})
#define PK_MUL(d, a, bp, i) do { if ((i) & 1) asm("v_pk_mul_f32 %0, %1, %2 op_sel:[0,1] op_sel_hi:[1,1]" : "=v"(d) : "v"(a), "v"(bp)); else asm("v_pk_mul_f32 %0, %1, %2 op_sel:[0,0] op_sel_hi:[1,0]" : "=v"(d) : "v"(a), "v"(bp)); } while (0)
#define PK_FMA(d, a, bp, i, c) do { if ((i) & 1) asm("v_pk_fma_f32 %0, %1, %2, %3 op_sel:[0,1,0] op_sel_hi:[1,1,1]" : "=v"(d) : "v"(a), "v"(bp), "v"(c)); else asm("v_pk_fma_f32 %0, %1, %2, %3 op_sel:[0,0,0] op_sel_hi:[1,0,1]" : "=v"(d) : "v"(a), "v"(bp), "v"(c)); } while (0)
#define PK_FNMA(d, a, bp, i, c) do { if ((i) & 1) asm("v_pk_fma_f32 %0, %1, %2, %3 op_sel:[0,1,0] op_sel_hi:[1,1,1] neg_lo:[1,0,0] neg_hi:[1,0,0]" : "=v"(d) : "v"(a), "v"(bp), "v"(c)); \
        else asm("v_pk_fma_f32 %0, %1, %2, %3 op_sel:[0,0,0] op_sel_hi:[1,0,1] neg_lo:[1,0,0] neg_hi:[1,0,0]" : "=v"(d) : "v"(a), "v"(bp), "v"(c)); } while (0)
#define OPP(x, e) PKH((x)[(e) >> 2], ((e) >> 1) & 1)
            f32x2 pa, za, pb, zb;
            PK_MUL(pa, St[0], OPP(kk4, 0), 0); PK_MUL(za, St[0], OPP(wr4, 0), 0); PK_MUL(pb, St[4], OPP(kk4, 4), 4); PK_MUL(zb, St[4], OPP(wr4, 4), 4);
#pragma unroll
            for (int i = 1; i < 4; ++i) { PK_FMA(pa, St[i], OPP(kk4, i), i, pa); PK_FMA(za, St[i], OPP(wr4, i), i, za); PK_FMA(pb, St[4 + i], OPP(kk4, 4 + i), 4 + i, pb); PK_FMA(zb, St[4 + i], OPP(wr4, 4 + i), 4 + i, zb); }
            const f32x2 p = pa + pb, z = za + zb;
            float p0 = p.x, p1 = p.y, z0 = z.x, z1 = z.y;
#define D4(ctl) "v_add_f32_dpp %0, %0, %0 " ctl " row_mask:0xf bank_mask:0xf\n\tv_add_f32_dpp %1, %1, %1 " ctl " row_mask:0xf bank_mask:0xf\n\tv_add_f32_dpp %2, %2, %2 " ctl " row_mask:0xf bank_mask:0xf\n\tv_add_f32_dpp %3, %3, %3 " ctl " row_mask:0xf bank_mask:0xf\n\t"
            asm volatile("s_nop 1\n\t" D4("quad_perm:[1,0,3,2]") D4("quad_perm:[2,3,0,1]") D4("row_half_mirror") "s_nop 0"
                : "+v"(p0), "+v"(p1), "+v"(z0), "+v"(z1));
#undef D4
            const f32x2 pp = {p0, p1}, zz = {z0, z1};
            { f32x2 y; PK_FNMA(y, pp, s2, 0, zz); PK_FMA(y, v2, s2, 1, y); *(LAS f32x2*)(yb + st * 64) = y; }
#pragma unroll
            for (int i = 0; i < 8; ++i) { f32x2 t; PK_MUL(t, v2, OPP(kd4, i), i); PK_FMA(t, St[i], OPP(w4, i), i, t); PK_FNMA(St[i], pp, OPP(b4, i), i, t); }
#undef OPP
#undef PKH
#undef PK_MUL
#undef PK_FMA
#undef PK_FNMA
#pragma unroll
            for (int q = 0; q < 2; ++q) { w4[q] = nw4[q]; kd4[q] = nkd4[q]; kk4[q] = nkk4[q]; b4[q] = nb4[q]; wr4[q] = nwr4[q]; }
            v2 = nv2; s2 = ns2;
        }
        }
        __syncthreads();
        bc = bc == 2 ? 0 : bc + 1; bw = bw == 2 ? 0 : bw + 1;
    }
    RW_FLUSH(NCHK - 1);
#undef RW_LOAD
#undef RW_WRITE
#undef RW_FLUSH
}
__device__ __forceinline__ void rwkv_out_row(Frame& F, int l, int row) {
    F.tid = ltid(); F.lane = F.tid & 63;
    const int c0 = F.lane * 16; const float* yf = (const float*)(F.ws + WS_YS) + (size_t)row * 1024 + c0; const float* yb = yf + (size_t)M_TOT * 1024;
    float y[16]; float s = 0.f;
#pragma unroll
    for (int j = 0; j < 4; ++j) { const f32x4 a = *(const f32x4*)(yf + 4 * j), b = *(const f32x4*)(yb + 4 * j);
#pragma unroll
        for (int e = 0; e < 4; ++e) { y[4 * j + e] = a[e] + b[e]; s += y[4 * j + e]; } }
    s = quad_sum(s); const float mu = s * (1.f / 64.f); float q = 0.f;
#pragma unroll
    for (int e = 0; e < 16; ++e) { y[e] -= mu; q += y[e] * y[e]; }
    q = quad_sum(q); const float rstd = 1.f / sqrtf(q * (1.f / 64.f) + GN_EPS);
    const bf16* RWF = (const bf16*)(F.ws + WS_RWF); const size_t RS = (size_t)M_TOT * 1024, o = (size_t)row * 1024 + c0;
    const float sbv = ((const float*)(F.ws + WS_SB))[(size_t)row * 16 + (F.lane >> 2)];
    const float* lg = F.A->in[I_LNG] + l * 1024 + c0; const float* lb = F.A->in[I_LNB] + l * 1024 + c0;
    bf16* dst = (bf16*)(F.ws + WS_MIX) + (size_t)row * DM + 3072 + c0;
#pragma unroll
    for (int hf = 0; hf < 2; ++hf) { const v4u vv = *(const v4u*)(RWF + 2 * RS + o + 8 * hf), gg = *(const v4u*)(RWF + 8 * RS + o + 8 * hf); float r[8];
#pragma unroll
        for (int w = 0; w < 4; ++w) { const int e = 8 * hf + 2 * w;
            r[2 * w] = (y[e] * rstd * lg[e] + lb[e] + sbv * bflo(vv[w])) * bflo(gg[w]); r[2 * w + 1] = (y[e + 1] * rstd * lg[e + 1] + lb[e + 1] + sbv * bfhi(vv[w])) * bfhi(gg[w]); }
        v4u ov; ov.x = pk2(r[0], r[1]); ov.y = pk2(r[2], r[3]); ov.z = pk2(r[4], r[5]); ov.w = pk2(r[6], r[7]); *(v4u*)(dst + 8 * hf) = ov; }
}

#ifndef W_OUT_K1
#define W_OUT_K1 2048
#endif
struct MlaTiles { gcbf KV; gcbf KR; int ctx_row0, lat_row0, h;
    __device__ __forceinline__ att::Tile operator()(int j) const { const int row = j < 4 ? ctx_row0 + 64 * j : lat_row0 + 64 * (j - 4);
        att::Tile t; t.kn = KV + (size_t)row * 2048 + h * 256; t.v = t.kn + 128; t.kr = KR + (size_t)row * 64; t.mtype = 0; t.krel0 = 0; return t; } };
struct SwaTiles { gcbf P; int blk_row0, ctx_row0, kvh, nwin, has_prev, has_next;
    __device__ __forceinline__ att::Tile operator()(int j) const { att::Tile t; int row; t.mtype = 0; t.krel0 = 0;
        if (j >= nwin) row = ctx_row0 + 64 * (j - nwin);
        else if (j < 2) row = blk_row0 + 64 * j;
        else if (has_prev && j < 4) { row = blk_row0 - 128 + 64 * (j - 2); t.mtype = 1; t.krel0 = -128 + 64 * (j - 2); }
        else { const int sub = j - 2 - 2 * has_prev; row = blk_row0 + 128 + 64 * sub; t.mtype = 2; t.krel0 = 128 + 64 * sub; }
        t.kn = P + (size_t)row * DINP + C_SWAK + kvh * 128; t.v = P + (size_t)row * DINP + C_SWAV + kvh * 128; t.kr = nullptr; return t; } };

#ifndef MLA_SDEPTH
#define MLA_SDEPTH 1
#endif
__device__ __forceinline__ void mla_item(Frame& F, int b, int h, int qb, bool ctxq) {
    F.tid = ltid(); F.lane = F.tid & 63;
    const int r32 = F.lane & 31; const int t = qb * 256 + F.wave * 32 + r32;
    const int roww0 = ctxq ? M_LAT + b * NCTX + F.wave * 32 : b * SEQ + qb * 256 + F.wave * 32;
    gcbf Qw = (gcbf)(F.ws + WS_Q) + (size_t)(roww0 + r32) * 1536 + h * 192;
    MlaTiles ts{(gcbf)(F.ws + WS_KV), (gcbf)(F.ws + WS_KR), M_LAT + b * NCTX, b * SEQ, h};
    gbfp Ow = (gbfp)(F.ws + WS_MIX) + (size_t)roww0 * DM + 2048 + h * 128;
    att::attn_body<192, 2048, 2048, false, false, MLA_SDEPTH>(Qw, ctxq ? 0 : 1, t >> 6, t & 63, (gcfl)(F.ws + WS_ROPE), 0, 0.f, ts, ctxq ? 4 : 132, Ow, (LAS char*)F.lds);
}
__device__ __forceinline__ void swa_item(Frame& F, int l, int b, int n, int kvh, int half, bool ctxq, int hq_ctx) {
    F.tid = ltid(); F.lane = F.tid & 63;
    const int r32 = F.lane & 31; gcbf P = (gcbf)(F.ws + WS_P);
    int hq, qi, roww0, t;
    if (ctxq) { hq = hq_ctx; kvh = hq >> 2; qi = 0; roww0 = M_LAT + b * NCTX + F.wave * 32; t = 0; }
    else { hq = kvh * 4 + 2 * half + (F.wave >> 2); qi = (F.wave & 3) * 32 + r32; roww0 = b * SEQ + n * 128 + (F.wave & 3) * 32; t = n * 128 + qi; }
    gcbf Qw = P + (size_t)(roww0 + r32) * DINP + C_SWAQ + hq * 128;
    SwaTiles ts; ts.P = P; ts.blk_row0 = b * SEQ + n * 128; ts.ctx_row0 = M_LAT + b * NCTX; ts.kvh = kvh;
    ts.has_prev = (!ctxq && n > 0) ? 1 : 0; ts.has_next = (!ctxq && n < SEQ / 128 - 1) ? 1 : 0; ts.nwin = ctxq ? 0 : 2 + 2 * ts.has_prev + 2 * ts.has_next;
    gbfp Ow = (gbfp)(F.ws + WS_MIX) + (size_t)roww0 * DM + hq * 128;
    const float sink_l2 = F.A->in[I_SINK][l * 8 + hq] * 1.4426950408889634f;
    att::attn_body<128, DINP, DINP, true, true, 2>(Qw, 0, 0, 0, (gcfl)nullptr, qi, sink_l2, ts, ts.nwin + 4, Ow, (LAS char*)F.lds);
}

#ifndef DBG_PHASES
#define DBG_PHASES 0xfffff
#endif
#define PH(n) ((DBG_PHASES >> (n)) & 1)
#ifndef DUP_PHASES
#define DUP_PHASES 0
#endif
#define REP(n) _Pragma("unroll") for (int rep_ = 0; rep_ < (((DUP_PHASES >> (n)) & 1) ? 2 : 1); ++rep_)
__global__ void __launch_bounds__(NTHR, 2) mk_fwd(Args args) {
    extern __shared__ __attribute__((aligned(16))) unsigned char lds[];
    Frame F;
    F.lds = (LAS unsigned char*)lds;
    F.tid = threadIdx.x; F.lane = F.tid & 63; F.wave = __builtin_amdgcn_readfirstlane(F.tid >> 6);
    F.G = gridDim.x; { const int bx = blockIdx.x; F.vcu = (F.G % 8 == 0) ? (bx % 8) * (F.G / 8) + bx / 8 : bx; }
    F.gw = F.vcu * NWAVES + F.wave; F.NGW = F.G * NWAVES;
    F.ws = args.ws; F.out = args.out; F.ctl = (gu32*)(args.ws + WS_CTL);
    F.A = (const __attribute__((address_space(4))) Args*)__builtin_amdgcn_kernarg_segment_ptr();
    for (int u = F.tid; u < (LDS_BYTES - LDSCTL_OFF) / 4; u += NTHR) ((LAS unsigned*)(F.lds + LDSCTL_OFF))[u] = 0u;
    __syncthreads();
    XcdBarrier bar = xcd_barrier_post((unsigned*)(args.ws + WS_CTL) + 4096, (volatile LAS unsigned*)(F.lds + MISC_OFF) + 8);
    const bool rwkv_blk = (blockIdx.x & 3) == 0;
    XcdBarrier bar2; bar2.bar = (unsigned*)(args.ws + WS_CTL) + 8192; bar2.x = 0; bar2.st = (volatile LAS unsigned*)(F.lds + MISC_OFF) + 12; bar2.nparts = gridDim.x - ((gridDim.x + 3) >> 2);
    if (!rwkv_blk) { const unsigned np_ = bar2.nparts; bar2 = xcd_barrier_post((unsigned*)(args.ws + WS_CTL) + 8192, (volatile LAS unsigned*)(F.lds + MISC_OFF) + 12); bar2.nparts = np_; }
#define SUB_BAR() do { bar2.bar = launder(bar2.bar); bar2.x = launder(bar2.x); xcd_barrier(bar2); F.ws = launder_g(F.ws); F.wsw = F.ws + (size_t)lcur * WSET_STRIDE; F.A = launder(F.A); F.tid = ltid(); F.lane = F.tid & 63; } while (0)
#define GRID_BAR() do { bar.bar = launder(bar.bar); bar.x = launder(bar.x); xcd_barrier(bar); F.ws = launder_g(F.ws); F.wsw = F.ws + (size_t)lcur * WSET_STRIDE; F.A = launder(F.A); F.tid = ltid(); F.lane = F.tid & 63; } while (0)
    const int bx = blockIdx.x; int lcur = 0; F.wsw = F.ws;
    bf16* H = (bf16*)(F.ws + WS_H); float* X = (float*)(F.ws + WS_X);

    REP(0) if (PH(0)) { mod_partials(F);
    convert_weights(F, 0, F.gw, F.NGW); }
    GRID_BAR();
    if (PH(1)) { mod_reduce(F); rope_table(F); }
    GRID_BAR();

#pragma unroll 1
    for (int l = 0; l < 2; ++l) {
        lcur = l; F.wsw = F.ws + (size_t)l * WSET_STRIDE;
        const bool wctx = (l == 0);
        const int MO = wctx ? M_TOT : M_LAT;
        if (PH(2) && l == 0) {
            for (int row = F.gw; row < M_TOT; row += F.NGW) { const int s = row_s(row);
                const float* xs = row < M_LAT ? F.A->in[I_X] + (size_t)row * DM : F.A->in[I_CTX] + (size_t)(row - M_LAT) * DM;
                ln_row<0>(F, xs, nullptr, nullptr, nullptr, nullptr, nullptr, true, mod_ptr(F, 0, s, 1), mod_ptr(F, 0, s, 0), H + (size_t)row * DM); }
        }
        GRID_BAR();
        REP(3) if (PH(3)) { pg8::Gemm g{H, (const bf16*)(F.wsw + WS_WIN), M_TOT, DINP, DM, DM, DM}; pg8::StaticOrder S; S.init(M_TOT, DINP, F.G, bx);
          pg8::EpiBf16<0> E{(bf16*)(F.ws + WS_P), DINP, nullptr};
          pg8::gemm_phase<pg8::EpiBf16<0>, pg8::StaticOrder, true, true>(F.lds, g, S, E); }
        GRID_BAR();
        REP(4) if (PH(4)) for (int it = F.vcu; it < 528; it += F.G) rwkv_feat_item(F, l, it);
        REP(5) if (PH(5)) { if (F.G == 256) { if (F.vcu < 16) { for (int it = F.vcu; it < 64; it += 16) lru_item<false>(F, l, it); }
                                              else { for (int it = 64 + F.vcu - 16; it < 2 * NCH * 8; it += 240) lru_item<false>(F, l, it); } }
                            else for (int it = F.vcu; it < 2 * NCH * 8; it += F.G) lru_item<false>(F, l, it); }
        __syncthreads();
        if (PH(6)) for (int row = F.gw; row < M_TOT; row += F.NGW) row_prep(F, row);
        GRID_BAR();
        REP(8) if (rwkv_blk) { const int nrw = (F.G + 3) >> 2; REP(18) if (PH(8)) for (int chain = bx >> 2; chain < 64; chain += nrw) rwkv_scan(F, l, chain); }
        else REP(19) { const int aw = (bx >> 2) * 3 + (bx & 3) - 1, naw = F.G - ((F.G + 3) >> 2);
            if (PH(7) && aw < 8) lru_carry(F, aw);
            if (PH(7)) { pg8::Gemm g{(const bf16*)(F.ws + WS_P) + C_QA, (const bf16*)(F.wsw + WS_WQB), M_TOT, 1536, 1024, DINP, 1024}; pg8::StaticOrder S; S.init(M_TOT, 1536, naw, aw);
              pg8::EpiBf16<2> E{(bf16*)(F.ws + WS_Q), 1536, (const float*)(F.ws + WS_RSQ)};
              pg8::gemm_phase<pg8::EpiBf16<2>, pg8::StaticOrder, true, true>(F.lds, g, S, E); }
            if (PH(7)) { pg8::Gemm g{(const bf16*)(F.ws + WS_P) + C_KVA, (const bf16*)(F.wsw + WS_WKVB), M_TOT, 2048, 512, DINP, 512}; pg8::StaticOrder S; S.init(M_TOT, 2048, naw, aw);
              pg8::EpiBf16<2> E{(bf16*)(F.ws + WS_KV), 2048, (const float*)(F.ws + WS_RSKV)};
              pg8::gemm_phase<pg8::EpiBf16<2>, pg8::StaticOrder, true, true>(F.lds, g, S, E); }
            SUB_BAR();
            if (PH(9)) for (int it = aw; it < 512; it += naw) mla_item(F, it >> 8, (it >> 5) & 7, it & 31, false);
            if (PH(9) && wctx) for (int it = aw; it < 16; it += naw) mla_item(F, it >> 3, it & 7, 0, true);
            if (PH(10)) for (int it = aw; it < 512; it += naw) swa_item(F, l, it >> 8, (it >> 2) & 63, (it >> 1) & 1, it & 1, false, 0);
            if (PH(10) && wctx) for (int it = aw; it < 16; it += naw) swa_item(F, l, it >> 3, 0, 0, 0, true, it & 7);
            if (PH(11)) { if (naw == 192) { const int i0 = aw < 128 ? aw : 1280 + aw - 128, st_ = aw < 128 ? 128 : 64, i1 = aw < 128 ? 1280 : 2 * NCH * 8;
                                            for (int it = i0; it < i1; it += st_) { if (!wctx && ((it >> 3) % NCH) < 8) continue; lru_item<true>(F, l, it); } }
                          else for (int it = aw; it < 2 * NCH * 8; it += naw) { if (!wctx && ((it >> 3) % NCH) < 8) continue; lru_item<true>(F, l, it); } }
            if (l == 0) { __syncthreads(); convert_weights(F, 1, aw * NWAVES + F.wave, naw * NWAVES); }
            else { SUB_BAR();
                pg8::Gemm g{(const bf16*)(F.ws + WS_MIX), (const bf16*)(F.wsw + WS_WOUT), M_LAT, DM, W_OUT_K1, DM, DM}; pg8::StaticOrder S; S.init(M_LAT, DM, naw, aw);
                pg8::EpiBf16<0> E{(bf16*)(F.ws + WS_Y1), DM, nullptr};
                pg8::gemm_phase<pg8::EpiBf16<0>, pg8::StaticOrder, true, true>(F.lds, g, S, E); }
        }
        GRID_BAR();
        REP(12) if (PH(12)) for (int row = F.gw; row < MO; row += F.NGW) rwkv_out_row(F, l, row);
        GRID_BAR();
        REP(13) if (PH(13)) {
          if (l == 0) { pg8::Gemm g{(const bf16*)(F.ws + WS_MIX), (const bf16*)(F.wsw + WS_WOUT), M_LAT, DM, DM, DM, DM}; pg8::StaticOrder S; S.init(M_LAT, DM, F.G, bx);
            pg8::EpiBf16<0> E{(bf16*)(F.ws + WS_Y1), DM, nullptr};
            pg8::gemm_phase<pg8::EpiBf16<0>, pg8::StaticOrder, true, true>(F.lds, g, S, E); }
          else { pg8::Gemm g{(const bf16*)(F.ws + WS_MIX) + W_OUT_K1, (const bf16*)(F.wsw + WS_WOUT) + W_OUT_K1, M_LAT, DM, DM - W_OUT_K1, DM, DM}; pg8::StaticOrder S; S.init(M_LAT, DM, F.G, bx);
            pg8::EpiBf16<3> E{(bf16*)(F.ws + WS_Y1), DM, nullptr};
            pg8::gemm_phase<pg8::EpiBf16<3>, pg8::StaticOrder, true, true>(F.lds, g, S, E); }
          if (wctx) {
              pg8::Gemm g2{(const bf16*)(F.ws + WS_MIX) + (size_t)M_LAT * DM, (const bf16*)(F.wsw + WS_WOUT), M_CTX, DM, DM / 8, DM, DM}; pg8::SplitOrder S2; S2.init(M_CTX, DM, DM / 8, bx);
              pg8::EpiF32 E2{(float*)(F.ws + WS_YP), DM, (size_t)M_CTX * DM};
              pg8::gemm_phase<pg8::EpiF32, pg8::SplitOrder, true, true>(F.lds, g2, S2, E2); } }
        GRID_BAR();
        if (PH(14)) for (int row = F.gw; row < MO; row += F.NGW) { const int s = row_s(row);
            const float* xs = (l == 0) ? (row < M_LAT ? F.A->in[I_X] + (size_t)row * DM : F.A->in[I_CTX] + (size_t)(row - M_LAT) * DM) : X + (size_t)row * DM;
            bf16* yrow = (bf16*)(F.ws + WS_Y1) + (size_t)row * DM;
            if (row >= M_LAT) sum_partials_row(F, (const float*)(F.ws + WS_YP) + (size_t)(row - M_LAT) * DM, (size_t)M_CTX * DM, yrow);
            ln_row<1>(F, xs, yrow, mod_ptr(F, l, s, 2), F.A->in[I_LN1G] + l * DM, F.A->in[I_LN1B] + l * DM, X + (size_t)row * DM,
                      true, mod_ptr(F, l, s, 4), mod_ptr(F, l, s, 3), H + (size_t)row * DM); }
        GRID_BAR();
        REP(15) if (PH(15)) { pg8::Gemm g{H, (const bf16*)(F.wsw + WS_WFF1), MO, DFF, DM, DM, DM}; pg8::StaticOrder S; S.init(MO, DFF, F.G, bx);
          pg8::EpiBf16<1> E{(bf16*)(F.ws + WS_HID), DFF, nullptr};
          pg8::gemm_phase<pg8::EpiBf16<1>, pg8::StaticOrder, true, true>(F.lds, g, S, E); }
        GRID_BAR();
        REP(16) if (PH(16)) { pg8::Gemm g{(const bf16*)(F.ws + WS_HID), (const bf16*)(F.wsw + WS_WFF2), M_LAT, DM, DFF, DFF, DFF}; pg8::StaticOrder S; S.init(M_LAT, DM, F.G, bx);
          pg8::EpiBf16<0> E{(bf16*)(F.ws + WS_Y2), DM, nullptr};
          pg8::gemm_phase<pg8::EpiBf16<0>, pg8::StaticOrder, true, true>(F.lds, g, S, E);
          if (wctx) {
              pg8::Gemm g2{(const bf16*)(F.ws + WS_HID) + (size_t)M_LAT * DFF, (const bf16*)(F.wsw + WS_WFF2), M_CTX, DM, DFF / 8, DFF, DFF}; pg8::SplitOrder S2; S2.init(M_CTX, DM, DFF / 8, bx);
              pg8::EpiF32 E2{(float*)(F.ws + WS_YP), DM, (size_t)M_CTX * DM};
              pg8::gemm_phase<pg8::EpiF32, pg8::SplitOrder, true, true>(F.lds, g2, S2, E2); } }
        GRID_BAR();
        if (!PH(17)) {} else if (l == 0) {
            for (int row = F.gw; row < M_TOT; row += F.NGW) { const int s = row_s(row);
                bf16* yrow = (bf16*)(F.ws + WS_Y2) + (size_t)row * DM;
                if (row >= M_LAT) sum_partials_row(F, (const float*)(F.ws + WS_YP) + (size_t)(row - M_LAT) * DM, (size_t)M_CTX * DM, yrow);
                ln_row<1>(F, X + (size_t)row * DM, yrow, mod_ptr(F, 0, s, 5), F.A->in[I_LN2G], F.A->in[I_LN2B], X + (size_t)row * DM,
                          true, mod_ptr(F, 1, s, 1), mod_ptr(F, 1, s, 0), H + (size_t)row * DM); }
        } else {
            for (int row = F.gw; row < M_LAT; row += F.NGW) { const int s = row_s(row);
                ln_row<1>(F, X + (size_t)row * DM, (const bf16*)(F.ws + WS_Y2) + (size_t)row * DM, mod_ptr(F, 1, s, 5), F.A->in[I_LN2G] + DM, F.A->in[I_LN2B] + DM, F.out + (size_t)row * DM,
                          false, nullptr, nullptr, nullptr); }
        }
    }
}

extern "C" void kernel_launch(void* const* d_in, const int* in_sizes, int n_in, void* d_out, int out_size, void* d_ws, size_t ws_size, hipStream_t stream) {
    static int grid = 0;
    if (grid == 0) {
        if (n_in != 38 || out_size != M_LAT * DM || ws_size < WS_END) { fprintf(stderr, "kernel_launch: unexpected shapes: n_in %d out %d ws %zu (need %zu)\n", n_in, out_size, ws_size, (size_t)WS_END); grid = -1; return; }
        int dev = 0, cus = 0, per_cu = 0;
        if (hipGetDevice(&dev) != hipSuccess || hipDeviceGetAttribute(&cus, hipDeviceAttributeMultiprocessorCount, dev) != hipSuccess) { grid = -1; return; }
        if (hipFuncSetAttribute((const void*)mk_fwd, hipFuncAttributeMaxDynamicSharedMemorySize, LDS_BYTES) != hipSuccess) { fprintf(stderr, "kernel_launch: hipFuncSetAttribute failed\n"); grid = -1; return; }
        if (hipOccupancyMaxActiveBlocksPerMultiprocessor(&per_cu, (const void*)mk_fwd, NTHR, LDS_BYTES) != hipSuccess || per_cu < 1) fprintf(stderr, "kernel_launch: occupancy query says %d\n", per_cu);
        (void)hipGetLastError();
        grid = cus;
    }
    if (grid < 0) return;
    if (hipMemsetAsync((char*)d_ws + WS_CTL, 0, CTL_ZERO_BYTES, stream) != hipSuccess) return;
    Args a{};
    for (int i = 0; i < 38; ++i) a.in[i] = (const float*)d_in[i];
    a.out = (float*)d_out; a.ws = (unsigned char*)d_ws;
    hipLaunchKernelGGL(mk_fwd, dim3(grid), dim3(NTHR), LDS_BYTES, stream, a);
    const hipError_t le = hipPeekAtLastError();
    if (le != hipSuccess) fprintf(stderr, "kernel_launch: launch failed: %s\n", hipGetErrorName(le));
}
```

```cpp
#include <hip/hip_runtime.h>
#include <hip/hip_bf16.h>
#include <cstdio>
#include <cstdint>

namespace pg8 {
#define PG8_LAS __attribute__((address_space(3)))
typedef unsigned short bf16_t;
typedef short bf16x8 __attribute__((ext_vector_type(8)));
typedef float f32x4 __attribute__((ext_vector_type(4)));
typedef unsigned u32x4 __attribute__((ext_vector_type(4)));
constexpr int BM = 256, BK = 64, HALF = 128, HTB = HALF * BK * 2  , STAGE_BYTES = 8 * HTB, NXCD = 8, WGM = 8;

__host__ __device__ __forceinline__ int lds_byte(int r, int c) { const int st = (r >> 4) * 2 + (c >> 5), rr = r & 15, cc = c & 31, ob = rr * 64 + cc * 2; return st * 1024 + (ob ^ (((ob >> 9) & 1) << 5)); }
__host__ __device__ __forceinline__ void stage_rc(int b, int& R, int& C) { const int st = b / 1024, sb = b % 1024, swz = sb ^ (((sb >> 9) & 1) << 5); R = (st >> 1) * 16 + swz / 64; C = (st & 1) * 32 + (swz % 64) / 2; }
__host__ __device__ __forceinline__ int perm32(int rho) { const int n = rho >> 4, i = rho & 15; return 8 * (i >> 2) + 4 * n + (i & 3); }

struct Unit { int pm, pn, ko, ks; };
struct Gemm { const bf16_t* A; const bf16_t* Bt; int M, N, K, lda, ldb; };

struct StaticOrder {
    int nM, nN, nwg, G, c;
    __host__ __device__ void init(int M, int N, int G_, int c_) { nM = M / BM; nN = N / BM; nwg = nM * nN; G = G_; c = c_; }
    __host__ __device__ bool next(int i, Unit& u) const {
        const long L = (long)i * G + c; if (L >= nwg) return false;
        int wgid = (int)L; { const int q = nwg / NXCD, r = nwg % NXCD, xcd = wgid % NXCD, off = wgid / NXCD; wgid = (xcd < r ? xcd * (q + 1) : r * (q + 1) + (xcd - r) * q) + off; }
        const int nig = WGM * nN, gid = wgid / nig, fm = gid * WGM, gsz = (nM - fm) < WGM ? (nM - fm) : WGM;
        u.pm = fm + ((wgid % nig) % gsz); u.pn = (wgid % nig) / gsz; u.ko = 0; u.ks = 0; return true;
    }
    __device__ __forceinline__ void a_ready(const Unit&) const {}
    __device__ __forceinline__ void done(const Unit&) const {}
};
struct SplitOrder {
    int nN, nitems, kslice, c;
    __host__ __device__ void init(int M, int N, int Kslice, int c_) { nN = N / BM; nitems = (M / BM) * nN * 8; kslice = Kslice; c = c_; }
    __host__ __device__ bool next(int i, Unit& u) const { if (i > 0 || c >= nitems) return false; u.ks = c & 7; u.ko = u.ks * kslice; u.pn = (c >> 3) % nN; u.pm = (c >> 3) / nN; return true; }
    __device__ __forceinline__ void a_ready(const Unit&) const {}
    __device__ __forceinline__ void done(const Unit&) const {}
};

__device__ __forceinline__ unsigned cvt_pk_bf16(float lo, float hi) { unsigned r; asm volatile("v_cvt_pk_bf16_f32 %0, %1, %2" : "=v"(r) : "v"(lo), "v"(hi)); return r; }

struct EpiF32 {
    static constexpr bool PERM = false, AFTER_DRAIN = false;
    float* C; int ldc; size_t split_stride;
    __device__ __forceinline__ void operator()(const f32x4 (&acc)[2][2][4][2], const Unit& u, int wr, int wc, int fr, int fq) const {
        const int row0 = u.pm * BM + wr * 64 + fr, col0 = u.pn * BM + wc * 32 + 4 * fq; float* Cb = C + (size_t)u.ks * split_stride;
#pragma unroll
        for (int ai = 0; ai < 2; ++ai)
#pragma unroll
            for (int m = 0; m < 4; ++m) { float* rowp = Cb + (size_t)(row0 + ai * HALF + m * 16) * ldc + col0;
#pragma unroll
                for (int bj = 0; bj < 2; ++bj)
#pragma unroll
                    for (int n = 0; n < 2; ++n) *(f32x4*)(rowp + bj * HALF + n * 16) = acc[ai][bj][m][n]; }
    }
};
template <int ACT> struct EpiBf16 {
    static constexpr bool PERM = true, AFTER_DRAIN = false;
    bf16_t* O; int ldc; const float* rowscale;
    __device__ __forceinline__ void operator()(const f32x4 (&acc)[2][2][4][2], const Unit& u, int wr, int wc, int fr, int fq) const {
        const int row0 = u.pm * BM + wr * 64 + fr; const int col0 = u.pn * BM + wc * 32 + 8 * fq;
#pragma unroll
        for (int ai = 0; ai < 2; ++ai)
#pragma unroll
            for (int m = 0; m < 4; ++m) { const int row = row0 + ai * HALF + m * 16; bf16_t* rowp = O + (size_t)row * ldc + col0;
                float rs = 1.f; if (ACT == 2) rs = rowscale[row];
#pragma unroll
                for (int bj = 0; bj < 2; ++bj) { f32x4 v0 = acc[ai][bj][m][0], v1 = acc[ai][bj][m][1];
                    if (ACT == 1) {
#pragma unroll
                        for (int j = 0; j < 4; ++j) { const float a = fmaxf(v0[j], 0.f), b = fmaxf(v1[j], 0.f); v0[j] = a * a; v1[j] = b * b; } }
                    if (ACT == 2) { v0 = v0 * rs; v1 = v1 * rs; }
                    if (ACT == 3) { const u32x4 o = *(const u32x4*)(rowp + bj * HALF);
                        v0[0] += __builtin_bit_cast(float, o.x << 16); v0[1] += __builtin_bit_cast(float, o.x & 0xffff0000u); v0[2] += __builtin_bit_cast(float, o.y << 16); v0[3] += __builtin_bit_cast(float, o.y & 0xffff0000u);
                        v1[0] += __builtin_bit_cast(float, o.z << 16); v1[1] += __builtin_bit_cast(float, o.z & 0xffff0000u); v1[2] += __builtin_bit_cast(float, o.w << 16); v1[3] += __builtin_bit_cast(float, o.w & 0xffff0000u); }
                    u32x4 w; w.x = cvt_pk_bf16(v0[0], v0[1]); w.y = cvt_pk_bf16(v0[2], v0[3]); w.z = cvt_pk_bf16(v1[0], v1[1]); w.w = cvt_pk_bf16(v1[2], v1[3]);
                    *(u32x4*)(rowp + bj * HALF) = w; } }
    }
};

template <class Epi, class Sched, bool ALIGN_EPI = false, bool SP2 = false>
__device__ __forceinline__ void gemm_phase(PG8_LAS unsigned char* lds, const Gemm g, const Sched& S, const Epi& E) {
    int tid = threadIdx.x; asm volatile("" : "+v"(tid));
    const int wid = __builtin_amdgcn_readfirstlane(tid >> 6), lane = tid & 63, wr = wid >> 2, wc = wid & 3, fr = lane & 15, fq = lane >> 4;
    const int K = g.K, nt = K / BK, lda = g.lda, ldb = g.ldb;
    unsigned voffA[2], voffB[2];
#pragma unroll
    for (int i = 0; i < 2; ++i) { int R, C; stage_rc(tid * 16 + i * 8192, R, C); const int Rb = Epi::PERM ? ((R & ~31) + perm32(R & 31)) : R;
        voffA[i] = (unsigned)(R * lda + C) * 2u; voffB[i] = (unsigned)(Rb * ldb + C) * 2u; }
    const size_t kstep = (size_t)(BK * 2);
    const size_t hstepA = (size_t)HALF * lda * 2, hstepB = (size_t)HALF * ldb * 2;
    const size_t tstepA = 2 * hstepA, tstepB = 2 * hstepB;
    const unsigned ldsw = (unsigned)wid * 1024u;
    const int aoff = lds_byte(wr * 64 + fr, fq * 8), boff = lds_byte(wc * 32 + fr, fq * 8);
#define PG8_SA(b, h) (((b) * 2 + (h)) * HTB)
#define PG8_SB(b, h) ((4 + (b) * 2 + (h)) * HTB)
#define PG8_STAGE(bufoff, gbase, voff) do { _Pragma("unroll") for (int _i = 0; _i < 2; ++_i) \
        __builtin_amdgcn_global_load_lds((const unsigned*)((const char*)(gbase) + (voff)[_i]), (PG8_LAS unsigned*)(lds + (bufoff) + ldsw + _i * 8192), 16, 0, 0); } while (0)
#define PG8_LDA(dst, b, h) do { _Pragma("unroll") for (int m = 0; m < 4; ++m) _Pragma("unroll") for (int k = 0; k < 2; ++k) dst[m][k] = *(const PG8_LAS bf16x8*)(lds + PG8_SA(b, h) + aoff + m * 2048 + k * 1024); } while (0)
#define PG8_LDB(dst, b, h) do { _Pragma("unroll") for (int n = 0; n < 2; ++n) _Pragma("unroll") for (int k = 0; k < 2; ++k) dst[n][k] = *(const PG8_LAS bf16x8*)(lds + PG8_SB(b, h) + boff + n * 2048 + k * 1024); } while (0)
#define PG8_MMA(ai, bj, At, Bt) do { __builtin_amdgcn_s_setprio(1); _Pragma("unroll") for (int m = 0; m < 4; ++m) _Pragma("unroll") for (int n = 0; n < 2; ++n) _Pragma("unroll") for (int k = 0; k < 2; ++k) \
        acc[ai][bj][m][n] = __builtin_amdgcn_mfma_f32_16x16x32_bf16(Bt[n][k], At[m][k], acc[ai][bj][m][n], 0, 0, 0); __builtin_amdgcn_s_setprio(0); } while (0)
#define PG8_WAIT_V(n) asm volatile("s_waitcnt vmcnt(" #n ")" ::: "memory")
#define PG8_WAIT_L(n) asm volatile("s_waitcnt lgkmcnt(" #n ")" ::: "memory")
#define PG8_BAR __builtin_amdgcn_s_barrier()
#define PG8_SCHED __builtin_amdgcn_sched_barrier(0)
    Unit cur, nxt; int ui = 0;
    if (!S.next(0, cur)) return;
    f32x4 acc[2][2][4][2];
#pragma unroll
    for (int a = 0; a < 2; ++a)
#pragma unroll
        for (int b = 0; b < 2; ++b)
#pragma unroll
            for (int m = 0; m < 4; ++m)
#pragma unroll
                for (int n = 0; n < 2; ++n) acc[a][b][m][n] = (f32x4){0.f, 0.f, 0.f, 0.f};
    bf16x8 At[4][2], B0[2][2], B1[2][2];
    const char* cA = (const char*)g.A + (size_t)cur.pm * tstepA + (size_t)cur.ko * 2; const char* cB = (const char*)g.Bt + (size_t)cur.pn * tstepB + (size_t)cur.ko * 2;
    S.a_ready(cur);
    if constexpr (SP2) {
        PG8_STAGE(PG8_SB(0, 0), cB, voffB); PG8_STAGE(PG8_SB(0, 1), cB + hstepB, voffB); PG8_STAGE(PG8_SA(0, 0), cA, voffA); PG8_STAGE(PG8_SA(0, 1), cA + hstepA, voffA);
        if (wr == 1) PG8_BAR;
        PG8_WAIT_V(2); PG8_BAR;
        PG8_STAGE(PG8_SB(1, 0), cB + kstep, voffB); PG8_STAGE(PG8_SA(1, 0), cA + kstep, voffA); PG8_STAGE(PG8_SB(1, 1), cB + hstepB + kstep, voffB);
        PG8_WAIT_V(6); PG8_BAR;
    } else {
        PG8_STAGE(PG8_SB(0, 0), cB, voffB); PG8_STAGE(PG8_SA(0, 0), cA, voffA); PG8_STAGE(PG8_SB(0, 1), cB + hstepB, voffB); PG8_STAGE(PG8_SA(0, 1), cA + hstepA, voffA);
        if (wr == 1) PG8_BAR;
        PG8_WAIT_V(4); PG8_BAR;
        PG8_STAGE(PG8_SB(1, 0), cB + kstep, voffB); PG8_STAGE(PG8_SA(1, 0), cA + kstep, voffA); PG8_STAGE(PG8_SB(1, 1), cB + hstepB + kstep, voffB);
        PG8_WAIT_V(6); PG8_BAR;
    }
    for (;;) {
        const bool has_next = S.next(ui + 1, nxt);
        const char* nA = has_next ? (const char*)g.A + (size_t)nxt.pm * tstepA + (size_t)nxt.ko * 2 : cA; const char* nB = has_next ? (const char*)g.Bt + (size_t)nxt.pn * tstepB + (size_t)nxt.ko * 2 : cB;
        for (int t = 0; t < nt; t += 2) {
            const bool last = (t == nt - 2);
            const char* a1 = cA + (size_t)(t + 1) * kstep;
            const char* a2 = last ? nA : cA + (size_t)(t + 2) * kstep; const char* b2 = last ? nB : cB + (size_t)(t + 2) * kstep;
            const char* a3 = a2 + kstep; const char* b3 = b2 + kstep;
            if (last && has_next) S.a_ready(nxt);
            if constexpr (SP2) {
            PG8_LDB(B0, 0, 0); PG8_LDB(B1, 0, 1); PG8_SCHED; PG8_LDA(At, 0, 0); PG8_STAGE(PG8_SA(1, 1), a1 + hstepA, voffA);
            PG8_WAIT_V(8); PG8_WAIT_L(0); PG8_BAR; PG8_MMA(0, 0, At, B0); PG8_MMA(0, 1, At, B1); PG8_BAR; PG8_SCHED;
            PG8_LDA(At, 0, 1); PG8_STAGE(PG8_SB(0, 0), b2, voffB); PG8_STAGE(PG8_SB(0, 1), b2 + hstepB, voffB); PG8_STAGE(PG8_SA(0, 0), a2, voffA);
            PG8_WAIT_V(8); PG8_WAIT_L(0); PG8_BAR; PG8_MMA(1, 0, At, B0); PG8_MMA(1, 1, At, B1); PG8_BAR; PG8_SCHED;
            PG8_LDB(B0, 1, 0); PG8_LDB(B1, 1, 1); PG8_SCHED; PG8_LDA(At, 1, 0); PG8_STAGE(PG8_SA(0, 1), a2 + hstepA, voffA);
            PG8_WAIT_V(8); PG8_WAIT_L(0); PG8_BAR; PG8_MMA(0, 0, At, B0); PG8_MMA(0, 1, At, B1); PG8_BAR; PG8_SCHED;
            PG8_LDA(At, 1, 1); PG8_STAGE(PG8_SB(1, 0), b3, voffB); PG8_STAGE(PG8_SB(1, 1), b3 + hstepB, voffB); PG8_STAGE(PG8_SA(1, 0), a3, voffA);
            PG8_WAIT_V(8); PG8_WAIT_L(0); PG8_BAR; PG8_MMA(1, 0, At, B0); PG8_MMA(1, 1, At, B1); PG8_BAR; PG8_SCHED;
            } else {
            PG8_LDB(B0, 0, 0); PG8_SCHED; PG8_LDA(At, 0, 0); PG8_STAGE(PG8_SA(1, 1), a1 + hstepA, voffA);
            PG8_WAIT_L(8); PG8_BAR; PG8_WAIT_L(0); PG8_MMA(0, 0, At, B0); PG8_BAR; PG8_SCHED;
            PG8_LDB(B1, 0, 1); PG8_STAGE(PG8_SB(0, 0), b2, voffB);
            PG8_BAR; PG8_WAIT_L(0); PG8_MMA(0, 1, At, B1); PG8_BAR;
            PG8_LDA(At, 0, 1); PG8_STAGE(PG8_SA(0, 0), a2, voffA);
            PG8_BAR; PG8_WAIT_L(0); PG8_MMA(1, 0, At, B0); PG8_BAR; PG8_SCHED;
            PG8_STAGE(PG8_SB(0, 1), b2 + hstepB, voffB);
            PG8_WAIT_V(6); PG8_BAR; PG8_MMA(1, 1, At, B1); PG8_BAR;
            PG8_LDB(B0, 1, 0); PG8_SCHED; PG8_LDA(At, 1, 0); PG8_STAGE(PG8_SA(0, 1), a2 + hstepA, voffA);
            PG8_WAIT_L(8); PG8_BAR; PG8_WAIT_L(0); PG8_MMA(0, 0, At, B0); PG8_BAR; PG8_SCHED;
            PG8_LDB(B1, 1, 1); PG8_STAGE(PG8_SB(1, 0), b3, voffB);
            PG8_BAR; PG8_WAIT_L(0); PG8_MMA(0, 1, At, B1); PG8_BAR;
            PG8_LDA(At, 1, 1); PG8_STAGE(PG8_SA(1, 0), a3, voffA);
            PG8_BAR; PG8_WAIT_L(0); PG8_MMA(1, 0, At, B0); PG8_BAR; PG8_SCHED;
            PG8_STAGE(PG8_SB(1, 1), b3 + hstepB, voffB);
            PG8_WAIT_V(6); PG8_BAR; PG8_MMA(1, 1, At, B1); PG8_BAR;
            }
        }
        if constexpr (ALIGN_EPI) { if (wr == 0) PG8_BAR; }
        E(acc, cur, wr, wc, fr, fq); S.done(cur);
        if (!has_next) break;
#pragma unroll
        for (int a = 0; a < 2; ++a)
#pragma unroll
            for (int b = 0; b < 2; ++b)
#pragma unroll
                for (int m = 0; m < 4; ++m)
#pragma unroll
                    for (int n = 0; n < 2; ++n) acc[a][b][m][n] = (f32x4){0.f, 0.f, 0.f, 0.f};
        cur = nxt; cA = nA; cB = nB; ++ui;
        if constexpr (ALIGN_EPI) { if (wr == 1) PG8_BAR; }
    }
    PG8_WAIT_V(0);
    if constexpr (!ALIGN_EPI) { if (wr == 0) PG8_BAR; }
    PG8_BAR;
#undef PG8_SA
#undef PG8_SB
#undef PG8_STAGE
#undef PG8_LDA
#undef PG8_LDB
#undef PG8_MMA
#undef PG8_WAIT_V
#undef PG8_WAIT_L
#undef PG8_BAR
#undef PG8_SCHED
}
}

constexpr int NWAVES = 8, NTHR = 512;
constexpr int DM = 4096, NB = 2, SEQ = 8192, NCTX = 256, DFF = 16384;
constexpr int M_LAT = NB * SEQ, M_CTX = NB * NCTX, M_TOT = M_LAT + M_CTX;
constexpr int DIN = 8672, DINP = 8704;
constexpr int C_SWAQ = 0, C_SWAK = 1024, C_SWAV = 1280, C_LRUX = 1536, C_LRUY = 2560, C_QA = 3584, C_KVA = 4608, C_KR = 5120, C_RW = 5184;
constexpr int C_RWR = C_RW, C_RWK = C_RW + 1024, C_RWV = C_RW + 2048, C_RWL = C_RW + 3072;
constexpr int RWC = 3488;
constexpr float LN_EPS = 1e-5f, RMS_EPS = 1e-6f, GN_EPS = 64e-5f, ALPHA = 1.41421356237f;
constexpr int NCH = 264;

constexpr size_t MiB = 1u << 20;
constexpr size_t WS_CTL = 0, CTL_ZERO_BYTES = 1 * MiB;
constexpr size_t WS_MOD = 1 * MiB;
constexpr size_t WS_MODP = 2 * MiB;
constexpr size_t WS_SMALL = 20 * MiB;
constexpr size_t WS_RSQ = WS_SMALL;
constexpr size_t WS_RSKV = WS_RSQ + 128 * 1024;
constexpr size_t WS_SB = WS_RSKV + 128 * 1024;
constexpr size_t WS_CA = WS_SB + 2 * MiB;
constexpr size_t WS_CB = WS_CA + 5 * MiB;
constexpr size_t WS_HIN = WS_CB + 5 * MiB;
constexpr size_t WS_QUIRK = WS_HIN + 5 * MiB;
constexpr size_t WS_ROPE = WS_QUIRK + 8192;
static_assert(WS_ROPE + 16384 <= 40 * MiB, "small region");
constexpr size_t WS_W = 40 * MiB;
constexpr size_t WS_WIN = WS_W, WS_WOUT = WS_WIN + 68 * MiB, WS_WFF1 = WS_WOUT + 32 * MiB, WS_WFF2 = WS_WFF1 + 128 * MiB, WS_WQB = WS_WFF2 + 128 * MiB,
                 WS_WKVB = WS_WQB + 3 * MiB, WS_WLRU = WS_WKVB + 2 * MiB, WS_WLORA = WS_WLRU + 1 * MiB;
constexpr size_t WS_W2T = WS_WLORA, WS_A2T = WS_W2T + 256 * 1024, WS_G2T = WS_A2T + 256 * 1024;
constexpr size_t WS_X = 403 * MiB;
constexpr size_t WS_H = 667 * MiB;
constexpr size_t WS_MIX = 799 * MiB;
constexpr size_t WS_YS = 931 * MiB;
constexpr size_t WS_P = 1063 * MiB;
constexpr size_t WS_RWF = 1344 * MiB;
constexpr size_t RWF_STRIDE = (size_t)M_TOT * 1024 * 2;
constexpr size_t WS_Q = 1641 * MiB;
constexpr size_t WS_KV = 1691 * MiB;
constexpr size_t WS_KR = 1757 * MiB;
constexpr size_t WS_SET2 = 1760 * MiB;
constexpr size_t WSET_STRIDE = WS_SET2 - WS_W;
constexpr size_t WS_END = WS_SET2 + 363 * MiB;
constexpr size_t WS_YP = WS_Q;
constexpr size_t WS_HID = WS_P;
constexpr size_t WS_Y1 = WS_P;
constexpr size_t WS_Y2 = WS_MIX;
static_assert(WS_WLORA + 1 * MiB <= WS_X && WS_P + (size_t)M_TOT * DINP * 2 <= WS_RWF && WS_RWF + 9 * RWF_STRIDE <= WS_Q, "ws map");
static_assert(WS_HID + (size_t)M_TOT * DFF * 2 <= WS_Q && WS_Y2 + (size_t)M_TOT * DM * 4 <= WS_P && WS_YS + 2 * (size_t)M_TOT * 1024 * 4 <= WS_P, "ws overlays");
static_assert(WS_KR + (size_t)M_TOT * 64 * 2 <= WS_SET2 && WS_YP + 8 * (size_t)M_CTX * DM * 4 <= WS_KR, "ws end");

constexpr int RING_BYTES = 131072;
constexpr int LDSCTL_OFF = RING_BYTES, MISC_OFF = LDSCTL_OFF + 320;
constexpr int LDS_BYTES = 147456;

#define GAS __attribute__((address_space(1)))
#define LAS __attribute__((address_space(3)))
typedef unsigned short bf16;
typedef unsigned v4u __attribute__((ext_vector_type(4)));
typedef unsigned v2u __attribute__((ext_vector_type(2)));
typedef float f32x4 __attribute__((ext_vector_type(4)));
typedef float f32x2 __attribute__((ext_vector_type(2)));
typedef float f32x16 __attribute__((ext_vector_type(16)));
typedef short bf16x8 __attribute__((ext_vector_type(8)));
typedef short s16x4 __attribute__((ext_vector_type(4)));
typedef GAS unsigned gu32;
typedef const GAS bf16* gcbf; typedef GAS bf16* gbfp; typedef const GAS float* gcfl; typedef GAS float* gflp;
#define LDS_WAIT() asm volatile("s_waitcnt lgkmcnt(0)" ::: "memory")
#define VM_WAIT() asm volatile("s_waitcnt vmcnt(0)" ::: "memory")
typedef __bf16 bf16x2_t __attribute__((ext_vector_type(2)));
__device__ __forceinline__ unsigned pk2(float lo, float hi) { const f32x2 v = {lo, hi}; const bf16x2_t b = __builtin_convertvector(v, bf16x2_t); return __builtin_bit_cast(unsigned, b); }
__device__ __forceinline__ unsigned f2bf(float f) { return pk2(f, f) & 0xffffu; }
__device__ __forceinline__ float bflo(unsigned w) { return __builtin_bit_cast(float, w << 16); }
__device__ __forceinline__ float bfhi(unsigned w) { return __builtin_bit_cast(float, w & 0xffff0000u); }
__device__ __forceinline__ float bf2f(bf16 h) { return __builtin_bit_cast(float, (unsigned)h << 16); }
#define DPP_ADD(x, ctrl) ((x) + __builtin_bit_cast(float, __builtin_amdgcn_update_dpp(0, __builtin_bit_cast(int, (x)), (ctrl), 0xf, 0xf, false)))
__device__ __forceinline__ float row_sum16(float x) { x = DPP_ADD(x, 0x128); x = DPP_ADD(x, 0x124); x = DPP_ADD(x, 0x122); x = DPP_ADD(x, 0x121); return x; }
#ifdef OLD_SUMS
__device__ __forceinline__ float wave_sum(float v) {
#pragma unroll
    for (int o = 1; o < 64; o <<= 1) v += __shfl_xor(v, o);
    return v;
}
__device__ __forceinline__ float half_swap_sum(float x) { return x + __shfl_xor(x, 32); }
__device__ __forceinline__ float quad_sum(float x) { x += __shfl_xor(x, 1); x += __shfl_xor(x, 2); return x; }
#else
__device__ __forceinline__ float wave_sum(float v) {
    const float r = row_sum16(v);
    const float a = __builtin_bit_cast(float, __builtin_amdgcn_readlane(__builtin_bit_cast(int, r), 0)), b = __builtin_bit_cast(float, __builtin_amdgcn_readlane(__builtin_bit_cast(int, r), 16));
    const float c = __builtin_bit_cast(float, __builtin_amdgcn_readlane(__builtin_bit_cast(int, r), 32)), d = __builtin_bit_cast(float, __builtin_amdgcn_readlane(__builtin_bit_cast(int, r), 48));
    return (a + b) + (c + d);
}
__device__ __forceinline__ float half_swap_sum(float x) {
    unsigned a = __builtin_bit_cast(unsigned, x), b = a; asm volatile("" : "+v"(b));
    auto rr = __builtin_amdgcn_permlane32_swap(a, b, false, false);
    const float lo = __uint_as_float(rr[0]), hi = __uint_as_float(rr[1]); return lo + hi;
}
__device__ __forceinline__ float quad_sum(float x) { x = DPP_ADD(x, 0xB1); x = DPP_ADD(x, 0x4E); return x; }
#endif
__device__ __forceinline__ float sigmoidf_(float x) { return __builtin_amdgcn_rcpf(1.f + __expf(-x)); }
__device__ __forceinline__ float softplusf_(float x) { return x > 20.f ? x : __logf(1.f + __expf(x)); }
__device__ __forceinline__ float tanhf_(float x) { const float e = __expf(2.f * x); return 1.f - 2.f * __builtin_amdgcn_rcpf(e + 1.f); }
__device__ __forceinline__ int ltid() { int t = threadIdx.x; asm volatile("" : "+v"(t)); return t; }
template <class T> __device__ __forceinline__ T ldg(const void* base, unsigned byteoff) { return *(const T*)((const char*)base + byteoff); }
template <class T> __device__ __forceinline__ void stg(void* base, unsigned byteoff, T v) { *(T*)((char*)base + byteoff) = v; }

#define XB_TMO      128
#define XB_XCNT(j)  (256  + 64 * (j))
#define XB_XSUB(j)  (1280 + 64 * (j))
#define XB_XGEN(j)  (2304 + 64 * (j))
#define XB_TOP      3328
#define XB_TOPGEN   3392
#define XCD_BAR_WORDS 3456
#define XB_SPIN_CAP (1u << 18)

__device__ __forceinline__ unsigned xb_ld(unsigned* p)              { return __hip_atomic_load(p, __ATOMIC_RELAXED, __HIP_MEMORY_SCOPE_AGENT); }
__device__ __forceinline__ unsigned xb_add(unsigned* p, unsigned v) { return __hip_atomic_fetch_add(p, v, __ATOMIC_RELAXED, __HIP_MEMORY_SCOPE_AGENT); }
__device__ __forceinline__ unsigned xb_xcc_id() { return (unsigned)__builtin_amdgcn_s_getreg((3 << 11) | 20) & 0xFu; }
#define XB_SPIN(cond, bar) do { unsigned _sp = 0; while (cond) { __builtin_amdgcn_s_sleep(1); \
    if ((++_sp & 255u) == 0u) { if (xb_ld(&(bar)[XB_TMO])) break; if (_sp > XB_SPIN_CAP) { atomicAdd(&(bar)[XB_TMO], 1u); break; } } } } while (0)

struct XcdBarrier {
    unsigned* bar; unsigned x;
    unsigned nparts;
    volatile LAS unsigned* st;
};

__device__ __forceinline__ XcdBarrier xcd_barrier_post(unsigned* bar, volatile LAS unsigned* st) {
    XcdBarrier b; b.bar = bar; b.x = xb_xcc_id(); b.st = st; b.nparts = 0u;
    if (threadIdx.x == 0) (void)xb_add(&bar[XB_XCNT(b.x)], 1u);
    return b;
}
__device__ __forceinline__ void xcd_barrier_complete(unsigned* bar, unsigned x, unsigned& nloc, unsigned& nx, unsigned nparts) {
    const unsigned G = nparts ? nparts : gridDim.x * gridDim.y * gridDim.z;
    unsigned sum, cnt, mine, sp = 0u;
    for (;;) {
        sum = 0u; cnt = 0u; mine = 0u;
#pragma unroll
        for (unsigned j = 0; j < 16; ++j) { const unsigned c = xb_ld(&bar[XB_XCNT(j)]); sum += c; cnt += (c > 0u) ? 1u : 0u; mine = (j == x) ? c : mine; }
        if (sum == G) break;
        __builtin_amdgcn_s_sleep(1);
        if ((++sp & 255u) == 0u) { if (xb_ld(&bar[XB_TMO])) break; if (sp > XB_SPIN_CAP) { atomicAdd(&bar[XB_TMO], 1u); break; } }
    }
    nloc = mine > 0u ? mine : 1u; nx = cnt > 0u ? cnt : 1u;
}

__device__ __forceinline__ void xcd_barrier(const XcdBarrier& b) {
    asm volatile("s_waitcnt vmcnt(0)" ::: "memory");
    __syncthreads();
    if (threadIdx.x == 0) {
        unsigned* bar = b.bar;
        __builtin_amdgcn_s_waitcnt(0);
        unsigned nloc = b.st[0], nx = b.st[1];
        if (nloc == 0u) { xcd_barrier_complete(bar, b.x, nloc, nx, b.nparts); b.st[0] = nloc; b.st[1] = nx; }
        const unsigned old = xb_add(&bar[XB_XSUB(b.x)], 1u);
        const unsigned gen = old / nloc;
        if (old + 1u == (gen + 1u) * nloc) {
            __builtin_amdgcn_fence(__ATOMIC_RELEASE, "agent");
            asm volatile("s_waitcnt vmcnt(0)" ::: "memory");
            const unsigned og = xb_add(&bar[XB_TOP], 1u);
            const unsigned tg = og / nx;
            if (og + 1u == (tg + 1u) * nx) xb_add(&bar[XB_TOPGEN], 1u);
            else XB_SPIN(xb_ld(&bar[XB_TOPGEN]) == tg, bar);
            __builtin_amdgcn_fence(__ATOMIC_ACQUIRE, "agent");
            xb_add(&bar[XB_XGEN(b.x)], 1u);
            asm volatile("s_waitcnt vmcnt(0)" ::: "memory");
        } else {
            XB_SPIN(xb_ld(&bar[XB_XGEN(b.x)]) == gen, bar);
            __builtin_amdgcn_fence(__ATOMIC_ACQUIRE, "agent");
            asm volatile("s_waitcnt vmcnt(0)" ::: "memory");
        }
    }
    __syncthreads();
}


namespace att {
constexpr int KVBLK = 64;
constexpr float THR = 8.f;
#define SBAR() __builtin_amdgcn_sched_barrier(0)
__device__ __forceinline__ int crow(int r, int hi) { return (r & 3) + 8 * (r >> 2) + 4 * hi; }
__device__ __forceinline__ unsigned cvtpk(float lo, float hi) { return pk2(lo, hi); }
template <int DQK> __device__ __forceinline__ int kswz(int row, int cb) { return row * (DQK * 2 + 16) + cb; }

template <int DQK> __device__ __forceinline__ void partialSM(f32x16& p0, f32x16& p1, float& m_reg, float& mn, float& alpha) {
  constexpr float SCALE = DQK == 128 ? 0.088388347648318440f : 0.072168783648703220f;
  constexpr float C = SCALE * 1.4426950408889634f;
  float pmax = p0[0];
#pragma unroll
  for (int r = 1; r < 16; ++r) pmax = fmaxf(pmax, p0[r]);
#pragma unroll
  for (int r = 0; r < 16; ++r) pmax = fmaxf(pmax, p1[r]);
  { auto rr = __builtin_amdgcn_permlane32_swap(__float_as_uint(pmax), __float_as_uint(pmax), false, false);
    pmax = fmaxf(__uint_as_float(rr[0]), __uint_as_float(rr[1])); }
  if (__builtin_expect(__all(pmax - m_reg <= THR / SCALE), 1)) { mn = m_reg; alpha = 1.f; }
  else { mn = fmaxf(m_reg, pmax); alpha = __builtin_amdgcn_exp2f((m_reg - mn) * C); m_reg = mn; }
  const float mnC = -mn * C;
#pragma unroll
  for (int r = 0; r < 16; ++r) p0[r] = fmaf(p0[r], C, mnC);
#pragma unroll
  for (int r = 0; r < 16; ++r) p1[r] = fmaf(p1[r], C, mnC);
#pragma unroll
  for (int r = 0; r < 16; ++r) p0[r] = __builtin_amdgcn_exp2f(p0[r]);
}
__device__ __forceinline__ void finishSM(f32x16& p0, f32x16& p1, float alpha, float& l_reg, bf16x8& pa0, bf16x8& pa1, bf16x8& pa2, bf16x8& pa3) {
#pragma unroll
  for (int r = 0; r < 16; ++r) p1[r] = __builtin_amdgcn_exp2f(p1[r]);
  float ps = 0;
#pragma unroll
  for (int r = 0; r < 16; ++r) ps += p0[r];
#pragma unroll
  for (int r = 0; r < 16; ++r) ps += p1[r];
  { auto rr = __builtin_amdgcn_permlane32_swap(__float_as_uint(ps), __float_as_uint(ps), false, false);
    ps = __uint_as_float(rr[0]) + __uint_as_float(rr[1]); }
  l_reg = l_reg * alpha + ps;
#define PK4(P, BASE, OUT) do { unsigned a0 = cvtpk(P[BASE + 0], P[BASE + 1]), a1 = cvtpk(P[BASE + 2], P[BASE + 3]);   \
    unsigned b0 = cvtpk(P[BASE + 4], P[BASE + 5]), b1 = cvtpk(P[BASE + 6], P[BASE + 7]);                              \
    auto r0 = __builtin_amdgcn_permlane32_swap(a0, b0, false, false); auto r1 = __builtin_amdgcn_permlane32_swap(a1, b1, false, false); \
    v4u w = {r0[0], r1[0], r0[1], r1[1]}; OUT = __builtin_bit_cast(bf16x8, w); } while (0)
  PK4(p0, 0, pa0); PK4(p0, 8, pa1); PK4(p1, 0, pa2); PK4(p1, 8, pa3);
#undef PK4
}
template <int DQK> __device__ __forceinline__ void qkt(f32x16& p0, f32x16& p1, const LAS char* Ks, const bf16x8* qr, const LAS char* qx, int r32, int hi) {
  p0 = f32x16{}; p1 = f32x16{};
#pragma unroll
  for (int d0 = 0; d0 < DQK / 16; ++d0) { const int cb = (d0 * 16 + hi * 8) * 2;
    bf16x8 b0 = *(const LAS bf16x8*)(Ks + kswz<DQK>(r32, cb));
    bf16x8 b1 = *(const LAS bf16x8*)(Ks + kswz<DQK>(32 + r32, cb));
    bf16x8 q; if (d0 < 8) q = qr[d0]; else q = *(const LAS bf16x8*)(qx + (d0 - 8) * 32);
    p0 = __builtin_amdgcn_mfma_f32_32x32x16_bf16(b0, q, p0, 0, 0, 0);
    p1 = __builtin_amdgcn_mfma_f32_32x32x16_bf16(b1, q, p1, 0, 0, 0);
    if ((d0 & 3) == 3 && d0 + 1 < DQK / 16) SBAR(); }
}
__device__ __forceinline__ int v_st(int k, int c) { const int kk = (k & ~0xC) | ((k & 4) << 1) | ((k & 8) >> 1); return ((kk >> 3) * 4 + (c >> 5)) * 512 + ((kk & 7) * 32 + (c & 31)) * 2; }
__device__ __forceinline__ int v_rd_base(int lane) { return ((lane & 3) << 3) | (((lane >> 2) & 3) << 6) | (((lane >> 4) & 1) << 5) | (((lane >> 5) & 1) << 8); }
constexpr int v_rd_off(int d0, int ks, int half) { return d0 * 512 + ks * 4096 + half * 2048; }
template <int OFF> __device__ __forceinline__ s16x4 tr_read(int vb) {
  s16x4 r; asm volatile("ds_read_b64_tr_b16 %0, %1 offset:%2" : "=&v"(r) : "v"(vb), "i"(OFF) : "memory"); return r;
}
template <int D0> __device__ __forceinline__ void pv_one(f32x16& od, int vb, bf16x8 pa0, bf16x8 pa1, bf16x8 pa2, bf16x8 pa3) {
  const s16x4 l0 = tr_read<v_rd_off(D0, 0, 0)>(vb), h0 = tr_read<v_rd_off(D0, 0, 1)>(vb), l1 = tr_read<v_rd_off(D0, 1, 0)>(vb), h1 = tr_read<v_rd_off(D0, 1, 1)>(vb);
  const s16x4 l2 = tr_read<v_rd_off(D0, 2, 0)>(vb), h2 = tr_read<v_rd_off(D0, 2, 1)>(vb), l3 = tr_read<v_rd_off(D0, 3, 0)>(vb), h3 = tr_read<v_rd_off(D0, 3, 1)>(vb);
  asm volatile("s_waitcnt lgkmcnt(0)" ::: "memory"); SBAR();
#define PK(L, H) (bf16x8){L[0], L[1], L[2], L[3], H[0], H[1], H[2], H[3]}
  od = __builtin_amdgcn_mfma_f32_32x32x16_bf16(pa0, PK(l0, h0), od, 0, 0, 0);
  od = __builtin_amdgcn_mfma_f32_32x32x16_bf16(pa1, PK(l1, h1), od, 0, 0, 0);
  od = __builtin_amdgcn_mfma_f32_32x32x16_bf16(pa2, PK(l2, h2), od, 0, 0, 0);
  od = __builtin_amdgcn_mfma_f32_32x32x16_bf16(pa3, PK(l3, h3), od, 0, 0, 0);
#undef PK
}
__device__ __forceinline__ void pv_d0(f32x16* o, int vb, bf16x8 pa0, bf16x8 pa1, bf16x8 pa2, bf16x8 pa3) {
  pv_one<0>(o[0], vb, pa0, pa1, pa2, pa3); pv_one<1>(o[1], vb, pa0, pa1, pa2, pa3); pv_one<2>(o[2], vb, pa0, pa1, pa2, pa3); pv_one<3>(o[3], vb, pa0, pa1, pa2, pa3);
}
__device__ __forceinline__ void apply_mask(f32x16& p0, f32x16& p1, int mtype, int krel0, int qi, int hi) {
  if (mtype == 0) return;
  const float ninf = -__builtin_inff();
#pragma unroll
  for (int r = 0; r < 16; ++r) { const int k0 = krel0 + crow(r, hi), k1 = k0 + 32;
    const bool ok0 = (mtype == 1) ? (k0 >= qi - 128) : (k0 <= qi + 128), ok1 = (mtype == 1) ? (k1 >= qi - 128) : (k1 <= qi + 128);
    p0[r] = ok0 ? p0[r] : ninf; p1[r] = ok1 ? p1[r] : ninf; }
}
struct Tile { gcbf kn; gcbf kr; gcbf v; int mtype; int krel0; };

__device__ __forceinline__ void rope_pair(bf16x8& a, bf16x8& b, gcfl ct, gcfl st) {
  const f32x4 c0 = *(const GAS f32x4*)ct, c1 = *(const GAS f32x4*)(ct + 4), s0 = *(const GAS f32x4*)st, s1 = *(const GAS f32x4*)(st + 4);
  const float cs[8] = {c0[0], c0[1], c0[2], c0[3], c1[0], c1[1], c1[2], c1[3]}, sn[8] = {s0[0], s0[1], s0[2], s0[3], s1[0], s1[1], s1[2], s1[3]};
  v4u ua = __builtin_bit_cast(v4u, a), ub = __builtin_bit_cast(v4u, b); v4u oa, ob;
#pragma unroll
  for (int w = 0; w < 4; ++w) { const float x1[2] = {bflo(ua[w]), bfhi(ua[w])}, x2[2] = {bflo(ub[w]), bfhi(ub[w])}; float y1[2], y2[2];
#pragma unroll
    for (int e = 0; e < 2; ++e) { const float c = cs[2 * w + e], sv = sn[2 * w + e]; y1[e] = x1[e] * c - x2[e] * sv; y2[e] = x2[e] * c + x1[e] * sv; }
    oa[w] = pk2(y1[0], y1[1]); ob[w] = pk2(y2[0], y2[1]); }
  a = __builtin_bit_cast(bf16x8, oa); b = __builtin_bit_cast(bf16x8, ob);
}

template <int DQK, int LDKN, int LDV, bool MASK, bool SINK, int SDEPTH, class TS>
__device__ __forceinline__ void attn_body(gcbf Qw, int rope, int prow, int pcol, gcfl rtab, int qi, float sink_l2, const TS& ts, int NT, gbfp Ow, LAS char* lds) {
  constexpr float SCALE = DQK == 128 ? 0.088388347648318440f : 0.072168783648703220f;
  constexpr float C = SCALE * 1.4426950408889634f;
  constexpr int SHM_K = KVBLK * (DQK * 2 + 16), SHM_V = KVBLK * 128 * 2;
  int tid = threadIdx.x; asm volatile("" : "+v"(tid));
  const int wid = tid >> 6, lane = tid & 63, r32 = lane & 31, hi = lane >> 5;
  LAS char* V_lds = lds; LAS char* K_lds = lds + 2 * SHM_V;
  LAS float* wsl = (LAS float*)(lds + 2 * SHM_V + 2 * SHM_K) + wid * 64; LAS float* li_l = wsl; LAS float* al_l = wsl + 32;
  float m_reg = -1e30f, l_reg = 0; f32x16 o[4] = {}; bf16x8 qr[8];
#pragma unroll
  for (int d0 = 0; d0 < 8; ++d0) qr[d0] = *(const GAS bf16x8*)(Qw + d0 * 16 + hi * 8);
  const LAS char* qx = lds + 2 * SHM_V + 2 * SHM_K + 2048 + wid * 4608 + r32 * 144 + hi * 16;
  if constexpr (DQK == 192) {
    bf16x8 x0 = *(const GAS bf16x8*)(Qw + 128 + hi * 8), x1 = *(const GAS bf16x8*)(Qw + 144 + hi * 8), x2 = *(const GAS bf16x8*)(Qw + 160 + hi * 8), x3 = *(const GAS bf16x8*)(Qw + 176 + hi * 8);
    if (rope) {
      rope_pair(x0, x1, rtab + (size_t)prow * 16 + hi * 8, rtab + 2048 + (size_t)prow * 16 + hi * 8);
      rope_pair(x2, x3, rtab + (size_t)pcol * 16 + hi * 8, rtab + 2048 + (size_t)pcol * 16 + hi * 8); }
    LAS char* qw_ = (LAS char*)qx; *(LAS bf16x8*)(qw_) = x0; *(LAS bf16x8*)(qw_ + 32) = x1; *(LAS bf16x8*)(qw_ + 64) = x2; *(LAS bf16x8*)(qw_ + 96) = x3;
  }
  const int sr = tid >> 4, sc = (tid & 15) * 8, vst0 = v_st(sr, sc), vst1 = v_st(32 + sr, sc);
  const int rr_ = tid >> 3, rc_ = (tid & 7) * 8;
  const int vb0 = (int)(uintptr_t)V_lds + v_rd_base(lane);
  struct { bf16x8 vs0, vs1, ks0, ks1, kx; } sr_[SDEPTH];
#define SLOAD(i, jt) do { const Tile t_ = ts(jt); sr_[i].vs0 = *(const GAS bf16x8*)(t_.v + (size_t)sr * LDV + sc); sr_[i].vs1 = *(const GAS bf16x8*)(t_.v + (size_t)(32 + sr) * LDV + sc); \
    sr_[i].ks0 = *(const GAS bf16x8*)(t_.kn + (size_t)sr * LDKN + sc); sr_[i].ks1 = *(const GAS bf16x8*)(t_.kn + (size_t)(32 + sr) * LDKN + sc); \
    if constexpr (DQK == 192) sr_[i].kx = *(const GAS bf16x8*)(t_.kr + (size_t)rr_ * 64 + rc_); } while (0)
#define SWRITE(b, i) do { *(LAS bf16x8*)(V_lds + (b) * SHM_V + vst0) = sr_[i].vs0; *(LAS bf16x8*)(V_lds + (b) * SHM_V + vst1) = sr_[i].vs1; const int kc = sc * 2; \
    *(LAS bf16x8*)(K_lds + (b) * SHM_K + kswz<DQK>(sr, kc)) = sr_[i].ks0; *(LAS bf16x8*)(K_lds + (b) * SHM_K + kswz<DQK>(32 + sr, kc)) = sr_[i].ks1; \
    if constexpr (DQK == 192) *(LAS bf16x8*)(K_lds + (b) * SHM_K + kswz<DQK>(rr_, 256 + rc_ * 2)) = sr_[i].kx; } while (0)
#define SWAIT() do { if constexpr (SDEPTH == 2) { if constexpr (DQK == 192) asm volatile("s_waitcnt vmcnt(5)" ::: "memory"); else asm volatile("s_waitcnt vmcnt(4)" ::: "memory"); } \
    else asm volatile("s_waitcnt vmcnt(0)" ::: "memory"); } while (0)
#define RESC(a) do { if (__any((a) < 1.f)) { if (hi == 0) al_l[r32] = (a); asm volatile("s_waitcnt lgkmcnt(0)" ::: "memory"); \
    _Pragma("unroll") for (int d = 0; d < 4; ++d) _Pragma("unroll") for (int r = 0; r < 16; ++r) o[d][r] *= al_l[crow(r, hi)]; } } while (0)
#define MASKT(pa_, pb_, jt) do { if constexpr (MASK) { const Tile t_ = ts(jt); apply_mask(pa_, pb_, t_.mtype, t_.krel0, qi, hi); } } while (0)
  f32x16 pA0, pA1, pB0, pB1; float mnA, mnB, alA, alB; bf16x8 pa0, pa1, pa2, pa3;
  constexpr int SE = 0, SO = SDEPTH - 1;
  SLOAD(SE, 0); asm volatile("s_waitcnt vmcnt(0)" ::: "memory"); SWRITE(0, SE); __syncthreads();
  qkt<DQK>(pA0, pA1, K_lds, qr, qx, r32, hi); MASKT(pA0, pA1, 0); partialSM<DQK>(pA0, pA1, m_reg, mnA, alA);
  SLOAD(SO, 1); if constexpr (SDEPTH == 2) { if (2 < NT) SLOAD(SE, 2); }
  SWAIT(); SWRITE(1, SO); __syncthreads();
  for (int j = 1; j + 1 < NT; j += 2) {
    SBAR(); qkt<DQK>(pB0, pB1, K_lds + SHM_K, qr, qx, r32, hi); MASKT(pB0, pB1, j);
    finishSM(pA0, pA1, alA, l_reg, pa0, pa1, pa2, pa3); SBAR();
    SLOAD(SO, j + SDEPTH); SBAR();
    pv_d0(o, vb0, pa0, pa1, pa2, pa3); partialSM<DQK>(pB0, pB1, m_reg, mnB, alB);
    __syncthreads(); SWAIT(); SWRITE(0, SE);
    RESC(alB); __syncthreads();
    SBAR(); qkt<DQK>(pA0, pA1, K_lds, qr, qx, r32, hi); MASKT(pA0, pA1, j + 1);
    finishSM(pB0, pB1, alB, l_reg, pa0, pa1, pa2, pa3); SBAR();
    if (SDEPTH == 1 || j + 3 < NT) SLOAD(SE, j + 1 + SDEPTH); SBAR();
    pv_d0(o, vb0 + SHM_V, pa0, pa1, pa2, pa3); partialSM<DQK>(pA0, pA1, m_reg, mnA, alA);
    __syncthreads(); SWAIT(); SWRITE(1, SO);
    RESC(alA); __syncthreads();
  }
  SBAR(); qkt<DQK>(pB0, pB1, K_lds + SHM_K, qr, qx, r32, hi); MASKT(pB0, pB1, NT - 1);
  finishSM(pA0, pA1, alA, l_reg, pa0, pa1, pa2, pa3); SBAR();
  pv_d0(o, vb0, pa0, pa1, pa2, pa3); partialSM<DQK>(pB0, pB1, m_reg, mnB, alB);
  __syncthreads(); RESC(alB);
  finishSM(pB0, pB1, alB, l_reg, pa0, pa1, pa2, pa3); SBAR();
  pv_d0(o, vb0 + SHM_V, pa0, pa1, pa2, pa3);
  if constexpr (SINK) l_reg += __builtin_amdgcn_exp2f(sink_l2 - m_reg * C);
  if (hi == 0) li_l[r32] = l_reg; asm volatile("s_waitcnt lgkmcnt(0)" ::: "memory");
  float rli[16];
#pragma unroll
  for (int r = 0; r < 16; ++r) rli[r] = __builtin_amdgcn_rcpf(li_l[crow(r, hi)]);
  __syncthreads();
  LAS bf16* ost = (LAS bf16*)(lds + wid * 8704);
#pragma unroll
  for (int r = 0; r < 16; ++r) { const int orow = crow(r, hi);
#pragma unroll
    for (int d0 = 0; d0 < 4; ++d0) ost[orow * 136 + d0 * 32 + r32] = (bf16)f2bf(o[d0][r] * rli[r]); }
  asm volatile("s_waitcnt lgkmcnt(0)" ::: "memory");
#pragma unroll
  for (int i = 0; i < 8; ++i) { const int orow = i * 4 + (lane >> 4), ch = lane & 15;
    *(GAS v4u*)(Ow + (size_t)orow * 4096 + ch * 8) = *(const LAS v4u*)(ost + orow * 136 + ch * 8); }
  __syncthreads();
#undef SLOAD
#undef SWRITE
#undef SWAIT
#undef RESC
#undef MASKT
}
}

struct Args { const float* in[38]; float* out; unsigned char* ws; };
template <class T> __device__ __forceinline__ T launder(T p) { asm volatile("" : "+s"(p)); return p; }
template <class T> __device__ __forceinline__ T* launder_g(T* p) { asm volatile("" : "+s"(p)); return p; }
struct Frame {
    LAS unsigned char* lds;
    gu32* ctl;
    int tid, lane, wave;
    int vcu, G, gw, NGW;
    const __attribute__((address_space(4))) Args* A;
    float* out;
    unsigned char* ws;
    unsigned char* wsw;
};
enum { I_X = 0, I_C, I_CTX, I_CCTX, I_WMOD, I_BMOD, I_WIN, I_WOUT, I_LN1G, I_LN1B, I_WFF1, I_WFF2, I_LN2G, I_LN2B, I_SINK, I_CONVW, I_CONVB, I_LWA, I_LBA, I_LWI, I_LBI, I_LAM,
       I_QNORM, I_KVNORM, I_WQB, I_WKVB, I_MUP, I_MUN, I_W0, I_W2, I_A0, I_A2, I_G2, I_KK, I_KA, I_RK, I_LNG, I_LNB };
__device__ __forceinline__ int row_s(int row) { return row < SEQ ? 0 : (row < M_LAT ? 1 : 2); }
__device__ __forceinline__ const float* mod_ptr(const Frame& F, int l, int s, int chunk) { return (const float*)(F.ws + WS_MOD) + ((size_t)(l * 3 + s) * 6 + chunk) * DM; }

__device__ __forceinline__ void transpose_item(const float* W, int N, int Kvalid, bf16* WT, int ldt, const float* kscale, LAS float* scr, int k0, int n0, int lane) {
    { const int kr = lane >> 3, c4 = (lane & 7) * 4;
#pragma unroll
      for (int i = 0; i < 8; ++i) { const int kk = 8 * i + kr, k = k0 + kk; f32x4 v = {0.f, 0.f, 0.f, 0.f};
          if (k < Kvalid) { v = *(const f32x4*)(W + (size_t)k * N + n0 + c4); if (kscale) v = v * kscale[k]; }
          scr[kk * 33 + c4] = v.x; scr[kk * 33 + c4 + 1] = v.y; scr[kk * 33 + c4 + 2] = v.z; scr[kk * 33 + c4 + 3] = v.w; } }
    LDS_WAIT(); asm volatile("" ::: "memory");
    const int c = lane & 7;
#pragma unroll
    for (int j = 0; j < 4; ++j) { const int n = (lane >> 3) + 8 * j; const LAS float* s = scr + (8 * c) * 33 + n;
        v4u o; o.x = pk2(s[0 * 33], s[1 * 33]); o.y = pk2(s[2 * 33], s[3 * 33]); o.z = pk2(s[4 * 33], s[5 * 33]); o.w = pk2(s[6 * 33], s[7 * 33]);
        *(v4u*)(WT + (size_t)(n0 + n) * ldt + k0 + 8 * c) = o; }
    LDS_WAIT(); asm volatile("" ::: "memory");
}
__device__ __forceinline__ void convert_weights(Frame& F, int l, int widx, int nw) {
    LAS float* scr = (LAS float*)(F.lds + F.wave * 16384);
    constexpr int I1 = 64 * 271, I2 = 64 * 128, I3 = 64 * 512, I4 = 256 * 128, I5 = 16 * 48, I6 = 8 * 64, I7 = 32 * 8, I8 = 2 * 32, I9 = 2 * 32, I10 = 3 * 32;
    constexpr int NIT = I1 + I2 + I3 + I4 + I5 + I6 + I7 + I8 + I9 + I10;
    unsigned char* ws = F.ws + (l ? WSET_STRIDE : 0);
    for (int it = widx; it < NIT; it += nw) {
        int r = it;
        if (r < I1) { transpose_item(F.A->in[I_WIN] + (size_t)l * DM * DIN, DIN, DM, (bf16*)(ws + WS_WIN), DM, nullptr, scr, 64 * (r / 271), 32 * (r % 271), F.lane); continue; } r -= I1;
        if (r < I2) { transpose_item(F.A->in[I_WOUT] + (size_t)l * DM * DM, DM, DM, (bf16*)(ws + WS_WOUT), DM, nullptr, scr, 64 * (r / 128), 32 * (r % 128), F.lane); continue; } r -= I2;
        if (r < I3) { transpose_item(F.A->in[I_WFF1] + (size_t)l * DM * DFF, DFF, DM, (bf16*)(ws + WS_WFF1), DM, nullptr, scr, 64 * (r / 512), 32 * (r % 512), F.lane); continue; } r -= I3;
        if (r < I4) { transpose_item(F.A->in[I_WFF2] + (size_t)l * DFF * DM, DM, DFF, (bf16*)(ws + WS_WFF2), DFF, nullptr, scr, 64 * (r / 128), 32 * (r % 128), F.lane); continue; } r -= I4;
        if (r < I5) { transpose_item(F.A->in[I_WQB] + (size_t)l * 1024 * 1536, 1536, 1024, (bf16*)(ws + WS_WQB), 1024, F.A->in[I_QNORM] + l * 1024, scr, 64 * (r / 48), 32 * (r % 48), F.lane); continue; } r -= I5;
        if (r < I6) { transpose_item(F.A->in[I_WKVB] + (size_t)l * 512 * 2048, 2048, 512, (bf16*)(ws + WS_WKVB), 512, F.A->in[I_KVNORM] + l * 512, scr, 64 * (r / 64), 32 * (r % 64), F.lane); continue; } r -= I6;
        if (r < I7) { const int mat = r >> 3, sub = r & 7, gate = mat & 1, dn = mat >> 1;
            const int d = dn >> 3, n = dn & 7;
            const float* src = (gate ? F.A->in[I_LWI] : F.A->in[I_LWA]) + ((size_t)(l * 2 + d) * 8 + n) * 128 * 128;
            bf16* dst = (bf16*)(ws + WS_WLRU) + ((size_t)(d * 2 + gate) * 8 + n) * 128 * 128;
            transpose_item(src, 128, 128, dst, 128, nullptr, scr, 64 * (sub >> 2), 32 * (sub & 3), F.lane); continue; } r -= I7;
        if (r < I8) { const int d = r >> 5; transpose_item(F.A->in[I_W2] + (size_t)(l * 2 + d) * 64 * 1024, 1024, 64, (bf16*)(ws + WS_W2T) + (size_t)d * 1024 * 64, 64, nullptr, scr, 0, 32 * (r & 31), F.lane); continue; } r -= I8;
        if (r < I9) { const int d = r >> 5; transpose_item(F.A->in[I_A2] + (size_t)(l * 2 + d) * 64 * 1024, 1024, 64, (bf16*)(ws + WS_A2T) + (size_t)d * 1024 * 64, 64, nullptr, scr, 0, 32 * (r & 31), F.lane); continue; } r -= I9;
        transpose_item(F.A->in[I_G2] + (size_t)l * 160 * 1024, 1024, 160, (bf16*)(ws + WS_G2T), 192, nullptr, scr, 64 * (r / 32), 32 * (r % 32), F.lane);
    }
    { unsigned zz = 0u; asm volatile("" : "+v"(zz)); v4u z = {zz, zz, zz, zz}; v4u* p = (v4u*)((bf16*)(ws + WS_WIN) + (size_t)DIN * DM);
      for (int i = widx * 64 + F.lane; i < 32 * DM / 8; i += nw * 64) p[i] = z; }
}

__device__ __forceinline__ void mod_partials(Frame& F) {
    LAS float* sl = (LAS float*)F.lds;
    for (int it = F.vcu; it < 2 * 32 * 12; it += F.G) {
        const int l = it / 384, ks = (it / 12) % 32, cc = it % 12;
        __syncthreads();
        if (F.tid < 384) { const int s = F.tid >> 7, k = ks * 128 + (F.tid & 127); const float c = s < 2 ? F.A->in[I_C][s * DM + k] : F.A->in[I_CCTX][k]; sl[F.tid] = c / (1.f + __expf(-c)); }
        __syncthreads();
        const float* wp = F.A->in[I_WMOD] + ((size_t)l * DM + ks * 128) * 24576 + cc * 2048 + F.tid * 4;
        f32x4 a0 = {0.f, 0.f, 0.f, 0.f}, a1 = a0, a2 = a0;
#pragma unroll 8
        for (int k = 0; k < 128; ++k) { const f32x4 w = *(const f32x4*)(wp + (size_t)k * 24576); a0 += w * sl[k]; a1 += w * sl[128 + k]; a2 += w * sl[256 + k]; }
        float* op = (float*)(F.ws + WS_MODP) + ((size_t)(l * 32 + ks) * 3) * 24576 + cc * 2048 + F.tid * 4;
        *(f32x4*)(op) = a0; *(f32x4*)(op + 24576) = a1; *(f32x4*)(op + 2 * 24576) = a2;
    }
    __syncthreads();
}
__device__ __forceinline__ void mod_reduce(Frame& F) {
    for (int i = F.vcu * NTHR + F.tid; i < 2 * 3 * 24576; i += F.G * NTHR) {
        const int l = i / (3 * 24576), s = (i / 24576) % 3, n = i % 24576;
        float a = F.A->in[I_BMOD][l * 24576 + n];
        const float* pp = (const float*)(F.ws + WS_MODP) + ((size_t)(l * 32) * 3 + s) * 24576 + n;
#pragma unroll 8
        for (int ks = 0; ks < 32; ++ks) a += pp[(size_t)ks * 3 * 24576];
        ((float*)(F.ws + WS_MOD))[i] = a;
    }
}

__device__ __forceinline__ void sum_partials_row(const Frame& F, const float* yp, size_t stride, bf16* ydst) {
    int lane = F.lane; asm volatile("" : "+v"(lane));
#pragma unroll 2
    for (int j = 0; j < 16; ++j) { const int c = 4 * lane + 256 * j; f32x4 y = *(const f32x4*)(yp + c);
#pragma unroll
        for (int sp = 1; sp < 8; ++sp) y += *(const f32x4*)(yp + sp * stride + c);
        v2u w; w.x = pk2(y.x, y.y); w.y = pk2(y.z, y.w); *(v2u*)(ydst + c) = w; }
}
template <int MODE>
__device__ __forceinline__ void ln_row(const Frame& F, const float* xsrc, const bf16* Y, const float* ga, const float* lg, const float* lb, float* xdst,
                                       bool domod, const float* sc, const float* sh, bf16* hrow) {
    f32x4 v[16]; float s = 0.f;
#pragma unroll
    for (int j = 0; j < 16; ++j) { const int c = 4 * F.lane + 256 * j; v[j] = *(const f32x4*)(xsrc + c);
        if (MODE == 1) { const v2u yw = *(const v2u*)(Y + c); const f32x4 y = {bflo(yw.x), bfhi(yw.x), bflo(yw.y), bfhi(yw.y)}, g = *(const f32x4*)(ga + c); v[j] = v[j] * ALPHA + g * y; }
        s += (v[j].x + v[j].y) + (v[j].z + v[j].w);
        if ((j & 7) == 7) asm volatile("" ::: "memory"); }
    float mean = wave_sum(s) * (1.f / DM), s2 = 0.f;
#pragma unroll
    for (int j = 0; j < 16; ++j) { v[j] = v[j] - mean; s2 += (v[j].x * v[j].x + v[j].y * v[j].y) + (v[j].z * v[j].z + v[j].w * v[j].w); }
    float rstd = 1.f / sqrtf(wave_sum(s2) * (1.f / DM) + LN_EPS);
    if (MODE == 1) {
        s = 0.f;
#pragma unroll
        for (int j = 0; j < 16; ++j) { const int c = 4 * F.lane + 256 * j; const f32x4 g = *(const f32x4*)(lg + c), b = *(const f32x4*)(lb + c); v[j] = v[j] * rstd * g + b;
            *(f32x4*)(xdst + c) = v[j]; s += (v[j].x + v[j].y) + (v[j].z + v[j].w);
            if ((j & 7) == 7) asm volatile("" ::: "memory"); }
        if (!domod) return;
        mean = wave_sum(s) * (1.f / DM); s2 = 0.f;
#pragma unroll
        for (int j = 0; j < 16; ++j) { v[j] = v[j] - mean; s2 += (v[j].x * v[j].x + v[j].y * v[j].y) + (v[j].z * v[j].z + v[j].w * v[j].w); }
        rstd = 1.f / sqrtf(wave_sum(s2) * (1.f / DM) + LN_EPS);
    }
#pragma unroll
    for (int j = 0; j < 16; ++j) { const int c = 4 * F.lane + 256 * j; const f32x4 a = *(const f32x4*)(sc + c), b = *(const f32x4*)(sh + c);
        const f32x4 o = v[j] * rstd * (a + 1.f) + b; v2u w; w.x = pk2(o.x, o.y); w.y = pk2(o.z, o.w); *(v2u*)(hrow + c) = w; }
}

__device__ __forceinline__ void shift4(const bf16* P, unsigned eo, bool hp, bool hn, const float* mup, const float* mun, unsigned mo, float (&u)[4]) {
    const v2u xc = ldg<v2u>(P, eo * 2u); v2u xp = {0u, 0u}, xn = {0u, 0u};
    if (hp) xp = ldg<v2u>(P, (eo - DINP) * 2u); if (hn) xn = ldg<v2u>(P, (eo + DINP) * 2u);
    const f32x4 mp = ldg<f32x4>(mup, mo * 4u), mn = ldg<f32x4>(mun, mo * 4u);
    const float c[4] = {bflo(xc.x), bfhi(xc.x), bflo(xc.y), bfhi(xc.y)}, p[4] = {bflo(xp.x), bfhi(xp.x), bflo(xp.y), bfhi(xp.y)}, n[4] = {bflo(xn.x), bfhi(xn.x), bflo(xn.y), bfhi(xn.y)};
#pragma unroll
    for (int e = 0; e < 4; ++e) u[e] = c[e] + mp[e] * (p[e] - c[e]) + mn[e] * (n[e] - c[e]);
}
__device__ __forceinline__ void st4bf(void* base, unsigned eo, float a, float b, float c, float d) { v2u w; w.x = pk2(a, b); w.y = pk2(c, d); stg<v2u>(base, eo * 2u, w); }

__device__ __forceinline__ void rwkv_feat_item(Frame& F, int l, int item) {
    F.tid = ltid(); F.lane = F.tid & 63;
    int row0, seq_lo, seq_hi;
    if (item < 16) { const int b = item >> 3; seq_lo = M_LAT + b * NCTX; seq_hi = seq_lo + NCTX; row0 = seq_lo + (item & 7) * 32; }
    else { const int it = item - 16, b = it >> 8; seq_lo = b * SEQ; seq_hi = seq_lo + SEQ; row0 = seq_lo + (it & 255) * 32; }
    const bf16* P = (const bf16*)(F.ws + WS_P);
    LAS bf16* ACT = (LAS bf16*)F.lds;
    const float* mup = F.A->in[I_MUP] + l * RWC; const float* mun = F.A->in[I_MUN] + l * RWC;
    __syncthreads();
    { const int tok = F.tid >> 4, jc = F.tid & 15, row = row0 + tok; const bool hp = row > seq_lo, hn = row + 1 < seq_hi;
      const bf16* pr = P + (size_t)row * DINP + C_RWL;
#pragma unroll
      for (int i = 0; i < 13; ++i) { const int j = jc * 2 + 32 * i;
          const unsigned xc = *(const unsigned*)(pr + j), xp = hp ? *(const unsigned*)(pr - DINP + j) : 0u, xn = hn ? *(const unsigned*)(pr + DINP + j) : 0u;
          float u[2];
#pragma unroll
          for (int e = 0; e < 2; ++e) { const float c = e ? bfhi(xc) : bflo(xc), p = e ? bfhi(xp) : bflo(xp), n = e ? bfhi(xn) : bflo(xn);
              float v = c + mup[3072 + j + e] * (p - c) + mun[3072 + j + e] * (n - c);
              if (j < 128) v = tanhf_(v); else if (j >= 256) v = sigmoidf_(v);
              u[e] = v; }
          *(LAS unsigned*)(ACT + tok * 424 + j) = pk2(u[0], u[1]); } }
    __syncthreads();
    const int tok = F.lane & 31, hi = F.lane >> 5, row = row0 + tok;
    const bf16* W2T = (const bf16*)(F.wsw + WS_W2T); const bf16* A2T = (const bf16*)(F.wsw + WS_A2T); const bf16* G2T = (const bf16*)(F.wsw + WS_G2T);
    bf16* RWF = (bf16*)(F.ws + WS_RWF); const size_t RS = (size_t)M_TOT * 1024;
    const float* kkv = F.A->in[I_KK] + l * 1024; const float* kav = F.A->in[I_KA] + l * 1024; const float* rkv = F.A->in[I_RK] + l * 1024;
    const float* w0f = F.A->in[I_W0] + (size_t)(l * 2) * 1024; const float* a0f = F.A->in[I_A0] + (size_t)(l * 2) * 1024;
    const LAS bf16* actl = ACT + tok * 424 + hi * 8;
    LAS unsigned char* TB = F.lds + 27136 + F.wave * 10880;
#define RF_LOADG(reg_, colbase) do { _Pragma("unroll") for (int i_ = 0; i_ < 3; ++i_) { const int p_ = F.lane + 64 * i_; reg_[i_] = (v4u){0u, 0u, 0u, 0u}; if (p_ < 136) { const int rr_ = p_ >> 2, cp_ = p_ & 3, gr_ = row0 - 1 + rr_; \
        if (gr_ >= seq_lo && gr_ < seq_hi) reg_[i_] = ldg<v4u>(P, ((unsigned)gr_ * DINP + (colbase) + 8 * cp_) * 2u); } } } while (0)
#define RF_STORET(ti, reg_) do { _Pragma("unroll") for (int i_ = 0; i_ < 3; ++i_) { const int p_ = F.lane + 64 * i_; if (p_ < 136) { const int rr_ = p_ >> 2, cp_ = p_ & 3; *(LAS v4u*)(TB + (ti) * 2720 + rr_ * 80 + cp_ * 16) = reg_[i_]; } } } while (0)
#define RF_SHIFT4(ti, g_, mo_, u_) do { const LAS unsigned char* q_ = TB + (ti) * 2720 + (tok + 1) * 80 + (8 * (g_) + 4 * hi) * 2; const v2u xc_ = *(const LAS v2u*)q_, xp_ = *(const LAS v2u*)(q_ - 80), xn_ = *(const LAS v2u*)(q_ + 80); \
        const f32x4 mp_ = ldg<f32x4>(mup, (mo_) * 4u), mn_ = ldg<f32x4>(mun, (mo_) * 4u); \
        const float c_[4] = {bflo(xc_.x), bfhi(xc_.x), bflo(xc_.y), bfhi(xc_.y)}, pp_[4] = {bflo(xp_.x), bfhi(xp_.x), bflo(xp_.y), bfhi(xp_.y)}, nn_[4] = {bflo(xn_.x), bfhi(xn_.x), bflo(xn_.y), bfhi(xn_.y)}; \
        _Pragma("unroll") for (int e_ = 0; e_ < 4; ++e_) u_[e_] = c_[e_] + mp_[e_] * (pp_[e_] - c_[e_]) + mn_[e_] * (nn_[e_] - c_[e_]); } while (0)
#define RF_PUT(ti, o_) do { _Pragma("unroll") for (int g_ = 0; g_ < 4; ++g_) *(LAS v2u*)(TB + (ti) * 2720 + tok * 80 + (8 * g_ + 4 * hi) * 2) = o_[g_]; } while (0)
#define RF_FLUSH3(a0_, a1_, a2_, cblk_) do { asm volatile("s_waitcnt lgkmcnt(0)" ::: "memory"); \
        _Pragma("unroll") for (int t_ = 0; t_ < 3; ++t_) { const int arr_ = t_ == 0 ? (a0_) : (t_ == 1 ? (a1_) : (a2_)); \
            _Pragma("unroll") for (int i_ = 0; i_ < 2; ++i_) { const int p_ = F.lane + 64 * i_, rr_ = p_ >> 2, cp_ = p_ & 3; const v4u v_ = *(const LAS v4u*)(TB + t_ * 2720 + rr_ * 80 + cp_ * 16); \
                stg<v4u>(RWF + arr_ * RS, ((unsigned)(row0 + rr_) * 1024u + (cblk_) + 8 * cp_) * 2u, v_); } } \
        asm volatile("s_waitcnt lgkmcnt(0)" ::: "memory"); } while (0)
#pragma unroll 1
    for (int hh = 0; hh < 2; ++hh) {
        const int h = 2 * F.wave + hh, cbase = h * 64;
        float ssq = 0.f;
        { v4u t0[3], t1[3]; RF_LOADG(t0, C_RWK + cbase); RF_LOADG(t1, C_RWK + cbase + 32); RF_STORET(0, t0); RF_STORET(1, t1); }
        asm volatile("s_waitcnt lgkmcnt(0)" ::: "memory");
#pragma unroll
        for (int bg = 0; bg < 8; ++bg) { const unsigned c4 = cbase + (bg >> 2) * 32 + 8 * (bg & 3) + 4 * hi; float uk[4];
            RF_SHIFT4(bg >> 2, bg & 3, 1024 + c4, uk); const f32x4 k4 = ldg<f32x4>(kkv, c4 * 4u);
#pragma unroll
            for (int e = 0; e < 4; ++e) { const float q = uk[e] * k4[e]; ssq += q * q; } }
        ssq = half_swap_sum(ssq);
        const float rn = 1.f / fmaxf(sqrtf(ssq), 1e-12f);
        float sb = 0.f;
        asm volatile("s_waitcnt lgkmcnt(0)" ::: "memory");
#pragma unroll 1
        for (int blk = 0; blk < 2; ++blk) {
            const unsigned cblk = cbase + blk * 32, cha = cblk + tok;
            v4u gR[3], gK[3], gV[3];
            RF_LOADG(gR, C_RWR + cblk); RF_LOADG(gK, C_RWK + cblk); RF_LOADG(gV, C_RWV + cblk);
#pragma unroll
            for (int d = 0; d < 2; ++d) { f32x16 aw = {};
#pragma unroll
                for (int ks = 0; ks < 4; ++ks) { const bf16x8 bw = *(const LAS bf16x8*)(actl + d * 64 + ks * 16); const bf16x8 w_ = ldg<bf16x8>(W2T, ((d * 1024 + cha) * 64 + ks * 16 + hi * 8) * 2u);
                    aw = __builtin_amdgcn_mfma_f32_32x32x16_bf16(w_, bw, aw, 0, 0, 0); }
                v2u o[4];
#pragma unroll
                for (int g = 0; g < 4; ++g) { const f32x4 w0 = ldg<f32x4>(w0f, (d * 1024 + cblk + 8 * g + 4 * hi) * 4u); float e4[4];
#pragma unroll
                    for (int e = 0; e < 4; ++e) e4[e] = 0.60653065971f * sigmoidf_(w0[e] + aw[4 * g + e]);
                    o[g].x = pk2(e4[0], e4[1]); o[g].y = pk2(e4[2], e4[3]); }
                RF_PUT(d, o); }
            { f32x16 ag = {};
#pragma unroll
              for (int ks = 0; ks < 10; ++ks) { const bf16x8 bg_ = *(const LAS bf16x8*)(actl + 256 + ks * 16); const bf16x8 g_ = ldg<bf16x8>(G2T, (cha * 192 + ks * 16 + hi * 8) * 2u);
                  ag = __builtin_amdgcn_mfma_f32_32x32x16_bf16(g_, bg_, ag, 0, 0, 0); }
              v2u o[4];
#pragma unroll
              for (int g = 0; g < 4; ++g) { o[g].x = pk2(ag[4 * g], ag[4 * g + 1]); o[g].y = pk2(ag[4 * g + 2], ag[4 * g + 3]); }
              RF_PUT(2, o); }
            RF_FLUSH3(4, 5, 8, cblk);
            RF_STORET(0, gR); RF_STORET(1, gK); RF_STORET(2, gV);
            { f32x16 aaf = {}, aab = {};
#pragma unroll
              for (int ks = 0; ks < 4; ++ks) { const bf16x8 baf = *(const LAS bf16x8*)(actl + 128 + ks * 16), bab = *(const LAS bf16x8*)(actl + 192 + ks * 16);
                  const bf16x8 a_f = ldg<bf16x8>(A2T, (cha * 64 + ks * 16 + hi * 8) * 2u), a_b = ldg<bf16x8>(A2T, ((1024 + cha) * 64 + ks * 16 + hi * 8) * 2u);
                  aaf = __builtin_amdgcn_mfma_f32_32x32x16_bf16(a_f, baf, aaf, 0, 0, 0); aab = __builtin_amdgcn_mfma_f32_32x32x16_bf16(a_b, bab, aab, 0, 0, 0); }
              v2u oR[4], oK[4], oV[4], oKK[4], oAF[4], oAB[4];
              asm volatile("s_waitcnt lgkmcnt(0)" ::: "memory");
#pragma unroll
              for (int g = 0; g < 4; ++g) { const unsigned c4 = cblk + 8 * g + 4 * hi; float ur[4], uk[4], uv[4];
                  RF_SHIFT4(0, g, c4, ur); RF_SHIFT4(1, g, 1024 + c4, uk); RF_SHIFT4(2, g, 2048 + c4, uv);
                  const f32x4 a0a = ldg<f32x4>(a0f, c4 * 4u), a0b = ldg<f32x4>(a0f, (1024 + c4) * 4u), kk4 = ldg<f32x4>(kkv, c4 * 4u), ka4 = ldg<f32x4>(kav, c4 * 4u), rk4 = ldg<f32x4>(rkv, c4 * 4u);
                  float af[4], ab[4], kk[4];
#pragma unroll
                  for (int e = 0; e < 4; ++e) { const int r = 4 * g + e;
                      af[e] = sigmoidf_(a0a[e] + aaf[r]); ab[e] = sigmoidf_(a0b[e] + aab[r]); kk[e] = uk[e] * kk4[e] * rn;
                      const float kdf = uk[e] * (1.f + (af[e] - 1.f) * ka4[e]), kdb = uk[e] * (1.f + (ab[e] - 1.f) * ka4[e]);
                      sb += ur[e] * rk4[e] * (kdf + kdb); }
                  oR[g].x = pk2(ur[0], ur[1]); oR[g].y = pk2(ur[2], ur[3]); oK[g].x = pk2(uk[0], uk[1]); oK[g].y = pk2(uk[2], uk[3]); oV[g].x = pk2(uv[0], uv[1]); oV[g].y = pk2(uv[2], uv[3]);
                  oKK[g].x = pk2(kk[0], kk[1]); oKK[g].y = pk2(kk[2], kk[3]); oAF[g].x = pk2(af[0], af[1]); oAF[g].y = pk2(af[2], af[3]); oAB[g].x = pk2(ab[0], ab[1]); oAB[g].y = pk2(ab[2], ab[3]); }
              asm volatile("s_waitcnt lgkmcnt(0)" ::: "memory");
              RF_PUT(0, oR); RF_PUT(1, oK); RF_PUT(2, oV); RF_FLUSH3(0, 1, 2, cblk);
              RF_PUT(0, oKK); RF_PUT(1, oAF); RF_PUT(2, oAB); RF_FLUSH3(3, 6, 7, cblk); }
        }
        sb = half_swap_sum(sb);
        if (hi == 0) ((float*)(F.ws + WS_SB))[(size_t)row * 16 + h] = sb;
    }
#undef RF_LOADG
#undef RF_STORET
#undef RF_SHIFT4
#undef RF_PUT
#undef RF_FLUSH3
}

__device__ __forceinline__ float gelu_tanh(float x) { return 0.5f * x * (1.f + tanhf_(0.7978845608028654f * (x + 0.044715f * x * x * x))); }
template <bool PASS3>
__device__ __forceinline__ void lru_item(Frame& F, int l, int item) {
    F.tid = ltid(); F.lane = F.tid & 63;
    const int sc = item >> 3, nb = item & 7, b = sc / NCH, ch = sc % NCH;
    int row0, seq_lo, seq_hi;
    if (ch < 8) { seq_lo = M_LAT + b * NCTX; seq_hi = seq_lo + NCTX; row0 = seq_lo + ch * 32; }
    else { seq_lo = b * SEQ; seq_hi = seq_lo + SEQ; row0 = seq_lo + (ch - 8) * 32; }
    const bf16* P = (const bf16*)(F.ws + WS_P);
    LAS float* U = (LAS float*)F.lds;
    LAS bf16* UA = (LAS bf16*)(F.lds + 16384);
    LAS float* AB = (LAS float*)(F.lds + 32768);
    __syncthreads();
    { const int tok = F.tid >> 4, c8 = (F.tid & 15) * 8, cg = nb * 128 + c8; float acc[8];
      const float* cb = F.A->in[I_CONVB] + l * 1024 + cg;
#pragma unroll
      for (int e = 0; e < 8; ++e) acc[e] = cb[e];
#pragma unroll
      for (int j = 0; j < 4; ++j) { const int r = row0 + tok - 2 + j;
          if (r >= seq_lo && r < seq_hi) { const v4u x = *(const v4u*)(P + (size_t)r * DINP + C_LRUX + cg); const float* cw = F.A->in[I_CONVW] + (size_t)(l * 4 + j) * 1024 + cg;
#pragma unroll
              for (int w = 0; w < 4; ++w) { acc[2 * w] += cw[2 * w] * bflo(x[w]); acc[2 * w + 1] += cw[2 * w + 1] * bfhi(x[w]); } } }
      *(LAS f32x4*)(U + tok * 128 + c8) = (f32x4){acc[0], acc[1], acc[2], acc[3]}; *(LAS f32x4*)(U + tok * 128 + c8 + 4) = (f32x4){acc[4], acc[5], acc[6], acc[7]};
      v4u o; o.x = pk2(acc[0], acc[1]); o.y = pk2(acc[2], acc[3]); o.z = pk2(acc[4], acc[5]); o.w = pk2(acc[6], acc[7]);
      *(LAS v4u*)(UA + tok * 136 + c8) = o; }
    __syncthreads();
    { const int dir = F.wave >> 2, cq = F.wave & 3, l32 = F.lane & 31, hi = F.lane >> 5, chn = cq * 32 + l32, cg = nb * 128 + chn;
      const bf16* Wr = (const bf16*)(F.wsw + WS_WLRU) + ((size_t)(dir * 2 + 0) * 8 + nb) * 16384 + (size_t)chn * 128;
      const bf16* Wi = (const bf16*)(F.wsw + WS_WLRU) + ((size_t)(dir * 2 + 1) * 8 + nb) * 16384 + (size_t)chn * 128;
      f32x16 accr = {}, acci = {};
#pragma unroll
      for (int ks = 0; ks < 8; ++ks) { const int ko = ks * 16 + hi * 8;
          const bf16x8 a = *(const LAS bf16x8*)(UA + l32 * 136 + ko); const bf16x8 br = *(const bf16x8*)(Wr + ko), bi = *(const bf16x8*)(Wi + ko);
          accr = __builtin_amdgcn_mfma_f32_32x32x16_bf16(a, br, accr, 0, 0, 0); acci = __builtin_amdgcn_mfma_f32_32x32x16_bf16(a, bi, acci, 0, 0, 0); }
      const float ba = F.A->in[I_LBA][(l * 2 + dir) * 1024 + cg], bi_ = F.A->in[I_LBI][(l * 2 + dir) * 1024 + cg], sp = softplusf_(-F.A->in[I_LAM][(l * 2 + dir) * 1024 + cg]);
#pragma unroll
      for (int r = 0; r < 16; ++r) { const int tok = att::crow(r, hi); const float u = U[tok * 128 + chn];
          const float rg = sigmoidf_(accr[r] + ba), ig = sigmoidf_(acci[r] + bi_), la = -8.f * rg * sp, a = __expf(la), x2 = 2.f * la;
          const float em = x2 * (1.f + x2 * (0.5f + x2 * (0.16666667f + x2 * (0.041666668f + x2 * (0.0083333338f + x2 * 0.0013888889f)))));
          const float bc = __builtin_amdgcn_sqrtf(x2 < -0.5f ? 1.f - a * a : -em) * (ig * u);
          AB[(dir * 2 + 0) * 4096 + tok * 128 + chn] = a; AB[(dir * 2 + 1) * 4096 + tok * 128 + chn] = bc; } }
    __syncthreads();
    if (F.tid < 256) { const int dir = F.tid >> 7, chn = F.tid & 127, cg = nb * 128 + chn; const size_t ci = ((size_t)(dir * 2 + b) * NCH + ch) * 1024 + cg;
        LAS float* Aa = AB + (dir * 2) * 4096 + chn; LAS float* Bb = AB + (dir * 2 + 1) * 4096 + chn;
        if (!PASS3) { float h = 0.f, ap = 1.f;
#pragma unroll 8
            for (int s = 0; s < 32; ++s) { const int tok = dir ? 31 - s : s; const float a = Aa[tok * 128]; h = a * h + Bb[tok * 128]; ap *= a;
                if (s == 0 && dir == 1 && ch == 7) ((float*)(F.ws + WS_QUIRK))[b * 1024 + cg] = h; }
            ((float*)(F.ws + WS_CA))[ci] = ap; ((float*)(F.ws + WS_CB))[ci] = h;
        } else { float h = ((const float*)(F.ws + WS_HIN))[ci];
#pragma unroll 8
            for (int s = 0; s < 32; ++s) { const int tok = dir ? 31 - s : s; h = Aa[tok * 128] * h + Bb[tok * 128]; Bb[tok * 128] = h; } } }
    if (PASS3) { __syncthreads();
        const int tok = F.tid >> 4, c8 = (F.tid & 15) * 8, cg = nb * 128 + c8, row = row0 + tok;
        const v4u y = *(const v4u*)(P + (size_t)row * DINP + C_LRUY + cg); float o[8];
#pragma unroll
        for (int w = 0; w < 4; ++w) { const float h0 = AB[4096 + tok * 128 + c8 + 2 * w] + AB[3 * 4096 + tok * 128 + c8 + 2 * w], h1 = AB[4096 + tok * 128 + c8 + 2 * w + 1] + AB[3 * 4096 + tok * 128 + c8 + 2 * w + 1];
            o[2 * w] = h0 * gelu_tanh(bflo(y[w])); o[2 * w + 1] = h1 * gelu_tanh(bfhi(y[w])); }
        v4u ov; ov.x = pk2(o[0], o[1]); ov.y = pk2(o[2], o[3]); ov.z = pk2(o[4], o[5]); ov.w = pk2(o[6], o[7]);
        *(v4u*)((bf16*)(F.ws + WS_MIX) + (size_t)row * DM + 1024 + cg) = ov; }
}
__device__ __forceinline__ void lru_carry(Frame& F, int blk) {
    F.tid = ltid(); F.lane = F.tid & 63;
    const int gid = blk * NTHR + F.tid; if (gid >= 4096) return;
    const int dir = gid >> 11, b = (gid >> 10) & 1, cg = gid & 1023;
    const float* CA = (const float*)(F.ws + WS_CA) + ((size_t)(dir * 2 + b) * NCH) * 1024 + cg; const float* CB = (const float*)(F.ws + WS_CB) + ((size_t)(dir * 2 + b) * NCH) * 1024 + cg;
    float* HIN = (float*)(F.ws + WS_HIN) + ((size_t)(dir * 2 + b) * NCH) * 1024 + cg;
    float h = 0.f;
    if (dir == 0) {
#pragma unroll 8
        for (int c = 0; c < NCH; ++c) { HIN[(size_t)c * 1024] = h; h = CA[(size_t)c * 1024] * h + CB[(size_t)c * 1024]; }
    } else {
        for (int c = 7; c >= 0; --c) { HIN[(size_t)c * 1024] = h; h = CA[(size_t)c * 1024] * h + CB[(size_t)c * 1024]; }
        h = ((const float*)(F.ws + WS_QUIRK))[b * 1024 + cg];
#pragma unroll 8
        for (int c = NCH - 1; c >= 8; --c) { HIN[(size_t)c * 1024] = h; h = CA[(size_t)c * 1024] * h + CB[(size_t)c * 1024]; }
    }
}

__device__ __forceinline__ void rope_table(Frame& F) {
    const int i = F.vcu * NTHR + F.tid; if (i >= 2048) return;
    const int pos = i >> 4, f = i & 15; float s, c; sincosf((float)pos * exp2f(-(float)f * (13.287712379549449f / 16.f)), &s, &c);
    float* t = (float*)(F.ws + WS_ROPE); t[i] = c; t[2048 + i] = s;
}
__device__ __forceinline__ void row_prep(Frame& F, int row) {
    F.tid = ltid(); F.lane = F.tid & 63;
    bf16* pr = (bf16*)(F.ws + WS_P) + (size_t)row * DINP; const int lane = F.lane;
    const bool lat = row < M_LAT; const int t = row & (SEQ - 1); const float prow = (float)(t >> 6), pcol = (float)(t & 63);
    { const v4u a = *(const v4u*)(pr + C_QA + lane * 16), b = *(const v4u*)(pr + C_QA + lane * 16 + 8); float ss = 0.f;
#pragma unroll
      for (int w = 0; w < 4; ++w) { const float x0 = bflo(a[w]), x1 = bfhi(a[w]), x2 = bflo(b[w]), x3 = bfhi(b[w]); ss += x0 * x0 + x1 * x1 + x2 * x2 + x3 * x3; }
      ss = wave_sum(ss); if (lane == 0) ((float*)(F.ws + WS_RSQ))[row] = 1.f / sqrtf(ss * (1.f / 1024.f) + RMS_EPS); }
    { const v4u a = *(const v4u*)(pr + C_KVA + lane * 8); float ss = 0.f;
#pragma unroll
      for (int w = 0; w < 4; ++w) { const float x0 = bflo(a[w]), x1 = bfhi(a[w]); ss += x0 * x0 + x1 * x1; }
      ss = wave_sum(ss); if (lane == 0) ((float*)(F.ws + WS_RSKV))[row] = 1.f / sqrtf(ss * (1.f / 512.f) + RMS_EPS); }
    bf16* kr = (bf16*)(F.ws + WS_KR) + (size_t)row * 64;
    if (lat) {
        { const int part = lane >> 5, sub = lane & 31;
          const float inv = exp2f(-(float)sub * (13.287712379549449f / 32.f)); float sn, cs; sincosf((part ? pcol : prow) * inv, &sn, &cs);
#pragma unroll
          for (int hd = 0; hd < 10; ++hd) { bf16* qb = pr + (hd < 8 ? C_SWAQ + hd * 128 : C_SWAK + (hd - 8) * 128) + part * 64;
              const float x1 = bf2f(qb[sub]), x2 = bf2f(qb[sub + 32]); qb[sub] = (bf16)f2bf(x1 * cs - x2 * sn); qb[sub + 32] = (bf16)f2bf(x2 * cs + x1 * sn); } }
        if (lane < 32) { const int part = lane >> 4, i = lane & 15; const bf16* src = pr + C_KR + part * 32;
          const float inv = exp2f(-(float)i * (13.287712379549449f / 16.f)); float s, c; sincosf((part ? pcol : prow) * inv, &s, &c);
          const float x1 = bf2f(src[i]), x2 = bf2f(src[i + 16]);
          kr[part * 32 + i] = (bf16)f2bf(x1 * c - x2 * s); kr[part * 32 + i + 16] = (bf16)f2bf(x2 * c + x1 * s); }
    } else kr[lane] = pr[C_KR + lane];
}

__device__ __forceinline__ float allred16(float x) { return row_sum16(x); }
__device__ __forceinline__ int scan_row(int s, int dir, int b) {
    if (s < NCTX) return M_LAT + b * NCTX + (dir ? NCTX - 1 - s : s);
    const int t = s - NCTX; return b * SEQ + (dir ? SEQ - 1 - t : t);
}
__device__ __forceinline__ void rwkv_scan(Frame& F, int l, int chain) {
    F.tid = ltid(); F.lane = F.tid & 63;
    const int dir = chain >> 5, b = (chain >> 4) & 1, h = chain & 15;
    constexpr int CT = 24, NCHK = (NCTX + SEQ) / CT, STEPF = 392, BUFF = CT * STEPF;
    LAS float* buf = (LAS float*)F.lds; LAS float* ybuf = (LAS float*)(F.lds + 3 * BUFF * 4);
    gcbf RWF = (gcbf)(F.ws + WS_RWF); const size_t RS = (size_t)M_TOT * 1024;
    gflp YS = (gflp)(F.ws + WS_YS) + (size_t)dir * M_TOT * 1024;
    const bool cmp = F.wave < 4; const int lt = F.tid - 256, lst = lt >> 4, lq = lt & 15, lc = h * 64 + 4 * lq;
    const f32x4 ka4 = *(const GAS f32x4*)((gcfl)F.A->in[I_KA] + l * 1024 + (cmp ? 0 : lc));
    v2u gr[2], gk[2], gv[2], gkk[2], ge[2], ga[2];
#pragma unroll
    for (int u = 0; u < 2; ++u) { gr[u] = (v2u){0u, 0u}; gk[u] = gr[u]; gv[u] = gr[u]; gkk[u] = gr[u]; ge[u] = gr[u]; ga[u] = gr[u]; }
#define RW_LOAD(c) do { if (!cmp) { _Pragma("unroll") for (int u_ = 0; u_ < 2; ++u_) { const int s_ = lst + 16 * u_; if (s_ < CT) { const size_t o_ = (size_t)scan_row((c) * CT + s_, dir, b) * 1024 + lc; \
        gr[u_] = *(const GAS v2u*)(RWF + 0 * RS + o_); gk[u_] = *(const GAS v2u*)(RWF + 1 * RS + o_); gv[u_] = *(const GAS v2u*)(RWF + 2 * RS + o_); \
        gkk[u_] = *(const GAS v2u*)(RWF + 3 * RS + o_); ge[u_] = *(const GAS v2u*)(RWF + (4 + dir) * RS + o_); ga[u_] = *(const GAS v2u*)(RWF + (6 + dir) * RS + o_); } } } } while (0)
#define RW_WRITE(bi) do { if (!cmp) { _Pragma("unroll") for (int u_ = 0; u_ < 2; ++u_) { const int s_ = lst + 16 * u_; if (s_ < CT) { LAS float* d_ = buf + (bi) * BUFF + s_ * STEPF + 4 * lq; \
        const float r_[4] = {bflo(gr[u_].x), bfhi(gr[u_].x), bflo(gr[u_].y), bfhi(gr[u_].y)}, k_[4] = {bflo(gk[u_].x), bfhi(gk[u_].x), bflo(gk[u_].y), bfhi(gk[u_].y)}, v_[4] = {bflo(gv[u_].x), bfhi(gv[u_].x), bflo(gv[u_].y), bfhi(gv[u_].y)}; \
        const float q_[4] = {bflo(gkk[u_].x), bfhi(gkk[u_].x), bflo(gkk[u_].y), bfhi(gkk[u_].y)}, e_[4] = {bflo(ge[u_].x), bfhi(ge[u_].x), bflo(ge[u_].y), bfhi(ge[u_].y)}, a_[4] = {bflo(ga[u_].x), bfhi(ga[u_].x), bflo(ga[u_].y), bfhi(ga[u_].y)}; \
        f32x4 w4, kd4, kk4, b4, wr4, v4; float sbr = 0.f, skr = 0.f; \
        _Pragma("unroll") for (int e = 0; e < 4; ++e) { w4[e] = __expf(-e_[e]); kd4[e] = k_[e] * (1.f + (a_[e] - 1.f) * ka4[e]); kk4[e] = q_[e]; b4[e] = q_[e] * a_[e]; wr4[e] = w4[e] * r_[e]; v4[e] = v_[e]; sbr += b4[e] * r_[e]; skr += kd4[e] * r_[e]; } \
        sbr = row_sum16(sbr); skr = row_sum16(skr); \
        *(LAS f32x4*)(d_) = w4; *(LAS f32x4*)(d_ + 64) = kd4; *(LAS f32x4*)(d_ + 128) = kk4; *(LAS f32x4*)(d_ + 192) = b4; *(LAS f32x4*)(d_ + 256) = wr4; *(LAS f32x4*)(d_ + 320) = v4; \
        if (lq == 0) *(LAS f32x2*)(buf + (bi) * BUFF + s_ * STEPF + 384) = (f32x2){sbr, skr}; } } } } while (0)
#define RW_FLUSH(c) do { if (!cmp) { _Pragma("unroll") for (int u_ = 0; u_ < 2; ++u_) { const int s_ = lst + 16 * u_; if (s_ < CT) { const f32x4 y_ = *(const LAS f32x4*)(ybuf + ((c) & 1) * (CT * 64) + s_ * 64 + 4 * lq); \
        *(GAS f32x4*)(YS + (size_t)scan_row((c) * CT + s_, dir, b) * 1024 + lc) = y_; } } } } while (0)
    __syncthreads();
    RW_LOAD(0); RW_WRITE(0); RW_LOAD(1); RW_WRITE(1); RW_LOAD(2);
    __syncthreads();
    const int kg = F.lane & 7, rg = F.lane >> 3, r0 = 16 * (F.wave & 3) + 2 * rg;
    f32x2 St[8];
#pragma unroll
    for (int i = 0; i < 8; ++i) St[i] = (f32x2){0.f, 0.f};
    int bc = 0, bw = 2;
#pragma unroll 1
    for (int c = 0; c < NCHK; ++c) {
        if (c + 2 < NCHK) { RW_WRITE(bw); if (c + 3 < NCHK) RW_LOAD(c + 3); }
        if (c > 0) RW_FLUSH(c - 1);
        if (cmp) {
        const LAS float* bb = buf + bc * BUFF + 8 * kg; const LAS float* vb = buf + bc * BUFF + 320 + r0; const LAS float* sb = buf + bc * BUFF + 384;
        LAS float* yb = ybuf + (c & 1) * (CT * 64) + r0;
        f32x4 w4[2], kd4[2], kk4[2], b4[2], wr4[2];
#pragma unroll
        for (int q = 0; q < 2; ++q) { w4[q] = *(const LAS f32x4*)(bb + 4 * q); kd4[q] = *(const LAS f32x4*)(bb + 64 + 4 * q); kk4[q] = *(const LAS f32x4*)(bb + 128 + 4 * q); b4[q] = *(const LAS f32x4*)(bb + 192 + 4 * q); wr4[q] = *(const LAS f32x4*)(bb + 256 + 4 * q); }
        f32x2 v2 = *(const LAS f32x2*)(vb), s2 = *(const LAS f32x2*)(sb);
#pragma unroll
        for (int st = 0; st < CT; ++st) {
            const int sn = (st + 1 < CT ? st + 1 : st) * STEPF;
            f32x4 nw4[2], nkd4[2], nkk4[2], nb4[2], nwr4[2];
#pragma unroll
            for (int q = 0; q < 2; ++q) { nw4[q] = *(const LAS f32x4*)(bb + sn + 4 * q); nkd4[q] = *(const LAS f32x4*)(bb + sn + 64 + 4 * q); nkk4[q] = *(const LAS f32x4*)(bb + sn + 128 + 4 * q); nb4[q] = *(const LAS f32x4*)(bb + sn + 192 + 4 * q); nwr4[q] = *(const LAS f32x4*)(bb + sn + 256 + 4 * q); }
            const f32x2 nv2 = *(const LAS f32x2*)(vb + sn), ns2 = *(const LAS f32x2*)(sb + sn);
#define PKH(x, i) ((i) & 1 ? (f32x2){(x)[2], (x)[3]} : (f32x2){(x)[0], (x)[1]})
#define PK_MUL(d, a, bp, i) do { if ((i) & 1) asm("v_pk_mul_f32 %0, %1, %2 op_sel:[0,1] op_sel_hi:[1,1]" : "=v"(d) : "v"(a), "v"(bp)); else asm("v_pk_mul_f32 %0, %1, %2 op_sel:[0,0] op_sel_hi:[1,0]" : "=v"(d) : "v"(a), "v"(bp)); } while (0)
#define PK_FMA(d, a, bp, i, c) do { if ((i) & 1) asm("v_pk_fma_f32 %0, %1, %2, %3 op_sel:[0,1,0] op_sel_hi:[1,1,1]" : "=v"(d) : "v"(a), "v"(bp), "v"(c)); else asm("v_pk_fma_f32 %0, %1, %2, %3 op_sel:[0,0,0] op_sel_hi:[1,0,1]" : "=v"(d) : "v"(a), "v"(bp), "v"(c)); } while (0)
#define PK_FNMA(d, a, bp, i, c) do { if ((i) & 1) asm("v_pk_fma_f32 %0, %1, %2, %3 op_sel:[0,1,0] op_sel_hi:[1,1,1] neg_lo:[1,0,0] neg_hi:[1,0,0]" : "=v"(d) : "v"(a), "v"(bp), "v"(c)); \
        else asm("v_pk_fma_f32 %0, %1, %2, %3 op_sel:[0,0,0] op_sel_hi:[1,0,1] neg_lo:[1,0,0] neg_hi:[1,0,0]" : "=v"(d) : "v"(a), "v"(bp), "v"(c)); } while (0)
#define OPP(x, e) PKH((x)[(e) >> 2], ((e) >> 1) & 1)
            f32x2 pa, za, pb, zb;
            PK_MUL(pa, St[0], OPP(kk4, 0), 0); PK_MUL(za, St[0], OPP(wr4, 0), 0); PK_MUL(pb, St[4], OPP(kk4, 4), 4); PK_MUL(zb, St[4], OPP(wr4, 4), 4);
#pragma unroll
            for (int i = 1; i < 4; ++i) { PK_FMA(pa, St[i], OPP(kk4, i), i, pa); PK_FMA(za, St[i], OPP(wr4, i), i, za); PK_FMA(pb, St[4 + i], OPP(kk4, 4 + i), 4 + i, pb); PK_FMA(zb, St[4 + i], OPP(wr4, 4 + i), 4 + i, zb); }
            const f32x2 p = pa + pb, z = za + zb;
            float p0 = p.x, p1 = p.y, z0 = z.x, z1 = z.y;
#define D4(ctl) "v_add_f32_dpp %0, %0, %0 " ctl " row_mask:0xf bank_mask:0xf\n\tv_add_f32_dpp %1, %1, %1 " ctl " row_mask:0xf bank_mask:0xf\n\tv_add_f32_dpp %2, %2, %2 " ctl " row_mask:0xf bank_mask:0xf\n\tv_add_f32_dpp %3, %3, %3 " ctl " row_mask:0xf bank_mask:0xf\n\t"
            asm volatile("s_nop 1\n\t" D4("quad_perm:[1,0,3,2]") D4("quad_perm:[2,3,0,1]") D4("row_half_mirror") "s_nop 0"
                : "+v"(p0), "+v"(p1), "+v"(z0), "+v"(z1));
#undef D4
            const f32x2 pp = {p0, p1}, zz = {z0, z1};
            { f32x2 y; PK_FNMA(y, pp, s2, 0, zz); PK_FMA(y, v2, s2, 1, y); *(LAS f32x2*)(yb + st * 64) = y; }
#pragma unroll
            for (int i = 0; i < 8; ++i) { f32x2 t; PK_MUL(t, v2, OPP(kd4, i), i); PK_FMA(t, St[i], OPP(w4, i), i, t); PK_FNMA(St[i], pp, OPP(b4, i), i, t); }
#undef OPP
#undef PKH
#undef PK_MUL
#undef PK_FMA
#undef PK_FNMA
#pragma unroll
            for (int q = 0; q < 2; ++q) { w4[q] = nw4[q]; kd4[q] = nkd4[q]; kk4[q] = nkk4[q]; b4[q] = nb4[q]; wr4[q] = nwr4[q]; }
            v2 = nv2; s2 = ns2;
        }
        }
        __syncthreads();
        bc = bc == 2 ? 0 : bc + 1; bw = bw == 2 ? 0 : bw + 1;
    }
    RW_FLUSH(NCHK - 1);
#undef RW_LOAD
#undef RW_WRITE
#undef RW_FLUSH
}
__device__ __forceinline__ void rwkv_out_row(Frame& F, int l, int row) {
    F.tid = ltid(); F.lane = F.tid & 63;
    const int c0 = F.lane * 16; const float* yf = (const float*)(F.ws + WS_YS) + (size_t)row * 1024 + c0; const float* yb = yf + (size_t)M_TOT * 1024;
    float y[16]; float s = 0.f;
#pragma unroll
    for (int j = 0; j < 4; ++j) { const f32x4 a = *(const f32x4*)(yf + 4 * j), b = *(const f32x4*)(yb + 4 * j);
#pragma unroll
        for (int e = 0; e < 4; ++e) { y[4 * j + e] = a[e] + b[e]; s += y[4 * j + e]; } }
    s = quad_sum(s); const float mu = s * (1.f / 64.f); float q = 0.f;
#pragma unroll
    for (int e = 0; e < 16; ++e) { y[e] -= mu; q += y[e] * y[e]; }
    q = quad_sum(q); const float rstd = 1.f / sqrtf(q * (1.f / 64.f) + GN_EPS);
    const bf16* RWF = (const bf16*)(F.ws + WS_RWF); const size_t RS = (size_t)M_TOT * 1024, o = (size_t)row * 1024 + c0;
    const float sbv = ((const float*)(F.ws + WS_SB))[(size_t)row * 16 + (F.lane >> 2)];
    const float* lg = F.A->in[I_LNG] + l * 1024 + c0; const float* lb = F.A->in[I_LNB] + l * 1024 + c0;
    bf16* dst = (bf16*)(F.ws + WS_MIX) + (size_t)row * DM + 3072 + c0;
#pragma unroll
    for (int hf = 0; hf < 2; ++hf) { const v4u vv = *(const v4u*)(RWF + 2 * RS + o + 8 * hf), gg = *(const v4u*)(RWF + 8 * RS + o + 8 * hf); float r[8];
#pragma unroll
        for (int w = 0; w < 4; ++w) { const int e = 8 * hf + 2 * w;
            r[2 * w] = (y[e] * rstd * lg[e] + lb[e] + sbv * bflo(vv[w])) * bflo(gg[w]); r[2 * w + 1] = (y[e + 1] * rstd * lg[e + 1] + lb[e + 1] + sbv * bfhi(vv[w])) * bfhi(gg[w]); }
        v4u ov; ov.x = pk2(r[0], r[1]); ov.y = pk2(r[2], r[3]); ov.z = pk2(r[4], r[5]); ov.w = pk2(r[6], r[7]); *(v4u*)(dst + 8 * hf) = ov; }
}

#ifndef W_OUT_K1
#define W_OUT_K1 2048
#endif
struct MlaTiles { gcbf KV; gcbf KR; int ctx_row0, lat_row0, h;
    __device__ __forceinline__ att::Tile operator()(int j) const { const int row = j < 4 ? ctx_row0 + 64 * j : lat_row0 + 64 * (j - 4);
        att::Tile t; t.kn = KV + (size_t)row * 2048 + h * 256; t.v = t.kn + 128; t.kr = KR + (size_t)row * 64; t.mtype = 0; t.krel0 = 0; return t; } };
struct SwaTiles { gcbf P; int blk_row0, ctx_row0, kvh, nwin, has_prev, has_next;
    __device__ __forceinline__ att::Tile operator()(int j) const { att::Tile t; int row; t.mtype = 0; t.krel0 = 0;
        if (j >= nwin) row = ctx_row0 + 64 * (j - nwin);
        else if (j < 2) row = blk_row0 + 64 * j;
        else if (has_prev && j < 4) { row = blk_row0 - 128 + 64 * (j - 2); t.mtype = 1; t.krel0 = -128 + 64 * (j - 2); }
        else { const int sub = j - 2 - 2 * has_prev; row = blk_row0 + 128 + 64 * sub; t.mtype = 2; t.krel0 = 128 + 64 * sub; }
        t.kn = P + (size_t)row * DINP + C_SWAK + kvh * 128; t.v = P + (size_t)row * DINP + C_SWAV + kvh * 128; t.kr = nullptr; return t; } };

#ifndef MLA_SDEPTH
#define MLA_SDEPTH 1
#endif
__device__ __forceinline__ void mla_item(Frame& F, int b, int h, int qb, bool ctxq) {
    F.tid = ltid(); F.lane = F.tid & 63;
    const int r32 = F.lane & 31; const int t = qb * 256 + F.wave * 32 + r32;
    const int roww0 = ctxq ? M_LAT + b * NCTX + F.wave * 32 : b * SEQ + qb * 256 + F.wave * 32;
    gcbf Qw = (gcbf)(F.ws + WS_Q) + (size_t)(roww0 + r32) * 1536 + h * 192;
    MlaTiles ts{(gcbf)(F.ws + WS_KV), (gcbf)(F.ws + WS_KR), M_LAT + b * NCTX, b * SEQ, h};
    gbfp Ow = (gbfp)(F.ws + WS_MIX) + (size_t)roww0 * DM + 2048 + h * 128;
    att::attn_body<192, 2048, 2048, false, false, MLA_SDEPTH>(Qw, ctxq ? 0 : 1, t >> 6, t & 63, (gcfl)(F.ws + WS_ROPE), 0, 0.f, ts, ctxq ? 4 : 132, Ow, (LAS char*)F.lds);
}
__device__ __forceinline__ void swa_item(Frame& F, int l, int b, int n, int kvh, int half, bool ctxq, int hq_ctx) {
    F.tid = ltid(); F.lane = F.tid & 63;
    const int r32 = F.lane & 31; gcbf P = (gcbf)(F.ws + WS_P);
    int hq, qi, roww0, t;
    if (ctxq) { hq = hq_ctx; kvh = hq >> 2; qi = 0; roww0 = M_LAT + b * NCTX + F.wave * 32; t = 0; }
    else { hq = kvh * 4 + 2 * half + (F.wave >> 2); qi = (F.wave & 3) * 32 + r32; roww0 = b * SEQ + n * 128 + (F.wave & 3) * 32; t = n * 128 + qi; }
    gcbf Qw = P + (size_t)(roww0 + r32) * DINP + C_SWAQ + hq * 128;
    SwaTiles ts; ts.P = P; ts.blk_row0 = b * SEQ + n * 128; ts.ctx_row0 = M_LAT + b * NCTX; ts.kvh = kvh;
    ts.has_prev = (!ctxq && n > 0) ? 1 : 0; ts.has_next = (!ctxq && n < SEQ / 128 - 1) ? 1 : 0; ts.nwin = ctxq ? 0 : 2 + 2 * ts.has_prev + 2 * ts.has_next;
    gbfp Ow = (gbfp)(F.ws + WS_MIX) + (size_t)roww0 * DM + hq * 128;
    const float sink_l2 = F.A->in[I_SINK][l * 8 + hq] * 1.4426950408889634f;
    att::attn_body<128, DINP, DINP, true, true, 2>(Qw, 0, 0, 0, (gcfl)nullptr, qi, sink_l2, ts, ts.nwin + 4, Ow, (LAS char*)F.lds);
}

#ifndef DBG_PHASES
#define DBG_PHASES 0xfffff
#endif
#define PH(n) ((DBG_PHASES >> (n)) & 1)
#ifndef DUP_PHASES
#define DUP_PHASES 0
#endif
#define REP(n) _Pragma("unroll") for (int rep_ = 0; rep_ < (((DUP_PHASES >> (n)) & 1) ? 2 : 1); ++rep_)
__global__ void __launch_bounds__(NTHR, 2) mk_fwd(Args args) {
    extern __shared__ __attribute__((aligned(16))) unsigned char lds[];
    Frame F;
    F.lds = (LAS unsigned char*)lds;
    F.tid = threadIdx.x; F.lane = F.tid & 63; F.wave = __builtin_amdgcn_readfirstlane(F.tid >> 6);
    F.G = gridDim.x; { const int bx = blockIdx.x; F.vcu = (F.G % 8 == 0) ? (bx % 8) * (F.G / 8) + bx / 8 : bx; }
    F.gw = F.vcu * NWAVES + F.wave; F.NGW = F.G * NWAVES;
    F.ws = args.ws; F.out = args.out; F.ctl = (gu32*)(args.ws + WS_CTL);
    F.A = (const __attribute__((address_space(4))) Args*)__builtin_amdgcn_kernarg_segment_ptr();
    for (int u = F.tid; u < (LDS_BYTES - LDSCTL_OFF) / 4; u += NTHR) ((LAS unsigned*)(F.lds + LDSCTL_OFF))[u] = 0u;
    __syncthreads();
    XcdBarrier bar = xcd_barrier_post((unsigned*)(args.ws + WS_CTL) + 4096, (volatile LAS unsigned*)(F.lds + MISC_OFF) + 8);
    const bool rwkv_blk = (blockIdx.x & 3) == 0;
    XcdBarrier bar2; bar2.bar = (unsigned*)(args.ws + WS_CTL) + 8192; bar2.x = 0; bar2.st = (volatile LAS unsigned*)(F.lds + MISC_OFF) + 12; bar2.nparts = gridDim.x - ((gridDim.x + 3) >> 2);
    if (!rwkv_blk) { const unsigned np_ = bar2.nparts; bar2 = xcd_barrier_post((unsigned*)(args.ws + WS_CTL) + 8192, (volatile LAS unsigned*)(F.lds + MISC_OFF) + 12); bar2.nparts = np_; }
#define SUB_BAR() do { bar2.bar = launder(bar2.bar); bar2.x = launder(bar2.x); xcd_barrier(bar2); F.ws = launder_g(F.ws); F.wsw = F.ws + (size_t)lcur * WSET_STRIDE; F.A = launder(F.A); F.tid = ltid(); F.lane = F.tid & 63; } while (0)
#define GRID_BAR() do { bar.bar = launder(bar.bar); bar.x = launder(bar.x); xcd_barrier(bar); F.ws = launder_g(F.ws); F.wsw = F.ws + (size_t)lcur * WSET_STRIDE; F.A = launder(F.A); F.tid = ltid(); F.lane = F.tid & 63; } while (0)
    const int bx = blockIdx.x; int lcur = 0; F.wsw = F.ws;
    bf16* H = (bf16*)(F.ws + WS_H); float* X = (float*)(F.ws + WS_X);

    REP(0) if (PH(0)) { mod_partials(F);
    convert_weights(F, 0, F.gw, F.NGW); }
    GRID_BAR();
    if (PH(1)) { mod_reduce(F); rope_table(F); }
    GRID_BAR();

#pragma unroll 1
    for (int l = 0; l < 2; ++l) {
        lcur = l; F.wsw = F.ws + (size_t)l * WSET_STRIDE;
        const bool wctx = (l == 0);
        const int MO = wctx ? M_TOT : M_LAT;
        if (PH(2) && l == 0) {
            for (int row = F.gw; row < M_TOT; row += F.NGW) { const int s = row_s(row);
                const float* xs = row < M_LAT ? F.A->in[I_X] + (size_t)row * DM : F.A->in[I_CTX] + (size_t)(row - M_LAT) * DM;
                ln_row<0>(F, xs, nullptr, nullptr, nullptr, nullptr, nullptr, true, mod_ptr(F, 0, s, 1), mod_ptr(F, 0, s, 0), H + (size_t)row * DM); }
        }
        GRID_BAR();
        REP(3) if (PH(3)) { pg8::Gemm g{H, (const bf16*)(F.wsw + WS_WIN), M_TOT, DINP, DM, DM, DM}; pg8::StaticOrder S; S.init(M_TOT, DINP, F.G, bx);
          pg8::EpiBf16<0> E{(bf16*)(F.ws + WS_P), DINP, nullptr};
          pg8::gemm_phase<pg8::EpiBf16<0>, pg8::StaticOrder, true, true>(F.lds, g, S, E); }
        GRID_BAR();
        REP(4) if (PH(4)) for (int it = F.vcu; it < 528; it += F.G) rwkv_feat_item(F, l, it);
        REP(5) if (PH(5)) { if (F.G == 256) { if (F.vcu < 16) { for (int it = F.vcu; it < 64; it += 16) lru_item<false>(F, l, it); }
                                              else { for (int it = 64 + F.vcu - 16; it < 2 * NCH * 8; it += 240) lru_item<false>(F, l, it); } }
                            else for (int it = F.vcu; it < 2 * NCH * 8; it += F.G) lru_item<false>(F, l, it); }
        __syncthreads();
        if (PH(6)) for (int row = F.gw; row < M_TOT; row += F.NGW) row_prep(F, row);
        GRID_BAR();
        REP(8) if (rwkv_blk) { const int nrw = (F.G + 3) >> 2; REP(18) if (PH(8)) for (int chain = bx >> 2; chain < 64; chain += nrw) rwkv_scan(F, l, chain); }
        else REP(19) { const int aw = (bx >> 2) * 3 + (bx & 3) - 1, naw = F.G - ((F.G + 3) >> 2);
            if (PH(7) && aw < 8) lru_carry(F, aw);
            if (PH(7)) { pg8::Gemm g{(const bf16*)(F.ws + WS_P) + C_QA, (const bf16*)(F.wsw + WS_WQB), M_TOT, 1536, 1024, DINP, 1024}; pg8::StaticOrder S; S.init(M_TOT, 1536, naw, aw);
              pg8::EpiBf16<2> E{(bf16*)(F.ws + WS_Q), 1536, (const float*)(F.ws + WS_RSQ)};
              pg8::gemm_phase<pg8::EpiBf16<2>, pg8::StaticOrder, true, true>(F.lds, g, S, E); }
            if (PH(7)) { pg8::Gemm g{(const bf16*)(F.ws + WS_P) + C_KVA, (const bf16*)(F.wsw + WS_WKVB), M_TOT, 2048, 512, DINP, 512}; pg8::StaticOrder S; S.init(M_TOT, 2048, naw, aw);
              pg8::EpiBf16<2> E{(bf16*)(F.ws + WS_KV), 2048, (const float*)(F.ws + WS_RSKV)};
              pg8::gemm_phase<pg8::EpiBf16<2>, pg8::StaticOrder, true, true>(F.lds, g, S, E); }
            SUB_BAR();
            if (PH(9)) for (int it = aw; it < 512; it += naw) mla_item(F, it >> 8, (it >> 5) & 7, it & 31, false);
            if (PH(9) && wctx) for (int it = aw; it < 16; it += naw) mla_item(F, it >> 3, it & 7, 0, true);
            if (PH(10)) for (int it = aw; it < 512; it += naw) swa_item(F, l, it >> 8, (it >> 2) & 63, (it >> 1) & 1, it & 1, false, 0);
            if (PH(10) && wctx) for (int it = aw; it < 16; it += naw) swa_item(F, l, it >> 3, 0, 0, 0, true, it & 7);
            if (PH(11)) { if (naw == 192) { const int i0 = aw < 128 ? aw : 1280 + aw - 128, st_ = aw < 128 ? 128 : 64, i1 = aw < 128 ? 1280 : 2 * NCH * 8;
                                            for (int it = i0; it < i1; it += st_) { if (!wctx && ((it >> 3) % NCH) < 8) continue; lru_item<true>(F, l, it); } }
                          else for (int it = aw; it < 2 * NCH * 8; it += naw) { if (!wctx && ((it >> 3) % NCH) < 8) continue; lru_item<true>(F, l, it); } }
            if (l == 0) { __syncthreads(); convert_weights(F, 1, aw * NWAVES + F.wave, naw * NWAVES); }
            else { SUB_BAR();
                pg8::Gemm g{(const bf16*)(F.ws + WS_MIX), (const bf16*)(F.wsw + WS_WOUT), M_LAT, DM, W_OUT_K1, DM, DM}; pg8::StaticOrder S; S.init(M_LAT, DM, naw, aw);
                pg8::EpiBf16<0> E{(bf16*)(F.ws + WS_Y1), DM, nullptr};
                pg8::gemm_phase<pg8::EpiBf16<0>, pg8::StaticOrder, true, true>(F.lds, g, S, E); }
        }
        GRID_BAR();
        REP(12) if (PH(12)) for (int row = F.gw; row < MO; row += F.NGW) rwkv_out_row(F, l, row);
        GRID_BAR();
        REP(13) if (PH(13)) {
          if (l == 0) { pg8::Gemm g{(const bf16*)(F.ws + WS_MIX), (const bf16*)(F.wsw + WS_WOUT), M_LAT, DM, DM, DM, DM}; pg8::StaticOrder S; S.init(M_LAT, DM, F.G, bx);
            pg8::EpiBf16<0> E{(bf16*)(F.ws + WS_Y1), DM, nullptr};
            pg8::gemm_phase<pg8::EpiBf16<0>, pg8::StaticOrder, true, true>(F.lds, g, S, E); }
          else { pg8::Gemm g{(const bf16*)(F.ws + WS_MIX) + W_OUT_K1, (const bf16*)(F.wsw + WS_WOUT) + W_OUT_K1, M_LAT, DM, DM - W_OUT_K1, DM, DM}; pg8::StaticOrder S; S.init(M_LAT, DM, F.G, bx);
            pg8::EpiBf16<3> E{(bf16*)(F.ws + WS_Y1), DM, nullptr};
            pg8::gemm_phase<pg8::EpiBf16<3>, pg8::StaticOrder, true, true>(F.lds, g, S, E); }
          if (wctx) {
              pg8::Gemm g2{(const bf16*)(F.ws + WS_MIX) + (size_t)M_LAT * DM, (const bf16*)(F.wsw + WS_WOUT), M_CTX, DM, DM / 8, DM, DM}; pg8::SplitOrder S2; S2.init(M_CTX, DM, DM / 8, bx);
              pg8::EpiF32 E2{(float*)(F.ws + WS_YP), DM, (size_t)M_CTX * DM};
              pg8::gemm_phase<pg8::EpiF32, pg8::SplitOrder, true, true>(F.lds, g2, S2, E2); } }
        GRID_BAR();
        if (PH(14)) for (int row = F.gw; row < MO; row += F.NGW) { const int s = row_s(row);
            const float* xs = (l == 0) ? (row < M_LAT ? F.A->in[I_X] + (size_t)row * DM : F.A->in[I_CTX] + (size_t)(row - M_LAT) * DM) : X + (size_t)row * DM;
            bf16* yrow = (bf16*)(F.ws + WS_Y1) + (size_t)row * DM;
            if (row >= M_LAT) sum_partials_row(F, (const float*)(F.ws + WS_YP) + (size_t)(row - M_LAT) * DM, (size_t)M_CTX * DM, yrow);
            ln_row<1>(F, xs, yrow, mod_ptr(F, l, s, 2), F.A->in[I_LN1G] + l * DM, F.A->in[I_LN1B] + l * DM, X + (size_t)row * DM,
                      true, mod_ptr(F, l, s, 4), mod_ptr(F, l, s, 3), H + (size_t)row * DM); }
        GRID_BAR();
        REP(15) if (PH(15)) { pg8::Gemm g{H, (const bf16*)(F.wsw + WS_WFF1), MO, DFF, DM, DM, DM}; pg8::StaticOrder S; S.init(MO, DFF, F.G, bx);
          pg8::EpiBf16<1> E{(bf16*)(F.ws + WS_HID), DFF, nullptr};
          pg8::gemm_phase<pg8::EpiBf16<1>, pg8::StaticOrder, true, true>(F.lds, g, S, E); }
        GRID_BAR();
        REP(16) if (PH(16)) { pg8::Gemm g{(const bf16*)(F.ws + WS_HID), (const bf16*)(F.wsw + WS_WFF2), M_LAT, DM, DFF, DFF, DFF}; pg8::StaticOrder S; S.init(M_LAT, DM, F.G, bx);
          pg8::EpiBf16<0> E{(bf16*)(F.ws + WS_Y2), DM, nullptr};
          pg8::gemm_phase<pg8::EpiBf16<0>, pg8::StaticOrder, true, true>(F.lds, g, S, E);
          if (wctx) {
              pg8::Gemm g2{(const bf16*)(F.ws + WS_HID) + (size_t)M_LAT * DFF, (const bf16*)(F.wsw + WS_WFF2), M_CTX, DM, DFF / 8, DFF, DFF}; pg8::SplitOrder S2; S2.init(M_CTX, DM, DFF / 8, bx);
              pg8::EpiF32 E2{(float*)(F.ws + WS_YP), DM, (size_t)M_CTX * DM};
              pg8::gemm_phase<pg8::EpiF32, pg8::SplitOrder, true, true>(F.lds, g2, S2, E2); } }
        GRID_BAR();
        if (!PH(17)) {} else if (l == 0) {
            for (int row = F.gw; row < M_TOT; row += F.NGW) { const int s = row_s(row);
                bf16* yrow = (bf16*)(F.ws + WS_Y2) + (size_t)row * DM;
                if (row >= M_LAT) sum_partials_row(F, (const float*)(F.ws + WS_YP) + (size_t)(row - M_LAT) * DM, (size_t)M_CTX * DM, yrow);
                ln_row<1>(F, X + (size_t)row * DM, yrow, mod_ptr(F, 0, s, 5), F.A->in[I_LN2G], F.A->in[I_LN2B], X + (size_t)row * DM,
                          true, mod_ptr(F, 1, s, 1), mod_ptr(F, 1, s, 0), H + (size_t)row * DM); }
        } else {
            for (int row = F.gw; row < M_LAT; row += F.NGW) { const int s = row_s(row);
                ln_row<1>(F, X + (size_t)row * DM, (const bf16*)(F.ws + WS_Y2) + (size_t)row * DM, mod_ptr(F, 1, s, 5), F.A->in[I_LN2G] + DM, F.A->in[I_LN2B] + DM, F.out + (size_t)row * DM,
                          false, nullptr, nullptr, nullptr); }
        }
    }
}

extern "C" void kernel_launch(void* const* d_in, const int* in_sizes, int n_in, void* d_out, int out_size, void* d_ws, size_t ws_size, hipStream_t stream) {
    static int grid = 0;
    if (grid == 0) {
        if (n_in != 38 || out_size != M_LAT * DM || ws_size < WS_END) { fprintf(stderr, "kernel_launch: unexpected shapes: n_in %d out %d ws %zu (need %zu)\n", n_in, out_size, ws_size, (size_t)WS_END); grid = -1; return; }
        int dev = 0, cus = 0, per_cu = 0;
        if (hipGetDevice(&dev) != hipSuccess || hipDeviceGetAttribute(&cus, hipDeviceAttributeMultiprocessorCount, dev) != hipSuccess) { grid = -1; return; }
        if (hipFuncSetAttribute((const void*)mk_fwd, hipFuncAttributeMaxDynamicSharedMemorySize, LDS_BYTES) != hipSuccess) { fprintf(stderr, "kernel_launch: hipFuncSetAttribute failed\n"); grid = -1; return; }
        if (hipOccupancyMaxActiveBlocksPerMultiprocessor(&per_cu, (const void*)mk_fwd, NTHR, LDS_BYTES) != hipSuccess || per_cu < 1) fprintf(stderr, "kernel_launch: occupancy query says %d\n", per_cu);
        (void)hipGetLastError();
        grid = cus;
    }
    if (grid < 0) return;
    if (hipMemsetAsync((char*)d_ws + WS_CTL, 0, CTL_ZERO_BYTES, stream) != hipSuccess) return;
    Args a{};
    for (int i = 0; i < 38; ++i) a.in[i] = (const float*)d_in[i];
    a.out = (float*)d_out; a.ws = (unsigned char*)d_ws;
    hipLaunchKernelGGL(mk_fwd, dim3(grid), dim3(NTHR), LDS_BYTES, stream, a);
    const hipError_t le = hipPeekAtLastError();
    if (le != hipSuccess) fprintf(stderr, "kernel_launch: launch failed: %s\n", hipGetErrorName(le));
}
```

```cpp
#include <hip/hip_runtime.h>
#include <hip/hip_bf16.h>
#include <cstdio>
#include <cstdint>

namespace pg8 {
#define PG8_LAS __attribute__((address_space(3)))
typedef unsigned short bf16_t;
typedef short bf16x8 __attribute__((ext_vector_type(8)));
typedef float f32x4 __attribute__((ext_vector_type(4)));
typedef unsigned u32x4 __attribute__((ext_vector_type(4)));
constexpr int BM = 256, BK = 64, HALF = 128, HTB = HALF * BK * 2  , STAGE_BYTES = 8 * HTB, NXCD = 8, WGM = 8;

__host__ __device__ __forceinline__ int lds_byte(int r, int c) { const int st = (r >> 4) * 2 + (c >> 5), rr = r & 15, cc = c & 31, ob = rr * 64 + cc * 2; return st * 1024 + (ob ^ (((ob >> 9) & 1) << 5)); }
__host__ __device__ __forceinline__ void stage_rc(int b, int& R, int& C) { const int st = b / 1024, sb = b % 1024, swz = sb ^ (((sb >> 9) & 1) << 5); R = (st >> 1) * 16 + swz / 64; C = (st & 1) * 32 + (swz % 64) / 2; }
__host__ __device__ __forceinline__ int perm32(int rho) { const int n = rho >> 4, i = rho & 15; return 8 * (i >> 2) + 4 * n + (i & 3); }

struct Unit { int pm, pn, ko, ks; };
struct Gemm { const bf16_t* A; const bf16_t* Bt; int M, N, K, lda, ldb; };

struct StaticOrder {
    int nM, nN, nwg, G, c;
    __host__ __device__ void init(int M, int N, int G_, int c_) { nM = M / BM; nN = N / BM; nwg = nM * nN; G = G_; c = c_; }
    __host__ __device__ bool next(int i, Unit& u) const {
        const long L = (long)i * G + c; if (L >= nwg) return false;
        int wgid = (int)L; { const int q = nwg / NXCD, r = nwg % NXCD, xcd = wgid % NXCD, off = wgid / NXCD; wgid = (xcd < r ? xcd * (q + 1) : r * (q + 1) + (xcd - r) * q) + off; }
        const int nig = WGM * nN, gid = wgid / nig, fm = gid * WGM, gsz = (nM - fm) < WGM ? (nM - fm) : WGM;
        u.pm = fm + ((wgid % nig) % gsz); u.pn = (wgid % nig) / gsz; u.ko = 0; u.ks = 0; return true;
    }
    __device__ __forceinline__ void a_ready(const Unit&) const {}
    __device__ __forceinline__ void done(const Unit&) const {}
};
struct SplitOrder {
    int nN, nitems, kslice, c;
    __host__ __device__ void init(int M, int N, int Kslice, int c_) { nN = N / BM; nitems = (M / BM) * nN * 8; kslice = Kslice; c = c_; }
    __host__ __device__ bool next(int i, Unit& u) const { if (i > 0 || c >= nitems) return false; u.ks = c & 7; u.ko = u.ks * kslice; u.pn = (c >> 3) % nN; u.pm = (c >> 3) / nN; return true; }
    __device__ __forceinline__ void a_ready(const Unit&) const {}
    __device__ __forceinline__ void done(const Unit&) const {}
};

__device__ __forceinline__ unsigned cvt_pk_bf16(float lo, float hi) { unsigned r; asm volatile("v_cvt_pk_bf16_f32 %0, %1, %2" : "=v"(r) : "v"(lo), "v"(hi)); return r; }

struct EpiF32 {
    static constexpr bool PERM = false, AFTER_DRAIN = false;
    float* C; int ldc; size_t split_stride;
    __device__ __forceinline__ void operator()(const f32x4 (&acc)[2][2][4][2], const Unit& u, int wr, int wc, int fr, int fq) const {
        const int row0 = u.pm * BM + wr * 64 + fr, col0 = u.pn * BM + wc * 32 + 4 * fq; float* Cb = C + (size_t)u.ks * split_stride;
#pragma unroll
        for (int ai = 0; ai < 2; ++ai)
#pragma unroll
            for (int m = 0; m < 4; ++m) { float* rowp = Cb + (size_t)(row0 + ai * HALF + m * 16) * ldc + col0;
#pragma unroll
                for (int bj = 0; bj < 2; ++bj)
#pragma unroll
                    for (int n = 0; n < 2; ++n) *(f32x4*)(rowp + bj * HALF + n * 16) = acc[ai][bj][m][n]; }
    }
};
template <int ACT> struct EpiBf16 {
    static constexpr bool PERM = true, AFTER_DRAIN = false;
    bf16_t* O; int ldc; const float* rowscale;
    __device__ __forceinline__ void operator()(const f32x4 (&acc)[2][2][4][2], const Unit& u, int wr, int wc, int fr, int fq) const {
        const int row0 = u.pm * BM + wr * 64 + fr; const int col0 = u.pn * BM + wc * 32 + 8 * fq;
#pragma unroll
        for (int ai = 0; ai < 2; ++ai)
#pragma unroll
            for (int m = 0; m < 4; ++m) { const int row = row0 + ai * HALF + m * 16; bf16_t* rowp = O + (size_t)row * ldc + col0;
                float rs = 1.f; if (ACT == 2) rs = rowscale[row];
#pragma unroll
                for (int bj = 0; bj < 2; ++bj) { f32x4 v0 = acc[ai][bj][m][0], v1 = acc[ai][bj][m][1];
                    if (ACT == 1) {
#pragma unroll
                        for (int j = 0; j < 4; ++j) { const float a = fmaxf(v0[j], 0.f), b = fmaxf(v1[j], 0.f); v0[j] = a * a; v1[j] = b * b; } }
                    if (ACT == 2) { v0 = v0 * rs; v1 = v1 * rs; }
                    if (ACT == 3) { const u32x4 o = *(const u32x4*)(rowp + bj * HALF);
                        v0[0] += __builtin_bit_cast(float, o.x << 16); v0[1] += __builtin_bit_cast(float, o.x & 0xffff0000u); v0[2] += __builtin_bit_cast(float, o.y << 16); v0[3] += __builtin_bit_cast(float, o.y & 0xffff0000u);
                        v1[0] += __builtin_bit_cast(float, o.z << 16); v1[1] += __builtin_bit_cast(float, o.z & 0xffff0000u); v1[2] += __builtin_bit_cast(float, o.w << 16); v1[3] += __builtin_bit_cast(float, o.w & 0xffff0000u); }
                    u32x4 w; w.x = cvt_pk_bf16(v0[0], v0[1]); w.y = cvt_pk_bf16(v0[2], v0[3]); w.z = cvt_pk_bf16(v1[0], v1[1]); w.w = cvt_pk_bf16(v1[2], v1[3]);
                    *(u32x4*)(rowp + bj * HALF) = w; } }
    }
};

template <class Epi, class Sched, bool ALIGN_EPI = false, bool SP2 = false>
__device__ __forceinline__ void gemm_phase(PG8_LAS unsigned char* lds, const Gemm g, const Sched& S, const Epi& E) {
    int tid = threadIdx.x; asm volatile("" : "+v"(tid));
    const int wid = __builtin_amdgcn_readfirstlane(tid >> 6), lane = tid & 63, wr = wid >> 2, wc = wid & 3, fr = lane & 15, fq = lane >> 4;
    const int K = g.K, nt = K / BK, lda = g.lda, ldb = g.ldb;
    unsigned voffA[2], voffB[2];
#pragma unroll
    for (int i = 0; i < 2; ++i) { int R, C; stage_rc(tid * 16 + i * 8192, R, C); const int Rb = Epi::PERM ? ((R & ~31) + perm32(R & 31)) : R;
        voffA[i] = (unsigned)(R * lda + C) * 2u; voffB[i] = (unsigned)(Rb * ldb + C) * 2u; }
    const size_t kstep = (size_t)(BK * 2);
    const size_t hstepA = (size_t)HALF * lda * 2, hstepB = (size_t)HALF * ldb * 2;
    const size_t tstepA = 2 * hstepA, tstepB = 2 * hstepB;
    const unsigned ldsw = (unsigned)wid * 1024u;
    const int aoff = lds_byte(wr * 64 + fr, fq * 8), boff = lds_byte(wc * 32 + fr, fq * 8);
#define PG8_SA(b, h) (((b) * 2 + (h)) * HTB)
#define PG8_SB(b, h) ((4 + (b) * 2 + (h)) * HTB)
#define PG8_STAGE(bufoff, gbase, voff) do { _Pragma("unroll") for (int _i = 0; _i < 2; ++_i) \
        __builtin_amdgcn_global_load_lds((const unsigned*)((const char*)(gbase) + (voff)[_i]), (PG8_LAS unsigned*)(lds + (bufoff) + ldsw + _i * 8192), 16, 0, 0); } while (0)
#define PG8_LDA(dst, b, h) do { _Pragma("unroll") for (int m = 0; m < 4; ++m) _Pragma("unroll") for (int k = 0; k < 2; ++k) dst[m][k] = *(const PG8_LAS bf16x8*)(lds + PG8_SA(b, h) + aoff + m * 2048 + k * 1024); } while (0)
#define PG8_LDB(dst, b, h) do { _Pragma("unroll") for (int n = 0; n < 2; ++n) _Pragma("unroll") for (int k = 0; k < 2; ++k) dst[n][k] = *(const PG8_LAS bf16x8*)(lds + PG8_SB(b, h) + boff + n * 2048 + k * 1024); } while (0)
#define PG8_MMA(ai, bj, At, Bt) do { __builtin_amdgcn_s_setprio(1); _Pragma("unroll") for (int m = 0; m < 4; ++m) _Pragma("unroll") for (int n = 0; n < 2; ++n) _Pragma("unroll") for (int k = 0; k < 2; ++k) \
        acc[ai][bj][m][n] = __builtin_amdgcn_mfma_f32_16x16x32_bf16(Bt[n][k], At[m][k], acc[ai][bj][m][n], 0, 0, 0); __builtin_amdgcn_s_setprio(0); } while (0)
#define PG8_WAIT_V(n) asm volatile("s_waitcnt vmcnt(" #n ")" ::: "memory")
#define PG8_WAIT_L(n) asm volatile("s_waitcnt lgkmcnt(" #n ")" ::: "memory")
#define PG8_BAR __builtin_amdgcn_s_barrier()
#define PG8_SCHED __builtin_amdgcn_sched_barrier(0)
    Unit cur, nxt; int ui = 0;
    if (!S.next(0, cur)) return;
    f32x4 acc[2][2][4][2];
#pragma unroll
    for (int a = 0; a < 2; ++a)
#pragma unroll
        for (int b = 0; b < 2; ++b)
#pragma unroll
            for (int m = 0; m < 4; ++m)
#pragma unroll
                for (int n = 0; n < 2; ++n) acc[a][b][m][n] = (f32x4){0.f, 0.f, 0.f, 0.f};
    bf16x8 At[4][2], B0[2][2], B1[2][2];
    const char* cA = (const char*)g.A + (size_t)cur.pm * tstepA + (size_t)cur.ko * 2; const char* cB = (const char*)g.Bt + (size_t)cur.pn * tstepB + (size_t)cur.ko * 2;
    S.a_ready(cur);
    if constexpr (SP2) {
        PG8_STAGE(PG8_SB(0, 0), cB, voffB); PG8_STAGE(PG8_SB(0, 1), cB + hstepB, voffB); PG8_STAGE(PG8_SA(0, 0), cA, voffA); PG8_STAGE(PG8_SA(0, 1), cA + hstepA, voffA);
        if (wr == 1) PG8_BAR;
        PG8_WAIT_V(2); PG8_BAR;
        PG8_STAGE(PG8_SB(1, 0), cB + kstep, voffB); PG8_STAGE(PG8_SA(1, 0), cA + kstep, voffA); PG8_STAGE(PG8_SB(1, 1), cB + hstepB + kstep, voffB);
        PG8_WAIT_V(6); PG8_BAR;
    } else {
        PG8_STAGE(PG8_SB(0, 0), cB, voffB); PG8_STAGE(PG8_SA(0, 0), cA, voffA); PG8_STAGE(PG8_SB(0, 1), cB + hstepB, voffB); PG8_STAGE(PG8_SA(0, 1), cA + hstepA, voffA);
        if (wr == 1) PG8_BAR;
        PG8_WAIT_V(4); PG8_BAR;
        PG8_STAGE(PG8_SB(1, 0), cB + kstep, voffB); PG8_STAGE(PG8_SA(1, 0), cA + kstep, voffA); PG8_STAGE(PG8_SB(1, 1), cB + hstepB + kstep, voffB);
        PG8_WAIT_V(6); PG8_BAR;
    }
    for (;;) {
        const bool has_next = S.next(ui + 1, nxt);
        const char* nA = has_next ? (const char*)g.A + (size_t)nxt.pm * tstepA + (size_t)nxt.ko * 2 : cA; const char* nB = has_next ? (const char*)g.Bt + (size_t)nxt.pn * tstepB + (size_t)nxt.ko * 2 : cB;
        for (int t = 0; t < nt; t += 2) {
            const bool last = (t == nt - 2);
            const char* a1 = cA + (size_t)(t + 1) * kstep;
            const char* a2 = last ? nA : cA + (size_t)(t + 2) * kstep; const char* b2 = last ? nB : cB + (size_t)(t + 2) * kstep;
            const char* a3 = a2 + kstep; const char* b3 = b2 + kstep;
            if (last && has_next) S.a_ready(nxt);
            if constexpr (SP2) {
            PG8_LDB(B0, 0, 0); PG8_LDB(B1, 0, 1); PG8_SCHED; PG8_LDA(At, 0, 0); PG8_STAGE(PG8_SA(1, 1), a1 + hstepA, voffA);
            PG8_WAIT_V(8); PG8_WAIT_L(0); PG8_BAR; PG8_MMA(0, 0, At, B0); PG8_MMA(0, 1, At, B1); PG8_BAR; PG8_SCHED;
            PG8_LDA(At, 0, 1); PG8_STAGE(PG8_SB(0, 0), b2, voffB); PG8_STAGE(PG8_SB(0, 1), b2 + hstepB, voffB); PG8_STAGE(PG8_SA(0, 0), a2, voffA);
            PG8_WAIT_V(8); PG8_WAIT_L(0); PG8_BAR; PG8_MMA(1, 0, At, B0); PG8_MMA(1, 1, At, B1); PG8_BAR; PG8_SCHED;
            PG8_LDB(B0, 1, 0); PG8_LDB(B1, 1, 1); PG8_SCHED; PG8_LDA(At, 1, 0); PG8_STAGE(PG8_SA(0, 1), a2 + hstepA, voffA);
            PG8_WAIT_V(8); PG8_WAIT_L(0); PG8_BAR; PG8_MMA(0, 0, At, B0); PG8_MMA(0, 1, At, B1); PG8_BAR; PG8_SCHED;
            PG8_LDA(At, 1, 1); PG8_STAGE(PG8_SB(1, 0), b3, voffB); PG8_STAGE(PG8_SB(1, 1), b3 + hstepB, voffB); PG8_STAGE(PG8_SA(1, 0), a3, voffA);
            PG8_WAIT_V(8); PG8_WAIT_L(0); PG8_BAR; PG8_MMA(1, 0, At, B0); PG8_MMA(1, 1, At, B1); PG8_BAR; PG8_SCHED;
            } else {
            PG8_LDB(B0, 0, 0); PG8_SCHED; PG8_LDA(At, 0, 0); PG8_STAGE(PG8_SA(1, 1), a1 + hstepA, voffA);
            PG8_WAIT_L(8); PG8_BAR; PG8_WAIT_L(0); PG8_MMA(0, 0, At, B0); PG8_BAR; PG8_SCHED;
            PG8_LDB(B1, 0, 1); PG8_STAGE(PG8_SB(0, 0), b2, voffB);
            PG8_BAR; PG8_WAIT_L(0); PG8_MMA(0, 1, At, B1); PG8_BAR;
            PG8_LDA(At, 0, 1); PG8_STAGE(PG8_SA(0, 0), a2, voffA);
            PG8_BAR; PG8_WAIT_L(0); PG8_MMA(1, 0, At, B0); PG8_BAR; PG8_SCHED;
            PG8_STAGE(PG8_SB(0, 1), b2 + hstepB, voffB);
            PG8_WAIT_V(6); PG8_BAR; PG8_MMA(1, 1, At, B1); PG8_BAR;
            PG8_LDB(B0, 1, 0); PG8_SCHED; PG8_LDA(At, 1, 0); PG8_STAGE(PG8_SA(0, 1), a2 + hstepA, voffA);
            PG8_WAIT_L(8); PG8_BAR; PG8_WAIT_L(0); PG8_MMA(0, 0, At, B0); PG8_BAR; PG8_SCHED;
            PG8_LDB(B1, 1, 1); PG8_STAGE(PG8_SB(1, 0), b3, voffB);
            PG8_BAR; PG8_WAIT_L(0); PG8_MMA(0, 1, At, B1); PG8_BAR;
            PG8_LDA(At, 1, 1); PG8_STAGE(PG8_SA(1, 0), a3, voffA);
            PG8_BAR; PG8_WAIT_L(0); PG8_MMA(1, 0, At, B0); PG8_BAR; PG8_SCHED;
            PG8_STAGE(PG8_SB(1, 1), b3 + hstepB, voffB);
            PG8_WAIT_V(6); PG8_BAR; PG8_MMA(1, 1, At, B1); PG8_BAR;
            }
        }
        if constexpr (ALIGN_EPI) { if (wr == 0) PG8_BAR; }
        E(acc, cur, wr, wc, fr, fq); S.done(cur);
        if (!has_next) break;
#pragma unroll
        for (int a = 0; a < 2; ++a)
#pragma unroll
            for (int b = 0; b < 2; ++b)
#pragma unroll
                for (int m = 0; m < 4; ++m)
#pragma unroll
                    for (int n = 0; n < 2; ++n) acc[a][b][m][n] = (f32x4){0.f, 0.f, 0.f, 0.f};
        cur = nxt; cA = nA; cB = nB; ++ui;
        if constexpr (ALIGN_EPI) { if (wr == 1) PG8_BAR; }
    }
    PG8_WAIT_V(0);
    if constexpr (!ALIGN_EPI) { if (wr == 0) PG8_BAR; }
    PG8_BAR;
#undef PG8_SA
#undef PG8_SB
#undef PG8_STAGE
#undef PG8_LDA
#undef PG8_LDB
#undef PG8_MMA
#undef PG8_WAIT_V
#undef PG8_WAIT_L
#undef PG8_BAR
#undef PG8_SCHED
}
}

constexpr int NWAVES = 8, NTHR = 512;
constexpr int DM = 4096, NB = 2, SEQ = 8192, NCTX = 256, DFF = 16384;
constexpr int M_LAT = NB * SEQ, M_CTX = NB * NCTX, M_TOT = M_LAT + M_CTX;
constexpr int DIN = 8672, DINP = 8704;
constexpr int C_SWAQ = 0, C_SWAK = 1024, C_SWAV = 1280, C_LRUX = 1536, C_LRUY = 2560, C_QA = 3584, C_KVA = 4608, C_KR = 5120, C_RW = 5184;
constexpr int C_RWR = C_RW, C_RWK = C_RW + 1024, C_RWV = C_RW + 2048, C_RWL = C_RW + 3072;
constexpr int RWC = 3488;
constexpr float LN_EPS = 1e-5f, RMS_EPS = 1e-6f, GN_EPS = 64e-5f, ALPHA = 1.41421356237f;
constexpr int NCH = 264;

constexpr size_t MiB = 1u << 20;
constexpr size_t WS_CTL = 0, CTL_ZERO_BYTES = 1 * MiB;
constexpr size_t WS_MOD = 1 * MiB;
constexpr size_t WS_MODP = 2 * MiB;
constexpr size_t WS_SMALL = 20 * MiB;
constexpr size_t WS_RSQ = WS_SMALL;
constexpr size_t WS_RSKV = WS_RSQ + 128 * 1024;
constexpr size_t WS_SB = WS_RSKV + 128 * 1024;
constexpr size_t WS_CA = WS_SB + 2 * MiB;
constexpr size_t WS_CB = WS_CA + 5 * MiB;
constexpr size_t WS_HIN = WS_CB + 5 * MiB;
constexpr size_t WS_QUIRK = WS_HIN + 5 * MiB;
constexpr size_t WS_ROPE = WS_QUIRK + 8192;
static_assert(WS_ROPE + 16384 <= 40 * MiB, "small region");
constexpr size_t WS_W = 40 * MiB;
constexpr size_t WS_WIN = WS_W, WS_WOUT = WS_WIN + 68 * MiB, WS_WFF1 = WS_WOUT + 32 * MiB, WS_WFF2 = WS_WFF1 + 128 * MiB, WS_WQB = WS_WFF2 + 128 * MiB,
                 WS_WKVB = WS_WQB + 3 * MiB, WS_WLRU = WS_WKVB + 2 * MiB, WS_WLORA = WS_WLRU + 1 * MiB;
constexpr size_t WS_W2T = WS_WLORA, WS_A2T = WS_W2T + 256 * 1024, WS_G2T = WS_A2T + 256 * 1024;
constexpr size_t WS_X = 403 * MiB;
constexpr size_t WS_H = 667 * MiB;
constexpr size_t WS_MIX = 799 * MiB;
constexpr size_t WS_YS = 931 * MiB;
constexpr size_t WS_P = 1063 * MiB;
constexpr size_t WS_RWF = 1344 * MiB;
constexpr size_t RWF_STRIDE = (size_t)M_TOT * 1024 * 2;
constexpr size_t WS_Q = 1641 * MiB;
constexpr size_t WS_KV = 1691 * MiB;
constexpr size_t WS_KR = 1757 * MiB;
constexpr size_t WS_SET2 = 1760 * MiB;
constexpr size_t WSET_STRIDE = WS_SET2 - WS_W;
constexpr size_t WS_END = WS_SET2 + 363 * MiB;
constexpr size_t WS_YP = WS_Q;
constexpr size_t WS_HID = WS_P;
constexpr size_t WS_Y1 = WS_P;
constexpr size_t WS_Y2 = WS_MIX;
static_assert(WS_WLORA + 1 * MiB <= WS_X && WS_P + (size_t)M_TOT * DINP * 2 <= WS_RWF && WS_RWF + 9 * RWF_STRIDE <= WS_Q, "ws map");
static_assert(WS_HID + (size_t)M_TOT * DFF * 2 <= WS_Q && WS_Y2 + (size_t)M_TOT * DM * 4 <= WS_P && WS_YS + 2 * (size_t)M_TOT * 1024 * 4 <= WS_P, "ws overlays");
static_assert(WS_KR + (size_t)M_TOT * 64 * 2 <= WS_SET2 && WS_YP + 8 * (size_t)M_CTX * DM * 4 <= WS_KR, "ws end");

constexpr int RING_BYTES = 131072;
constexpr int LDSCTL_OFF = RING_BYTES, MISC_OFF = LDSCTL_OFF + 320;
constexpr int LDS_BYTES = 147456;

#define GAS __attribute__((address_space(1)))
#define LAS __attribute__((address_space(3)))
typedef unsigned short bf16;
typedef unsigned v4u __attribute__((ext_vector_type(4)));
typedef unsigned v2u __attribute__((ext_vector_type(2)));
typedef float f32x4 __attribute__((ext_vector_type(4)));
typedef float f32x2 __attribute__((ext_vector_type(2)));
typedef float f32x16 __attribute__((ext_vector_type(16)));
typedef short bf16x8 __attribute__((ext_vector_type(8)));
typedef short s16x4 __attribute__((ext_vector_type(4)));
typedef GAS unsigned gu32;
typedef const GAS bf16* gcbf; typedef GAS bf16* gbfp; typedef const GAS float* gcfl; typedef GAS float* gflp;
#define LDS_WAIT() asm volatile("s_waitcnt lgkmcnt(0)" ::: "memory")
#define VM_WAIT() asm volatile("s_waitcnt vmcnt(0)" ::: "memory")
typedef __bf16 bf16x2_t __attribute__((ext_vector_type(2)));
__device__ __forceinline__ unsigned pk2(float lo, float hi) { const f32x2 v = {lo, hi}; const bf16x2_t b = __builtin_convertvector(v, bf16x2_t); return __builtin_bit_cast(unsigned, b); }
__device__ __forceinline__ unsigned f2bf(float f) { return pk2(f, f) & 0xffffu; }
__device__ __forceinline__ float bflo(unsigned w) { return __builtin_bit_cast(float, w << 16); }
__device__ __forceinline__ float bfhi(unsigned w) { return __builtin_bit_cast(float, w & 0xffff0000u); }
__device__ __forceinline__ float bf2f(bf16 h) { return __builtin_bit_cast(float, (unsigned)h << 16); }
#define DPP_ADD(x, ctrl) ((x) + __builtin_bit_cast(float, __builtin_amdgcn_update_dpp(0, __builtin_bit_cast(int, (x)), (ctrl), 0xf, 0xf, false)))
__device__ __forceinline__ float row_sum16(float x) { x = DPP_ADD(x, 0x128); x = DPP_ADD(x, 0x124); x = DPP_ADD(x, 0x122); x = DPP_ADD(x, 0x121); return x; }
#ifdef OLD_SUMS
__device__ __forceinline__ float wave_sum(float v) {
#pragma unroll
    for (int o = 1; o < 64; o <<= 1) v += __shfl_xor(v, o);
    return v;
}
__device__ __forceinline__ float half_swap_sum(float x) { return x + __shfl_xor(x, 32); }
__device__ __forceinline__ float quad_sum(float x) { x += __shfl_xor(x, 1); x += __shfl_xor(x, 2); return x; }
#else
__device__ __forceinline__ float wave_sum(float v) {
    const float r = row_sum16(v);
    const float a = __builtin_bit_cast(float, __builtin_amdgcn_readlane(__builtin_bit_cast(int, r), 0)), b = __builtin_bit_cast(float, __builtin_amdgcn_readlane(__builtin_bit_cast(int, r), 16));
    const float c = __builtin_bit_cast(float, __builtin_amdgcn_readlane(__builtin_bit_cast(int, r), 32)), d = __builtin_bit_cast(float, __builtin_amdgcn_readlane(__builtin_bit_cast(int, r), 48));
    return (a + b) + (c + d);
}
__device__ __forceinline__ float half_swap_sum(float x) {
    unsigned a = __builtin_bit_cast(unsigned, x), b = a; asm volatile("" : "+v"(b));
    auto rr = __builtin_amdgcn_permlane32_swap(a, b, false, false);
    const float lo = __uint_as_float(rr[0]), hi = __uint_as_float(rr[1]); return lo + hi;
}
__device__ __forceinline__ float quad_sum(float x) { x = DPP_ADD(x, 0xB1); x = DPP_ADD(x, 0x4E); return x; }
#endif
__device__ __forceinline__ float sigmoidf_(float x) { return __builtin_amdgcn_rcpf(1.f + __expf(-x)); }
__device__ __forceinline__ float softplusf_(float x) { return x > 20.f ? x : __logf(1.f + __expf(x)); }
__device__ __forceinline__ float tanhf_(float x) { const float e = __expf(2.f * x); return 1.f - 2.f * __builtin_amdgcn_rcpf(e + 1.f); }
__device__ __forceinline__ int ltid() { int t = threadIdx.x; asm volatile("" : "+v"(t)); return t; }
template <class T> __device__ __forceinline__ T ldg(const void* base, unsigned byteoff) { return *(const T*)((const char*)base + byteoff); }
template <class T> __device__ __forceinline__ void stg(void* base, unsigned byteoff, T v) { *(T*)((char*)base + byteoff) = v; }

#define XB_TMO      128
#define XB_XCNT(j)  (256  + 64 * (j))
#define XB_XSUB(j)  (1280 + 64 * (j))
#define XB_XGEN(j)  (2304 + 64 * (j))
#define XB_TOP      3328
#define XB_TOPGEN   3392
#define XCD_BAR_WORDS 3456
#define XB_SPIN_CAP (1u << 18)

__device__ __forceinline__ unsigned xb_ld(unsigned* p)              { return __hip_atomic_load(p, __ATOMIC_RELAXED, __HIP_MEMORY_SCOPE_AGENT); }
__device__ __forceinline__ unsigned xb_add(unsigned* p, unsigned v) { return __hip_atomic_fetch_add(p, v, __ATOMIC_RELAXED, __HIP_MEMORY_SCOPE_AGENT); }
__device__ __forceinline__ unsigned xb_xcc_id() { return (unsigned)__builtin_amdgcn_s_getreg((3 << 11) | 20) & 0xFu; }
#define XB_SPIN(cond, bar) do { unsigned _sp = 0; while (cond) { __builtin_amdgcn_s_sleep(1); \
    if ((++_sp & 255u) == 0u) { if (xb_ld(&(bar)[XB_TMO])) break; if (_sp > XB_SPIN_CAP) { atomicAdd(&(bar)[XB_TMO], 1u); break; } } } } while (0)

struct XcdBarrier {
    unsigned* bar; unsigned x;
    unsigned nparts;
    volatile LAS unsigned* st;
};

__device__ __forceinline__ XcdBarrier xcd_barrier_post(unsigned* bar, volatile LAS unsigned* st) {
    XcdBarrier b; b.bar = bar; b.x = xb_xcc_id(); b.st = st; b.nparts = 0u;
    if (threadIdx.x == 0) (void)xb_add(&bar[XB_XCNT(b.x)], 1u);
    return b;
}
__device__ __forceinline__ void xcd_barrier_complete(unsigned* bar, unsigned x, unsigned& nloc, unsigned& nx, unsigned nparts) {
    const unsigned G = nparts ? nparts : gridDim.x * gridDim.y * gridDim.z;
    unsigned sum, cnt, mine, sp = 0u;
    for (;;) {
        sum = 0u; cnt = 0u; mine = 0u;
#pragma unroll
        for (unsigned j = 0; j < 16; ++j) { const unsigned c = xb_ld(&bar[XB_XCNT(j)]); sum += c; cnt += (c > 0u) ? 1u : 0u; mine = (j == x) ? c : mine; }
        if (sum == G) break;
        __builtin_amdgcn_s_sleep(1);
        if ((++sp & 255u) == 0u) { if (xb_ld(&bar[XB_TMO])) break; if (sp > XB_SPIN_CAP) { atomicAdd(&bar[XB_TMO], 1u); break; } }
    }
    nloc = mine > 0u ? mine : 1u; nx = cnt > 0u ? cnt : 1u;
}

__device__ __forceinline__ void xcd_barrier(const XcdBarrier& b) {
    asm volatile("s_waitcnt vmcnt(0)" ::: "memory");
    __syncthreads();
    if (threadIdx.x == 0) {
        unsigned* bar = b.bar;
        __builtin_amdgcn_s_waitcnt(0);
        unsigned nloc = b.st[0], nx = b.st[1];
        if (nloc == 0u) { xcd_barrier_complete(bar, b.x, nloc, nx, b.nparts); b.st[0] = nloc; b.st[1] = nx; }
        const unsigned old = xb_add(&bar[XB_XSUB(b.x)], 1u);
        const unsigned gen = old / nloc;
        if (old + 1u == (gen + 1u) * nloc) {
            __builtin_amdgcn_fence(__ATOMIC_RELEASE, "agent");
            asm volatile("s_waitcnt vmcnt(0)" ::: "memory");
            const unsigned og = xb_add(&bar[XB_TOP], 1u);
            const unsigned tg = og / nx;
            if (og + 1u == (tg + 1u) * nx) xb_add(&bar[XB_TOPGEN], 1u);
            else XB_SPIN(xb_ld(&bar[XB_TOPGEN]) == tg, bar);
            __builtin_amdgcn_fence(__ATOMIC_ACQUIRE, "agent");
            xb_add(&bar[XB_XGEN(b.x)], 1u);
            asm volatile("s_waitcnt vmcnt(0)" ::: "memory");
        } else {
            XB_SPIN(xb_ld(&bar[XB_XGEN(b.x)]) == gen, bar);
            __builtin_amdgcn_fence(__ATOMIC_ACQUIRE, "agent");
            asm volatile("s_waitcnt vmcnt(0)" ::: "memory");
        }
    }
    __syncthreads();
}


namespace att {
constexpr int KVBLK = 64;
constexpr float THR = 8.f;
#define SBAR() __builtin_amdgcn_sched_barrier(0)
__device__ __forceinline__ int crow(int r, int hi) { return (r & 3) + 8 * (r >> 2) + 4 * hi; }
__device__ __forceinline__ unsigned cvtpk(float lo, float hi) { return pk2(lo, hi); }
template <int DQK> __device__ __forceinline__ int kswz(int row, int cb) { return row * (DQK * 2 + 16) + cb; }

template <int DQK> __device__ __forceinline__ void partialSM(f32x16& p0, f32x16& p1, float& m_reg, float& mn, float& alpha) {
  constexpr float SCALE = DQK == 128 ? 0.088388347648318440f : 0.072168783648703220f;
  constexpr float C = SCALE * 1.4426950408889634f;
  float pmax = p0[0];
#pragma unroll
  for (int r = 1; r < 16; ++r) pmax = fmaxf(pmax, p0[r]);
#pragma unroll
  for (int r = 0; r < 16; ++r) pmax = fmaxf(pmax, p1[r]);
  { auto rr = __builtin_amdgcn_permlane32_swap(__float_as_uint(pmax), __float_as_uint(pmax), false, false);
    pmax = fmaxf(__uint_as_float(rr[0]), __uint_as_float(rr[1])); }
  if (__builtin_expect(__all(pmax - m_reg <= THR / SCALE), 1)) { mn = m_reg; alpha = 1.f; }
  else { mn = fmaxf(m_reg, pmax); alpha = __builtin_amdgcn_exp2f((m_reg - mn) * C); m_reg = mn; }
  const float mnC = -mn * C;
#pragma unroll
  for (int r = 0; r < 16; ++r) p0[r] = fmaf(p0[r], C, mnC);
#pragma unroll
  for (int r = 0; r < 16; ++r) p1[r] = fmaf(p1[r], C, mnC);
#pragma unroll
  for (int r = 0; r < 16; ++r) p0[r] = __builtin_amdgcn_exp2f(p0[r]);
}
__device__ __forceinline__ void finishSM(f32x16& p0, f32x16& p1, float alpha, float& l_reg, bf16x8& pa0, bf16x8& pa1, bf16x8& pa2, bf16x8& pa3) {
#pragma unroll
  for (int r = 0; r < 16; ++r) p1[r] = __builtin_amdgcn_exp2f(p1[r]);
  float ps = 0;
#pragma unroll
  for (int r = 0; r < 16; ++r) ps += p0[r];
#pragma unroll
  for (int r = 0; r < 16; ++r) ps += p1[r];
  { auto rr = __builtin_amdgcn_permlane32_swap(__float_as_uint(ps), __float_as_uint(ps), false, false);
    ps = __uint_as_float(rr[0]) + __uint_as_float(rr[1]); }
  l_reg = l_reg * alpha + ps;
#define PK4(P, BASE, OUT) do { unsigned a0 = cvtpk(P[BASE + 0], P[BASE + 1]), a1 = cvtpk(P[BASE + 2], P[BASE + 3]);   \
    unsigned b0 = cvtpk(P[BASE + 4], P[BASE + 5]), b1 = cvtpk(P[BASE + 6], P[BASE + 7]);                              \
    auto r0 = __builtin_amdgcn_permlane32_swap(a0, b0, false, false); auto r1 = __builtin_amdgcn_permlane32_swap(a1, b1, false, false); \
    v4u w = {r0[0], r1[0], r0[1], r1[1]}; OUT = __builtin_bit_cast(bf16x8, w); } while (0)
  PK4(p0, 0, pa0); PK4(p0, 8, pa1); PK4(p1, 0, pa2); PK4(p1, 8, pa3);
#undef PK4
}
template <int DQK> __device__ __forceinline__ void qkt(f32x16& p0, f32x16& p1, const LAS char* Ks, const bf16x8* qr, const LAS char* qx, int r32, int hi) {
  p0 = f32x16{}; p1 = f32x16{};
#pragma unroll
  for (int d0 = 0; d0 < DQK / 16; ++d0) { const int cb = (d0 * 16 + hi * 8) * 2;
    bf16x8 b0 = *(const LAS bf16x8*)(Ks + kswz<DQK>(r32, cb));
    bf16x8 b1 = *(const LAS bf16x8*)(Ks + kswz<DQK>(32 + r32, cb));
    bf16x8 q; if (d0 < 8) q = qr[d0]; else q = *(const LAS bf16x8*)(qx + (d0 - 8) * 32);
    p0 = __builtin_amdgcn_mfma_f32_32x32x16_bf16(b0, q, p0, 0, 0, 0);
    p1 = __builtin_amdgcn_mfma_f32_32x32x16_bf16(b1, q, p1, 0, 0, 0);
    if ((d0 & 3) == 3 && d0 + 1 < DQK / 16) SBAR(); }
}
__device__ __forceinline__ int v_st(int k, int c) { const int kk = (k & ~0xC) | ((k & 4) << 1) | ((k & 8) >> 1); return ((kk >> 3) * 4 + (c >> 5)) * 512 + ((kk & 7) * 32 + (c & 31)) * 2; }
__device__ __forceinline__ int v_rd_base(int lane) { return ((lane & 3) << 3) | (((lane >> 2) & 3) << 6) | (((lane >> 4) & 1) << 5) | (((lane >> 5) & 1) << 8); }
constexpr int v_rd_off(int d0, int ks, int half) { return d0 * 512 + ks * 4096 + half * 2048; }
template <int OFF> __device__ __forceinline__ s16x4 tr_read(int vb) {
  s16x4 r; asm volatile("ds_read_b64_tr_b16 %0, %1 offset:%2" : "=&v"(r) : "v"(vb), "i"(OFF) : "memory"); return r;
}
template <int D0> __device__ __forceinline__ void pv_one(f32x16& od, int vb, bf16x8 pa0, bf16x8 pa1, bf16x8 pa2, bf16x8 pa3) {
  const s16x4 l0 = tr_read<v_rd_off(D0, 0, 0)>(vb), h0 = tr_read<v_rd_off(D0, 0, 1)>(vb), l1 = tr_read<v_rd_off(D0, 1, 0)>(vb), h1 = tr_read<v_rd_off(D0, 1, 1)>(vb);
  const s16x4 l2 = tr_read<v_rd_off(D0, 2, 0)>(vb), h2 = tr_read<v_rd_off(D0, 2, 1)>(vb), l3 = tr_read<v_rd_off(D0, 3, 0)>(vb), h3 = tr_read<v_rd_off(D0, 3, 1)>(vb);
  asm volatile("s_waitcnt lgkmcnt(0)" ::: "memory"); SBAR();
#define PK(L, H) (bf16x8){L[0], L[1], L[2], L[3], H[0], H[1], H[2], H[3]}
  od = __builtin_amdgcn_mfma_f32_32x32x16_bf16(pa0, PK(l0, h0), od, 0, 0, 0);
  od = __builtin_amdgcn_mfma_f32_32x32x16_bf16(pa1, PK(l1, h1), od, 0, 0, 0);
  od = __builtin_amdgcn_mfma_f32_32x32x16_bf16(pa2, PK(l2, h2), od, 0, 0, 0);
  od = __builtin_amdgcn_mfma_f32_32x32x16_bf16(pa3, PK(l3, h3), od, 0, 0, 0);
#undef PK
}
__device__ __forceinline__ void pv_d0(f32x16* o, int vb, bf16x8 pa0, bf16x8 pa1, bf16x8 pa2, bf16x8 pa3) {
  pv_one<0>(o[0], vb, pa0, pa1, pa2, pa3); pv_one<1>(o[1], vb, pa0, pa1, pa2, pa3); pv_one<2>(o[2], vb, pa0, pa1, pa2, pa3); pv_one<3>(o[3], vb, pa0, pa1, pa2, pa3);
}
__device__ __forceinline__ void apply_mask(f32x16& p0, f32x16& p1, int mtype, int krel0, int qi, int hi) {
  if (mtype == 0) return;
  const float ninf = -__builtin_inff();
#pragma unroll
  for (int r = 0; r < 16; ++r) { const int k0 = krel0 + crow(r, hi), k1 = k0 + 32;
    const bool ok0 = (mtype == 1) ? (k0 >= qi - 128) : (k0 <= qi + 128), ok1 = (mtype == 1) ? (k1 >= qi - 128) : (k1 <= qi + 128);
    p0[r] = ok0 ? p0[r] : ninf; p1[r] = ok1 ? p1[r] : ninf; }
}
struct Tile { gcbf kn; gcbf kr; gcbf v; int mtype; int krel0; };

__device__ __forceinline__ void rope_pair(bf16x8& a, bf16x8& b, gcfl ct, gcfl st) {
  const f32x4 c0 = *(const GAS f32x4*)ct, c1 = *(const GAS f32x4*)(ct + 4), s0 = *(const GAS f32x4*)st, s1 = *(const GAS f32x4*)(st + 4);
  const float cs[8] = {c0[0], c0[1], c0[2], c0[3], c1[0], c1[1], c1[2], c1[3]}, sn[8] = {s0[0], s0[1], s0[2], s0[3], s1[0], s1[1], s1[2], s1[3]};
  v4u ua = __builtin_bit_cast(v4u, a), ub = __builtin_bit_cast(v4u, b); v4u oa, ob;
#pragma unroll
  for (int w = 0; w < 4; ++w) { const float x1[2] = {bflo(ua[w]), bfhi(ua[w])}, x2[2] = {bflo(ub[w]), bfhi(ub[w])}; float y1[2], y2[2];
#pragma unroll
    for (int e = 0; e < 2; ++e) { const float c = cs[2 * w + e], sv = sn[2 * w + e]; y1[e] = x1[e] * c - x2[e] * sv; y2[e] = x2[e] * c + x1[e] * sv; }
    oa[w] = pk2(y1[0], y1[1]); ob[w] = pk2(y2[0], y2[1]); }
  a = __builtin_bit_cast(bf16x8, oa); b = __builtin_bit_cast(bf16x8, ob);
}

template <int DQK, int LDKN, int LDV, bool MASK, bool SINK, int SDEPTH, class TS>
__device__ __forceinline__ void attn_body(gcbf Qw, int rope, int prow, int pcol, gcfl rtab, int qi, float sink_l2, const TS& ts, int NT, gbfp Ow, LAS char* lds) {
  constexpr float SCALE = DQK == 128 ? 0.088388347648318440f : 0.072168783648703220f;
  constexpr float C = SCALE * 1.4426950408889634f;
  constexpr int SHM_K = KVBLK * (DQK * 2 + 16), SHM_V = KVBLK * 128 * 2;
  int tid = threadIdx.x; asm volatile("" : "+v"(tid));
  const int wid = tid >> 6, lane = tid & 63, r32 = lane & 31, hi = lane >> 5;
  LAS char* V_lds = lds; LAS char* K_lds = lds + 2 * SHM_V;
  LAS float* wsl = (LAS float*)(lds + 2 * SHM_V + 2 * SHM_K) + wid * 64; LAS float* li_l = wsl; LAS float* al_l = wsl + 32;
  float m_reg = -1e30f, l_reg = 0; f32x16 o[4] = {}; bf16x8 qr[8];
#pragma unroll
  for (int d0 = 0; d0 < 8; ++d0) qr[d0] = *(const GAS bf16x8*)(Qw + d0 * 16 + hi * 8);
  const LAS char* qx = lds + 2 * SHM_V + 2 * SHM_K + 2048 + wid * 4608 + r32 * 144 + hi * 16;
  if constexpr (DQK == 192) {
    bf16x8 x0 = *(const GAS bf16x8*)(Qw + 128 + hi * 8), x1 = *(const GAS bf16x8*)(Qw + 144 + hi * 8), x2 = *(const GAS bf16x8*)(Qw + 160 + hi * 8), x3 = *(const GAS bf16x8*)(Qw + 176 + hi * 8);
    if (rope) {
      rope_pair(x0, x1, rtab + (size_t)prow * 16 + hi * 8, rtab + 2048 + (size_t)prow * 16 + hi * 8);
      rope_pair(x2, x3, rtab + (size_t)pcol * 16 + hi * 8, rtab + 2048 + (size_t)pcol * 16 + hi * 8); }
    LAS char* qw_ = (LAS char*)qx; *(LAS bf16x8*)(qw_) = x0; *(LAS bf16x8*)(qw_ + 32) = x1; *(LAS bf16x8*)(qw_ + 64) = x2; *(LAS bf16x8*)(qw_ + 96) = x3;
  }
  const int sr = tid >> 4, sc = (tid & 15) * 8, vst0 = v_st(sr, sc), vst1 = v_st(32 + sr, sc);
  const int rr_ = tid >> 3, rc_ = (tid & 7) * 8;
  const int vb0 = (int)(uintptr_t)V_lds + v_rd_base(lane);
  struct { bf16x8 vs0, vs1, ks0, ks1, kx; } sr_[SDEPTH];
#define SLOAD(i, jt) do { const Tile t_ = ts(jt); sr_[i].vs0 = *(const GAS bf16x8*)(t_.v + (size_t)sr * LDV + sc); sr_[i].vs1 = *(const GAS bf16x8*)(t_.v + (size_t)(32 + sr) * LDV + sc); \
    sr_[i].ks0 = *(const GAS bf16x8*)(t_.kn + (size_t)sr * LDKN + sc); sr_[i].ks1 = *(const GAS bf16x8*)(t_.kn + (size_t)(32 + sr) * LDKN + sc); \
    if constexpr (DQK == 192) sr_[i].kx = *(const GAS bf16x8*)(t_.kr + (size_t)rr_ * 64 + rc_); } while (0)
#define SWRITE(b, i) do { *(LAS bf16x8*)(V_lds + (b) * SHM_V + vst0) = sr_[i].vs0; *(LAS bf16x8*)(V_lds + (b) * SHM_V + vst1) = sr_[i].vs1; const int kc = sc * 2; \
    *(LAS bf16x8*)(K_lds + (b) * SHM_K + kswz<DQK>(sr, kc)) = sr_[i].ks0; *(LAS bf16x8*)(K_lds + (b) * SHM_K + kswz<DQK>(32 + sr, kc)) = sr_[i].ks1; \
    if constexpr (DQK == 192) *(LAS bf16x8*)(K_lds + (b) * SHM_K + kswz<DQK>(rr_, 256 + rc_ * 2)) = sr_[i].kx; } while (0)
#define SWAIT() do { if constexpr (SDEPTH == 2) { if constexpr (DQK == 192) asm volatile("s_waitcnt vmcnt(5)" ::: "memory"); else asm volatile("s_waitcnt vmcnt(4)" ::: "memory"); } \
    else asm volatile("s_waitcnt vmcnt(0)" ::: "memory"); } while (0)
#define RESC(a) do { if (__any((a) < 1.f)) { if (hi == 0) al_l[r32] = (a); asm volatile("s_waitcnt lgkmcnt(0)" ::: "memory"); \
    _Pragma("unroll") for (int d = 0; d < 4; ++d) _Pragma("unroll") for (int r = 0; r < 16; ++r) o[d][r] *= al_l[crow(r, hi)]; } } while (0)
#define MASKT(pa_, pb_, jt) do { if constexpr (MASK) { const Tile t_ = ts(jt); apply_mask(pa_, pb_, t_.mtype, t_.krel0, qi, hi); } } while (0)
  f32x16 pA0, pA1, pB0, pB1; float mnA, mnB, alA, alB; bf16x8 pa0, pa1, pa2, pa3;
  constexpr int SE = 0, SO = SDEPTH - 1;
  SLOAD(SE, 0); asm volatile("s_waitcnt vmcnt(0)" ::: "memory"); SWRITE(0, SE); __syncthreads();
  qkt<DQK>(pA0, pA1, K_lds, qr, qx, r32, hi); MASKT(pA0, pA1, 0); partialSM<DQK>(pA0, pA1, m_reg, mnA, alA);
  SLOAD(SO, 1); if constexpr (SDEPTH == 2) { if (2 < NT) SLOAD(SE, 2); }
  SWAIT(); SWRITE(1, SO); __syncthreads();
  for (int j = 1; j + 1 < NT; j += 2) {
    SBAR(); qkt<DQK>(pB0, pB1, K_lds + SHM_K, qr, qx, r32, hi); MASKT(pB0, pB1, j);
    finishSM(pA0, pA1, alA, l_reg, pa0, pa1, pa2, pa3); SBAR();
    SLOAD(SO, j + SDEPTH); SBAR();
    pv_d0(o, vb0, pa0, pa1, pa2, pa3); partialSM<DQK>(pB0, pB1, m_reg, mnB, alB);
    __syncthreads(); SWAIT(); SWRITE(0, SE);
    RESC(alB); __syncthreads();
    SBAR(); qkt<DQK>(pA0, pA1, K_lds, qr, qx, r32, hi); MASKT(pA0, pA1, j + 1);
    finishSM(pB0, pB1, alB, l_reg, pa0, pa1, pa2, pa3); SBAR();
    if (SDEPTH == 1 || j + 3 < NT) SLOAD(SE, j + 1 + SDEPTH); SBAR();
    pv_d0(o, vb0 + SHM_V, pa0, pa1, pa2, pa3); partialSM<DQK>(pA0, pA1, m_reg, mnA, alA);
    __syncthreads(); SWAIT(); SWRITE(1, SO);
    RESC(alA); __syncthreads();
  }
  SBAR(); qkt<DQK>(pB0, pB1, K_lds + SHM_K, qr, qx, r32, hi); MASKT(pB0, pB1, NT - 1);
  finishSM(pA0, pA1, alA, l_reg, pa0, pa1, pa2, pa3); SBAR();
  pv_d0(o, vb0, pa0, pa1, pa2, pa3); partialSM<DQK>(pB0, pB1, m_reg, mnB, alB);
  __syncthreads(); RESC(alB);
  finishSM(pB0, pB1, alB, l_reg, pa0, pa1, pa2, pa3); SBAR();
  pv_d0(o, vb0 + SHM_V, pa0, pa1, pa2, pa3);
  if constexpr (SINK) l_reg += __builtin_amdgcn_exp2f(sink_l2 - m_reg * C);
  if (hi == 0) li_l[r32] = l_reg; asm volatile("s_waitcnt lgkmcnt(0)" ::: "memory");
  float rli[16];
#pragma unroll
  for (int r = 0; r < 16; ++r) rli[r] = __builtin_amdgcn_rcpf(li_l[crow(r, hi)]);
  __syncthreads();
  LAS bf16* ost = (LAS bf16*)(lds + wid * 8704);
#pragma unroll
  for (int r = 0; r < 16; ++r) { const int orow = crow(r, hi);
#pragma unroll
    for (int d0 = 0; d0 < 4; ++d0) ost[orow * 136 + d0 * 32 + r32] = (bf16)f2bf(o[d0][r] * rli[r]); }
  asm volatile("s_waitcnt lgkmcnt(0)" ::: "memory");
#pragma unroll
  for (int i = 0; i < 8; ++i) { const int orow = i * 4 + (lane >> 4), ch = lane & 15;
    *(GAS v4u*)(Ow + (size_t)orow * 4096 + ch * 8) = *(const LAS v4u*)(ost + orow * 136 + ch * 8); }
  __syncthreads();
#undef SLOAD
#undef SWRITE
#undef SWAIT
#undef RESC
#undef MASKT
}
}

struct Args { const float* in[38]; float* out; unsigned char* ws; };
template <class T> __device__ __forceinline__ T launder(T p) { asm volatile("" : "+s"(p)); return p; }
template <class T> __device__ __forceinline__ T* launder_g(T* p) { asm volatile("" : "+s"(p)); return p; }
struct Frame {
    LAS unsigned char* lds;
    gu32* ctl;
    int tid, lane, wave;
    int vcu, G, gw, NGW;
    const __attribute__((address_space(4))) Args* A;
    float* out;
    unsigned char* ws;
    unsigned char* wsw;
};
enum { I_X = 0, I_C, I_CTX, I_CCTX, I_WMOD, I_BMOD, I_WIN, I_WOUT, I_LN1G, I_LN1B, I_WFF1, I_WFF2, I_LN2G, I_LN2B, I_SINK, I_CONVW, I_CONVB, I_LWA, I_LBA, I_LWI, I_LBI, I_LAM,
       I_QNORM, I_KVNORM, I_WQB, I_WKVB, I_MUP, I_MUN, I_W0, I_W2, I_A0, I_A2, I_G2, I_KK, I_KA, I_RK, I_LNG, I_LNB };
__device__ __forceinline__ int row_s(int row) { return row < SEQ ? 0 : (row < M_LAT ? 1 : 2); }
__device__ __forceinline__ const float* mod_ptr(const Frame& F, int l, int s, int chunk) { return (const float*)(F.ws + WS_MOD) + ((size_t)(l * 3 + s) * 6 + chunk) * DM; }

__device__ __forceinline__ void transpose_item(const float* W, int N, int Kvalid, bf16* WT, int ldt, const float* kscale, LAS float* scr, int k0, int n0, int lane) {
    { const int kr = lane >> 3, c4 = (lane & 7) * 4;
#pragma unroll
      for (int i = 0; i < 8; ++i) { const int kk = 8 * i + kr, k = k0 + kk; f32x4 v = {0.f, 0.f, 0.f, 0.f};
          if (k < Kvalid) { v = *(const f32x4*)(W + (size_t)k * N + n0 + c4); if (kscale) v = v * kscale[k]; }
          scr[kk * 33 + c4] = v.x; scr[kk * 33 + c4 + 1] = v.y; scr[kk * 33 + c4 + 2] = v.z; scr[kk * 33 + c4 + 3] = v.w; } }
    LDS_WAIT(); asm volatile("" ::: "memory");
    const int c = lane & 7;
#pragma unroll
    for (int j = 0; j < 4; ++j) { const int n = (lane >> 3) + 8 * j; const LAS float* s = scr + (8 * c) * 33 + n;
        v4u o; o.x = pk2(s[0 * 33], s[1 * 33]); o.y = pk2(s[2 * 33], s[3 * 33]); o.z = pk2(s[4 * 33], s[5 * 33]); o.w = pk2(s[6 * 33], s[7 * 33]);
        *(v4u*)(WT + (size_t)(n0 + n) * ldt + k0 + 8 * c) = o; }
    LDS_WAIT(); asm volatile("" ::: "memory");
}
__device__ __forceinline__ void convert_weights(Frame& F, int l, int widx, int nw) {
    LAS float* scr = (LAS float*)(F.lds + F.wave * 16384);
    constexpr int I1 = 64 * 271, I2 = 64 * 128, I3 = 64 * 512, I4 = 256 * 128, I5 = 16 * 48, I6 = 8 * 64, I7 = 32 * 8, I8 = 2 * 32, I9 = 2 * 32, I10 = 3 * 32;
    constexpr int NIT = I1 + I2 + I3 + I4 + I5 + I6 + I7 + I8 + I9 + I10;
    unsigned char* ws = F.ws + (l ? WSET_STRIDE : 0);
    for (int it = widx; it < NIT; it += nw) {
        int r = it;
        if (r < I1) { transpose_item(F.A->in[I_WIN] + (size_t)l * DM * DIN, DIN, DM, (bf16*)(ws + WS_WIN), DM, nullptr, scr, 64 * (r / 271), 32 * (r % 271), F.lane); continue; } r -= I1;
        if (r < I2) { transpose_item(F.A->in[I_WOUT] + (size_t)l * DM * DM, DM, DM, (bf16*)(ws + WS_WOUT), DM, nullptr, scr, 64 * (r / 128), 32 * (r % 128), F.lane); continue; } r -= I2;
        if (r < I3) { transpose_item(F.A->in[I_WFF1] + (size_t)l * DM * DFF, DFF, DM, (bf16*)(ws + WS_WFF1), DM, nullptr, scr, 64 * (r / 512), 32 * (r % 512), F.lane); continue; } r -= I3;
        if (r < I4) { transpose_item(F.A->in[I_WFF2] + (size_t)l * DFF * DM, DM, DFF, (bf16*)(ws + WS_WFF2), DFF, nullptr, scr, 64 * (r / 128), 32 * (r % 128), F.lane); continue; } r -= I4;
        if (r < I5) { transpose_item(F.A->in[I_WQB] + (size_t)l * 1024 * 1536, 1536, 1024, (bf16*)(ws + WS_WQB), 1024, F.A->in[I_QNORM] + l * 1024, scr, 64 * (r / 48), 32 * (r % 48), F.lane); continue; } r -= I5;
        if (r < I6) { transpose_item(F.A->in[I_WKVB] + (size_t)l * 512 * 2048, 2048, 512, (bf16*)(ws + WS_WKVB), 512, F.A->in[I_KVNORM] + l * 512, scr, 64 * (r / 64), 32 * (r % 64), F.lane); continue; } r -= I6;
        if (r < I7) { const int mat = r >> 3, sub = r & 7, gate = mat & 1, dn = mat >> 1;
            const int d = dn >> 3, n = dn & 7;
            const float* src = (gate ? F.A->in[I_LWI] : F.A->in[I_LWA]) + ((size_t)(l * 2 + d) * 8 + n) * 128 * 128;
            bf16* dst = (bf16*)(ws + WS_WLRU) + ((size_t)(d * 2 + gate) * 8 + n) * 128 * 128;
            transpose_item(src, 128, 128, dst, 128, nullptr, scr, 64 * (sub >> 2), 32 * (sub & 3), F.lane); continue; } r -= I7;
        if (r < I8) { const int d = r >> 5; transpose_item(F.A->in[I_W2] + (size_t)(l * 2 + d) * 64 * 1024, 1024, 64, (bf16*)(ws + WS_W2T) + (size_t)d * 1024 * 64, 64, nullptr, scr, 0, 32 * (r & 31), F.lane); continue; } r -= I8;
        if (r < I9) { const int d = r >> 5; transpose_item(F.A->in[I_A2] + (size_t)(l * 2 + d) * 64 * 1024, 1024, 64, (bf16*)(ws + WS_A2T) + (size_t)d * 1024 * 64, 64, nullptr, scr, 0, 32 * (r & 31), F.lane); continue; } r -= I9;
        transpose_item(F.A->in[I_G2] + (size_t)l * 160 * 1024, 1024, 160, (bf16*)(ws + WS_G2T), 192, nullptr, scr, 64 * (r / 32), 32 * (r % 32), F.lane);
    }
    { unsigned zz = 0u; asm volatile("" : "+v"(zz)); v4u z = {zz, zz, zz, zz}; v4u* p = (v4u*)((bf16*)(ws + WS_WIN) + (size_t)DIN * DM);
      for (int i = widx * 64 + F.lane; i < 32 * DM / 8; i += nw * 64) p[i] = z; }
}

__device__ __forceinline__ void mod_partials(Frame& F) {
    LAS float* sl = (LAS float*)F.lds;
    for (int it = F.vcu; it < 2 * 32 * 12; it += F.G) {
        const int l = it / 384, ks = (it / 12) % 32, cc = it % 12;
        __syncthreads();
        if (F.tid < 384) { const int s = F.tid >> 7, k = ks * 128 + (F.tid & 127); const float c = s < 2 ? F.A->in[I_C][s * DM + k] : F.A->in[I_CCTX][k]; sl[F.tid] = c / (1.f + __expf(-c)); }
        __syncthreads();
        const float* wp = F.A->in[I_WMOD] + ((size_t)l * DM + ks * 128) * 24576 + cc * 2048 + F.tid * 4;
        f32x4 a0 = {0.f, 0.f, 0.f, 0.f}, a1 = a0, a2 = a0;
#pragma unroll 8
        for (int k = 0; k < 128; ++k) { const f32x4 w = *(const f32x4*)(wp + (size_t)k * 24576); a0 += w * sl[k]; a1 += w * sl[128 + k]; a2 += w * sl[256 + k]; }
        float* op = (float*)(F.ws + WS_MODP) + ((size_t)(l * 32 + ks) * 3) * 24576 + cc * 2048 + F.tid * 4;
        *(f32x4*)(op) = a0; *(f32x4*)(op + 24576) = a1; *(f32x4*)(op + 2 * 24576) = a2;
    }
    __syncthreads();
}
__device__ __forceinline__ void mod_reduce(Frame& F) {
    for (int i = F.vcu * NTHR + F.tid; i < 2 * 3 * 24576; i += F.G * NTHR) {
        const int l = i / (3 * 24576), s = (i / 24576) % 3, n = i % 24576;
        float a = F.A->in[I_BMOD][l * 24576 + n];
        const float* pp = (const float*)(F.ws + WS_MODP) + ((size_t)(l * 32) * 3 + s) * 24576 + n;
#pragma unroll 8
        for (int ks = 0; ks < 32; ++ks) a += pp[(size_t)ks * 3 * 24576];
        ((float*)(F.ws + WS_MOD))[i] = a;
    }
}

__device__ __forceinline__ void sum_partials_row(const Frame& F, const float* yp, size_t stride, bf16* ydst) {
    int lane = F.lane; asm volatile("" : "+v"(lane));
#pragma unroll 2
    for (int j = 0; j < 16; ++j) { const int c = 4 * lane + 256 * j; f32x4 y = *(const f32x4*)(yp + c);
#pragma unroll
        for (int sp = 1; sp < 8; ++sp) y += *(const f32x4*)(yp + sp * stride + c);
        v2u w; w.x = pk2(y.x, y.y); w.y = pk2(y.z, y.w); *(v2u*)(ydst + c) = w; }
}
template <int MODE>
__device__ __forceinline__ void ln_row(const Frame& F, const float* xsrc, const bf16* Y, const float* ga, const float* lg, const float* lb, float* xdst,
                                       bool domod, const float* sc, const float* sh, bf16* hrow) {
    f32x4 v[16]; float s = 0.f;
#pragma unroll
    for (int j = 0; j < 16; ++j) { const int c = 4 * F.lane + 256 * j; v[j] = __builtin_nontemporal_load((const f32x4*)(xsrc + c));
        if (MODE == 1) { const v2u yw = __builtin_nontemporal_load((const v2u*)(Y + c)); const f32x4 y = {bflo(yw.x), bfhi(yw.x), bflo(yw.y), bfhi(yw.y)}, g = *(const f32x4*)(ga + c); v[j] = v[j] * ALPHA + g * y; }
        s += (v[j].x + v[j].y) + (v[j].z + v[j].w);
        if ((j & 7) == 7) asm volatile("" ::: "memory"); }
    float mean = wave_sum(s) * (1.f / DM), s2 = 0.f;
#pragma unroll
    for (int j = 0; j < 16; ++j) { v[j] = v[j] - mean; s2 += (v[j].x * v[j].x + v[j].y * v[j].y) + (v[j].z * v[j].z + v[j].w * v[j].w); }
    float rstd = 1.f / sqrtf(wave_sum(s2) * (1.f / DM) + LN_EPS);
    if (MODE == 1) {
        s = 0.f;
#pragma unroll
        for (int j = 0; j < 16; ++j) { const int c = 4 * F.lane + 256 * j; const f32x4 g = *(const f32x4*)(lg + c), b = *(const f32x4*)(lb + c); v[j] = v[j] * rstd * g + b;
            __builtin_nontemporal_store(v[j], (f32x4*)(xdst + c)); s += (v[j].x + v[j].y) + (v[j].z + v[j].w);
            if ((j & 7) == 7) asm volatile("" ::: "memory"); }
        if (!domod) return;
        mean = wave_sum(s) * (1.f / DM); s2 = 0.f;
#pragma unroll
        for (int j = 0; j < 16; ++j) { v[j] = v[j] - mean; s2 += (v[j].x * v[j].x + v[j].y * v[j].y) + (v[j].z * v[j].z + v[j].w * v[j].w); }
        rstd = 1.f / sqrtf(wave_sum(s2) * (1.f / DM) + LN_EPS);
    }
#pragma unroll
    for (int j = 0; j < 16; ++j) { const int c = 4 * F.lane + 256 * j; const f32x4 a = *(const f32x4*)(sc + c), b = *(const f32x4*)(sh + c);
        const f32x4 o = v[j] * rstd * (a + 1.f) + b; v2u w; w.x = pk2(o.x, o.y); w.y = pk2(o.z, o.w); *(v2u*)(hrow + c) = w; }
}

__device__ __forceinline__ void shift4(const bf16* P, unsigned eo, bool hp, bool hn, const float* mup, const float* mun, unsigned mo, float (&u)[4]) {
    const v2u xc = ldg<v2u>(P, eo * 2u); v2u xp = {0u, 0u}, xn = {0u, 0u};
    if (hp) xp = ldg<v2u>(P, (eo - DINP) * 2u); if (hn) xn = ldg<v2u>(P, (eo + DINP) * 2u);
    const f32x4 mp = ldg<f32x4>(mup, mo * 4u), mn = ldg<f32x4>(mun, mo * 4u);
    const float c[4] = {bflo(xc.x), bfhi(xc.x), bflo(xc.y), bfhi(xc.y)}, p[4] = {bflo(xp.x), bfhi(xp.x), bflo(xp.y), bfhi(xp.y)}, n[4] = {bflo(xn.x), bfhi(xn.x), bflo(xn.y), bfhi(xn.y)};
#pragma unroll
    for (int e = 0; e < 4; ++e) u[e] = c[e] + mp[e] * (p[e] - c[e]) + mn[e] * (n[e] - c[e]);
}
__device__ __forceinline__ void st4bf(void* base, unsigned eo, float a, float b, float c, float d) { v2u w; w.x = pk2(a, b); w.y = pk2(c, d); stg<v2u>(base, eo * 2u, w); }

__device__ __forceinline__ void rwkv_feat_item(Frame& F, int l, int item) {
    F.tid = ltid(); F.lane = F.tid & 63;
    int row0, seq_lo, seq_hi;
    if (item < 16) { const int b = item >> 3; seq_lo = M_LAT + b * NCTX; seq_hi = seq_lo + NCTX; row0 = seq_lo + (item & 7) * 32; }
    else { const int it = item - 16, b = it >> 8; seq_lo = b * SEQ; seq_hi = seq_lo + SEQ; row0 = seq_lo + (it & 255) * 32; }
    const bf16* P = (const bf16*)(F.ws + WS_P);
    LAS bf16* ACT = (LAS bf16*)F.lds;
    const float* mup = F.A->in[I_MUP] + l * RWC; const float* mun = F.A->in[I_MUN] + l * RWC;
    __syncthreads();
    { const int tok = F.tid >> 4, jc = F.tid & 15, row = row0 + tok; const bool hp = row > seq_lo, hn = row + 1 < seq_hi;
      const bf16* pr = P + (size_t)row * DINP + C_RWL;
#pragma unroll
      for (int i = 0; i < 13; ++i) { const int j = jc * 2 + 32 * i;
          const unsigned xc = *(const unsigned*)(pr + j), xp = hp ? *(const unsigned*)(pr - DINP + j) : 0u, xn = hn ? *(const unsigned*)(pr + DINP + j) : 0u;
          float u[2];
#pragma unroll
          for (int e = 0; e < 2; ++e) { const float c = e ? bfhi(xc) : bflo(xc), p = e ? bfhi(xp) : bflo(xp), n = e ? bfhi(xn) : bflo(xn);
              float v = c + mup[3072 + j + e] * (p - c) + mun[3072 + j + e] * (n - c);
              if (j < 128) v = tanhf_(v); else if (j >= 256) v = sigmoidf_(v);
              u[e] = v; }
          *(LAS unsigned*)(ACT + tok * 424 + j) = pk2(u[0], u[1]); } }
    __syncthreads();
    const int tok = F.lane & 31, hi = F.lane >> 5, row = row0 + tok;
    const bf16* W2T = (const bf16*)(F.wsw + WS_W2T); const bf16* A2T = (const bf16*)(F.wsw + WS_A2T); const bf16* G2T = (const bf16*)(F.wsw + WS_G2T);
    bf16* RWF = (bf16*)(F.ws + WS_RWF); const size_t RS = (size_t)M_TOT * 1024;
    const float* kkv = F.A->in[I_KK] + l * 1024; const float* kav = F.A->in[I_KA] + l * 1024; const float* rkv = F.A->in[I_RK] + l * 1024;
    const float* w0f = F.A->in[I_W0] + (size_t)(l * 2) * 1024; const float* a0f = F.A->in[I_A0] + (size_t)(l * 2) * 1024;
    const LAS bf16* actl = ACT + tok * 424 + hi * 8;
    LAS unsigned char* TB = F.lds + 27136 + F.wave * 10880;
#define RF_LOADG(reg_, colbase) do { _Pragma("unroll") for (int i_ = 0; i_ < 3; ++i_) { const int p_ = F.lane + 64 * i_; reg_[i_] = (v4u){0u, 0u, 0u, 0u}; if (p_ < 136) { const int rr_ = p_ >> 2, cp_ = p_ & 3, gr_ = row0 - 1 + rr_; \
        if (gr_ >= seq_lo && gr_ < seq_hi) reg_[i_] = ldg<v4u>(P, ((unsigned)gr_ * DINP + (colbase) + 8 * cp_) * 2u); } } } while (0)
#define RF_STORET(ti, reg_) do { _Pragma("unroll") for (int i_ = 0; i_ < 3; ++i_) { const int p_ = F.lane + 64 * i_; if (p_ < 136) { const int rr_ = p_ >> 2, cp_ = p_ & 3; *(LAS v4u*)(TB + (ti) * 2720 + rr_ * 80 + cp_ * 16) = reg_[i_]; } } } while (0)
#define RF_SHIFT4(ti, g_, mo_, u_) do { const LAS unsigned char* q_ = TB + (ti) * 2720 + (tok + 1) * 80 + (8 * (g_) + 4 * hi) * 2; const v2u xc_ = *(const LAS v2u*)q_, xp_ = *(const LAS v2u*)(q_ - 80), xn_ = *(const LAS v2u*)(q_ + 80); \
        const f32x4 mp_ = ldg<f32x4>(mup, (mo_) * 4u), mn_ = ldg<f32x4>(mun, (mo_) * 4u); \
        const float c_[4] = {bflo(xc_.x), bfhi(xc_.x), bflo(xc_.y), bfhi(xc_.y)}, pp_[4] = {bflo(xp_.x), bfhi(xp_.x), bflo(xp_.y), bfhi(xp_.y)}, nn_[4] = {bflo(xn_.x), bfhi(xn_.x), bflo(xn_.y), bfhi(xn_.y)}; \
        _Pragma("unroll") for (int e_ = 0; e_ < 4; ++e_) u_[e_] = c_[e_] + mp_[e_] * (pp_[e_] - c_[e_]) + mn_[e_] * (nn_[e_] - c_[e_]); } while (0)
#define RF_PUT(ti, o_) do { _Pragma("unroll") for (int g_ = 0; g_ < 4; ++g_) *(LAS v2u*)(TB + (ti) * 2720 + tok * 80 + (8 * g_ + 4 * hi) * 2) = o_[g_]; } while (0)
#define RF_FLUSH3(a0_, a1_, a2_, cblk_) do { asm volatile("s_waitcnt lgkmcnt(0)" ::: "memory"); \
        _Pragma("unroll") for (int t_ = 0; t_ < 3; ++t_) { const int arr_ = t_ == 0 ? (a0_) : (t_ == 1 ? (a1_) : (a2_)); \
            _Pragma("unroll") for (int i_ = 0; i_ < 2; ++i_) { const int p_ = F.lane + 64 * i_, rr_ = p_ >> 2, cp_ = p_ & 3; const v4u v_ = *(const LAS v4u*)(TB + t_ * 2720 + rr_ * 80 + cp_ * 16); \
                stg<v4u>(RWF + arr_ * RS, ((unsigned)(row0 + rr_) * 1024u + (cblk_) + 8 * cp_) * 2u, v_); } } \
        asm volatile("s_waitcnt lgkmcnt(0)" ::: "memory"); } while (0)
#pragma unroll 1
    for (int hh = 0; hh < 2; ++hh) {
        const int h = 2 * F.wave + hh, cbase = h * 64;
        float ssq = 0.f;
        { v4u t0[3], t1[3]; RF_LOADG(t0, C_RWK + cbase); RF_LOADG(t1, C_RWK + cbase + 32); RF_STORET(0, t0); RF_STORET(1, t1); }
        asm volatile("s_waitcnt lgkmcnt(0)" ::: "memory");
#pragma unroll
        for (int bg = 0; bg < 8; ++bg) { const unsigned c4 = cbase + (bg >> 2) * 32 + 8 * (bg & 3) + 4 * hi; float uk[4];
            RF_SHIFT4(bg >> 2, bg & 3, 1024 + c4, uk); const f32x4 k4 = ldg<f32x4>(kkv, c4 * 4u);
#pragma unroll
            for (int e = 0; e < 4; ++e) { const float q = uk[e] * k4[e]; ssq += q * q; } }
        ssq = half_swap_sum(ssq);
        const float rn = 1.f / fmaxf(sqrtf(ssq), 1e-12f);
        float sb = 0.f;
        asm volatile("s_waitcnt lgkmcnt(0)" ::: "memory");
#pragma unroll 1
        for (int blk = 0; blk < 2; ++blk) {
            const unsigned cblk = cbase + blk * 32, cha = cblk + tok;
            v4u gR[3], gK[3], gV[3];
            RF_LOADG(gR, C_RWR + cblk); RF_LOADG(gK, C_RWK + cblk); RF_LOADG(gV, C_RWV + cblk);
#pragma unroll
            for (int d = 0; d < 2; ++d) { f32x16 aw = {};
#pragma unroll
                for (int ks = 0; ks < 4; ++ks) { const bf16x8 bw = *(const LAS bf16x8*)(actl + d * 64 + ks * 16); const bf16x8 w_ = ldg<bf16x8>(W2T, ((d * 1024 + cha) * 64 + ks * 16 + hi * 8) * 2u);
                    aw = __builtin_amdgcn_mfma_f32_32x32x16_bf16(w_, bw, aw, 0, 0, 0); }
                v2u o[4];
#pragma unroll
                for (int g = 0; g < 4; ++g) { const f32x4 w0 = ldg<f32x4>(w0f, (d * 1024 + cblk + 8 * g + 4 * hi) * 4u); float e4[4];
#pragma unroll
                    for (int e = 0; e < 4; ++e) e4[e] = 0.60653065971f * sigmoidf_(w0[e] + aw[4 * g + e]);
                    o[g].x = pk2(e4[0], e4[1]); o[g].y = pk2(e4[2], e4[3]); }
                RF_PUT(d, o); }
            { f32x16 ag = {};
#pragma unroll
              for (int ks = 0; ks < 10; ++ks) { const bf16x8 bg_ = *(const LAS bf16x8*)(actl + 256 + ks * 16); const bf16x8 g_ = ldg<bf16x8>(G2T, (cha * 192 + ks * 16 + hi * 8) * 2u);
                  ag = __builtin_amdgcn_mfma_f32_32x32x16_bf16(g_, bg_, ag, 0, 0, 0); }
              v2u o[4];
#pragma unroll
              for (int g = 0; g < 4; ++g) { o[g].x = pk2(ag[4 * g], ag[4 * g + 1]); o[g].y = pk2(ag[4 * g + 2], ag[4 * g + 3]); }
              RF_PUT(2, o); }
            RF_FLUSH3(4, 5, 8, cblk);
            RF_STORET(0, gR); RF_STORET(1, gK); RF_STORET(2, gV);
            { f32x16 aaf = {}, aab = {};
#pragma unroll
              for (int ks = 0; ks < 4; ++ks) { const bf16x8 baf = *(const LAS bf16x8*)(actl + 128 + ks * 16), bab = *(const LAS bf16x8*)(actl + 192 + ks * 16);
                  const bf16x8 a_f = ldg<bf16x8>(A2T, (cha * 64 + ks * 16 + hi * 8) * 2u), a_b = ldg<bf16x8>(A2T, ((1024 + cha) * 64 + ks * 16 + hi * 8) * 2u);
                  aaf = __builtin_amdgcn_mfma_f32_32x32x16_bf16(a_f, baf, aaf, 0, 0, 0); aab = __builtin_amdgcn_mfma_f32_32x32x16_bf16(a_b, bab, aab, 0, 0, 0); }
              v2u oR[4], oK[4], oV[4], oKK[4], oAF[4], oAB[4];
              asm volatile("s_waitcnt lgkmcnt(0)" ::: "memory");
#pragma unroll
              for (int g = 0; g < 4; ++g) { const unsigned c4 = cblk + 8 * g + 4 * hi; float ur[4], uk[4], uv[4];
                  RF_SHIFT4(0, g, c4, ur); RF_SHIFT4(1, g, 1024 + c4, uk); RF_SHIFT4(2, g, 2048 + c4, uv);
                  const f32x4 a0a = ldg<f32x4>(a0f, c4 * 4u), a0b = ldg<f32x4>(a0f, (1024 + c4) * 4u), kk4 = ldg<f32x4>(kkv, c4 * 4u), ka4 = ldg<f32x4>(kav, c4 * 4u), rk4 = ldg<f32x4>(rkv, c4 * 4u);
                  float af[4], ab[4], kk[4];
#pragma unroll
                  for (int e = 0; e < 4; ++e) { const int r = 4 * g + e;
                      af[e] = sigmoidf_(a0a[e] + aaf[r]); ab[e] = sigmoidf_(a0b[e] + aab[r]); kk[e] = uk[e] * kk4[e] * rn;
                      const float kdf = uk[e] * (1.f + (af[e] - 1.f) * ka4[e]), kdb = uk[e] * (1.f + (ab[e] - 1.f) * ka4[e]);
                      sb += ur[e] * rk4[e] * (kdf + kdb); }
                  oR[g].x = pk2(ur[0], ur[1]); oR[g].y = pk2(ur[2], ur[3]); oK[g].x = pk2(uk[0], uk[1]); oK[g].y = pk2(uk[2], uk[3]); oV[g].x = pk2(uv[0], uv[1]); oV[g].y = pk2(uv[2], uv[3]);
                  oKK[g].x = pk2(kk[0], kk[1]); oKK[g].y = pk2(kk[2], kk[3]); oAF[g].x = pk2(af[0], af[1]); oAF[g].y = pk2(af[2], af[3]); oAB[g].x = pk2(ab[0], ab[1]); oAB[g].y = pk2(ab[2], ab[3]); }
              asm volatile("s_waitcnt lgkmcnt(0)" ::: "memory");
              RF_PUT(0, oR); RF_PUT(1, oK); RF_PUT(2, oV); RF_FLUSH3(0, 1, 2, cblk);
              RF_PUT(0, oKK); RF_PUT(1, oAF); RF_PUT(2, oAB); RF_FLUSH3(3, 6, 7, cblk); }
        }
        sb = half_swap_sum(sb);
        if (hi == 0) ((float*)(F.ws + WS_SB))[(size_t)row * 16 + h] = sb;
    }
#undef RF_LOADG
#undef RF_STORET
#undef RF_SHIFT4
#undef RF_PUT
#undef RF_FLUSH3
}

__device__ __forceinline__ float gelu_tanh(float x) { return 0.5f * x * (1.f + tanhf_(0.7978845608028654f * (x + 0.044715f * x * x * x))); }
template <bool PASS3>
__device__ __forceinline__ void lru_item(Frame& F, int l, int item) {
    F.tid = ltid(); F.lane = F.tid & 63;
    const int sc = item >> 3, nb = item & 7, b = sc / NCH, ch = sc % NCH;
    int row0, seq_lo, seq_hi;
    if (ch < 8) { seq_lo = M_LAT + b * NCTX; seq_hi = seq_lo + NCTX; row0 = seq_lo + ch * 32; }
    else { seq_lo = b * SEQ; seq_hi = seq_lo + SEQ; row0 = seq_lo + (ch - 8) * 32; }
    const bf16* P = (const bf16*)(F.ws + WS_P);
    LAS float* U = (LAS float*)F.lds;
    LAS bf16* UA = (LAS bf16*)(F.lds + 16384);
    LAS float* AB = (LAS float*)(F.lds + 32768);
    __syncthreads();
    { const int tok = F.tid >> 4, c8 = (F.tid & 15) * 8, cg = nb * 128 + c8; float acc[8];
      const float* cb = F.A->in[I_CONVB] + l * 1024 + cg;
#pragma unroll
      for (int e = 0; e < 8; ++e) acc[e] = cb[e];
#pragma unroll
      for (int j = 0; j < 4; ++j) { const int r = row0 + tok - 2 + j;
          if (r >= seq_lo && r < seq_hi) { const v4u x = *(const v4u*)(P + (size_t)r * DINP + C_LRUX + cg); const float* cw = F.A->in[I_CONVW] + (size_t)(l * 4 + j) * 1024 + cg;
#pragma unroll
              for (int w = 0; w < 4; ++w) { acc[2 * w] += cw[2 * w] * bflo(x[w]); acc[2 * w + 1] += cw[2 * w + 1] * bfhi(x[w]); } } }
      *(LAS f32x4*)(U + tok * 128 + c8) = (f32x4){acc[0], acc[1], acc[2], acc[3]}; *(LAS f32x4*)(U + tok * 128 + c8 + 4) = (f32x4){acc[4], acc[5], acc[6], acc[7]};
      v4u o; o.x = pk2(acc[0], acc[1]); o.y = pk2(acc[2], acc[3]); o.z = pk2(acc[4], acc[5]); o.w = pk2(acc[6], acc[7]);
      *(LAS v4u*)(UA + tok * 136 + c8) = o; }
    __syncthreads();
    { const int dir = F.wave >> 2, cq = F.wave & 3, l32 = F.lane & 31, hi = F.lane >> 5, chn = cq * 32 + l32, cg = nb * 128 + chn;
      const bf16* Wr = (const bf16*)(F.wsw + WS_WLRU) + ((size_t)(dir * 2 + 0) * 8 + nb) * 16384 + (size_t)chn * 128;
      const bf16* Wi = (const bf16*)(F.wsw + WS_WLRU) + ((size_t)(dir * 2 + 1) * 8 + nb) * 16384 + (size_t)chn * 128;
      f32x16 accr = {}, acci = {};
#pragma unroll
      for (int ks = 0; ks < 8; ++ks) { const int ko = ks * 16 + hi * 8;
          const bf16x8 a = *(const LAS bf16x8*)(UA + l32 * 136 + ko); const bf16x8 br = *(const bf16x8*)(Wr + ko), bi = *(const bf16x8*)(Wi + ko);
          accr = __builtin_amdgcn_mfma_f32_32x32x16_bf16(a, br, accr, 0, 0, 0); acci = __builtin_amdgcn_mfma_f32_32x32x16_bf16(a, bi, acci, 0, 0, 0); }
      const float ba = F.A->in[I_LBA][(l * 2 + dir) * 1024 + cg], bi_ = F.A->in[I_LBI][(l * 2 + dir) * 1024 + cg], sp = softplusf_(-F.A->in[I_LAM][(l * 2 + dir) * 1024 + cg]);
#pragma unroll
      for (int r = 0; r < 16; ++r) { const int tok = att::crow(r, hi); const float u = U[tok * 128 + chn];
          const float rg = sigmoidf_(accr[r] + ba), ig = sigmoidf_(acci[r] + bi_), la = -8.f * rg * sp, a = __expf(la), x2 = 2.f * la;
          const float em = x2 * (1.f + x2 * (0.5f + x2 * (0.16666667f + x2 * (0.041666668f + x2 * (0.0083333338f + x2 * 0.0013888889f)))));
          const float bc = __builtin_amdgcn_sqrtf(x2 < -0.5f ? 1.f - a * a : -em) * (ig * u);
          AB[(dir * 2 + 0) * 4096 + tok * 128 + chn] = a; AB[(dir * 2 + 1) * 4096 + tok * 128 + chn] = bc; } }
    __syncthreads();
    if (F.tid < 256) { const int dir = F.tid >> 7, chn = F.tid & 127, cg = nb * 128 + chn; const size_t ci = ((size_t)(dir * 2 + b) * NCH + ch) * 1024 + cg;
        LAS float* Aa = AB + (dir * 2) * 4096 + chn; LAS float* Bb = AB + (dir * 2 + 1) * 4096 + chn;
        if (!PASS3) { float h = 0.f, ap = 1.f;
#pragma unroll 8
            for (int s = 0; s < 32; ++s) { const int tok = dir ? 31 - s : s; const float a = Aa[tok * 128]; h = a * h + Bb[tok * 128]; ap *= a;
                if (s == 0 && dir == 1 && ch == 7) ((float*)(F.ws + WS_QUIRK))[b * 1024 + cg] = h; }
            ((float*)(F.ws + WS_CA))[ci] = ap; ((float*)(F.ws + WS_CB))[ci] = h;
        } else { float h = ((const float*)(F.ws + WS_HIN))[ci];
#pragma unroll 8
            for (int s = 0; s < 32; ++s) { const int tok = dir ? 31 - s : s; h = Aa[tok * 128] * h + Bb[tok * 128]; Bb[tok * 128] = h; } } }
    if (PASS3) { __syncthreads();
        const int tok = F.tid >> 4, c8 = (F.tid & 15) * 8, cg = nb * 128 + c8, row = row0 + tok;
        const v4u y = *(const v4u*)(P + (size_t)row * DINP + C_LRUY + cg); float o[8];
#pragma unroll
        for (int w = 0; w < 4; ++w) { const float h0 = AB[4096 + tok * 128 + c8 + 2 * w] + AB[3 * 4096 + tok * 128 + c8 + 2 * w], h1 = AB[4096 + tok * 128 + c8 + 2 * w + 1] + AB[3 * 4096 + tok * 128 + c8 + 2 * w + 1];
            o[2 * w] = h0 * gelu_tanh(bflo(y[w])); o[2 * w + 1] = h1 * gelu_tanh(bfhi(y[w])); }
        v4u ov; ov.x = pk2(o[0], o[1]); ov.y = pk2(o[2], o[3]); ov.z = pk2(o[4], o[5]); ov.w = pk2(o[6], o[7]);
        *(v4u*)((bf16*)(F.ws + WS_MIX) + (size_t)row * DM + 1024 + cg) = ov; }
}
__device__ __forceinline__ void lru_carry(Frame& F, int blk) {
    F.tid = ltid(); F.lane = F.tid & 63;
    const int gid = blk * NTHR + F.tid; if (gid >= 4096) return;
    const int dir = gid >> 11, b = (gid >> 10) & 1, cg = gid & 1023;
    const float* CA = (const float*)(F.ws + WS_CA) + ((size_t)(dir * 2 + b) * NCH) * 1024 + cg; const float* CB = (const float*)(F.ws + WS_CB) + ((size_t)(dir * 2 + b) * NCH) * 1024 + cg;
    float* HIN = (float*)(F.ws + WS_HIN) + ((size_t)(dir * 2 + b) * NCH) * 1024 + cg;
    float h = 0.f;
    if (dir == 0) {
#pragma unroll 8
        for (int c = 0; c < NCH; ++c) { HIN[(size_t)c * 1024] = h; h = CA[(size_t)c * 1024] * h + CB[(size_t)c * 1024]; }
    } else {
        for (int c = 7; c >= 0; --c) { HIN[(size_t)c * 1024] = h; h = CA[(size_t)c * 1024] * h + CB[(size_t)c * 1024]; }
        h = ((const float*)(F.ws + WS_QUIRK))[b * 1024 + cg];
#pragma unroll 8
        for (int c = NCH - 1; c >= 8; --c) { HIN[(size_t)c * 1024] = h; h = CA[(size_t)c * 1024] * h + CB[(size_t)c * 1024]; }
    }
}

__device__ __forceinline__ void rope_table(Frame& F) {
    const int i = F.vcu * NTHR + F.tid; if (i >= 2048) return;
    const int pos = i >> 4, f = i & 15; float s, c; sincosf((float)pos * exp2f(-(float)f * (13.287712379549449f / 16.f)), &s, &c);
    float* t = (float*)(F.ws + WS_ROPE); t[i] = c; t[2048 + i] = s;
}
__device__ __forceinline__ void row_prep(Frame& F, int row) {
    F.tid = ltid(); F.lane = F.tid & 63;
    bf16* pr = (bf16*)(F.ws + WS_P) + (size_t)row * DINP; const int lane = F.lane;
    const bool lat = row < M_LAT; const int t = row & (SEQ - 1); const float prow = (float)(t >> 6), pcol = (float)(t & 63);
    { const v4u a = *(const v4u*)(pr + C_QA + lane * 16), b = *(const v4u*)(pr + C_QA + lane * 16 + 8); float ss = 0.f;
#pragma unroll
      for (int w = 0; w < 4; ++w) { const float x0 = bflo(a[w]), x1 = bfhi(a[w]), x2 = bflo(b[w]), x3 = bfhi(b[w]); ss += x0 * x0 + x1 * x1 + x2 * x2 + x3 * x3; }
      ss = wave_sum(ss); if (lane == 0) ((float*)(F.ws + WS_RSQ))[row] = 1.f / sqrtf(ss * (1.f / 1024.f) + RMS_EPS); }
    { const v4u a = *(const v4u*)(pr + C_KVA + lane * 8); float ss = 0.f;
#pragma unroll
      for (int w = 0; w < 4; ++w) { const float x0 = bflo(a[w]), x1 = bfhi(a[w]); ss += x0 * x0 + x1 * x1; }
      ss = wave_sum(ss); if (lane == 0) ((float*)(F.ws + WS_RSKV))[row] = 1.f / sqrtf(ss * (1.f / 512.f) + RMS_EPS); }
    bf16* kr = (bf16*)(F.ws + WS_KR) + (size_t)row * 64;
    if (lat) {
        { const int part = lane >> 5, sub = lane & 31;
          const float inv = exp2f(-(float)sub * (13.287712379549449f / 32.f)); float sn, cs; sincosf((part ? pcol : prow) * inv, &sn, &cs);
#pragma unroll
          for (int hd = 0; hd < 10; ++hd) { bf16* qb = pr + (hd < 8 ? C_SWAQ + hd * 128 : C_SWAK + (hd - 8) * 128) + part * 64;
              const float x1 = bf2f(qb[sub]), x2 = bf2f(qb[sub + 32]); qb[sub] = (bf16)f2bf(x1 * cs - x2 * sn); qb[sub + 32] = (bf16)f2bf(x2 * cs + x1 * sn); } }
        if (lane < 32) { const int part = lane >> 4, i = lane & 15; const bf16* src = pr + C_KR + part * 32;
          const float inv = exp2f(-(float)i * (13.287712379549449f / 16.f)); float s, c; sincosf((part ? pcol : prow) * inv, &s, &c);
          const float x1 = bf2f(src[i]), x2 = bf2f(src[i + 16]);
          kr[part * 32 + i] = (bf16)f2bf(x1 * c - x2 * s); kr[part * 32 + i + 16] = (bf16)f2bf(x2 * c + x1 * s); }
    } else kr[lane] = pr[C_KR + lane];
}

__device__ __forceinline__ float allred16(float x) { return row_sum16(x); }
__device__ __forceinline__ int scan_row(int s, int dir, int b) {
    if (s < NCTX) return M_LAT + b * NCTX + (dir ? NCTX - 1 - s : s);
    const int t = s - NCTX; return b * SEQ + (dir ? SEQ - 1 - t : t);
}
__device__ __forceinline__ void rwkv_scan(Frame& F, int l, int chain) {
    F.tid = ltid(); F.lane = F.tid & 63;
    const int dir = chain >> 5, b = (chain >> 4) & 1, h = chain & 15;
    constexpr int CT = 24, NCHK = (NCTX + SEQ) / CT, STEPF = 392, BUFF = CT * STEPF;
    LAS float* buf = (LAS float*)F.lds; LAS float* ybuf = (LAS float*)(F.lds + 3 * BUFF * 4);
    gcbf RWF = (gcbf)(F.ws + WS_RWF); const size_t RS = (size_t)M_TOT * 1024;
    gflp YS = (gflp)(F.ws + WS_YS) + (size_t)dir * M_TOT * 1024;
    const bool cmp = F.wave < 4; const int lt = F.tid - 256, lst = lt >> 4, lq = lt & 15, lc = h * 64 + 4 * lq;
    const f32x4 ka4 = *(const GAS f32x4*)((gcfl)F.A->in[I_KA] + l * 1024 + (cmp ? 0 : lc));
    v2u gr[2], gk[2], gv[2], gkk[2], ge[2], ga[2];
#pragma unroll
    for (int u = 0; u < 2; ++u) { gr[u] = (v2u){0u, 0u}; gk[u] = gr[u]; gv[u] = gr[u]; gkk[u] = gr[u]; ge[u] = gr[u]; ga[u] = gr[u]; }
#define RW_LOAD(c) do { if (!cmp) { _Pragma("unroll") for (int u_ = 0; u_ < 2; ++u_) { const int s_ = lst + 16 * u_; if (s_ < CT) { const size_t o_ = (size_t)scan_row((c) * CT + s_, dir, b) * 1024 + lc; \
        gr[u_] = *(const GAS v2u*)(RWF + 0 * RS + o_); gk[u_] = *(const GAS v2u*)(RWF + 1 * RS + o_); gv[u_] = *(const GAS v2u*)(RWF + 2 * RS + o_); \
        gkk[u_] = *(const GAS v2u*)(RWF + 3 * RS + o_); ge[u_] = *(const GAS v2u*)(RWF + (4 + dir) * RS + o_); ga[u_] = *(const GAS v2u*)(RWF + (6 + dir) * RS + o_); } } } } while (0)
#define RW_WRITE(bi) do { if (!cmp) { _Pragma("unroll") for (int u_ = 0; u_ < 2; ++u_) { const int s_ = lst + 16 * u_; if (s_ < CT) { LAS float* d_ = buf + (bi) * BUFF + s_ * STEPF + 4 * lq; \
        const float r_[4] = {bflo(gr[u_].x), bfhi(gr[u_].x), bflo(gr[u_].y), bfhi(gr[u_].y)}, k_[4] = {bflo(gk[u_].x), bfhi(gk[u_].x), bflo(gk[u_].y), bfhi(gk[u_].y)}, v_[4] = {bflo(gv[u_].x), bfhi(gv[u_].x), bflo(gv[u_].y), bfhi(gv[u_].y)}; \
        const float q_[4] = {bflo(gkk[u_].x), bfhi(gkk[u_].x), bflo(gkk[u_].y), bfhi(gkk[u_].y)}, e_[4] = {bflo(ge[u_].x), bfhi(ge[u_].x), bflo(ge[u_].y), bfhi(ge[u_].y)}, a_[4] = {bflo(ga[u_].x), bfhi(ga[u_].x), bflo(ga[u_].y), bfhi(ga[u_].y)}; \
        f32x4 w4, kd4, kk4, b4, wr4, v4; float sbr = 0.f, skr = 0.f; \
        _Pragma("unroll") for (int e = 0; e < 4; ++e) { w4[e] = __expf(-e_[e]); kd4[e] = k_[e] * (1.f + (a_[e] - 1.f) * ka4[e]); kk4[e] = q_[e]; b4[e] = q_[e] * a_[e]; wr4[e] = w4[e] * r_[e]; v4[e] = v_[e]; sbr += b4[e] * r_[e]; skr += kd4[e] * r_[e]; } \
        sbr = row_sum16(sbr); skr = row_sum16(skr); \
        *(LAS f32x4*)(d_) = w4; *(LAS f32x4*)(d_ + 64) = kd4; *(LAS f32x4*)(d_ + 128) = kk4; *(LAS f32x4*)(d_ + 192) = b4; *(LAS f32x4*)(d_ + 256) = wr4; *(LAS f32x4*)(d_ + 320) = v4; \
        if (lq == 0) *(LAS f32x2*)(buf + (bi) * BUFF + s_ * STEPF + 384) = (f32x2){sbr, skr}; } } } } while (0)
#define RW_FLUSH(c) do { if (!cmp) { _Pragma("unroll") for (int u_ = 0; u_ < 2; ++u_) { const int s_ = lst + 16 * u_; if (s_ < CT) { const f32x4 y_ = *(const LAS f32x4*)(ybuf + ((c) & 1) * (CT * 64) + s_ * 64 + 4 * lq); \
        *(GAS f32x4*)(YS + (size_t)scan_row((c) * CT + s_, dir, b) * 1024 + lc) = y_; } } } } while (0)
    __syncthreads();
    RW_LOAD(0); RW_WRITE(0); RW_LOAD(1); RW_WRITE(1); RW_LOAD(2);
    __syncthreads();
    const int kg = F.lane & 7, rg = F.lane >> 3, r0 = 16 * (F.wave & 3) + 2 * rg;
    f32x2 St[8];
#pragma unroll
    for (int i = 0; i < 8; ++i) St[i] = (f32x2){0.f, 0.f};
    int bc = 0, bw = 2;
#pragma unroll 1
    for (int c = 0; c < NCHK; ++c) {
        if (c + 2 < NCHK) { RW_WRITE(bw); if (c + 3 < NCHK) RW_LOAD(c + 3); }
        if (c > 0) RW_FLUSH(c - 1);
        if (cmp) {
        const LAS float* bb = buf + bc * BUFF + 8 * kg; const LAS float* vb = buf + bc * BUFF + 320 + r0; const LAS float* sb = buf + bc * BUFF + 384;
        LAS float* yb = ybuf + (c & 1) * (CT * 64) + r0;
        f32x4 w4[2], kd4[2], kk4[2], b4[2], wr4[2];
#pragma unroll
        for (int q = 0; q < 2; ++q) { w4[q] = *(const LAS f32x4*)(bb + 4 * q); kd4[q] = *(const LAS f32x4*)(bb + 64 + 4 * q); kk4[q] = *(const LAS f32x4*)(bb + 128 + 4 * q); b4[q] = *(const LAS f32x4*)(bb + 192 + 4 * q); wr4[q] = *(const LAS f32x4*)(bb + 256 + 4 * q); }
        f32x2 v2 = *(const LAS f32x2*)(vb), s2 = *(const LAS f32x2*)(sb);
#pragma unroll
        for (int st = 0; st < CT; ++st) {
            const int sn = (st + 1 < CT ? st + 1 : st) * STEPF;
            f32x4 nw4[2], nkd4[2], nkk4[2], nb4[2], nwr4[2];
#pragma unroll
            for (int q = 0; q < 2; ++q) { nw4[q] = *(const LAS f32x4*)(bb + sn + 4 * q); nkd4[q] = *(const LAS f32x4*)(bb + sn + 64 + 4 * q); nkk4[q] = *(const LAS f32x4*)(bb + sn + 128 + 4 * q); nb4[q] = *(const LAS f32x4*)(bb + sn + 192 + 4 * q); nwr4[q] = *(const LAS f32x4*)(bb + sn + 256 + 4 * q); }
            const f32x2 nv2 = *(const LAS f32x2*)(vb + sn), ns2 = *(const LAS f32x2*)(sb + sn);
#define PKH(x, i) ((i) & 1 ? (f32x2){(x)[2], (x)[3]} : (f32x2){(x)[0], (x)[1]})
#define PK_MUL(d, a, bp, i) do { if ((i) & 1) asm("v_pk_mul_f32 %0, %1, %2 op_sel:[0,1] op_sel_hi:[1,1]" : "=v"(d) : "v"(a), "v"(bp)); else asm("v_pk_mul_f32 %0, %1, %2 op_sel:[0,0] op_sel_hi:[1,0]" : "=v"(d) : "v"(a), "v"(bp)); } while (0)
#define PK_FMA(d, a, bp, i, c) do { if ((i) & 1) asm("v_pk_fma_f32 %0, %1, %2, %3 op_sel:[0,1,0] op_sel_hi:[1,1,1]" : "=v"(d) : "v"(a), "v"(bp), "v"(c)); else asm("v_pk_fma_f32 %0, %1, %2, %3 op_sel:[0,0,0] op_sel_hi:[1,0,1]" : "=v"(d) : "v"(a), "v"(bp), "v"(c)); } while (0)
#define PK_FNMA(d, a, bp, i, c) do { if ((i) & 1) asm("v_pk_fma_f32 %0, %1, %2, %3 op_sel:[0,1,0] op_sel_hi:[1,1,1] neg_lo:[1,0,0] neg_hi:[1,0,0]" : "=v"(d) : "v"(a), "v"(bp), "v"(c)); \
        else asm("v_pk_fma_f32 %0, %1, %2, %3 op_sel:[0,0,0] op_sel_hi:[1,0,1] neg_lo:[1,0,0] neg_hi:[1,0,0]" : "=v"(d) : "v"(a), "v"(bp), "v"(c)); } while (0)
#define OPP(x, e) PKH((x)[(e) >> 2], ((e) >> 1) & 1)
            f32x2 pa, za, pb, zb;
            PK_MUL(pa, St[0], OPP(kk4, 0), 0); PK_MUL(za, St[0], OPP(wr4, 0), 0); PK_MUL(pb, St[4], OPP(kk4, 4), 4); PK_MUL(zb, St[4], OPP(wr4, 4), 4);
#pragma unroll
            for (int i = 1; i < 4; ++i) { PK_FMA(pa, St[i], OPP(kk4, i), i, pa); PK_FMA(za, St[i], OPP(wr4, i), i, za); PK_FMA(pb, St[4 + i], OPP(kk4, 4 + i), 4 + i, pb); PK_FMA(zb, St[4 + i], OPP(wr4, 4 + i), 4 + i, zb); }
            const f32x2 p = pa + pb, z = za + zb;
            float p0 = p.x, p1 = p.y, z0 = z.x, z1 = z.y;
#define D4(ctl) "v_add_f32_dpp %0, %0, %0 " ctl " row_mask:0xf bank_mask:0xf\n\tv_add_f32_dpp %1, %1, %1 " ctl " row_mask:0xf bank_mask:0xf\n\tv_add_f32_dpp %2, %2, %2 " ctl " row_mask:0xf bank_mask:0xf\n\tv_add_f32_dpp %3, %3, %3 " ctl " row_mask:0xf bank_mask:0xf\n\t"
            asm volatile("s_nop 1\n\t" D4("quad_perm:[1,0,3,2]") D4("quad_perm:[2,3,0,1]") D4("row_half_mirror") "s_nop 0"
                : "+v"(p0), "+v"(p1), "+v"(z0), "+v"(z1));
#undef D4
            const f32x2 pp = {p0, p1}, zz = {z0, z1};
            { f32x2 y; PK_FNMA(y, pp, s2, 0, zz); PK_FMA(y, v2, s2, 1, y); *(LAS f32x2*)(yb + st * 64) = y; }
#pragma unroll
            for (int i = 0; i < 8; ++i) { f32x2 t; PK_MUL(t, v2, OPP(kd4, i), i); PK_FMA(t, St[i], OPP(w4, i), i, t); PK_FNMA(St[i], pp, OPP(b4, i), i, t); }
#undef OPP
#undef PKH
#undef PK_MUL
#undef PK_FMA
#undef PK_FNMA
#pragma unroll
            for (int q = 0; q < 2; ++q) { w4[q] = nw4[q]; kd4[q] = nkd4[q]; kk4[q] = nkk4[q]; b4[q] = nb4[q]; wr4[q] = nwr4[q]; }
            v2 = nv2; s2 = ns2;
        }
        }
        __syncthreads();
        bc = bc == 2 ? 0 : bc + 1; bw = bw == 2 ? 0 : bw + 1;
    }
    RW_FLUSH(NCHK - 1);
#undef RW_LOAD
#undef RW_WRITE
#undef RW_FLUSH
}
__device__ __forceinline__ void rwkv_out_row(Frame& F, int l, int row) {
    F.tid = ltid(); F.lane = F.tid & 63;
    const int c0 = F.lane * 16; const float* yf = (const float*)(F.ws + WS_YS) + (size_t)row * 1024 + c0; const float* yb = yf + (size_t)M_TOT * 1024;
    float y[16]; float s = 0.f;
#pragma unroll
    for (int j = 0; j < 4; ++j) { const f32x4 a = __builtin_nontemporal_load((const f32x4*)(yf + 4 * j)), b = __builtin_nontemporal_load((const f32x4*)(yb + 4 * j));
#pragma unroll
        for (int e = 0; e < 4; ++e) { y[4 * j + e] = a[e] + b[e]; s += y[4 * j + e]; } }
    s = quad_sum(s); const float mu = s * (1.f / 64.f); float q = 0.f;
#pragma unroll
    for (int e = 0; e < 16; ++e) { y[e] -= mu; q += y[e] * y[e]; }
    q = quad_sum(q); const float rstd = 1.f / sqrtf(q * (1.f / 64.f) + GN_EPS);
    const bf16* RWF = (const bf16*)(F.ws + WS_RWF); const size_t RS = (size_t)M_TOT * 1024, o = (size_t)row * 1024 + c0;
    const float sbv = ((const float*)(F.ws + WS_SB))[(size_t)row * 16 + (F.lane >> 2)];
    const float* lg = F.A->in[I_LNG] + l * 1024 + c0; const float* lb = F.A->in[I_LNB] + l * 1024 + c0;
    bf16* dst = (bf16*)(F.ws + WS_MIX) + (size_t)row * DM + 3072 + c0;
#pragma unroll
    for (int hf = 0; hf < 2; ++hf) { const v4u vv = *(const v4u*)(RWF + 2 * RS + o + 8 * hf), gg = *(const v4u*)(RWF + 8 * RS + o + 8 * hf); float r[8];
#pragma unroll
        for (int w = 0; w < 4; ++w) { const int e = 8 * hf + 2 * w;
            r[2 * w] = (y[e] * rstd * lg[e] + lb[e] + sbv * bflo(vv[w])) * bflo(gg[w]); r[2 * w + 1] = (y[e + 1] * rstd * lg[e + 1] + lb[e + 1] + sbv * bfhi(vv[w])) * bfhi(gg[w]); }
        v4u ov; ov.x = pk2(r[0], r[1]); ov.y = pk2(r[2], r[3]); ov.z = pk2(r[4], r[5]); ov.w = pk2(r[6], r[7]); *(v4u*)(dst + 8 * hf) = ov; }
}

#ifndef W_OUT_K1
#define W_OUT_K1 2048
#endif
struct MlaTiles { gcbf KV; gcbf KR; int ctx_row0, lat_row0, h;
    __device__ __forceinline__ att::Tile operator()(int j) const { const int row = j < 4 ? ctx_row0 + 64 * j : lat_row0 + 64 * (j - 4);
        att::Tile t; t.kn = KV + (size_t)row * 2048 + h * 256; t.v = t.kn + 128; t.kr = KR + (size_t)row * 64; t.mtype = 0; t.krel0 = 0; return t; } };
struct SwaTiles { gcbf P; int blk_row0, ctx_row0, kvh, nwin, has_prev, has_next;
    __device__ __forceinline__ att::Tile operator()(int j) const { att::Tile t; int row; t.mtype = 0; t.krel0 = 0;
        if (j >= nwin) row = ctx_row0 + 64 * (j - nwin);
        else if (j < 2) row = blk_row0 + 64 * j;
        else if (has_prev && j < 4) { row = blk_row0 - 128 + 64 * (j - 2); t.mtype = 1; t.krel0 = -128 + 64 * (j - 2); }
        else { const int sub = j - 2 - 2 * has_prev; row = blk_row0 + 128 + 64 * sub; t.mtype = 2; t.krel0 = 128 + 64 * sub; }
        t.kn = P + (size_t)row * DINP + C_SWAK + kvh * 128; t.v = P + (size_t)row * DINP + C_SWAV + kvh * 128; t.kr = nullptr; return t; } };

#ifndef MLA_SDEPTH
#define MLA_SDEPTH 1
#endif
__device__ __forceinline__ void mla_item(Frame& F, int b, int h, int qb, bool ctxq) {
    F.tid = ltid(); F.lane = F.tid & 63;
    const int r32 = F.lane & 31; const int t = qb * 256 + F.wave * 32 + r32;
    const int roww0 = ctxq ? M_LAT + b * NCTX + F.wave * 32 : b * SEQ + qb * 256 + F.wave * 32;
    gcbf Qw = (gcbf)(F.ws + WS_Q) + (size_t)(roww0 + r32) * 1536 + h * 192;
    MlaTiles ts{(gcbf)(F.ws + WS_KV), (gcbf)(F.ws + WS_KR), M_LAT + b * NCTX, b * SEQ, h};
    gbfp Ow = (gbfp)(F.ws + WS_MIX) + (size_t)roww0 * DM + 2048 + h * 128;
    att::attn_body<192, 2048, 2048, false, false, MLA_SDEPTH>(Qw, ctxq ? 0 : 1, t >> 6, t & 63, (gcfl)(F.ws + WS_ROPE), 0, 0.f, ts, ctxq ? 4 : 132, Ow, (LAS char*)F.lds);
}
__device__ __forceinline__ void swa_item(Frame& F, int l, int b, int n, int kvh, int half, bool ctxq, int hq_ctx) {
    F.tid = ltid(); F.lane = F.tid & 63;
    const int r32 = F.lane & 31; gcbf P = (gcbf)(F.ws + WS_P);
    int hq, qi, roww0, t;
    if (ctxq) { hq = hq_ctx; kvh = hq >> 2; qi = 0; roww0 = M_LAT + b * NCTX + F.wave * 32; t = 0; }
    else { hq = kvh * 4 + 2 * half + (F.wave >> 2); qi = (F.wave & 3) * 32 + r32; roww0 = b * SEQ + n * 128 + (F.wave & 3) * 32; t = n * 128 + qi; }
    gcbf Qw = P + (size_t)(roww0 + r32) * DINP + C_SWAQ + hq * 128;
    SwaTiles ts; ts.P = P; ts.blk_row0 = b * SEQ + n * 128; ts.ctx_row0 = M_LAT + b * NCTX; ts.kvh = kvh;
    ts.has_prev = (!ctxq && n > 0) ? 1 : 0; ts.has_next = (!ctxq && n < SEQ / 128 - 1) ? 1 : 0; ts.nwin = ctxq ? 0 : 2 + 2 * ts.has_prev + 2 * ts.has_next;
    gbfp Ow = (gbfp)(F.ws + WS_MIX) + (size_t)roww0 * DM + hq * 128;
    const float sink_l2 = F.A->in[I_SINK][l * 8 + hq] * 1.4426950408889634f;
    att::attn_body<128, DINP, DINP, true, true, 2>(Qw, 0, 0, 0, (gcfl)nullptr, qi, sink_l2, ts, ts.nwin + 4, Ow, (LAS char*)F.lds);
}

#ifndef DBG_PHASES
#define DBG_PHASES 0xfffff
#endif
#define PH(n) ((DBG_PHASES >> (n)) & 1)
#ifndef DUP_PHASES
#define DUP_PHASES 0
#endif
#define REP(n) _Pragma("unroll") for (int rep_ = 0; rep_ < (((DUP_PHASES >> (n)) & 1) ? 2 : 1); ++rep_)
__global__ void __launch_bounds__(NTHR, 2) mk_fwd(Args args) {
    extern __shared__ __attribute__((aligned(16))) unsigned char lds[];
    Frame F;
    F.lds = (LAS unsigned char*)lds;
    F.tid = threadIdx.x; F.lane = F.tid & 63; F.wave = __builtin_amdgcn_readfirstlane(F.tid >> 6);
    F.G = gridDim.x; { const int bx = blockIdx.x; F.vcu = (F.G % 8 == 0) ? (bx % 8) * (F.G / 8) + bx / 8 : bx; }
    F.gw = F.vcu * NWAVES + F.wave; F.NGW = F.G * NWAVES;
    F.ws = args.ws; F.out = args.out; F.ctl = (gu32*)(args.ws + WS_CTL);
    F.A = (const __attribute__((address_space(4))) Args*)__builtin_amdgcn_kernarg_segment_ptr();
    for (int u = F.tid; u < (LDS_BYTES - LDSCTL_OFF) / 4; u += NTHR) ((LAS unsigned*)(F.lds + LDSCTL_OFF))[u] = 0u;
    __syncthreads();
    XcdBarrier bar = xcd_barrier_post((unsigned*)(args.ws + WS_CTL) + 4096, (volatile LAS unsigned*)(F.lds + MISC_OFF) + 8);
    const bool rwkv_blk = (blockIdx.x & 3) == 0;
    XcdBarrier bar2; bar2.bar = (unsigned*)(args.ws + WS_CTL) + 8192; bar2.x = 0; bar2.st = (volatile LAS unsigned*)(F.lds + MISC_OFF) + 12; bar2.nparts = gridDim.x - ((gridDim.x + 3) >> 2);
    if (!rwkv_blk) { const unsigned np_ = bar2.nparts; bar2 = xcd_barrier_post((unsigned*)(args.ws + WS_CTL) + 8192, (volatile LAS unsigned*)(F.lds + MISC_OFF) + 12); bar2.nparts = np_; }
#define SUB_BAR() do { bar2.bar = launder(bar2.bar); bar2.x = launder(bar2.x); xcd_barrier(bar2); F.ws = launder_g(F.ws); F.wsw = F.ws + (size_t)lcur * WSET_STRIDE; F.A = launder(F.A); F.tid = ltid(); F.lane = F.tid & 63; } while (0)
#define GRID_BAR() do { bar.bar = launder(bar.bar); bar.x = launder(bar.x); xcd_barrier(bar); F.ws = launder_g(F.ws); F.wsw = F.ws + (size_t)lcur * WSET_STRIDE; F.A = launder(F.A); F.tid = ltid(); F.lane = F.tid & 63; } while (0)
    const int bx = blockIdx.x; int lcur = 0; F.wsw = F.ws;
    bf16* H = (bf16*)(F.ws + WS_H); float* X = (float*)(F.ws + WS_X);

    REP(0) if (PH(0)) { mod_partials(F);
    convert_weights(F, 0, F.gw, F.NGW); }
    GRID_BAR();
    if (PH(1)) { mod_reduce(F); rope_table(F); }
    GRID_BAR();

#pragma unroll 1
    for (int l = 0; l < 2; ++l) {
        lcur = l; F.wsw = F.ws + (size_t)l * WSET_STRIDE;
        const bool wctx = (l == 0);
        const int MO = wctx ? M_TOT : M_LAT;
        if (PH(2) && l == 0) {
            for (int row = F.gw; row < M_TOT; row += F.NGW) { const int s = row_s(row);
                const float* xs = row < M_LAT ? F.A->in[I_X] + (size_t)row * DM : F.A->in[I_CTX] + (size_t)(row - M_LAT) * DM;
                ln_row<0>(F, xs, nullptr, nullptr, nullptr, nullptr, nullptr, true, mod_ptr(F, 0, s, 1), mod_ptr(F, 0, s, 0), H + (size_t)row * DM); }
        }
        GRID_BAR();
        REP(3) if (PH(3)) { pg8::Gemm g{H, (const bf16*)(F.wsw + WS_WIN), M_TOT, DINP, DM, DM, DM}; pg8::StaticOrder S; S.init(M_TOT, DINP, F.G, bx);
          pg8::EpiBf16<0> E{(bf16*)(F.ws + WS_P), DINP, nullptr};
          pg8::gemm_phase<pg8::EpiBf16<0>, pg8::StaticOrder, true, true>(F.lds, g, S, E); }
        GRID_BAR();
        REP(4) if (PH(4)) for (int it = F.vcu; it < 528; it += F.G) rwkv_feat_item(F, l, it);
        REP(5) if (PH(5)) { if (F.G == 256) { if (F.vcu < 16) { for (int it = F.vcu; it < 64; it += 16) lru_item<false>(F, l, it); }
                                              else { for (int it = 64 + F.vcu - 16; it < 2 * NCH * 8; it += 240) lru_item<false>(F, l, it); } }
                            else for (int it = F.vcu; it < 2 * NCH * 8; it += F.G) lru_item<false>(F, l, it); }
        __syncthreads();
        if (PH(6)) for (int row = F.gw; row < M_TOT; row += F.NGW) row_prep(F, row);
        GRID_BAR();
        REP(8) if (rwkv_blk) { const int nrw = (F.G + 3) >> 2; REP(18) if (PH(8)) for (int chain = bx >> 2; chain < 64; chain += nrw) rwkv_scan(F, l, chain); }
        else REP(19) { const int aw = (bx >> 2) * 3 + (bx & 3) - 1, naw = F.G - ((F.G + 3) >> 2);
            if (PH(7) && aw < 8) lru_carry(F, aw);
            if (PH(7)) { pg8::Gemm g{(const bf16*)(F.ws + WS_P) + C_QA, (const bf16*)(F.wsw + WS_WQB), M_TOT, 1536, 1024, DINP, 1024}; pg8::StaticOrder S; S.init(M_TOT, 1536, naw, aw);
              pg8::EpiBf16<2> E{(bf16*)(F.ws + WS_Q), 1536, (const float*)(F.ws + WS_RSQ)};
              pg8::gemm_phase<pg8::EpiBf16<2>, pg8::StaticOrder, true, true>(F.lds, g, S, E); }
            if (PH(7)) { pg8::Gemm g{(const bf16*)(F.ws + WS_P) + C_KVA, (const bf16*)(F.wsw + WS_WKVB), M_TOT, 2048, 512, DINP, 512}; pg8::StaticOrder S; S.init(M_TOT, 2048, naw, aw);
              pg8::EpiBf16<2> E{(bf16*)(F.ws + WS_KV), 2048, (const float*)(F.ws + WS_RSKV)};
              pg8::gemm_phase<pg8::EpiBf16<2>, pg8::StaticOrder, true, true>(F.lds, g, S, E); }
            SUB_BAR();
            if (PH(9)) for (int it = aw; it < 512; it += naw) mla_item(F, it >> 8, (it >> 5) & 7, it & 31, false);
            if (PH(9) && wctx) for (int it = aw; it < 16; it += naw) mla_item(F, it >> 3, it & 7, 0, true);
            if (PH(10)) for (int it = aw; it < 512; it += naw) swa_item(F, l, it >> 8, (it >> 2) & 63, (it >> 1) & 1, it & 1, false, 0);
            if (PH(10) && wctx) for (int it = aw; it < 16; it += naw) swa_item(F, l, it >> 3, 0, 0, 0, true, it & 7);
            if (PH(11)) { if (naw == 192) { const int i0 = aw < 128 ? aw : 1280 + aw - 128, st_ = aw < 128 ? 128 : 64, i1 = aw < 128 ? 1280 : 2 * NCH * 8;
                                            for (int it = i0; it < i1; it += st_) { if (!wctx && ((it >> 3) % NCH) < 8) continue; lru_item<true>(F, l, it); } }
                          else for (int it = aw; it < 2 * NCH * 8; it += naw) { if (!wctx && ((it >> 3) % NCH) < 8) continue; lru_item<true>(F, l, it); } }
            if (l == 0) { __syncthreads(); convert_weights(F, 1, aw * NWAVES + F.wave, naw * NWAVES); }
            else { SUB_BAR();
                pg8::Gemm g{(const bf16*)(F.ws + WS_MIX), (const bf16*)(F.wsw + WS_WOUT), M_LAT, DM, W_OUT_K1, DM, DM}; pg8::StaticOrder S; S.init(M_LAT, DM, naw, aw);
                pg8::EpiBf16<0> E{(bf16*)(F.ws + WS_Y1), DM, nullptr};
                pg8::gemm_phase<pg8::EpiBf16<0>, pg8::StaticOrder, true, true>(F.lds, g, S, E); }
        }
        GRID_BAR();
        REP(12) if (PH(12)) for (int row = F.gw; row < MO; row += F.NGW) rwkv_out_row(F, l, row);
        GRID_BAR();
        REP(13) if (PH(13)) {
          if (l == 0) { pg8::Gemm g{(const bf16*)(F.ws + WS_MIX), (const bf16*)(F.wsw + WS_WOUT), M_LAT, DM, DM, DM, DM}; pg8::StaticOrder S; S.init(M_LAT, DM, F.G, bx);
            pg8::EpiBf16<0> E{(bf16*)(F.ws + WS_Y1), DM, nullptr};
            pg8::gemm_phase<pg8::EpiBf16<0>, pg8::StaticOrder, true, true>(F.lds, g, S, E); }
          else { pg8::Gemm g{(const bf16*)(F.ws + WS_MIX) + W_OUT_K1, (const bf16*)(F.wsw + WS_WOUT) + W_OUT_K1, M_LAT, DM, DM - W_OUT_K1, DM, DM}; pg8::StaticOrder S; S.init(M_LAT, DM, F.G, bx);
            pg8::EpiBf16<3> E{(bf16*)(F.ws + WS_Y1), DM, nullptr};
            pg8::gemm_phase<pg8::EpiBf16<3>, pg8::StaticOrder, true, true>(F.lds, g, S, E); }
          if (wctx) {
              pg8::Gemm g2{(const bf16*)(F.ws + WS_MIX) + (size_t)M_LAT * DM, (const bf16*)(F.wsw + WS_WOUT), M_CTX, DM, DM / 8, DM, DM}; pg8::SplitOrder S2; S2.init(M_CTX, DM, DM / 8, bx);
              pg8::EpiF32 E2{(float*)(F.ws + WS_YP), DM, (size_t)M_CTX * DM};
              pg8::gemm_phase<pg8::EpiF32, pg8::SplitOrder, true, true>(F.lds, g2, S2, E2); } }
        GRID_BAR();
        if (PH(14)) for (int row = F.gw; row < MO; row += F.NGW) { const int s = row_s(row);
            const float* xs = (l == 0) ? (row < M_LAT ? F.A->in[I_X] + (size_t)row * DM : F.A->in[I_CTX] + (size_t)(row - M_LAT) * DM) : X + (size_t)row * DM;
            bf16* yrow = (bf16*)(F.ws + WS_Y1) + (size_t)row * DM;
            if (row >= M_LAT) sum_partials_row(F, (const float*)(F.ws + WS_YP) + (size_t)(row - M_LAT) * DM, (size_t)M_CTX * DM, yrow);
            ln_row<1>(F, xs, yrow, mod_ptr(F, l, s, 2), F.A->in[I_LN1G] + l * DM, F.A->in[I_LN1B] + l * DM, X + (size_t)row * DM,
                      true, mod_ptr(F, l, s, 4), mod_ptr(F, l, s, 3), H + (size_t)row * DM); }
        GRID_BAR();
        REP(15) if (PH(15)) { pg8::Gemm g{H, (const bf16*)(F.wsw + WS_WFF1), MO, DFF, DM, DM, DM}; pg8::StaticOrder S; S.init(MO, DFF, F.G, bx);
          pg8::EpiBf16<1> E{(bf16*)(F.ws + WS_HID), DFF, nullptr};
          pg8::gemm_phase<pg8::EpiBf16<1>, pg8::StaticOrder, true, true>(F.lds, g, S, E); }
        GRID_BAR();
        REP(16) if (PH(16)) { pg8::Gemm g{(const bf16*)(F.ws + WS_HID), (const bf16*)(F.wsw + WS_WFF2), M_LAT, DM, DFF, DFF, DFF}; pg8::StaticOrder S; S.init(M_LAT, DM, F.G, bx);
          pg8::EpiBf16<0> E{(bf16*)(F.ws + WS_Y2), DM, nullptr};
          pg8::gemm_phase<pg8::EpiBf16<0>, pg8::StaticOrder, true, true>(F.lds, g, S, E);
          if (wctx) {
              pg8::Gemm g2{(const bf16*)(F.ws + WS_HID) + (size_t)M_LAT * DFF, (const bf16*)(F.wsw + WS_WFF2), M_CTX, DM, DFF / 8, DFF, DFF}; pg8::SplitOrder S2; S2.init(M_CTX, DM, DFF / 8, bx);
              pg8::EpiF32 E2{(float*)(F.ws + WS_YP), DM, (size_t)M_CTX * DM};
              pg8::gemm_phase<pg8::EpiF32, pg8::SplitOrder, true, true>(F.lds, g2, S2, E2); } }
        GRID_BAR();
        if (!PH(17)) {} else if (l == 0) {
            for (int row = F.gw; row < M_TOT; row += F.NGW) { const int s = row_s(row);
                bf16* yrow = (bf16*)(F.ws + WS_Y2) + (size_t)row * DM;
                if (row >= M_LAT) sum_partials_row(F, (const float*)(F.ws + WS_YP) + (size_t)(row - M_LAT) * DM, (size_t)M_CTX * DM, yrow);
                ln_row<1>(F, X + (size_t)row * DM, yrow, mod_ptr(F, 0, s, 5), F.A->in[I_LN2G], F.A->in[I_LN2B], X + (size_t)row * DM,
                          true, mod_ptr(F, 1, s, 1), mod_ptr(F, 1, s, 0), H + (size_t)row * DM); }
        } else {
            for (int row = F.gw; row < M_LAT; row += F.NGW) { const int s = row_s(row);
                ln_row<1>(F, X + (size_t)row * DM, (const bf16*)(F.ws + WS_Y2) + (size_t)row * DM, mod_ptr(F, 1, s, 5), F.A->in[I_LN2G] + DM, F.A->in[I_LN2B] + DM, F.out + (size_t)row * DM,
                          false, nullptr, nullptr, nullptr); }
        }
    }
}

extern "C" void kernel_launch(void* const* d_in, const int* in_sizes, int n_in, void* d_out, int out_size, void* d_ws, size_t ws_size, hipStream_t stream) {
    static int grid = 0;
    if (grid == 0) {
        if (n_in != 38 || out_size != M_LAT * DM || ws_size < WS_END) { fprintf(stderr, "kernel_launch: unexpected shapes: n_in %d out %d ws %zu (need %zu)\n", n_in, out_size, ws_size, (size_t)WS_END); grid = -1; return; }
        int dev = 0, cus = 0, per_cu = 0;
        if (hipGetDevice(&dev) != hipSuccess || hipDeviceGetAttribute(&cus, hipDeviceAttributeMultiprocessorCount, dev) != hipSuccess) { grid = -1; return; }
        if (hipFuncSetAttribute((const void*)mk_fwd, hipFuncAttributeMaxDynamicSharedMemorySize, LDS_BYTES) != hipSuccess) { fprintf(stderr, "kernel_launch: hipFuncSetAttribute failed\n"); grid = -1; return; }
        if (hipOccupancyMaxActiveBlocksPerMultiprocessor(&per_cu, (const void*)mk_fwd, NTHR, LDS_BYTES) != hipSuccess || per_cu < 1) fprintf(stderr, "kernel_launch: occupancy query says %d\n", per_cu);
        (void)hipGetLastError();
        grid = cus;
    }
    if (grid < 0) return;
    if (hipMemsetAsync((char*)d_ws + WS_CTL, 0, CTL_ZERO_BYTES, stream) != hipSuccess) return;
    Args a{};
    for (int i = 0; i < 38; ++i) a.in[i] = (const float*)d_in[i];
    a.out = (float*)d_out; a.ws = (unsigned char*)d_ws;
    hipLaunchKernelGGL(mk_fwd, dim3(grid), dim3(NTHR), LDS_BYTES, stream, a);
    const hipError_t le = hipPeekAtLastError();
    if (le != hipSuccess) fprintf(stderr, "kernel_launch: launch failed: %s\n", hipGetErrorName(le));
}
```

```cpp
#include <hip/hip_runtime.h>
#include <hip/hip_bf16.h>
#include <cstdio>
#include <cstdint>

namespace pg8 {
#define PG8_LAS __attribute__((address_space(3)))
typedef unsigned short bf16_t;
typedef short bf16x8 __attribute__((ext_vector_type(8)));
typedef float f32x4 __attribute__((ext_vector_type(4)));
typedef unsigned u32x4 __attribute__((ext_vector_type(4)));
constexpr int BM = 256, BK = 64, HALF = 128, HTB = HALF * BK * 2  , STAGE_BYTES = 8 * HTB, NXCD = 8, WGM = 8;

__host__ __device__ __forceinline__ int lds_byte(int r, int c) { const int st = (r >> 4) * 2 + (c >> 5), rr = r & 15, cc = c & 31, ob = rr * 64 + cc * 2; return st * 1024 + (ob ^ (((ob >> 9) & 1) << 5)); }
__host__ __device__ __forceinline__ void stage_rc(int b, int& R, int& C) { const int st = b / 1024, sb = b % 1024, swz = sb ^ (((sb >> 9) & 1) << 5); R = (st >> 1) * 16 + swz / 64; C = (st & 1) * 32 + (swz % 64) / 2; }
__host__ __device__ __forceinline__ int perm32(int rho) { const int n = rho >> 4, i = rho & 15; return 8 * (i >> 2) + 4 * n + (i & 3); }

struct Unit { int pm, pn, ko, ks; };
struct Gemm { const bf16_t* A; const bf16_t* Bt; int M, N, K, lda, ldb; };

struct StaticOrder {
    int nM, nN, nwg, G, c;
    __host__ __device__ void init(int M, int N, int G_, int c_) { nM = M / BM; nN = N / BM; nwg = nM * nN; G = G_; c = c_; }
    __host__ __device__ bool next(int i, Unit& u) const {
        const long L = (long)i * G + c; if (L >= nwg) return false;
        int wgid = (int)L; { const int q = nwg / NXCD, r = nwg % NXCD, xcd = wgid % NXCD, off = wgid / NXCD; wgid = (xcd < r ? xcd * (q + 1) : r * (q + 1) + (xcd - r) * q) + off; }
        const int nig = WGM * nN, gid = wgid / nig, fm = gid * WGM, gsz = (nM - fm) < WGM ? (nM - fm) : WGM;
        u.pm = fm + ((wgid % nig) % gsz); u.pn = (wgid % nig) / gsz; u.ko = 0; u.ks = 0; return true;
    }
    __device__ __forceinline__ void a_ready(const Unit&) const {}
    __device__ __forceinline__ void done(const Unit&) const {}
};
struct SplitOrder {
    int nN, nitems, kslice, c;
    __host__ __device__ void init(int M, int N, int Kslice, int c_) { nN = N / BM; nitems = (M / BM) * nN * 8; kslice = Kslice; c = c_; }
    __host__ __device__ bool next(int i, Unit& u) const { if (i > 0 || c >= nitems) return false; u.ks = c & 7; u.ko = u.ks * kslice; u.pn = (c >> 3) % nN; u.pm = (c >> 3) / nN; return true; }
    __device__ __forceinline__ void a_ready(const Unit&) const {}
    __device__ __forceinline__ void done(const Unit&) const {}
};

__device__ __forceinline__ unsigned cvt_pk_bf16(float lo, float hi) { unsigned r; asm volatile("v_cvt_pk_bf16_f32 %0, %1, %2" : "=v"(r) : "v"(lo), "v"(hi)); return r; }

struct EpiF32 {
    static constexpr bool PERM = false, AFTER_DRAIN = false;
    float* C; int ldc; size_t split_stride;
    __device__ __forceinline__ void operator()(const f32x4 (&acc)[2][2][4][2], const Unit& u, int wr, int wc, int fr, int fq) const {
        const int row0 = u.pm * BM + wr * 64 + fr, col0 = u.pn * BM + wc * 32 + 4 * fq; float* Cb = C + (size_t)u.ks * split_stride;
#pragma unroll
        for (int ai = 0; ai < 2; ++ai)
#pragma unroll
            for (int m = 0; m < 4; ++m) { float* rowp = Cb + (size_t)(row0 + ai * HALF + m * 16) * ldc + col0;
#pragma unroll
                for (int bj = 0; bj < 2; ++bj)
#pragma unroll
                    for (int n = 0; n < 2; ++n) *(f32x4*)(rowp + bj * HALF + n * 16) = acc[ai][bj][m][n]; }
    }
};
template <int ACT> struct EpiBf16 {
    static constexpr bool PERM = true, AFTER_DRAIN = false;
    bf16_t* O; int ldc; const float* rowscale;
    __device__ __forceinline__ void operator()(const f32x4 (&acc)[2][2][4][2], const Unit& u, int wr, int wc, int fr, int fq) const {
        const int row0 = u.pm * BM + wr * 64 + fr; const int col0 = u.pn * BM + wc * 32 + 8 * fq;
#pragma unroll
        for (int ai = 0; ai < 2; ++ai)
#pragma unroll
            for (int m = 0; m < 4; ++m) { const int row = row0 + ai * HALF + m * 16; bf16_t* rowp = O + (size_t)row * ldc + col0;
                float rs = 1.f; if (ACT == 2) rs = rowscale[row];
#pragma unroll
                for (int bj = 0; bj < 2; ++bj) { f32x4 v0 = acc[ai][bj][m][0], v1 = acc[ai][bj][m][1];
                    if (ACT == 1) {
#pragma unroll
                        for (int j = 0; j < 4; ++j) { const float a = fmaxf(v0[j], 0.f), b = fmaxf(v1[j], 0.f); v0[j] = a * a; v1[j] = b * b; } }
                    if (ACT == 2) { v0 = v0 * rs; v1 = v1 * rs; }
                    if (ACT == 3) { const u32x4 o = *(const u32x4*)(rowp + bj * HALF);
                        v0[0] += __builtin_bit_cast(float, o.x << 16); v0[1] += __builtin_bit_cast(float, o.x & 0xffff0000u); v0[2] += __builtin_bit_cast(float, o.y << 16); v0[3] += __builtin_bit_cast(float, o.y & 0xffff0000u);
                        v1[0] += __builtin_bit_cast(float, o.z << 16); v1[1] += __builtin_bit_cast(float, o.z & 0xffff0000u); v1[2] += __builtin_bit_cast(float, o.w << 16); v1[3] += __builtin_bit_cast(float, o.w & 0xffff0000u); }
                    u32x4 w; w.x = cvt_pk_bf16(v0[0], v0[1]); w.y = cvt_pk_bf16(v0[2], v0[3]); w.z = cvt_pk_bf16(v1[0], v1[1]); w.w = cvt_pk_bf16(v1[2], v1[3]);
                    *(u32x4*)(rowp + bj * HALF) = w; } }
    }
};

template <class Epi, class Sched, bool ALIGN_EPI = false, bool SP2 = false>
__device__ __forceinline__ void gemm_phase(PG8_LAS unsigned char* lds, const Gemm g, const Sched& S, const Epi& E) {
    int tid = threadIdx.x; asm volatile("" : "+v"(tid));
    const int wid = __builtin_amdgcn_readfirstlane(tid >> 6), lane = tid & 63, wr = wid >> 2, wc = wid & 3, fr = lane & 15, fq = lane >> 4;
    const int K = g.K, nt = K / BK, lda = g.lda, ldb = g.ldb;
    unsigned voffA[2], voffB[2];
#pragma unroll
    for (int i = 0; i < 2; ++i) { int R, C; stage_rc(tid * 16 + i * 8192, R, C); const int Rb = Epi::PERM ? ((R & ~31) + perm32(R & 31)) : R;
        voffA[i] = (unsigned)(R * lda + C) * 2u; voffB[i] = (unsigned)(Rb * ldb + C) * 2u; }
    const size_t kstep = (size_t)(BK * 2);
    const size_t hstepA = (size_t)HALF * lda * 2, hstepB = (size_t)HALF * ldb * 2;
    const size_t tstepA = 2 * hstepA, tstepB = 2 * hstepB;
    const unsigned ldsw = (unsigned)wid * 1024u;
    const int aoff = lds_byte(wr * 64 + fr, fq * 8), boff = lds_byte(wc * 32 + fr, fq * 8);
#define PG8_SA(b, h) (((b) * 2 + (h)) * HTB)
#define PG8_SB(b, h) ((4 + (b) * 2 + (h)) * HTB)
#define PG8_STAGE(bufoff, gbase, voff) do { _Pragma("unroll") for (int _i = 0; _i < 2; ++_i) \
        __builtin_amdgcn_global_load_lds((const unsigned*)((const char*)(gbase) + (voff)[_i]), (PG8_LAS unsigned*)(lds + (bufoff) + ldsw + _i * 8192), 16, 0, 0); } while (0)
#define PG8_LDA(dst, b, h) do { _Pragma("unroll") for (int m = 0; m < 4; ++m) _Pragma("unroll") for (int k = 0; k < 2; ++k) dst[m][k] = *(const PG8_LAS bf16x8*)(lds + PG8_SA(b, h) + aoff + m * 2048 + k * 1024); } while (0)
#define PG8_LDB(dst, b, h) do { _Pragma("unroll") for (int n = 0; n < 2; ++n) _Pragma("unroll") for (int k = 0; k < 2; ++k) dst[n][k] = *(const PG8_LAS bf16x8*)(lds + PG8_SB(b, h) + boff + n * 2048 + k * 1024); } while (0)
#define PG8_MMA(ai, bj, At, Bt) do { __builtin_amdgcn_s_setprio(1); _Pragma("unroll") for (int m = 0; m < 4; ++m) _Pragma("unroll") for (int n = 0; n < 2; ++n) _Pragma("unroll") for (int k = 0; k < 2; ++k) \
        acc[ai][bj][m][n] = __builtin_amdgcn_mfma_f32_16x16x32_bf16(Bt[n][k], At[m][k], acc[ai][bj][m][n], 0, 0, 0); __builtin_amdgcn_s_setprio(0); } while (0)
#define PG8_WAIT_V(n) asm volatile("s_waitcnt vmcnt(" #n ")" ::: "memory")
#define PG8_WAIT_L(n) asm volatile("s_waitcnt lgkmcnt(" #n ")" ::: "memory")
#define PG8_BAR __builtin_amdgcn_s_barrier()
#define PG8_SCHED __builtin_amdgcn_sched_barrier(0)
    Unit cur, nxt; int ui = 0;
    if (!S.next(0, cur)) return;
    f32x4 acc[2][2][4][2];
#pragma unroll
    for (int a = 0; a < 2; ++a)
#pragma unroll
        for (int b = 0; b < 2; ++b)
#pragma unroll
            for (int m = 0; m < 4; ++m)
#pragma unroll
                for (int n = 0; n < 2; ++n) acc[a][b][m][n] = (f32x4){0.f, 0.f, 0.f, 0.f};
    bf16x8 At[4][2], B0[2][2], B1[2][2];
    const char* cA = (const char*)g.A + (size_t)cur.pm * tstepA + (size_t)cur.ko * 2; const char* cB = (const char*)g.Bt + (size_t)cur.pn * tstepB + (size_t)cur.ko * 2;
    S.a_ready(cur);
    if constexpr (SP2) {
        PG8_STAGE(PG8_SB(0, 0), cB, voffB); PG8_STAGE(PG8_SB(0, 1), cB + hstepB, voffB); PG8_STAGE(PG8_SA(0, 0), cA, voffA); PG8_STAGE(PG8_SA(0, 1), cA + hstepA, voffA);
        if (wr == 1) PG8_BAR;
        PG8_WAIT_V(2); PG8_BAR;
        PG8_STAGE(PG8_SB(1, 0), cB + kstep, voffB); PG8_STAGE(PG8_SA(1, 0), cA + kstep, voffA); PG8_STAGE(PG8_SB(1, 1), cB + hstepB + kstep, voffB);
        PG8_WAIT_V(6); PG8_BAR;
    } else {
        PG8_STAGE(PG8_SB(0, 0), cB, voffB); PG8_STAGE(PG8_SA(0, 0), cA, voffA); PG8_STAGE(PG8_SB(0, 1), cB + hstepB, voffB); PG8_STAGE(PG8_SA(0, 1), cA + hstepA, voffA);
        if (wr == 1) PG8_BAR;
        PG8_WAIT_V(4); PG8_BAR;
        PG8_STAGE(PG8_SB(1, 0), cB + kstep, voffB); PG8_STAGE(PG8_SA(1, 0), cA + kstep, voffA); PG8_STAGE(PG8_SB(1, 1), cB + hstepB + kstep, voffB);
        PG8_WAIT_V(6); PG8_BAR;
    }
    for (;;) {
        const bool has_next = S.next(ui + 1, nxt);
        const char* nA = has_next ? (const char*)g.A + (size_t)nxt.pm * tstepA + (size_t)nxt.ko * 2 : cA; const char* nB = has_next ? (const char*)g.Bt + (size_t)nxt.pn * tstepB + (size_t)nxt.ko * 2 : cB;
        for (int t = 0; t < nt; t += 2) {
            const bool last = (t == nt - 2);
            const char* a1 = cA + (size_t)(t + 1) * kstep;
            const char* a2 = last ? nA : cA + (size_t)(t + 2) * kstep; const char* b2 = last ? nB : cB + (size_t)(t + 2) * kstep;
            const char* a3 = a2 + kstep; const char* b3 = b2 + kstep;
            if (last && has_next) S.a_ready(nxt);
            if constexpr (SP2) {
            PG8_LDB(B0, 0, 0); PG8_LDB(B1, 0, 1); PG8_SCHED; PG8_LDA(At, 0, 0); PG8_STAGE(PG8_SA(1, 1), a1 + hstepA, voffA);
            PG8_WAIT_V(8); PG8_WAIT_L(0); PG8_BAR; PG8_MMA(0, 0, At, B0); PG8_MMA(0, 1, At, B1); PG8_BAR; PG8_SCHED;
            PG8_LDA(At, 0, 1); PG8_STAGE(PG8_SB(0, 0), b2, voffB); PG8_STAGE(PG8_SB(0, 1), b2 + hstepB, voffB); PG8_STAGE(PG8_SA(0, 0), a2, voffA);
            PG8_WAIT_V(8); PG8_WAIT_L(0); PG8_BAR; PG8_MMA(1, 0, At, B0); PG8_MMA(1, 1, At, B1); PG8_BAR; PG8_SCHED;
            PG8_LDB(B0, 1, 0); PG8_LDB(B1, 1, 1); PG8_SCHED; PG8_LDA(At, 1, 0); PG8_STAGE(PG8_SA(0, 1), a2 + hstepA, voffA);
            PG8_WAIT_V(8); PG8_WAIT_L(0); PG8_BAR; PG8_MMA(0, 0, At, B0); PG8_MMA(0, 1, At, B1); PG8_BAR; PG8_SCHED;
            PG8_LDA(At, 1, 1); PG8_STAGE(PG8_SB(1, 0), b3, voffB); PG8_STAGE(PG8_SB(1, 1), b3 + hstepB, voffB); PG8_STAGE(PG8_SA(1, 0), a3, voffA);
            PG8_WAIT_V(8); PG8_WAIT_L(0); PG8_BAR; PG8_MMA(1, 0, At, B0); PG8_MMA(1, 1, At, B1); PG8_BAR; PG8_SCHED;
            } else {
            PG8_LDB(B0, 0, 0); PG8_SCHED; PG8_LDA(At, 0, 0); PG8_STAGE(PG8_SA(1, 1), a1 + hstepA, voffA);
            PG8_WAIT_L(8); PG8_BAR; PG8_WAIT_L(0); PG8_MMA(0, 0, At, B0); PG8_BAR; PG8_SCHED;
            PG8_LDB(B1, 0, 1); PG8_STAGE(PG8_SB(0, 0), b2, voffB);
            PG8_BAR; PG8_WAIT_L(0); PG8_MMA(0, 1, At, B1); PG8_BAR;
            PG8_LDA(At, 0, 1); PG8_STAGE(PG8_SA(0, 0), a2, voffA);
            PG8_BAR; PG8_WAIT_L(0); PG8_MMA(1, 0, At, B0); PG8_BAR; PG8_SCHED;
            PG8_STAGE(PG8_SB(0, 1), b2 + hstepB, voffB);
            PG8_WAIT_V(6); PG8_BAR; PG8_MMA(1, 1, At, B1); PG8_BAR;
            PG8_LDB(B0, 1, 0); PG8_SCHED; PG8_LDA(At, 1, 0); PG8_STAGE(PG8_SA(0, 1), a2 + hstepA, voffA);
            PG8_WAIT_L(8); PG8_BAR; PG8_WAIT_L(0); PG8_MMA(0, 0, At, B0); PG8_BAR; PG8_SCHED;
            PG8_LDB(B1, 1, 1); PG8_STAGE(PG8_SB(1, 0), b3, voffB);
            PG8_BAR; PG8_WAIT_L(0); PG8_MMA(0, 1, At, B1); PG8_BAR;
            PG8_LDA(At, 1, 1); PG8_STAGE(PG8_SA(1, 0), a3, voffA);
            PG8_BAR; PG8_WAIT_L(0); PG8_MMA(1, 0, At, B0); PG8_BAR; PG8_SCHED;
            PG8_STAGE(PG8_SB(1, 1), b3 + hstepB, voffB);
            PG8_WAIT_V(6); PG8_BAR; PG8_MMA(1, 1, At, B1); PG8_BAR;
            }
        }
        if constexpr (ALIGN_EPI) { if (wr == 0) PG8_BAR; }
        E(acc, cur, wr, wc, fr, fq); S.done(cur);
        if (!has_next) break;
#pragma unroll
        for (int a = 0; a < 2; ++a)
#pragma unroll
            for (int b = 0; b < 2; ++b)
#pragma unroll
                for (int m = 0; m < 4; ++m)
#pragma unroll
                    for (int n = 0; n < 2; ++n) acc[a][b][m][n] = (f32x4){0.f, 0.f, 0.f, 0.f};
        cur = nxt; cA = nA; cB = nB; ++ui;
        if constexpr (ALIGN_EPI) { if (wr == 1) PG8_BAR; }
    }
    PG8_WAIT_V(0);
    if constexpr (!ALIGN_EPI) { if (wr == 0) PG8_BAR; }
    PG8_BAR;
#undef PG8_SA
#undef PG8_SB
#undef PG8_STAGE
#undef PG8_LDA
#undef PG8_LDB
#undef PG8_MMA
#undef PG8_WAIT_V
#undef PG8_WAIT_L
#undef PG8_BAR
#undef PG8_SCHED
}
}

constexpr int NWAVES = 8, NTHR = 512;
constexpr int DM = 4096, NB = 2, SEQ = 8192, NCTX = 256, DFF = 16384;
constexpr int M_LAT = NB * SEQ, M_CTX = NB * NCTX, M_TOT = M_LAT + M_CTX;
constexpr int DIN = 8672, DINP = 8704;
constexpr int C_SWAQ = 0, C_SWAK = 1024, C_SWAV = 1280, C_LRUX = 1536, C_LRUY = 2560, C_QA = 3584, C_KVA = 4608, C_KR = 5120, C_RW = 5184;
constexpr int C_RWR = C_RW, C_RWK = C_RW + 1024, C_RWV = C_RW + 2048, C_RWL = C_RW + 3072;
constexpr int RWC = 3488;
constexpr float LN_EPS = 1e-5f, RMS_EPS = 1e-6f, GN_EPS = 64e-5f, ALPHA = 1.41421356237f;
constexpr int NCH = 264;

constexpr size_t MiB = 1u << 20;
constexpr size_t WS_CTL = 0, CTL_ZERO_BYTES = 1 * MiB;
constexpr size_t WS_MOD = 1 * MiB;
constexpr size_t WS_MODP = 2 * MiB;
constexpr size_t WS_SMALL = 20 * MiB;
constexpr size_t WS_RSQ = WS_SMALL;
constexpr size_t WS_RSKV = WS_RSQ + 128 * 1024;
constexpr size_t WS_SB = WS_RSKV + 128 * 1024;
constexpr size_t WS_CA = WS_SB + 2 * MiB;
constexpr size_t WS_CB = WS_CA + 5 * MiB;
constexpr size_t WS_HIN = WS_CB + 5 * MiB;
constexpr size_t WS_QUIRK = WS_HIN + 5 * MiB;
constexpr size_t WS_ROPE = WS_QUIRK + 8192;
static_assert(WS_ROPE + 16384 <= 40 * MiB, "small region");
constexpr size_t WS_W = 40 * MiB;
constexpr size_t WS_WIN = WS_W, WS_WOUT = WS_WIN + 68 * MiB, WS_WFF1 = WS_WOUT + 32 * MiB, WS_WFF2 = WS_WFF1 + 128 * MiB, WS_WQB = WS_WFF2 + 128 * MiB,
                 WS_WKVB = WS_WQB + 3 * MiB, WS_WLRU = WS_WKVB + 2 * MiB, WS_WLORA = WS_WLRU + 1 * MiB;
constexpr size_t WS_W2T = WS_WLORA, WS_A2T = WS_W2T + 256 * 1024, WS_G2T = WS_A2T + 256 * 1024;
constexpr size_t WS_X = 403 * MiB;
constexpr size_t WS_H = 667 * MiB;
constexpr size_t WS_MIX = 799 * MiB;
constexpr size_t WS_YS = 931 * MiB;
constexpr size_t WS_P = 1063 * MiB;
constexpr size_t WS_RWF = 1344 * MiB;
constexpr size_t RWF_STRIDE = (size_t)M_TOT * 1024 * 2;
constexpr size_t WS_Q = 1641 * MiB;
constexpr size_t WS_KV = 1691 * MiB;
constexpr size_t WS_KR = 1757 * MiB;
constexpr size_t WS_SET2 = 1760 * MiB;
constexpr size_t WSET_STRIDE = WS_SET2 - WS_W;
constexpr size_t WS_END = WS_SET2 + 363 * MiB;
constexpr size_t WS_YP = WS_Q;
constexpr size_t WS_HID = WS_P;
constexpr size_t WS_Y1 = WS_P;
constexpr size_t WS_Y2 = WS_MIX;
static_assert(WS_WLORA + 1 * MiB <= WS_X && WS_P + (size_t)M_TOT * DINP * 2 <= WS_RWF && WS_RWF + 9 * RWF_STRIDE <= WS_Q, "ws map");
static_assert(WS_HID + (size_t)M_TOT * DFF * 2 <= WS_Q && WS_Y2 + (size_t)M_TOT * DM * 4 <= WS_P && WS_YS + 2 * (size_t)M_TOT * 1024 * 4 <= WS_P, "ws overlays");
static_assert(WS_KR + (size_t)M_TOT * 64 * 2 <= WS_SET2 && WS_YP + 8 * (size_t)M_CTX * DM * 4 <= WS_KR, "ws end");

constexpr int RING_BYTES = 131072;
constexpr int LDSCTL_OFF = RING_BYTES, MISC_OFF = LDSCTL_OFF + 320;
constexpr int LDS_BYTES = 147456;

#define GAS __attribute__((address_space(1)))
#define LAS __attribute__((address_space(3)))
typedef unsigned short bf16;
typedef unsigned v4u __attribute__((ext_vector_type(4)));
typedef unsigned v2u __attribute__((ext_vector_type(2)));
typedef float f32x4 __attribute__((ext_vector_type(4)));
typedef float f32x2 __attribute__((ext_vector_type(2)));
typedef float f32x16 __attribute__((ext_vector_type(16)));
typedef short bf16x8 __attribute__((ext_vector_type(8)));
typedef short s16x4 __attribute__((ext_vector_type(4)));
typedef GAS unsigned gu32;
typedef const GAS bf16* gcbf; typedef GAS bf16* gbfp; typedef const GAS float* gcfl; typedef GAS float* gflp;
#define LDS_WAIT() asm volatile("s_waitcnt lgkmcnt(0)" ::: "memory")
#define VM_WAIT() asm volatile("s_waitcnt vmcnt(0)" ::: "memory")
typedef __bf16 bf16x2_t __attribute__((ext_vector_type(2)));
__device__ __forceinline__ unsigned pk2(float lo, float hi) { const f32x2 v = {lo, hi}; const bf16x2_t b = __builtin_convertvector(v, bf16x2_t); return __builtin_bit_cast(unsigned, b); }
__device__ __forceinline__ unsigned f2bf(float f) { return pk2(f, f) & 0xffffu; }
__device__ __forceinline__ float bflo(unsigned w) { return __builtin_bit_cast(float, w << 16); }
__device__ __forceinline__ float bfhi(unsigned w) { return __builtin_bit_cast(float, w & 0xffff0000u); }
__device__ __forceinline__ float bf2f(bf16 h) { return __builtin_bit_cast(float, (unsigned)h << 16); }
#define DPP_ADD(x, ctrl) ((x) + __builtin_bit_cast(float, __builtin_amdgcn_update_dpp(0, __builtin_bit_cast(int, (x)), (ctrl), 0xf, 0xf, false)))
__device__ __forceinline__ float row_sum16(float x) { x = DPP_ADD(x, 0x128); x = DPP_ADD(x, 0x124); x = DPP_ADD(x, 0x122); x = DPP_ADD(x, 0x121); return x; }
#ifdef OLD_SUMS
__device__ __forceinline__ float wave_sum(float v) {
#pragma unroll
    for (int o = 1; o < 64; o <<= 1) v += __shfl_xor(v, o);
    return v;
}
__device__ __forceinline__ float half_swap_sum(float x) { return x + __shfl_xor(x, 32); }
__device__ __forceinline__ float quad_sum(float x) { x += __shfl_xor(x, 1); x += __shfl_xor(x, 2); return x; }
#else
__device__ __forceinline__ float wave_sum(float v) {
    const float r = row_sum16(v);
    const float a = __builtin_bit_cast(float, __builtin_amdgcn_readlane(__builtin_bit_cast(int, r), 0)), b = __builtin_bit_cast(float, __builtin_amdgcn_readlane(__builtin_bit_cast(int, r), 16));
    const float c = __builtin_bit_cast(float, __builtin_amdgcn_readlane(__builtin_bit_cast(int, r), 32)), d = __builtin_bit_cast(float, __builtin_amdgcn_readlane(__builtin_bit_cast(int, r), 48));
    return (a + b) + (c + d);
}
__device__ __forceinline__ float half_swap_sum(float x) {
    unsigned a = __builtin_bit_cast(unsigned, x), b = a; asm volatile("" : "+v"(b));
    auto rr = __builtin_amdgcn_permlane32_swap(a, b, false, false);
    const float lo = __uint_as_float(rr[0]), hi = __uint_as_float(rr[1]); return lo + hi;
}
__device__ __forceinline__ float quad_sum(float x) { x = DPP_ADD(x, 0xB1); x = DPP_ADD(x, 0x4E); return x; }
#endif
__device__ __forceinline__ float sigmoidf_(float x) { return __builtin_amdgcn_rcpf(1.f + __expf(-x)); }
__device__ __forceinline__ float softplusf_(float x) { return x > 20.f ? x : __logf(1.f + __expf(x)); }
__device__ __forceinline__ float tanhf_(float x) { const float e = __expf(2.f * x); return 1.f - 2.f * __builtin_amdgcn_rcpf(e + 1.f); }
__device__ __forceinline__ int ltid() { int t = threadIdx.x; asm volatile("" : "+v"(t)); return t; }
template <class T> __device__ __forceinline__ T ldg(const void* base, unsigned byteoff) { return *(const T*)((const char*)base + byteoff); }
template <class T> __device__ __forceinline__ void stg(void* base, unsigned byteoff, T v) { *(T*)((char*)base + byteoff) = v; }

#define XB_TMO      128
#define XB_XCNT(j)  (256  + 64 * (j))
#define XB_XSUB(j)  (1280 + 64 * (j))
#define XB_XGEN(j)  (2304 + 64 * (j))
#define XB_TOP      3328
#define XB_TOPGEN   3392
#define XCD_BAR_WORDS 3456
#define XB_SPIN_CAP (1u << 18)

__device__ __forceinline__ unsigned xb_ld(unsigned* p)              { return __hip_atomic_load(p, __ATOMIC_RELAXED, __HIP_MEMORY_SCOPE_AGENT); }
__device__ __forceinline__ unsigned xb_add(unsigned* p, unsigned v) { return __hip_atomic_fetch_add(p, v, __ATOMIC_RELAXED, __HIP_MEMORY_SCOPE_AGENT); }
__device__ __forceinline__ unsigned xb_xcc_id() { return (unsigned)__builtin_amdgcn_s_getreg((3 << 11) | 20) & 0xFu; }
#define XB_SPIN(cond, bar) do { unsigned _sp = 0; while (cond) { __builtin_amdgcn_s_sleep(1); \
    if ((++_sp & 255u) == 0u) { if (xb_ld(&(bar)[XB_TMO])) break; if (_sp > XB_SPIN_CAP) { atomicAdd(&(bar)[XB_TMO], 1u); break; } } } } while (0)

struct XcdBarrier {
    unsigned* bar; unsigned x;
    unsigned nparts;
    volatile LAS unsigned* st;
};

__device__ __forceinline__ XcdBarrier xcd_barrier_post(unsigned* bar, volatile LAS unsigned* st) {
    XcdBarrier b; b.bar = bar; b.x = xb_xcc_id(); b.st = st; b.nparts = 0u;
    if (threadIdx.x == 0) (void)xb_add(&bar[XB_XCNT(b.x)], 1u);
    return b;
}
__device__ __forceinline__ void xcd_barrier_complete(unsigned* bar, unsigned x, unsigned& nloc, unsigned& nx, unsigned nparts) {
    const unsigned G = nparts ? nparts : gridDim.x * gridDim.y * gridDim.z;
    unsigned sum, cnt, mine, sp = 0u;
    for (;;) {
        sum = 0u; cnt = 0u; mine = 0u;
#pragma unroll
        for (unsigned j = 0; j < 16; ++j) { const unsigned c = xb_ld(&bar[XB_XCNT(j)]); sum += c; cnt += (c > 0u) ? 1u : 0u; mine = (j == x) ? c : mine; }
        if (sum == G) break;
        __builtin_amdgcn_s_sleep(1);
        if ((++sp & 255u) == 0u) { if (xb_ld(&bar[XB_TMO])) break; if (sp > XB_SPIN_CAP) { atomicAdd(&bar[XB_TMO], 1u); break; } }
    }
    nloc = mine > 0u ? mine : 1u; nx = cnt > 0u ? cnt : 1u;
}

__device__ __forceinline__ void xcd_barrier(const XcdBarrier& b) {
    asm volatile("s_waitcnt vmcnt(0)" ::: "memory");
    __syncthreads();
    if (threadIdx.x == 0) {
        unsigned* bar = b.bar;
        __builtin_amdgcn_s_waitcnt(0);
        unsigned nloc = b.st[0], nx = b.st[1];
        if (nloc == 0u) { xcd_barrier_complete(bar, b.x, nloc, nx, b.nparts); b.st[0] = nloc; b.st[1] = nx; }
        const unsigned old = xb_add(&bar[XB_XSUB(b.x)], 1u);
        const unsigned gen = old / nloc;
        if (old + 1u == (gen + 1u) * nloc) {
            __builtin_amdgcn_fence(__ATOMIC_RELEASE, "agent");
            asm volatile("s_waitcnt vmcnt(0)" ::: "memory");
            const unsigned og = xb_add(&bar[XB_TOP], 1u);
            const unsigned tg = og / nx;
            if (og + 1u == (tg + 1u) * nx) xb_add(&bar[XB_TOPGEN], 1u);
            else XB_SPIN(xb_ld(&bar[XB_TOPGEN]) == tg, bar);
            __builtin_amdgcn_fence(__ATOMIC_ACQUIRE, "agent");
            xb_add(&bar[XB_XGEN(b.x)], 1u);
            asm volatile("s_waitcnt vmcnt(0)" ::: "memory");
        } else {
            XB_SPIN(xb_ld(&bar[XB_XGEN(b.x)]) == gen, bar);
            __builtin_amdgcn_fence(__ATOMIC_ACQUIRE, "agent");
            asm volatile("s_waitcnt vmcnt(0)" ::: "memory");
        }
    }
    __syncthreads();
}


namespace att {
constexpr int KVBLK = 64;
constexpr float THR = 8.f;
#define SBAR() __builtin_amdgcn_sched_barrier(0)
__device__ __forceinline__ int crow(int r, int hi) { return (r & 3) + 8 * (r >> 2) + 4 * hi; }
__device__ __forceinline__ unsigned cvtpk(float lo, float hi) { return pk2(lo, hi); }
template <int DQK> __device__ __forceinline__ int kswz(int row, int cb) { return row * (DQK * 2 + 16) + cb; }

template <int DQK> __device__ __forceinline__ void partialSM(f32x16& p0, f32x16& p1, float& m_reg, float& mn, float& alpha) {
  constexpr float SCALE = DQK == 128 ? 0.088388347648318440f : 0.072168783648703220f;
  constexpr float C = SCALE * 1.4426950408889634f;
  float pmax = p0[0];
#pragma unroll
  for (int r = 1; r < 16; ++r) pmax = fmaxf(pmax, p0[r]);
#pragma unroll
  for (int r = 0; r < 16; ++r) pmax = fmaxf(pmax, p1[r]);
  { auto rr = __builtin_amdgcn_permlane32_swap(__float_as_uint(pmax), __float_as_uint(pmax), false, false);
    pmax = fmaxf(__uint_as_float(rr[0]), __uint_as_float(rr[1])); }
  if (__builtin_expect(__all(pmax - m_reg <= THR / SCALE), 1)) { mn = m_reg; alpha = 1.f; }
  else { mn = fmaxf(m_reg, pmax); alpha = __builtin_amdgcn_exp2f((m_reg - mn) * C); m_reg = mn; }
  const float mnC = -mn * C;
#pragma unroll
  for (int r = 0; r < 16; ++r) p0[r] = fmaf(p0[r], C, mnC);
#pragma unroll
  for (int r = 0; r < 16; ++r) p1[r] = fmaf(p1[r], C, mnC);
#pragma unroll
  for (int r = 0; r < 16; ++r) p0[r] = __builtin_amdgcn_exp2f(p0[r]);
}
__device__ __forceinline__ void finishSM(f32x16& p0, f32x16& p1, float alpha, float& l_reg, bf16x8& pa0, bf16x8& pa1, bf16x8& pa2, bf16x8& pa3) {
#pragma unroll
  for (int r = 0; r < 16; ++r) p1[r] = __builtin_amdgcn_exp2f(p1[r]);
  float ps = 0;
#pragma unroll
  for (int r = 0; r < 16; ++r) ps += p0[r];
#pragma unroll
  for (int r = 0; r < 16; ++r) ps += p1[r];
  { auto rr = __builtin_amdgcn_permlane32_swap(__float_as_uint(ps), __float_as_uint(ps), false, false);
    ps = __uint_as_float(rr[0]) + __uint_as_float(rr[1]); }
  l_reg = l_reg * alpha + ps;
#define PK4(P, BASE, OUT) do { unsigned a0 = cvtpk(P[BASE + 0], P[BASE + 1]), a1 = cvtpk(P[BASE + 2], P[BASE + 3]);   \
    unsigned b0 = cvtpk(P[BASE + 4], P[BASE + 5]), b1 = cvtpk(P[BASE + 6], P[BASE + 7]);                              \
    auto r0 = __builtin_amdgcn_permlane32_swap(a0, b0, false, false); auto r1 = __builtin_amdgcn_permlane32_swap(a1, b1, false, false); \
    v4u w = {r0[0], r1[0], r0[1], r1[1]}; OUT = __builtin_bit_cast(bf16x8, w); } while (0)
  PK4(p0, 0, pa0); PK4(p0, 8, pa1); PK4(p1, 0, pa2); PK4(p1, 8, pa3);
#undef PK4
}
template <int DQK> __device__ __forceinline__ void qkt(f32x16& p0, f32x16& p1, const LAS char* Ks, const bf16x8* qr, const LAS char* qx, int r32, int hi) {
  p0 = f32x16{}; p1 = f32x16{};
#pragma unroll
  for (int d0 = 0; d0 < DQK / 16; ++d0) { const int cb = (d0 * 16 + hi * 8) * 2;
    bf16x8 b0 = *(const LAS bf16x8*)(Ks + kswz<DQK>(r32, cb));
    bf16x8 b1 = *(const LAS bf16x8*)(Ks + kswz<DQK>(32 + r32, cb));
    bf16x8 q; if (d0 < 8) q = qr[d0]; else q = *(const LAS bf16x8*)(qx + (d0 - 8) * 32);
    p0 = __builtin_amdgcn_mfma_f32_32x32x16_bf16(b0, q, p0, 0, 0, 0);
    p1 = __builtin_amdgcn_mfma_f32_32x32x16_bf16(b1, q, p1, 0, 0, 0);
    if ((d0 & 3) == 3 && d0 + 1 < DQK / 16) SBAR(); }
}
__device__ __forceinline__ int v_st(int k, int c) { const int kk = (k & ~0xC) | ((k & 4) << 1) | ((k & 8) >> 1); return ((kk >> 3) * 4 + (c >> 5)) * 512 + ((kk & 7) * 32 + (c & 31)) * 2; }
__device__ __forceinline__ int v_rd_base(int lane) { return ((lane & 3) << 3) | (((lane >> 2) & 3) << 6) | (((lane >> 4) & 1) << 5) | (((lane >> 5) & 1) << 8); }
constexpr int v_rd_off(int d0, int ks, int half) { return d0 * 512 + ks * 4096 + half * 2048; }
template <int OFF> __device__ __forceinline__ s16x4 tr_read(int vb) {
  s16x4 r; asm volatile("ds_read_b64_tr_b16 %0, %1 offset:%2" : "=&v"(r) : "v"(vb), "i"(OFF) : "memory"); return r;
}
template <int D0> __device__ __forceinline__ void pv_one(f32x16& od, int vb, bf16x8 pa0, bf16x8 pa1, bf16x8 pa2, bf16x8 pa3) {
  const s16x4 l0 = tr_read<v_rd_off(D0, 0, 0)>(vb), h0 = tr_read<v_rd_off(D0, 0, 1)>(vb), l1 = tr_read<v_rd_off(D0, 1, 0)>(vb), h1 = tr_read<v_rd_off(D0, 1, 1)>(vb);
  const s16x4 l2 = tr_read<v_rd_off(D0, 2, 0)>(vb), h2 = tr_read<v_rd_off(D0, 2, 1)>(vb), l3 = tr_read<v_rd_off(D0, 3, 0)>(vb), h3 = tr_read<v_rd_off(D0, 3, 1)>(vb);
  asm volatile("s_waitcnt lgkmcnt(0)" ::: "memory"); SBAR();
#define PK(L, H) (bf16x8){L[0], L[1], L[2], L[3], H[0], H[1], H[2], H[3]}
  od = __builtin_amdgcn_mfma_f32_32x32x16_bf16(pa0, PK(l0, h0), od, 0, 0, 0);
  od = __builtin_amdgcn_mfma_f32_32x32x16_bf16(pa1, PK(l1, h1), od, 0, 0, 0);
  od = __builtin_amdgcn_mfma_f32_32x32x16_bf16(pa2, PK(l2, h2), od, 0, 0, 0);
  od = __builtin_amdgcn_mfma_f32_32x32x16_bf16(pa3, PK(l3, h3), od, 0, 0, 0);
#undef PK
}
__device__ __forceinline__ void pv_d0(f32x16* o, int vb, bf16x8 pa0, bf16x8 pa1, bf16x8 pa2, bf16x8 pa3) {
  pv_one<0>(o[0], vb, pa0, pa1, pa2, pa3); pv_one<1>(o[1], vb, pa0, pa1, pa2, pa3); pv_one<2>(o[2], vb, pa0, pa1, pa2, pa3); pv_one<3>(o[3], vb, pa0, pa1, pa2, pa3);
}
__device__ __forceinline__ void apply_mask(f32x16& p0, f32x16& p1, int mtype, int krel0, int qi, int hi) {
  if (mtype == 0) return;
  const float ninf = -__builtin_inff();
#pragma unroll
  for (int r = 0; r < 16; ++r) { const int k0 = krel0 + crow(r, hi), k1 = k0 + 32;
    const bool ok0 = (mtype == 1) ? (k0 >= qi - 128) : (k0 <= qi + 128), ok1 = (mtype == 1) ? (k1 >= qi - 128) : (k1 <= qi + 128);
    p0[r] = ok0 ? p0[r] : ninf; p1[r] = ok1 ? p1[r] : ninf; }
}
struct Tile { gcbf kn; gcbf kr; gcbf v; int mtype; int krel0; };

__device__ __forceinline__ void rope_pair(bf16x8& a, bf16x8& b, gcfl ct, gcfl st) {
  const f32x4 c0 = *(const GAS f32x4*)ct, c1 = *(const GAS f32x4*)(ct + 4), s0 = *(const GAS f32x4*)st, s1 = *(const GAS f32x4*)(st + 4);
  const float cs[8] = {c0[0], c0[1], c0[2], c0[3], c1[0], c1[1], c1[2], c1[3]}, sn[8] = {s0[0], s0[1], s0[2], s0[3], s1[0], s1[1], s1[2], s1[3]};
  v4u ua = __builtin_bit_cast(v4u, a), ub = __builtin_bit_cast(v4u, b); v4u oa, ob;
#pragma unroll
  for (int w = 0; w < 4; ++w) { const float x1[2] = {bflo(ua[w]), bfhi(ua[w])}, x2[2] = {bflo(ub[w]), bfhi(ub[w])}; float y1[2], y2[2];
#pragma unroll
    for (int e = 0; e < 2; ++e) { const float c = cs[2 * w + e], sv = sn[2 * w + e]; y1[e] = x1[e] * c - x2[e] * sv; y2[e] = x2[e] * c + x1[e] * sv; }
    oa[w] = pk2(y1[0], y1[1]); ob[w] = pk2(y2[0], y2[1]); }
  a = __builtin_bit_cast(bf16x8, oa); b = __builtin_bit_cast(bf16x8, ob);
}

template <int DQK, int LDKN, int LDV, bool MASK, bool SINK, int SDEPTH, class TS>
__device__ __forceinline__ void attn_body(gcbf Qw, int rope, int prow, int pcol, gcfl rtab, int qi, float sink_l2, const TS& ts, int NT, gbfp Ow, LAS char* lds) {
  constexpr float SCALE = DQK == 128 ? 0.088388347648318440f : 0.072168783648703220f;
  constexpr float C = SCALE * 1.4426950408889634f;
  constexpr int SHM_K = KVBLK * (DQK * 2 + 16), SHM_V = KVBLK * 128 * 2;
  int tid = threadIdx.x; asm volatile("" : "+v"(tid));
  const int wid = tid >> 6, lane = tid & 63, r32 = lane & 31, hi = lane >> 5;
  LAS char* V_lds = lds; LAS char* K_lds = lds + 2 * SHM_V;
  LAS float* wsl = (LAS float*)(lds + 2 * SHM_V + 2 * SHM_K) + wid * 64; LAS float* li_l = wsl; LAS float* al_l = wsl + 32;
  float m_reg = -1e30f, l_reg = 0; f32x16 o[4] = {}; bf16x8 qr[8];
#pragma unroll
  for (int d0 = 0; d0 < 8; ++d0) qr[d0] = *(const GAS bf16x8*)(Qw + d0 * 16 + hi * 8);
  const LAS char* qx = lds + 2 * SHM_V + 2 * SHM_K + 2048 + wid * 4608 + r32 * 144 + hi * 16;
  if constexpr (DQK == 192) {
    bf16x8 x0 = *(const GAS bf16x8*)(Qw + 128 + hi * 8), x1 = *(const GAS bf16x8*)(Qw + 144 + hi * 8), x2 = *(const GAS bf16x8*)(Qw + 160 + hi * 8), x3 = *(const GAS bf16x8*)(Qw + 176 + hi * 8);
    if (rope) {
      rope_pair(x0, x1, rtab + (size_t)prow * 16 + hi * 8, rtab + 2048 + (size_t)prow * 16 + hi * 8);
      rope_pair(x2, x3, rtab + (size_t)pcol * 16 + hi * 8, rtab + 2048 + (size_t)pcol * 16 + hi * 8); }
    LAS char* qw_ = (LAS char*)qx; *(LAS bf16x8*)(qw_) = x0; *(LAS bf16x8*)(qw_ + 32) = x1; *(LAS bf16x8*)(qw_ + 64) = x2; *(LAS bf16x8*)(qw_ + 96) = x3;
  }
  const int sr = tid >> 4, sc = (tid & 15) * 8, vst0 = v_st(sr, sc), vst1 = v_st(32 + sr, sc);
  const int rr_ = tid >> 3, rc_ = (tid & 7) * 8;
  const int vb0 = (int)(uintptr_t)V_lds + v_rd_base(lane);
  struct { bf16x8 vs0, vs1, ks0, ks1, kx; } sr_[SDEPTH];
#define SLOAD(i, jt) do { const Tile t_ = ts(jt); sr_[i].vs0 = *(const GAS bf16x8*)(t_.v + (size_t)sr * LDV + sc); sr_[i].vs1 = *(const GAS bf16x8*)(t_.v + (size_t)(32 + sr) * LDV + sc); \
    sr_[i].ks0 = *(const GAS bf16x8*)(t_.kn + (size_t)sr * LDKN + sc); sr_[i].ks1 = *(const GAS bf16x8*)(t_.kn + (size_t)(32 + sr) * LDKN + sc); \
    if constexpr (DQK == 192) sr_[i].kx = *(const GAS bf16x8*)(t_.kr + (size_t)rr_ * 64 + rc_); } while (0)
#define SWRITE(b, i) do { *(LAS bf16x8*)(V_lds + (b) * SHM_V + vst0) = sr_[i].vs0; *(LAS bf16x8*)(V_lds + (b) * SHM_V + vst1) = sr_[i].vs1; const int kc = sc * 2; \
    *(LAS bf16x8*)(K_lds + (b) * SHM_K + kswz<DQK>(sr, kc)) = sr_[i].ks0; *(LAS bf16x8*)(K_lds + (b) * SHM_K + kswz<DQK>(32 + sr, kc)) = sr_[i].ks1; \
    if constexpr (DQK == 192) *(LAS bf16x8*)(K_lds + (b) * SHM_K + kswz<DQK>(rr_, 256 + rc_ * 2)) = sr_[i].kx; } while (0)
#define SWAIT() do { if constexpr (SDEPTH == 2) { if constexpr (DQK == 192) asm volatile("s_waitcnt vmcnt(5)" ::: "memory"); else asm volatile("s_waitcnt vmcnt(4)" ::: "memory"); } \
    else asm volatile("s_waitcnt vmcnt(0)" ::: "memory"); } while (0)
#define RESC(a) do { if (__any((a) < 1.f)) { if (hi == 0) al_l[r32] = (a); asm volatile("s_waitcnt lgkmcnt(0)" ::: "memory"); \
    _Pragma("unroll") for (int d = 0; d < 4; ++d) _Pragma("unroll") for (int r = 0; r < 16; ++r) o[d][r] *= al_l[crow(r, hi)]; } } while (0)
#define MASKT(pa_, pb_, jt) do { if constexpr (MASK) { const Tile t_ = ts(jt); apply_mask(pa_, pb_, t_.mtype, t_.krel0, qi, hi); } } while (0)
  f32x16 pA0, pA1, pB0, pB1; float mnA, mnB, alA, alB; bf16x8 pa0, pa1, pa2, pa3;
  constexpr int SE = 0, SO = SDEPTH - 1;
  SLOAD(SE, 0); asm volatile("s_waitcnt vmcnt(0)" ::: "memory"); SWRITE(0, SE); __syncthreads();
  qkt<DQK>(pA0, pA1, K_lds, qr, qx, r32, hi); MASKT(pA0, pA1, 0); partialSM<DQK>(pA0, pA1, m_reg, mnA, alA);
  SLOAD(SO, 1); if constexpr (SDEPTH == 2) { if (2 < NT) SLOAD(SE, 2); }
  SWAIT(); SWRITE(1, SO); __syncthreads();
  for (int j = 1; j + 1 < NT; j += 2) {
    SBAR(); qkt<DQK>(pB0, pB1, K_lds + SHM_K, qr, qx, r32, hi); MASKT(pB0, pB1, j);
    finishSM(pA0, pA1, alA, l_reg, pa0, pa1, pa2, pa3); SBAR();
    SLOAD(SO, j + SDEPTH); SBAR();
    pv_d0(o, vb0, pa0, pa1, pa2, pa3); partialSM<DQK>(pB0, pB1, m_reg, mnB, alB);
    __syncthreads(); SWAIT(); SWRITE(0, SE);
    RESC(alB); __syncthreads();
    SBAR(); qkt<DQK>(pA0, pA1, K_lds, qr, qx, r32, hi); MASKT(pA0, pA1, j + 1);
    finishSM(pB0, pB1, alB, l_reg, pa0, pa1, pa2, pa3); SBAR();
    if (SDEPTH == 1 || j + 3 < NT) SLOAD(SE, j + 1 + SDEPTH); SBAR();
    pv_d0(o, vb0 + SHM_V, pa0, pa1, pa2, pa3); partialSM<DQK>(pA0, pA1, m_reg, mnA, alA);
    __syncthreads(); SWAIT(); SWRITE(1, SO);
    RESC(alA); __syncthreads();
  }
  SBAR(); qkt<DQK>(pB0, pB1, K_lds + SHM_K, qr, qx, r32, hi); MASKT(pB0, pB1, NT - 1);
  finishSM(pA0, pA1, alA, l_reg, pa0, pa1, pa2, pa3); SBAR();
  pv_d0(o, vb0, pa0, pa1, pa2, pa3); partialSM<DQK>(pB0, pB1, m_reg, mnB, alB);
  __syncthreads(); RESC(alB);
  finishSM(pB0, pB1, alB, l_reg, pa0, pa1, pa2, pa3); SBAR();
  pv_d0(o, vb0 + SHM_V, pa0, pa1, pa2, pa3);
  if constexpr (SINK) l_reg += __builtin_amdgcn_exp2f(sink_l2 - m_reg * C);
  if (hi == 0) li_l[r32] = l_reg; asm volatile("s_waitcnt lgkmcnt(0)" ::: "memory");
  float rli[16];
#pragma unroll
  for (int r = 0; r < 16; ++r) rli[r] = __builtin_amdgcn_rcpf(li_l[crow(r, hi)]);
  __syncthreads();
  LAS bf16* ost = (LAS bf16*)(lds + wid * 8704);
#pragma unroll
  for (int r = 0; r < 16; ++r) { const int orow = crow(r, hi);
#pragma unroll
    for (int d0 = 0; d0 < 4; ++d0) ost[orow * 136 + d0 * 32 + r32] = (bf16)f2bf(o[d0][r] * rli[r]); }
  asm volatile("s_waitcnt lgkmcnt(0)" ::: "memory");
#pragma unroll
  for (int i = 0; i < 8; ++i) { const int orow = i * 4 + (lane >> 4), ch = lane & 15;
    *(GAS v4u*)(Ow + (size_t)orow * 4096 + ch * 8) = *(const LAS v4u*)(ost + orow * 136 + ch * 8); }
  __syncthreads();
#undef SLOAD
#undef SWRITE
#undef SWAIT
#undef RESC
#undef MASKT
}
}

struct Args { const float* in[38]; float* out; unsigned char* ws; };
template <class T> __device__ __forceinline__ T launder(T p) { asm volatile("" : "+s"(p)); return p; }
template <class T> __device__ __forceinline__ T* launder_g(T* p) { asm volatile("" : "+s"(p)); return p; }
struct Frame {
    LAS unsigned char* lds;
    gu32* ctl;
    int tid, lane, wave;
    int vcu, G, gw, NGW;
    const __attribute__((address_space(4))) Args* A;
    float* out;
    unsigned char* ws;
    unsigned char* wsw;
};
enum { I_X = 0, I_C, I_CTX, I_CCTX, I_WMOD, I_BMOD, I_WIN, I_WOUT, I_LN1G, I_LN1B, I_WFF1, I_WFF2, I_LN2G, I_LN2B, I_SINK, I_CONVW, I_CONVB, I_LWA, I_LBA, I_LWI, I_LBI, I_LAM,
       I_QNORM, I_KVNORM, I_WQB, I_WKVB, I_MUP, I_MUN, I_W0, I_W2, I_A0, I_A2, I_G2, I_KK, I_KA, I_RK, I_LNG, I_LNB };
__device__ __forceinline__ int row_s(int row) { return row < SEQ ? 0 : (row < M_LAT ? 1 : 2); }
__device__ __forceinline__ const float* mod_ptr(const Frame& F, int l, int s, int chunk) { return (const float*)(F.ws + WS_MOD) + ((size_t)(l * 3 + s) * 6 + chunk) * DM; }

__device__ __forceinline__ void transpose_item(const float* W, int N, int Kvalid, bf16* WT, int ldt, const float* kscale, LAS float* scr, int k0, int n0, int lane) {
    { const int kr = lane >> 3, c4 = (lane & 7) * 4;
#pragma unroll
      for (int i = 0; i < 8; ++i) { const int kk = 8 * i + kr, k = k0 + kk; f32x4 v = {0.f, 0.f, 0.f, 0.f};
          if (k < Kvalid) { v = *(const f32x4*)(W + (size_t)k * N + n0 + c4); if (kscale) v = v * kscale[k]; }
          scr[kk * 33 + c4] = v.x; scr[kk * 33 + c4 + 1] = v.y; scr[kk * 33 + c4 + 2] = v.z; scr[kk * 33 + c4 + 3] = v.w; } }
    LDS_WAIT(); asm volatile("" ::: "memory");
    const int c = lane & 7;
#pragma unroll
    for (int j = 0; j < 4; ++j) { const int n = (lane >> 3) + 8 * j; const LAS float* s = scr + (8 * c) * 33 + n;
        v4u o; o.x = pk2(s[0 * 33], s[1 * 33]); o.y = pk2(s[2 * 33], s[3 * 33]); o.z = pk2(s[4 * 33], s[5 * 33]); o.w = pk2(s[6 * 33], s[7 * 33]);
        *(v4u*)(WT + (size_t)(n0 + n) * ldt + k0 + 8 * c) = o; }
    LDS_WAIT(); asm volatile("" ::: "memory");
}
__device__ __forceinline__ void convert_weights(Frame& F, int l, int widx, int nw) {
    LAS float* scr = (LAS float*)(F.lds + F.wave * 16384);
    constexpr int I1 = 64 * 271, I2 = 64 * 128, I3 = 64 * 512, I4 = 256 * 128, I5 = 16 * 48, I6 = 8 * 64, I7 = 32 * 8, I8 = 2 * 32, I9 = 2 * 32, I10 = 3 * 32;
    constexpr int NIT = I1 + I2 + I3 + I4 + I5 + I6 + I7 + I8 + I9 + I10;
    unsigned char* ws = F.ws + (l ? WSET_STRIDE : 0);
    for (int it = widx; it < NIT; it += nw) {
        int r = it;
        if (r < I1) { transpose_item(F.A->in[I_WIN] + (size_t)l * DM * DIN, DIN, DM, (bf16*)(ws + WS_WIN), DM, nullptr, scr, 64 * (r / 271), 32 * (r % 271), F.lane); continue; } r -= I1;
        if (r < I2) { transpose_item(F.A->in[I_WOUT] + (size_t)l * DM * DM, DM, DM, (bf16*)(ws + WS_WOUT), DM, nullptr, scr, 64 * (r / 128), 32 * (r % 128), F.lane); continue; } r -= I2;
        if (r < I3) { transpose_item(F.A->in[I_WFF1] + (size_t)l * DM * DFF, DFF, DM, (bf16*)(ws + WS_WFF1), DM, nullptr, scr, 64 * (r / 512), 32 * (r % 512), F.lane); continue; } r -= I3;
        if (r < I4) { transpose_item(F.A->in[I_WFF2] + (size_t)l * DFF * DM, DM, DFF, (bf16*)(ws + WS_WFF2), DFF, nullptr, scr, 64 * (r / 128), 32 * (r % 128), F.lane); continue; } r -= I4;
        if (r < I5) { transpose_item(F.A->in[I_WQB] + (size_t)l * 1024 * 1536, 1536, 1024, (bf16*)(ws + WS_WQB), 1024, F.A->in[I_QNORM] + l * 1024, scr, 64 * (r / 48), 32 * (r % 48), F.lane); continue; } r -= I5;
        if (r < I6) { transpose_item(F.A->in[I_WKVB] + (size_t)l * 512 * 2048, 2048, 512, (bf16*)(ws + WS_WKVB), 512, F.A->in[I_KVNORM] + l * 512, scr, 64 * (r / 64), 32 * (r % 64), F.lane); continue; } r -= I6;
        if (r < I7) { const int mat = r >> 3, sub = r & 7, gate = mat & 1, dn = mat >> 1;
            const int d = dn >> 3, n = dn & 7;
            const float* src = (gate ? F.A->in[I_LWI] : F.A->in[I_LWA]) + ((size_t)(l * 2 + d) * 8 + n) * 128 * 128;
            bf16* dst = (bf16*)(ws + WS_WLRU) + ((size_t)(d * 2 + gate) * 8 + n) * 128 * 128;
            transpose_item(src, 128, 128, dst, 128, nullptr, scr, 64 * (sub >> 2), 32 * (sub & 3), F.lane); continue; } r -= I7;
        if (r < I8) { const int d = r >> 5; transpose_item(F.A->in[I_W2] + (size_t)(l * 2 + d) * 64 * 1024, 1024, 64, (bf16*)(ws + WS_W2T) + (size_t)d * 1024 * 64, 64, nullptr, scr, 0, 32 * (r & 31), F.lane); continue; } r -= I8;
        if (r < I9) { const int d = r >> 5; transpose_item(F.A->in[I_A2] + (size_t)(l * 2 + d) * 64 * 1024, 1024, 64, (bf16*)(ws + WS_A2T) + (size_t)d * 1024 * 64, 64, nullptr, scr, 0, 32 * (r & 31), F.lane); continue; } r -= I9;
        transpose_item(F.A->in[I_G2] + (size_t)l * 160 * 1024, 1024, 160, (bf16*)(ws + WS_G2T), 192, nullptr, scr, 64 * (r / 32), 32 * (r % 32), F.lane);
    }
    { unsigned zz = 0u; asm volatile("" : "+v"(zz)); v4u z = {zz, zz, zz, zz}; v4u* p = (v4u*)((bf16*)(ws + WS_WIN) + (size_t)DIN * DM);
      for (int i = widx * 64 + F.lane; i < 32 * DM / 8; i += nw * 64) p[i] = z; }
}

__device__ __forceinline__ void mod_partials(Frame& F) {
    LAS float* sl = (LAS float*)F.lds;
    for (int it = F.vcu; it < 2 * 32 * 12; it += F.G) {
        const int l = it / 384, ks = (it / 12) % 32, cc = it % 12;
        __syncthreads();
        if (F.tid < 384) { const int s = F.tid >> 7, k = ks * 128 + (F.tid & 127); const float c = s < 2 ? F.A->in[I_C][s * DM + k] : F.A->in[I_CCTX][k]; sl[F.tid] = c / (1.f + __expf(-c)); }
        __syncthreads();
        const float* wp = F.A->in[I_WMOD] + ((size_t)l * DM + ks * 128) * 24576 + cc * 2048 + F.tid * 4;
        f32x4 a0 = {0.f, 0.f, 0.f, 0.f}, a1 = a0, a2 = a0;
#pragma unroll 8
        for (int k = 0; k < 128; ++k) { const f32x4 w = *(const f32x4*)(wp + (size_t)k * 24576); a0 += w * sl[k]; a1 += w * sl[128 + k]; a2 += w * sl[256 + k]; }
        float* op = (float*)(F.ws + WS_MODP) + ((size_t)(l * 32 + ks) * 3) * 24576 + cc * 2048 + F.tid * 4;
        *(f32x4*)(op) = a0; *(f32x4*)(op + 24576) = a1; *(f32x4*)(op + 2 * 24576) = a2;
    }
    __syncthreads();
}
__device__ __forceinline__ void mod_reduce(Frame& F) {
    for (int i = F.vcu * NTHR + F.tid; i < 2 * 3 * 24576; i += F.G * NTHR) {
        const int l = i / (3 * 24576), s = (i / 24576) % 3, n = i % 24576;
        float a = F.A->in[I_BMOD][l * 24576 + n];
        const float* pp = (const float*)(F.ws + WS_MODP) + ((size_t)(l * 32) * 3 + s) * 24576 + n;
#pragma unroll 8
        for (int ks = 0; ks < 32; ++ks) a += pp[(size_t)ks * 3 * 24576];
        ((float*)(F.ws + WS_MOD))[i] = a;
    }
}

__device__ __forceinline__ void sum_partials_row(const Frame& F, const float* yp, size_t stride, bf16* ydst) {
    int lane = F.lane; asm volatile("" : "+v"(lane));
#pragma unroll 2
    for (int j = 0; j < 16; ++j) { const int c = 4 * lane + 256 * j; f32x4 y = *(const f32x4*)(yp + c);
#pragma unroll
        for (int sp = 1; sp < 8; ++sp) y += *(const f32x4*)(yp + sp * stride + c);
        v2u w; w.x = pk2(y.x, y.y); w.y = pk2(y.z, y.w); *(v2u*)(ydst + c) = w; }
}
template <int MODE>
__device__ __forceinline__ void ln_row(const Frame& F, const float* xsrc, const bf16* Y, const float* ga, const float* lg, const float* lb, float* xdst,
                                       bool domod, const float* sc, const float* sh, bf16* hrow) {
    f32x4 v[16]; float s = 0.f;
#pragma unroll
    for (int j = 0; j < 16; ++j) { const int c = 4 * F.lane + 256 * j; v[j] = __builtin_nontemporal_load((const f32x4*)(xsrc + c));
        if (MODE == 1) { const v2u yw = __builtin_nontemporal_load((const v2u*)(Y + c)); const f32x4 y = {bflo(yw.x), bfhi(yw.x), bflo(yw.y), bfhi(yw.y)}, g = *(const f32x4*)(ga + c); v[j] = v[j] * ALPHA + g * y; }
        s += (v[j].x + v[j].y) + (v[j].z + v[j].w);
        if ((j & 7) == 7) asm volatile("" ::: "memory"); }
    float mean = wave_sum(s) * (1.f / DM), s2 = 0.f;
#pragma unroll
    for (int j = 0; j < 16; ++j) { v[j] = v[j] - mean; s2 += (v[j].x * v[j].x + v[j].y * v[j].y) + (v[j].z * v[j].z + v[j].w * v[j].w); }
    float rstd = 1.f / sqrtf(wave_sum(s2) * (1.f / DM) + LN_EPS);
    if (MODE == 1) {
        s = 0.f;
#pragma unroll
        for (int j = 0; j < 16; ++j) { const int c = 4 * F.lane + 256 * j; const f32x4 g = *(const f32x4*)(lg + c), b = *(const f32x4*)(lb + c); v[j] = v[j] * rstd * g + b;
            __builtin_nontemporal_store(v[j], (f32x4*)(xdst + c)); s += (v[j].x + v[j].y) + (v[j].z + v[j].w);
            if ((j & 7) == 7) asm volatile("" ::: "memory"); }
        if (!domod) return;
        mean = wave_sum(s) * (1.f / DM); s2 = 0.f;
#pragma unroll
        for (int j = 0; j < 16; ++j) { v[j] = v[j] - mean; s2 += (v[j].x * v[j].x + v[j].y * v[j].y) + (v[j].z * v[j].z + v[j].w * v[j].w); }
        rstd = 1.f / sqrtf(wave_sum(s2) * (1.f / DM) + LN_EPS);
    }
#pragma unroll
    for (int j = 0; j < 16; ++j) { const int c = 4 * F.lane + 256 * j; const f32x4 a = *(const f32x4*)(sc + c), b = *(const f32x4*)(sh + c);
        const f32x4 o = v[j] * rstd * (a + 1.f) + b; v2u w; w.x = pk2(o.x, o.y); w.y = pk2(o.z, o.w); *(v2u*)(hrow + c) = w; }
}

__device__ __forceinline__ void shift4(const bf16* P, unsigned eo, bool hp, bool hn, const float* mup, const float* mun, unsigned mo, float (&u)[4]) {
    const v2u xc = ldg<v2u>(P, eo * 2u); v2u xp = {0u, 0u}, xn = {0u, 0u};
    if (hp) xp = ldg<v2u>(P, (eo - DINP) * 2u); if (hn) xn = ldg<v2u>(P, (eo + DINP) * 2u);
    const f32x4 mp = ldg<f32x4>(mup, mo * 4u), mn = ldg<f32x4>(mun, mo * 4u);
    const float c[4] = {bflo(xc.x), bfhi(xc.x), bflo(xc.y), bfhi(xc.y)}, p[4] = {bflo(xp.x), bfhi(xp.x), bflo(xp.y), bfhi(xp.y)}, n[4] = {bflo(xn.x), bfhi(xn.x), bflo(xn.y), bfhi(xn.y)};
#pragma unroll
    for (int e = 0; e < 4; ++e) u[e] = c[e] + mp[e] * (p[e] - c[e]) + mn[e] * (n[e] - c[e]);
}
__device__ __forceinline__ void st4bf(void* base, unsigned eo, float a, float b, float c, float d) { v2u w; w.x = pk2(a, b); w.y = pk2(c, d); stg<v2u>(base, eo * 2u, w); }

__device__ __forceinline__ void rwkv_feat_item(Frame& F, int l, int item) {
    F.tid = ltid(); F.lane = F.tid & 63;
    int row0, seq_lo, seq_hi;
    if (item < 16) { const int b = item >> 3; seq_lo = M_LAT + b * NCTX; seq_hi = seq_lo + NCTX; row0 = seq_lo + (item & 7) * 32; }
    else { const int it = item - 16, b = it >> 8; seq_lo = b * SEQ; seq_hi = seq_lo + SEQ; row0 = seq_lo + (it & 255) * 32; }
    const bf16* P = (const bf16*)(F.ws + WS_P);
    LAS bf16* ACT = (LAS bf16*)F.lds;
    const float* mup = F.A->in[I_MUP] + l * RWC; const float* mun = F.A->in[I_MUN] + l * RWC;
    __syncthreads();
    { const int tok = F.tid >> 4, jc = F.tid & 15, row = row0 + tok; const bool hp = row > seq_lo, hn = row + 1 < seq_hi;
      const bf16* pr = P + (size_t)row * DINP + C_RWL;
#pragma unroll
      for (int i = 0; i < 13; ++i) { const int j = jc * 2 + 32 * i;
          const unsigned xc = *(const unsigned*)(pr + j), xp = hp ? *(const unsigned*)(pr - DINP + j) : 0u, xn = hn ? *(const unsigned*)(pr + DINP + j) : 0u;
          float u[2];
#pragma unroll
          for (int e = 0; e < 2; ++e) { const float c = e ? bfhi(xc) : bflo(xc), p = e ? bfhi(xp) : bflo(xp), n = e ? bfhi(xn) : bflo(xn);
              float v = c + mup[3072 + j + e] * (p - c) + mun[3072 + j + e] * (n - c);
              if (j < 128) v = tanhf_(v); else if (j >= 256) v = sigmoidf_(v);
              u[e] = v; }
          *(LAS unsigned*)(ACT + tok * 424 + j) = pk2(u[0], u[1]); } }
    __syncthreads();
    const int tok = F.lane & 31, hi = F.lane >> 5, row = row0 + tok;
    const bf16* W2T = (const bf16*)(F.wsw + WS_W2T); const bf16* A2T = (const bf16*)(F.wsw + WS_A2T); const bf16* G2T = (const bf16*)(F.wsw + WS_G2T);
    bf16* RWF = (bf16*)(F.ws + WS_RWF); const size_t RS = (size_t)M_TOT * 1024;
    const float* kkv = F.A->in[I_KK] + l * 1024; const float* kav = F.A->in[I_KA] + l * 1024; const float* rkv = F.A->in[I_RK] + l * 1024;
    const float* w0f = F.A->in[I_W0] + (size_t)(l * 2) * 1024; const float* a0f = F.A->in[I_A0] + (size_t)(l * 2) * 1024;
    const LAS bf16* actl = ACT + tok * 424 + hi * 8;
    LAS unsigned char* TB = F.lds + 27136 + F.wave * 10880;
#define RF_LOADG(reg_, colbase) do { _Pragma("unroll") for (int i_ = 0; i_ < 3; ++i_) { const int p_ = F.lane + 64 * i_; reg_[i_] = (v4u){0u, 0u, 0u, 0u}; if (p_ < 136) { const int rr_ = p_ >> 2, cp_ = p_ & 3, gr_ = row0 - 1 + rr_; \
        if (gr_ >= seq_lo && gr_ < seq_hi) reg_[i_] = ldg<v4u>(P, ((unsigned)gr_ * DINP + (colbase) + 8 * cp_) * 2u); } } } while (0)
#define RF_STORET(ti, reg_) do { _Pragma("unroll") for (int i_ = 0; i_ < 3; ++i_) { const int p_ = F.lane + 64 * i_; if (p_ < 136) { const int rr_ = p_ >> 2, cp_ = p_ & 3; *(LAS v4u*)(TB + (ti) * 2720 + rr_ * 80 + cp_ * 16) = reg_[i_]; } } } while (0)
#define RF_SHIFT4(ti, g_, mo_, u_) do { const LAS unsigned char* q_ = TB + (ti) * 2720 + (tok + 1) * 80 + (8 * (g_) + 4 * hi) * 2; const v2u xc_ = *(const LAS v2u*)q_, xp_ = *(const LAS v2u*)(q_ - 80), xn_ = *(const LAS v2u*)(q_ + 80); \
        const f32x4 mp_ = ldg<f32x4>(mup, (mo_) * 4u), mn_ = ldg<f32x4>(mun, (mo_) * 4u); \
        const float c_[4] = {bflo(xc_.x), bfhi(xc_.x), bflo(xc_.y), bfhi(xc_.y)}, pp_[4] = {bflo(xp_.x), bfhi(xp_.x), bflo(xp_.y), bfhi(xp_.y)}, nn_[4] = {bflo(xn_.x), bfhi(xn_.x), bflo(xn_.y), bfhi(xn_.y)}; \
        _Pragma("unroll") for (int e_ = 0; e_ < 4; ++e_) u_[e_] = c_[e_] + mp_[e_] * (pp_[e_] - c_[e_]) + mn_[e_] * (nn_[e_] - c_[e_]); } while (0)
#define RF_PUT(ti, o_) do { _Pragma("unroll") for (int g_ = 0; g_ < 4; ++g_) *(LAS v2u*)(TB + (ti) * 2720 + tok * 80 + (8 * g_ + 4 * hi) * 2) = o_[g_]; } while (0)
#define RF_FLUSH3(a0_, a1_, a2_, cblk_) do { asm volatile("s_waitcnt lgkmcnt(0)" ::: "memory"); \
        _Pragma("unroll") for (int t_ = 0; t_ < 3; ++t_) { const int arr_ = t_ == 0 ? (a0_) : (t_ == 1 ? (a1_) : (a2_)); \
            _Pragma("unroll") for (int i_ = 0; i_ < 2; ++i_) { const int p_ = F.lane + 64 * i_, rr_ = p_ >> 2, cp_ = p_ & 3; const v4u v_ = *(const LAS v4u*)(TB + t_ * 2720 + rr_ * 80 + cp_ * 16); \
                stg<v4u>(RWF + arr_ * RS, ((unsigned)(row0 + rr_) * 1024u + (cblk_) + 8 * cp_) * 2u, v_); } } \
        asm volatile("s_waitcnt lgkmcnt(0)" ::: "memory"); } while (0)
#pragma unroll 1
    for (int hh = 0; hh < 2; ++hh) {
        const int h = 2 * F.wave + hh, cbase = h * 64;
        float ssq = 0.f;
        { v4u t0[3], t1[3]; RF_LOADG(t0, C_RWK + cbase); RF_LOADG(t1, C_RWK + cbase + 32); RF_STORET(0, t0); RF_STORET(1, t1); }
        asm volatile("s_waitcnt lgkmcnt(0)" ::: "memory");
#pragma unroll
        for (int bg = 0; bg < 8; ++bg) { const unsigned c4 = cbase + (bg >> 2) * 32 + 8 * (bg & 3) + 4 * hi; float uk[4];
            RF_SHIFT4(bg >> 2, bg & 3, 1024 + c4, uk); const f32x4 k4 = ldg<f32x4>(kkv, c4 * 4u);
#pragma unroll
            for (int e = 0; e < 4; ++e) { const float q = uk[e] * k4[e]; ssq += q * q; } }
        ssq = half_swap_sum(ssq);
        const float rn = 1.f / fmaxf(sqrtf(ssq), 1e-12f);
        float sb = 0.f;
        asm volatile("s_waitcnt lgkmcnt(0)" ::: "memory");
#pragma unroll 1
        for (int blk = 0; blk < 2; ++blk) {
            const unsigned cblk = cbase + blk * 32, cha = cblk + tok;
            v4u gR[3], gK[3], gV[3];
            RF_LOADG(gR, C_RWR + cblk); RF_LOADG(gK, C_RWK + cblk); RF_LOADG(gV, C_RWV + cblk);
#pragma unroll
            for (int d = 0; d < 2; ++d) { f32x16 aw = {};
#pragma unroll
                for (int ks = 0; ks < 4; ++ks) { const bf16x8 bw = *(const LAS bf16x8*)(actl + d * 64 + ks * 16); const bf16x8 w_ = ldg<bf16x8>(W2T, ((d * 1024 + cha) * 64 + ks * 16 + hi * 8) * 2u);
                    aw = __builtin_amdgcn_mfma_f32_32x32x16_bf16(w_, bw, aw, 0, 0, 0); }
                v2u o[4];
#pragma unroll
                for (int g = 0; g < 4; ++g) { const f32x4 w0 = ldg<f32x4>(w0f, (d * 1024 + cblk + 8 * g + 4 * hi) * 4u); float e4[4];
#pragma unroll
                    for (int e = 0; e < 4; ++e) e4[e] = 0.60653065971f * sigmoidf_(w0[e] + aw[4 * g + e]);
                    o[g].x = pk2(e4[0], e4[1]); o[g].y = pk2(e4[2], e4[3]); }
                RF_PUT(d, o); }
            { f32x16 ag = {};
#pragma unroll
              for (int ks = 0; ks < 10; ++ks) { const bf16x8 bg_ = *(const LAS bf16x8*)(actl + 256 + ks * 16); const bf16x8 g_ = ldg<bf16x8>(G2T, (cha * 192 + ks * 16 + hi * 8) * 2u);
                  ag = __builtin_amdgcn_mfma_f32_32x32x16_bf16(g_, bg_, ag, 0, 0, 0); }
              v2u o[4];
#pragma unroll
              for (int g = 0; g < 4; ++g) { o[g].x = pk2(ag[4 * g], ag[4 * g + 1]); o[g].y = pk2(ag[4 * g + 2], ag[4 * g + 3]); }
              RF_PUT(2, o); }
            RF_FLUSH3(4, 5, 8, cblk);
            RF_STORET(0, gR); RF_STORET(1, gK); RF_STORET(2, gV);
            { f32x16 aaf = {}, aab = {};
#pragma unroll
              for (int ks = 0; ks < 4; ++ks) { const bf16x8 baf = *(const LAS bf16x8*)(actl + 128 + ks * 16), bab = *(const LAS bf16x8*)(actl + 192 + ks * 16);
                  const bf16x8 a_f = ldg<bf16x8>(A2T, (cha * 64 + ks * 16 + hi * 8) * 2u), a_b = ldg<bf16x8>(A2T, ((1024 + cha) * 64 + ks * 16 + hi * 8) * 2u);
                  aaf = __builtin_amdgcn_mfma_f32_32x32x16_bf16(a_f, baf, aaf, 0, 0, 0); aab = __builtin_amdgcn_mfma_f32_32x32x16_bf16(a_b, bab, aab, 0, 0, 0); }
              v2u oR[4], oK[4], oV[4], oKK[4], oAF[4], oAB[4];
              asm volatile("s_waitcnt lgkmcnt(0)" ::: "memory");
#pragma unroll
              for (int g = 0; g < 4; ++g) { const unsigned c4 = cblk + 8 * g + 4 * hi; float ur[4], uk[4], uv[4];
                  RF_SHIFT4(0, g, c4, ur); RF_SHIFT4(1, g, 1024 + c4, uk); RF_SHIFT4(2, g, 2048 + c4, uv);
                  const f32x4 a0a = ldg<f32x4>(a0f, c4 * 4u), a0b = ldg<f32x4>(a0f, (1024 + c4) * 4u), kk4 = ldg<f32x4>(kkv, c4 * 4u), ka4 = ldg<f32x4>(kav, c4 * 4u), rk4 = ldg<f32x4>(rkv, c4 * 4u);
                  float af[4], ab[4], kk[4];
#pragma unroll
                  for (int e = 0; e < 4; ++e) { const int r = 4 * g + e;
                      af[e] = sigmoidf_(a0a[e] + aaf[r]); ab[e] = sigmoidf_(a0b[e] + aab[r]); kk[e] = uk[e] * kk4[e] * rn;
                      const float kdf = uk[e] * (1.f + (af[e] - 1.f) * ka4[e]), kdb = uk[e] * (1.f + (ab[e] - 1.f) * ka4[e]);
                      sb += ur[e] * rk4[e] * (kdf + kdb); }
                  oR[g].x = pk2(ur[0], ur[1]); oR[g].y = pk2(ur[2], ur[3]); oK[g].x = pk2(uk[0], uk[1]); oK[g].y = pk2(uk[2], uk[3]); oV[g].x = pk2(uv[0], uv[1]); oV[g].y = pk2(uv[2], uv[3]);
                  oKK[g].x = pk2(kk[0], kk[1]); oKK[g].y = pk2(kk[2], kk[3]); oAF[g].x = pk2(af[0], af[1]); oAF[g].y = pk2(af[2], af[3]); oAB[g].x = pk2(ab[0], ab[1]); oAB[g].y = pk2(ab[2], ab[3]); }
              asm volatile("s_waitcnt lgkmcnt(0)" ::: "memory");
              RF_PUT(0, oR); RF_PUT(1, oK); RF_PUT(2, oV); RF_FLUSH3(0, 1, 2, cblk);
              RF_PUT(0, oKK); RF_PUT(1, oAF); RF_PUT(2, oAB); RF_FLUSH3(3, 6, 7, cblk); }
        }
        sb = half_swap_sum(sb);
        if (hi == 0) ((float*)(F.ws + WS_SB))[(size_t)row * 16 + h] = sb;
    }
#undef RF_LOADG
#undef RF_STORET
#undef RF_SHIFT4
#undef RF_PUT
#undef RF_FLUSH3
}

__device__ __forceinline__ float gelu_tanh(float x) { return 0.5f * x * (1.f + tanhf_(0.7978845608028654f * (x + 0.044715f * x * x * x))); }
template <bool PASS3>
__device__ __forceinline__ void lru_item(Frame& F, int l, int item) {
    F.tid = ltid(); F.lane = F.tid & 63;
    const int sc = item >> 3, nb = item & 7, b = sc / NCH, ch = sc % NCH;
    int row0, seq_lo, seq_hi;
    if (ch < 8) { seq_lo = M_LAT + b * NCTX; seq_hi = seq_lo + NCTX; row0 = seq_lo + ch * 32; }
    else { seq_lo = b * SEQ; seq_hi = seq_lo + SEQ; row0 = seq_lo + (ch - 8) * 32; }
    const bf16* P = (const bf16*)(F.ws + WS_P);
    LAS float* U = (LAS float*)F.lds;
    LAS bf16* UA = (LAS bf16*)(F.lds + 16384);
    LAS float* AB = (LAS float*)(F.lds + 32768);
    __syncthreads();
    { const int tok = F.tid >> 4, c8 = (F.tid & 15) * 8, cg = nb * 128 + c8; float acc[8];
      const float* cb = F.A->in[I_CONVB] + l * 1024 + cg;
#pragma unroll
      for (int e = 0; e < 8; ++e) acc[e] = cb[e];
#pragma unroll
      for (int j = 0; j < 4; ++j) { const int r = row0 + tok - 2 + j;
          if (r >= seq_lo && r < seq_hi) { const v4u x = *(const v4u*)(P + (size_t)r * DINP + C_LRUX + cg); const float* cw = F.A->in[I_CONVW] + (size_t)(l * 4 + j) * 1024 + cg;
#pragma unroll
              for (int w = 0; w < 4; ++w) { acc[2 * w] += cw[2 * w] * bflo(x[w]); acc[2 * w + 1] += cw[2 * w + 1] * bfhi(x[w]); } } }
      *(LAS f32x4*)(U + tok * 128 + c8) = (f32x4){acc[0], acc[1], acc[2], acc[3]}; *(LAS f32x4*)(U + tok * 128 + c8 + 4) = (f32x4){acc[4], acc[5], acc[6], acc[7]};
      v4u o; o.x = pk2(acc[0], acc[1]); o.y = pk2(acc[2], acc[3]); o.z = pk2(acc[4], acc[5]); o.w = pk2(acc[6], acc[7]);
      *(LAS v4u*)(UA + tok * 136 + c8) = o; }
    __syncthreads();
    { const int dir = F.wave >> 2, cq = F.wave & 3, l32 = F.lane & 31, hi = F.lane >> 5, chn = cq * 32 + l32, cg = nb * 128 + chn;
      const bf16* Wr = (const bf16*)(F.wsw + WS_WLRU) + ((size_t)(dir * 2 + 0) * 8 + nb) * 16384 + (size_t)chn * 128;
      const bf16* Wi = (const bf16*)(F.wsw + WS_WLRU) + ((size_t)(dir * 2 + 1) * 8 + nb) * 16384 + (size_t)chn * 128;
      f32x16 accr = {}, acci = {};
#pragma unroll
      for (int ks = 0; ks < 8; ++ks) { const int ko = ks * 16 + hi * 8;
          const bf16x8 a = *(const LAS bf16x8*)(UA + l32 * 136 + ko); const bf16x8 br = *(const bf16x8*)(Wr + ko), bi = *(const bf16x8*)(Wi + ko);
          accr = __builtin_amdgcn_mfma_f32_32x32x16_bf16(a, br, accr, 0, 0, 0); acci = __builtin_amdgcn_mfma_f32_32x32x16_bf16(a, bi, acci, 0, 0, 0); }
      const float ba = F.A->in[I_LBA][(l * 2 + dir) * 1024 + cg], bi_ = F.A->in[I_LBI][(l * 2 + dir) * 1024 + cg], sp = softplusf_(-F.A->in[I_LAM][(l * 2 + dir) * 1024 + cg]);
#pragma unroll
      for (int r = 0; r < 16; ++r) { const int tok = att::crow(r, hi); const float u = U[tok * 128 + chn];
          const float rg = sigmoidf_(accr[r] + ba), ig = sigmoidf_(acci[r] + bi_), la = -8.f * rg * sp, a = __expf(la), x2 = 2.f * la;
          const float em = x2 * (1.f + x2 * (0.5f + x2 * (0.16666667f + x2 * (0.041666668f + x2 * (0.0083333338f + x2 * 0.0013888889f)))));
          const float bc = __builtin_amdgcn_sqrtf(x2 < -0.5f ? 1.f - a * a : -em) * (ig * u);
          AB[(dir * 2 + 0) * 4096 + tok * 128 + chn] = a; AB[(dir * 2 + 1) * 4096 + tok * 128 + chn] = bc; } }
    __syncthreads();
    if (F.tid < 256) { const int dir = F.tid >> 7, chn = F.tid & 127, cg = nb * 128 + chn; const size_t ci = ((size_t)(dir * 2 + b) * NCH + ch) * 1024 + cg;
        LAS float* Aa = AB + (dir * 2) * 4096 + chn; LAS float* Bb = AB + (dir * 2 + 1) * 4096 + chn;
        if (!PASS3) { float h = 0.f, ap = 1.f;
#pragma unroll 8
            for (int s = 0; s < 32; ++s) { const int tok = dir ? 31 - s : s; const float a = Aa[tok * 128]; h = a * h + Bb[tok * 128]; ap *= a;
                if (s == 0 && dir == 1 && ch == 7) ((float*)(F.ws + WS_QUIRK))[b * 1024 + cg] = h; }
            ((float*)(F.ws + WS_CA))[ci] = ap; ((float*)(F.ws + WS_CB))[ci] = h;
        } else { float h = ((const float*)(F.ws + WS_HIN))[ci];
#pragma unroll 8
            for (int s = 0; s < 32; ++s) { const int tok = dir ? 31 - s : s; h = Aa[tok * 128] * h + Bb[tok * 128]; Bb[tok * 128] = h; } } }
    if (PASS3) { __syncthreads();
        const int tok = F.tid >> 4, c8 = (F.tid & 15) * 8, cg = nb * 128 + c8, row = row0 + tok;
        const v4u y = *(const v4u*)(P + (size_t)row * DINP + C_LRUY + cg); float o[8];
#pragma unroll
        for (int w = 0; w < 4; ++w) { const float h0 = AB[4096 + tok * 128 + c8 + 2 * w] + AB[3 * 4096 + tok * 128 + c8 + 2 * w], h1 = AB[4096 + tok * 128 + c8 + 2 * w + 1] + AB[3 * 4096 + tok * 128 + c8 + 2 * w + 1];
            o[2 * w] = h0 * gelu_tanh(bflo(y[w])); o[2 * w + 1] = h1 * gelu_tanh(bfhi(y[w])); }
        v4u ov; ov.x = pk2(o[0], o[1]); ov.y = pk2(o[2], o[3]); ov.z = pk2(o[4], o[5]); ov.w = pk2(o[6], o[7]);
        *(v4u*)((bf16*)(F.ws + WS_MIX) + (size_t)row * DM + 1024 + cg) = ov; }
}
__device__ __forceinline__ void lru_carry(Frame& F, int blk) {
    F.tid = ltid(); F.lane = F.tid & 63;
    const int gid = blk * NTHR + F.tid; if (gid >= 4096) return;
    const int dir = gid >> 11, b = (gid >> 10) & 1, cg = gid & 1023;
    const float* CA = (const float*)(F.ws + WS_CA) + ((size_t)(dir * 2 + b) * NCH) * 1024 + cg; const float* CB = (const float*)(F.ws + WS_CB) + ((size_t)(dir * 2 + b) * NCH) * 1024 + cg;
    float* HIN = (float*)(F.ws + WS_HIN) + ((size_t)(dir * 2 + b) * NCH) * 1024 + cg;
    float h = 0.f;
    if (dir == 0) {
#pragma unroll 8
        for (int c = 0; c < NCH; ++c) { HIN[(size_t)c * 1024] = h; h = CA[(size_t)c * 1024] * h + CB[(size_t)c * 1024]; }
    } else {
        for (int c = 7; c >= 0; --c) { HIN[(size_t)c * 1024] = h; h = CA[(size_t)c * 1024] * h + CB[(size_t)c * 1024]; }
        h = ((const float*)(F.ws + WS_QUIRK))[b * 1024 + cg];
#pragma unroll 8
        for (int c = NCH - 1; c >= 8; --c) { HIN[(size_t)c * 1024] = h; h = CA[(size_t)c * 1024] * h + CB[(size_t)c * 1024]; }
    }
}

__device__ __forceinline__ void rope_table(Frame& F) {
    const int i = F.vcu * NTHR + F.tid; if (i >= 2048) return;
    const int pos = i >> 4, f = i & 15; float s, c; sincosf((float)pos * exp2f(-(float)f * (13.287712379549449f / 16.f)), &s, &c);
    float* t = (float*)(F.ws + WS_ROPE); t[i] = c; t[2048 + i] = s;
}
__device__ __forceinline__ void row_prep(Frame& F, int row) {
    F.tid = ltid(); F.lane = F.tid & 63;
    bf16* pr = (bf16*)(F.ws + WS_P) + (size_t)row * DINP; const int lane = F.lane;
    const bool lat = row < M_LAT; const int t = row & (SEQ - 1); const float prow = (float)(t >> 6), pcol = (float)(t & 63);
    { const v4u a = *(const v4u*)(pr + C_QA + lane * 16), b = *(const v4u*)(pr + C_QA + lane * 16 + 8); float ss = 0.f;
#pragma unroll
      for (int w = 0; w < 4; ++w) { const float x0 = bflo(a[w]), x1 = bfhi(a[w]), x2 = bflo(b[w]), x3 = bfhi(b[w]); ss += x0 * x0 + x1 * x1 + x2 * x2 + x3 * x3; }
      ss = wave_sum(ss); if (lane == 0) ((float*)(F.ws + WS_RSQ))[row] = 1.f / sqrtf(ss * (1.f / 1024.f) + RMS_EPS); }
    { const v4u a = *(const v4u*)(pr + C_KVA + lane * 8); float ss = 0.f;
#pragma unroll
      for (int w = 0; w < 4; ++w) { const float x0 = bflo(a[w]), x1 = bfhi(a[w]); ss += x0 * x0 + x1 * x1; }
      ss = wave_sum(ss); if (lane == 0) ((float*)(F.ws + WS_RSKV))[row] = 1.f / sqrtf(ss * (1.f / 512.f) + RMS_EPS); }
    bf16* kr = (bf16*)(F.ws + WS_KR) + (size_t)row * 64;
    if (lat) {
        { const int part = lane >> 5, sub = lane & 31;
          const float inv = exp2f(-(float)sub * (13.287712379549449f / 32.f)); float sn, cs; sincosf((part ? pcol : prow) * inv, &sn, &cs);
#pragma unroll
          for (int hd = 0; hd < 10; ++hd) { bf16* qb = pr + (hd < 8 ? C_SWAQ + hd * 128 : C_SWAK + (hd - 8) * 128) + part * 64;
              const float x1 = bf2f(qb[sub]), x2 = bf2f(qb[sub + 32]); qb[sub] = (bf16)f2bf(x1 * cs - x2 * sn); qb[sub + 32] = (bf16)f2bf(x2 * cs + x1 * sn); } }
        if (lane < 32) { const int part = lane >> 4, i = lane & 15; const bf16* src = pr + C_KR + part * 32;
          const float inv = exp2f(-(float)i * (13.287712379549449f / 16.f)); float s, c; sincosf((part ? pcol : prow) * inv, &s, &c);
          const float x1 = bf2f(src[i]), x2 = bf2f(src[i + 16]);
          kr[part * 32 + i] = (bf16)f2bf(x1 * c - x2 * s); kr[part * 32 + i + 16] = (bf16)f2bf(x2 * c + x1 * s); }
    } else kr[lane] = pr[C_KR + lane];
}

__device__ __forceinline__ float allred16(float x) { return row_sum16(x); }
__device__ __forceinline__ int scan_row(int s, int dir, int b) {
    if (s < NCTX) return M_LAT + b * NCTX + (dir ? NCTX - 1 - s : s);
    const int t = s - NCTX; return b * SEQ + (dir ? SEQ - 1 - t : t);
}
__device__ __forceinline__ void rwkv_scan(Frame& F, int l, int chain) {
    F.tid = ltid(); F.lane = F.tid & 63;
    const int dir = chain >> 5, b = (chain >> 4) & 1, h = chain & 15;
    constexpr int CT = 24, NCHK = (NCTX + SEQ) / CT, STEPF = 392, BUFF = CT * STEPF;
    LAS float* buf = (LAS float*)F.lds; LAS float* ybuf = (LAS float*)(F.lds + 3 * BUFF * 4);
    gcbf RWF = (gcbf)(F.ws + WS_RWF); const size_t RS = (size_t)M_TOT * 1024;
    gflp YS = (gflp)(F.ws + WS_YS) + (size_t)dir * M_TOT * 1024;
    const bool cmp = F.wave < 4; const int lt = F.tid - 256, lst = lt >> 4, lq = lt & 15, lc = h * 64 + 4 * lq;
    const f32x4 ka4 = *(const GAS f32x4*)((gcfl)F.A->in[I_KA] + l * 1024 + (cmp ? 0 : lc));
    v2u gr[2], gk[2], gv[2], gkk[2], ge[2], ga[2];
#pragma unroll
    for (int u = 0; u < 2; ++u) { gr[u] = (v2u){0u, 0u}; gk[u] = gr[u]; gv[u] = gr[u]; gkk[u] = gr[u]; ge[u] = gr[u]; ga[u] = gr[u]; }
#define RW_LOAD(c) do { if (!cmp) { _Pragma("unroll") for (int u_ = 0; u_ < 2; ++u_) { const int s_ = lst + 16 * u_; if (s_ < CT) { const size_t o_ = (size_t)scan_row((c) * CT + s_, dir, b) * 1024 + lc; \
        gr[u_] = *(const GAS v2u*)(RWF + 0 * RS + o_); gk[u_] = *(const GAS v2u*)(RWF + 1 * RS + o_); gv[u_] = *(const GAS v2u*)(RWF + 2 * RS + o_); \
        gkk[u_] = *(const GAS v2u*)(RWF + 3 * RS + o_); ge[u_] = *(const GAS v2u*)(RWF + (4 + dir) * RS + o_); ga[u_] = *(const GAS v2u*)(RWF + (6 + dir) * RS + o_); } } } } while (0)
#define RW_WRITE(bi) do { if (!cmp) { _Pragma("unroll") for (int u_ = 0; u_ < 2; ++u_) { const int s_ = lst + 16 * u_; if (s_ < CT) { LAS float* d_ = buf + (bi) * BUFF + s_ * STEPF + 4 * lq; \
        const float r_[4] = {bflo(gr[u_].x), bfhi(gr[u_].x), bflo(gr[u_].y), bfhi(gr[u_].y)}, k_[4] = {bflo(gk[u_].x), bfhi(gk[u_].x), bflo(gk[u_].y), bfhi(gk[u_].y)}, v_[4] = {bflo(gv[u_].x), bfhi(gv[u_].x), bflo(gv[u_].y), bfhi(gv[u_].y)}; \
        const float q_[4] = {bflo(gkk[u_].x), bfhi(gkk[u_].x), bflo(gkk[u_].y), bfhi(gkk[u_].y)}, e_[4] = {bflo(ge[u_].x), bfhi(ge[u_].x), bflo(ge[u_].y), bfhi(ge[u_].y)}, a_[4] = {bflo(ga[u_].x), bfhi(ga[u_].x), bflo(ga[u_].y), bfhi(ga[u_].y)}; \
        f32x4 w4, kd4, kk4, b4, wr4, v4; float sbr = 0.f, skr = 0.f; \
        _Pragma("unroll") for (int e = 0; e < 4; ++e) { w4[e] = __expf(-e_[e]); kd4[e] = k_[e] * (1.f + (a_[e] - 1.f) * ka4[e]); kk4[e] = q_[e]; b4[e] = q_[e] * a_[e]; wr4[e] = w4[e] * r_[e]; v4[e] = v_[e]; sbr += b4[e] * r_[e]; skr += kd4[e] * r_[e]; } \
        sbr = row_sum16(sbr); skr = row_sum16(skr); \
        *(LAS f32x4*)(d_) = w4; *(LAS f32x4*)(d_ + 64) = kd4; *(LAS f32x4*)(d_ + 128) = kk4; *(LAS f32x4*)(d_ + 192) = b4; *(LAS f32x4*)(d_ + 256) = wr4; *(LAS f32x4*)(d_ + 320) = v4; \
        if (lq == 0) *(LAS f32x2*)(buf + (bi) * BUFF + s_ * STEPF + 384) = (f32x2){sbr, skr}; } } } } while (0)
#define RW_FLUSH(c) do { if (!cmp) { _Pragma("unroll") for (int u_ = 0; u_ < 2; ++u_) { const int s_ = lst + 16 * u_; if (s_ < CT) { const f32x4 y_ = *(const LAS f32x4*)(ybuf + ((c) & 1) * (CT * 64) + s_ * 64 + 4 * lq); \
        *(GAS f32x4*)(YS + (size_t)scan_row((c) * CT + s_, dir, b) * 1024 + lc) = y_; } } } } while (0)
    __syncthreads();
    RW_LOAD(0); RW_WRITE(0); RW_LOAD(1); RW_WRITE(1); RW_LOAD(2);
    __syncthreads();
    const int kg = F.lane & 7, rg = F.lane >> 3, r0 = 16 * (F.wave & 3) + 2 * rg;
    f32x2 St[8];
#pragma unroll
    for (int i = 0; i < 8; ++i) St[i] = (f32x2){0.f, 0.f};
    int bc = 0, bw = 2;
#pragma unroll 1
    for (int c = 0; c < NCHK; ++c) {
        if (c + 2 < NCHK) { RW_WRITE(bw); if (c + 3 < NCHK) RW_LOAD(c + 3); }
        if (c > 0) RW_FLUSH(c - 1);
        if (cmp) {
        const LAS float* bb = buf + bc * BUFF + 8 * kg; const LAS float* vb = buf + bc * BUFF + 320 + r0; const LAS float* sb = buf + bc * BUFF + 384;
        LAS float* yb = ybuf + (c & 1) * (CT * 64) + r0;
        f32x4 w4[2], kd4[2], kk4[2], b4[2], wr4[2];
#pragma unroll
        for (int q = 0; q < 2; ++q) { w4[q] = *(const LAS f32x4*)(bb + 4 * q); kd4[q] = *(const LAS f32x4*)(bb + 64 + 4 * q); kk4[q] = *(const LAS f32x4*)(bb + 128 + 4 * q); b4[q] = *(const LAS f32x4*)(bb + 192 + 4 * q); wr4[q] = *(const LAS f32x4*)(bb + 256 + 4 * q); }
        f32x2 v2 = *(const LAS f32x2*)(vb), s2 = *(const LAS f32x2*)(sb);
#pragma unroll
        for (int st = 0; st < CT; ++st) {
            const int sn = (st + 1 < CT ? st + 1 : st) * STEPF;
            f32x4 nw4[2], nkd4[2], nkk4[2], nb4[2], nwr4[2];
#pragma unroll
            for (int q = 0; q < 2; ++q) { nw4[q] = *(const LAS f32x4*)(bb + sn + 4 * q); nkd4[q] = *(const LAS f32x4*)(bb + sn + 64 + 4 * q); nkk4[q] = *(const LAS f32x4*)(bb + sn + 128 + 4 * q); nb4[q] = *(const LAS f32x4*)(bb + sn + 192 + 4 * q); nwr4[q] = *(const LAS f32x4*)(bb + sn + 256 + 4 * q); }
            const f32x2 nv2 = *(const LAS f32x2*)(vb + sn), ns2 = *(const LAS f32x2*)(sb + sn);
#define PR(x, e) ((((e) >> 1) & 1) ? (f32x2){(x)[(e) >> 2][2], (x)[(e) >> 2][3]} : (f32x2){(x)[(e) >> 2][0], (x)[(e) >> 2][1]})
            f32x2 p, z, tpb, tzb;
            asm("v_pk_mul_f32 %0, %4, %12 op_sel:[0,0] op_sel_hi:[1,0]\n\tv_pk_mul_f32 %1, %4, %16 op_sel:[0,0] op_sel_hi:[1,0]\n\tv_pk_mul_f32 %2, %8, %14 op_sel:[0,0] op_sel_hi:[1,0]\n\tv_pk_mul_f32 %3, %8, %18 op_sel:[0,0] op_sel_hi:[1,0]\n\tv_pk_fma_f32 %0, %5, %12, %0 op_sel:[0,1,0] op_sel_hi:[1,1,1]\n\tv_pk_fma_f32 %1, %5, %16, %1 op_sel:[0,1,0] op_sel_hi:[1,1,1]\n\tv_pk_fma_f32 %2, %9, %14, %2 op_sel:[0,1,0] op_sel_hi:[1,1,1]\n\tv_pk_fma_f32 %3, %9, %18, %3 op_sel:[0,1,0] op_sel_hi:[1,1,1]\n\tv_pk_fma_f32 %0, %6, %13, %0 op_sel:[0,0,0] op_sel_hi:[1,0,1]\n\tv_pk_fma_f32 %1, %6, %17, %1 op_sel:[0,0,0] op_sel_hi:[1,0,1]\n\tv_pk_fma_f32 %2, %10, %15, %2 op_sel:[0,0,0] op_sel_hi:[1,0,1]\n\tv_pk_fma_f32 %3, %10, %19, %3 op_sel:[0,0,0] op_sel_hi:[1,0,1]\n\tv_pk_fma_f32 %0, %7, %13, %0 op_sel:[0,1,0] op_sel_hi:[1,1,1]\n\tv_pk_fma_f32 %1, %7, %17, %1 op_sel:[0,1,0] op_sel_hi:[1,1,1]\n\tv_pk_fma_f32 %2, %11, %15, %2 op_sel:[0,1,0] op_sel_hi:[1,1,1]\n\tv_pk_fma_f32 %3, %11, %19, %3 op_sel:[0,1,0] op_sel_hi:[1,1,1]\n\tv_pk_add_f32 %0, %0, %2\n\tv_pk_add_f32 %1, %1, %3\n\tv_pk_mul_f32 %4, %4, %20 op_sel:[0,0] op_sel_hi:[1,0]\n\tv_pk_mul_f32 %5, %5, %20 op_sel:[0,1] op_sel_hi:[1,1]\n\tv_pk_mul_f32 %6, %6, %21 op_sel:[0,0] op_sel_hi:[1,0]\n\tv_pk_mul_f32 %7, %7, %21 op_sel:[0,1] op_sel_hi:[1,1]\n\tv_pk_mul_f32 %8, %8, %22 op_sel:[0,0] op_sel_hi:[1,0]\n\tv_pk_mul_f32 %9, %9, %22 op_sel:[0,1] op_sel_hi:[1,1]\n\tv_pk_mul_f32 %10, %10, %23 op_sel:[0,0] op_sel_hi:[1,0]\n\tv_pk_mul_f32 %11, %11, %23 op_sel:[0,1] op_sel_hi:[1,1]\n\tv_pk_fma_f32 %4, %28, %24, %4 op_sel:[0,0,0] op_sel_hi:[1,0,1]\n\tv_pk_fma_f32 %5, %28, %24, %5 op_sel:[0,1,0] op_sel_hi:[1,1,1]\n\tv_pk_fma_f32 %6, %28, %25, %6 op_sel:[0,0,0] op_sel_hi:[1,0,1]\n\tv_pk_fma_f32 %7, %28, %25, %7 op_sel:[0,1,0] op_sel_hi:[1,1,1]\n\tv_pk_fma_f32 %8, %28, %26, %8 op_sel:[0,0,0] op_sel_hi:[1,0,1]\n\tv_pk_fma_f32 %9, %28, %26, %9 op_sel:[0,1,0] op_sel_hi:[1,1,1]\n\tv_pk_fma_f32 %10, %28, %27, %10 op_sel:[0,0,0] op_sel_hi:[1,0,1]\n\tv_pk_fma_f32 %11, %28, %27, %11 op_sel:[0,1,0] op_sel_hi:[1,1,1]"
                : "=&v"(p), "=&v"(z), "=&v"(tpb), "=&v"(tzb), "+v"(St[0]), "+v"(St[1]), "+v"(St[2]), "+v"(St[3]), "+v"(St[4]), "+v"(St[5]), "+v"(St[6]), "+v"(St[7])
                : "v"(PR(kk4, 0)), "v"(PR(kk4, 2)), "v"(PR(kk4, 4)), "v"(PR(kk4, 6)), "v"(PR(wr4, 0)), "v"(PR(wr4, 2)), "v"(PR(wr4, 4)), "v"(PR(wr4, 6)),
                  "v"(PR(w4, 0)), "v"(PR(w4, 2)), "v"(PR(w4, 4)), "v"(PR(w4, 6)), "v"(PR(kd4, 0)), "v"(PR(kd4, 2)), "v"(PR(kd4, 4)), "v"(PR(kd4, 6)), "v"(v2));
            float p0 = p.x, p1 = p.y, z0 = z.x, z1 = z.y;
#define D4(ctl) "v_add_f32_dpp %0, %0, %0 " ctl " row_mask:0xf bank_mask:0xf\n\tv_add_f32_dpp %1, %1, %1 " ctl " row_mask:0xf bank_mask:0xf\n\tv_add_f32_dpp %2, %2, %2 " ctl " row_mask:0xf bank_mask:0xf\n\tv_add_f32_dpp %3, %3, %3 " ctl " row_mask:0xf bank_mask:0xf\n\t"
            asm volatile("s_nop 1\n\t" D4("quad_perm:[1,0,3,2]") D4("quad_perm:[2,3,0,1]") D4("row_half_mirror") "s_nop 0"
                : "+v"(p0), "+v"(p1), "+v"(z0), "+v"(z1));
#undef D4
            const f32x2 pp = {p0, p1}, zz = {z0, z1};
            { f32x2 y;
              asm("v_pk_fma_f32 %0, %9, %11, %10 op_sel:[0,0,0] op_sel_hi:[1,0,1] neg_lo:[1,0,0] neg_hi:[1,0,0]\n\tv_pk_fma_f32 %0, %12, %11, %0 op_sel:[0,1,0] op_sel_hi:[1,1,1]\n\tv_pk_fma_f32 %1, %9, %13, %1 op_sel:[0,0,0] op_sel_hi:[1,0,1] neg_lo:[1,0,0] neg_hi:[1,0,0]\n\tv_pk_fma_f32 %2, %9, %13, %2 op_sel:[0,1,0] op_sel_hi:[1,1,1] neg_lo:[1,0,0] neg_hi:[1,0,0]\n\tv_pk_fma_f32 %3, %9, %14, %3 op_sel:[0,0,0] op_sel_hi:[1,0,1] neg_lo:[1,0,0] neg_hi:[1,0,0]\n\tv_pk_fma_f32 %4, %9, %14, %4 op_sel:[0,1,0] op_sel_hi:[1,1,1] neg_lo:[1,0,0] neg_hi:[1,0,0]\n\tv_pk_fma_f32 %5, %9, %15, %5 op_sel:[0,0,0] op_sel_hi:[1,0,1] neg_lo:[1,0,0] neg_hi:[1,0,0]\n\tv_pk_fma_f32 %6, %9, %15, %6 op_sel:[0,1,0] op_sel_hi:[1,1,1] neg_lo:[1,0,0] neg_hi:[1,0,0]\n\tv_pk_fma_f32 %7, %9, %16, %7 op_sel:[0,0,0] op_sel_hi:[1,0,1] neg_lo:[1,0,0] neg_hi:[1,0,0]\n\tv_pk_fma_f32 %8, %9, %16, %8 op_sel:[0,1,0] op_sel_hi:[1,1,1] neg_lo:[1,0,0] neg_hi:[1,0,0]"
                : "=&v"(y), "+v"(St[0]), "+v"(St[1]), "+v"(St[2]), "+v"(St[3]), "+v"(St[4]), "+v"(St[5]), "+v"(St[6]), "+v"(St[7])
                : "v"(pp), "v"(zz), "v"(s2), "v"(v2), "v"(PR(b4, 0)), "v"(PR(b4, 2)), "v"(PR(b4, 4)), "v"(PR(b4, 6)));
              *(LAS f32x2*)(yb + st * 64) = y; }
#undef PR
#pragma unroll
            for (int q = 0; q < 2; ++q) { w4[q] = nw4[q]; kd4[q] = nkd4[q]; kk4[q] = nkk4[q]; b4[q] = nb4[q]; wr4[q] = nwr4[q]; }
            v2 = nv2; s2 = ns2;
        }
        }
        __syncthreads();
        bc = bc == 2 ? 0 : bc + 1; bw = bw == 2 ? 0 : bw + 1;
    }
    RW_FLUSH(NCHK - 1);
#undef RW_LOAD
#undef RW_WRITE
#undef RW_FLUSH
}
__device__ __forceinline__ void rwkv_out_row(Frame& F, int l, int row) {
    F.tid = ltid(); F.lane = F.tid & 63;
    const int c0 = F.lane * 16; const float* yf = (const float*)(F.ws + WS_YS) + (size_t)row * 1024 + c0; const float* yb = yf + (size_t)M_TOT * 1024;
    float y[16]; float s = 0.f;
#pragma unroll
    for (int j = 0; j < 4; ++j) { const f32x4 a = __builtin_nontemporal_load((const f32x4*)(yf + 4 * j)), b = __builtin_nontemporal_load((const f32x4*)(yb + 4 * j));
#pragma unroll
        for (int e = 0; e < 4; ++e) { y[4 * j + e] = a[e] + b[e]; s += y[4 * j + e]; } }
    s = quad_sum(s); const float mu = s * (1.f / 64.f); float q = 0.f;
#pragma unroll
    for (int e = 0; e < 16; ++e) { y[e] -= mu; q += y[e] * y[e]; }
    q = quad_sum(q); const float rstd = 1.f / sqrtf(q * (1.f / 64.f) + GN_EPS);
    const bf16* RWF = (const bf16*)(F.ws + WS_RWF); const size_t RS = (size_t)M_TOT * 1024, o = (size_t)row * 1024 + c0;
    const float sbv = ((const float*)(F.ws + WS_SB))[(size_t)row * 16 + (F.lane >> 2)];
    const float* lg = F.A->in[I_LNG] + l * 1024 + c0; const float* lb = F.A->in[I_LNB] + l * 1024 + c0;
    bf16* dst = (bf16*)(F.ws + WS_MIX) + (size_t)row * DM + 3072 + c0;
#pragma unroll
    for (int hf = 0; hf < 2; ++hf) { const v4u vv = *(const v4u*)(RWF + 2 * RS + o + 8 * hf), gg = *(const v4u*)(RWF + 8 * RS + o + 8 * hf); float r[8];
#pragma unroll
        for (int w = 0; w < 4; ++w) { const int e = 8 * hf + 2 * w;
            r[2 * w] = (y[e] * rstd * lg[e] + lb[e] + sbv * bflo(vv[w])) * bflo(gg[w]); r[2 * w + 1] = (y[e + 1] * rstd * lg[e + 1] + lb[e + 1] + sbv * bfhi(vv[w])) * bfhi(gg[w]); }
        v4u ov; ov.x = pk2(r[0], r[1]); ov.y = pk2(r[2], r[3]); ov.z = pk2(r[4], r[5]); ov.w = pk2(r[6], r[7]); *(v4u*)(dst + 8 * hf) = ov; }
}

#ifndef W_OUT_K1
#define W_OUT_K1 2048
#endif
struct MlaTiles { gcbf KV; gcbf KR; int ctx_row0, lat_row0, h;
    __device__ __forceinline__ att::Tile operator()(int j) const { const int row = j < 4 ? ctx_row0 + 64 * j : lat_row0 + 64 * (j - 4);
        att::Tile t; t.kn = KV + (size_t)row * 2048 + h * 256; t.v = t.kn + 128; t.kr = KR + (size_t)row * 64; t.mtype = 0; t.krel0 = 0; return t; } };
struct SwaTiles { gcbf P; int blk_row0, ctx_row0, kvh, nwin, has_prev, has_next;
    __device__ __forceinline__ att::Tile operator()(int j) const { att::Tile t; int row; t.mtype = 0; t.krel0 = 0;
        if (j >= nwin) row = ctx_row0 + 64 * (j - nwin);
        else if (j < 2) row = blk_row0 + 64 * j;
        else if (has_prev && j < 4) { row = blk_row0 - 128 + 64 * (j - 2); t.mtype = 1; t.krel0 = -128 + 64 * (j - 2); }
        else { const int sub = j - 2 - 2 * has_prev; row = blk_row0 + 128 + 64 * sub; t.mtype = 2; t.krel0 = 128 + 64 * sub; }
        t.kn = P + (size_t)row * DINP + C_SWAK + kvh * 128; t.v = P + (size_t)row * DINP + C_SWAV + kvh * 128; t.kr = nullptr; return t; } };

#ifndef MLA_SDEPTH
#define MLA_SDEPTH 1
#endif
__device__ __forceinline__ void mla_item(Frame& F, int b, int h, int qb, bool ctxq) {
    F.tid = ltid(); F.lane = F.tid & 63;
    const int r32 = F.lane & 31; const int t = qb * 256 + F.wave * 32 + r32;
    const int roww0 = ctxq ? M_LAT + b * NCTX + F.wave * 32 : b * SEQ + qb * 256 + F.wave * 32;
    gcbf Qw = (gcbf)(F.ws + WS_Q) + (size_t)(roww0 + r32) * 1536 + h * 192;
    MlaTiles ts{(gcbf)(F.ws + WS_KV), (gcbf)(F.ws + WS_KR), M_LAT + b * NCTX, b * SEQ, h};
    gbfp Ow = (gbfp)(F.ws + WS_MIX) + (size_t)roww0 * DM + 2048 + h * 128;
    att::attn_body<192, 2048, 2048, false, false, MLA_SDEPTH>(Qw, ctxq ? 0 : 1, t >> 6, t & 63, (gcfl)(F.ws + WS_ROPE), 0, 0.f, ts, ctxq ? 4 : 132, Ow, (LAS char*)F.lds);
}
__device__ __forceinline__ void swa_item(Frame& F, int l, int b, int n, int kvh, int half, bool ctxq, int hq_ctx) {
    F.tid = ltid(); F.lane = F.tid & 63;
    const int r32 = F.lane & 31; gcbf P = (gcbf)(F.ws + WS_P);
    int hq, qi, roww0, t;
    if (ctxq) { hq = hq_ctx; kvh = hq >> 2; qi = 0; roww0 = M_LAT + b * NCTX + F.wave * 32; t = 0; }
    else { hq = kvh * 4 + 2 * half + (F.wave >> 2); qi = (F.wave & 3) * 32 + r32; roww0 = b * SEQ + n * 128 + (F.wave & 3) * 32; t = n * 128 + qi; }
    gcbf Qw = P + (size_t)(roww0 + r32) * DINP + C_SWAQ + hq * 128;
    SwaTiles ts; ts.P = P; ts.blk_row0 = b * SEQ + n * 128; ts.ctx_row0 = M_LAT + b * NCTX; ts.kvh = kvh;
    ts.has_prev = (!ctxq && n > 0) ? 1 : 0; ts.has_next = (!ctxq && n < SEQ / 128 - 1) ? 1 : 0; ts.nwin = ctxq ? 0 : 2 + 2 * ts.has_prev + 2 * ts.has_next;
    gbfp Ow = (gbfp)(F.ws + WS_MIX) + (size_t)roww0 * DM + hq * 128;
    const float sink_l2 = F.A->in[I_SINK][l * 8 + hq] * 1.4426950408889634f;
    att::attn_body<128, DINP, DINP, true, true, 2>(Qw, 0, 0, 0, (gcfl)nullptr, qi, sink_l2, ts, ts.nwin + 4, Ow, (LAS char*)F.lds);
}

#ifndef DBG_PHASES
#define DBG_PHASES 0xfffff
#endif
#define PH(n) ((DBG_PHASES >> (n)) & 1)
#ifndef DUP_PHASES
#define DUP_PHASES 0
#endif
#define REP(n) _Pragma("unroll") for (int rep_ = 0; rep_ < (((DUP_PHASES >> (n)) & 1) ? 2 : 1); ++rep_)
__global__ void __launch_bounds__(NTHR, 2) mk_fwd(Args args) {
    extern __shared__ __attribute__((aligned(16))) unsigned char lds[];
    Frame F;
    F.lds = (LAS unsigned char*)lds;
    F.tid = threadIdx.x; F.lane = F.tid & 63; F.wave = __builtin_amdgcn_readfirstlane(F.tid >> 6);
    F.G = gridDim.x; { const int bx = blockIdx.x; F.vcu = (F.G % 8 == 0) ? (bx % 8) * (F.G / 8) + bx / 8 : bx; }
    F.gw = F.vcu * NWAVES + F.wave; F.NGW = F.G * NWAVES;
    F.ws = args.ws; F.out = args.out; F.ctl = (gu32*)(args.ws + WS_CTL);
    F.A = (const __attribute__((address_space(4))) Args*)__builtin_amdgcn_kernarg_segment_ptr();
    for (int u = F.tid; u < (LDS_BYTES - LDSCTL_OFF) / 4; u += NTHR) ((LAS unsigned*)(F.lds + LDSCTL_OFF))[u] = 0u;
    __syncthreads();
    XcdBarrier bar = xcd_barrier_post((unsigned*)(args.ws + WS_CTL) + 4096, (volatile LAS unsigned*)(F.lds + MISC_OFF) + 8);
    const bool rwkv_blk = (blockIdx.x & 3) == 0;
    XcdBarrier bar2; bar2.bar = (unsigned*)(args.ws + WS_CTL) + 8192; bar2.x = 0; bar2.st = (volatile LAS unsigned*)(F.lds + MISC_OFF) + 12; bar2.nparts = gridDim.x - ((gridDim.x + 3) >> 2);
    if (!rwkv_blk) { const unsigned np_ = bar2.nparts; bar2 = xcd_barrier_post((unsigned*)(args.ws + WS_CTL) + 8192, (volatile LAS unsigned*)(F.lds + MISC_OFF) + 12); bar2.nparts = np_; }
#define SUB_BAR() do { bar2.bar = launder(bar2.bar); bar2.x = launder(bar2.x); xcd_barrier(bar2); F.ws = launder_g(F.ws); F.wsw = F.ws + (size_t)lcur * WSET_STRIDE; F.A = launder(F.A); F.tid = ltid(); F.lane = F.tid & 63; } while (0)
#define GRID_BAR() do { bar.bar = launder(bar.bar); bar.x = launder(bar.x); xcd_barrier(bar); F.ws = launder_g(F.ws); F.wsw = F.ws + (size_t)lcur * WSET_STRIDE; F.A = launder(F.A); F.tid = ltid(); F.lane = F.tid & 63; } while (0)
    const int bx = blockIdx.x; int lcur = 0; F.wsw = F.ws;
    bf16* H = (bf16*)(F.ws + WS_H); float* X = (float*)(F.ws + WS_X);

    REP(0) if (PH(0)) { mod_partials(F);
    convert_weights(F, 0, F.gw, F.NGW); }
    GRID_BAR();
    if (PH(1)) { mod_reduce(F); rope_table(F); }
    GRID_BAR();

#pragma unroll 1
    for (int l = 0; l < 2; ++l) {
        lcur = l; F.wsw = F.ws + (size_t)l * WSET_STRIDE;
        const bool wctx = (l == 0);
        const int MO = wctx ? M_TOT : M_LAT;
        if (PH(2) && l == 0) {
            for (int row = F.gw; row < M_TOT; row += F.NGW) { const int s = row_s(row);
                const float* xs = row < M_LAT ? F.A->in[I_X] + (size_t)row * DM : F.A->in[I_CTX] + (size_t)(row - M_LAT) * DM;
                ln_row<0>(F, xs, nullptr, nullptr, nullptr, nullptr, nullptr, true, mod_ptr(F, 0, s, 1), mod_ptr(F, 0, s, 0), H + (size_t)row * DM); }
        }
        GRID_BAR();
        REP(3) if (PH(3)) { pg8::Gemm g{H, (const bf16*)(F.wsw + WS_WIN), M_TOT, DINP, DM, DM, DM}; pg8::StaticOrder S; S.init(M_TOT, DINP, F.G, bx);
          pg8::EpiBf16<0> E{(bf16*)(F.ws + WS_P), DINP, nullptr};
          pg8::gemm_phase<pg8::EpiBf16<0>, pg8::StaticOrder, true, true>(F.lds, g, S, E); }
        GRID_BAR();
        REP(4) if (PH(4)) for (int it = F.vcu; it < 528; it += F.G) rwkv_feat_item(F, l, it);
        REP(5) if (PH(5)) { if (F.G == 256) { if (F.vcu < 16) { for (int it = F.vcu; it < 64; it += 16) lru_item<false>(F, l, it); }
                                              else { for (int it = 64 + F.vcu - 16; it < 2 * NCH * 8; it += 240) lru_item<false>(F, l, it); } }
                            else for (int it = F.vcu; it < 2 * NCH * 8; it += F.G) lru_item<false>(F, l, it); }
        __syncthreads();
        if (PH(6)) for (int row = F.gw; row < M_TOT; row += F.NGW) row_prep(F, row);
        GRID_BAR();
        REP(8) if (rwkv_blk) { const int nrw = (F.G + 3) >> 2; REP(18) if (PH(8)) for (int chain = bx >> 2; chain < 64; chain += nrw) rwkv_scan(F, l, chain); }
        else REP(19) { const int x8 = bx & 7, naw = F.G - ((F.G + 3) >> 2);
            const int aw = (F.G == 256) ? ((x8 < 4 ? x8 - 1 : x8 - 2) * 32 + (bx >> 3)) : ((bx >> 2) * 3 + (bx & 3) - 1);
            if (PH(7) && aw < 8) lru_carry(F, aw);
            if (PH(7)) { pg8::Gemm g{(const bf16*)(F.ws + WS_P) + C_QA, (const bf16*)(F.wsw + WS_WQB), M_TOT, 1536, 1024, DINP, 1024}; pg8::StaticOrder S; S.init(M_TOT, 1536, naw, aw);
              pg8::EpiBf16<2> E{(bf16*)(F.ws + WS_Q), 1536, (const float*)(F.ws + WS_RSQ)};
              pg8::gemm_phase<pg8::EpiBf16<2>, pg8::StaticOrder, true, true>(F.lds, g, S, E); }
            if (PH(7)) { pg8::Gemm g{(const bf16*)(F.ws + WS_P) + C_KVA, (const bf16*)(F.wsw + WS_WKVB), M_TOT, 2048, 512, DINP, 512}; pg8::StaticOrder S; S.init(M_TOT, 2048, naw, aw);
              pg8::EpiBf16<2> E{(bf16*)(F.ws + WS_KV), 2048, (const float*)(F.ws + WS_RSKV)};
              pg8::gemm_phase<pg8::EpiBf16<2>, pg8::StaticOrder, true, true>(F.lds, g, S, E); }
            SUB_BAR();
            if (PH(9)) for (int it = aw; it < 512; it += naw) mla_item(F, it >> 8, (it >> 5) & 7, it & 31, false);
            if (PH(9) && wctx) for (int it = aw; it < 16; it += naw) mla_item(F, it >> 3, it & 7, 0, true);
            if (PH(10)) for (int it = aw; it < 512; it += naw) swa_item(F, l, it >> 8, (it >> 2) & 63, (it >> 1) & 1, it & 1, false, 0);
            if (PH(10) && wctx) for (int it = aw; it < 16; it += naw) swa_item(F, l, it >> 3, 0, 0, 0, true, it & 7);
            if (PH(11)) { if (naw == 192) { const int i0 = aw < 128 ? aw : 1280 + aw - 128, st_ = aw < 128 ? 128 : 64, i1 = aw < 128 ? 1280 : 2 * NCH * 8;
                                            for (int it = i0; it < i1; it += st_) { if (!wctx && ((it >> 3) % NCH) < 8) continue; lru_item<true>(F, l, it); } }
                          else for (int it = aw; it < 2 * NCH * 8; it += naw) { if (!wctx && ((it >> 3) % NCH) < 8) continue; lru_item<true>(F, l, it); } }
            if (l == 0) { __syncthreads(); convert_weights(F, 1, aw * NWAVES + F.wave, naw * NWAVES); }
            else { SUB_BAR();
                pg8::Gemm g{(const bf16*)(F.ws + WS_MIX), (const bf16*)(F.wsw + WS_WOUT), M_LAT, DM, W_OUT_K1, DM, DM}; pg8::StaticOrder S; S.init(M_LAT, DM, naw, aw);
                pg8::EpiBf16<0> E{(bf16*)(F.ws + WS_Y1), DM, nullptr};
                pg8::gemm_phase<pg8::EpiBf16<0>, pg8::StaticOrder, true, true>(F.lds, g, S, E); }
        }
        GRID_BAR();
        REP(12) if (PH(12)) for (int row = F.gw; row < MO; row += F.NGW) rwkv_out_row(F, l, row);
        GRID_BAR();
        REP(13) if (PH(13)) {
          if (l == 0) { pg8::Gemm g{(const bf16*)(F.ws + WS_MIX), (const bf16*)(F.wsw + WS_WOUT), M_LAT, DM, DM, DM, DM}; pg8::StaticOrder S; S.init(M_LAT, DM, F.G, bx);
            pg8::EpiBf16<0> E{(bf16*)(F.ws + WS_Y1), DM, nullptr};
            pg8::gemm_phase<pg8::EpiBf16<0>, pg8::StaticOrder, true, true>(F.lds, g, S, E); }
          else { pg8::Gemm g{(const bf16*)(F.ws + WS_MIX) + W_OUT_K1, (const bf16*)(F.wsw + WS_WOUT) + W_OUT_K1, M_LAT, DM, DM - W_OUT_K1, DM, DM}; pg8::StaticOrder S; S.init(M_LAT, DM, F.G, bx);
            pg8::EpiBf16<3> E{(bf16*)(F.ws + WS_Y1), DM, nullptr};
            pg8::gemm_phase<pg8::EpiBf16<3>, pg8::StaticOrder, true, true>(F.lds, g, S, E); }
          if (wctx) {
              pg8::Gemm g2{(const bf16*)(F.ws + WS_MIX) + (size_t)M_LAT * DM, (const bf16*)(F.wsw + WS_WOUT), M_CTX, DM, DM / 8, DM, DM}; pg8::SplitOrder S2; S2.init(M_CTX, DM, DM / 8, bx);
              pg8::EpiF32 E2{(float*)(F.ws + WS_YP), DM, (size_t)M_CTX * DM};
              pg8::gemm_phase<pg8::EpiF32, pg8::SplitOrder, true, true>(F.lds, g2, S2, E2); } }
        GRID_BAR();
        if (PH(14)) for (int row = F.gw; row < MO; row += F.NGW) { const int s = row_s(row);
            const float* xs = (l == 0) ? (row < M_LAT ? F.A->in[I_X] + (size_t)row * DM : F.A->in[I_CTX] + (size_t)(row - M_LAT) * DM) : X + (size_t)row * DM;
            bf16* yrow = (bf16*)(F.ws + WS_Y1) + (size_t)row * DM;
            if (row >= M_LAT) sum_partials_row(F, (const float*)(F.ws + WS_YP) + (size_t)(row - M_LAT) * DM, (size_t)M_CTX * DM, yrow);
            ln_row<1>(F, xs, yrow, mod_ptr(F, l, s, 2), F.A->in[I_LN1G] + l * DM, F.A->in[I_LN1B] + l * DM, X + (size_t)row * DM,
                      true, mod_ptr(F, l, s, 4), mod_ptr(F, l, s, 3), H + (size_t)row * DM); }
        GRID_BAR();
        REP(15) if (PH(15)) { pg8::Gemm g{H, (const bf16*)(F.wsw + WS_WFF1), MO, DFF, DM, DM, DM}; pg8::StaticOrder S; S.init(MO, DFF, F.G, bx);
          pg8::EpiBf16<1> E{(bf16*)(F.ws + WS_HID), DFF, nullptr};
          pg8::gemm_phase<pg8::EpiBf16<1>, pg8::StaticOrder, true, true>(F.lds, g, S, E); }
        GRID_BAR();
        REP(16) if (PH(16)) { pg8::Gemm g{(const bf16*)(F.ws + WS_HID), (const bf16*)(F.wsw + WS_WFF2), M_LAT, DM, DFF, DFF, DFF}; pg8::StaticOrder S; S.init(M_LAT, DM, F.G, bx);
          pg8::EpiBf16<0> E{(bf16*)(F.ws + WS_Y2), DM, nullptr};
          pg8::gemm_phase<pg8::EpiBf16<0>, pg8::StaticOrder, true, true>(F.lds, g, S, E);
          if (wctx) {
              pg8::Gemm g2{(const bf16*)(F.ws + WS_HID) + (size_t)M_LAT * DFF, (const bf16*)(F.wsw + WS_WFF2), M_CTX, DM, DFF / 8, DFF, DFF}; pg8::SplitOrder S2; S2.init(M_CTX, DM, DFF / 8, bx);
              pg8::EpiF32 E2{(float*)(F.ws + WS_YP), DM, (size_t)M_CTX * DM};
              pg8::gemm_phase<pg8::EpiF32, pg8::SplitOrder, true, true>(F.lds, g2, S2, E2); } }
        GRID_BAR();
        if (!PH(17)) {} else if (l == 0) {
            for (int row = F.gw; row < M_TOT; row += F.NGW) { const int s = row_s(row);
                bf16* yrow = (bf16*)(F.ws + WS_Y2) + (size_t)row * DM;
                if (row >= M_LAT) sum_partials_row(F, (const float*)(F.ws + WS_YP) + (size_t)(row - M_LAT) * DM, (size_t)M_CTX * DM, yrow);
                ln_row<1>(F, X + (size_t)row * DM, yrow, mod_ptr(F, 0, s, 5), F.A->in[I_LN2G], F.A->in[I_LN2B], X + (size_t)row * DM,
                          true, mod_ptr(F, 1, s, 1), mod_ptr(F, 1, s, 0), H + (size_t)row * DM); }
        } else {
            for (int row = F.gw; row < M_LAT; row += F.NGW) { const int s = row_s(row);
                ln_row<1>(F, X + (size_t)row * DM, (const bf16*)(F.ws + WS_Y2) + (size_t)row * DM, mod_ptr(F, 1, s, 5), F.A->in[I_LN2G] + DM, F.A->in[I_LN2B] + DM, F.out + (size_t)row * DM,
                          false, nullptr, nullptr, nullptr); }
        }
    }
}

extern "C" void kernel_launch(void* const* d_in, const int* in_sizes, int n_in, void* d_out, int out_size, void* d_ws, size_t ws_size, hipStream_t stream) {
    static int grid = 0;
    if (grid == 0) {
        if (n_in != 38 || out_size != M_LAT * DM || ws_size < WS_END) { fprintf(stderr, "kernel_launch: unexpected shapes: n_in %d out %d ws %zu (need %zu)\n", n_in, out_size, ws_size, (size_t)WS_END); grid = -1; return; }
        int dev = 0, cus = 0, per_cu = 0;
        if (hipGetDevice(&dev) != hipSuccess || hipDeviceGetAttribute(&cus, hipDeviceAttributeMultiprocessorCount, dev) != hipSuccess) { grid = -1; return; }
        if (hipFuncSetAttribute((const void*)mk_fwd, hipFuncAttributeMaxDynamicSharedMemorySize, LDS_BYTES) != hipSuccess) { fprintf(stderr, "kernel_launch: hipFuncSetAttribute failed\n"); grid = -1; return; }
        if (hipOccupancyMaxActiveBlocksPerMultiprocessor(&per_cu, (const void*)mk_fwd, NTHR, LDS_BYTES) != hipSuccess || per_cu < 1) fprintf(stderr, "kernel_launch: occupancy query says %d\n", per_cu);
        (void)hipGetLastError();
        grid = cus;
    }
    if (grid < 0) return;
    if (hipMemsetAsync((char*)d_ws + WS_CTL, 0, CTL_ZERO_BYTES, stream) != hipSuccess) return;
    Args a{};
    for (int i = 0; i < 38; ++i) a.in[i] = (const float*)d_in[i];
    a.out = (float*)d_out; a.ws = (unsigned char*)d_ws;
    hipLaunchKernelGGL(mk_fwd, dim3(grid), dim3(NTHR), LDS_BYTES, stream, a);
    const hipError_t le = hipPeekAtLastError();
    if (le != hipSuccess) fprintf(stderr, "kernel_launch: launch failed: %s\n", hipGetErrorName(le));
}
```

```cpp
#include <hip/hip_runtime.h>
#include <hip/hip_bf16.h>
#include <cstdio>
#include <cstdint>

namespace pg8 {
#define PG8_LAS __attribute__((address_space(3)))
typedef unsigned short bf16_t;
typedef short bf16x8 __attribute__((ext_vector_type(8)));
typedef float f32x4 __attribute__((ext_vector_type(4)));
typedef unsigned u32x4 __attribute__((ext_vector_type(4)));
constexpr int BM = 256, BK = 64, HALF = 128, HTB = HALF * BK * 2  , STAGE_BYTES = 8 * HTB, NXCD = 8, WGM = 8;

__host__ __device__ __forceinline__ int lds_byte(int r, int c) { const int st = (r >> 4) * 2 + (c >> 5), rr = r & 15, cc = c & 31, ob = rr * 64 + cc * 2; return st * 1024 + (ob ^ (((ob >> 9) & 1) << 5)); }
__host__ __device__ __forceinline__ void stage_rc(int b, int& R, int& C) { const int st = b / 1024, sb = b % 1024, swz = sb ^ (((sb >> 9) & 1) << 5); R = (st >> 1) * 16 + swz / 64; C = (st & 1) * 32 + (swz % 64) / 2; }
__host__ __device__ __forceinline__ int perm32(int rho) { const int n = rho >> 4, i = rho & 15; return 8 * (i >> 2) + 4 * n + (i & 3); }

struct Unit { int pm, pn, ko, ks; };
struct Gemm { const bf16_t* A; const bf16_t* Bt; int M, N, K, lda, ldb; };

struct StaticOrder {
    int nM, nN, nwg, G, c;
    __host__ __device__ void init(int M, int N, int G_, int c_) { nM = M / BM; nN = N / BM; nwg = nM * nN; G = G_; c = c_; }
    __host__ __device__ bool next(int i, Unit& u) const {
        const long L = (long)i * G + c; if (L >= nwg) return false;
        int wgid = (int)L; { const int q = nwg / NXCD, r = nwg % NXCD, xcd = wgid % NXCD, off = wgid / NXCD; wgid = (xcd < r ? xcd * (q + 1) : r * (q + 1) + (xcd - r) * q) + off; }
        const int nig = WGM * nN, gid = wgid / nig, fm = gid * WGM, gsz = (nM - fm) < WGM ? (nM - fm) : WGM;
        u.pm = fm + ((wgid % nig) % gsz); u.pn = (wgid % nig) / gsz; u.ko = 0; u.ks = 0; return true;
    }
    __device__ __forceinline__ void a_ready(const Unit&) const {}
    __device__ __forceinline__ void done(const Unit&) const {}
};
struct SplitOrder {
    int nN, nitems, kslice, c;
    __host__ __device__ void init(int M, int N, int Kslice, int c_) { nN = N / BM; nitems = (M / BM) * nN * 8; kslice = Kslice; c = c_; }
    __host__ __device__ bool next(int i, Unit& u) const { if (i > 0 || c >= nitems) return false; u.ks = c & 7; u.ko = u.ks * kslice; u.pn = (c >> 3) % nN; u.pm = (c >> 3) / nN; return true; }
    __device__ __forceinline__ void a_ready(const Unit&) const {}
    __device__ __forceinline__ void done(const Unit&) const {}
};

__device__ __forceinline__ unsigned cvt_pk_bf16(float lo, float hi) { unsigned r; asm volatile("v_cvt_pk_bf16_f32 %0, %1, %2" : "=v"(r) : "v"(lo), "v"(hi)); return r; }

struct EpiF32 {
    static constexpr bool PERM = false, AFTER_DRAIN = false;
    float* C; int ldc; size_t split_stride;
    __device__ __forceinline__ void operator()(const f32x4 (&acc)[2][2][4][2], const Unit& u, int wr, int wc, int fr, int fq) const {
        const int row0 = u.pm * BM + wr * 64 + fr, col0 = u.pn * BM + wc * 32 + 4 * fq; float* Cb = C + (size_t)u.ks * split_stride;
#pragma unroll
        for (int ai = 0; ai < 2; ++ai)
#pragma unroll
            for (int m = 0; m < 4; ++m) { float* rowp = Cb + (size_t)(row0 + ai * HALF + m * 16) * ldc + col0;
#pragma unroll
                for (int bj = 0; bj < 2; ++bj)
#pragma unroll
                    for (int n = 0; n < 2; ++n) *(f32x4*)(rowp + bj * HALF + n * 16) = acc[ai][bj][m][n]; }
    }
};
template <int ACT> struct EpiBf16 {
    static constexpr bool PERM = true, AFTER_DRAIN = false;
    bf16_t* O; int ldc; const float* rowscale;
    __device__ __forceinline__ void operator()(const f32x4 (&acc)[2][2][4][2], const Unit& u, int wr, int wc, int fr, int fq) const {
        const int row0 = u.pm * BM + wr * 64 + fr; const int col0 = u.pn * BM + wc * 32 + 8 * fq;
#pragma unroll
        for (int ai = 0; ai < 2; ++ai)
#pragma unroll
            for (int m = 0; m < 4; ++m) { const int row = row0 + ai * HALF + m * 16; bf16_t* rowp = O + (size_t)row * ldc + col0;
                float rs = 1.f; if (ACT == 2) rs = rowscale[row];
#pragma unroll
                for (int bj = 0; bj < 2; ++bj) { f32x4 v0 = acc[ai][bj][m][0], v1 = acc[ai][bj][m][1];
                    if (ACT == 1) {
#pragma unroll
                        for (int j = 0; j < 4; ++j) { const float a = fmaxf(v0[j], 0.f), b = fmaxf(v1[j], 0.f); v0[j] = a * a; v1[j] = b * b; } }
                    if (ACT == 2) { v0 = v0 * rs; v1 = v1 * rs; }
                    if (ACT == 3) { const u32x4 o = *(const u32x4*)(rowp + bj * HALF);
                        v0[0] += __builtin_bit_cast(float, o.x << 16); v0[1] += __builtin_bit_cast(float, o.x & 0xffff0000u); v0[2] += __builtin_bit_cast(float, o.y << 16); v0[3] += __builtin_bit_cast(float, o.y & 0xffff0000u);
                        v1[0] += __builtin_bit_cast(float, o.z << 16); v1[1] += __builtin_bit_cast(float, o.z & 0xffff0000u); v1[2] += __builtin_bit_cast(float, o.w << 16); v1[3] += __builtin_bit_cast(float, o.w & 0xffff0000u); }
                    u32x4 w; w.x = cvt_pk_bf16(v0[0], v0[1]); w.y = cvt_pk_bf16(v0[2], v0[3]); w.z = cvt_pk_bf16(v1[0], v1[1]); w.w = cvt_pk_bf16(v1[2], v1[3]);
                    *(u32x4*)(rowp + bj * HALF) = w; } }
    }
};

template <class Epi, class Sched, bool ALIGN_EPI = false, bool SP2 = false>
__device__ __forceinline__ void gemm_phase(PG8_LAS unsigned char* lds, const Gemm g, const Sched& S, const Epi& E) {
    int tid = threadIdx.x; asm volatile("" : "+v"(tid));
    const int wid = __builtin_amdgcn_readfirstlane(tid >> 6), lane = tid & 63, wr = wid >> 2, wc = wid & 3, fr = lane & 15, fq = lane >> 4;
    const int K = g.K, nt = K / BK, lda = g.lda, ldb = g.ldb;
    unsigned voffA[2], voffB[2];
#pragma unroll
    for (int i = 0; i < 2; ++i) { int R, C; stage_rc(tid * 16 + i * 8192, R, C); const int Rb = Epi::PERM ? ((R & ~31) + perm32(R & 31)) : R;
        voffA[i] = (unsigned)(R * lda + C) * 2u; voffB[i] = (unsigned)(Rb * ldb + C) * 2u; }
    const size_t kstep = (size_t)(BK * 2);
    const size_t hstepA = (size_t)HALF * lda * 2, hstepB = (size_t)HALF * ldb * 2;
    const size_t tstepA = 2 * hstepA, tstepB = 2 * hstepB;
    const unsigned ldsw = (unsigned)wid * 1024u;
    const int aoff = lds_byte(wr * 64 + fr, fq * 8), boff = lds_byte(wc * 32 + fr, fq * 8);
#define PG8_SA(b, h) (((b) * 2 + (h)) * HTB)
#define PG8_SB(b, h) ((4 + (b) * 2 + (h)) * HTB)
#define PG8_STAGE(bufoff, gbase, voff) do { _Pragma("unroll") for (int _i = 0; _i < 2; ++_i) \
        __builtin_amdgcn_global_load_lds((const unsigned*)((const char*)(gbase) + (voff)[_i]), (PG8_LAS unsigned*)(lds + (bufoff) + ldsw + _i * 8192), 16, 0, 0); } while (0)
#define PG8_LDA(dst, b, h) do { _Pragma("unroll") for (int m = 0; m < 4; ++m) _Pragma("unroll") for (int k = 0; k < 2; ++k) dst[m][k] = *(const PG8_LAS bf16x8*)(lds + PG8_SA(b, h) + aoff + m * 2048 + k * 1024); } while (0)
#define PG8_LDB(dst, b, h) do { _Pragma("unroll") for (int n = 0; n < 2; ++n) _Pragma("unroll") for (int k = 0; k < 2; ++k) dst[n][k] = *(const PG8_LAS bf16x8*)(lds + PG8_SB(b, h) + boff + n * 2048 + k * 1024); } while (0)
#define PG8_MMA(ai, bj, At, Bt) do { __builtin_amdgcn_s_setprio(1); _Pragma("unroll") for (int m = 0; m < 4; ++m) _Pragma("unroll") for (int n = 0; n < 2; ++n) _Pragma("unroll") for (int k = 0; k < 2; ++k) \
        acc[ai][bj][m][n] = __builtin_amdgcn_mfma_f32_16x16x32_bf16(Bt[n][k], At[m][k], acc[ai][bj][m][n], 0, 0, 0); __builtin_amdgcn_s_setprio(0); } while (0)
#define PG8_WAIT_V(n) asm volatile("s_waitcnt vmcnt(" #n ")" ::: "memory")
#define PG8_WAIT_L(n) asm volatile("s_waitcnt lgkmcnt(" #n ")" ::: "memory")
#define PG8_BAR __builtin_amdgcn_s_barrier()
#define PG8_SCHED __builtin_amdgcn_sched_barrier(0)
    Unit cur, nxt; int ui = 0;
    if (!S.next(0, cur)) return;
    f32x4 acc[2][2][4][2];
#pragma unroll
    for (int a = 0; a < 2; ++a)
#pragma unroll
        for (int b = 0; b < 2; ++b)
#pragma unroll
            for (int m = 0; m < 4; ++m)
#pragma unroll
                for (int n = 0; n < 2; ++n) acc[a][b][m][n] = (f32x4){0.f, 0.f, 0.f, 0.f};
    bf16x8 At[4][2], B0[2][2], B1[2][2];
    const char* cA = (const char*)g.A + (size_t)cur.pm * tstepA + (size_t)cur.ko * 2; const char* cB = (const char*)g.Bt + (size_t)cur.pn * tstepB + (size_t)cur.ko * 2;
    S.a_ready(cur);
    if constexpr (SP2) {
        PG8_STAGE(PG8_SB(0, 0), cB, voffB); PG8_STAGE(PG8_SB(0, 1), cB + hstepB, voffB); PG8_STAGE(PG8_SA(0, 0), cA, voffA); PG8_STAGE(PG8_SA(0, 1), cA + hstepA, voffA);
        if (wr == 1) PG8_BAR;
        PG8_WAIT_V(2); PG8_BAR;
        PG8_STAGE(PG8_SB(1, 0), cB + kstep, voffB); PG8_STAGE(PG8_SA(1, 0), cA + kstep, voffA); PG8_STAGE(PG8_SB(1, 1), cB + hstepB + kstep, voffB);
        PG8_WAIT_V(6); PG8_BAR;
    } else {
        PG8_STAGE(PG8_SB(0, 0), cB, voffB); PG8_STAGE(PG8_SA(0, 0), cA, voffA); PG8_STAGE(PG8_SB(0, 1), cB + hstepB, voffB); PG8_STAGE(PG8_SA(0, 1), cA + hstepA, voffA);
        if (wr == 1) PG8_BAR;
        PG8_WAIT_V(4); PG8_BAR;
        PG8_STAGE(PG8_SB(1, 0), cB + kstep, voffB); PG8_STAGE(PG8_SA(1, 0), cA + kstep, voffA); PG8_STAGE(PG8_SB(1, 1), cB + hstepB + kstep, voffB);
        PG8_WAIT_V(6); PG8_BAR;
    }
    for (;;) {
        const bool has_next = S.next(ui + 1, nxt);
        const char* nA = has_next ? (const char*)g.A + (size_t)nxt.pm * tstepA + (size_t)nxt.ko * 2 : cA; const char* nB = has_next ? (const char*)g.Bt + (size_t)nxt.pn * tstepB + (size_t)nxt.ko * 2 : cB;
        for (int t = 0; t < nt; t += 2) {
            const bool last = (t == nt - 2);
            const char* a1 = cA + (size_t)(t + 1) * kstep;
            const char* a2 = last ? nA : cA + (size_t)(t + 2) * kstep; const char* b2 = last ? nB : cB + (size_t)(t + 2) * kstep;
            const char* a3 = a2 + kstep; const char* b3 = b2 + kstep;
            if (last && has_next) S.a_ready(nxt);
            if constexpr (SP2) {
            PG8_LDB(B0, 0, 0); PG8_LDB(B1, 0, 1); PG8_SCHED; PG8_LDA(At, 0, 0); PG8_STAGE(PG8_SA(1, 1), a1 + hstepA, voffA);
            PG8_WAIT_V(8); PG8_WAIT_L(0); PG8_BAR; PG8_MMA(0, 0, At, B0); PG8_MMA(0, 1, At, B1); PG8_BAR; PG8_SCHED;
            PG8_LDA(At, 0, 1); PG8_STAGE(PG8_SB(0, 0), b2, voffB); PG8_STAGE(PG8_SB(0, 1), b2 + hstepB, voffB); PG8_STAGE(PG8_SA(0, 0), a2, voffA);
            PG8_WAIT_V(8); PG8_WAIT_L(0); PG8_BAR; PG8_MMA(1, 0, At, B0); PG8_MMA(1, 1, At, B1); PG8_BAR; PG8_SCHED;
            PG8_LDB(B0, 1, 0); PG8_LDB(B1, 1, 1); PG8_SCHED; PG8_LDA(At, 1, 0); PG8_STAGE(PG8_SA(0, 1), a2 + hstepA, voffA);
            PG8_WAIT_V(8); PG8_WAIT_L(0); PG8_BAR; PG8_MMA(0, 0, At, B0); PG8_MMA(0, 1, At, B1); PG8_BAR; PG8_SCHED;
            PG8_LDA(At, 1, 1); PG8_STAGE(PG8_SB(1, 0), b3, voffB); PG8_STAGE(PG8_SB(1, 1), b3 + hstepB, voffB); PG8_STAGE(PG8_SA(1, 0), a3, voffA);
            PG8_WAIT_V(8); PG8_WAIT_L(0); PG8_BAR; PG8_MMA(1, 0, At, B0); PG8_MMA(1, 1, At, B1); PG8_BAR; PG8_SCHED;
            } else {
            PG8_LDB(B0, 0, 0); PG8_SCHED; PG8_LDA(At, 0, 0); PG8_STAGE(PG8_SA(1, 1), a1 + hstepA, voffA);
            PG8_WAIT_L(8); PG8_BAR; PG8_WAIT_L(0); PG8_MMA(0, 0, At, B0); PG8_BAR; PG8_SCHED;
            PG8_LDB(B1, 0, 1); PG8_STAGE(PG8_SB(0, 0), b2, voffB);
            PG8_BAR; PG8_WAIT_L(0); PG8_MMA(0, 1, At, B1); PG8_BAR;
            PG8_LDA(At, 0, 1); PG8_STAGE(PG8_SA(0, 0), a2, voffA);
            PG8_BAR; PG8_WAIT_L(0); PG8_MMA(1, 0, At, B0); PG8_BAR; PG8_SCHED;
            PG8_STAGE(PG8_SB(0, 1), b2 + hstepB, voffB);
            PG8_WAIT_V(6); PG8_BAR; PG8_MMA(1, 1, At, B1); PG8_BAR;
            PG8_LDB(B0, 1, 0); PG8_SCHED; PG8_LDA(At, 1, 0); PG8_STAGE(PG8_SA(0, 1), a2 + hstepA, voffA);
            PG8_WAIT_L(8); PG8_BAR; PG8_WAIT_L(0); PG8_MMA(0, 0, At, B0); PG8_BAR; PG8_SCHED;
            PG8_LDB(B1, 1, 1); PG8_STAGE(PG8_SB(1, 0), b3, voffB);
            PG8_BAR; PG8_WAIT_L(0); PG8_MMA(0, 1, At, B1); PG8_BAR;
            PG8_LDA(At, 1, 1); PG8_STAGE(PG8_SA(1, 0), a3, voffA);
            PG8_BAR; PG8_WAIT_L(0); PG8_MMA(1, 0, At, B0); PG8_BAR; PG8_SCHED;
            PG8_STAGE(PG8_SB(1, 1), b3 + hstepB, voffB);
            PG8_WAIT_V(6); PG8_BAR; PG8_MMA(1, 1, At, B1); PG8_BAR;
            }
        }
        if constexpr (ALIGN_EPI) { if (wr == 0) PG8_BAR; }
        E(acc, cur, wr, wc, fr, fq); S.done(cur);
        if (!has_next) break;
#pragma unroll
        for (int a = 0; a < 2; ++a)
#pragma unroll
            for (int b = 0; b < 2; ++b)
#pragma unroll
                for (int m = 0; m < 4; ++m)
#pragma unroll
                    for (int n = 0; n < 2; ++n) acc[a][b][m][n] = (f32x4){0.f, 0.f, 0.f, 0.f};
        cur = nxt; cA = nA; cB = nB; ++ui;
        if constexpr (ALIGN_EPI) { if (wr == 1) PG8_BAR; }
    }
    PG8_WAIT_V(0);
    if constexpr (!ALIGN_EPI) { if (wr == 0) PG8_BAR; }
    PG8_BAR;
#undef PG8_SA
#undef PG8_SB
#undef PG8_STAGE
#undef PG8_LDA
#undef PG8_LDB
#undef PG8_MMA
#undef PG8_WAIT_V
#undef PG8_WAIT_L
#undef PG8_BAR
#undef PG8_SCHED
}
}

constexpr int NWAVES = 8, NTHR = 512;
constexpr int DM = 4096, NB = 2, SEQ = 8192, NCTX = 256, DFF = 16384;
constexpr int M_LAT = NB * SEQ, M_CTX = NB * NCTX, M_TOT = M_LAT + M_CTX;
constexpr int DIN = 8672, DINP = 8704;
constexpr int C_SWAQ = 0, C_SWAK = 1024, C_SWAV = 1280, C_LRUX = 1536, C_LRUY = 2560, C_QA = 3584, C_KVA = 4608, C_KR = 5120, C_RW = 5184;
constexpr int C_RWR = C_RW, C_RWK = C_RW + 1024, C_RWV = C_RW + 2048, C_RWL = C_RW + 3072;
constexpr int RWC = 3488;
constexpr float LN_EPS = 1e-5f, RMS_EPS = 1e-6f, GN_EPS = 64e-5f, ALPHA = 1.41421356237f;
constexpr int NCH = 264;

constexpr size_t MiB = 1u << 20;
constexpr size_t WS_CTL = 0, CTL_ZERO_BYTES = 1 * MiB;
constexpr size_t WS_MOD = 1 * MiB;
constexpr size_t WS_MODP = 2 * MiB;
constexpr size_t WS_SMALL = 20 * MiB;
constexpr size_t WS_RSQ = WS_SMALL;
constexpr size_t WS_RSKV = WS_RSQ + 128 * 1024;
constexpr size_t WS_SB = WS_RSKV + 128 * 1024;
constexpr size_t WS_CA = WS_SB + 2 * MiB;
constexpr size_t WS_CB = WS_CA + 5 * MiB;
constexpr size_t WS_HIN = WS_CB + 5 * MiB;
constexpr size_t WS_QUIRK = WS_HIN + 5 * MiB;
constexpr size_t WS_ROPE = WS_QUIRK + 8192;
static_assert(WS_ROPE + 16384 <= 40 * MiB, "small region");
constexpr size_t WS_W = 40 * MiB;
constexpr size_t WS_WIN = WS_W, WS_WOUT = WS_WIN + 68 * MiB, WS_WFF1 = WS_WOUT + 32 * MiB, WS_WFF2 = WS_WFF1 + 128 * MiB, WS_WQB = WS_WFF2 + 128 * MiB,
                 WS_WKVB = WS_WQB + 3 * MiB, WS_WLRU = WS_WKVB + 2 * MiB, WS_WLORA = WS_WLRU + 1 * MiB;
constexpr size_t WS_W2T = WS_WLORA, WS_A2T = WS_W2T + 256 * 1024, WS_G2T = WS_A2T + 256 * 1024;
constexpr size_t WS_X = 403 * MiB;
constexpr size_t WS_H = 667 * MiB;
constexpr size_t WS_MIX = 799 * MiB;
constexpr size_t WS_YS = 931 * MiB;
constexpr size_t WS_P = 1063 * MiB;
constexpr size_t WS_RWF = 1344 * MiB;
constexpr size_t RWF_STRIDE = (size_t)M_TOT * 1024 * 2;
constexpr size_t WS_Q = 1641 * MiB;
constexpr size_t WS_KV = 1691 * MiB;
constexpr size_t WS_KR = 1757 * MiB;
constexpr size_t WS_SET2 = 1760 * MiB;
constexpr size_t WSET_STRIDE = WS_SET2 - WS_W;
constexpr size_t WS_END = WS_SET2 + 363 * MiB;
constexpr size_t WS_YP = WS_Q;
constexpr size_t WS_HID = WS_P;
constexpr size_t WS_Y1 = WS_P;
constexpr size_t WS_Y2 = WS_MIX;
static_assert(WS_WLORA + 1 * MiB <= WS_X && WS_P + (size_t)M_TOT * DINP * 2 <= WS_RWF && WS_RWF + 9 * RWF_STRIDE <= WS_Q, "ws map");
static_assert(WS_HID + (size_t)M_TOT * DFF * 2 <= WS_Q && WS_Y2 + (size_t)M_TOT * DM * 4 <= WS_P && WS_YS + 2 * (size_t)M_TOT * 1024 * 4 <= WS_P, "ws overlays");
static_assert(WS_KR + (size_t)M_TOT * 64 * 2 <= WS_SET2 && WS_YP + 8 * (size_t)M_CTX * DM * 4 <= WS_KR, "ws end");

constexpr int RING_BYTES = 131072;
constexpr int LDSCTL_OFF = RING_BYTES, MISC_OFF = LDSCTL_OFF + 320;
constexpr int LDS_BYTES = 147456;

#define GAS __attribute__((address_space(1)))
#define LAS __attribute__((address_space(3)))
typedef unsigned short bf16;
typedef unsigned v4u __attribute__((ext_vector_type(4)));
typedef unsigned v2u __attribute__((ext_vector_type(2)));
typedef float f32x4 __attribute__((ext_vector_type(4)));
typedef _Float16 h16x4 __attribute__((ext_vector_type(4)));
#ifndef XH16_
#define XH16_ 0
#endif
constexpr bool XH16 = XH16_;
#if XH16_
typedef _Float16 xres_t;
#else
typedef float xres_t;
#endif
typedef float f32x2 __attribute__((ext_vector_type(2)));
typedef float f32x16 __attribute__((ext_vector_type(16)));
typedef short bf16x8 __attribute__((ext_vector_type(8)));
typedef short s16x4 __attribute__((ext_vector_type(4)));
typedef GAS unsigned gu32;
typedef const GAS bf16* gcbf; typedef GAS bf16* gbfp; typedef const GAS float* gcfl; typedef GAS float* gflp;
#define LDS_WAIT() asm volatile("s_waitcnt lgkmcnt(0)" ::: "memory")
#define VM_WAIT() asm volatile("s_waitcnt vmcnt(0)" ::: "memory")
typedef __bf16 bf16x2_t __attribute__((ext_vector_type(2)));
__device__ __forceinline__ unsigned pk2(float lo, float hi) { const f32x2 v = {lo, hi}; const bf16x2_t b = __builtin_convertvector(v, bf16x2_t); return __builtin_bit_cast(unsigned, b); }
__device__ __forceinline__ unsigned f2bf(float f) { return pk2(f, f) & 0xffffu; }
__device__ __forceinline__ float bflo(unsigned w) { return __builtin_bit_cast(float, w << 16); }
__device__ __forceinline__ float bfhi(unsigned w) { return __builtin_bit_cast(float, w & 0xffff0000u); }
__device__ __forceinline__ float bf2f(bf16 h) { return __builtin_bit_cast(float, (unsigned)h << 16); }
#define DPP_ADD(x, ctrl) ((x) + __builtin_bit_cast(float, __builtin_amdgcn_update_dpp(0, __builtin_bit_cast(int, (x)), (ctrl), 0xf, 0xf, false)))
__device__ __forceinline__ float row_sum16(float x) { x = DPP_ADD(x, 0x128); x = DPP_ADD(x, 0x124); x = DPP_ADD(x, 0x122); x = DPP_ADD(x, 0x121); return x; }
#ifdef OLD_SUMS
__device__ __forceinline__ float wave_sum(float v) {
#pragma unroll
    for (int o = 1; o < 64; o <<= 1) v += __shfl_xor(v, o);
    return v;
}
__device__ __forceinline__ float half_swap_sum(float x) { return x + __shfl_xor(x, 32); }
__device__ __forceinline__ float quad_sum(float x) { x += __shfl_xor(x, 1); x += __shfl_xor(x, 2); return x; }
#else
__device__ __forceinline__ float wave_sum(float v) {
    const float r = row_sum16(v);
    const float a = __builtin_bit_cast(float, __builtin_amdgcn_readlane(__builtin_bit_cast(int, r), 0)), b = __builtin_bit_cast(float, __builtin_amdgcn_readlane(__builtin_bit_cast(int, r), 16));
    const float c = __builtin_bit_cast(float, __builtin_amdgcn_readlane(__builtin_bit_cast(int, r), 32)), d = __builtin_bit_cast(float, __builtin_amdgcn_readlane(__builtin_bit_cast(int, r), 48));
    return (a + b) + (c + d);
}
__device__ __forceinline__ float half_swap_sum(float x) {
    unsigned a = __builtin_bit_cast(unsigned, x), b = a; asm volatile("" : "+v"(b));
    auto rr = __builtin_amdgcn_permlane32_swap(a, b, false, false);
    const float lo = __uint_as_float(rr[0]), hi = __uint_as_float(rr[1]); return lo + hi;
}
__device__ __forceinline__ float quad_sum(float x) { x = DPP_ADD(x, 0xB1); x = DPP_ADD(x, 0x4E); return x; }
#endif
__device__ __forceinline__ float sigmoidf_(float x) { return __builtin_amdgcn_rcpf(1.f + __expf(-x)); }
__device__ __forceinline__ float softplusf_(float x) { return x > 20.f ? x : __logf(1.f + __expf(x)); }
__device__ __forceinline__ float tanhf_(float x) { const float e = __expf(2.f * x); return 1.f - 2.f * __builtin_amdgcn_rcpf(e + 1.f); }
__device__ __forceinline__ int ltid() { int t = threadIdx.x; asm volatile("" : "+v"(t)); return t; }
template <class T> __device__ __forceinline__ T ldg(const void* base, unsigned byteoff) { return *(const T*)((const char*)base + byteoff); }
template <class T> __device__ __forceinline__ void stg(void* base, unsigned byteoff, T v) { *(T*)((char*)base + byteoff) = v; }

#define XB_TMO      128
#define XB_XCNT(j)  (256  + 64 * (j))
#define XB_XSUB(j)  (1280 + 64 * (j))
#define XB_XGEN(j)  (2304 + 64 * (j))
#define XB_TOP      3328
#define XB_TOPGEN   3392
#define XCD_BAR_WORDS 3456
#define XB_SPIN_CAP (1u << 18)

__device__ __forceinline__ unsigned xb_ld(unsigned* p)              { return __hip_atomic_load(p, __ATOMIC_RELAXED, __HIP_MEMORY_SCOPE_AGENT); }
__device__ __forceinline__ unsigned xb_add(unsigned* p, unsigned v) { return __hip_atomic_fetch_add(p, v, __ATOMIC_RELAXED, __HIP_MEMORY_SCOPE_AGENT); }
__device__ __forceinline__ unsigned xb_xcc_id() { return (unsigned)__builtin_amdgcn_s_getreg((3 << 11) | 20) & 0xFu; }
#define XB_SPIN(cond, bar) do { unsigned _sp = 0; while (cond) { __builtin_amdgcn_s_sleep(1); \
    if ((++_sp & 255u) == 0u) { if (xb_ld(&(bar)[XB_TMO])) break; if (_sp > XB_SPIN_CAP) { atomicAdd(&(bar)[XB_TMO], 1u); break; } } } } while (0)

struct XcdBarrier {
    unsigned* bar; unsigned x;
    unsigned nparts;
    volatile LAS unsigned* st;
};

__device__ __forceinline__ XcdBarrier xcd_barrier_post(unsigned* bar, volatile LAS unsigned* st) {
    XcdBarrier b; b.bar = bar; b.x = xb_xcc_id(); b.st = st; b.nparts = 0u;
    if (threadIdx.x == 0) (void)xb_add(&bar[XB_XCNT(b.x)], 1u);
    return b;
}
__device__ __forceinline__ void xcd_barrier_complete(unsigned* bar, unsigned x, unsigned& nloc, unsigned& nx, unsigned nparts) {
    const unsigned G = nparts ? nparts : gridDim.x * gridDim.y * gridDim.z;
    unsigned sum, cnt, mine, sp = 0u;
    for (;;) {
        sum = 0u; cnt = 0u; mine = 0u;
#pragma unroll
        for (unsigned j = 0; j < 16; ++j) { const unsigned c = xb_ld(&bar[XB_XCNT(j)]); sum += c; cnt += (c > 0u) ? 1u : 0u; mine = (j == x) ? c : mine; }
        if (sum == G) break;
        __builtin_amdgcn_s_sleep(1);
        if ((++sp & 255u) == 0u) { if (xb_ld(&bar[XB_TMO])) break; if (sp > XB_SPIN_CAP) { atomicAdd(&bar[XB_TMO], 1u); break; } }
    }
    nloc = mine > 0u ? mine : 1u; nx = cnt > 0u ? cnt : 1u;
}

__device__ __forceinline__ void xcd_barrier(const XcdBarrier& b) {
    asm volatile("s_waitcnt vmcnt(0)" ::: "memory");
    __syncthreads();
    if (threadIdx.x == 0) {
        unsigned* bar = b.bar;
        __builtin_amdgcn_s_waitcnt(0);
        unsigned nloc = b.st[0], nx = b.st[1];
        if (nloc == 0u) { xcd_barrier_complete(bar, b.x, nloc, nx, b.nparts); b.st[0] = nloc; b.st[1] = nx; }
        const unsigned old = xb_add(&bar[XB_XSUB(b.x)], 1u);
        const unsigned gen = old / nloc;
        if (old + 1u == (gen + 1u) * nloc) {
            __builtin_amdgcn_fence(__ATOMIC_RELEASE, "agent");
            asm volatile("s_waitcnt vmcnt(0)" ::: "memory");
            const unsigned og = xb_add(&bar[XB_TOP], 1u);
            const unsigned tg = og / nx;
            if (og + 1u == (tg + 1u) * nx) xb_add(&bar[XB_TOPGEN], 1u);
            else XB_SPIN(xb_ld(&bar[XB_TOPGEN]) == tg, bar);
            __builtin_amdgcn_fence(__ATOMIC_ACQUIRE, "agent");
            xb_add(&bar[XB_XGEN(b.x)], 1u);
            asm volatile("s_waitcnt vmcnt(0)" ::: "memory");
        } else {
            XB_SPIN(xb_ld(&bar[XB_XGEN(b.x)]) == gen, bar);
            __builtin_amdgcn_fence(__ATOMIC_ACQUIRE, "agent");
            asm volatile("s_waitcnt vmcnt(0)" ::: "memory");
        }
    }
    __syncthreads();
}


namespace att {
constexpr int KVBLK = 64;
constexpr float THR = 8.f;
#define SBAR() __builtin_amdgcn_sched_barrier(0)
__device__ __forceinline__ int crow(int r, int hi) { return (r & 3) + 8 * (r >> 2) + 4 * hi; }
__device__ __forceinline__ unsigned cvtpk(float lo, float hi) { return pk2(lo, hi); }
template <int DQK> __device__ __forceinline__ int kswz(int row, int cb) { return row * (DQK * 2 + 16) + cb; }

template <int DQK> __device__ __forceinline__ void partialSM(f32x16& p0, f32x16& p1, float& m_reg, float& mn, float& alpha) {
  constexpr float SCALE = DQK == 128 ? 0.088388347648318440f : 0.072168783648703220f;
  constexpr float C = SCALE * 1.4426950408889634f;
  float pmax = p0[0];
#pragma unroll
  for (int r = 1; r < 16; ++r) pmax = fmaxf(pmax, p0[r]);
#pragma unroll
  for (int r = 0; r < 16; ++r) pmax = fmaxf(pmax, p1[r]);
  { auto rr = __builtin_amdgcn_permlane32_swap(__float_as_uint(pmax), __float_as_uint(pmax), false, false);
    pmax = fmaxf(__uint_as_float(rr[0]), __uint_as_float(rr[1])); }
  if (__builtin_expect(__all(pmax - m_reg <= THR / SCALE), 1)) { mn = m_reg; alpha = 1.f; }
  else { mn = fmaxf(m_reg, pmax); alpha = __builtin_amdgcn_exp2f((m_reg - mn) * C); m_reg = mn; }
  const float mnC = -mn * C;
#pragma unroll
  for (int r = 0; r < 16; ++r) p0[r] = fmaf(p0[r], C, mnC);
#pragma unroll
  for (int r = 0; r < 16; ++r) p1[r] = fmaf(p1[r], C, mnC);
#pragma unroll
  for (int r = 0; r < 16; ++r) p0[r] = __builtin_amdgcn_exp2f(p0[r]);
}
__device__ __forceinline__ void finishSM(f32x16& p0, f32x16& p1, float alpha, float& l_reg, bf16x8& pa0, bf16x8& pa1, bf16x8& pa2, bf16x8& pa3) {
#pragma unroll
  for (int r = 0; r < 16; ++r) p1[r] = __builtin_amdgcn_exp2f(p1[r]);
  float ps = 0;
#pragma unroll
  for (int r = 0; r < 16; ++r) ps += p0[r];
#pragma unroll
  for (int r = 0; r < 16; ++r) ps += p1[r];
  { auto rr = __builtin_amdgcn_permlane32_swap(__float_as_uint(ps), __float_as_uint(ps), false, false);
    ps = __uint_as_float(rr[0]) + __uint_as_float(rr[1]); }
  l_reg = l_reg * alpha + ps;
#define PK4(P, BASE, OUT) do { unsigned a0 = cvtpk(P[BASE + 0], P[BASE + 1]), a1 = cvtpk(P[BASE + 2], P[BASE + 3]);   \
    unsigned b0 = cvtpk(P[BASE + 4], P[BASE + 5]), b1 = cvtpk(P[BASE + 6], P[BASE + 7]);                              \
    auto r0 = __builtin_amdgcn_permlane32_swap(a0, b0, false, false); auto r1 = __builtin_amdgcn_permlane32_swap(a1, b1, false, false); \
    v4u w = {r0[0], r1[0], r0[1], r1[1]}; OUT = __builtin_bit_cast(bf16x8, w); } while (0)
  PK4(p0, 0, pa0); PK4(p0, 8, pa1); PK4(p1, 0, pa2); PK4(p1, 8, pa3);
#undef PK4
}
template <int DQK> __device__ __forceinline__ void qkt(f32x16& p0, f32x16& p1, const LAS char* Ks, const bf16x8* qr, const LAS char* qx, int r32, int hi) {
  p0 = f32x16{}; p1 = f32x16{};
#pragma unroll
  for (int d0 = 0; d0 < DQK / 16; ++d0) { const int cb = (d0 * 16 + hi * 8) * 2;
    bf16x8 b0 = *(const LAS bf16x8*)(Ks + kswz<DQK>(r32, cb));
    bf16x8 b1 = *(const LAS bf16x8*)(Ks + kswz<DQK>(32 + r32, cb));
    bf16x8 q; if (d0 < 8) q = qr[d0]; else q = *(const LAS bf16x8*)(qx + (d0 - 8) * 32);
    p0 = __builtin_amdgcn_mfma_f32_32x32x16_bf16(b0, q, p0, 0, 0, 0);
    p1 = __builtin_amdgcn_mfma_f32_32x32x16_bf16(b1, q, p1, 0, 0, 0);
    if ((d0 & 3) == 3 && d0 + 1 < DQK / 16) SBAR(); }
}
__device__ __forceinline__ int v_st(int k, int c) { const int kk = (k & ~0xC) | ((k & 4) << 1) | ((k & 8) >> 1); return ((kk >> 3) * 4 + (c >> 5)) * 512 + ((kk & 7) * 32 + (c & 31)) * 2; }
__device__ __forceinline__ int v_rd_base(int lane) { return ((lane & 3) << 3) | (((lane >> 2) & 3) << 6) | (((lane >> 4) & 1) << 5) | (((lane >> 5) & 1) << 8); }
constexpr int v_rd_off(int d0, int ks, int half) { return d0 * 512 + ks * 4096 + half * 2048; }
template <int OFF> __device__ __forceinline__ s16x4 tr_read(int vb) {
  s16x4 r; asm volatile("ds_read_b64_tr_b16 %0, %1 offset:%2" : "=&v"(r) : "v"(vb), "i"(OFF) : "memory"); return r;
}
template <int D0> __device__ __forceinline__ void pv_one(f32x16& od, int vb, bf16x8 pa0, bf16x8 pa1, bf16x8 pa2, bf16x8 pa3) {
  const s16x4 l0 = tr_read<v_rd_off(D0, 0, 0)>(vb), h0 = tr_read<v_rd_off(D0, 0, 1)>(vb), l1 = tr_read<v_rd_off(D0, 1, 0)>(vb), h1 = tr_read<v_rd_off(D0, 1, 1)>(vb);
  const s16x4 l2 = tr_read<v_rd_off(D0, 2, 0)>(vb), h2 = tr_read<v_rd_off(D0, 2, 1)>(vb), l3 = tr_read<v_rd_off(D0, 3, 0)>(vb), h3 = tr_read<v_rd_off(D0, 3, 1)>(vb);
  asm volatile("s_waitcnt lgkmcnt(0)" ::: "memory"); SBAR();
#define PK(L, H) (bf16x8){L[0], L[1], L[2], L[3], H[0], H[1], H[2], H[3]}
  od = __builtin_amdgcn_mfma_f32_32x32x16_bf16(pa0, PK(l0, h0), od, 0, 0, 0);
  od = __builtin_amdgcn_mfma_f32_32x32x16_bf16(pa1, PK(l1, h1), od, 0, 0, 0);
  od = __builtin_amdgcn_mfma_f32_32x32x16_bf16(pa2, PK(l2, h2), od, 0, 0, 0);
  od = __builtin_amdgcn_mfma_f32_32x32x16_bf16(pa3, PK(l3, h3), od, 0, 0, 0);
#undef PK
}
__device__ __forceinline__ void pv_d0(f32x16* o, int vb, bf16x8 pa0, bf16x8 pa1, bf16x8 pa2, bf16x8 pa3) {
  pv_one<0>(o[0], vb, pa0, pa1, pa2, pa3); pv_one<1>(o[1], vb, pa0, pa1, pa2, pa3); pv_one<2>(o[2], vb, pa0, pa1, pa2, pa3); pv_one<3>(o[3], vb, pa0, pa1, pa2, pa3);
}
__device__ __forceinline__ void apply_mask(f32x16& p0, f32x16& p1, int mtype, int krel0, int qi, int hi) {
  if (mtype == 0) return;
  const float ninf = -__builtin_inff();
#pragma unroll
  for (int r = 0; r < 16; ++r) { const int k0 = krel0 + crow(r, hi), k1 = k0 + 32;
    const bool ok0 = (mtype == 1) ? (k0 >= qi - 128) : (k0 <= qi + 128), ok1 = (mtype == 1) ? (k1 >= qi - 128) : (k1 <= qi + 128);
    p0[r] = ok0 ? p0[r] : ninf; p1[r] = ok1 ? p1[r] : ninf; }
}
struct Tile { gcbf kn; gcbf kr; gcbf v; int mtype; int krel0; };

__device__ __forceinline__ void rope_pair(bf16x8& a, bf16x8& b, gcfl ct, gcfl st) {
  const f32x4 c0 = *(const GAS f32x4*)ct, c1 = *(const GAS f32x4*)(ct + 4), s0 = *(const GAS f32x4*)st, s1 = *(const GAS f32x4*)(st + 4);
  const float cs[8] = {c0[0], c0[1], c0[2], c0[3], c1[0], c1[1], c1[2], c1[3]}, sn[8] = {s0[0], s0[1], s0[2], s0[3], s1[0], s1[1], s1[2], s1[3]};
  v4u ua = __builtin_bit_cast(v4u, a), ub = __builtin_bit_cast(v4u, b); v4u oa, ob;
#pragma unroll
  for (int w = 0; w < 4; ++w) { const float x1[2] = {bflo(ua[w]), bfhi(ua[w])}, x2[2] = {bflo(ub[w]), bfhi(ub[w])}; float y1[2], y2[2];
#pragma unroll
    for (int e = 0; e < 2; ++e) { const float c = cs[2 * w + e], sv = sn[2 * w + e]; y1[e] = x1[e] * c - x2[e] * sv; y2[e] = x2[e] * c + x1[e] * sv; }
    oa[w] = pk2(y1[0], y1[1]); ob[w] = pk2(y2[0], y2[1]); }
  a = __builtin_bit_cast(bf16x8, oa); b = __builtin_bit_cast(bf16x8, ob);
}

template <int DQK, int LDKN, int LDV, bool MASK, bool SINK, int SDEPTH, class TS>
__device__ __forceinline__ void attn_body(gcbf Qw, int rope, int prow, int pcol, gcfl rtab, int qi, float sink_l2, const TS& ts, int NT, gbfp Ow, LAS char* lds) {
  constexpr float SCALE = DQK == 128 ? 0.088388347648318440f : 0.072168783648703220f;
  constexpr float C = SCALE * 1.4426950408889634f;
  constexpr int SHM_K = KVBLK * (DQK * 2 + 16), SHM_V = KVBLK * 128 * 2;
  int tid = threadIdx.x; asm volatile("" : "+v"(tid));
  const int wid = tid >> 6, lane = tid & 63, r32 = lane & 31, hi = lane >> 5;
  LAS char* V_lds = lds; LAS char* K_lds = lds + 2 * SHM_V;
  LAS float* wsl = (LAS float*)(lds + 2 * SHM_V + 2 * SHM_K) + wid * 64; LAS float* li_l = wsl; LAS float* al_l = wsl + 32;
  float m_reg = -1e30f, l_reg = 0; f32x16 o[4] = {}; bf16x8 qr[8];
#pragma unroll
  for (int d0 = 0; d0 < 8; ++d0) qr[d0] = *(const GAS bf16x8*)(Qw + d0 * 16 + hi * 8);
  const LAS char* qx = lds + 2 * SHM_V + 2 * SHM_K + 2048 + wid * 4608 + r32 * 144 + hi * 16;
  if constexpr (DQK == 192) {
    bf16x8 x0 = *(const GAS bf16x8*)(Qw + 128 + hi * 8), x1 = *(const GAS bf16x8*)(Qw + 144 + hi * 8), x2 = *(const GAS bf16x8*)(Qw + 160 + hi * 8), x3 = *(const GAS bf16x8*)(Qw + 176 + hi * 8);
    if (rope) {
      rope_pair(x0, x1, rtab + (size_t)prow * 16 + hi * 8, rtab + 2048 + (size_t)prow * 16 + hi * 8);
      rope_pair(x2, x3, rtab + (size_t)pcol * 16 + hi * 8, rtab + 2048 + (size_t)pcol * 16 + hi * 8); }
    LAS char* qw_ = (LAS char*)qx; *(LAS bf16x8*)(qw_) = x0; *(LAS bf16x8*)(qw_ + 32) = x1; *(LAS bf16x8*)(qw_ + 64) = x2; *(LAS bf16x8*)(qw_ + 96) = x3;
  }
  const int sr = tid >> 4, sc = (tid & 15) * 8, vst0 = v_st(sr, sc), vst1 = v_st(32 + sr, sc);
  const int rr_ = tid >> 3, rc_ = (tid & 7) * 8;
  const int vb0 = (int)(uintptr_t)V_lds + v_rd_base(lane);
  struct { bf16x8 vs0, vs1, ks0, ks1, kx; } sr_[SDEPTH];
#define SLOAD(i, jt) do { const Tile t_ = ts(jt); sr_[i].vs0 = *(const GAS bf16x8*)(t_.v + (size_t)sr * LDV + sc); sr_[i].vs1 = *(const GAS bf16x8*)(t_.v + (size_t)(32 + sr) * LDV + sc); \
    sr_[i].ks0 = *(const GAS bf16x8*)(t_.kn + (size_t)sr * LDKN + sc); sr_[i].ks1 = *(const GAS bf16x8*)(t_.kn + (size_t)(32 + sr) * LDKN + sc); \
    if constexpr (DQK == 192) sr_[i].kx = *(const GAS bf16x8*)(t_.kr + (size_t)rr_ * 64 + rc_); } while (0)
#define SWRITE(b, i) do { *(LAS bf16x8*)(V_lds + (b) * SHM_V + vst0) = sr_[i].vs0; *(LAS bf16x8*)(V_lds + (b) * SHM_V + vst1) = sr_[i].vs1; const int kc = sc * 2; \
    *(LAS bf16x8*)(K_lds + (b) * SHM_K + kswz<DQK>(sr, kc)) = sr_[i].ks0; *(LAS bf16x8*)(K_lds + (b) * SHM_K + kswz<DQK>(32 + sr, kc)) = sr_[i].ks1; \
    if constexpr (DQK == 192) *(LAS bf16x8*)(K_lds + (b) * SHM_K + kswz<DQK>(rr_, 256 + rc_ * 2)) = sr_[i].kx; } while (0)
#define SWAIT() do { if constexpr (SDEPTH == 2) { if constexpr (DQK == 192) asm volatile("s_waitcnt vmcnt(5)" ::: "memory"); else asm volatile("s_waitcnt vmcnt(4)" ::: "memory"); } \
    else asm volatile("s_waitcnt vmcnt(0)" ::: "memory"); } while (0)
#define RESC(a) do { if (__any((a) < 1.f)) { if (hi == 0) al_l[r32] = (a); asm volatile("s_waitcnt lgkmcnt(0)" ::: "memory"); \
    _Pragma("unroll") for (int d = 0; d < 4; ++d) _Pragma("unroll") for (int r = 0; r < 16; ++r) o[d][r] *= al_l[crow(r, hi)]; } } while (0)
#define MASKT(pa_, pb_, jt) do { if constexpr (MASK) { const Tile t_ = ts(jt); apply_mask(pa_, pb_, t_.mtype, t_.krel0, qi, hi); } } while (0)
  f32x16 pA0, pA1, pB0, pB1; float mnA, mnB, alA, alB; bf16x8 pa0, pa1, pa2, pa3;
  constexpr int SE = 0, SO = SDEPTH - 1;
  SLOAD(SE, 0); asm volatile("s_waitcnt vmcnt(0)" ::: "memory"); SWRITE(0, SE); __syncthreads();
  qkt<DQK>(pA0, pA1, K_lds, qr, qx, r32, hi); MASKT(pA0, pA1, 0); partialSM<DQK>(pA0, pA1, m_reg, mnA, alA);
  SLOAD(SO, 1); if constexpr (SDEPTH == 2) { if (2 < NT) SLOAD(SE, 2); }
  SWAIT(); SWRITE(1, SO); __syncthreads();
  for (int j = 1; j + 1 < NT; j += 2) {
    SBAR(); qkt<DQK>(pB0, pB1, K_lds + SHM_K, qr, qx, r32, hi); MASKT(pB0, pB1, j);
    finishSM(pA0, pA1, alA, l_reg, pa0, pa1, pa2, pa3); SBAR();
    SLOAD(SO, j + SDEPTH); SBAR();
    pv_d0(o, vb0, pa0, pa1, pa2, pa3); partialSM<DQK>(pB0, pB1, m_reg, mnB, alB);
    __syncthreads(); SWAIT(); SWRITE(0, SE);
    RESC(alB); __syncthreads();
    SBAR(); qkt<DQK>(pA0, pA1, K_lds, qr, qx, r32, hi); MASKT(pA0, pA1, j + 1);
    finishSM(pB0, pB1, alB, l_reg, pa0, pa1, pa2, pa3); SBAR();
    if (SDEPTH == 1 || j + 3 < NT) SLOAD(SE, j + 1 + SDEPTH); SBAR();
    pv_d0(o, vb0 + SHM_V, pa0, pa1, pa2, pa3); partialSM<DQK>(pA0, pA1, m_reg, mnA, alA);
    __syncthreads(); SWAIT(); SWRITE(1, SO);
    RESC(alA); __syncthreads();
  }
  SBAR(); qkt<DQK>(pB0, pB1, K_lds + SHM_K, qr, qx, r32, hi); MASKT(pB0, pB1, NT - 1);
  finishSM(pA0, pA1, alA, l_reg, pa0, pa1, pa2, pa3); SBAR();
  pv_d0(o, vb0, pa0, pa1, pa2, pa3); partialSM<DQK>(pB0, pB1, m_reg, mnB, alB);
  __syncthreads(); RESC(alB);
  finishSM(pB0, pB1, alB, l_reg, pa0, pa1, pa2, pa3); SBAR();
  pv_d0(o, vb0 + SHM_V, pa0, pa1, pa2, pa3);
  if constexpr (SINK) l_reg += __builtin_amdgcn_exp2f(sink_l2 - m_reg * C);
  if (hi == 0) li_l[r32] = l_reg; asm volatile("s_waitcnt lgkmcnt(0)" ::: "memory");
  float rli[16];
#pragma unroll
  for (int r = 0; r < 16; ++r) rli[r] = __builtin_amdgcn_rcpf(li_l[crow(r, hi)]);
  __syncthreads();
  LAS bf16* ost = (LAS bf16*)(lds + wid * 8704);
#pragma unroll
  for (int r = 0; r < 16; ++r) { const int orow = crow(r, hi);
#pragma unroll
    for (int d0 = 0; d0 < 4; ++d0) ost[orow * 136 + d0 * 32 + r32] = (bf16)f2bf(o[d0][r] * rli[r]); }
  asm volatile("s_waitcnt lgkmcnt(0)" ::: "memory");
#pragma unroll
  for (int i = 0; i < 8; ++i) { const int orow = i * 4 + (lane >> 4), ch = lane & 15;
    *(GAS v4u*)(Ow + (size_t)orow * 4096 + ch * 8) = *(const LAS v4u*)(ost + orow * 136 + ch * 8); }
  __syncthreads();
#undef SLOAD
#undef SWRITE
#undef SWAIT
#undef RESC
#undef MASKT
}
}

struct Args { const float* in[38]; float* out; unsigned char* ws; };
template <class T> __device__ __forceinline__ T launder(T p) { asm volatile("" : "+s"(p)); return p; }
template <class T> __device__ __forceinline__ T* launder_g(T* p) { GAS T* g = (GAS T*)p; asm volatile("" : "+s"(g)); return (T*)g; }
#define INP(i) ((const float*)(gcfl)F.A->in[i])
struct Frame {
    LAS unsigned char* lds;
    gu32* ctl;
    int tid, lane, wave;
    int vcu, G, gw, NGW;
    const __attribute__((address_space(4))) Args* A;
    float* out;
    unsigned char* ws;
    unsigned char* wsw;
};
enum { I_X = 0, I_C, I_CTX, I_CCTX, I_WMOD, I_BMOD, I_WIN, I_WOUT, I_LN1G, I_LN1B, I_WFF1, I_WFF2, I_LN2G, I_LN2B, I_SINK, I_CONVW, I_CONVB, I_LWA, I_LBA, I_LWI, I_LBI, I_LAM,
       I_QNORM, I_KVNORM, I_WQB, I_WKVB, I_MUP, I_MUN, I_W0, I_W2, I_A0, I_A2, I_G2, I_KK, I_KA, I_RK, I_LNG, I_LNB };
__device__ __forceinline__ int row_s(int row) { return row < SEQ ? 0 : (row < M_LAT ? 1 : 2); }
__device__ __forceinline__ const float* mod_ptr(const Frame& F, int l, int s, int chunk) { return (const float*)(F.ws + WS_MOD) + ((size_t)(l * 3 + s) * 6 + chunk) * DM; }

__device__ __forceinline__ void transpose_item(const float* W, int N, int Kvalid, bf16* WT, int ldt, const float* kscale, LAS float* scr, int k0, int n0, int lane) {
    { const int kr = lane >> 3, c4 = (lane & 7) * 4;
#pragma unroll
      for (int i = 0; i < 8; ++i) { const int kk = 8 * i + kr, k = k0 + kk; f32x4 v = {0.f, 0.f, 0.f, 0.f};
          if (k < Kvalid) { v = *(const f32x4*)(W + (size_t)k * N + n0 + c4); if (kscale) v = v * kscale[k]; }
          scr[kk * 33 + c4] = v.x; scr[kk * 33 + c4 + 1] = v.y; scr[kk * 33 + c4 + 2] = v.z; scr[kk * 33 + c4 + 3] = v.w; } }
    LDS_WAIT(); asm volatile("" ::: "memory");
    const int c = lane & 7;
#pragma unroll
    for (int j = 0; j < 4; ++j) { const int n = (lane >> 3) + 8 * j; const LAS float* s = scr + (8 * c) * 33 + n;
        v4u o; o.x = pk2(s[0 * 33], s[1 * 33]); o.y = pk2(s[2 * 33], s[3 * 33]); o.z = pk2(s[4 * 33], s[5 * 33]); o.w = pk2(s[6 * 33], s[7 * 33]);
        *(v4u*)(WT + (size_t)(n0 + n) * ldt + k0 + 8 * c) = o; }
    LDS_WAIT(); asm volatile("" ::: "memory");
}
__device__ __forceinline__ void convert_weights(Frame& F, int l, int widx, int nw) {
    LAS float* scr = (LAS float*)(F.lds + F.wave * 16384);
    constexpr int I1 = 64 * 271, I2 = 64 * 128, I3 = 64 * 512, I4 = 256 * 128, I5 = 16 * 48, I6 = 8 * 64, I7 = 32 * 8, I8 = 2 * 32, I9 = 2 * 32, I10 = 3 * 32;
    constexpr int NIT = I1 + I2 + I3 + I4 + I5 + I6 + I7 + I8 + I9 + I10;
    unsigned char* ws = F.ws + (l ? WSET_STRIDE : 0);
    for (int it = widx; it < NIT; it += nw) {
        int r = it;
        if (r < I1) { transpose_item(INP(I_WIN) + (size_t)l * DM * DIN, DIN, DM, (bf16*)(ws + WS_WIN), DM, nullptr, scr, 64 * (r / 271), 32 * (r % 271), F.lane); continue; } r -= I1;
        if (r < I2) { transpose_item(INP(I_WOUT) + (size_t)l * DM * DM, DM, DM, (bf16*)(ws + WS_WOUT), DM, nullptr, scr, 64 * (r / 128), 32 * (r % 128), F.lane); continue; } r -= I2;
        if (r < I3) { transpose_item(INP(I_WFF1) + (size_t)l * DM * DFF, DFF, DM, (bf16*)(ws + WS_WFF1), DM, nullptr, scr, 64 * (r / 512), 32 * (r % 512), F.lane); continue; } r -= I3;
        if (r < I4) { transpose_item(INP(I_WFF2) + (size_t)l * DFF * DM, DM, DFF, (bf16*)(ws + WS_WFF2), DFF, nullptr, scr, 64 * (r / 128), 32 * (r % 128), F.lane); continue; } r -= I4;
        if (r < I5) { transpose_item(INP(I_WQB) + (size_t)l * 1024 * 1536, 1536, 1024, (bf16*)(ws + WS_WQB), 1024, INP(I_QNORM) + l * 1024, scr, 64 * (r / 48), 32 * (r % 48), F.lane); continue; } r -= I5;
        if (r < I6) { transpose_item(INP(I_WKVB) + (size_t)l * 512 * 2048, 2048, 512, (bf16*)(ws + WS_WKVB), 512, INP(I_KVNORM) + l * 512, scr, 64 * (r / 64), 32 * (r % 64), F.lane); continue; } r -= I6;
        if (r < I7) { const int mat = r >> 3, sub = r & 7, gate = mat & 1, dn = mat >> 1;
            const int d = dn >> 3, n = dn & 7;
            const float* src = (gate ? INP(I_LWI) : INP(I_LWA)) + ((size_t)(l * 2 + d) * 8 + n) * 128 * 128;
            bf16* dst = (bf16*)(ws + WS_WLRU) + ((size_t)(d * 2 + gate) * 8 + n) * 128 * 128;
            transpose_item(src, 128, 128, dst, 128, nullptr, scr, 64 * (sub >> 2), 32 * (sub & 3), F.lane); continue; } r -= I7;
        if (r < I8) { const int d = r >> 5; transpose_item(INP(I_W2) + (size_t)(l * 2 + d) * 64 * 1024, 1024, 64, (bf16*)(ws + WS_W2T) + (size_t)d * 1024 * 64, 64, nullptr, scr, 0, 32 * (r & 31), F.lane); continue; } r -= I8;
        if (r < I9) { const int d = r >> 5; transpose_item(INP(I_A2) + (size_t)(l * 2 + d) * 64 * 1024, 1024, 64, (bf16*)(ws + WS_A2T) + (size_t)d * 1024 * 64, 64, nullptr, scr, 0, 32 * (r & 31), F.lane); continue; } r -= I9;
        transpose_item(INP(I_G2) + (size_t)l * 160 * 1024, 1024, 160, (bf16*)(ws + WS_G2T), 192, nullptr, scr, 64 * (r / 32), 32 * (r % 32), F.lane);
    }
    { unsigned zz = 0u; asm volatile("" : "+v"(zz)); v4u z = {zz, zz, zz, zz}; v4u* p = (v4u*)((bf16*)(ws + WS_WIN) + (size_t)DIN * DM);
      for (int i = widx * 64 + F.lane; i < 32 * DM / 8; i += nw * 64) p[i] = z; }
}

__device__ __forceinline__ void mod_partials(Frame& F) {
    LAS float* sl = (LAS float*)F.lds;
    for (int it = F.vcu; it < 2 * 32 * 12; it += F.G) {
        const int l = it / 384, ks = (it / 12) % 32, cc = it % 12;
        __syncthreads();
        if (F.tid < 384) { const int s = F.tid >> 7, k = ks * 128 + (F.tid & 127); const float c = s < 2 ? INP(I_C)[s * DM + k] : INP(I_CCTX)[k]; sl[F.tid] = c / (1.f + __expf(-c)); }
        __syncthreads();
        const float* wp = INP(I_WMOD) + ((size_t)l * DM + ks * 128) * 24576 + cc * 2048 + F.tid * 4;
        f32x4 a0 = {0.f, 0.f, 0.f, 0.f}, a1 = a0, a2 = a0;
#pragma unroll 8
        for (int k = 0; k < 128; ++k) { const f32x4 w = *(const f32x4*)(wp + (size_t)k * 24576); a0 += w * sl[k]; a1 += w * sl[128 + k]; a2 += w * sl[256 + k]; }
        float* op = (float*)(F.ws + WS_MODP) + ((size_t)(l * 32 + ks) * 3) * 24576 + cc * 2048 + F.tid * 4;
        *(f32x4*)(op) = a0; *(f32x4*)(op + 24576) = a1; *(f32x4*)(op + 2 * 24576) = a2;
    }
    __syncthreads();
}
__device__ __forceinline__ void mod_reduce(Frame& F) {
    for (int i = F.vcu * NTHR + F.tid; i < 2 * 3 * 24576; i += F.G * NTHR) {
        const int l = i / (3 * 24576), s = (i / 24576) % 3, n = i % 24576;
        float a = INP(I_BMOD)[l * 24576 + n];
        const float* pp = (const float*)(F.ws + WS_MODP) + ((size_t)(l * 32) * 3 + s) * 24576 + n;
#pragma unroll 8
        for (int ks = 0; ks < 32; ++ks) a += pp[(size_t)ks * 3 * 24576];
        ((float*)(F.ws + WS_MOD))[i] = a;
    }
}

__device__ __forceinline__ void sum_partials_row(const Frame& F, const float* yp, size_t stride, bf16* ydst) {
    int lane = F.lane; asm volatile("" : "+v"(lane));
#pragma unroll 2
    for (int j = 0; j < 16; ++j) { const int c = 4 * lane + 256 * j; f32x4 y = *(const f32x4*)(yp + c);
#pragma unroll
        for (int sp = 1; sp < 8; ++sp) y += *(const f32x4*)(yp + sp * stride + c);
        v2u w; w.x = pk2(y.x, y.y); w.y = pk2(y.z, y.w); *(v2u*)(ydst + c) = w; }
}
constexpr int LNV_G = 0, LNV_B = DM, LNV_GA = 2 * DM, LNV_SC = 3 * DM, LNV_SH = 4 * DM;
__device__ __forceinline__ void ln_stage(const Frame& F, int slot, const float* src) {
    LAS float* d = (LAS float*)F.lds + slot; gcfl g = (gcfl)src;
#pragma unroll
    for (int u = 0; u < 2; ++u) { const int c = 4 * (F.tid + NTHR * u); *(LAS f32x4*)(d + c) = *(const GAS f32x4*)(g + c); }
}
template <int MODE, bool XSH = false, bool XDH = false>
__device__ __forceinline__ void ln_row(const Frame& F, const void* xsrc_, const bf16* Y_, void* xdst_, bool domod, bf16* hrow_) {
    gcfl xsrc = (gcfl)xsrc_; const GAS _Float16* xsrch = (const GAS _Float16*)xsrc_; gflp xdst = (gflp)xdst_; GAS _Float16* xdsth = (GAS _Float16*)xdst_;
    gcbf Y = (gcbf)Y_; gbfp hrow = (gbfp)hrow_; const LAS float* L = (const LAS float*)F.lds + 4 * F.lane;
    f32x4 v[16]; v2u yr[16]; float s = 0.f;
#pragma unroll
    for (int j = 0; j < 16; ++j) { const int c = 4 * F.lane + 256 * j;
        if (XSH) v[j] = __builtin_convertvector(__builtin_nontemporal_load((const GAS h16x4*)(xsrch + c)), f32x4); else v[j] = __builtin_nontemporal_load((const GAS f32x4*)(xsrc + c)); }
    if (MODE == 1) {
#pragma unroll
        for (int j = 0; j < 16; ++j) yr[j] = __builtin_nontemporal_load((const GAS v2u*)(Y + 4 * F.lane + 256 * j));
    }
#pragma unroll
    for (int j = 0; j < 16; ++j) {
        if (MODE == 1) { const f32x4 y = {bflo(yr[j].x), bfhi(yr[j].x), bflo(yr[j].y), bfhi(yr[j].y)}, g = *(const LAS f32x4*)(L + LNV_GA + 256 * j); v[j] = v[j] * ALPHA + g * y; }
        s += (v[j].x + v[j].y) + (v[j].z + v[j].w); }
    float mean = wave_sum(s) * (1.f / DM), s2 = 0.f;
#pragma unroll
    for (int j = 0; j < 16; ++j) { v[j] = v[j] - mean; s2 += (v[j].x * v[j].x + v[j].y * v[j].y) + (v[j].z * v[j].z + v[j].w * v[j].w); }
    float rstd = 1.f / sqrtf(wave_sum(s2) * (1.f / DM) + LN_EPS);
    if (MODE == 1) {
        s = 0.f;
#pragma unroll
        for (int j = 0; j < 16; ++j) { const int c = 4 * F.lane + 256 * j; const f32x4 g = *(const LAS f32x4*)(L + LNV_G + 256 * j), b = *(const LAS f32x4*)(L + LNV_B + 256 * j); v[j] = v[j] * rstd * g + b;
            if (XDH) __builtin_nontemporal_store(__builtin_convertvector(v[j], h16x4), (GAS h16x4*)(xdsth + c)); else __builtin_nontemporal_store(v[j], (GAS f32x4*)(xdst + c));
            s += (v[j].x + v[j].y) + (v[j].z + v[j].w); }
        if (!domod) return;
        mean = wave_sum(s) * (1.f / DM); s2 = 0.f;
#pragma unroll
        for (int j = 0; j < 16; ++j) { v[j] = v[j] - mean; s2 += (v[j].x * v[j].x + v[j].y * v[j].y) + (v[j].z * v[j].z + v[j].w * v[j].w); }
        rstd = 1.f / sqrtf(wave_sum(s2) * (1.f / DM) + LN_EPS);
    }
#pragma unroll
    for (int j = 0; j < 16; ++j) { const int c = 4 * F.lane + 256 * j; const f32x4 a = *(const LAS f32x4*)(L + LNV_SC + 256 * j), b = *(const LAS f32x4*)(L + LNV_SH + 256 * j);
        const f32x4 o = v[j] * rstd * (a + 1.f) + b; v2u w; w.x = pk2(o.x, o.y); w.y = pk2(o.z, o.w); *(GAS v2u*)(hrow + c) = w; }
}

__device__ __forceinline__ void shift4(const bf16* P, unsigned eo, bool hp, bool hn, const float* mup, const float* mun, unsigned mo, float (&u)[4]) {
    const v2u xc = ldg<v2u>(P, eo * 2u); v2u xp = {0u, 0u}, xn = {0u, 0u};
    if (hp) xp = ldg<v2u>(P, (eo - DINP) * 2u); if (hn) xn = ldg<v2u>(P, (eo + DINP) * 2u);
    const f32x4 mp = ldg<f32x4>(mup, mo * 4u), mn = ldg<f32x4>(mun, mo * 4u);
    const float c[4] = {bflo(xc.x), bfhi(xc.x), bflo(xc.y), bfhi(xc.y)}, p[4] = {bflo(xp.x), bfhi(xp.x), bflo(xp.y), bfhi(xp.y)}, n[4] = {bflo(xn.x), bfhi(xn.x), bflo(xn.y), bfhi(xn.y)};
#pragma unroll
    for (int e = 0; e < 4; ++e) u[e] = c[e] + mp[e] * (p[e] - c[e]) + mn[e] * (n[e] - c[e]);
}
__device__ __forceinline__ void st4bf(void* base, unsigned eo, float a, float b, float c, float d) { v2u w; w.x = pk2(a, b); w.y = pk2(c, d); stg<v2u>(base, eo * 2u, w); }

__device__ __forceinline__ void rwkv_feat_item(Frame& F, int l, int item) {
    F.tid = ltid(); F.lane = F.tid & 63;
    int row0, seq_lo, seq_hi;
    if (item < 16) { const int b = item >> 3; seq_lo = M_LAT + b * NCTX; seq_hi = seq_lo + NCTX; row0 = seq_lo + (item & 7) * 32; }
    else { const int it = item - 16, b = it >> 8; seq_lo = b * SEQ; seq_hi = seq_lo + SEQ; row0 = seq_lo + (it & 255) * 32; }
    const bf16* P = (const bf16*)(F.ws + WS_P);
    LAS bf16* ACT = (LAS bf16*)F.lds;
    const float* mup = INP(I_MUP) + l * RWC; const float* mun = INP(I_MUN) + l * RWC;
    __syncthreads();
    { const int tok = F.tid >> 4, jc = F.tid & 15, row = row0 + tok; const bool hp = row > seq_lo, hn = row + 1 < seq_hi;
      const bf16* pr = P + (size_t)row * DINP + C_RWL;
#pragma unroll
      for (int i = 0; i < 13; ++i) { const int j = jc * 2 + 32 * i;
          const unsigned xc = *(const unsigned*)(pr + j), xp = hp ? *(const unsigned*)(pr - DINP + j) : 0u, xn = hn ? *(const unsigned*)(pr + DINP + j) : 0u;
          float u[2];
#pragma unroll
          for (int e = 0; e < 2; ++e) { const float c = e ? bfhi(xc) : bflo(xc), p = e ? bfhi(xp) : bflo(xp), n = e ? bfhi(xn) : bflo(xn);
              float v = c + mup[3072 + j + e] * (p - c) + mun[3072 + j + e] * (n - c);
              if (j < 128) v = tanhf_(v); else if (j >= 256) v = sigmoidf_(v);
              u[e] = v; }
          *(LAS unsigned*)(ACT + tok * 424 + j) = pk2(u[0], u[1]); } }
    __syncthreads();
    const int tok = F.lane & 31, hi = F.lane >> 5, row = row0 + tok;
    const bf16* W2T = (const bf16*)(F.wsw + WS_W2T); const bf16* A2T = (const bf16*)(F.wsw + WS_A2T); const bf16* G2T = (const bf16*)(F.wsw + WS_G2T);
    bf16* RWF = (bf16*)(F.ws + WS_RWF); const size_t RS = (size_t)M_TOT * 1024;
    const float* kkv = INP(I_KK) + l * 1024; const float* kav = INP(I_KA) + l * 1024; const float* rkv = INP(I_RK) + l * 1024;
    const float* w0f = INP(I_W0) + (size_t)(l * 2) * 1024; const float* a0f = INP(I_A0) + (size_t)(l * 2) * 1024;
    const LAS bf16* actl = ACT + tok * 424 + hi * 8;
    LAS unsigned char* TB = F.lds + 27136 + F.wave * 10880;
#define RF_LOADG(reg_, colbase) do { _Pragma("unroll") for (int i_ = 0; i_ < 3; ++i_) { const int p_ = F.lane + 64 * i_; reg_[i_] = (v4u){0u, 0u, 0u, 0u}; if (p_ < 136) { const int rr_ = p_ >> 2, cp_ = p_ & 3, gr_ = row0 - 1 + rr_; \
        if (gr_ >= seq_lo && gr_ < seq_hi) reg_[i_] = ldg<v4u>(P, ((unsigned)gr_ * DINP + (colbase) + 8 * cp_) * 2u); } } } while (0)
#define RF_STORET(ti, reg_) do { _Pragma("unroll") for (int i_ = 0; i_ < 3; ++i_) { const int p_ = F.lane + 64 * i_; if (p_ < 136) { const int rr_ = p_ >> 2, cp_ = p_ & 3; *(LAS v4u*)(TB + (ti) * 2720 + rr_ * 80 + cp_ * 16) = reg_[i_]; } } } while (0)
#define RF_SHIFT4(ti, g_, mo_, u_) do { const LAS unsigned char* q_ = TB + (ti) * 2720 + (tok + 1) * 80 + (8 * (g_) + 4 * hi) * 2; const v2u xc_ = *(const LAS v2u*)q_, xp_ = *(const LAS v2u*)(q_ - 80), xn_ = *(const LAS v2u*)(q_ + 80); \
        const f32x4 mp_ = ldg<f32x4>(mup, (mo_) * 4u), mn_ = ldg<f32x4>(mun, (mo_) * 4u); \
        const float c_[4] = {bflo(xc_.x), bfhi(xc_.x), bflo(xc_.y), bfhi(xc_.y)}, pp_[4] = {bflo(xp_.x), bfhi(xp_.x), bflo(xp_.y), bfhi(xp_.y)}, nn_[4] = {bflo(xn_.x), bfhi(xn_.x), bflo(xn_.y), bfhi(xn_.y)}; \
        _Pragma("unroll") for (int e_ = 0; e_ < 4; ++e_) u_[e_] = c_[e_] + mp_[e_] * (pp_[e_] - c_[e_]) + mn_[e_] * (nn_[e_] - c_[e_]); } while (0)
#define RF_PUT(ti, o_) do { _Pragma("unroll") for (int g_ = 0; g_ < 4; ++g_) *(LAS v2u*)(TB + (ti) * 2720 + tok * 80 + (8 * g_ + 4 * hi) * 2) = o_[g_]; } while (0)
#define RF_FLUSH3(a0_, a1_, a2_, cblk_) do { asm volatile("s_waitcnt lgkmcnt(0)" ::: "memory"); \
        _Pragma("unroll") for (int t_ = 0; t_ < 3; ++t_) { const int arr_ = t_ == 0 ? (a0_) : (t_ == 1 ? (a1_) : (a2_)); \
            _Pragma("unroll") for (int i_ = 0; i_ < 2; ++i_) { const int p_ = F.lane + 64 * i_, rr_ = p_ >> 2, cp_ = p_ & 3; const v4u v_ = *(const LAS v4u*)(TB + t_ * 2720 + rr_ * 80 + cp_ * 16); \
                stg<v4u>(RWF + arr_ * RS, ((unsigned)(row0 + rr_) * 1024u + (cblk_) + 8 * cp_) * 2u, v_); } } \
        asm volatile("s_waitcnt lgkmcnt(0)" ::: "memory"); } while (0)
#pragma unroll 1
    for (int hh = 0; hh < 2; ++hh) {
        const int h = 2 * F.wave + hh, cbase = h * 64;
        float ssq = 0.f;
        { v4u t0[3], t1[3]; RF_LOADG(t0, C_RWK + cbase); RF_LOADG(t1, C_RWK + cbase + 32); RF_STORET(0, t0); RF_STORET(1, t1); }
        asm volatile("s_waitcnt lgkmcnt(0)" ::: "memory");
#pragma unroll
        for (int bg = 0; bg < 8; ++bg) { const unsigned c4 = cbase + (bg >> 2) * 32 + 8 * (bg & 3) + 4 * hi; float uk[4];
            RF_SHIFT4(bg >> 2, bg & 3, 1024 + c4, uk); const f32x4 k4 = ldg<f32x4>(kkv, c4 * 4u);
#pragma unroll
            for (int e = 0; e < 4; ++e) { const float q = uk[e] * k4[e]; ssq += q * q; } }
        ssq = half_swap_sum(ssq);
        const float rn = 1.f / fmaxf(sqrtf(ssq), 1e-12f);
        float sb = 0.f;
        asm volatile("s_waitcnt lgkmcnt(0)" ::: "memory");
#pragma unroll 1
        for (int blk = 0; blk < 2; ++blk) {
            const unsigned cblk = cbase + blk * 32, cha = cblk + tok;
            v4u gR[3], gK[3], gV[3];
            RF_LOADG(gR, C_RWR + cblk); RF_LOADG(gK, C_RWK + cblk); RF_LOADG(gV, C_RWV + cblk);
#pragma unroll
            for (int d = 0; d < 2; ++d) { f32x16 aw = {};
#pragma unroll
                for (int ks = 0; ks < 4; ++ks) { const bf16x8 bw = *(const LAS bf16x8*)(actl + d * 64 + ks * 16); const bf16x8 w_ = ldg<bf16x8>(W2T, ((d * 1024 + cha) * 64 + ks * 16 + hi * 8) * 2u);
                    aw = __builtin_amdgcn_mfma_f32_32x32x16_bf16(w_, bw, aw, 0, 0, 0); }
                v2u o[4];
#pragma unroll
                for (int g = 0; g < 4; ++g) { const f32x4 w0 = ldg<f32x4>(w0f, (d * 1024 + cblk + 8 * g + 4 * hi) * 4u); float e4[4];
#pragma unroll
                    for (int e = 0; e < 4; ++e) e4[e] = 0.60653065971f * sigmoidf_(w0[e] + aw[4 * g + e]);
                    o[g].x = pk2(e4[0], e4[1]); o[g].y = pk2(e4[2], e4[3]); }
                RF_PUT(d, o); }
            { f32x16 ag = {};
#pragma unroll
              for (int ks = 0; ks < 10; ++ks) { const bf16x8 bg_ = *(const LAS bf16x8*)(actl + 256 + ks * 16); const bf16x8 g_ = ldg<bf16x8>(G2T, (cha * 192 + ks * 16 + hi * 8) * 2u);
                  ag = __builtin_amdgcn_mfma_f32_32x32x16_bf16(g_, bg_, ag, 0, 0, 0); }
              v2u o[4];
#pragma unroll
              for (int g = 0; g < 4; ++g) { o[g].x = pk2(ag[4 * g], ag[4 * g + 1]); o[g].y = pk2(ag[4 * g + 2], ag[4 * g + 3]); }
              RF_PUT(2, o); }
            RF_FLUSH3(4, 5, 8, cblk);
            RF_STORET(0, gR); RF_STORET(1, gK); RF_STORET(2, gV);
            { f32x16 aaf = {}, aab = {};
#pragma unroll
              for (int ks = 0; ks < 4; ++ks) { const bf16x8 baf = *(const LAS bf16x8*)(actl + 128 + ks * 16), bab = *(const LAS bf16x8*)(actl + 192 + ks * 16);
                  const bf16x8 a_f = ldg<bf16x8>(A2T, (cha * 64 + ks * 16 + hi * 8) * 2u), a_b = ldg<bf16x8>(A2T, ((1024 + cha) * 64 + ks * 16 + hi * 8) * 2u);
                  aaf = __builtin_amdgcn_mfma_f32_32x32x16_bf16(a_f, baf, aaf, 0, 0, 0); aab = __builtin_amdgcn_mfma_f32_32x32x16_bf16(a_b, bab, aab, 0, 0, 0); }
              v2u oR[4], oK[4], oV[4], oKK[4], oAF[4], oAB[4];
              asm volatile("s_waitcnt lgkmcnt(0)" ::: "memory");
#pragma unroll
              for (int g = 0; g < 4; ++g) { const unsigned c4 = cblk + 8 * g + 4 * hi; float ur[4], uk[4], uv[4];
                  RF_SHIFT4(0, g, c4, ur); RF_SHIFT4(1, g, 1024 + c4, uk); RF_SHIFT4(2, g, 2048 + c4, uv);
                  const f32x4 a0a = ldg<f32x4>(a0f, c4 * 4u), a0b = ldg<f32x4>(a0f, (1024 + c4) * 4u), kk4 = ldg<f32x4>(kkv, c4 * 4u), ka4 = ldg<f32x4>(kav, c4 * 4u), rk4 = ldg<f32x4>(rkv, c4 * 4u);
                  float af[4], ab[4], kk[4];
#pragma unroll
                  for (int e = 0; e < 4; ++e) { const int r = 4 * g + e;
                      af[e] = sigmoidf_(a0a[e] + aaf[r]); ab[e] = sigmoidf_(a0b[e] + aab[r]); kk[e] = uk[e] * kk4[e] * rn;
                      const float kdf = uk[e] * (1.f + (af[e] - 1.f) * ka4[e]), kdb = uk[e] * (1.f + (ab[e] - 1.f) * ka4[e]);
                      sb += ur[e] * rk4[e] * (kdf + kdb); }
                  oR[g].x = pk2(ur[0], ur[1]); oR[g].y = pk2(ur[2], ur[3]); oK[g].x = pk2(uk[0], uk[1]); oK[g].y = pk2(uk[2], uk[3]); oV[g].x = pk2(uv[0], uv[1]); oV[g].y = pk2(uv[2], uv[3]);
                  oKK[g].x = pk2(kk[0], kk[1]); oKK[g].y = pk2(kk[2], kk[3]); oAF[g].x = pk2(af[0], af[1]); oAF[g].y = pk2(af[2], af[3]); oAB[g].x = pk2(ab[0], ab[1]); oAB[g].y = pk2(ab[2], ab[3]); }
              asm volatile("s_waitcnt lgkmcnt(0)" ::: "memory");
              RF_PUT(0, oR); RF_PUT(1, oK); RF_PUT(2, oV); RF_FLUSH3(0, 1, 2, cblk);
              RF_PUT(0, oKK); RF_PUT(1, oAF); RF_PUT(2, oAB); RF_FLUSH3(3, 6, 7, cblk); }
        }
        sb = half_swap_sum(sb);
        if (hi == 0) ((float*)(F.ws + WS_SB))[(size_t)row * 16 + h] = sb;
    }
#undef RF_LOADG
#undef RF_STORET
#undef RF_SHIFT4
#undef RF_PUT
#undef RF_FLUSH3
}

__device__ __forceinline__ float gelu_tanh(float x) { return 0.5f * x * (1.f + tanhf_(0.7978845608028654f * (x + 0.044715f * x * x * x))); }
template <bool PASS3>
__device__ __forceinline__ void lru_item(Frame& F, int l, int item) {
    F.tid = ltid(); F.lane = F.tid & 63;
    const int sc = item >> 3, nb = item & 7, b = sc / NCH, ch = sc % NCH;
    int row0, seq_lo, seq_hi;
    if (ch < 8) { seq_lo = M_LAT + b * NCTX; seq_hi = seq_lo + NCTX; row0 = seq_lo + ch * 32; }
    else { seq_lo = b * SEQ; seq_hi = seq_lo + SEQ; row0 = seq_lo + (ch - 8) * 32; }
    const bf16* P = (const bf16*)(F.ws + WS_P);
    LAS float* U = (LAS float*)F.lds;
    LAS bf16* UA = (LAS bf16*)(F.lds + 16384);
    LAS float* AB = (LAS float*)(F.lds + 32768);
    __syncthreads();
    { const int tok = F.tid >> 4, c8 = (F.tid & 15) * 8, cg = nb * 128 + c8; float acc[8];
      const float* cb = INP(I_CONVB) + l * 1024 + cg;
#pragma unroll
      for (int e = 0; e < 8; ++e) acc[e] = cb[e];
#pragma unroll
      for (int j = 0; j < 4; ++j) { const int r = row0 + tok - 2 + j;
          if (r >= seq_lo && r < seq_hi) { const v4u x = *(const v4u*)(P + (size_t)r * DINP + C_LRUX + cg); const float* cw = INP(I_CONVW) + (size_t)(l * 4 + j) * 1024 + cg;
#pragma unroll
              for (int w = 0; w < 4; ++w) { acc[2 * w] += cw[2 * w] * bflo(x[w]); acc[2 * w + 1] += cw[2 * w + 1] * bfhi(x[w]); } } }
      *(LAS f32x4*)(U + tok * 128 + c8) = (f32x4){acc[0], acc[1], acc[2], acc[3]}; *(LAS f32x4*)(U + tok * 128 + c8 + 4) = (f32x4){acc[4], acc[5], acc[6], acc[7]};
      v4u o; o.x = pk2(acc[0], acc[1]); o.y = pk2(acc[2], acc[3]); o.z = pk2(acc[4], acc[5]); o.w = pk2(acc[6], acc[7]);
      *(LAS v4u*)(UA + tok * 136 + c8) = o; }
    __syncthreads();
    { const int dir = F.wave >> 2, cq = F.wave & 3, l32 = F.lane & 31, hi = F.lane >> 5, chn = cq * 32 + l32, cg = nb * 128 + chn;
      const bf16* Wr = (const bf16*)(F.wsw + WS_WLRU) + ((size_t)(dir * 2 + 0) * 8 + nb) * 16384 + (size_t)chn * 128;
      const bf16* Wi = (const bf16*)(F.wsw + WS_WLRU) + ((size_t)(dir * 2 + 1) * 8 + nb) * 16384 + (size_t)chn * 128;
      f32x16 accr = {}, acci = {};
#pragma unroll
      for (int ks = 0; ks < 8; ++ks) { const int ko = ks * 16 + hi * 8;
          const bf16x8 a = *(const LAS bf16x8*)(UA + l32 * 136 + ko); const bf16x8 br = *(const bf16x8*)(Wr + ko), bi = *(const bf16x8*)(Wi + ko);
          accr = __builtin_amdgcn_mfma_f32_32x32x16_bf16(a, br, accr, 0, 0, 0); acci = __builtin_amdgcn_mfma_f32_32x32x16_bf16(a, bi, acci, 0, 0, 0); }
      const float ba = INP(I_LBA)[(l * 2 + dir) * 1024 + cg], bi_ = INP(I_LBI)[(l * 2 + dir) * 1024 + cg], sp = softplusf_(-INP(I_LAM)[(l * 2 + dir) * 1024 + cg]);
#pragma unroll
      for (int r = 0; r < 16; ++r) { const int tok = att::crow(r, hi); const float u = U[tok * 128 + chn];
          const float rg = sigmoidf_(accr[r] + ba), ig = sigmoidf_(acci[r] + bi_), la = -8.f * rg * sp, a = __expf(la), x2 = 2.f * la;
          const float em = x2 * (1.f + x2 * (0.5f + x2 * (0.16666667f + x2 * (0.041666668f + x2 * (0.0083333338f + x2 * 0.0013888889f)))));
          const float bc = __builtin_amdgcn_sqrtf(x2 < -0.5f ? 1.f - a * a : -em) * (ig * u);
          AB[(dir * 2 + 0) * 4096 + tok * 128 + chn] = a; AB[(dir * 2 + 1) * 4096 + tok * 128 + chn] = bc; } }
    __syncthreads();
    if (F.tid < 256) { const int dir = F.tid >> 7, chn = F.tid & 127, cg = nb * 128 + chn; const size_t ci = ((size_t)(dir * 2 + b) * NCH + ch) * 1024 + cg;
        LAS float* Aa = AB + (dir * 2) * 4096 + chn; LAS float* Bb = AB + (dir * 2 + 1) * 4096 + chn;
        if (!PASS3) { float h = 0.f, ap = 1.f;
#pragma unroll 8
            for (int s = 0; s < 32; ++s) { const int tok = dir ? 31 - s : s; const float a = Aa[tok * 128]; h = a * h + Bb[tok * 128]; ap *= a;
                if (s == 0 && dir == 1 && ch == 7) ((float*)(F.ws + WS_QUIRK))[b * 1024 + cg] = h; }
            ((float*)(F.ws + WS_CA))[ci] = ap; ((float*)(F.ws + WS_CB))[ci] = h;
        } else { float h = ((const float*)(F.ws + WS_HIN))[ci];
#pragma unroll 8
            for (int s = 0; s < 32; ++s) { const int tok = dir ? 31 - s : s; h = Aa[tok * 128] * h + Bb[tok * 128]; Bb[tok * 128] = h; } } }
    if (PASS3) { __syncthreads();
        const int tok = F.tid >> 4, c8 = (F.tid & 15) * 8, cg = nb * 128 + c8, row = row0 + tok;
        const v4u y = *(const v4u*)(P + (size_t)row * DINP + C_LRUY + cg); float o[8];
#pragma unroll
        for (int w = 0; w < 4; ++w) { const float h0 = AB[4096 + tok * 128 + c8 + 2 * w] + AB[3 * 4096 + tok * 128 + c8 + 2 * w], h1 = AB[4096 + tok * 128 + c8 + 2 * w + 1] + AB[3 * 4096 + tok * 128 + c8 + 2 * w + 1];
            o[2 * w] = h0 * gelu_tanh(bflo(y[w])); o[2 * w + 1] = h1 * gelu_tanh(bfhi(y[w])); }
        v4u ov; ov.x = pk2(o[0], o[1]); ov.y = pk2(o[2], o[3]); ov.z = pk2(o[4], o[5]); ov.w = pk2(o[6], o[7]);
        *(v4u*)((bf16*)(F.ws + WS_MIX) + (size_t)row * DM + 1024 + cg) = ov; }
}
__device__ __forceinline__ void lru_carry(Frame& F, int blk) {
    F.tid = ltid(); F.lane = F.tid & 63;
    const int gid = blk * NTHR + F.tid; if (gid >= 4096) return;
    const int dir = gid >> 11, b = (gid >> 10) & 1, cg = gid & 1023;
    const float* CA = (const float*)(F.ws + WS_CA) + ((size_t)(dir * 2 + b) * NCH) * 1024 + cg; const float* CB = (const float*)(F.ws + WS_CB) + ((size_t)(dir * 2 + b) * NCH) * 1024 + cg;
    float* HIN = (float*)(F.ws + WS_HIN) + ((size_t)(dir * 2 + b) * NCH) * 1024 + cg;
    float h = 0.f;
    if (dir == 0) {
#pragma unroll 8
        for (int c = 0; c < NCH; ++c) { HIN[(size_t)c * 1024] = h; h = CA[(size_t)c * 1024] * h + CB[(size_t)c * 1024]; }
    } else {
        for (int c = 7; c >= 0; --c) { HIN[(size_t)c * 1024] = h; h = CA[(size_t)c * 1024] * h + CB[(size_t)c * 1024]; }
        h = ((const float*)(F.ws + WS_QUIRK))[b * 1024 + cg];
#pragma unroll 8
        for (int c = NCH - 1; c >= 8; --c) { HIN[(size_t)c * 1024] = h; h = CA[(size_t)c * 1024] * h + CB[(size_t)c * 1024]; }
    }
}

__device__ __forceinline__ void rope_table(Frame& F) {
    const int i = F.vcu * NTHR + F.tid; if (i >= 2048) return;
    const int pos = i >> 4, f = i & 15; float s, c; sincosf((float)pos * exp2f(-(float)f * (13.287712379549449f / 16.f)), &s, &c);
    float* t = (float*)(F.ws + WS_ROPE); t[i] = c; t[2048 + i] = s;
}
__device__ __forceinline__ void row_prep(Frame& F, int row) {
    F.tid = ltid(); F.lane = F.tid & 63;
    bf16* pr = (bf16*)(F.ws + WS_P) + (size_t)row * DINP; const int lane = F.lane;
    const bool lat = row < M_LAT; const int t = row & (SEQ - 1); const float prow = (float)(t >> 6), pcol = (float)(t & 63);
    { const v4u a = *(const v4u*)(pr + C_QA + lane * 16), b = *(const v4u*)(pr + C_QA + lane * 16 + 8); float ss = 0.f;
#pragma unroll
      for (int w = 0; w < 4; ++w) { const float x0 = bflo(a[w]), x1 = bfhi(a[w]), x2 = bflo(b[w]), x3 = bfhi(b[w]); ss += x0 * x0 + x1 * x1 + x2 * x2 + x3 * x3; }
      ss = wave_sum(ss); if (lane == 0) ((float*)(F.ws + WS_RSQ))[row] = 1.f / sqrtf(ss * (1.f / 1024.f) + RMS_EPS); }
    { const v4u a = *(const v4u*)(pr + C_KVA + lane * 8); float ss = 0.f;
#pragma unroll
      for (int w = 0; w < 4; ++w) { const float x0 = bflo(a[w]), x1 = bfhi(a[w]); ss += x0 * x0 + x1 * x1; }
      ss = wave_sum(ss); if (lane == 0) ((float*)(F.ws + WS_RSKV))[row] = 1.f / sqrtf(ss * (1.f / 512.f) + RMS_EPS); }
    bf16* kr = (bf16*)(F.ws + WS_KR) + (size_t)row * 64;
    if (lat) {
        { const int part = lane >> 5, sub = lane & 31;
          const float inv = exp2f(-(float)sub * (13.287712379549449f / 32.f)); float sn, cs; sincosf((part ? pcol : prow) * inv, &sn, &cs);
#pragma unroll
          for (int hd = 0; hd < 10; ++hd) { bf16* qb = pr + (hd < 8 ? C_SWAQ + hd * 128 : C_SWAK + (hd - 8) * 128) + part * 64;
              const float x1 = bf2f(qb[sub]), x2 = bf2f(qb[sub + 32]); qb[sub] = (bf16)f2bf(x1 * cs - x2 * sn); qb[sub + 32] = (bf16)f2bf(x2 * cs + x1 * sn); } }
        if (lane < 32) { const int part = lane >> 4, i = lane & 15; const bf16* src = pr + C_KR + part * 32;
          const float inv = exp2f(-(float)i * (13.287712379549449f / 16.f)); float s, c; sincosf((part ? pcol : prow) * inv, &s, &c);
          const float x1 = bf2f(src[i]), x2 = bf2f(src[i + 16]);
          kr[part * 32 + i] = (bf16)f2bf(x1 * c - x2 * s); kr[part * 32 + i + 16] = (bf16)f2bf(x2 * c + x1 * s); }
    } else kr[lane] = pr[C_KR + lane];
}

__device__ __forceinline__ float allred16(float x) { return row_sum16(x); }
__device__ __forceinline__ int scan_row(int s, int dir, int b) {
    if (s < NCTX) return M_LAT + b * NCTX + (dir ? NCTX - 1 - s : s);
    const int t = s - NCTX; return b * SEQ + (dir ? SEQ - 1 - t : t);
}
__device__ __forceinline__ void rwkv_scan(Frame& F, int l, int chain) {
    F.tid = ltid(); F.lane = F.tid & 63;
    const int dir = chain >> 5, b = (chain >> 4) & 1, h = chain & 15;
    constexpr int CT = 24, NCHK = (NCTX + SEQ) / CT, STEPF = 392, BUFF = CT * STEPF;
    LAS float* buf = (LAS float*)F.lds; LAS float* ybuf = (LAS float*)(F.lds + 3 * BUFF * 4);
    gcbf RWF = (gcbf)(F.ws + WS_RWF); const size_t RS = (size_t)M_TOT * 1024;
    gflp YS = (gflp)(F.ws + WS_YS) + (size_t)dir * M_TOT * 1024;
    const bool cmp = F.wave < 4; const int lt = F.tid - 256, lst = lt >> 4, lq = lt & 15, lc = h * 64 + 4 * lq;
    const f32x4 ka4 = *(const GAS f32x4*)((gcfl)INP(I_KA) + l * 1024 + (cmp ? 0 : lc));
    v2u gr[2], gk[2], gv[2], gkk[2], ge[2], ga[2];
#pragma unroll
    for (int u = 0; u < 2; ++u) { gr[u] = (v2u){0u, 0u}; gk[u] = gr[u]; gv[u] = gr[u]; gkk[u] = gr[u]; ge[u] = gr[u]; ga[u] = gr[u]; }
#define RW_LOAD(c) do { if (!cmp) { _Pragma("unroll") for (int u_ = 0; u_ < 2; ++u_) { const int s_ = lst + 16 * u_; if (s_ < CT) { const size_t o_ = (size_t)scan_row((c) * CT + s_, dir, b) * 1024 + lc; \
        gr[u_] = *(const GAS v2u*)(RWF + 0 * RS + o_); gk[u_] = *(const GAS v2u*)(RWF + 1 * RS + o_); gv[u_] = *(const GAS v2u*)(RWF + 2 * RS + o_); \
        gkk[u_] = *(const GAS v2u*)(RWF + 3 * RS + o_); ge[u_] = *(const GAS v2u*)(RWF + (4 + dir) * RS + o_); ga[u_] = *(const GAS v2u*)(RWF + (6 + dir) * RS + o_); } } } } while (0)
#define RW_WRITE(bi) do { if (!cmp) { _Pragma("unroll") for (int u_ = 0; u_ < 2; ++u_) { const int s_ = lst + 16 * u_; if (s_ < CT) { LAS float* d_ = buf + (bi) * BUFF + s_ * STEPF + 4 * lq; \
        const float r_[4] = {bflo(gr[u_].x), bfhi(gr[u_].x), bflo(gr[u_].y), bfhi(gr[u_].y)}, k_[4] = {bflo(gk[u_].x), bfhi(gk[u_].x), bflo(gk[u_].y), bfhi(gk[u_].y)}, v_[4] = {bflo(gv[u_].x), bfhi(gv[u_].x), bflo(gv[u_].y), bfhi(gv[u_].y)}; \
        const float q_[4] = {bflo(gkk[u_].x), bfhi(gkk[u_].x), bflo(gkk[u_].y), bfhi(gkk[u_].y)}, e_[4] = {bflo(ge[u_].x), bfhi(ge[u_].x), bflo(ge[u_].y), bfhi(ge[u_].y)}, a_[4] = {bflo(ga[u_].x), bfhi(ga[u_].x), bflo(ga[u_].y), bfhi(ga[u_].y)}; \
        f32x4 w4, kd4, kk4, b4, wr4, v4; float sbr = 0.f, skr = 0.f; \
        _Pragma("unroll") for (int e = 0; e < 4; ++e) { w4[e] = __expf(-e_[e]); kd4[e] = k_[e] * (1.f + (a_[e] - 1.f) * ka4[e]); kk4[e] = q_[e]; b4[e] = q_[e] * a_[e]; wr4[e] = w4[e] * r_[e]; v4[e] = v_[e]; sbr += b4[e] * r_[e]; skr += kd4[e] * r_[e]; } \
        sbr = row_sum16(sbr); skr = row_sum16(skr); \
        *(LAS f32x4*)(d_) = w4; *(LAS f32x4*)(d_ + 64) = kd4; *(LAS f32x4*)(d_ + 128) = kk4; *(LAS f32x4*)(d_ + 192) = b4; *(LAS f32x4*)(d_ + 256) = wr4; *(LAS f32x4*)(d_ + 320) = v4; \
        if (lq == 0) *(LAS f32x2*)(buf + (bi) * BUFF + s_ * STEPF + 384) = (f32x2){sbr, skr}; } } } } while (0)
#define RW_FLUSH(c) do { if (!cmp) { _Pragma("unroll") for (int u_ = 0; u_ < 2; ++u_) { const int s_ = lst + 16 * u_; if (s_ < CT) { const f32x4 y_ = *(const LAS f32x4*)(ybuf + ((c) & 1) * (CT * 64) + s_ * 64 + 4 * lq); \
        *(GAS f32x4*)(YS + (size_t)scan_row((c) * CT + s_, dir, b) * 1024 + lc) = y_; } } } } while (0)
    __syncthreads();
    RW_LOAD(0); RW_WRITE(0); RW_LOAD(1); RW_WRITE(1); RW_LOAD(2);
    __syncthreads();
    const int kg = F.lane & 7, rg = F.lane >> 3, r0 = 16 * (F.wave & 3) + 2 * rg;
    f32x2 St[8];
#pragma unroll
    for (int i = 0; i < 8; ++i) St[i] = (f32x2){0.f, 0.f};
    int bc = 0, bw = 2;
#pragma unroll 1
    for (int c = 0; c < NCHK; ++c) {
        if (c + 2 < NCHK) { RW_WRITE(bw); if (c + 3 < NCHK) RW_LOAD(c + 3); }
        if (c > 0) RW_FLUSH(c - 1);
        if (cmp) {
        const LAS float* bb = buf + bc * BUFF + 8 * kg; const LAS float* vb = buf + bc * BUFF + 320 + r0; const LAS float* sb = buf + bc * BUFF + 384;
        LAS float* yb = ybuf + (c & 1) * (CT * 64) + r0;
        f32x4 w4[2], kd4[2], kk4[2], b4[2], wr4[2];
#pragma unroll
        for (int q = 0; q < 2; ++q) { w4[q] = *(const LAS f32x4*)(bb + 4 * q); kd4[q] = *(const LAS f32x4*)(bb + 64 + 4 * q); kk4[q] = *(const LAS f32x4*)(bb + 128 + 4 * q); b4[q] = *(const LAS f32x4*)(bb + 192 + 4 * q); wr4[q] = *(const LAS f32x4*)(bb + 256 + 4 * q); }
        f32x2 v2 = *(const LAS f32x2*)(vb), s2 = *(const LAS f32x2*)(sb);
#pragma unroll
        for (int st = 0; st < CT; ++st) {
            const int sn = (st + 1 < CT ? st + 1 : st) * STEPF;
            f32x4 nw4[2], nkd4[2], nkk4[2], nb4[2], nwr4[2];
#pragma unroll
            for (int q = 0; q < 2; ++q) { nw4[q] = *(const LAS f32x4*)(bb + sn + 4 * q); nkd4[q] = *(const LAS f32x4*)(bb + sn + 64 + 4 * q); nkk4[q] = *(const LAS f32x4*)(bb + sn + 128 + 4 * q); nb4[q] = *(const LAS f32x4*)(bb + sn + 192 + 4 * q); nwr4[q] = *(const LAS f32x4*)(bb + sn + 256 + 4 * q); }
            const f32x2 nv2 = *(const LAS f32x2*)(vb + sn), ns2 = *(const LAS f32x2*)(sb + sn);
#define PR(x, e) ((((e) >> 1) & 1) ? (f32x2){(x)[(e) >> 2][2], (x)[(e) >> 2][3]} : (f32x2){(x)[(e) >> 2][0], (x)[(e) >> 2][1]})
            f32x2 p, z, tpb, tzb;
            asm("v_pk_mul_f32 %0, %4, %12 op_sel:[0,0] op_sel_hi:[1,0]\n\tv_pk_mul_f32 %1, %4, %16 op_sel:[0,0] op_sel_hi:[1,0]\n\tv_pk_mul_f32 %2, %8, %14 op_sel:[0,0] op_sel_hi:[1,0]\n\tv_pk_mul_f32 %3, %8, %18 op_sel:[0,0] op_sel_hi:[1,0]\n\tv_pk_fma_f32 %0, %5, %12, %0 op_sel:[0,1,0] op_sel_hi:[1,1,1]\n\tv_pk_fma_f32 %1, %5, %16, %1 op_sel:[0,1,0] op_sel_hi:[1,1,1]\n\tv_pk_fma_f32 %2, %9, %14, %2 op_sel:[0,1,0] op_sel_hi:[1,1,1]\n\tv_pk_fma_f32 %3, %9, %18, %3 op_sel:[0,1,0] op_sel_hi:[1,1,1]\n\tv_pk_fma_f32 %0, %6, %13, %0 op_sel:[0,0,0] op_sel_hi:[1,0,1]\n\tv_pk_fma_f32 %1, %6, %17, %1 op_sel:[0,0,0] op_sel_hi:[1,0,1]\n\tv_pk_fma_f32 %2, %10, %15, %2 op_sel:[0,0,0] op_sel_hi:[1,0,1]\n\tv_pk_fma_f32 %3, %10, %19, %3 op_sel:[0,0,0] op_sel_hi:[1,0,1]\n\tv_pk_fma_f32 %0, %7, %13, %0 op_sel:[0,1,0] op_sel_hi:[1,1,1]\n\tv_pk_fma_f32 %1, %7, %17, %1 op_sel:[0,1,0] op_sel_hi:[1,1,1]\n\tv_pk_fma_f32 %2, %11, %15, %2 op_sel:[0,1,0] op_sel_hi:[1,1,1]\n\tv_pk_fma_f32 %3, %11, %19, %3 op_sel:[0,1,0] op_sel_hi:[1,1,1]\n\tv_pk_add_f32 %0, %0, %2\n\tv_pk_add_f32 %1, %1, %3\n\tv_pk_mul_f32 %4, %4, %20 op_sel:[0,0] op_sel_hi:[1,0]\n\tv_pk_mul_f32 %5, %5, %20 op_sel:[0,1] op_sel_hi:[1,1]\n\tv_pk_mul_f32 %6, %6, %21 op_sel:[0,0] op_sel_hi:[1,0]\n\tv_pk_mul_f32 %7, %7, %21 op_sel:[0,1] op_sel_hi:[1,1]\n\tv_pk_mul_f32 %8, %8, %22 op_sel:[0,0] op_sel_hi:[1,0]\n\tv_pk_mul_f32 %9, %9, %22 op_sel:[0,1] op_sel_hi:[1,1]\n\tv_pk_mul_f32 %10, %10, %23 op_sel:[0,0] op_sel_hi:[1,0]\n\tv_pk_mul_f32 %11, %11, %23 op_sel:[0,1] op_sel_hi:[1,1]\n\tv_pk_fma_f32 %4, %28, %24, %4 op_sel:[0,0,0] op_sel_hi:[1,0,1]\n\tv_pk_fma_f32 %5, %28, %24, %5 op_sel:[0,1,0] op_sel_hi:[1,1,1]\n\tv_pk_fma_f32 %6, %28, %25, %6 op_sel:[0,0,0] op_sel_hi:[1,0,1]\n\tv_pk_fma_f32 %7, %28, %25, %7 op_sel:[0,1,0] op_sel_hi:[1,1,1]\n\tv_pk_fma_f32 %8, %28, %26, %8 op_sel:[0,0,0] op_sel_hi:[1,0,1]\n\tv_pk_fma_f32 %9, %28, %26, %9 op_sel:[0,1,0] op_sel_hi:[1,1,1]\n\tv_pk_fma_f32 %10, %28, %27, %10 op_sel:[0,0,0] op_sel_hi:[1,0,1]\n\tv_pk_fma_f32 %11, %28, %27, %11 op_sel:[0,1,0] op_sel_hi:[1,1,1]"
                : "=&v"(p), "=&v"(z), "=&v"(tpb), "=&v"(tzb), "+v"(St[0]), "+v"(St[1]), "+v"(St[2]), "+v"(St[3]), "+v"(St[4]), "+v"(St[5]), "+v"(St[6]), "+v"(St[7])
                : "v"(PR(kk4, 0)), "v"(PR(kk4, 2)), "v"(PR(kk4, 4)), "v"(PR(kk4, 6)), "v"(PR(wr4, 0)), "v"(PR(wr4, 2)), "v"(PR(wr4, 4)), "v"(PR(wr4, 6)),
                  "v"(PR(w4, 0)), "v"(PR(w4, 2)), "v"(PR(w4, 4)), "v"(PR(w4, 6)), "v"(PR(kd4, 0)), "v"(PR(kd4, 2)), "v"(PR(kd4, 4)), "v"(PR(kd4, 6)), "v"(v2));
            float p0 = p.x, p1 = p.y, z0 = z.x, z1 = z.y;
#define D4(ctl) "v_add_f32_dpp %0, %0, %0 " ctl " row_mask:0xf bank_mask:0xf\n\tv_add_f32_dpp %1, %1, %1 " ctl " row_mask:0xf bank_mask:0xf\n\tv_add_f32_dpp %2, %2, %2 " ctl " row_mask:0xf bank_mask:0xf\n\tv_add_f32_dpp %3, %3, %3 " ctl " row_mask:0xf bank_mask:0xf\n\t"
            asm volatile("s_nop 1\n\t" D4("quad_perm:[1,0,3,2]") D4("quad_perm:[2,3,0,1]") D4("row_half_mirror") "s_nop 0"
                : "+v"(p0), "+v"(p1), "+v"(z0), "+v"(z1));
#undef D4
            const f32x2 pp = {p0, p1}, zz = {z0, z1};
            { f32x2 y;
              asm("v_pk_fma_f32 %0, %9, %11, %10 op_sel:[0,0,0] op_sel_hi:[1,0,1] neg_lo:[1,0,0] neg_hi:[1,0,0]\n\tv_pk_fma_f32 %0, %12, %11, %0 op_sel:[0,1,0] op_sel_hi:[1,1,1]\n\tv_pk_fma_f32 %1, %9, %13, %1 op_sel:[0,0,0] op_sel_hi:[1,0,1] neg_lo:[1,0,0] neg_hi:[1,0,0]\n\tv_pk_fma_f32 %2, %9, %13, %2 op_sel:[0,1,0] op_sel_hi:[1,1,1] neg_lo:[1,0,0] neg_hi:[1,0,0]\n\tv_pk_fma_f32 %3, %9, %14, %3 op_sel:[0,0,0] op_sel_hi:[1,0,1] neg_lo:[1,0,0] neg_hi:[1,0,0]\n\tv_pk_fma_f32 %4, %9, %14, %4 op_sel:[0,1,0] op_sel_hi:[1,1,1] neg_lo:[1,0,0] neg_hi:[1,0,0]\n\tv_pk_fma_f32 %5, %9, %15, %5 op_sel:[0,0,0] op_sel_hi:[1,0,1] neg_lo:[1,0,0] neg_hi:[1,0,0]\n\tv_pk_fma_f32 %6, %9, %15, %6 op_sel:[0,1,0] op_sel_hi:[1,1,1] neg_lo:[1,0,0] neg_hi:[1,0,0]\n\tv_pk_fma_f32 %7, %9, %16, %7 op_sel:[0,0,0] op_sel_hi:[1,0,1] neg_lo:[1,0,0] neg_hi:[1,0,0]\n\tv_pk_fma_f32 %8, %9, %16, %8 op_sel:[0,1,0] op_sel_hi:[1,1,1] neg_lo:[1,0,0] neg_hi:[1,0,0]"
                : "=&v"(y), "+v"(St[0]), "+v"(St[1]), "+v"(St[2]), "+v"(St[3]), "+v"(St[4]), "+v"(St[5]), "+v"(St[6]), "+v"(St[7])
                : "v"(pp), "v"(zz), "v"(s2), "v"(v2), "v"(PR(b4, 0)), "v"(PR(b4, 2)), "v"(PR(b4, 4)), "v"(PR(b4, 6)));
              *(LAS f32x2*)(yb + st * 64) = y; }
#undef PR
#pragma unroll
            for (int q = 0; q < 2; ++q) { w4[q] = nw4[q]; kd4[q] = nkd4[q]; kk4[q] = nkk4[q]; b4[q] = nb4[q]; wr4[q] = nwr4[q]; }
            v2 = nv2; s2 = ns2;
        }
        }
        __syncthreads();
        bc = bc == 2 ? 0 : bc + 1; bw = bw == 2 ? 0 : bw + 1;
    }
    RW_FLUSH(NCHK - 1);
#undef RW_LOAD
#undef RW_WRITE
#undef RW_FLUSH
}
__device__ __forceinline__ void rwkv_out_row(Frame& F, int l, int row) {
    F.tid = ltid(); F.lane = F.tid & 63;
    const int c0 = F.lane * 16; const float* yf = (const float*)(F.ws + WS_YS) + (size_t)row * 1024 + c0; const float* yb = yf + (size_t)M_TOT * 1024;
    float y[16]; float s = 0.f;
#pragma unroll
    for (int j = 0; j < 4; ++j) { const f32x4 a = __builtin_nontemporal_load((const f32x4*)(yf + 4 * j)), b = __builtin_nontemporal_load((const f32x4*)(yb + 4 * j));
#pragma unroll
        for (int e = 0; e < 4; ++e) { y[4 * j + e] = a[e] + b[e]; s += y[4 * j + e]; } }
    s = quad_sum(s); const float mu = s * (1.f / 64.f); float q = 0.f;
#pragma unroll
    for (int e = 0; e < 16; ++e) { y[e] -= mu; q += y[e] * y[e]; }
    q = quad_sum(q); const float rstd = 1.f / sqrtf(q * (1.f / 64.f) + GN_EPS);
    const bf16* RWF = (const bf16*)(F.ws + WS_RWF); const size_t RS = (size_t)M_TOT * 1024, o = (size_t)row * 1024 + c0;
    const float sbv = ((const float*)(F.ws + WS_SB))[(size_t)row * 16 + (F.lane >> 2)];
    const float* lg = INP(I_LNG) + l * 1024 + c0; const float* lb = INP(I_LNB) + l * 1024 + c0;
    bf16* dst = (bf16*)(F.ws + WS_MIX) + (size_t)row * DM + 3072 + c0;
#pragma unroll
    for (int hf = 0; hf < 2; ++hf) { const v4u vv = *(const v4u*)(RWF + 2 * RS + o + 8 * hf), gg = *(const v4u*)(RWF + 8 * RS + o + 8 * hf); float r[8];
#pragma unroll
        for (int w = 0; w < 4; ++w) { const int e = 8 * hf + 2 * w;
            r[2 * w] = (y[e] * rstd * lg[e] + lb[e] + sbv * bflo(vv[w])) * bflo(gg[w]); r[2 * w + 1] = (y[e + 1] * rstd * lg[e + 1] + lb[e + 1] + sbv * bfhi(vv[w])) * bfhi(gg[w]); }
        v4u ov; ov.x = pk2(r[0], r[1]); ov.y = pk2(r[2], r[3]); ov.z = pk2(r[4], r[5]); ov.w = pk2(r[6], r[7]); *(v4u*)(dst + 8 * hf) = ov; }
}

#ifndef W_OUT_K1
#define W_OUT_K1 2048
#endif
struct MlaTiles { gcbf KV; gcbf KR; int ctx_row0, lat_row0, h;
    __device__ __forceinline__ att::Tile operator()(int j) const { const int row = j < 4 ? ctx_row0 + 64 * j : lat_row0 + 64 * (j - 4);
        att::Tile t; t.kn = KV + (size_t)row * 2048 + h * 256; t.v = t.kn + 128; t.kr = KR + (size_t)row * 64; t.mtype = 0; t.krel0 = 0; return t; } };
struct SwaTiles { gcbf P; int blk_row0, ctx_row0, kvh, nwin, has_prev, has_next;
    __device__ __forceinline__ att::Tile operator()(int j) const { att::Tile t; int row; t.mtype = 0; t.krel0 = 0;
        if (j >= nwin) row = ctx_row0 + 64 * (j - nwin);
        else if (j < 2) row = blk_row0 + 64 * j;
        else if (has_prev && j < 4) { row = blk_row0 - 128 + 64 * (j - 2); t.mtype = 1; t.krel0 = -128 + 64 * (j - 2); }
        else { const int sub = j - 2 - 2 * has_prev; row = blk_row0 + 128 + 64 * sub; t.mtype = 2; t.krel0 = 128 + 64 * sub; }
        t.kn = P + (size_t)row * DINP + C_SWAK + kvh * 128; t.v = P + (size_t)row * DINP + C_SWAV + kvh * 128; t.kr = nullptr; return t; } };

#ifndef MLA_SDEPTH
#define MLA_SDEPTH 1
#endif
__device__ __forceinline__ void mla_item(Frame& F, int b, int h, int qb, bool ctxq) {
    F.tid = ltid(); F.lane = F.tid & 63;
    const int r32 = F.lane & 31; const int t = qb * 256 + F.wave * 32 + r32;
    const int roww0 = ctxq ? M_LAT + b * NCTX + F.wave * 32 : b * SEQ + qb * 256 + F.wave * 32;
    gcbf Qw = (gcbf)(F.ws + WS_Q) + (size_t)(roww0 + r32) * 1536 + h * 192;
    MlaTiles ts{(gcbf)(F.ws + WS_KV), (gcbf)(F.ws + WS_KR), M_LAT + b * NCTX, b * SEQ, h};
    gbfp Ow = (gbfp)(F.ws + WS_MIX) + (size_t)roww0 * DM + 2048 + h * 128;
    att::attn_body<192, 2048, 2048, false, false, MLA_SDEPTH>(Qw, ctxq ? 0 : 1, t >> 6, t & 63, (gcfl)(F.ws + WS_ROPE), 0, 0.f, ts, ctxq ? 4 : 132, Ow, (LAS char*)F.lds);
}
__device__ __forceinline__ void swa_item(Frame& F, int l, int b, int n, int kvh, int half, bool ctxq, int hq_ctx) {
    F.tid = ltid(); F.lane = F.tid & 63;
    const int r32 = F.lane & 31; gcbf P = (gcbf)(F.ws + WS_P);
    int hq, qi, roww0, t;
    if (ctxq) { hq = hq_ctx; kvh = hq >> 2; qi = 0; roww0 = M_LAT + b * NCTX + F.wave * 32; t = 0; }
    else { hq = kvh * 4 + 2 * half + (F.wave >> 2); qi = (F.wave & 3) * 32 + r32; roww0 = b * SEQ + n * 128 + (F.wave & 3) * 32; t = n * 128 + qi; }
    gcbf Qw = P + (size_t)(roww0 + r32) * DINP + C_SWAQ + hq * 128;
    SwaTiles ts; ts.P = P; ts.blk_row0 = b * SEQ + n * 128; ts.ctx_row0 = M_LAT + b * NCTX; ts.kvh = kvh;
    ts.has_prev = (!ctxq && n > 0) ? 1 : 0; ts.has_next = (!ctxq && n < SEQ / 128 - 1) ? 1 : 0; ts.nwin = ctxq ? 0 : 2 + 2 * ts.has_prev + 2 * ts.has_next;
    gbfp Ow = (gbfp)(F.ws + WS_MIX) + (size_t)roww0 * DM + hq * 128;
    const float sink_l2 = INP(I_SINK)[l * 8 + hq] * 1.4426950408889634f;
    att::attn_body<128, DINP, DINP, true, true, 2>(Qw, 0, 0, 0, (gcfl)nullptr, qi, sink_l2, ts, ts.nwin + 4, Ow, (LAS char*)F.lds);
}

#ifndef DBG_PHASES
#define DBG_PHASES 0xfffff
#endif
#define PH(n) ((DBG_PHASES >> (n)) & 1)
#ifndef DUP_PHASES
#define DUP_PHASES 0
#endif
#define REP(n) _Pragma("unroll") for (int rep_ = 0; rep_ < (((DUP_PHASES >> (n)) & 1) ? 2 : 1); ++rep_)
__global__ void __launch_bounds__(NTHR, 2) mk_fwd(Args args) {
    extern __shared__ __attribute__((aligned(16))) unsigned char lds[];
    Frame F;
    F.lds = (LAS unsigned char*)lds;
    F.tid = threadIdx.x; F.lane = F.tid & 63; F.wave = __builtin_amdgcn_readfirstlane(F.tid >> 6);
    F.G = gridDim.x; { const int bx = blockIdx.x; F.vcu = (F.G % 8 == 0) ? (bx % 8) * (F.G / 8) + bx / 8 : bx; }
    F.gw = F.vcu * NWAVES + F.wave; F.NGW = F.G * NWAVES;
    F.ws = args.ws; F.out = args.out; F.ctl = (gu32*)(args.ws + WS_CTL);
    F.A = (const __attribute__((address_space(4))) Args*)__builtin_amdgcn_kernarg_segment_ptr();
    for (int u = F.tid; u < (LDS_BYTES - LDSCTL_OFF) / 4; u += NTHR) ((LAS unsigned*)(F.lds + LDSCTL_OFF))[u] = 0u;
    __syncthreads();
    XcdBarrier bar = xcd_barrier_post((unsigned*)(args.ws + WS_CTL) + 4096, (volatile LAS unsigned*)(F.lds + MISC_OFF) + 8);
    const bool rwkv_blk = (blockIdx.x & 3) == 0;
    XcdBarrier bar2; bar2.bar = (unsigned*)(args.ws + WS_CTL) + 8192; bar2.x = 0; bar2.st = (volatile LAS unsigned*)(F.lds + MISC_OFF) + 12; bar2.nparts = gridDim.x - ((gridDim.x + 3) >> 2);
    if (!rwkv_blk) { const unsigned np_ = bar2.nparts; bar2 = xcd_barrier_post((unsigned*)(args.ws + WS_CTL) + 8192, (volatile LAS unsigned*)(F.lds + MISC_OFF) + 12); bar2.nparts = np_; }
#define SUB_BAR() do { bar2.bar = launder(bar2.bar); bar2.x = launder(bar2.x); xcd_barrier(bar2); F.ws = launder_g(F.ws); F.wsw = F.ws + (size_t)lcur * WSET_STRIDE; F.A = launder(F.A); F.tid = ltid(); F.lane = F.tid & 63; } while (0)
#define GRID_BAR() do { bar.bar = launder(bar.bar); bar.x = launder(bar.x); xcd_barrier(bar); F.ws = launder_g(F.ws); F.wsw = F.ws + (size_t)lcur * WSET_STRIDE; F.A = launder(F.A); F.tid = ltid(); F.lane = F.tid & 63; } while (0)
    const int bx = blockIdx.x; int lcur = 0; F.wsw = F.ws;
    bf16* H = (bf16*)(F.ws + WS_H); xres_t* X = (xres_t*)(F.ws + WS_X);

    REP(0) if (PH(0)) { mod_partials(F);
    convert_weights(F, 0, F.gw, F.NGW); }
    GRID_BAR();
    if (PH(1)) { mod_reduce(F); rope_table(F); }
    GRID_BAR();

#pragma unroll 1
    for (int l = 0; l < 2; ++l) {
        lcur = l; F.wsw = F.ws + (size_t)l * WSET_STRIDE;
        const bool wctx = (l == 0);
        const int MO = wctx ? M_TOT : M_LAT;
        if (PH(2) && l == 0) {
            int cs = -1;
            for (int row = F.gw; row < M_TOT; row += F.NGW) { const int s = row_s(row);
                if (s != cs) { __syncthreads(); ln_stage(F, LNV_SC, mod_ptr(F, 0, s, 1)); ln_stage(F, LNV_SH, mod_ptr(F, 0, s, 0)); __syncthreads(); cs = s; }
                const float* xs = row < M_LAT ? INP(I_X) + (size_t)row * DM : INP(I_CTX) + (size_t)(row - M_LAT) * DM;
                ln_row<0>(F, xs, nullptr, nullptr, true, H + (size_t)row * DM); }
            __syncthreads();
        }
        GRID_BAR();
        REP(3) if (PH(3)) { pg8::Gemm g{H, (const bf16*)(F.wsw + WS_WIN), M_TOT, DINP, DM, DM, DM}; pg8::StaticOrder S; S.init(M_TOT, DINP, F.G, bx);
          pg8::EpiBf16<0> E{(bf16*)(F.ws + WS_P), DINP, nullptr};
          pg8::gemm_phase<pg8::EpiBf16<0>, pg8::StaticOrder, true, true>(F.lds, g, S, E); }
        GRID_BAR();
        REP(4) if (PH(4)) for (int it = F.vcu; it < 528; it += F.G) rwkv_feat_item(F, l, it);
        REP(5) if (PH(5)) { if (F.G == 256) { if (F.vcu < 16) { for (int it = F.vcu; it < 64; it += 16) lru_item<false>(F, l, it); }
                                              else { for (int it = 64 + F.vcu - 16; it < 2 * NCH * 8; it += 240) lru_item<false>(F, l, it); } }
                            else for (int it = F.vcu; it < 2 * NCH * 8; it += F.G) lru_item<false>(F, l, it); }
        __syncthreads();
        if (PH(6)) for (int row = F.gw; row < M_TOT; row += F.NGW) row_prep(F, row);
        GRID_BAR();
        REP(8) if (rwkv_blk) { const int nrw = (F.G + 3) >> 2; REP(18) if (PH(8)) for (int chain = bx >> 2; chain < 64; chain += nrw) rwkv_scan(F, l, chain); }
        else REP(19) { const int x8 = bx & 7, naw = F.G - ((F.G + 3) >> 2);
            const int aw = (F.G == 256) ? ((x8 < 4 ? x8 - 1 : x8 - 2) * 32 + (bx >> 3)) : ((bx >> 2) * 3 + (bx & 3) - 1);
            if (PH(7) && aw < 8) lru_carry(F, aw);
            if (PH(7)) { pg8::Gemm g{(const bf16*)(F.ws + WS_P) + C_QA, (const bf16*)(F.wsw + WS_WQB), M_TOT, 1536, 1024, DINP, 1024}; pg8::StaticOrder S; S.init(M_TOT, 1536, naw, aw);
              pg8::EpiBf16<2> E{(bf16*)(F.ws + WS_Q), 1536, (const float*)(F.ws + WS_RSQ)};
              pg8::gemm_phase<pg8::EpiBf16<2>, pg8::StaticOrder, true, true>(F.lds, g, S, E); }
            if (PH(7)) { pg8::Gemm g{(const bf16*)(F.ws + WS_P) + C_KVA, (const bf16*)(F.wsw + WS_WKVB), M_TOT, 2048, 512, DINP, 512}; pg8::StaticOrder S; S.init(M_TOT, 2048, naw, aw);
              pg8::EpiBf16<2> E{(bf16*)(F.ws + WS_KV), 2048, (const float*)(F.ws + WS_RSKV)};
              pg8::gemm_phase<pg8::EpiBf16<2>, pg8::StaticOrder, true, true>(F.lds, g, S, E); }
            SUB_BAR();
            if (PH(9)) for (int it = aw; it < 512; it += naw) mla_item(F, it >> 8, (it >> 5) & 7, it & 31, false);
            if (PH(9) && wctx) for (int it = aw; it < 16; it += naw) mla_item(F, it >> 3, it & 7, 0, true);
            if (PH(10)) for (int it = aw; it < 512; it += naw) swa_item(F, l, it >> 8, (it >> 2) & 63, (it >> 1) & 1, it & 1, false, 0);
            if (PH(10) && wctx) for (int it = aw; it < 16; it += naw) swa_item(F, l, it >> 3, 0, 0, 0, true, it & 7);
            if (PH(11)) { if (naw == 192) { const int i0 = aw < 128 ? aw : 1280 + aw - 128, st_ = aw < 128 ? 128 : 64, i1 = aw < 128 ? 1280 : 2 * NCH * 8;
                                            for (int it = i0; it < i1; it += st_) { if (!wctx && ((it >> 3) % NCH) < 8) continue; lru_item<true>(F, l, it); } }
                          else for (int it = aw; it < 2 * NCH * 8; it += naw) { if (!wctx && ((it >> 3) % NCH) < 8) continue; lru_item<true>(F, l, it); } }
            if (l == 0) { __syncthreads(); convert_weights(F, 1, aw * NWAVES + F.wave, naw * NWAVES); }
            else { SUB_BAR();
                pg8::Gemm g{(const bf16*)(F.ws + WS_MIX), (const bf16*)(F.wsw + WS_WOUT), M_LAT, DM, W_OUT_K1, DM, DM}; pg8::StaticOrder S; S.init(M_LAT, DM, naw, aw);
                pg8::EpiBf16<0> E{(bf16*)(F.ws + WS_Y1), DM, nullptr};
                pg8::gemm_phase<pg8::EpiBf16<0>, pg8::StaticOrder, true, true>(F.lds, g, S, E); }
        }
        GRID_BAR();
        REP(12) if (PH(12)) for (int row = F.gw; row < MO; row += F.NGW) rwkv_out_row(F, l, row);
        GRID_BAR();
        REP(13) if (PH(13)) {
          if (l == 0) { pg8::Gemm g{(const bf16*)(F.ws + WS_MIX), (const bf16*)(F.wsw + WS_WOUT), M_LAT, DM, DM, DM, DM}; pg8::StaticOrder S; S.init(M_LAT, DM, F.G, bx);
            pg8::EpiBf16<0> E{(bf16*)(F.ws + WS_Y1), DM, nullptr};
            pg8::gemm_phase<pg8::EpiBf16<0>, pg8::StaticOrder, true, true>(F.lds, g, S, E); }
          else { pg8::Gemm g{(const bf16*)(F.ws + WS_MIX) + W_OUT_K1, (const bf16*)(F.wsw + WS_WOUT) + W_OUT_K1, M_LAT, DM, DM - W_OUT_K1, DM, DM}; pg8::StaticOrder S; S.init(M_LAT, DM, F.G, bx);
            pg8::EpiBf16<3> E{(bf16*)(F.ws + WS_Y1), DM, nullptr};
            pg8::gemm_phase<pg8::EpiBf16<3>, pg8::StaticOrder, true, true>(F.lds, g, S, E); }
          if (wctx) {
              pg8::Gemm g2{(const bf16*)(F.ws + WS_MIX) + (size_t)M_LAT * DM, (const bf16*)(F.wsw + WS_WOUT), M_CTX, DM, DM / 8, DM, DM}; pg8::SplitOrder S2; S2.init(M_CTX, DM, DM / 8, bx);
              pg8::EpiF32 E2{(float*)(F.ws + WS_YP), DM, (size_t)M_CTX * DM};
              pg8::gemm_phase<pg8::EpiF32, pg8::SplitOrder, true, true>(F.lds, g2, S2, E2); } }
        GRID_BAR();
        if (PH(14)) { int cs = -1;
          for (int row = F.gw; row < MO; row += F.NGW) { const int s = row_s(row);
            if (s != cs) { __syncthreads(); if (cs < 0) { ln_stage(F, LNV_G, INP(I_LN1G) + l * DM); ln_stage(F, LNV_B, INP(I_LN1B) + l * DM); }
                ln_stage(F, LNV_GA, mod_ptr(F, l, s, 2)); ln_stage(F, LNV_SC, mod_ptr(F, l, s, 4)); ln_stage(F, LNV_SH, mod_ptr(F, l, s, 3)); __syncthreads(); cs = s; }
            bf16* yrow = (bf16*)(F.ws + WS_Y1) + (size_t)row * DM;
            if (row >= M_LAT) sum_partials_row(F, (const float*)(F.ws + WS_YP) + (size_t)(row - M_LAT) * DM, (size_t)M_CTX * DM, yrow);
            if (l == 0) { const float* xs = row < M_LAT ? INP(I_X) + (size_t)row * DM : INP(I_CTX) + (size_t)(row - M_LAT) * DM;
                ln_row<1, false, XH16>(F, xs, yrow, X + (size_t)row * DM, true, H + (size_t)row * DM); }
            else ln_row<1, XH16, XH16>(F, X + (size_t)row * DM, yrow, X + (size_t)row * DM, true, H + (size_t)row * DM); }
          __syncthreads(); }
        GRID_BAR();
        REP(15) if (PH(15)) { pg8::Gemm g{H, (const bf16*)(F.wsw + WS_WFF1), MO, DFF, DM, DM, DM}; pg8::StaticOrder S; S.init(MO, DFF, F.G, bx);
          pg8::EpiBf16<1> E{(bf16*)(F.ws + WS_HID), DFF, nullptr};
          pg8::gemm_phase<pg8::EpiBf16<1>, pg8::StaticOrder, true, true>(F.lds, g, S, E); }
        GRID_BAR();
        REP(16) if (PH(16)) { pg8::Gemm g{(const bf16*)(F.ws + WS_HID), (const bf16*)(F.wsw + WS_WFF2), M_LAT, DM, DFF, DFF, DFF}; pg8::StaticOrder S; S.init(M_LAT, DM, F.G, bx);
          pg8::EpiBf16<0> E{(bf16*)(F.ws + WS_Y2), DM, nullptr};
          pg8::gemm_phase<pg8::EpiBf16<0>, pg8::StaticOrder, true, true>(F.lds, g, S, E);
          if (wctx) {
              pg8::Gemm g2{(const bf16*)(F.ws + WS_HID) + (size_t)M_LAT * DFF, (const bf16*)(F.wsw + WS_WFF2), M_CTX, DM, DFF / 8, DFF, DFF}; pg8::SplitOrder S2; S2.init(M_CTX, DM, DFF / 8, bx);
              pg8::EpiF32 E2{(float*)(F.ws + WS_YP), DM, (size_t)M_CTX * DM};
              pg8::gemm_phase<pg8::EpiF32, pg8::SplitOrder, true, true>(F.lds, g2, S2, E2); } }
        GRID_BAR();
        if (!PH(17)) {} else if (l == 0) { int cs = -1;
            for (int row = F.gw; row < M_TOT; row += F.NGW) { const int s = row_s(row);
                if (s != cs) { __syncthreads(); if (cs < 0) { ln_stage(F, LNV_G, INP(I_LN2G)); ln_stage(F, LNV_B, INP(I_LN2B)); }
                    ln_stage(F, LNV_GA, mod_ptr(F, 0, s, 5)); ln_stage(F, LNV_SC, mod_ptr(F, 1, s, 1)); ln_stage(F, LNV_SH, mod_ptr(F, 1, s, 0)); __syncthreads(); cs = s; }
                bf16* yrow = (bf16*)(F.ws + WS_Y2) + (size_t)row * DM;
                if (row >= M_LAT) sum_partials_row(F, (const float*)(F.ws + WS_YP) + (size_t)(row - M_LAT) * DM, (size_t)M_CTX * DM, yrow);
                ln_row<1, XH16, XH16>(F, X + (size_t)row * DM, yrow, X + (size_t)row * DM, true, H + (size_t)row * DM); }
            __syncthreads();
        } else { int cs = -1;
            for (int row = F.gw; row < M_LAT; row += F.NGW) { const int s = row_s(row);
                if (s != cs) { __syncthreads(); if (cs < 0) { ln_stage(F, LNV_G, INP(I_LN2G) + DM); ln_stage(F, LNV_B, INP(I_LN2B) + DM); }
                    ln_stage(F, LNV_GA, mod_ptr(F, 1, s, 5)); __syncthreads(); cs = s; }
                ln_row<1, XH16, false>(F, X + (size_t)row * DM, (const bf16*)(F.ws + WS_Y2) + (size_t)row * DM, F.out + (size_t)row * DM, false, nullptr); }
        }
    }
}

extern "C" void kernel_launch(void* const* d_in, const int* in_sizes, int n_in, void* d_out, int out_size, void* d_ws, size_t ws_size, hipStream_t stream) {
    static int grid = 0;
    if (grid == 0) {
        if (n_in != 38 || out_size != M_LAT * DM || ws_size < WS_END) { fprintf(stderr, "kernel_launch: unexpected shapes: n_in %d out %d ws %zu (need %zu)\n", n_in, out_size, ws_size, (size_t)WS_END); grid = -1; return; }
        int dev = 0, cus = 0, per_cu = 0;
        if (hipGetDevice(&dev) != hipSuccess || hipDeviceGetAttribute(&cus, hipDeviceAttributeMultiprocessorCount, dev) != hipSuccess) { grid = -1; return; }
        if (hipFuncSetAttribute((const void*)mk_fwd, hipFuncAttributeMaxDynamicSharedMemorySize, LDS_BYTES) != hipSuccess) { fprintf(stderr, "kernel_launch: hipFuncSetAttribute failed\n"); grid = -1; return; }
        if (hipOccupancyMaxActiveBlocksPerMultiprocessor(&per_cu, (const void*)mk_fwd, NTHR, LDS_BYTES) != hipSuccess || per_cu < 1) fprintf(stderr, "kernel_launch: occupancy query says %d\n", per_cu);
        (void)hipGetLastError();
        grid = cus;
    }
    if (grid < 0) return;
    if (hipMemsetAsync((char*)d_ws + WS_CTL, 0, CTL_ZERO_BYTES, stream) != hipSuccess) return;
    Args a{};
    for (int i = 0; i < 38; ++i) a.in[i] = (const float*)d_in[i];
    a.out = (float*)d_out; a.ws = (unsigned char*)d_ws;
    hipLaunchKernelGGL(mk_fwd, dim3(grid), dim3(NTHR), LDS_BYTES, stream, a);
    const hipError_t le = hipPeekAtLastError();
    if (le != hipSuccess) fprintf(stderr, "kernel_launch: launch failed: %s\n", hipGetErrorName(le));
}
```

```cpp
#include <hip/hip_runtime.h>
#include <hip/hip_bf16.h>
#include <cstdio>
#include <cstdint>

namespace pg8 {
#define PG8_LAS __attribute__((address_space(3)))
typedef unsigned short bf16_t;
typedef short bf16x8 __attribute__((ext_vector_type(8)));
typedef float f32x4 __attribute__((ext_vector_type(4)));
typedef unsigned u32x4 __attribute__((ext_vector_type(4)));
constexpr int BM = 256, BK = 64, HALF = 128, HTB = HALF * BK * 2  , STAGE_BYTES = 8 * HTB, NXCD = 8, WGM = 8;

__host__ __device__ __forceinline__ int lds_byte(int r, int c) { const int st = (r >> 4) * 2 + (c >> 5), rr = r & 15, cc = c & 31, ob = rr * 64 + cc * 2; return st * 1024 + (ob ^ (((ob >> 9) & 1) << 5)); }
__host__ __device__ __forceinline__ void stage_rc(int b, int& R, int& C) { const int st = b / 1024, sb = b % 1024, swz = sb ^ (((sb >> 9) & 1) << 5); R = (st >> 1) * 16 + swz / 64; C = (st & 1) * 32 + (swz % 64) / 2; }
__host__ __device__ __forceinline__ int perm32(int rho) { const int n = rho >> 4, i = rho & 15; return 8 * (i >> 2) + 4 * n + (i & 3); }

struct Unit { int pm, pn, ko, ks; };
struct Gemm { const bf16_t* A; const bf16_t* Bt; int M, N, K, lda, ldb; };

struct StaticOrder {
    int nM, nN, nwg, G, c;
    __host__ __device__ void init(int M, int N, int G_, int c_) { nM = M / BM; nN = N / BM; nwg = nM * nN; G = G_; c = c_; }
    __host__ __device__ bool next(int i, Unit& u) const {
        const long L = (long)i * G + c; if (L >= nwg) return false;
        int wgid = (int)L; { const int q = nwg / NXCD, r = nwg % NXCD, xcd = wgid % NXCD, off = wgid / NXCD; wgid = (xcd < r ? xcd * (q + 1) : r * (q + 1) + (xcd - r) * q) + off; }
        const int nig = WGM * nN, gid = wgid / nig, fm = gid * WGM, gsz = (nM - fm) < WGM ? (nM - fm) : WGM;
        u.pm = fm + ((wgid % nig) % gsz); u.pn = (wgid % nig) / gsz; u.ko = 0; u.ks = 0; return true;
    }
    __device__ __forceinline__ void a_ready(const Unit&) const {}
    __device__ __forceinline__ void done(const Unit&) const {}
};
struct SplitOrder {
    int nN, nitems, kslice, c;
    __host__ __device__ void init(int M, int N, int Kslice, int c_) { nN = N / BM; nitems = (M / BM) * nN * 8; kslice = Kslice; c = c_; }
    __host__ __device__ bool next(int i, Unit& u) const { if (i > 0 || c >= nitems) return false; u.ks = c & 7; u.ko = u.ks * kslice; u.pn = (c >> 3) % nN; u.pm = (c >> 3) / nN; return true; }
    __device__ __forceinline__ void a_ready(const Unit&) const {}
    __device__ __forceinline__ void done(const Unit&) const {}
};

__device__ __forceinline__ unsigned cvt_pk_bf16(float lo, float hi) { unsigned r; asm volatile("v_cvt_pk_bf16_f32 %0, %1, %2" : "=v"(r) : "v"(lo), "v"(hi)); return r; }

struct EpiF32 {
    static constexpr bool PERM = false, AFTER_DRAIN = false;
    float* C; int ldc; size_t split_stride;
    __device__ __forceinline__ void operator()(const f32x4 (&acc)[2][2][4][2], const Unit& u, int wr, int wc, int fr, int fq) const {
        const int row0 = u.pm * BM + wr * 64 + fr, col0 = u.pn * BM + wc * 32 + 4 * fq; float* Cb = C + (size_t)u.ks * split_stride;
#pragma unroll
        for (int ai = 0; ai < 2; ++ai)
#pragma unroll
            for (int m = 0; m < 4; ++m) { float* rowp = Cb + (size_t)(row0 + ai * HALF + m * 16) * ldc + col0;
#pragma unroll
                for (int bj = 0; bj < 2; ++bj)
#pragma unroll
                    for (int n = 0; n < 2; ++n) *(f32x4*)(rowp + bj * HALF + n * 16) = acc[ai][bj][m][n]; }
    }
};
template <int ACT> struct EpiBf16 {
    static constexpr bool PERM = true, AFTER_DRAIN = false;
    bf16_t* O; int ldc; const float* rowscale;
    __device__ __forceinline__ void operator()(const f32x4 (&acc)[2][2][4][2], const Unit& u, int wr, int wc, int fr, int fq) const {
        const int row0 = u.pm * BM + wr * 64 + fr; const int col0 = u.pn * BM + wc * 32 + 8 * fq;
#pragma unroll
        for (int ai = 0; ai < 2; ++ai)
#pragma unroll
            for (int m = 0; m < 4; ++m) { const int row = row0 + ai * HALF + m * 16; bf16_t* rowp = O + (size_t)row * ldc + col0;
                float rs = 1.f; if (ACT == 2) rs = rowscale[row];
#pragma unroll
                for (int bj = 0; bj < 2; ++bj) { f32x4 v0 = acc[ai][bj][m][0], v1 = acc[ai][bj][m][1];
                    if (ACT == 1) {
#pragma unroll
                        for (int j = 0; j < 4; ++j) { const float a = fmaxf(v0[j], 0.f), b = fmaxf(v1[j], 0.f); v0[j] = a * a; v1[j] = b * b; } }
                    if (ACT == 2) { v0 = v0 * rs; v1 = v1 * rs; }
                    if (ACT == 3) { const u32x4 o = *(const u32x4*)(rowp + bj * HALF);
                        v0[0] += __builtin_bit_cast(float, o.x << 16); v0[1] += __builtin_bit_cast(float, o.x & 0xffff0000u); v0[2] += __builtin_bit_cast(float, o.y << 16); v0[3] += __builtin_bit_cast(float, o.y & 0xffff0000u);
                        v1[0] += __builtin_bit_cast(float, o.z << 16); v1[1] += __builtin_bit_cast(float, o.z & 0xffff0000u); v1[2] += __builtin_bit_cast(float, o.w << 16); v1[3] += __builtin_bit_cast(float, o.w & 0xffff0000u); }
                    u32x4 w; w.x = cvt_pk_bf16(v0[0], v0[1]); w.y = cvt_pk_bf16(v0[2], v0[3]); w.z = cvt_pk_bf16(v1[0], v1[1]); w.w = cvt_pk_bf16(v1[2], v1[3]);
                    *(u32x4*)(rowp + bj * HALF) = w; } }
    }
};

template <class Epi, class Sched, bool ALIGN_EPI = false, bool SP2 = false>
__device__ __forceinline__ void gemm_phase(PG8_LAS unsigned char* lds, const Gemm g, const Sched& S, const Epi& E) {
    int tid = threadIdx.x; asm volatile("" : "+v"(tid));
    const int wid = __builtin_amdgcn_readfirstlane(tid >> 6), lane = tid & 63, wr = wid >> 2, wc = wid & 3, fr = lane & 15, fq = lane >> 4;
    const int K = g.K, nt = K / BK, lda = g.lda, ldb = g.ldb;
    unsigned voffA[2], voffB[2];
#pragma unroll
    for (int i = 0; i < 2; ++i) { int R, C; stage_rc(tid * 16 + i * 8192, R, C); const int Rb = Epi::PERM ? ((R & ~31) + perm32(R & 31)) : R;
        voffA[i] = (unsigned)(R * lda + C) * 2u; voffB[i] = (unsigned)(Rb * ldb + C) * 2u; }
    const size_t kstep = (size_t)(BK * 2);
    const size_t hstepA = (size_t)HALF * lda * 2, hstepB = (size_t)HALF * ldb * 2;
    const size_t tstepA = 2 * hstepA, tstepB = 2 * hstepB;
    const unsigned ldsw = (unsigned)wid * 1024u;
    const int aoff = lds_byte(wr * 64 + fr, fq * 8), boff = lds_byte(wc * 32 + fr, fq * 8);
#define PG8_SA(b, h) (((b) * 2 + (h)) * HTB)
#define PG8_SB(b, h) ((4 + (b) * 2 + (h)) * HTB)
#define PG8_STAGE(bufoff, gbase, voff) do { _Pragma("unroll") for (int _i = 0; _i < 2; ++_i) \
        __builtin_amdgcn_global_load_lds((const unsigned*)((const char*)(gbase) + (voff)[_i]), (PG8_LAS unsigned*)(lds + (bufoff) + ldsw + _i * 8192), 16, 0, 0); } while (0)
#define PG8_LDA(dst, b, h) do { _Pragma("unroll") for (int m = 0; m < 4; ++m) _Pragma("unroll") for (int k = 0; k < 2; ++k) dst[m][k] = *(const PG8_LAS bf16x8*)(lds + PG8_SA(b, h) + aoff + m * 2048 + k * 1024); } while (0)
#define PG8_LDB(dst, b, h) do { _Pragma("unroll") for (int n = 0; n < 2; ++n) _Pragma("unroll") for (int k = 0; k < 2; ++k) dst[n][k] = *(const PG8_LAS bf16x8*)(lds + PG8_SB(b, h) + boff + n * 2048 + k * 1024); } while (0)
#define PG8_MMA(ai, bj, At, Bt) do { __builtin_amdgcn_s_setprio(1); _Pragma("unroll") for (int m = 0; m < 4; ++m) _Pragma("unroll") for (int n = 0; n < 2; ++n) _Pragma("unroll") for (int k = 0; k < 2; ++k) \
        acc[ai][bj][m][n] = __builtin_amdgcn_mfma_f32_16x16x32_bf16(Bt[n][k], At[m][k], acc[ai][bj][m][n], 0, 0, 0); __builtin_amdgcn_s_setprio(0); } while (0)
#define PG8_WAIT_V(n) asm volatile("s_waitcnt vmcnt(" #n ")" ::: "memory")
#define PG8_WAIT_L(n) asm volatile("s_waitcnt lgkmcnt(" #n ")" ::: "memory")
#define PG8_BAR __builtin_amdgcn_s_barrier()
#define PG8_SCHED __builtin_amdgcn_sched_barrier(0)
    Unit cur, nxt; int ui = 0;
    if (!S.next(0, cur)) return;
    f32x4 acc[2][2][4][2];
#pragma unroll
    for (int a = 0; a < 2; ++a)
#pragma unroll
        for (int b = 0; b < 2; ++b)
#pragma unroll
            for (int m = 0; m < 4; ++m)
#pragma unroll
                for (int n = 0; n < 2; ++n) acc[a][b][m][n] = (f32x4){0.f, 0.f, 0.f, 0.f};
    bf16x8 At[4][2], B0[2][2], B1[2][2];
    const char* cA = (const char*)g.A + (size_t)cur.pm * tstepA + (size_t)cur.ko * 2; const char* cB = (const char*)g.Bt + (size_t)cur.pn * tstepB + (size_t)cur.ko * 2;
    S.a_ready(cur);
    if constexpr (SP2) {
        PG8_STAGE(PG8_SB(0, 0), cB, voffB); PG8_STAGE(PG8_SB(0, 1), cB + hstepB, voffB); PG8_STAGE(PG8_SA(0, 0), cA, voffA); PG8_STAGE(PG8_SA(0, 1), cA + hstepA, voffA);
        if (wr == 1) PG8_BAR;
        PG8_WAIT_V(2); PG8_BAR;
        PG8_STAGE(PG8_SB(1, 0), cB + kstep, voffB); PG8_STAGE(PG8_SA(1, 0), cA + kstep, voffA); PG8_STAGE(PG8_SB(1, 1), cB + hstepB + kstep, voffB);
        PG8_WAIT_V(6); PG8_BAR;
    } else {
        PG8_STAGE(PG8_SB(0, 0), cB, voffB); PG8_STAGE(PG8_SA(0, 0), cA, voffA); PG8_STAGE(PG8_SB(0, 1), cB + hstepB, voffB); PG8_STAGE(PG8_SA(0, 1), cA + hstepA, voffA);
        if (wr == 1) PG8_BAR;
        PG8_WAIT_V(4); PG8_BAR;
        PG8_STAGE(PG8_SB(1, 0), cB + kstep, voffB); PG8_STAGE(PG8_SA(1, 0), cA + kstep, voffA); PG8_STAGE(PG8_SB(1, 1), cB + hstepB + kstep, voffB);
        PG8_WAIT_V(6); PG8_BAR;
    }
    for (;;) {
        const bool has_next = S.next(ui + 1, nxt);
        const char* nA = has_next ? (const char*)g.A + (size_t)nxt.pm * tstepA + (size_t)nxt.ko * 2 : cA; const char* nB = has_next ? (const char*)g.Bt + (size_t)nxt.pn * tstepB + (size_t)nxt.ko * 2 : cB;
        for (int t = 0; t < nt; t += 2) {
            const bool last = (t == nt - 2);
            const char* a1 = cA + (size_t)(t + 1) * kstep;
            const char* a2 = last ? nA : cA + (size_t)(t + 2) * kstep; const char* b2 = last ? nB : cB + (size_t)(t + 2) * kstep;
            const char* a3 = a2 + kstep; const char* b3 = b2 + kstep;
            if (last && has_next) S.a_ready(nxt);
            if constexpr (SP2) {
            PG8_LDB(B0, 0, 0); PG8_LDB(B1, 0, 1); PG8_SCHED; PG8_LDA(At, 0, 0); PG8_STAGE(PG8_SA(1, 1), a1 + hstepA, voffA);
            PG8_WAIT_V(8); PG8_WAIT_L(0); PG8_BAR; PG8_MMA(0, 0, At, B0); PG8_MMA(0, 1, At, B1); PG8_BAR; PG8_SCHED;
            PG8_LDA(At, 0, 1); PG8_STAGE(PG8_SB(0, 0), b2, voffB); PG8_STAGE(PG8_SB(0, 1), b2 + hstepB, voffB); PG8_STAGE(PG8_SA(0, 0), a2, voffA);
            PG8_WAIT_V(8); PG8_WAIT_L(0); PG8_BAR; PG8_MMA(1, 0, At, B0); PG8_MMA(1, 1, At, B1); PG8_BAR; PG8_SCHED;
            PG8_LDB(B0, 1, 0); PG8_LDB(B1, 1, 1); PG8_SCHED; PG8_LDA(At, 1, 0); PG8_STAGE(PG8_SA(0, 1), a2 + hstepA, voffA);
            PG8_WAIT_V(8); PG8_WAIT_L(0); PG8_BAR; PG8_MMA(0, 0, At, B0); PG8_MMA(0, 1, At, B1); PG8_BAR; PG8_SCHED;
            PG8_LDA(At, 1, 1); PG8_STAGE(PG8_SB(1, 0), b3, voffB); PG8_STAGE(PG8_SB(1, 1), b3 + hstepB, voffB); PG8_STAGE(PG8_SA(1, 0), a3, voffA);
            PG8_WAIT_V(8); PG8_WAIT_L(0); PG8_BAR; PG8_MMA(1, 0, At, B0); PG8_MMA(1, 1, At, B1); PG8_BAR; PG8_SCHED;
            } else {
            PG8_LDB(B0, 0, 0); PG8_SCHED; PG8_LDA(At, 0, 0); PG8_STAGE(PG8_SA(1, 1), a1 + hstepA, voffA);
            PG8_WAIT_L(8); PG8_BAR; PG8_WAIT_L(0); PG8_MMA(0, 0, At, B0); PG8_BAR; PG8_SCHED;
            PG8_LDB(B1, 0, 1); PG8_STAGE(PG8_SB(0, 0), b2, voffB);
            PG8_BAR; PG8_WAIT_L(0); PG8_MMA(0, 1, At, B1); PG8_BAR;
            PG8_LDA(At, 0, 1); PG8_STAGE(PG8_SA(0, 0), a2, voffA);
            PG8_BAR; PG8_WAIT_L(0); PG8_MMA(1, 0, At, B0); PG8_BAR; PG8_SCHED;
            PG8_STAGE(PG8_SB(0, 1), b2 + hstepB, voffB);
            PG8_WAIT_V(6); PG8_BAR; PG8_MMA(1, 1, At, B1); PG8_BAR;
            PG8_LDB(B0, 1, 0); PG8_SCHED; PG8_LDA(At, 1, 0); PG8_STAGE(PG8_SA(0, 1), a2 + hstepA, voffA);
            PG8_WAIT_L(8); PG8_BAR; PG8_WAIT_L(0); PG8_MMA(0, 0, At, B0); PG8_BAR; PG8_SCHED;
            PG8_LDB(B1, 1, 1); PG8_STAGE(PG8_SB(1, 0), b3, voffB);
            PG8_BAR; PG8_WAIT_L(0); PG8_MMA(0, 1, At, B1); PG8_BAR;
            PG8_LDA(At, 1, 1); PG8_STAGE(PG8_SA(1, 0), a3, voffA);
            PG8_BAR; PG8_WAIT_L(0); PG8_MMA(1, 0, At, B0); PG8_BAR; PG8_SCHED;
            PG8_STAGE(PG8_SB(1, 1), b3 + hstepB, voffB);
            PG8_WAIT_V(6); PG8_BAR; PG8_MMA(1, 1, At, B1); PG8_BAR;
            }
        }
        if constexpr (ALIGN_EPI) { if (wr == 0) PG8_BAR; }
        E(acc, cur, wr, wc, fr, fq); S.done(cur);
        if (!has_next) break;
#pragma unroll
        for (int a = 0; a < 2; ++a)
#pragma unroll
            for (int b = 0; b < 2; ++b)
#pragma unroll
                for (int m = 0; m < 4; ++m)
#pragma unroll
                    for (int n = 0; n < 2; ++n) acc[a][b][m][n] = (f32x4){0.f, 0.f, 0.f, 0.f};
        cur = nxt; cA = nA; cB = nB; ++ui;
        if constexpr (ALIGN_EPI) { if (wr == 1) PG8_BAR; }
    }
    PG8_WAIT_V(0);
    if constexpr (!ALIGN_EPI) { if (wr == 0) PG8_BAR; }
    PG8_BAR;
#undef PG8_SA
#undef PG8_SB
#undef PG8_STAGE
#undef PG8_LDA
#undef PG8_LDB
#undef PG8_MMA
#undef PG8_WAIT_V
#undef PG8_WAIT_L
#undef PG8_BAR
#undef PG8_SCHED
}
}

constexpr int NWAVES = 8, NTHR = 512;
constexpr int DM = 4096, NB = 2, SEQ = 8192, NCTX = 256, DFF = 16384;
constexpr int M_LAT = NB * SEQ, M_CTX = NB * NCTX, M_TOT = M_LAT + M_CTX;
constexpr int DIN = 8672, DINP = 8704;
constexpr int C_SWAQ = 0, C_SWAK = 1024, C_SWAV = 1280, C_LRUX = 1536, C_LRUY = 2560, C_QA = 3584, C_KVA = 4608, C_KR = 5120, C_RW = 5184;
constexpr int C_RWR = C_RW, C_RWK = C_RW + 1024, C_RWV = C_RW + 2048, C_RWL = C_RW + 3072;
constexpr int RWC = 3488;
constexpr float LN_EPS = 1e-5f, RMS_EPS = 1e-6f, GN_EPS = 64e-5f, ALPHA = 1.41421356237f;
constexpr int NCH = 264;

constexpr size_t MiB = 1u << 20;
constexpr size_t WS_CTL = 0, CTL_ZERO_BYTES = 1 * MiB;
constexpr size_t WS_MOD = 1 * MiB;
constexpr size_t WS_MODP = 2 * MiB;
constexpr size_t WS_SMALL = 20 * MiB;
constexpr size_t WS_RSQ = WS_SMALL;
constexpr size_t WS_RSKV = WS_RSQ + 128 * 1024;
constexpr size_t WS_SB = WS_RSKV + 128 * 1024;
constexpr size_t WS_CA = WS_SB + 2 * MiB;
constexpr size_t WS_CB = WS_CA + 5 * MiB;
constexpr size_t WS_HIN = WS_CB + 5 * MiB;
constexpr size_t WS_QUIRK = WS_HIN + 5 * MiB;
constexpr size_t WS_ROPE = WS_QUIRK + 8192;
static_assert(WS_ROPE + 16384 <= 40 * MiB, "small region");
constexpr size_t WS_W = 40 * MiB;
constexpr size_t WS_WIN = WS_W, WS_WOUT = WS_WIN + 68 * MiB, WS_WFF1 = WS_WOUT + 32 * MiB, WS_WFF2 = WS_WFF1 + 128 * MiB, WS_WQB = WS_WFF2 + 128 * MiB,
                 WS_WKVB = WS_WQB + 3 * MiB, WS_WLRU = WS_WKVB + 2 * MiB, WS_WLORA = WS_WLRU + 1 * MiB;
constexpr size_t WS_W2T = WS_WLORA, WS_A2T = WS_W2T + 256 * 1024, WS_G2T = WS_A2T + 256 * 1024;
constexpr size_t WS_X = 403 * MiB;
constexpr size_t WS_H = 667 * MiB;
constexpr size_t WS_MIX = 799 * MiB;
constexpr size_t WS_YS = 931 * MiB;
constexpr size_t WS_P = 1063 * MiB;
constexpr size_t WS_RWF = 1344 * MiB;
constexpr size_t RWF_STRIDE = (size_t)M_TOT * 1024 * 2;
constexpr size_t WS_Q = 1641 * MiB;
constexpr size_t WS_KV = 1691 * MiB;
constexpr size_t WS_KR = 1757 * MiB;
constexpr size_t WS_SET2 = 1760 * MiB;
constexpr size_t WSET_STRIDE = WS_SET2 - WS_W;
constexpr size_t WS_END = WS_SET2 + 363 * MiB;
constexpr size_t WS_YP = WS_Q;
constexpr size_t WS_HID = WS_P;
constexpr size_t WS_Y1 = WS_P;
constexpr size_t WS_Y2 = WS_MIX;
static_assert(WS_WLORA + 1 * MiB <= WS_X && WS_P + (size_t)M_TOT * DINP * 2 <= WS_RWF && WS_RWF + 9 * RWF_STRIDE <= WS_Q, "ws map");
static_assert(WS_HID + (size_t)M_TOT * DFF * 2 <= WS_Q && WS_Y2 + (size_t)M_TOT * DM * 4 <= WS_P && WS_YS + 2 * (size_t)M_TOT * 1024 * 4 <= WS_P, "ws overlays");
static_assert(WS_KR + (size_t)M_TOT * 64 * 2 <= WS_SET2 && WS_YP + 8 * (size_t)M_CTX * DM * 4 <= WS_KR, "ws end");

constexpr int RING_BYTES = 131072;
constexpr int LDSCTL_OFF = RING_BYTES, MISC_OFF = LDSCTL_OFF + 320;
constexpr int LDS_BYTES = 147456;

#define GAS __attribute__((address_space(1)))
#define LAS __attribute__((address_space(3)))
typedef unsigned short bf16;
typedef unsigned v4u __attribute__((ext_vector_type(4)));
typedef unsigned v2u __attribute__((ext_vector_type(2)));
typedef float f32x4 __attribute__((ext_vector_type(4)));
typedef _Float16 h16x4 __attribute__((ext_vector_type(4)));
#ifndef XH16_
#define XH16_ 0
#endif
constexpr bool XH16 = XH16_;
#if XH16_
typedef _Float16 xres_t;
#else
typedef float xres_t;
#endif
typedef float f32x2 __attribute__((ext_vector_type(2)));
typedef float f32x16 __attribute__((ext_vector_type(16)));
typedef short bf16x8 __attribute__((ext_vector_type(8)));
typedef short s16x4 __attribute__((ext_vector_type(4)));
typedef GAS unsigned gu32;
typedef const GAS bf16* gcbf; typedef GAS bf16* gbfp; typedef const GAS float* gcfl; typedef GAS float* gflp;
#define LDS_WAIT() asm volatile("s_waitcnt lgkmcnt(0)" ::: "memory")
#define VM_WAIT() asm volatile("s_waitcnt vmcnt(0)" ::: "memory")
typedef __bf16 bf16x2_t __attribute__((ext_vector_type(2)));
__device__ __forceinline__ unsigned pk2(float lo, float hi) { const f32x2 v = {lo, hi}; const bf16x2_t b = __builtin_convertvector(v, bf16x2_t); return __builtin_bit_cast(unsigned, b); }
__device__ __forceinline__ unsigned f2bf(float f) { return pk2(f, f) & 0xffffu; }
__device__ __forceinline__ float bflo(unsigned w) { return __builtin_bit_cast(float, w << 16); }
__device__ __forceinline__ float bfhi(unsigned w) { return __builtin_bit_cast(float, w & 0xffff0000u); }
__device__ __forceinline__ float bf2f(bf16 h) { return __builtin_bit_cast(float, (unsigned)h << 16); }
#define DPP_ADD(x, ctrl) ((x) + __builtin_bit_cast(float, __builtin_amdgcn_update_dpp(0, __builtin_bit_cast(int, (x)), (ctrl), 0xf, 0xf, false)))
__device__ __forceinline__ float row_sum16(float x) { x = DPP_ADD(x, 0x128); x = DPP_ADD(x, 0x124); x = DPP_ADD(x, 0x122); x = DPP_ADD(x, 0x121); return x; }
#ifdef OLD_SUMS
__device__ __forceinline__ float wave_sum(float v) {
#pragma unroll
    for (int o = 1; o < 64; o <<= 1) v += __shfl_xor(v, o);
    return v;
}
__device__ __forceinline__ float half_swap_sum(float x) { return x + __shfl_xor(x, 32); }
__device__ __forceinline__ float quad_sum(float x) { x += __shfl_xor(x, 1); x += __shfl_xor(x, 2); return x; }
#else
__device__ __forceinline__ float wave_sum(float v) {
    const float r = row_sum16(v);
    const float a = __builtin_bit_cast(float, __builtin_amdgcn_readlane(__builtin_bit_cast(int, r), 0)), b = __builtin_bit_cast(float, __builtin_amdgcn_readlane(__builtin_bit_cast(int, r), 16));
    const float c = __builtin_bit_cast(float, __builtin_amdgcn_readlane(__builtin_bit_cast(int, r), 32)), d = __builtin_bit_cast(float, __builtin_amdgcn_readlane(__builtin_bit_cast(int, r), 48));
    return (a + b) + (c + d);
}
__device__ __forceinline__ float half_swap_sum(float x) {
    unsigned a = __builtin_bit_cast(unsigned, x), b = a; asm volatile("" : "+v"(b));
    auto rr = __builtin_amdgcn_permlane32_swap(a, b, false, false);
    const float lo = __uint_as_float(rr[0]), hi = __uint_as_float(rr[1]); return lo + hi;
}
__device__ __forceinline__ float quad_sum(float x) { x = DPP_ADD(x, 0xB1); x = DPP_ADD(x, 0x4E); return x; }
#endif
__device__ __forceinline__ float sigmoidf_(float x) { return __builtin_amdgcn_rcpf(1.f + __expf(-x)); }
__device__ __forceinline__ float softplusf_(float x) { return x > 20.f ? x : __logf(1.f + __expf(x)); }
__device__ __forceinline__ float tanhf_(float x) { const float e = __expf(2.f * x); return 1.f - 2.f * __builtin_amdgcn_rcpf(e + 1.f); }
__device__ __forceinline__ int ltid() { int t = threadIdx.x; asm volatile("" : "+v"(t)); return t; }
template <class T> __device__ __forceinline__ T ldg(const void* base, unsigned byteoff) { return *(const T*)((const char*)base + byteoff); }
template <class T> __device__ __forceinline__ void stg(void* base, unsigned byteoff, T v) { *(T*)((char*)base + byteoff) = v; }

#define XB_TMO      128
#define XB_XCNT(j)  (256  + 64 * (j))
#define XB_XSUB(j)  (1280 + 64 * (j))
#define XB_XGEN(j)  (2304 + 64 * (j))
#define XB_TOP      3328
#define XB_TOPGEN   3392
#define XCD_BAR_WORDS 3456
#define XB_SPIN_CAP (1u << 18)

__device__ __forceinline__ unsigned xb_ld(unsigned* p)              { return __hip_atomic_load(p, __ATOMIC_RELAXED, __HIP_MEMORY_SCOPE_AGENT); }
__device__ __forceinline__ unsigned xb_add(unsigned* p, unsigned v) { return __hip_atomic_fetch_add(p, v, __ATOMIC_RELAXED, __HIP_MEMORY_SCOPE_AGENT); }
__device__ __forceinline__ unsigned xb_xcc_id() { return (unsigned)__builtin_amdgcn_s_getreg((3 << 11) | 20) & 0xFu; }
#define XB_SPIN(cond, bar) do { unsigned _sp = 0; while (cond) { __builtin_amdgcn_s_sleep(1); \
    if ((++_sp & 255u) == 0u) { if (xb_ld(&(bar)[XB_TMO])) break; if (_sp > XB_SPIN_CAP) { atomicAdd(&(bar)[XB_TMO], 1u); break; } } } } while (0)

struct XcdBarrier {
    unsigned* bar; unsigned x;
    unsigned nparts;
    volatile LAS unsigned* st;
};

__device__ __forceinline__ XcdBarrier xcd_barrier_post(unsigned* bar, volatile LAS unsigned* st) {
    XcdBarrier b; b.bar = bar; b.x = xb_xcc_id(); b.st = st; b.nparts = 0u;
    if (threadIdx.x == 0) (void)xb_add(&bar[XB_XCNT(b.x)], 1u);
    return b;
}
__device__ __forceinline__ void xcd_barrier_complete(unsigned* bar, unsigned x, unsigned& nloc, unsigned& nx, unsigned nparts) {
    const unsigned G = nparts ? nparts : gridDim.x * gridDim.y * gridDim.z;
    unsigned sum, cnt, mine, sp = 0u;
    for (;;) {
        sum = 0u; cnt = 0u; mine = 0u;
#pragma unroll
        for (unsigned j = 0; j < 16; ++j) { const unsigned c = xb_ld(&bar[XB_XCNT(j)]); sum += c; cnt += (c > 0u) ? 1u : 0u; mine = (j == x) ? c : mine; }
        if (sum == G) break;
        __builtin_amdgcn_s_sleep(1);
        if ((++sp & 255u) == 0u) { if (xb_ld(&bar[XB_TMO])) break; if (sp > XB_SPIN_CAP) { atomicAdd(&bar[XB_TMO], 1u); break; } }
    }
    nloc = mine > 0u ? mine : 1u; nx = cnt > 0u ? cnt : 1u;
}

__device__ __forceinline__ void xcd_barrier(const XcdBarrier& b) {
    asm volatile("s_waitcnt vmcnt(0)" ::: "memory");
    __syncthreads();
    if (threadIdx.x == 0) {
        unsigned* bar = b.bar;
        __builtin_amdgcn_s_waitcnt(0);
        unsigned nloc = b.st[0], nx = b.st[1];
        if (nloc == 0u) { xcd_barrier_complete(bar, b.x, nloc, nx, b.nparts); b.st[0] = nloc; b.st[1] = nx; }
        const unsigned old = xb_add(&bar[XB_XSUB(b.x)], 1u);
        const unsigned gen = old / nloc;
        if (old + 1u == (gen + 1u) * nloc) {
            __builtin_amdgcn_fence(__ATOMIC_RELEASE, "agent");
            asm volatile("s_waitcnt vmcnt(0)" ::: "memory");
            const unsigned og = xb_add(&bar[XB_TOP], 1u);
            const unsigned tg = og / nx;
            if (og + 1u == (tg + 1u) * nx) xb_add(&bar[XB_TOPGEN], 1u);
            else XB_SPIN(xb_ld(&bar[XB_TOPGEN]) == tg, bar);
            __builtin_amdgcn_fence(__ATOMIC_ACQUIRE, "agent");
            xb_add(&bar[XB_XGEN(b.x)], 1u);
            asm volatile("s_waitcnt vmcnt(0)" ::: "memory");
        } else {
            XB_SPIN(xb_ld(&bar[XB_XGEN(b.x)]) == gen, bar);
            __builtin_amdgcn_fence(__ATOMIC_ACQUIRE, "agent");
            asm volatile("s_waitcnt vmcnt(0)" ::: "memory");
        }
    }
    __syncthreads();
}


namespace att {
constexpr int KVBLK = 64;
constexpr float THR = 8.f;
#define SBAR() __builtin_amdgcn_sched_barrier(0)
__device__ __forceinline__ int crow(int r, int hi) { return (r & 3) + 8 * (r >> 2) + 4 * hi; }
__device__ __forceinline__ unsigned cvtpk(float lo, float hi) { return pk2(lo, hi); }
template <int DQK> __device__ __forceinline__ int kswz(int row, int cb) { return row * (DQK * 2 + 16) + cb; }

template <int DQK> __device__ __forceinline__ void partialSM(f32x16& p0, f32x16& p1, float& m_reg, float& mn, float& alpha) {
  constexpr float SCALE = DQK == 128 ? 0.088388347648318440f : 0.072168783648703220f;
  constexpr float C = SCALE * 1.4426950408889634f;
  float pmax = p0[0];
#pragma unroll
  for (int r = 1; r < 16; ++r) pmax = fmaxf(pmax, p0[r]);
#pragma unroll
  for (int r = 0; r < 16; ++r) pmax = fmaxf(pmax, p1[r]);
  { auto rr = __builtin_amdgcn_permlane32_swap(__float_as_uint(pmax), __float_as_uint(pmax), false, false);
    pmax = fmaxf(__uint_as_float(rr[0]), __uint_as_float(rr[1])); }
  if (__builtin_expect(__all(pmax - m_reg <= THR / SCALE), 1)) { mn = m_reg; alpha = 1.f; }
  else { mn = fmaxf(m_reg, pmax); alpha = __builtin_amdgcn_exp2f((m_reg - mn) * C); m_reg = mn; }
  const float mnC = -mn * C;
#pragma unroll
  for (int r = 0; r < 16; ++r) p0[r] = fmaf(p0[r], C, mnC);
#pragma unroll
  for (int r = 0; r < 16; ++r) p1[r] = fmaf(p1[r], C, mnC);
#pragma unroll
  for (int r = 0; r < 16; ++r) p0[r] = __builtin_amdgcn_exp2f(p0[r]);
}
__device__ __forceinline__ void finishSM(f32x16& p0, f32x16& p1, float alpha, float& l_reg, bf16x8& pa0, bf16x8& pa1, bf16x8& pa2, bf16x8& pa3) {
#pragma unroll
  for (int r = 0; r < 16; ++r) p1[r] = __builtin_amdgcn_exp2f(p1[r]);
  float ps = 0;
#pragma unroll
  for (int r = 0; r < 16; ++r) ps += p0[r];
#pragma unroll
  for (int r = 0; r < 16; ++r) ps += p1[r];
  { auto rr = __builtin_amdgcn_permlane32_swap(__float_as_uint(ps), __float_as_uint(ps), false, false);
    ps = __uint_as_float(rr[0]) + __uint_as_float(rr[1]); }
  l_reg = l_reg * alpha + ps;
#define PK4(P, BASE, OUT) do { unsigned a0 = cvtpk(P[BASE + 0], P[BASE + 1]), a1 = cvtpk(P[BASE + 2], P[BASE + 3]);   \
    unsigned b0 = cvtpk(P[BASE + 4], P[BASE + 5]), b1 = cvtpk(P[BASE + 6], P[BASE + 7]);                              \
    auto r0 = __builtin_amdgcn_permlane32_swap(a0, b0, false, false); auto r1 = __builtin_amdgcn_permlane32_swap(a1, b1, false, false); \
    v4u w = {r0[0], r1[0], r0[1], r1[1]}; OUT = __builtin_bit_cast(bf16x8, w); } while (0)
  PK4(p0, 0, pa0); PK4(p0, 8, pa1); PK4(p1, 0, pa2); PK4(p1, 8, pa3);
#undef PK4
}
template <int DQK> __device__ __forceinline__ void qkt(f32x16& p0, f32x16& p1, const LAS char* Ks, const bf16x8* qr, const LAS char* qx, int r32, int hi) {
  p0 = f32x16{}; p1 = f32x16{};
#pragma unroll
  for (int d0 = 0; d0 < DQK / 16; ++d0) { const int cb = (d0 * 16 + hi * 8) * 2;
    bf16x8 b0 = *(const LAS bf16x8*)(Ks + kswz<DQK>(r32, cb));
    bf16x8 b1 = *(const LAS bf16x8*)(Ks + kswz<DQK>(32 + r32, cb));
    bf16x8 q; if (d0 < 8) q = qr[d0]; else q = *(const LAS bf16x8*)(qx + (d0 - 8) * 32);
    p0 = __builtin_amdgcn_mfma_f32_32x32x16_bf16(b0, q, p0, 0, 0, 0);
    p1 = __builtin_amdgcn_mfma_f32_32x32x16_bf16(b1, q, p1, 0, 0, 0);
    if ((d0 & 3) == 3 && d0 + 1 < DQK / 16) SBAR(); }
}
__device__ __forceinline__ int v_st(int k, int c) { const int kk = (k & ~0xC) | ((k & 4) << 1) | ((k & 8) >> 1); return ((kk >> 3) * 4 + (c >> 5)) * 512 + ((kk & 7) * 32 + (c & 31)) * 2; }
__device__ __forceinline__ int v_rd_base(int lane) { return ((lane & 3) << 3) | (((lane >> 2) & 3) << 6) | (((lane >> 4) & 1) << 5) | (((lane >> 5) & 1) << 8); }
constexpr int v_rd_off(int d0, int ks, int half) { return d0 * 512 + ks * 4096 + half * 2048; }
template <int OFF> __device__ __forceinline__ s16x4 tr_read(int vb) {
  s16x4 r; asm volatile("ds_read_b64_tr_b16 %0, %1 offset:%2" : "=&v"(r) : "v"(vb), "i"(OFF) : "memory"); return r;
}
template <int D0> __device__ __forceinline__ void pv_one(f32x16& od, int vb, bf16x8 pa0, bf16x8 pa1, bf16x8 pa2, bf16x8 pa3) {
  const s16x4 l0 = tr_read<v_rd_off(D0, 0, 0)>(vb), h0 = tr_read<v_rd_off(D0, 0, 1)>(vb), l1 = tr_read<v_rd_off(D0, 1, 0)>(vb), h1 = tr_read<v_rd_off(D0, 1, 1)>(vb);
  const s16x4 l2 = tr_read<v_rd_off(D0, 2, 0)>(vb), h2 = tr_read<v_rd_off(D0, 2, 1)>(vb), l3 = tr_read<v_rd_off(D0, 3, 0)>(vb), h3 = tr_read<v_rd_off(D0, 3, 1)>(vb);
  asm volatile("s_waitcnt lgkmcnt(0)" ::: "memory"); SBAR();
#define PK(L, H) (bf16x8){L[0], L[1], L[2], L[3], H[0], H[1], H[2], H[3]}
  od = __builtin_amdgcn_mfma_f32_32x32x16_bf16(pa0, PK(l0, h0), od, 0, 0, 0);
  od = __builtin_amdgcn_mfma_f32_32x32x16_bf16(pa1, PK(l1, h1), od, 0, 0, 0);
  od = __builtin_amdgcn_mfma_f32_32x32x16_bf16(pa2, PK(l2, h2), od, 0, 0, 0);
  od = __builtin_amdgcn_mfma_f32_32x32x16_bf16(pa3, PK(l3, h3), od, 0, 0, 0);
#undef PK
}
__device__ __forceinline__ void pv_d0(f32x16* o, int vb, bf16x8 pa0, bf16x8 pa1, bf16x8 pa2, bf16x8 pa3) {
  pv_one<0>(o[0], vb, pa0, pa1, pa2, pa3); pv_one<1>(o[1], vb, pa0, pa1, pa2, pa3); pv_one<2>(o[2], vb, pa0, pa1, pa2, pa3); pv_one<3>(o[3], vb, pa0, pa1, pa2, pa3);
}
__device__ __forceinline__ void apply_mask(f32x16& p0, f32x16& p1, int mtype, int krel0, int qi, int hi) {
  if (mtype == 0) return;
  const float ninf = -__builtin_inff();
#pragma unroll
  for (int r = 0; r < 16; ++r) { const int k0 = krel0 + crow(r, hi), k1 = k0 + 32;
    const bool ok0 = (mtype == 1) ? (k0 >= qi - 128) : (k0 <= qi + 128), ok1 = (mtype == 1) ? (k1 >= qi - 128) : (k1 <= qi + 128);
    p0[r] = ok0 ? p0[r] : ninf; p1[r] = ok1 ? p1[r] : ninf; }
}
struct Tile { gcbf kn; gcbf kr; gcbf v; int mtype; int krel0; };

__device__ __forceinline__ void rope_pair(bf16x8& a, bf16x8& b, gcfl ct, gcfl st) {
  const f32x4 c0 = *(const GAS f32x4*)ct, c1 = *(const GAS f32x4*)(ct + 4), s0 = *(const GAS f32x4*)st, s1 = *(const GAS f32x4*)(st + 4);
  const float cs[8] = {c0[0], c0[1], c0[2], c0[3], c1[0], c1[1], c1[2], c1[3]}, sn[8] = {s0[0], s0[1], s0[2], s0[3], s1[0], s1[1], s1[2], s1[3]};
  v4u ua = __builtin_bit_cast(v4u, a), ub = __builtin_bit_cast(v4u, b); v4u oa, ob;
#pragma unroll
  for (int w = 0; w < 4; ++w) { const float x1[2] = {bflo(ua[w]), bfhi(ua[w])}, x2[2] = {bflo(ub[w]), bfhi(ub[w])}; float y1[2], y2[2];
#pragma unroll
    for (int e = 0; e < 2; ++e) { const float c = cs[2 * w + e], sv = sn[2 * w + e]; y1[e] = x1[e] * c - x2[e] * sv; y2[e] = x2[e] * c + x1[e] * sv; }
    oa[w] = pk2(y1[0], y1[1]); ob[w] = pk2(y2[0], y2[1]); }
  a = __builtin_bit_cast(bf16x8, oa); b = __builtin_bit_cast(bf16x8, ob);
}

template <int DQK, int LDKN, int LDV, bool MASK, bool SINK, int SDEPTH, class TS>
__device__ __forceinline__ void attn_body(gcbf Qw, int rope, int prow, int pcol, gcfl rtab, int qi, float sink_l2, const TS& ts, int NT, gbfp Ow, LAS char* lds) {
  constexpr float SCALE = DQK == 128 ? 0.088388347648318440f : 0.072168783648703220f;
  constexpr float C = SCALE * 1.4426950408889634f;
  constexpr int SHM_K = KVBLK * (DQK * 2 + 16), SHM_V = KVBLK * 128 * 2;
  int tid = threadIdx.x; asm volatile("" : "+v"(tid));
  const int wid = tid >> 6, lane = tid & 63, r32 = lane & 31, hi = lane >> 5;
  LAS char* V_lds = lds; LAS char* K_lds = lds + 2 * SHM_V;
  LAS float* wsl = (LAS float*)(lds + 2 * SHM_V + 2 * SHM_K) + wid * 64; LAS float* li_l = wsl; LAS float* al_l = wsl + 32;
  float m_reg = -1e30f, l_reg = 0; f32x16 o[4] = {}; bf16x8 qr[8];
#pragma unroll
  for (int d0 = 0; d0 < 8; ++d0) qr[d0] = *(const GAS bf16x8*)(Qw + d0 * 16 + hi * 8);
  const LAS char* qx = lds + 2 * SHM_V + 2 * SHM_K + 2048 + wid * 4608 + r32 * 144 + hi * 16;
  if constexpr (DQK == 192) {
    bf16x8 x0 = *(const GAS bf16x8*)(Qw + 128 + hi * 8), x1 = *(const GAS bf16x8*)(Qw + 144 + hi * 8), x2 = *(const GAS bf16x8*)(Qw + 160 + hi * 8), x3 = *(const GAS bf16x8*)(Qw + 176 + hi * 8);
    if (rope) {
      rope_pair(x0, x1, rtab + (size_t)prow * 16 + hi * 8, rtab + 2048 + (size_t)prow * 16 + hi * 8);
      rope_pair(x2, x3, rtab + (size_t)pcol * 16 + hi * 8, rtab + 2048 + (size_t)pcol * 16 + hi * 8); }
    LAS char* qw_ = (LAS char*)qx; *(LAS bf16x8*)(qw_) = x0; *(LAS bf16x8*)(qw_ + 32) = x1; *(LAS bf16x8*)(qw_ + 64) = x2; *(LAS bf16x8*)(qw_ + 96) = x3;
  }
  const int sr = tid >> 4, sc = (tid & 15) * 8, vst0 = v_st(sr, sc), vst1 = v_st(32 + sr, sc);
  const int rr_ = tid >> 3, rc_ = (tid & 7) * 8;
  const int vb0 = (int)(uintptr_t)V_lds + v_rd_base(lane);
  struct { bf16x8 vs0, vs1, ks0, ks1, kx; } sr_[SDEPTH];
#define SLOAD(i, jt) do { const Tile t_ = ts(jt); sr_[i].vs0 = *(const GAS bf16x8*)(t_.v + (size_t)sr * LDV + sc); sr_[i].vs1 = *(const GAS bf16x8*)(t_.v + (size_t)(32 + sr) * LDV + sc); \
    sr_[i].ks0 = *(const GAS bf16x8*)(t_.kn + (size_t)sr * LDKN + sc); sr_[i].ks1 = *(const GAS bf16x8*)(t_.kn + (size_t)(32 + sr) * LDKN + sc); \
    if constexpr (DQK == 192) sr_[i].kx = *(const GAS bf16x8*)(t_.kr + (size_t)rr_ * 64 + rc_); } while (0)
#define SWRITE(b, i) do { *(LAS bf16x8*)(V_lds + (b) * SHM_V + vst0) = sr_[i].vs0; *(LAS bf16x8*)(V_lds + (b) * SHM_V + vst1) = sr_[i].vs1; const int kc = sc * 2; \
    *(LAS bf16x8*)(K_lds + (b) * SHM_K + kswz<DQK>(sr, kc)) = sr_[i].ks0; *(LAS bf16x8*)(K_lds + (b) * SHM_K + kswz<DQK>(32 + sr, kc)) = sr_[i].ks1; \
    if constexpr (DQK == 192) *(LAS bf16x8*)(K_lds + (b) * SHM_K + kswz<DQK>(rr_, 256 + rc_ * 2)) = sr_[i].kx; } while (0)
#define SWAIT() do { if constexpr (SDEPTH == 2) { if constexpr (DQK == 192) asm volatile("s_waitcnt vmcnt(5)" ::: "memory"); else asm volatile("s_waitcnt vmcnt(4)" ::: "memory"); } \
    else asm volatile("s_waitcnt vmcnt(0)" ::: "memory"); } while (0)
#define RESC(a) do { if (__any((a) < 1.f)) { if (hi == 0) al_l[r32] = (a); asm volatile("s_waitcnt lgkmcnt(0)" ::: "memory"); \
    _Pragma("unroll") for (int d = 0; d < 4; ++d) _Pragma("unroll") for (int r = 0; r < 16; ++r) o[d][r] *= al_l[crow(r, hi)]; } } while (0)
#define MASKT(pa_, pb_, jt) do { if constexpr (MASK) { const Tile t_ = ts(jt); apply_mask(pa_, pb_, t_.mtype, t_.krel0, qi, hi); } } while (0)
  f32x16 pA0, pA1, pB0, pB1; float mnA, mnB, alA, alB; bf16x8 pa0, pa1, pa2, pa3;
  constexpr int SE = 0, SO = SDEPTH - 1;
  SLOAD(SE, 0); asm volatile("s_waitcnt vmcnt(0)" ::: "memory"); SWRITE(0, SE); __syncthreads();
  qkt<DQK>(pA0, pA1, K_lds, qr, qx, r32, hi); MASKT(pA0, pA1, 0); partialSM<DQK>(pA0, pA1, m_reg, mnA, alA);
  SLOAD(SO, 1); if constexpr (SDEPTH == 2) { if (2 < NT) SLOAD(SE, 2); }
  SWAIT(); SWRITE(1, SO); __syncthreads();
  for (int j = 1; j + 1 < NT; j += 2) {
    SBAR(); qkt<DQK>(pB0, pB1, K_lds + SHM_K, qr, qx, r32, hi); MASKT(pB0, pB1, j);
    finishSM(pA0, pA1, alA, l_reg, pa0, pa1, pa2, pa3); SBAR();
    SLOAD(SO, j + SDEPTH); SBAR();
    pv_d0(o, vb0, pa0, pa1, pa2, pa3); partialSM<DQK>(pB0, pB1, m_reg, mnB, alB);
    __syncthreads(); SWAIT(); SWRITE(0, SE);
    RESC(alB); __syncthreads();
    SBAR(); qkt<DQK>(pA0, pA1, K_lds, qr, qx, r32, hi); MASKT(pA0, pA1, j + 1);
    finishSM(pB0, pB1, alB, l_reg, pa0, pa1, pa2, pa3); SBAR();
    if (SDEPTH == 1 || j + 3 < NT) SLOAD(SE, j + 1 + SDEPTH); SBAR();
    pv_d0(o, vb0 + SHM_V, pa0, pa1, pa2, pa3); partialSM<DQK>(pA0, pA1, m_reg, mnA, alA);
    __syncthreads(); SWAIT(); SWRITE(1, SO);
    RESC(alA); __syncthreads();
  }
  SBAR(); qkt<DQK>(pB0, pB1, K_lds + SHM_K, qr, qx, r32, hi); MASKT(pB0, pB1, NT - 1);
  finishSM(pA0, pA1, alA, l_reg, pa0, pa1, pa2, pa3); SBAR();
  pv_d0(o, vb0, pa0, pa1, pa2, pa3); partialSM<DQK>(pB0, pB1, m_reg, mnB, alB);
  __syncthreads(); RESC(alB);
  finishSM(pB0, pB1, alB, l_reg, pa0, pa1, pa2, pa3); SBAR();
  pv_d0(o, vb0 + SHM_V, pa0, pa1, pa2, pa3);
  if constexpr (SINK) l_reg += __builtin_amdgcn_exp2f(sink_l2 - m_reg * C);
  if (hi == 0) li_l[r32] = l_reg; asm volatile("s_waitcnt lgkmcnt(0)" ::: "memory");
  float rli[16];
#pragma unroll
  for (int r = 0; r < 16; ++r) rli[r] = __builtin_amdgcn_rcpf(li_l[crow(r, hi)]);
  __syncthreads();
  LAS bf16* ost = (LAS bf16*)(lds + wid * 8704);
#pragma unroll
  for (int r = 0; r < 16; ++r) { const int orow = crow(r, hi);
#pragma unroll
    for (int d0 = 0; d0 < 4; ++d0) ost[orow * 136 + d0 * 32 + r32] = (bf16)f2bf(o[d0][r] * rli[r]); }
  asm volatile("s_waitcnt lgkmcnt(0)" ::: "memory");
#pragma unroll
  for (int i = 0; i < 8; ++i) { const int orow = i * 4 + (lane >> 4), ch = lane & 15;
    *(GAS v4u*)(Ow + (size_t)orow * 4096 + ch * 8) = *(const LAS v4u*)(ost + orow * 136 + ch * 8); }
  __syncthreads();
#undef SLOAD
#undef SWRITE
#undef SWAIT
#undef RESC
#undef MASKT
}
}

struct Args { const float* in[38]; float* out; unsigned char* ws; };
template <class T> __device__ __forceinline__ T launder(T p) { asm volatile("" : "+s"(p)); return p; }
template <class T> __device__ __forceinline__ T* launder_g(T* p) { GAS T* g = (GAS T*)p; asm volatile("" : "+s"(g)); return (T*)g; }
#define INP(i) ((const float*)(gcfl)F.A->in[i])
struct Frame {
    LAS unsigned char* lds;
    gu32* ctl;
    int tid, lane, wave;
    int vcu, G, gw, NGW;
    const __attribute__((address_space(4))) Args* A;
    float* out;
    unsigned char* ws;
    unsigned char* wsw;
};
enum { I_X = 0, I_C, I_CTX, I_CCTX, I_WMOD, I_BMOD, I_WIN, I_WOUT, I_LN1G, I_LN1B, I_WFF1, I_WFF2, I_LN2G, I_LN2B, I_SINK, I_CONVW, I_CONVB, I_LWA, I_LBA, I_LWI, I_LBI, I_LAM,
       I_QNORM, I_KVNORM, I_WQB, I_WKVB, I_MUP, I_MUN, I_W0, I_W2, I_A0, I_A2, I_G2, I_KK, I_KA, I_RK, I_LNG, I_LNB };
__device__ __forceinline__ int row_s(int row) { return row < SEQ ? 0 : (row < M_LAT ? 1 : 2); }
__device__ __forceinline__ const float* mod_ptr(const Frame& F, int l, int s, int chunk) { return (const float*)(F.ws + WS_MOD) + ((size_t)(l * 3 + s) * 6 + chunk) * DM; }

__device__ __forceinline__ void transpose_item(const float* W, int N, int Kvalid, bf16* WT, int ldt, const float* kscale, LAS float* scr, int k0, int n0, int lane) {
    { const int kr = lane >> 3, c4 = (lane & 7) * 4;
#pragma unroll
      for (int i = 0; i < 8; ++i) { const int kk = 8 * i + kr, k = k0 + kk; f32x4 v = {0.f, 0.f, 0.f, 0.f};
          if (k < Kvalid) { v = *(const f32x4*)(W + (size_t)k * N + n0 + c4); if (kscale) v = v * kscale[k]; }
          scr[kk * 33 + c4] = v.x; scr[kk * 33 + c4 + 1] = v.y; scr[kk * 33 + c4 + 2] = v.z; scr[kk * 33 + c4 + 3] = v.w; } }
    LDS_WAIT(); asm volatile("" ::: "memory");
    const int c = lane & 7;
#pragma unroll
    for (int j = 0; j < 4; ++j) { const int n = (lane >> 3) + 8 * j; const LAS float* s = scr + (8 * c) * 33 + n;
        v4u o; o.x = pk2(s[0 * 33], s[1 * 33]); o.y = pk2(s[2 * 33], s[3 * 33]); o.z = pk2(s[4 * 33], s[5 * 33]); o.w = pk2(s[6 * 33], s[7 * 33]);
        *(v4u*)(WT + (size_t)(n0 + n) * ldt + k0 + 8 * c) = o; }
    LDS_WAIT(); asm volatile("" ::: "memory");
}
__device__ __forceinline__ void convert_weights(Frame& F, int l, int widx, int nw) {
    LAS float* scr = (LAS float*)(F.lds + F.wave * 16384);
    constexpr int I1 = 64 * 271, I2 = 64 * 128, I3 = 64 * 512, I4 = 256 * 128, I5 = 16 * 48, I6 = 8 * 64, I7 = 32 * 8, I8 = 2 * 32, I9 = 2 * 32, I10 = 3 * 32;
    constexpr int NIT = I1 + I2 + I3 + I4 + I5 + I6 + I7 + I8 + I9 + I10;
    unsigned char* ws = F.ws + (l ? WSET_STRIDE : 0);
    for (int it = widx; it < NIT; it += nw) {
        int r = it;
        if (r < I1) { transpose_item(INP(I_WIN) + (size_t)l * DM * DIN, DIN, DM, (bf16*)(ws + WS_WIN), DM, nullptr, scr, 64 * (r / 271), 32 * (r % 271), F.lane); continue; } r -= I1;
        if (r < I2) { transpose_item(INP(I_WOUT) + (size_t)l * DM * DM, DM, DM, (bf16*)(ws + WS_WOUT), DM, nullptr, scr, 64 * (r / 128), 32 * (r % 128), F.lane); continue; } r -= I2;
        if (r < I3) { transpose_item(INP(I_WFF1) + (size_t)l * DM * DFF, DFF, DM, (bf16*)(ws + WS_WFF1), DM, nullptr, scr, 64 * (r / 512), 32 * (r % 512), F.lane); continue; } r -= I3;
        if (r < I4) { transpose_item(INP(I_WFF2) + (size_t)l * DFF * DM, DM, DFF, (bf16*)(ws + WS_WFF2), DFF, nullptr, scr, 64 * (r / 128), 32 * (r % 128), F.lane); continue; } r -= I4;
        if (r < I5) { transpose_item(INP(I_WQB) + (size_t)l * 1024 * 1536, 1536, 1024, (bf16*)(ws + WS_WQB), 1024, INP(I_QNORM) + l * 1024, scr, 64 * (r / 48), 32 * (r % 48), F.lane); continue; } r -= I5;
        if (r < I6) { transpose_item(INP(I_WKVB) + (size_t)l * 512 * 2048, 2048, 512, (bf16*)(ws + WS_WKVB), 512, INP(I_KVNORM) + l * 512, scr, 64 * (r / 64), 32 * (r % 64), F.lane); continue; } r -= I6;
        if (r < I7) { const int mat = r >> 3, sub = r & 7, gate = mat & 1, dn = mat >> 1;
            const int d = dn >> 3, n = dn & 7;
            const float* src = (gate ? INP(I_LWI) : INP(I_LWA)) + ((size_t)(l * 2 + d) * 8 + n) * 128 * 128;
            bf16* dst = (bf16*)(ws + WS_WLRU) + ((size_t)(d * 2 + gate) * 8 + n) * 128 * 128;
            transpose_item(src, 128, 128, dst, 128, nullptr, scr, 64 * (sub >> 2), 32 * (sub & 3), F.lane); continue; } r -= I7;
        if (r < I8) { const int d = r >> 5; transpose_item(INP(I_W2) + (size_t)(l * 2 + d) * 64 * 1024, 1024, 64, (bf16*)(ws + WS_W2T) + (size_t)d * 1024 * 64, 64, nullptr, scr, 0, 32 * (r & 31), F.lane); continue; } r -= I8;
        if (r < I9) { const int d = r >> 5; transpose_item(INP(I_A2) + (size_t)(l * 2 + d) * 64 * 1024, 1024, 64, (bf16*)(ws + WS_A2T) + (size_t)d * 1024 * 64, 64, nullptr, scr, 0, 32 * (r & 31), F.lane); continue; } r -= I9;
        transpose_item(INP(I_G2) + (size_t)l * 160 * 1024, 1024, 160, (bf16*)(ws + WS_G2T), 192, nullptr, scr, 64 * (r / 32), 32 * (r % 32), F.lane);
    }
    { unsigned zz = 0u; asm volatile("" : "+v"(zz)); v4u z = {zz, zz, zz, zz}; v4u* p = (v4u*)((bf16*)(ws + WS_WIN) + (size_t)DIN * DM);
      for (int i = widx * 64 + F.lane; i < 32 * DM / 8; i += nw * 64) p[i] = z; }
}

__device__ __forceinline__ void mod_partials(Frame& F) {
    LAS float* sl = (LAS float*)F.lds;
    for (int it = F.vcu; it < 2 * 32 * 12; it += F.G) {
        const int l = it / 384, ks = (it / 12) % 32, cc = it % 12;
        __syncthreads();
        if (F.tid < 384) { const int s = F.tid >> 7, k = ks * 128 + (F.tid & 127); const float c = s < 2 ? INP(I_C)[s * DM + k] : INP(I_CCTX)[k]; sl[F.tid] = c / (1.f + __expf(-c)); }
        __syncthreads();
        const float* wp = INP(I_WMOD) + ((size_t)l * DM + ks * 128) * 24576 + cc * 2048 + F.tid * 4;
        f32x4 a0 = {0.f, 0.f, 0.f, 0.f}, a1 = a0, a2 = a0;
#pragma unroll 8
        for (int k = 0; k < 128; ++k) { const f32x4 w = *(const f32x4*)(wp + (size_t)k * 24576); a0 += w * sl[k]; a1 += w * sl[128 + k]; a2 += w * sl[256 + k]; }
        float* op = (float*)(F.ws + WS_MODP) + ((size_t)(l * 32 + ks) * 3) * 24576 + cc * 2048 + F.tid * 4;
        *(f32x4*)(op) = a0; *(f32x4*)(op + 24576) = a1; *(f32x4*)(op + 2 * 24576) = a2;
    }
    __syncthreads();
}
__device__ __forceinline__ void mod_reduce(Frame& F) {
    for (int i = F.vcu * NTHR + F.tid; i < 2 * 3 * 24576; i += F.G * NTHR) {
        const int l = i / (3 * 24576), s = (i / 24576) % 3, n = i % 24576;
        float a = INP(I_BMOD)[l * 24576 + n];
        const float* pp = (const float*)(F.ws + WS_MODP) + ((size_t)(l * 32) * 3 + s) * 24576 + n;
#pragma unroll 8
        for (int ks = 0; ks < 32; ++ks) a += pp[(size_t)ks * 3 * 24576];
        ((float*)(F.ws + WS_MOD))[i] = a;
    }
}

__device__ __forceinline__ void sum_partials_row(const Frame& F, const float* yp, size_t stride, bf16* ydst) {
    int lane = F.lane; asm volatile("" : "+v"(lane));
#pragma unroll 2
    for (int j = 0; j < 16; ++j) { const int c = 4 * lane + 256 * j; f32x4 y = *(const f32x4*)(yp + c);
#pragma unroll
        for (int sp = 1; sp < 8; ++sp) y += *(const f32x4*)(yp + sp * stride + c);
        v2u w; w.x = pk2(y.x, y.y); w.y = pk2(y.z, y.w); *(v2u*)(ydst + c) = w; }
}
constexpr int LNV_G = 0, LNV_B = DM, LNV_GA = 2 * DM, LNV_SC = 3 * DM, LNV_SH = 4 * DM;
__device__ __forceinline__ void ln_stage(const Frame& F, int slot, const float* src) {
    LAS float* d = (LAS float*)F.lds + slot; gcfl g = (gcfl)src;
#pragma unroll
    for (int u = 0; u < 2; ++u) { const int c = 4 * (F.tid + NTHR * u); *(LAS f32x4*)(d + c) = *(const GAS f32x4*)(g + c); }
}
template <int MODE, bool XSH = false, bool XDH = false>
__device__ __forceinline__ void ln_row(const Frame& F, const void* xsrc_, const bf16* Y_, void* xdst_, bool domod, bf16* hrow_) {
    gcfl xsrc = (gcfl)xsrc_; const GAS _Float16* xsrch = (const GAS _Float16*)xsrc_; gflp xdst = (gflp)xdst_; GAS _Float16* xdsth = (GAS _Float16*)xdst_;
    gcbf Y = (gcbf)Y_; gbfp hrow = (gbfp)hrow_; const LAS float* L = (const LAS float*)F.lds + 4 * F.lane;
    f32x4 v[16]; v2u yr[16]; float s = 0.f;
#pragma unroll
    for (int j = 0; j < 16; ++j) { const int c = 4 * F.lane + 256 * j;
        if (XSH) v[j] = __builtin_convertvector(__builtin_nontemporal_load((const GAS h16x4*)(xsrch + c)), f32x4); else v[j] = __builtin_nontemporal_load((const GAS f32x4*)(xsrc + c)); }
    if (MODE == 1) {
#pragma unroll
        for (int j = 0; j < 16; ++j) yr[j] = __builtin_nontemporal_load((const GAS v2u*)(Y + 4 * F.lane + 256 * j));
    }
#pragma unroll
    for (int j = 0; j < 16; ++j) {
        if (MODE == 1) { const f32x4 y = {bflo(yr[j].x), bfhi(yr[j].x), bflo(yr[j].y), bfhi(yr[j].y)}, g = *(const LAS f32x4*)(L + LNV_GA + 256 * j); v[j] = v[j] * ALPHA + g * y; }
        s += (v[j].x + v[j].y) + (v[j].z + v[j].w); }
    float mean = wave_sum(s) * (1.f / DM), s2 = 0.f;
#pragma unroll
    for (int j = 0; j < 16; ++j) { v[j] = v[j] - mean; s2 += (v[j].x * v[j].x + v[j].y * v[j].y) + (v[j].z * v[j].z + v[j].w * v[j].w); }
    float rstd = 1.f / sqrtf(wave_sum(s2) * (1.f / DM) + LN_EPS);
    if (MODE == 1) {
        s = 0.f;
#pragma unroll
        for (int j = 0; j < 16; ++j) { const int c = 4 * F.lane + 256 * j; const f32x4 g = *(const LAS f32x4*)(L + LNV_G + 256 * j), b = *(const LAS f32x4*)(L + LNV_B + 256 * j); v[j] = v[j] * rstd * g + b;
            if (XDH) __builtin_nontemporal_store(__builtin_convertvector(v[j], h16x4), (GAS h16x4*)(xdsth + c)); else __builtin_nontemporal_store(v[j], (GAS f32x4*)(xdst + c));
            s += (v[j].x + v[j].y) + (v[j].z + v[j].w); }
        if (!domod) return;
        mean = wave_sum(s) * (1.f / DM); s2 = 0.f;
#pragma unroll
        for (int j = 0; j < 16; ++j) { v[j] = v[j] - mean; s2 += (v[j].x * v[j].x + v[j].y * v[j].y) + (v[j].z * v[j].z + v[j].w * v[j].w); }
        rstd = 1.f / sqrtf(wave_sum(s2) * (1.f / DM) + LN_EPS);
    }
#pragma unroll
    for (int j = 0; j < 16; ++j) { const int c = 4 * F.lane + 256 * j; const f32x4 a = *(const LAS f32x4*)(L + LNV_SC + 256 * j), b = *(const LAS f32x4*)(L + LNV_SH + 256 * j);
        const f32x4 o = v[j] * rstd * (a + 1.f) + b; v2u w; w.x = pk2(o.x, o.y); w.y = pk2(o.z, o.w); *(GAS v2u*)(hrow + c) = w; }
}

__device__ __forceinline__ void shift4(const bf16* P, unsigned eo, bool hp, bool hn, const float* mup, const float* mun, unsigned mo, float (&u)[4]) {
    const v2u xc = ldg<v2u>(P, eo * 2u); v2u xp = {0u, 0u}, xn = {0u, 0u};
    if (hp) xp = ldg<v2u>(P, (eo - DINP) * 2u); if (hn) xn = ldg<v2u>(P, (eo + DINP) * 2u);
    const f32x4 mp = ldg<f32x4>(mup, mo * 4u), mn = ldg<f32x4>(mun, mo * 4u);
    const float c[4] = {bflo(xc.x), bfhi(xc.x), bflo(xc.y), bfhi(xc.y)}, p[4] = {bflo(xp.x), bfhi(xp.x), bflo(xp.y), bfhi(xp.y)}, n[4] = {bflo(xn.x), bfhi(xn.x), bflo(xn.y), bfhi(xn.y)};
#pragma unroll
    for (int e = 0; e < 4; ++e) u[e] = c[e] + mp[e] * (p[e] - c[e]) + mn[e] * (n[e] - c[e]);
}
__device__ __forceinline__ void st4bf(void* base, unsigned eo, float a, float b, float c, float d) { v2u w; w.x = pk2(a, b); w.y = pk2(c, d); stg<v2u>(base, eo * 2u, w); }

__device__ __forceinline__ void rwkv_feat_item(Frame& F, int l, int item) {
    F.tid = ltid(); F.lane = F.tid & 63;
    int row0, seq_lo, seq_hi;
    if (item < 16) { const int b = item >> 3; seq_lo = M_LAT + b * NCTX; seq_hi = seq_lo + NCTX; row0 = seq_lo + (item & 7) * 32; }
    else { const int it = item - 16, b = it >> 8; seq_lo = b * SEQ; seq_hi = seq_lo + SEQ; row0 = seq_lo + (it & 255) * 32; }
    const bf16* P = (const bf16*)(F.ws + WS_P);
    LAS bf16* ACT = (LAS bf16*)F.lds;
    const float* mup = INP(I_MUP) + l * RWC; const float* mun = INP(I_MUN) + l * RWC;
    __syncthreads();
    { const int tok = F.tid >> 4, jc = F.tid & 15, row = row0 + tok; const bool hp = row > seq_lo, hn = row + 1 < seq_hi;
      const bf16* pr = P + (size_t)row * DINP + C_RWL;
#pragma unroll
      for (int i = 0; i < 13; ++i) { const int j = jc * 2 + 32 * i;
          const unsigned xc = *(const unsigned*)(pr + j), xp = hp ? *(const unsigned*)(pr - DINP + j) : 0u, xn = hn ? *(const unsigned*)(pr + DINP + j) : 0u;
          float u[2];
#pragma unroll
          for (int e = 0; e < 2; ++e) { const float c = e ? bfhi(xc) : bflo(xc), p = e ? bfhi(xp) : bflo(xp), n = e ? bfhi(xn) : bflo(xn);
              float v = c + mup[3072 + j + e] * (p - c) + mun[3072 + j + e] * (n - c);
              if (j < 128) v = tanhf_(v); else if (j >= 256) v = sigmoidf_(v);
              u[e] = v; }
          *(LAS unsigned*)(ACT + tok * 424 + j) = pk2(u[0], u[1]); } }
    __syncthreads();
    const int tok = F.lane & 31, hi = F.lane >> 5, row = row0 + tok;
    const bf16* W2T = (const bf16*)(F.wsw + WS_W2T); const bf16* A2T = (const bf16*)(F.wsw + WS_A2T); const bf16* G2T = (const bf16*)(F.wsw + WS_G2T);
    bf16* RWF = (bf16*)(F.ws + WS_RWF); const size_t RS = (size_t)M_TOT * 1024;
    const float* kkv = INP(I_KK) + l * 1024; const float* kav = INP(I_KA) + l * 1024; const float* rkv = INP(I_RK) + l * 1024;
    const float* w0f = INP(I_W0) + (size_t)(l * 2) * 1024; const float* a0f = INP(I_A0) + (size_t)(l * 2) * 1024;
    const LAS bf16* actl = ACT + tok * 424 + hi * 8;
    LAS unsigned char* TB = F.lds + 27136 + F.wave * 10880;
    LAS float* VB = (LAS float*)(F.lds + (F.wave < 4 ? 114176 + F.wave * 3328 : 131584 + (F.wave - 4) * 3328));
#define RF_LOADG(reg_, colbase) do { _Pragma("unroll") for (int i_ = 0; i_ < 3; ++i_) { const int p_ = F.lane + 64 * i_; reg_[i_] = (v4u){0u, 0u, 0u, 0u}; if (p_ < 136) { const int rr_ = p_ >> 2, cp_ = p_ & 3, gr_ = row0 - 1 + rr_; \
        if (gr_ >= seq_lo && gr_ < seq_hi) reg_[i_] = ldg<v4u>(P, ((unsigned)gr_ * DINP + (colbase) + 8 * cp_) * 2u); } } } while (0)
#define RF_STORET(ti, reg_) do { _Pragma("unroll") for (int i_ = 0; i_ < 3; ++i_) { const int p_ = F.lane + 64 * i_; if (p_ < 136) { const int rr_ = p_ >> 2, cp_ = p_ & 3; *(LAS v4u*)(TB + (ti) * 2720 + rr_ * 80 + cp_ * 16) = reg_[i_]; } } } while (0)
#define RF_SHIFT4(ti, g_, vb_, cc_, u_) do { const LAS unsigned char* q_ = TB + (ti) * 2720 + (tok + 1) * 80 + (8 * (g_) + 4 * hi) * 2; const v2u xc_ = *(const LAS v2u*)q_, xp_ = *(const LAS v2u*)(q_ - 80), xn_ = *(const LAS v2u*)(q_ + 80); \
        const f32x4 mp_ = *(const LAS f32x4*)(VB + (vb_) * 64 + (cc_)), mn_ = *(const LAS f32x4*)(VB + ((vb_) + 1) * 64 + (cc_)); \
        const float c_[4] = {bflo(xc_.x), bfhi(xc_.x), bflo(xc_.y), bfhi(xc_.y)}, pp_[4] = {bflo(xp_.x), bfhi(xp_.x), bflo(xp_.y), bfhi(xp_.y)}, nn_[4] = {bflo(xn_.x), bfhi(xn_.x), bflo(xn_.y), bfhi(xn_.y)}; \
        _Pragma("unroll") for (int e_ = 0; e_ < 4; ++e_) u_[e_] = c_[e_] + mp_[e_] * (pp_[e_] - c_[e_]) + mn_[e_] * (nn_[e_] - c_[e_]); } while (0)
#define RF_PUT(ti, o_) do { _Pragma("unroll") for (int g_ = 0; g_ < 4; ++g_) *(LAS v2u*)(TB + (ti) * 2720 + tok * 80 + (8 * g_ + 4 * hi) * 2) = o_[g_]; } while (0)
#define RF_FLUSH3(a0_, a1_, a2_, cblk_) do { asm volatile("s_waitcnt lgkmcnt(0)" ::: "memory"); \
        _Pragma("unroll") for (int t_ = 0; t_ < 3; ++t_) { const int arr_ = t_ == 0 ? (a0_) : (t_ == 1 ? (a1_) : (a2_)); \
            _Pragma("unroll") for (int i_ = 0; i_ < 2; ++i_) { const int p_ = F.lane + 64 * i_, rr_ = p_ >> 2, cp_ = p_ & 3; const v4u v_ = *(const LAS v4u*)(TB + t_ * 2720 + rr_ * 80 + cp_ * 16); \
                stg<v4u>(RWF + arr_ * RS, ((unsigned)(row0 + rr_) * 1024u + (cblk_) + 8 * cp_) * 2u, v_); } } \
        asm volatile("s_waitcnt lgkmcnt(0)" ::: "memory"); } while (0)
#pragma unroll 1
    for (int hh = 0; hh < 2; ++hh) {
        const int h = 2 * F.wave + hh, cbase = h * 64;
        float ssq = 0.f;
        { v4u t0[3], t1[3]; RF_LOADG(t0, C_RWK + cbase); RF_LOADG(t1, C_RWK + cbase + 32);
          const unsigned co = (cbase + F.lane) * 4u; float vv[13];
#pragma unroll
          for (int sct = 0; sct < 3; ++sct) { vv[2 * sct] = ldg<float>(mup, co + sct * 4096u); vv[2 * sct + 1] = ldg<float>(mun, co + sct * 4096u); }
          vv[6] = ldg<float>(kkv, co); vv[7] = ldg<float>(kav, co); vv[8] = ldg<float>(rkv, co); vv[9] = ldg<float>(a0f, co); vv[10] = ldg<float>(a0f, co + 4096u); vv[11] = ldg<float>(w0f, co); vv[12] = ldg<float>(w0f, co + 4096u);
          RF_STORET(0, t0); RF_STORET(1, t1);
#pragma unroll
          for (int q = 0; q < 13; ++q) VB[q * 64 + F.lane] = vv[q]; }
        asm volatile("s_waitcnt lgkmcnt(0)" ::: "memory");
#pragma unroll
        for (int bg = 0; bg < 8; ++bg) { const int cc = (bg >> 2) * 32 + 8 * (bg & 3) + 4 * hi; float uk[4];
            RF_SHIFT4(bg >> 2, bg & 3, 2, cc, uk); const f32x4 k4 = *(const LAS f32x4*)(VB + 6 * 64 + cc);
#pragma unroll
            for (int e = 0; e < 4; ++e) { const float q = uk[e] * k4[e]; ssq += q * q; } }
        ssq = half_swap_sum(ssq);
        const float rn = 1.f / fmaxf(sqrtf(ssq), 1e-12f);
        float sb = 0.f;
        asm volatile("s_waitcnt lgkmcnt(0)" ::: "memory");
#pragma unroll 1
        for (int blk = 0; blk < 2; ++blk) {
            const unsigned cblk = cbase + blk * 32, cha = cblk + tok;
            v4u gR[3], gK[3], gV[3];
            RF_LOADG(gR, C_RWR + cblk); RF_LOADG(gK, C_RWK + cblk); RF_LOADG(gV, C_RWV + cblk);
            bf16x8 wd[2][4], wg[10], wa[2][4];
#pragma unroll
            for (int d = 0; d < 2; ++d) {
#pragma unroll
                for (int ks = 0; ks < 4; ++ks) wd[d][ks] = ldg<bf16x8>(W2T, ((d * 1024 + cha) * 64 + ks * 16 + hi * 8) * 2u); }
#pragma unroll
            for (int ks = 0; ks < 10; ++ks) wg[ks] = ldg<bf16x8>(G2T, (cha * 192 + ks * 16 + hi * 8) * 2u);
#pragma unroll
            for (int d = 0; d < 2; ++d) {
#pragma unroll
                for (int ks = 0; ks < 4; ++ks) wa[d][ks] = ldg<bf16x8>(A2T, ((d * 1024 + cha) * 64 + ks * 16 + hi * 8) * 2u); }
#pragma unroll
            for (int d = 0; d < 2; ++d) { f32x16 aw = {};
#pragma unroll
                for (int ks = 0; ks < 4; ++ks) { const bf16x8 bw = *(const LAS bf16x8*)(actl + d * 64 + ks * 16);
                    aw = __builtin_amdgcn_mfma_f32_32x32x16_bf16(wd[d][ks], bw, aw, 0, 0, 0); }
                v2u o[4];
#pragma unroll
                for (int g = 0; g < 4; ++g) { const f32x4 w0 = *(const LAS f32x4*)(VB + (11 + d) * 64 + blk * 32 + 8 * g + 4 * hi); float e4[4];
#pragma unroll
                    for (int e = 0; e < 4; ++e) e4[e] = 0.60653065971f * sigmoidf_(w0[e] + aw[4 * g + e]);
                    o[g].x = pk2(e4[0], e4[1]); o[g].y = pk2(e4[2], e4[3]); }
                RF_PUT(d, o); }
            { f32x16 ag = {};
#pragma unroll
              for (int ks = 0; ks < 10; ++ks) { const bf16x8 bg_ = *(const LAS bf16x8*)(actl + 256 + ks * 16);
                  ag = __builtin_amdgcn_mfma_f32_32x32x16_bf16(wg[ks], bg_, ag, 0, 0, 0); }
              v2u o[4];
#pragma unroll
              for (int g = 0; g < 4; ++g) { o[g].x = pk2(ag[4 * g], ag[4 * g + 1]); o[g].y = pk2(ag[4 * g + 2], ag[4 * g + 3]); }
              RF_PUT(2, o); }
            RF_FLUSH3(4, 5, 8, cblk);
            RF_STORET(0, gR); RF_STORET(1, gK); RF_STORET(2, gV);
            { f32x16 aaf = {}, aab = {};
#pragma unroll
              for (int ks = 0; ks < 4; ++ks) { const bf16x8 baf = *(const LAS bf16x8*)(actl + 128 + ks * 16), bab = *(const LAS bf16x8*)(actl + 192 + ks * 16);
                  aaf = __builtin_amdgcn_mfma_f32_32x32x16_bf16(wa[0][ks], baf, aaf, 0, 0, 0); aab = __builtin_amdgcn_mfma_f32_32x32x16_bf16(wa[1][ks], bab, aab, 0, 0, 0); }
              v2u oR[4], oK[4], oV[4], oKK[4], oAF[4], oAB[4];
              asm volatile("s_waitcnt lgkmcnt(0)" ::: "memory");
#pragma unroll
              for (int g = 0; g < 4; ++g) { const int cc = blk * 32 + 8 * g + 4 * hi; float ur[4], uk[4], uv[4];
                  RF_SHIFT4(0, g, 0, cc, ur); RF_SHIFT4(1, g, 2, cc, uk); RF_SHIFT4(2, g, 4, cc, uv);
                  const f32x4 a0a = *(const LAS f32x4*)(VB + 9 * 64 + cc), a0b = *(const LAS f32x4*)(VB + 10 * 64 + cc), kk4 = *(const LAS f32x4*)(VB + 6 * 64 + cc), ka4 = *(const LAS f32x4*)(VB + 7 * 64 + cc), rk4 = *(const LAS f32x4*)(VB + 8 * 64 + cc);
                  float af[4], ab[4], kk[4];
#pragma unroll
                  for (int e = 0; e < 4; ++e) { const int r = 4 * g + e;
                      af[e] = sigmoidf_(a0a[e] + aaf[r]); ab[e] = sigmoidf_(a0b[e] + aab[r]); kk[e] = uk[e] * kk4[e] * rn;
                      const float kdf = uk[e] * (1.f + (af[e] - 1.f) * ka4[e]), kdb = uk[e] * (1.f + (ab[e] - 1.f) * ka4[e]);
                      sb += ur[e] * rk4[e] * (kdf + kdb); }
                  oR[g].x = pk2(ur[0], ur[1]); oR[g].y = pk2(ur[2], ur[3]); oK[g].x = pk2(uk[0], uk[1]); oK[g].y = pk2(uk[2], uk[3]); oV[g].x = pk2(uv[0], uv[1]); oV[g].y = pk2(uv[2], uv[3]);
                  oKK[g].x = pk2(kk[0], kk[1]); oKK[g].y = pk2(kk[2], kk[3]); oAF[g].x = pk2(af[0], af[1]); oAF[g].y = pk2(af[2], af[3]); oAB[g].x = pk2(ab[0], ab[1]); oAB[g].y = pk2(ab[2], ab[3]); }
              asm volatile("s_waitcnt lgkmcnt(0)" ::: "memory");
              RF_PUT(0, oR); RF_PUT(1, oK); RF_PUT(2, oV); RF_FLUSH3(0, 1, 2, cblk);
              RF_PUT(0, oKK); RF_PUT(1, oAF); RF_PUT(2, oAB); RF_FLUSH3(3, 6, 7, cblk); }
        }
        sb = half_swap_sum(sb);
        if (hi == 0) ((float*)(F.ws + WS_SB))[(size_t)row * 16 + h] = sb;
    }
#undef RF_LOADG
#undef RF_STORET
#undef RF_SHIFT4
#undef RF_PUT
#undef RF_FLUSH3
}

__device__ __forceinline__ float gelu_tanh(float x) { return 0.5f * x * (1.f + tanhf_(0.7978845608028654f * (x + 0.044715f * x * x * x))); }
template <bool PASS3>
__device__ __forceinline__ void lru_item(Frame& F, int l, int item) {
    F.tid = ltid(); F.lane = F.tid & 63;
    const int sc = item >> 3, nb = item & 7, b = sc / NCH, ch = sc % NCH;
    int row0, seq_lo, seq_hi;
    if (ch < 8) { seq_lo = M_LAT + b * NCTX; seq_hi = seq_lo + NCTX; row0 = seq_lo + ch * 32; }
    else { seq_lo = b * SEQ; seq_hi = seq_lo + SEQ; row0 = seq_lo + (ch - 8) * 32; }
    const bf16* P = (const bf16*)(F.ws + WS_P);
    LAS float* U = (LAS float*)F.lds;
    LAS bf16* UA = (LAS bf16*)(F.lds + 16384);
    LAS float* AB = (LAS float*)(F.lds + 32768);
    __syncthreads();
    { const int tok = F.tid >> 4, c8 = (F.tid & 15) * 8, cg = nb * 128 + c8; float acc[8];
      const float* cb = INP(I_CONVB) + l * 1024 + cg;
#pragma unroll
      for (int e = 0; e < 8; ++e) acc[e] = cb[e];
#pragma unroll
      for (int j = 0; j < 4; ++j) { const int r = row0 + tok - 2 + j;
          if (r >= seq_lo && r < seq_hi) { const v4u x = *(const v4u*)(P + (size_t)r * DINP + C_LRUX + cg); const float* cw = INP(I_CONVW) + (size_t)(l * 4 + j) * 1024 + cg;
#pragma unroll
              for (int w = 0; w < 4; ++w) { acc[2 * w] += cw[2 * w] * bflo(x[w]); acc[2 * w + 1] += cw[2 * w + 1] * bfhi(x[w]); } } }
      *(LAS f32x4*)(U + tok * 128 + c8) = (f32x4){acc[0], acc[1], acc[2], acc[3]}; *(LAS f32x4*)(U + tok * 128 + c8 + 4) = (f32x4){acc[4], acc[5], acc[6], acc[7]};
      v4u o; o.x = pk2(acc[0], acc[1]); o.y = pk2(acc[2], acc[3]); o.z = pk2(acc[4], acc[5]); o.w = pk2(acc[6], acc[7]);
      *(LAS v4u*)(UA + tok * 136 + c8) = o; }
    __syncthreads();
    { const int dir = F.wave >> 2, cq = F.wave & 3, l32 = F.lane & 31, hi = F.lane >> 5, chn = cq * 32 + l32, cg = nb * 128 + chn;
      const bf16* Wr = (const bf16*)(F.wsw + WS_WLRU) + ((size_t)(dir * 2 + 0) * 8 + nb) * 16384 + (size_t)chn * 128;
      const bf16* Wi = (const bf16*)(F.wsw + WS_WLRU) + ((size_t)(dir * 2 + 1) * 8 + nb) * 16384 + (size_t)chn * 128;
      f32x16 accr = {}, acci = {};
#pragma unroll
      for (int ks = 0; ks < 8; ++ks) { const int ko = ks * 16 + hi * 8;
          const bf16x8 a = *(const LAS bf16x8*)(UA + l32 * 136 + ko); const bf16x8 br = *(const bf16x8*)(Wr + ko), bi = *(const bf16x8*)(Wi + ko);
          accr = __builtin_amdgcn_mfma_f32_32x32x16_bf16(a, br, accr, 0, 0, 0); acci = __builtin_amdgcn_mfma_f32_32x32x16_bf16(a, bi, acci, 0, 0, 0); }
      const float ba = INP(I_LBA)[(l * 2 + dir) * 1024 + cg], bi_ = INP(I_LBI)[(l * 2 + dir) * 1024 + cg], sp = softplusf_(-INP(I_LAM)[(l * 2 + dir) * 1024 + cg]);
#pragma unroll
      for (int r = 0; r < 16; ++r) { const int tok = att::crow(r, hi); const float u = U[tok * 128 + chn];
          const float rg = sigmoidf_(accr[r] + ba), ig = sigmoidf_(acci[r] + bi_), la = -8.f * rg * sp, a = __expf(la), x2 = 2.f * la;
          const float em = x2 * (1.f + x2 * (0.5f + x2 * (0.16666667f + x2 * (0.041666668f + x2 * (0.0083333338f + x2 * 0.0013888889f)))));
          const float bc = __builtin_amdgcn_sqrtf(x2 < -0.5f ? 1.f - a * a : -em) * (ig * u);
          AB[(dir * 2 + 0) * 4096 + tok * 128 + chn] = a; AB[(dir * 2 + 1) * 4096 + tok * 128 + chn] = bc; } }
    __syncthreads();
    if (F.tid < 256) { const int dir = F.tid >> 7, chn = F.tid & 127, cg = nb * 128 + chn; const size_t ci = ((size_t)(dir * 2 + b) * NCH + ch) * 1024 + cg;
        LAS float* Aa = AB + (dir * 2) * 4096 + chn; LAS float* Bb = AB + (dir * 2 + 1) * 4096 + chn;
        if (!PASS3) { float h = 0.f, ap = 1.f;
#pragma unroll 8
            for (int s = 0; s < 32; ++s) { const int tok = dir ? 31 - s : s; const float a = Aa[tok * 128]; h = a * h + Bb[tok * 128]; ap *= a;
                if (s == 0 && dir == 1 && ch == 7) ((float*)(F.ws + WS_QUIRK))[b * 1024 + cg] = h; }
            ((float*)(F.ws + WS_CA))[ci] = ap; ((float*)(F.ws + WS_CB))[ci] = h;
        } else { float h = ((const float*)(F.ws + WS_HIN))[ci];
#pragma unroll 8
            for (int s = 0; s < 32; ++s) { const int tok = dir ? 31 - s : s; h = Aa[tok * 128] * h + Bb[tok * 128]; Bb[tok * 128] = h; } } }
    if (PASS3) { __syncthreads();
        const int tok = F.tid >> 4, c8 = (F.tid & 15) * 8, cg = nb * 128 + c8, row = row0 + tok;
        const v4u y = *(const v4u*)(P + (size_t)row * DINP + C_LRUY + cg); float o[8];
#pragma unroll
        for (int w = 0; w < 4; ++w) { const float h0 = AB[4096 + tok * 128 + c8 + 2 * w] + AB[3 * 4096 + tok * 128 + c8 + 2 * w], h1 = AB[4096 + tok * 128 + c8 + 2 * w + 1] + AB[3 * 4096 + tok * 128 + c8 + 2 * w + 1];
            o[2 * w] = h0 * gelu_tanh(bflo(y[w])); o[2 * w + 1] = h1 * gelu_tanh(bfhi(y[w])); }
        v4u ov; ov.x = pk2(o[0], o[1]); ov.y = pk2(o[2], o[3]); ov.z = pk2(o[4], o[5]); ov.w = pk2(o[6], o[7]);
        *(v4u*)((bf16*)(F.ws + WS_MIX) + (size_t)row * DM + 1024 + cg) = ov; }
}
template <bool PASS3>
__device__ __forceinline__ void lru_items(Frame& F, int l, int i0, int i1, int st, bool skipctx) {
    F.tid = ltid(); F.lane = F.tid & 63;
    int it = i0; while (it < i1 && skipctx && ((it >> 3) % NCH) < 8) it += st;
    if (it >= i1) return;
    const int nb = it & 7;
    const bf16* P = (const bf16*)(F.ws + WS_P);
    LAS float* U = (LAS float*)F.lds; LAS bf16* UA = (LAS bf16*)(F.lds + 16384); LAS float* AB = (LAS float*)(F.lds + 32768);
    const int tokc = F.tid >> 4, c8 = (F.tid & 15) * 8, cgc = nb * 128 + c8;
    const int dir = F.wave >> 2, cq = F.wave & 3, l32 = F.lane & 31, hi = F.lane >> 5, chn = cq * 32 + l32, cg = nb * 128 + chn;
    f32x4 cbv[2], cwv[4][2];
#pragma unroll
    for (int q = 0; q < 2; ++q) { cbv[q] = *(const f32x4*)(INP(I_CONVB) + l * 1024 + cgc + 4 * q);
#pragma unroll
        for (int j = 0; j < 4; ++j) cwv[j][q] = *(const f32x4*)(INP(I_CONVW) + (size_t)(l * 4 + j) * 1024 + cgc + 4 * q); }
    bf16x8 wr[8], wi[8];
    { const bf16* Wr = (const bf16*)(F.wsw + WS_WLRU) + ((size_t)(dir * 2 + 0) * 8 + nb) * 16384 + (size_t)chn * 128;
      const bf16* Wi = (const bf16*)(F.wsw + WS_WLRU) + ((size_t)(dir * 2 + 1) * 8 + nb) * 16384 + (size_t)chn * 128;
#pragma unroll
      for (int ks = 0; ks < 8; ++ks) { wr[ks] = *(const bf16x8*)(Wr + ks * 16 + hi * 8); wi[ks] = *(const bf16x8*)(Wi + ks * 16 + hi * 8); } }
    const float ba = INP(I_LBA)[(l * 2 + dir) * 1024 + cg], bi_ = INP(I_LBI)[(l * 2 + dir) * 1024 + cg], sp = softplusf_(-INP(I_LAM)[(l * 2 + dir) * 1024 + cg]);
    v4u xr[4];
#define LRU_LOADX(it_) do { const int sc_ = (it_) >> 3, b_ = sc_ / NCH, ch_ = sc_ % NCH; const int lo_ = ch_ < 8 ? M_LAT + b_ * NCTX : b_ * SEQ, hi_ = lo_ + (ch_ < 8 ? NCTX : SEQ), r0_ = lo_ + (ch_ < 8 ? ch_ : ch_ - 8) * 32; \
        _Pragma("unroll") for (int j_ = 0; j_ < 4; ++j_) { const int r_ = r0_ + tokc - 2 + j_; xr[j_] = (v4u){0u, 0u, 0u, 0u}; if (r_ >= lo_ && r_ < hi_) xr[j_] = *(const v4u*)(P + (size_t)r_ * DINP + C_LRUX + cgc); } } while (0)
    LRU_LOADX(it);
#pragma unroll 1
    for (;;) {
        const int sc = it >> 3, b = sc / NCH, ch = sc % NCH;
        const int row0 = ch < 8 ? M_LAT + b * NCTX + ch * 32 : b * SEQ + (ch - 8) * 32;
        __syncthreads();
        { float acc[8];
#pragma unroll
          for (int e = 0; e < 8; ++e) acc[e] = cbv[e >> 2][e & 3];
#pragma unroll
          for (int j = 0; j < 4; ++j) {
#pragma unroll
              for (int w = 0; w < 4; ++w) { acc[2 * w] += cwv[j][(2 * w) >> 2][(2 * w) & 3] * bflo(xr[j][w]); acc[2 * w + 1] += cwv[j][(2 * w + 1) >> 2][(2 * w + 1) & 3] * bfhi(xr[j][w]); } }
          *(LAS f32x4*)(U + tokc * 128 + c8) = (f32x4){acc[0], acc[1], acc[2], acc[3]}; *(LAS f32x4*)(U + tokc * 128 + c8 + 4) = (f32x4){acc[4], acc[5], acc[6], acc[7]};
          v4u o; o.x = pk2(acc[0], acc[1]); o.y = pk2(acc[2], acc[3]); o.z = pk2(acc[4], acc[5]); o.w = pk2(acc[6], acc[7]);
          *(LAS v4u*)(UA + tokc * 136 + c8) = o; }
        int itn = it + st; while (itn < i1 && skipctx && ((itn >> 3) % NCH) < 8) itn += st;
        if (itn < i1) LRU_LOADX(itn);
        __syncthreads();
        { f32x16 accr = {}, acci = {};
#pragma unroll
          for (int ks = 0; ks < 8; ++ks) { const bf16x8 a = *(const LAS bf16x8*)(UA + l32 * 136 + ks * 16 + hi * 8);
              accr = __builtin_amdgcn_mfma_f32_32x32x16_bf16(a, wr[ks], accr, 0, 0, 0); acci = __builtin_amdgcn_mfma_f32_32x32x16_bf16(a, wi[ks], acci, 0, 0, 0); }
#pragma unroll
          for (int r = 0; r < 16; ++r) { const int tok = att::crow(r, hi); const float u = U[tok * 128 + chn];
              const float rg = sigmoidf_(accr[r] + ba), ig = sigmoidf_(acci[r] + bi_), la = -8.f * rg * sp, a = __expf(la), x2 = 2.f * la;
              const float em = x2 * (1.f + x2 * (0.5f + x2 * (0.16666667f + x2 * (0.041666668f + x2 * (0.0083333338f + x2 * 0.0013888889f)))));
              const float bc = __builtin_amdgcn_sqrtf(x2 < -0.5f ? 1.f - a * a : -em) * (ig * u);
              AB[(dir * 2 + 0) * 4096 + tok * 128 + chn] = a; AB[(dir * 2 + 1) * 4096 + tok * 128 + chn] = bc; } }
        __syncthreads();
        if (F.tid < 256) { const int dr = F.tid >> 7, cn = F.tid & 127, cgs = nb * 128 + cn; const size_t ci = ((size_t)(dr * 2 + b) * NCH + ch) * 1024 + cgs;
            LAS float* Aa = AB + (dr * 2) * 4096 + cn; LAS float* Bb = AB + (dr * 2 + 1) * 4096 + cn;
            if (!PASS3) { float h = 0.f, ap = 1.f;
#pragma unroll 8
                for (int s = 0; s < 32; ++s) { const int tok = dr ? 31 - s : s; const float a = Aa[tok * 128]; h = a * h + Bb[tok * 128]; ap *= a;
                    if (s == 0 && dr == 1 && ch == 7) ((float*)(F.ws + WS_QUIRK))[b * 1024 + cgs] = h; }
                ((float*)(F.ws + WS_CA))[ci] = ap; ((float*)(F.ws + WS_CB))[ci] = h;
            } else { float h = ((const float*)(F.ws + WS_HIN))[ci];
#pragma unroll 8
                for (int s = 0; s < 32; ++s) { const int tok = dr ? 31 - s : s; h = Aa[tok * 128] * h + Bb[tok * 128]; Bb[tok * 128] = h; } } }
        if (PASS3) { __syncthreads();
            const int cgo = nb * 128 + c8, row = row0 + tokc;
            const v4u y = *(const v4u*)(P + (size_t)row * DINP + C_LRUY + cgo); float o[8];
#pragma unroll
            for (int w = 0; w < 4; ++w) { const float h0 = AB[4096 + tokc * 128 + c8 + 2 * w] + AB[3 * 4096 + tokc * 128 + c8 + 2 * w], h1 = AB[4096 + tokc * 128 + c8 + 2 * w + 1] + AB[3 * 4096 + tokc * 128 + c8 + 2 * w + 1];
                o[2 * w] = h0 * gelu_tanh(bflo(y[w])); o[2 * w + 1] = h1 * gelu_tanh(bfhi(y[w])); }
            v4u ov; ov.x = pk2(o[0], o[1]); ov.y = pk2(o[2], o[3]); ov.z = pk2(o[4], o[5]); ov.w = pk2(o[6], o[7]);
            *(v4u*)((bf16*)(F.ws + WS_MIX) + (size_t)row * DM + 1024 + cgo) = ov; }
        if (itn >= i1) break;
        it = itn;
    }
#undef LRU_LOADX
}
__device__ __forceinline__ void lru_carry(Frame& F, int blk) {
    F.tid = ltid(); F.lane = F.tid & 63;
    const int gid = blk * NTHR + F.tid; if (gid >= 4096) return;
    const int dir = gid >> 11, b = (gid >> 10) & 1, cg = gid & 1023;
    const float* CA = (const float*)(F.ws + WS_CA) + ((size_t)(dir * 2 + b) * NCH) * 1024 + cg; const float* CB = (const float*)(F.ws + WS_CB) + ((size_t)(dir * 2 + b) * NCH) * 1024 + cg;
    float* HIN = (float*)(F.ws + WS_HIN) + ((size_t)(dir * 2 + b) * NCH) * 1024 + cg;
    float h = 0.f;
    if (dir == 0) {
#pragma unroll 8
        for (int c = 0; c < NCH; ++c) { HIN[(size_t)c * 1024] = h; h = CA[(size_t)c * 1024] * h + CB[(size_t)c * 1024]; }
    } else {
        for (int c = 7; c >= 0; --c) { HIN[(size_t)c * 1024] = h; h = CA[(size_t)c * 1024] * h + CB[(size_t)c * 1024]; }
        h = ((const float*)(F.ws + WS_QUIRK))[b * 1024 + cg];
#pragma unroll 8
        for (int c = NCH - 1; c >= 8; --c) { HIN[(size_t)c * 1024] = h; h = CA[(size_t)c * 1024] * h + CB[(size_t)c * 1024]; }
    }
}

__device__ __forceinline__ void rope_table(Frame& F) {
    const int i = F.vcu * NTHR + F.tid; if (i >= 2048) return;
    const int pos = i >> 4, f = i & 15; float s, c; sincosf((float)pos * exp2f(-(float)f * (13.287712379549449f / 16.f)), &s, &c);
    float* t = (float*)(F.ws + WS_ROPE); t[i] = c; t[2048 + i] = s;
}
__device__ __forceinline__ void row_prep(Frame& F, int row) {
    F.tid = ltid(); F.lane = F.tid & 63;
    bf16* pr = (bf16*)(F.ws + WS_P) + (size_t)row * DINP; const int lane = F.lane;
    const bool lat = row < M_LAT; const int t = row & (SEQ - 1); const float prow = (float)(t >> 6), pcol = (float)(t & 63);
    { const v4u a = *(const v4u*)(pr + C_QA + lane * 16), b = *(const v4u*)(pr + C_QA + lane * 16 + 8); float ss = 0.f;
#pragma unroll
      for (int w = 0; w < 4; ++w) { const float x0 = bflo(a[w]), x1 = bfhi(a[w]), x2 = bflo(b[w]), x3 = bfhi(b[w]); ss += x0 * x0 + x1 * x1 + x2 * x2 + x3 * x3; }
      ss = wave_sum(ss); if (lane == 0) ((float*)(F.ws + WS_RSQ))[row] = 1.f / sqrtf(ss * (1.f / 1024.f) + RMS_EPS); }
    { const v4u a = *(const v4u*)(pr + C_KVA + lane * 8); float ss = 0.f;
#pragma unroll
      for (int w = 0; w < 4; ++w) { const float x0 = bflo(a[w]), x1 = bfhi(a[w]); ss += x0 * x0 + x1 * x1; }
      ss = wave_sum(ss); if (lane == 0) ((float*)(F.ws + WS_RSKV))[row] = 1.f / sqrtf(ss * (1.f / 512.f) + RMS_EPS); }
    bf16* kr = (bf16*)(F.ws + WS_KR) + (size_t)row * 64;
    if (lat) {
        { const int part = lane >> 5, sub = lane & 31;
          const float inv = exp2f(-(float)sub * (13.287712379549449f / 32.f)); float sn, cs; sincosf((part ? pcol : prow) * inv, &sn, &cs);
#pragma unroll
          for (int hd = 0; hd < 10; ++hd) { bf16* qb = pr + (hd < 8 ? C_SWAQ + hd * 128 : C_SWAK + (hd - 8) * 128) + part * 64;
              const float x1 = bf2f(qb[sub]), x2 = bf2f(qb[sub + 32]); qb[sub] = (bf16)f2bf(x1 * cs - x2 * sn); qb[sub + 32] = (bf16)f2bf(x2 * cs + x1 * sn); } }
        if (lane < 32) { const int part = lane >> 4, i = lane & 15; const bf16* src = pr + C_KR + part * 32;
          const float inv = exp2f(-(float)i * (13.287712379549449f / 16.f)); float s, c; sincosf((part ? pcol : prow) * inv, &s, &c);
          const float x1 = bf2f(src[i]), x2 = bf2f(src[i + 16]);
          kr[part * 32 + i] = (bf16)f2bf(x1 * c - x2 * s); kr[part * 32 + i + 16] = (bf16)f2bf(x2 * c + x1 * s); }
    } else kr[lane] = pr[C_KR + lane];
}

__device__ __forceinline__ float allred16(float x) { return row_sum16(x); }
__device__ __forceinline__ int scan_row(int s, int dir, int b) {
    if (s < NCTX) return M_LAT + b * NCTX + (dir ? NCTX - 1 - s : s);
    const int t = s - NCTX; return b * SEQ + (dir ? SEQ - 1 - t : t);
}
__device__ __forceinline__ void rwkv_scan(Frame& F, int l, int chain) {
    F.tid = ltid(); F.lane = F.tid & 63;
    const int dir = chain >> 5, b = (chain >> 4) & 1, h = chain & 15;
    constexpr int CT = 24, NCHK = (NCTX + SEQ) / CT, STEPF = 392, BUFF = CT * STEPF;
    LAS float* buf = (LAS float*)F.lds; LAS float* ybuf = (LAS float*)(F.lds + 3 * BUFF * 4);
    gcbf RWF = (gcbf)(F.ws + WS_RWF); const size_t RS = (size_t)M_TOT * 1024;
    gflp YS = (gflp)(F.ws + WS_YS) + (size_t)dir * M_TOT * 1024;
    const bool cmp = F.wave < 4; const int lt = F.tid - 256, lst = lt >> 4, lq = lt & 15, lc = h * 64 + 4 * lq;
    const f32x4 ka4 = *(const GAS f32x4*)((gcfl)INP(I_KA) + l * 1024 + (cmp ? 0 : lc));
    v2u gr[2], gk[2], gv[2], gkk[2], ge[2], ga[2];
#pragma unroll
    for (int u = 0; u < 2; ++u) { gr[u] = (v2u){0u, 0u}; gk[u] = gr[u]; gv[u] = gr[u]; gkk[u] = gr[u]; ge[u] = gr[u]; ga[u] = gr[u]; }
#define RW_LOAD(c) do { if (!cmp) { _Pragma("unroll") for (int u_ = 0; u_ < 2; ++u_) { const int s_ = lst + 16 * u_; if (s_ < CT) { const size_t o_ = (size_t)scan_row((c) * CT + s_, dir, b) * 1024 + lc; \
        gr[u_] = *(const GAS v2u*)(RWF + 0 * RS + o_); gk[u_] = *(const GAS v2u*)(RWF + 1 * RS + o_); gv[u_] = *(const GAS v2u*)(RWF + 2 * RS + o_); \
        gkk[u_] = *(const GAS v2u*)(RWF + 3 * RS + o_); ge[u_] = *(const GAS v2u*)(RWF + (4 + dir) * RS + o_); ga[u_] = *(const GAS v2u*)(RWF + (6 + dir) * RS + o_); } } } } while (0)
#define RW_WRITE(bi) do { if (!cmp) { _Pragma("unroll") for (int u_ = 0; u_ < 2; ++u_) { const int s_ = lst + 16 * u_; if (s_ < CT) { LAS float* d_ = buf + (bi) * BUFF + s_ * STEPF + 4 * lq; \
        const float r_[4] = {bflo(gr[u_].x), bfhi(gr[u_].x), bflo(gr[u_].y), bfhi(gr[u_].y)}, k_[4] = {bflo(gk[u_].x), bfhi(gk[u_].x), bflo(gk[u_].y), bfhi(gk[u_].y)}, v_[4] = {bflo(gv[u_].x), bfhi(gv[u_].x), bflo(gv[u_].y), bfhi(gv[u_].y)}; \
        const float q_[4] = {bflo(gkk[u_].x), bfhi(gkk[u_].x), bflo(gkk[u_].y), bfhi(gkk[u_].y)}, e_[4] = {bflo(ge[u_].x), bfhi(ge[u_].x), bflo(ge[u_].y), bfhi(ge[u_].y)}, a_[4] = {bflo(ga[u_].x), bfhi(ga[u_].x), bflo(ga[u_].y), bfhi(ga[u_].y)}; \
        f32x4 w4, kd4, kk4, b4, wr4, v4; float sbr = 0.f, skr = 0.f; \
        _Pragma("unroll") for (int e = 0; e < 4; ++e) { w4[e] = __expf(-e_[e]); kd4[e] = k_[e] * (1.f + (a_[e] - 1.f) * ka4[e]); kk4[e] = q_[e]; b4[e] = q_[e] * a_[e]; wr4[e] = w4[e] * r_[e]; v4[e] = v_[e]; sbr += b4[e] * r_[e]; skr += kd4[e] * r_[e]; } \
        sbr = row_sum16(sbr); skr = row_sum16(skr); \
        *(LAS f32x4*)(d_) = w4; *(LAS f32x4*)(d_ + 64) = kd4; *(LAS f32x4*)(d_ + 128) = kk4; *(LAS f32x4*)(d_ + 192) = b4; *(LAS f32x4*)(d_ + 256) = wr4; *(LAS f32x4*)(d_ + 320) = v4; \
        if (lq == 0) *(LAS f32x2*)(buf + (bi) * BUFF + s_ * STEPF + 384) = (f32x2){sbr, skr}; } } } } while (0)
#define RW_FLUSH(c) do { if (!cmp) { _Pragma("unroll") for (int u_ = 0; u_ < 2; ++u_) { const int s_ = lst + 16 * u_; if (s_ < CT) { const f32x4 y_ = *(const LAS f32x4*)(ybuf + ((c) & 1) * (CT * 64) + s_ * 64 + 4 * lq); \
        *(GAS f32x4*)(YS + (size_t)scan_row((c) * CT + s_, dir, b) * 1024 + lc) = y_; } } } } while (0)
    __syncthreads();
    RW_LOAD(0); RW_WRITE(0); RW_LOAD(1); RW_WRITE(1); RW_LOAD(2);
    __syncthreads();
    const int kg = F.lane & 7, rg = F.lane >> 3, r0 = 16 * (F.wave & 3) + 2 * rg;
    f32x2 St[8];
#pragma unroll
    for (int i = 0; i < 8; ++i) St[i] = (f32x2){0.f, 0.f};
    int bc = 0, bw = 2;
#pragma unroll 1
    for (int c = 0; c < NCHK; ++c) {
        if (c + 2 < NCHK) { RW_WRITE(bw); if (c + 3 < NCHK) RW_LOAD(c + 3); }
        if (c > 0) RW_FLUSH(c - 1);
        if (cmp) {
        const LAS float* bb = buf + bc * BUFF + 8 * kg; const LAS float* vb = buf + bc * BUFF + 320 + r0; const LAS float* sb = buf + bc * BUFF + 384;
        LAS float* yb = ybuf + (c & 1) * (CT * 64) + r0;
        f32x4 w4[2], kd4[2], kk4[2], b4[2], wr4[2];
#pragma unroll
        for (int q = 0; q < 2; ++q) { w4[q] = *(const LAS f32x4*)(bb + 4 * q); kd4[q] = *(const LAS f32x4*)(bb + 64 + 4 * q); kk4[q] = *(const LAS f32x4*)(bb + 128 + 4 * q); b4[q] = *(const LAS f32x4*)(bb + 192 + 4 * q); wr4[q] = *(const LAS f32x4*)(bb + 256 + 4 * q); }
        f32x2 v2 = *(const LAS f32x2*)(vb), s2 = *(const LAS f32x2*)(sb);
#pragma unroll
        for (int st = 0; st < CT; ++st) {
            const int sn = (st + 1 < CT ? st + 1 : st) * STEPF;
            f32x4 nw4[2], nkd4[2], nkk4[2], nb4[2], nwr4[2];
#pragma unroll
            for (int q = 0; q < 2; ++q) { nw4[q] = *(const LAS f32x4*)(bb + sn + 4 * q); nkd4[q] = *(const LAS f32x4*)(bb + sn + 64 + 4 * q); nkk4[q] = *(const LAS f32x4*)(bb + sn + 128 + 4 * q); nb4[q] = *(const LAS f32x4*)(bb + sn + 192 + 4 * q); nwr4[q] = *(const LAS f32x4*)(bb + sn + 256 + 4 * q); }
            const f32x2 nv2 = *(const LAS f32x2*)(vb + sn), ns2 = *(const LAS f32x2*)(sb + sn);
#define PR(x, e) ((((e) >> 1) & 1) ? (f32x2){(x)[(e) >> 2][2], (x)[(e) >> 2][3]} : (f32x2){(x)[(e) >> 2][0], (x)[(e) >> 2][1]})
            f32x2 p, z, tpb, tzb;
            asm("v_pk_mul_f32 %0, %4, %12 op_sel:[0,0] op_sel_hi:[1,0]\n\tv_pk_mul_f32 %1, %4, %16 op_sel:[0,0] op_sel_hi:[1,0]\n\tv_pk_mul_f32 %2, %8, %14 op_sel:[0,0] op_sel_hi:[1,0]\n\tv_pk_mul_f32 %3, %8, %18 op_sel:[0,0] op_sel_hi:[1,0]\n\tv_pk_fma_f32 %0, %5, %12, %0 op_sel:[0,1,0] op_sel_hi:[1,1,1]\n\tv_pk_fma_f32 %1, %5, %16, %1 op_sel:[0,1,0] op_sel_hi:[1,1,1]\n\tv_pk_fma_f32 %2, %9, %14, %2 op_sel:[0,1,0] op_sel_hi:[1,1,1]\n\tv_pk_fma_f32 %3, %9, %18, %3 op_sel:[0,1,0] op_sel_hi:[1,1,1]\n\tv_pk_fma_f32 %0, %6, %13, %0 op_sel:[0,0,0] op_sel_hi:[1,0,1]\n\tv_pk_fma_f32 %1, %6, %17, %1 op_sel:[0,0,0] op_sel_hi:[1,0,1]\n\tv_pk_fma_f32 %2, %10, %15, %2 op_sel:[0,0,0] op_sel_hi:[1,0,1]\n\tv_pk_fma_f32 %3, %10, %19, %3 op_sel:[0,0,0] op_sel_hi:[1,0,1]\n\tv_pk_fma_f32 %0, %7, %13, %0 op_sel:[0,1,0] op_sel_hi:[1,1,1]\n\tv_pk_fma_f32 %1, %7, %17, %1 op_sel:[0,1,0] op_sel_hi:[1,1,1]\n\tv_pk_fma_f32 %2, %11, %15, %2 op_sel:[0,1,0] op_sel_hi:[1,1,1]\n\tv_pk_fma_f32 %3, %11, %19, %3 op_sel:[0,1,0] op_sel_hi:[1,1,1]\n\tv_pk_add_f32 %0, %0, %2\n\tv_pk_add_f32 %1, %1, %3\n\tv_pk_mul_f32 %4, %4, %20 op_sel:[0,0] op_sel_hi:[1,0]\n\tv_pk_mul_f32 %5, %5, %20 op_sel:[0,1] op_sel_hi:[1,1]\n\tv_pk_mul_f32 %6, %6, %21 op_sel:[0,0] op_sel_hi:[1,0]\n\tv_pk_mul_f32 %7, %7, %21 op_sel:[0,1] op_sel_hi:[1,1]\n\tv_pk_mul_f32 %8, %8, %22 op_sel:[0,0] op_sel_hi:[1,0]\n\tv_pk_mul_f32 %9, %9, %22 op_sel:[0,1] op_sel_hi:[1,1]\n\tv_pk_mul_f32 %10, %10, %23 op_sel:[0,0] op_sel_hi:[1,0]\n\tv_pk_mul_f32 %11, %11, %23 op_sel:[0,1] op_sel_hi:[1,1]\n\tv_pk_fma_f32 %4, %28, %24, %4 op_sel:[0,0,0] op_sel_hi:[1,0,1]\n\tv_pk_fma_f32 %5, %28, %24, %5 op_sel:[0,1,0] op_sel_hi:[1,1,1]\n\tv_pk_fma_f32 %6, %28, %25, %6 op_sel:[0,0,0] op_sel_hi:[1,0,1]\n\tv_pk_fma_f32 %7, %28, %25, %7 op_sel:[0,1,0] op_sel_hi:[1,1,1]\n\tv_pk_fma_f32 %8, %28, %26, %8 op_sel:[0,0,0] op_sel_hi:[1,0,1]\n\tv_pk_fma_f32 %9, %28, %26, %9 op_sel:[0,1,0] op_sel_hi:[1,1,1]\n\tv_pk_fma_f32 %10, %28, %27, %10 op_sel:[0,0,0] op_sel_hi:[1,0,1]\n\tv_pk_fma_f32 %11, %28, %27, %11 op_sel:[0,1,0] op_sel_hi:[1,1,1]"
                : "=&v"(p), "=&v"(z), "=&v"(tpb), "=&v"(tzb), "+v"(St[0]), "+v"(St[1]), "+v"(St[2]), "+v"(St[3]), "+v"(St[4]), "+v"(St[5]), "+v"(St[6]), "+v"(St[7])
                : "v"(PR(kk4, 0)), "v"(PR(kk4, 2)), "v"(PR(kk4, 4)), "v"(PR(kk4, 6)), "v"(PR(wr4, 0)), "v"(PR(wr4, 2)), "v"(PR(wr4, 4)), "v"(PR(wr4, 6)),
                  "v"(PR(w4, 0)), "v"(PR(w4, 2)), "v"(PR(w4, 4)), "v"(PR(w4, 6)), "v"(PR(kd4, 0)), "v"(PR(kd4, 2)), "v"(PR(kd4, 4)), "v"(PR(kd4, 6)), "v"(v2));
            float p0 = p.x, p1 = p.y, z0 = z.x, z1 = z.y;
#define D4(ctl) "v_add_f32_dpp %0, %0, %0 " ctl " row_mask:0xf bank_mask:0xf\n\tv_add_f32_dpp %1, %1, %1 " ctl " row_mask:0xf bank_mask:0xf\n\tv_add_f32_dpp %2, %2, %2 " ctl " row_mask:0xf bank_mask:0xf\n\tv_add_f32_dpp %3, %3, %3 " ctl " row_mask:0xf bank_mask:0xf\n\t"
            asm volatile("s_nop 1\n\t" D4("quad_perm:[1,0,3,2]") D4("quad_perm:[2,3,0,1]") D4("row_half_mirror") "s_nop 0"
                : "+v"(p0), "+v"(p1), "+v"(z0), "+v"(z1));
#undef D4
            const f32x2 pp = {p0, p1}, zz = {z0, z1};
            { f32x2 y;
              asm("v_pk_fma_f32 %0, %9, %11, %10 op_sel:[0,0,0] op_sel_hi:[1,0,1] neg_lo:[1,0,0] neg_hi:[1,0,0]\n\tv_pk_fma_f32 %0, %12, %11, %0 op_sel:[0,1,0] op_sel_hi:[1,1,1]\n\tv_pk_fma_f32 %1, %9, %13, %1 op_sel:[0,0,0] op_sel_hi:[1,0,1] neg_lo:[1,0,0] neg_hi:[1,0,0]\n\tv_pk_fma_f32 %2, %9, %13, %2 op_sel:[0,1,0] op_sel_hi:[1,1,1] neg_lo:[1,0,0] neg_hi:[1,0,0]\n\tv_pk_fma_f32 %3, %9, %14, %3 op_sel:[0,0,0] op_sel_hi:[1,0,1] neg_lo:[1,0,0] neg_hi:[1,0,0]\n\tv_pk_fma_f32 %4, %9, %14, %4 op_sel:[0,1,0] op_sel_hi:[1,1,1] neg_lo:[1,0,0] neg_hi:[1,0,0]\n\tv_pk_fma_f32 %5, %9, %15, %5 op_sel:[0,0,0] op_sel_hi:[1,0,1] neg_lo:[1,0,0] neg_hi:[1,0,0]\n\tv_pk_fma_f32 %6, %9, %15, %6 op_sel:[0,1,0] op_sel_hi:[1,1,1] neg_lo:[1,0,0] neg_hi:[1,0,0]\n\tv_pk_fma_f32 %7, %9, %16, %7 op_sel:[0,0,0] op_sel_hi:[1,0,1] neg_lo:[1,0,0] neg_hi:[1,0,0]\n\tv_pk_fma_f32 %8, %9, %16, %8 op_sel:[0,1,0] op_sel_hi:[1,1,1] neg_lo:[1,0,0] neg_hi:[1,0,0]"
                : "=&v"(y), "+v"(St[0]), "+v"(St[1]), "+v"(St[2]), "+v"(St[3]), "+v"(St[4]), "+v"(St[5]), "+v"(St[6]), "+v"(St[7])
                : "v"(pp), "v"(zz), "v"(s2), "v"(v2), "v"(PR(b4, 0)), "v"(PR(b4, 2)), "v"(PR(b4, 4)), "v"(PR(b4, 6)));
              *(LAS f32x2*)(yb + st * 64) = y; }
#undef PR
#pragma unroll
            for (int q = 0; q < 2; ++q) { w4[q] = nw4[q]; kd4[q] = nkd4[q]; kk4[q] = nkk4[q]; b4[q] = nb4[q]; wr4[q] = nwr4[q]; }
            v2 = nv2; s2 = ns2;
        }
        }
        __syncthreads();
        bc = bc == 2 ? 0 : bc + 1; bw = bw == 2 ? 0 : bw + 1;
    }
    RW_FLUSH(NCHK - 1);
#undef RW_LOAD
#undef RW_WRITE
#undef RW_FLUSH
}
__device__ __forceinline__ void rwkv_out_row(Frame& F, int l, int row) {
    F.tid = ltid(); F.lane = F.tid & 63;
    const int c0 = F.lane * 16; const float* yf = (const float*)(F.ws + WS_YS) + (size_t)row * 1024 + c0; const float* yb = yf + (size_t)M_TOT * 1024;
    float y[16]; float s = 0.f;
#pragma unroll
    for (int j = 0; j < 4; ++j) { const f32x4 a = __builtin_nontemporal_load((const f32x4*)(yf + 4 * j)), b = __builtin_nontemporal_load((const f32x4*)(yb + 4 * j));
#pragma unroll
        for (int e = 0; e < 4; ++e) { y[4 * j + e] = a[e] + b[e]; s += y[4 * j + e]; } }
    s = quad_sum(s); const float mu = s * (1.f / 64.f); float q = 0.f;
#pragma unroll
    for (int e = 0; e < 16; ++e) { y[e] -= mu; q += y[e] * y[e]; }
    q = quad_sum(q); const float rstd = 1.f / sqrtf(q * (1.f / 64.f) + GN_EPS);
    const bf16* RWF = (const bf16*)(F.ws + WS_RWF); const size_t RS = (size_t)M_TOT * 1024, o = (size_t)row * 1024 + c0;
    const float sbv = ((const float*)(F.ws + WS_SB))[(size_t)row * 16 + (F.lane >> 2)];
    const float* lg = INP(I_LNG) + l * 1024 + c0; const float* lb = INP(I_LNB) + l * 1024 + c0;
    bf16* dst = (bf16*)(F.ws + WS_MIX) + (size_t)row * DM + 3072 + c0;
#pragma unroll
    for (int hf = 0; hf < 2; ++hf) { const v4u vv = *(const v4u*)(RWF + 2 * RS + o + 8 * hf), gg = *(const v4u*)(RWF + 8 * RS + o + 8 * hf); float r[8];
#pragma unroll
        for (int w = 0; w < 4; ++w) { const int e = 8 * hf + 2 * w;
            r[2 * w] = (y[e] * rstd * lg[e] + lb[e] + sbv * bflo(vv[w])) * bflo(gg[w]); r[2 * w + 1] = (y[e + 1] * rstd * lg[e + 1] + lb[e + 1] + sbv * bfhi(vv[w])) * bfhi(gg[w]); }
        v4u ov; ov.x = pk2(r[0], r[1]); ov.y = pk2(r[2], r[3]); ov.z = pk2(r[4], r[5]); ov.w = pk2(r[6], r[7]); *(v4u*)(dst + 8 * hf) = ov; }
}

#ifndef W_OUT_K1
#define W_OUT_K1 2048
#endif
struct MlaTiles { gcbf KV; gcbf KR; int ctx_row0, lat_row0, h;
    __device__ __forceinline__ att::Tile operator()(int j) const { const int row = j < 4 ? ctx_row0 + 64 * j : lat_row0 + 64 * (j - 4);
        att::Tile t; t.kn = KV + (size_t)row * 2048 + h * 256; t.v = t.kn + 128; t.kr = KR + (size_t)row * 64; t.mtype = 0; t.krel0 = 0; return t; } };
struct SwaTiles { gcbf P; int blk_row0, ctx_row0, kvh, nwin, has_prev, has_next;
    __device__ __forceinline__ att::Tile operator()(int j) const { att::Tile t; int row; t.mtype = 0; t.krel0 = 0;
        if (j >= nwin) row = ctx_row0 + 64 * (j - nwin);
        else if (j < 2) row = blk_row0 + 64 * j;
        else if (has_prev && j < 4) { row = blk_row0 - 128 + 64 * (j - 2); t.mtype = 1; t.krel0 = -128 + 64 * (j - 2); }
        else { const int sub = j - 2 - 2 * has_prev; row = blk_row0 + 128 + 64 * sub; t.mtype = 2; t.krel0 = 128 + 64 * sub; }
        t.kn = P + (size_t)row * DINP + C_SWAK + kvh * 128; t.v = P + (size_t)row * DINP + C_SWAV + kvh * 128; t.kr = nullptr; return t; } };

#ifndef MLA_SDEPTH
#define MLA_SDEPTH 1
#endif
__device__ __forceinline__ void mla_item(Frame& F, int b, int h, int qb, bool ctxq) {
    F.tid = ltid(); F.lane = F.tid & 63;
    const int r32 = F.lane & 31; const int t = qb * 256 + F.wave * 32 + r32;
    const int roww0 = ctxq ? M_LAT + b * NCTX + F.wave * 32 : b * SEQ + qb * 256 + F.wave * 32;
    gcbf Qw = (gcbf)(F.ws + WS_Q) + (size_t)(roww0 + r32) * 1536 + h * 192;
    MlaTiles ts{(gcbf)(F.ws + WS_KV), (gcbf)(F.ws + WS_KR), M_LAT + b * NCTX, b * SEQ, h};
    gbfp Ow = (gbfp)(F.ws + WS_MIX) + (size_t)roww0 * DM + 2048 + h * 128;
    att::attn_body<192, 2048, 2048, false, false, MLA_SDEPTH>(Qw, ctxq ? 0 : 1, t >> 6, t & 63, (gcfl)(F.ws + WS_ROPE), 0, 0.f, ts, ctxq ? 4 : 132, Ow, (LAS char*)F.lds);
}
__device__ __forceinline__ void swa_item(Frame& F, int l, int b, int n, int kvh, int half, bool ctxq, int hq_ctx) {
    F.tid = ltid(); F.lane = F.tid & 63;
    const int r32 = F.lane & 31; gcbf P = (gcbf)(F.ws + WS_P);
    int hq, qi, roww0, t;
    if (ctxq) { hq = hq_ctx; kvh = hq >> 2; qi = 0; roww0 = M_LAT + b * NCTX + F.wave * 32; t = 0; }
    else { hq = kvh * 4 + 2 * half + (F.wave >> 2); qi = (F.wave & 3) * 32 + r32; roww0 = b * SEQ + n * 128 + (F.wave & 3) * 32; t = n * 128 + qi; }
    gcbf Qw = P + (size_t)(roww0 + r32) * DINP + C_SWAQ + hq * 128;
    SwaTiles ts; ts.P = P; ts.blk_row0 = b * SEQ + n * 128; ts.ctx_row0 = M_LAT + b * NCTX; ts.kvh = kvh;
    ts.has_prev = (!ctxq && n > 0) ? 1 : 0; ts.has_next = (!ctxq && n < SEQ / 128 - 1) ? 1 : 0; ts.nwin = ctxq ? 0 : 2 + 2 * ts.has_prev + 2 * ts.has_next;
    gbfp Ow = (gbfp)(F.ws + WS_MIX) + (size_t)roww0 * DM + hq * 128;
    const float sink_l2 = INP(I_SINK)[l * 8 + hq] * 1.4426950408889634f;
    att::attn_body<128, DINP, DINP, true, true, 2>(Qw, 0, 0, 0, (gcfl)nullptr, qi, sink_l2, ts, ts.nwin + 4, Ow, (LAS char*)F.lds);
}

#ifndef DBG_PHASES
#define DBG_PHASES 0xfffff
#endif
#define PH(n) ((DBG_PHASES >> (n)) & 1)
#ifndef DUP_PHASES
#define DUP_PHASES 0
#endif
#define REP(n) _Pragma("unroll") for (int rep_ = 0; rep_ < (((DUP_PHASES >> (n)) & 1) ? 2 : 1); ++rep_)
__global__ void __launch_bounds__(NTHR, 2) mk_fwd(Args args) {
    extern __shared__ __attribute__((aligned(16))) unsigned char lds[];
    Frame F;
    F.lds = (LAS unsigned char*)lds;
    F.tid = threadIdx.x; F.lane = F.tid & 63; F.wave = __builtin_amdgcn_readfirstlane(F.tid >> 6);
    F.G = gridDim.x; { const int bx = blockIdx.x; F.vcu = (F.G % 8 == 0) ? (bx % 8) * (F.G / 8) + bx / 8 : bx; }
    F.gw = F.vcu * NWAVES + F.wave; F.NGW = F.G * NWAVES;
    F.ws = args.ws; F.out = args.out; F.ctl = (gu32*)(args.ws + WS_CTL);
    F.A = (const __attribute__((address_space(4))) Args*)__builtin_amdgcn_kernarg_segment_ptr();
    for (int u = F.tid; u < (LDS_BYTES - LDSCTL_OFF) / 4; u += NTHR) ((LAS unsigned*)(F.lds + LDSCTL_OFF))[u] = 0u;
    __syncthreads();
    XcdBarrier bar = xcd_barrier_post((unsigned*)(args.ws + WS_CTL) + 4096, (volatile LAS unsigned*)(F.lds + MISC_OFF) + 8);
    const bool rwkv_blk = (blockIdx.x & 3) == 0;
    XcdBarrier bar2; bar2.bar = (unsigned*)(args.ws + WS_CTL) + 8192; bar2.x = 0; bar2.st = (volatile LAS unsigned*)(F.lds + MISC_OFF) + 12; bar2.nparts = gridDim.x - ((gridDim.x + 3) >> 2);
    if (!rwkv_blk) { const unsigned np_ = bar2.nparts; bar2 = xcd_barrier_post((unsigned*)(args.ws + WS_CTL) + 8192, (volatile LAS unsigned*)(F.lds + MISC_OFF) + 12); bar2.nparts = np_; }
#define SUB_BAR() do { bar2.bar = launder(bar2.bar); bar2.x = launder(bar2.x); xcd_barrier(bar2); F.ws = launder_g(F.ws); F.wsw = F.ws + (size_t)lcur * WSET_STRIDE; F.A = launder(F.A); F.tid = ltid(); F.lane = F.tid & 63; } while (0)
#define GRID_BAR() do { bar.bar = launder(bar.bar); bar.x = launder(bar.x); xcd_barrier(bar); F.ws = launder_g(F.ws); F.wsw = F.ws + (size_t)lcur * WSET_STRIDE; F.A = launder(F.A); F.tid = ltid(); F.lane = F.tid & 63; } while (0)
    const int bx = blockIdx.x; int lcur = 0; F.wsw = F.ws;
    bf16* H = (bf16*)(F.ws + WS_H); xres_t* X = (xres_t*)(F.ws + WS_X);

    REP(0) if (PH(0)) { mod_partials(F);
    convert_weights(F, 0, F.gw, F.NGW); }
    GRID_BAR();
    if (PH(1)) { mod_reduce(F); rope_table(F); }
    GRID_BAR();

#pragma unroll 1
    for (int l = 0; l < 2; ++l) {
        lcur = l; F.wsw = F.ws + (size_t)l * WSET_STRIDE;
        const bool wctx = (l == 0);
        const int MO = wctx ? M_TOT : M_LAT;
        if (PH(2) && l == 0) {
            int cs = -1;
            for (int row = F.gw; row < M_TOT; row += F.NGW) { const int s = row_s(row);
                if (s != cs) { __syncthreads(); ln_stage(F, LNV_SC, mod_ptr(F, 0, s, 1)); ln_stage(F, LNV_SH, mod_ptr(F, 0, s, 0)); __syncthreads(); cs = s; }
                const float* xs = row < M_LAT ? INP(I_X) + (size_t)row * DM : INP(I_CTX) + (size_t)(row - M_LAT) * DM;
                ln_row<0>(F, xs, nullptr, nullptr, true, H + (size_t)row * DM); }
            __syncthreads();
        }
        GRID_BAR();
        REP(3) if (PH(3)) { pg8::Gemm g{H, (const bf16*)(F.wsw + WS_WIN), M_TOT, DINP, DM, DM, DM}; pg8::StaticOrder S; S.init(M_TOT, DINP, F.G, bx);
          pg8::EpiBf16<0> E{(bf16*)(F.ws + WS_P), DINP, nullptr};
          pg8::gemm_phase<pg8::EpiBf16<0>, pg8::StaticOrder, true, true>(F.lds, g, S, E); }
        GRID_BAR();
        REP(4) if (PH(4)) for (int it = F.vcu; it < 528; it += F.G) rwkv_feat_item(F, l, it);
        REP(5) if (PH(5)) { if (F.G == 256) { if (F.vcu < 16) lru_items<false>(F, l, F.vcu, 64, 16, false);
                                              else lru_items<false>(F, l, 64 + F.vcu - 16, 2 * NCH * 8, 240, false); }
                            else for (int it = F.vcu; it < 2 * NCH * 8; it += F.G) lru_item<false>(F, l, it); }
        __syncthreads();
        if (PH(6)) for (int row = F.gw; row < M_TOT; row += F.NGW) row_prep(F, row);
        GRID_BAR();
        REP(8) if (rwkv_blk) { const int nrw = (F.G + 3) >> 2; REP(18) if (PH(8)) for (int chain = bx >> 2; chain < 64; chain += nrw) rwkv_scan(F, l, chain); }
        else REP(19) { const int x8 = bx & 7, naw = F.G - ((F.G + 3) >> 2);
            const int aw = (F.G == 256) ? ((x8 < 4 ? x8 - 1 : x8 - 2) * 32 + (bx >> 3)) : ((bx >> 2) * 3 + (bx & 3) - 1);
            if (PH(7) && aw < 8) lru_carry(F, aw);
            if (PH(7)) { pg8::Gemm g{(const bf16*)(F.ws + WS_P) + C_QA, (const bf16*)(F.wsw + WS_WQB), M_TOT, 1536, 1024, DINP, 1024}; pg8::StaticOrder S; S.init(M_TOT, 1536, naw, aw);
              pg8::EpiBf16<2> E{(bf16*)(F.ws + WS_Q), 1536, (const float*)(F.ws + WS_RSQ)};
              pg8::gemm_phase<pg8::EpiBf16<2>, pg8::StaticOrder, true, true>(F.lds, g, S, E); }
            if (PH(7)) { pg8::Gemm g{(const bf16*)(F.ws + WS_P) + C_KVA, (const bf16*)(F.wsw + WS_WKVB), M_TOT, 2048, 512, DINP, 512}; pg8::StaticOrder S; S.init(M_TOT, 2048, naw, aw);
              pg8::EpiBf16<2> E{(bf16*)(F.ws + WS_KV), 2048, (const float*)(F.ws + WS_RSKV)};
              pg8::gemm_phase<pg8::EpiBf16<2>, pg8::StaticOrder, true, true>(F.lds, g, S, E); }
            SUB_BAR();
            if (PH(9)) for (int it = aw; it < 512; it += naw) mla_item(F, it >> 8, (it >> 5) & 7, it & 31, false);
            if (PH(9) && wctx) for (int it = aw; it < 16; it += naw) mla_item(F, it >> 3, it & 7, 0, true);
            if (PH(10)) for (int it = aw; it < 512; it += naw) swa_item(F, l, it >> 8, (it >> 2) & 63, (it >> 1) & 1, it & 1, false, 0);
            if (PH(10) && wctx) for (int it = aw; it < 16; it += naw) swa_item(F, l, it >> 3, 0, 0, 0, true, it & 7);
            if (PH(11)) { if (naw == 192) { const int i0 = aw < 128 ? aw : 1280 + aw - 128, st_ = aw < 128 ? 128 : 64, i1 = aw < 128 ? 1280 : 2 * NCH * 8;
                                            lru_items<true>(F, l, i0, i1, st_, !wctx); }
                          else for (int it = aw; it < 2 * NCH * 8; it += naw) { if (!wctx && ((it >> 3) % NCH) < 8) continue; lru_item<true>(F, l, it); } }
            if (l == 0) { __syncthreads(); convert_weights(F, 1, aw * NWAVES + F.wave, naw * NWAVES); }
            else { SUB_BAR();
                pg8::Gemm g{(const bf16*)(F.ws + WS_MIX), (const bf16*)(F.wsw + WS_WOUT), M_LAT, DM, W_OUT_K1, DM, DM}; pg8::StaticOrder S; S.init(M_LAT, DM, naw, aw);
                pg8::EpiBf16<0> E{(bf16*)(F.ws + WS_Y1), DM, nullptr};
                pg8::gemm_phase<pg8::EpiBf16<0>, pg8::StaticOrder, true, true>(F.lds, g, S, E); }
        }
        GRID_BAR();
        REP(12) if (PH(12)) for (int row = F.gw; row < MO; row += F.NGW) rwkv_out_row(F, l, row);
        GRID_BAR();
        REP(13) if (PH(13)) {
          if (l == 0) { pg8::Gemm g{(const bf16*)(F.ws + WS_MIX), (const bf16*)(F.wsw + WS_WOUT), M_LAT, DM, DM, DM, DM}; pg8::StaticOrder S; S.init(M_LAT, DM, F.G, bx);
            pg8::EpiBf16<0> E{(bf16*)(F.ws + WS_Y1), DM, nullptr};
            pg8::gemm_phase<pg8::EpiBf16<0>, pg8::StaticOrder, true, true>(F.lds, g, S, E); }
          else { pg8::Gemm g{(const bf16*)(F.ws + WS_MIX) + W_OUT_K1, (const bf16*)(F.wsw + WS_WOUT) + W_OUT_K1, M_LAT, DM, DM - W_OUT_K1, DM, DM}; pg8::StaticOrder S; S.init(M_LAT, DM, F.G, bx);
            pg8::EpiBf16<3> E{(bf16*)(F.ws + WS_Y1), DM, nullptr};
            pg8::gemm_phase<pg8::EpiBf16<3>, pg8::StaticOrder, true, true>(F.lds, g, S, E); }
          if (wctx) {
              pg8::Gemm g2{(const bf16*)(F.ws + WS_MIX) + (size_t)M_LAT * DM, (const bf16*)(F.wsw + WS_WOUT), M_CTX, DM, DM / 8, DM, DM}; pg8::SplitOrder S2; S2.init(M_CTX, DM, DM / 8, bx);
              pg8::EpiF32 E2{(float*)(F.ws + WS_YP), DM, (size_t)M_CTX * DM};
              pg8::gemm_phase<pg8::EpiF32, pg8::SplitOrder, true, true>(F.lds, g2, S2, E2); } }
        GRID_BAR();
        if (PH(14)) { int cs = -1;
          for (int row = F.gw; row < MO; row += F.NGW) { const int s = row_s(row);
            if (s != cs) { __syncthreads(); if (cs < 0) { ln_stage(F, LNV_G, INP(I_LN1G) + l * DM); ln_stage(F, LNV_B, INP(I_LN1B) + l * DM); }
                ln_stage(F, LNV_GA, mod_ptr(F, l, s, 2)); ln_stage(F, LNV_SC, mod_ptr(F, l, s, 4)); ln_stage(F, LNV_SH, mod_ptr(F, l, s, 3)); __syncthreads(); cs = s; }
            bf16* yrow = (bf16*)(F.ws + WS_Y1) + (size_t)row * DM;
            if (row >= M_LAT) sum_partials_row(F, (const float*)(F.ws + WS_YP) + (size_t)(row - M_LAT) * DM, (size_t)M_CTX * DM, yrow);
            if (l == 0) { const float* xs = row < M_LAT ? INP(I_X) + (size_t)row * DM : INP(I_CTX) + (size_t)(row - M_LAT) * DM;
                ln_row<1, false, XH16>(F, xs, yrow, X + (size_t)row * DM, true, H + (size_t)row * DM); }
            else ln_row<1, XH16, XH16>(F, X + (size_t)row * DM, yrow, X + (size_t)row * DM, true, H + (size_t)row * DM); }
          __syncthreads(); }
        GRID_BAR();
        REP(15) if (PH(15)) { pg8::Gemm g{H, (const bf16*)(F.wsw + WS_WFF1), MO, DFF, DM, DM, DM}; pg8::StaticOrder S; S.init(MO, DFF, F.G, bx);
          pg8::EpiBf16<1> E{(bf16*)(F.ws + WS_HID), DFF, nullptr};
          pg8::gemm_phase<pg8::EpiBf16<1>, pg8::StaticOrder, true, true>(F.lds, g, S, E); }
        GRID_BAR();
        REP(16) if (PH(16)) { pg8::Gemm g{(const bf16*)(F.ws + WS_HID), (const bf16*)(F.wsw + WS_WFF2), M_LAT, DM, DFF, DFF, DFF}; pg8::StaticOrder S; S.init(M_LAT, DM, F.G, bx);
          pg8::EpiBf16<0> E{(bf16*)(F.ws + WS_Y2), DM, nullptr};
          pg8::gemm_phase<pg8::EpiBf16<0>, pg8::StaticOrder, true, true>(F.lds, g, S, E);
          if (wctx) {
              pg8::Gemm g2{(const bf16*)(F.ws + WS_HID) + (size_t)M_LAT * DFF, (const bf16*)(F.wsw + WS_WFF2), M_CTX, DM, DFF / 8, DFF, DFF}; pg8::SplitOrder S2; S2.init(M_CTX, DM, DFF / 8, bx);
              pg8::EpiF32 E2{(float*)(F.ws + WS_YP), DM, (size_t)M_CTX * DM};
              pg8::gemm_phase<pg8::EpiF32, pg8::SplitOrder, true, true>(F.lds, g2, S2, E2); } }
        GRID_BAR();
        if (!PH(17)) {} else if (l == 0) { int cs = -1;
            for (int row = F.gw; row < M_TOT; row += F.NGW) { const int s = row_s(row);
                if (s != cs) { __syncthreads(); if (cs < 0) { ln_stage(F, LNV_G, INP(I_LN2G)); ln_stage(F, LNV_B, INP(I_LN2B)); }
                    ln_stage(F, LNV_GA, mod_ptr(F, 0, s, 5)); ln_stage(F, LNV_SC, mod_ptr(F, 1, s, 1)); ln_stage(F, LNV_SH, mod_ptr(F, 1, s, 0)); __syncthreads(); cs = s; }
                bf16* yrow = (bf16*)(F.ws + WS_Y2) + (size_t)row * DM;
                if (row >= M_LAT) sum_partials_row(F, (const float*)(F.ws + WS_YP) + (size_t)(row - M_LAT) * DM, (size_t)M_CTX * DM, yrow);
                ln_row<1, XH16, XH16>(F, X + (size_t)row * DM, yrow, X + (size_t)row * DM, true, H + (size_t)row * DM); }
            __syncthreads();
        } else { int cs = -1;
            for (int row = F.gw; row < M_LAT; row += F.NGW) { const int s = row_s(row);
                if (s != cs) { __syncthreads(); if (cs < 0) { ln_stage(F, LNV_G, INP(I_LN2G) + DM); ln_stage(F, LNV_B, INP(I_LN2B) + DM); }
                    ln_stage(F, LNV_GA, mod_ptr(F, 1, s, 5)); __syncthreads(); cs = s; }
                ln_row<1, XH16, false>(F, X + (size_t)row * DM, (const bf16*)(F.ws + WS_Y2) + (size_t)row * DM, F.out + (size_t)row * DM, false, nullptr); }
        }
    }
}

extern "C" void kernel_launch(void* const* d_in, const int* in_sizes, int n_in, void* d_out, int out_size, void* d_ws, size_t ws_size, hipStream_t stream) {
    static int grid = 0;
    if (grid == 0) {
        if (n_in != 38 || out_size != M_LAT * DM || ws_size < WS_END) { fprintf(stderr, "kernel_launch: unexpected shapes: n_in %d out %d ws %zu (need %zu)\n", n_in, out_size, ws_size, (size_t)WS_END); grid = -1; return; }
        int dev = 0, cus = 0, per_cu = 0;
        if (hipGetDevice(&dev) != hipSuccess || hipDeviceGetAttribute(&cus, hipDeviceAttributeMultiprocessorCount, dev) != hipSuccess) { grid = -1; return; }
        if (hipFuncSetAttribute((const void*)mk_fwd, hipFuncAttributeMaxDynamicSharedMemorySize, LDS_BYTES) != hipSuccess) { fprintf(stderr, "kernel_launch: hipFuncSetAttribute failed\n"); grid = -1; return; }
        if (hipOccupancyMaxActiveBlocksPerMultiprocessor(&per_cu, (const void*)mk_fwd, NTHR, LDS_BYTES) != hipSuccess || per_cu < 1) fprintf(stderr, "kernel_launch: occupancy query says %d\n", per_cu);
        (void)hipGetLastError();
        grid = cus;
    }
    if (grid < 0) return;
    if (hipMemsetAsync((char*)d_ws + WS_CTL, 0, CTL_ZERO_BYTES, stream) != hipSuccess) return;
    Args a{};
    for (int i = 0; i < 38; ++i) a.in[i] = (const float*)d_in[i];
    a.out = (float*)d_out; a.ws = (unsigned char*)d_ws;
    hipLaunchKernelGGL(mk_fwd, dim3(grid), dim3(NTHR), LDS_BYTES, stream, a);
    const hipError_t le = hipPeekAtLastError();
    if (le != hipSuccess) fprintf(stderr, "kernel_launch: launch failed: %s\n", hipGetErrorName(le));
}
```

```cpp
#include <hip/hip_runtime.h>
#include <hip/hip_bf16.h>
#include <cstdio>
#include <cstdint>

namespace pg8 {
#define PG8_LAS __attribute__((address_space(3)))
typedef unsigned short bf16_t;
typedef short bf16x8 __attribute__((ext_vector_type(8)));
typedef float f32x4 __attribute__((ext_vector_type(4)));
typedef unsigned u32x4 __attribute__((ext_vector_type(4)));
constexpr int BM = 256, BK = 64, HALF = 128, HTB = HALF * BK * 2  , STAGE_BYTES = 8 * HTB, NXCD = 8, WGM = 8;

__host__ __device__ __forceinline__ int lds_byte(int r, int c) { const int st = (r >> 4) * 2 + (c >> 5), rr = r & 15, cc = c & 31, ob = rr * 64 + cc * 2; return st * 1024 + (ob ^ (((ob >> 9) & 1) << 5)); }
__host__ __device__ __forceinline__ void stage_rc(int b, int& R, int& C) { const int st = b / 1024, sb = b % 1024, swz = sb ^ (((sb >> 9) & 1) << 5); R = (st >> 1) * 16 + swz / 64; C = (st & 1) * 32 + (swz % 64) / 2; }
__host__ __device__ __forceinline__ int perm32(int rho) { const int n = rho >> 4, i = rho & 15; return 8 * (i >> 2) + 4 * n + (i & 3); }

struct Unit { int pm, pn, ko, ks; };
struct Gemm { const bf16_t* A; const bf16_t* Bt; int M, N, K, lda, ldb; };

struct StaticOrder {
    int nM, nN, nwg, G, c;
    __host__ __device__ void init(int M, int N, int G_, int c_) { nM = M / BM; nN = N / BM; nwg = nM * nN; G = G_; c = c_; }
    __host__ __device__ bool next(int i, Unit& u) const {
        const long L = (long)i * G + c; if (L >= nwg) return false;
        int wgid = (int)L; { const int q = nwg / NXCD, r = nwg % NXCD, xcd = wgid % NXCD, off = wgid / NXCD; wgid = (xcd < r ? xcd * (q + 1) : r * (q + 1) + (xcd - r) * q) + off; }
        const int nig = WGM * nN, gid = wgid / nig, fm = gid * WGM, gsz = (nM - fm) < WGM ? (nM - fm) : WGM;
        u.pm = fm + ((wgid % nig) % gsz); u.pn = (wgid % nig) / gsz; u.ko = 0; u.ks = 0; return true;
    }
    __device__ __forceinline__ void a_ready(const Unit&) const {}
    __device__ __forceinline__ void done(const Unit&) const {}
};
struct SplitOrder {
    int nN, nitems, kslice, c;
    __host__ __device__ void init(int M, int N, int Kslice, int c_) { nN = N / BM; nitems = (M / BM) * nN * 8; kslice = Kslice; c = c_; }
    __host__ __device__ bool next(int i, Unit& u) const { if (i > 0 || c >= nitems) return false; u.ks = c & 7; u.ko = u.ks * kslice; u.pn = (c >> 3) % nN; u.pm = (c >> 3) / nN; return true; }
    __device__ __forceinline__ void a_ready(const Unit&) const {}
    __device__ __forceinline__ void done(const Unit&) const {}
};

__device__ __forceinline__ unsigned cvt_pk_bf16(float lo, float hi) { unsigned r; asm volatile("v_cvt_pk_bf16_f32 %0, %1, %2" : "=v"(r) : "v"(lo), "v"(hi)); return r; }

struct EpiF32 {
    static constexpr bool PERM = false, AFTER_DRAIN = false;
    float* C; int ldc; size_t split_stride;
    __device__ __forceinline__ void operator()(const f32x4 (&acc)[2][2][4][2], const Unit& u, int wr, int wc, int fr, int fq) const {
        const int row0 = u.pm * BM + wr * 64 + fr, col0 = u.pn * BM + wc * 32 + 4 * fq; float* Cb = C + (size_t)u.ks * split_stride;
#pragma unroll
        for (int ai = 0; ai < 2; ++ai)
#pragma unroll
            for (int m = 0; m < 4; ++m) { float* rowp = Cb + (size_t)(row0 + ai * HALF + m * 16) * ldc + col0;
#pragma unroll
                for (int bj = 0; bj < 2; ++bj)
#pragma unroll
                    for (int n = 0; n < 2; ++n) *(f32x4*)(rowp + bj * HALF + n * 16) = acc[ai][bj][m][n]; }
    }
};
template <int ACT> struct EpiBf16 {
    static constexpr bool PERM = true, AFTER_DRAIN = false;
    bf16_t* O; int ldc; const float* rowscale;
    __device__ __forceinline__ void operator()(const f32x4 (&acc)[2][2][4][2], const Unit& u, int wr, int wc, int fr, int fq) const {
        const int row0 = u.pm * BM + wr * 64 + fr; const int col0 = u.pn * BM + wc * 32 + 8 * fq;
#pragma unroll
        for (int ai = 0; ai < 2; ++ai)
#pragma unroll
            for (int m = 0; m < 4; ++m) { const int row = row0 + ai * HALF + m * 16; bf16_t* rowp = O + (size_t)row * ldc + col0;
                float rs = 1.f; if (ACT == 2) rs = rowscale[row];
#pragma unroll
                for (int bj = 0; bj < 2; ++bj) { f32x4 v0 = acc[ai][bj][m][0], v1 = acc[ai][bj][m][1];
                    if (ACT == 1) {
#pragma unroll
                        for (int j = 0; j < 4; ++j) { const float a = fmaxf(v0[j], 0.f), b = fmaxf(v1[j], 0.f); v0[j] = a * a; v1[j] = b * b; } }
                    if (ACT == 2) { v0 = v0 * rs; v1 = v1 * rs; }
                    if (ACT == 3) { const u32x4 o = *(const u32x4*)(rowp + bj * HALF);
                        v0[0] += __builtin_bit_cast(float, o.x << 16); v0[1] += __builtin_bit_cast(float, o.x & 0xffff0000u); v0[2] += __builtin_bit_cast(float, o.y << 16); v0[3] += __builtin_bit_cast(float, o.y & 0xffff0000u);
                        v1[0] += __builtin_bit_cast(float, o.z << 16); v1[1] += __builtin_bit_cast(float, o.z & 0xffff0000u); v1[2] += __builtin_bit_cast(float, o.w << 16); v1[3] += __builtin_bit_cast(float, o.w & 0xffff0000u); }
                    u32x4 w; w.x = cvt_pk_bf16(v0[0], v0[1]); w.y = cvt_pk_bf16(v0[2], v0[3]); w.z = cvt_pk_bf16(v1[0], v1[1]); w.w = cvt_pk_bf16(v1[2], v1[3]);
                    *(u32x4*)(rowp + bj * HALF) = w; } }
    }
};

template <class Epi, class Sched, bool ALIGN_EPI = false, bool SP2 = false>
__device__ __forceinline__ void gemm_phase(PG8_LAS unsigned char* lds, const Gemm g, const Sched& S, const Epi& E) {
    int tid = threadIdx.x; asm volatile("" : "+v"(tid));
    const int wid = __builtin_amdgcn_readfirstlane(tid >> 6), lane = tid & 63, wr = wid >> 2, wc = wid & 3, fr = lane & 15, fq = lane >> 4;
    const int K = g.K, nt = K / BK, lda = g.lda, ldb = g.ldb;
    unsigned voffA[2], voffB[2];
#pragma unroll
    for (int i = 0; i < 2; ++i) { int R, C; stage_rc(tid * 16 + i * 8192, R, C); const int Rb = Epi::PERM ? ((R & ~31) + perm32(R & 31)) : R;
        voffA[i] = (unsigned)(R * lda + C) * 2u; voffB[i] = (unsigned)(Rb * ldb + C) * 2u; }
    const size_t kstep = (size_t)(BK * 2);
    const size_t hstepA = (size_t)HALF * lda * 2, hstepB = (size_t)HALF * ldb * 2;
    const size_t tstepA = 2 * hstepA, tstepB = 2 * hstepB;
    const unsigned ldsw = (unsigned)wid * 1024u;
    const int aoff = lds_byte(wr * 64 + fr, fq * 8), boff = lds_byte(wc * 32 + fr, fq * 8);
#define PG8_SA(b, h) (((b) * 2 + (h)) * HTB)
#define PG8_SB(b, h) ((4 + (b) * 2 + (h)) * HTB)
#define PG8_STAGE(bufoff, gbase, voff) do { _Pragma("unroll") for (int _i = 0; _i < 2; ++_i) \
        __builtin_amdgcn_global_load_lds((const unsigned*)((const char*)(gbase) + (voff)[_i]), (PG8_LAS unsigned*)(lds + (bufoff) + ldsw + _i * 8192), 16, 0, 0); } while (0)
#define PG8_LDA(dst, b, h) do { _Pragma("unroll") for (int m = 0; m < 4; ++m) _Pragma("unroll") for (int k = 0; k < 2; ++k) dst[m][k] = *(const PG8_LAS bf16x8*)(lds + PG8_SA(b, h) + aoff + m * 2048 + k * 1024); } while (0)
#define PG8_LDB(dst, b, h) do { _Pragma("unroll") for (int n = 0; n < 2; ++n) _Pragma("unroll") for (int k = 0; k < 2; ++k) dst[n][k] = *(const PG8_LAS bf16x8*)(lds + PG8_SB(b, h) + boff + n * 2048 + k * 1024); } while (0)
#define PG8_MMA(ai, bj, At, Bt) do { __builtin_amdgcn_s_setprio(1); _Pragma("unroll") for (int m = 0; m < 4; ++m) _Pragma("unroll") for (int n = 0; n < 2; ++n) _Pragma("unroll") for (int k = 0; k < 2; ++k) \
        acc[ai][bj][m][n] = __builtin_amdgcn_mfma_f32_16x16x32_bf16(Bt[n][k], At[m][k], acc[ai][bj][m][n], 0, 0, 0); __builtin_amdgcn_s_setprio(0); } while (0)
#define PG8_WAIT_V(n) asm volatile("s_waitcnt vmcnt(" #n ")" ::: "memory")
#define PG8_WAIT_L(n) asm volatile("s_waitcnt lgkmcnt(" #n ")" ::: "memory")
#define PG8_BAR __builtin_amdgcn_s_barrier()
#define PG8_SCHED __builtin_amdgcn_sched_barrier(0)
    Unit cur, nxt; int ui = 0;
    if (!S.next(0, cur)) return;
    f32x4 acc[2][2][4][2];
#pragma unroll
    for (int a = 0; a < 2; ++a)
#pragma unroll
        for (int b = 0; b < 2; ++b)
#pragma unroll
            for (int m = 0; m < 4; ++m)
#pragma unroll
                for (int n = 0; n < 2; ++n) acc[a][b][m][n] = (f32x4){0.f, 0.f, 0.f, 0.f};
    bf16x8 At[4][2], B0[2][2], B1[2][2];
    const char* cA = (const char*)g.A + (size_t)cur.pm * tstepA + (size_t)cur.ko * 2; const char* cB = (const char*)g.Bt + (size_t)cur.pn * tstepB + (size_t)cur.ko * 2;
    S.a_ready(cur);
    if constexpr (SP2) {
        PG8_STAGE(PG8_SB(0, 0), cB, voffB); PG8_STAGE(PG8_SB(0, 1), cB + hstepB, voffB); PG8_STAGE(PG8_SA(0, 0), cA, voffA); PG8_STAGE(PG8_SA(0, 1), cA + hstepA, voffA);
        if (wr == 1) PG8_BAR;
        PG8_WAIT_V(2); PG8_BAR;
        PG8_STAGE(PG8_SB(1, 0), cB + kstep, voffB); PG8_STAGE(PG8_SA(1, 0), cA + kstep, voffA); PG8_STAGE(PG8_SB(1, 1), cB + hstepB + kstep, voffB);
        PG8_WAIT_V(6); PG8_BAR;
    } else {
        PG8_STAGE(PG8_SB(0, 0), cB, voffB); PG8_STAGE(PG8_SA(0, 0), cA, voffA); PG8_STAGE(PG8_SB(0, 1), cB + hstepB, voffB); PG8_STAGE(PG8_SA(0, 1), cA + hstepA, voffA);
        if (wr == 1) PG8_BAR;
        PG8_WAIT_V(4); PG8_BAR;
        PG8_STAGE(PG8_SB(1, 0), cB + kstep, voffB); PG8_STAGE(PG8_SA(1, 0), cA + kstep, voffA); PG8_STAGE(PG8_SB(1, 1), cB + hstepB + kstep, voffB);
        PG8_WAIT_V(6); PG8_BAR;
    }
    for (;;) {
        const bool has_next = S.next(ui + 1, nxt);
        const char* nA = has_next ? (const char*)g.A + (size_t)nxt.pm * tstepA + (size_t)nxt.ko * 2 : cA; const char* nB = has_next ? (const char*)g.Bt + (size_t)nxt.pn * tstepB + (size_t)nxt.ko * 2 : cB;
        for (int t = 0; t < nt; t += 2) {
            const bool last = (t == nt - 2);
            const char* a1 = cA + (size_t)(t + 1) * kstep;
            const char* a2 = last ? nA : cA + (size_t)(t + 2) * kstep; const char* b2 = last ? nB : cB + (size_t)(t + 2) * kstep;
            const char* a3 = a2 + kstep; const char* b3 = b2 + kstep;
            if (last && has_next) S.a_ready(nxt);
            if constexpr (SP2) {
            PG8_LDB(B0, 0, 0); PG8_LDB(B1, 0, 1); PG8_SCHED; PG8_LDA(At, 0, 0); PG8_STAGE(PG8_SA(1, 1), a1 + hstepA, voffA);
            PG8_WAIT_V(8); PG8_WAIT_L(0); PG8_BAR; PG8_MMA(0, 0, At, B0); PG8_MMA(0, 1, At, B1); PG8_BAR; PG8_SCHED;
            PG8_LDA(At, 0, 1); PG8_STAGE(PG8_SB(0, 0), b2, voffB); PG8_STAGE(PG8_SB(0, 1), b2 + hstepB, voffB); PG8_STAGE(PG8_SA(0, 0), a2, voffA);
            PG8_WAIT_V(8); PG8_WAIT_L(0); PG8_BAR; PG8_MMA(1, 0, At, B0); PG8_MMA(1, 1, At, B1); PG8_BAR; PG8_SCHED;
            PG8_LDB(B0, 1, 0); PG8_LDB(B1, 1, 1); PG8_SCHED; PG8_LDA(At, 1, 0); PG8_STAGE(PG8_SA(0, 1), a2 + hstepA, voffA);
            PG8_WAIT_V(8); PG8_WAIT_L(0); PG8_BAR; PG8_MMA(0, 0, At, B0); PG8_MMA(0, 1, At, B1); PG8_BAR; PG8_SCHED;
            PG8_LDA(At, 1, 1); PG8_STAGE(PG8_SB(1, 0), b3, voffB); PG8_STAGE(PG8_SB(1, 1), b3 + hstepB, voffB); PG8_STAGE(PG8_SA(1, 0), a3, voffA);
            PG8_WAIT_V(8); PG8_WAIT_L(0); PG8_BAR; PG8_MMA(1, 0, At, B0); PG8_MMA(1, 1, At, B1); PG8_BAR; PG8_SCHED;
            } else {
            PG8_LDB(B0, 0, 0); PG8_SCHED; PG8_LDA(At, 0, 0); PG8_STAGE(PG8_SA(1, 1), a1 + hstepA, voffA);
            PG8_WAIT_L(8); PG8_BAR; PG8_WAIT_L(0); PG8_MMA(0, 0, At, B0); PG8_BAR; PG8_SCHED;
            PG8_LDB(B1, 0, 1); PG8_STAGE(PG8_SB(0, 0), b2, voffB);
            PG8_BAR; PG8_WAIT_L(0); PG8_MMA(0, 1, At, B1); PG8_BAR;
            PG8_LDA(At, 0, 1); PG8_STAGE(PG8_SA(0, 0), a2, voffA);
            PG8_BAR; PG8_WAIT_L(0); PG8_MMA(1, 0, At, B0); PG8_BAR; PG8_SCHED;
            PG8_STAGE(PG8_SB(0, 1), b2 + hstepB, voffB);
            PG8_WAIT_V(6); PG8_BAR; PG8_MMA(1, 1, At, B1); PG8_BAR;
            PG8_LDB(B0, 1, 0); PG8_SCHED; PG8_LDA(At, 1, 0); PG8_STAGE(PG8_SA(0, 1), a2 + hstepA, voffA);
            PG8_WAIT_L(8); PG8_BAR; PG8_WAIT_L(0); PG8_MMA(0, 0, At, B0); PG8_BAR; PG8_SCHED;
            PG8_LDB(B1, 1, 1); PG8_STAGE(PG8_SB(1, 0), b3, voffB);
            PG8_BAR; PG8_WAIT_L(0); PG8_MMA(0, 1, At, B1); PG8_BAR;
            PG8_LDA(At, 1, 1); PG8_STAGE(PG8_SA(1, 0), a3, voffA);
            PG8_BAR; PG8_WAIT_L(0); PG8_MMA(1, 0, At, B0); PG8_BAR; PG8_SCHED;
            PG8_STAGE(PG8_SB(1, 1), b3 + hstepB, voffB);
            PG8_WAIT_V(6); PG8_BAR; PG8_MMA(1, 1, At, B1); PG8_BAR;
            }
        }
        if constexpr (ALIGN_EPI) { if (wr == 0) PG8_BAR; }
        E(acc, cur, wr, wc, fr, fq); S.done(cur);
        if (!has_next) break;
#pragma unroll
        for (int a = 0; a < 2; ++a)
#pragma unroll
            for (int b = 0; b < 2; ++b)
#pragma unroll
                for (int m = 0; m < 4; ++m)
#pragma unroll
                    for (int n = 0; n < 2; ++n) acc[a][b][m][n] = (f32x4){0.f, 0.f, 0.f, 0.f};
        cur = nxt; cA = nA; cB = nB; ++ui;
        if constexpr (ALIGN_EPI) { if (wr == 1) PG8_BAR; }
    }
    PG8_WAIT_V(0);
    if constexpr (!ALIGN_EPI) { if (wr == 0) PG8_BAR; }
    PG8_BAR;
#undef PG8_SA
#undef PG8_SB
#undef PG8_STAGE
#undef PG8_LDA
#undef PG8_LDB
#undef PG8_MMA
#undef PG8_WAIT_V
#undef PG8_WAIT_L
#undef PG8_BAR
#undef PG8_SCHED
}
}

constexpr int NWAVES = 8, NTHR = 512;
constexpr int DM = 4096, NB = 2, SEQ = 8192, NCTX = 256, DFF = 16384;
constexpr int M_LAT = NB * SEQ, M_CTX = NB * NCTX, M_TOT = M_LAT + M_CTX;
constexpr int DIN = 8672, DINP = 8704;
constexpr int C_SWAQ = 0, C_SWAK = 1024, C_SWAV = 1280, C_LRUX = 1536, C_LRUY = 2560, C_QA = 3584, C_KVA = 4608, C_KR = 5120, C_RW = 5184;
constexpr int C_RWR = C_RW, C_RWK = C_RW + 1024, C_RWV = C_RW + 2048, C_RWL = C_RW + 3072;
constexpr int RWC = 3488;
constexpr float LN_EPS = 1e-5f, RMS_EPS = 1e-6f, GN_EPS = 64e-5f, ALPHA = 1.41421356237f;
constexpr int NCH = 264;

constexpr size_t MiB = 1u << 20;
constexpr size_t WS_CTL = 0, CTL_ZERO_BYTES = 1 * MiB;
constexpr size_t WS_MOD = 1 * MiB;
constexpr size_t WS_MODP = 2 * MiB;
constexpr size_t WS_SMALL = 20 * MiB;
constexpr size_t WS_RSQ = WS_SMALL;
constexpr size_t WS_RSKV = WS_RSQ + 128 * 1024;
constexpr size_t WS_SB = WS_RSKV + 128 * 1024;
constexpr size_t WS_CA = WS_SB + 2 * MiB;
constexpr size_t WS_CB = WS_CA + 5 * MiB;
constexpr size_t WS_HIN = WS_CB + 5 * MiB;
constexpr size_t WS_QUIRK = WS_HIN + 5 * MiB;
constexpr size_t WS_ROPE = WS_QUIRK + 8192;
static_assert(WS_ROPE + 16384 <= 40 * MiB, "small region");
constexpr size_t WS_W = 40 * MiB;
constexpr size_t WS_WIN = WS_W, WS_WOUT = WS_WIN + 68 * MiB, WS_WFF1 = WS_WOUT + 32 * MiB, WS_WFF2 = WS_WFF1 + 128 * MiB, WS_WQB = WS_WFF2 + 128 * MiB,
                 WS_WKVB = WS_WQB + 3 * MiB, WS_WLRU = WS_WKVB + 2 * MiB, WS_WLORA = WS_WLRU + 1 * MiB;
constexpr size_t WS_W2T = WS_WLORA, WS_A2T = WS_W2T + 256 * 1024, WS_G2T = WS_A2T + 256 * 1024;
constexpr size_t WS_X = 403 * MiB;
constexpr size_t WS_H = 667 * MiB;
constexpr size_t WS_MIX = 799 * MiB;
constexpr size_t WS_YS = 931 * MiB;
constexpr size_t WS_P = 1063 * MiB;
constexpr size_t WS_RWF = 1344 * MiB;
constexpr size_t RWF_STRIDE = (size_t)M_TOT * 1024 * 2;
constexpr size_t WS_Q = 1641 * MiB;
constexpr size_t WS_KV = 1691 * MiB;
constexpr size_t WS_KR = 1757 * MiB;
constexpr size_t WS_SET2 = 1760 * MiB;
constexpr size_t WSET_STRIDE = WS_SET2 - WS_W;
constexpr size_t WS_END = WS_SET2 + 363 * MiB;
constexpr size_t WS_YP = WS_Q;
constexpr size_t WS_HID = WS_P;
constexpr size_t WS_Y1 = WS_P;
constexpr size_t WS_Y2 = WS_MIX;
static_assert(WS_WLORA + 1 * MiB <= WS_X && WS_P + (size_t)M_TOT * DINP * 2 <= WS_RWF && WS_RWF + 9 * RWF_STRIDE <= WS_Q, "ws map");
static_assert(WS_HID + (size_t)M_TOT * DFF * 2 <= WS_Q && WS_Y2 + (size_t)M_TOT * DM * 4 <= WS_P && WS_YS + 2 * (size_t)M_TOT * 1024 * 4 <= WS_P, "ws overlays");
static_assert(WS_KR + (size_t)M_TOT * 64 * 2 <= WS_SET2 && WS_YP + 8 * (size_t)M_CTX * DM * 4 <= WS_KR, "ws end");

constexpr int RING_BYTES = 131072;
constexpr int LDSCTL_OFF = RING_BYTES, MISC_OFF = LDSCTL_OFF + 320;
constexpr int LDS_BYTES = 147456;

#define GAS __attribute__((address_space(1)))
#define LAS __attribute__((address_space(3)))
typedef unsigned short bf16;
typedef unsigned v4u __attribute__((ext_vector_type(4)));
typedef unsigned v2u __attribute__((ext_vector_type(2)));
typedef float f32x4 __attribute__((ext_vector_type(4)));
typedef _Float16 h16x4 __attribute__((ext_vector_type(4)));
#ifndef XH16_
#define XH16_ 0
#endif
constexpr bool XH16 = XH16_;
#if XH16_
typedef _Float16 xres_t;
#else
typedef float xres_t;
#endif
typedef float f32x2 __attribute__((ext_vector_type(2)));
typedef float f32x16 __attribute__((ext_vector_type(16)));
typedef short bf16x8 __attribute__((ext_vector_type(8)));
typedef short s16x4 __attribute__((ext_vector_type(4)));
typedef GAS unsigned gu32;
typedef const GAS bf16* gcbf; typedef GAS bf16* gbfp; typedef const GAS float* gcfl; typedef GAS float* gflp;
#define LDS_WAIT() asm volatile("s_waitcnt lgkmcnt(0)" ::: "memory")
#define VM_WAIT() asm volatile("s_waitcnt vmcnt(0)" ::: "memory")
typedef __bf16 bf16x2_t __attribute__((ext_vector_type(2)));
__device__ __forceinline__ unsigned pk2(float lo, float hi) { const f32x2 v = {lo, hi}; const bf16x2_t b = __builtin_convertvector(v, bf16x2_t); return __builtin_bit_cast(unsigned, b); }
__device__ __forceinline__ unsigned f2bf(float f) { return pk2(f, f) & 0xffffu; }
__device__ __forceinline__ float bflo(unsigned w) { return __builtin_bit_cast(float, w << 16); }
__device__ __forceinline__ float bfhi(unsigned w) { return __builtin_bit_cast(float, w & 0xffff0000u); }
__device__ __forceinline__ float bf2f(bf16 h) { return __builtin_bit_cast(float, (unsigned)h << 16); }
#define DPP_ADD(x, ctrl) ((x) + __builtin_bit_cast(float, __builtin_amdgcn_update_dpp(0, __builtin_bit_cast(int, (x)), (ctrl), 0xf, 0xf, false)))
__device__ __forceinline__ float row_sum16(float x) { x = DPP_ADD(x, 0x128); x = DPP_ADD(x, 0x124); x = DPP_ADD(x, 0x122); x = DPP_ADD(x, 0x121); return x; }
#ifdef OLD_SUMS
__device__ __forceinline__ float wave_sum(float v) {
#pragma unroll
    for (int o = 1; o < 64; o <<= 1) v += __shfl_xor(v, o);
    return v;
}
__device__ __forceinline__ float half_swap_sum(float x) { return x + __shfl_xor(x, 32); }
__device__ __forceinline__ float quad_sum(float x) { x += __shfl_xor(x, 1); x += __shfl_xor(x, 2); return x; }
#else
__device__ __forceinline__ float wave_sum(float v) {
    const float r = row_sum16(v);
    const float a = __builtin_bit_cast(float, __builtin_amdgcn_readlane(__builtin_bit_cast(int, r), 0)), b = __builtin_bit_cast(float, __builtin_amdgcn_readlane(__builtin_bit_cast(int, r), 16));
    const float c = __builtin_bit_cast(float, __builtin_amdgcn_readlane(__builtin_bit_cast(int, r), 32)), d = __builtin_bit_cast(float, __builtin_amdgcn_readlane(__builtin_bit_cast(int, r), 48));
    return (a + b) + (c + d);
}
__device__ __forceinline__ float half_swap_sum(float x) {
    unsigned a = __builtin_bit_cast(unsigned, x), b = a; asm volatile("" : "+v"(b));
    auto rr = __builtin_amdgcn_permlane32_swap(a, b, false, false);
    const float lo = __uint_as_float(rr[0]), hi = __uint_as_float(rr[1]); return lo + hi;
}
__device__ __forceinline__ float quad_sum(float x) { x = DPP_ADD(x, 0xB1); x = DPP_ADD(x, 0x4E); return x; }
#endif
__device__ __forceinline__ float sigmoidf_(float x) { return __builtin_amdgcn_rcpf(1.f + __expf(-x)); }
__device__ __forceinline__ float softplusf_(float x) { return x > 20.f ? x : __logf(1.f + __expf(x)); }
__device__ __forceinline__ float tanhf_(float x) { const float e = __expf(2.f * x); return 1.f - 2.f * __builtin_amdgcn_rcpf(e + 1.f); }
__device__ __forceinline__ int ltid() { int t = threadIdx.x; asm volatile("" : "+v"(t)); return t; }
template <class T> __device__ __forceinline__ T ldg(const void* base, unsigned byteoff) { return *(const T*)((const char*)base + byteoff); }
template <class T> __device__ __forceinline__ void stg(void* base, unsigned byteoff, T v) { *(T*)((char*)base + byteoff) = v; }

#define XB_TMO      128
#define XB_XCNT(j)  (256  + 64 * (j))
#define XB_XSUB(j)  (1280 + 64 * (j))
#define XB_XGEN(j)  (2304 + 64 * (j))
#define XB_TOP      3328
#define XB_TOPGEN   3392
#define XCD_BAR_WORDS 3456
#define XB_SPIN_CAP (1u << 18)

__device__ __forceinline__ unsigned xb_ld(unsigned* p)              { return __hip_atomic_load(p, __ATOMIC_RELAXED, __HIP_MEMORY_SCOPE_AGENT); }
__device__ __forceinline__ unsigned xb_add(unsigned* p, unsigned v) { return __hip_atomic_fetch_add(p, v, __ATOMIC_RELAXED, __HIP_MEMORY_SCOPE_AGENT); }
__device__ __forceinline__ unsigned xb_xcc_id() { return (unsigned)__builtin_amdgcn_s_getreg((3 << 11) | 20) & 0xFu; }
#define XB_SPIN(cond, bar) do { unsigned _sp = 0; while (cond) { __builtin_amdgcn_s_sleep(1); \
    if ((++_sp & 255u) == 0u) { if (xb_ld(&(bar)[XB_TMO])) break; if (_sp > XB_SPIN_CAP) { atomicAdd(&(bar)[XB_TMO], 1u); break; } } } } while (0)

struct XcdBarrier {
    unsigned* bar; unsigned x;
    unsigned nparts;
    volatile LAS unsigned* st;
};

__device__ __forceinline__ XcdBarrier xcd_barrier_post(unsigned* bar, volatile LAS unsigned* st) {
    XcdBarrier b; b.bar = bar; b.x = xb_xcc_id(); b.st = st; b.nparts = 0u;
    if (threadIdx.x == 0) (void)xb_add(&bar[XB_XCNT(b.x)], 1u);
    return b;
}
__device__ __forceinline__ void xcd_barrier_complete(unsigned* bar, unsigned x, unsigned& nloc, unsigned& nx, unsigned nparts) {
    const unsigned G = nparts ? nparts : gridDim.x * gridDim.y * gridDim.z;
    unsigned sum, cnt, mine, sp = 0u;
    for (;;) {
        sum = 0u; cnt = 0u; mine = 0u;
#pragma unroll
        for (unsigned j = 0; j < 16; ++j) { const unsigned c = xb_ld(&bar[XB_XCNT(j)]); sum += c; cnt += (c > 0u) ? 1u : 0u; mine = (j == x) ? c : mine; }
        if (sum == G) break;
        __builtin_amdgcn_s_sleep(1);
        if ((++sp & 255u) == 0u) { if (xb_ld(&bar[XB_TMO])) break; if (sp > XB_SPIN_CAP) { atomicAdd(&bar[XB_TMO], 1u); break; } }
    }
    nloc = mine > 0u ? mine : 1u; nx = cnt > 0u ? cnt : 1u;
}

__device__ __forceinline__ void xcd_barrier(const XcdBarrier& b) {
    asm volatile("s_waitcnt vmcnt(0)" ::: "memory");
    __syncthreads();
    if (threadIdx.x == 0) {
        unsigned* bar = b.bar;
        __builtin_amdgcn_s_waitcnt(0);
        unsigned nloc = b.st[0], nx = b.st[1];
        if (nloc == 0u) { xcd_barrier_complete(bar, b.x, nloc, nx, b.nparts); b.st[0] = nloc; b.st[1] = nx; }
        const unsigned old = xb_add(&bar[XB_XSUB(b.x)], 1u);
        const unsigned gen = old / nloc;
        if (old + 1u == (gen + 1u) * nloc) {
            __builtin_amdgcn_fence(__ATOMIC_RELEASE, "agent");
            asm volatile("s_waitcnt vmcnt(0)" ::: "memory");
            const unsigned og = xb_add(&bar[XB_TOP], 1u);
            const unsigned tg = og / nx;
            if (og + 1u == (tg + 1u) * nx) xb_add(&bar[XB_TOPGEN], 1u);
            else XB_SPIN(xb_ld(&bar[XB_TOPGEN]) == tg, bar);
            __builtin_amdgcn_fence(__ATOMIC_ACQUIRE, "agent");
            xb_add(&bar[XB_XGEN(b.x)], 1u);
            asm volatile("s_waitcnt vmcnt(0)" ::: "memory");
        } else {
            XB_SPIN(xb_ld(&bar[XB_XGEN(b.x)]) == gen, bar);
            __builtin_amdgcn_fence(__ATOMIC_ACQUIRE, "agent");
            asm volatile("s_waitcnt vmcnt(0)" ::: "memory");
        }
    }
    __syncthreads();
}


namespace att {
constexpr int KVBLK = 64;
constexpr float THR = 8.f;
#define SBAR() __builtin_amdgcn_sched_barrier(0)
__device__ __forceinline__ int crow(int r, int hi) { return (r & 3) + 8 * (r >> 2) + 4 * hi; }
__device__ __forceinline__ unsigned cvtpk(float lo, float hi) { return pk2(lo, hi); }
template <int DQK> __device__ __forceinline__ int kswz(int row, int cb) { return row * (DQK * 2 + 16) + cb; }

template <int DQK> __device__ __forceinline__ void partialSM(f32x16& p0, f32x16& p1, float& m_reg, float& mn, float& alpha) {
  constexpr float SCALE = DQK == 128 ? 0.088388347648318440f : 0.072168783648703220f;
  constexpr float C = SCALE * 1.4426950408889634f;
  float pmax = p0[0];
#pragma unroll
  for (int r = 1; r < 16; ++r) pmax = fmaxf(pmax, p0[r]);
#pragma unroll
  for (int r = 0; r < 16; ++r) pmax = fmaxf(pmax, p1[r]);
  { auto rr = __builtin_amdgcn_permlane32_swap(__float_as_uint(pmax), __float_as_uint(pmax), false, false);
    pmax = fmaxf(__uint_as_float(rr[0]), __uint_as_float(rr[1])); }
  if (__builtin_expect(__all(pmax - m_reg <= THR / SCALE), 1)) { mn = m_reg; alpha = 1.f; }
  else { mn = fmaxf(m_reg, pmax); alpha = __builtin_amdgcn_exp2f((m_reg - mn) * C); m_reg = mn; }
  const float mnC = -mn * C;
#pragma unroll
  for (int r = 0; r < 16; ++r) p0[r] = fmaf(p0[r], C, mnC);
#pragma unroll
  for (int r = 0; r < 16; ++r) p1[r] = fmaf(p1[r], C, mnC);
#pragma unroll
  for (int r = 0; r < 16; ++r) p0[r] = __builtin_amdgcn_exp2f(p0[r]);
}
__device__ __forceinline__ void finishSM(f32x16& p0, f32x16& p1, float alpha, float& l_reg, bf16x8& pa0, bf16x8& pa1, bf16x8& pa2, bf16x8& pa3) {
#pragma unroll
  for (int r = 0; r < 16; ++r) p1[r] = __builtin_amdgcn_exp2f(p1[r]);
  float ps = 0;
#pragma unroll
  for (int r = 0; r < 16; ++r) ps += p0[r];
#pragma unroll
  for (int r = 0; r < 16; ++r) ps += p1[r];
  { auto rr = __builtin_amdgcn_permlane32_swap(__float_as_uint(ps), __float_as_uint(ps), false, false);
    ps = __uint_as_float(rr[0]) + __uint_as_float(rr[1]); }
  l_reg = l_reg * alpha + ps;
#define PK4(P, BASE, OUT) do { unsigned a0 = cvtpk(P[BASE + 0], P[BASE + 1]), a1 = cvtpk(P[BASE + 2], P[BASE + 3]);   \
    unsigned b0 = cvtpk(P[BASE + 4], P[BASE + 5]), b1 = cvtpk(P[BASE + 6], P[BASE + 7]);                              \
    auto r0 = __builtin_amdgcn_permlane32_swap(a0, b0, false, false); auto r1 = __builtin_amdgcn_permlane32_swap(a1, b1, false, false); \
    v4u w = {r0[0], r1[0], r0[1], r1[1]}; OUT = __builtin_bit_cast(bf16x8, w); } while (0)
  PK4(p0, 0, pa0); PK4(p0, 8, pa1); PK4(p1, 0, pa2); PK4(p1, 8, pa3);
#undef PK4
}
template <int DQK> __device__ __forceinline__ void qkt(f32x16& p0, f32x16& p1, const LAS char* Ks, const bf16x8* qr, const LAS char* qx, int r32, int hi) {
  p0 = f32x16{}; p1 = f32x16{};
#pragma unroll
  for (int d0 = 0; d0 < DQK / 16; ++d0) { const int cb = (d0 * 16 + hi * 8) * 2;
    bf16x8 b0 = *(const LAS bf16x8*)(Ks + kswz<DQK>(r32, cb));
    bf16x8 b1 = *(const LAS bf16x8*)(Ks + kswz<DQK>(32 + r32, cb));
    bf16x8 q; if (d0 < 8) q = qr[d0]; else q = *(const LAS bf16x8*)(qx + (d0 - 8) * 32);
    p0 = __builtin_amdgcn_mfma_f32_32x32x16_bf16(b0, q, p0, 0, 0, 0);
    p1 = __builtin_amdgcn_mfma_f32_32x32x16_bf16(b1, q, p1, 0, 0, 0);
    if ((d0 & 3) == 3 && d0 + 1 < DQK / 16) SBAR(); }
}
__device__ __forceinline__ int v_st(int k, int c) { const int kk = (k & ~0xC) | ((k & 4) << 1) | ((k & 8) >> 1); return ((kk >> 3) * 4 + (c >> 5)) * 512 + ((kk & 7) * 32 + (c & 31)) * 2; }
__device__ __forceinline__ int v_rd_base(int lane) { return ((lane & 3) << 3) | (((lane >> 2) & 3) << 6) | (((lane >> 4) & 1) << 5) | (((lane >> 5) & 1) << 8); }
constexpr int v_rd_off(int d0, int ks, int half) { return d0 * 512 + ks * 4096 + half * 2048; }
template <int OFF> __device__ __forceinline__ s16x4 tr_read(int vb) {
  s16x4 r; asm volatile("ds_read_b64_tr_b16 %0, %1 offset:%2" : "=&v"(r) : "v"(vb), "i"(OFF) : "memory"); return r;
}
template <int D0> __device__ __forceinline__ void pv_one(f32x16& od, int vb, bf16x8 pa0, bf16x8 pa1, bf16x8 pa2, bf16x8 pa3) {
  const s16x4 l0 = tr_read<v_rd_off(D0, 0, 0)>(vb), h0 = tr_read<v_rd_off(D0, 0, 1)>(vb), l1 = tr_read<v_rd_off(D0, 1, 0)>(vb), h1 = tr_read<v_rd_off(D0, 1, 1)>(vb);
  const s16x4 l2 = tr_read<v_rd_off(D0, 2, 0)>(vb), h2 = tr_read<v_rd_off(D0, 2, 1)>(vb), l3 = tr_read<v_rd_off(D0, 3, 0)>(vb), h3 = tr_read<v_rd_off(D0, 3, 1)>(vb);
  asm volatile("s_waitcnt lgkmcnt(0)" ::: "memory"); SBAR();
#define PK(L, H) (bf16x8){L[0], L[1], L[2], L[3], H[0], H[1], H[2], H[3]}
  od = __builtin_amdgcn_mfma_f32_32x32x16_bf16(pa0, PK(l0, h0), od, 0, 0, 0);
  od = __builtin_amdgcn_mfma_f32_32x32x16_bf16(pa1, PK(l1, h1), od, 0, 0, 0);
  od = __builtin_amdgcn_mfma_f32_32x32x16_bf16(pa2, PK(l2, h2), od, 0, 0, 0);
  od = __builtin_amdgcn_mfma_f32_32x32x16_bf16(pa3, PK(l3, h3), od, 0, 0, 0);
#undef PK
}
__device__ __forceinline__ void pv_d0(f32x16* o, int vb, bf16x8 pa0, bf16x8 pa1, bf16x8 pa2, bf16x8 pa3) {
  pv_one<0>(o[0], vb, pa0, pa1, pa2, pa3); pv_one<1>(o[1], vb, pa0, pa1, pa2, pa3); pv_one<2>(o[2], vb, pa0, pa1, pa2, pa3); pv_one<3>(o[3], vb, pa0, pa1, pa2, pa3);
}
__device__ __forceinline__ void apply_mask(f32x16& p0, f32x16& p1, int mtype, int krel0, int qi, int hi) {
  if (mtype == 0) return;
  const float ninf = -__builtin_inff();
#pragma unroll
  for (int r = 0; r < 16; ++r) { const int k0 = krel0 + crow(r, hi), k1 = k0 + 32;
    const bool ok0 = (mtype == 1) ? (k0 >= qi - 128) : (k0 <= qi + 128), ok1 = (mtype == 1) ? (k1 >= qi - 128) : (k1 <= qi + 128);
    p0[r] = ok0 ? p0[r] : ninf; p1[r] = ok1 ? p1[r] : ninf; }
}
struct Tile { gcbf kn; gcbf kr; gcbf v; int mtype; int krel0; };

__device__ __forceinline__ void rope_pair(bf16x8& a, bf16x8& b, gcfl ct, gcfl st) {
  const f32x4 c0 = *(const GAS f32x4*)ct, c1 = *(const GAS f32x4*)(ct + 4), s0 = *(const GAS f32x4*)st, s1 = *(const GAS f32x4*)(st + 4);
  const float cs[8] = {c0[0], c0[1], c0[2], c0[3], c1[0], c1[1], c1[2], c1[3]}, sn[8] = {s0[0], s0[1], s0[2], s0[3], s1[0], s1[1], s1[2], s1[3]};
  v4u ua = __builtin_bit_cast(v4u, a), ub = __builtin_bit_cast(v4u, b); v4u oa, ob;
#pragma unroll
  for (int w = 0; w < 4; ++w) { const float x1[2] = {bflo(ua[w]), bfhi(ua[w])}, x2[2] = {bflo(ub[w]), bfhi(ub[w])}; float y1[2], y2[2];
#pragma unroll
    for (int e = 0; e < 2; ++e) { const float c = cs[2 * w + e], sv = sn[2 * w + e]; y1[e] = x1[e] * c - x2[e] * sv; y2[e] = x2[e] * c + x1[e] * sv; }
    oa[w] = pk2(y1[0], y1[1]); ob[w] = pk2(y2[0], y2[1]); }
  a = __builtin_bit_cast(bf16x8, oa); b = __builtin_bit_cast(bf16x8, ob);
}

template <int DQK, int LDKN, int LDV, bool MASK, bool SINK, int SDEPTH, class TS>
__device__ __forceinline__ void attn_body(gcbf Qw, int rope, int prow, int pcol, gcfl rtab, int qi, float sink_l2, const TS& ts, int NT, gbfp Ow, LAS char* lds) {
  constexpr float SCALE = DQK == 128 ? 0.088388347648318440f : 0.072168783648703220f;
  constexpr float C = SCALE * 1.4426950408889634f;
  constexpr int SHM_K = KVBLK * (DQK * 2 + 16), SHM_V = KVBLK * 128 * 2;
  int tid = threadIdx.x; asm volatile("" : "+v"(tid));
  const int wid = tid >> 6, lane = tid & 63, r32 = lane & 31, hi = lane >> 5;
  LAS char* V_lds = lds; LAS char* K_lds = lds + 2 * SHM_V;
  LAS float* wsl = (LAS float*)(lds + 2 * SHM_V + 2 * SHM_K) + wid * 64; LAS float* li_l = wsl; LAS float* al_l = wsl + 32;
  float m_reg = -1e30f, l_reg = 0; f32x16 o[4] = {}; bf16x8 qr[8];
#pragma unroll
  for (int d0 = 0; d0 < 8; ++d0) qr[d0] = *(const GAS bf16x8*)(Qw + d0 * 16 + hi * 8);
  const LAS char* qx = lds + 2 * SHM_V + 2 * SHM_K + 2048 + wid * 4608 + r32 * 144 + hi * 16;
  if constexpr (DQK == 192) {
    bf16x8 x0 = *(const GAS bf16x8*)(Qw + 128 + hi * 8), x1 = *(const GAS bf16x8*)(Qw + 144 + hi * 8), x2 = *(const GAS bf16x8*)(Qw + 160 + hi * 8), x3 = *(const GAS bf16x8*)(Qw + 176 + hi * 8);
    if (rope) {
      rope_pair(x0, x1, rtab + (size_t)prow * 16 + hi * 8, rtab + 2048 + (size_t)prow * 16 + hi * 8);
      rope_pair(x2, x3, rtab + (size_t)pcol * 16 + hi * 8, rtab + 2048 + (size_t)pcol * 16 + hi * 8); }
    LAS char* qw_ = (LAS char*)qx; *(LAS bf16x8*)(qw_) = x0; *(LAS bf16x8*)(qw_ + 32) = x1; *(LAS bf16x8*)(qw_ + 64) = x2; *(LAS bf16x8*)(qw_ + 96) = x3;
  }
  const int sr = tid >> 4, sc = (tid & 15) * 8, vst0 = v_st(sr, sc), vst1 = v_st(32 + sr, sc);
  const int rr_ = tid >> 3, rc_ = (tid & 7) * 8;
  const int vb0 = (int)(uintptr_t)V_lds + v_rd_base(lane);
  struct { bf16x8 vs0, vs1, ks0, ks1, kx; } sr_[SDEPTH];
#define SLOAD(i, jt) do { const Tile t_ = ts(jt); sr_[i].vs0 = *(const GAS bf16x8*)(t_.v + (size_t)sr * LDV + sc); sr_[i].vs1 = *(const GAS bf16x8*)(t_.v + (size_t)(32 + sr) * LDV + sc); \
    sr_[i].ks0 = *(const GAS bf16x8*)(t_.kn + (size_t)sr * LDKN + sc); sr_[i].ks1 = *(const GAS bf16x8*)(t_.kn + (size_t)(32 + sr) * LDKN + sc); \
    if constexpr (DQK == 192) sr_[i].kx = *(const GAS bf16x8*)(t_.kr + (size_t)rr_ * 64 + rc_); } while (0)
#define SWRITE(b, i) do { *(LAS bf16x8*)(V_lds + (b) * SHM_V + vst0) = sr_[i].vs0; *(LAS bf16x8*)(V_lds + (b) * SHM_V + vst1) = sr_[i].vs1; const int kc = sc * 2; \
    *(LAS bf16x8*)(K_lds + (b) * SHM_K + kswz<DQK>(sr, kc)) = sr_[i].ks0; *(LAS bf16x8*)(K_lds + (b) * SHM_K + kswz<DQK>(32 + sr, kc)) = sr_[i].ks1; \
    if constexpr (DQK == 192) *(LAS bf16x8*)(K_lds + (b) * SHM_K + kswz<DQK>(rr_, 256 + rc_ * 2)) = sr_[i].kx; } while (0)
#define SWAIT() do { if constexpr (SDEPTH == 2) { if constexpr (DQK == 192) asm volatile("s_waitcnt vmcnt(5)" ::: "memory"); else asm volatile("s_waitcnt vmcnt(4)" ::: "memory"); } \
    else asm volatile("s_waitcnt vmcnt(0)" ::: "memory"); } while (0)
#define RESC(a) do { if (__any((a) < 1.f)) { if (hi == 0) al_l[r32] = (a); asm volatile("s_waitcnt lgkmcnt(0)" ::: "memory"); \
    _Pragma("unroll") for (int d = 0; d < 4; ++d) _Pragma("unroll") for (int r = 0; r < 16; ++r) o[d][r] *= al_l[crow(r, hi)]; } } while (0)
#define MASKT(pa_, pb_, jt) do { if constexpr (MASK) { const Tile t_ = ts(jt); apply_mask(pa_, pb_, t_.mtype, t_.krel0, qi, hi); } } while (0)
  f32x16 pA0, pA1, pB0, pB1; float mnA, mnB, alA, alB; bf16x8 pa0, pa1, pa2, pa3;
  constexpr int SE = 0, SO = SDEPTH - 1;
  SLOAD(SE, 0); asm volatile("s_waitcnt vmcnt(0)" ::: "memory"); SWRITE(0, SE); __syncthreads();
  qkt<DQK>(pA0, pA1, K_lds, qr, qx, r32, hi); MASKT(pA0, pA1, 0); partialSM<DQK>(pA0, pA1, m_reg, mnA, alA);
  SLOAD(SO, 1); if constexpr (SDEPTH == 2) { if (2 < NT) SLOAD(SE, 2); }
  SWAIT(); SWRITE(1, SO); __syncthreads();
  for (int j = 1; j + 1 < NT; j += 2) {
    SBAR(); qkt<DQK>(pB0, pB1, K_lds + SHM_K, qr, qx, r32, hi); MASKT(pB0, pB1, j);
    finishSM(pA0, pA1, alA, l_reg, pa0, pa1, pa2, pa3); SBAR();
    SLOAD(SO, j + SDEPTH); SBAR();
    pv_d0(o, vb0, pa0, pa1, pa2, pa3); partialSM<DQK>(pB0, pB1, m_reg, mnB, alB);
    __syncthreads(); SWAIT(); SWRITE(0, SE);
    RESC(alB); __syncthreads();
    SBAR(); qkt<DQK>(pA0, pA1, K_lds, qr, qx, r32, hi); MASKT(pA0, pA1, j + 1);
    finishSM(pB0, pB1, alB, l_reg, pa0, pa1, pa2, pa3); SBAR();
    if (SDEPTH == 1 || j + 3 < NT) SLOAD(SE, j + 1 + SDEPTH); SBAR();
    pv_d0(o, vb0 + SHM_V, pa0, pa1, pa2, pa3); partialSM<DQK>(pA0, pA1, m_reg, mnA, alA);
    __syncthreads(); SWAIT(); SWRITE(1, SO);
    RESC(alA); __syncthreads();
  }
  SBAR(); qkt<DQK>(pB0, pB1, K_lds + SHM_K, qr, qx, r32, hi); MASKT(pB0, pB1, NT - 1);
  finishSM(pA0, pA1, alA, l_reg, pa0, pa1, pa2, pa3); SBAR();
  pv_d0(o, vb0, pa0, pa1, pa2, pa3); partialSM<DQK>(pB0, pB1, m_reg, mnB, alB);
  __syncthreads(); RESC(alB);
  finishSM(pB0, pB1, alB, l_reg, pa0, pa1, pa2, pa3); SBAR();
  pv_d0(o, vb0 + SHM_V, pa0, pa1, pa2, pa3);
  if constexpr (SINK) l_reg += __builtin_amdgcn_exp2f(sink_l2 - m_reg * C);
  if (hi == 0) li_l[r32] = l_reg; asm volatile("s_waitcnt lgkmcnt(0)" ::: "memory");
  float rli[16];
#pragma unroll
  for (int r = 0; r < 16; ++r) rli[r] = __builtin_amdgcn_rcpf(li_l[crow(r, hi)]);
  __syncthreads();
  LAS bf16* ost = (LAS bf16*)(lds + wid * 8704);
#pragma unroll
  for (int r = 0; r < 16; ++r) { const int orow = crow(r, hi);
#pragma unroll
    for (int d0 = 0; d0 < 4; ++d0) ost[orow * 136 + d0 * 32 + r32] = (bf16)f2bf(o[d0][r] * rli[r]); }
  asm volatile("s_waitcnt lgkmcnt(0)" ::: "memory");
#pragma unroll
  for (int i = 0; i < 8; ++i) { const int orow = i * 4 + (lane >> 4), ch = lane & 15;
    *(GAS v4u*)(Ow + (size_t)orow * 4096 + ch * 8) = *(const LAS v4u*)(ost + orow * 136 + ch * 8); }
  __syncthreads();
#undef SLOAD
#undef SWRITE
#undef SWAIT
#undef RESC
#undef MASKT
}
}

struct Args { const float* in[38]; float* out; unsigned char* ws; };
template <class T> __device__ __forceinline__ T launder(T p) { asm volatile("" : "+s"(p)); return p; }
template <class T> __device__ __forceinline__ T* launder_g(T* p) { GAS T* g = (GAS T*)p; asm volatile("" : "+s"(g)); return (T*)g; }
#define INP(i) ((const float*)(gcfl)F.A->in[i])
struct Frame {
    LAS unsigned char* lds;
    gu32* ctl;
    int tid, lane, wave;
    int vcu, G, gw, NGW;
    const __attribute__((address_space(4))) Args* A;
    float* out;
    unsigned char* ws;
    unsigned char* wsw;
};
enum { I_X = 0, I_C, I_CTX, I_CCTX, I_WMOD, I_BMOD, I_WIN, I_WOUT, I_LN1G, I_LN1B, I_WFF1, I_WFF2, I_LN2G, I_LN2B, I_SINK, I_CONVW, I_CONVB, I_LWA, I_LBA, I_LWI, I_LBI, I_LAM,
       I_QNORM, I_KVNORM, I_WQB, I_WKVB, I_MUP, I_MUN, I_W0, I_W2, I_A0, I_A2, I_G2, I_KK, I_KA, I_RK, I_LNG, I_LNB };
__device__ __forceinline__ int row_s(int row) { return row < SEQ ? 0 : (row < M_LAT ? 1 : 2); }
__device__ __forceinline__ const float* mod_ptr(const Frame& F, int l, int s, int chunk) { return (const float*)(F.ws + WS_MOD) + ((size_t)(l * 3 + s) * 6 + chunk) * DM; }

__device__ __forceinline__ void transpose_item(const float* W, int N, int Kvalid, bf16* WT, int ldt, const float* kscale, LAS float* scr, int k0, int n0, int lane) {
    { const int kr = lane >> 3, c4 = (lane & 7) * 4;
#pragma unroll
      for (int i = 0; i < 8; ++i) { const int kk = 8 * i + kr, k = k0 + kk; f32x4 v = {0.f, 0.f, 0.f, 0.f};
          if (k < Kvalid) { v = *(const f32x4*)(W + (size_t)k * N + n0 + c4); if (kscale) v = v * kscale[k]; }
          scr[kk * 33 + c4] = v.x; scr[kk * 33 + c4 + 1] = v.y; scr[kk * 33 + c4 + 2] = v.z; scr[kk * 33 + c4 + 3] = v.w; } }
    LDS_WAIT(); asm volatile("" ::: "memory");
    const int c = lane & 7;
#pragma unroll
    for (int j = 0; j < 4; ++j) { const int n = (lane >> 3) + 8 * j; const LAS float* s = scr + (8 * c) * 33 + n;
        v4u o; o.x = pk2(s[0 * 33], s[1 * 33]); o.y = pk2(s[2 * 33], s[3 * 33]); o.z = pk2(s[4 * 33], s[5 * 33]); o.w = pk2(s[6 * 33], s[7 * 33]);
        *(v4u*)(WT + (size_t)(n0 + n) * ldt + k0 + 8 * c) = o; }
    LDS_WAIT(); asm volatile("" ::: "memory");
}
struct TItem { const float* W; bf16* WT; const float* kscale; int N, Kvalid, ldt, k0, n0; };
__device__ __forceinline__ void titem_load(const TItem& t, int lane, f32x4 (&v)[8]) {
    const int kr = lane >> 3, c4 = (lane & 7) * 4;
#pragma unroll
    for (int i = 0; i < 8; ++i) { const int k = t.k0 + 8 * i + kr; v[i] = (f32x4){0.f, 0.f, 0.f, 0.f}; if (k < t.Kvalid) v[i] = *(const f32x4*)(t.W + (size_t)k * t.N + t.n0 + c4); }
}
__device__ __forceinline__ void titem_finish(const TItem& t, int lane, LAS float* scr, f32x4 (&v)[8]) {
    { const int kr = lane >> 3, c4 = (lane & 7) * 4;
#pragma unroll
      for (int i = 0; i < 8; ++i) { const int kk = 8 * i + kr, k = t.k0 + kk; f32x4 x = v[i]; if (t.kscale && k < t.Kvalid) x = x * t.kscale[k];
          scr[kk * 33 + c4] = x.x; scr[kk * 33 + c4 + 1] = x.y; scr[kk * 33 + c4 + 2] = x.z; scr[kk * 33 + c4 + 3] = x.w; } }
    LDS_WAIT(); asm volatile("" ::: "memory");
    const int c = lane & 7;
#pragma unroll
    for (int j = 0; j < 4; ++j) { const int n = (lane >> 3) + 8 * j; const LAS float* s = scr + (8 * c) * 33 + n;
        v4u o; o.x = pk2(s[0 * 33], s[1 * 33]); o.y = pk2(s[2 * 33], s[3 * 33]); o.z = pk2(s[4 * 33], s[5 * 33]); o.w = pk2(s[6 * 33], s[7 * 33]);
        *(v4u*)(t.WT + (size_t)(t.n0 + n) * t.ldt + t.k0 + 8 * c) = o; }
    LDS_WAIT(); asm volatile("" ::: "memory");
}
__device__ __forceinline__ TItem conv_decode(const Frame& F, int l, unsigned char* ws, int r) {
    constexpr int I1 = 64 * 271, I2 = 64 * 128, I3 = 64 * 512, I4 = 256 * 128, I5 = 16 * 48, I6 = 8 * 64, I7 = 32 * 8, I8 = 2 * 32, I9 = 2 * 32;
    if (r < I1) return TItem{INP(I_WIN) + (size_t)l * DM * DIN, (bf16*)(ws + WS_WIN), nullptr, DIN, DM, DM, 64 * (r / 271), 32 * (r % 271)}; r -= I1;
    if (r < I2) return TItem{INP(I_WOUT) + (size_t)l * DM * DM, (bf16*)(ws + WS_WOUT), nullptr, DM, DM, DM, 64 * (r / 128), 32 * (r % 128)}; r -= I2;
    if (r < I3) return TItem{INP(I_WFF1) + (size_t)l * DM * DFF, (bf16*)(ws + WS_WFF1), nullptr, DFF, DM, DM, 64 * (r / 512), 32 * (r % 512)}; r -= I3;
    if (r < I4) return TItem{INP(I_WFF2) + (size_t)l * DFF * DM, (bf16*)(ws + WS_WFF2), nullptr, DM, DFF, DFF, 64 * (r / 128), 32 * (r % 128)}; r -= I4;
    if (r < I5) return TItem{INP(I_WQB) + (size_t)l * 1024 * 1536, (bf16*)(ws + WS_WQB), INP(I_QNORM) + l * 1024, 1536, 1024, 1024, 64 * (r / 48), 32 * (r % 48)}; r -= I5;
    if (r < I6) return TItem{INP(I_WKVB) + (size_t)l * 512 * 2048, (bf16*)(ws + WS_WKVB), INP(I_KVNORM) + l * 512, 2048, 512, 512, 64 * (r / 64), 32 * (r % 64)}; r -= I6;
    if (r < I7) { const int mat = r >> 3, sub = r & 7, gate = mat & 1, dn = mat >> 1, d = dn >> 3, n = dn & 7;
        return TItem{(gate ? INP(I_LWI) : INP(I_LWA)) + ((size_t)(l * 2 + d) * 8 + n) * 128 * 128, (bf16*)(ws + WS_WLRU) + ((size_t)(d * 2 + gate) * 8 + n) * 128 * 128, nullptr, 128, 128, 128, 64 * (sub >> 2), 32 * (sub & 3)}; } r -= I7;
    if (r < I8) { const int d = r >> 5; return TItem{INP(I_W2) + (size_t)(l * 2 + d) * 64 * 1024, (bf16*)(ws + WS_W2T) + (size_t)d * 1024 * 64, nullptr, 1024, 64, 64, 0, 32 * (r & 31)}; } r -= I8;
    if (r < I9) { const int d = r >> 5; return TItem{INP(I_A2) + (size_t)(l * 2 + d) * 64 * 1024, (bf16*)(ws + WS_A2T) + (size_t)d * 1024 * 64, nullptr, 1024, 64, 64, 0, 32 * (r & 31)}; } r -= I9;
    return TItem{INP(I_G2) + (size_t)l * 160 * 1024, (bf16*)(ws + WS_G2T), nullptr, 1024, 160, 192, 64 * (r / 32), 32 * (r % 32)};
}
__device__ __forceinline__ void convert_weights(Frame& F, int l, int widx, int nw) {
    LAS float* scr = (LAS float*)(F.lds + F.wave * 16384);
    constexpr int NIT = 64 * 271 + 64 * 128 + 64 * 512 + 256 * 128 + 16 * 48 + 8 * 64 + 32 * 8 + 2 * 32 + 2 * 32 + 3 * 32;
    unsigned char* ws = F.ws + (l ? WSET_STRIDE : 0);
    int it = __builtin_amdgcn_readfirstlane(widx);
    if (it < NIT) { TItem cur = conv_decode(F, l, ws, it); f32x4 va[8]; titem_load(cur, F.lane, va);
#pragma unroll 1
        for (;;) { const int itn = it + nw; TItem nxt = cur; f32x4 vb[8];
            if (itn < NIT) { nxt = conv_decode(F, l, ws, itn); titem_load(nxt, F.lane, vb); }
            else {
#pragma unroll
                for (int i = 0; i < 8; ++i) vb[i] = va[i]; }
            titem_finish(cur, F.lane, scr, va);
            if (itn >= NIT) break;
            cur = nxt; it = itn;
#pragma unroll
            for (int i = 0; i < 8; ++i) va[i] = vb[i]; } }
    { unsigned zz = 0u; asm volatile("" : "+v"(zz)); v4u z = {zz, zz, zz, zz}; v4u* p = (v4u*)((bf16*)(ws + WS_WIN) + (size_t)DIN * DM);
      for (int i = widx * 64 + F.lane; i < 32 * DM / 8; i += nw * 64) p[i] = z; }
}

__device__ __forceinline__ void mod_partials(Frame& F) {
    LAS float* sl = (LAS float*)F.lds;
    for (int it = F.vcu; it < 2 * 32 * 12; it += F.G) {
        const int l = it / 384, ks = (it / 12) % 32, cc = it % 12;
        __syncthreads();
        if (F.tid < 384) { const int s = F.tid >> 7, k = ks * 128 + (F.tid & 127); const float c = s < 2 ? INP(I_C)[s * DM + k] : INP(I_CCTX)[k]; sl[F.tid] = c / (1.f + __expf(-c)); }
        __syncthreads();
        const float* wp = INP(I_WMOD) + ((size_t)l * DM + ks * 128) * 24576 + cc * 2048 + F.tid * 4;
        f32x4 a0 = {0.f, 0.f, 0.f, 0.f}, a1 = a0, a2 = a0;
#pragma unroll 8
        for (int k = 0; k < 128; ++k) { const f32x4 w = *(const f32x4*)(wp + (size_t)k * 24576); a0 += w * sl[k]; a1 += w * sl[128 + k]; a2 += w * sl[256 + k]; }
        float* op = (float*)(F.ws + WS_MODP) + ((size_t)(l * 32 + ks) * 3) * 24576 + cc * 2048 + F.tid * 4;
        *(f32x4*)(op) = a0; *(f32x4*)(op + 24576) = a1; *(f32x4*)(op + 2 * 24576) = a2;
    }
    __syncthreads();
}
__device__ __forceinline__ void mod_reduce(Frame& F) {
    for (int i = F.vcu * NTHR + F.tid; i < 2 * 3 * 24576; i += F.G * NTHR) {
        const int l = i / (3 * 24576), s = (i / 24576) % 3, n = i % 24576;
        float a = INP(I_BMOD)[l * 24576 + n];
        const float* pp = (const float*)(F.ws + WS_MODP) + ((size_t)(l * 32) * 3 + s) * 24576 + n;
#pragma unroll 8
        for (int ks = 0; ks < 32; ++ks) a += pp[(size_t)ks * 3 * 24576];
        ((float*)(F.ws + WS_MOD))[i] = a;
    }
}

__device__ __forceinline__ void sum_partials_row(const Frame& F, const float* yp, size_t stride, bf16* ydst) {
    int lane = F.lane; asm volatile("" : "+v"(lane));
#pragma unroll 2
    for (int j = 0; j < 16; ++j) { const int c = 4 * lane + 256 * j; f32x4 y = *(const f32x4*)(yp + c);
#pragma unroll
        for (int sp = 1; sp < 8; ++sp) y += *(const f32x4*)(yp + sp * stride + c);
        v2u w; w.x = pk2(y.x, y.y); w.y = pk2(y.z, y.w); *(v2u*)(ydst + c) = w; }
}
constexpr int LNV_G = 0, LNV_B = DM, LNV_GA = 2 * DM, LNV_SC = 3 * DM, LNV_SH = 4 * DM;
__device__ __forceinline__ void ln_stage(const Frame& F, int slot, const float* src) {
    LAS float* d = (LAS float*)F.lds + slot; gcfl g = (gcfl)src;
#pragma unroll
    for (int u = 0; u < 2; ++u) { const int c = 4 * (F.tid + NTHR * u); *(LAS f32x4*)(d + c) = *(const GAS f32x4*)(g + c); }
}
template <int MODE, bool XSH = false, bool XDH = false>
__device__ __forceinline__ void ln_row(const Frame& F, const void* xsrc_, const bf16* Y_, void* xdst_, bool domod, bf16* hrow_) {
    gcfl xsrc = (gcfl)xsrc_; const GAS _Float16* xsrch = (const GAS _Float16*)xsrc_; gflp xdst = (gflp)xdst_; GAS _Float16* xdsth = (GAS _Float16*)xdst_;
    gcbf Y = (gcbf)Y_; gbfp hrow = (gbfp)hrow_; const LAS float* L = (const LAS float*)F.lds + 4 * F.lane;
    f32x4 v[16]; v2u yr[16]; float s = 0.f;
#pragma unroll
    for (int j = 0; j < 16; ++j) { const int c = 4 * F.lane + 256 * j;
        if (XSH) v[j] = __builtin_convertvector(__builtin_nontemporal_load((const GAS h16x4*)(xsrch + c)), f32x4); else v[j] = __builtin_nontemporal_load((const GAS f32x4*)(xsrc + c)); }
    if (MODE == 1) {
#pragma unroll
        for (int j = 0; j < 16; ++j) yr[j] = __builtin_nontemporal_load((const GAS v2u*)(Y + 4 * F.lane + 256 * j));
    }
#pragma unroll
    for (int j = 0; j < 16; ++j) {
        if (MODE == 1) { const f32x4 y = {bflo(yr[j].x), bfhi(yr[j].x), bflo(yr[j].y), bfhi(yr[j].y)}, g = *(const LAS f32x4*)(L + LNV_GA + 256 * j); v[j] = v[j] * ALPHA + g * y; }
        s += (v[j].x + v[j].y) + (v[j].z + v[j].w); }
    float mean = wave_sum(s) * (1.f / DM), s2 = 0.f;
#pragma unroll
    for (int j = 0; j < 16; ++j) { v[j] = v[j] - mean; s2 += (v[j].x * v[j].x + v[j].y * v[j].y) + (v[j].z * v[j].z + v[j].w * v[j].w); }
    float rstd = 1.f / sqrtf(wave_sum(s2) * (1.f / DM) + LN_EPS);
    if (MODE == 1) {
        s = 0.f;
#pragma unroll
        for (int j = 0; j < 16; ++j) { const int c = 4 * F.lane + 256 * j; const f32x4 g = *(const LAS f32x4*)(L + LNV_G + 256 * j), b = *(const LAS f32x4*)(L + LNV_B + 256 * j); v[j] = v[j] * rstd * g + b;
            if (XDH) __builtin_nontemporal_store(__builtin_convertvector(v[j], h16x4), (GAS h16x4*)(xdsth + c)); else __builtin_nontemporal_store(v[j], (GAS f32x4*)(xdst + c));
            s += (v[j].x + v[j].y) + (v[j].z + v[j].w); }
        if (!domod) return;
        mean = wave_sum(s) * (1.f / DM); s2 = 0.f;
#pragma unroll
        for (int j = 0; j < 16; ++j) { v[j] = v[j] - mean; s2 += (v[j].x * v[j].x + v[j].y * v[j].y) + (v[j].z * v[j].z + v[j].w * v[j].w); }
        rstd = 1.f / sqrtf(wave_sum(s2) * (1.f / DM) + LN_EPS);
    }
#pragma unroll
    for (int j = 0; j < 16; ++j) { const int c = 4 * F.lane + 256 * j; const f32x4 a = *(const LAS f32x4*)(L + LNV_SC + 256 * j), b = *(const LAS f32x4*)(L + LNV_SH + 256 * j);
        const f32x4 o = v[j] * rstd * (a + 1.f) + b; v2u w; w.x = pk2(o.x, o.y); w.y = pk2(o.z, o.w); *(GAS v2u*)(hrow + c) = w; }
}

__device__ __forceinline__ void shift4(const bf16* P, unsigned eo, bool hp, bool hn, const float* mup, const float* mun, unsigned mo, float (&u)[4]) {
    const v2u xc = ldg<v2u>(P, eo * 2u); v2u xp = {0u, 0u}, xn = {0u, 0u};
    if (hp) xp = ldg<v2u>(P, (eo - DINP) * 2u); if (hn) xn = ldg<v2u>(P, (eo + DINP) * 2u);
    const f32x4 mp = ldg<f32x4>(mup, mo * 4u), mn = ldg<f32x4>(mun, mo * 4u);
    const float c[4] = {bflo(xc.x), bfhi(xc.x), bflo(xc.y), bfhi(xc.y)}, p[4] = {bflo(xp.x), bfhi(xp.x), bflo(xp.y), bfhi(xp.y)}, n[4] = {bflo(xn.x), bfhi(xn.x), bflo(xn.y), bfhi(xn.y)};
#pragma unroll
    for (int e = 0; e < 4; ++e) u[e] = c[e] + mp[e] * (p[e] - c[e]) + mn[e] * (n[e] - c[e]);
}
__device__ __forceinline__ void st4bf(void* base, unsigned eo, float a, float b, float c, float d) { v2u w; w.x = pk2(a, b); w.y = pk2(c, d); stg<v2u>(base, eo * 2u, w); }

__device__ __forceinline__ void rwkv_feat_item(Frame& F, int l, int item) {
    F.tid = ltid(); F.lane = F.tid & 63;
    int row0, seq_lo, seq_hi;
    if (item < 16) { const int b = item >> 3; seq_lo = M_LAT + b * NCTX; seq_hi = seq_lo + NCTX; row0 = seq_lo + (item & 7) * 32; }
    else { const int it = item - 16, b = it >> 8; seq_lo = b * SEQ; seq_hi = seq_lo + SEQ; row0 = seq_lo + (it & 255) * 32; }
    const bf16* P = (const bf16*)(F.ws + WS_P);
    LAS bf16* ACT = (LAS bf16*)F.lds;
    const float* mup = INP(I_MUP) + l * RWC; const float* mun = INP(I_MUN) + l * RWC;
    __syncthreads();
    { const int tok = F.tid >> 4, jc = F.tid & 15, row = row0 + tok; const bool hp = row > seq_lo, hn = row + 1 < seq_hi;
      const bf16* pr = P + (size_t)row * DINP + C_RWL;
#pragma unroll
      for (int i = 0; i < 13; ++i) { const int j = jc * 2 + 32 * i;
          const unsigned xc = *(const unsigned*)(pr + j), xp = hp ? *(const unsigned*)(pr - DINP + j) : 0u, xn = hn ? *(const unsigned*)(pr + DINP + j) : 0u;
          float u[2];
#pragma unroll
          for (int e = 0; e < 2; ++e) { const float c = e ? bfhi(xc) : bflo(xc), p = e ? bfhi(xp) : bflo(xp), n = e ? bfhi(xn) : bflo(xn);
              float v = c + mup[3072 + j + e] * (p - c) + mun[3072 + j + e] * (n - c);
              if (j < 128) v = tanhf_(v); else if (j >= 256) v = sigmoidf_(v);
              u[e] = v; }
          *(LAS unsigned*)(ACT + tok * 424 + j) = pk2(u[0], u[1]); } }
    __syncthreads();
    const int tok = F.lane & 31, hi = F.lane >> 5, row = row0 + tok;
    const bf16* W2T = (const bf16*)(F.wsw + WS_W2T); const bf16* A2T = (const bf16*)(F.wsw + WS_A2T); const bf16* G2T = (const bf16*)(F.wsw + WS_G2T);
    bf16* RWF = (bf16*)(F.ws + WS_RWF); const size_t RS = (size_t)M_TOT * 1024;
    const float* kkv = INP(I_KK) + l * 1024; const float* kav = INP(I_KA) + l * 1024; const float* rkv = INP(I_RK) + l * 1024;
    const float* w0f = INP(I_W0) + (size_t)(l * 2) * 1024; const float* a0f = INP(I_A0) + (size_t)(l * 2) * 1024;
    const LAS bf16* actl = ACT + tok * 424 + hi * 8;
    LAS unsigned char* TB = F.lds + 27136 + F.wave * 10880;
    LAS float* VB = (LAS float*)(F.lds + (F.wave < 4 ? 114176 + F.wave * 3328 : 131584 + (F.wave - 4) * 3328));
#define RF_LOADG(reg_, colbase) do { _Pragma("unroll") for (int i_ = 0; i_ < 3; ++i_) { const int p_ = F.lane + 64 * i_; reg_[i_] = (v4u){0u, 0u, 0u, 0u}; if (p_ < 136) { const int rr_ = p_ >> 2, cp_ = p_ & 3, gr_ = row0 - 1 + rr_; \
        if (gr_ >= seq_lo && gr_ < seq_hi) reg_[i_] = ldg<v4u>(P, ((unsigned)gr_ * DINP + (colbase) + 8 * cp_) * 2u); } } } while (0)
#define RF_STORET(ti, reg_) do { _Pragma("unroll") for (int i_ = 0; i_ < 3; ++i_) { const int p_ = F.lane + 64 * i_; if (p_ < 136) { const int rr_ = p_ >> 2, cp_ = p_ & 3; *(LAS v4u*)(TB + (ti) * 2720 + rr_ * 80 + cp_ * 16) = reg_[i_]; } } } while (0)
#define RF_SHIFT4(ti, g_, vb_, cc_, u_) do { const LAS unsigned char* q_ = TB + (ti) * 2720 + (tok + 1) * 80 + (8 * (g_) + 4 * hi) * 2; const v2u xc_ = *(const LAS v2u*)q_, xp_ = *(const LAS v2u*)(q_ - 80), xn_ = *(const LAS v2u*)(q_ + 80); \
        const f32x4 mp_ = *(const LAS f32x4*)(VB + (vb_) * 64 + (cc_)), mn_ = *(const LAS f32x4*)(VB + ((vb_) + 1) * 64 + (cc_)); \
        const float c_[4] = {bflo(xc_.x), bfhi(xc_.x), bflo(xc_.y), bfhi(xc_.y)}, pp_[4] = {bflo(xp_.x), bfhi(xp_.x), bflo(xp_.y), bfhi(xp_.y)}, nn_[4] = {bflo(xn_.x), bfhi(xn_.x), bflo(xn_.y), bfhi(xn_.y)}; \
        _Pragma("unroll") for (int e_ = 0; e_ < 4; ++e_) u_[e_] = c_[e_] + mp_[e_] * (pp_[e_] - c_[e_]) + mn_[e_] * (nn_[e_] - c_[e_]); } while (0)
#define RF_PUT(ti, o_) do { _Pragma("unroll") for (int g_ = 0; g_ < 4; ++g_) *(LAS v2u*)(TB + (ti) * 2720 + tok * 80 + (8 * g_ + 4 * hi) * 2) = o_[g_]; } while (0)
#define RF_FLUSH3(a0_, a1_, a2_, cblk_) do { asm volatile("s_waitcnt lgkmcnt(0)" ::: "memory"); \
        _Pragma("unroll") for (int t_ = 0; t_ < 3; ++t_) { const int arr_ = t_ == 0 ? (a0_) : (t_ == 1 ? (a1_) : (a2_)); \
            _Pragma("unroll") for (int i_ = 0; i_ < 2; ++i_) { const int p_ = F.lane + 64 * i_, rr_ = p_ >> 2, cp_ = p_ & 3; const v4u v_ = *(const LAS v4u*)(TB + t_ * 2720 + rr_ * 80 + cp_ * 16); \
                stg<v4u>(RWF + arr_ * RS, ((unsigned)(row0 + rr_) * 1024u + (cblk_) + 8 * cp_) * 2u, v_); } } \
        asm volatile("s_waitcnt lgkmcnt(0)" ::: "memory"); } while (0)
#pragma unroll 1
    for (int hh = 0; hh < 2; ++hh) {
        const int h = 2 * F.wave + hh, cbase = h * 64;
        float ssq = 0.f;
        { v4u t0[3], t1[3]; RF_LOADG(t0, C_RWK + cbase); RF_LOADG(t1, C_RWK + cbase + 32);
          const unsigned co = (cbase + F.lane) * 4u; float vv[13];
#pragma unroll
          for (int sct = 0; sct < 3; ++sct) { vv[2 * sct] = ldg<float>(mup, co + sct * 4096u); vv[2 * sct + 1] = ldg<float>(mun, co + sct * 4096u); }
          vv[6] = ldg<float>(kkv, co); vv[7] = ldg<float>(kav, co); vv[8] = ldg<float>(rkv, co); vv[9] = ldg<float>(a0f, co); vv[10] = ldg<float>(a0f, co + 4096u); vv[11] = ldg<float>(w0f, co); vv[12] = ldg<float>(w0f, co + 4096u);
          RF_STORET(0, t0); RF_STORET(1, t1);
#pragma unroll
          for (int q = 0; q < 13; ++q) VB[q * 64 + F.lane] = vv[q]; }
        asm volatile("s_waitcnt lgkmcnt(0)" ::: "memory");
#pragma unroll
        for (int bg = 0; bg < 8; ++bg) { const int cc = (bg >> 2) * 32 + 8 * (bg & 3) + 4 * hi; float uk[4];
            RF_SHIFT4(bg >> 2, bg & 3, 2, cc, uk); const f32x4 k4 = *(const LAS f32x4*)(VB + 6 * 64 + cc);
#pragma unroll
            for (int e = 0; e < 4; ++e) { const float q = uk[e] * k4[e]; ssq += q * q; } }
        ssq = half_swap_sum(ssq);
        const float rn = 1.f / fmaxf(sqrtf(ssq), 1e-12f);
        float sb = 0.f;
        asm volatile("s_waitcnt lgkmcnt(0)" ::: "memory");
#pragma unroll 1
        for (int blk = 0; blk < 2; ++blk) {
            const unsigned cblk = cbase + blk * 32, cha = cblk + tok;
            v4u gR[3], gK[3], gV[3];
            RF_LOADG(gR, C_RWR + cblk); RF_LOADG(gK, C_RWK + cblk); RF_LOADG(gV, C_RWV + cblk);
            bf16x8 wd[2][4], wg[10], wa[2][4];
#pragma unroll
            for (int d = 0; d < 2; ++d) {
#pragma unroll
                for (int ks = 0; ks < 4; ++ks) wd[d][ks] = ldg<bf16x8>(W2T, ((d * 1024 + cha) * 64 + ks * 16 + hi * 8) * 2u); }
#pragma unroll
            for (int ks = 0; ks < 10; ++ks) wg[ks] = ldg<bf16x8>(G2T, (cha * 192 + ks * 16 + hi * 8) * 2u);
#pragma unroll
            for (int d = 0; d < 2; ++d) {
#pragma unroll
                for (int ks = 0; ks < 4; ++ks) wa[d][ks] = ldg<bf16x8>(A2T, ((d * 1024 + cha) * 64 + ks * 16 + hi * 8) * 2u); }
#pragma unroll
            for (int d = 0; d < 2; ++d) { f32x16 aw = {};
#pragma unroll
                for (int ks = 0; ks < 4; ++ks) { const bf16x8 bw = *(const LAS bf16x8*)(actl + d * 64 + ks * 16);
                    aw = __builtin_amdgcn_mfma_f32_32x32x16_bf16(wd[d][ks], bw, aw, 0, 0, 0); }
                v2u o[4];
#pragma unroll
                for (int g = 0; g < 4; ++g) { const f32x4 w0 = *(const LAS f32x4*)(VB + (11 + d) * 64 + blk * 32 + 8 * g + 4 * hi); float e4[4];
#pragma unroll
                    for (int e = 0; e < 4; ++e) e4[e] = 0.60653065971f * sigmoidf_(w0[e] + aw[4 * g + e]);
                    o[g].x = pk2(e4[0], e4[1]); o[g].y = pk2(e4[2], e4[3]); }
                RF_PUT(d, o); }
            { f32x16 ag = {};
#pragma unroll
              for (int ks = 0; ks < 10; ++ks) { const bf16x8 bg_ = *(const LAS bf16x8*)(actl + 256 + ks * 16);
                  ag = __builtin_amdgcn_mfma_f32_32x32x16_bf16(wg[ks], bg_, ag, 0, 0, 0); }
              v2u o[4];
#pragma unroll
              for (int g = 0; g < 4; ++g) { o[g].x = pk2(ag[4 * g], ag[4 * g + 1]); o[g].y = pk2(ag[4 * g + 2], ag[4 * g + 3]); }
              RF_PUT(2, o); }
            RF_FLUSH3(4, 5, 8, cblk);
            RF_STORET(0, gR); RF_STORET(1, gK); RF_STORET(2, gV);
            { f32x16 aaf = {}, aab = {};
#pragma unroll
              for (int ks = 0; ks < 4; ++ks) { const bf16x8 baf = *(const LAS bf16x8*)(actl + 128 + ks * 16), bab = *(const LAS bf16x8*)(actl + 192 + ks * 16);
                  aaf = __builtin_amdgcn_mfma_f32_32x32x16_bf16(wa[0][ks], baf, aaf, 0, 0, 0); aab = __builtin_amdgcn_mfma_f32_32x32x16_bf16(wa[1][ks], bab, aab, 0, 0, 0); }
              v2u oR[4], oK[4], oV[4], oKK[4], oAF[4], oAB[4];
              asm volatile("s_waitcnt lgkmcnt(0)" ::: "memory");
#pragma unroll
              for (int g = 0; g < 4; ++g) { const int cc = blk * 32 + 8 * g + 4 * hi; float ur[4], uk[4], uv[4];
                  RF_SHIFT4(0, g, 0, cc, ur); RF_SHIFT4(1, g, 2, cc, uk); RF_SHIFT4(2, g, 4, cc, uv);
                  const f32x4 a0a = *(const LAS f32x4*)(VB + 9 * 64 + cc), a0b = *(const LAS f32x4*)(VB + 10 * 64 + cc), kk4 = *(const LAS f32x4*)(VB + 6 * 64 + cc), ka4 = *(const LAS f32x4*)(VB + 7 * 64 + cc), rk4 = *(const LAS f32x4*)(VB + 8 * 64 + cc);
                  float af[4], ab[4], kk[4];
#pragma unroll
                  for (int e = 0; e < 4; ++e) { const int r = 4 * g + e;
                      af[e] = sigmoidf_(a0a[e] + aaf[r]); ab[e] = sigmoidf_(a0b[e] + aab[r]); kk[e] = uk[e] * kk4[e] * rn;
                      const float kdf = uk[e] * (1.f + (af[e] - 1.f) * ka4[e]), kdb = uk[e] * (1.f + (ab[e] - 1.f) * ka4[e]);
                      sb += ur[e] * rk4[e] * (kdf + kdb); }
                  oR[g].x = pk2(ur[0], ur[1]); oR[g].y = pk2(ur[2], ur[3]); oK[g].x = pk2(uk[0], uk[1]); oK[g].y = pk2(uk[2], uk[3]); oV[g].x = pk2(uv[0], uv[1]); oV[g].y = pk2(uv[2], uv[3]);
                  oKK[g].x = pk2(kk[0], kk[1]); oKK[g].y = pk2(kk[2], kk[3]); oAF[g].x = pk2(af[0], af[1]); oAF[g].y = pk2(af[2], af[3]); oAB[g].x = pk2(ab[0], ab[1]); oAB[g].y = pk2(ab[2], ab[3]); }
              asm volatile("s_waitcnt lgkmcnt(0)" ::: "memory");
              RF_PUT(0, oR); RF_PUT(1, oK); RF_PUT(2, oV); RF_FLUSH3(0, 1, 2, cblk);
              RF_PUT(0, oKK); RF_PUT(1, oAF); RF_PUT(2, oAB); RF_FLUSH3(3, 6, 7, cblk); }
        }
        sb = half_swap_sum(sb);
        if (hi == 0) ((float*)(F.ws + WS_SB))[(size_t)row * 16 + h] = sb;
    }
#undef RF_LOADG
#undef RF_STORET
#undef RF_SHIFT4
#undef RF_PUT
#undef RF_FLUSH3
}

__device__ __forceinline__ float gelu_tanh(float x) { return 0.5f * x * (1.f + tanhf_(0.7978845608028654f * (x + 0.044715f * x * x * x))); }
template <bool PASS3>
__device__ __forceinline__ void lru_item(Frame& F, int l, int item) {
    F.tid = ltid(); F.lane = F.tid & 63;
    const int sc = item >> 3, nb = item & 7, b = sc / NCH, ch = sc % NCH;
    int row0, seq_lo, seq_hi;
    if (ch < 8) { seq_lo = M_LAT + b * NCTX; seq_hi = seq_lo + NCTX; row0 = seq_lo + ch * 32; }
    else { seq_lo = b * SEQ; seq_hi = seq_lo + SEQ; row0 = seq_lo + (ch - 8) * 32; }
    const bf16* P = (const bf16*)(F.ws + WS_P);
    LAS float* U = (LAS float*)F.lds;
    LAS bf16* UA = (LAS bf16*)(F.lds + 16384);
    LAS float* AB = (LAS float*)(F.lds + 32768);
    __syncthreads();
    { const int tok = F.tid >> 4, c8 = (F.tid & 15) * 8, cg = nb * 128 + c8; float acc[8];
      const float* cb = INP(I_CONVB) + l * 1024 + cg;
#pragma unroll
      for (int e = 0; e < 8; ++e) acc[e] = cb[e];
#pragma unroll
      for (int j = 0; j < 4; ++j) { const int r = row0 + tok - 2 + j;
          if (r >= seq_lo && r < seq_hi) { const v4u x = *(const v4u*)(P + (size_t)r * DINP + C_LRUX + cg); const float* cw = INP(I_CONVW) + (size_t)(l * 4 + j) * 1024 + cg;
#pragma unroll
              for (int w = 0; w < 4; ++w) { acc[2 * w] += cw[2 * w] * bflo(x[w]); acc[2 * w + 1] += cw[2 * w + 1] * bfhi(x[w]); } } }
      *(LAS f32x4*)(U + tok * 128 + c8) = (f32x4){acc[0], acc[1], acc[2], acc[3]}; *(LAS f32x4*)(U + tok * 128 + c8 + 4) = (f32x4){acc[4], acc[5], acc[6], acc[7]};
      v4u o; o.x = pk2(acc[0], acc[1]); o.y = pk2(acc[2], acc[3]); o.z = pk2(acc[4], acc[5]); o.w = pk2(acc[6], acc[7]);
      *(LAS v4u*)(UA + tok * 136 + c8) = o; }
    __syncthreads();
    { const int dir = F.wave >> 2, cq = F.wave & 3, l32 = F.lane & 31, hi = F.lane >> 5, chn = cq * 32 + l32, cg = nb * 128 + chn;
      const bf16* Wr = (const bf16*)(F.wsw + WS_WLRU) + ((size_t)(dir * 2 + 0) * 8 + nb) * 16384 + (size_t)chn * 128;
      const bf16* Wi = (const bf16*)(F.wsw + WS_WLRU) + ((size_t)(dir * 2 + 1) * 8 + nb) * 16384 + (size_t)chn * 128;
      f32x16 accr = {}, acci = {};
#pragma unroll
      for (int ks = 0; ks < 8; ++ks) { const int ko = ks * 16 + hi * 8;
          const bf16x8 a = *(const LAS bf16x8*)(UA + l32 * 136 + ko); const bf16x8 br = *(const bf16x8*)(Wr + ko), bi = *(const bf16x8*)(Wi + ko);
          accr = __builtin_amdgcn_mfma_f32_32x32x16_bf16(a, br, accr, 0, 0, 0); acci = __builtin_amdgcn_mfma_f32_32x32x16_bf16(a, bi, acci, 0, 0, 0); }
      const float ba = INP(I_LBA)[(l * 2 + dir) * 1024 + cg], bi_ = INP(I_LBI)[(l * 2 + dir) * 1024 + cg], sp = softplusf_(-INP(I_LAM)[(l * 2 + dir) * 1024 + cg]);
#pragma unroll
      for (int r = 0; r < 16; ++r) { const int tok = att::crow(r, hi); const float u = U[tok * 128 + chn];
          const float rg = sigmoidf_(accr[r] + ba), ig = sigmoidf_(acci[r] + bi_), la = -8.f * rg * sp, a = __expf(la), x2 = 2.f * la;
          const float em = x2 * (1.f + x2 * (0.5f + x2 * (0.16666667f + x2 * (0.041666668f + x2 * (0.0083333338f + x2 * 0.0013888889f)))));
          const float bc = __builtin_amdgcn_sqrtf(x2 < -0.5f ? 1.f - a * a : -em) * (ig * u);
          AB[(dir * 2 + 0) * 4096 + tok * 128 + chn] = a; AB[(dir * 2 + 1) * 4096 + tok * 128 + chn] = bc; } }
    __syncthreads();
    if (F.tid < 256) { const int dir = F.tid >> 7, chn = F.tid & 127, cg = nb * 128 + chn; const size_t ci = ((size_t)(dir * 2 + b) * NCH + ch) * 1024 + cg;
        LAS float* Aa = AB + (dir * 2) * 4096 + chn; LAS float* Bb = AB + (dir * 2 + 1) * 4096 + chn;
        if (!PASS3) { float h = 0.f, ap = 1.f;
#pragma unroll 8
            for (int s = 0; s < 32; ++s) { const int tok = dir ? 31 - s : s; const float a = Aa[tok * 128]; h = a * h + Bb[tok * 128]; ap *= a;
                if (s == 0 && dir == 1 && ch == 7) ((float*)(F.ws + WS_QUIRK))[b * 1024 + cg] = h; }
            ((float*)(F.ws + WS_CA))[ci] = ap; ((float*)(F.ws + WS_CB))[ci] = h;
        } else { float h = ((const float*)(F.ws + WS_HIN))[ci];
#pragma unroll 8
            for (int s = 0; s < 32; ++s) { const int tok = dir ? 31 - s : s; h = Aa[tok * 128] * h + Bb[tok * 128]; Bb[tok * 128] = h; } } }
    if (PASS3) { __syncthreads();
        const int tok = F.tid >> 4, c8 = (F.tid & 15) * 8, cg = nb * 128 + c8, row = row0 + tok;
        const v4u y = *(const v4u*)(P + (size_t)row * DINP + C_LRUY + cg); float o[8];
#pragma unroll
        for (int w = 0; w < 4; ++w) { const float h0 = AB[4096 + tok * 128 + c8 + 2 * w] + AB[3 * 4096 + tok * 128 + c8 + 2 * w], h1 = AB[4096 + tok * 128 + c8 + 2 * w + 1] + AB[3 * 4096 + tok * 128 + c8 + 2 * w + 1];
            o[2 * w] = h0 * gelu_tanh(bflo(y[w])); o[2 * w + 1] = h1 * gelu_tanh(bfhi(y[w])); }
        v4u ov; ov.x = pk2(o[0], o[1]); ov.y = pk2(o[2], o[3]); ov.z = pk2(o[4], o[5]); ov.w = pk2(o[6], o[7]);
        *(v4u*)((bf16*)(F.ws + WS_MIX) + (size_t)row * DM + 1024 + cg) = ov; }
}
template <bool PASS3>
__device__ __forceinline__ void lru_items(Frame& F, int l, int i0, int i1, int st, bool skipctx) {
    F.tid = ltid(); F.lane = F.tid & 63;
    int it = i0; while (it < i1 && skipctx && ((it >> 3) % NCH) < 8) it += st;
    if (it >= i1) return;
    const int nb = it & 7;
    const bf16* P = (const bf16*)(F.ws + WS_P);
    LAS float* U = (LAS float*)F.lds; LAS bf16* UA = (LAS bf16*)(F.lds + 16384); LAS float* AB = (LAS float*)(F.lds + 32768);
    const int tokc = F.tid >> 4, c8 = (F.tid & 15) * 8, cgc = nb * 128 + c8;
    const int dir = F.wave >> 2, cq = F.wave & 3, l32 = F.lane & 31, hi = F.lane >> 5, chn = cq * 32 + l32, cg = nb * 128 + chn;
    f32x4 cbv[2], cwv[4][2];
#pragma unroll
    for (int q = 0; q < 2; ++q) { cbv[q] = *(const f32x4*)(INP(I_CONVB) + l * 1024 + cgc + 4 * q);
#pragma unroll
        for (int j = 0; j < 4; ++j) cwv[j][q] = *(const f32x4*)(INP(I_CONVW) + (size_t)(l * 4 + j) * 1024 + cgc + 4 * q); }
    bf16x8 wr[8], wi[8];
    { const bf16* Wr = (const bf16*)(F.wsw + WS_WLRU) + ((size_t)(dir * 2 + 0) * 8 + nb) * 16384 + (size_t)chn * 128;
      const bf16* Wi = (const bf16*)(F.wsw + WS_WLRU) + ((size_t)(dir * 2 + 1) * 8 + nb) * 16384 + (size_t)chn * 128;
#pragma unroll
      for (int ks = 0; ks < 8; ++ks) { wr[ks] = *(const bf16x8*)(Wr + ks * 16 + hi * 8); wi[ks] = *(const bf16x8*)(Wi + ks * 16 + hi * 8); } }
    const float ba = INP(I_LBA)[(l * 2 + dir) * 1024 + cg], bi_ = INP(I_LBI)[(l * 2 + dir) * 1024 + cg], sp = softplusf_(-INP(I_LAM)[(l * 2 + dir) * 1024 + cg]);
    v4u xr[4];
#define LRU_LOADX(it_) do { const int sc_ = (it_) >> 3, b_ = sc_ / NCH, ch_ = sc_ % NCH; const int lo_ = ch_ < 8 ? M_LAT + b_ * NCTX : b_ * SEQ, hi_ = lo_ + (ch_ < 8 ? NCTX : SEQ), r0_ = lo_ + (ch_ < 8 ? ch_ : ch_ - 8) * 32; \
        _Pragma("unroll") for (int j_ = 0; j_ < 4; ++j_) { const int r_ = r0_ + tokc - 2 + j_; xr[j_] = (v4u){0u, 0u, 0u, 0u}; if (r_ >= lo_ && r_ < hi_) xr[j_] = *(const v4u*)(P + (size_t)r_ * DINP + C_LRUX + cgc); } } while (0)
    LRU_LOADX(it);
#pragma unroll 1
    for (;;) {
        const int sc = it >> 3, b = sc / NCH, ch = sc % NCH;
        const int row0 = ch < 8 ? M_LAT + b * NCTX + ch * 32 : b * SEQ + (ch - 8) * 32;
        __syncthreads();
        { float acc[8];
#pragma unroll
          for (int e = 0; e < 8; ++e) acc[e] = cbv[e >> 2][e & 3];
#pragma unroll
          for (int j = 0; j < 4; ++j) {
#pragma unroll
              for (int w = 0; w < 4; ++w) { acc[2 * w] += cwv[j][(2 * w) >> 2][(2 * w) & 3] * bflo(xr[j][w]); acc[2 * w + 1] += cwv[j][(2 * w + 1) >> 2][(2 * w + 1) & 3] * bfhi(xr[j][w]); } }
          *(LAS f32x4*)(U + tokc * 128 + c8) = (f32x4){acc[0], acc[1], acc[2], acc[3]}; *(LAS f32x4*)(U + tokc * 128 + c8 + 4) = (f32x4){acc[4], acc[5], acc[6], acc[7]};
          v4u o; o.x = pk2(acc[0], acc[1]); o.y = pk2(acc[2], acc[3]); o.z = pk2(acc[4], acc[5]); o.w = pk2(acc[6], acc[7]);
          *(LAS v4u*)(UA + tokc * 136 + c8) = o; }
        int itn = it + st; while (itn < i1 && skipctx && ((itn >> 3) % NCH) < 8) itn += st;
        if (itn < i1) LRU_LOADX(itn);
        __syncthreads();
        { f32x16 accr = {}, acci = {};
#pragma unroll
          for (int ks = 0; ks < 8; ++ks) { const bf16x8 a = *(const LAS bf16x8*)(UA + l32 * 136 + ks * 16 + hi * 8);
              accr = __builtin_amdgcn_mfma_f32_32x32x16_bf16(a, wr[ks], accr, 0, 0, 0); acci = __builtin_amdgcn_mfma_f32_32x32x16_bf16(a, wi[ks], acci, 0, 0, 0); }
#pragma unroll
          for (int r = 0; r < 16; ++r) { const int tok = att::crow(r, hi); const float u = U[tok * 128 + chn];
              const float rg = sigmoidf_(accr[r] + ba), ig = sigmoidf_(acci[r] + bi_), la = -8.f * rg * sp, a = __expf(la), x2 = 2.f * la;
              const float em = x2 * (1.f + x2 * (0.5f + x2 * (0.16666667f + x2 * (0.041666668f + x2 * (0.0083333338f + x2 * 0.0013888889f)))));
              const float bc = __builtin_amdgcn_sqrtf(x2 < -0.5f ? 1.f - a * a : -em) * (ig * u);
              AB[(dir * 2 + 0) * 4096 + tok * 128 + chn] = a; AB[(dir * 2 + 1) * 4096 + tok * 128 + chn] = bc; } }
        __syncthreads();
        if (F.tid < 256) { const int dr = F.tid >> 7, cn = F.tid & 127, cgs = nb * 128 + cn; const size_t ci = ((size_t)(dr * 2 + b) * NCH + ch) * 1024 + cgs;
            LAS float* Aa = AB + (dr * 2) * 4096 + cn; LAS float* Bb = AB + (dr * 2 + 1) * 4096 + cn;
            if (!PASS3) { float h = 0.f, ap = 1.f;
#pragma unroll 8
                for (int s = 0; s < 32; ++s) { const int tok = dr ? 31 - s : s; const float a = Aa[tok * 128]; h = a * h + Bb[tok * 128]; ap *= a;
                    if (s == 0 && dr == 1 && ch == 7) ((float*)(F.ws + WS_QUIRK))[b * 1024 + cgs] = h; }
                ((float*)(F.ws + WS_CA))[ci] = ap; ((float*)(F.ws + WS_CB))[ci] = h;
            } else { float h = ((const float*)(F.ws + WS_HIN))[ci];
#pragma unroll 8
                for (int s = 0; s < 32; ++s) { const int tok = dr ? 31 - s : s; h = Aa[tok * 128] * h + Bb[tok * 128]; Bb[tok * 128] = h; } } }
        if (PASS3) { __syncthreads();
            const int cgo = nb * 128 + c8, row = row0 + tokc;
            const v4u y = *(const v4u*)(P + (size_t)row * DINP + C_LRUY + cgo); float o[8];
#pragma unroll
            for (int w = 0; w < 4; ++w) { const float h0 = AB[4096 + tokc * 128 + c8 + 2 * w] + AB[3 * 4096 + tokc * 128 + c8 + 2 * w], h1 = AB[4096 + tokc * 128 + c8 + 2 * w + 1] + AB[3 * 4096 + tokc * 128 + c8 + 2 * w + 1];
                o[2 * w] = h0 * gelu_tanh(bflo(y[w])); o[2 * w + 1] = h1 * gelu_tanh(bfhi(y[w])); }
            v4u ov; ov.x = pk2(o[0], o[1]); ov.y = pk2(o[2], o[3]); ov.z = pk2(o[4], o[5]); ov.w = pk2(o[6], o[7]);
            *(v4u*)((bf16*)(F.ws + WS_MIX) + (size_t)row * DM + 1024 + cgo) = ov; }
        if (itn >= i1) break;
        it = itn;
    }
#undef LRU_LOADX
}
__device__ __forceinline__ void lru_carry(Frame& F, int blk) {
    F.tid = ltid(); F.lane = F.tid & 63;
    const int gid = blk * NTHR + F.tid; if (gid >= 4096) return;
    const int dir = gid >> 11, b = (gid >> 10) & 1, cg = gid & 1023;
    const float* CA = (const float*)(F.ws + WS_CA) + ((size_t)(dir * 2 + b) * NCH) * 1024 + cg; const float* CB = (const float*)(F.ws + WS_CB) + ((size_t)(dir * 2 + b) * NCH) * 1024 + cg;
    float* HIN = (float*)(F.ws + WS_HIN) + ((size_t)(dir * 2 + b) * NCH) * 1024 + cg;
    float h = 0.f;
    if (dir == 0) {
#pragma unroll 8
        for (int c = 0; c < NCH; ++c) { HIN[(size_t)c * 1024] = h; h = CA[(size_t)c * 1024] * h + CB[(size_t)c * 1024]; }
    } else {
        for (int c = 7; c >= 0; --c) { HIN[(size_t)c * 1024] = h; h = CA[(size_t)c * 1024] * h + CB[(size_t)c * 1024]; }
        h = ((const float*)(F.ws + WS_QUIRK))[b * 1024 + cg];
#pragma unroll 8
        for (int c = NCH - 1; c >= 8; --c) { HIN[(size_t)c * 1024] = h; h = CA[(size_t)c * 1024] * h + CB[(size_t)c * 1024]; }
    }
}

__device__ __forceinline__ void rope_table(Frame& F) {
    const int i = F.vcu * NTHR + F.tid; if (i >= 2048) return;
    const int pos = i >> 4, f = i & 15; float s, c; sincosf((float)pos * exp2f(-(float)f * (13.287712379549449f / 16.f)), &s, &c);
    float* t = (float*)(F.ws + WS_ROPE); t[i] = c; t[2048 + i] = s;
}
__device__ __forceinline__ void row_prep(Frame& F, int row) {
    F.tid = ltid(); F.lane = F.tid & 63;
    bf16* pr = (bf16*)(F.ws + WS_P) + (size_t)row * DINP; const int lane = F.lane;
    const bool lat = row < M_LAT; const int t = row & (SEQ - 1); const float prow = (float)(t >> 6), pcol = (float)(t & 63);
    { const v4u a = *(const v4u*)(pr + C_QA + lane * 16), b = *(const v4u*)(pr + C_QA + lane * 16 + 8); float ss = 0.f;
#pragma unroll
      for (int w = 0; w < 4; ++w) { const float x0 = bflo(a[w]), x1 = bfhi(a[w]), x2 = bflo(b[w]), x3 = bfhi(b[w]); ss += x0 * x0 + x1 * x1 + x2 * x2 + x3 * x3; }
      ss = wave_sum(ss); if (lane == 0) ((float*)(F.ws + WS_RSQ))[row] = 1.f / sqrtf(ss * (1.f / 1024.f) + RMS_EPS); }
    { const v4u a = *(const v4u*)(pr + C_KVA + lane * 8); float ss = 0.f;
#pragma unroll
      for (int w = 0; w < 4; ++w) { const float x0 = bflo(a[w]), x1 = bfhi(a[w]); ss += x0 * x0 + x1 * x1; }
      ss = wave_sum(ss); if (lane == 0) ((float*)(F.ws + WS_RSKV))[row] = 1.f / sqrtf(ss * (1.f / 512.f) + RMS_EPS); }
    bf16* kr = (bf16*)(F.ws + WS_KR) + (size_t)row * 64;
    if (lat) {
        { const int part = lane >> 5, sub = lane & 31;
          const float inv = exp2f(-(float)sub * (13.287712379549449f / 32.f)); float sn, cs; sincosf((part ? pcol : prow) * inv, &sn, &cs);
#pragma unroll
          for (int hd = 0; hd < 10; ++hd) { bf16* qb = pr + (hd < 8 ? C_SWAQ + hd * 128 : C_SWAK + (hd - 8) * 128) + part * 64;
              const float x1 = bf2f(qb[sub]), x2 = bf2f(qb[sub + 32]); qb[sub] = (bf16)f2bf(x1 * cs - x2 * sn); qb[sub + 32] = (bf16)f2bf(x2 * cs + x1 * sn); } }
        if (lane < 32) { const int part = lane >> 4, i = lane & 15; const bf16* src = pr + C_KR + part * 32;
          const float inv = exp2f(-(float)i * (13.287712379549449f / 16.f)); float s, c; sincosf((part ? pcol : prow) * inv, &s, &c);
          const float x1 = bf2f(src[i]), x2 = bf2f(src[i + 16]);
          kr[part * 32 + i] = (bf16)f2bf(x1 * c - x2 * s); kr[part * 32 + i + 16] = (bf16)f2bf(x2 * c + x1 * s); }
    } else kr[lane] = pr[C_KR + lane];
}

__device__ __forceinline__ float allred16(float x) { return row_sum16(x); }
__device__ __forceinline__ int scan_row(int s, int dir, int b) {
    if (s < NCTX) return M_LAT + b * NCTX + (dir ? NCTX - 1 - s : s);
    const int t = s - NCTX; return b * SEQ + (dir ? SEQ - 1 - t : t);
}
__device__ __forceinline__ void rwkv_scan(Frame& F, int l, int chain) {
    F.tid = ltid(); F.lane = F.tid & 63;
    const int dir = chain >> 5, b = (chain >> 4) & 1, h = chain & 15;
    constexpr int CT = 24, NCHK = (NCTX + SEQ) / CT, STEPF = 392, BUFF = CT * STEPF;
    LAS float* buf = (LAS float*)F.lds; LAS float* ybuf = (LAS float*)(F.lds + 3 * BUFF * 4);
    gcbf RWF = (gcbf)(F.ws + WS_RWF); const size_t RS = (size_t)M_TOT * 1024;
    gflp YS = (gflp)(F.ws + WS_YS) + (size_t)dir * M_TOT * 1024;
    const bool cmp = F.wave < 4; const int lt = F.tid - 256, lst = lt >> 4, lq = lt & 15, lc = h * 64 + 4 * lq;
    const f32x4 ka4 = *(const GAS f32x4*)((gcfl)INP(I_KA) + l * 1024 + (cmp ? 0 : lc));
    v2u gr[2], gk[2], gv[2], gkk[2], ge[2], ga[2];
#pragma unroll
    for (int u = 0; u < 2; ++u) { gr[u] = (v2u){0u, 0u}; gk[u] = gr[u]; gv[u] = gr[u]; gkk[u] = gr[u]; ge[u] = gr[u]; ga[u] = gr[u]; }
#define RW_LOAD(c) do { if (!cmp) { _Pragma("unroll") for (int u_ = 0; u_ < 2; ++u_) { const int s_ = lst + 16 * u_; if (s_ < CT) { const size_t o_ = (size_t)scan_row((c) * CT + s_, dir, b) * 1024 + lc; \
        gr[u_] = *(const GAS v2u*)(RWF + 0 * RS + o_); gk[u_] = *(const GAS v2u*)(RWF + 1 * RS + o_); gv[u_] = *(const GAS v2u*)(RWF + 2 * RS + o_); \
        gkk[u_] = *(const GAS v2u*)(RWF + 3 * RS + o_); ge[u_] = *(const GAS v2u*)(RWF + (4 + dir) * RS + o_); ga[u_] = *(const GAS v2u*)(RWF + (6 + dir) * RS + o_); } } } } while (0)
#define RW_WRITE(bi) do { if (!cmp) { _Pragma("unroll") for (int u_ = 0; u_ < 2; ++u_) { const int s_ = lst + 16 * u_; if (s_ < CT) { LAS float* d_ = buf + (bi) * BUFF + s_ * STEPF + 4 * lq; \
        const float r_[4] = {bflo(gr[u_].x), bfhi(gr[u_].x), bflo(gr[u_].y), bfhi(gr[u_].y)}, k_[4] = {bflo(gk[u_].x), bfhi(gk[u_].x), bflo(gk[u_].y), bfhi(gk[u_].y)}, v_[4] = {bflo(gv[u_].x), bfhi(gv[u_].x), bflo(gv[u_].y), bfhi(gv[u_].y)}; \
        const float q_[4] = {bflo(gkk[u_].x), bfhi(gkk[u_].x), bflo(gkk[u_].y), bfhi(gkk[u_].y)}, e_[4] = {bflo(ge[u_].x), bfhi(ge[u_].x), bflo(ge[u_].y), bfhi(ge[u_].y)}, a_[4] = {bflo(ga[u_].x), bfhi(ga[u_].x), bflo(ga[u_].y), bfhi(ga[u_].y)}; \
        f32x4 w4, kd4, kk4, b4, wr4, v4; float sbr = 0.f, skr = 0.f; \
        _Pragma("unroll") for (int e = 0; e < 4; ++e) { w4[e] = __expf(-e_[e]); kd4[e] = k_[e] * (1.f + (a_[e] - 1.f) * ka4[e]); kk4[e] = q_[e]; b4[e] = q_[e] * a_[e]; wr4[e] = w4[e] * r_[e]; v4[e] = v_[e]; sbr += b4[e] * r_[e]; skr += kd4[e] * r_[e]; } \
        sbr = row_sum16(sbr); skr = row_sum16(skr); \
        *(LAS f32x4*)(d_) = w4; *(LAS f32x4*)(d_ + 64) = kd4; *(LAS f32x4*)(d_ + 128) = kk4; *(LAS f32x4*)(d_ + 192) = b4; *(LAS f32x4*)(d_ + 256) = wr4; *(LAS f32x4*)(d_ + 320) = v4; \
        if (lq == 0) *(LAS f32x2*)(buf + (bi) * BUFF + s_ * STEPF + 384) = (f32x2){sbr, skr}; } } } } while (0)
#define RW_FLUSH(c) do { if (!cmp) { _Pragma("unroll") for (int u_ = 0; u_ < 2; ++u_) { const int s_ = lst + 16 * u_; if (s_ < CT) { const f32x4 y_ = *(const LAS f32x4*)(ybuf + ((c) & 1) * (CT * 64) + s_ * 64 + 4 * lq); \
        *(GAS f32x4*)(YS + (size_t)scan_row((c) * CT + s_, dir, b) * 1024 + lc) = y_; } } } } while (0)
    __syncthreads();
    RW_LOAD(0); RW_WRITE(0); RW_LOAD(1); RW_WRITE(1); RW_LOAD(2);
    __syncthreads();
    const int kg = F.lane & 7, rg = F.lane >> 3, r0 = 16 * (F.wave & 3) + 2 * rg;
    f32x2 St[8];
#pragma unroll
    for (int i = 0; i < 8; ++i) St[i] = (f32x2){0.f, 0.f};
    int bc = 0, bw = 2;
#pragma unroll 1
    for (int c = 0; c < NCHK; ++c) {
        if (c + 2 < NCHK) { RW_WRITE(bw); if (c + 3 < NCHK) RW_LOAD(c + 3); }
        if (c > 0) RW_FLUSH(c - 1);
        if (cmp) {
        const LAS float* bb = buf + bc * BUFF + 8 * kg; const LAS float* vb = buf + bc * BUFF + 320 + r0; const LAS float* sb = buf + bc * BUFF + 384;
        LAS float* yb = ybuf + (c & 1) * (CT * 64) + r0;
        f32x4 w4[2], kd4[2], kk4[2], b4[2], wr4[2];
#pragma unroll
        for (int q = 0; q < 2; ++q) { w4[q] = *(const LAS f32x4*)(bb + 4 * q); kd4[q] = *(const LAS f32x4*)(bb + 64 + 4 * q); kk4[q] = *(const LAS f32x4*)(bb + 128 + 4 * q); b4[q] = *(const LAS f32x4*)(bb + 192 + 4 * q); wr4[q] = *(const LAS f32x4*)(bb + 256 + 4 * q); }
        f32x2 v2 = *(const LAS f32x2*)(vb), s2 = *(const LAS f32x2*)(sb);
#pragma unroll
        for (int st = 0; st < CT; ++st) {
            const int sn = (st + 1 < CT ? st + 1 : st) * STEPF;
            f32x4 nw4[2], nkd4[2], nkk4[2], nb4[2], nwr4[2];
#pragma unroll
            for (int q = 0; q < 2; ++q) { nw4[q] = *(const LAS f32x4*)(bb + sn + 4 * q); nkd4[q] = *(const LAS f32x4*)(bb + sn + 64 + 4 * q); nkk4[q] = *(const LAS f32x4*)(bb + sn + 128 + 4 * q); nb4[q] = *(const LAS f32x4*)(bb + sn + 192 + 4 * q); nwr4[q] = *(const LAS f32x4*)(bb + sn + 256 + 4 * q); }
            const f32x2 nv2 = *(const LAS f32x2*)(vb + sn), ns2 = *(const LAS f32x2*)(sb + sn);
#define PR(x, e) ((((e) >> 1) & 1) ? (f32x2){(x)[(e) >> 2][2], (x)[(e) >> 2][3]} : (f32x2){(x)[(e) >> 2][0], (x)[(e) >> 2][1]})
            f32x2 p, z, tpb, tzb;
            asm("v_pk_mul_f32 %0, %4, %12 op_sel:[0,0] op_sel_hi:[1,0]\n\tv_pk_mul_f32 %1, %4, %16 op_sel:[0,0] op_sel_hi:[1,0]\n\tv_pk_mul_f32 %2, %8, %14 op_sel:[0,0] op_sel_hi:[1,0]\n\tv_pk_mul_f32 %3, %8, %18 op_sel:[0,0] op_sel_hi:[1,0]\n\tv_pk_fma_f32 %0, %5, %12, %0 op_sel:[0,1,0] op_sel_hi:[1,1,1]\n\tv_pk_fma_f32 %1, %5, %16, %1 op_sel:[0,1,0] op_sel_hi:[1,1,1]\n\tv_pk_fma_f32 %2, %9, %14, %2 op_sel:[0,1,0] op_sel_hi:[1,1,1]\n\tv_pk_fma_f32 %3, %9, %18, %3 op_sel:[0,1,0] op_sel_hi:[1,1,1]\n\tv_pk_fma_f32 %0, %6, %13, %0 op_sel:[0,0,0] op_sel_hi:[1,0,1]\n\tv_pk_fma_f32 %1, %6, %17, %1 op_sel:[0,0,0] op_sel_hi:[1,0,1]\n\tv_pk_fma_f32 %2, %10, %15, %2 op_sel:[0,0,0] op_sel_hi:[1,0,1]\n\tv_pk_fma_f32 %3, %10, %19, %3 op_sel:[0,0,0] op_sel_hi:[1,0,1]\n\tv_pk_fma_f32 %0, %7, %13, %0 op_sel:[0,1,0] op_sel_hi:[1,1,1]\n\tv_pk_fma_f32 %1, %7, %17, %1 op_sel:[0,1,0] op_sel_hi:[1,1,1]\n\tv_pk_fma_f32 %2, %11, %15, %2 op_sel:[0,1,0] op_sel_hi:[1,1,1]\n\tv_pk_fma_f32 %3, %11, %19, %3 op_sel:[0,1,0] op_sel_hi:[1,1,1]\n\tv_pk_add_f32 %0, %0, %2\n\tv_pk_add_f32 %1, %1, %3\n\tv_pk_mul_f32 %4, %4, %20 op_sel:[0,0] op_sel_hi:[1,0]\n\tv_pk_mul_f32 %5, %5, %20 op_sel:[0,1] op_sel_hi:[1,1]\n\tv_pk_mul_f32 %6, %6, %21 op_sel:[0,0] op_sel_hi:[1,0]\n\tv_pk_mul_f32 %7, %7, %21 op_sel:[0,1] op_sel_hi:[1,1]\n\tv_pk_mul_f32 %8, %8, %22 op_sel:[0,0] op_sel_hi:[1,0]\n\tv_pk_mul_f32 %9, %9, %22 op_sel:[0,1] op_sel_hi:[1,1]\n\tv_pk_mul_f32 %10, %10, %23 op_sel:[0,0] op_sel_hi:[1,0]\n\tv_pk_mul_f32 %11, %11, %23 op_sel:[0,1] op_sel_hi:[1,1]\n\tv_pk_fma_f32 %4, %28, %24, %4 op_sel:[0,0,0] op_sel_hi:[1,0,1]\n\tv_pk_fma_f32 %5, %28, %24, %5 op_sel:[0,1,0] op_sel_hi:[1,1,1]\n\tv_pk_fma_f32 %6, %28, %25, %6 op_sel:[0,0,0] op_sel_hi:[1,0,1]\n\tv_pk_fma_f32 %7, %28, %25, %7 op_sel:[0,1,0] op_sel_hi:[1,1,1]\n\tv_pk_fma_f32 %8, %28, %26, %8 op_sel:[0,0,0] op_sel_hi:[1,0,1]\n\tv_pk_fma_f32 %9, %28, %26, %9 op_sel:[0,1,0] op_sel_hi:[1,1,1]\n\tv_pk_fma_f32 %10, %28, %27, %10 op_sel:[0,0,0] op_sel_hi:[1,0,1]\n\tv_pk_fma_f32 %11, %28, %27, %11 op_sel:[0,1,0] op_sel_hi:[1,1,1]"
                : "=&v"(p), "=&v"(z), "=&v"(tpb), "=&v"(tzb), "+v"(St[0]), "+v"(St[1]), "+v"(St[2]), "+v"(St[3]), "+v"(St[4]), "+v"(St[5]), "+v"(St[6]), "+v"(St[7])
                : "v"(PR(kk4, 0)), "v"(PR(kk4, 2)), "v"(PR(kk4, 4)), "v"(PR(kk4, 6)), "v"(PR(wr4, 0)), "v"(PR(wr4, 2)), "v"(PR(wr4, 4)), "v"(PR(wr4, 6)),
                  "v"(PR(w4, 0)), "v"(PR(w4, 2)), "v"(PR(w4, 4)), "v"(PR(w4, 6)), "v"(PR(kd4, 0)), "v"(PR(kd4, 2)), "v"(PR(kd4, 4)), "v"(PR(kd4, 6)), "v"(v2));
            float p0 = p.x, p1 = p.y, z0 = z.x, z1 = z.y;
#define D4(ctl) "v_add_f32_dpp %0, %0, %0 " ctl " row_mask:0xf bank_mask:0xf\n\tv_add_f32_dpp %1, %1, %1 " ctl " row_mask:0xf bank_mask:0xf\n\tv_add_f32_dpp %2, %2, %2 " ctl " row_mask:0xf bank_mask:0xf\n\tv_add_f32_dpp %3, %3, %3 " ctl " row_mask:0xf bank_mask:0xf\n\t"
            asm volatile("s_nop 1\n\t" D4("quad_perm:[1,0,3,2]") D4("quad_perm:[2,3,0,1]") D4("row_half_mirror") "s_nop 0"
                : "+v"(p0), "+v"(p1), "+v"(z0), "+v"(z1));
#undef D4
            const f32x2 pp = {p0, p1}, zz = {z0, z1};
            { f32x2 y;
              asm("v_pk_fma_f32 %0, %9, %11, %10 op_sel:[0,0,0] op_sel_hi:[1,0,1] neg_lo:[1,0,0] neg_hi:[1,0,0]\n\tv_pk_fma_f32 %0, %12, %11, %0 op_sel:[0,1,0] op_sel_hi:[1,1,1]\n\tv_pk_fma_f32 %1, %9, %13, %1 op_sel:[0,0,0] op_sel_hi:[1,0,1] neg_lo:[1,0,0] neg_hi:[1,0,0]\n\tv_pk_fma_f32 %2, %9, %13, %2 op_sel:[0,1,0] op_sel_hi:[1,1,1] neg_lo:[1,0,0] neg_hi:[1,0,0]\n\tv_pk_fma_f32 %3, %9, %14, %3 op_sel:[0,0,0] op_sel_hi:[1,0,1] neg_lo:[1,0,0] neg_hi:[1,0,0]\n\tv_pk_fma_f32 %4, %9, %14, %4 op_sel:[0,1,0] op_sel_hi:[1,1,1] neg_lo:[1,0,0] neg_hi:[1,0,0]\n\tv_pk_fma_f32 %5, %9, %15, %5 op_sel:[0,0,0] op_sel_hi:[1,0,1] neg_lo:[1,0,0] neg_hi:[1,0,0]\n\tv_pk_fma_f32 %6, %9, %15, %6 op_sel:[0,1,0] op_sel_hi:[1,1,1] neg_lo:[1,0,0] neg_hi:[1,0,0]\n\tv_pk_fma_f32 %7, %9, %16, %7 op_sel:[0,0,0] op_sel_hi:[1,0,1] neg_lo:[1,0,0] neg_hi:[1,0,0]\n\tv_pk_fma_f32 %8, %9, %16, %8 op_sel:[0,1,0] op_sel_hi:[1,1,1] neg_lo:[1,0,0] neg_hi:[1,0,0]"
                : "=&v"(y), "+v"(St[0]), "+v"(St[1]), "+v"(St[2]), "+v"(St[3]), "+v"(St[4]), "+v"(St[5]), "+v"(St[6]), "+v"(St[7])
                : "v"(pp), "v"(zz), "v"(s2), "v"(v2), "v"(PR(b4, 0)), "v"(PR(b4, 2)), "v"(PR(b4, 4)), "v"(PR(b4, 6)));
              *(LAS f32x2*)(yb + st * 64) = y; }
#undef PR
#pragma unroll
            for (int q = 0; q < 2; ++q) { w4[q] = nw4[q]; kd4[q] = nkd4[q]; kk4[q] = nkk4[q]; b4[q] = nb4[q]; wr4[q] = nwr4[q]; }
            v2 = nv2; s2 = ns2;
        }
        }
        __syncthreads();
        bc = bc == 2 ? 0 : bc + 1; bw = bw == 2 ? 0 : bw + 1;
    }
    RW_FLUSH(NCHK - 1);
#undef RW_LOAD
#undef RW_WRITE
#undef RW_FLUSH
}
__device__ __forceinline__ void rwkv_out_row(Frame& F, int l, int row) {
    F.tid = ltid(); F.lane = F.tid & 63;
    const int c0 = F.lane * 16; const float* yf = (const float*)(F.ws + WS_YS) + (size_t)row * 1024 + c0; const float* yb = yf + (size_t)M_TOT * 1024;
    float y[16]; float s = 0.f;
#pragma unroll
    for (int j = 0; j < 4; ++j) { const f32x4 a = __builtin_nontemporal_load((const f32x4*)(yf + 4 * j)), b = __builtin_nontemporal_load((const f32x4*)(yb + 4 * j));
#pragma unroll
        for (int e = 0; e < 4; ++e) { y[4 * j + e] = a[e] + b[e]; s += y[4 * j + e]; } }
    s = quad_sum(s); const float mu = s * (1.f / 64.f); float q = 0.f;
#pragma unroll
    for (int e = 0; e < 16; ++e) { y[e] -= mu; q += y[e] * y[e]; }
    q = quad_sum(q); const float rstd = 1.f / sqrtf(q * (1.f / 64.f) + GN_EPS);
    const bf16* RWF = (const bf16*)(F.ws + WS_RWF); const size_t RS = (size_t)M_TOT * 1024, o = (size_t)row * 1024 + c0;
    const float sbv = ((const float*)(F.ws + WS_SB))[(size_t)row * 16 + (F.lane >> 2)];
    const float* lg = INP(I_LNG) + l * 1024 + c0; const float* lb = INP(I_LNB) + l * 1024 + c0;
    bf16* dst = (bf16*)(F.ws + WS_MIX) + (size_t)row * DM + 3072 + c0;
#pragma unroll
    for (int hf = 0; hf < 2; ++hf) { const v4u vv = *(const v4u*)(RWF + 2 * RS + o + 8 * hf), gg = *(const v4u*)(RWF + 8 * RS + o + 8 * hf); float r[8];
#pragma unroll
        for (int w = 0; w < 4; ++w) { const int e = 8 * hf + 2 * w;
            r[2 * w] = (y[e] * rstd * lg[e] + lb[e] + sbv * bflo(vv[w])) * bflo(gg[w]); r[2 * w + 1] = (y[e + 1] * rstd * lg[e + 1] + lb[e + 1] + sbv * bfhi(vv[w])) * bfhi(gg[w]); }
        v4u ov; ov.x = pk2(r[0], r[1]); ov.y = pk2(r[2], r[3]); ov.z = pk2(r[4], r[5]); ov.w = pk2(r[6], r[7]); *(v4u*)(dst + 8 * hf) = ov; }
}

#ifndef W_OUT_K0
#define W_OUT_K0 0
#endif
#ifndef W_OUT_K1
#define W_OUT_K1 3072
#endif
struct MlaTiles { gcbf KV; gcbf KR; int ctx_row0, lat_row0, h;
    __device__ __forceinline__ att::Tile operator()(int j) const { const int row = j < 4 ? ctx_row0 + 64 * j : lat_row0 + 64 * (j - 4);
        att::Tile t; t.kn = KV + (size_t)row * 2048 + h * 256; t.v = t.kn + 128; t.kr = KR + (size_t)row * 64; t.mtype = 0; t.krel0 = 0; return t; } };
struct SwaTiles { gcbf P; int blk_row0, ctx_row0, kvh, nwin, has_prev, has_next;
    __device__ __forceinline__ att::Tile operator()(int j) const { att::Tile t; int row; t.mtype = 0; t.krel0 = 0;
        if (j >= nwin) row = ctx_row0 + 64 * (j - nwin);
        else if (j < 2) row = blk_row0 + 64 * j;
        else if (has_prev && j < 4) { row = blk_row0 - 128 + 64 * (j - 2); t.mtype = 1; t.krel0 = -128 + 64 * (j - 2); }
        else { const int sub = j - 2 - 2 * has_prev; row = blk_row0 + 128 + 64 * sub; t.mtype = 2; t.krel0 = 128 + 64 * sub; }
        t.kn = P + (size_t)row * DINP + C_SWAK + kvh * 128; t.v = P + (size_t)row * DINP + C_SWAV + kvh * 128; t.kr = nullptr; return t; } };

#ifndef MLA_SDEPTH
#define MLA_SDEPTH 1
#endif
__device__ __forceinline__ void mla_item(Frame& F, int b, int h, int qb, bool ctxq) {
    F.tid = ltid(); F.lane = F.tid & 63;
    const int r32 = F.lane & 31; const int t = qb * 256 + F.wave * 32 + r32;
    const int roww0 = ctxq ? M_LAT + b * NCTX + F.wave * 32 : b * SEQ + qb * 256 + F.wave * 32;
    gcbf Qw = (gcbf)(F.ws + WS_Q) + (size_t)(roww0 + r32) * 1536 + h * 192;
    MlaTiles ts{(gcbf)(F.ws + WS_KV), (gcbf)(F.ws + WS_KR), M_LAT + b * NCTX, b * SEQ, h};
    gbfp Ow = (gbfp)(F.ws + WS_MIX) + (size_t)roww0 * DM + 2048 + h * 128;
    att::attn_body<192, 2048, 2048, false, false, MLA_SDEPTH>(Qw, ctxq ? 0 : 1, t >> 6, t & 63, (gcfl)(F.ws + WS_ROPE), 0, 0.f, ts, ctxq ? 4 : 132, Ow, (LAS char*)F.lds);
}
__device__ __forceinline__ void swa_item(Frame& F, int l, int b, int n, int kvh, int half, bool ctxq, int hq_ctx) {
    F.tid = ltid(); F.lane = F.tid & 63;
    const int r32 = F.lane & 31; gcbf P = (gcbf)(F.ws + WS_P);
    int hq, qi, roww0, t;
    if (ctxq) { hq = hq_ctx; kvh = hq >> 2; qi = 0; roww0 = M_LAT + b * NCTX + F.wave * 32; t = 0; }
    else { hq = kvh * 4 + 2 * half + (F.wave >> 2); qi = (F.wave & 3) * 32 + r32; roww0 = b * SEQ + n * 128 + (F.wave & 3) * 32; t = n * 128 + qi; }
    gcbf Qw = P + (size_t)(roww0 + r32) * DINP + C_SWAQ + hq * 128;
    SwaTiles ts; ts.P = P; ts.blk_row0 = b * SEQ + n * 128; ts.ctx_row0 = M_LAT + b * NCTX; ts.kvh = kvh;
    ts.has_prev = (!ctxq && n > 0) ? 1 : 0; ts.has_next = (!ctxq && n < SEQ / 128 - 1) ? 1 : 0; ts.nwin = ctxq ? 0 : 2 + 2 * ts.has_prev + 2 * ts.has_next;
    gbfp Ow = (gbfp)(F.ws + WS_MIX) + (size_t)roww0 * DM + hq * 128;
    const float sink_l2 = INP(I_SINK)[l * 8 + hq] * 1.4426950408889634f;
    att::attn_body<128, DINP, DINP, true, true, 2>(Qw, 0, 0, 0, (gcfl)nullptr, qi, sink_l2, ts, ts.nwin + 4, Ow, (LAS char*)F.lds);
}

#ifndef DBG_PHASES
#define DBG_PHASES 0xfffff
#endif
#define PH(n) ((DBG_PHASES >> (n)) & 1)
#ifndef DUP_PHASES
#define DUP_PHASES 0
#endif
#define REP(n) _Pragma("unroll") for (int rep_ = 0; rep_ < (((DUP_PHASES >> (n)) & 1) ? 2 : 1); ++rep_)
__global__ void __launch_bounds__(NTHR, 2) mk_fwd(Args args) {
    extern __shared__ __attribute__((aligned(16))) unsigned char lds[];
    Frame F;
    F.lds = (LAS unsigned char*)lds;
    F.tid = threadIdx.x; F.lane = F.tid & 63; F.wave = __builtin_amdgcn_readfirstlane(F.tid >> 6);
    F.G = gridDim.x; { const int bx = blockIdx.x; F.vcu = (F.G % 8 == 0) ? (bx % 8) * (F.G / 8) + bx / 8 : bx; }
    F.gw = F.vcu * NWAVES + F.wave; F.NGW = F.G * NWAVES;
    F.ws = args.ws; F.out = args.out; F.ctl = (gu32*)(args.ws + WS_CTL);
    F.A = (const __attribute__((address_space(4))) Args*)__builtin_amdgcn_kernarg_segment_ptr();
    for (int u = F.tid; u < (LDS_BYTES - LDSCTL_OFF) / 4; u += NTHR) ((LAS unsigned*)(F.lds + LDSCTL_OFF))[u] = 0u;
    __syncthreads();
    XcdBarrier bar = xcd_barrier_post((unsigned*)(args.ws + WS_CTL) + 4096, (volatile LAS unsigned*)(F.lds + MISC_OFF) + 8);
    const bool rwkv_blk = (blockIdx.x & 3) == 0;
    XcdBarrier bar2; bar2.bar = (unsigned*)(args.ws + WS_CTL) + 8192; bar2.x = 0; bar2.st = (volatile LAS unsigned*)(F.lds + MISC_OFF) + 12; bar2.nparts = gridDim.x - ((gridDim.x + 3) >> 2);
    if (!rwkv_blk) { const unsigned np_ = bar2.nparts; bar2 = xcd_barrier_post((unsigned*)(args.ws + WS_CTL) + 8192, (volatile LAS unsigned*)(F.lds + MISC_OFF) + 12); bar2.nparts = np_; }
#define SUB_BAR() do { bar2.bar = launder(bar2.bar); bar2.x = launder(bar2.x); xcd_barrier(bar2); F.ws = launder_g(F.ws); F.wsw = F.ws + (size_t)lcur * WSET_STRIDE; F.A = launder(F.A); F.tid = ltid(); F.lane = F.tid & 63; } while (0)
#define GRID_BAR() do { bar.bar = launder(bar.bar); bar.x = launder(bar.x); xcd_barrier(bar); F.ws = launder_g(F.ws); F.wsw = F.ws + (size_t)lcur * WSET_STRIDE; F.A = launder(F.A); F.tid = ltid(); F.lane = F.tid & 63; } while (0)
    const int bx = blockIdx.x; int lcur = 0; F.wsw = F.ws;
    bf16* H = (bf16*)(F.ws + WS_H); xres_t* X = (xres_t*)(F.ws + WS_X);

    REP(0) if (PH(0)) { mod_partials(F);
    convert_weights(F, 0, F.gw, F.NGW); }
    GRID_BAR();
    if (PH(1)) { mod_reduce(F); rope_table(F); }
    GRID_BAR();

#pragma unroll 1
    for (int l = 0; l < 2; ++l) {
        lcur = l; F.wsw = F.ws + (size_t)l * WSET_STRIDE;
        const bool wctx = (l == 0);
        const int MO = wctx ? M_TOT : M_LAT;
        if (PH(2) && l == 0) {
            int cs = -1;
            for (int row = F.gw; row < M_TOT; row += F.NGW) { const int s = row_s(row);
                if (s != cs) { __syncthreads(); ln_stage(F, LNV_SC, mod_ptr(F, 0, s, 1)); ln_stage(F, LNV_SH, mod_ptr(F, 0, s, 0)); __syncthreads(); cs = s; }
                const float* xs = row < M_LAT ? INP(I_X) + (size_t)row * DM : INP(I_CTX) + (size_t)(row - M_LAT) * DM;
                ln_row<0>(F, xs, nullptr, nullptr, true, H + (size_t)row * DM); }
            __syncthreads();
        }
        GRID_BAR();
        REP(3) if (PH(3)) { pg8::Gemm g{H, (const bf16*)(F.wsw + WS_WIN), M_TOT, DINP, DM, DM, DM}; pg8::StaticOrder S; S.init(M_TOT, DINP, F.G, bx);
          pg8::EpiBf16<0> E{(bf16*)(F.ws + WS_P), DINP, nullptr};
          pg8::gemm_phase<pg8::EpiBf16<0>, pg8::StaticOrder, true, true>(F.lds, g, S, E); }
        GRID_BAR();
        REP(4) if (PH(4)) for (int it = F.vcu; it < 528; it += F.G) rwkv_feat_item(F, l, it);
        REP(5) if (PH(5)) { if (F.G == 256) { if (F.vcu < 16) lru_items<false>(F, l, F.vcu, 64, 16, false);
                                              else lru_items<false>(F, l, 64 + F.vcu - 16, 2 * NCH * 8, 240, false); }
                            else for (int it = F.vcu; it < 2 * NCH * 8; it += F.G) lru_item<false>(F, l, it); }
        __syncthreads();
        if (PH(6)) for (int row = F.gw; row < M_TOT; row += F.NGW) row_prep(F, row);
        GRID_BAR();
        REP(8) if (rwkv_blk) { const int nrw = (F.G + 3) >> 2; REP(18) if (PH(8)) for (int chain = bx >> 2; chain < 64; chain += nrw) rwkv_scan(F, l, chain); }
        else REP(19) { const int x8 = bx & 7, naw = F.G - ((F.G + 3) >> 2);
            const int aw = (F.G == 256) ? ((x8 < 4 ? x8 - 1 : x8 - 2) * 32 + (bx >> 3)) : ((bx >> 2) * 3 + (bx & 3) - 1);
            if (PH(7) && aw < 8) lru_carry(F, aw);
            if (PH(7)) { pg8::Gemm g{(const bf16*)(F.ws + WS_P) + C_QA, (const bf16*)(F.wsw + WS_WQB), M_TOT, 1536, 1024, DINP, 1024}; pg8::StaticOrder S; S.init(M_TOT, 1536, naw, aw);
              pg8::EpiBf16<2> E{(bf16*)(F.ws + WS_Q), 1536, (const float*)(F.ws + WS_RSQ)};
              pg8::gemm_phase<pg8::EpiBf16<2>, pg8::StaticOrder, true, true>(F.lds, g, S, E); }
            if (PH(7)) { pg8::Gemm g{(const bf16*)(F.ws + WS_P) + C_KVA, (const bf16*)(F.wsw + WS_WKVB), M_TOT, 2048, 512, DINP, 512}; pg8::StaticOrder S; S.init(M_TOT, 2048, naw, aw);
              pg8::EpiBf16<2> E{(bf16*)(F.ws + WS_KV), 2048, (const float*)(F.ws + WS_RSKV)};
              pg8::gemm_phase<pg8::EpiBf16<2>, pg8::StaticOrder, true, true>(F.lds, g, S, E); }
            SUB_BAR();
            if (PH(9)) for (int it = aw; it < 512; it += naw) mla_item(F, it >> 8, (it >> 5) & 7, it & 31, false);
            if (PH(9) && wctx) for (int it = aw; it < 16; it += naw) mla_item(F, it >> 3, it & 7, 0, true);
            if (PH(10)) for (int it = aw; it < 512; it += naw) swa_item(F, l, it >> 8, (it >> 2) & 63, (it >> 1) & 1, it & 1, false, 0);
            if (PH(10) && wctx) for (int it = aw; it < 16; it += naw) swa_item(F, l, it >> 3, 0, 0, 0, true, it & 7);
            if (PH(11)) { if (naw == 192) { const int i0 = aw < 128 ? aw : 1280 + aw - 128, st_ = aw < 128 ? 128 : 64, i1 = aw < 128 ? 1280 : 2 * NCH * 8;
                                            lru_items<true>(F, l, i0, i1, st_, !wctx); }
                          else for (int it = aw; it < 2 * NCH * 8; it += naw) { if (!wctx && ((it >> 3) % NCH) < 8) continue; lru_item<true>(F, l, it); } }
            if (l == 0) { __syncthreads(); convert_weights(F, 1, aw * NWAVES + F.wave, naw * NWAVES); }
            const int k1 = l ? W_OUT_K1 : W_OUT_K0;
            if (k1 > 0) { SUB_BAR();
                pg8::Gemm g{(const bf16*)(F.ws + WS_MIX), (const bf16*)(F.wsw + WS_WOUT), M_LAT, DM, k1, DM, DM}; pg8::StaticOrder S; S.init(M_LAT, DM, naw, aw);
                pg8::EpiBf16<0> E{(bf16*)(F.ws + WS_Y1), DM, nullptr};
                pg8::gemm_phase<pg8::EpiBf16<0>, pg8::StaticOrder, true, true>(F.lds, g, S, E); }
        }
        GRID_BAR();
        REP(12) if (PH(12)) for (int row = F.gw; row < MO; row += F.NGW) rwkv_out_row(F, l, row);
        GRID_BAR();
        REP(13) if (PH(13)) {
          const int k1 = l ? W_OUT_K1 : W_OUT_K0;
          if (k1 == 0) { pg8::Gemm g{(const bf16*)(F.ws + WS_MIX), (const bf16*)(F.wsw + WS_WOUT), M_LAT, DM, DM, DM, DM}; pg8::StaticOrder S; S.init(M_LAT, DM, F.G, bx);
            pg8::EpiBf16<0> E{(bf16*)(F.ws + WS_Y1), DM, nullptr};
            pg8::gemm_phase<pg8::EpiBf16<0>, pg8::StaticOrder, true, true>(F.lds, g, S, E); }
          else { pg8::Gemm g{(const bf16*)(F.ws + WS_MIX) + k1, (const bf16*)(F.wsw + WS_WOUT) + k1, M_LAT, DM, DM - k1, DM, DM}; pg8::StaticOrder S; S.init(M_LAT, DM, F.G, bx);
            pg8::EpiBf16<3> E{(bf16*)(F.ws + WS_Y1), DM, nullptr};
            pg8::gemm_phase<pg8::EpiBf16<3>, pg8::StaticOrder, true, true>(F.lds, g, S, E); }
          if (wctx) {
              pg8::Gemm g2{(const bf16*)(F.ws + WS_MIX) + (size_t)M_LAT * DM, (const bf16*)(F.wsw + WS_WOUT), M_CTX, DM, DM / 8, DM, DM}; pg8::SplitOrder S2; S2.init(M_CTX, DM, DM / 8, bx);
              pg8::EpiF32 E2{(float*)(F.ws + WS_YP), DM, (size_t)M_CTX * DM};
              pg8::gemm_phase<pg8::EpiF32, pg8::SplitOrder, true, true>(F.lds, g2, S2, E2); } }
        GRID_BAR();
        if (PH(14)) { int cs = -1;
          for (int row = F.gw; row < MO; row += F.NGW) { const int s = row_s(row);
            if (s != cs) { __syncthreads(); if (cs < 0) { ln_stage(F, LNV_G, INP(I_LN1G) + l * DM); ln_stage(F, LNV_B, INP(I_LN1B) + l * DM); }
                ln_stage(F, LNV_GA, mod_ptr(F, l, s, 2)); ln_stage(F, LNV_SC, mod_ptr(F, l, s, 4)); ln_stage(F, LNV_SH, mod_ptr(F, l, s, 3)); __syncthreads(); cs = s; }
            bf16* yrow = (bf16*)(F.ws + WS_Y1) + (size_t)row * DM;
            if (row >= M_LAT) sum_partials_row(F, (const float*)(F.ws + WS_YP) + (size_t)(row - M_LAT) * DM, (size_t)M_CTX * DM, yrow);
            if (l == 0) { const float* xs = row < M_LAT ? INP(I_X) + (size_t)row * DM : INP(I_CTX) + (size_t)(row - M_LAT) * DM;
                ln_row<1, false, XH16>(F, xs, yrow, X + (size_t)row * DM, true, H + (size_t)row * DM); }
            else ln_row<1, XH16, XH16>(F, X + (size_t)row * DM, yrow, X + (size_t)row * DM, true, H + (size_t)row * DM); }
          __syncthreads(); }
        GRID_BAR();
        REP(15) if (PH(15)) { pg8::Gemm g{H, (const bf16*)(F.wsw + WS_WFF1), MO, DFF, DM, DM, DM}; pg8::StaticOrder S; S.init(MO, DFF, F.G, bx);
          pg8::EpiBf16<1> E{(bf16*)(F.ws + WS_HID), DFF, nullptr};
          pg8::gemm_phase<pg8::EpiBf16<1>, pg8::StaticOrder, true, true>(F.lds, g, S, E); }
        GRID_BAR();
        REP(16) if (PH(16)) { pg8::Gemm g{(const bf16*)(F.ws + WS_HID), (const bf16*)(F.wsw + WS_WFF2), M_LAT, DM, DFF, DFF, DFF}; pg8::StaticOrder S; S.init(M_LAT, DM, F.G, bx);
          pg8::EpiBf16<0> E{(bf16*)(F.ws + WS_Y2), DM, nullptr};
          pg8::gemm_phase<pg8::EpiBf16<0>, pg8::StaticOrder, true, true>(F.lds, g, S, E);
          if (wctx) {
              pg8::Gemm g2{(const bf16*)(F.ws + WS_HID) + (size_t)M_LAT * DFF, (const bf16*)(F.wsw + WS_WFF2), M_CTX, DM, DFF / 8, DFF, DFF}; pg8::SplitOrder S2; S2.init(M_CTX, DM, DFF / 8, bx);
              pg8::EpiF32 E2{(float*)(F.ws + WS_YP), DM, (size_t)M_CTX * DM};
              pg8::gemm_phase<pg8::EpiF32, pg8::SplitOrder, true, true>(F.lds, g2, S2, E2); } }
        GRID_BAR();
        if (!PH(17)) {} else if (l == 0) { int cs = -1;
            for (int row = F.gw; row < M_TOT; row += F.NGW) { const int s = row_s(row);
                if (s != cs) { __syncthreads(); if (cs < 0) { ln_stage(F, LNV_G, INP(I_LN2G)); ln_stage(F, LNV_B, INP(I_LN2B)); }
                    ln_stage(F, LNV_GA, mod_ptr(F, 0, s, 5)); ln_stage(F, LNV_SC, mod_ptr(F, 1, s, 1)); ln_stage(F, LNV_SH, mod_ptr(F, 1, s, 0)); __syncthreads(); cs = s; }
                bf16* yrow = (bf16*)(F.ws + WS_Y2) + (size_t)row * DM;
                if (row >= M_LAT) sum_partials_row(F, (const float*)(F.ws + WS_YP) + (size_t)(row - M_LAT) * DM, (size_t)M_CTX * DM, yrow);
                ln_row<1, XH16, XH16>(F, X + (size_t)row * DM, yrow, X + (size_t)row * DM, true, H + (size_t)row * DM); }
            __syncthreads();
        } else { int cs = -1;
            for (int row = F.gw; row < M_LAT; row += F.NGW) { const int s = row_s(row);
                if (s != cs) { __syncthreads(); if (cs < 0) { ln_stage(F, LNV_G, INP(I_LN2G) + DM); ln_stage(F, LNV_B, INP(I_LN2B) + DM); }
                    ln_stage(F, LNV_GA, mod_ptr(F, 1, s, 5)); __syncthreads(); cs = s; }
                ln_row<1, XH16, false>(F, X + (size_t)row * DM, (const bf16*)(F.ws + WS_Y2) + (size_t)row * DM, F.out + (size_t)row * DM, false, nullptr); }
        }
    }
}

extern "C" void kernel_launch(void* const* d_in, const int* in_sizes, int n_in, void* d_out, int out_size, void* d_ws, size_t ws_size, hipStream_t stream) {
    static int grid = 0;
    if (grid == 0) {
        if (n_in != 38 || out_size != M_LAT * DM || ws_size < WS_END) { fprintf(stderr, "kernel_launch: unexpected shapes: n_in %d out %d ws %zu (need %zu)\n", n_in, out_size, ws_size, (size_t)WS_END); grid = -1; return; }
        int dev = 0, cus = 0, per_cu = 0;
        if (hipGetDevice(&dev) != hipSuccess || hipDeviceGetAttribute(&cus, hipDeviceAttributeMultiprocessorCount, dev) != hipSuccess) { grid = -1; return; }
        if (hipFuncSetAttribute((const void*)mk_fwd, hipFuncAttributeMaxDynamicSharedMemorySize, LDS_BYTES) != hipSuccess) { fprintf(stderr, "kernel_launch: hipFuncSetAttribute failed\n"); grid = -1; return; }
        if (hipOccupancyMaxActiveBlocksPerMultiprocessor(&per_cu, (const void*)mk_fwd, NTHR, LDS_BYTES) != hipSuccess || per_cu < 1) fprintf(stderr, "kernel_launch: occupancy query says %d\n", per_cu);
        (void)hipGetLastError();
        grid = cus;
    }
    if (grid < 0) return;
    if (hipMemsetAsync((char*)d_ws + WS_CTL, 0, CTL_ZERO_BYTES, stream) != hipSuccess) return;
    Args a{};
    for (int i = 0; i < 38; ++i) a.in[i] = (const float*)d_in[i];
    a.out = (float*)d_out; a.ws = (unsigned char*)d_ws;
    hipLaunchKernelGGL(mk_fwd, dim3(grid), dim3(NTHR), LDS_BYTES, stream, a);
    const hipError_t le = hipPeekAtLastError();
    if (le != hipSuccess) fprintf(stderr, "kernel_launch: launch failed: %s\n", hipGetErrorName(le));
}
```

```cpp
#include <hip/hip_runtime.h>
#include <hip/hip_bf16.h>
#include <cstdio>
#include <cstdint>

namespace pg8 {
#define PG8_LAS __attribute__((address_space(3)))
typedef unsigned short bf16_t;
typedef short bf16x8 __attribute__((ext_vector_type(8)));
typedef float f32x4 __attribute__((ext_vector_type(4)));
typedef unsigned u32x4 __attribute__((ext_vector_type(4)));
constexpr int BM = 256, BK = 64, HALF = 128, HTB = HALF * BK * 2  , STAGE_BYTES = 8 * HTB, NXCD = 8, WGM = 8;

__host__ __device__ __forceinline__ int lds_byte(int r, int c) { const int st = (r >> 4) * 2 + (c >> 5), rr = r & 15, cc = c & 31, ob = rr * 64 + cc * 2; return st * 1024 + (ob ^ (((ob >> 9) & 1) << 5)); }
__host__ __device__ __forceinline__ void stage_rc(int b, int& R, int& C) { const int st = b / 1024, sb = b % 1024, swz = sb ^ (((sb >> 9) & 1) << 5); R = (st >> 1) * 16 + swz / 64; C = (st & 1) * 32 + (swz % 64) / 2; }
__host__ __device__ __forceinline__ int perm32(int rho) { const int n = rho >> 4, i = rho & 15; return 8 * (i >> 2) + 4 * n + (i & 3); }

struct Unit { int pm, pn, ko, ks; };
struct Gemm { const bf16_t* A; const bf16_t* Bt; int M, N, K, lda, ldb; };

struct StaticOrder {
    int nM, nN, nwg, G, c;
    __host__ __device__ void init(int M, int N, int G_, int c_) { nM = M / BM; nN = N / BM; nwg = nM * nN; G = G_; c = c_; }
    __host__ __device__ bool next(int i, Unit& u) const {
        const long L = (long)i * G + c; if (L >= nwg) return false;
        int wgid = (int)L; { const int q = nwg / NXCD, r = nwg % NXCD, xcd = wgid % NXCD, off = wgid / NXCD; wgid = (xcd < r ? xcd * (q + 1) : r * (q + 1) + (xcd - r) * q) + off; }
        const int nig = WGM * nN, gid = wgid / nig, fm = gid * WGM, gsz = (nM - fm) < WGM ? (nM - fm) : WGM;
        u.pm = fm + ((wgid % nig) % gsz); u.pn = (wgid % nig) / gsz; u.ko = 0; u.ks = 0; return true;
    }
    __device__ __forceinline__ void a_ready(const Unit&) const {}
    __device__ __forceinline__ void done(const Unit&) const {}
};
struct SplitOrder {
    int nN, nitems, kslice, c;
    __host__ __device__ void init(int M, int N, int Kslice, int c_) { nN = N / BM; nitems = (M / BM) * nN * 8; kslice = Kslice; c = c_; }
    __host__ __device__ bool next(int i, Unit& u) const { if (i > 0 || c >= nitems) return false; u.ks = c & 7; u.ko = u.ks * kslice; u.pn = (c >> 3) % nN; u.pm = (c >> 3) / nN; return true; }
    __device__ __forceinline__ void a_ready(const Unit&) const {}
    __device__ __forceinline__ void done(const Unit&) const {}
};

__device__ __forceinline__ unsigned cvt_pk_bf16(float lo, float hi) { unsigned r; asm volatile("v_cvt_pk_bf16_f32 %0, %1, %2" : "=v"(r) : "v"(lo), "v"(hi)); return r; }

struct EpiF32 {
    static constexpr bool PERM = false, AFTER_DRAIN = false;
    float* C; int ldc; size_t split_stride;
    __device__ __forceinline__ void operator()(const f32x4 (&acc)[2][2][4][2], const Unit& u, int wr, int wc, int fr, int fq) const {
        const int row0 = u.pm * BM + wr * 64 + fr, col0 = u.pn * BM + wc * 32 + 4 * fq; float* Cb = C + (size_t)u.ks * split_stride;
#pragma unroll
        for (int ai = 0; ai < 2; ++ai)
#pragma unroll
            for (int m = 0; m < 4; ++m) { float* rowp = Cb + (size_t)(row0 + ai * HALF + m * 16) * ldc + col0;
#pragma unroll
                for (int bj = 0; bj < 2; ++bj)
#pragma unroll
                    for (int n = 0; n < 2; ++n) *(f32x4*)(rowp + bj * HALF + n * 16) = acc[ai][bj][m][n]; }
    }
};
template <int ACT> struct EpiBf16 {
    static constexpr bool PERM = true, AFTER_DRAIN = false;
    bf16_t* O; int ldc; const float* rowscale;
    __device__ __forceinline__ void operator()(const f32x4 (&acc)[2][2][4][2], const Unit& u, int wr, int wc, int fr, int fq) const {
        const int row0 = u.pm * BM + wr * 64 + fr; const int col0 = u.pn * BM + wc * 32 + 8 * fq;
#pragma unroll
        for (int ai = 0; ai < 2; ++ai)
#pragma unroll
            for (int m = 0; m < 4; ++m) { const int row = row0 + ai * HALF + m * 16; bf16_t* rowp = O + (size_t)row * ldc + col0;
                float rs = 1.f; if (ACT == 2) rs = rowscale[row];
#pragma unroll
                for (int bj = 0; bj < 2; ++bj) { f32x4 v0 = acc[ai][bj][m][0], v1 = acc[ai][bj][m][1];
                    if (ACT == 1) {
#pragma unroll
                        for (int j = 0; j < 4; ++j) { const float a = fmaxf(v0[j], 0.f), b = fmaxf(v1[j], 0.f); v0[j] = a * a; v1[j] = b * b; } }
                    if (ACT == 2) { v0 = v0 * rs; v1 = v1 * rs; }
                    if (ACT == 3) { const u32x4 o = *(const u32x4*)(rowp + bj * HALF);
                        v0[0] += __builtin_bit_cast(float, o.x << 16); v0[1] += __builtin_bit_cast(float, o.x & 0xffff0000u); v0[2] += __builtin_bit_cast(float, o.y << 16); v0[3] += __builtin_bit_cast(float, o.y & 0xffff0000u);
                        v1[0] += __builtin_bit_cast(float, o.z << 16); v1[1] += __builtin_bit_cast(float, o.z & 0xffff0000u); v1[2] += __builtin_bit_cast(float, o.w << 16); v1[3] += __builtin_bit_cast(float, o.w & 0xffff0000u); }
                    u32x4 w; w.x = cvt_pk_bf16(v0[0], v0[1]); w.y = cvt_pk_bf16(v0[2], v0[3]); w.z = cvt_pk_bf16(v1[0], v1[1]); w.w = cvt_pk_bf16(v1[2], v1[3]);
                    *(u32x4*)(rowp + bj * HALF) = w; } }
    }
};

template <class Epi, class Sched, bool ALIGN_EPI = false, bool SP2 = false>
__device__ __forceinline__ void gemm_phase(PG8_LAS unsigned char* lds, const Gemm g, const Sched& S, const Epi& E) {
    int tid = threadIdx.x; asm volatile("" : "+v"(tid));
    const int wid = __builtin_amdgcn_readfirstlane(tid >> 6), lane = tid & 63, wr = wid >> 2, wc = wid & 3, fr = lane & 15, fq = lane >> 4;
    const int K = g.K, nt = K / BK, lda = g.lda, ldb = g.ldb;
    unsigned voffA[2], voffB[2];
#pragma unroll
    for (int i = 0; i < 2; ++i) { int R, C; stage_rc(tid * 16 + i * 8192, R, C); const int Rb = Epi::PERM ? ((R & ~31) + perm32(R & 31)) : R;
        voffA[i] = (unsigned)(R * lda + C) * 2u; voffB[i] = (unsigned)(Rb * ldb + C) * 2u; }
    const size_t kstep = (size_t)(BK * 2);
    const size_t hstepA = (size_t)HALF * lda * 2, hstepB = (size_t)HALF * ldb * 2;
    const size_t tstepA = 2 * hstepA, tstepB = 2 * hstepB;
    const unsigned ldsw = (unsigned)wid * 1024u;
    const int aoff = lds_byte(wr * 64 + fr, fq * 8), boff = lds_byte(wc * 32 + fr, fq * 8);
#define PG8_SA(b, h) (((b) * 2 + (h)) * HTB)
#define PG8_SB(b, h) ((4 + (b) * 2 + (h)) * HTB)
#define PG8_STAGE(bufoff, gbase, voff) do { _Pragma("unroll") for (int _i = 0; _i < 2; ++_i) \
        __builtin_amdgcn_global_load_lds((const unsigned*)((const char*)(gbase) + (voff)[_i]), (PG8_LAS unsigned*)(lds + (bufoff) + ldsw + _i * 8192), 16, 0, 0); } while (0)
#define PG8_LDA(dst, b, h) do { _Pragma("unroll") for (int m = 0; m < 4; ++m) _Pragma("unroll") for (int k = 0; k < 2; ++k) dst[m][k] = *(const PG8_LAS bf16x8*)(lds + PG8_SA(b, h) + aoff + m * 2048 + k * 1024); } while (0)
#define PG8_LDB(dst, b, h) do { _Pragma("unroll") for (int n = 0; n < 2; ++n) _Pragma("unroll") for (int k = 0; k < 2; ++k) dst[n][k] = *(const PG8_LAS bf16x8*)(lds + PG8_SB(b, h) + boff + n * 2048 + k * 1024); } while (0)
#define PG8_MMA(ai, bj, At, Bt) do { __builtin_amdgcn_s_setprio(1); _Pragma("unroll") for (int m = 0; m < 4; ++m) _Pragma("unroll") for (int n = 0; n < 2; ++n) _Pragma("unroll") for (int k = 0; k < 2; ++k) \
        acc[ai][bj][m][n] = __builtin_amdgcn_mfma_f32_16x16x32_bf16(Bt[n][k], At[m][k], acc[ai][bj][m][n], 0, 0, 0); __builtin_amdgcn_s_setprio(0); } while (0)
#define PG8_WAIT_V(n) asm volatile("s_waitcnt vmcnt(" #n ")" ::: "memory")
#define PG8_WAIT_L(n) asm volatile("s_waitcnt lgkmcnt(" #n ")" ::: "memory")
#define PG8_BAR __builtin_amdgcn_s_barrier()
#define PG8_SCHED __builtin_amdgcn_sched_barrier(0)
    Unit cur, nxt; int ui = 0;
    if (!S.next(0, cur)) return;
    f32x4 acc[2][2][4][2];
#pragma unroll
    for (int a = 0; a < 2; ++a)
#pragma unroll
        for (int b = 0; b < 2; ++b)
#pragma unroll
            for (int m = 0; m < 4; ++m)
#pragma unroll
                for (int n = 0; n < 2; ++n) acc[a][b][m][n] = (f32x4){0.f, 0.f, 0.f, 0.f};
    bf16x8 At[4][2], B0[2][2], B1[2][2];
    const char* cA = (const char*)g.A + (size_t)cur.pm * tstepA + (size_t)cur.ko * 2; const char* cB = (const char*)g.Bt + (size_t)cur.pn * tstepB + (size_t)cur.ko * 2;
    S.a_ready(cur);
    if constexpr (SP2) {
        PG8_STAGE(PG8_SB(0, 0), cB, voffB); PG8_STAGE(PG8_SB(0, 1), cB + hstepB, voffB); PG8_STAGE(PG8_SA(0, 0), cA, voffA); PG8_STAGE(PG8_SA(0, 1), cA + hstepA, voffA);
        if (wr == 1) PG8_BAR;
        PG8_WAIT_V(2); PG8_BAR;
        PG8_STAGE(PG8_SB(1, 0), cB + kstep, voffB); PG8_STAGE(PG8_SA(1, 0), cA + kstep, voffA); PG8_STAGE(PG8_SB(1, 1), cB + hstepB + kstep, voffB);
        PG8_WAIT_V(6); PG8_BAR;
    } else {
        PG8_STAGE(PG8_SB(0, 0), cB, voffB); PG8_STAGE(PG8_SA(0, 0), cA, voffA); PG8_STAGE(PG8_SB(0, 1), cB + hstepB, voffB); PG8_STAGE(PG8_SA(0, 1), cA + hstepA, voffA);
        if (wr == 1) PG8_BAR;
        PG8_WAIT_V(4); PG8_BAR;
        PG8_STAGE(PG8_SB(1, 0), cB + kstep, voffB); PG8_STAGE(PG8_SA(1, 0), cA + kstep, voffA); PG8_STAGE(PG8_SB(1, 1), cB + hstepB + kstep, voffB);
        PG8_WAIT_V(6); PG8_BAR;
    }
    for (;;) {
        const bool has_next = S.next(ui + 1, nxt);
        const char* nA = has_next ? (const char*)g.A + (size_t)nxt.pm * tstepA + (size_t)nxt.ko * 2 : cA; const char* nB = has_next ? (const char*)g.Bt + (size_t)nxt.pn * tstepB + (size_t)nxt.ko * 2 : cB;
        for (int t = 0; t < nt; t += 2) {
            const bool last = (t == nt - 2);
            const char* a1 = cA + (size_t)(t + 1) * kstep;
            const char* a2 = last ? nA : cA + (size_t)(t + 2) * kstep; const char* b2 = last ? nB : cB + (size_t)(t + 2) * kstep;
            const char* a3 = a2 + kstep; const char* b3 = b2 + kstep;
            if (last && has_next) S.a_ready(nxt);
            if constexpr (SP2) {
            PG8_LDB(B0, 0, 0); PG8_LDB(B1, 0, 1); PG8_SCHED; PG8_LDA(At, 0, 0); PG8_STAGE(PG8_SA(1, 1), a1 + hstepA, voffA);
            PG8_WAIT_V(8); PG8_WAIT_L(0); PG8_BAR; PG8_MMA(0, 0, At, B0); PG8_MMA(0, 1, At, B1); PG8_BAR; PG8_SCHED;
            PG8_LDA(At, 0, 1); PG8_STAGE(PG8_SB(0, 0), b2, voffB); PG8_STAGE(PG8_SB(0, 1), b2 + hstepB, voffB); PG8_STAGE(PG8_SA(0, 0), a2, voffA);
            PG8_WAIT_V(8); PG8_WAIT_L(0); PG8_BAR; PG8_MMA(1, 0, At, B0); PG8_MMA(1, 1, At, B1); PG8_BAR; PG8_SCHED;
            PG8_LDB(B0, 1, 0); PG8_LDB(B1, 1, 1); PG8_SCHED; PG8_LDA(At, 1, 0); PG8_STAGE(PG8_SA(0, 1), a2 + hstepA, voffA);
            PG8_WAIT_V(8); PG8_WAIT_L(0); PG8_BAR; PG8_MMA(0, 0, At, B0); PG8_MMA(0, 1, At, B1); PG8_BAR; PG8_SCHED;
            PG8_LDA(At, 1, 1); PG8_STAGE(PG8_SB(1, 0), b3, voffB); PG8_STAGE(PG8_SB(1, 1), b3 + hstepB, voffB); PG8_STAGE(PG8_SA(1, 0), a3, voffA);
            PG8_WAIT_V(8); PG8_WAIT_L(0); PG8_BAR; PG8_MMA(1, 0, At, B0); PG8_MMA(1, 1, At, B1); PG8_BAR; PG8_SCHED;
            } else {
            PG8_LDB(B0, 0, 0); PG8_SCHED; PG8_LDA(At, 0, 0); PG8_STAGE(PG8_SA(1, 1), a1 + hstepA, voffA);
            PG8_WAIT_L(8); PG8_BAR; PG8_WAIT_L(0); PG8_MMA(0, 0, At, B0); PG8_BAR; PG8_SCHED;
            PG8_LDB(B1, 0, 1); PG8_STAGE(PG8_SB(0, 0), b2, voffB);
            PG8_BAR; PG8_WAIT_L(0); PG8_MMA(0, 1, At, B1); PG8_BAR;
            PG8_LDA(At, 0, 1); PG8_STAGE(PG8_SA(0, 0), a2, voffA);
            PG8_BAR; PG8_WAIT_L(0); PG8_MMA(1, 0, At, B0); PG8_BAR; PG8_SCHED;
            PG8_STAGE(PG8_SB(0, 1), b2 + hstepB, voffB);
            PG8_WAIT_V(6); PG8_BAR; PG8_MMA(1, 1, At, B1); PG8_BAR;
            PG8_LDB(B0, 1, 0); PG8_SCHED; PG8_LDA(At, 1, 0); PG8_STAGE(PG8_SA(0, 1), a2 + hstepA, voffA);
            PG8_WAIT_L(8); PG8_BAR; PG8_WAIT_L(0); PG8_MMA(0, 0, At, B0); PG8_BAR; PG8_SCHED;
            PG8_LDB(B1, 1, 1); PG8_STAGE(PG8_SB(1, 0), b3, voffB);
            PG8_BAR; PG8_WAIT_L(0); PG8_MMA(0, 1, At, B1); PG8_BAR;
            PG8_LDA(At, 1, 1); PG8_STAGE(PG8_SA(1, 0), a3, voffA);
            PG8_BAR; PG8_WAIT_L(0); PG8_MMA(1, 0, At, B0); PG8_BAR; PG8_SCHED;
            PG8_STAGE(PG8_SB(1, 1), b3 + hstepB, voffB);
            PG8_WAIT_V(6); PG8_BAR; PG8_MMA(1, 1, At, B1); PG8_BAR;
            }
        }
        if constexpr (ALIGN_EPI) { if (wr == 0) PG8_BAR; }
        E(acc, cur, wr, wc, fr, fq); S.done(cur);
        if (!has_next) break;
#pragma unroll
        for (int a = 0; a < 2; ++a)
#pragma unroll
            for (int b = 0; b < 2; ++b)
#pragma unroll
                for (int m = 0; m < 4; ++m)
#pragma unroll
                    for (int n = 0; n < 2; ++n) acc[a][b][m][n] = (f32x4){0.f, 0.f, 0.f, 0.f};
        cur = nxt; cA = nA; cB = nB; ++ui;
        if constexpr (ALIGN_EPI) { if (wr == 1) PG8_BAR; }
    }
    PG8_WAIT_V(0);
    if constexpr (!ALIGN_EPI) { if (wr == 0) PG8_BAR; }
    PG8_BAR;
#undef PG8_SA
#undef PG8_SB
#undef PG8_STAGE
#undef PG8_LDA
#undef PG8_LDB
#undef PG8_MMA
#undef PG8_WAIT_V
#undef PG8_WAIT_L
#undef PG8_BAR
#undef PG8_SCHED
}
}

constexpr int NWAVES = 8, NTHR = 512;
constexpr int DM = 4096, NB = 2, SEQ = 8192, NCTX = 256, DFF = 16384;
constexpr int M_LAT = NB * SEQ, M_CTX = NB * NCTX, M_TOT = M_LAT + M_CTX;
constexpr int DIN = 8672, DINP = 8704;
constexpr int C_SWAQ = 0, C_SWAK = 1024, C_SWAV = 1280, C_LRUX = 1536, C_LRUY = 2560, C_QA = 3584, C_KVA = 4608, C_KR = 5120, C_RW = 5184;
constexpr int C_RWR = C_RW, C_RWK = C_RW + 1024, C_RWV = C_RW + 2048, C_RWL = C_RW + 3072;
constexpr int RWC = 3488;
constexpr float LN_EPS = 1e-5f, RMS_EPS = 1e-6f, GN_EPS = 64e-5f, ALPHA = 1.41421356237f;
constexpr int NCH = 264;

constexpr size_t MiB = 1u << 20;
constexpr size_t WS_CTL = 0, CTL_ZERO_BYTES = 1 * MiB;
constexpr size_t WS_MOD = 1 * MiB;
constexpr size_t WS_MODP = 2 * MiB;
constexpr size_t WS_SMALL = 20 * MiB;
constexpr size_t WS_RSQ = WS_SMALL;
constexpr size_t WS_RSKV = WS_RSQ + 128 * 1024;
constexpr size_t WS_SB = WS_RSKV + 128 * 1024;
constexpr size_t WS_CA = WS_SB + 2 * MiB;
constexpr size_t WS_CB = WS_CA + 5 * MiB;
constexpr size_t WS_HIN = WS_CB + 5 * MiB;
constexpr size_t WS_QUIRK = WS_HIN + 5 * MiB;
constexpr size_t WS_ROPE = WS_QUIRK + 8192;
static_assert(WS_ROPE + 16384 <= 40 * MiB, "small region");
constexpr size_t WS_W = 40 * MiB;
constexpr size_t WS_WIN = WS_W, WS_WOUT = WS_WIN + 68 * MiB, WS_WFF1 = WS_WOUT + 32 * MiB, WS_WFF2 = WS_WFF1 + 128 * MiB, WS_WQB = WS_WFF2 + 128 * MiB,
                 WS_WKVB = WS_WQB + 3 * MiB, WS_WLRU = WS_WKVB + 2 * MiB, WS_WLORA = WS_WLRU + 1 * MiB;
constexpr size_t WS_W2T = WS_WLORA, WS_A2T = WS_W2T + 256 * 1024, WS_G2T = WS_A2T + 256 * 1024;
constexpr size_t WS_X = 403 * MiB;
constexpr size_t WS_H = 667 * MiB;
constexpr size_t WS_MIX = 799 * MiB;
constexpr size_t WS_YS = 931 * MiB;
constexpr size_t WS_P = 1063 * MiB;
constexpr size_t WS_RWF = 1344 * MiB;
constexpr size_t RWF_STRIDE = (size_t)M_TOT * 1024 * 2;
constexpr size_t WS_Q = 1641 * MiB;
constexpr size_t WS_KV = 1691 * MiB;
constexpr size_t WS_KR = 1757 * MiB;
constexpr size_t WS_SET2 = 1760 * MiB;
constexpr size_t WSET_STRIDE = WS_SET2 - WS_W;
constexpr size_t WS_END = WS_SET2 + 363 * MiB;
constexpr size_t WS_YP = WS_Q;
constexpr size_t WS_HID = WS_P;
constexpr size_t WS_Y1 = WS_P;
constexpr size_t WS_Y2 = WS_MIX;
static_assert(WS_WLORA + 1 * MiB <= WS_X && WS_P + (size_t)M_TOT * DINP * 2 <= WS_RWF && WS_RWF + 9 * RWF_STRIDE <= WS_Q, "ws map");
static_assert(WS_HID + (size_t)M_TOT * DFF * 2 <= WS_Q && WS_Y2 + (size_t)M_TOT * DM * 4 <= WS_P && WS_YS + 2 * (size_t)M_TOT * 1024 * 4 <= WS_P, "ws overlays");
static_assert(WS_KR + (size_t)M_TOT * 64 * 2 <= WS_SET2 && WS_YP + 8 * (size_t)M_CTX * DM * 4 <= WS_KR, "ws end");

constexpr int RING_BYTES = 131072;
constexpr int LDSCTL_OFF = RING_BYTES, MISC_OFF = LDSCTL_OFF + 320;
constexpr int LDS_BYTES = 147456;

#define GAS __attribute__((address_space(1)))
#define LAS __attribute__((address_space(3)))
typedef unsigned short bf16;
typedef unsigned v4u __attribute__((ext_vector_type(4)));
typedef unsigned v2u __attribute__((ext_vector_type(2)));
typedef float f32x4 __attribute__((ext_vector_type(4)));
typedef _Float16 h16x4 __attribute__((ext_vector_type(4)));
typedef _Float16 h16x8 __attribute__((ext_vector_type(8)));
#ifndef XH16_
#define XH16_ 1
#endif
constexpr bool XH16 = XH16_;
#if XH16_
typedef _Float16 xres_t;
#else
typedef float xres_t;
#endif
typedef float f32x2 __attribute__((ext_vector_type(2)));
typedef float f32x16 __attribute__((ext_vector_type(16)));
typedef short bf16x8 __attribute__((ext_vector_type(8)));
typedef short s16x4 __attribute__((ext_vector_type(4)));
typedef GAS unsigned gu32;
typedef const GAS bf16* gcbf; typedef GAS bf16* gbfp; typedef const GAS float* gcfl; typedef GAS float* gflp;
#define LDS_WAIT() asm volatile("s_waitcnt lgkmcnt(0)" ::: "memory")
#define VM_WAIT() asm volatile("s_waitcnt vmcnt(0)" ::: "memory")
typedef __bf16 bf16x2_t __attribute__((ext_vector_type(2)));
__device__ __forceinline__ unsigned pk2(float lo, float hi) { const f32x2 v = {lo, hi}; const bf16x2_t b = __builtin_convertvector(v, bf16x2_t); return __builtin_bit_cast(unsigned, b); }
__device__ __forceinline__ unsigned f2bf(float f) { return pk2(f, f) & 0xffffu; }
__device__ __forceinline__ float bflo(unsigned w) { return __builtin_bit_cast(float, w << 16); }
__device__ __forceinline__ float bfhi(unsigned w) { return __builtin_bit_cast(float, w & 0xffff0000u); }
__device__ __forceinline__ float bf2f(bf16 h) { return __builtin_bit_cast(float, (unsigned)h << 16); }
#define DPP_ADD(x, ctrl) ((x) + __builtin_bit_cast(float, __builtin_amdgcn_update_dpp(0, __builtin_bit_cast(int, (x)), (ctrl), 0xf, 0xf, false)))
__device__ __forceinline__ float row_sum16(float x) { x = DPP_ADD(x, 0x128); x = DPP_ADD(x, 0x124); x = DPP_ADD(x, 0x122); x = DPP_ADD(x, 0x121); return x; }
#ifdef OLD_SUMS
__device__ __forceinline__ float wave_sum(float v) {
#pragma unroll
    for (int o = 1; o < 64; o <<= 1) v += __shfl_xor(v, o);
    return v;
}
__device__ __forceinline__ float half_swap_sum(float x) { return x + __shfl_xor(x, 32); }
__device__ __forceinline__ float quad_sum(float x) { x += __shfl_xor(x, 1); x += __shfl_xor(x, 2); return x; }
#else
__device__ __forceinline__ float wave_sum(float v) {
    const float r = row_sum16(v);
    const float a = __builtin_bit_cast(float, __builtin_amdgcn_readlane(__builtin_bit_cast(int, r), 0)), b = __builtin_bit_cast(float, __builtin_amdgcn_readlane(__builtin_bit_cast(int, r), 16));
    const float c = __builtin_bit_cast(float, __builtin_amdgcn_readlane(__builtin_bit_cast(int, r), 32)), d = __builtin_bit_cast(float, __builtin_amdgcn_readlane(__builtin_bit_cast(int, r), 48));
    return (a + b) + (c + d);
}
__device__ __forceinline__ float half_swap_sum(float x) {
    unsigned a = __builtin_bit_cast(unsigned, x), b = a; asm volatile("" : "+v"(b));
    auto rr = __builtin_amdgcn_permlane32_swap(a, b, false, false);
    const float lo = __uint_as_float(rr[0]), hi = __uint_as_float(rr[1]); return lo + hi;
}
__device__ __forceinline__ float quad_sum(float x) { x = DPP_ADD(x, 0xB1); x = DPP_ADD(x, 0x4E); return x; }
#endif
__device__ __forceinline__ float sigmoidf_(float x) { return __builtin_amdgcn_rcpf(1.f + __expf(-x)); }
__device__ __forceinline__ float softplusf_(float x) { return x > 20.f ? x : __logf(1.f + __expf(x)); }
__device__ __forceinline__ float tanhf_(float x) { const float e = __expf(2.f * x); return 1.f - 2.f * __builtin_amdgcn_rcpf(e + 1.f); }
__device__ __forceinline__ int ltid() { int t = threadIdx.x; asm volatile("" : "+v"(t)); return t; }
template <class T> __device__ __forceinline__ T ldg(const void* base, unsigned byteoff) { return *(const T*)((const char*)base + byteoff); }
template <class T> __device__ __forceinline__ void stg(void* base, unsigned byteoff, T v) { *(T*)((char*)base + byteoff) = v; }

#define XB_TMO      128
#define XB_XCNT(j)  (256  + 64 * (j))
#define XB_XSUB(j)  (1280 + 64 * (j))
#define XB_XGEN(j)  (2304 + 64 * (j))
#define XB_TOP      3328
#define XB_TOPGEN   3392
#define XCD_BAR_WORDS 3456
#define XB_SPIN_CAP (1u << 18)

__device__ __forceinline__ unsigned xb_ld(unsigned* p)              { return __hip_atomic_load(p, __ATOMIC_RELAXED, __HIP_MEMORY_SCOPE_AGENT); }
__device__ __forceinline__ unsigned xb_add(unsigned* p, unsigned v) { return __hip_atomic_fetch_add(p, v, __ATOMIC_RELAXED, __HIP_MEMORY_SCOPE_AGENT); }
__device__ __forceinline__ unsigned xb_xcc_id() { return (unsigned)__builtin_amdgcn_s_getreg((3 << 11) | 20) & 0xFu; }
#define XB_SPIN(cond, bar) do { unsigned _sp = 0; while (cond) { __builtin_amdgcn_s_sleep(1); \
    if ((++_sp & 255u) == 0u) { if (xb_ld(&(bar)[XB_TMO])) break; if (_sp > XB_SPIN_CAP) { atomicAdd(&(bar)[XB_TMO], 1u); break; } } } } while (0)

struct XcdBarrier {
    unsigned* bar; unsigned x;
    unsigned nparts;
    volatile LAS unsigned* st;
};

__device__ __forceinline__ XcdBarrier xcd_barrier_post(unsigned* bar, volatile LAS unsigned* st) {
    XcdBarrier b; b.bar = bar; b.x = xb_xcc_id(); b.st = st; b.nparts = 0u;
    if (threadIdx.x == 0) (void)xb_add(&bar[XB_XCNT(b.x)], 1u);
    return b;
}
__device__ __forceinline__ void xcd_barrier_complete(unsigned* bar, unsigned x, unsigned& nloc, unsigned& nx, unsigned nparts) {
    const unsigned G = nparts ? nparts : gridDim.x * gridDim.y * gridDim.z;
    unsigned sum, cnt, mine, sp = 0u;
    for (;;) {
        sum = 0u; cnt = 0u; mine = 0u;
#pragma unroll
        for (unsigned j = 0; j < 16; ++j) { const unsigned c = xb_ld(&bar[XB_XCNT(j)]); sum += c; cnt += (c > 0u) ? 1u : 0u; mine = (j == x) ? c : mine; }
        if (sum == G) break;
        __builtin_amdgcn_s_sleep(1);
        if ((++sp & 255u) == 0u) { if (xb_ld(&bar[XB_TMO])) break; if (sp > XB_SPIN_CAP) { atomicAdd(&bar[XB_TMO], 1u); break; } }
    }
    nloc = mine > 0u ? mine : 1u; nx = cnt > 0u ? cnt : 1u;
}

__device__ __forceinline__ void xcd_barrier(const XcdBarrier& b) {
    asm volatile("s_waitcnt vmcnt(0)" ::: "memory");
    __syncthreads();
    if (threadIdx.x == 0) {
        unsigned* bar = b.bar;
        __builtin_amdgcn_s_waitcnt(0);
        unsigned nloc = b.st[0], nx = b.st[1];
        if (nloc == 0u) { xcd_barrier_complete(bar, b.x, nloc, nx, b.nparts); b.st[0] = nloc; b.st[1] = nx; }
        const unsigned old = xb_add(&bar[XB_XSUB(b.x)], 1u);
        const unsigned gen = old / nloc;
        if (old + 1u == (gen + 1u) * nloc) {
            __builtin_amdgcn_fence(__ATOMIC_RELEASE, "agent");
            asm volatile("s_waitcnt vmcnt(0)" ::: "memory");
            const unsigned og = xb_add(&bar[XB_TOP], 1u);
            const unsigned tg = og / nx;
            if (og + 1u == (tg + 1u) * nx) xb_add(&bar[XB_TOPGEN], 1u);
            else XB_SPIN(xb_ld(&bar[XB_TOPGEN]) == tg, bar);
            __builtin_amdgcn_fence(__ATOMIC_ACQUIRE, "agent");
            xb_add(&bar[XB_XGEN(b.x)], 1u);
            asm volatile("s_waitcnt vmcnt(0)" ::: "memory");
        } else {
            XB_SPIN(xb_ld(&bar[XB_XGEN(b.x)]) == gen, bar);
            __builtin_amdgcn_fence(__ATOMIC_ACQUIRE, "agent");
            asm volatile("s_waitcnt vmcnt(0)" ::: "memory");
        }
    }
    __syncthreads();
}


namespace att {
constexpr int KVBLK = 64;
constexpr float THR = 8.f;
#define SBAR() __builtin_amdgcn_sched_barrier(0)
__device__ __forceinline__ int crow(int r, int hi) { return (r & 3) + 8 * (r >> 2) + 4 * hi; }
__device__ __forceinline__ unsigned cvtpk(float lo, float hi) { return pk2(lo, hi); }
template <int DQK> __device__ __forceinline__ int kswz(int row, int cb) { return row * (DQK * 2 + 16) + cb; }

template <int DQK> __device__ __forceinline__ void partialSM(f32x16& p0, f32x16& p1, float& m_reg, float& mn, float& alpha) {
  constexpr float SCALE = DQK == 128 ? 0.088388347648318440f : 0.072168783648703220f;
  constexpr float C = SCALE * 1.4426950408889634f;
  float pmax = p0[0];
#pragma unroll
  for (int r = 1; r < 16; ++r) pmax = fmaxf(pmax, p0[r]);
#pragma unroll
  for (int r = 0; r < 16; ++r) pmax = fmaxf(pmax, p1[r]);
  { auto rr = __builtin_amdgcn_permlane32_swap(__float_as_uint(pmax), __float_as_uint(pmax), false, false);
    pmax = fmaxf(__uint_as_float(rr[0]), __uint_as_float(rr[1])); }
  if (__builtin_expect(__all(pmax - m_reg <= THR / SCALE), 1)) { mn = m_reg; alpha = 1.f; }
  else { mn = fmaxf(m_reg, pmax); alpha = __builtin_amdgcn_exp2f((m_reg - mn) * C); m_reg = mn; }
  const float mnC = -mn * C;
#pragma unroll
  for (int r = 0; r < 16; ++r) p0[r] = fmaf(p0[r], C, mnC);
#pragma unroll
  for (int r = 0; r < 16; ++r) p1[r] = fmaf(p1[r], C, mnC);
#pragma unroll
  for (int r = 0; r < 16; ++r) p0[r] = __builtin_amdgcn_exp2f(p0[r]);
}
__device__ __forceinline__ void finishSM(f32x16& p0, f32x16& p1, float alpha, float& l_reg, bf16x8& pa0, bf16x8& pa1, bf16x8& pa2, bf16x8& pa3) {
#pragma unroll
  for (int r = 0; r < 16; ++r) p1[r] = __builtin_amdgcn_exp2f(p1[r]);
  float ps = 0;
#pragma unroll
  for (int r = 0; r < 16; ++r) ps += p0[r];
#pragma unroll
  for (int r = 0; r < 16; ++r) ps += p1[r];
  { auto rr = __builtin_amdgcn_permlane32_swap(__float_as_uint(ps), __float_as_uint(ps), false, false);
    ps = __uint_as_float(rr[0]) + __uint_as_float(rr[1]); }
  l_reg = l_reg * alpha + ps;
#define PK4(P, BASE, OUT) do { unsigned a0 = cvtpk(P[BASE + 0], P[BASE + 1]), a1 = cvtpk(P[BASE + 2], P[BASE + 3]);   \
    unsigned b0 = cvtpk(P[BASE + 4], P[BASE + 5]), b1 = cvtpk(P[BASE + 6], P[BASE + 7]);                              \
    auto r0 = __builtin_amdgcn_permlane32_swap(a0, b0, false, false); auto r1 = __builtin_amdgcn_permlane32_swap(a1, b1, false, false); \
    v4u w = {r0[0], r1[0], r0[1], r1[1]}; OUT = __builtin_bit_cast(bf16x8, w); } while (0)
  PK4(p0, 0, pa0); PK4(p0, 8, pa1); PK4(p1, 0, pa2); PK4(p1, 8, pa3);
#undef PK4
}
template <int DQK> __device__ __forceinline__ void qkt(f32x16& p0, f32x16& p1, const LAS char* Ks, const bf16x8* qr, const LAS char* qx, int r32, int hi) {
  p0 = f32x16{}; p1 = f32x16{};
#pragma unroll
  for (int d0 = 0; d0 < DQK / 16; ++d0) { const int cb = (d0 * 16 + hi * 8) * 2;
    bf16x8 b0 = *(const LAS bf16x8*)(Ks + kswz<DQK>(r32, cb));
    bf16x8 b1 = *(const LAS bf16x8*)(Ks + kswz<DQK>(32 + r32, cb));
    bf16x8 q; if (d0 < 8) q = qr[d0]; else q = *(const LAS bf16x8*)(qx + (d0 - 8) * 32);
    p0 = __builtin_amdgcn_mfma_f32_32x32x16_bf16(b0, q, p0, 0, 0, 0);
    p1 = __builtin_amdgcn_mfma_f32_32x32x16_bf16(b1, q, p1, 0, 0, 0);
    if ((d0 & 3) == 3 && d0 + 1 < DQK / 16) SBAR(); }
}
__device__ __forceinline__ int v_st(int k, int c) { const int kk = (k & ~0xC) | ((k & 4) << 1) | ((k & 8) >> 1); return ((kk >> 3) * 4 + (c >> 5)) * 512 + ((kk & 7) * 32 + (c & 31)) * 2; }
__device__ __forceinline__ int v_rd_base(int lane) { return ((lane & 3) << 3) | (((lane >> 2) & 3) << 6) | (((lane >> 4) & 1) << 5) | (((lane >> 5) & 1) << 8); }
constexpr int v_rd_off(int d0, int ks, int half) { return d0 * 512 + ks * 4096 + half * 2048; }
template <int OFF> __device__ __forceinline__ s16x4 tr_read(int vb) {
  s16x4 r; asm volatile("ds_read_b64_tr_b16 %0, %1 offset:%2" : "=&v"(r) : "v"(vb), "i"(OFF) : "memory"); return r;
}
template <int D0> __device__ __forceinline__ void pv_one(f32x16& od, int vb, bf16x8 pa0, bf16x8 pa1, bf16x8 pa2, bf16x8 pa3) {
  const s16x4 l0 = tr_read<v_rd_off(D0, 0, 0)>(vb), h0 = tr_read<v_rd_off(D0, 0, 1)>(vb), l1 = tr_read<v_rd_off(D0, 1, 0)>(vb), h1 = tr_read<v_rd_off(D0, 1, 1)>(vb);
  const s16x4 l2 = tr_read<v_rd_off(D0, 2, 0)>(vb), h2 = tr_read<v_rd_off(D0, 2, 1)>(vb), l3 = tr_read<v_rd_off(D0, 3, 0)>(vb), h3 = tr_read<v_rd_off(D0, 3, 1)>(vb);
  asm volatile("s_waitcnt lgkmcnt(0)" ::: "memory"); SBAR();
#define PK(L, H) (bf16x8){L[0], L[1], L[2], L[3], H[0], H[1], H[2], H[3]}
  od = __builtin_amdgcn_mfma_f32_32x32x16_bf16(pa0, PK(l0, h0), od, 0, 0, 0);
  od = __builtin_amdgcn_mfma_f32_32x32x16_bf16(pa1, PK(l1, h1), od, 0, 0, 0);
  od = __builtin_amdgcn_mfma_f32_32x32x16_bf16(pa2, PK(l2, h2), od, 0, 0, 0);
  od = __builtin_amdgcn_mfma_f32_32x32x16_bf16(pa3, PK(l3, h3), od, 0, 0, 0);
#undef PK
}
__device__ __forceinline__ void pv_d0(f32x16* o, int vb, bf16x8 pa0, bf16x8 pa1, bf16x8 pa2, bf16x8 pa3) {
  pv_one<0>(o[0], vb, pa0, pa1, pa2, pa3); pv_one<1>(o[1], vb, pa0, pa1, pa2, pa3); pv_one<2>(o[2], vb, pa0, pa1, pa2, pa3); pv_one<3>(o[3], vb, pa0, pa1, pa2, pa3);
}
__device__ __forceinline__ void apply_mask(f32x16& p0, f32x16& p1, int mtype, int krel0, int qi, int hi) {
  if (mtype == 0) return;
  const float ninf = -__builtin_inff();
#pragma unroll
  for (int r = 0; r < 16; ++r) { const int k0 = krel0 + crow(r, hi), k1 = k0 + 32;
    const bool ok0 = (mtype == 1) ? (k0 >= qi - 128) : (k0 <= qi + 128), ok1 = (mtype == 1) ? (k1 >= qi - 128) : (k1 <= qi + 128);
    p0[r] = ok0 ? p0[r] : ninf; p1[r] = ok1 ? p1[r] : ninf; }
}
struct Tile { gcbf kn; gcbf kr; gcbf v; int mtype; int krel0; };

__device__ __forceinline__ void rope_pair(bf16x8& a, bf16x8& b, gcfl ct, gcfl st) {
  const f32x4 c0 = *(const GAS f32x4*)ct, c1 = *(const GAS f32x4*)(ct + 4), s0 = *(const GAS f32x4*)st, s1 = *(const GAS f32x4*)(st + 4);
  const float cs[8] = {c0[0], c0[1], c0[2], c0[3], c1[0], c1[1], c1[2], c1[3]}, sn[8] = {s0[0], s0[1], s0[2], s0[3], s1[0], s1[1], s1[2], s1[3]};
  v4u ua = __builtin_bit_cast(v4u, a), ub = __builtin_bit_cast(v4u, b); v4u oa, ob;
#pragma unroll
  for (int w = 0; w < 4; ++w) { const float x1[2] = {bflo(ua[w]), bfhi(ua[w])}, x2[2] = {bflo(ub[w]), bfhi(ub[w])}; float y1[2], y2[2];
#pragma unroll
    for (int e = 0; e < 2; ++e) { const float c = cs[2 * w + e], sv = sn[2 * w + e]; y1[e] = x1[e] * c - x2[e] * sv; y2[e] = x2[e] * c + x1[e] * sv; }
    oa[w] = pk2(y1[0], y1[1]); ob[w] = pk2(y2[0], y2[1]); }
  a = __builtin_bit_cast(bf16x8, oa); b = __builtin_bit_cast(bf16x8, ob);
}

template <int DQK, int LDKN, int LDV, bool MASK, bool SINK, int SDEPTH, class TS>
__device__ __forceinline__ void attn_body(gcbf Qw, int rope, int prow, int pcol, gcfl rtab, int qi, float sink_l2, const TS& ts, int NT, gbfp Ow, LAS char* lds) {
  constexpr float SCALE = DQK == 128 ? 0.088388347648318440f : 0.072168783648703220f;
  constexpr float C = SCALE * 1.4426950408889634f;
  constexpr int SHM_K = KVBLK * (DQK * 2 + 16), SHM_V = KVBLK * 128 * 2;
  int tid = threadIdx.x; asm volatile("" : "+v"(tid));
  const int wid = tid >> 6, lane = tid & 63, r32 = lane & 31, hi = lane >> 5;
  LAS char* V_lds = lds; LAS char* K_lds = lds + 2 * SHM_V;
  LAS float* wsl = (LAS float*)(lds + 2 * SHM_V + 2 * SHM_K) + wid * 64; LAS float* li_l = wsl; LAS float* al_l = wsl + 32;
  float m_reg = -1e30f, l_reg = 0; f32x16 o[4] = {}; bf16x8 qr[8];
#pragma unroll
  for (int d0 = 0; d0 < 8; ++d0) qr[d0] = *(const GAS bf16x8*)(Qw + d0 * 16 + hi * 8);
  const LAS char* qx = lds + 2 * SHM_V + 2 * SHM_K + 2048 + wid * 4608 + r32 * 144 + hi * 16;
  if constexpr (DQK == 192) {
    bf16x8 x0 = *(const GAS bf16x8*)(Qw + 128 + hi * 8), x1 = *(const GAS bf16x8*)(Qw + 144 + hi * 8), x2 = *(const GAS bf16x8*)(Qw + 160 + hi * 8), x3 = *(const GAS bf16x8*)(Qw + 176 + hi * 8);
    if (rope) {
      rope_pair(x0, x1, rtab + (size_t)prow * 16 + hi * 8, rtab + 2048 + (size_t)prow * 16 + hi * 8);
      rope_pair(x2, x3, rtab + (size_t)pcol * 16 + hi * 8, rtab + 2048 + (size_t)pcol * 16 + hi * 8); }
    LAS char* qw_ = (LAS char*)qx; *(LAS bf16x8*)(qw_) = x0; *(LAS bf16x8*)(qw_ + 32) = x1; *(LAS bf16x8*)(qw_ + 64) = x2; *(LAS bf16x8*)(qw_ + 96) = x3;
  }
  const int sr = tid >> 4, sc = (tid & 15) * 8, vst0 = v_st(sr, sc), vst1 = v_st(32 + sr, sc);
  const int rr_ = tid >> 3, rc_ = (tid & 7) * 8;
  const int vb0 = (int)(uintptr_t)V_lds + v_rd_base(lane);
  struct { bf16x8 vs0, vs1, ks0, ks1, kx; } sr_[SDEPTH];
#define SLOAD(i, jt) do { const Tile t_ = ts(jt); sr_[i].vs0 = *(const GAS bf16x8*)(t_.v + (size_t)sr * LDV + sc); sr_[i].vs1 = *(const GAS bf16x8*)(t_.v + (size_t)(32 + sr) * LDV + sc); \
    sr_[i].ks0 = *(const GAS bf16x8*)(t_.kn + (size_t)sr * LDKN + sc); sr_[i].ks1 = *(const GAS bf16x8*)(t_.kn + (size_t)(32 + sr) * LDKN + sc); \
    if constexpr (DQK == 192) sr_[i].kx = *(const GAS bf16x8*)(t_.kr + (size_t)rr_ * 64 + rc_); } while (0)
#define SWRITE(b, i) do { *(LAS bf16x8*)(V_lds + (b) * SHM_V + vst0) = sr_[i].vs0; *(LAS bf16x8*)(V_lds + (b) * SHM_V + vst1) = sr_[i].vs1; const int kc = sc * 2; \
    *(LAS bf16x8*)(K_lds + (b) * SHM_K + kswz<DQK>(sr, kc)) = sr_[i].ks0; *(LAS bf16x8*)(K_lds + (b) * SHM_K + kswz<DQK>(32 + sr, kc)) = sr_[i].ks1; \
    if constexpr (DQK == 192) *(LAS bf16x8*)(K_lds + (b) * SHM_K + kswz<DQK>(rr_, 256 + rc_ * 2)) = sr_[i].kx; } while (0)
#define SWAIT() do { if constexpr (SDEPTH == 2) { if constexpr (DQK == 192) asm volatile("s_waitcnt vmcnt(5)" ::: "memory"); else asm volatile("s_waitcnt vmcnt(4)" ::: "memory"); } \
    else asm volatile("s_waitcnt vmcnt(0)" ::: "memory"); } while (0)
#define RESC(a) do { if (__any((a) < 1.f)) { if (hi == 0) al_l[r32] = (a); asm volatile("s_waitcnt lgkmcnt(0)" ::: "memory"); \
    _Pragma("unroll") for (int d = 0; d < 4; ++d) _Pragma("unroll") for (int r = 0; r < 16; ++r) o[d][r] *= al_l[crow(r, hi)]; } } while (0)
#define MASKT(pa_, pb_, jt) do { if constexpr (MASK) { const Tile t_ = ts(jt); apply_mask(pa_, pb_, t_.mtype, t_.krel0, qi, hi); } } while (0)
  f32x16 pA0, pA1, pB0, pB1; float mnA, mnB, alA, alB; bf16x8 pa0, pa1, pa2, pa3;
  constexpr int SE = 0, SO = SDEPTH - 1;
  SLOAD(SE, 0); asm volatile("s_waitcnt vmcnt(0)" ::: "memory"); SWRITE(0, SE); __syncthreads();
  qkt<DQK>(pA0, pA1, K_lds, qr, qx, r32, hi); MASKT(pA0, pA1, 0); partialSM<DQK>(pA0, pA1, m_reg, mnA, alA);
  SLOAD(SO, 1); if constexpr (SDEPTH == 2) { if (2 < NT) SLOAD(SE, 2); }
  SWAIT(); SWRITE(1, SO); __syncthreads();
  for (int j = 1; j + 1 < NT; j += 2) {
    SBAR(); qkt<DQK>(pB0, pB1, K_lds + SHM_K, qr, qx, r32, hi); MASKT(pB0, pB1, j);
    finishSM(pA0, pA1, alA, l_reg, pa0, pa1, pa2, pa3); SBAR();
    SLOAD(SO, j + SDEPTH); SBAR();
    pv_d0(o, vb0, pa0, pa1, pa2, pa3); partialSM<DQK>(pB0, pB1, m_reg, mnB, alB);
    __syncthreads(); SWAIT(); SWRITE(0, SE);
    RESC(alB); __syncthreads();
    SBAR(); qkt<DQK>(pA0, pA1, K_lds, qr, qx, r32, hi); MASKT(pA0, pA1, j + 1);
    finishSM(pB0, pB1, alB, l_reg, pa0, pa1, pa2, pa3); SBAR();
    if (SDEPTH == 1 || j + 3 < NT) SLOAD(SE, j + 1 + SDEPTH); SBAR();
    pv_d0(o, vb0 + SHM_V, pa0, pa1, pa2, pa3); partialSM<DQK>(pA0, pA1, m_reg, mnA, alA);
    __syncthreads(); SWAIT(); SWRITE(1, SO);
    RESC(alA); __syncthreads();
  }
  SBAR(); qkt<DQK>(pB0, pB1, K_lds + SHM_K, qr, qx, r32, hi); MASKT(pB0, pB1, NT - 1);
  finishSM(pA0, pA1, alA, l_reg, pa0, pa1, pa2, pa3); SBAR();
  pv_d0(o, vb0, pa0, pa1, pa2, pa3); partialSM<DQK>(pB0, pB1, m_reg, mnB, alB);
  __syncthreads(); RESC(alB);
  finishSM(pB0, pB1, alB, l_reg, pa0, pa1, pa2, pa3); SBAR();
  pv_d0(o, vb0 + SHM_V, pa0, pa1, pa2, pa3);
  if constexpr (SINK) l_reg += __builtin_amdgcn_exp2f(sink_l2 - m_reg * C);
  if (hi == 0) li_l[r32] = l_reg; asm volatile("s_waitcnt lgkmcnt(0)" ::: "memory");
  float rli[16];
#pragma unroll
  for (int r = 0; r < 16; ++r) rli[r] = __builtin_amdgcn_rcpf(li_l[crow(r, hi)]);
  __syncthreads();
  LAS bf16* ost = (LAS bf16*)(lds + wid * 8704);
#pragma unroll
  for (int r = 0; r < 16; ++r) { const int orow = crow(r, hi);
#pragma unroll
    for (int d0 = 0; d0 < 4; ++d0) ost[orow * 136 + d0 * 32 + r32] = (bf16)f2bf(o[d0][r] * rli[r]); }
  asm volatile("s_waitcnt lgkmcnt(0)" ::: "memory");
#pragma unroll
  for (int i = 0; i < 8; ++i) { const int orow = i * 4 + (lane >> 4), ch = lane & 15;
    *(GAS v4u*)(Ow + (size_t)orow * 4096 + ch * 8) = *(const LAS v4u*)(ost + orow * 136 + ch * 8); }
  __syncthreads();
#undef SLOAD
#undef SWRITE
#undef SWAIT
#undef RESC
#undef MASKT
}
}

struct Args { const float* in[38]; float* out; unsigned char* ws; };
template <class T> __device__ __forceinline__ T launder(T p) { asm volatile("" : "+s"(p)); return p; }
template <class T> __device__ __forceinline__ T* launder_g(T* p) { GAS T* g = (GAS T*)p; asm volatile("" : "+s"(g)); return (T*)g; }
#define INP(i) ((const float*)(gcfl)F.A->in[i])
struct Frame {
    LAS unsigned char* lds;
    gu32* ctl;
    int tid, lane, wave;
    int vcu, G, gw, NGW;
    const __attribute__((address_space(4))) Args* A;
    float* out;
    unsigned char* ws;
    unsigned char* wsw;
};
enum { I_X = 0, I_C, I_CTX, I_CCTX, I_WMOD, I_BMOD, I_WIN, I_WOUT, I_LN1G, I_LN1B, I_WFF1, I_WFF2, I_LN2G, I_LN2B, I_SINK, I_CONVW, I_CONVB, I_LWA, I_LBA, I_LWI, I_LBI, I_LAM,
       I_QNORM, I_KVNORM, I_WQB, I_WKVB, I_MUP, I_MUN, I_W0, I_W2, I_A0, I_A2, I_G2, I_KK, I_KA, I_RK, I_LNG, I_LNB };
__device__ __forceinline__ int row_s(int row) { return row < SEQ ? 0 : (row < M_LAT ? 1 : 2); }
__device__ __forceinline__ const float* mod_ptr(const Frame& F, int l, int s, int chunk) { return (const float*)(F.ws + WS_MOD) + ((size_t)(l * 3 + s) * 6 + chunk) * DM; }

__device__ __forceinline__ void transpose_item(const float* W, int N, int Kvalid, bf16* WT, int ldt, const float* kscale, LAS float* scr, int k0, int n0, int lane) {
    { const int kr = lane >> 3, c4 = (lane & 7) * 4;
#pragma unroll
      for (int i = 0; i < 8; ++i) { const int kk = 8 * i + kr, k = k0 + kk; f32x4 v = {0.f, 0.f, 0.f, 0.f};
          if (k < Kvalid) { v = *(const f32x4*)(W + (size_t)k * N + n0 + c4); if (kscale) v = v * kscale[k]; }
          scr[kk * 33 + c4] = v.x; scr[kk * 33 + c4 + 1] = v.y; scr[kk * 33 + c4 + 2] = v.z; scr[kk * 33 + c4 + 3] = v.w; } }
    LDS_WAIT(); asm volatile("" ::: "memory");
    const int c = lane & 7;
#pragma unroll
    for (int j = 0; j < 4; ++j) { const int n = (lane >> 3) + 8 * j; const LAS float* s = scr + (8 * c) * 33 + n;
        v4u o; o.x = pk2(s[0 * 33], s[1 * 33]); o.y = pk2(s[2 * 33], s[3 * 33]); o.z = pk2(s[4 * 33], s[5 * 33]); o.w = pk2(s[6 * 33], s[7 * 33]);
        *(v4u*)(WT + (size_t)(n0 + n) * ldt + k0 + 8 * c) = o; }
    LDS_WAIT(); asm volatile("" ::: "memory");
}
struct TItem { const float* W; bf16* WT; const float* kscale; int N, Kvalid, ldt, k0, n0; };
__device__ __forceinline__ void titem_load(const TItem& t, int lane, f32x4 (&v)[8]) {
    const int kr = lane >> 3, c4 = (lane & 7) * 4;
#pragma unroll
    for (int i = 0; i < 8; ++i) { const int k = t.k0 + 8 * i + kr; v[i] = (f32x4){0.f, 0.f, 0.f, 0.f}; if (k < t.Kvalid) v[i] = *(const f32x4*)(t.W + (size_t)k * t.N + t.n0 + c4); }
}
__device__ __forceinline__ void titem_finish(const TItem& t, int lane, LAS float* scr, f32x4 (&v)[8]) {
    { const int kr = lane >> 3, c4 = (lane & 7) * 4;
#pragma unroll
      for (int i = 0; i < 8; ++i) { const int kk = 8 * i + kr, k = t.k0 + kk; f32x4 x = v[i]; if (t.kscale && k < t.Kvalid) x = x * t.kscale[k];
          scr[kk * 33 + c4] = x.x; scr[kk * 33 + c4 + 1] = x.y; scr[kk * 33 + c4 + 2] = x.z; scr[kk * 33 + c4 + 3] = x.w; } }
    LDS_WAIT(); asm volatile("" ::: "memory");
    const int c = lane & 7;
#pragma unroll
    for (int j = 0; j < 4; ++j) { const int n = (lane >> 3) + 8 * j; const LAS float* s = scr + (8 * c) * 33 + n;
        v4u o; o.x = pk2(s[0 * 33], s[1 * 33]); o.y = pk2(s[2 * 33], s[3 * 33]); o.z = pk2(s[4 * 33], s[5 * 33]); o.w = pk2(s[6 * 33], s[7 * 33]);
        *(v4u*)(t.WT + (size_t)(t.n0 + n) * t.ldt + t.k0 + 8 * c) = o; }
    LDS_WAIT(); asm volatile("" ::: "memory");
}
__device__ __forceinline__ TItem conv_decode(const Frame& F, int l, unsigned char* ws, int r) {
    constexpr int I1 = 64 * 271, I2 = 64 * 128, I3 = 64 * 512, I4 = 256 * 128, I5 = 16 * 48, I6 = 8 * 64, I7 = 32 * 8, I8 = 2 * 32, I9 = 2 * 32;
    if (r < I1) return TItem{INP(I_WIN) + (size_t)l * DM * DIN, (bf16*)(ws + WS_WIN), nullptr, DIN, DM, DM, 64 * (r / 271), 32 * (r % 271)}; r -= I1;
    if (r < I2) return TItem{INP(I_WOUT) + (size_t)l * DM * DM, (bf16*)(ws + WS_WOUT), nullptr, DM, DM, DM, 64 * (r / 128), 32 * (r % 128)}; r -= I2;
    if (r < I3) return TItem{INP(I_WFF1) + (size_t)l * DM * DFF, (bf16*)(ws + WS_WFF1), nullptr, DFF, DM, DM, 64 * (r / 512), 32 * (r % 512)}; r -= I3;
    if (r < I4) return TItem{INP(I_WFF2) + (size_t)l * DFF * DM, (bf16*)(ws + WS_WFF2), nullptr, DM, DFF, DFF, 64 * (r / 128), 32 * (r % 128)}; r -= I4;
    if (r < I5) return TItem{INP(I_WQB) + (size_t)l * 1024 * 1536, (bf16*)(ws + WS_WQB), INP(I_QNORM) + l * 1024, 1536, 1024, 1024, 64 * (r / 48), 32 * (r % 48)}; r -= I5;
    if (r < I6) return TItem{INP(I_WKVB) + (size_t)l * 512 * 2048, (bf16*)(ws + WS_WKVB), INP(I_KVNORM) + l * 512, 2048, 512, 512, 64 * (r / 64), 32 * (r % 64)}; r -= I6;
    if (r < I7) { const int mat = r >> 3, sub = r & 7, gate = mat & 1, dn = mat >> 1, d = dn >> 3, n = dn & 7;
        return TItem{(gate ? INP(I_LWI) : INP(I_LWA)) + ((size_t)(l * 2 + d) * 8 + n) * 128 * 128, (bf16*)(ws + WS_WLRU) + ((size_t)(d * 2 + gate) * 8 + n) * 128 * 128, nullptr, 128, 128, 128, 64 * (sub >> 2), 32 * (sub & 3)}; } r -= I7;
    if (r < I8) { const int d = r >> 5; return TItem{INP(I_W2) + (size_t)(l * 2 + d) * 64 * 1024, (bf16*)(ws + WS_W2T) + (size_t)d * 1024 * 64, nullptr, 1024, 64, 64, 0, 32 * (r & 31)}; } r -= I8;
    if (r < I9) { const int d = r >> 5; return TItem{INP(I_A2) + (size_t)(l * 2 + d) * 64 * 1024, (bf16*)(ws + WS_A2T) + (size_t)d * 1024 * 64, nullptr, 1024, 64, 64, 0, 32 * (r & 31)}; } r -= I9;
    return TItem{INP(I_G2) + (size_t)l * 160 * 1024, (bf16*)(ws + WS_G2T), nullptr, 1024, 160, 192, 64 * (r / 32), 32 * (r % 32)};
}
__device__ __forceinline__ void convert_weights(Frame& F, int l, int widx, int nw) {
    LAS float* scr = (LAS float*)(F.lds + F.wave * 16384);
    constexpr int NIT = 64 * 271 + 64 * 128 + 64 * 512 + 256 * 128 + 16 * 48 + 8 * 64 + 32 * 8 + 2 * 32 + 2 * 32 + 3 * 32;
    unsigned char* ws = F.ws + (l ? WSET_STRIDE : 0);
    int it = __builtin_amdgcn_readfirstlane(widx);
    if (it < NIT) { TItem cur = conv_decode(F, l, ws, it); f32x4 va[8]; titem_load(cur, F.lane, va);
#pragma unroll 1
        for (;;) { const int itn = it + nw; TItem nxt = cur; f32x4 vb[8];
            if (itn < NIT) { nxt = conv_decode(F, l, ws, itn); titem_load(nxt, F.lane, vb); }
            else {
#pragma unroll
                for (int i = 0; i < 8; ++i) vb[i] = va[i]; }
            titem_finish(cur, F.lane, scr, va);
            if (itn >= NIT) break;
            cur = nxt; it = itn;
#pragma unroll
            for (int i = 0; i < 8; ++i) va[i] = vb[i]; } }
    { unsigned zz = 0u; asm volatile("" : "+v"(zz)); v4u z = {zz, zz, zz, zz}; v4u* p = (v4u*)((bf16*)(ws + WS_WIN) + (size_t)DIN * DM);
      for (int i = widx * 64 + F.lane; i < 32 * DM / 8; i += nw * 64) p[i] = z; }
}

__device__ __forceinline__ void mod_partials(Frame& F) {
    LAS float* sl = (LAS float*)F.lds;
    for (int it = F.vcu; it < 2 * 32 * 12; it += F.G) {
        const int l = it / 384, ks = (it / 12) % 32, cc = it % 12;
        __syncthreads();
        if (F.tid < 384) { const int s = F.tid >> 7, k = ks * 128 + (F.tid & 127); const float c = s < 2 ? INP(I_C)[s * DM + k] : INP(I_CCTX)[k]; sl[F.tid] = c / (1.f + __expf(-c)); }
        __syncthreads();
        const float* wp = INP(I_WMOD) + ((size_t)l * DM + ks * 128) * 24576 + cc * 2048 + F.tid * 4;
        f32x4 a0 = {0.f, 0.f, 0.f, 0.f}, a1 = a0, a2 = a0;
#pragma unroll 8
        for (int k = 0; k < 128; ++k) { const f32x4 w = *(const f32x4*)(wp + (size_t)k * 24576); a0 += w * sl[k]; a1 += w * sl[128 + k]; a2 += w * sl[256 + k]; }
        float* op = (float*)(F.ws + WS_MODP) + ((size_t)(l * 32 + ks) * 3) * 24576 + cc * 2048 + F.tid * 4;
        *(f32x4*)(op) = a0; *(f32x4*)(op + 24576) = a1; *(f32x4*)(op + 2 * 24576) = a2;
    }
    __syncthreads();
}
__device__ __forceinline__ void mod_reduce(Frame& F) {
    for (int i = F.vcu * NTHR + F.tid; i < 2 * 3 * 24576; i += F.G * NTHR) {
        const int l = i / (3 * 24576), s = (i / 24576) % 3, n = i % 24576;
        float a = INP(I_BMOD)[l * 24576 + n];
        const float* pp = (const float*)(F.ws + WS_MODP) + ((size_t)(l * 32) * 3 + s) * 24576 + n;
#pragma unroll 8
        for (int ks = 0; ks < 32; ++ks) a += pp[(size_t)ks * 3 * 24576];
        ((float*)(F.ws + WS_MOD))[i] = a;
    }
}

__device__ __forceinline__ void sum_partials_row(const Frame& F, const float* yp, size_t stride, bf16* ydst) {
    int lane = F.lane; asm volatile("" : "+v"(lane));
#pragma unroll 2
    for (int j = 0; j < 8; ++j) { const int c = 8 * lane + 512 * j; f32x4 y0 = *(const f32x4*)(yp + c), y1 = *(const f32x4*)(yp + c + 4);
#pragma unroll
        for (int sp = 1; sp < 8; ++sp) { y0 += *(const f32x4*)(yp + sp * stride + c); y1 += *(const f32x4*)(yp + sp * stride + c + 4); }
        v4u w; w.x = pk2(y0.x, y0.y); w.y = pk2(y0.z, y0.w); w.z = pk2(y1.x, y1.y); w.w = pk2(y1.z, y1.w); *(v4u*)(ydst + c) = w; }
}
constexpr int LNV_G = 0, LNV_B = DM, LNV_GA = 2 * DM, LNV_SC = 3 * DM, LNV_SH = 4 * DM;
__device__ __forceinline__ void ln_stage(const Frame& F, int slot, const float* src) {
    LAS float* d = (LAS float*)F.lds + slot; gcfl g = (gcfl)src;
#pragma unroll
    for (int u = 0; u < 2; ++u) { const int c = 4 * (F.tid + NTHR * u); *(LAS f32x4*)(d + c) = *(const GAS f32x4*)(g + c); }
}
template <int MODE, bool XSH = false, bool XDH = false>
__device__ __forceinline__ void ln_row(const Frame& F, const void* xsrc_, const bf16* Y_, void* xdst_, bool domod, bf16* hrow_) {
    gcfl xsrc = (gcfl)xsrc_; const GAS _Float16* xsrch = (const GAS _Float16*)xsrc_; gflp xdst = (gflp)xdst_; GAS _Float16* xdsth = (GAS _Float16*)xdst_;
    gcbf Y = (gcbf)Y_; gbfp hrow = (gbfp)hrow_; const LAS float* L = (const LAS float*)F.lds + 8 * F.lane;
    f32x4 v[16]; v4u yr[8]; float s = 0.f;
#pragma unroll
    for (int j = 0; j < 8; ++j) { const int c = 8 * F.lane + 512 * j;
        if (XSH) { const h16x8 h = __builtin_nontemporal_load((const GAS h16x8*)(xsrch + c));
            v[2 * j] = __builtin_convertvector(__builtin_shufflevector(h, h, 0, 1, 2, 3), f32x4); v[2 * j + 1] = __builtin_convertvector(__builtin_shufflevector(h, h, 4, 5, 6, 7), f32x4); }
        else { v[2 * j] = __builtin_nontemporal_load((const GAS f32x4*)(xsrc + c)); v[2 * j + 1] = __builtin_nontemporal_load((const GAS f32x4*)(xsrc + c + 4)); } }
    if (MODE == 1) {
#pragma unroll
        for (int j = 0; j < 8; ++j) yr[j] = __builtin_nontemporal_load((const GAS v4u*)(Y + 8 * F.lane + 512 * j));
    }
#pragma unroll
    for (int q = 0; q < 16; ++q) { const int j = q >> 1, hf = q & 1;
        if (MODE == 1) { const unsigned w0 = hf ? yr[j].z : yr[j].x, w1 = hf ? yr[j].w : yr[j].y; const f32x4 y = {bflo(w0), bfhi(w0), bflo(w1), bfhi(w1)}, g = *(const LAS f32x4*)(L + LNV_GA + 512 * j + 4 * hf); v[q] = v[q] * ALPHA + g * y; }
        s += (v[q].x + v[q].y) + (v[q].z + v[q].w); }
    float mean = wave_sum(s) * (1.f / DM), s2 = 0.f;
#pragma unroll
    for (int q = 0; q < 16; ++q) { v[q] = v[q] - mean; s2 += (v[q].x * v[q].x + v[q].y * v[q].y) + (v[q].z * v[q].z + v[q].w * v[q].w); }
    float rstd = 1.f / sqrtf(wave_sum(s2) * (1.f / DM) + LN_EPS);
    if (MODE == 1) {
        s = 0.f;
#pragma unroll
        for (int j = 0; j < 8; ++j) { const int c = 8 * F.lane + 512 * j;
#pragma unroll
            for (int hf = 0; hf < 2; ++hf) { const int q = 2 * j + hf; const f32x4 g = *(const LAS f32x4*)(L + LNV_G + 512 * j + 4 * hf), b = *(const LAS f32x4*)(L + LNV_B + 512 * j + 4 * hf); v[q] = v[q] * rstd * g + b;
                s += (v[q].x + v[q].y) + (v[q].z + v[q].w); }
            if (XDH) { const h16x4 h0 = __builtin_convertvector(v[2 * j], h16x4), h1 = __builtin_convertvector(v[2 * j + 1], h16x4);
                __builtin_nontemporal_store(__builtin_shufflevector(h0, h1, 0, 1, 2, 3, 4, 5, 6, 7), (GAS h16x8*)(xdsth + c)); }
            else { __builtin_nontemporal_store(v[2 * j], (GAS f32x4*)(xdst + c)); __builtin_nontemporal_store(v[2 * j + 1], (GAS f32x4*)(xdst + c + 4)); } }
        if (!domod) return;
        mean = wave_sum(s) * (1.f / DM); s2 = 0.f;
#pragma unroll
        for (int q = 0; q < 16; ++q) { v[q] = v[q] - mean; s2 += (v[q].x * v[q].x + v[q].y * v[q].y) + (v[q].z * v[q].z + v[q].w * v[q].w); }
        rstd = 1.f / sqrtf(wave_sum(s2) * (1.f / DM) + LN_EPS);
    }
#pragma unroll
    for (int j = 0; j < 8; ++j) { const int c = 8 * F.lane + 512 * j; unsigned w[4];
#pragma unroll
        for (int hf = 0; hf < 2; ++hf) { const f32x4 a = *(const LAS f32x4*)(L + LNV_SC + 512 * j + 4 * hf), b = *(const LAS f32x4*)(L + LNV_SH + 512 * j + 4 * hf);
            const f32x4 o = v[2 * j + hf] * rstd * (a + 1.f) + b; w[2 * hf] = pk2(o.x, o.y); w[2 * hf + 1] = pk2(o.z, o.w); }
        *(GAS v4u*)(hrow + c) = (v4u){w[0], w[1], w[2], w[3]}; }
}

__device__ __forceinline__ void shift4(const bf16* P, unsigned eo, bool hp, bool hn, const float* mup, const float* mun, unsigned mo, float (&u)[4]) {
    const v2u xc = ldg<v2u>(P, eo * 2u); v2u xp = {0u, 0u}, xn = {0u, 0u};
    if (hp) xp = ldg<v2u>(P, (eo - DINP) * 2u); if (hn) xn = ldg<v2u>(P, (eo + DINP) * 2u);
    const f32x4 mp = ldg<f32x4>(mup, mo * 4u), mn = ldg<f32x4>(mun, mo * 4u);
    const float c[4] = {bflo(xc.x), bfhi(xc.x), bflo(xc.y), bfhi(xc.y)}, p[4] = {bflo(xp.x), bfhi(xp.x), bflo(xp.y), bfhi(xp.y)}, n[4] = {bflo(xn.x), bfhi(xn.x), bflo(xn.y), bfhi(xn.y)};
#pragma unroll
    for (int e = 0; e < 4; ++e) u[e] = c[e] + mp[e] * (p[e] - c[e]) + mn[e] * (n[e] - c[e]);
}
__device__ __forceinline__ void st4bf(void* base, unsigned eo, float a, float b, float c, float d) { v2u w; w.x = pk2(a, b); w.y = pk2(c, d); stg<v2u>(base, eo * 2u, w); }

__device__ __forceinline__ void rwkv_feat_item(Frame& F, int l, int item) {
    F.tid = ltid(); F.lane = F.tid & 63;
    int row0, seq_lo, seq_hi;
    if (item < 16) { const int b = item >> 3; seq_lo = M_LAT + b * NCTX; seq_hi = seq_lo + NCTX; row0 = seq_lo + (item & 7) * 32; }
    else { const int it = item - 16, b = it >> 8; seq_lo = b * SEQ; seq_hi = seq_lo + SEQ; row0 = seq_lo + (it & 255) * 32; }
    const bf16* P = (const bf16*)(F.ws + WS_P);
    LAS bf16* ACT = (LAS bf16*)F.lds;
    const float* mup = INP(I_MUP) + l * RWC; const float* mun = INP(I_MUN) + l * RWC;
    __syncthreads();
    { const int tok = F.tid >> 4, jc = F.tid & 15, row = row0 + tok; const bool hp = row > seq_lo, hn = row + 1 < seq_hi;
      const bf16* pr = P + (size_t)row * DINP + C_RWL;
#pragma unroll
      for (int i = 0; i < 13; ++i) { const int j = jc * 2 + 32 * i;
          const unsigned xc = *(const unsigned*)(pr + j), xp = hp ? *(const unsigned*)(pr - DINP + j) : 0u, xn = hn ? *(const unsigned*)(pr + DINP + j) : 0u;
          float u[2];
#pragma unroll
          for (int e = 0; e < 2; ++e) { const float c = e ? bfhi(xc) : bflo(xc), p = e ? bfhi(xp) : bflo(xp), n = e ? bfhi(xn) : bflo(xn);
              float v = c + mup[3072 + j + e] * (p - c) + mun[3072 + j + e] * (n - c);
              if (j < 128) v = tanhf_(v); else if (j >= 256) v = sigmoidf_(v);
              u[e] = v; }
          *(LAS unsigned*)(ACT + tok * 424 + j) = pk2(u[0], u[1]); } }
    __syncthreads();
    const int tok = F.lane & 31, hi = F.lane >> 5, row = row0 + tok;
    const bf16* W2T = (const bf16*)(F.wsw + WS_W2T); const bf16* A2T = (const bf16*)(F.wsw + WS_A2T); const bf16* G2T = (const bf16*)(F.wsw + WS_G2T);
    bf16* RWF = (bf16*)(F.ws + WS_RWF); const size_t RS = (size_t)M_TOT * 1024;
    const float* kkv = INP(I_KK) + l * 1024; const float* kav = INP(I_KA) + l * 1024; const float* rkv = INP(I_RK) + l * 1024;
    const float* w0f = INP(I_W0) + (size_t)(l * 2) * 1024; const float* a0f = INP(I_A0) + (size_t)(l * 2) * 1024;
    const LAS bf16* actl = ACT + tok * 424 + hi * 8;
    LAS unsigned char* TB = F.lds + 27136 + F.wave * 10880;
    LAS float* VB = (LAS float*)(F.lds + (F.wave < 4 ? 114176 + F.wave * 3328 : 131584 + (F.wave - 4) * 3328));
#define RF_LOADG(reg_, colbase) do { _Pragma("unroll") for (int i_ = 0; i_ < 3; ++i_) { const int p_ = F.lane + 64 * i_; reg_[i_] = (v4u){0u, 0u, 0u, 0u}; if (p_ < 136) { const int rr_ = p_ >> 2, cp_ = p_ & 3, gr_ = row0 - 1 + rr_; \
        if (gr_ >= seq_lo && gr_ < seq_hi) reg_[i_] = ldg<v4u>(P, ((unsigned)gr_ * DINP + (colbase) + 8 * cp_) * 2u); } } } while (0)
#define RF_STORET(ti, reg_) do { _Pragma("unroll") for (int i_ = 0; i_ < 3; ++i_) { const int p_ = F.lane + 64 * i_; if (p_ < 136) { const int rr_ = p_ >> 2, cp_ = p_ & 3; *(LAS v4u*)(TB + (ti) * 2720 + rr_ * 80 + cp_ * 16) = reg_[i_]; } } } while (0)
#define RF_SHIFT4(ti, g_, vb_, cc_, u_) do { const LAS unsigned char* q_ = TB + (ti) * 2720 + (tok + 1) * 80 + (8 * (g_) + 4 * hi) * 2; const v2u xc_ = *(const LAS v2u*)q_, xp_ = *(const LAS v2u*)(q_ - 80), xn_ = *(const LAS v2u*)(q_ + 80); \
        const f32x4 mp_ = *(const LAS f32x4*)(VB + (vb_) * 64 + (cc_)), mn_ = *(const LAS f32x4*)(VB + ((vb_) + 1) * 64 + (cc_)); \
        const float c_[4] = {bflo(xc_.x), bfhi(xc_.x), bflo(xc_.y), bfhi(xc_.y)}, pp_[4] = {bflo(xp_.x), bfhi(xp_.x), bflo(xp_.y), bfhi(xp_.y)}, nn_[4] = {bflo(xn_.x), bfhi(xn_.x), bflo(xn_.y), bfhi(xn_.y)}; \
        _Pragma("unroll") for (int e_ = 0; e_ < 4; ++e_) u_[e_] = c_[e_] + mp_[e_] * (pp_[e_] - c_[e_]) + mn_[e_] * (nn_[e_] - c_[e_]); } while (0)
#define RF_PUT(ti, o_) do { _Pragma("unroll") for (int g_ = 0; g_ < 4; ++g_) *(LAS v2u*)(TB + (ti) * 2720 + tok * 80 + (8 * g_ + 4 * hi) * 2) = o_[g_]; } while (0)
#define RF_FLUSH3(a0_, a1_, a2_, cblk_) do { asm volatile("s_waitcnt lgkmcnt(0)" ::: "memory"); \
        _Pragma("unroll") for (int t_ = 0; t_ < 3; ++t_) { const int arr_ = t_ == 0 ? (a0_) : (t_ == 1 ? (a1_) : (a2_)); \
            _Pragma("unroll") for (int i_ = 0; i_ < 2; ++i_) { const int p_ = F.lane + 64 * i_, rr_ = p_ >> 2, cp_ = p_ & 3; const v4u v_ = *(const LAS v4u*)(TB + t_ * 2720 + rr_ * 80 + cp_ * 16); \
                stg<v4u>(RWF + arr_ * RS, ((unsigned)(row0 + rr_) * 1024u + (cblk_) + 8 * cp_) * 2u, v_); } } \
        asm volatile("s_waitcnt lgkmcnt(0)" ::: "memory"); } while (0)
#pragma unroll 1
    for (int hh = 0; hh < 2; ++hh) {
        const int h = 2 * F.wave + hh, cbase = h * 64;
        float ssq = 0.f;
        { v4u t0[3], t1[3]; RF_LOADG(t0, C_RWK + cbase); RF_LOADG(t1, C_RWK + cbase + 32);
          const unsigned co = (cbase + F.lane) * 4u; float vv[13];
#pragma unroll
          for (int sct = 0; sct < 3; ++sct) { vv[2 * sct] = ldg<float>(mup, co + sct * 4096u); vv[2 * sct + 1] = ldg<float>(mun, co + sct * 4096u); }
          vv[6] = ldg<float>(kkv, co); vv[7] = ldg<float>(kav, co); vv[8] = ldg<float>(rkv, co); vv[9] = ldg<float>(a0f, co); vv[10] = ldg<float>(a0f, co + 4096u); vv[11] = ldg<float>(w0f, co); vv[12] = ldg<float>(w0f, co + 4096u);
          RF_STORET(0, t0); RF_STORET(1, t1);
#pragma unroll
          for (int q = 0; q < 13; ++q) VB[q * 64 + F.lane] = vv[q]; }
        asm volatile("s_waitcnt lgkmcnt(0)" ::: "memory");
#pragma unroll
        for (int bg = 0; bg < 8; ++bg) { const int cc = (bg >> 2) * 32 + 8 * (bg & 3) + 4 * hi; float uk[4];
            RF_SHIFT4(bg >> 2, bg & 3, 2, cc, uk); const f32x4 k4 = *(const LAS f32x4*)(VB + 6 * 64 + cc);
#pragma unroll
            for (int e = 0; e < 4; ++e) { const float q = uk[e] * k4[e]; ssq += q * q; } }
        ssq = half_swap_sum(ssq);
        const float rn = 1.f / fmaxf(sqrtf(ssq), 1e-12f);
        float sb = 0.f;
        asm volatile("s_waitcnt lgkmcnt(0)" ::: "memory");
#pragma unroll 1
        for (int blk = 0; blk < 2; ++blk) {
            const unsigned cblk = cbase + blk * 32, cha = cblk + tok;
            v4u gR[3], gK[3], gV[3];
            RF_LOADG(gR, C_RWR + cblk); RF_LOADG(gK, C_RWK + cblk); RF_LOADG(gV, C_RWV + cblk);
            bf16x8 wd[2][4], wg[10], wa[2][4];
#pragma unroll
            for (int d = 0; d < 2; ++d) {
#pragma unroll
                for (int ks = 0; ks < 4; ++ks) wd[d][ks] = ldg<bf16x8>(W2T, ((d * 1024 + cha) * 64 + ks * 16 + hi * 8) * 2u); }
#pragma unroll
            for (int ks = 0; ks < 10; ++ks) wg[ks] = ldg<bf16x8>(G2T, (cha * 192 + ks * 16 + hi * 8) * 2u);
#pragma unroll
            for (int d = 0; d < 2; ++d) {
#pragma unroll
                for (int ks = 0; ks < 4; ++ks) wa[d][ks] = ldg<bf16x8>(A2T, ((d * 1024 + cha) * 64 + ks * 16 + hi * 8) * 2u); }
#pragma unroll
            for (int d = 0; d < 2; ++d) { f32x16 aw = {};
#pragma unroll
                for (int ks = 0; ks < 4; ++ks) { const bf16x8 bw = *(const LAS bf16x8*)(actl + d * 64 + ks * 16);
                    aw = __builtin_amdgcn_mfma_f32_32x32x16_bf16(wd[d][ks], bw, aw, 0, 0, 0); }
                v2u o[4];
#pragma unroll
                for (int g = 0; g < 4; ++g) { const f32x4 w0 = *(const LAS f32x4*)(VB + (11 + d) * 64 + blk * 32 + 8 * g + 4 * hi); float e4[4];
#pragma unroll
                    for (int e = 0; e < 4; ++e) e4[e] = 0.60653065971f * sigmoidf_(w0[e] + aw[4 * g + e]);
                    o[g].x = pk2(e4[0], e4[1]); o[g].y = pk2(e4[2], e4[3]); }
                RF_PUT(d, o); }
            { f32x16 ag = {};
#pragma unroll
              for (int ks = 0; ks < 10; ++ks) { const bf16x8 bg_ = *(const LAS bf16x8*)(actl + 256 + ks * 16);
                  ag = __builtin_amdgcn_mfma_f32_32x32x16_bf16(wg[ks], bg_, ag, 0, 0, 0); }
              v2u o[4];
#pragma unroll
              for (int g = 0; g < 4; ++g) { o[g].x = pk2(ag[4 * g], ag[4 * g + 1]); o[g].y = pk2(ag[4 * g + 2], ag[4 * g + 3]); }
              RF_PUT(2, o); }
            RF_FLUSH3(4, 5, 8, cblk);
            RF_STORET(0, gR); RF_STORET(1, gK); RF_STORET(2, gV);
            { f32x16 aaf = {}, aab = {};
#pragma unroll
              for (int ks = 0; ks < 4; ++ks) { const bf16x8 baf = *(const LAS bf16x8*)(actl + 128 + ks * 16), bab = *(const LAS bf16x8*)(actl + 192 + ks * 16);
                  aaf = __builtin_amdgcn_mfma_f32_32x32x16_bf16(wa[0][ks], baf, aaf, 0, 0, 0); aab = __builtin_amdgcn_mfma_f32_32x32x16_bf16(wa[1][ks], bab, aab, 0, 0, 0); }
              v2u oR[4], oK[4], oV[4], oKK[4], oAF[4], oAB[4];
              asm volatile("s_waitcnt lgkmcnt(0)" ::: "memory");
#pragma unroll
              for (int g = 0; g < 4; ++g) { const int cc = blk * 32 + 8 * g + 4 * hi; float ur[4], uk[4], uv[4];
                  RF_SHIFT4(0, g, 0, cc, ur); RF_SHIFT4(1, g, 2, cc, uk); RF_SHIFT4(2, g, 4, cc, uv);
                  const f32x4 a0a = *(const LAS f32x4*)(VB + 9 * 64 + cc), a0b = *(const LAS f32x4*)(VB + 10 * 64 + cc), kk4 = *(const LAS f32x4*)(VB + 6 * 64 + cc), ka4 = *(const LAS f32x4*)(VB + 7 * 64 + cc), rk4 = *(const LAS f32x4*)(VB + 8 * 64 + cc);
                  float af[4], ab[4], kk[4];
#pragma unroll
                  for (int e = 0; e < 4; ++e) { const int r = 4 * g + e;
                      af[e] = sigmoidf_(a0a[e] + aaf[r]); ab[e] = sigmoidf_(a0b[e] + aab[r]); kk[e] = uk[e] * kk4[e] * rn;
                      const float kdf = uk[e] * (1.f + (af[e] - 1.f) * ka4[e]), kdb = uk[e] * (1.f + (ab[e] - 1.f) * ka4[e]);
                      sb += ur[e] * rk4[e] * (kdf + kdb); }
                  oR[g].x = pk2(ur[0], ur[1]); oR[g].y = pk2(ur[2], ur[3]); oK[g].x = pk2(uk[0], uk[1]); oK[g].y = pk2(uk[2], uk[3]); oV[g].x = pk2(uv[0], uv[1]); oV[g].y = pk2(uv[2], uv[3]);
                  oKK[g].x = pk2(kk[0], kk[1]); oKK[g].y = pk2(kk[2], kk[3]); oAF[g].x = pk2(af[0], af[1]); oAF[g].y = pk2(af[2], af[3]); oAB[g].x = pk2(ab[0], ab[1]); oAB[g].y = pk2(ab[2], ab[3]); }
              asm volatile("s_waitcnt lgkmcnt(0)" ::: "memory");
              RF_PUT(0, oR); RF_PUT(1, oK); RF_PUT(2, oV); RF_FLUSH3(0, 1, 2, cblk);
              RF_PUT(0, oKK); RF_PUT(1, oAF); RF_PUT(2, oAB); RF_FLUSH3(3, 6, 7, cblk); }
        }
        sb = half_swap_sum(sb);
        if (hi == 0) ((float*)(F.ws + WS_SB))[(size_t)row * 16 + h] = sb;
    }
#undef RF_LOADG
#undef RF_STORET
#undef RF_SHIFT4
#undef RF_PUT
#undef RF_FLUSH3
}

__device__ __forceinline__ float gelu_tanh(float x) { return 0.5f * x * (1.f + tanhf_(0.7978845608028654f * (x + 0.044715f * x * x * x))); }
template <bool PASS3>
__device__ __forceinline__ void lru_item(Frame& F, int l, int item) {
    F.tid = ltid(); F.lane = F.tid & 63;
    const int sc = item >> 3, nb = item & 7, b = sc / NCH, ch = sc % NCH;
    int row0, seq_lo, seq_hi;
    if (ch < 8) { seq_lo = M_LAT + b * NCTX; seq_hi = seq_lo + NCTX; row0 = seq_lo + ch * 32; }
    else { seq_lo = b * SEQ; seq_hi = seq_lo + SEQ; row0 = seq_lo + (ch - 8) * 32; }
    const bf16* P = (const bf16*)(F.ws + WS_P);
    LAS float* U = (LAS float*)F.lds;
    LAS bf16* UA = (LAS bf16*)(F.lds + 16384);
    LAS float* AB = (LAS float*)(F.lds + 32768);
    __syncthreads();
    { const int tok = F.tid >> 4, c8 = (F.tid & 15) * 8, cg = nb * 128 + c8; float acc[8];
      const float* cb = INP(I_CONVB) + l * 1024 + cg;
#pragma unroll
      for (int e = 0; e < 8; ++e) acc[e] = cb[e];
#pragma unroll
      for (int j = 0; j < 4; ++j) { const int r = row0 + tok - 2 + j;
          if (r >= seq_lo && r < seq_hi) { const v4u x = *(const v4u*)(P + (size_t)r * DINP + C_LRUX + cg); const float* cw = INP(I_CONVW) + (size_t)(l * 4 + j) * 1024 + cg;
#pragma unroll
              for (int w = 0; w < 4; ++w) { acc[2 * w] += cw[2 * w] * bflo(x[w]); acc[2 * w + 1] += cw[2 * w + 1] * bfhi(x[w]); } } }
      *(LAS f32x4*)(U + tok * 128 + c8) = (f32x4){acc[0], acc[1], acc[2], acc[3]}; *(LAS f32x4*)(U + tok * 128 + c8 + 4) = (f32x4){acc[4], acc[5], acc[6], acc[7]};
      v4u o; o.x = pk2(acc[0], acc[1]); o.y = pk2(acc[2], acc[3]); o.z = pk2(acc[4], acc[5]); o.w = pk2(acc[6], acc[7]);
      *(LAS v4u*)(UA + tok * 136 + c8) = o; }
    __syncthreads();
    { const int dir = F.wave >> 2, cq = F.wave & 3, l32 = F.lane & 31, hi = F.lane >> 5, chn = cq * 32 + l32, cg = nb * 128 + chn;
      const bf16* Wr = (const bf16*)(F.wsw + WS_WLRU) + ((size_t)(dir * 2 + 0) * 8 + nb) * 16384 + (size_t)chn * 128;
      const bf16* Wi = (const bf16*)(F.wsw + WS_WLRU) + ((size_t)(dir * 2 + 1) * 8 + nb) * 16384 + (size_t)chn * 128;
      f32x16 accr = {}, acci = {};
#pragma unroll
      for (int ks = 0; ks < 8; ++ks) { const int ko = ks * 16 + hi * 8;
          const bf16x8 a = *(const LAS bf16x8*)(UA + l32 * 136 + ko); const bf16x8 br = *(const bf16x8*)(Wr + ko), bi = *(const bf16x8*)(Wi + ko);
          accr = __builtin_amdgcn_mfma_f32_32x32x16_bf16(a, br, accr, 0, 0, 0); acci = __builtin_amdgcn_mfma_f32_32x32x16_bf16(a, bi, acci, 0, 0, 0); }
      const float ba = INP(I_LBA)[(l * 2 + dir) * 1024 + cg], bi_ = INP(I_LBI)[(l * 2 + dir) * 1024 + cg], sp = softplusf_(-INP(I_LAM)[(l * 2 + dir) * 1024 + cg]);
#pragma unroll
      for (int r = 0; r < 16; ++r) { const int tok = att::crow(r, hi); const float u = U[tok * 128 + chn];
          const float rg = sigmoidf_(accr[r] + ba), ig = sigmoidf_(acci[r] + bi_), la = -8.f * rg * sp, a = __expf(la), x2 = 2.f * la;
          const float em = x2 * (1.f + x2 * (0.5f + x2 * (0.16666667f + x2 * (0.041666668f + x2 * (0.0083333338f + x2 * 0.0013888889f)))));
          const float bc = __builtin_amdgcn_sqrtf(x2 < -0.5f ? 1.f - a * a : -em) * (ig * u);
          AB[(dir * 2 + 0) * 4096 + tok * 128 + chn] = a; AB[(dir * 2 + 1) * 4096 + tok * 128 + chn] = bc; } }
    __syncthreads();
    if (F.tid < 256) { const int dir = F.tid >> 7, chn = F.tid & 127, cg = nb * 128 + chn; const size_t ci = ((size_t)(dir * 2 + b) * NCH + ch) * 1024 + cg;
        LAS float* Aa = AB + (dir * 2) * 4096 + chn; LAS float* Bb = AB + (dir * 2 + 1) * 4096 + chn;
        if (!PASS3) { float h = 0.f, ap = 1.f;
#pragma unroll 8
            for (int s = 0; s < 32; ++s) { const int tok = dir ? 31 - s : s; const float a = Aa[tok * 128]; h = a * h + Bb[tok * 128]; ap *= a;
                if (s == 0 && dir == 1 && ch == 7) ((float*)(F.ws + WS_QUIRK))[b * 1024 + cg] = h; }
            ((float*)(F.ws + WS_CA))[ci] = ap; ((float*)(F.ws + WS_CB))[ci] = h;
        } else { float h = ((const float*)(F.ws + WS_HIN))[ci];
#pragma unroll 8
            for (int s = 0; s < 32; ++s) { const int tok = dir ? 31 - s : s; h = Aa[tok * 128] * h + Bb[tok * 128]; Bb[tok * 128] = h; } } }
    if (PASS3) { __syncthreads();
        const int tok = F.tid >> 4, c8 = (F.tid & 15) * 8, cg = nb * 128 + c8, row = row0 + tok;
        const v4u y = *(const v4u*)(P + (size_t)row * DINP + C_LRUY + cg); float o[8];
#pragma unroll
        for (int w = 0; w < 4; ++w) { const float h0 = AB[4096 + tok * 128 + c8 + 2 * w] + AB[3 * 4096 + tok * 128 + c8 + 2 * w], h1 = AB[4096 + tok * 128 + c8 + 2 * w + 1] + AB[3 * 4096 + tok * 128 + c8 + 2 * w + 1];
            o[2 * w] = h0 * gelu_tanh(bflo(y[w])); o[2 * w + 1] = h1 * gelu_tanh(bfhi(y[w])); }
        v4u ov; ov.x = pk2(o[0], o[1]); ov.y = pk2(o[2], o[3]); ov.z = pk2(o[4], o[5]); ov.w = pk2(o[6], o[7]);
        *(v4u*)((bf16*)(F.ws + WS_MIX) + (size_t)row * DM + 1024 + cg) = ov; }
}
template <bool PASS3>
__device__ __forceinline__ void lru_items(Frame& F, int l, int i0, int i1, int st, bool skipctx) {
    F.tid = ltid(); F.lane = F.tid & 63;
    int it = i0; while (it < i1 && skipctx && ((it >> 3) % NCH) < 8) it += st;
    if (it >= i1) return;
    const int nb = it & 7;
    const bf16* P = (const bf16*)(F.ws + WS_P);
    LAS float* U = (LAS float*)F.lds; LAS bf16* UA = (LAS bf16*)(F.lds + 16384); LAS float* AB = (LAS float*)(F.lds + 32768);
    const int tokc = F.tid >> 4, c8 = (F.tid & 15) * 8, cgc = nb * 128 + c8;
    const int dir = F.wave >> 2, cq = F.wave & 3, l32 = F.lane & 31, hi = F.lane >> 5, chn = cq * 32 + l32, cg = nb * 128 + chn;
    f32x4 cbv[2], cwv[4][2];
#pragma unroll
    for (int q = 0; q < 2; ++q) { cbv[q] = *(const f32x4*)(INP(I_CONVB) + l * 1024 + cgc + 4 * q);
#pragma unroll
        for (int j = 0; j < 4; ++j) cwv[j][q] = *(const f32x4*)(INP(I_CONVW) + (size_t)(l * 4 + j) * 1024 + cgc + 4 * q); }
    bf16x8 wr[8], wi[8];
    { const bf16* Wr = (const bf16*)(F.wsw + WS_WLRU) + ((size_t)(dir * 2 + 0) * 8 + nb) * 16384 + (size_t)chn * 128;
      const bf16* Wi = (const bf16*)(F.wsw + WS_WLRU) + ((size_t)(dir * 2 + 1) * 8 + nb) * 16384 + (size_t)chn * 128;
#pragma unroll
      for (int ks = 0; ks < 8; ++ks) { wr[ks] = *(const bf16x8*)(Wr + ks * 16 + hi * 8); wi[ks] = *(const bf16x8*)(Wi + ks * 16 + hi * 8); } }
    const float ba = INP(I_LBA)[(l * 2 + dir) * 1024 + cg], bi_ = INP(I_LBI)[(l * 2 + dir) * 1024 + cg], sp = softplusf_(-INP(I_LAM)[(l * 2 + dir) * 1024 + cg]);
    v4u xr[4];
#define LRU_LOADX(it_) do { const int sc_ = (it_) >> 3, b_ = sc_ / NCH, ch_ = sc_ % NCH; const int lo_ = ch_ < 8 ? M_LAT + b_ * NCTX : b_ * SEQ, hi_ = lo_ + (ch_ < 8 ? NCTX : SEQ), r0_ = lo_ + (ch_ < 8 ? ch_ : ch_ - 8) * 32; \
        _Pragma("unroll") for (int j_ = 0; j_ < 4; ++j_) { const int r_ = r0_ + tokc - 2 + j_; xr[j_] = (v4u){0u, 0u, 0u, 0u}; if (r_ >= lo_ && r_ < hi_) xr[j_] = *(const v4u*)(P + (size_t)r_ * DINP + C_LRUX + cgc); } } while (0)
    LRU_LOADX(it);
#pragma unroll 1
    for (;;) {
        const int sc = it >> 3, b = sc / NCH, ch = sc % NCH;
        const int row0 = ch < 8 ? M_LAT + b * NCTX + ch * 32 : b * SEQ + (ch - 8) * 32;
        __syncthreads();
        { float acc[8];
#pragma unroll
          for (int e = 0; e < 8; ++e) acc[e] = cbv[e >> 2][e & 3];
#pragma unroll
          for (int j = 0; j < 4; ++j) {
#pragma unroll
              for (int w = 0; w < 4; ++w) { acc[2 * w] += cwv[j][(2 * w) >> 2][(2 * w) & 3] * bflo(xr[j][w]); acc[2 * w + 1] += cwv[j][(2 * w + 1) >> 2][(2 * w + 1) & 3] * bfhi(xr[j][w]); } }
          *(LAS f32x4*)(U + tokc * 128 + c8) = (f32x4){acc[0], acc[1], acc[2], acc[3]}; *(LAS f32x4*)(U + tokc * 128 + c8 + 4) = (f32x4){acc[4], acc[5], acc[6], acc[7]};
          v4u o; o.x = pk2(acc[0], acc[1]); o.y = pk2(acc[2], acc[3]); o.z = pk2(acc[4], acc[5]); o.w = pk2(acc[6], acc[7]);
          *(LAS v4u*)(UA + tokc * 136 + c8) = o; }
        int itn = it + st; while (itn < i1 && skipctx && ((itn >> 3) % NCH) < 8) itn += st;
        if (itn < i1) LRU_LOADX(itn);
        __syncthreads();
        { f32x16 accr = {}, acci = {};
#pragma unroll
          for (int ks = 0; ks < 8; ++ks) { const bf16x8 a = *(const LAS bf16x8*)(UA + l32 * 136 + ks * 16 + hi * 8);
              accr = __builtin_amdgcn_mfma_f32_32x32x16_bf16(a, wr[ks], accr, 0, 0, 0); acci = __builtin_amdgcn_mfma_f32_32x32x16_bf16(a, wi[ks], acci, 0, 0, 0); }
#pragma unroll
          for (int r = 0; r < 16; ++r) { const int tok = att::crow(r, hi); const float u = U[tok * 128 + chn];
              const float rg = sigmoidf_(accr[r] + ba), ig = sigmoidf_(acci[r] + bi_), la = -8.f * rg * sp, a = __expf(la), x2 = 2.f * la;
              const float em = x2 * (1.f + x2 * (0.5f + x2 * (0.16666667f + x2 * (0.041666668f + x2 * (0.0083333338f + x2 * 0.0013888889f)))));
              const float bc = __builtin_amdgcn_sqrtf(x2 < -0.5f ? 1.f - a * a : -em) * (ig * u);
              AB[(dir * 2 + 0) * 4096 + tok * 128 + chn] = a; AB[(dir * 2 + 1) * 4096 + tok * 128 + chn] = bc; } }
        __syncthreads();
        if (F.tid < 256) { const int dr = F.tid >> 7, cn = F.tid & 127, cgs = nb * 128 + cn; const size_t ci = ((size_t)(dr * 2 + b) * NCH + ch) * 1024 + cgs;
            LAS float* Aa = AB + (dr * 2) * 4096 + cn; LAS float* Bb = AB + (dr * 2 + 1) * 4096 + cn;
            if (!PASS3) { float h = 0.f, ap = 1.f;
#pragma unroll 8
                for (int s = 0; s < 32; ++s) { const int tok = dr ? 31 - s : s; const float a = Aa[tok * 128]; h = a * h + Bb[tok * 128]; ap *= a;
                    if (s == 0 && dr == 1 && ch == 7) ((float*)(F.ws + WS_QUIRK))[b * 1024 + cgs] = h; }
                ((float*)(F.ws + WS_CA))[ci] = ap; ((float*)(F.ws + WS_CB))[ci] = h;
            } else { float h = ((const float*)(F.ws + WS_HIN))[ci];
#pragma unroll 8
                for (int s = 0; s < 32; ++s) { const int tok = dr ? 31 - s : s; h = Aa[tok * 128] * h + Bb[tok * 128]; Bb[tok * 128] = h; } } }
        if (PASS3) { __syncthreads();
            const int cgo = nb * 128 + c8, row = row0 + tokc;
            const v4u y = *(const v4u*)(P + (size_t)row * DINP + C_LRUY + cgo); float o[8];
#pragma unroll
            for (int w = 0; w < 4; ++w) { const float h0 = AB[4096 + tokc * 128 + c8 + 2 * w] + AB[3 * 4096 + tokc * 128 + c8 + 2 * w], h1 = AB[4096 + tokc * 128 + c8 + 2 * w + 1] + AB[3 * 4096 + tokc * 128 + c8 + 2 * w + 1];
                o[2 * w] = h0 * gelu_tanh(bflo(y[w])); o[2 * w + 1] = h1 * gelu_tanh(bfhi(y[w])); }
            v4u ov; ov.x = pk2(o[0], o[1]); ov.y = pk2(o[2], o[3]); ov.z = pk2(o[4], o[5]); ov.w = pk2(o[6], o[7]);
            *(v4u*)((bf16*)(F.ws + WS_MIX) + (size_t)row * DM + 1024 + cgo) = ov; }
        if (itn >= i1) break;
        it = itn;
    }
#undef LRU_LOADX
}
__device__ __forceinline__ void lru_carry(Frame& F, int blk) {
    F.tid = ltid(); F.lane = F.tid & 63;
    const int gid = blk * NTHR + F.tid; if (gid >= 4096) return;
    const int dir = gid >> 11, b = (gid >> 10) & 1, cg = gid & 1023;
    const float* CA = (const float*)(F.ws + WS_CA) + ((size_t)(dir * 2 + b) * NCH) * 1024 + cg; const float* CB = (const float*)(F.ws + WS_CB) + ((size_t)(dir * 2 + b) * NCH) * 1024 + cg;
    float* HIN = (float*)(F.ws + WS_HIN) + ((size_t)(dir * 2 + b) * NCH) * 1024 + cg;
    float h = 0.f;
    if (dir == 0) {
#pragma unroll 8
        for (int c = 0; c < NCH; ++c) { HIN[(size_t)c * 1024] = h; h = CA[(size_t)c * 1024] * h + CB[(size_t)c * 1024]; }
    } else {
        for (int c = 7; c >= 0; --c) { HIN[(size_t)c * 1024] = h; h = CA[(size_t)c * 1024] * h + CB[(size_t)c * 1024]; }
        h = ((const float*)(F.ws + WS_QUIRK))[b * 1024 + cg];
#pragma unroll 8
        for (int c = NCH - 1; c >= 8; --c) { HIN[(size_t)c * 1024] = h; h = CA[(size_t)c * 1024] * h + CB[(size_t)c * 1024]; }
    }
}

__device__ __forceinline__ void rope_table(Frame& F) {
    const int i = F.vcu * NTHR + F.tid; if (i >= 2048) return;
    const int pos = i >> 4, f = i & 15; float s, c; sincosf((float)pos * exp2f(-(float)f * (13.287712379549449f / 16.f)), &s, &c);
    float* t = (float*)(F.ws + WS_ROPE); t[i] = c; t[2048 + i] = s;
}
__device__ __forceinline__ void row_prep(Frame& F, int row) {
    F.tid = ltid(); F.lane = F.tid & 63;
    bf16* pr = (bf16*)(F.ws + WS_P) + (size_t)row * DINP; const int lane = F.lane;
    const bool lat = row < M_LAT; const int t = row & (SEQ - 1); const float prow = (float)(t >> 6), pcol = (float)(t & 63);
    { const v4u a = *(const v4u*)(pr + C_QA + lane * 16), b = *(const v4u*)(pr + C_QA + lane * 16 + 8); float ss = 0.f;
#pragma unroll
      for (int w = 0; w < 4; ++w) { const float x0 = bflo(a[w]), x1 = bfhi(a[w]), x2 = bflo(b[w]), x3 = bfhi(b[w]); ss += x0 * x0 + x1 * x1 + x2 * x2 + x3 * x3; }
      ss = wave_sum(ss); if (lane == 0) ((float*)(F.ws + WS_RSQ))[row] = 1.f / sqrtf(ss * (1.f / 1024.f) + RMS_EPS); }
    { const v4u a = *(const v4u*)(pr + C_KVA + lane * 8); float ss = 0.f;
#pragma unroll
      for (int w = 0; w < 4; ++w) { const float x0 = bflo(a[w]), x1 = bfhi(a[w]); ss += x0 * x0 + x1 * x1; }
      ss = wave_sum(ss); if (lane == 0) ((float*)(F.ws + WS_RSKV))[row] = 1.f / sqrtf(ss * (1.f / 512.f) + RMS_EPS); }
    bf16* kr = (bf16*)(F.ws + WS_KR) + (size_t)row * 64;
    if (lat) {
        { const int part = lane >> 5, sub = lane & 31;
          const float inv = exp2f(-(float)sub * (13.287712379549449f / 32.f)); float sn, cs; sincosf((part ? pcol : prow) * inv, &sn, &cs);
#pragma unroll
          for (int hd = 0; hd < 10; ++hd) { bf16* qb = pr + (hd < 8 ? C_SWAQ + hd * 128 : C_SWAK + (hd - 8) * 128) + part * 64;
              const float x1 = bf2f(qb[sub]), x2 = bf2f(qb[sub + 32]); qb[sub] = (bf16)f2bf(x1 * cs - x2 * sn); qb[sub + 32] = (bf16)f2bf(x2 * cs + x1 * sn); } }
        if (lane < 32) { const int part = lane >> 4, i = lane & 15; const bf16* src = pr + C_KR + part * 32;
          const float inv = exp2f(-(float)i * (13.287712379549449f / 16.f)); float s, c; sincosf((part ? pcol : prow) * inv, &s, &c);
          const float x1 = bf2f(src[i]), x2 = bf2f(src[i + 16]);
          kr[part * 32 + i] = (bf16)f2bf(x1 * c - x2 * s); kr[part * 32 + i + 16] = (bf16)f2bf(x2 * c + x1 * s); }
    } else kr[lane] = pr[C_KR + lane];
}

__device__ __forceinline__ float allred16(float x) { return row_sum16(x); }
__device__ __forceinline__ int scan_row(int s, int dir, int b) {
    if (s < NCTX) return M_LAT + b * NCTX + (dir ? NCTX - 1 - s : s);
    const int t = s - NCTX; return b * SEQ + (dir ? SEQ - 1 - t : t);
}
__device__ __forceinline__ void rwkv_scan(Frame& F, int l, int chain) {
    F.tid = ltid(); F.lane = F.tid & 63;
    const int dir = chain >> 5, b = (chain >> 4) & 1, h = chain & 15;
    constexpr int CT = 24, NCHK = (NCTX + SEQ) / CT, STEPF = 392, BUFF = CT * STEPF;
    LAS float* buf = (LAS float*)F.lds; LAS float* ybuf = (LAS float*)(F.lds + 3 * BUFF * 4);
    gcbf RWF = (gcbf)(F.ws + WS_RWF); const size_t RS = (size_t)M_TOT * 1024;
    gflp YS = (gflp)(F.ws + WS_YS) + (size_t)dir * M_TOT * 1024;
    const bool cmp = F.wave < 4; const int lt = F.tid - 256, lst = lt >> 4, lq = lt & 15, lc = h * 64 + 4 * lq;
    const f32x4 ka4 = *(const GAS f32x4*)((gcfl)INP(I_KA) + l * 1024 + (cmp ? 0 : lc));
    v2u gr[2], gk[2], gv[2], gkk[2], ge[2], ga[2];
#pragma unroll
    for (int u = 0; u < 2; ++u) { gr[u] = (v2u){0u, 0u}; gk[u] = gr[u]; gv[u] = gr[u]; gkk[u] = gr[u]; ge[u] = gr[u]; ga[u] = gr[u]; }
#define RW_LOAD(c) do { if (!cmp) { _Pragma("unroll") for (int u_ = 0; u_ < 2; ++u_) { const int s_ = lst + 16 * u_; if (s_ < CT) { const size_t o_ = (size_t)scan_row((c) * CT + s_, dir, b) * 1024 + lc; \
        gr[u_] = *(const GAS v2u*)(RWF + 0 * RS + o_); gk[u_] = *(const GAS v2u*)(RWF + 1 * RS + o_); gv[u_] = *(const GAS v2u*)(RWF + 2 * RS + o_); \
        gkk[u_] = *(const GAS v2u*)(RWF + 3 * RS + o_); ge[u_] = *(const GAS v2u*)(RWF + (4 + dir) * RS + o_); ga[u_] = *(const GAS v2u*)(RWF + (6 + dir) * RS + o_); } } } } while (0)
#define RW_WRITE(bi) do { if (!cmp) { _Pragma("unroll") for (int u_ = 0; u_ < 2; ++u_) { const int s_ = lst + 16 * u_; if (s_ < CT) { LAS float* d_ = buf + (bi) * BUFF + s_ * STEPF + 4 * lq; \
        const float r_[4] = {bflo(gr[u_].x), bfhi(gr[u_].x), bflo(gr[u_].y), bfhi(gr[u_].y)}, k_[4] = {bflo(gk[u_].x), bfhi(gk[u_].x), bflo(gk[u_].y), bfhi(gk[u_].y)}, v_[4] = {bflo(gv[u_].x), bfhi(gv[u_].x), bflo(gv[u_].y), bfhi(gv[u_].y)}; \
        const float q_[4] = {bflo(gkk[u_].x), bfhi(gkk[u_].x), bflo(gkk[u_].y), bfhi(gkk[u_].y)}, e_[4] = {bflo(ge[u_].x), bfhi(ge[u_].x), bflo(ge[u_].y), bfhi(ge[u_].y)}, a_[4] = {bflo(ga[u_].x), bfhi(ga[u_].x), bflo(ga[u_].y), bfhi(ga[u_].y)}; \
        f32x4 w4, kd4, kk4, b4, wr4, v4; float sbr = 0.f, skr = 0.f; \
        _Pragma("unroll") for (int e = 0; e < 4; ++e) { w4[e] = __expf(-e_[e]); kd4[e] = k_[e] * (1.f + (a_[e] - 1.f) * ka4[e]); kk4[e] = q_[e]; b4[e] = q_[e] * a_[e]; wr4[e] = w4[e] * r_[e]; v4[e] = v_[e]; sbr += b4[e] * r_[e]; skr += kd4[e] * r_[e]; } \
        sbr = row_sum16(sbr); skr = row_sum16(skr); \
        *(LAS f32x4*)(d_) = w4; *(LAS f32x4*)(d_ + 64) = kd4; *(LAS f32x4*)(d_ + 128) = kk4; *(LAS f32x4*)(d_ + 192) = b4; *(LAS f32x4*)(d_ + 256) = wr4; *(LAS f32x4*)(d_ + 320) = v4; \
        if (lq == 0) *(LAS f32x2*)(buf + (bi) * BUFF + s_ * STEPF + 384) = (f32x2){sbr, skr}; } } } } while (0)
#define RW_FLUSH(c) do { if (!cmp) { _Pragma("unroll") for (int u_ = 0; u_ < 2; ++u_) { const int s_ = lst + 16 * u_; if (s_ < CT) { const f32x4 y_ = *(const LAS f32x4*)(ybuf + ((c) & 1) * (CT * 64) + s_ * 64 + 4 * lq); \
        *(GAS f32x4*)(YS + (size_t)scan_row((c) * CT + s_, dir, b) * 1024 + lc) = y_; } } } } while (0)
    __syncthreads();
    RW_LOAD(0); RW_WRITE(0); RW_LOAD(1); RW_WRITE(1); RW_LOAD(2);
    __syncthreads();
    const int kg = F.lane & 7, rg = F.lane >> 3, r0 = 16 * (F.wave & 3) + 2 * rg;
    f32x2 St[8];
#pragma unroll
    for (int i = 0; i < 8; ++i) St[i] = (f32x2){0.f, 0.f};
    int bc = 0, bw = 2;
#pragma unroll 1
    for (int c = 0; c < NCHK; ++c) {
        if (c + 2 < NCHK) { RW_WRITE(bw); if (c + 3 < NCHK) RW_LOAD(c + 3); }
        if (c > 0) RW_FLUSH(c - 1);
        if (cmp) {
        const LAS float* bb = buf + bc * BUFF + 8 * kg; const LAS float* vb = buf + bc * BUFF + 320 + r0; const LAS float* sb = buf + bc * BUFF + 384;
        LAS float* yb = ybuf + (c & 1) * (CT * 64) + r0;
        f32x4 w4[2], kd4[2], kk4[2], b4[2], wr4[2];
#pragma unroll
        for (int q = 0; q < 2; ++q) { w4[q] = *(const LAS f32x4*)(bb + 4 * q); kd4[q] = *(const LAS f32x4*)(bb + 64 + 4 * q); kk4[q] = *(const LAS f32x4*)(bb + 128 + 4 * q); b4[q] = *(const LAS f32x4*)(bb + 192 + 4 * q); wr4[q] = *(const LAS f32x4*)(bb + 256 + 4 * q); }
        f32x2 v2 = *(const LAS f32x2*)(vb), s2 = *(const LAS f32x2*)(sb);
#pragma unroll
        for (int st = 0; st < CT; ++st) {
            const int sn = (st + 1 < CT ? st + 1 : st) * STEPF;
            f32x4 nw4[2], nkd4[2], nkk4[2], nb4[2], nwr4[2];
#pragma unroll
            for (int q = 0; q < 2; ++q) { nw4[q] = *(const LAS f32x4*)(bb + sn + 4 * q); nkd4[q] = *(const LAS f32x4*)(bb + sn + 64 + 4 * q); nkk4[q] = *(const LAS f32x4*)(bb + sn + 128 + 4 * q); nb4[q] = *(const LAS f32x4*)(bb + sn + 192 + 4 * q); nwr4[q] = *(const LAS f32x4*)(bb + sn + 256 + 4 * q); }
            const f32x2 nv2 = *(const LAS f32x2*)(vb + sn), ns2 = *(const LAS f32x2*)(sb + sn);
#define PR(x, e) ((((e) >> 1) & 1) ? (f32x2){(x)[(e) >> 2][2], (x)[(e) >> 2][3]} : (f32x2){(x)[(e) >> 2][0], (x)[(e) >> 2][1]})
            f32x2 p, z, tpb, tzb;
            asm("v_pk_mul_f32 %0, %4, %12 op_sel:[0,0] op_sel_hi:[1,0]\n\tv_pk_mul_f32 %1, %4, %16 op_sel:[0,0] op_sel_hi:[1,0]\n\tv_pk_mul_f32 %2, %8, %14 op_sel:[0,0] op_sel_hi:[1,0]\n\tv_pk_mul_f32 %3, %8, %18 op_sel:[0,0] op_sel_hi:[1,0]\n\tv_pk_fma_f32 %0, %5, %12, %0 op_sel:[0,1,0] op_sel_hi:[1,1,1]\n\tv_pk_fma_f32 %1, %5, %16, %1 op_sel:[0,1,0] op_sel_hi:[1,1,1]\n\tv_pk_fma_f32 %2, %9, %14, %2 op_sel:[0,1,0] op_sel_hi:[1,1,1]\n\tv_pk_fma_f32 %3, %9, %18, %3 op_sel:[0,1,0] op_sel_hi:[1,1,1]\n\tv_pk_fma_f32 %0, %6, %13, %0 op_sel:[0,0,0] op_sel_hi:[1,0,1]\n\tv_pk_fma_f32 %1, %6, %17, %1 op_sel:[0,0,0] op_sel_hi:[1,0,1]\n\tv_pk_fma_f32 %2, %10, %15, %2 op_sel:[0,0,0] op_sel_hi:[1,0,1]\n\tv_pk_fma_f32 %3, %10, %19, %3 op_sel:[0,0,0] op_sel_hi:[1,0,1]\n\tv_pk_fma_f32 %0, %7, %13, %0 op_sel:[0,1,0] op_sel_hi:[1,1,1]\n\tv_pk_fma_f32 %1, %7, %17, %1 op_sel:[0,1,0] op_sel_hi:[1,1,1]\n\tv_pk_fma_f32 %2, %11, %15, %2 op_sel:[0,1,0] op_sel_hi:[1,1,1]\n\tv_pk_fma_f32 %3, %11, %19, %3 op_sel:[0,1,0] op_sel_hi:[1,1,1]\n\tv_pk_add_f32 %0, %0, %2\n\tv_pk_add_f32 %1, %1, %3\n\tv_pk_mul_f32 %4, %4, %20 op_sel:[0,0] op_sel_hi:[1,0]\n\tv_pk_mul_f32 %5, %5, %20 op_sel:[0,1] op_sel_hi:[1,1]\n\tv_pk_mul_f32 %6, %6, %21 op_sel:[0,0] op_sel_hi:[1,0]\n\tv_pk_mul_f32 %7, %7, %21 op_sel:[0,1] op_sel_hi:[1,1]\n\tv_pk_mul_f32 %8, %8, %22 op_sel:[0,0] op_sel_hi:[1,0]\n\tv_pk_mul_f32 %9, %9, %22 op_sel:[0,1] op_sel_hi:[1,1]\n\tv_pk_mul_f32 %10, %10, %23 op_sel:[0,0] op_sel_hi:[1,0]\n\tv_pk_mul_f32 %11, %11, %23 op_sel:[0,1] op_sel_hi:[1,1]\n\tv_pk_fma_f32 %4, %28, %24, %4 op_sel:[0,0,0] op_sel_hi:[1,0,1]\n\tv_pk_fma_f32 %5, %28, %24, %5 op_sel:[0,1,0] op_sel_hi:[1,1,1]\n\tv_pk_fma_f32 %6, %28, %25, %6 op_sel:[0,0,0] op_sel_hi:[1,0,1]\n\tv_pk_fma_f32 %7, %28, %25, %7 op_sel:[0,1,0] op_sel_hi:[1,1,1]\n\tv_pk_fma_f32 %8, %28, %26, %8 op_sel:[0,0,0] op_sel_hi:[1,0,1]\n\tv_pk_fma_f32 %9, %28, %26, %9 op_sel:[0,1,0] op_sel_hi:[1,1,1]\n\tv_pk_fma_f32 %10, %28, %27, %10 op_sel:[0,0,0] op_sel_hi:[1,0,1]\n\tv_pk_fma_f32 %11, %28, %27, %11 op_sel:[0,1,0] op_sel_hi:[1,1,1]"
                : "=&v"(p), "=&v"(z), "=&v"(tpb), "=&v"(tzb), "+v"(St[0]), "+v"(St[1]), "+v"(St[2]), "+v"(St[3]), "+v"(St[4]), "+v"(St[5]), "+v"(St[6]), "+v"(St[7])
                : "v"(PR(kk4, 0)), "v"(PR(kk4, 2)), "v"(PR(kk4, 4)), "v"(PR(kk4, 6)), "v"(PR(wr4, 0)), "v"(PR(wr4, 2)), "v"(PR(wr4, 4)), "v"(PR(wr4, 6)),
                  "v"(PR(w4, 0)), "v"(PR(w4, 2)), "v"(PR(w4, 4)), "v"(PR(w4, 6)), "v"(PR(kd4, 0)), "v"(PR(kd4, 2)), "v"(PR(kd4, 4)), "v"(PR(kd4, 6)), "v"(v2));
            float p0 = p.x, p1 = p.y, z0 = z.x, z1 = z.y;
#define D4(ctl) "v_add_f32_dpp %0, %0, %0 " ctl " row_mask:0xf bank_mask:0xf\n\tv_add_f32_dpp %1, %1, %1 " ctl " row_mask:0xf bank_mask:0xf\n\tv_add_f32_dpp %2, %2, %2 " ctl " row_mask:0xf bank_mask:0xf\n\tv_add_f32_dpp %3, %3, %3 " ctl " row_mask:0xf bank_mask:0xf\n\t"
            asm volatile("s_nop 1\n\t" D4("quad_perm:[1,0,3,2]") D4("quad_perm:[2,3,0,1]") D4("row_half_mirror") "s_nop 0"
                : "+v"(p0), "+v"(p1), "+v"(z0), "+v"(z1));
#undef D4
            const f32x2 pp = {p0, p1}, zz = {z0, z1};
            { f32x2 y;
              asm("v_pk_fma_f32 %0, %9, %11, %10 op_sel:[0,0,0] op_sel_hi:[1,0,1] neg_lo:[1,0,0] neg_hi:[1,0,0]\n\tv_pk_fma_f32 %0, %12, %11, %0 op_sel:[0,1,0] op_sel_hi:[1,1,1]\n\tv_pk_fma_f32 %1, %9, %13, %1 op_sel:[0,0,0] op_sel_hi:[1,0,1] neg_lo:[1,0,0] neg_hi:[1,0,0]\n\tv_pk_fma_f32 %2, %9, %13, %2 op_sel:[0,1,0] op_sel_hi:[1,1,1] neg_lo:[1,0,0] neg_hi:[1,0,0]\n\tv_pk_fma_f32 %3, %9, %14, %3 op_sel:[0,0,0] op_sel_hi:[1,0,1] neg_lo:[1,0,0] neg_hi:[1,0,0]\n\tv_pk_fma_f32 %4, %9, %14, %4 op_sel:[0,1,0] op_sel_hi:[1,1,1] neg_lo:[1,0,0] neg_hi:[1,0,0]\n\tv_pk_fma_f32 %5, %9, %15, %5 op_sel:[0,0,0] op_sel_hi:[1,0,1] neg_lo:[1,0,0] neg_hi:[1,0,0]\n\tv_pk_fma_f32 %6, %9, %15, %6 op_sel:[0,1,0] op_sel_hi:[1,1,1] neg_lo:[1,0,0] neg_hi:[1,0,0]\n\tv_pk_fma_f32 %7, %9, %16, %7 op_sel:[0,0,0] op_sel_hi:[1,0,1] neg_lo:[1,0,0] neg_hi:[1,0,0]\n\tv_pk_fma_f32 %8, %9, %16, %8 op_sel:[0,1,0] op_sel_hi:[1,1,1] neg_lo:[1,0,0] neg_hi:[1,0,0]"
                : "=&v"(y), "+v"(St[0]), "+v"(St[1]), "+v"(St[2]), "+v"(St[3]), "+v"(St[4]), "+v"(St[5]), "+v"(St[6]), "+v"(St[7])
                : "v"(pp), "v"(zz), "v"(s2), "v"(v2), "v"(PR(b4, 0)), "v"(PR(b4, 2)), "v"(PR(b4, 4)), "v"(PR(b4, 6)));
              *(LAS f32x2*)(yb + st * 64) = y; }
#undef PR
#pragma unroll
            for (int q = 0; q < 2; ++q) { w4[q] = nw4[q]; kd4[q] = nkd4[q]; kk4[q] = nkk4[q]; b4[q] = nb4[q]; wr4[q] = nwr4[q]; }
            v2 = nv2; s2 = ns2;
        }
        }
        __syncthreads();
        bc = bc == 2 ? 0 : bc + 1; bw = bw == 2 ? 0 : bw + 1;
    }
    RW_FLUSH(NCHK - 1);
#undef RW_LOAD
#undef RW_WRITE
#undef RW_FLUSH
}
__device__ __forceinline__ void rwkv_out_row(Frame& F, int l, int row) {
    F.tid = ltid(); F.lane = F.tid & 63;
    const int c0 = F.lane * 16; const float* yf = (const float*)(F.ws + WS_YS) + (size_t)row * 1024 + c0; const float* yb = yf + (size_t)M_TOT * 1024;
    float y[16]; float s = 0.f;
#pragma unroll
    for (int j = 0; j < 4; ++j) { const f32x4 a = __builtin_nontemporal_load((const f32x4*)(yf + 4 * j)), b = __builtin_nontemporal_load((const f32x4*)(yb + 4 * j));
#pragma unroll
        for (int e = 0; e < 4; ++e) { y[4 * j + e] = a[e] + b[e]; s += y[4 * j + e]; } }
    s = quad_sum(s); const float mu = s * (1.f / 64.f); float q = 0.f;
#pragma unroll
    for (int e = 0; e < 16; ++e) { y[e] -= mu; q += y[e] * y[e]; }
    q = quad_sum(q); const float rstd = 1.f / sqrtf(q * (1.f / 64.f) + GN_EPS);
    const bf16* RWF = (const bf16*)(F.ws + WS_RWF); const size_t RS = (size_t)M_TOT * 1024, o = (size_t)row * 1024 + c0;
    const float sbv = ((const float*)(F.ws + WS_SB))[(size_t)row * 16 + (F.lane >> 2)];
    const float* lg = INP(I_LNG) + l * 1024 + c0; const float* lb = INP(I_LNB) + l * 1024 + c0;
    bf16* dst = (bf16*)(F.ws + WS_MIX) + (size_t)row * DM + 3072 + c0;
#pragma unroll
    for (int hf = 0; hf < 2; ++hf) { const v4u vv = *(const v4u*)(RWF + 2 * RS + o + 8 * hf), gg = *(const v4u*)(RWF + 8 * RS + o + 8 * hf); float r[8];
#pragma unroll
        for (int w = 0; w < 4; ++w) { const int e = 8 * hf + 2 * w;
            r[2 * w] = (y[e] * rstd * lg[e] + lb[e] + sbv * bflo(vv[w])) * bflo(gg[w]); r[2 * w + 1] = (y[e + 1] * rstd * lg[e + 1] + lb[e + 1] + sbv * bfhi(vv[w])) * bfhi(gg[w]); }
        v4u ov; ov.x = pk2(r[0], r[1]); ov.y = pk2(r[2], r[3]); ov.z = pk2(r[4], r[5]); ov.w = pk2(r[6], r[7]); *(v4u*)(dst + 8 * hf) = ov; }
}

#ifndef W_OUT_K0
#define W_OUT_K0 0
#endif
#ifndef W_OUT_K1
#define W_OUT_K1 3072
#endif
struct MlaTiles { gcbf KV; gcbf KR; int ctx_row0, lat_row0, h;
    __device__ __forceinline__ att::Tile operator()(int j) const { const int row = j < 4 ? ctx_row0 + 64 * j : lat_row0 + 64 * (j - 4);
        att::Tile t; t.kn = KV + (size_t)row * 2048 + h * 256; t.v = t.kn + 128; t.kr = KR + (size_t)row * 64; t.mtype = 0; t.krel0 = 0; return t; } };
struct SwaTiles { gcbf P; int blk_row0, ctx_row0, kvh, nwin, has_prev, has_next;
    __device__ __forceinline__ att::Tile operator()(int j) const { att::Tile t; int row; t.mtype = 0; t.krel0 = 0;
        if (j >= nwin) row = ctx_row0 + 64 * (j - nwin);
        else if (j < 2) row = blk_row0 + 64 * j;
        else if (has_prev && j < 4) { row = blk_row0 - 128 + 64 * (j - 2); t.mtype = 1; t.krel0 = -128 + 64 * (j - 2); }
        else { const int sub = j - 2 - 2 * has_prev; row = blk_row0 + 128 + 64 * sub; t.mtype = 2; t.krel0 = 128 + 64 * sub; }
        t.kn = P + (size_t)row * DINP + C_SWAK + kvh * 128; t.v = P + (size_t)row * DINP + C_SWAV + kvh * 128; t.kr = nullptr; return t; } };

#ifndef MLA_SDEPTH
#define MLA_SDEPTH 1
#endif
__device__ __forceinline__ void mla_item(Frame& F, int b, int h, int qb, bool ctxq) {
    F.tid = ltid(); F.lane = F.tid & 63;
    const int r32 = F.lane & 31; const int t = qb * 256 + F.wave * 32 + r32;
    const int roww0 = ctxq ? M_LAT + b * NCTX + F.wave * 32 : b * SEQ + qb * 256 + F.wave * 32;
    gcbf Qw = (gcbf)(F.ws + WS_Q) + (size_t)(roww0 + r32) * 1536 + h * 192;
    MlaTiles ts{(gcbf)(F.ws + WS_KV), (gcbf)(F.ws + WS_KR), M_LAT + b * NCTX, b * SEQ, h};
    gbfp Ow = (gbfp)(F.ws + WS_MIX) + (size_t)roww0 * DM + 2048 + h * 128;
    att::attn_body<192, 2048, 2048, false, false, MLA_SDEPTH>(Qw, ctxq ? 0 : 1, t >> 6, t & 63, (gcfl)(F.ws + WS_ROPE), 0, 0.f, ts, ctxq ? 4 : 132, Ow, (LAS char*)F.lds);
}
__device__ __forceinline__ void swa_item(Frame& F, int l, int b, int n, int kvh, int half, bool ctxq, int hq_ctx) {
    F.tid = ltid(); F.lane = F.tid & 63;
    const int r32 = F.lane & 31; gcbf P = (gcbf)(F.ws + WS_P);
    int hq, qi, roww0, t;
    if (ctxq) { hq = hq_ctx; kvh = hq >> 2; qi = 0; roww0 = M_LAT + b * NCTX + F.wave * 32; t = 0; }
    else { hq = kvh * 4 + 2 * half + (F.wave >> 2); qi = (F.wave & 3) * 32 + r32; roww0 = b * SEQ + n * 128 + (F.wave & 3) * 32; t = n * 128 + qi; }
    gcbf Qw = P + (size_t)(roww0 + r32) * DINP + C_SWAQ + hq * 128;
    SwaTiles ts; ts.P = P; ts.blk_row0 = b * SEQ + n * 128; ts.ctx_row0 = M_LAT + b * NCTX; ts.kvh = kvh;
    ts.has_prev = (!ctxq && n > 0) ? 1 : 0; ts.has_next = (!ctxq && n < SEQ / 128 - 1) ? 1 : 0; ts.nwin = ctxq ? 0 : 2 + 2 * ts.has_prev + 2 * ts.has_next;
    gbfp Ow = (gbfp)(F.ws + WS_MIX) + (size_t)roww0 * DM + hq * 128;
    const float sink_l2 = INP(I_SINK)[l * 8 + hq] * 1.4426950408889634f;
    att::attn_body<128, DINP, DINP, true, true, 2>(Qw, 0, 0, 0, (gcfl)nullptr, qi, sink_l2, ts, ts.nwin + 4, Ow, (LAS char*)F.lds);
}

#ifndef DBG_PHASES
#define DBG_PHASES 0xfffff
#endif
#define PH(n) ((DBG_PHASES >> (n)) & 1)
#ifndef DUP_PHASES
#define DUP_PHASES 0
#endif
#define REP(n) _Pragma("unroll") for (int rep_ = 0; rep_ < (((DUP_PHASES >> (n)) & 1) ? 2 : 1); ++rep_)
__global__ void __launch_bounds__(NTHR, 2) mk_fwd(Args args) {
    extern __shared__ __attribute__((aligned(16))) unsigned char lds[];
    Frame F;
    F.lds = (LAS unsigned char*)lds;
    F.tid = threadIdx.x; F.lane = F.tid & 63; F.wave = __builtin_amdgcn_readfirstlane(F.tid >> 6);
    F.G = gridDim.x; { const int bx = blockIdx.x; F.vcu = (F.G % 8 == 0) ? (bx % 8) * (F.G / 8) + bx / 8 : bx; }
    F.gw = F.vcu * NWAVES + F.wave; F.NGW = F.G * NWAVES;
    F.ws = args.ws; F.out = args.out; F.ctl = (gu32*)(args.ws + WS_CTL);
    F.A = (const __attribute__((address_space(4))) Args*)__builtin_amdgcn_kernarg_segment_ptr();
    for (int u = F.tid; u < (LDS_BYTES - LDSCTL_OFF) / 4; u += NTHR) ((LAS unsigned*)(F.lds + LDSCTL_OFF))[u] = 0u;
    __syncthreads();
    XcdBarrier bar = xcd_barrier_post((unsigned*)(args.ws + WS_CTL) + 4096, (volatile LAS unsigned*)(F.lds + MISC_OFF) + 8);
    const bool rwkv_blk = (blockIdx.x & 3) == 0;
    XcdBarrier bar2; bar2.bar = (unsigned*)(args.ws + WS_CTL) + 8192; bar2.x = 0; bar2.st = (volatile LAS unsigned*)(F.lds + MISC_OFF) + 12; bar2.nparts = gridDim.x - ((gridDim.x + 3) >> 2);
    if (!rwkv_blk) { const unsigned np_ = bar2.nparts; bar2 = xcd_barrier_post((unsigned*)(args.ws + WS_CTL) + 8192, (volatile LAS unsigned*)(F.lds + MISC_OFF) + 12); bar2.nparts = np_; }
#define SUB_BAR() do { bar2.bar = launder(bar2.bar); bar2.x = launder(bar2.x); xcd_barrier(bar2); F.ws = launder_g(F.ws); F.wsw = F.ws + (size_t)lcur * WSET_STRIDE; F.A = launder(F.A); F.tid = ltid(); F.lane = F.tid & 63; } while (0)
#define GRID_BAR() do { bar.bar = launder(bar.bar); bar.x = launder(bar.x); xcd_barrier(bar); F.ws = launder_g(F.ws); F.wsw = F.ws + (size_t)lcur * WSET_STRIDE; F.A = launder(F.A); F.tid = ltid(); F.lane = F.tid & 63; } while (0)
    const int bx = blockIdx.x; int lcur = 0; F.wsw = F.ws;
    bf16* H = (bf16*)(F.ws + WS_H); xres_t* X = (xres_t*)(F.ws + WS_X);

    REP(0) if (PH(0)) { mod_partials(F);
    convert_weights(F, 0, F.gw, F.NGW); }
    GRID_BAR();
    if (PH(1)) { mod_reduce(F); rope_table(F); }
    GRID_BAR();

#pragma unroll 1
    for (int l = 0; l < 2; ++l) {
        lcur = l; F.wsw = F.ws + (size_t)l * WSET_STRIDE;
        const bool wctx = (l == 0);
        const int MO = wctx ? M_TOT : M_LAT;
        if (PH(2) && l == 0) {
            int cs = -1;
            for (int row = F.gw; row < M_TOT; row += F.NGW) { const int s = row_s(row);
                if (s != cs) { __syncthreads(); ln_stage(F, LNV_SC, mod_ptr(F, 0, s, 1)); ln_stage(F, LNV_SH, mod_ptr(F, 0, s, 0)); __syncthreads(); cs = s; }
                const float* xs = row < M_LAT ? INP(I_X) + (size_t)row * DM : INP(I_CTX) + (size_t)(row - M_LAT) * DM;
                ln_row<0>(F, xs, nullptr, nullptr, true, H + (size_t)row * DM); }
            __syncthreads();
        }
        GRID_BAR();
        REP(3) if (PH(3)) { pg8::Gemm g{H, (const bf16*)(F.wsw + WS_WIN), M_TOT, DINP, DM, DM, DM}; pg8::StaticOrder S; S.init(M_TOT, DINP, F.G, bx);
          pg8::EpiBf16<0> E{(bf16*)(F.ws + WS_P), DINP, nullptr};
          pg8::gemm_phase<pg8::EpiBf16<0>, pg8::StaticOrder, true, true>(F.lds, g, S, E); }
        GRID_BAR();
        REP(4) if (PH(4)) for (int it = F.vcu; it < 528; it += F.G) rwkv_feat_item(F, l, it);
        REP(5) if (PH(5)) { if (F.G == 256) { if (F.vcu < 16) lru_items<false>(F, l, F.vcu, 64, 16, false);
                                              else lru_items<false>(F, l, 64 + F.vcu - 16, 2 * NCH * 8, 240, false); }
                            else for (int it = F.vcu; it < 2 * NCH * 8; it += F.G) lru_item<false>(F, l, it); }
        __syncthreads();
        if (PH(6)) for (int row = F.gw; row < M_TOT; row += F.NGW) row_prep(F, row);
        GRID_BAR();
        REP(8) if (rwkv_blk) { const int nrw = (F.G + 3) >> 2; REP(18) if (PH(8)) for (int chain = bx >> 2; chain < 64; chain += nrw) rwkv_scan(F, l, chain); }
        else REP(19) { const int x8 = bx & 7, naw = F.G - ((F.G + 3) >> 2);
            const int aw = (F.G == 256) ? ((x8 < 4 ? x8 - 1 : x8 - 2) * 32 + (bx >> 3)) : ((bx >> 2) * 3 + (bx & 3) - 1);
            if (PH(7) && aw < 8) lru_carry(F, aw);
            if (PH(7)) { pg8::Gemm g{(const bf16*)(F.ws + WS_P) + C_QA, (const bf16*)(F.wsw + WS_WQB), M_TOT, 1536, 1024, DINP, 1024}; pg8::StaticOrder S; S.init(M_TOT, 1536, naw, aw);
              pg8::EpiBf16<2> E{(bf16*)(F.ws + WS_Q), 1536, (const float*)(F.ws + WS_RSQ)};
              pg8::gemm_phase<pg8::EpiBf16<2>, pg8::StaticOrder, true, true>(F.lds, g, S, E); }
            if (PH(7)) { pg8::Gemm g{(const bf16*)(F.ws + WS_P) + C_KVA, (const bf16*)(F.wsw + WS_WKVB), M_TOT, 2048, 512, DINP, 512}; pg8::StaticOrder S; S.init(M_TOT, 2048, naw, aw);
              pg8::EpiBf16<2> E{(bf16*)(F.ws + WS_KV), 2048, (const float*)(F.ws + WS_RSKV)};
              pg8::gemm_phase<pg8::EpiBf16<2>, pg8::StaticOrder, true, true>(F.lds, g, S, E); }
            SUB_BAR();
            if (PH(9)) for (int it = aw; it < 512; it += naw) mla_item(F, it >> 8, (it >> 5) & 7, it & 31, false);
            if (PH(9) && wctx) for (int it = aw; it < 16; it += naw) mla_item(F, it >> 3, it & 7, 0, true);
            if (PH(10)) for (int it = aw; it < 512; it += naw) swa_item(F, l, it >> 8, (it >> 2) & 63, (it >> 1) & 1, it & 1, false, 0);
            if (PH(10) && wctx) for (int it = aw; it < 16; it += naw) swa_item(F, l, it >> 3, 0, 0, 0, true, it & 7);
            if (PH(11)) { if (naw == 192) { const int i0 = aw < 128 ? aw : 1280 + aw - 128, st_ = aw < 128 ? 128 : 64, i1 = aw < 128 ? 1280 : 2 * NCH * 8;
                                            lru_items<true>(F, l, i0, i1, st_, !wctx); }
                          else for (int it = aw; it < 2 * NCH * 8; it += naw) { if (!wctx && ((it >> 3) % NCH) < 8) continue; lru_item<true>(F, l, it); } }
            if (l == 0) { __syncthreads(); convert_weights(F, 1, aw * NWAVES + F.wave, naw * NWAVES); }
            const int k1 = l ? W_OUT_K1 : W_OUT_K0;
            if (k1 > 0) { SUB_BAR();
                pg8::Gemm g{(const bf16*)(F.ws + WS_MIX), (const bf16*)(F.wsw + WS_WOUT), M_LAT, DM, k1, DM, DM}; pg8::StaticOrder S; S.init(M_LAT, DM, naw, aw);
                pg8::EpiBf16<0> E{(bf16*)(F.ws + WS_Y1), DM, nullptr};
                pg8::gemm_phase<pg8::EpiBf16<0>, pg8::StaticOrder, true, true>(F.lds, g, S, E); }
        }
        GRID_BAR();
        REP(12) if (PH(12)) for (int row = F.gw; row < MO; row += F.NGW) rwkv_out_row(F, l, row);
        GRID_BAR();
        REP(13) if (PH(13)) {
          const int k1 = l ? W_OUT_K1 : W_OUT_K0;
          if (k1 == 0) { pg8::Gemm g{(const bf16*)(F.ws + WS_MIX), (const bf16*)(F.wsw + WS_WOUT), M_LAT, DM, DM, DM, DM}; pg8::StaticOrder S; S.init(M_LAT, DM, F.G, bx);
            pg8::EpiBf16<0> E{(bf16*)(F.ws + WS_Y1), DM, nullptr};
            pg8::gemm_phase<pg8::EpiBf16<0>, pg8::StaticOrder, true, true>(F.lds, g, S, E); }
          else { pg8::Gemm g{(const bf16*)(F.ws + WS_MIX) + k1, (const bf16*)(F.wsw + WS_WOUT) + k1, M_LAT, DM, DM - k1, DM, DM}; pg8::StaticOrder S; S.init(M_LAT, DM, F.G, bx);
            pg8::EpiBf16<3> E{(bf16*)(F.ws + WS_Y1), DM, nullptr};
            pg8::gemm_phase<pg8::EpiBf16<3>, pg8::StaticOrder, true, true>(F.lds, g, S, E); }
          if (wctx) {
              pg8::Gemm g2{(const bf16*)(F.ws + WS_MIX) + (size_t)M_LAT * DM, (const bf16*)(F.wsw + WS_WOUT), M_CTX, DM, DM / 8, DM, DM}; pg8::SplitOrder S2; S2.init(M_CTX, DM, DM / 8, bx);
              pg8::EpiF32 E2{(float*)(F.ws + WS_YP), DM, (size_t)M_CTX * DM};
              pg8::gemm_phase<pg8::EpiF32, pg8::SplitOrder, true, true>(F.lds, g2, S2, E2); } }
        GRID_BAR();
        if (PH(14)) { int cs = -1;
          for (int row = F.gw; row < MO; row += F.NGW) { const int s = row_s(row);
            if (s != cs) { __syncthreads(); if (cs < 0) { ln_stage(F, LNV_G, INP(I_LN1G) + l * DM); ln_stage(F, LNV_B, INP(I_LN1B) + l * DM); }
                ln_stage(F, LNV_GA, mod_ptr(F, l, s, 2)); ln_stage(F, LNV_SC, mod_ptr(F, l, s, 4)); ln_stage(F, LNV_SH, mod_ptr(F, l, s, 3)); __syncthreads(); cs = s; }
            bf16* yrow = (bf16*)(F.ws + WS_Y1) + (size_t)row * DM;
            if (row >= M_LAT) sum_partials_row(F, (const float*)(F.ws + WS_YP) + (size_t)(row - M_LAT) * DM, (size_t)M_CTX * DM, yrow);
            if (l == 0) { const float* xs = row < M_LAT ? INP(I_X) + (size_t)row * DM : INP(I_CTX) + (size_t)(row - M_LAT) * DM;
                ln_row<1, false, XH16>(F, xs, yrow, X + (size_t)row * DM, true, H + (size_t)row * DM); }
            else ln_row<1, XH16, XH16>(F, X + (size_t)row * DM, yrow, X + (size_t)row * DM, true, H + (size_t)row * DM); }
          __syncthreads(); }
        GRID_BAR();
        REP(15) if (PH(15)) { pg8::Gemm g{H, (const bf16*)(F.wsw + WS_WFF1), MO, DFF, DM, DM, DM}; pg8::StaticOrder S; S.init(MO, DFF, F.G, bx);
          pg8::EpiBf16<1> E{(bf16*)(F.ws + WS_HID), DFF, nullptr};
          pg8::gemm_phase<pg8::EpiBf16<1>, pg8::StaticOrder, true, true>(F.lds, g, S, E); }
        GRID_BAR();
        REP(16) if (PH(16)) { pg8::Gemm g{(const bf16*)(F.ws + WS_HID), (const bf16*)(F.wsw + WS_WFF2), M_LAT, DM, DFF, DFF, DFF}; pg8::StaticOrder S; S.init(M_LAT, DM, F.G, bx);
          pg8::EpiBf16<0> E{(bf16*)(F.ws + WS_Y2), DM, nullptr};
          pg8::gemm_phase<pg8::EpiBf16<0>, pg8::StaticOrder, true, true>(F.lds, g, S, E);
          if (wctx) {
              pg8::Gemm g2{(const bf16*)(F.ws + WS_HID) + (size_t)M_LAT * DFF, (const bf16*)(F.wsw + WS_WFF2), M_CTX, DM, DFF / 8, DFF, DFF}; pg8::SplitOrder S2; S2.init(M_CTX, DM, DFF / 8, bx);
              pg8::EpiF32 E2{(float*)(F.ws + WS_YP), DM, (size_t)M_CTX * DM};
              pg8::gemm_phase<pg8::EpiF32, pg8::SplitOrder, true, true>(F.lds, g2, S2, E2); } }
        GRID_BAR();
        if (!PH(17)) {} else if (l == 0) { int cs = -1;
            for (int row = F.gw; row < M_TOT; row += F.NGW) { const int s = row_s(row);
                if (s != cs) { __syncthreads(); if (cs < 0) { ln_stage(F, LNV_G, INP(I_LN2G)); ln_stage(F, LNV_B, INP(I_LN2B)); }
                    ln_stage(F, LNV_GA, mod_ptr(F, 0, s, 5)); ln_stage(F, LNV_SC, mod_ptr(F, 1, s, 1)); ln_stage(F, LNV_SH, mod_ptr(F, 1, s, 0)); __syncthreads(); cs = s; }
                bf16* yrow = (bf16*)(F.ws + WS_Y2) + (size_t)row * DM;
                if (row >= M_LAT) sum_partials_row(F, (const float*)(F.ws + WS_YP) + (size_t)(row - M_LAT) * DM, (size_t)M_CTX * DM, yrow);
                ln_row<1, XH16, XH16>(F, X + (size_t)row * DM, yrow, X + (size_t)row * DM, true, H + (size_t)row * DM); }
            __syncthreads();
        } else { int cs = -1;
            for (int row = F.gw; row < M_LAT; row += F.NGW) { const int s = row_s(row);
                if (s != cs) { __syncthreads(); if (cs < 0) { ln_stage(F, LNV_G, INP(I_LN2G) + DM); ln_stage(F, LNV_B, INP(I_LN2B) + DM); }
                    ln_stage(F, LNV_GA, mod_ptr(F, 1, s, 5)); __syncthreads(); cs = s; }
                ln_row<1, XH16, false>(F, X + (size_t)row * DM, (const bf16*)(F.ws + WS_Y2) + (size_t)row * DM, F.out + (size_t)row * DM, false, nullptr); }
        }
    }
}

extern "C" void kernel_launch(void* const* d_in, const int* in_sizes, int n_in, void* d_out, int out_size, void* d_ws, size_t ws_size, hipStream_t stream) {
    static int grid = 0;
    if (grid == 0) {
        if (n_in != 38 || out_size != M_LAT * DM || ws_size < WS_END) { fprintf(stderr, "kernel_launch: unexpected shapes: n_in %d out %d ws %zu (need %zu)\n", n_in, out_size, ws_size, (size_t)WS_END); grid = -1; return; }
        int dev = 0, cus = 0, per_cu = 0;
        if (hipGetDevice(&dev) != hipSuccess || hipDeviceGetAttribute(&cus, hipDeviceAttributeMultiprocessorCount, dev) != hipSuccess) { grid = -1; return; }
        if (hipFuncSetAttribute((const void*)mk_fwd, hipFuncAttributeMaxDynamicSharedMemorySize, LDS_BYTES) != hipSuccess) { fprintf(stderr, "kernel_launch: hipFuncSetAttribute failed\n"); grid = -1; return; }
        if (hipOccupancyMaxActiveBlocksPerMultiprocessor(&per_cu, (const void*)mk_fwd, NTHR, LDS_BYTES) != hipSuccess || per_cu < 1) fprintf(stderr, "kernel_launch: occupancy query says %d\n", per_cu);
        (void)hipGetLastError();
        grid = cus;
    }
    if (grid < 0) return;
    if (hipMemsetAsync((char*)d_ws + WS_CTL, 0, CTL_ZERO_BYTES, stream) != hipSuccess) return;
    Args a{};
    for (int i = 0; i < 38; ++i) a.in[i] = (const float*)d_in[i];
    a.out = (float*)d_out; a.ws = (unsigned char*)d_ws;
    hipLaunchKernelGGL(mk_fwd, dim3(grid), dim3(NTHR), LDS_BYTES, stream, a);
    const hipError_t le = hipPeekAtLastError();
    if (le != hipSuccess) fprintf(stderr, "kernel_launch: launch failed: %s\n", hipGetErrorName(le));
}
```

```cpp
#include <hip/hip_runtime.h>
#include <hip/hip_bf16.h>
#include <cstdio>
#include <cstdint>

namespace pg8 {
#define PG8_LAS __attribute__((address_space(3)))
typedef unsigned short bf16_t;
typedef short bf16x8 __attribute__((ext_vector_type(8)));
typedef float f32x4 __attribute__((ext_vector_type(4)));
typedef unsigned u32x4 __attribute__((ext_vector_type(4)));
constexpr int BM = 256, BK = 64, HALF = 128, HTB = HALF * BK * 2  , STAGE_BYTES = 8 * HTB, NXCD = 8, WGM = 8;

__host__ __device__ __forceinline__ int lds_byte(int r, int c) { const int st = (r >> 4) * 2 + (c >> 5), rr = r & 15, cc = c & 31, ob = rr * 64 + cc * 2; return st * 1024 + (ob ^ (((ob >> 9) & 1) << 5)); }
__host__ __device__ __forceinline__ void stage_rc(int b, int& R, int& C) { const int st = b / 1024, sb = b % 1024, swz = sb ^ (((sb >> 9) & 1) << 5); R = (st >> 1) * 16 + swz / 64; C = (st & 1) * 32 + (swz % 64) / 2; }
__host__ __device__ __forceinline__ int perm32(int rho) { const int n = rho >> 4, i = rho & 15; return 8 * (i >> 2) + 4 * n + (i & 3); }

struct Unit { int pm, pn, ko, ks; };
struct Gemm { const bf16_t* A; const bf16_t* Bt; int M, N, K, lda, ldb; };

struct StaticOrder {
    int nM, nN, nwg, G, c;
    __host__ __device__ void init(int M, int N, int G_, int c_) { nM = M / BM; nN = N / BM; nwg = nM * nN; G = G_; c = c_; }
    __host__ __device__ bool next(int i, Unit& u) const {
        const long L = (long)i * G + c; if (L >= nwg) return false;
        int wgid = (int)L; { const int q = nwg / NXCD, r = nwg % NXCD, xcd = wgid % NXCD, off = wgid / NXCD; wgid = (xcd < r ? xcd * (q + 1) : r * (q + 1) + (xcd - r) * q) + off; }
        const int nig = WGM * nN, gid = wgid / nig, fm = gid * WGM, gsz = (nM - fm) < WGM ? (nM - fm) : WGM;
        u.pm = fm + ((wgid % nig) % gsz); u.pn = (wgid % nig) / gsz; u.ko = 0; u.ks = 0; return true;
    }
    __device__ __forceinline__ void a_ready(const Unit&) const {}
    __device__ __forceinline__ void done(const Unit&) const {}
};
struct SplitOrder {
    int nN, nitems, kslice, c;
    __host__ __device__ void init(int M, int N, int Kslice, int c_) { nN = N / BM; nitems = (M / BM) * nN * 8; kslice = Kslice; c = c_; }
    __host__ __device__ bool next(int i, Unit& u) const { if (i > 0 || c >= nitems) return false; u.ks = c & 7; u.ko = u.ks * kslice; u.pn = (c >> 3) % nN; u.pm = (c >> 3) / nN; return true; }
    __device__ __forceinline__ void a_ready(const Unit&) const {}
    __device__ __forceinline__ void done(const Unit&) const {}
};

__device__ __forceinline__ unsigned cvt_pk_bf16(float lo, float hi) { unsigned r; asm volatile("v_cvt_pk_bf16_f32 %0, %1, %2" : "=v"(r) : "v"(lo), "v"(hi)); return r; }

struct EpiF32 {
    static constexpr bool PERM = false, AFTER_DRAIN = false;
    float* C; int ldc; size_t split_stride;
    __device__ __forceinline__ void operator()(const f32x4 (&acc)[2][2][4][2], const Unit& u, int wr, int wc, int fr, int fq) const {
        const int row0 = u.pm * BM + wr * 64 + fr, col0 = u.pn * BM + wc * 32 + 4 * fq; float* Cb = C + (size_t)u.ks * split_stride;
#pragma unroll
        for (int ai = 0; ai < 2; ++ai)
#pragma unroll
            for (int m = 0; m < 4; ++m) { float* rowp = Cb + (size_t)(row0 + ai * HALF + m * 16) * ldc + col0;
#pragma unroll
                for (int bj = 0; bj < 2; ++bj)
#pragma unroll
                    for (int n = 0; n < 2; ++n) *(f32x4*)(rowp + bj * HALF + n * 16) = acc[ai][bj][m][n]; }
    }
};
template <int ACT> struct EpiBf16 {
    static constexpr bool PERM = true, AFTER_DRAIN = false;
    bf16_t* O; int ldc; const float* rowscale;
    __device__ __forceinline__ void operator()(const f32x4 (&acc)[2][2][4][2], const Unit& u, int wr, int wc, int fr, int fq) const {
        const int row0 = u.pm * BM + wr * 64 + fr; const int col0 = u.pn * BM + wc * 32 + 8 * fq;
#pragma unroll
        for (int ai = 0; ai < 2; ++ai)
#pragma unroll
            for (int m = 0; m < 4; ++m) { const int row = row0 + ai * HALF + m * 16; bf16_t* rowp = O + (size_t)row * ldc + col0;
                float rs = 1.f; if (ACT == 2) rs = rowscale[row];
#pragma unroll
                for (int bj = 0; bj < 2; ++bj) { f32x4 v0 = acc[ai][bj][m][0], v1 = acc[ai][bj][m][1];
                    if (ACT == 1) {
#pragma unroll
                        for (int j = 0; j < 4; ++j) { const float a = fmaxf(v0[j], 0.f), b = fmaxf(v1[j], 0.f); v0[j] = a * a; v1[j] = b * b; } }
                    if (ACT == 2) { v0 = v0 * rs; v1 = v1 * rs; }
                    if (ACT == 3) { const u32x4 o = *(const u32x4*)(rowp + bj * HALF);
                        v0[0] += __builtin_bit_cast(float, o.x << 16); v0[1] += __builtin_bit_cast(float, o.x & 0xffff0000u); v0[2] += __builtin_bit_cast(float, o.y << 16); v0[3] += __builtin_bit_cast(float, o.y & 0xffff0000u);
                        v1[0] += __builtin_bit_cast(float, o.z << 16); v1[1] += __builtin_bit_cast(float, o.z & 0xffff0000u); v1[2] += __builtin_bit_cast(float, o.w << 16); v1[3] += __builtin_bit_cast(float, o.w & 0xffff0000u); }
                    u32x4 w; w.x = cvt_pk_bf16(v0[0], v0[1]); w.y = cvt_pk_bf16(v0[2], v0[3]); w.z = cvt_pk_bf16(v1[0], v1[1]); w.w = cvt_pk_bf16(v1[2], v1[3]);
                    *(u32x4*)(rowp + bj * HALF) = w; } }
    }
};

template <class Epi, class Sched, bool ALIGN_EPI = false, bool SP2 = false>
__device__ __forceinline__ void gemm_phase(PG8_LAS unsigned char* lds, const Gemm g, const Sched& S, const Epi& E) {
    int tid = threadIdx.x; asm volatile("" : "+v"(tid));
    const int wid = __builtin_amdgcn_readfirstlane(tid >> 6), lane = tid & 63, wr = wid >> 2, wc = wid & 3, fr = lane & 15, fq = lane >> 4;
    const int K = g.K, nt = K / BK, lda = g.lda, ldb = g.ldb;
    unsigned voffA[2], voffB[2];
#pragma unroll
    for (int i = 0; i < 2; ++i) { int R, C; stage_rc(tid * 16 + i * 8192, R, C); const int Rb = Epi::PERM ? ((R & ~31) + perm32(R & 31)) : R;
        voffA[i] = (unsigned)(R * lda + C) * 2u; voffB[i] = (unsigned)(Rb * ldb + C) * 2u; }
    const size_t kstep = (size_t)(BK * 2);
    const size_t hstepA = (size_t)HALF * lda * 2, hstepB = (size_t)HALF * ldb * 2;
    const size_t tstepA = 2 * hstepA, tstepB = 2 * hstepB;
    const unsigned ldsw = (unsigned)wid * 1024u;
    const int aoff = lds_byte(wr * 64 + fr, fq * 8), boff = lds_byte(wc * 32 + fr, fq * 8);
#define PG8_SA(b, h) (((b) * 2 + (h)) * HTB)
#define PG8_SB(b, h) ((4 + (b) * 2 + (h)) * HTB)
#define PG8_STAGE(bufoff, gbase, voff) do { _Pragma("unroll") for (int _i = 0; _i < 2; ++_i) \
        __builtin_amdgcn_global_load_lds((const unsigned*)((const char*)(gbase) + (voff)[_i]), (PG8_LAS unsigned*)(lds + (bufoff) + ldsw + _i * 8192), 16, 0, 0); } while (0)
#define PG8_LDA(dst, b, h) do { _Pragma("unroll") for (int m = 0; m < 4; ++m) _Pragma("unroll") for (int k = 0; k < 2; ++k) dst[m][k] = *(const PG8_LAS bf16x8*)(lds + PG8_SA(b, h) + aoff + m * 2048 + k * 1024); } while (0)
#define PG8_LDB(dst, b, h) do { _Pragma("unroll") for (int n = 0; n < 2; ++n) _Pragma("unroll") for (int k = 0; k < 2; ++k) dst[n][k] = *(const PG8_LAS bf16x8*)(lds + PG8_SB(b, h) + boff + n * 2048 + k * 1024); } while (0)
#define PG8_MMA(ai, bj, At, Bt) do { __builtin_amdgcn_s_setprio(1); _Pragma("unroll") for (int m = 0; m < 4; ++m) _Pragma("unroll") for (int n = 0; n < 2; ++n) _Pragma("unroll") for (int k = 0; k < 2; ++k) \
        acc[ai][bj][m][n] = __builtin_amdgcn_mfma_f32_16x16x32_bf16(Bt[n][k], At[m][k], acc[ai][bj][m][n], 0, 0, 0); __builtin_amdgcn_s_setprio(0); } while (0)
#define PG8_WAIT_V(n) asm volatile("s_waitcnt vmcnt(" #n ")" ::: "memory")
#define PG8_WAIT_L(n) asm volatile("s_waitcnt lgkmcnt(" #n ")" ::: "memory")
#define PG8_BAR __builtin_amdgcn_s_barrier()
#define PG8_SCHED __builtin_amdgcn_sched_barrier(0)
    Unit cur, nxt; int ui = 0;
    if (!S.next(0, cur)) return;
    f32x4 acc[2][2][4][2];
#pragma unroll
    for (int a = 0; a < 2; ++a)
#pragma unroll
        for (int b = 0; b < 2; ++b)
#pragma unroll
            for (int m = 0; m < 4; ++m)
#pragma unroll
                for (int n = 0; n < 2; ++n) acc[a][b][m][n] = (f32x4){0.f, 0.f, 0.f, 0.f};
    bf16x8 At[4][2], B0[2][2], B1[2][2];
    const char* cA = (const char*)g.A + (size_t)cur.pm * tstepA + (size_t)cur.ko * 2; const char* cB = (const char*)g.Bt + (size_t)cur.pn * tstepB + (size_t)cur.ko * 2;
    S.a_ready(cur);
    if constexpr (SP2) {
        PG8_STAGE(PG8_SB(0, 0), cB, voffB); PG8_STAGE(PG8_SB(0, 1), cB + hstepB, voffB); PG8_STAGE(PG8_SA(0, 0), cA, voffA); PG8_STAGE(PG8_SA(0, 1), cA + hstepA, voffA);
        if (wr == 1) PG8_BAR;
        PG8_WAIT_V(2); PG8_BAR;
        PG8_STAGE(PG8_SB(1, 0), cB + kstep, voffB); PG8_STAGE(PG8_SA(1, 0), cA + kstep, voffA); PG8_STAGE(PG8_SB(1, 1), cB + hstepB + kstep, voffB);
        PG8_WAIT_V(6); PG8_BAR;
    } else {
        PG8_STAGE(PG8_SB(0, 0), cB, voffB); PG8_STAGE(PG8_SA(0, 0), cA, voffA); PG8_STAGE(PG8_SB(0, 1), cB + hstepB, voffB); PG8_STAGE(PG8_SA(0, 1), cA + hstepA, voffA);
        if (wr == 1) PG8_BAR;
        PG8_WAIT_V(4); PG8_BAR;
        PG8_STAGE(PG8_SB(1, 0), cB + kstep, voffB); PG8_STAGE(PG8_SA(1, 0), cA + kstep, voffA); PG8_STAGE(PG8_SB(1, 1), cB + hstepB + kstep, voffB);
        PG8_WAIT_V(6); PG8_BAR;
    }
    for (;;) {
        const bool has_next = S.next(ui + 1, nxt);
        const char* nA = has_next ? (const char*)g.A + (size_t)nxt.pm * tstepA + (size_t)nxt.ko * 2 : cA; const char* nB = has_next ? (const char*)g.Bt + (size_t)nxt.pn * tstepB + (size_t)nxt.ko * 2 : cB;
        for (int t = 0; t < nt; t += 2) {
            const bool last = (t == nt - 2);
            const char* a1 = cA + (size_t)(t + 1) * kstep;
            const char* a2 = last ? nA : cA + (size_t)(t + 2) * kstep; const char* b2 = last ? nB : cB + (size_t)(t + 2) * kstep;
            const char* a3 = a2 + kstep; const char* b3 = b2 + kstep;
            if (last && has_next) S.a_ready(nxt);
            if constexpr (SP2) {
            PG8_LDB(B0, 0, 0); PG8_LDB(B1, 0, 1); PG8_SCHED; PG8_LDA(At, 0, 0); PG8_STAGE(PG8_SA(1, 1), a1 + hstepA, voffA);
            PG8_WAIT_V(8); PG8_WAIT_L(0); PG8_BAR; PG8_MMA(0, 0, At, B0); PG8_MMA(0, 1, At, B1); PG8_BAR; PG8_SCHED;
            PG8_LDA(At, 0, 1); PG8_STAGE(PG8_SB(0, 0), b2, voffB); PG8_STAGE(PG8_SB(0, 1), b2 + hstepB, voffB); PG8_STAGE(PG8_SA(0, 0), a2, voffA);
            PG8_WAIT_V(8); PG8_WAIT_L(0); PG8_BAR; PG8_MMA(1, 0, At, B0); PG8_MMA(1, 1, At, B1); PG8_BAR; PG8_SCHED;
            PG8_LDB(B0, 1, 0); PG8_LDB(B1, 1, 1); PG8_SCHED; PG8_LDA(At, 1, 0); PG8_STAGE(PG8_SA(0, 1), a2 + hstepA, voffA);
            PG8_WAIT_V(8); PG8_WAIT_L(0); PG8_BAR; PG8_MMA(0, 0, At, B0); PG8_MMA(0, 1, At, B1); PG8_BAR; PG8_SCHED;
            PG8_LDA(At, 1, 1); PG8_STAGE(PG8_SB(1, 0), b3, voffB); PG8_STAGE(PG8_SB(1, 1), b3 + hstepB, voffB); PG8_STAGE(PG8_SA(1, 0), a3, voffA);
            PG8_WAIT_V(8); PG8_WAIT_L(0); PG8_BAR; PG8_MMA(1, 0, At, B0); PG8_MMA(1, 1, At, B1); PG8_BAR; PG8_SCHED;
            } else {
            PG8_LDB(B0, 0, 0); PG8_SCHED; PG8_LDA(At, 0, 0); PG8_STAGE(PG8_SA(1, 1), a1 + hstepA, voffA);
            PG8_WAIT_L(8); PG8_BAR; PG8_WAIT_L(0); PG8_MMA(0, 0, At, B0); PG8_BAR; PG8_SCHED;
            PG8_LDB(B1, 0, 1); PG8_STAGE(PG8_SB(0, 0), b2, voffB);
            PG8_BAR; PG8_WAIT_L(0); PG8_MMA(0, 1, At, B1); PG8_BAR;
            PG8_LDA(At, 0, 1); PG8_STAGE(PG8_SA(0, 0), a2, voffA);
            PG8_BAR; PG8_WAIT_L(0); PG8_MMA(1, 0, At, B0); PG8_BAR; PG8_SCHED;
            PG8_STAGE(PG8_SB(0, 1), b2 + hstepB, voffB);
            PG8_WAIT_V(6); PG8_BAR; PG8_MMA(1, 1, At, B1); PG8_BAR;
            PG8_LDB(B0, 1, 0); PG8_SCHED; PG8_LDA(At, 1, 0); PG8_STAGE(PG8_SA(0, 1), a2 + hstepA, voffA);
            PG8_WAIT_L(8); PG8_BAR; PG8_WAIT_L(0); PG8_MMA(0, 0, At, B0); PG8_BAR; PG8_SCHED;
            PG8_LDB(B1, 1, 1); PG8_STAGE(PG8_SB(1, 0), b3, voffB);
            PG8_BAR; PG8_WAIT_L(0); PG8_MMA(0, 1, At, B1); PG8_BAR;
            PG8_LDA(At, 1, 1); PG8_STAGE(PG8_SA(1, 0), a3, voffA);
            PG8_BAR; PG8_WAIT_L(0); PG8_MMA(1, 0, At, B0); PG8_BAR; PG8_SCHED;
            PG8_STAGE(PG8_SB(1, 1), b3 + hstepB, voffB);
            PG8_WAIT_V(6); PG8_BAR; PG8_MMA(1, 1, At, B1); PG8_BAR;
            }
        }
        if constexpr (ALIGN_EPI) { if (wr == 0) PG8_BAR; }
        E(acc, cur, wr, wc, fr, fq); S.done(cur);
        if (!has_next) break;
#pragma unroll
        for (int a = 0; a < 2; ++a)
#pragma unroll
            for (int b = 0; b < 2; ++b)
#pragma unroll
                for (int m = 0; m < 4; ++m)
#pragma unroll
                    for (int n = 0; n < 2; ++n) acc[a][b][m][n] = (f32x4){0.f, 0.f, 0.f, 0.f};
        cur = nxt; cA = nA; cB = nB; ++ui;
        if constexpr (ALIGN_EPI) { if (wr == 1) PG8_BAR; }
    }
    PG8_WAIT_V(0);
    if constexpr (!ALIGN_EPI) { if (wr == 0) PG8_BAR; }
    PG8_BAR;
#undef PG8_SA
#undef PG8_SB
#undef PG8_STAGE
#undef PG8_LDA
#undef PG8_LDB
#undef PG8_MMA
#undef PG8_WAIT_V
#undef PG8_WAIT_L
#undef PG8_BAR
#undef PG8_SCHED
}
}

constexpr int NWAVES = 8, NTHR = 512;
constexpr int DM = 4096, NB = 2, SEQ = 8192, NCTX = 256, DFF = 16384;
constexpr int M_LAT = NB * SEQ, M_CTX = NB * NCTX, M_TOT = M_LAT + M_CTX;
constexpr int DIN = 8672, DINP = 8704;
constexpr int C_SWAQ = 0, C_SWAK = 1024, C_SWAV = 1280, C_LRUX = 1536, C_LRUY = 2560, C_QA = 3584, C_KVA = 4608, C_KR = 5120, C_RW = 5184;
constexpr int C_RWR = C_RW, C_RWK = C_RW + 1024, C_RWV = C_RW + 2048, C_RWL = C_RW + 3072;
constexpr int RWC = 3488;
constexpr float LN_EPS = 1e-5f, RMS_EPS = 1e-6f, GN_EPS = 64e-5f, ALPHA = 1.41421356237f;
constexpr int NCH = 264;

constexpr size_t MiB = 1u << 20;
constexpr size_t WS_CTL = 0, CTL_ZERO_BYTES = 1 * MiB;
constexpr size_t WS_MOD = 1 * MiB;
constexpr size_t WS_MODP = 2 * MiB;
constexpr size_t WS_SMALL = 20 * MiB;
constexpr size_t WS_RSQ = WS_SMALL;
constexpr size_t WS_RSKV = WS_RSQ + 128 * 1024;
constexpr size_t WS_SB = WS_RSKV + 128 * 1024;
constexpr size_t WS_CA = WS_SB + 2 * MiB;
constexpr size_t WS_CB = WS_CA + 5 * MiB;
constexpr size_t WS_HIN = WS_CB + 5 * MiB;
constexpr size_t WS_QUIRK = WS_HIN + 5 * MiB;
constexpr size_t WS_ROPE = WS_QUIRK + 8192;
static_assert(WS_ROPE + 16384 <= 40 * MiB, "small region");
constexpr size_t WS_W = 40 * MiB;
constexpr size_t WS_WIN = WS_W, WS_WOUT = WS_WIN + 68 * MiB, WS_WFF1 = WS_WOUT + 32 * MiB, WS_WFF2 = WS_WFF1 + 128 * MiB, WS_WQB = WS_WFF2 + 128 * MiB,
                 WS_WKVB = WS_WQB + 3 * MiB, WS_WLRU = WS_WKVB + 2 * MiB, WS_WLORA = WS_WLRU + 1 * MiB;
constexpr size_t WS_W2T = WS_WLORA, WS_A2T = WS_W2T + 256 * 1024, WS_G2T = WS_A2T + 256 * 1024;
constexpr size_t WS_X = 403 * MiB;
constexpr size_t WS_H = 667 * MiB;
constexpr size_t WS_MIX = 799 * MiB;
constexpr size_t WS_YS = 931 * MiB;
constexpr size_t WS_P = 1063 * MiB;
constexpr size_t WS_RWF = 1344 * MiB;
constexpr size_t RWF_STRIDE = (size_t)M_TOT * 1024 * 2;
constexpr size_t WS_Q = 1641 * MiB;
constexpr size_t WS_KV = 1691 * MiB;
constexpr size_t WS_KR = 1757 * MiB;
constexpr size_t WS_SET2 = 1760 * MiB;
constexpr size_t WSET_STRIDE = WS_SET2 - WS_W;
constexpr size_t WS_END = WS_SET2 + 363 * MiB;
constexpr size_t WS_YP = WS_Q;
constexpr size_t WS_HID = WS_P;
constexpr size_t WS_Y1 = WS_P;
constexpr size_t WS_Y2 = WS_MIX;
static_assert(WS_WLORA + 1 * MiB <= WS_X && WS_P + (size_t)M_TOT * DINP * 2 <= WS_RWF && WS_RWF + 9 * RWF_STRIDE <= WS_Q, "ws map");
static_assert(WS_HID + (size_t)M_TOT * DFF * 2 <= WS_Q && WS_Y2 + (size_t)M_TOT * DM * 4 <= WS_P && WS_YS + 2 * (size_t)M_TOT * 1024 * 4 <= WS_P, "ws overlays");
static_assert(WS_KR + (size_t)M_TOT * 64 * 2 <= WS_SET2 && WS_YP + 8 * (size_t)M_CTX * DM * 4 <= WS_KR, "ws end");

constexpr int RING_BYTES = 131072;
constexpr int LDSCTL_OFF = RING_BYTES, MISC_OFF = LDSCTL_OFF + 320;
constexpr int LDS_BYTES = 147456;

#define GAS __attribute__((address_space(1)))
#define LAS __attribute__((address_space(3)))
typedef unsigned short bf16;
typedef unsigned v4u __attribute__((ext_vector_type(4)));
typedef unsigned v2u __attribute__((ext_vector_type(2)));
typedef float f32x4 __attribute__((ext_vector_type(4)));
typedef _Float16 h16x4 __attribute__((ext_vector_type(4)));
typedef _Float16 h16x8 __attribute__((ext_vector_type(8)));
#ifndef XH16_
#define XH16_ 1
#endif
constexpr bool XH16 = XH16_;
#if XH16_
typedef _Float16 xres_t;
#else
typedef float xres_t;
#endif
typedef float f32x2 __attribute__((ext_vector_type(2)));
typedef float f32x16 __attribute__((ext_vector_type(16)));
typedef short bf16x8 __attribute__((ext_vector_type(8)));
typedef short s16x4 __attribute__((ext_vector_type(4)));
typedef GAS unsigned gu32;
typedef const GAS bf16* gcbf; typedef GAS bf16* gbfp; typedef const GAS float* gcfl; typedef GAS float* gflp;
#define LDS_WAIT() asm volatile("s_waitcnt lgkmcnt(0)" ::: "memory")
#define VM_WAIT() asm volatile("s_waitcnt vmcnt(0)" ::: "memory")
typedef __bf16 bf16x2_t __attribute__((ext_vector_type(2)));
__device__ __forceinline__ unsigned pk2(float lo, float hi) { const f32x2 v = {lo, hi}; const bf16x2_t b = __builtin_convertvector(v, bf16x2_t); return __builtin_bit_cast(unsigned, b); }
__device__ __forceinline__ unsigned f2bf(float f) { return pk2(f, f) & 0xffffu; }
__device__ __forceinline__ float bflo(unsigned w) { return __builtin_bit_cast(float, w << 16); }
__device__ __forceinline__ float bfhi(unsigned w) { return __builtin_bit_cast(float, w & 0xffff0000u); }
__device__ __forceinline__ float bf2f(bf16 h) { return __builtin_bit_cast(float, (unsigned)h << 16); }
#define DPP_ADD(x, ctrl) ((x) + __builtin_bit_cast(float, __builtin_amdgcn_update_dpp(0, __builtin_bit_cast(int, (x)), (ctrl), 0xf, 0xf, false)))
__device__ __forceinline__ float row_sum16(float x) { x = DPP_ADD(x, 0x128); x = DPP_ADD(x, 0x124); x = DPP_ADD(x, 0x122); x = DPP_ADD(x, 0x121); return x; }
#ifdef OLD_SUMS
__device__ __forceinline__ float wave_sum(float v) {
#pragma unroll
    for (int o = 1; o < 64; o <<= 1) v += __shfl_xor(v, o);
    return v;
}
__device__ __forceinline__ float half_swap_sum(float x) { return x + __shfl_xor(x, 32); }
__device__ __forceinline__ float quad_sum(float x) { x += __shfl_xor(x, 1); x += __shfl_xor(x, 2); return x; }
#else
__device__ __forceinline__ float wave_sum(float v) {
    const float r = row_sum16(v);
    const float a = __builtin_bit_cast(float, __builtin_amdgcn_readlane(__builtin_bit_cast(int, r), 0)), b = __builtin_bit_cast(float, __builtin_amdgcn_readlane(__builtin_bit_cast(int, r), 16));
    const float c = __builtin_bit_cast(float, __builtin_amdgcn_readlane(__builtin_bit_cast(int, r), 32)), d = __builtin_bit_cast(float, __builtin_amdgcn_readlane(__builtin_bit_cast(int, r), 48));
    return (a + b) + (c + d);
}
__device__ __forceinline__ float half_swap_sum(float x) {
    unsigned a = __builtin_bit_cast(unsigned, x), b = a; asm volatile("" : "+v"(b));
    auto rr = __builtin_amdgcn_permlane32_swap(a, b, false, false);
    const float lo = __uint_as_float(rr[0]), hi = __uint_as_float(rr[1]); return lo + hi;
}
__device__ __forceinline__ float quad_sum(float x) { x = DPP_ADD(x, 0xB1); x = DPP_ADD(x, 0x4E); return x; }
#endif
__device__ __forceinline__ float sigmoidf_(float x) { return __builtin_amdgcn_rcpf(1.f + __expf(-x)); }
__device__ __forceinline__ float softplusf_(float x) { return x > 20.f ? x : __logf(1.f + __expf(x)); }
__device__ __forceinline__ float tanhf_(float x) { const float e = __expf(2.f * x); return 1.f - 2.f * __builtin_amdgcn_rcpf(e + 1.f); }
__device__ __forceinline__ int ltid() { int t = threadIdx.x; asm volatile("" : "+v"(t)); return t; }
template <class T> __device__ __forceinline__ T ldg(const void* base, unsigned byteoff) { return *(const T*)((const char*)base + byteoff); }
template <class T> __device__ __forceinline__ void stg(void* base, unsigned byteoff, T v) { *(T*)((char*)base + byteoff) = v; }

#define XB_TMO      128
#define XB_XCNT(j)  (256  + 64 * (j))
#define XB_XSUB(j)  (1280 + 64 * (j))
#define XB_XGEN(j)  (2304 + 64 * (j))
#define XB_TOP      3328
#define XB_TOPGEN   3392
#define XCD_BAR_WORDS 3456
#define XB_SPIN_CAP (1u << 18)

__device__ __forceinline__ unsigned xb_ld(unsigned* p)              { return __hip_atomic_load(p, __ATOMIC_RELAXED, __HIP_MEMORY_SCOPE_AGENT); }
__device__ __forceinline__ unsigned xb_add(unsigned* p, unsigned v) { return __hip_atomic_fetch_add(p, v, __ATOMIC_RELAXED, __HIP_MEMORY_SCOPE_AGENT); }
__device__ __forceinline__ unsigned xb_xcc_id() { return (unsigned)__builtin_amdgcn_s_getreg((3 << 11) | 20) & 0xFu; }
#define XB_SPIN(cond, bar) do { unsigned _sp = 0; while (cond) { __builtin_amdgcn_s_sleep(1); \
    if ((++_sp & 255u) == 0u) { if (xb_ld(&(bar)[XB_TMO])) break; if (_sp > XB_SPIN_CAP) { atomicAdd(&(bar)[XB_TMO], 1u); break; } } } } while (0)

struct XcdBarrier {
    unsigned* bar; unsigned x;
    unsigned nparts;
    volatile LAS unsigned* st;
};

__device__ __forceinline__ XcdBarrier xcd_barrier_post(unsigned* bar, volatile LAS unsigned* st) {
    XcdBarrier b; b.bar = bar; b.x = xb_xcc_id(); b.st = st; b.nparts = 0u;
    if (threadIdx.x == 0) (void)xb_add(&bar[XB_XCNT(b.x)], 1u);
    return b;
}
__device__ __forceinline__ void xcd_barrier_complete(unsigned* bar, unsigned x, unsigned& nloc, unsigned& nx, unsigned nparts) {
    const unsigned G = nparts ? nparts : gridDim.x * gridDim.y * gridDim.z;
    unsigned sum, cnt, mine, sp = 0u;
    for (;;) {
        sum = 0u; cnt = 0u; mine = 0u;
#pragma unroll
        for (unsigned j = 0; j < 16; ++j) { const unsigned c = xb_ld(&bar[XB_XCNT(j)]); sum += c; cnt += (c > 0u) ? 1u : 0u; mine = (j == x) ? c : mine; }
        if (sum == G) break;
        __builtin_amdgcn_s_sleep(1);
        if ((++sp & 255u) == 0u) { if (xb_ld(&bar[XB_TMO])) break; if (sp > XB_SPIN_CAP) { atomicAdd(&bar[XB_TMO], 1u); break; } }
    }
    nloc = mine > 0u ? mine : 1u; nx = cnt > 0u ? cnt : 1u;
}

__device__ __forceinline__ void xcd_barrier(const XcdBarrier& b) {
    asm volatile("s_waitcnt vmcnt(0)" ::: "memory");
    __syncthreads();
    if (threadIdx.x == 0) {
        unsigned* bar = b.bar;
        __builtin_amdgcn_s_waitcnt(0);
        unsigned nloc = b.st[0], nx = b.st[1];
        if (nloc == 0u) { xcd_barrier_complete(bar, b.x, nloc, nx, b.nparts); b.st[0] = nloc; b.st[1] = nx; }
        const unsigned old = xb_add(&bar[XB_XSUB(b.x)], 1u);
        const unsigned gen = old / nloc;
        if (old + 1u == (gen + 1u) * nloc) {
            __builtin_amdgcn_fence(__ATOMIC_RELEASE, "agent");
            asm volatile("s_waitcnt vmcnt(0)" ::: "memory");
            const unsigned og = xb_add(&bar[XB_TOP], 1u);
            const unsigned tg = og / nx;
            if (og + 1u == (tg + 1u) * nx) xb_add(&bar[XB_TOPGEN], 1u);
            else XB_SPIN(xb_ld(&bar[XB_TOPGEN]) == tg, bar);
            __builtin_amdgcn_fence(__ATOMIC_ACQUIRE, "agent");
            xb_add(&bar[XB_XGEN(b.x)], 1u);
            asm volatile("s_waitcnt vmcnt(0)" ::: "memory");
        } else {
            XB_SPIN(xb_ld(&bar[XB_XGEN(b.x)]) == gen, bar);
            __builtin_amdgcn_fence(__ATOMIC_ACQUIRE, "agent");
            asm volatile("s_waitcnt vmcnt(0)" ::: "memory");
        }
    }
    __syncthreads();
}


namespace att {
constexpr int KVBLK = 64;
constexpr float THR = 8.f;
#define SBAR() __builtin_amdgcn_sched_barrier(0)
__device__ __forceinline__ int crow(int r, int hi) { return (r & 3) + 8 * (r >> 2) + 4 * hi; }
__device__ __forceinline__ unsigned cvtpk(float lo, float hi) { return pk2(lo, hi); }
template <int DQK> __device__ __forceinline__ int kswz(int row, int cb) { return row * (DQK * 2 + 16) + cb; }

template <int DQK> __device__ __forceinline__ void partialSM(f32x16& p0, f32x16& p1, float& m_reg, float& mn, float& alpha) {
  constexpr float SCALE = DQK == 128 ? 0.088388347648318440f : 0.072168783648703220f;
  constexpr float C = SCALE * 1.4426950408889634f;
  float pmax = p0[0];
#pragma unroll
  for (int r = 1; r < 16; ++r) pmax = fmaxf(pmax, p0[r]);
#pragma unroll
  for (int r = 0; r < 16; ++r) pmax = fmaxf(pmax, p1[r]);
  { auto rr = __builtin_amdgcn_permlane32_swap(__float_as_uint(pmax), __float_as_uint(pmax), false, false);
    pmax = fmaxf(__uint_as_float(rr[0]), __uint_as_float(rr[1])); }
  if (__builtin_expect(__all(pmax - m_reg <= THR / SCALE), 1)) { mn = m_reg; alpha = 1.f; }
  else { mn = fmaxf(m_reg, pmax); alpha = __builtin_amdgcn_exp2f((m_reg - mn) * C); m_reg = mn; }
  const float mnC = -mn * C;
#pragma unroll
  for (int r = 0; r < 16; ++r) p0[r] = fmaf(p0[r], C, mnC);
#pragma unroll
  for (int r = 0; r < 16; ++r) p1[r] = fmaf(p1[r], C, mnC);
#pragma unroll
  for (int r = 0; r < 16; ++r) p0[r] = __builtin_amdgcn_exp2f(p0[r]);
}
__device__ __forceinline__ void finishSM(f32x16& p0, f32x16& p1, float alpha, float& l_reg, bf16x8& pa0, bf16x8& pa1, bf16x8& pa2, bf16x8& pa3) {
#pragma unroll
  for (int r = 0; r < 16; ++r) p1[r] = __builtin_amdgcn_exp2f(p1[r]);
  float ps = 0;
#pragma unroll
  for (int r = 0; r < 16; ++r) ps += p0[r];
#pragma unroll
  for (int r = 0; r < 16; ++r) ps += p1[r];
  { auto rr = __builtin_amdgcn_permlane32_swap(__float_as_uint(ps), __float_as_uint(ps), false, false);
    ps = __uint_as_float(rr[0]) + __uint_as_float(rr[1]); }
  l_reg = l_reg * alpha + ps;
#define PK4(P, BASE, OUT) do { unsigned a0 = cvtpk(P[BASE + 0], P[BASE + 1]), a1 = cvtpk(P[BASE + 2], P[BASE + 3]);   \
    unsigned b0 = cvtpk(P[BASE + 4], P[BASE + 5]), b1 = cvtpk(P[BASE + 6], P[BASE + 7]);                              \
    auto r0 = __builtin_amdgcn_permlane32_swap(a0, b0, false, false); auto r1 = __builtin_amdgcn_permlane32_swap(a1, b1, false, false); \
    v4u w = {r0[0], r1[0], r0[1], r1[1]}; OUT = __builtin_bit_cast(bf16x8, w); } while (0)
  PK4(p0, 0, pa0); PK4(p0, 8, pa1); PK4(p1, 0, pa2); PK4(p1, 8, pa3);
#undef PK4
}
template <int DQK> __device__ __forceinline__ void qkt(f32x16& p0, f32x16& p1, const LAS char* Ks, const bf16x8* qr, const LAS char* qx, int r32, int hi) {
  p0 = f32x16{}; p1 = f32x16{};
#pragma unroll
  for (int d0 = 0; d0 < DQK / 16; ++d0) { const int cb = (d0 * 16 + hi * 8) * 2;
    bf16x8 b0 = *(const LAS bf16x8*)(Ks + kswz<DQK>(r32, cb));
    bf16x8 b1 = *(const LAS bf16x8*)(Ks + kswz<DQK>(32 + r32, cb));
    bf16x8 q; if (d0 < 8) q = qr[d0]; else q = *(const LAS bf16x8*)(qx + (d0 - 8) * 32);
    p0 = __builtin_amdgcn_mfma_f32_32x32x16_bf16(b0, q, p0, 0, 0, 0);
    p1 = __builtin_amdgcn_mfma_f32_32x32x16_bf16(b1, q, p1, 0, 0, 0);
    if ((d0 & 3) == 3 && d0 + 1 < DQK / 16) SBAR(); }
}
__device__ __forceinline__ int v_st(int k, int c) { const int kk = (k & ~0xC) | ((k & 4) << 1) | ((k & 8) >> 1); return ((kk >> 3) * 4 + (c >> 5)) * 512 + ((kk & 7) * 32 + (c & 31)) * 2; }
__device__ __forceinline__ int v_rd_base(int lane) { return ((lane & 3) << 3) | (((lane >> 2) & 3) << 6) | (((lane >> 4) & 1) << 5) | (((lane >> 5) & 1) << 8); }
constexpr int v_rd_off(int d0, int ks, int half) { return d0 * 512 + ks * 4096 + half * 2048; }
template <int OFF> __device__ __forceinline__ s16x4 tr_read(int vb) {
  s16x4 r; asm volatile("ds_read_b64_tr_b16 %0, %1 offset:%2" : "=&v"(r) : "v"(vb), "i"(OFF) : "memory"); return r;
}
template <int D0> __device__ __forceinline__ void pv_one(f32x16& od, int vb, bf16x8 pa0, bf16x8 pa1, bf16x8 pa2, bf16x8 pa3) {
  const s16x4 l0 = tr_read<v_rd_off(D0, 0, 0)>(vb), h0 = tr_read<v_rd_off(D0, 0, 1)>(vb), l1 = tr_read<v_rd_off(D0, 1, 0)>(vb), h1 = tr_read<v_rd_off(D0, 1, 1)>(vb);
  const s16x4 l2 = tr_read<v_rd_off(D0, 2, 0)>(vb), h2 = tr_read<v_rd_off(D0, 2, 1)>(vb), l3 = tr_read<v_rd_off(D0, 3, 0)>(vb), h3 = tr_read<v_rd_off(D0, 3, 1)>(vb);
  asm volatile("s_waitcnt lgkmcnt(0)" ::: "memory"); SBAR();
#define PK(L, H) (bf16x8){L[0], L[1], L[2], L[3], H[0], H[1], H[2], H[3]}
  od = __builtin_amdgcn_mfma_f32_32x32x16_bf16(pa0, PK(l0, h0), od, 0, 0, 0);
  od = __builtin_amdgcn_mfma_f32_32x32x16_bf16(pa1, PK(l1, h1), od, 0, 0, 0);
  od = __builtin_amdgcn_mfma_f32_32x32x16_bf16(pa2, PK(l2, h2), od, 0, 0, 0);
  od = __builtin_amdgcn_mfma_f32_32x32x16_bf16(pa3, PK(l3, h3), od, 0, 0, 0);
#undef PK
}
__device__ __forceinline__ void pv_d0(f32x16* o, int vb, bf16x8 pa0, bf16x8 pa1, bf16x8 pa2, bf16x8 pa3) {
  pv_one<0>(o[0], vb, pa0, pa1, pa2, pa3); pv_one<1>(o[1], vb, pa0, pa1, pa2, pa3); pv_one<2>(o[2], vb, pa0, pa1, pa2, pa3); pv_one<3>(o[3], vb, pa0, pa1, pa2, pa3);
}
__device__ __forceinline__ void apply_mask(f32x16& p0, f32x16& p1, int mtype, int krel0, int qi, int hi) {
  if (mtype == 0) return;
  const float ninf = -__builtin_inff();
#pragma unroll
  for (int r = 0; r < 16; ++r) { const int k0 = krel0 + crow(r, hi), k1 = k0 + 32;
    const bool ok0 = (mtype == 1) ? (k0 >= qi - 128) : (k0 <= qi + 128), ok1 = (mtype == 1) ? (k1 >= qi - 128) : (k1 <= qi + 128);
    p0[r] = ok0 ? p0[r] : ninf; p1[r] = ok1 ? p1[r] : ninf; }
}
struct Tile { gcbf kn; gcbf kr; gcbf v; int mtype; int krel0; };

__device__ __forceinline__ void rope_pair(bf16x8& a, bf16x8& b, gcfl ct, gcfl st) {
  const f32x4 c0 = *(const GAS f32x4*)ct, c1 = *(const GAS f32x4*)(ct + 4), s0 = *(const GAS f32x4*)st, s1 = *(const GAS f32x4*)(st + 4);
  const float cs[8] = {c0[0], c0[1], c0[2], c0[3], c1[0], c1[1], c1[2], c1[3]}, sn[8] = {s0[0], s0[1], s0[2], s0[3], s1[0], s1[1], s1[2], s1[3]};
  v4u ua = __builtin_bit_cast(v4u, a), ub = __builtin_bit_cast(v4u, b); v4u oa, ob;
#pragma unroll
  for (int w = 0; w < 4; ++w) { const float x1[2] = {bflo(ua[w]), bfhi(ua[w])}, x2[2] = {bflo(ub[w]), bfhi(ub[w])}; float y1[2], y2[2];
#pragma unroll
    for (int e = 0; e < 2; ++e) { const float c = cs[2 * w + e], sv = sn[2 * w + e]; y1[e] = x1[e] * c - x2[e] * sv; y2[e] = x2[e] * c + x1[e] * sv; }
    oa[w] = pk2(y1[0], y1[1]); ob[w] = pk2(y2[0], y2[1]); }
  a = __builtin_bit_cast(bf16x8, oa); b = __builtin_bit_cast(bf16x8, ob);
}

template <int DQK, int LDKN, int LDV, bool MASK, bool SINK, int SDEPTH, class TS>
__device__ __forceinline__ void attn_body(gcbf Qw, int rope, int prow, int pcol, gcfl rtab, int qi, float sink_l2, const TS& ts, int NT, gbfp Ow, LAS char* lds) {
  constexpr float SCALE = DQK == 128 ? 0.088388347648318440f : 0.072168783648703220f;
  constexpr float C = SCALE * 1.4426950408889634f;
  constexpr int SHM_K = KVBLK * (DQK * 2 + 16), SHM_V = KVBLK * 128 * 2;
  int tid = threadIdx.x; asm volatile("" : "+v"(tid));
  const int wid = tid >> 6, lane = tid & 63, r32 = lane & 31, hi = lane >> 5;
  LAS char* V_lds = lds; LAS char* K_lds = lds + 2 * SHM_V;
  LAS float* wsl = (LAS float*)(lds + 2 * SHM_V + 2 * SHM_K) + wid * 64; LAS float* li_l = wsl; LAS float* al_l = wsl + 32;
  float m_reg = -1e30f, l_reg = 0; f32x16 o[4] = {}; bf16x8 qr[8];
#pragma unroll
  for (int d0 = 0; d0 < 8; ++d0) qr[d0] = *(const GAS bf16x8*)(Qw + d0 * 16 + hi * 8);
  const LAS char* qx = lds + 2 * SHM_V + 2 * SHM_K + 2048 + wid * 4608 + r32 * 144 + hi * 16;
  if constexpr (DQK == 192) {
    bf16x8 x0 = *(const GAS bf16x8*)(Qw + 128 + hi * 8), x1 = *(const GAS bf16x8*)(Qw + 144 + hi * 8), x2 = *(const GAS bf16x8*)(Qw + 160 + hi * 8), x3 = *(const GAS bf16x8*)(Qw + 176 + hi * 8);
    if (rope) {
      rope_pair(x0, x1, rtab + (size_t)prow * 16 + hi * 8, rtab + 2048 + (size_t)prow * 16 + hi * 8);
      rope_pair(x2, x3, rtab + (size_t)pcol * 16 + hi * 8, rtab + 2048 + (size_t)pcol * 16 + hi * 8); }
    LAS char* qw_ = (LAS char*)qx; *(LAS bf16x8*)(qw_) = x0; *(LAS bf16x8*)(qw_ + 32) = x1; *(LAS bf16x8*)(qw_ + 64) = x2; *(LAS bf16x8*)(qw_ + 96) = x3;
  }
  const int sr = tid >> 4, sc = (tid & 15) * 8, vst0 = v_st(sr, sc), vst1 = v_st(32 + sr, sc);
  const int rr_ = tid >> 3, rc_ = (tid & 7) * 8;
  const int vb0 = (int)(uintptr_t)V_lds + v_rd_base(lane);
  struct { bf16x8 vs0, vs1, ks0, ks1, kx; } sr_[SDEPTH];
#define SLOAD(i, jt) do { const Tile t_ = ts(jt); sr_[i].vs0 = *(const GAS bf16x8*)(t_.v + (size_t)sr * LDV + sc); sr_[i].vs1 = *(const GAS bf16x8*)(t_.v + (size_t)(32 + sr) * LDV + sc); \
    sr_[i].ks0 = *(const GAS bf16x8*)(t_.kn + (size_t)sr * LDKN + sc); sr_[i].ks1 = *(const GAS bf16x8*)(t_.kn + (size_t)(32 + sr) * LDKN + sc); \
    if constexpr (DQK == 192) sr_[i].kx = *(const GAS bf16x8*)(t_.kr + (size_t)rr_ * 64 + rc_); } while (0)
#define SWRITE(b, i) do { *(LAS bf16x8*)(V_lds + (b) * SHM_V + vst0) = sr_[i].vs0; *(LAS bf16x8*)(V_lds + (b) * SHM_V + vst1) = sr_[i].vs1; const int kc = sc * 2; \
    *(LAS bf16x8*)(K_lds + (b) * SHM_K + kswz<DQK>(sr, kc)) = sr_[i].ks0; *(LAS bf16x8*)(K_lds + (b) * SHM_K + kswz<DQK>(32 + sr, kc)) = sr_[i].ks1; \
    if constexpr (DQK == 192) *(LAS bf16x8*)(K_lds + (b) * SHM_K + kswz<DQK>(rr_, 256 + rc_ * 2)) = sr_[i].kx; } while (0)
#define SWAIT() do { if constexpr (SDEPTH == 2) { if constexpr (DQK == 192) asm volatile("s_waitcnt vmcnt(5)" ::: "memory"); else asm volatile("s_waitcnt vmcnt(4)" ::: "memory"); } \
    else asm volatile("s_waitcnt vmcnt(0)" ::: "memory"); } while (0)
#define RESC(a) do { if (__any((a) < 1.f)) { if (hi == 0) al_l[r32] = (a); asm volatile("s_waitcnt lgkmcnt(0)" ::: "memory"); \
    _Pragma("unroll") for (int d = 0; d < 4; ++d) _Pragma("unroll") for (int r = 0; r < 16; ++r) o[d][r] *= al_l[crow(r, hi)]; } } while (0)
#define MASKT(pa_, pb_, jt) do { if constexpr (MASK) { const Tile t_ = ts(jt); apply_mask(pa_, pb_, t_.mtype, t_.krel0, qi, hi); } } while (0)
  f32x16 pA0, pA1, pB0, pB1; float mnA, mnB, alA, alB; bf16x8 pa0, pa1, pa2, pa3;
  constexpr int SE = 0, SO = SDEPTH - 1;
  SLOAD(SE, 0); asm volatile("s_waitcnt vmcnt(0)" ::: "memory"); SWRITE(0, SE); __syncthreads();
  qkt<DQK>(pA0, pA1, K_lds, qr, qx, r32, hi); MASKT(pA0, pA1, 0); partialSM<DQK>(pA0, pA1, m_reg, mnA, alA);
  SLOAD(SO, 1); if constexpr (SDEPTH == 2) { if (2 < NT) SLOAD(SE, 2); }
  SWAIT(); SWRITE(1, SO); __syncthreads();
  for (int j = 1; j + 1 < NT; j += 2) {
    SBAR(); qkt<DQK>(pB0, pB1, K_lds + SHM_K, qr, qx, r32, hi); MASKT(pB0, pB1, j);
    finishSM(pA0, pA1, alA, l_reg, pa0, pa1, pa2, pa3); SBAR();
    SLOAD(SO, j + SDEPTH); SBAR();
    pv_d0(o, vb0, pa0, pa1, pa2, pa3); partialSM<DQK>(pB0, pB1, m_reg, mnB, alB);
    __syncthreads(); SWAIT(); SWRITE(0, SE);
    RESC(alB); __syncthreads();
    SBAR(); qkt<DQK>(pA0, pA1, K_lds, qr, qx, r32, hi); MASKT(pA0, pA1, j + 1);
    finishSM(pB0, pB1, alB, l_reg, pa0, pa1, pa2, pa3); SBAR();
    if (SDEPTH == 1 || j + 3 < NT) SLOAD(SE, j + 1 + SDEPTH); SBAR();
    pv_d0(o, vb0 + SHM_V, pa0, pa1, pa2, pa3); partialSM<DQK>(pA0, pA1, m_reg, mnA, alA);
    __syncthreads(); SWAIT(); SWRITE(1, SO);
    RESC(alA); __syncthreads();
  }
  SBAR(); qkt<DQK>(pB0, pB1, K_lds + SHM_K, qr, qx, r32, hi); MASKT(pB0, pB1, NT - 1);
  finishSM(pA0, pA1, alA, l_reg, pa0, pa1, pa2, pa3); SBAR();
  pv_d0(o, vb0, pa0, pa1, pa2, pa3); partialSM<DQK>(pB0, pB1, m_reg, mnB, alB);
  __syncthreads(); RESC(alB);
  finishSM(pB0, pB1, alB, l_reg, pa0, pa1, pa2, pa3); SBAR();
  pv_d0(o, vb0 + SHM_V, pa0, pa1, pa2, pa3);
  if constexpr (SINK) l_reg += __builtin_amdgcn_exp2f(sink_l2 - m_reg * C);
  if (hi == 0) li_l[r32] = l_reg; asm volatile("s_waitcnt lgkmcnt(0)" ::: "memory");
  float rli[16];
#pragma unroll
  for (int r = 0; r < 16; ++r) rli[r] = __builtin_amdgcn_rcpf(li_l[crow(r, hi)]);
  __syncthreads();
  LAS bf16* ost = (LAS bf16*)(lds + wid * 8704);
#pragma unroll
  for (int r = 0; r < 16; ++r) { const int orow = crow(r, hi);
#pragma unroll
    for (int d0 = 0; d0 < 4; ++d0) ost[orow * 136 + d0 * 32 + r32] = (bf16)f2bf(o[d0][r] * rli[r]); }
  asm volatile("s_waitcnt lgkmcnt(0)" ::: "memory");
#pragma unroll
  for (int i = 0; i < 8; ++i) { const int orow = i * 4 + (lane >> 4), ch = lane & 15;
    *(GAS v4u*)(Ow + (size_t)orow * 4096 + ch * 8) = *(const LAS v4u*)(ost + orow * 136 + ch * 8); }
  __syncthreads();
#undef SLOAD
#undef SWRITE
#undef SWAIT
#undef RESC
#undef MASKT
}
}

struct Args { const float* in[38]; float* out; unsigned char* ws; };
template <class T> __device__ __forceinline__ T launder(T p) { asm volatile("" : "+s"(p)); return p; }
template <class T> __device__ __forceinline__ T* launder_g(T* p) { GAS T* g = (GAS T*)p; asm volatile("" : "+s"(g)); return (T*)g; }
#define INP(i) ((const float*)(gcfl)F.A->in[i])
struct Frame {
    LAS unsigned char* lds;
    gu32* ctl;
    int tid, lane, wave;
    int vcu, G, gw, NGW;
    const __attribute__((address_space(4))) Args* A;
    float* out;
    unsigned char* ws;
    unsigned char* wsw;
};
enum { I_X = 0, I_C, I_CTX, I_CCTX, I_WMOD, I_BMOD, I_WIN, I_WOUT, I_LN1G, I_LN1B, I_WFF1, I_WFF2, I_LN2G, I_LN2B, I_SINK, I_CONVW, I_CONVB, I_LWA, I_LBA, I_LWI, I_LBI, I_LAM,
       I_QNORM, I_KVNORM, I_WQB, I_WKVB, I_MUP, I_MUN, I_W0, I_W2, I_A0, I_A2, I_G2, I_KK, I_KA, I_RK, I_LNG, I_LNB };
__device__ __forceinline__ int row_s(int row) { return row < SEQ ? 0 : (row < M_LAT ? 1 : 2); }
__device__ __forceinline__ const float* mod_ptr(const Frame& F, int l, int s, int chunk) { return (const float*)(F.ws + WS_MOD) + ((size_t)(l * 3 + s) * 6 + chunk) * DM; }

__device__ __forceinline__ void transpose_item(const float* W, int N, int Kvalid, bf16* WT, int ldt, const float* kscale, LAS float* scr, int k0, int n0, int lane) {
    { const int kr = lane >> 3, c4 = (lane & 7) * 4;
#pragma unroll
      for (int i = 0; i < 8; ++i) { const int kk = 8 * i + kr, k = k0 + kk; f32x4 v = {0.f, 0.f, 0.f, 0.f};
          if (k < Kvalid) { v = *(const f32x4*)(W + (size_t)k * N + n0 + c4); if (kscale) v = v * kscale[k]; }
          scr[kk * 33 + c4] = v.x; scr[kk * 33 + c4 + 1] = v.y; scr[kk * 33 + c4 + 2] = v.z; scr[kk * 33 + c4 + 3] = v.w; } }
    LDS_WAIT(); asm volatile("" ::: "memory");
    const int c = lane & 7;
#pragma unroll
    for (int j = 0; j < 4; ++j) { const int n = (lane >> 3) + 8 * j; const LAS float* s = scr + (8 * c) * 33 + n;
        v4u o; o.x = pk2(s[0 * 33], s[1 * 33]); o.y = pk2(s[2 * 33], s[3 * 33]); o.z = pk2(s[4 * 33], s[5 * 33]); o.w = pk2(s[6 * 33], s[7 * 33]);
        *(v4u*)(WT + (size_t)(n0 + n) * ldt + k0 + 8 * c) = o; }
    LDS_WAIT(); asm volatile("" ::: "memory");
}
struct TItem { const float* W; bf16* WT; const float* kscale; int N, Kvalid, ldt, k0, n0; };
__device__ __forceinline__ void titem_load(const TItem& t, int lane, f32x4 (&v)[8]) {
    const int kr = lane >> 3, c4 = (lane & 7) * 4;
#pragma unroll
    for (int i = 0; i < 8; ++i) { const int k = t.k0 + 8 * i + kr; v[i] = (f32x4){0.f, 0.f, 0.f, 0.f}; if (k < t.Kvalid) v[i] = *(const f32x4*)(t.W + (size_t)k * t.N + t.n0 + c4); }
}
__device__ __forceinline__ void titem_finish(const TItem& t, int lane, LAS float* scr, f32x4 (&v)[8]) {
    { const int kr = lane >> 3, c4 = (lane & 7) * 4;
#pragma unroll
      for (int i = 0; i < 8; ++i) { const int kk = 8 * i + kr, k = t.k0 + kk; f32x4 x = v[i]; if (t.kscale && k < t.Kvalid) x = x * t.kscale[k];
          scr[kk * 33 + c4] = x.x; scr[kk * 33 + c4 + 1] = x.y; scr[kk * 33 + c4 + 2] = x.z; scr[kk * 33 + c4 + 3] = x.w; } }
    LDS_WAIT(); asm volatile("" ::: "memory");
    const int c = lane & 7;
#pragma unroll
    for (int j = 0; j < 4; ++j) { const int n = (lane >> 3) + 8 * j; const LAS float* s = scr + (8 * c) * 33 + n;
        v4u o; o.x = pk2(s[0 * 33], s[1 * 33]); o.y = pk2(s[2 * 33], s[3 * 33]); o.z = pk2(s[4 * 33], s[5 * 33]); o.w = pk2(s[6 * 33], s[7 * 33]);
        *(v4u*)(t.WT + (size_t)(t.n0 + n) * t.ldt + t.k0 + 8 * c) = o; }
    LDS_WAIT(); asm volatile("" ::: "memory");
}
__device__ __forceinline__ TItem conv_decode(const Frame& F, int l, unsigned char* ws, int r) {
    constexpr int I1 = 64 * 271, I2 = 64 * 128, I3 = 64 * 512, I4 = 256 * 128, I5 = 16 * 48, I6 = 8 * 64, I7 = 32 * 8, I8 = 2 * 32, I9 = 2 * 32;
    if (r < I1) return TItem{INP(I_WIN) + (size_t)l * DM * DIN, (bf16*)(ws + WS_WIN), nullptr, DIN, DM, DM, 64 * (r / 271), 32 * (r % 271)}; r -= I1;
    if (r < I2) return TItem{INP(I_WOUT) + (size_t)l * DM * DM, (bf16*)(ws + WS_WOUT), nullptr, DM, DM, DM, 64 * (r / 128), 32 * (r % 128)}; r -= I2;
    if (r < I3) return TItem{INP(I_WFF1) + (size_t)l * DM * DFF, (bf16*)(ws + WS_WFF1), nullptr, DFF, DM, DM, 64 * (r / 512), 32 * (r % 512)}; r -= I3;
    if (r < I4) return TItem{INP(I_WFF2) + (size_t)l * DFF * DM, (bf16*)(ws + WS_WFF2), nullptr, DM, DFF, DFF, 64 * (r / 128), 32 * (r % 128)}; r -= I4;
    if (r < I5) return TItem{INP(I_WQB) + (size_t)l * 1024 * 1536, (bf16*)(ws + WS_WQB), INP(I_QNORM) + l * 1024, 1536, 1024, 1024, 64 * (r / 48), 32 * (r % 48)}; r -= I5;
    if (r < I6) return TItem{INP(I_WKVB) + (size_t)l * 512 * 2048, (bf16*)(ws + WS_WKVB), INP(I_KVNORM) + l * 512, 2048, 512, 512, 64 * (r / 64), 32 * (r % 64)}; r -= I6;
    if (r < I7) { const int mat = r >> 3, sub = r & 7, gate = mat & 1, dn = mat >> 1, d = dn >> 3, n = dn & 7;
        return TItem{(gate ? INP(I_LWI) : INP(I_LWA)) + ((size_t)(l * 2 + d) * 8 + n) * 128 * 128, (bf16*)(ws + WS_WLRU) + ((size_t)(d * 2 + gate) * 8 + n) * 128 * 128, nullptr, 128, 128, 128, 64 * (sub >> 2), 32 * (sub & 3)}; } r -= I7;
    if (r < I8) { const int d = r >> 5; return TItem{INP(I_W2) + (size_t)(l * 2 + d) * 64 * 1024, (bf16*)(ws + WS_W2T) + (size_t)d * 1024 * 64, nullptr, 1024, 64, 64, 0, 32 * (r & 31)}; } r -= I8;
    if (r < I9) { const int d = r >> 5; return TItem{INP(I_A2) + (size_t)(l * 2 + d) * 64 * 1024, (bf16*)(ws + WS_A2T) + (size_t)d * 1024 * 64, nullptr, 1024, 64, 64, 0, 32 * (r & 31)}; } r -= I9;
    return TItem{INP(I_G2) + (size_t)l * 160 * 1024, (bf16*)(ws + WS_G2T), nullptr, 1024, 160, 192, 64 * (r / 32), 32 * (r % 32)};
}
__device__ __forceinline__ void convert_weights(Frame& F, int l, int widx, int nw) {
    LAS float* scr = (LAS float*)(F.lds + F.wave * 16384);
    constexpr int NIT = 64 * 271 + 64 * 128 + 64 * 512 + 256 * 128 + 16 * 48 + 8 * 64 + 32 * 8 + 2 * 32 + 2 * 32 + 3 * 32;
    unsigned char* ws = F.ws + (l ? WSET_STRIDE : 0);
    int it = __builtin_amdgcn_readfirstlane(widx);
    if (it < NIT) { TItem cur = conv_decode(F, l, ws, it); f32x4 va[8]; titem_load(cur, F.lane, va);
#pragma unroll 1
        for (;;) { const int itn = it + nw; TItem nxt = cur; f32x4 vb[8];
            if (itn < NIT) { nxt = conv_decode(F, l, ws, itn); titem_load(nxt, F.lane, vb); }
            else {
#pragma unroll
                for (int i = 0; i < 8; ++i) vb[i] = va[i]; }
            titem_finish(cur, F.lane, scr, va);
            if (itn >= NIT) break;
            cur = nxt; it = itn;
#pragma unroll
            for (int i = 0; i < 8; ++i) va[i] = vb[i]; } }
    { unsigned zz = 0u; asm volatile("" : "+v"(zz)); v4u z = {zz, zz, zz, zz}; v4u* p = (v4u*)((bf16*)(ws + WS_WIN) + (size_t)DIN * DM);
      for (int i = widx * 64 + F.lane; i < 32 * DM / 8; i += nw * 64) p[i] = z; }
}

__device__ __forceinline__ void mod_partials(Frame& F) {
    LAS float* sl = (LAS float*)F.lds;
    for (int it = F.vcu; it < 2 * 32 * 12; it += F.G) {
        const int l = it / 384, ks = (it / 12) % 32, cc = it % 12;
        __syncthreads();
        if (F.tid < 384) { const int s = F.tid >> 7, k = ks * 128 + (F.tid & 127); const float c = s < 2 ? INP(I_C)[s * DM + k] : INP(I_CCTX)[k]; sl[F.tid] = c / (1.f + __expf(-c)); }
        __syncthreads();
        const float* wp = INP(I_WMOD) + ((size_t)l * DM + ks * 128) * 24576 + cc * 2048 + F.tid * 4;
        f32x4 a0 = {0.f, 0.f, 0.f, 0.f}, a1 = a0, a2 = a0;
#pragma unroll 8
        for (int k = 0; k < 128; ++k) { const f32x4 w = *(const f32x4*)(wp + (size_t)k * 24576); a0 += w * sl[k]; a1 += w * sl[128 + k]; a2 += w * sl[256 + k]; }
        float* op = (float*)(F.ws + WS_MODP) + ((size_t)(l * 32 + ks) * 3) * 24576 + cc * 2048 + F.tid * 4;
        *(f32x4*)(op) = a0; *(f32x4*)(op + 24576) = a1; *(f32x4*)(op + 2 * 24576) = a2;
    }
    __syncthreads();
}
__device__ __forceinline__ void mod_reduce(Frame& F) {
    for (int i = F.vcu * NTHR + F.tid; i < 2 * 3 * 24576; i += F.G * NTHR) {
        const int l = i / (3 * 24576), s = (i / 24576) % 3, n = i % 24576;
        float a = INP(I_BMOD)[l * 24576 + n];
        const float* pp = (const float*)(F.ws + WS_MODP) + ((size_t)(l * 32) * 3 + s) * 24576 + n;
#pragma unroll 8
        for (int ks = 0; ks < 32; ++ks) a += pp[(size_t)ks * 3 * 24576];
        ((float*)(F.ws + WS_MOD))[i] = a;
    }
}

__device__ __forceinline__ void sum_partials_row(const Frame& F, const float* yp, size_t stride, bf16* ydst) {
    int lane = F.lane; asm volatile("" : "+v"(lane));
#pragma unroll 2
    for (int j = 0; j < 8; ++j) { const int c = 8 * lane + 512 * j; f32x4 y0 = *(const f32x4*)(yp + c), y1 = *(const f32x4*)(yp + c + 4);
#pragma unroll
        for (int sp = 1; sp < 8; ++sp) { y0 += *(const f32x4*)(yp + sp * stride + c); y1 += *(const f32x4*)(yp + sp * stride + c + 4); }
        v4u w; w.x = pk2(y0.x, y0.y); w.y = pk2(y0.z, y0.w); w.z = pk2(y1.x, y1.y); w.w = pk2(y1.z, y1.w); *(v4u*)(ydst + c) = w; }
}
constexpr int LNV_G = 0, LNV_B = DM, LNV_GA = 2 * DM, LNV_SC = 3 * DM, LNV_SH = 4 * DM;
__device__ __forceinline__ void ln_stage(const Frame& F, int slot, const float* src) {
    LAS float* d = (LAS float*)F.lds + slot; gcfl g = (gcfl)src;
#pragma unroll
    for (int u = 0; u < 2; ++u) { const int c = 4 * (F.tid + NTHR * u); *(LAS f32x4*)(d + c) = *(const GAS f32x4*)(g + c); }
}
template <int MODE, bool XSH = false, bool XDH = false>
__device__ __forceinline__ void ln_row(const Frame& F, const void* xsrc_, const bf16* Y_, void* xdst_, bool domod, bf16* hrow_) {
    gcfl xsrc = (gcfl)xsrc_; const GAS _Float16* xsrch = (const GAS _Float16*)xsrc_; gflp xdst = (gflp)xdst_; GAS _Float16* xdsth = (GAS _Float16*)xdst_;
    gcbf Y = (gcbf)Y_; gbfp hrow = (gbfp)hrow_; const LAS float* L = (const LAS float*)F.lds + 8 * F.lane;
    f32x4 v[16]; v4u yr[8]; float s = 0.f;
#pragma unroll
    for (int j = 0; j < 8; ++j) { const int c = 8 * F.lane + 512 * j;
        if (XSH) { const h16x8 h = __builtin_nontemporal_load((const GAS h16x8*)(xsrch + c));
            v[2 * j] = __builtin_convertvector(__builtin_shufflevector(h, h, 0, 1, 2, 3), f32x4); v[2 * j + 1] = __builtin_convertvector(__builtin_shufflevector(h, h, 4, 5, 6, 7), f32x4); }
        else { v[2 * j] = __builtin_nontemporal_load((const GAS f32x4*)(xsrc + c)); v[2 * j + 1] = __builtin_nontemporal_load((const GAS f32x4*)(xsrc + c + 4)); } }
    if (MODE == 1) {
#pragma unroll
        for (int j = 0; j < 8; ++j) yr[j] = __builtin_nontemporal_load((const GAS v4u*)(Y + 8 * F.lane + 512 * j));
    }
#pragma unroll
    for (int q = 0; q < 16; ++q) { const int j = q >> 1, hf = q & 1;
        if (MODE == 1) { const unsigned w0 = hf ? yr[j].z : yr[j].x, w1 = hf ? yr[j].w : yr[j].y; const f32x4 y = {bflo(w0), bfhi(w0), bflo(w1), bfhi(w1)}, g = *(const LAS f32x4*)(L + LNV_GA + 512 * j + 4 * hf); v[q] = v[q] * ALPHA + g * y; }
        s += (v[q].x + v[q].y) + (v[q].z + v[q].w); }
    float mean = wave_sum(s) * (1.f / DM), s2 = 0.f;
#pragma unroll
    for (int q = 0; q < 16; ++q) { v[q] = v[q] - mean; s2 += (v[q].x * v[q].x + v[q].y * v[q].y) + (v[q].z * v[q].z + v[q].w * v[q].w); }
    float rstd = 1.f / sqrtf(wave_sum(s2) * (1.f / DM) + LN_EPS);
    if (MODE == 1) {
        s = 0.f;
#pragma unroll
        for (int j = 0; j < 8; ++j) { const int c = 8 * F.lane + 512 * j;
#pragma unroll
            for (int hf = 0; hf < 2; ++hf) { const int q = 2 * j + hf; const f32x4 g = *(const LAS f32x4*)(L + LNV_G + 512 * j + 4 * hf), b = *(const LAS f32x4*)(L + LNV_B + 512 * j + 4 * hf); v[q] = v[q] * rstd * g + b;
                s += (v[q].x + v[q].y) + (v[q].z + v[q].w); }
            if (XDH) { const h16x4 h0 = __builtin_convertvector(v[2 * j], h16x4), h1 = __builtin_convertvector(v[2 * j + 1], h16x4);
                __builtin_nontemporal_store(__builtin_shufflevector(h0, h1, 0, 1, 2, 3, 4, 5, 6, 7), (GAS h16x8*)(xdsth + c)); }
            else { __builtin_nontemporal_store(v[2 * j], (GAS f32x4*)(xdst + c)); __builtin_nontemporal_store(v[2 * j + 1], (GAS f32x4*)(xdst + c + 4)); } }
        if (!domod) return;
        mean = wave_sum(s) * (1.f / DM); s2 = 0.f;
#pragma unroll
        for (int q = 0; q < 16; ++q) { v[q] = v[q] - mean; s2 += (v[q].x * v[q].x + v[q].y * v[q].y) + (v[q].z * v[q].z + v[q].w * v[q].w); }
        rstd = 1.f / sqrtf(wave_sum(s2) * (1.f / DM) + LN_EPS);
    }
#pragma unroll
    for (int j = 0; j < 8; ++j) { const int c = 8 * F.lane + 512 * j; unsigned w[4];
#pragma unroll
        for (int hf = 0; hf < 2; ++hf) { const f32x4 a = *(const LAS f32x4*)(L + LNV_SC + 512 * j + 4 * hf), b = *(const LAS f32x4*)(L + LNV_SH + 512 * j + 4 * hf);
            const f32x4 o = v[2 * j + hf] * rstd * (a + 1.f) + b; w[2 * hf] = pk2(o.x, o.y); w[2 * hf + 1] = pk2(o.z, o.w); }
        *(GAS v4u*)(hrow + c) = (v4u){w[0], w[1], w[2], w[3]}; }
}

__device__ __forceinline__ void shift4(const bf16* P, unsigned eo, bool hp, bool hn, const float* mup, const float* mun, unsigned mo, float (&u)[4]) {
    const v2u xc = ldg<v2u>(P, eo * 2u); v2u xp = {0u, 0u}, xn = {0u, 0u};
    if (hp) xp = ldg<v2u>(P, (eo - DINP) * 2u); if (hn) xn = ldg<v2u>(P, (eo + DINP) * 2u);
    const f32x4 mp = ldg<f32x4>(mup, mo * 4u), mn = ldg<f32x4>(mun, mo * 4u);
    const float c[4] = {bflo(xc.x), bfhi(xc.x), bflo(xc.y), bfhi(xc.y)}, p[4] = {bflo(xp.x), bfhi(xp.x), bflo(xp.y), bfhi(xp.y)}, n[4] = {bflo(xn.x), bfhi(xn.x), bflo(xn.y), bfhi(xn.y)};
#pragma unroll
    for (int e = 0; e < 4; ++e) u[e] = c[e] + mp[e] * (p[e] - c[e]) + mn[e] * (n[e] - c[e]);
}
__device__ __forceinline__ void st4bf(void* base, unsigned eo, float a, float b, float c, float d) { v2u w; w.x = pk2(a, b); w.y = pk2(c, d); stg<v2u>(base, eo * 2u, w); }

__device__ __forceinline__ void rwkv_feat_item(Frame& F, int l, int item) {
    F.tid = ltid(); F.lane = F.tid & 63;
    int row0, seq_lo, seq_hi;
    if (item < 16) { const int b = item >> 3; seq_lo = M_LAT + b * NCTX; seq_hi = seq_lo + NCTX; row0 = seq_lo + (item & 7) * 32; }
    else { const int it = item - 16, b = it >> 8; seq_lo = b * SEQ; seq_hi = seq_lo + SEQ; row0 = seq_lo + (it & 255) * 32; }
    const bf16* P = (const bf16*)(F.ws + WS_P);
    LAS bf16* ACT = (LAS bf16*)F.lds;
    const float* mup = INP(I_MUP) + l * RWC; const float* mun = INP(I_MUN) + l * RWC;
    __syncthreads();
    {
#pragma unroll
      for (int k = 0; k < 4; ++k) { const int p = F.tid + NTHR * k;
        if (p < 32 * 52) { const int tok = p / 52, j = (p - tok * 52) * 8, row = row0 + tok; const bool hp = row > seq_lo, hn = row + 1 < seq_hi;
          const bf16* pr = P + (size_t)row * DINP + C_RWL + j;
          const v4u xc = *(const v4u*)pr; v4u xp = {0u, 0u, 0u, 0u}, xn = {0u, 0u, 0u, 0u};
          if (hp) xp = *(const v4u*)(pr - DINP); if (hn) xn = *(const v4u*)(pr + DINP);
          const f32x4 mp[2] = {*(const f32x4*)(mup + 3072 + j), *(const f32x4*)(mup + 3072 + j + 4)}, mn[2] = {*(const f32x4*)(mun + 3072 + j), *(const f32x4*)(mun + 3072 + j + 4)};
          unsigned o[4];
#pragma unroll
          for (int w = 0; w < 4; ++w) { float u[2];
#pragma unroll
              for (int e = 0; e < 2; ++e) { const int idx = 2 * w + e; const float c = e ? bfhi(xc[w]) : bflo(xc[w]), pv = e ? bfhi(xp[w]) : bflo(xp[w]), nv = e ? bfhi(xn[w]) : bflo(xn[w]);
                  float v = c + mp[idx >> 2][idx & 3] * (pv - c) + mn[idx >> 2][idx & 3] * (nv - c);
                  if (j < 128) v = tanhf_(v); else if (j >= 256) v = sigmoidf_(v);
                  u[e] = v; }
              o[w] = pk2(u[0], u[1]); }
          *(LAS v4u*)(ACT + tok * 424 + j) = (v4u){o[0], o[1], o[2], o[3]}; } } }
    __syncthreads();
    const int tok = F.lane & 31, hi = F.lane >> 5, row = row0 + tok;
    const bf16* W2T = (const bf16*)(F.wsw + WS_W2T); const bf16* A2T = (const bf16*)(F.wsw + WS_A2T); const bf16* G2T = (const bf16*)(F.wsw + WS_G2T);
    bf16* RWF = (bf16*)(F.ws + WS_RWF); const size_t RS = (size_t)M_TOT * 1024;
    const float* kkv = INP(I_KK) + l * 1024; const float* kav = INP(I_KA) + l * 1024; const float* rkv = INP(I_RK) + l * 1024;
    const float* w0f = INP(I_W0) + (size_t)(l * 2) * 1024; const float* a0f = INP(I_A0) + (size_t)(l * 2) * 1024;
    const LAS bf16* actl = ACT + tok * 424 + hi * 8;
    LAS unsigned char* TB = F.lds + 27136 + F.wave * 10880;
    LAS float* VB = (LAS float*)(F.lds + (F.wave < 4 ? 114176 + F.wave * 3328 : 131584 + (F.wave - 4) * 3328));
#define RF_LOADG(reg_, colbase) do { _Pragma("unroll") for (int i_ = 0; i_ < 3; ++i_) { const int p_ = F.lane + 64 * i_; reg_[i_] = (v4u){0u, 0u, 0u, 0u}; if (p_ < 136) { const int rr_ = p_ >> 2, cp_ = p_ & 3, gr_ = row0 - 1 + rr_; \
        if (gr_ >= seq_lo && gr_ < seq_hi) reg_[i_] = ldg<v4u>(P, ((unsigned)gr_ * DINP + (colbase) + 8 * cp_) * 2u); } } } while (0)
#define RF_STORET(ti, reg_) do { _Pragma("unroll") for (int i_ = 0; i_ < 3; ++i_) { const int p_ = F.lane + 64 * i_; if (p_ < 136) { const int rr_ = p_ >> 2, cp_ = p_ & 3; *(LAS v4u*)(TB + (ti) * 2720 + rr_ * 80 + cp_ * 16) = reg_[i_]; } } } while (0)
#define RF_SHIFT4(ti, g_, vb_, cc_, u_) do { const LAS unsigned char* q_ = TB + (ti) * 2720 + (tok + 1) * 80 + (8 * (g_) + 4 * hi) * 2; const v2u xc_ = *(const LAS v2u*)q_, xp_ = *(const LAS v2u*)(q_ - 80), xn_ = *(const LAS v2u*)(q_ + 80); \
        const f32x4 mp_ = *(const LAS f32x4*)(VB + (vb_) * 64 + (cc_)), mn_ = *(const LAS f32x4*)(VB + ((vb_) + 1) * 64 + (cc_)); \
        const float c_[4] = {bflo(xc_.x), bfhi(xc_.x), bflo(xc_.y), bfhi(xc_.y)}, pp_[4] = {bflo(xp_.x), bfhi(xp_.x), bflo(xp_.y), bfhi(xp_.y)}, nn_[4] = {bflo(xn_.x), bfhi(xn_.x), bflo(xn_.y), bfhi(xn_.y)}; \
        _Pragma("unroll") for (int e_ = 0; e_ < 4; ++e_) u_[e_] = c_[e_] + mp_[e_] * (pp_[e_] - c_[e_]) + mn_[e_] * (nn_[e_] - c_[e_]); } while (0)
#define RF_PUT(ti, o_) do { _Pragma("unroll") for (int g_ = 0; g_ < 4; ++g_) *(LAS v2u*)(TB + (ti) * 2720 + tok * 80 + (8 * g_ + 4 * hi) * 2) = o_[g_]; } while (0)
#define RF_FLUSH3(a0_, a1_, a2_, cblk_) do { asm volatile("s_waitcnt lgkmcnt(0)" ::: "memory"); \
        _Pragma("unroll") for (int t_ = 0; t_ < 3; ++t_) { const int arr_ = t_ == 0 ? (a0_) : (t_ == 1 ? (a1_) : (a2_)); \
            _Pragma("unroll") for (int i_ = 0; i_ < 2; ++i_) { const int p_ = F.lane + 64 * i_, rr_ = p_ >> 2, cp_ = p_ & 3; const v4u v_ = *(const LAS v4u*)(TB + t_ * 2720 + rr_ * 80 + cp_ * 16); \
                stg<v4u>(RWF + arr_ * RS, ((unsigned)(row0 + rr_) * 1024u + (cblk_) + 8 * cp_) * 2u, v_); } } \
        asm volatile("s_waitcnt lgkmcnt(0)" ::: "memory"); } while (0)
#pragma unroll 1
    for (int hh = 0; hh < 2; ++hh) {
        const int h = 2 * F.wave + hh, cbase = h * 64;
        float ssq = 0.f;
        { v4u t0[3], t1[3]; RF_LOADG(t0, C_RWK + cbase); RF_LOADG(t1, C_RWK + cbase + 32);
          const unsigned co = (cbase + F.lane) * 4u; float vv[13];
#pragma unroll
          for (int sct = 0; sct < 3; ++sct) { vv[2 * sct] = ldg<float>(mup, co + sct * 4096u); vv[2 * sct + 1] = ldg<float>(mun, co + sct * 4096u); }
          vv[6] = ldg<float>(kkv, co); vv[7] = ldg<float>(kav, co); vv[8] = ldg<float>(rkv, co); vv[9] = ldg<float>(a0f, co); vv[10] = ldg<float>(a0f, co + 4096u); vv[11] = ldg<float>(w0f, co); vv[12] = ldg<float>(w0f, co + 4096u);
          RF_STORET(0, t0); RF_STORET(1, t1);
#pragma unroll
          for (int q = 0; q < 13; ++q) VB[q * 64 + F.lane] = vv[q]; }
        asm volatile("s_waitcnt lgkmcnt(0)" ::: "memory");
#pragma unroll
        for (int bg = 0; bg < 8; ++bg) { const int cc = (bg >> 2) * 32 + 8 * (bg & 3) + 4 * hi; float uk[4];
            RF_SHIFT4(bg >> 2, bg & 3, 2, cc, uk); const f32x4 k4 = *(const LAS f32x4*)(VB + 6 * 64 + cc);
#pragma unroll
            for (int e = 0; e < 4; ++e) { const float q = uk[e] * k4[e]; ssq += q * q; } }
        ssq = half_swap_sum(ssq);
        const float rn = 1.f / fmaxf(sqrtf(ssq), 1e-12f);
        float sb = 0.f;
        asm volatile("s_waitcnt lgkmcnt(0)" ::: "memory");
#pragma unroll 1
        for (int blk = 0; blk < 2; ++blk) {
            const unsigned cblk = cbase + blk * 32, cha = cblk + tok;
            v4u gR[3], gK[3], gV[3];
            RF_LOADG(gR, C_RWR + cblk); RF_LOADG(gK, C_RWK + cblk); RF_LOADG(gV, C_RWV + cblk);
            bf16x8 wd[2][4], wg[10], wa[2][4];
#pragma unroll
            for (int d = 0; d < 2; ++d) {
#pragma unroll
                for (int ks = 0; ks < 4; ++ks) wd[d][ks] = ldg<bf16x8>(W2T, ((d * 1024 + cha) * 64 + ks * 16 + hi * 8) * 2u); }
#pragma unroll
            for (int ks = 0; ks < 10; ++ks) wg[ks] = ldg<bf16x8>(G2T, (cha * 192 + ks * 16 + hi * 8) * 2u);
#pragma unroll
            for (int d = 0; d < 2; ++d) {
#pragma unroll
                for (int ks = 0; ks < 4; ++ks) wa[d][ks] = ldg<bf16x8>(A2T, ((d * 1024 + cha) * 64 + ks * 16 + hi * 8) * 2u); }
#pragma unroll
            for (int d = 0; d < 2; ++d) { f32x16 aw = {};
#pragma unroll
                for (int ks = 0; ks < 4; ++ks) { const bf16x8 bw = *(const LAS bf16x8*)(actl + d * 64 + ks * 16);
                    aw = __builtin_amdgcn_mfma_f32_32x32x16_bf16(wd[d][ks], bw, aw, 0, 0, 0); }
                v2u o[4];
#pragma unroll
                for (int g = 0; g < 4; ++g) { const f32x4 w0 = *(const LAS f32x4*)(VB + (11 + d) * 64 + blk * 32 + 8 * g + 4 * hi); float e4[4];
#pragma unroll
                    for (int e = 0; e < 4; ++e) e4[e] = 0.60653065971f * sigmoidf_(w0[e] + aw[4 * g + e]);
                    o[g].x = pk2(e4[0], e4[1]); o[g].y = pk2(e4[2], e4[3]); }
                RF_PUT(d, o); }
            { f32x16 ag = {};
#pragma unroll
              for (int ks = 0; ks < 10; ++ks) { const bf16x8 bg_ = *(const LAS bf16x8*)(actl + 256 + ks * 16);
                  ag = __builtin_amdgcn_mfma_f32_32x32x16_bf16(wg[ks], bg_, ag, 0, 0, 0); }
              v2u o[4];
#pragma unroll
              for (int g = 0; g < 4; ++g) { o[g].x = pk2(ag[4 * g], ag[4 * g + 1]); o[g].y = pk2(ag[4 * g + 2], ag[4 * g + 3]); }
              RF_PUT(2, o); }
            RF_FLUSH3(4, 5, 8, cblk);
            RF_STORET(0, gR); RF_STORET(1, gK); RF_STORET(2, gV);
            { f32x16 aaf = {}, aab = {};
#pragma unroll
              for (int ks = 0; ks < 4; ++ks) { const bf16x8 baf = *(const LAS bf16x8*)(actl + 128 + ks * 16), bab = *(const LAS bf16x8*)(actl + 192 + ks * 16);
                  aaf = __builtin_amdgcn_mfma_f32_32x32x16_bf16(wa[0][ks], baf, aaf, 0, 0, 0); aab = __builtin_amdgcn_mfma_f32_32x32x16_bf16(wa[1][ks], bab, aab, 0, 0, 0); }
              v2u oR[4], oK[4], oV[4], oKK[4], oAF[4], oAB[4];
              asm volatile("s_waitcnt lgkmcnt(0)" ::: "memory");
#pragma unroll
              for (int g = 0; g < 4; ++g) { const int cc = blk * 32 + 8 * g + 4 * hi; float ur[4], uk[4], uv[4];
                  RF_SHIFT4(0, g, 0, cc, ur); RF_SHIFT4(1, g, 2, cc, uk); RF_SHIFT4(2, g, 4, cc, uv);
                  const f32x4 a0a = *(const LAS f32x4*)(VB + 9 * 64 + cc), a0b = *(const LAS f32x4*)(VB + 10 * 64 + cc), kk4 = *(const LAS f32x4*)(VB + 6 * 64 + cc), ka4 = *(const LAS f32x4*)(VB + 7 * 64 + cc), rk4 = *(const LAS f32x4*)(VB + 8 * 64 + cc);
                  float af[4], ab[4], kk[4];
#pragma unroll
                  for (int e = 0; e < 4; ++e) { const int r = 4 * g + e;
                      af[e] = sigmoidf_(a0a[e] + aaf[r]); ab[e] = sigmoidf_(a0b[e] + aab[r]); kk[e] = uk[e] * kk4[e] * rn;
                      const float kdf = uk[e] * (1.f + (af[e] - 1.f) * ka4[e]), kdb = uk[e] * (1.f + (ab[e] - 1.f) * ka4[e]);
                      sb += ur[e] * rk4[e] * (kdf + kdb); }
                  oR[g].x = pk2(ur[0], ur[1]); oR[g].y = pk2(ur[2], ur[3]); oK[g].x = pk2(uk[0], uk[1]); oK[g].y = pk2(uk[2], uk[3]); oV[g].x = pk2(uv[0], uv[1]); oV[g].y = pk2(uv[2], uv[3]);
                  oKK[g].x = pk2(kk[0], kk[1]); oKK[g].y = pk2(kk[2], kk[3]); oAF[g].x = pk2(af[0], af[1]); oAF[g].y = pk2(af[2], af[3]); oAB[g].x = pk2(ab[0], ab[1]); oAB[g].y = pk2(ab[2], ab[3]); }
              asm volatile("s_waitcnt lgkmcnt(0)" ::: "memory");
              RF_PUT(0, oR); RF_PUT(1, oK); RF_PUT(2, oV); RF_FLUSH3(0, 1, 2, cblk);
              RF_PUT(0, oKK); RF_PUT(1, oAF); RF_PUT(2, oAB); RF_FLUSH3(3, 6, 7, cblk); }
        }
        sb = half_swap_sum(sb);
        if (hi == 0) ((float*)(F.ws + WS_SB))[(size_t)row * 16 + h] = sb;
    }
#undef RF_LOADG
#undef RF_STORET
#undef RF_SHIFT4
#undef RF_PUT
#undef RF_FLUSH3
}

__device__ __forceinline__ float gelu_tanh(float x) { return 0.5f * x * (1.f + tanhf_(0.7978845608028654f * (x + 0.044715f * x * x * x))); }
template <bool PASS3>
__device__ __forceinline__ void lru_item(Frame& F, int l, int item) {
    F.tid = ltid(); F.lane = F.tid & 63;
    const int sc = item >> 3, nb = item & 7, b = sc / NCH, ch = sc % NCH;
    int row0, seq_lo, seq_hi;
    if (ch < 8) { seq_lo = M_LAT + b * NCTX; seq_hi = seq_lo + NCTX; row0 = seq_lo + ch * 32; }
    else { seq_lo = b * SEQ; seq_hi = seq_lo + SEQ; row0 = seq_lo + (ch - 8) * 32; }
    const bf16* P = (const bf16*)(F.ws + WS_P);
    LAS float* U = (LAS float*)F.lds;
    LAS bf16* UA = (LAS bf16*)(F.lds + 16384);
    LAS float* AB = (LAS float*)(F.lds + 32768);
    __syncthreads();
    { const int tok = F.tid >> 4, c8 = (F.tid & 15) * 8, cg = nb * 128 + c8; float acc[8];
      const float* cb = INP(I_CONVB) + l * 1024 + cg;
#pragma unroll
      for (int e = 0; e < 8; ++e) acc[e] = cb[e];
#pragma unroll
      for (int j = 0; j < 4; ++j) { const int r = row0 + tok - 2 + j;
          if (r >= seq_lo && r < seq_hi) { const v4u x = *(const v4u*)(P + (size_t)r * DINP + C_LRUX + cg); const float* cw = INP(I_CONVW) + (size_t)(l * 4 + j) * 1024 + cg;
#pragma unroll
              for (int w = 0; w < 4; ++w) { acc[2 * w] += cw[2 * w] * bflo(x[w]); acc[2 * w + 1] += cw[2 * w + 1] * bfhi(x[w]); } } }
      *(LAS f32x4*)(U + tok * 128 + c8) = (f32x4){acc[0], acc[1], acc[2], acc[3]}; *(LAS f32x4*)(U + tok * 128 + c8 + 4) = (f32x4){acc[4], acc[5], acc[6], acc[7]};
      v4u o; o.x = pk2(acc[0], acc[1]); o.y = pk2(acc[2], acc[3]); o.z = pk2(acc[4], acc[5]); o.w = pk2(acc[6], acc[7]);
      *(LAS v4u*)(UA + tok * 136 + c8) = o; }
    __syncthreads();
    { const int dir = F.wave >> 2, cq = F.wave & 3, l32 = F.lane & 31, hi = F.lane >> 5, chn = cq * 32 + l32, cg = nb * 128 + chn;
      const bf16* Wr = (const bf16*)(F.wsw + WS_WLRU) + ((size_t)(dir * 2 + 0) * 8 + nb) * 16384 + (size_t)chn * 128;
      const bf16* Wi = (const bf16*)(F.wsw + WS_WLRU) + ((size_t)(dir * 2 + 1) * 8 + nb) * 16384 + (size_t)chn * 128;
      f32x16 accr = {}, acci = {};
#pragma unroll
      for (int ks = 0; ks < 8; ++ks) { const int ko = ks * 16 + hi * 8;
          const bf16x8 a = *(const LAS bf16x8*)(UA + l32 * 136 + ko); const bf16x8 br = *(const bf16x8*)(Wr + ko), bi = *(const bf16x8*)(Wi + ko);
          accr = __builtin_amdgcn_mfma_f32_32x32x16_bf16(a, br, accr, 0, 0, 0); acci = __builtin_amdgcn_mfma_f32_32x32x16_bf16(a, bi, acci, 0, 0, 0); }
      const float ba = INP(I_LBA)[(l * 2 + dir) * 1024 + cg], bi_ = INP(I_LBI)[(l * 2 + dir) * 1024 + cg], sp = softplusf_(-INP(I_LAM)[(l * 2 + dir) * 1024 + cg]);
#pragma unroll
      for (int r = 0; r < 16; ++r) { const int tok = att::crow(r, hi); const float u = U[tok * 128 + chn];
          const float rg = sigmoidf_(accr[r] + ba), ig = sigmoidf_(acci[r] + bi_), la = -8.f * rg * sp, a = __expf(la), x2 = 2.f * la;
          const float em = x2 * (1.f + x2 * (0.5f + x2 * (0.16666667f + x2 * (0.041666668f + x2 * (0.0083333338f + x2 * 0.0013888889f)))));
          const float bc = __builtin_amdgcn_sqrtf(x2 < -0.5f ? 1.f - a * a : -em) * (ig * u);
          AB[(dir * 2 + 0) * 4096 + tok * 128 + chn] = a; AB[(dir * 2 + 1) * 4096 + tok * 128 + chn] = bc; } }
    __syncthreads();
    if (F.tid < 256) { const int dir = F.tid >> 7, chn = F.tid & 127, cg = nb * 128 + chn; const size_t ci = ((size_t)(dir * 2 + b) * NCH + ch) * 1024 + cg;
        LAS float* Aa = AB + (dir * 2) * 4096 + chn; LAS float* Bb = AB + (dir * 2 + 1) * 4096 + chn;
        if (!PASS3) { float h = 0.f, ap = 1.f;
#pragma unroll 8
            for (int s = 0; s < 32; ++s) { const int tok = dir ? 31 - s : s; const float a = Aa[tok * 128]; h = a * h + Bb[tok * 128]; ap *= a;
                if (s == 0 && dir == 1 && ch == 7) ((float*)(F.ws + WS_QUIRK))[b * 1024 + cg] = h; }
            ((float*)(F.ws + WS_CA))[ci] = ap; ((float*)(F.ws + WS_CB))[ci] = h;
        } else { float h = ((const float*)(F.ws + WS_HIN))[ci];
#pragma unroll 8
            for (int s = 0; s < 32; ++s) { const int tok = dir ? 31 - s : s; h = Aa[tok * 128] * h + Bb[tok * 128]; Bb[tok * 128] = h; } } }
    if (PASS3) { __syncthreads();
        const int tok = F.tid >> 4, c8 = (F.tid & 15) * 8, cg = nb * 128 + c8, row = row0 + tok;
        const v4u y = *(const v4u*)(P + (size_t)row * DINP + C_LRUY + cg); float o[8];
#pragma unroll
        for (int w = 0; w < 4; ++w) { const float h0 = AB[4096 + tok * 128 + c8 + 2 * w] + AB[3 * 4096 + tok * 128 + c8 + 2 * w], h1 = AB[4096 + tok * 128 + c8 + 2 * w + 1] + AB[3 * 4096 + tok * 128 + c8 + 2 * w + 1];
            o[2 * w] = h0 * gelu_tanh(bflo(y[w])); o[2 * w + 1] = h1 * gelu_tanh(bfhi(y[w])); }
        v4u ov; ov.x = pk2(o[0], o[1]); ov.y = pk2(o[2], o[3]); ov.z = pk2(o[4], o[5]); ov.w = pk2(o[6], o[7]);
        *(v4u*)((bf16*)(F.ws + WS_MIX) + (size_t)row * DM + 1024 + cg) = ov; }
}
template <bool PASS3>
__device__ __forceinline__ void lru_items(Frame& F, int l, int i0, int i1, int st, bool skipctx) {
    F.tid = ltid(); F.lane = F.tid & 63;
    int it = i0; while (it < i1 && skipctx && ((it >> 3) % NCH) < 8) it += st;
    if (it >= i1) return;
    const int nb = it & 7;
    const bf16* P = (const bf16*)(F.ws + WS_P);
    LAS float* U = (LAS float*)F.lds; LAS bf16* UA = (LAS bf16*)(F.lds + 16384); LAS float* AB = (LAS float*)(F.lds + 32768);
    const int tokc = F.tid >> 4, c8 = (F.tid & 15) * 8, cgc = nb * 128 + c8;
    const int dir = F.wave >> 2, cq = F.wave & 3, l32 = F.lane & 31, hi = F.lane >> 5, chn = cq * 32 + l32, cg = nb * 128 + chn;
    f32x4 cbv[2], cwv[4][2];
#pragma unroll
    for (int q = 0; q < 2; ++q) { cbv[q] = *(const f32x4*)(INP(I_CONVB) + l * 1024 + cgc + 4 * q);
#pragma unroll
        for (int j = 0; j < 4; ++j) cwv[j][q] = *(const f32x4*)(INP(I_CONVW) + (size_t)(l * 4 + j) * 1024 + cgc + 4 * q); }
    bf16x8 wr[8], wi[8];
    { const bf16* Wr = (const bf16*)(F.wsw + WS_WLRU) + ((size_t)(dir * 2 + 0) * 8 + nb) * 16384 + (size_t)chn * 128;
      const bf16* Wi = (const bf16*)(F.wsw + WS_WLRU) + ((size_t)(dir * 2 + 1) * 8 + nb) * 16384 + (size_t)chn * 128;
#pragma unroll
      for (int ks = 0; ks < 8; ++ks) { wr[ks] = *(const bf16x8*)(Wr + ks * 16 + hi * 8); wi[ks] = *(const bf16x8*)(Wi + ks * 16 + hi * 8); } }
    const float ba = INP(I_LBA)[(l * 2 + dir) * 1024 + cg], bi_ = INP(I_LBI)[(l * 2 + dir) * 1024 + cg], sp = softplusf_(-INP(I_LAM)[(l * 2 + dir) * 1024 + cg]);
    v4u xr[4];
#define LRU_LOADX(it_) do { const int sc_ = (it_) >> 3, b_ = sc_ / NCH, ch_ = sc_ % NCH; const int lo_ = ch_ < 8 ? M_LAT + b_ * NCTX : b_ * SEQ, hi_ = lo_ + (ch_ < 8 ? NCTX : SEQ), r0_ = lo_ + (ch_ < 8 ? ch_ : ch_ - 8) * 32; \
        _Pragma("unroll") for (int j_ = 0; j_ < 4; ++j_) { const int r_ = r0_ + tokc - 2 + j_; xr[j_] = (v4u){0u, 0u, 0u, 0u}; if (r_ >= lo_ && r_ < hi_) xr[j_] = *(const v4u*)(P + (size_t)r_ * DINP + C_LRUX + cgc); } } while (0)
    LRU_LOADX(it);
#pragma unroll 1
    for (;;) {
        const int sc = it >> 3, b = sc / NCH, ch = sc % NCH;
        const int row0 = ch < 8 ? M_LAT + b * NCTX + ch * 32 : b * SEQ + (ch - 8) * 32;
        __syncthreads();
        { float acc[8];
#pragma unroll
          for (int e = 0; e < 8; ++e) acc[e] = cbv[e >> 2][e & 3];
#pragma unroll
          for (int j = 0; j < 4; ++j) {
#pragma unroll
              for (int w = 0; w < 4; ++w) { acc[2 * w] += cwv[j][(2 * w) >> 2][(2 * w) & 3] * bflo(xr[j][w]); acc[2 * w + 1] += cwv[j][(2 * w + 1) >> 2][(2 * w + 1) & 3] * bfhi(xr[j][w]); } }
          *(LAS f32x4*)(U + tokc * 128 + c8) = (f32x4){acc[0], acc[1], acc[2], acc[3]}; *(LAS f32x4*)(U + tokc * 128 + c8 + 4) = (f32x4){acc[4], acc[5], acc[6], acc[7]};
          v4u o; o.x = pk2(acc[0], acc[1]); o.y = pk2(acc[2], acc[3]); o.z = pk2(acc[4], acc[5]); o.w = pk2(acc[6], acc[7]);
          *(LAS v4u*)(UA + tokc * 136 + c8) = o; }
        int itn = it + st; while (itn < i1 && skipctx && ((itn >> 3) % NCH) < 8) itn += st;
        if (itn < i1) LRU_LOADX(itn);
        __syncthreads();
        { f32x16 accr = {}, acci = {};
#pragma unroll
          for (int ks = 0; ks < 8; ++ks) { const bf16x8 a = *(const LAS bf16x8*)(UA + l32 * 136 + ks * 16 + hi * 8);
              accr = __builtin_amdgcn_mfma_f32_32x32x16_bf16(a, wr[ks], accr, 0, 0, 0); acci = __builtin_amdgcn_mfma_f32_32x32x16_bf16(a, wi[ks], acci, 0, 0, 0); }
#pragma unroll
          for (int r = 0; r < 16; ++r) { const int tok = att::crow(r, hi); const float u = U[tok * 128 + chn];
              const float rg = sigmoidf_(accr[r] + ba), ig = sigmoidf_(acci[r] + bi_), la = -8.f * rg * sp, a = __expf(la), x2 = 2.f * la;
              const float em = x2 * (1.f + x2 * (0.5f + x2 * (0.16666667f + x2 * (0.041666668f + x2 * (0.0083333338f + x2 * 0.0013888889f)))));
              const float bc = __builtin_amdgcn_sqrtf(x2 < -0.5f ? 1.f - a * a : -em) * (ig * u);
              AB[(dir * 2 + 0) * 4096 + tok * 128 + chn] = a; AB[(dir * 2 + 1) * 4096 + tok * 128 + chn] = bc; } }
        __syncthreads();
        if (F.tid < 256) { const int dr = F.tid >> 7, cn = F.tid & 127, cgs = nb * 128 + cn; const size_t ci = ((size_t)(dr * 2 + b) * NCH + ch) * 1024 + cgs;
            LAS float* Aa = AB + (dr * 2) * 4096 + cn; LAS float* Bb = AB + (dr * 2 + 1) * 4096 + cn;
            if (!PASS3) { float h = 0.f, ap = 1.f;
#pragma unroll 8
                for (int s = 0; s < 32; ++s) { const int tok = dr ? 31 - s : s; const float a = Aa[tok * 128]; h = a * h + Bb[tok * 128]; ap *= a;
                    if (s == 0 && dr == 1 && ch == 7) ((float*)(F.ws + WS_QUIRK))[b * 1024 + cgs] = h; }
                ((float*)(F.ws + WS_CA))[ci] = ap; ((float*)(F.ws + WS_CB))[ci] = h;
            } else { float h = ((const float*)(F.ws + WS_HIN))[ci];
#pragma unroll 8
                for (int s = 0; s < 32; ++s) { const int tok = dr ? 31 - s : s; h = Aa[tok * 128] * h + Bb[tok * 128]; Bb[tok * 128] = h; } } }
        if (PASS3) { __syncthreads();
            const int cgo = nb * 128 + c8, row = row0 + tokc;
            const v4u y = *(const v4u*)(P + (size_t)row * DINP + C_LRUY + cgo); float o[8];
#pragma unroll
            for (int w = 0; w < 4; ++w) { const float h0 = AB[4096 + tokc * 128 + c8 + 2 * w] + AB[3 * 4096 + tokc * 128 + c8 + 2 * w], h1 = AB[4096 + tokc * 128 + c8 + 2 * w + 1] + AB[3 * 4096 + tokc * 128 + c8 + 2 * w + 1];
                o[2 * w] = h0 * gelu_tanh(bflo(y[w])); o[2 * w + 1] = h1 * gelu_tanh(bfhi(y[w])); }
            v4u ov; ov.x = pk2(o[0], o[1]); ov.y = pk2(o[2], o[3]); ov.z = pk2(o[4], o[5]); ov.w = pk2(o[6], o[7]);
            *(v4u*)((bf16*)(F.ws + WS_MIX) + (size_t)row * DM + 1024 + cgo) = ov; }
        if (itn >= i1) break;
        it = itn;
    }
#undef LRU_LOADX
}
__device__ __forceinline__ void lru_carry(Frame& F, int blk) {
    F.tid = ltid(); F.lane = F.tid & 63;
    const int gid = blk * NTHR + F.tid; if (gid >= 4096) return;
    const int dir = gid >> 11, b = (gid >> 10) & 1, cg = gid & 1023;
    const float* CA = (const float*)(F.ws + WS_CA) + ((size_t)(dir * 2 + b) * NCH) * 1024 + cg; const float* CB = (const float*)(F.ws + WS_CB) + ((size_t)(dir * 2 + b) * NCH) * 1024 + cg;
    float* HIN = (float*)(F.ws + WS_HIN) + ((size_t)(dir * 2 + b) * NCH) * 1024 + cg;
    float h = 0.f;
    if (dir == 0) {
#pragma unroll 8
        for (int c = 0; c < NCH; ++c) { HIN[(size_t)c * 1024] = h; h = CA[(size_t)c * 1024] * h + CB[(size_t)c * 1024]; }
    } else {
        for (int c = 7; c >= 0; --c) { HIN[(size_t)c * 1024] = h; h = CA[(size_t)c * 1024] * h + CB[(size_t)c * 1024]; }
        h = ((const float*)(F.ws + WS_QUIRK))[b * 1024 + cg];
#pragma unroll 8
        for (int c = NCH - 1; c >= 8; --c) { HIN[(size_t)c * 1024] = h; h = CA[(size_t)c * 1024] * h + CB[(size_t)c * 1024]; }
    }
}

__device__ __forceinline__ void rope_table(Frame& F) {
    const int i = F.vcu * NTHR + F.tid; if (i >= 2048) return;
    const int pos = i >> 4, f = i & 15; float s, c; sincosf((float)pos * exp2f(-(float)f * (13.287712379549449f / 16.f)), &s, &c);
    float* t = (float*)(F.ws + WS_ROPE); t[i] = c; t[2048 + i] = s;
}
__device__ __forceinline__ void row_prep(Frame& F, int row) {
    F.tid = ltid(); F.lane = F.tid & 63;
    bf16* pr = (bf16*)(F.ws + WS_P) + (size_t)row * DINP; const int lane = F.lane;
    const bool lat = row < M_LAT; const int t = row & (SEQ - 1); const float prow = (float)(t >> 6), pcol = (float)(t & 63);
    { const v4u a = *(const v4u*)(pr + C_QA + lane * 16), b = *(const v4u*)(pr + C_QA + lane * 16 + 8); float ss = 0.f;
#pragma unroll
      for (int w = 0; w < 4; ++w) { const float x0 = bflo(a[w]), x1 = bfhi(a[w]), x2 = bflo(b[w]), x3 = bfhi(b[w]); ss += x0 * x0 + x1 * x1 + x2 * x2 + x3 * x3; }
      ss = wave_sum(ss); if (lane == 0) ((float*)(F.ws + WS_RSQ))[row] = 1.f / sqrtf(ss * (1.f / 1024.f) + RMS_EPS); }
    { const v4u a = *(const v4u*)(pr + C_KVA + lane * 8); float ss = 0.f;
#pragma unroll
      for (int w = 0; w < 4; ++w) { const float x0 = bflo(a[w]), x1 = bfhi(a[w]); ss += x0 * x0 + x1 * x1; }
      ss = wave_sum(ss); if (lane == 0) ((float*)(F.ws + WS_RSKV))[row] = 1.f / sqrtf(ss * (1.f / 512.f) + RMS_EPS); }
    bf16* kr = (bf16*)(F.ws + WS_KR) + (size_t)row * 64;
    if (lat) {
        { const int part = lane >> 5, sub = lane & 31;
          const float inv = exp2f(-(float)sub * (13.287712379549449f / 32.f)); float sn, cs; sincosf((part ? pcol : prow) * inv, &sn, &cs);
          LAS float* tb = (LAS float*)(F.lds + F.wave * 512); tb[lane] = cs; tb[64 + lane] = sn;
          asm volatile("s_waitcnt lgkmcnt(0)" ::: "memory");
#pragma unroll
          for (int i = 0; i < 2; ++i) { const int t = lane + 64 * i; if (t < 80) { const int unit = t >> 2, q = t & 3, hd = unit >> 1, pt = unit & 1;
              bf16* qb = pr + (hd < 8 ? C_SWAQ + hd * 128 : C_SWAK + (hd - 8) * 128) + pt * 64 + 8 * q;
              const v4u a = *(const v4u*)qb, b = *(const v4u*)(qb + 32);
              const f32x4 c0 = *(const LAS f32x4*)(tb + pt * 32 + 8 * q), c1 = *(const LAS f32x4*)(tb + pt * 32 + 8 * q + 4), s0 = *(const LAS f32x4*)(tb + 64 + pt * 32 + 8 * q), s1 = *(const LAS f32x4*)(tb + 64 + pt * 32 + 8 * q + 4);
              v4u oa, ob;
#pragma unroll
              for (int w = 0; w < 4; ++w) { const float cl = w < 2 ? c0[2 * w] : c1[2 * w - 4], ch = w < 2 ? c0[2 * w + 1] : c1[2 * w - 3], sl = w < 2 ? s0[2 * w] : s1[2 * w - 4], sh = w < 2 ? s0[2 * w + 1] : s1[2 * w - 3];
                  const float x1l = bflo(a[w]), x1h = bfhi(a[w]), x2l = bflo(b[w]), x2h = bfhi(b[w]);
                  oa[w] = pk2(x1l * cl - x2l * sl, x1h * ch - x2h * sh); ob[w] = pk2(x2l * cl + x1l * sl, x2h * ch + x1h * sh); }
              *(v4u*)qb = oa; *(v4u*)(qb + 32) = ob; } }
          asm volatile("s_waitcnt lgkmcnt(0)" ::: "memory"); }
        if (lane < 32) { const int part = lane >> 4, i = lane & 15; const bf16* src = pr + C_KR + part * 32;
          const float inv = exp2f(-(float)i * (13.287712379549449f / 16.f)); float s, c; sincosf((part ? pcol : prow) * inv, &s, &c);
          const float x1 = bf2f(src[i]), x2 = bf2f(src[i + 16]);
          kr[part * 32 + i] = (bf16)f2bf(x1 * c - x2 * s); kr[part * 32 + i + 16] = (bf16)f2bf(x2 * c + x1 * s); }
    } else kr[lane] = pr[C_KR + lane];
}

__device__ __forceinline__ float allred16(float x) { return row_sum16(x); }
__device__ __forceinline__ int scan_row(int s, int dir, int b) {
    if (s < NCTX) return M_LAT + b * NCTX + (dir ? NCTX - 1 - s : s);
    const int t = s - NCTX; return b * SEQ + (dir ? SEQ - 1 - t : t);
}
__device__ __forceinline__ void rwkv_scan(Frame& F, int l, int chain) {
    F.tid = ltid(); F.lane = F.tid & 63;
    const int dir = chain >> 5, b = (chain >> 4) & 1, h = chain & 15;
    constexpr int CT = 24, NCHK = (NCTX + SEQ) / CT, STEPF = 392, BUFF = CT * STEPF;
    LAS float* buf = (LAS float*)F.lds; LAS float* ybuf = (LAS float*)(F.lds + 3 * BUFF * 4);
    gcbf RWF = (gcbf)(F.ws + WS_RWF); const size_t RS = (size_t)M_TOT * 1024;
    gflp YS = (gflp)(F.ws + WS_YS) + (size_t)dir * M_TOT * 1024;
    const bool cmp = F.wave < 4; const int lt = F.tid - 256, lst = lt >> 4, lq = lt & 15, lc = h * 64 + 4 * lq;
    const f32x4 ka4 = *(const GAS f32x4*)((gcfl)INP(I_KA) + l * 1024 + (cmp ? 0 : lc));
    v2u gr[2], gk[2], gv[2], gkk[2], ge[2], ga[2];
#pragma unroll
    for (int u = 0; u < 2; ++u) { gr[u] = (v2u){0u, 0u}; gk[u] = gr[u]; gv[u] = gr[u]; gkk[u] = gr[u]; ge[u] = gr[u]; ga[u] = gr[u]; }
#define RW_LOAD(c) do { if (!cmp) { _Pragma("unroll") for (int u_ = 0; u_ < 2; ++u_) { const int s_ = lst + 16 * u_; if (s_ < CT) { const size_t o_ = (size_t)scan_row((c) * CT + s_, dir, b) * 1024 + lc; \
        gr[u_] = *(const GAS v2u*)(RWF + 0 * RS + o_); gk[u_] = *(const GAS v2u*)(RWF + 1 * RS + o_); gv[u_] = *(const GAS v2u*)(RWF + 2 * RS + o_); \
        gkk[u_] = *(const GAS v2u*)(RWF + 3 * RS + o_); ge[u_] = *(const GAS v2u*)(RWF + (4 + dir) * RS + o_); ga[u_] = *(const GAS v2u*)(RWF + (6 + dir) * RS + o_); } } } } while (0)
#define RW_WRITE(bi) do { if (!cmp) { _Pragma("unroll") for (int u_ = 0; u_ < 2; ++u_) { const int s_ = lst + 16 * u_; if (s_ < CT) { LAS float* d_ = buf + (bi) * BUFF + s_ * STEPF + 4 * lq; \
        const float r_[4] = {bflo(gr[u_].x), bfhi(gr[u_].x), bflo(gr[u_].y), bfhi(gr[u_].y)}, k_[4] = {bflo(gk[u_].x), bfhi(gk[u_].x), bflo(gk[u_].y), bfhi(gk[u_].y)}, v_[4] = {bflo(gv[u_].x), bfhi(gv[u_].x), bflo(gv[u_].y), bfhi(gv[u_].y)}; \
        const float q_[4] = {bflo(gkk[u_].x), bfhi(gkk[u_].x), bflo(gkk[u_].y), bfhi(gkk[u_].y)}, e_[4] = {bflo(ge[u_].x), bfhi(ge[u_].x), bflo(ge[u_].y), bfhi(ge[u_].y)}, a_[4] = {bflo(ga[u_].x), bfhi(ga[u_].x), bflo(ga[u_].y), bfhi(ga[u_].y)}; \
        f32x4 w4, kd4, kk4, b4, wr4, v4; float sbr = 0.f, skr = 0.f; \
        _Pragma("unroll") for (int e = 0; e < 4; ++e) { w4[e] = __expf(-e_[e]); kd4[e] = k_[e] * (1.f + (a_[e] - 1.f) * ka4[e]); kk4[e] = q_[e]; b4[e] = q_[e] * a_[e]; wr4[e] = w4[e] * r_[e]; v4[e] = v_[e]; sbr += b4[e] * r_[e]; skr += kd4[e] * r_[e]; } \
        sbr = row_sum16(sbr); skr = row_sum16(skr); \
        *(LAS f32x4*)(d_) = w4; *(LAS f32x4*)(d_ + 64) = kd4; *(LAS f32x4*)(d_ + 128) = kk4; *(LAS f32x4*)(d_ + 192) = b4; *(LAS f32x4*)(d_ + 256) = wr4; *(LAS f32x4*)(d_ + 320) = v4; \
        if (lq == 0) *(LAS f32x2*)(buf + (bi) * BUFF + s_ * STEPF + 384) = (f32x2){sbr, skr}; } } } } while (0)
#define RW_FLUSH(c) do { if (!cmp) { _Pragma("unroll") for (int u_ = 0; u_ < 2; ++u_) { const int s_ = lst + 16 * u_; if (s_ < CT) { const f32x4 y_ = *(const LAS f32x4*)(ybuf + ((c) & 1) * (CT * 64) + s_ * 64 + 4 * lq); \
        *(GAS f32x4*)(YS + (size_t)scan_row((c) * CT + s_, dir, b) * 1024 + lc) = y_; } } } } while (0)
    __syncthreads();
    RW_LOAD(0); RW_WRITE(0); RW_LOAD(1); RW_WRITE(1); RW_LOAD(2);
    __syncthreads();
    const int kg = F.lane & 7, rg = F.lane >> 3, r0 = 16 * (F.wave & 3) + 2 * rg;
    f32x2 St[8];
#pragma unroll
    for (int i = 0; i < 8; ++i) St[i] = (f32x2){0.f, 0.f};
    int bc = 0, bw = 2;
#pragma unroll 1
    for (int c = 0; c < NCHK; ++c) {
        if (c + 2 < NCHK) { RW_WRITE(bw); if (c + 3 < NCHK) RW_LOAD(c + 3); }
        if (c > 0) RW_FLUSH(c - 1);
        if (cmp) {
        const LAS float* bb = buf + bc * BUFF + 8 * kg; const LAS float* vb = buf + bc * BUFF + 320 + r0; const LAS float* sb = buf + bc * BUFF + 384;
        LAS float* yb = ybuf + (c & 1) * (CT * 64) + r0;
        f32x4 w4[2], kd4[2], kk4[2], b4[2], wr4[2];
#pragma unroll
        for (int q = 0; q < 2; ++q) { w4[q] = *(const LAS f32x4*)(bb + 4 * q); kd4[q] = *(const LAS f32x4*)(bb + 64 + 4 * q); kk4[q] = *(const LAS f32x4*)(bb + 128 + 4 * q); b4[q] = *(const LAS f32x4*)(bb + 192 + 4 * q); wr4[q] = *(const LAS f32x4*)(bb + 256 + 4 * q); }
        f32x2 v2 = *(const LAS f32x2*)(vb), s2 = *(const LAS f32x2*)(sb);
#pragma unroll
        for (int st = 0; st < CT; ++st) {
            const int sn = (st + 1 < CT ? st + 1 : st) * STEPF;
            f32x4 nw4[2], nkd4[2], nkk4[2], nb4[2], nwr4[2];
#pragma unroll
            for (int q = 0; q < 2; ++q) { nw4[q] = *(const LAS f32x4*)(bb + sn + 4 * q); nkd4[q] = *(const LAS f32x4*)(bb + sn + 64 + 4 * q); nkk4[q] = *(const LAS f32x4*)(bb + sn + 128 + 4 * q); nb4[q] = *(const LAS f32x4*)(bb + sn + 192 + 4 * q); nwr4[q] = *(const LAS f32x4*)(bb + sn + 256 + 4 * q); }
            const f32x2 nv2 = *(const LAS f32x2*)(vb + sn), ns2 = *(const LAS f32x2*)(sb + sn);
#define PR(x, e) ((((e) >> 1) & 1) ? (f32x2){(x)[(e) >> 2][2], (x)[(e) >> 2][3]} : (f32x2){(x)[(e) >> 2][0], (x)[(e) >> 2][1]})
            f32x2 p, z, tpb, tzb;
            asm("v_pk_mul_f32 %0, %4, %12 op_sel:[0,0] op_sel_hi:[1,0]\n\tv_pk_mul_f32 %1, %4, %16 op_sel:[0,0] op_sel_hi:[1,0]\n\tv_pk_mul_f32 %2, %8, %14 op_sel:[0,0] op_sel_hi:[1,0]\n\tv_pk_mul_f32 %3, %8, %18 op_sel:[0,0] op_sel_hi:[1,0]\n\tv_pk_fma_f32 %0, %5, %12, %0 op_sel:[0,1,0] op_sel_hi:[1,1,1]\n\tv_pk_fma_f32 %1, %5, %16, %1 op_sel:[0,1,0] op_sel_hi:[1,1,1]\n\tv_pk_fma_f32 %2, %9, %14, %2 op_sel:[0,1,0] op_sel_hi:[1,1,1]\n\tv_pk_fma_f32 %3, %9, %18, %3 op_sel:[0,1,0] op_sel_hi:[1,1,1]\n\tv_pk_fma_f32 %0, %6, %13, %0 op_sel:[0,0,0] op_sel_hi:[1,0,1]\n\tv_pk_fma_f32 %1, %6, %17, %1 op_sel:[0,0,0] op_sel_hi:[1,0,1]\n\tv_pk_fma_f32 %2, %10, %15, %2 op_sel:[0,0,0] op_sel_hi:[1,0,1]\n\tv_pk_fma_f32 %3, %10, %19, %3 op_sel:[0,0,0] op_sel_hi:[1,0,1]\n\tv_pk_fma_f32 %0, %7, %13, %0 op_sel:[0,1,0] op_sel_hi:[1,1,1]\n\tv_pk_fma_f32 %1, %7, %17, %1 op_sel:[0,1,0] op_sel_hi:[1,1,1]\n\tv_pk_fma_f32 %2, %11, %15, %2 op_sel:[0,1,0] op_sel_hi:[1,1,1]\n\tv_pk_fma_f32 %3, %11, %19, %3 op_sel:[0,1,0] op_sel_hi:[1,1,1]\n\tv_pk_add_f32 %0, %0, %2\n\tv_pk_add_f32 %1, %1, %3\n\tv_pk_mul_f32 %4, %4, %20 op_sel:[0,0] op_sel_hi:[1,0]\n\tv_pk_mul_f32 %5, %5, %20 op_sel:[0,1] op_sel_hi:[1,1]\n\tv_pk_mul_f32 %6, %6, %21 op_sel:[0,0] op_sel_hi:[1,0]\n\tv_pk_mul_f32 %7, %7, %21 op_sel:[0,1] op_sel_hi:[1,1]\n\tv_pk_mul_f32 %8, %8, %22 op_sel:[0,0] op_sel_hi:[1,0]\n\tv_pk_mul_f32 %9, %9, %22 op_sel:[0,1] op_sel_hi:[1,1]\n\tv_pk_mul_f32 %10, %10, %23 op_sel:[0,0] op_sel_hi:[1,0]\n\tv_pk_mul_f32 %11, %11, %23 op_sel:[0,1] op_sel_hi:[1,1]\n\tv_pk_fma_f32 %4, %28, %24, %4 op_sel:[0,0,0] op_sel_hi:[1,0,1]\n\tv_pk_fma_f32 %5, %28, %24, %5 op_sel:[0,1,0] op_sel_hi:[1,1,1]\n\tv_pk_fma_f32 %6, %28, %25, %6 op_sel:[0,0,0] op_sel_hi:[1,0,1]\n\tv_pk_fma_f32 %7, %28, %25, %7 op_sel:[0,1,0] op_sel_hi:[1,1,1]\n\tv_pk_fma_f32 %8, %28, %26, %8 op_sel:[0,0,0] op_sel_hi:[1,0,1]\n\tv_pk_fma_f32 %9, %28, %26, %9 op_sel:[0,1,0] op_sel_hi:[1,1,1]\n\tv_pk_fma_f32 %10, %28, %27, %10 op_sel:[0,0,0] op_sel_hi:[1,0,1]\n\tv_pk_fma_f32 %11, %28, %27, %11 op_sel:[0,1,0] op_sel_hi:[1,1,1]"
                : "=&v"(p), "=&v"(z), "=&v"(tpb), "=&v"(tzb), "+v"(St[0]), "+v"(St[1]), "+v"(St[2]), "+v"(St[3]), "+v"(St[4]), "+v"(St[5]), "+v"(St[6]), "+v"(St[7])
                : "v"(PR(kk4, 0)), "v"(PR(kk4, 2)), "v"(PR(kk4, 4)), "v"(PR(kk4, 6)), "v"(PR(wr4, 0)), "v"(PR(wr4, 2)), "v"(PR(wr4, 4)), "v"(PR(wr4, 6)),
                  "v"(PR(w4, 0)), "v"(PR(w4, 2)), "v"(PR(w4, 4)), "v"(PR(w4, 6)), "v"(PR(kd4, 0)), "v"(PR(kd4, 2)), "v"(PR(kd4, 4)), "v"(PR(kd4, 6)), "v"(v2));
            float p0 = p.x, p1 = p.y, z0 = z.x, z1 = z.y;
#define D4(ctl) "v_add_f32_dpp %0, %0, %0 " ctl " row_mask:0xf bank_mask:0xf\n\tv_add_f32_dpp %1, %1, %1 " ctl " row_mask:0xf bank_mask:0xf\n\tv_add_f32_dpp %2, %2, %2 " ctl " row_mask:0xf bank_mask:0xf\n\tv_add_f32_dpp %3, %3, %3 " ctl " row_mask:0xf bank_mask:0xf\n\t"
            asm volatile("s_nop 1\n\t" D4("quad_perm:[1,0,3,2]") D4("quad_perm:[2,3,0,1]") D4("row_half_mirror") "s_nop 0"
                : "+v"(p0), "+v"(p1), "+v"(z0), "+v"(z1));
#undef D4
            const f32x2 pp = {p0, p1}, zz = {z0, z1};
            { f32x2 y;
              asm("v_pk_fma_f32 %0, %9, %11, %10 op_sel:[0,0,0] op_sel_hi:[1,0,1] neg_lo:[1,0,0] neg_hi:[1,0,0]\n\tv_pk_fma_f32 %0, %12, %11, %0 op_sel:[0,1,0] op_sel_hi:[1,1,1]\n\tv_pk_fma_f32 %1, %9, %13, %1 op_sel:[0,0,0] op_sel_hi:[1,0,1] neg_lo:[1,0,0] neg_hi:[1,0,0]\n\tv_pk_fma_f32 %2, %9, %13, %2 op_sel:[0,1,0] op_sel_hi:[1,1,1] neg_lo:[1,0,0] neg_hi:[1,0,0]\n\tv_pk_fma_f32 %3, %9, %14, %3 op_sel:[0,0,0] op_sel_hi:[1,0,1] neg_lo:[1,0,0] neg_hi:[1,0,0]\n\tv_pk_fma_f32 %4, %9, %14, %4 op_sel:[0,1,0] op_sel_hi:[1,1,1] neg_lo:[1,0,0] neg_hi:[1,0,0]\n\tv_pk_fma_f32 %5, %9, %15, %5 op_sel:[0,0,0] op_sel_hi:[1,0,1] neg_lo:[1,0,0] neg_hi:[1,0,0]\n\tv_pk_fma_f32 %6, %9, %15, %6 op_sel:[0,1,0] op_sel_hi:[1,1,1] neg_lo:[1,0,0] neg_hi:[1,0,0]\n\tv_pk_fma_f32 %7, %9, %16, %7 op_sel:[0,0,0] op_sel_hi:[1,0,1] neg_lo:[1,0,0] neg_hi:[1,0,0]\n\tv_pk_fma_f32 %8, %9, %16, %8 op_sel:[0,1,0] op_sel_hi:[1,1,1] neg_lo:[1,0,0] neg_hi:[1,0,0]"
                : "=&v"(y), "+v"(St[0]), "+v"(St[1]), "+v"(St[2]), "+v"(St[3]), "+v"(St[4]), "+v"(St[5]), "+v"(St[6]), "+v"(St[7])
                : "v"(pp), "v"(zz), "v"(s2), "v"(v2), "v"(PR(b4, 0)), "v"(PR(b4, 2)), "v"(PR(b4, 4)), "v"(PR(b4, 6)));
              *(LAS f32x2*)(yb + st * 64) = y; }
#undef PR
#pragma unroll
            for (int q = 0; q < 2; ++q) { w4[q] = nw4[q]; kd4[q] = nkd4[q]; kk4[q] = nkk4[q]; b4[q] = nb4[q]; wr4[q] = nwr4[q]; }
            v2 = nv2; s2 = ns2;
        }
        }
        __syncthreads();
        bc = bc == 2 ? 0 : bc + 1; bw = bw == 2 ? 0 : bw + 1;
    }
    RW_FLUSH(NCHK - 1);
#undef RW_LOAD
#undef RW_WRITE
#undef RW_FLUSH
}
__device__ __forceinline__ void rwkv_out_row(Frame& F, int l, int row) {
    F.tid = ltid(); F.lane = F.tid & 63;
    const int c0 = F.lane * 16; const float* yf = (const float*)(F.ws + WS_YS) + (size_t)row * 1024 + c0; const float* yb = yf + (size_t)M_TOT * 1024;
    float y[16]; float s = 0.f;
#pragma unroll
    for (int j = 0; j < 4; ++j) { const f32x4 a = __builtin_nontemporal_load((const f32x4*)(yf + 4 * j)), b = __builtin_nontemporal_load((const f32x4*)(yb + 4 * j));
#pragma unroll
        for (int e = 0; e < 4; ++e) { y[4 * j + e] = a[e] + b[e]; s += y[4 * j + e]; } }
    s = quad_sum(s); const float mu = s * (1.f / 64.f); float q = 0.f;
#pragma unroll
    for (int e = 0; e < 16; ++e) { y[e] -= mu; q += y[e] * y[e]; }
    q = quad_sum(q); const float rstd = 1.f / sqrtf(q * (1.f / 64.f) + GN_EPS);
    const bf16* RWF = (const bf16*)(F.ws + WS_RWF); const size_t RS = (size_t)M_TOT * 1024, o = (size_t)row * 1024 + c0;
    const float sbv = ((const float*)(F.ws + WS_SB))[(size_t)row * 16 + (F.lane >> 2)];
    const float* lg = INP(I_LNG) + l * 1024 + c0; const float* lb = INP(I_LNB) + l * 1024 + c0;
    bf16* dst = (bf16*)(F.ws + WS_MIX) + (size_t)row * DM + 3072 + c0;
#pragma unroll
    for (int hf = 0; hf < 2; ++hf) { const v4u vv = *(const v4u*)(RWF + 2 * RS + o + 8 * hf), gg = *(const v4u*)(RWF + 8 * RS + o + 8 * hf); float r[8];
#pragma unroll
        for (int w = 0; w < 4; ++w) { const int e = 8 * hf + 2 * w;
            r[2 * w] = (y[e] * rstd * lg[e] + lb[e] + sbv * bflo(vv[w])) * bflo(gg[w]); r[2 * w + 1] = (y[e + 1] * rstd * lg[e + 1] + lb[e + 1] + sbv * bfhi(vv[w])) * bfhi(gg[w]); }
        v4u ov; ov.x = pk2(r[0], r[1]); ov.y = pk2(r[2], r[3]); ov.z = pk2(r[4], r[5]); ov.w = pk2(r[6], r[7]); *(v4u*)(dst + 8 * hf) = ov; }
}

#ifndef W_OUT_K0
#define W_OUT_K0 0
#endif
#ifndef W_OUT_K1
#define W_OUT_K1 3072
#endif
struct MlaTiles { gcbf KV; gcbf KR; int ctx_row0, lat_row0, h;
    __device__ __forceinline__ att::Tile operator()(int j) const { const int row = j < 4 ? ctx_row0 + 64 * j : lat_row0 + 64 * (j - 4);
        att::Tile t; t.kn = KV + (size_t)row * 2048 + h * 256; t.v = t.kn + 128; t.kr = KR + (size_t)row * 64; t.mtype = 0; t.krel0 = 0; return t; } };
struct SwaTiles { gcbf P; int blk_row0, ctx_row0, kvh, nwin, has_prev, has_next;
    __device__ __forceinline__ att::Tile operator()(int j) const { att::Tile t; int row; t.mtype = 0; t.krel0 = 0;
        if (j >= nwin) row = ctx_row0 + 64 * (j - nwin);
        else if (j < 2) row = blk_row0 + 64 * j;
        else if (has_prev && j < 4) { row = blk_row0 - 128 + 64 * (j - 2); t.mtype = 1; t.krel0 = -128 + 64 * (j - 2); }
        else { const int sub = j - 2 - 2 * has_prev; row = blk_row0 + 128 + 64 * sub; t.mtype = 2; t.krel0 = 128 + 64 * sub; }
        t.kn = P + (size_t)row * DINP + C_SWAK + kvh * 128; t.v = P + (size_t)row * DINP + C_SWAV + kvh * 128; t.kr = nullptr; return t; } };

#ifndef MLA_SDEPTH
#define MLA_SDEPTH 1
#endif
__device__ __forceinline__ void mla_item(Frame& F, int b, int h, int qb, bool ctxq) {
    F.tid = ltid(); F.lane = F.tid & 63;
    const int r32 = F.lane & 31; const int t = qb * 256 + F.wave * 32 + r32;
    const int roww0 = ctxq ? M_LAT + b * NCTX + F.wave * 32 : b * SEQ + qb * 256 + F.wave * 32;
    gcbf Qw = (gcbf)(F.ws + WS_Q) + (size_t)(roww0 + r32) * 1536 + h * 192;
    MlaTiles ts{(gcbf)(F.ws + WS_KV), (gcbf)(F.ws + WS_KR), M_LAT + b * NCTX, b * SEQ, h};
    gbfp Ow = (gbfp)(F.ws + WS_MIX) + (size_t)roww0 * DM + 2048 + h * 128;
    att::attn_body<192, 2048, 2048, false, false, MLA_SDEPTH>(Qw, ctxq ? 0 : 1, t >> 6, t & 63, (gcfl)(F.ws + WS_ROPE), 0, 0.f, ts, ctxq ? 4 : 132, Ow, (LAS char*)F.lds);
}
__device__ __forceinline__ void swa_item(Frame& F, int l, int b, int n, int kvh, int half, bool ctxq, int hq_ctx) {
    F.tid = ltid(); F.lane = F.tid & 63;
    const int r32 = F.lane & 31; gcbf P = (gcbf)(F.ws + WS_P);
    int hq, qi, roww0, t;
    if (ctxq) { hq = hq_ctx; kvh = hq >> 2; qi = 0; roww0 = M_LAT + b * NCTX + F.wave * 32; t = 0; }
    else { hq = kvh * 4 + 2 * half + (F.wave >> 2); qi = (F.wave & 3) * 32 + r32; roww0 = b * SEQ + n * 128 + (F.wave & 3) * 32; t = n * 128 + qi; }
    gcbf Qw = P + (size_t)(roww0 + r32) * DINP + C_SWAQ + hq * 128;
    SwaTiles ts; ts.P = P; ts.blk_row0 = b * SEQ + n * 128; ts.ctx_row0 = M_LAT + b * NCTX; ts.kvh = kvh;
    ts.has_prev = (!ctxq && n > 0) ? 1 : 0; ts.has_next = (!ctxq && n < SEQ / 128 - 1) ? 1 : 0; ts.nwin = ctxq ? 0 : 2 + 2 * ts.has_prev + 2 * ts.has_next;
    gbfp Ow = (gbfp)(F.ws + WS_MIX) + (size_t)roww0 * DM + hq * 128;
    const float sink_l2 = INP(I_SINK)[l * 8 + hq] * 1.4426950408889634f;
    att::attn_body<128, DINP, DINP, true, true, 2>(Qw, 0, 0, 0, (gcfl)nullptr, qi, sink_l2, ts, ts.nwin + 4, Ow, (LAS char*)F.lds);
}

#ifndef DBG_PHASES
#define DBG_PHASES 0xfffff
#endif
#define PH(n) ((DBG_PHASES >> (n)) & 1)
#ifndef DUP_PHASES
#define DUP_PHASES 0
#endif
#define REP(n) _Pragma("unroll") for (int rep_ = 0; rep_ < (((DUP_PHASES >> (n)) & 1) ? 2 : 1); ++rep_)
__global__ void __launch_bounds__(NTHR, 2) mk_fwd(Args args) {
    extern __shared__ __attribute__((aligned(16))) unsigned char lds[];
    Frame F;
    F.lds = (LAS unsigned char*)lds;
    F.tid = threadIdx.x; F.lane = F.tid & 63; F.wave = __builtin_amdgcn_readfirstlane(F.tid >> 6);
    F.G = gridDim.x; { const int bx = blockIdx.x; F.vcu = (F.G % 8 == 0) ? (bx % 8) * (F.G / 8) + bx / 8 : bx; }
    F.gw = F.vcu * NWAVES + F.wave; F.NGW = F.G * NWAVES;
    F.ws = args.ws; F.out = args.out; F.ctl = (gu32*)(args.ws + WS_CTL);
    F.A = (const __attribute__((address_space(4))) Args*)__builtin_amdgcn_kernarg_segment_ptr();
    for (int u = F.tid; u < (LDS_BYTES - LDSCTL_OFF) / 4; u += NTHR) ((LAS unsigned*)(F.lds + LDSCTL_OFF))[u] = 0u;
    __syncthreads();
    XcdBarrier bar = xcd_barrier_post((unsigned*)(args.ws + WS_CTL) + 4096, (volatile LAS unsigned*)(F.lds + MISC_OFF) + 8);
    const bool rwkv_blk = (blockIdx.x & 3) == 0;
    XcdBarrier bar2; bar2.bar = (unsigned*)(args.ws + WS_CTL) + 8192; bar2.x = 0; bar2.st = (volatile LAS unsigned*)(F.lds + MISC_OFF) + 12; bar2.nparts = gridDim.x - ((gridDim.x + 3) >> 2);
    if (!rwkv_blk) { const unsigned np_ = bar2.nparts; bar2 = xcd_barrier_post((unsigned*)(args.ws + WS_CTL) + 8192, (volatile LAS unsigned*)(F.lds + MISC_OFF) + 12); bar2.nparts = np_; }
#define SUB_BAR() do { bar2.bar = launder(bar2.bar); bar2.x = launder(bar2.x); xcd_barrier(bar2); F.ws = launder_g(F.ws); F.wsw = F.ws + (size_t)lcur * WSET_STRIDE; F.A = launder(F.A); F.tid = ltid(); F.lane = F.tid & 63; } while (0)
#define GRID_BAR() do { bar.bar = launder(bar.bar); bar.x = launder(bar.x); xcd_barrier(bar); F.ws = launder_g(F.ws); F.wsw = F.ws + (size_t)lcur * WSET_STRIDE; F.A = launder(F.A); F.tid = ltid(); F.lane = F.tid & 63; } while (0)
    const int bx = blockIdx.x; int lcur = 0; F.wsw = F.ws;
    bf16* H = (bf16*)(F.ws + WS_H); xres_t* X = (xres_t*)(F.ws + WS_X);

    REP(0) if (PH(0)) { mod_partials(F);
    convert_weights(F, 0, F.gw, F.NGW); }
    GRID_BAR();
    if (PH(1)) { mod_reduce(F); rope_table(F); }
    GRID_BAR();

#pragma unroll 1
    for (int l = 0; l < 2; ++l) {
        lcur = l; F.wsw = F.ws + (size_t)l * WSET_STRIDE;
        const bool wctx = (l == 0);
        const int MO = wctx ? M_TOT : M_LAT;
        if (PH(2) && l == 0) {
            int cs = -1;
            for (int row = F.gw; row < M_TOT; row += F.NGW) { const int s = row_s(row);
                if (s != cs) { __syncthreads(); ln_stage(F, LNV_SC, mod_ptr(F, 0, s, 1)); ln_stage(F, LNV_SH, mod_ptr(F, 0, s, 0)); __syncthreads(); cs = s; }
                const float* xs = row < M_LAT ? INP(I_X) + (size_t)row * DM : INP(I_CTX) + (size_t)(row - M_LAT) * DM;
                ln_row<0>(F, xs, nullptr, nullptr, true, H + (size_t)row * DM); }
            __syncthreads();
        }
        GRID_BAR();
        REP(3) if (PH(3)) { pg8::Gemm g{H, (const bf16*)(F.wsw + WS_WIN), M_TOT, DINP, DM, DM, DM}; pg8::StaticOrder S; S.init(M_TOT, DINP, F.G, bx);
          pg8::EpiBf16<0> E{(bf16*)(F.ws + WS_P), DINP, nullptr};
          pg8::gemm_phase<pg8::EpiBf16<0>, pg8::StaticOrder, true, true>(F.lds, g, S, E); }
        GRID_BAR();
        REP(4) if (PH(4)) for (int it = F.vcu; it < 528; it += F.G) rwkv_feat_item(F, l, it);
        REP(5) if (PH(5)) { if (F.G == 256) { if (F.vcu < 16) lru_items<false>(F, l, F.vcu, 64, 16, false);
                                              else lru_items<false>(F, l, 64 + F.vcu - 16, 2 * NCH * 8, 240, false); }
                            else for (int it = F.vcu; it < 2 * NCH * 8; it += F.G) lru_item<false>(F, l, it); }
        __syncthreads();
        if (PH(6)) for (int row = F.gw; row < M_TOT; row += F.NGW) row_prep(F, row);
        GRID_BAR();
        REP(8) if (rwkv_blk) { const int nrw = (F.G + 3) >> 2; REP(18) if (PH(8)) for (int chain = bx >> 2; chain < 64; chain += nrw) rwkv_scan(F, l, chain); }
        else REP(19) { const int x8 = bx & 7, naw = F.G - ((F.G + 3) >> 2);
            const int aw = (F.G == 256) ? ((x8 < 4 ? x8 - 1 : x8 - 2) * 32 + (bx >> 3)) : ((bx >> 2) * 3 + (bx & 3) - 1);
            if (PH(7) && aw < 8) lru_carry(F, aw);
            if (PH(7)) { pg8::Gemm g{(const bf16*)(F.ws + WS_P) + C_QA, (const bf16*)(F.wsw + WS_WQB), M_TOT, 1536, 1024, DINP, 1024}; pg8::StaticOrder S; S.init(M_TOT, 1536, naw, aw);
              pg8::EpiBf16<2> E{(bf16*)(F.ws + WS_Q), 1536, (const float*)(F.ws + WS_RSQ)};
              pg8::gemm_phase<pg8::EpiBf16<2>, pg8::StaticOrder, true, true>(F.lds, g, S, E); }
            if (PH(7)) { pg8::Gemm g{(const bf16*)(F.ws + WS_P) + C_KVA, (const bf16*)(F.wsw + WS_WKVB), M_TOT, 2048, 512, DINP, 512}; pg8::StaticOrder S; S.init(M_TOT, 2048, naw, aw);
              pg8::EpiBf16<2> E{(bf16*)(F.ws + WS_KV), 2048, (const float*)(F.ws + WS_RSKV)};
              pg8::gemm_phase<pg8::EpiBf16<2>, pg8::StaticOrder, true, true>(F.lds, g, S, E); }
            SUB_BAR();
            if (PH(9)) for (int it = aw; it < 512; it += naw) mla_item(F, it >> 8, (it >> 5) & 7, it & 31, false);
            if (PH(9) && wctx) for (int it = aw; it < 16; it += naw) mla_item(F, it >> 3, it & 7, 0, true);
            if (PH(10)) for (int it = aw; it < 512; it += naw) swa_item(F, l, it >> 8, (it >> 2) & 63, (it >> 1) & 1, it & 1, false, 0);
            if (PH(10) && wctx) for (int it = aw; it < 16; it += naw) swa_item(F, l, it >> 3, 0, 0, 0, true, it & 7);
            if (PH(11)) { if (naw == 192) { const int i0 = aw < 128 ? aw : 1280 + aw - 128, st_ = aw < 128 ? 128 : 64, i1 = aw < 128 ? 1280 : 2 * NCH * 8;
                                            lru_items<true>(F, l, i0, i1, st_, !wctx); }
                          else for (int it = aw; it < 2 * NCH * 8; it += naw) { if (!wctx && ((it >> 3) % NCH) < 8) continue; lru_item<true>(F, l, it); } }
            if (l == 0) { __syncthreads(); convert_weights(F, 1, aw * NWAVES + F.wave, naw * NWAVES); }
            const int k1 = l ? W_OUT_K1 : W_OUT_K0;
            if (k1 > 0) { SUB_BAR();
                pg8::Gemm g{(const bf16*)(F.ws + WS_MIX), (const bf16*)(F.wsw + WS_WOUT), M_LAT, DM, k1, DM, DM}; pg8::StaticOrder S; S.init(M_LAT, DM, naw, aw);
                pg8::EpiBf16<0> E{(bf16*)(F.ws + WS_Y1), DM, nullptr};
                pg8::gemm_phase<pg8::EpiBf16<0>, pg8::StaticOrder, true, true>(F.lds, g, S, E); }
        }
        GRID_BAR();
        REP(12) if (PH(12)) for (int row = F.gw; row < MO; row += F.NGW) rwkv_out_row(F, l, row);
        GRID_BAR();
        REP(13) if (PH(13)) {
          const int k1 = l ? W_OUT_K1 : W_OUT_K0;
          if (k1 == 0) { pg8::Gemm g{(const bf16*)(F.ws + WS_MIX), (const bf16*)(F.wsw + WS_WOUT), M_LAT, DM, DM, DM, DM}; pg8::StaticOrder S; S.init(M_LAT, DM, F.G, bx);
            pg8::EpiBf16<0> E{(bf16*)(F.ws + WS_Y1), DM, nullptr};
            pg8::gemm_phase<pg8::EpiBf16<0>, pg8::StaticOrder, true, true>(F.lds, g, S, E); }
          else { pg8::Gemm g{(const bf16*)(F.ws + WS_MIX) + k1, (const bf16*)(F.wsw + WS_WOUT) + k1, M_LAT, DM, DM - k1, DM, DM}; pg8::StaticOrder S; S.init(M_LAT, DM, F.G, bx);
            pg8::EpiBf16<3> E{(bf16*)(F.ws + WS_Y1), DM, nullptr};
            pg8::gemm_phase<pg8::EpiBf16<3>, pg8::StaticOrder, true, true>(F.lds, g, S, E); }
          if (wctx) {
              pg8::Gemm g2{(const bf16*)(F.ws + WS_MIX) + (size_t)M_LAT * DM, (const bf16*)(F.wsw + WS_WOUT), M_CTX, DM, DM / 8, DM, DM}; pg8::SplitOrder S2; S2.init(M_CTX, DM, DM / 8, bx);
              pg8::EpiF32 E2{(float*)(F.ws + WS_YP), DM, (size_t)M_CTX * DM};
              pg8::gemm_phase<pg8::EpiF32, pg8::SplitOrder, true, true>(F.lds, g2, S2, E2); } }
        GRID_BAR();
        if (PH(14)) { int cs = -1;
          for (int row = F.gw; row < MO; row += F.NGW) { const int s = row_s(row);
            if (s != cs) { __syncthreads(); if (cs < 0) { ln_stage(F, LNV_G, INP(I_LN1G) + l * DM); ln_stage(F, LNV_B, INP(I_LN1B) + l * DM); }
                ln_stage(F, LNV_GA, mod_ptr(F, l, s, 2)); ln_stage(F, LNV_SC, mod_ptr(F, l, s, 4)); ln_stage(F, LNV_SH, mod_ptr(F, l, s, 3)); __syncthreads(); cs = s; }
            bf16* yrow = (bf16*)(F.ws + WS_Y1) + (size_t)row * DM;
            if (row >= M_LAT) sum_partials_row(F, (const float*)(F.ws + WS_YP) + (size_t)(row - M_LAT) * DM, (size_t)M_CTX * DM, yrow);
            if (l == 0) { const float* xs = row < M_LAT ? INP(I_X) + (size_t)row * DM : INP(I_CTX) + (size_t)(row - M_LAT) * DM;
                ln_row<1, false, XH16>(F, xs, yrow, X + (size_t)row * DM, true, H + (size_t)row * DM); }
            else ln_row<1, XH16, XH16>(F, X + (size_t)row * DM, yrow, X + (size_t)row * DM, true, H + (size_t)row * DM); }
          __syncthreads(); }
        GRID_BAR();
        REP(15) if (PH(15)) { pg8::Gemm g{H, (const bf16*)(F.wsw + WS_WFF1), MO, DFF, DM, DM, DM}; pg8::StaticOrder S; S.init(MO, DFF, F.G, bx);
          pg8::EpiBf16<1> E{(bf16*)(F.ws + WS_HID), DFF, nullptr};
          pg8::gemm_phase<pg8::EpiBf16<1>, pg8::StaticOrder, true, true>(F.lds, g, S, E); }
        GRID_BAR();
        REP(16) if (PH(16)) { pg8::Gemm g{(const bf16*)(F.ws + WS_HID), (const bf16*)(F.wsw + WS_WFF2), M_LAT, DM, DFF, DFF, DFF}; pg8::StaticOrder S; S.init(M_LAT, DM, F.G, bx);
          pg8::EpiBf16<0> E{(bf16*)(F.ws + WS_Y2), DM, nullptr};
          pg8::gemm_phase<pg8::EpiBf16<0>, pg8::StaticOrder, true, true>(F.lds, g, S, E);
          if (wctx) {
              pg8::Gemm g2{(const bf16*)(F.ws + WS_HID) + (size_t)M_LAT * DFF, (const bf16*)(F.wsw + WS_WFF2), M_CTX, DM, DFF / 8, DFF, DFF}; pg8::SplitOrder S2; S2.init(M_CTX, DM, DFF / 8, bx);
              pg8::EpiF32 E2{(float*)(F.ws + WS_YP), DM, (size_t)M_CTX * DM};
              pg8::gemm_phase<pg8::EpiF32, pg8::SplitOrder, true, true>(F.lds, g2, S2, E2); } }
        GRID_BAR();
        if (!PH(17)) {} else if (l == 0) { int cs = -1;
            for (int row = F.gw; row < M_TOT; row += F.NGW) { const int s = row_s(row);
                if (s != cs) { __syncthreads(); if (cs < 0) { ln_stage(F, LNV_G, INP(I_LN2G)); ln_stage(F, LNV_B, INP(I_LN2B)); }
                    ln_stage(F, LNV_GA, mod_ptr(F, 0, s, 5)); ln_stage(F, LNV_SC, mod_ptr(F, 1, s, 1)); ln_stage(F, LNV_SH, mod_ptr(F, 1, s, 0)); __syncthreads(); cs = s; }
                bf16* yrow = (bf16*)(F.ws + WS_Y2) + (size_t)row * DM;
                if (row >= M_LAT) sum_partials_row(F, (const float*)(F.ws + WS_YP) + (size_t)(row - M_LAT) * DM, (size_t)M_CTX * DM, yrow);
                ln_row<1, XH16, XH16>(F, X + (size_t)row * DM, yrow, X + (size_t)row * DM, true, H + (size_t)row * DM); }
            __syncthreads();
        } else { int cs = -1;
            for (int row = F.gw; row < M_LAT; row += F.NGW) { const int s = row_s(row);
                if (s != cs) { __syncthreads(); if (cs < 0) { ln_stage(F, LNV_G, INP(I_LN2G) + DM); ln_stage(F, LNV_B, INP(I_LN2B) + DM); }
                    ln_stage(F, LNV_GA, mod_ptr(F, 1, s, 5)); __syncthreads(); cs = s; }
                ln_row<1, XH16, false>(F, X + (size_t)row * DM, (const bf16*)(F.ws + WS_Y2) + (size_t)row * DM, F.out + (size_t)row * DM, false, nullptr); }
        }
    }
}

extern "C" void kernel_launch(void* const* d_in, const int* in_sizes, int n_in, void* d_out, int out_size, void* d_ws, size_t ws_size, hipStream_t stream) {
    static int grid = 0;
    if (grid == 0) {
        if (n_in != 38 || out_size != M_LAT * DM || ws_size < WS_END) { fprintf(stderr, "kernel_launch: unexpected shapes: n_in %d out %d ws %zu (need %zu)\n", n_in, out_size, ws_size, (size_t)WS_END); grid = -1; return; }
        int dev = 0, cus = 0, per_cu = 0;
        if (hipGetDevice(&dev) != hipSuccess || hipDeviceGetAttribute(&cus, hipDeviceAttributeMultiprocessorCount, dev) != hipSuccess) { grid = -1; return; }
        if (hipFuncSetAttribute((const void*)mk_fwd, hipFuncAttributeMaxDynamicSharedMemorySize, LDS_BYTES) != hipSuccess) { fprintf(stderr, "kernel_launch: hipFuncSetAttribute failed\n"); grid = -1; return; }
        if (hipOccupancyMaxActiveBlocksPerMultiprocessor(&per_cu, (const void*)mk_fwd, NTHR, LDS_BYTES) != hipSuccess || per_cu < 1) fprintf(stderr, "kernel_launch: occupancy query says %d\n", per_cu);
        (void)hipGetLastError();
        grid = cus;
    }
    if (grid < 0) return;
    if (hipMemsetAsync((char*)d_ws + WS_CTL, 0, CTL_ZERO_BYTES, stream) != hipSuccess) return;
    Args a{};
    for (int i = 0; i < 38; ++i) a.in[i] = (const float*)d_in[i];
    a.out = (float*)d_out; a.ws = (unsigned char*)d_ws;
    hipLaunchKernelGGL(mk_fwd, dim3(grid), dim3(NTHR), LDS_BYTES, stream, a);
    const hipError_t le = hipPeekAtLastError();
    if (le != hipSuccess) fprintf(stderr, "kernel_launch: launch failed: %s\n", hipGetErrorName(le));
}
```

```cpp
#include <hip/hip_runtime.h>
#include <hip/hip_bf16.h>
#include <cstdio>
#include <cstdint>

namespace pg8 {
#define PG8_LAS __attribute__((address_space(3)))
typedef unsigned short bf16_t;
typedef short bf16x8 __attribute__((ext_vector_type(8)));
typedef float f32x4 __attribute__((ext_vector_type(4)));
typedef unsigned u32x4 __attribute__((ext_vector_type(4)));
constexpr int BM = 256, BK = 64, HALF = 128, HTB = HALF * BK * 2  , STAGE_BYTES = 8 * HTB, NXCD = 8, WGM = 8;

__host__ __device__ __forceinline__ int lds_byte(int r, int c) { const int st = (r >> 4) * 2 + (c >> 5), rr = r & 15, cc = c & 31, ob = rr * 64 + cc * 2; return st * 1024 + (ob ^ (((ob >> 9) & 1) << 5)); }
__host__ __device__ __forceinline__ void stage_rc(int b, int& R, int& C) { const int st = b / 1024, sb = b % 1024, swz = sb ^ (((sb >> 9) & 1) << 5); R = (st >> 1) * 16 + swz / 64; C = (st & 1) * 32 + (swz % 64) / 2; }
__host__ __device__ __forceinline__ int perm32(int rho) { const int n = rho >> 4, i = rho & 15; return 8 * (i >> 2) + 4 * n + (i & 3); }

struct Unit { int pm, pn, ko, ks; };
struct Gemm { const bf16_t* A; const bf16_t* Bt; int M, N, K, lda, ldb; };

struct StaticOrder {
    int nM, nN, nwg, G, c;
    __host__ __device__ void init(int M, int N, int G_, int c_) { nM = M / BM; nN = N / BM; nwg = nM * nN; G = G_; c = c_; }
    __host__ __device__ bool next(int i, Unit& u) const {
        const long L = (long)i * G + c; if (L >= nwg) return false;
        int wgid = (int)L; { const int q = nwg / NXCD, r = nwg % NXCD, xcd = wgid % NXCD, off = wgid / NXCD; wgid = (xcd < r ? xcd * (q + 1) : r * (q + 1) + (xcd - r) * q) + off; }
        const int nig = WGM * nN, gid = wgid / nig, fm = gid * WGM, gsz = (nM - fm) < WGM ? (nM - fm) : WGM;
        u.pm = fm + ((wgid % nig) % gsz); u.pn = (wgid % nig) / gsz; u.ko = 0; u.ks = 0; return true;
    }
    __device__ __forceinline__ void a_ready(const Unit&) const {}
    __device__ __forceinline__ void done(const Unit&) const {}
};
struct SplitOrder {
    int nN, nitems, kslice, c;
    __host__ __device__ void init(int M, int N, int Kslice, int c_) { nN = N / BM; nitems = (M / BM) * nN * 8; kslice = Kslice; c = c_; }
    __host__ __device__ bool next(int i, Unit& u) const { if (i > 0 || c >= nitems) return false; u.ks = c & 7; u.ko = u.ks * kslice; u.pn = (c >> 3) % nN; u.pm = (c >> 3) / nN; return true; }
    __device__ __forceinline__ void a_ready(const Unit&) const {}
    __device__ __forceinline__ void done(const Unit&) const {}
};

__device__ __forceinline__ unsigned cvt_pk_bf16(float lo, float hi) { unsigned r; asm volatile("v_cvt_pk_bf16_f32 %0, %1, %2" : "=v"(r) : "v"(lo), "v"(hi)); return r; }

struct EpiF32 {
    static constexpr bool PERM = false, AFTER_DRAIN = false;
    float* C; int ldc; size_t split_stride;
    __device__ __forceinline__ void operator()(const f32x4 (&acc)[2][2][4][2], const Unit& u, int wr, int wc, int fr, int fq) const {
        const int row0 = u.pm * BM + wr * 64 + fr, col0 = u.pn * BM + wc * 32 + 4 * fq; float* Cb = C + (size_t)u.ks * split_stride;
#pragma unroll
        for (int ai = 0; ai < 2; ++ai)
#pragma unroll
            for (int m = 0; m < 4; ++m) { float* rowp = Cb + (size_t)(row0 + ai * HALF + m * 16) * ldc + col0;
#pragma unroll
                for (int bj = 0; bj < 2; ++bj)
#pragma unroll
                    for (int n = 0; n < 2; ++n) *(f32x4*)(rowp + bj * HALF + n * 16) = acc[ai][bj][m][n]; }
    }
};
template <int ACT> struct EpiBf16 {
    static constexpr bool PERM = true, AFTER_DRAIN = false;
    bf16_t* O; int ldc; const float* rowscale;
    __device__ __forceinline__ void operator()(const f32x4 (&acc)[2][2][4][2], const Unit& u, int wr, int wc, int fr, int fq) const {
        const int row0 = u.pm * BM + wr * 64 + fr; const int col0 = u.pn * BM + wc * 32 + 8 * fq;
#pragma unroll
        for (int ai = 0; ai < 2; ++ai)
#pragma unroll
            for (int m = 0; m < 4; ++m) { const int row = row0 + ai * HALF + m * 16; bf16_t* rowp = O + (size_t)row * ldc + col0;
                float rs = 1.f; if (ACT == 2) rs = rowscale[row];
#pragma unroll
                for (int bj = 0; bj < 2; ++bj) { f32x4 v0 = acc[ai][bj][m][0], v1 = acc[ai][bj][m][1];
                    if (ACT == 1) {
#pragma unroll
                        for (int j = 0; j < 4; ++j) { const float a = fmaxf(v0[j], 0.f), b = fmaxf(v1[j], 0.f); v0[j] = a * a; v1[j] = b * b; } }
                    if (ACT == 2) { v0 = v0 * rs; v1 = v1 * rs; }
                    if (ACT == 3) { const u32x4 o = *(const u32x4*)(rowp + bj * HALF);
                        v0[0] += __builtin_bit_cast(float, o.x << 16); v0[1] += __builtin_bit_cast(float, o.x & 0xffff0000u); v0[2] += __builtin_bit_cast(float, o.y << 16); v0[3] += __builtin_bit_cast(float, o.y & 0xffff0000u);
                        v1[0] += __builtin_bit_cast(float, o.z << 16); v1[1] += __builtin_bit_cast(float, o.z & 0xffff0000u); v1[2] += __builtin_bit_cast(float, o.w << 16); v1[3] += __builtin_bit_cast(float, o.w & 0xffff0000u); }
                    u32x4 w; w.x = cvt_pk_bf16(v0[0], v0[1]); w.y = cvt_pk_bf16(v0[2], v0[3]); w.z = cvt_pk_bf16(v1[0], v1[1]); w.w = cvt_pk_bf16(v1[2], v1[3]);
                    *(u32x4*)(rowp + bj * HALF) = w; } }
    }
};

template <class Epi, class Sched, bool ALIGN_EPI = false, bool SP2 = false>
__device__ __forceinline__ void gemm_phase(PG8_LAS unsigned char* lds, const Gemm g, const Sched& S, const Epi& E) {
    int tid = threadIdx.x; asm volatile("" : "+v"(tid));
    const int wid = __builtin_amdgcn_readfirstlane(tid >> 6), lane = tid & 63, wr = wid >> 2, wc = wid & 3, fr = lane & 15, fq = lane >> 4;
    const int K = g.K, nt = K / BK, lda = g.lda, ldb = g.ldb;
    unsigned voffA[2], voffB[2];
#pragma unroll
    for (int i = 0; i < 2; ++i) { int R, C; stage_rc(tid * 16 + i * 8192, R, C); const int Rb = Epi::PERM ? ((R & ~31) + perm32(R & 31)) : R;
        voffA[i] = (unsigned)(R * lda + C) * 2u; voffB[i] = (unsigned)(Rb * ldb + C) * 2u; }
    const size_t kstep = (size_t)(BK * 2);
    const size_t hstepA = (size_t)HALF * lda * 2, hstepB = (size_t)HALF * ldb * 2;
    const size_t tstepA = 2 * hstepA, tstepB = 2 * hstepB;
    const unsigned ldsw = (unsigned)wid * 1024u;
    const int aoff = lds_byte(wr * 64 + fr, fq * 8), boff = lds_byte(wc * 32 + fr, fq * 8);
#define PG8_SA(b, h) (((b) * 2 + (h)) * HTB)
#define PG8_SB(b, h) ((4 + (b) * 2 + (h)) * HTB)
#define PG8_STAGE(bufoff, gbase, voff) do { _Pragma("unroll") for (int _i = 0; _i < 2; ++_i) \
        __builtin_amdgcn_global_load_lds((const unsigned*)((const char*)(gbase) + (voff)[_i]), (PG8_LAS unsigned*)(lds + (bufoff) + ldsw + _i * 8192), 16, 0, 0); } while (0)
#define PG8_LDA(dst, b, h) do { _Pragma("unroll") for (int m = 0; m < 4; ++m) _Pragma("unroll") for (int k = 0; k < 2; ++k) dst[m][k] = *(const PG8_LAS bf16x8*)(lds + PG8_SA(b, h) + aoff + m * 2048 + k * 1024); } while (0)
#define PG8_LDB(dst, b, h) do { _Pragma("unroll") for (int n = 0; n < 2; ++n) _Pragma("unroll") for (int k = 0; k < 2; ++k) dst[n][k] = *(const PG8_LAS bf16x8*)(lds + PG8_SB(b, h) + boff + n * 2048 + k * 1024); } while (0)
#define PG8_MMA(ai, bj, At, Bt) do { __builtin_amdgcn_s_setprio(1); _Pragma("unroll") for (int m = 0; m < 4; ++m) _Pragma("unroll") for (int n = 0; n < 2; ++n) _Pragma("unroll") for (int k = 0; k < 2; ++k) \
        acc[ai][bj][m][n] = __builtin_amdgcn_mfma_f32_16x16x32_bf16(Bt[n][k], At[m][k], acc[ai][bj][m][n], 0, 0, 0); __builtin_amdgcn_s_setprio(0); } while (0)
#define PG8_WAIT_V(n) asm volatile("s_waitcnt vmcnt(" #n ")" ::: "memory")
#define PG8_WAIT_L(n) asm volatile("s_waitcnt lgkmcnt(" #n ")" ::: "memory")
#define PG8_BAR __builtin_amdgcn_s_barrier()
#define PG8_SCHED __builtin_amdgcn_sched_barrier(0)
    Unit cur, nxt; int ui = 0;
    if (!S.next(0, cur)) return;
    f32x4 acc[2][2][4][2];
#pragma unroll
    for (int a = 0; a < 2; ++a)
#pragma unroll
        for (int b = 0; b < 2; ++b)
#pragma unroll
            for (int m = 0; m < 4; ++m)
#pragma unroll
                for (int n = 0; n < 2; ++n) acc[a][b][m][n] = (f32x4){0.f, 0.f, 0.f, 0.f};
    bf16x8 At[4][2], B0[2][2], B1[2][2];
    const char* cA = (const char*)g.A + (size_t)cur.pm * tstepA + (size_t)cur.ko * 2; const char* cB = (const char*)g.Bt + (size_t)cur.pn * tstepB + (size_t)cur.ko * 2;
    S.a_ready(cur);
    if constexpr (SP2) {
        PG8_STAGE(PG8_SB(0, 0), cB, voffB); PG8_STAGE(PG8_SB(0, 1), cB + hstepB, voffB); PG8_STAGE(PG8_SA(0, 0), cA, voffA); PG8_STAGE(PG8_SA(0, 1), cA + hstepA, voffA);
        if (wr == 1) PG8_BAR;
        PG8_WAIT_V(2); PG8_BAR;
        PG8_STAGE(PG8_SB(1, 0), cB + kstep, voffB); PG8_STAGE(PG8_SA(1, 0), cA + kstep, voffA); PG8_STAGE(PG8_SB(1, 1), cB + hstepB + kstep, voffB);
        PG8_WAIT_V(6); PG8_BAR;
    } else {
        PG8_STAGE(PG8_SB(0, 0), cB, voffB); PG8_STAGE(PG8_SA(0, 0), cA, voffA); PG8_STAGE(PG8_SB(0, 1), cB + hstepB, voffB); PG8_STAGE(PG8_SA(0, 1), cA + hstepA, voffA);
        if (wr == 1) PG8_BAR;
        PG8_WAIT_V(4); PG8_BAR;
        PG8_STAGE(PG8_SB(1, 0), cB + kstep, voffB); PG8_STAGE(PG8_SA(1, 0), cA + kstep, voffA); PG8_STAGE(PG8_SB(1, 1), cB + hstepB + kstep, voffB);
        PG8_WAIT_V(6); PG8_BAR;
    }
    for (;;) {
        const bool has_next = S.next(ui + 1, nxt);
        const char* nA = has_next ? (const char*)g.A + (size_t)nxt.pm * tstepA + (size_t)nxt.ko * 2 : cA; const char* nB = has_next ? (const char*)g.Bt + (size_t)nxt.pn * tstepB + (size_t)nxt.ko * 2 : cB;
        for (int t = 0; t < nt; t += 2) {
            const bool last = (t == nt - 2);
            const char* a1 = cA + (size_t)(t + 1) * kstep;
            const char* a2 = last ? nA : cA + (size_t)(t + 2) * kstep; const char* b2 = last ? nB : cB + (size_t)(t + 2) * kstep;
            const char* a3 = a2 + kstep; const char* b3 = b2 + kstep;
            if (last && has_next) S.a_ready(nxt);
            if constexpr (SP2) {
            PG8_LDB(B0, 0, 0); PG8_LDB(B1, 0, 1); PG8_SCHED; PG8_LDA(At, 0, 0); PG8_STAGE(PG8_SA(1, 1), a1 + hstepA, voffA);
            PG8_WAIT_V(8); PG8_WAIT_L(0); PG8_BAR; PG8_MMA(0, 0, At, B0); PG8_MMA(0, 1, At, B1); PG8_BAR; PG8_SCHED;
            PG8_LDA(At, 0, 1); PG8_STAGE(PG8_SB(0, 0), b2, voffB); PG8_STAGE(PG8_SB(0, 1), b2 + hstepB, voffB); PG8_STAGE(PG8_SA(0, 0), a2, voffA);
            PG8_WAIT_V(8); PG8_WAIT_L(0); PG8_BAR; PG8_MMA(1, 0, At, B0); PG8_MMA(1, 1, At, B1); PG8_BAR; PG8_SCHED;
            PG8_LDB(B0, 1, 0); PG8_LDB(B1, 1, 1); PG8_SCHED; PG8_LDA(At, 1, 0); PG8_STAGE(PG8_SA(0, 1), a2 + hstepA, voffA);
            PG8_WAIT_V(8); PG8_WAIT_L(0); PG8_BAR; PG8_MMA(0, 0, At, B0); PG8_MMA(0, 1, At, B1); PG8_BAR; PG8_SCHED;
            PG8_LDA(At, 1, 1); PG8_STAGE(PG8_SB(1, 0), b3, voffB); PG8_STAGE(PG8_SB(1, 1), b3 + hstepB, voffB); PG8_STAGE(PG8_SA(1, 0), a3, voffA);
            PG8_WAIT_V(8); PG8_WAIT_L(0); PG8_BAR; PG8_MMA(1, 0, At, B0); PG8_MMA(1, 1, At, B1); PG8_BAR; PG8_SCHED;
            } else {
            PG8_LDB(B0, 0, 0); PG8_SCHED; PG8_LDA(At, 0, 0); PG8_STAGE(PG8_SA(1, 1), a1 + hstepA, voffA);
            PG8_WAIT_L(8); PG8_BAR; PG8_WAIT_L(0); PG8_MMA(0, 0, At, B0); PG8_BAR; PG8_SCHED;
            PG8_LDB(B1, 0, 1); PG8_STAGE(PG8_SB(0, 0), b2, voffB);
            PG8_BAR; PG8_WAIT_L(0); PG8_MMA(0, 1, At, B1); PG8_BAR;
            PG8_LDA(At, 0, 1); PG8_STAGE(PG8_SA(0, 0), a2, voffA);
            PG8_BAR; PG8_WAIT_L(0); PG8_MMA(1, 0, At, B0); PG8_BAR; PG8_SCHED;
            PG8_STAGE(PG8_SB(0, 1), b2 + hstepB, voffB);
            PG8_WAIT_V(6); PG8_BAR; PG8_MMA(1, 1, At, B1); PG8_BAR;
            PG8_LDB(B0, 1, 0); PG8_SCHED; PG8_LDA(At, 1, 0); PG8_STAGE(PG8_SA(0, 1), a2 + hstepA, voffA);
            PG8_WAIT_L(8); PG8_BAR; PG8_WAIT_L(0); PG8_MMA(0, 0, At, B0); PG8_BAR; PG8_SCHED;
            PG8_LDB(B1, 1, 1); PG8_STAGE(PG8_SB(1, 0), b3, voffB);
            PG8_BAR; PG8_WAIT_L(0); PG8_MMA(0, 1, At, B1); PG8_BAR;
            PG8_LDA(At, 1, 1); PG8_STAGE(PG8_SA(1, 0), a3, voffA);
            PG8_BAR; PG8_WAIT_L(0); PG8_MMA(1, 0, At, B0); PG8_BAR; PG8_SCHED;
            PG8_STAGE(PG8_SB(1, 1), b3 + hstepB, voffB);
            PG8_WAIT_V(6); PG8_BAR; PG8_MMA(1, 1, At, B1); PG8_BAR;
            }
        }
        if constexpr (ALIGN_EPI) { if (wr == 0) PG8_BAR; }
        E(acc, cur, wr, wc, fr, fq); S.done(cur);
        if (!has_next) break;
#pragma unroll
        for (int a = 0; a < 2; ++a)
#pragma unroll
            for (int b = 0; b < 2; ++b)
#pragma unroll
                for (int m = 0; m < 4; ++m)
#pragma unroll
                    for (int n = 0; n < 2; ++n) acc[a][b][m][n] = (f32x4){0.f, 0.f, 0.f, 0.f};
        cur = nxt; cA = nA; cB = nB; ++ui;
        if constexpr (ALIGN_EPI) { if (wr == 1) PG8_BAR; }
    }
    PG8_WAIT_V(0);
    if constexpr (!ALIGN_EPI) { if (wr == 0) PG8_BAR; }
    PG8_BAR;
#undef PG8_SA
#undef PG8_SB
#undef PG8_STAGE
#undef PG8_LDA
#undef PG8_LDB
#undef PG8_MMA
#undef PG8_WAIT_V
#undef PG8_WAIT_L
#undef PG8_BAR
#undef PG8_SCHED
}
}

constexpr int NWAVES = 8, NTHR = 512;
constexpr int DM = 4096, NB = 2, SEQ = 8192, NCTX = 256, DFF = 16384;
constexpr int M_LAT = NB * SEQ, M_CTX = NB * NCTX, M_TOT = M_LAT + M_CTX;
constexpr int DIN = 8672, DINP = 8704;
constexpr int C_SWAQ = 0, C_SWAK = 1024, C_SWAV = 1280, C_LRUX = 1536, C_LRUY = 2560, C_QA = 3584, C_KVA = 4608, C_KR = 5120, C_RW = 5184;
constexpr int C_RWR = C_RW, C_RWK = C_RW + 1024, C_RWV = C_RW + 2048, C_RWL = C_RW + 3072;
constexpr int RWC = 3488;
constexpr float LN_EPS = 1e-5f, RMS_EPS = 1e-6f, GN_EPS = 64e-5f, ALPHA = 1.41421356237f;
constexpr int NCH = 264;

constexpr size_t MiB = 1u << 20;
constexpr size_t WS_CTL = 0, CTL_ZERO_BYTES = 1 * MiB;
constexpr size_t WS_MOD = 1 * MiB;
constexpr size_t WS_MODP = 2 * MiB;
constexpr size_t WS_SMALL = 20 * MiB;
constexpr size_t WS_RSQ = WS_SMALL;
constexpr size_t WS_RSKV = WS_RSQ + 128 * 1024;
constexpr size_t WS_SB = WS_RSKV + 128 * 1024;
constexpr size_t WS_CA = WS_SB + 2 * MiB;
constexpr size_t WS_CB = WS_CA + 5 * MiB;
constexpr size_t WS_HIN = WS_CB + 5 * MiB;
constexpr size_t WS_QUIRK = WS_HIN + 5 * MiB;
constexpr size_t WS_ROPE = WS_QUIRK + 8192;
static_assert(WS_ROPE + 16384 <= 40 * MiB, "small region");
constexpr size_t WS_W = 40 * MiB;
constexpr size_t WS_WIN = WS_W, WS_WOUT = WS_WIN + 68 * MiB, WS_WFF1 = WS_WOUT + 32 * MiB, WS_WFF2 = WS_WFF1 + 128 * MiB, WS_WQB = WS_WFF2 + 128 * MiB,
                 WS_WKVB = WS_WQB + 3 * MiB, WS_WLRU = WS_WKVB + 2 * MiB, WS_WLORA = WS_WLRU + 1 * MiB;
constexpr size_t WS_W2T = WS_WLORA, WS_A2T = WS_W2T + 256 * 1024, WS_G2T = WS_A2T + 256 * 1024;
constexpr size_t WS_X = 403 * MiB;
constexpr size_t WS_H = 667 * MiB;
constexpr size_t WS_MIX = 799 * MiB;
constexpr size_t WS_YS = 931 * MiB;
constexpr size_t WS_P = 1063 * MiB;
constexpr size_t WS_RWF = 1344 * MiB;
constexpr size_t RWF_STRIDE = (size_t)M_TOT * 1024 * 2;
constexpr size_t WS_Q = 1641 * MiB;
constexpr size_t WS_KV = 1691 * MiB;
constexpr size_t WS_KR = 1757 * MiB;
constexpr size_t WS_SET2 = 1760 * MiB;
constexpr size_t WSET_STRIDE = WS_SET2 - WS_W;
constexpr size_t WS_END = WS_SET2 + 363 * MiB;
constexpr size_t WS_YP = WS_Q;
constexpr size_t WS_HID = WS_P;
constexpr size_t WS_Y1 = WS_P;
constexpr size_t WS_Y2 = WS_MIX;
static_assert(WS_WLORA + 1 * MiB <= WS_X && WS_P + (size_t)M_TOT * DINP * 2 <= WS_RWF && WS_RWF + 9 * RWF_STRIDE <= WS_Q, "ws map");
static_assert(WS_HID + (size_t)M_TOT * DFF * 2 <= WS_Q && WS_Y2 + (size_t)M_TOT * DM * 4 <= WS_P && WS_YS + 2 * (size_t)M_TOT * 1024 * 4 <= WS_P, "ws overlays");
static_assert(WS_KR + (size_t)M_TOT * 64 * 2 <= WS_SET2 && WS_YP + 8 * (size_t)M_CTX * DM * 4 <= WS_KR, "ws end");

constexpr int RING_BYTES = 131072;
constexpr int LDSCTL_OFF = RING_BYTES, MISC_OFF = LDSCTL_OFF + 320;
constexpr int LDS_BYTES = 147456;

#define GAS __attribute__((address_space(1)))
#define LAS __attribute__((address_space(3)))
typedef unsigned short bf16;
typedef unsigned v4u __attribute__((ext_vector_type(4)));
typedef unsigned v2u __attribute__((ext_vector_type(2)));
typedef float f32x4 __attribute__((ext_vector_type(4)));
typedef _Float16 h16x4 __attribute__((ext_vector_type(4)));
typedef _Float16 h16x8 __attribute__((ext_vector_type(8)));
#ifndef XH16_
#define XH16_ 1
#endif
constexpr bool XH16 = XH16_;
#if XH16_
typedef _Float16 xres_t;
#else
typedef float xres_t;
#endif
typedef float f32x2 __attribute__((ext_vector_type(2)));
typedef float f32x16 __attribute__((ext_vector_type(16)));
typedef short bf16x8 __attribute__((ext_vector_type(8)));
typedef short s16x4 __attribute__((ext_vector_type(4)));
typedef GAS unsigned gu32;
typedef const GAS bf16* gcbf; typedef GAS bf16* gbfp; typedef const GAS float* gcfl; typedef GAS float* gflp;
#define LDS_WAIT() asm volatile("s_waitcnt lgkmcnt(0)" ::: "memory")
#define VM_WAIT() asm volatile("s_waitcnt vmcnt(0)" ::: "memory")
typedef __bf16 bf16x2_t __attribute__((ext_vector_type(2)));
__device__ __forceinline__ unsigned pk2(float lo, float hi) { const f32x2 v = {lo, hi}; const bf16x2_t b = __builtin_convertvector(v, bf16x2_t); return __builtin_bit_cast(unsigned, b); }
__device__ __forceinline__ unsigned f2bf(float f) { return pk2(f, f) & 0xffffu; }
__device__ __forceinline__ float bflo(unsigned w) { return __builtin_bit_cast(float, w << 16); }
__device__ __forceinline__ float bfhi(unsigned w) { return __builtin_bit_cast(float, w & 0xffff0000u); }
__device__ __forceinline__ float bf2f(bf16 h) { return __builtin_bit_cast(float, (unsigned)h << 16); }
#define DPP_ADD(x, ctrl) ((x) + __builtin_bit_cast(float, __builtin_amdgcn_update_dpp(0, __builtin_bit_cast(int, (x)), (ctrl), 0xf, 0xf, false)))
__device__ __forceinline__ float row_sum16(float x) { x = DPP_ADD(x, 0x128); x = DPP_ADD(x, 0x124); x = DPP_ADD(x, 0x122); x = DPP_ADD(x, 0x121); return x; }
#ifdef OLD_SUMS
__device__ __forceinline__ float wave_sum(float v) {
#pragma unroll
    for (int o = 1; o < 64; o <<= 1) v += __shfl_xor(v, o);
    return v;
}
__device__ __forceinline__ float half_swap_sum(float x) { return x + __shfl_xor(x, 32); }
__device__ __forceinline__ float quad_sum(float x) { x += __shfl_xor(x, 1); x += __shfl_xor(x, 2); return x; }
#else
__device__ __forceinline__ float wave_sum(float v) {
    const float r = row_sum16(v);
    const float a = __builtin_bit_cast(float, __builtin_amdgcn_readlane(__builtin_bit_cast(int, r), 0)), b = __builtin_bit_cast(float, __builtin_amdgcn_readlane(__builtin_bit_cast(int, r), 16));
    const float c = __builtin_bit_cast(float, __builtin_amdgcn_readlane(__builtin_bit_cast(int, r), 32)), d = __builtin_bit_cast(float, __builtin_amdgcn_readlane(__builtin_bit_cast(int, r), 48));
    return (a + b) + (c + d);
}
__device__ __forceinline__ float half_swap_sum(float x) {
    unsigned a = __builtin_bit_cast(unsigned, x), b = a; asm volatile("" : "+v"(b));
    auto rr = __builtin_amdgcn_permlane32_swap(a, b, false, false);
    const float lo = __uint_as_float(rr[0]), hi = __uint_as_float(rr[1]); return lo + hi;
}
__device__ __forceinline__ float quad_sum(float x) { x = DPP_ADD(x, 0xB1); x = DPP_ADD(x, 0x4E); return x; }
#endif
__device__ __forceinline__ float sigmoidf_(float x) { return __builtin_amdgcn_rcpf(1.f + __expf(-x)); }
__device__ __forceinline__ float softplusf_(float x) { return x > 20.f ? x : __logf(1.f + __expf(x)); }
__device__ __forceinline__ float tanhf_(float x) { const float e = __expf(2.f * x); return 1.f - 2.f * __builtin_amdgcn_rcpf(e + 1.f); }
__device__ __forceinline__ int ltid() { int t = threadIdx.x; asm volatile("" : "+v"(t)); return t; }
template <class T> __device__ __forceinline__ T ldg(const void* base, unsigned byteoff) { return *(const T*)((const char*)base + byteoff); }
template <class T> __device__ __forceinline__ void stg(void* base, unsigned byteoff, T v) { *(T*)((char*)base + byteoff) = v; }

#define XB_TMO      128
#define XB_XCNT(j)  (256  + 64 * (j))
#define XB_XSUB(j)  (1280 + 64 * (j))
#define XB_XGEN(j)  (2304 + 64 * (j))
#define XB_TOP      3328
#define XB_TOPGEN   3392
#define XCD_BAR_WORDS 3456
#define XB_SPIN_CAP (1u << 18)

__device__ __forceinline__ unsigned xb_ld(unsigned* p)              { return __hip_atomic_load(p, __ATOMIC_RELAXED, __HIP_MEMORY_SCOPE_AGENT); }
__device__ __forceinline__ unsigned xb_add(unsigned* p, unsigned v) { return __hip_atomic_fetch_add(p, v, __ATOMIC_RELAXED, __HIP_MEMORY_SCOPE_AGENT); }
__device__ __forceinline__ unsigned xb_xcc_id() { return (unsigned)__builtin_amdgcn_s_getreg((3 << 11) | 20) & 0xFu; }
#define XB_SPIN(cond, bar) do { unsigned _sp = 0; while (cond) { __builtin_amdgcn_s_sleep(1); \
    if ((++_sp & 255u) == 0u) { if (xb_ld(&(bar)[XB_TMO])) break; if (_sp > XB_SPIN_CAP) { atomicAdd(&(bar)[XB_TMO], 1u); break; } } } } while (0)

struct XcdBarrier {
    unsigned* bar; unsigned x;
    unsigned nparts;
    volatile LAS unsigned* st;
};

__device__ __forceinline__ XcdBarrier xcd_barrier_post(unsigned* bar, volatile LAS unsigned* st) {
    XcdBarrier b; b.bar = bar; b.x = xb_xcc_id(); b.st = st; b.nparts = 0u;
    if (threadIdx.x == 0) (void)xb_add(&bar[XB_XCNT(b.x)], 1u);
    return b;
}
__device__ __forceinline__ void xcd_barrier_complete(unsigned* bar, unsigned x, unsigned& nloc, unsigned& nx, unsigned nparts) {
    const unsigned G = nparts ? nparts : gridDim.x * gridDim.y * gridDim.z;
    unsigned sum, cnt, mine, sp = 0u;
    for (;;) {
        sum = 0u; cnt = 0u; mine = 0u;
#pragma unroll
        for (unsigned j = 0; j < 16; ++j) { const unsigned c = xb_ld(&bar[XB_XCNT(j)]); sum += c; cnt += (c > 0u) ? 1u : 0u; mine = (j == x) ? c : mine; }
        if (sum == G) break;
        __builtin_amdgcn_s_sleep(1);
        if ((++sp & 255u) == 0u) { if (xb_ld(&bar[XB_TMO])) break; if (sp > XB_SPIN_CAP) { atomicAdd(&bar[XB_TMO], 1u); break; } }
    }
    nloc = mine > 0u ? mine : 1u; nx = cnt > 0u ? cnt : 1u;
}

__device__ __forceinline__ void xcd_barrier(const XcdBarrier& b) {
    asm volatile("s_waitcnt vmcnt(0)" ::: "memory");
    __syncthreads();
    if (threadIdx.x == 0) {
        unsigned* bar = b.bar;
        __builtin_amdgcn_s_waitcnt(0);
        unsigned nloc = b.st[0], nx = b.st[1];
        if (nloc == 0u) { xcd_barrier_complete(bar, b.x, nloc, nx, b.nparts); b.st[0] = nloc; b.st[1] = nx; }
        const unsigned old = xb_add(&bar[XB_XSUB(b.x)], 1u);
        const unsigned gen = old / nloc;
        if (old + 1u == (gen + 1u) * nloc) {
            __builtin_amdgcn_fence(__ATOMIC_RELEASE, "agent");
            asm volatile("s_waitcnt vmcnt(0)" ::: "memory");
            const unsigned og = xb_add(&bar[XB_TOP], 1u);
            const unsigned tg = og / nx;
            if (og + 1u == (tg + 1u) * nx) xb_add(&bar[XB_TOPGEN], 1u);
            else XB_SPIN(xb_ld(&bar[XB_TOPGEN]) == tg, bar);
            __builtin_amdgcn_fence(__ATOMIC_ACQUIRE, "agent");
            xb_add(&bar[XB_XGEN(b.x)], 1u);
            asm volatile("s_waitcnt vmcnt(0)" ::: "memory");
        } else {
            XB_SPIN(xb_ld(&bar[XB_XGEN(b.x)]) == gen, bar);
            __builtin_amdgcn_fence(__ATOMIC_ACQUIRE, "agent");
            asm volatile("s_waitcnt vmcnt(0)" ::: "memory");
        }
    }
    __syncthreads();
}


namespace att {
constexpr int KVBLK = 64;
constexpr float THR = 8.f;
#define SBAR() __builtin_amdgcn_sched_barrier(0)
__device__ __forceinline__ int crow(int r, int hi) { return (r & 3) + 8 * (r >> 2) + 4 * hi; }
__device__ __forceinline__ unsigned cvtpk(float lo, float hi) { return pk2(lo, hi); }
template <int DQK> __device__ __forceinline__ int kswz(int row, int cb) { return row * (DQK * 2 + 16) + cb; }

template <int DQK> __device__ __forceinline__ void partialSM(f32x16& p0, f32x16& p1, float& m_reg, float& mn, float& alpha) {
  constexpr float SCALE = DQK == 128 ? 0.088388347648318440f : 0.072168783648703220f;
  constexpr float C = SCALE * 1.4426950408889634f;
  float pmax = p0[0];
#pragma unroll
  for (int r = 1; r < 16; ++r) pmax = fmaxf(pmax, p0[r]);
#pragma unroll
  for (int r = 0; r < 16; ++r) pmax = fmaxf(pmax, p1[r]);
  { auto rr = __builtin_amdgcn_permlane32_swap(__float_as_uint(pmax), __float_as_uint(pmax), false, false);
    pmax = fmaxf(__uint_as_float(rr[0]), __uint_as_float(rr[1])); }
  if (__builtin_expect(__all(pmax - m_reg <= THR / SCALE), 1)) { mn = m_reg; alpha = 1.f; }
  else { mn = fmaxf(m_reg, pmax); alpha = __builtin_amdgcn_exp2f((m_reg - mn) * C); m_reg = mn; }
  const float mnC = -mn * C;
#pragma unroll
  for (int r = 0; r < 16; ++r) p0[r] = fmaf(p0[r], C, mnC);
#pragma unroll
  for (int r = 0; r < 16; ++r) p1[r] = fmaf(p1[r], C, mnC);
#pragma unroll
  for (int r = 0; r < 16; ++r) p0[r] = __builtin_amdgcn_exp2f(p0[r]);
}
__device__ __forceinline__ void finishSM(f32x16& p0, f32x16& p1, float alpha, float& l_reg, bf16x8& pa0, bf16x8& pa1, bf16x8& pa2, bf16x8& pa3) {
#pragma unroll
  for (int r = 0; r < 16; ++r) p1[r] = __builtin_amdgcn_exp2f(p1[r]);
  float ps = 0;
#pragma unroll
  for (int r = 0; r < 16; ++r) ps += p0[r];
#pragma unroll
  for (int r = 0; r < 16; ++r) ps += p1[r];
  { auto rr = __builtin_amdgcn_permlane32_swap(__float_as_uint(ps), __float_as_uint(ps), false, false);
    ps = __uint_as_float(rr[0]) + __uint_as_float(rr[1]); }
  l_reg = l_reg * alpha + ps;
#define PK4(P, BASE, OUT) do { unsigned a0 = cvtpk(P[BASE + 0], P[BASE + 1]), a1 = cvtpk(P[BASE + 2], P[BASE + 3]);   \
    unsigned b0 = cvtpk(P[BASE + 4], P[BASE + 5]), b1 = cvtpk(P[BASE + 6], P[BASE + 7]);                              \
    auto r0 = __builtin_amdgcn_permlane32_swap(a0, b0, false, false); auto r1 = __builtin_amdgcn_permlane32_swap(a1, b1, false, false); \
    v4u w = {r0[0], r1[0], r0[1], r1[1]}; OUT = __builtin_bit_cast(bf16x8, w); } while (0)
  PK4(p0, 0, pa0); PK4(p0, 8, pa1); PK4(p1, 0, pa2); PK4(p1, 8, pa3);
#undef PK4
}
template <int DQK> __device__ __forceinline__ void qkt(f32x16& p0, f32x16& p1, const LAS char* Ks, const bf16x8* qr, const LAS char* qx, int r32, int hi) {
  p0 = f32x16{}; p1 = f32x16{};
#pragma unroll
  for (int d0 = 0; d0 < DQK / 16; ++d0) { const int cb = (d0 * 16 + hi * 8) * 2;
    bf16x8 b0 = *(const LAS bf16x8*)(Ks + kswz<DQK>(r32, cb));
    bf16x8 b1 = *(const LAS bf16x8*)(Ks + kswz<DQK>(32 + r32, cb));
    bf16x8 q; if (d0 < 8) q = qr[d0]; else q = *(const LAS bf16x8*)(qx + (d0 - 8) * 32);
    p0 = __builtin_amdgcn_mfma_f32_32x32x16_bf16(b0, q, p0, 0, 0, 0);
    p1 = __builtin_amdgcn_mfma_f32_32x32x16_bf16(b1, q, p1, 0, 0, 0);
    if ((d0 & 3) == 3 && d0 + 1 < DQK / 16) SBAR(); }
}
__device__ __forceinline__ int v_st(int k, int c) { const int kk = (k & ~0xC) | ((k & 4) << 1) | ((k & 8) >> 1); return ((kk >> 3) * 4 + (c >> 5)) * 512 + ((kk & 7) * 32 + (c & 31)) * 2; }
__device__ __forceinline__ int v_rd_base(int lane) { return ((lane & 3) << 3) | (((lane >> 2) & 3) << 6) | (((lane >> 4) & 1) << 5) | (((lane >> 5) & 1) << 8); }
constexpr int v_rd_off(int d0, int ks, int half) { return d0 * 512 + ks * 4096 + half * 2048; }
template <int OFF> __device__ __forceinline__ s16x4 tr_read(int vb) {
  s16x4 r; asm volatile("ds_read_b64_tr_b16 %0, %1 offset:%2" : "=&v"(r) : "v"(vb), "i"(OFF) : "memory"); return r;
}
template <int D0> __device__ __forceinline__ void pv_one(f32x16& od, int vb, bf16x8 pa0, bf16x8 pa1, bf16x8 pa2, bf16x8 pa3) {
  const s16x4 l0 = tr_read<v_rd_off(D0, 0, 0)>(vb), h0 = tr_read<v_rd_off(D0, 0, 1)>(vb), l1 = tr_read<v_rd_off(D0, 1, 0)>(vb), h1 = tr_read<v_rd_off(D0, 1, 1)>(vb);
  const s16x4 l2 = tr_read<v_rd_off(D0, 2, 0)>(vb), h2 = tr_read<v_rd_off(D0, 2, 1)>(vb), l3 = tr_read<v_rd_off(D0, 3, 0)>(vb), h3 = tr_read<v_rd_off(D0, 3, 1)>(vb);
  asm volatile("s_waitcnt lgkmcnt(0)" ::: "memory"); SBAR();
#define PK(L, H) (bf16x8){L[0], L[1], L[2], L[3], H[0], H[1], H[2], H[3]}
  od = __builtin_amdgcn_mfma_f32_32x32x16_bf16(pa0, PK(l0, h0), od, 0, 0, 0);
  od = __builtin_amdgcn_mfma_f32_32x32x16_bf16(pa1, PK(l1, h1), od, 0, 0, 0);
  od = __builtin_amdgcn_mfma_f32_32x32x16_bf16(pa2, PK(l2, h2), od, 0, 0, 0);
  od = __builtin_amdgcn_mfma_f32_32x32x16_bf16(pa3, PK(l3, h3), od, 0, 0, 0);
#undef PK
}
__device__ __forceinline__ void pv_d0(f32x16* o, int vb, bf16x8 pa0, bf16x8 pa1, bf16x8 pa2, bf16x8 pa3) {
  pv_one<0>(o[0], vb, pa0, pa1, pa2, pa3); pv_one<1>(o[1], vb, pa0, pa1, pa2, pa3); pv_one<2>(o[2], vb, pa0, pa1, pa2, pa3); pv_one<3>(o[3], vb, pa0, pa1, pa2, pa3);
}
__device__ __forceinline__ void apply_mask(f32x16& p0, f32x16& p1, int mtype, int krel0, int qi, int hi) {
  if (mtype == 0) return;
  const float ninf = -__builtin_inff();
#pragma unroll
  for (int r = 0; r < 16; ++r) { const int k0 = krel0 + crow(r, hi), k1 = k0 + 32;
    const bool ok0 = (mtype == 1) ? (k0 >= qi - 128) : (k0 <= qi + 128), ok1 = (mtype == 1) ? (k1 >= qi - 128) : (k1 <= qi + 128);
    p0[r] = ok0 ? p0[r] : ninf; p1[r] = ok1 ? p1[r] : ninf; }
}
struct Tile { gcbf kn; gcbf kr; gcbf v; int mtype; int krel0; };

__device__ __forceinline__ void rope_pair(bf16x8& a, bf16x8& b, gcfl ct, gcfl st) {
  const f32x4 c0 = *(const GAS f32x4*)ct, c1 = *(const GAS f32x4*)(ct + 4), s0 = *(const GAS f32x4*)st, s1 = *(const GAS f32x4*)(st + 4);
  const float cs[8] = {c0[0], c0[1], c0[2], c0[3], c1[0], c1[1], c1[2], c1[3]}, sn[8] = {s0[0], s0[1], s0[2], s0[3], s1[0], s1[1], s1[2], s1[3]};
  v4u ua = __builtin_bit_cast(v4u, a), ub = __builtin_bit_cast(v4u, b); v4u oa, ob;
#pragma unroll
  for (int w = 0; w < 4; ++w) { const float x1[2] = {bflo(ua[w]), bfhi(ua[w])}, x2[2] = {bflo(ub[w]), bfhi(ub[w])}; float y1[2], y2[2];
#pragma unroll
    for (int e = 0; e < 2; ++e) { const float c = cs[2 * w + e], sv = sn[2 * w + e]; y1[e] = x1[e] * c - x2[e] * sv; y2[e] = x2[e] * c + x1[e] * sv; }
    oa[w] = pk2(y1[0], y1[1]); ob[w] = pk2(y2[0], y2[1]); }
  a = __builtin_bit_cast(bf16x8, oa); b = __builtin_bit_cast(bf16x8, ob);
}

template <int DQK, int LDKN, int LDV, bool MASK, bool SINK, int SDEPTH, class TS>
__device__ __forceinline__ void attn_body(gcbf Qw, int rope, int prow, int pcol, gcfl rtab, int qi, float sink_l2, const TS& ts, int NT, gbfp Ow, LAS char* lds) {
  constexpr float SCALE = DQK == 128 ? 0.088388347648318440f : 0.072168783648703220f;
  constexpr float C = SCALE * 1.4426950408889634f;
  constexpr int SHM_K = KVBLK * (DQK * 2 + 16), SHM_V = KVBLK * 128 * 2;
  int tid = threadIdx.x; asm volatile("" : "+v"(tid));
  const int wid = tid >> 6, lane = tid & 63, r32 = lane & 31, hi = lane >> 5;
  LAS char* V_lds = lds; LAS char* K_lds = lds + 2 * SHM_V;
  LAS float* wsl = (LAS float*)(lds + 2 * SHM_V + 2 * SHM_K) + wid * 64; LAS float* li_l = wsl; LAS float* al_l = wsl + 32;
  float m_reg = -1e30f, l_reg = 0; f32x16 o[4] = {}; bf16x8 qr[8];
#pragma unroll
  for (int d0 = 0; d0 < 8; ++d0) qr[d0] = *(const GAS bf16x8*)(Qw + d0 * 16 + hi * 8);
  const LAS char* qx = lds + 2 * SHM_V + 2 * SHM_K + 2048 + wid * 4608 + r32 * 144 + hi * 16;
  if constexpr (DQK == 192) {
    bf16x8 x0 = *(const GAS bf16x8*)(Qw + 128 + hi * 8), x1 = *(const GAS bf16x8*)(Qw + 144 + hi * 8), x2 = *(const GAS bf16x8*)(Qw + 160 + hi * 8), x3 = *(const GAS bf16x8*)(Qw + 176 + hi * 8);
    if (rope) {
      rope_pair(x0, x1, rtab + (size_t)prow * 16 + hi * 8, rtab + 2048 + (size_t)prow * 16 + hi * 8);
      rope_pair(x2, x3, rtab + (size_t)pcol * 16 + hi * 8, rtab + 2048 + (size_t)pcol * 16 + hi * 8); }
    LAS char* qw_ = (LAS char*)qx; *(LAS bf16x8*)(qw_) = x0; *(LAS bf16x8*)(qw_ + 32) = x1; *(LAS bf16x8*)(qw_ + 64) = x2; *(LAS bf16x8*)(qw_ + 96) = x3;
  }
  const int sr = tid >> 4, sc = (tid & 15) * 8, vst0 = v_st(sr, sc), vst1 = v_st(32 + sr, sc);
  const int rr_ = tid >> 3, rc_ = (tid & 7) * 8;
  const int vb0 = (int)(uintptr_t)V_lds + v_rd_base(lane);
  struct { bf16x8 vs0, vs1, ks0, ks1, kx; } sr_[SDEPTH];
#define SLOAD(i, jt) do { const Tile t_ = ts(jt); sr_[i].vs0 = *(const GAS bf16x8*)(t_.v + (size_t)sr * LDV + sc); sr_[i].vs1 = *(const GAS bf16x8*)(t_.v + (size_t)(32 + sr) * LDV + sc); \
    sr_[i].ks0 = *(const GAS bf16x8*)(t_.kn + (size_t)sr * LDKN + sc); sr_[i].ks1 = *(const GAS bf16x8*)(t_.kn + (size_t)(32 + sr) * LDKN + sc); \
    if constexpr (DQK == 192) sr_[i].kx = *(const GAS bf16x8*)(t_.kr + (size_t)rr_ * 64 + rc_); } while (0)
#define SWRITE(b, i) do { *(LAS bf16x8*)(V_lds + (b) * SHM_V + vst0) = sr_[i].vs0; *(LAS bf16x8*)(V_lds + (b) * SHM_V + vst1) = sr_[i].vs1; const int kc = sc * 2; \
    *(LAS bf16x8*)(K_lds + (b) * SHM_K + kswz<DQK>(sr, kc)) = sr_[i].ks0; *(LAS bf16x8*)(K_lds + (b) * SHM_K + kswz<DQK>(32 + sr, kc)) = sr_[i].ks1; \
    if constexpr (DQK == 192) *(LAS bf16x8*)(K_lds + (b) * SHM_K + kswz<DQK>(rr_, 256 + rc_ * 2)) = sr_[i].kx; } while (0)
#define SWAIT() do { if constexpr (SDEPTH == 2) { if constexpr (DQK == 192) asm volatile("s_waitcnt vmcnt(5)" ::: "memory"); else asm volatile("s_waitcnt vmcnt(4)" ::: "memory"); } \
    else asm volatile("s_waitcnt vmcnt(0)" ::: "memory"); } while (0)
#define RESC(a) do { if (__any((a) < 1.f)) { if (hi == 0) al_l[r32] = (a); asm volatile("s_waitcnt lgkmcnt(0)" ::: "memory"); \
    _Pragma("unroll") for (int d = 0; d < 4; ++d) _Pragma("unroll") for (int r = 0; r < 16; ++r) o[d][r] *= al_l[crow(r, hi)]; } } while (0)
#define MASKT(pa_, pb_, jt) do { if constexpr (MASK) { const Tile t_ = ts(jt); apply_mask(pa_, pb_, t_.mtype, t_.krel0, qi, hi); } } while (0)
  f32x16 pA0, pA1, pB0, pB1; float mnA, mnB, alA, alB; bf16x8 pa0, pa1, pa2, pa3;
  constexpr int SE = 0, SO = SDEPTH - 1;
  SLOAD(SE, 0); asm volatile("s_waitcnt vmcnt(0)" ::: "memory"); SWRITE(0, SE); __syncthreads();
  qkt<DQK>(pA0, pA1, K_lds, qr, qx, r32, hi); MASKT(pA0, pA1, 0); partialSM<DQK>(pA0, pA1, m_reg, mnA, alA);
  SLOAD(SO, 1); if constexpr (SDEPTH == 2) { if (2 < NT) SLOAD(SE, 2); }
  SWAIT(); SWRITE(1, SO); __syncthreads();
  for (int j = 1; j + 1 < NT; j += 2) {
    SBAR(); qkt<DQK>(pB0, pB1, K_lds + SHM_K, qr, qx, r32, hi); MASKT(pB0, pB1, j);
    finishSM(pA0, pA1, alA, l_reg, pa0, pa1, pa2, pa3); SBAR();
    SLOAD(SO, j + SDEPTH); SBAR();
    pv_d0(o, vb0, pa0, pa1, pa2, pa3); partialSM<DQK>(pB0, pB1, m_reg, mnB, alB);
    __syncthreads(); SWAIT(); SWRITE(0, SE);
    RESC(alB); __syncthreads();
    SBAR(); qkt<DQK>(pA0, pA1, K_lds, qr, qx, r32, hi); MASKT(pA0, pA1, j + 1);
    finishSM(pB0, pB1, alB, l_reg, pa0, pa1, pa2, pa3); SBAR();
    if (SDEPTH == 1 || j + 3 < NT) SLOAD(SE, j + 1 + SDEPTH); SBAR();
    pv_d0(o, vb0 + SHM_V, pa0, pa1, pa2, pa3); partialSM<DQK>(pA0, pA1, m_reg, mnA, alA);
    __syncthreads(); SWAIT(); SWRITE(1, SO);
    RESC(alA); __syncthreads();
  }
  SBAR(); qkt<DQK>(pB0, pB1, K_lds + SHM_K, qr, qx, r32, hi); MASKT(pB0, pB1, NT - 1);
  finishSM(pA0, pA1, alA, l_reg, pa0, pa1, pa2, pa3); SBAR();
  pv_d0(o, vb0, pa0, pa1, pa2, pa3); partialSM<DQK>(pB0, pB1, m_reg, mnB, alB);
  __syncthreads(); RESC(alB);
  finishSM(pB0, pB1, alB, l_reg, pa0, pa1, pa2, pa3); SBAR();
  pv_d0(o, vb0 + SHM_V, pa0, pa1, pa2, pa3);
  if constexpr (SINK) l_reg += __builtin_amdgcn_exp2f(sink_l2 - m_reg * C);
  if (hi == 0) li_l[r32] = l_reg; asm volatile("s_waitcnt lgkmcnt(0)" ::: "memory");
  float rli[16];
#pragma unroll
  for (int r = 0; r < 16; ++r) rli[r] = __builtin_amdgcn_rcpf(li_l[crow(r, hi)]);
  __syncthreads();
  LAS bf16* ost = (LAS bf16*)(lds + wid * 8704);
#pragma unroll
  for (int r = 0; r < 16; ++r) { const int orow = crow(r, hi);
#pragma unroll
    for (int d0 = 0; d0 < 4; ++d0) ost[orow * 136 + d0 * 32 + r32] = (bf16)f2bf(o[d0][r] * rli[r]); }
  asm volatile("s_waitcnt lgkmcnt(0)" ::: "memory");
#pragma unroll
  for (int i = 0; i < 8; ++i) { const int orow = i * 4 + (lane >> 4), ch = lane & 15;
    *(GAS v4u*)(Ow + (size_t)orow * 4096 + ch * 8) = *(const LAS v4u*)(ost + orow * 136 + ch * 8); }
  __syncthreads();
#undef SLOAD
#undef SWRITE
#undef SWAIT
#undef RESC
#undef MASKT
}
}

struct Args { const float* in[38]; float* out; unsigned char* ws; };
template <class T> __device__ __forceinline__ T launder(T p) { asm volatile("" : "+s"(p)); return p; }
template <class T> __device__ __forceinline__ T* launder_g(T* p) { GAS T* g = (GAS T*)p; asm volatile("" : "+s"(g)); return (T*)g; }
#define INP(i) ((const float*)(gcfl)F.A->in[i])
struct Frame {
    LAS unsigned char* lds;
    gu32* ctl;
    int tid, lane, wave;
    int vcu, G, gw, NGW;
    const __attribute__((address_space(4))) Args* A;
    float* out;
    unsigned char* ws;
    unsigned char* wsw;
};
enum { I_X = 0, I_C, I_CTX, I_CCTX, I_WMOD, I_BMOD, I_WIN, I_WOUT, I_LN1G, I_LN1B, I_WFF1, I_WFF2, I_LN2G, I_LN2B, I_SINK, I_CONVW, I_CONVB, I_LWA, I_LBA, I_LWI, I_LBI, I_LAM,
       I_QNORM, I_KVNORM, I_WQB, I_WKVB, I_MUP, I_MUN, I_W0, I_W2, I_A0, I_A2, I_G2, I_KK, I_KA, I_RK, I_LNG, I_LNB };
__device__ __forceinline__ int row_s(int row) { return row < SEQ ? 0 : (row < M_LAT ? 1 : 2); }
__device__ __forceinline__ const float* mod_ptr(const Frame& F, int l, int s, int chunk) { return (const float*)(F.ws + WS_MOD) + ((size_t)(l * 3 + s) * 6 + chunk) * DM; }

__device__ __forceinline__ void transpose_item(const float* W, int N, int Kvalid, bf16* WT, int ldt, const float* kscale, LAS float* scr, int k0, int n0, int lane) {
    { const int kr = lane >> 3, c4 = (lane & 7) * 4;
#pragma unroll
      for (int i = 0; i < 8; ++i) { const int kk = 8 * i + kr, k = k0 + kk; f32x4 v = {0.f, 0.f, 0.f, 0.f};
          if (k < Kvalid) { v = *(const f32x4*)(W + (size_t)k * N + n0 + c4); if (kscale) v = v * kscale[k]; }
          scr[kk * 33 + c4] = v.x; scr[kk * 33 + c4 + 1] = v.y; scr[kk * 33 + c4 + 2] = v.z; scr[kk * 33 + c4 + 3] = v.w; } }
    LDS_WAIT(); asm volatile("" ::: "memory");
    const int c = lane & 7;
#pragma unroll
    for (int j = 0; j < 4; ++j) { const int n = (lane >> 3) + 8 * j; const LAS float* s = scr + (8 * c) * 33 + n;
        v4u o; o.x = pk2(s[0 * 33], s[1 * 33]); o.y = pk2(s[2 * 33], s[3 * 33]); o.z = pk2(s[4 * 33], s[5 * 33]); o.w = pk2(s[6 * 33], s[7 * 33]);
        *(v4u*)(WT + (size_t)(n0 + n) * ldt + k0 + 8 * c) = o; }
    LDS_WAIT(); asm volatile("" ::: "memory");
}
struct TItem { const float* W; bf16* WT; const float* kscale; int N, Kvalid, ldt, k0, n0; };
__device__ __forceinline__ void titem_load(const TItem& t, int lane, f32x4 (&v)[8]) {
    const int kr = lane >> 3, c4 = (lane & 7) * 4;
#pragma unroll
    for (int i = 0; i < 8; ++i) { const int k = t.k0 + 8 * i + kr; v[i] = (f32x4){0.f, 0.f, 0.f, 0.f}; if (k < t.Kvalid) v[i] = *(const f32x4*)(t.W + (size_t)k * t.N + t.n0 + c4); }
}
__device__ __forceinline__ void titem_finish(const TItem& t, int lane, LAS float* scr, f32x4 (&v)[8]) {
    { const int kr = lane >> 3, c4 = (lane & 7) * 4;
#pragma unroll
      for (int i = 0; i < 8; ++i) { const int kk = 8 * i + kr, k = t.k0 + kk; f32x4 x = v[i]; if (t.kscale && k < t.Kvalid) x = x * t.kscale[k];
          scr[kk * 33 + c4] = x.x; scr[kk * 33 + c4 + 1] = x.y; scr[kk * 33 + c4 + 2] = x.z; scr[kk * 33 + c4 + 3] = x.w; } }
    LDS_WAIT(); asm volatile("" ::: "memory");
    const int c = lane & 7;
#pragma unroll
    for (int j = 0; j < 4; ++j) { const int n = (lane >> 3) + 8 * j; const LAS float* s = scr + (8 * c) * 33 + n;
        v4u o; o.x = pk2(s[0 * 33], s[1 * 33]); o.y = pk2(s[2 * 33], s[3 * 33]); o.z = pk2(s[4 * 33], s[5 * 33]); o.w = pk2(s[6 * 33], s[7 * 33]);
        *(v4u*)(t.WT + (size_t)(t.n0 + n) * t.ldt + t.k0 + 8 * c) = o; }
    LDS_WAIT(); asm volatile("" ::: "memory");
}
__device__ __forceinline__ TItem conv_decode(const Frame& F, int l, unsigned char* ws, int r) {
    constexpr int I1 = 64 * 271, I2 = 64 * 128, I3 = 64 * 512, I4 = 256 * 128, I5 = 16 * 48, I6 = 8 * 64, I7 = 32 * 8, I8 = 2 * 32, I9 = 2 * 32;
    if (r < I1) return TItem{INP(I_WIN) + (size_t)l * DM * DIN, (bf16*)(ws + WS_WIN), nullptr, DIN, DM, DM, 64 * (r / 271), 32 * (r % 271)}; r -= I1;
    if (r < I2) return TItem{INP(I_WOUT) + (size_t)l * DM * DM, (bf16*)(ws + WS_WOUT), nullptr, DM, DM, DM, 64 * (r / 128), 32 * (r % 128)}; r -= I2;
    if (r < I3) return TItem{INP(I_WFF1) + (size_t)l * DM * DFF, (bf16*)(ws + WS_WFF1), nullptr, DFF, DM, DM, 64 * (r / 512), 32 * (r % 512)}; r -= I3;
    if (r < I4) return TItem{INP(I_WFF2) + (size_t)l * DFF * DM, (bf16*)(ws + WS_WFF2), nullptr, DM, DFF, DFF, 64 * (r / 128), 32 * (r % 128)}; r -= I4;
    if (r < I5) return TItem{INP(I_WQB) + (size_t)l * 1024 * 1536, (bf16*)(ws + WS_WQB), INP(I_QNORM) + l * 1024, 1536, 1024, 1024, 64 * (r / 48), 32 * (r % 48)}; r -= I5;
    if (r < I6) return TItem{INP(I_WKVB) + (size_t)l * 512 * 2048, (bf16*)(ws + WS_WKVB), INP(I_KVNORM) + l * 512, 2048, 512, 512, 64 * (r / 64), 32 * (r % 64)}; r -= I6;
    if (r < I7) { const int mat = r >> 3, sub = r & 7, gate = mat & 1, dn = mat >> 1, d = dn >> 3, n = dn & 7;
        return TItem{(gate ? INP(I_LWI) : INP(I_LWA)) + ((size_t)(l * 2 + d) * 8 + n) * 128 * 128, (bf16*)(ws + WS_WLRU) + ((size_t)(d * 2 + gate) * 8 + n) * 128 * 128, nullptr, 128, 128, 128, 64 * (sub >> 2), 32 * (sub & 3)}; } r -= I7;
    if (r < I8) { const int d = r >> 5; return TItem{INP(I_W2) + (size_t)(l * 2 + d) * 64 * 1024, (bf16*)(ws + WS_W2T) + (size_t)d * 1024 * 64, nullptr, 1024, 64, 64, 0, 32 * (r & 31)}; } r -= I8;
    if (r < I9) { const int d = r >> 5; return TItem{INP(I_A2) + (size_t)(l * 2 + d) * 64 * 1024, (bf16*)(ws + WS_A2T) + (size_t)d * 1024 * 64, nullptr, 1024, 64, 64, 0, 32 * (r & 31)}; } r -= I9;
    return TItem{INP(I_G2) + (size_t)l * 160 * 1024, (bf16*)(ws + WS_G2T), nullptr, 1024, 160, 192, 64 * (r / 32), 32 * (r % 32)};
}
__device__ __forceinline__ void convert_weights(Frame& F, int l, int widx, int nw) {
    LAS float* scr = (LAS float*)(F.lds + F.wave * 16384);
    constexpr int NIT = 64 * 271 + 64 * 128 + 64 * 512 + 256 * 128 + 16 * 48 + 8 * 64 + 32 * 8 + 2 * 32 + 2 * 32 + 3 * 32;
    unsigned char* ws = F.ws + (l ? WSET_STRIDE : 0);
    int it = __builtin_amdgcn_readfirstlane(widx);
    if (it < NIT) { TItem cur = conv_decode(F, l, ws, it); f32x4 va[8]; titem_load(cur, F.lane, va);
#pragma unroll 1
        for (;;) { const int itn = it + nw; TItem nxt = cur; f32x4 vb[8];
            if (itn < NIT) { nxt = conv_decode(F, l, ws, itn); titem_load(nxt, F.lane, vb); }
            else {
#pragma unroll
                for (int i = 0; i < 8; ++i) vb[i] = va[i]; }
            titem_finish(cur, F.lane, scr, va);
            if (itn >= NIT) break;
            cur = nxt; it = itn;
#pragma unroll
            for (int i = 0; i < 8; ++i) va[i] = vb[i]; } }
    { unsigned zz = 0u; asm volatile("" : "+v"(zz)); v4u z = {zz, zz, zz, zz}; v4u* p = (v4u*)((bf16*)(ws + WS_WIN) + (size_t)DIN * DM);
      for (int i = widx * 64 + F.lane; i < 32 * DM / 8; i += nw * 64) p[i] = z; }
}

__device__ __forceinline__ void mod_partials(Frame& F) {
    LAS float* sl = (LAS float*)F.lds;
    for (int it = F.vcu; it < 2 * 32 * 12; it += F.G) {
        const int l = it / 384, ks = (it / 12) % 32, cc = it % 12;
        __syncthreads();
        if (F.tid < 384) { const int s = F.tid >> 7, k = ks * 128 + (F.tid & 127); const float c = s < 2 ? INP(I_C)[s * DM + k] : INP(I_CCTX)[k]; sl[F.tid] = c / (1.f + __expf(-c)); }
        __syncthreads();
        const float* wp = INP(I_WMOD) + ((size_t)l * DM + ks * 128) * 24576 + cc * 2048 + F.tid * 4;
        f32x4 a0 = {0.f, 0.f, 0.f, 0.f}, a1 = a0, a2 = a0;
#pragma unroll 8
        for (int k = 0; k < 128; ++k) { const f32x4 w = *(const f32x4*)(wp + (size_t)k * 24576); a0 += w * sl[k]; a1 += w * sl[128 + k]; a2 += w * sl[256 + k]; }
        float* op = (float*)(F.ws + WS_MODP) + ((size_t)(l * 32 + ks) * 3) * 24576 + cc * 2048 + F.tid * 4;
        *(f32x4*)(op) = a0; *(f32x4*)(op + 24576) = a1; *(f32x4*)(op + 2 * 24576) = a2;
    }
    __syncthreads();
}
__device__ __forceinline__ void mod_reduce(Frame& F) {
    for (int i = F.vcu * NTHR + F.tid; i < 2 * 3 * 24576; i += F.G * NTHR) {
        const int l = i / (3 * 24576), s = (i / 24576) % 3, n = i % 24576;
        float a = INP(I_BMOD)[l * 24576 + n];
        const float* pp = (const float*)(F.ws + WS_MODP) + ((size_t)(l * 32) * 3 + s) * 24576 + n;
#pragma unroll 8
        for (int ks = 0; ks < 32; ++ks) a += pp[(size_t)ks * 3 * 24576];
        ((float*)(F.ws + WS_MOD))[i] = a;
    }
}

__device__ __forceinline__ void sum_partials_row(const Frame& F, const float* yp, size_t stride, bf16* ydst) {
    int lane = F.lane; asm volatile("" : "+v"(lane));
#pragma unroll 2
    for (int j = 0; j < 8; ++j) { const int c = 8 * lane + 512 * j; f32x4 y0 = *(const f32x4*)(yp + c), y1 = *(const f32x4*)(yp + c + 4);
#pragma unroll
        for (int sp = 1; sp < 8; ++sp) { y0 += *(const f32x4*)(yp + sp * stride + c); y1 += *(const f32x4*)(yp + sp * stride + c + 4); }
        v4u w; w.x = pk2(y0.x, y0.y); w.y = pk2(y0.z, y0.w); w.z = pk2(y1.x, y1.y); w.w = pk2(y1.z, y1.w); *(v4u*)(ydst + c) = w; }
}
constexpr int LNV_G = 0, LNV_B = DM, LNV_GA = 2 * DM, LNV_SC = 3 * DM, LNV_SH = 4 * DM;
__device__ __forceinline__ void ln_stage(const Frame& F, int slot, const float* src) {
    LAS float* d = (LAS float*)F.lds + slot; gcfl g = (gcfl)src;
#pragma unroll
    for (int u = 0; u < 2; ++u) { const int c = 4 * (F.tid + NTHR * u); *(LAS f32x4*)(d + c) = *(const GAS f32x4*)(g + c); }
}
template <int MODE, bool XSH = false, bool XDH = false>
__device__ __forceinline__ void ln_row(const Frame& F, const void* xsrc_, const bf16* Y_, void* xdst_, bool domod, bf16* hrow_) {
    gcfl xsrc = (gcfl)xsrc_; const GAS _Float16* xsrch = (const GAS _Float16*)xsrc_; gflp xdst = (gflp)xdst_; GAS _Float16* xdsth = (GAS _Float16*)xdst_;
    gcbf Y = (gcbf)Y_; gbfp hrow = (gbfp)hrow_; const LAS float* L = (const LAS float*)F.lds + 8 * F.lane;
    f32x4 v[16]; v4u yr[8]; float s = 0.f;
#pragma unroll
    for (int j = 0; j < 8; ++j) { const int c = 8 * F.lane + 512 * j;
        if (XSH) { const h16x8 h = __builtin_nontemporal_load((const GAS h16x8*)(xsrch + c));
            v[2 * j] = __builtin_convertvector(__builtin_shufflevector(h, h, 0, 1, 2, 3), f32x4); v[2 * j + 1] = __builtin_convertvector(__builtin_shufflevector(h, h, 4, 5, 6, 7), f32x4); }
        else { v[2 * j] = __builtin_nontemporal_load((const GAS f32x4*)(xsrc + c)); v[2 * j + 1] = __builtin_nontemporal_load((const GAS f32x4*)(xsrc + c + 4)); } }
    if (MODE == 1) {
#pragma unroll
        for (int j = 0; j < 8; ++j) yr[j] = __builtin_nontemporal_load((const GAS v4u*)(Y + 8 * F.lane + 512 * j));
    }
#pragma unroll
    for (int q = 0; q < 16; ++q) { const int j = q >> 1, hf = q & 1;
        if (MODE == 1) { const unsigned w0 = hf ? yr[j].z : yr[j].x, w1 = hf ? yr[j].w : yr[j].y; const f32x4 y = {bflo(w0), bfhi(w0), bflo(w1), bfhi(w1)}, g = *(const LAS f32x4*)(L + LNV_GA + 512 * j + 4 * hf); v[q] = v[q] * ALPHA + g * y; }
        s += (v[q].x + v[q].y) + (v[q].z + v[q].w); }
    float mean = wave_sum(s) * (1.f / DM), s2 = 0.f;
#pragma unroll
    for (int q = 0; q < 16; ++q) { v[q] = v[q] - mean; s2 += (v[q].x * v[q].x + v[q].y * v[q].y) + (v[q].z * v[q].z + v[q].w * v[q].w); }
    float rstd = 1.f / sqrtf(wave_sum(s2) * (1.f / DM) + LN_EPS);
    if (MODE == 1) {
        s = 0.f;
#pragma unroll
        for (int j = 0; j < 8; ++j) { const int c = 8 * F.lane + 512 * j;
#pragma unroll
            for (int hf = 0; hf < 2; ++hf) { const int q = 2 * j + hf; const f32x4 g = *(const LAS f32x4*)(L + LNV_G + 512 * j + 4 * hf), b = *(const LAS f32x4*)(L + LNV_B + 512 * j + 4 * hf); v[q] = v[q] * rstd * g + b;
                s += (v[q].x + v[q].y) + (v[q].z + v[q].w); }
            if (XDH) { const h16x4 h0 = __builtin_convertvector(v[2 * j], h16x4), h1 = __builtin_convertvector(v[2 * j + 1], h16x4);
                __builtin_nontemporal_store(__builtin_shufflevector(h0, h1, 0, 1, 2, 3, 4, 5, 6, 7), (GAS h16x8*)(xdsth + c)); }
            else { __builtin_nontemporal_store(v[2 * j], (GAS f32x4*)(xdst + c)); __builtin_nontemporal_store(v[2 * j + 1], (GAS f32x4*)(xdst + c + 4)); } }
        if (!domod) return;
        mean = wave_sum(s) * (1.f / DM); s2 = 0.f;
#pragma unroll
        for (int q = 0; q < 16; ++q) { v[q] = v[q] - mean; s2 += (v[q].x * v[q].x + v[q].y * v[q].y) + (v[q].z * v[q].z + v[q].w * v[q].w); }
        rstd = 1.f / sqrtf(wave_sum(s2) * (1.f / DM) + LN_EPS);
    }
#pragma unroll
    for (int j = 0; j < 8; ++j) { const int c = 8 * F.lane + 512 * j; unsigned w[4];
#pragma unroll
        for (int hf = 0; hf < 2; ++hf) { const f32x4 a = *(const LAS f32x4*)(L + LNV_SC + 512 * j + 4 * hf), b = *(const LAS f32x4*)(L + LNV_SH + 512 * j + 4 * hf);
            const f32x4 o = v[2 * j + hf] * rstd * (a + 1.f) + b; w[2 * hf] = pk2(o.x, o.y); w[2 * hf + 1] = pk2(o.z, o.w); }
        *(GAS v4u*)(hrow + c) = (v4u){w[0], w[1], w[2], w[3]}; }
}

__device__ __forceinline__ void shift4(const bf16* P, unsigned eo, bool hp, bool hn, const float* mup, const float* mun, unsigned mo, float (&u)[4]) {
    const v2u xc = ldg<v2u>(P, eo * 2u); v2u xp = {0u, 0u}, xn = {0u, 0u};
    if (hp) xp = ldg<v2u>(P, (eo - DINP) * 2u); if (hn) xn = ldg<v2u>(P, (eo + DINP) * 2u);
    const f32x4 mp = ldg<f32x4>(mup, mo * 4u), mn = ldg<f32x4>(mun, mo * 4u);
    const float c[4] = {bflo(xc.x), bfhi(xc.x), bflo(xc.y), bfhi(xc.y)}, p[4] = {bflo(xp.x), bfhi(xp.x), bflo(xp.y), bfhi(xp.y)}, n[4] = {bflo(xn.x), bfhi(xn.x), bflo(xn.y), bfhi(xn.y)};
#pragma unroll
    for (int e = 0; e < 4; ++e) u[e] = c[e] + mp[e] * (p[e] - c[e]) + mn[e] * (n[e] - c[e]);
}
__device__ __forceinline__ void st4bf(void* base, unsigned eo, float a, float b, float c, float d) { v2u w; w.x = pk2(a, b); w.y = pk2(c, d); stg<v2u>(base, eo * 2u, w); }

__device__ __forceinline__ void rwkv_feat_item(Frame& F, int l, int item) {
    F.tid = ltid(); F.lane = F.tid & 63;
    int row0, seq_lo, seq_hi;
    if (item < 16) { const int b = item >> 3; seq_lo = M_LAT + b * NCTX; seq_hi = seq_lo + NCTX; row0 = seq_lo + (item & 7) * 32; }
    else { const int it = item - 16, b = it >> 8; seq_lo = b * SEQ; seq_hi = seq_lo + SEQ; row0 = seq_lo + (it & 255) * 32; }
    const bf16* P = (const bf16*)(F.ws + WS_P);
    LAS bf16* ACT = (LAS bf16*)F.lds;
    const float* mup = INP(I_MUP) + l * RWC; const float* mun = INP(I_MUN) + l * RWC;
    __syncthreads();
    {
#pragma unroll
      for (int k = 0; k < 4; ++k) { const int p = F.tid + NTHR * k;
        if (p < 32 * 52) { const int tok = p / 52, j = (p - tok * 52) * 8, row = row0 + tok; const bool hp = row > seq_lo, hn = row + 1 < seq_hi;
          const bf16* pr = P + (size_t)row * DINP + C_RWL + j;
          const v4u xc = *(const v4u*)pr; v4u xp = {0u, 0u, 0u, 0u}, xn = {0u, 0u, 0u, 0u};
          if (hp) xp = *(const v4u*)(pr - DINP); if (hn) xn = *(const v4u*)(pr + DINP);
          const f32x4 mp[2] = {*(const f32x4*)(mup + 3072 + j), *(const f32x4*)(mup + 3072 + j + 4)}, mn[2] = {*(const f32x4*)(mun + 3072 + j), *(const f32x4*)(mun + 3072 + j + 4)};
          unsigned o[4];
#pragma unroll
          for (int w = 0; w < 4; ++w) { float u[2];
#pragma unroll
              for (int e = 0; e < 2; ++e) { const int idx = 2 * w + e; const float c = e ? bfhi(xc[w]) : bflo(xc[w]), pv = e ? bfhi(xp[w]) : bflo(xp[w]), nv = e ? bfhi(xn[w]) : bflo(xn[w]);
                  float v = c + mp[idx >> 2][idx & 3] * (pv - c) + mn[idx >> 2][idx & 3] * (nv - c);
                  if (j < 128) v = tanhf_(v); else if (j >= 256) v = sigmoidf_(v);
                  u[e] = v; }
              o[w] = pk2(u[0], u[1]); }
          *(LAS v4u*)(ACT + tok * 424 + j) = (v4u){o[0], o[1], o[2], o[3]}; } } }
    __syncthreads();
    const int tok = F.lane & 31, hi = F.lane >> 5, row = row0 + tok;
    const bf16* W2T = (const bf16*)(F.wsw + WS_W2T); const bf16* A2T = (const bf16*)(F.wsw + WS_A2T); const bf16* G2T = (const bf16*)(F.wsw + WS_G2T);
    bf16* RWF = (bf16*)(F.ws + WS_RWF); const size_t RS = (size_t)M_TOT * 1024;
    const float* kkv = INP(I_KK) + l * 1024; const float* kav = INP(I_KA) + l * 1024; const float* rkv = INP(I_RK) + l * 1024;
    const float* w0f = INP(I_W0) + (size_t)(l * 2) * 1024; const float* a0f = INP(I_A0) + (size_t)(l * 2) * 1024;
    const LAS bf16* actl = ACT + tok * 424 + hi * 8;
    LAS unsigned char* TB = F.lds + 27136 + F.wave * 10880;
    LAS float* VB = (LAS float*)(F.lds + (F.wave < 4 ? 114176 + F.wave * 3328 : 131584 + (F.wave - 4) * 3328));
#define RF_LOADG(reg_, colbase) do { _Pragma("unroll") for (int i_ = 0; i_ < 3; ++i_) { const int p_ = F.lane + 64 * i_; reg_[i_] = (v4u){0u, 0u, 0u, 0u}; if (p_ < 136) { const int rr_ = p_ >> 2, cp_ = p_ & 3, gr_ = row0 - 1 + rr_; \
        if (gr_ >= seq_lo && gr_ < seq_hi) reg_[i_] = ldg<v4u>(P, ((unsigned)gr_ * DINP + (colbase) + 8 * cp_) * 2u); } } } while (0)
#define RF_STORET(ti, reg_) do { _Pragma("unroll") for (int i_ = 0; i_ < 3; ++i_) { const int p_ = F.lane + 64 * i_; if (p_ < 136) { const int rr_ = p_ >> 2, cp_ = p_ & 3; *(LAS v4u*)(TB + (ti) * 2720 + rr_ * 80 + cp_ * 16) = reg_[i_]; } } } while (0)
#define RF_SHIFT4(ti, g_, vb_, cc_, u_) do { const LAS unsigned char* q_ = TB + (ti) * 2720 + (tok + 1) * 80 + (8 * (g_) + 4 * hi) * 2; const v2u xc_ = *(const LAS v2u*)q_, xp_ = *(const LAS v2u*)(q_ - 80), xn_ = *(const LAS v2u*)(q_ + 80); \
        const f32x4 mp_ = *(const LAS f32x4*)(VB + (vb_) * 64 + (cc_)), mn_ = *(const LAS f32x4*)(VB + ((vb_) + 1) * 64 + (cc_)); \
        const float c_[4] = {bflo(xc_.x), bfhi(xc_.x), bflo(xc_.y), bfhi(xc_.y)}, pp_[4] = {bflo(xp_.x), bfhi(xp_.x), bflo(xp_.y), bfhi(xp_.y)}, nn_[4] = {bflo(xn_.x), bfhi(xn_.x), bflo(xn_.y), bfhi(xn_.y)}; \
        _Pragma("unroll") for (int e_ = 0; e_ < 4; ++e_) u_[e_] = c_[e_] + mp_[e_] * (pp_[e_] - c_[e_]) + mn_[e_] * (nn_[e_] - c_[e_]); } while (0)
#define RF_PUT(ti, o_) do { _Pragma("unroll") for (int g_ = 0; g_ < 4; ++g_) *(LAS v2u*)(TB + (ti) * 2720 + tok * 80 + (8 * g_ + 4 * hi) * 2) = o_[g_]; } while (0)
#define RF_FLUSH3(a0_, a1_, a2_, cblk_) do { asm volatile("s_waitcnt lgkmcnt(0)" ::: "memory"); \
        _Pragma("unroll") for (int t_ = 0; t_ < 3; ++t_) { const int arr_ = t_ == 0 ? (a0_) : (t_ == 1 ? (a1_) : (a2_)); \
            _Pragma("unroll") for (int i_ = 0; i_ < 2; ++i_) { const int p_ = F.lane + 64 * i_, rr_ = p_ >> 2, cp_ = p_ & 3; const v4u v_ = *(const LAS v4u*)(TB + t_ * 2720 + rr_ * 80 + cp_ * 16); \
                stg<v4u>(RWF + arr_ * RS, ((unsigned)(row0 + rr_) * 1024u + (cblk_) + 8 * cp_) * 2u, v_); } } \
        asm volatile("s_waitcnt lgkmcnt(0)" ::: "memory"); } while (0)
#pragma unroll 1
    for (int hh = 0; hh < 2; ++hh) {
        const int h = 2 * F.wave + hh, cbase = h * 64;
        float ssq = 0.f;
        { v4u t0[3], t1[3]; RF_LOADG(t0, C_RWK + cbase); RF_LOADG(t1, C_RWK + cbase + 32);
          const unsigned co = (cbase + F.lane) * 4u; float vv[13];
#pragma unroll
          for (int sct = 0; sct < 3; ++sct) { vv[2 * sct] = ldg<float>(mup, co + sct * 4096u); vv[2 * sct + 1] = ldg<float>(mun, co + sct * 4096u); }
          vv[6] = ldg<float>(kkv, co); vv[7] = ldg<float>(kav, co); vv[8] = ldg<float>(rkv, co); vv[9] = ldg<float>(a0f, co); vv[10] = ldg<float>(a0f, co + 4096u); vv[11] = ldg<float>(w0f, co); vv[12] = ldg<float>(w0f, co + 4096u);
          RF_STORET(0, t0); RF_STORET(1, t1);
#pragma unroll
          for (int q = 0; q < 13; ++q) VB[q * 64 + F.lane] = vv[q]; }
        asm volatile("s_waitcnt lgkmcnt(0)" ::: "memory");
#pragma unroll
        for (int bg = 0; bg < 8; ++bg) { const int cc = (bg >> 2) * 32 + 8 * (bg & 3) + 4 * hi; float uk[4];
            RF_SHIFT4(bg >> 2, bg & 3, 2, cc, uk); const f32x4 k4 = *(const LAS f32x4*)(VB + 6 * 64 + cc);
#pragma unroll
            for (int e = 0; e < 4; ++e) { const float q = uk[e] * k4[e]; ssq += q * q; } }
        ssq = half_swap_sum(ssq);
        const float rn = 1.f / fmaxf(sqrtf(ssq), 1e-12f);
        float sb = 0.f;
        asm volatile("s_waitcnt lgkmcnt(0)" ::: "memory");
#pragma unroll 1
        for (int blk = 0; blk < 2; ++blk) {
            const unsigned cblk = cbase + blk * 32, cha = cblk + tok;
            v4u gR[3], gK[3], gV[3];
            RF_LOADG(gR, C_RWR + cblk); RF_LOADG(gK, C_RWK + cblk); RF_LOADG(gV, C_RWV + cblk);
            bf16x8 wd[2][4], wg[10], wa[2][4];
#pragma unroll
            for (int d = 0; d < 2; ++d) {
#pragma unroll
                for (int ks = 0; ks < 4; ++ks) wd[d][ks] = ldg<bf16x8>(W2T, ((d * 1024 + cha) * 64 + ks * 16 + hi * 8) * 2u); }
#pragma unroll
            for (int ks = 0; ks < 10; ++ks) wg[ks] = ldg<bf16x8>(G2T, (cha * 192 + ks * 16 + hi * 8) * 2u);
#pragma unroll
            for (int d = 0; d < 2; ++d) {
#pragma unroll
                for (int ks = 0; ks < 4; ++ks) wa[d][ks] = ldg<bf16x8>(A2T, ((d * 1024 + cha) * 64 + ks * 16 + hi * 8) * 2u); }
#pragma unroll
            for (int d = 0; d < 2; ++d) { f32x16 aw = {};
#pragma unroll
                for (int ks = 0; ks < 4; ++ks) { const bf16x8 bw = *(const LAS bf16x8*)(actl + d * 64 + ks * 16);
                    aw = __builtin_amdgcn_mfma_f32_32x32x16_bf16(wd[d][ks], bw, aw, 0, 0, 0); }
                v2u o[4];
#pragma unroll
                for (int g = 0; g < 4; ++g) { const f32x4 w0 = *(const LAS f32x4*)(VB + (11 + d) * 64 + blk * 32 + 8 * g + 4 * hi); float e4[4];
#pragma unroll
                    for (int e = 0; e < 4; ++e) e4[e] = 0.60653065971f * sigmoidf_(w0[e] + aw[4 * g + e]);
                    o[g].x = pk2(e4[0], e4[1]); o[g].y = pk2(e4[2], e4[3]); }
                RF_PUT(d, o); }
            { f32x16 ag = {};
#pragma unroll
              for (int ks = 0; ks < 10; ++ks) { const bf16x8 bg_ = *(const LAS bf16x8*)(actl + 256 + ks * 16);
                  ag = __builtin_amdgcn_mfma_f32_32x32x16_bf16(wg[ks], bg_, ag, 0, 0, 0); }
              v2u o[4];
#pragma unroll
              for (int g = 0; g < 4; ++g) { o[g].x = pk2(ag[4 * g], ag[4 * g + 1]); o[g].y = pk2(ag[4 * g + 2], ag[4 * g + 3]); }
              RF_PUT(2, o); }
            RF_FLUSH3(4, 5, 8, cblk);
            RF_STORET(0, gR); RF_STORET(1, gK); RF_STORET(2, gV);
            { f32x16 aaf = {}, aab = {};
#pragma unroll
              for (int ks = 0; ks < 4; ++ks) { const bf16x8 baf = *(const LAS bf16x8*)(actl + 128 + ks * 16), bab = *(const LAS bf16x8*)(actl + 192 + ks * 16);
                  aaf = __builtin_amdgcn_mfma_f32_32x32x16_bf16(wa[0][ks], baf, aaf, 0, 0, 0); aab = __builtin_amdgcn_mfma_f32_32x32x16_bf16(wa[1][ks], bab, aab, 0, 0, 0); }
              v2u oR[4], oK[4], oV[4], oKK[4], oAF[4], oAB[4];
              asm volatile("s_waitcnt lgkmcnt(0)" ::: "memory");
#pragma unroll
              for (int g = 0; g < 4; ++g) { const int cc = blk * 32 + 8 * g + 4 * hi; float ur[4], uk[4], uv[4];
                  RF_SHIFT4(0, g, 0, cc, ur); RF_SHIFT4(1, g, 2, cc, uk); RF_SHIFT4(2, g, 4, cc, uv);
                  const f32x4 a0a = *(const LAS f32x4*)(VB + 9 * 64 + cc), a0b = *(const LAS f32x4*)(VB + 10 * 64 + cc), kk4 = *(const LAS f32x4*)(VB + 6 * 64 + cc), ka4 = *(const LAS f32x4*)(VB + 7 * 64 + cc), rk4 = *(const LAS f32x4*)(VB + 8 * 64 + cc);
                  float af[4], ab[4], kk[4];
#pragma unroll
                  for (int e = 0; e < 4; ++e) { const int r = 4 * g + e;
                      af[e] = sigmoidf_(a0a[e] + aaf[r]); ab[e] = sigmoidf_(a0b[e] + aab[r]); kk[e] = uk[e] * kk4[e] * rn;
                      const float kdf = uk[e] * (1.f + (af[e] - 1.f) * ka4[e]), kdb = uk[e] * (1.f + (ab[e] - 1.f) * ka4[e]);
                      sb += ur[e] * rk4[e] * (kdf + kdb); }
                  oR[g].x = pk2(ur[0], ur[1]); oR[g].y = pk2(ur[2], ur[3]); oK[g].x = pk2(uk[0], uk[1]); oK[g].y = pk2(uk[2], uk[3]); oV[g].x = pk2(uv[0], uv[1]); oV[g].y = pk2(uv[2], uv[3]);
                  oKK[g].x = pk2(kk[0], kk[1]); oKK[g].y = pk2(kk[2], kk[3]); oAF[g].x = pk2(af[0], af[1]); oAF[g].y = pk2(af[2], af[3]); oAB[g].x = pk2(ab[0], ab[1]); oAB[g].y = pk2(ab[2], ab[3]); }
              asm volatile("s_waitcnt lgkmcnt(0)" ::: "memory");
              RF_PUT(0, oR); RF_PUT(1, oK); RF_PUT(2, oV); RF_FLUSH3(0, 1, 2, cblk);
              RF_PUT(0, oKK); RF_PUT(1, oAF); RF_PUT(2, oAB); RF_FLUSH3(3, 6, 7, cblk); }
        }
        sb = half_swap_sum(sb);
        if (hi == 0) ((float*)(F.ws + WS_SB))[(size_t)row * 16 + h] = sb;
    }
#undef RF_LOADG
#undef RF_STORET
#undef RF_SHIFT4
#undef RF_PUT
#undef RF_FLUSH3
}

__device__ __forceinline__ float gelu_tanh(float x) { return 0.5f * x * (1.f + tanhf_(0.7978845608028654f * (x + 0.044715f * x * x * x))); }
template <bool PASS3>
__device__ __forceinline__ void lru_item(Frame& F, int l, int item) {
    F.tid = ltid(); F.lane = F.tid & 63;
    const int sc = item >> 3, nb = item & 7, b = sc / NCH, ch = sc % NCH;
    int row0, seq_lo, seq_hi;
    if (ch < 8) { seq_lo = M_LAT + b * NCTX; seq_hi = seq_lo + NCTX; row0 = seq_lo + ch * 32; }
    else { seq_lo = b * SEQ; seq_hi = seq_lo + SEQ; row0 = seq_lo + (ch - 8) * 32; }
    const bf16* P = (const bf16*)(F.ws + WS_P);
    LAS float* U = (LAS float*)F.lds;
    LAS bf16* UA = (LAS bf16*)(F.lds + 16384);
    LAS float* AB = (LAS float*)(F.lds + 32768);
    __syncthreads();
    { const int tok = F.tid >> 4, c8 = (F.tid & 15) * 8, cg = nb * 128 + c8; float acc[8];
      const float* cb = INP(I_CONVB) + l * 1024 + cg;
#pragma unroll
      for (int e = 0; e < 8; ++e) acc[e] = cb[e];
#pragma unroll
      for (int j = 0; j < 4; ++j) { const int r = row0 + tok - 2 + j;
          if (r >= seq_lo && r < seq_hi) { const v4u x = *(const v4u*)(P + (size_t)r * DINP + C_LRUX + cg); const float* cw = INP(I_CONVW) + (size_t)(l * 4 + j) * 1024 + cg;
#pragma unroll
              for (int w = 0; w < 4; ++w) { acc[2 * w] += cw[2 * w] * bflo(x[w]); acc[2 * w + 1] += cw[2 * w + 1] * bfhi(x[w]); } } }
      *(LAS f32x4*)(U + tok * 128 + c8) = (f32x4){acc[0], acc[1], acc[2], acc[3]}; *(LAS f32x4*)(U + tok * 128 + c8 + 4) = (f32x4){acc[4], acc[5], acc[6], acc[7]};
      v4u o; o.x = pk2(acc[0], acc[1]); o.y = pk2(acc[2], acc[3]); o.z = pk2(acc[4], acc[5]); o.w = pk2(acc[6], acc[7]);
      *(LAS v4u*)(UA + tok * 136 + c8) = o; }
    __syncthreads();
    { const int dir = F.wave >> 2, cq = F.wave & 3, l32 = F.lane & 31, hi = F.lane >> 5, chn = cq * 32 + l32, cg = nb * 128 + chn;
      const bf16* Wr = (const bf16*)(F.wsw + WS_WLRU) + ((size_t)(dir * 2 + 0) * 8 + nb) * 16384 + (size_t)chn * 128;
      const bf16* Wi = (const bf16*)(F.wsw + WS_WLRU) + ((size_t)(dir * 2 + 1) * 8 + nb) * 16384 + (size_t)chn * 128;
      f32x16 accr = {}, acci = {};
#pragma unroll
      for (int ks = 0; ks < 8; ++ks) { const int ko = ks * 16 + hi * 8;
          const bf16x8 a = *(const LAS bf16x8*)(UA + l32 * 136 + ko); const bf16x8 br = *(const bf16x8*)(Wr + ko), bi = *(const bf16x8*)(Wi + ko);
          accr = __builtin_amdgcn_mfma_f32_32x32x16_bf16(a, br, accr, 0, 0, 0); acci = __builtin_amdgcn_mfma_f32_32x32x16_bf16(a, bi, acci, 0, 0, 0); }
      const float ba = INP(I_LBA)[(l * 2 + dir) * 1024 + cg], bi_ = INP(I_LBI)[(l * 2 + dir) * 1024 + cg], sp = softplusf_(-INP(I_LAM)[(l * 2 + dir) * 1024 + cg]);
#pragma unroll
      for (int r = 0; r < 16; ++r) { const int tok = att::crow(r, hi); const float u = U[tok * 128 + chn];
          const float rg = sigmoidf_(accr[r] + ba), ig = sigmoidf_(acci[r] + bi_), la = -8.f * rg * sp, a = __expf(la), x2 = 2.f * la;
          const float em = x2 * (1.f + x2 * (0.5f + x2 * (0.16666667f + x2 * (0.041666668f + x2 * (0.0083333338f + x2 * 0.0013888889f)))));
          const float bc = __builtin_amdgcn_sqrtf(x2 < -0.5f ? 1.f - a * a : -em) * (ig * u);
          AB[(dir * 2 + 0) * 4096 + tok * 128 + chn] = a; AB[(dir * 2 + 1) * 4096 + tok * 128 + chn] = bc; } }
    __syncthreads();
    if (F.tid < 256) { const int dir = F.tid >> 7, chn = F.tid & 127, cg = nb * 128 + chn; const size_t ci = ((size_t)(dir * 2 + b) * NCH + ch) * 1024 + cg;
        LAS float* Aa = AB + (dir * 2) * 4096 + chn; LAS float* Bb = AB + (dir * 2 + 1) * 4096 + chn;
        if (!PASS3) { float h = 0.f, ap = 1.f;
#pragma unroll 8
            for (int s = 0; s < 32; ++s) { const int tok = dir ? 31 - s : s; const float a = Aa[tok * 128]; h = a * h + Bb[tok * 128]; ap *= a;
                if (s == 0 && dir == 1 && ch == 7) ((float*)(F.ws + WS_QUIRK))[b * 1024 + cg] = h; }
            ((float*)(F.ws + WS_CA))[ci] = ap; ((float*)(F.ws + WS_CB))[ci] = h;
        } else { float h = ((const float*)(F.ws + WS_HIN))[ci];
#pragma unroll 8
            for (int s = 0; s < 32; ++s) { const int tok = dir ? 31 - s : s; h = Aa[tok * 128] * h + Bb[tok * 128]; Bb[tok * 128] = h; } } }
    if (PASS3) { __syncthreads();
        const int tok = F.tid >> 4, c8 = (F.tid & 15) * 8, cg = nb * 128 + c8, row = row0 + tok;
        const v4u y = *(const v4u*)(P + (size_t)row * DINP + C_LRUY + cg); float o[8];
#pragma unroll
        for (int w = 0; w < 4; ++w) { const float h0 = AB[4096 + tok * 128 + c8 + 2 * w] + AB[3 * 4096 + tok * 128 + c8 + 2 * w], h1 = AB[4096 + tok * 128 + c8 + 2 * w + 1] + AB[3 * 4096 + tok * 128 + c8 + 2 * w + 1];
            o[2 * w] = h0 * gelu_tanh(bflo(y[w])); o[2 * w + 1] = h1 * gelu_tanh(bfhi(y[w])); }
        v4u ov; ov.x = pk2(o[0], o[1]); ov.y = pk2(o[2], o[3]); ov.z = pk2(o[4], o[5]); ov.w = pk2(o[6], o[7]);
        *(v4u*)((bf16*)(F.ws + WS_MIX) + (size_t)row * DM + 1024 + cg) = ov; }
}
template <bool PASS3>
__device__ __forceinline__ void lru_items(Frame& F, int l, int i0, int i1, int st, bool skipctx) {
    F.tid = ltid(); F.lane = F.tid & 63;
    int it = i0; while (it < i1 && skipctx && ((it >> 3) % NCH) < 8) it += st;
    if (it >= i1) return;
    const int nb = it & 7;
    const bf16* P = (const bf16*)(F.ws + WS_P);
    LAS float* U = (LAS float*)F.lds; LAS bf16* UA = (LAS bf16*)(F.lds + 16384); LAS float* AB = (LAS float*)(F.lds + 32768);
    const int tokc = F.tid >> 4, c8 = (F.tid & 15) * 8, cgc = nb * 128 + c8;
    const int dir = F.wave >> 2, cq = F.wave & 3, l32 = F.lane & 31, hi = F.lane >> 5, chn = cq * 32 + l32, cg = nb * 128 + chn;
    f32x4 cbv[2], cwv[4][2];
#pragma unroll
    for (int q = 0; q < 2; ++q) { cbv[q] = *(const f32x4*)(INP(I_CONVB) + l * 1024 + cgc + 4 * q);
#pragma unroll
        for (int j = 0; j < 4; ++j) cwv[j][q] = *(const f32x4*)(INP(I_CONVW) + (size_t)(l * 4 + j) * 1024 + cgc + 4 * q); }
    bf16x8 wr[8], wi[8];
    { const bf16* Wr = (const bf16*)(F.wsw + WS_WLRU) + ((size_t)(dir * 2 + 0) * 8 + nb) * 16384 + (size_t)chn * 128;
      const bf16* Wi = (const bf16*)(F.wsw + WS_WLRU) + ((size_t)(dir * 2 + 1) * 8 + nb) * 16384 + (size_t)chn * 128;
#pragma unroll
      for (int ks = 0; ks < 8; ++ks) { wr[ks] = *(const bf16x8*)(Wr + ks * 16 + hi * 8); wi[ks] = *(const bf16x8*)(Wi + ks * 16 + hi * 8); } }
    const float ba = INP(I_LBA)[(l * 2 + dir) * 1024 + cg], bi_ = INP(I_LBI)[(l * 2 + dir) * 1024 + cg], sp = softplusf_(-INP(I_LAM)[(l * 2 + dir) * 1024 + cg]);
    v4u xr[4];
#define LRU_LOADX(it_) do { const int sc_ = (it_) >> 3, b_ = sc_ / NCH, ch_ = sc_ % NCH; const int lo_ = ch_ < 8 ? M_LAT + b_ * NCTX : b_ * SEQ, hi_ = lo_ + (ch_ < 8 ? NCTX : SEQ), r0_ = lo_ + (ch_ < 8 ? ch_ : ch_ - 8) * 32; \
        _Pragma("unroll") for (int j_ = 0; j_ < 4; ++j_) { const int r_ = r0_ + tokc - 2 + j_; xr[j_] = (v4u){0u, 0u, 0u, 0u}; if (r_ >= lo_ && r_ < hi_) xr[j_] = *(const v4u*)(P + (size_t)r_ * DINP + C_LRUX + cgc); } } while (0)
    LRU_LOADX(it);
#pragma unroll 1
    for (;;) {
        const int sc = it >> 3, b = sc / NCH, ch = sc % NCH;
        const int row0 = ch < 8 ? M_LAT + b * NCTX + ch * 32 : b * SEQ + (ch - 8) * 32;
        __syncthreads();
        { float acc[8];
#pragma unroll
          for (int e = 0; e < 8; ++e) acc[e] = cbv[e >> 2][e & 3];
#pragma unroll
          for (int j = 0; j < 4; ++j) {
#pragma unroll
              for (int w = 0; w < 4; ++w) { acc[2 * w] += cwv[j][(2 * w) >> 2][(2 * w) & 3] * bflo(xr[j][w]); acc[2 * w + 1] += cwv[j][(2 * w + 1) >> 2][(2 * w + 1) & 3] * bfhi(xr[j][w]); } }
          *(LAS f32x4*)(U + tokc * 128 + c8) = (f32x4){acc[0], acc[1], acc[2], acc[3]}; *(LAS f32x4*)(U + tokc * 128 + c8 + 4) = (f32x4){acc[4], acc[5], acc[6], acc[7]};
          v4u o; o.x = pk2(acc[0], acc[1]); o.y = pk2(acc[2], acc[3]); o.z = pk2(acc[4], acc[5]); o.w = pk2(acc[6], acc[7]);
          *(LAS v4u*)(UA + tokc * 136 + c8) = o; }
        int itn = it + st; while (itn < i1 && skipctx && ((itn >> 3) % NCH) < 8) itn += st;
        if (itn < i1) LRU_LOADX(itn);
        __syncthreads();
        { f32x16 accr = {}, acci = {};
#pragma unroll
          for (int ks = 0; ks < 8; ++ks) { const bf16x8 a = *(const LAS bf16x8*)(UA + l32 * 136 + ks * 16 + hi * 8);
              accr = __builtin_amdgcn_mfma_f32_32x32x16_bf16(a, wr[ks], accr, 0, 0, 0); acci = __builtin_amdgcn_mfma_f32_32x32x16_bf16(a, wi[ks], acci, 0, 0, 0); }
#pragma unroll
          for (int r = 0; r < 16; ++r) { const int tok = att::crow(r, hi); const float u = U[tok * 128 + chn];
              const float rg = sigmoidf_(accr[r] + ba), ig = sigmoidf_(acci[r] + bi_), la = -8.f * rg * sp, a = __expf(la), x2 = 2.f * la;
              const float em = x2 * (1.f + x2 * (0.5f + x2 * (0.16666667f + x2 * (0.041666668f + x2 * (0.0083333338f + x2 * 0.0013888889f)))));
              const float bc = __builtin_amdgcn_sqrtf(x2 < -0.5f ? 1.f - a * a : -em) * (ig * u);
              AB[(dir * 2 + 0) * 4096 + tok * 128 + chn] = a; AB[(dir * 2 + 1) * 4096 + tok * 128 + chn] = bc; } }
        __syncthreads();
        if (F.tid < 256) { const int dr = F.tid >> 7, cn = F.tid & 127, cgs = nb * 128 + cn; const size_t ci = ((size_t)(dr * 2 + b) * NCH + ch) * 1024 + cgs;
            LAS float* Aa = AB + (dr * 2) * 4096 + cn; LAS float* Bb = AB + (dr * 2 + 1) * 4096 + cn;
            if (!PASS3) { float h = 0.f, ap = 1.f;
#pragma unroll 8
                for (int s = 0; s < 32; ++s) { const int tok = dr ? 31 - s : s; const float a = Aa[tok * 128]; h = a * h + Bb[tok * 128]; ap *= a;
                    if (s == 0 && dr == 1 && ch == 7) ((float*)(F.ws + WS_QUIRK))[b * 1024 + cgs] = h; }
                ((float*)(F.ws + WS_CA))[ci] = ap; ((float*)(F.ws + WS_CB))[ci] = h;
            } else { float h = ((const float*)(F.ws + WS_HIN))[ci];
#pragma unroll 8
                for (int s = 0; s < 32; ++s) { const int tok = dr ? 31 - s : s; h = Aa[tok * 128] * h + Bb[tok * 128]; Bb[tok * 128] = h; } } }
        if (PASS3) { __syncthreads();
            const int cgo = nb * 128 + c8, row = row0 + tokc;
            const v4u y = *(const v4u*)(P + (size_t)row * DINP + C_LRUY + cgo); float o[8];
#pragma unroll
            for (int w = 0; w < 4; ++w) { const float h0 = AB[4096 + tokc * 128 + c8 + 2 * w] + AB[3 * 4096 + tokc * 128 + c8 + 2 * w], h1 = AB[4096 + tokc * 128 + c8 + 2 * w + 1] + AB[3 * 4096 + tokc * 128 + c8 + 2 * w + 1];
                o[2 * w] = h0 * gelu_tanh(bflo(y[w])); o[2 * w + 1] = h1 * gelu_tanh(bfhi(y[w])); }
            v4u ov; ov.x = pk2(o[0], o[1]); ov.y = pk2(o[2], o[3]); ov.z = pk2(o[4], o[5]); ov.w = pk2(o[6], o[7]);
            *(v4u*)((bf16*)(F.ws + WS_MIX) + (size_t)row * DM + 1024 + cgo) = ov; }
        if (itn >= i1) break;
        it = itn;
    }
#undef LRU_LOADX
}
__device__ __forceinline__ void lru_carry(Frame& F, int blk) {
    F.tid = ltid(); F.lane = F.tid & 63;
    const int gid = blk * NTHR + F.tid; if (gid >= 4096) return;
    const int dir = gid >> 11, b = (gid >> 10) & 1, cg = gid & 1023;
    gcfl CA = (gcfl)((const float*)(F.ws + WS_CA) + ((size_t)(dir * 2 + b) * NCH) * 1024 + cg); gcfl CB = (gcfl)((const float*)(F.ws + WS_CB) + ((size_t)(dir * 2 + b) * NCH) * 1024 + cg);
    gflp HIN = (gflp)((float*)(F.ws + WS_HIN) + ((size_t)(dir * 2 + b) * NCH) * 1024 + cg);
    float h = 0.f;
#define LC_RUN(cstart, count, step) do { _Pragma("unroll 1") for (int base_ = 0; base_ < (count); base_ += 33) { float a_[33], b_[33]; \
        _Pragma("unroll") for (int i_ = 0; i_ < 33; ++i_) { a_[i_] = 0.f; b_[i_] = 0.f; if (base_ + i_ < (count)) { const int c_ = (cstart) + (step) * (base_ + i_); a_[i_] = CA[(size_t)c_ * 1024]; b_[i_] = CB[(size_t)c_ * 1024]; } } \
        _Pragma("unroll") for (int i_ = 0; i_ < 33; ++i_) { if (base_ + i_ < (count)) { const int c_ = (cstart) + (step) * (base_ + i_); HIN[(size_t)c_ * 1024] = h; h = a_[i_] * h + b_[i_]; } } } } while (0)
    if (dir == 0) LC_RUN(0, NCH, 1);
    else { LC_RUN(7, 8, -1);
        h = ((const float*)(F.ws + WS_QUIRK))[b * 1024 + cg];
        LC_RUN(NCH - 1, NCH - 8, -1); }
#undef LC_RUN
}

__device__ __forceinline__ void rope_table(Frame& F) {
    const int i = F.vcu * NTHR + F.tid; if (i >= 2048) return;
    const int pos = i >> 4, f = i & 15; float s, c; sincosf((float)pos * exp2f(-(float)f * (13.287712379549449f / 16.f)), &s, &c);
    float* t = (float*)(F.ws + WS_ROPE); t[i] = c; t[2048 + i] = s;
}
__device__ __forceinline__ void row_prep(Frame& F, int row) {
    F.tid = ltid(); F.lane = F.tid & 63;
    bf16* pr = (bf16*)(F.ws + WS_P) + (size_t)row * DINP; const int lane = F.lane;
    const bool lat = row < M_LAT; const int t = row & (SEQ - 1); const float prow = (float)(t >> 6), pcol = (float)(t & 63);
    { const v4u a = *(const v4u*)(pr + C_QA + lane * 16), b = *(const v4u*)(pr + C_QA + lane * 16 + 8); float ss = 0.f;
#pragma unroll
      for (int w = 0; w < 4; ++w) { const float x0 = bflo(a[w]), x1 = bfhi(a[w]), x2 = bflo(b[w]), x3 = bfhi(b[w]); ss += x0 * x0 + x1 * x1 + x2 * x2 + x3 * x3; }
      ss = wave_sum(ss); if (lane == 0) ((float*)(F.ws + WS_RSQ))[row] = 1.f / sqrtf(ss * (1.f / 1024.f) + RMS_EPS); }
    { const v4u a = *(const v4u*)(pr + C_KVA + lane * 8); float ss = 0.f;
#pragma unroll
      for (int w = 0; w < 4; ++w) { const float x0 = bflo(a[w]), x1 = bfhi(a[w]); ss += x0 * x0 + x1 * x1; }
      ss = wave_sum(ss); if (lane == 0) ((float*)(F.ws + WS_RSKV))[row] = 1.f / sqrtf(ss * (1.f / 512.f) + RMS_EPS); }
    bf16* kr = (bf16*)(F.ws + WS_KR) + (size_t)row * 64;
    if (lat) {
        { const int part = lane >> 5, sub = lane & 31;
          const float inv = exp2f(-(float)sub * (13.287712379549449f / 32.f)); float sn, cs; sincosf((part ? pcol : prow) * inv, &sn, &cs);
          LAS float* tb = (LAS float*)(F.lds + F.wave * 512); tb[lane] = cs; tb[64 + lane] = sn;
          asm volatile("s_waitcnt lgkmcnt(0)" ::: "memory");
#pragma unroll
          for (int i = 0; i < 2; ++i) { const int t = lane + 64 * i; if (t < 80) { const int unit = t >> 2, q = t & 3, hd = unit >> 1, pt = unit & 1;
              bf16* qb = pr + (hd < 8 ? C_SWAQ + hd * 128 : C_SWAK + (hd - 8) * 128) + pt * 64 + 8 * q;
              const v4u a = *(const v4u*)qb, b = *(const v4u*)(qb + 32);
              const f32x4 c0 = *(const LAS f32x4*)(tb + pt * 32 + 8 * q), c1 = *(const LAS f32x4*)(tb + pt * 32 + 8 * q + 4), s0 = *(const LAS f32x4*)(tb + 64 + pt * 32 + 8 * q), s1 = *(const LAS f32x4*)(tb + 64 + pt * 32 + 8 * q + 4);
              v4u oa, ob;
#pragma unroll
              for (int w = 0; w < 4; ++w) { const float cl = w < 2 ? c0[2 * w] : c1[2 * w - 4], ch = w < 2 ? c0[2 * w + 1] : c1[2 * w - 3], sl = w < 2 ? s0[2 * w] : s1[2 * w - 4], sh = w < 2 ? s0[2 * w + 1] : s1[2 * w - 3];
                  const float x1l = bflo(a[w]), x1h = bfhi(a[w]), x2l = bflo(b[w]), x2h = bfhi(b[w]);
                  oa[w] = pk2(x1l * cl - x2l * sl, x1h * ch - x2h * sh); ob[w] = pk2(x2l * cl + x1l * sl, x2h * ch + x1h * sh); }
              *(v4u*)qb = oa; *(v4u*)(qb + 32) = ob; } }
          asm volatile("s_waitcnt lgkmcnt(0)" ::: "memory"); }
        if (lane < 32) { const int part = lane >> 4, i = lane & 15; const bf16* src = pr + C_KR + part * 32;
          const float inv = exp2f(-(float)i * (13.287712379549449f / 16.f)); float s, c; sincosf((part ? pcol : prow) * inv, &s, &c);
          const float x1 = bf2f(src[i]), x2 = bf2f(src[i + 16]);
          kr[part * 32 + i] = (bf16)f2bf(x1 * c - x2 * s); kr[part * 32 + i + 16] = (bf16)f2bf(x2 * c + x1 * s); }
    } else kr[lane] = pr[C_KR + lane];
}

__device__ __forceinline__ float allred16(float x) { return row_sum16(x); }
__device__ __forceinline__ int scan_row(int s, int dir, int b) {
    if (s < NCTX) return M_LAT + b * NCTX + (dir ? NCTX - 1 - s : s);
    const int t = s - NCTX; return b * SEQ + (dir ? SEQ - 1 - t : t);
}
__device__ __forceinline__ void rwkv_scan(Frame& F, int l, int chain) {
    F.tid = ltid(); F.lane = F.tid & 63;
    const int dir = chain >> 5, b = (chain >> 4) & 1, h = chain & 15;
    constexpr int CT = 24, NCHK = (NCTX + SEQ) / CT, STEPF = 392, BUFF = CT * STEPF;
    LAS float* buf = (LAS float*)F.lds; LAS float* ybuf = (LAS float*)(F.lds + 3 * BUFF * 4);
    gcbf RWF = (gcbf)(F.ws + WS_RWF); const size_t RS = (size_t)M_TOT * 1024;
    gflp YS = (gflp)(F.ws + WS_YS) + (size_t)dir * M_TOT * 1024;
    const bool cmp = F.wave < 4; const int lt = F.tid - 256, lst = lt >> 4, lq = lt & 15, lc = h * 64 + 4 * lq;
    const f32x4 ka4 = *(const GAS f32x4*)((gcfl)INP(I_KA) + l * 1024 + (cmp ? 0 : lc));
    v2u gr[2], gk[2], gv[2], gkk[2], ge[2], ga[2];
#pragma unroll
    for (int u = 0; u < 2; ++u) { gr[u] = (v2u){0u, 0u}; gk[u] = gr[u]; gv[u] = gr[u]; gkk[u] = gr[u]; ge[u] = gr[u]; ga[u] = gr[u]; }
#define RW_LOAD(c) do { if (!cmp) { _Pragma("unroll") for (int u_ = 0; u_ < 2; ++u_) { const int s_ = lst + 16 * u_; if (s_ < CT) { const size_t o_ = (size_t)scan_row((c) * CT + s_, dir, b) * 1024 + lc; \
        gr[u_] = *(const GAS v2u*)(RWF + 0 * RS + o_); gk[u_] = *(const GAS v2u*)(RWF + 1 * RS + o_); gv[u_] = *(const GAS v2u*)(RWF + 2 * RS + o_); \
        gkk[u_] = *(const GAS v2u*)(RWF + 3 * RS + o_); ge[u_] = *(const GAS v2u*)(RWF + (4 + dir) * RS + o_); ga[u_] = *(const GAS v2u*)(RWF + (6 + dir) * RS + o_); } } } } while (0)
#define RW_WRITE(bi) do { if (!cmp) { _Pragma("unroll") for (int u_ = 0; u_ < 2; ++u_) { const int s_ = lst + 16 * u_; if (s_ < CT) { LAS float* d_ = buf + (bi) * BUFF + s_ * STEPF + 4 * lq; \
        const float r_[4] = {bflo(gr[u_].x), bfhi(gr[u_].x), bflo(gr[u_].y), bfhi(gr[u_].y)}, k_[4] = {bflo(gk[u_].x), bfhi(gk[u_].x), bflo(gk[u_].y), bfhi(gk[u_].y)}, v_[4] = {bflo(gv[u_].x), bfhi(gv[u_].x), bflo(gv[u_].y), bfhi(gv[u_].y)}; \
        const float q_[4] = {bflo(gkk[u_].x), bfhi(gkk[u_].x), bflo(gkk[u_].y), bfhi(gkk[u_].y)}, e_[4] = {bflo(ge[u_].x), bfhi(ge[u_].x), bflo(ge[u_].y), bfhi(ge[u_].y)}, a_[4] = {bflo(ga[u_].x), bfhi(ga[u_].x), bflo(ga[u_].y), bfhi(ga[u_].y)}; \
        f32x4 w4, kd4, kk4, b4, wr4, v4; float sbr = 0.f, skr = 0.f; \
        _Pragma("unroll") for (int e = 0; e < 4; ++e) { w4[e] = __expf(-e_[e]); kd4[e] = k_[e] * (1.f + (a_[e] - 1.f) * ka4[e]); kk4[e] = q_[e]; b4[e] = q_[e] * a_[e]; wr4[e] = w4[e] * r_[e]; v4[e] = v_[e]; sbr += b4[e] * r_[e]; skr += kd4[e] * r_[e]; } \
        sbr = row_sum16(sbr); skr = row_sum16(skr); \
        *(LAS f32x4*)(d_) = w4; *(LAS f32x4*)(d_ + 64) = kd4; *(LAS f32x4*)(d_ + 128) = kk4; *(LAS f32x4*)(d_ + 192) = b4; *(LAS f32x4*)(d_ + 256) = wr4; *(LAS f32x4*)(d_ + 320) = v4; \
        if (lq == 0) *(LAS f32x2*)(buf + (bi) * BUFF + s_ * STEPF + 384) = (f32x2){sbr, skr}; } } } } while (0)
#define RW_FLUSH(c) do { if (!cmp) { _Pragma("unroll") for (int u_ = 0; u_ < 2; ++u_) { const int s_ = lst + 16 * u_; if (s_ < CT) { const f32x4 y_ = *(const LAS f32x4*)(ybuf + ((c) & 1) * (CT * 64) + s_ * 64 + 4 * lq); \
        *(GAS f32x4*)(YS + (size_t)scan_row((c) * CT + s_, dir, b) * 1024 + lc) = y_; } } } } while (0)
    __syncthreads();
    RW_LOAD(0); RW_WRITE(0); RW_LOAD(1); RW_WRITE(1); RW_LOAD(2);
    __syncthreads();
    const int kg = F.lane & 7, rg = F.lane >> 3, r0 = 16 * (F.wave & 3) + 2 * rg;
    f32x2 St[8];
#pragma unroll
    for (int i = 0; i < 8; ++i) St[i] = (f32x2){0.f, 0.f};
    int bc = 0, bw = 2;
#pragma unroll 1
    for (int c = 0; c < NCHK; ++c) {
        if (c + 2 < NCHK) { RW_WRITE(bw); if (c + 3 < NCHK) RW_LOAD(c + 3); }
        if (c > 0) RW_FLUSH(c - 1);
        if (cmp) {
        const LAS float* bb = buf + bc * BUFF + 8 * kg; const LAS float* vb = buf + bc * BUFF + 320 + r0; const LAS float* sb = buf + bc * BUFF + 384;
        LAS float* yb = ybuf + (c & 1) * (CT * 64) + r0;
        f32x4 w4[2], kd4[2], kk4[2], b4[2], wr4[2];
#pragma unroll
        for (int q = 0; q < 2; ++q) { w4[q] = *(const LAS f32x4*)(bb + 4 * q); kd4[q] = *(const LAS f32x4*)(bb + 64 + 4 * q); kk4[q] = *(const LAS f32x4*)(bb + 128 + 4 * q); b4[q] = *(const LAS f32x4*)(bb + 192 + 4 * q); wr4[q] = *(const LAS f32x4*)(bb + 256 + 4 * q); }
        f32x2 v2 = *(const LAS f32x2*)(vb), s2 = *(const LAS f32x2*)(sb);
#pragma unroll
        for (int st = 0; st < CT; ++st) {
            const int sn = (st + 1 < CT ? st + 1 : st) * STEPF;
            f32x4 nw4[2], nkd4[2], nkk4[2], nb4[2], nwr4[2];
#pragma unroll
            for (int q = 0; q < 2; ++q) { nw4[q] = *(const LAS f32x4*)(bb + sn + 4 * q); nkd4[q] = *(const LAS f32x4*)(bb + sn + 64 + 4 * q); nkk4[q] = *(const LAS f32x4*)(bb + sn + 128 + 4 * q); nb4[q] = *(const LAS f32x4*)(bb + sn + 192 + 4 * q); nwr4[q] = *(const LAS f32x4*)(bb + sn + 256 + 4 * q); }
            const f32x2 nv2 = *(const LAS f32x2*)(vb + sn), ns2 = *(const LAS f32x2*)(sb + sn);
#define PR(x, e) ((((e) >> 1) & 1) ? (f32x2){(x)[(e) >> 2][2], (x)[(e) >> 2][3]} : (f32x2){(x)[(e) >> 2][0], (x)[(e) >> 2][1]})
            f32x2 p, z, tpb, tzb;
            asm("v_pk_mul_f32 %0, %4, %12 op_sel:[0,0] op_sel_hi:[1,0]\n\tv_pk_mul_f32 %1, %4, %16 op_sel:[0,0] op_sel_hi:[1,0]\n\tv_pk_mul_f32 %2, %8, %14 op_sel:[0,0] op_sel_hi:[1,0]\n\tv_pk_mul_f32 %3, %8, %18 op_sel:[0,0] op_sel_hi:[1,0]\n\tv_pk_fma_f32 %0, %5, %12, %0 op_sel:[0,1,0] op_sel_hi:[1,1,1]\n\tv_pk_fma_f32 %1, %5, %16, %1 op_sel:[0,1,0] op_sel_hi:[1,1,1]\n\tv_pk_fma_f32 %2, %9, %14, %2 op_sel:[0,1,0] op_sel_hi:[1,1,1]\n\tv_pk_fma_f32 %3, %9, %18, %3 op_sel:[0,1,0] op_sel_hi:[1,1,1]\n\tv_pk_fma_f32 %0, %6, %13, %0 op_sel:[0,0,0] op_sel_hi:[1,0,1]\n\tv_pk_fma_f32 %1, %6, %17, %1 op_sel:[0,0,0] op_sel_hi:[1,0,1]\n\tv_pk_fma_f32 %2, %10, %15, %2 op_sel:[0,0,0] op_sel_hi:[1,0,1]\n\tv_pk_fma_f32 %3, %10, %19, %3 op_sel:[0,0,0] op_sel_hi:[1,0,1]\n\tv_pk_fma_f32 %0, %7, %13, %0 op_sel:[0,1,0] op_sel_hi:[1,1,1]\n\tv_pk_fma_f32 %1, %7, %17, %1 op_sel:[0,1,0] op_sel_hi:[1,1,1]\n\tv_pk_fma_f32 %2, %11, %15, %2 op_sel:[0,1,0] op_sel_hi:[1,1,1]\n\tv_pk_fma_f32 %3, %11, %19, %3 op_sel:[0,1,0] op_sel_hi:[1,1,1]\n\tv_pk_add_f32 %0, %0, %2\n\tv_pk_add_f32 %1, %1, %3\n\tv_pk_mul_f32 %4, %4, %20 op_sel:[0,0] op_sel_hi:[1,0]\n\tv_pk_mul_f32 %5, %5, %20 op_sel:[0,1] op_sel_hi:[1,1]\n\tv_pk_mul_f32 %6, %6, %21 op_sel:[0,0] op_sel_hi:[1,0]\n\tv_pk_mul_f32 %7, %7, %21 op_sel:[0,1] op_sel_hi:[1,1]\n\tv_pk_mul_f32 %8, %8, %22 op_sel:[0,0] op_sel_hi:[1,0]\n\tv_pk_mul_f32 %9, %9, %22 op_sel:[0,1] op_sel_hi:[1,1]\n\tv_pk_mul_f32 %10, %10, %23 op_sel:[0,0] op_sel_hi:[1,0]\n\tv_pk_mul_f32 %11, %11, %23 op_sel:[0,1] op_sel_hi:[1,1]\n\tv_pk_fma_f32 %4, %28, %24, %4 op_sel:[0,0,0] op_sel_hi:[1,0,1]\n\tv_pk_fma_f32 %5, %28, %24, %5 op_sel:[0,1,0] op_sel_hi:[1,1,1]\n\tv_pk_fma_f32 %6, %28, %25, %6 op_sel:[0,0,0] op_sel_hi:[1,0,1]\n\tv_pk_fma_f32 %7, %28, %25, %7 op_sel:[0,1,0] op_sel_hi:[1,1,1]\n\tv_pk_fma_f32 %8, %28, %26, %8 op_sel:[0,0,0] op_sel_hi:[1,0,1]\n\tv_pk_fma_f32 %9, %28, %26, %9 op_sel:[0,1,0] op_sel_hi:[1,1,1]\n\tv_pk_fma_f32 %10, %28, %27, %10 op_sel:[0,0,0] op_sel_hi:[1,0,1]\n\tv_pk_fma_f32 %11, %28, %27, %11 op_sel:[0,1,0] op_sel_hi:[1,1,1]"
                : "=&v"(p), "=&v"(z), "=&v"(tpb), "=&v"(tzb), "+v"(St[0]), "+v"(St[1]), "+v"(St[2]), "+v"(St[3]), "+v"(St[4]), "+v"(St[5]), "+v"(St[6]), "+v"(St[7])
                : "v"(PR(kk4, 0)), "v"(PR(kk4, 2)), "v"(PR(kk4, 4)), "v"(PR(kk4, 6)), "v"(PR(wr4, 0)), "v"(PR(wr4, 2)), "v"(PR(wr4, 4)), "v"(PR(wr4, 6)),
                  "v"(PR(w4, 0)), "v"(PR(w4, 2)), "v"(PR(w4, 4)), "v"(PR(w4, 6)), "v"(PR(kd4, 0)), "v"(PR(kd4, 2)), "v"(PR(kd4, 4)), "v"(PR(kd4, 6)), "v"(v2));
            float p0 = p.x, p1 = p.y, z0 = z.x, z1 = z.y;
#define D4(ctl) "v_add_f32_dpp %0, %0, %0 " ctl " row_mask:0xf bank_mask:0xf\n\tv_add_f32_dpp %1, %1, %1 " ctl " row_mask:0xf bank_mask:0xf\n\tv_add_f32_dpp %2, %2, %2 " ctl " row_mask:0xf bank_mask:0xf\n\tv_add_f32_dpp %3, %3, %3 " ctl " row_mask:0xf bank_mask:0xf\n\t"
            asm volatile("s_nop 1\n\t" D4("quad_perm:[1,0,3,2]") D4("quad_perm:[2,3,0,1]") D4("row_half_mirror") "s_nop 0"
                : "+v"(p0), "+v"(p1), "+v"(z0), "+v"(z1));
#undef D4
            const f32x2 pp = {p0, p1}, zz = {z0, z1};
            { f32x2 y;
              asm("v_pk_fma_f32 %0, %9, %11, %10 op_sel:[0,0,0] op_sel_hi:[1,0,1] neg_lo:[1,0,0] neg_hi:[1,0,0]\n\tv_pk_fma_f32 %0, %12, %11, %0 op_sel:[0,1,0] op_sel_hi:[1,1,1]\n\tv_pk_fma_f32 %1, %9, %13, %1 op_sel:[0,0,0] op_sel_hi:[1,0,1] neg_lo:[1,0,0] neg_hi:[1,0,0]\n\tv_pk_fma_f32 %2, %9, %13, %2 op_sel:[0,1,0] op_sel_hi:[1,1,1] neg_lo:[1,0,0] neg_hi:[1,0,0]\n\tv_pk_fma_f32 %3, %9, %14, %3 op_sel:[0,0,0] op_sel_hi:[1,0,1] neg_lo:[1,0,0] neg_hi:[1,0,0]\n\tv_pk_fma_f32 %4, %9, %14, %4 op_sel:[0,1,0] op_sel_hi:[1,1,1] neg_lo:[1,0,0] neg_hi:[1,0,0]\n\tv_pk_fma_f32 %5, %9, %15, %5 op_sel:[0,0,0] op_sel_hi:[1,0,1] neg_lo:[1,0,0] neg_hi:[1,0,0]\n\tv_pk_fma_f32 %6, %9, %15, %6 op_sel:[0,1,0] op_sel_hi:[1,1,1] neg_lo:[1,0,0] neg_hi:[1,0,0]\n\tv_pk_fma_f32 %7, %9, %16, %7 op_sel:[0,0,0] op_sel_hi:[1,0,1] neg_lo:[1,0,0] neg_hi:[1,0,0]\n\tv_pk_fma_f32 %8, %9, %16, %8 op_sel:[0,1,0] op_sel_hi:[1,1,1] neg_lo:[1,0,0] neg_hi:[1,0,0]"
                : "=&v"(y), "+v"(St[0]), "+v"(St[1]), "+v"(St[2]), "+v"(St[3]), "+v"(St[4]), "+v"(St[5]), "+v"(St[6]), "+v"(St[7])
                : "v"(pp), "v"(zz), "v"(s2), "v"(v2), "v"(PR(b4, 0)), "v"(PR(b4, 2)), "v"(PR(b4, 4)), "v"(PR(b4, 6)));
              *(LAS f32x2*)(yb + st * 64) = y; }
#undef PR
#pragma unroll
            for (int q = 0; q < 2; ++q) { w4[q] = nw4[q]; kd4[q] = nkd4[q]; kk4[q] = nkk4[q]; b4[q] = nb4[q]; wr4[q] = nwr4[q]; }
            v2 = nv2; s2 = ns2;
        }
        }
        __syncthreads();
        bc = bc == 2 ? 0 : bc + 1; bw = bw == 2 ? 0 : bw + 1;
    }
    RW_FLUSH(NCHK - 1);
#undef RW_LOAD
#undef RW_WRITE
#undef RW_FLUSH
}
__device__ __forceinline__ void rwkv_out_row(Frame& F, int l, int row) {
    F.tid = ltid(); F.lane = F.tid & 63;
    const int c0 = F.lane * 16; const float* yf = (const float*)(F.ws + WS_YS) + (size_t)row * 1024 + c0; const float* yb = yf + (size_t)M_TOT * 1024;
    float y[16]; float s = 0.f;
#pragma unroll
    for (int j = 0; j < 4; ++j) { const f32x4 a = __builtin_nontemporal_load((const f32x4*)(yf + 4 * j)), b = __builtin_nontemporal_load((const f32x4*)(yb + 4 * j));
#pragma unroll
        for (int e = 0; e < 4; ++e) { y[4 * j + e] = a[e] + b[e]; s += y[4 * j + e]; } }
    s = quad_sum(s); const float mu = s * (1.f / 64.f); float q = 0.f;
#pragma unroll
    for (int e = 0; e < 16; ++e) { y[e] -= mu; q += y[e] * y[e]; }
    q = quad_sum(q); const float rstd = 1.f / sqrtf(q * (1.f / 64.f) + GN_EPS);
    const bf16* RWF = (const bf16*)(F.ws + WS_RWF); const size_t RS = (size_t)M_TOT * 1024, o = (size_t)row * 1024 + c0;
    const float sbv = ((const float*)(F.ws + WS_SB))[(size_t)row * 16 + (F.lane >> 2)];
    const float* lg = INP(I_LNG) + l * 1024 + c0; const float* lb = INP(I_LNB) + l * 1024 + c0;
    bf16* dst = (bf16*)(F.ws + WS_MIX) + (size_t)row * DM + 3072 + c0;
#pragma unroll
    for (int hf = 0; hf < 2; ++hf) { const v4u vv = *(const v4u*)(RWF + 2 * RS + o + 8 * hf), gg = *(const v4u*)(RWF + 8 * RS + o + 8 * hf); float r[8];
#pragma unroll
        for (int w = 0; w < 4; ++w) { const int e = 8 * hf + 2 * w;
            r[2 * w] = (y[e] * rstd * lg[e] + lb[e] + sbv * bflo(vv[w])) * bflo(gg[w]); r[2 * w + 1] = (y[e + 1] * rstd * lg[e + 1] + lb[e + 1] + sbv * bfhi(vv[w])) * bfhi(gg[w]); }
        v4u ov; ov.x = pk2(r[0], r[1]); ov.y = pk2(r[2], r[3]); ov.z = pk2(r[4], r[5]); ov.w = pk2(r[6], r[7]); *(v4u*)(dst + 8 * hf) = ov; }
}

#ifndef W_OUT_K0
#define W_OUT_K0 1024
#endif
#ifndef W_OUT_K1
#define W_OUT_K1 3072
#endif
struct MlaTiles { gcbf KV; gcbf KR; int ctx_row0, lat_row0, h;
    __device__ __forceinline__ att::Tile operator()(int j) const { const int row = j < 4 ? ctx_row0 + 64 * j : lat_row0 + 64 * (j - 4);
        att::Tile t; t.kn = KV + (size_t)row * 2048 + h * 256; t.v = t.kn + 128; t.kr = KR + (size_t)row * 64; t.mtype = 0; t.krel0 = 0; return t; } };
struct SwaTiles { gcbf P; int blk_row0, ctx_row0, kvh, nwin, has_prev, has_next;
    __device__ __forceinline__ att::Tile operator()(int j) const { att::Tile t; int row; t.mtype = 0; t.krel0 = 0;
        if (j >= nwin) row = ctx_row0 + 64 * (j - nwin);
        else if (j < 2) row = blk_row0 + 64 * j;
        else if (has_prev && j < 4) { row = blk_row0 - 128 + 64 * (j - 2); t.mtype = 1; t.krel0 = -128 + 64 * (j - 2); }
        else { const int sub = j - 2 - 2 * has_prev; row = blk_row0 + 128 + 64 * sub; t.mtype = 2; t.krel0 = 128 + 64 * sub; }
        t.kn = P + (size_t)row * DINP + C_SWAK + kvh * 128; t.v = P + (size_t)row * DINP + C_SWAV + kvh * 128; t.kr = nullptr; return t; } };

#ifndef MLA_SDEPTH
#define MLA_SDEPTH 1
#endif
__device__ __forceinline__ void mla_item(Frame& F, int b, int h, int qb, bool ctxq) {
    F.tid = ltid(); F.lane = F.tid & 63;
    const int r32 = F.lane & 31; const int t = qb * 256 + F.wave * 32 + r32;
    const int roww0 = ctxq ? M_LAT + b * NCTX + F.wave * 32 : b * SEQ + qb * 256 + F.wave * 32;
    gcbf Qw = (gcbf)(F.ws + WS_Q) + (size_t)(roww0 + r32) * 1536 + h * 192;
    MlaTiles ts{(gcbf)(F.ws + WS_KV), (gcbf)(F.ws + WS_KR), M_LAT + b * NCTX, b * SEQ, h};
    gbfp Ow = (gbfp)(F.ws + WS_MIX) + (size_t)roww0 * DM + 2048 + h * 128;
    att::attn_body<192, 2048, 2048, false, false, MLA_SDEPTH>(Qw, ctxq ? 0 : 1, t >> 6, t & 63, (gcfl)(F.ws + WS_ROPE), 0, 0.f, ts, ctxq ? 4 : 132, Ow, (LAS char*)F.lds);
}
__device__ __forceinline__ void swa_item(Frame& F, int l, int b, int n, int kvh, int half, bool ctxq, int hq_ctx) {
    F.tid = ltid(); F.lane = F.tid & 63;
    const int r32 = F.lane & 31; gcbf P = (gcbf)(F.ws + WS_P);
    int hq, qi, roww0, t;
    if (ctxq) { hq = hq_ctx; kvh = hq >> 2; qi = 0; roww0 = M_LAT + b * NCTX + F.wave * 32; t = 0; }
    else { hq = kvh * 4 + 2 * half + (F.wave >> 2); qi = (F.wave & 3) * 32 + r32; roww0 = b * SEQ + n * 128 + (F.wave & 3) * 32; t = n * 128 + qi; }
    gcbf Qw = P + (size_t)(roww0 + r32) * DINP + C_SWAQ + hq * 128;
    SwaTiles ts; ts.P = P; ts.blk_row0 = b * SEQ + n * 128; ts.ctx_row0 = M_LAT + b * NCTX; ts.kvh = kvh;
    ts.has_prev = (!ctxq && n > 0) ? 1 : 0; ts.has_next = (!ctxq && n < SEQ / 128 - 1) ? 1 : 0; ts.nwin = ctxq ? 0 : 2 + 2 * ts.has_prev + 2 * ts.has_next;
    gbfp Ow = (gbfp)(F.ws + WS_MIX) + (size_t)roww0 * DM + hq * 128;
    const float sink_l2 = INP(I_SINK)[l * 8 + hq] * 1.4426950408889634f;
    att::attn_body<128, DINP, DINP, true, true, 2>(Qw, 0, 0, 0, (gcfl)nullptr, qi, sink_l2, ts, ts.nwin + 4, Ow, (LAS char*)F.lds);
}

#ifndef DBG_PHASES
#define DBG_PHASES 0xfffff
#endif
#define PH(n) ((DBG_PHASES >> (n)) & 1)
#ifndef DUP_PHASES
#define DUP_PHASES 0
#endif
#define REP(n) _Pragma("unroll") for (int rep_ = 0; rep_ < (((DUP_PHASES >> (n)) & 1) ? 2 : 1); ++rep_)
__global__ void __launch_bounds__(NTHR, 2) mk_fwd(Args args) {
    extern __shared__ __attribute__((aligned(16))) unsigned char lds[];
    Frame F;
    F.lds = (LAS unsigned char*)lds;
    F.tid = threadIdx.x; F.lane = F.tid & 63; F.wave = __builtin_amdgcn_readfirstlane(F.tid >> 6);
    F.G = gridDim.x; { const int bx = blockIdx.x; F.vcu = (F.G % 8 == 0) ? (bx % 8) * (F.G / 8) + bx / 8 : bx; }
    F.gw = F.vcu * NWAVES + F.wave; F.NGW = F.G * NWAVES;
    F.ws = args.ws; F.out = args.out; F.ctl = (gu32*)(args.ws + WS_CTL);
    F.A = (const __attribute__((address_space(4))) Args*)__builtin_amdgcn_kernarg_segment_ptr();
    for (int u = F.tid; u < (LDS_BYTES - LDSCTL_OFF) / 4; u += NTHR) ((LAS unsigned*)(F.lds + LDSCTL_OFF))[u] = 0u;
    __syncthreads();
    XcdBarrier bar = xcd_barrier_post((unsigned*)(args.ws + WS_CTL) + 4096, (volatile LAS unsigned*)(F.lds + MISC_OFF) + 8);
    const bool rwkv_blk = (blockIdx.x & 3) == 0;
    XcdBarrier bar2; bar2.bar = (unsigned*)(args.ws + WS_CTL) + 8192; bar2.x = 0; bar2.st = (volatile LAS unsigned*)(F.lds + MISC_OFF) + 12; bar2.nparts = gridDim.x - ((gridDim.x + 3) >> 2);
    if (!rwkv_blk) { const unsigned np_ = bar2.nparts; bar2 = xcd_barrier_post((unsigned*)(args.ws + WS_CTL) + 8192, (volatile LAS unsigned*)(F.lds + MISC_OFF) + 12); bar2.nparts = np_; }
#define SUB_BAR() do { bar2.bar = launder(bar2.bar); bar2.x = launder(bar2.x); xcd_barrier(bar2); F.ws = launder_g(F.ws); F.wsw = F.ws + (size_t)lcur * WSET_STRIDE; F.A = launder(F.A); F.tid = ltid(); F.lane = F.tid & 63; } while (0)
#define GRID_BAR() do { bar.bar = launder(bar.bar); bar.x = launder(bar.x); xcd_barrier(bar); F.ws = launder_g(F.ws); F.wsw = F.ws + (size_t)lcur * WSET_STRIDE; F.A = launder(F.A); F.tid = ltid(); F.lane = F.tid & 63; } while (0)
    const int bx = blockIdx.x; int lcur = 0; F.wsw = F.ws;
    bf16* H = (bf16*)(F.ws + WS_H); xres_t* X = (xres_t*)(F.ws + WS_X);

    REP(0) if (PH(0)) { mod_partials(F);
    convert_weights(F, 0, F.gw, F.NGW); }
    GRID_BAR();
    if (PH(1)) { mod_reduce(F); rope_table(F); }
    GRID_BAR();

#pragma unroll 1
    for (int l = 0; l < 2; ++l) {
        lcur = l; F.wsw = F.ws + (size_t)l * WSET_STRIDE;
        const bool wctx = (l == 0);
        const int MO = wctx ? M_TOT : M_LAT;
        if (PH(2) && l == 0) {
            int cs = -1;
            for (int row = F.gw; row < M_TOT; row += F.NGW) { const int s = row_s(row);
                if (s != cs) { __syncthreads(); ln_stage(F, LNV_SC, mod_ptr(F, 0, s, 1)); ln_stage(F, LNV_SH, mod_ptr(F, 0, s, 0)); __syncthreads(); cs = s; }
                const float* xs = row < M_LAT ? INP(I_X) + (size_t)row * DM : INP(I_CTX) + (size_t)(row - M_LAT) * DM;
                ln_row<0>(F, xs, nullptr, nullptr, true, H + (size_t)row * DM); }
            __syncthreads();
        }
        GRID_BAR();
        REP(3) if (PH(3)) { pg8::Gemm g{H, (const bf16*)(F.wsw + WS_WIN), M_TOT, DINP, DM, DM, DM}; pg8::StaticOrder S; S.init(M_TOT, DINP, F.G, bx);
          pg8::EpiBf16<0> E{(bf16*)(F.ws + WS_P), DINP, nullptr};
          pg8::gemm_phase<pg8::EpiBf16<0>, pg8::StaticOrder, true, true>(F.lds, g, S, E); }
        GRID_BAR();
        REP(4) if (PH(4)) for (int it = F.vcu; it < 528; it += F.G) rwkv_feat_item(F, l, it);
        REP(5) if (PH(5)) { if (F.G == 256) { if (F.vcu < 16) lru_items<false>(F, l, F.vcu, 64, 16, false);
                                              else lru_items<false>(F, l, 64 + F.vcu - 16, 2 * NCH * 8, 240, false); }
                            else for (int it = F.vcu; it < 2 * NCH * 8; it += F.G) lru_item<false>(F, l, it); }
        __syncthreads();
        if (PH(6)) for (int row = F.gw; row < M_TOT; row += F.NGW) row_prep(F, row);
        GRID_BAR();
        REP(8) if (rwkv_blk) { const int nrw = (F.G + 3) >> 2; REP(18) if (PH(8)) for (int chain = bx >> 2; chain < 64; chain += nrw) rwkv_scan(F, l, chain); }
        else REP(19) { const int x8 = bx & 7, naw = F.G - ((F.G + 3) >> 2);
            const int aw = (F.G == 256) ? ((x8 < 4 ? x8 - 1 : x8 - 2) * 32 + (bx >> 3)) : ((bx >> 2) * 3 + (bx & 3) - 1);
            if (PH(7) && aw < 8) lru_carry(F, aw);
            if (PH(7)) { pg8::Gemm g{(const bf16*)(F.ws + WS_P) + C_QA, (const bf16*)(F.wsw + WS_WQB), M_TOT, 1536, 1024, DINP, 1024}; pg8::StaticOrder S; S.init(M_TOT, 1536, naw, aw);
              pg8::EpiBf16<2> E{(bf16*)(F.ws + WS_Q), 1536, (const float*)(F.ws + WS_RSQ)};
              pg8::gemm_phase<pg8::EpiBf16<2>, pg8::StaticOrder, true, true>(F.lds, g, S, E); }
            if (PH(7)) { pg8::Gemm g{(const bf16*)(F.ws + WS_P) + C_KVA, (const bf16*)(F.wsw + WS_WKVB), M_TOT, 2048, 512, DINP, 512}; pg8::StaticOrder S; S.init(M_TOT, 2048, naw, aw);
              pg8::EpiBf16<2> E{(bf16*)(F.ws + WS_KV), 2048, (const float*)(F.ws + WS_RSKV)};
              pg8::gemm_phase<pg8::EpiBf16<2>, pg8::StaticOrder, true, true>(F.lds, g, S, E); }
            SUB_BAR();
            if (PH(9)) for (int it = aw; it < 512; it += naw) mla_item(F, it >> 8, (it >> 5) & 7, it & 31, false);
            if (PH(9) && wctx) for (int it = aw; it < 16; it += naw) mla_item(F, it >> 3, it & 7, 0, true);
            if (PH(10)) for (int it = aw; it < 512; it += naw) swa_item(F, l, it >> 8, (it >> 2) & 63, (it >> 1) & 1, it & 1, false, 0);
            if (PH(10) && wctx) for (int it = aw; it < 16; it += naw) swa_item(F, l, it >> 3, 0, 0, 0, true, it & 7);
            if (PH(11)) { if (naw == 192) { const int i0 = aw < 128 ? aw : 1280 + aw - 128, st_ = aw < 128 ? 128 : 64, i1 = aw < 128 ? 1280 : 2 * NCH * 8;
                                            lru_items<true>(F, l, i0, i1, st_, !wctx); }
                          else for (int it = aw; it < 2 * NCH * 8; it += naw) { if (!wctx && ((it >> 3) % NCH) < 8) continue; lru_item<true>(F, l, it); } }
            if (l == 0) { __syncthreads(); convert_weights(F, 1, aw * NWAVES + F.wave, naw * NWAVES); }
            const int k1 = l ? W_OUT_K1 : W_OUT_K0;
            if (k1 > 0) { SUB_BAR();
                pg8::Gemm g{(const bf16*)(F.ws + WS_MIX), (const bf16*)(F.wsw + WS_WOUT), M_LAT, DM, k1, DM, DM}; pg8::StaticOrder S; S.init(M_LAT, DM, naw, aw);
                pg8::EpiBf16<0> E{(bf16*)(F.ws + WS_Y1), DM, nullptr};
                pg8::gemm_phase<pg8::EpiBf16<0>, pg8::StaticOrder, true, true>(F.lds, g, S, E); }
        }
        GRID_BAR();
        REP(12) if (PH(12)) for (int row = F.gw; row < MO; row += F.NGW) rwkv_out_row(F, l, row);
        GRID_BAR();
        REP(13) if (PH(13)) {
          const int k1 = l ? W_OUT_K1 : W_OUT_K0;
          if (k1 == 0) { pg8::Gemm g{(const bf16*)(F.ws + WS_MIX), (const bf16*)(F.wsw + WS_WOUT), M_LAT, DM, DM, DM, DM}; pg8::StaticOrder S; S.init(M_LAT, DM, F.G, bx);
            pg8::EpiBf16<0> E{(bf16*)(F.ws + WS_Y1), DM, nullptr};
            pg8::gemm_phase<pg8::EpiBf16<0>, pg8::StaticOrder, true, true>(F.lds, g, S, E); }
          else { pg8::Gemm g{(const bf16*)(F.ws + WS_MIX) + k1, (const bf16*)(F.wsw + WS_WOUT) + k1, M_LAT, DM, DM - k1, DM, DM}; pg8::StaticOrder S; S.init(M_LAT, DM, F.G, bx);
            pg8::EpiBf16<3> E{(bf16*)(F.ws + WS_Y1), DM, nullptr};
            pg8::gemm_phase<pg8::EpiBf16<3>, pg8::StaticOrder, true, true>(F.lds, g, S, E); }
          if (wctx) {
              pg8::Gemm g2{(const bf16*)(F.ws + WS_MIX) + (size_t)M_LAT * DM, (const bf16*)(F.wsw + WS_WOUT), M_CTX, DM, DM / 8, DM, DM}; pg8::SplitOrder S2; S2.init(M_CTX, DM, DM / 8, bx);
              pg8::EpiF32 E2{(float*)(F.ws + WS_YP), DM, (size_t)M_CTX * DM};
              pg8::gemm_phase<pg8::EpiF32, pg8::SplitOrder, true, true>(F.lds, g2, S2, E2); } }
        GRID_BAR();
        if (PH(14)) { int cs = -1;
          for (int row = F.gw; row < MO; row += F.NGW) { const int s = row_s(row);
            if (s != cs) { __syncthreads(); if (cs < 0) { ln_stage(F, LNV_G, INP(I_LN1G) + l * DM); ln_stage(F, LNV_B, INP(I_LN1B) + l * DM); }
                ln_stage(F, LNV_GA, mod_ptr(F, l, s, 2)); ln_stage(F, LNV_SC, mod_ptr(F, l, s, 4)); ln_stage(F, LNV_SH, mod_ptr(F, l, s, 3)); __syncthreads(); cs = s; }
            bf16* yrow = (bf16*)(F.ws + WS_Y1) + (size_t)row * DM;
            if (row >= M_LAT) sum_partials_row(F, (const float*)(F.ws + WS_YP) + (size_t)(row - M_LAT) * DM, (size_t)M_CTX * DM, yrow);
            if (l == 0) { const float* xs = row < M_LAT ? INP(I_X) + (size_t)row * DM : INP(I_CTX) + (size_t)(row - M_LAT) * DM;
                ln_row<1, false, XH16>(F, xs, yrow, X + (size_t)row * DM, true, H + (size_t)row * DM); }
            else ln_row<1, XH16, XH16>(F, X + (size_t)row * DM, yrow, X + (size_t)row * DM, true, H + (size_t)row * DM); }
          __syncthreads(); }
        GRID_BAR();
        REP(15) if (PH(15)) { pg8::Gemm g{H, (const bf16*)(F.wsw + WS_WFF1), MO, DFF, DM, DM, DM}; pg8::StaticOrder S; S.init(MO, DFF, F.G, bx);
          pg8::EpiBf16<1> E{(bf16*)(F.ws + WS_HID), DFF, nullptr};
          pg8::gemm_phase<pg8::EpiBf16<1>, pg8::StaticOrder, true, true>(F.lds, g, S, E); }
        GRID_BAR();
        REP(16) if (PH(16)) { pg8::Gemm g{(const bf16*)(F.ws + WS_HID), (const bf16*)(F.wsw + WS_WFF2), M_LAT, DM, DFF, DFF, DFF}; pg8::StaticOrder S; S.init(M_LAT, DM, F.G, bx);
          pg8::EpiBf16<0> E{(bf16*)(F.ws + WS_Y2), DM, nullptr};
          pg8::gemm_phase<pg8::EpiBf16<0>, pg8::StaticOrder, true, true>(F.lds, g, S, E);
          if (wctx) {
              pg8::Gemm g2{(const bf16*)(F.ws + WS_HID) + (size_t)M_LAT * DFF, (const bf16*)(F.wsw + WS_WFF2), M_CTX, DM, DFF / 8, DFF, DFF}; pg8::SplitOrder S2; S2.init(M_CTX, DM, DFF / 8, bx);
              pg8::EpiF32 E2{(float*)(F.ws + WS_YP), DM, (size_t)M_CTX * DM};
              pg8::gemm_phase<pg8::EpiF32, pg8::SplitOrder, true, true>(F.lds, g2, S2, E2); } }
        GRID_BAR();
        if (!PH(17)) {} else if (l == 0) { int cs = -1;
            for (int row = F.gw; row < M_TOT; row += F.NGW) { const int s = row_s(row);
                if (s != cs) { __syncthreads(); if (cs < 0) { ln_stage(F, LNV_G, INP(I_LN2G)); ln_stage(F, LNV_B, INP(I_LN2B)); }
                    ln_stage(F, LNV_GA, mod_ptr(F, 0, s, 5)); ln_stage(F, LNV_SC, mod_ptr(F, 1, s, 1)); ln_stage(F, LNV_SH, mod_ptr(F, 1, s, 0)); __syncthreads(); cs = s; }
                bf16* yrow = (bf16*)(F.ws + WS_Y2) + (size_t)row * DM;
                if (row >= M_LAT) sum_partials_row(F, (const float*)(F.ws + WS_YP) + (size_t)(row - M_LAT) * DM, (size_t)M_CTX * DM, yrow);
                ln_row<1, XH16, XH16>(F, X + (size_t)row * DM, yrow, X + (size_t)row * DM, true, H + (size_t)row * DM); }
            __syncthreads();
        } else { int cs = -1;
            for (int row = F.gw; row < M_LAT; row += F.NGW) { const int s = row_s(row);
                if (s != cs) { __syncthreads(); if (cs < 0) { ln_stage(F, LNV_G, INP(I_LN2G) + DM); ln_stage(F, LNV_B, INP(I_LN2B) + DM); }
                    ln_stage(F, LNV_GA, mod_ptr(F, 1, s, 5)); __syncthreads(); cs = s; }
                ln_row<1, XH16, false>(F, X + (size_t)row * DM, (const bf16*)(F.ws + WS_Y2) + (size_t)row * DM, F.out + (size_t)row * DM, false, nullptr); }
        }
    }
}

extern "C" void kernel_launch(void* const* d_in, const int* in_sizes, int n_in, void* d_out, int out_size, void* d_ws, size_t ws_size, hipStream_t stream) {
    static int grid = 0;
    if (grid == 0) {
        if (n_in != 38 || out_size != M_LAT * DM || ws_size < WS_END) { fprintf(stderr, "kernel_launch: unexpected shapes: n_in %d out %d ws %zu (need %zu)\n", n_in, out_size, ws_size, (size_t)WS_END); grid = -1; return; }
        int dev = 0, cus = 0, per_cu = 0;
        if (hipGetDevice(&dev) != hipSuccess || hipDeviceGetAttribute(&cus, hipDeviceAttributeMultiprocessorCount, dev) != hipSuccess) { grid = -1; return; }
        if (hipFuncSetAttribute((const void*)mk_fwd, hipFuncAttributeMaxDynamicSharedMemorySize, LDS_BYTES) != hipSuccess) { fprintf(stderr, "kernel_launch: hipFuncSetAttribute failed\n"); grid = -1; return; }
        if (hipOccupancyMaxActiveBlocksPerMultiprocessor(&per_cu, (const void*)mk_fwd, NTHR, LDS_BYTES) != hipSuccess || per_cu < 1) fprintf(stderr, "kernel_launch: occupancy query says %d\n", per_cu);
        (void)hipGetLastError();
        grid = cus;
    }
    if (grid < 0) return;
    if (hipMemsetAsync((char*)d_ws + WS_CTL, 0, CTL_ZERO_BYTES, stream) != hipSuccess) return;
    Args a{};
    for (int i = 0; i < 38; ++i) a.in[i] = (const float*)d_in[i];
    a.out = (float*)d_out; a.ws = (unsigned char*)d_ws;
    hipLaunchKernelGGL(mk_fwd, dim3(grid), dim3(NTHR), LDS_BYTES, stream, a);
    const hipError_t le = hipPeekAtLastError();
    if (le != hipSuccess) fprintf(stderr, "kernel_launch: launch failed: %s\n", hipGetErrorName(le));
}
```

```cpp
#include <hip/hip_runtime.h>
#include <hip/hip_bf16.h>
#include <cstdio>
#include <cstdint>

namespace pg8 {
#define PG8_LAS __attribute__((address_space(3)))
typedef unsigned short bf16_t;
typedef short bf16x8 __attribute__((ext_vector_type(8)));
typedef float f32x4 __attribute__((ext_vector_type(4)));
typedef unsigned u32x4 __attribute__((ext_vector_type(4)));
constexpr int BM = 256, BK = 64, HALF = 128, HTB = HALF * BK * 2  , STAGE_BYTES = 8 * HTB, NXCD = 8, WGM = 8;

__host__ __device__ __forceinline__ int lds_byte(int r, int c) { const int st = (r >> 4) * 2 + (c >> 5), rr = r & 15, cc = c & 31, ob = rr * 64 + cc * 2; return st * 1024 + (ob ^ (((ob >> 9) & 1) << 5)); }
__host__ __device__ __forceinline__ void stage_rc(int b, int& R, int& C) { const int st = b / 1024, sb = b % 1024, swz = sb ^ (((sb >> 9) & 1) << 5); R = (st >> 1) * 16 + swz / 64; C = (st & 1) * 32 + (swz % 64) / 2; }
__host__ __device__ __forceinline__ int perm32(int rho) { const int n = rho >> 4, i = rho & 15; return 8 * (i >> 2) + 4 * n + (i & 3); }

struct Unit { int pm, pn, ko, ks; };
struct Gemm { const bf16_t* A; const bf16_t* Bt; int M, N, K, lda, ldb; };

struct StaticOrder {
    int nM, nN, nwg, G, c;
    __host__ __device__ void init(int M, int N, int G_, int c_) { nM = M / BM; nN = N / BM; nwg = nM * nN; G = G_; c = c_; }
    __host__ __device__ bool next(int i, Unit& u) const {
        const long L = (long)i * G + c; if (L >= nwg) return false;
        int wgid = (int)L; { const int q = nwg / NXCD, r = nwg % NXCD, xcd = wgid % NXCD, off = wgid / NXCD; wgid = (xcd < r ? xcd * (q + 1) : r * (q + 1) + (xcd - r) * q) + off; }
        const int nig = WGM * nN, gid = wgid / nig, fm = gid * WGM, gsz = (nM - fm) < WGM ? (nM - fm) : WGM;
        u.pm = fm + ((wgid % nig) % gsz); u.pn = (wgid % nig) / gsz; u.ko = 0; u.ks = 0; return true;
    }
    __device__ __forceinline__ void a_ready(const Unit&) const {}
    __device__ __forceinline__ void done(const Unit&) const {}
};
struct SplitOrder {
    int nN, nitems, kslice, c;
    __host__ __device__ void init(int M, int N, int Kslice, int c_) { nN = N / BM; nitems = (M / BM) * nN * 8; kslice = Kslice; c = c_; }
    __host__ __device__ bool next(int i, Unit& u) const { if (i > 0 || c >= nitems) return false; u.ks = c & 7; u.ko = u.ks * kslice; u.pn = (c >> 3) % nN; u.pm = (c >> 3) / nN; return true; }
    __device__ __forceinline__ void a_ready(const Unit&) const {}
    __device__ __forceinline__ void done(const Unit&) const {}
};

__device__ __forceinline__ unsigned cvt_pk_bf16(float lo, float hi) { unsigned r; asm volatile("v_cvt_pk_bf16_f32 %0, %1, %2" : "=v"(r) : "v"(lo), "v"(hi)); return r; }

struct EpiF32 {
    static constexpr bool PERM = false, AFTER_DRAIN = false;
    float* C; int ldc; size_t split_stride;
    __device__ __forceinline__ void operator()(const f32x4 (&acc)[2][2][4][2], const Unit& u, int wr, int wc, int fr, int fq) const {
        const int row0 = u.pm * BM + wr * 64 + fr, col0 = u.pn * BM + wc * 32 + 4 * fq; float* Cb = C + (size_t)u.ks * split_stride;
#pragma unroll
        for (int ai = 0; ai < 2; ++ai)
#pragma unroll
            for (int m = 0; m < 4; ++m) { float* rowp = Cb + (size_t)(row0 + ai * HALF + m * 16) * ldc + col0;
#pragma unroll
                for (int bj = 0; bj < 2; ++bj)
#pragma unroll
                    for (int n = 0; n < 2; ++n) *(f32x4*)(rowp + bj * HALF + n * 16) = acc[ai][bj][m][n]; }
    }
};
template <int ACT> struct EpiBf16 {
    static constexpr bool PERM = true, AFTER_DRAIN = false;
    bf16_t* O; int ldc; const float* rowscale;
    __device__ __forceinline__ void operator()(const f32x4 (&acc)[2][2][4][2], const Unit& u, int wr, int wc, int fr, int fq) const {
        const int row0 = u.pm * BM + wr * 64 + fr; const int col0 = u.pn * BM + wc * 32 + 8 * fq;
#pragma unroll
        for (int ai = 0; ai < 2; ++ai)
#pragma unroll
            for (int m = 0; m < 4; ++m) { const int row = row0 + ai * HALF + m * 16; bf16_t* rowp = O + (size_t)row * ldc + col0;
                float rs = 1.f; if (ACT == 2) rs = rowscale[row];
#pragma unroll
                for (int bj = 0; bj < 2; ++bj) { f32x4 v0 = acc[ai][bj][m][0], v1 = acc[ai][bj][m][1];
                    if (ACT == 1) {
#pragma unroll
                        for (int j = 0; j < 4; ++j) { const float a = fmaxf(v0[j], 0.f), b = fmaxf(v1[j], 0.f); v0[j] = a * a; v1[j] = b * b; } }
                    if (ACT == 2) { v0 = v0 * rs; v1 = v1 * rs; }
                    if (ACT == 3) { const u32x4 o = *(const u32x4*)(rowp + bj * HALF);
                        v0[0] += __builtin_bit_cast(float, o.x << 16); v0[1] += __builtin_bit_cast(float, o.x & 0xffff0000u); v0[2] += __builtin_bit_cast(float, o.y << 16); v0[3] += __builtin_bit_cast(float, o.y & 0xffff0000u);
                        v1[0] += __builtin_bit_cast(float, o.z << 16); v1[1] += __builtin_bit_cast(float, o.z & 0xffff0000u); v1[2] += __builtin_bit_cast(float, o.w << 16); v1[3] += __builtin_bit_cast(float, o.w & 0xffff0000u); }
                    u32x4 w; w.x = cvt_pk_bf16(v0[0], v0[1]); w.y = cvt_pk_bf16(v0[2], v0[3]); w.z = cvt_pk_bf16(v1[0], v1[1]); w.w = cvt_pk_bf16(v1[2], v1[3]);
                    *(u32x4*)(rowp + bj * HALF) = w; } }
    }
};

template <class Epi, class Sched, bool ALIGN_EPI = false, bool SP2 = false>
__device__ __forceinline__ void gemm_phase(PG8_LAS unsigned char* lds, const Gemm g, const Sched& S, const Epi& E) {
    int tid = threadIdx.x; asm volatile("" : "+v"(tid));
    const int wid = __builtin_amdgcn_readfirstlane(tid >> 6), lane = tid & 63, wr = wid >> 2, wc = wid & 3, fr = lane & 15, fq = lane >> 4;
    const int K = g.K, nt = K / BK, lda = g.lda, ldb = g.ldb;
    unsigned voffA[2], voffB[2];
#pragma unroll
    for (int i = 0; i < 2; ++i) { int R, C; stage_rc(tid * 16 + i * 8192, R, C); const int Rb = Epi::PERM ? ((R & ~31) + perm32(R & 31)) : R;
        voffA[i] = (unsigned)(R * lda + C) * 2u; voffB[i] = (unsigned)(Rb * ldb + C) * 2u; }
    const size_t kstep = (size_t)(BK * 2);
    const size_t hstepA = (size_t)HALF * lda * 2, hstepB = (size_t)HALF * ldb * 2;
    const size_t tstepA = 2 * hstepA, tstepB = 2 * hstepB;
    const unsigned ldsw = (unsigned)wid * 1024u;
    const int aoff = lds_byte(wr * 64 + fr, fq * 8), boff = lds_byte(wc * 32 + fr, fq * 8);
#define PG8_SA(b, h) (((b) * 2 + (h)) * HTB)
#define PG8_SB(b, h) ((4 + (b) * 2 + (h)) * HTB)
#define PG8_STAGE(bufoff, gbase, voff) do { _Pragma("unroll") for (int _i = 0; _i < 2; ++_i) \
        __builtin_amdgcn_global_load_lds((const unsigned*)((const char*)(gbase) + (voff)[_i]), (PG8_LAS unsigned*)(lds + (bufoff) + ldsw + _i * 8192), 16, 0, 0); } while (0)
#define PG8_LDA(dst, b, h) do { _Pragma("unroll") for (int m = 0; m < 4; ++m) _Pragma("unroll") for (int k = 0; k < 2; ++k) dst[m][k] = *(const PG8_LAS bf16x8*)(lds + PG8_SA(b, h) + aoff + m * 2048 + k * 1024); } while (0)
#define PG8_LDB(dst, b, h) do { _Pragma("unroll") for (int n = 0; n < 2; ++n) _Pragma("unroll") for (int k = 0; k < 2; ++k) dst[n][k] = *(const PG8_LAS bf16x8*)(lds + PG8_SB(b, h) + boff + n * 2048 + k * 1024); } while (0)
#define PG8_MMA(ai, bj, At, Bt) do { __builtin_amdgcn_s_setprio(1); _Pragma("unroll") for (int m = 0; m < 4; ++m) _Pragma("unroll") for (int n = 0; n < 2; ++n) _Pragma("unroll") for (int k = 0; k < 2; ++k) \
        acc[ai][bj][m][n] = __builtin_amdgcn_mfma_f32_16x16x32_bf16(Bt[n][k], At[m][k], acc[ai][bj][m][n], 0, 0, 0); __builtin_amdgcn_s_setprio(0); } while (0)
#define PG8_WAIT_V(n) asm volatile("s_waitcnt vmcnt(" #n ")" ::: "memory")
#define PG8_WAIT_L(n) asm volatile("s_waitcnt lgkmcnt(" #n ")" ::: "memory")
#define PG8_BAR __builtin_amdgcn_s_barrier()
#define PG8_SCHED __builtin_amdgcn_sched_barrier(0)
    Unit cur, nxt; int ui = 0;
    if (!S.next(0, cur)) return;
    f32x4 acc[2][2][4][2];
#pragma unroll
    for (int a = 0; a < 2; ++a)
#pragma unroll
        for (int b = 0; b < 2; ++b)
#pragma unroll
            for (int m = 0; m < 4; ++m)
#pragma unroll
                for (int n = 0; n < 2; ++n) acc[a][b][m][n] = (f32x4){0.f, 0.f, 0.f, 0.f};
    bf16x8 At[4][2], B0[2][2], B1[2][2];
    const char* cA = (const char*)g.A + (size_t)cur.pm * tstepA + (size_t)cur.ko * 2; const char* cB = (const char*)g.Bt + (size_t)cur.pn * tstepB + (size_t)cur.ko * 2;
    S.a_ready(cur);
    if constexpr (SP2) {
        PG8_STAGE(PG8_SB(0, 0), cB, voffB); PG8_STAGE(PG8_SB(0, 1), cB + hstepB, voffB); PG8_STAGE(PG8_SA(0, 0), cA, voffA); PG8_STAGE(PG8_SA(0, 1), cA + hstepA, voffA);
        if (wr == 1) PG8_BAR;
        PG8_WAIT_V(2); PG8_BAR;
        PG8_STAGE(PG8_SB(1, 0), cB + kstep, voffB); PG8_STAGE(PG8_SA(1, 0), cA + kstep, voffA); PG8_STAGE(PG8_SB(1, 1), cB + hstepB + kstep, voffB);
        PG8_WAIT_V(6); PG8_BAR;
    } else {
        PG8_STAGE(PG8_SB(0, 0), cB, voffB); PG8_STAGE(PG8_SA(0, 0), cA, voffA); PG8_STAGE(PG8_SB(0, 1), cB + hstepB, voffB); PG8_STAGE(PG8_SA(0, 1), cA + hstepA, voffA);
        if (wr == 1) PG8_BAR;
        PG8_WAIT_V(4); PG8_BAR;
        PG8_STAGE(PG8_SB(1, 0), cB + kstep, voffB); PG8_STAGE(PG8_SA(1, 0), cA + kstep, voffA); PG8_STAGE(PG8_SB(1, 1), cB + hstepB + kstep, voffB);
        PG8_WAIT_V(6); PG8_BAR;
    }
    for (;;) {
        const bool has_next = S.next(ui + 1, nxt);
        const char* nA = has_next ? (const char*)g.A + (size_t)nxt.pm * tstepA + (size_t)nxt.ko * 2 : cA; const char* nB = has_next ? (const char*)g.Bt + (size_t)nxt.pn * tstepB + (size_t)nxt.ko * 2 : cB;
        for (int t = 0; t < nt; t += 2) {
            const bool last = (t == nt - 2);
            const char* a1 = cA + (size_t)(t + 1) * kstep;
            const char* a2 = last ? nA : cA + (size_t)(t + 2) * kstep; const char* b2 = last ? nB : cB + (size_t)(t + 2) * kstep;
            const char* a3 = a2 + kstep; const char* b3 = b2 + kstep;
            if (last && has_next) S.a_ready(nxt);
            if constexpr (SP2) {
            PG8_LDB(B0, 0, 0); PG8_LDB(B1, 0, 1); PG8_SCHED; PG8_LDA(At, 0, 0); PG8_STAGE(PG8_SA(1, 1), a1 + hstepA, voffA);
            PG8_WAIT_V(8); PG8_WAIT_L(0); PG8_BAR; PG8_MMA(0, 0, At, B0); PG8_MMA(0, 1, At, B1); PG8_BAR; PG8_SCHED;
            PG8_LDA(At, 0, 1); PG8_STAGE(PG8_SB(0, 0), b2, voffB); PG8_STAGE(PG8_SB(0, 1), b2 + hstepB, voffB); PG8_STAGE(PG8_SA(0, 0), a2, voffA);
            PG8_WAIT_V(8); PG8_WAIT_L(0); PG8_BAR; PG8_MMA(1, 0, At, B0); PG8_MMA(1, 1, At, B1); PG8_BAR; PG8_SCHED;
            PG8_LDB(B0, 1, 0); PG8_LDB(B1, 1, 1); PG8_SCHED; PG8_LDA(At, 1, 0); PG8_STAGE(PG8_SA(0, 1), a2 + hstepA, voffA);
            PG8_WAIT_V(8); PG8_WAIT_L(0); PG8_BAR; PG8_MMA(0, 0, At, B0); PG8_MMA(0, 1, At, B1); PG8_BAR; PG8_SCHED;
            PG8_LDA(At, 1, 1); PG8_STAGE(PG8_SB(1, 0), b3, voffB); PG8_STAGE(PG8_SB(1, 1), b3 + hstepB, voffB); PG8_STAGE(PG8_SA(1, 0), a3, voffA);
            PG8_WAIT_V(8); PG8_WAIT_L(0); PG8_BAR; PG8_MMA(1, 0, At, B0); PG8_MMA(1, 1, At, B1); PG8_BAR; PG8_SCHED;
            } else {
            PG8_LDB(B0, 0, 0); PG8_SCHED; PG8_LDA(At, 0, 0); PG8_STAGE(PG8_SA(1, 1), a1 + hstepA, voffA);
            PG8_WAIT_L(8); PG8_BAR; PG8_WAIT_L(0); PG8_MMA(0, 0, At, B0); PG8_BAR; PG8_SCHED;
            PG8_LDB(B1, 0, 1); PG8_STAGE(PG8_SB(0, 0), b2, voffB);
            PG8_BAR; PG8_WAIT_L(0); PG8_MMA(0, 1, At, B1); PG8_BAR;
            PG8_LDA(At, 0, 1); PG8_STAGE(PG8_SA(0, 0), a2, voffA);
            PG8_BAR; PG8_WAIT_L(0); PG8_MMA(1, 0, At, B0); PG8_BAR; PG8_SCHED;
            PG8_STAGE(PG8_SB(0, 1), b2 + hstepB, voffB);
            PG8_WAIT_V(6); PG8_BAR; PG8_MMA(1, 1, At, B1); PG8_BAR;
            PG8_LDB(B0, 1, 0); PG8_SCHED; PG8_LDA(At, 1, 0); PG8_STAGE(PG8_SA(0, 1), a2 + hstepA, voffA);
            PG8_WAIT_L(8); PG8_BAR; PG8_WAIT_L(0); PG8_MMA(0, 0, At, B0); PG8_BAR; PG8_SCHED;
            PG8_LDB(B1, 1, 1); PG8_STAGE(PG8_SB(1, 0), b3, voffB);
            PG8_BAR; PG8_WAIT_L(0); PG8_MMA(0, 1, At, B1); PG8_BAR;
            PG8_LDA(At, 1, 1); PG8_STAGE(PG8_SA(1, 0), a3, voffA);
            PG8_BAR; PG8_WAIT_L(0); PG8_MMA(1, 0, At, B0); PG8_BAR; PG8_SCHED;
            PG8_STAGE(PG8_SB(1, 1), b3 + hstepB, voffB);
            PG8_WAIT_V(6); PG8_BAR; PG8_MMA(1, 1, At, B1); PG8_BAR;
            }
        }
        if constexpr (ALIGN_EPI) { if (wr == 0) PG8_BAR; }
        E(acc, cur, wr, wc, fr, fq); S.done(cur);
        if (!has_next) break;
#pragma unroll
        for (int a = 0; a < 2; ++a)
#pragma unroll
            for (int b = 0; b < 2; ++b)
#pragma unroll
                for (int m = 0; m < 4; ++m)
#pragma unroll
                    for (int n = 0; n < 2; ++n) acc[a][b][m][n] = (f32x4){0.f, 0.f, 0.f, 0.f};
        cur = nxt; cA = nA; cB = nB; ++ui;
        if constexpr (ALIGN_EPI) { if (wr == 1) PG8_BAR; }
    }
    PG8_WAIT_V(0);
    if constexpr (!ALIGN_EPI) { if (wr == 0) PG8_BAR; }
    PG8_BAR;
#undef PG8_SA
#undef PG8_SB
#undef PG8_STAGE
#undef PG8_LDA
#undef PG8_LDB
#undef PG8_MMA
#undef PG8_WAIT_V
#undef PG8_WAIT_L
#undef PG8_BAR
#undef PG8_SCHED
}
}

constexpr int NWAVES = 8, NTHR = 512;
constexpr int DM = 4096, NB = 2, SEQ = 8192, NCTX = 256, DFF = 16384;
constexpr int M_LAT = NB * SEQ, M_CTX = NB * NCTX, M_TOT = M_LAT + M_CTX;
constexpr int DIN = 8672, DINP = 8704;
constexpr int C_SWAQ = 0, C_SWAK = 1024, C_SWAV = 1280, C_LRUX = 1536, C_LRUY = 2560, C_QA = 3584, C_KVA = 4608, C_KR = 5120, C_RW = 5184;
constexpr int C_RWR = C_RW, C_RWK = C_RW + 1024, C_RWV = C_RW + 2048, C_RWL = C_RW + 3072;
constexpr int RWC = 3488;
constexpr float LN_EPS = 1e-5f, RMS_EPS = 1e-6f, GN_EPS = 64e-5f, ALPHA = 1.41421356237f;
constexpr int NCH = 264;

constexpr size_t MiB = 1u << 20;
constexpr size_t WS_CTL = 0, CTL_ZERO_BYTES = 1 * MiB;
constexpr size_t WS_MOD = 1 * MiB;
constexpr size_t WS_MODP = 2 * MiB;
constexpr size_t WS_SMALL = 20 * MiB;
constexpr size_t WS_RSQ = WS_SMALL;
constexpr size_t WS_RSKV = WS_RSQ + 128 * 1024;
constexpr size_t WS_SB = WS_RSKV + 128 * 1024;
constexpr size_t WS_CA = WS_SB + 2 * MiB;
constexpr size_t WS_CB = WS_CA + 5 * MiB;
constexpr size_t WS_HIN = WS_CB + 5 * MiB;
constexpr size_t WS_QUIRK = WS_HIN + 5 * MiB;
constexpr size_t WS_ROPE = WS_QUIRK + 8192;
static_assert(WS_ROPE + 16384 <= 40 * MiB, "small region");
constexpr size_t WS_W = 40 * MiB;
constexpr size_t WS_WIN = WS_W, WS_WOUT = WS_WIN + 68 * MiB, WS_WFF1 = WS_WOUT + 32 * MiB, WS_WFF2 = WS_WFF1 + 128 * MiB, WS_WQB = WS_WFF2 + 128 * MiB,
                 WS_WKVB = WS_WQB + 3 * MiB, WS_WLRU = WS_WKVB + 2 * MiB, WS_WLORA = WS_WLRU + 1 * MiB;
constexpr size_t WS_W2T = WS_WLORA, WS_A2T = WS_W2T + 256 * 1024, WS_G2T = WS_A2T + 256 * 1024;
constexpr size_t WS_X = 403 * MiB;
constexpr size_t WS_H = 667 * MiB;
constexpr size_t WS_MIX = 799 * MiB;
constexpr size_t WS_YS = 931 * MiB;
constexpr size_t WS_P = 1063 * MiB;
constexpr size_t WS_RWF = 1344 * MiB;
constexpr size_t RWF_STRIDE = (size_t)M_TOT * 1024 * 2;
constexpr size_t WS_Q = 1641 * MiB;
constexpr size_t WS_KV = 1691 * MiB;
constexpr size_t WS_KR = 1757 * MiB;
constexpr size_t WS_SET2 = 1760 * MiB;
constexpr size_t WSET_STRIDE = WS_SET2 - WS_W;
constexpr size_t WS_END = WS_SET2 + 363 * MiB;
constexpr size_t WS_YP = WS_Q;
constexpr size_t WS_HID = WS_P;
constexpr size_t WS_Y1 = WS_P;
constexpr size_t WS_Y2 = WS_MIX;
static_assert(WS_WLORA + 1 * MiB <= WS_X && WS_P + (size_t)M_TOT * DINP * 2 <= WS_RWF && WS_RWF + 9 * RWF_STRIDE <= WS_Q, "ws map");
static_assert(WS_HID + (size_t)M_TOT * DFF * 2 <= WS_Q && WS_Y2 + (size_t)M_TOT * DM * 4 <= WS_P && WS_YS + 2 * (size_t)M_TOT * 1024 * 4 <= WS_P, "ws overlays");
static_assert(WS_KR + (size_t)M_TOT * 64 * 2 <= WS_SET2 && WS_YP + 8 * (size_t)M_CTX * DM * 4 <= WS_KR, "ws end");

constexpr int RING_BYTES = 131072;
constexpr int LDSCTL_OFF = RING_BYTES, MISC_OFF = LDSCTL_OFF + 320;
constexpr int LDS_BYTES = 147456;

#define GAS __attribute__((address_space(1)))
#define LAS __attribute__((address_space(3)))
typedef unsigned short bf16;
typedef unsigned v4u __attribute__((ext_vector_type(4)));
typedef unsigned v2u __attribute__((ext_vector_type(2)));
typedef float f32x4 __attribute__((ext_vector_type(4)));
typedef _Float16 h16x4 __attribute__((ext_vector_type(4)));
typedef _Float16 h16x8 __attribute__((ext_vector_type(8)));
#ifndef XH16_
#define XH16_ 1
#endif
constexpr bool XH16 = XH16_;
#if XH16_
typedef _Float16 xres_t;
#else
typedef float xres_t;
#endif
typedef float f32x2 __attribute__((ext_vector_type(2)));
typedef float f32x16 __attribute__((ext_vector_type(16)));
typedef short bf16x8 __attribute__((ext_vector_type(8)));
typedef short s16x4 __attribute__((ext_vector_type(4)));
typedef GAS unsigned gu32;
typedef const GAS bf16* gcbf; typedef GAS bf16* gbfp; typedef const GAS float* gcfl; typedef GAS float* gflp;
#define LDS_WAIT() asm volatile("s_waitcnt lgkmcnt(0)" ::: "memory")
#define VM_WAIT() asm volatile("s_waitcnt vmcnt(0)" ::: "memory")
typedef __bf16 bf16x2_t __attribute__((ext_vector_type(2)));
__device__ __forceinline__ unsigned pk2(float lo, float hi) { const f32x2 v = {lo, hi}; const bf16x2_t b = __builtin_convertvector(v, bf16x2_t); return __builtin_bit_cast(unsigned, b); }
__device__ __forceinline__ unsigned f2bf(float f) { return pk2(f, f) & 0xffffu; }
__device__ __forceinline__ float bflo(unsigned w) { return __builtin_bit_cast(float, w << 16); }
__device__ __forceinline__ float bfhi(unsigned w) { return __builtin_bit_cast(float, w & 0xffff0000u); }
__device__ __forceinline__ float bf2f(bf16 h) { return __builtin_bit_cast(float, (unsigned)h << 16); }
#define DPP_ADD(x, ctrl) ((x) + __builtin_bit_cast(float, __builtin_amdgcn_update_dpp(0, __builtin_bit_cast(int, (x)), (ctrl), 0xf, 0xf, false)))
__device__ __forceinline__ float row_sum16(float x) { x = DPP_ADD(x, 0x128); x = DPP_ADD(x, 0x124); x = DPP_ADD(x, 0x122); x = DPP_ADD(x, 0x121); return x; }
#ifdef OLD_SUMS
__device__ __forceinline__ float wave_sum(float v) {
#pragma unroll
    for (int o = 1; o < 64; o <<= 1) v += __shfl_xor(v, o);
    return v;
}
__device__ __forceinline__ float half_swap_sum(float x) { return x + __shfl_xor(x, 32); }
__device__ __forceinline__ float quad_sum(float x) { x += __shfl_xor(x, 1); x += __shfl_xor(x, 2); return x; }
#else
__device__ __forceinline__ float wave_sum(float v) {
    const float r = row_sum16(v);
    const float a = __builtin_bit_cast(float, __builtin_amdgcn_readlane(__builtin_bit_cast(int, r), 0)), b = __builtin_bit_cast(float, __builtin_amdgcn_readlane(__builtin_bit_cast(int, r), 16));
    const float c = __builtin_bit_cast(float, __builtin_amdgcn_readlane(__builtin_bit_cast(int, r), 32)), d = __builtin_bit_cast(float, __builtin_amdgcn_readlane(__builtin_bit_cast(int, r), 48));
    return (a + b) + (c + d);
}
__device__ __forceinline__ float half_swap_sum(float x) {
    unsigned a = __builtin_bit_cast(unsigned, x), b = a; asm volatile("" : "+v"(b));
    auto rr = __builtin_amdgcn_permlane32_swap(a, b, false, false);
    const float lo = __uint_as_float(rr[0]), hi = __uint_as_float(rr[1]); return lo + hi;
}
__device__ __forceinline__ float quad_sum(float x) { x = DPP_ADD(x, 0xB1); x = DPP_ADD(x, 0x4E); return x; }
#endif
__device__ __forceinline__ float sigmoidf_(float x) { return __builtin_amdgcn_rcpf(1.f + __expf(-x)); }
__device__ __forceinline__ float softplusf_(float x) { return x > 20.f ? x : __logf(1.f + __expf(x)); }
__device__ __forceinline__ float tanhf_(float x) { const float e = __expf(2.f * x); return 1.f - 2.f * __builtin_amdgcn_rcpf(e + 1.f); }
__device__ __forceinline__ int ltid() { int t = threadIdx.x; asm volatile("" : "+v"(t)); return t; }
template <class T> __device__ __forceinline__ T ldg(const void* base, unsigned byteoff) { return *(const T*)((const char*)base + byteoff); }
template <class T> __device__ __forceinline__ void stg(void* base, unsigned byteoff, T v) { *(T*)((char*)base + byteoff) = v; }

#define XB_TMO      128
#define XB_XCNT(j)  (256  + 64 * (j))
#define XB_XSUB(j)  (1280 + 64 * (j))
#define XB_XGEN(j)  (2304 + 64 * (j))
#define XB_TOP      3328
#define XB_TOPGEN   3392
#define XCD_BAR_WORDS 3456
#define XB_SPIN_CAP (1u << 18)

__device__ __forceinline__ unsigned xb_ld(unsigned* p)              { return __hip_atomic_load(p, __ATOMIC_RELAXED, __HIP_MEMORY_SCOPE_AGENT); }
__device__ __forceinline__ unsigned xb_add(unsigned* p, unsigned v) { return __hip_atomic_fetch_add(p, v, __ATOMIC_RELAXED, __HIP_MEMORY_SCOPE_AGENT); }
__device__ __forceinline__ unsigned xb_xcc_id() { return (unsigned)__builtin_amdgcn_s_getreg((3 << 11) | 20) & 0xFu; }
#define XB_SPIN(cond, bar) do { unsigned _sp = 0; while (cond) { __builtin_amdgcn_s_sleep(1); \
    if ((++_sp & 255u) == 0u) { if (xb_ld(&(bar)[XB_TMO])) break; if (_sp > XB_SPIN_CAP) { atomicAdd(&(bar)[XB_TMO], 1u); break; } } } } while (0)

struct XcdBarrier {
    unsigned* bar; unsigned x;
    unsigned nparts;
    volatile LAS unsigned* st;
};

__device__ __forceinline__ XcdBarrier xcd_barrier_post(unsigned* bar, volatile LAS unsigned* st) {
    XcdBarrier b; b.bar = bar; b.x = xb_xcc_id(); b.st = st; b.nparts = 0u;
    if (threadIdx.x == 0) (void)xb_add(&bar[XB_XCNT(b.x)], 1u);
    return b;
}
__device__ __forceinline__ void xcd_barrier_complete(unsigned* bar, unsigned x, unsigned& nloc, unsigned& nx, unsigned nparts) {
    const unsigned G = nparts ? nparts : gridDim.x * gridDim.y * gridDim.z;
    unsigned sum, cnt, mine, sp = 0u;
    for (;;) {
        sum = 0u; cnt = 0u; mine = 0u;
#pragma unroll
        for (unsigned j = 0; j < 16; ++j) { const unsigned c = xb_ld(&bar[XB_XCNT(j)]); sum += c; cnt += (c > 0u) ? 1u : 0u; mine = (j == x) ? c : mine; }
        if (sum == G) break;
        __builtin_amdgcn_s_sleep(1);
        if ((++sp & 255u) == 0u) { if (xb_ld(&bar[XB_TMO])) break; if (sp > XB_SPIN_CAP) { atomicAdd(&bar[XB_TMO], 1u); break; } }
    }
    nloc = mine > 0u ? mine : 1u; nx = cnt > 0u ? cnt : 1u;
}

__device__ __forceinline__ void xcd_barrier(const XcdBarrier& b) {
    asm volatile("s_waitcnt vmcnt(0)" ::: "memory");
    __syncthreads();
    if (threadIdx.x == 0) {
        unsigned* bar = b.bar;
        __builtin_amdgcn_s_waitcnt(0);
        unsigned nloc = b.st[0], nx = b.st[1];
        if (nloc == 0u) { xcd_barrier_complete(bar, b.x, nloc, nx, b.nparts); b.st[0] = nloc; b.st[1] = nx; }
        const unsigned old = xb_add(&bar[XB_XSUB(b.x)], 1u);
        const unsigned gen = old / nloc;
        if (old + 1u == (gen + 1u) * nloc) {
            __builtin_amdgcn_fence(__ATOMIC_RELEASE, "agent");
            asm volatile("s_waitcnt vmcnt(0)" ::: "memory");
            const unsigned og = xb_add(&bar[XB_TOP], 1u);
            const unsigned tg = og / nx;
            if (og + 1u == (tg + 1u) * nx) xb_add(&bar[XB_TOPGEN], 1u);
            else XB_SPIN(xb_ld(&bar[XB_TOPGEN]) == tg, bar);
            __builtin_amdgcn_fence(__ATOMIC_ACQUIRE, "agent");
            xb_add(&bar[XB_XGEN(b.x)], 1u);
            asm volatile("s_waitcnt vmcnt(0)" ::: "memory");
        } else {
            XB_SPIN(xb_ld(&bar[XB_XGEN(b.x)]) == gen, bar);
            __builtin_amdgcn_fence(__ATOMIC_ACQUIRE, "agent");
            asm volatile("s_waitcnt vmcnt(0)" ::: "memory");
        }
    }
    __syncthreads();
}


namespace att {
constexpr int KVBLK = 64;
constexpr float THR = 8.f;
#define SBAR() __builtin_amdgcn_sched_barrier(0)
__device__ __forceinline__ int crow(int r, int hi) { return (r & 3) + 8 * (r >> 2) + 4 * hi; }
__device__ __forceinline__ unsigned cvtpk(float lo, float hi) { return pk2(lo, hi); }
template <int DQK> __device__ __forceinline__ int kswz(int row, int cb) { return row * (DQK * 2 + 16) + cb; }

template <int DQK> __device__ __forceinline__ void partialSM(f32x16& p0, f32x16& p1, float& m_reg, float& mn, float& alpha) {
  constexpr float SCALE = DQK == 128 ? 0.088388347648318440f : 0.072168783648703220f;
  constexpr float C = SCALE * 1.4426950408889634f;
  float pmax = p0[0];
#pragma unroll
  for (int r = 1; r < 16; ++r) pmax = fmaxf(pmax, p0[r]);
#pragma unroll
  for (int r = 0; r < 16; ++r) pmax = fmaxf(pmax, p1[r]);
  { auto rr = __builtin_amdgcn_permlane32_swap(__float_as_uint(pmax), __float_as_uint(pmax), false, false);
    pmax = fmaxf(__uint_as_float(rr[0]), __uint_as_float(rr[1])); }
  if (__builtin_expect(__all(pmax - m_reg <= THR / SCALE), 1)) { mn = m_reg; alpha = 1.f; }
  else { mn = fmaxf(m_reg, pmax); alpha = __builtin_amdgcn_exp2f((m_reg - mn) * C); m_reg = mn; }
  const float mnC = -mn * C;
#pragma unroll
  for (int r = 0; r < 16; ++r) p0[r] = fmaf(p0[r], C, mnC);
#pragma unroll
  for (int r = 0; r < 16; ++r) p1[r] = fmaf(p1[r], C, mnC);
#pragma unroll
  for (int r = 0; r < 16; ++r) p0[r] = __builtin_amdgcn_exp2f(p0[r]);
}
__device__ __forceinline__ void finishSM(f32x16& p0, f32x16& p1, float alpha, float& l_reg, bf16x8& pa0, bf16x8& pa1, bf16x8& pa2, bf16x8& pa3) {
#pragma unroll
  for (int r = 0; r < 16; ++r) p1[r] = __builtin_amdgcn_exp2f(p1[r]);
  float ps = 0;
#pragma unroll
  for (int r = 0; r < 16; ++r) ps += p0[r];
#pragma unroll
  for (int r = 0; r < 16; ++r) ps += p1[r];
  { auto rr = __builtin_amdgcn_permlane32_swap(__float_as_uint(ps), __float_as_uint(ps), false, false);
    ps = __uint_as_float(rr[0]) + __uint_as_float(rr[1]); }
  l_reg = l_reg * alpha + ps;
#define PK4(P, BASE, OUT) do { unsigned a0 = cvtpk(P[BASE + 0], P[BASE + 1]), a1 = cvtpk(P[BASE + 2], P[BASE + 3]);   \
    unsigned b0 = cvtpk(P[BASE + 4], P[BASE + 5]), b1 = cvtpk(P[BASE + 6], P[BASE + 7]);                              \
    auto r0 = __builtin_amdgcn_permlane32_swap(a0, b0, false, false); auto r1 = __builtin_amdgcn_permlane32_swap(a1, b1, false, false); \
    v4u w = {r0[0], r1[0], r0[1], r1[1]}; OUT = __builtin_bit_cast(bf16x8, w); } while (0)
  PK4(p0, 0, pa0); PK4(p0, 8, pa1); PK4(p1, 0, pa2); PK4(p1, 8, pa3);
#undef PK4
}
template <int DQK> __device__ __forceinline__ void qkt(f32x16& p0, f32x16& p1, const LAS char* Ks, const bf16x8* qr, const LAS char* qx, int r32, int hi) {
  p0 = f32x16{}; p1 = f32x16{};
#pragma unroll
  for (int d0 = 0; d0 < DQK / 16; ++d0) { const int cb = (d0 * 16 + hi * 8) * 2;
    bf16x8 b0 = *(const LAS bf16x8*)(Ks + kswz<DQK>(r32, cb));
    bf16x8 b1 = *(const LAS bf16x8*)(Ks + kswz<DQK>(32 + r32, cb));
    bf16x8 q; if (d0 < 8) q = qr[d0]; else q = *(const LAS bf16x8*)(qx + (d0 - 8) * 32);
    p0 = __builtin_amdgcn_mfma_f32_32x32x16_bf16(b0, q, p0, 0, 0, 0);
    p1 = __builtin_amdgcn_mfma_f32_32x32x16_bf16(b1, q, p1, 0, 0, 0);
    if ((d0 & 3) == 3 && d0 + 1 < DQK / 16) SBAR(); }
}
__device__ __forceinline__ int v_st(int k, int c) { const int kk = (k & ~0xC) | ((k & 4) << 1) | ((k & 8) >> 1); return ((kk >> 3) * 4 + (c >> 5)) * 512 + ((kk & 7) * 32 + (c & 31)) * 2; }
__device__ __forceinline__ int v_rd_base(int lane) { return ((lane & 3) << 3) | (((lane >> 2) & 3) << 6) | (((lane >> 4) & 1) << 5) | (((lane >> 5) & 1) << 8); }
constexpr int v_rd_off(int d0, int ks, int half) { return d0 * 512 + ks * 4096 + half * 2048; }
template <int OFF> __device__ __forceinline__ s16x4 tr_read(int vb) {
  s16x4 r; asm volatile("ds_read_b64_tr_b16 %0, %1 offset:%2" : "=&v"(r) : "v"(vb), "i"(OFF) : "memory"); return r;
}
template <int D0> __device__ __forceinline__ void pv_one(f32x16& od, int vb, bf16x8 pa0, bf16x8 pa1, bf16x8 pa2, bf16x8 pa3) {
  const s16x4 l0 = tr_read<v_rd_off(D0, 0, 0)>(vb), h0 = tr_read<v_rd_off(D0, 0, 1)>(vb), l1 = tr_read<v_rd_off(D0, 1, 0)>(vb), h1 = tr_read<v_rd_off(D0, 1, 1)>(vb);
  const s16x4 l2 = tr_read<v_rd_off(D0, 2, 0)>(vb), h2 = tr_read<v_rd_off(D0, 2, 1)>(vb), l3 = tr_read<v_rd_off(D0, 3, 0)>(vb), h3 = tr_read<v_rd_off(D0, 3, 1)>(vb);
  asm volatile("s_waitcnt lgkmcnt(0)" ::: "memory"); SBAR();
#define PK(L, H) (bf16x8){L[0], L[1], L[2], L[3], H[0], H[1], H[2], H[3]}
  od = __builtin_amdgcn_mfma_f32_32x32x16_bf16(pa0, PK(l0, h0), od, 0, 0, 0);
  od = __builtin_amdgcn_mfma_f32_32x32x16_bf16(pa1, PK(l1, h1), od, 0, 0, 0);
  od = __builtin_amdgcn_mfma_f32_32x32x16_bf16(pa2, PK(l2, h2), od, 0, 0, 0);
  od = __builtin_amdgcn_mfma_f32_32x32x16_bf16(pa3, PK(l3, h3), od, 0, 0, 0);
#undef PK
}
__device__ __forceinline__ void pv_d0(f32x16* o, int vb, bf16x8 pa0, bf16x8 pa1, bf16x8 pa2, bf16x8 pa3) {
  pv_one<0>(o[0], vb, pa0, pa1, pa2, pa3); pv_one<1>(o[1], vb, pa0, pa1, pa2, pa3); pv_one<2>(o[2], vb, pa0, pa1, pa2, pa3); pv_one<3>(o[3], vb, pa0, pa1, pa2, pa3);
}
__device__ __forceinline__ void apply_mask(f32x16& p0, f32x16& p1, int mtype, int krel0, int qi, int hi) {
  if (mtype == 0) return;
  const float ninf = -__builtin_inff();
#pragma unroll
  for (int r = 0; r < 16; ++r) { const int k0 = krel0 + crow(r, hi), k1 = k0 + 32;
    const bool ok0 = (mtype == 1) ? (k0 >= qi - 128) : (k0 <= qi + 128), ok1 = (mtype == 1) ? (k1 >= qi - 128) : (k1 <= qi + 128);
    p0[r] = ok0 ? p0[r] : ninf; p1[r] = ok1 ? p1[r] : ninf; }
}
struct Tile { gcbf kn; gcbf kr; gcbf v; int mtype; int krel0; };

__device__ __forceinline__ void rope_pair(bf16x8& a, bf16x8& b, gcfl ct, gcfl st) {
  const f32x4 c0 = *(const GAS f32x4*)ct, c1 = *(const GAS f32x4*)(ct + 4), s0 = *(const GAS f32x4*)st, s1 = *(const GAS f32x4*)(st + 4);
  const float cs[8] = {c0[0], c0[1], c0[2], c0[3], c1[0], c1[1], c1[2], c1[3]}, sn[8] = {s0[0], s0[1], s0[2], s0[3], s1[0], s1[1], s1[2], s1[3]};
  v4u ua = __builtin_bit_cast(v4u, a), ub = __builtin_bit_cast(v4u, b); v4u oa, ob;
#pragma unroll
  for (int w = 0; w < 4; ++w) { const float x1[2] = {bflo(ua[w]), bfhi(ua[w])}, x2[2] = {bflo(ub[w]), bfhi(ub[w])}; float y1[2], y2[2];
#pragma unroll
    for (int e = 0; e < 2; ++e) { const float c = cs[2 * w + e], sv = sn[2 * w + e]; y1[e] = x1[e] * c - x2[e] * sv; y2[e] = x2[e] * c + x1[e] * sv; }
    oa[w] = pk2(y1[0], y1[1]); ob[w] = pk2(y2[0], y2[1]); }
  a = __builtin_bit_cast(bf16x8, oa); b = __builtin_bit_cast(bf16x8, ob);
}

template <int DQK, int LDKN, int LDV, bool MASK, bool SINK, int SDEPTH, class TS>
__device__ __forceinline__ void attn_body(gcbf Qw, int rope, int prow, int pcol, gcfl rtab, int qi, float sink_l2, const TS& ts, int NT, gbfp Ow, LAS char* lds) {
  constexpr float SCALE = DQK == 128 ? 0.088388347648318440f : 0.072168783648703220f;
  constexpr float C = SCALE * 1.4426950408889634f;
  constexpr int SHM_K = KVBLK * (DQK * 2 + 16), SHM_V = KVBLK * 128 * 2;
  int tid = threadIdx.x; asm volatile("" : "+v"(tid));
  const int wid = tid >> 6, lane = tid & 63, r32 = lane & 31, hi = lane >> 5;
  LAS char* V_lds = lds; LAS char* K_lds = lds + 2 * SHM_V;
  LAS float* wsl = (LAS float*)(lds + 2 * SHM_V + 2 * SHM_K) + wid * 64; LAS float* li_l = wsl; LAS float* al_l = wsl + 32;
  float m_reg = -1e30f, l_reg = 0; f32x16 o[4] = {}; bf16x8 qr[8];
#pragma unroll
  for (int d0 = 0; d0 < 8; ++d0) qr[d0] = *(const GAS bf16x8*)(Qw + d0 * 16 + hi * 8);
  const LAS char* qx = lds + 2 * SHM_V + 2 * SHM_K + 2048 + wid * 4608 + r32 * 144 + hi * 16;
  if constexpr (DQK == 192) {
    bf16x8 x0 = *(const GAS bf16x8*)(Qw + 128 + hi * 8), x1 = *(const GAS bf16x8*)(Qw + 144 + hi * 8), x2 = *(const GAS bf16x8*)(Qw + 160 + hi * 8), x3 = *(const GAS bf16x8*)(Qw + 176 + hi * 8);
    if (rope) {
      rope_pair(x0, x1, rtab + (size_t)prow * 16 + hi * 8, rtab + 2048 + (size_t)prow * 16 + hi * 8);
      rope_pair(x2, x3, rtab + (size_t)pcol * 16 + hi * 8, rtab + 2048 + (size_t)pcol * 16 + hi * 8); }
    LAS char* qw_ = (LAS char*)qx; *(LAS bf16x8*)(qw_) = x0; *(LAS bf16x8*)(qw_ + 32) = x1; *(LAS bf16x8*)(qw_ + 64) = x2; *(LAS bf16x8*)(qw_ + 96) = x3;
  }
  const int sr = tid >> 4, sc = (tid & 15) * 8, vst0 = v_st(sr, sc), vst1 = v_st(32 + sr, sc);
  const int rr_ = tid >> 3, rc_ = (tid & 7) * 8;
  const int vb0 = (int)(uintptr_t)V_lds + v_rd_base(lane);
  struct { bf16x8 vs0, vs1, ks0, ks1, kx; } sr_[SDEPTH];
#define SLOAD(i, jt) do { const Tile t_ = ts(jt); sr_[i].vs0 = *(const GAS bf16x8*)(t_.v + (size_t)sr * LDV + sc); sr_[i].vs1 = *(const GAS bf16x8*)(t_.v + (size_t)(32 + sr) * LDV + sc); \
    sr_[i].ks0 = *(const GAS bf16x8*)(t_.kn + (size_t)sr * LDKN + sc); sr_[i].ks1 = *(const GAS bf16x8*)(t_.kn + (size_t)(32 + sr) * LDKN + sc); \
    if constexpr (DQK == 192) sr_[i].kx = *(const GAS bf16x8*)(t_.kr + (size_t)rr_ * 64 + rc_); } while (0)
#define SWRITE(b, i) do { *(LAS bf16x8*)(V_lds + (b) * SHM_V + vst0) = sr_[i].vs0; *(LAS bf16x8*)(V_lds + (b) * SHM_V + vst1) = sr_[i].vs1; const int kc = sc * 2; \
    *(LAS bf16x8*)(K_lds + (b) * SHM_K + kswz<DQK>(sr, kc)) = sr_[i].ks0; *(LAS bf16x8*)(K_lds + (b) * SHM_K + kswz<DQK>(32 + sr, kc)) = sr_[i].ks1; \
    if constexpr (DQK == 192) *(LAS bf16x8*)(K_lds + (b) * SHM_K + kswz<DQK>(rr_, 256 + rc_ * 2)) = sr_[i].kx; } while (0)
#define SWAIT() do { if constexpr (SDEPTH == 2) { if constexpr (DQK == 192) asm volatile("s_waitcnt vmcnt(5)" ::: "memory"); else asm volatile("s_waitcnt vmcnt(4)" ::: "memory"); } \
    else asm volatile("s_waitcnt vmcnt(0)" ::: "memory"); } while (0)
#define RESC(a) do { if (__any((a) < 1.f)) { if (hi == 0) al_l[r32] = (a); asm volatile("s_waitcnt lgkmcnt(0)" ::: "memory"); \
    _Pragma("unroll") for (int d = 0; d < 4; ++d) _Pragma("unroll") for (int r = 0; r < 16; ++r) o[d][r] *= al_l[crow(r, hi)]; } } while (0)
#define MASKT(pa_, pb_, jt) do { if constexpr (MASK) { const Tile t_ = ts(jt); apply_mask(pa_, pb_, t_.mtype, t_.krel0, qi, hi); } } while (0)
  f32x16 pA0, pA1, pB0, pB1; float mnA, mnB, alA, alB; bf16x8 pa0, pa1, pa2, pa3;
  constexpr int SE = 0, SO = SDEPTH - 1;
  SLOAD(SE, 0); asm volatile("s_waitcnt vmcnt(0)" ::: "memory"); SWRITE(0, SE); __syncthreads();
  qkt<DQK>(pA0, pA1, K_lds, qr, qx, r32, hi); MASKT(pA0, pA1, 0); partialSM<DQK>(pA0, pA1, m_reg, mnA, alA);
  SLOAD(SO, 1); if constexpr (SDEPTH == 2) { if (2 < NT) SLOAD(SE, 2); }
  SWAIT(); SWRITE(1, SO); __syncthreads();
  for (int j = 1; j + 1 < NT; j += 2) {
    SBAR(); qkt<DQK>(pB0, pB1, K_lds + SHM_K, qr, qx, r32, hi); MASKT(pB0, pB1, j);
    finishSM(pA0, pA1, alA, l_reg, pa0, pa1, pa2, pa3); SBAR();
    SLOAD(SO, j + SDEPTH); SBAR();
    pv_d0(o, vb0, pa0, pa1, pa2, pa3); partialSM<DQK>(pB0, pB1, m_reg, mnB, alB);
    __syncthreads(); SWAIT(); SWRITE(0, SE);
    RESC(alB); __syncthreads();
    SBAR(); qkt<DQK>(pA0, pA1, K_lds, qr, qx, r32, hi); MASKT(pA0, pA1, j + 1);
    finishSM(pB0, pB1, alB, l_reg, pa0, pa1, pa2, pa3); SBAR();
    if (SDEPTH == 1 || j + 3 < NT) SLOAD(SE, j + 1 + SDEPTH); SBAR();
    pv_d0(o, vb0 + SHM_V, pa0, pa1, pa2, pa3); partialSM<DQK>(pA0, pA1, m_reg, mnA, alA);
    __syncthreads(); SWAIT(); SWRITE(1, SO);
    RESC(alA); __syncthreads();
  }
  SBAR(); qkt<DQK>(pB0, pB1, K_lds + SHM_K, qr, qx, r32, hi); MASKT(pB0, pB1, NT - 1);
  finishSM(pA0, pA1, alA, l_reg, pa0, pa1, pa2, pa3); SBAR();
  pv_d0(o, vb0, pa0, pa1, pa2, pa3); partialSM<DQK>(pB0, pB1, m_reg, mnB, alB);
  __syncthreads(); RESC(alB);
  finishSM(pB0, pB1, alB, l_reg, pa0, pa1, pa2, pa3); SBAR();
  pv_d0(o, vb0 + SHM_V, pa0, pa1, pa2, pa3);
  if constexpr (SINK) l_reg += __builtin_amdgcn_exp2f(sink_l2 - m_reg * C);
  if (hi == 0) li_l[r32] = l_reg; asm volatile("s_waitcnt lgkmcnt(0)" ::: "memory");
  float rli[16];
#pragma unroll
  for (int r = 0; r < 16; ++r) rli[r] = __builtin_amdgcn_rcpf(li_l[crow(r, hi)]);
  __syncthreads();
  LAS bf16* ost = (LAS bf16*)(lds + wid * 8704);
#pragma unroll
  for (int r = 0; r < 16; ++r) { const int orow = crow(r, hi);
#pragma unroll
    for (int d0 = 0; d0 < 4; ++d0) ost[orow * 136 + d0 * 32 + r32] = (bf16)f2bf(o[d0][r] * rli[r]); }
  asm volatile("s_waitcnt lgkmcnt(0)" ::: "memory");
#pragma unroll
  for (int i = 0; i < 8; ++i) { const int orow = i * 4 + (lane >> 4), ch = lane & 15;
    *(GAS v4u*)(Ow + (size_t)orow * 4096 + ch * 8) = *(const LAS v4u*)(ost + orow * 136 + ch * 8); }
  __syncthreads();
#undef SLOAD
#undef SWRITE
#undef SWAIT
#undef RESC
#undef MASKT
}
}

struct Args { const float* in[38]; float* out; unsigned char* ws; };
template <class T> __device__ __forceinline__ T launder(T p) { asm volatile("" : "+s"(p)); return p; }
template <class T> __device__ __forceinline__ T* launder_g(T* p) { GAS T* g = (GAS T*)p; asm volatile("" : "+s"(g)); return (T*)g; }
#define INP(i) ((const float*)(gcfl)F.A->in[i])
struct Frame {
    LAS unsigned char* lds;
    gu32* ctl;
    int tid, lane, wave;
    int vcu, G, gw, NGW;
    const __attribute__((address_space(4))) Args* A;
    float* out;
    unsigned char* ws;
    unsigned char* wsw;
};
enum { I_X = 0, I_C, I_CTX, I_CCTX, I_WMOD, I_BMOD, I_WIN, I_WOUT, I_LN1G, I_LN1B, I_WFF1, I_WFF2, I_LN2G, I_LN2B, I_SINK, I_CONVW, I_CONVB, I_LWA, I_LBA, I_LWI, I_LBI, I_LAM,
       I_QNORM, I_KVNORM, I_WQB, I_WKVB, I_MUP, I_MUN, I_W0, I_W2, I_A0, I_A2, I_G2, I_KK, I_KA, I_RK, I_LNG, I_LNB };
__device__ __forceinline__ int row_s(int row) { return row < SEQ ? 0 : (row < M_LAT ? 1 : 2); }
__device__ __forceinline__ const float* mod_ptr(const Frame& F, int l, int s, int chunk) { return (const float*)(F.ws + WS_MOD) + ((size_t)(l * 3 + s) * 6 + chunk) * DM; }

__device__ __forceinline__ void transpose_item(const float* W, int N, int Kvalid, bf16* WT, int ldt, const float* kscale, LAS float* scr, int k0, int n0, int lane) {
    { const int kr = lane >> 3, c4 = (lane & 7) * 4;
#pragma unroll
      for (int i = 0; i < 8; ++i) { const int kk = 8 * i + kr, k = k0 + kk; f32x4 v = {0.f, 0.f, 0.f, 0.f};
          if (k < Kvalid) { v = *(const f32x4*)(W + (size_t)k * N + n0 + c4); if (kscale) v = v * kscale[k]; }
          scr[kk * 33 + c4] = v.x; scr[kk * 33 + c4 + 1] = v.y; scr[kk * 33 + c4 + 2] = v.z; scr[kk * 33 + c4 + 3] = v.w; } }
    LDS_WAIT(); asm volatile("" ::: "memory");
    const int c = lane & 7;
#pragma unroll
    for (int j = 0; j < 4; ++j) { const int n = (lane >> 3) + 8 * j; const LAS float* s = scr + (8 * c) * 33 + n;
        v4u o; o.x = pk2(s[0 * 33], s[1 * 33]); o.y = pk2(s[2 * 33], s[3 * 33]); o.z = pk2(s[4 * 33], s[5 * 33]); o.w = pk2(s[6 * 33], s[7 * 33]);
        *(v4u*)(WT + (size_t)(n0 + n) * ldt + k0 + 8 * c) = o; }
    LDS_WAIT(); asm volatile("" ::: "memory");
}
struct TItem { const float* W; bf16* WT; const float* kscale; int N, Kvalid, ldt, k0, n0; };
__device__ __forceinline__ void titem_load(const TItem& t, int lane, f32x4 (&v)[8]) {
    const int kr = lane >> 3, c4 = (lane & 7) * 4;
#pragma unroll
    for (int i = 0; i < 8; ++i) { const int k = t.k0 + 8 * i + kr; v[i] = (f32x4){0.f, 0.f, 0.f, 0.f}; if (k < t.Kvalid) v[i] = *(const f32x4*)(t.W + (size_t)k * t.N + t.n0 + c4); }
}
__device__ __forceinline__ void titem_finish(const TItem& t, int lane, LAS float* scr, f32x4 (&v)[8]) {
    { const int kr = lane >> 3, c4 = (lane & 7) * 4;
#pragma unroll
      for (int i = 0; i < 8; ++i) { const int kk = 8 * i + kr, k = t.k0 + kk; f32x4 x = v[i]; if (t.kscale && k < t.Kvalid) x = x * t.kscale[k];
          scr[kk * 33 + c4] = x.x; scr[kk * 33 + c4 + 1] = x.y; scr[kk * 33 + c4 + 2] = x.z; scr[kk * 33 + c4 + 3] = x.w; } }
    LDS_WAIT(); asm volatile("" ::: "memory");
    const int c = lane & 7;
#pragma unroll
    for (int j = 0; j < 4; ++j) { const int n = (lane >> 3) + 8 * j; const LAS float* s = scr + (8 * c) * 33 + n;
        v4u o; o.x = pk2(s[0 * 33], s[1 * 33]); o.y = pk2(s[2 * 33], s[3 * 33]); o.z = pk2(s[4 * 33], s[5 * 33]); o.w = pk2(s[6 * 33], s[7 * 33]);
        *(v4u*)(t.WT + (size_t)(t.n0 + n) * t.ldt + t.k0 + 8 * c) = o; }
    LDS_WAIT(); asm volatile("" ::: "memory");
}
__device__ __forceinline__ TItem conv_decode(const Frame& F, int l, unsigned char* ws, int r) {
    constexpr int I1 = 64 * 271, I2 = 64 * 128, I3 = 64 * 512, I4 = 256 * 128, I5 = 16 * 48, I6 = 8 * 64, I7 = 32 * 8, I8 = 2 * 32, I9 = 2 * 32;
    if (r < I1) return TItem{INP(I_WIN) + (size_t)l * DM * DIN, (bf16*)(ws + WS_WIN), nullptr, DIN, DM, DM, 64 * (r / 271), 32 * (r % 271)}; r -= I1;
    if (r < I2) return TItem{INP(I_WOUT) + (size_t)l * DM * DM, (bf16*)(ws + WS_WOUT), nullptr, DM, DM, DM, 64 * (r / 128), 32 * (r % 128)}; r -= I2;
    if (r < I3) return TItem{INP(I_WFF1) + (size_t)l * DM * DFF, (bf16*)(ws + WS_WFF1), nullptr, DFF, DM, DM, 64 * (r / 512), 32 * (r % 512)}; r -= I3;
    if (r < I4) return TItem{INP(I_WFF2) + (size_t)l * DFF * DM, (bf16*)(ws + WS_WFF2), nullptr, DM, DFF, DFF, 64 * (r / 128), 32 * (r % 128)}; r -= I4;
    if (r < I5) return TItem{INP(I_WQB) + (size_t)l * 1024 * 1536, (bf16*)(ws + WS_WQB), INP(I_QNORM) + l * 1024, 1536, 1024, 1024, 64 * (r / 48), 32 * (r % 48)}; r -= I5;
    if (r < I6) return TItem{INP(I_WKVB) + (size_t)l * 512 * 2048, (bf16*)(ws + WS_WKVB), INP(I_KVNORM) + l * 512, 2048, 512, 512, 64 * (r / 64), 32 * (r % 64)}; r -= I6;
    if (r < I7) { const int mat = r >> 3, sub = r & 7, gate = mat & 1, dn = mat >> 1, d = dn >> 3, n = dn & 7;
        return TItem{(gate ? INP(I_LWI) : INP(I_LWA)) + ((size_t)(l * 2 + d) * 8 + n) * 128 * 128, (bf16*)(ws + WS_WLRU) + ((size_t)(d * 2 + gate) * 8 + n) * 128 * 128, nullptr, 128, 128, 128, 64 * (sub >> 2), 32 * (sub & 3)}; } r -= I7;
    if (r < I8) { const int d = r >> 5; return TItem{INP(I_W2) + (size_t)(l * 2 + d) * 64 * 1024, (bf16*)(ws + WS_W2T) + (size_t)d * 1024 * 64, nullptr, 1024, 64, 64, 0, 32 * (r & 31)}; } r -= I8;
    if (r < I9) { const int d = r >> 5; return TItem{INP(I_A2) + (size_t)(l * 2 + d) * 64 * 1024, (bf16*)(ws + WS_A2T) + (size_t)d * 1024 * 64, nullptr, 1024, 64, 64, 0, 32 * (r & 31)}; } r -= I9;
    return TItem{INP(I_G2) + (size_t)l * 160 * 1024, (bf16*)(ws + WS_G2T), nullptr, 1024, 160, 192, 64 * (r / 32), 32 * (r % 32)};
}
__device__ __forceinline__ void convert_weights(Frame& F, int l, int widx, int nw) {
    LAS float* scr = (LAS float*)(F.lds + F.wave * 16384);
    constexpr int NIT = 64 * 271 + 64 * 128 + 64 * 512 + 256 * 128 + 16 * 48 + 8 * 64 + 32 * 8 + 2 * 32 + 2 * 32 + 3 * 32;
    unsigned char* ws = F.ws + (l ? WSET_STRIDE : 0);
    int it = __builtin_amdgcn_readfirstlane(widx);
    if (it < NIT) { TItem cur = conv_decode(F, l, ws, it); f32x4 va[8]; titem_load(cur, F.lane, va);
#pragma unroll 1
        for (;;) { const int itn = it + nw; TItem nxt = cur; f32x4 vb[8];
            if (itn < NIT) { nxt = conv_decode(F, l, ws, itn); titem_load(nxt, F.lane, vb); }
            else {
#pragma unroll
                for (int i = 0; i < 8; ++i) vb[i] = va[i]; }
            titem_finish(cur, F.lane, scr, va);
            if (itn >= NIT) break;
            cur = nxt; it = itn;
#pragma unroll
            for (int i = 0; i < 8; ++i) va[i] = vb[i]; } }
    { unsigned zz = 0u; asm volatile("" : "+v"(zz)); v4u z = {zz, zz, zz, zz}; v4u* p = (v4u*)((bf16*)(ws + WS_WIN) + (size_t)DIN * DM);
      for (int i = widx * 64 + F.lane; i < 32 * DM / 8; i += nw * 64) p[i] = z; }
}

__device__ __forceinline__ void mod_partials(Frame& F) {
    LAS float* sl = (LAS float*)F.lds;
    for (int it = F.vcu; it < 2 * 32 * 12; it += F.G) {
        const int l = it / 384, ks = (it / 12) % 32, cc = it % 12;
        __syncthreads();
        if (F.tid < 384) { const int s = F.tid >> 7, k = ks * 128 + (F.tid & 127); const float c = s < 2 ? INP(I_C)[s * DM + k] : INP(I_CCTX)[k]; sl[F.tid] = c / (1.f + __expf(-c)); }
        __syncthreads();
        const float* wp = INP(I_WMOD) + ((size_t)l * DM + ks * 128) * 24576 + cc * 2048 + F.tid * 4;
        f32x4 a0 = {0.f, 0.f, 0.f, 0.f}, a1 = a0, a2 = a0;
#pragma unroll 8
        for (int k = 0; k < 128; ++k) { const f32x4 w = *(const f32x4*)(wp + (size_t)k * 24576); a0 += w * sl[k]; a1 += w * sl[128 + k]; a2 += w * sl[256 + k]; }
        float* op = (float*)(F.ws + WS_MODP) + ((size_t)(l * 32 + ks) * 3) * 24576 + cc * 2048 + F.tid * 4;
        *(f32x4*)(op) = a0; *(f32x4*)(op + 24576) = a1; *(f32x4*)(op + 2 * 24576) = a2;
    }
    __syncthreads();
}
__device__ __forceinline__ void mod_reduce(Frame& F) {
    for (int i = F.vcu * NTHR + F.tid; i < 2 * 3 * 24576; i += F.G * NTHR) {
        const int l = i / (3 * 24576), s = (i / 24576) % 3, n = i % 24576;
        float a = INP(I_BMOD)[l * 24576 + n];
        const float* pp = (const float*)(F.ws + WS_MODP) + ((size_t)(l * 32) * 3 + s) * 24576 + n;
#pragma unroll 8
        for (int ks = 0; ks < 32; ++ks) a += pp[(size_t)ks * 3 * 24576];
        ((float*)(F.ws + WS_MOD))[i] = a;
    }
}

__device__ __forceinline__ void sum_partials_row(const Frame& F, const float* yp, size_t stride, bf16* ydst) {
    int lane = F.lane; asm volatile("" : "+v"(lane));
#pragma unroll 2
    for (int j = 0; j < 8; ++j) { const int c = 8 * lane + 512 * j; f32x4 y0 = *(const f32x4*)(yp + c), y1 = *(const f32x4*)(yp + c + 4);
#pragma unroll
        for (int sp = 1; sp < 8; ++sp) { y0 += *(const f32x4*)(yp + sp * stride + c); y1 += *(const f32x4*)(yp + sp * stride + c + 4); }
        v4u w; w.x = pk2(y0.x, y0.y); w.y = pk2(y0.z, y0.w); w.z = pk2(y1.x, y1.y); w.w = pk2(y1.z, y1.w); *(v4u*)(ydst + c) = w; }
}
constexpr int LNV_G = 0, LNV_B = DM, LNV_GA = 2 * DM, LNV_SC = 3 * DM, LNV_SH = 4 * DM;
__device__ __forceinline__ void ln_stage(const Frame& F, int slot, const float* src) {
    LAS float* d = (LAS float*)F.lds + slot; gcfl g = (gcfl)src;
#pragma unroll
    for (int u = 0; u < 2; ++u) { const int c = 4 * (F.tid + NTHR * u); *(LAS f32x4*)(d + c) = *(const GAS f32x4*)(g + c); }
}
template <int MODE, bool XSH = false, bool XDH = false>
__device__ __forceinline__ void ln_row(const Frame& F, const void* xsrc_, const bf16* Y_, void* xdst_, bool domod, bf16* hrow_) {
    gcfl xsrc = (gcfl)xsrc_; const GAS _Float16* xsrch = (const GAS _Float16*)xsrc_; gflp xdst = (gflp)xdst_; GAS _Float16* xdsth = (GAS _Float16*)xdst_;
    gcbf Y = (gcbf)Y_; gbfp hrow = (gbfp)hrow_; const LAS float* L = (const LAS float*)F.lds + 8 * F.lane;
    f32x4 v[16]; v4u yr[8]; float s = 0.f;
#pragma unroll
    for (int j = 0; j < 8; ++j) { const int c = 8 * F.lane + 512 * j;
        if (XSH) { const h16x8 h = __builtin_nontemporal_load((const GAS h16x8*)(xsrch + c));
            v[2 * j] = __builtin_convertvector(__builtin_shufflevector(h, h, 0, 1, 2, 3), f32x4); v[2 * j + 1] = __builtin_convertvector(__builtin_shufflevector(h, h, 4, 5, 6, 7), f32x4); }
        else { v[2 * j] = __builtin_nontemporal_load((const GAS f32x4*)(xsrc + c)); v[2 * j + 1] = __builtin_nontemporal_load((const GAS f32x4*)(xsrc + c + 4)); } }
    if (MODE == 1) {
#pragma unroll
        for (int j = 0; j < 8; ++j) yr[j] = __builtin_nontemporal_load((const GAS v4u*)(Y + 8 * F.lane + 512 * j));
    }
#pragma unroll
    for (int q = 0; q < 16; ++q) { const int j = q >> 1, hf = q & 1;
        if (MODE == 1) { const unsigned w0 = hf ? yr[j].z : yr[j].x, w1 = hf ? yr[j].w : yr[j].y; const f32x4 y = {bflo(w0), bfhi(w0), bflo(w1), bfhi(w1)}, g = *(const LAS f32x4*)(L + LNV_GA + 512 * j + 4 * hf); v[q] = v[q] * ALPHA + g * y; }
        s += (v[q].x + v[q].y) + (v[q].z + v[q].w); }
    float mean = wave_sum(s) * (1.f / DM), s2 = 0.f;
#pragma unroll
    for (int q = 0; q < 16; ++q) { v[q] = v[q] - mean; s2 += (v[q].x * v[q].x + v[q].y * v[q].y) + (v[q].z * v[q].z + v[q].w * v[q].w); }
    float rstd = 1.f / sqrtf(wave_sum(s2) * (1.f / DM) + LN_EPS);
    if (MODE == 1) {
        s = 0.f;
#pragma unroll
        for (int j = 0; j < 8; ++j) { const int c = 8 * F.lane + 512 * j;
#pragma unroll
            for (int hf = 0; hf < 2; ++hf) { const int q = 2 * j + hf; const f32x4 g = *(const LAS f32x4*)(L + LNV_G + 512 * j + 4 * hf), b = *(const LAS f32x4*)(L + LNV_B + 512 * j + 4 * hf); v[q] = v[q] * rstd * g + b;
                s += (v[q].x + v[q].y) + (v[q].z + v[q].w); }
            if (XDH) { const h16x4 h0 = __builtin_convertvector(v[2 * j], h16x4), h1 = __builtin_convertvector(v[2 * j + 1], h16x4);
                __builtin_nontemporal_store(__builtin_shufflevector(h0, h1, 0, 1, 2, 3, 4, 5, 6, 7), (GAS h16x8*)(xdsth + c)); }
            else { __builtin_nontemporal_store(v[2 * j], (GAS f32x4*)(xdst + c)); __builtin_nontemporal_store(v[2 * j + 1], (GAS f32x4*)(xdst + c + 4)); } }
        if (!domod) return;
        mean = wave_sum(s) * (1.f / DM); s2 = 0.f;
#pragma unroll
        for (int q = 0; q < 16; ++q) { v[q] = v[q] - mean; s2 += (v[q].x * v[q].x + v[q].y * v[q].y) + (v[q].z * v[q].z + v[q].w * v[q].w); }
        rstd = 1.f / sqrtf(wave_sum(s2) * (1.f / DM) + LN_EPS);
    }
#pragma unroll
    for (int j = 0; j < 8; ++j) { const int c = 8 * F.lane + 512 * j; unsigned w[4];
#pragma unroll
        for (int hf = 0; hf < 2; ++hf) { const f32x4 a = *(const LAS f32x4*)(L + LNV_SC + 512 * j + 4 * hf), b = *(const LAS f32x4*)(L + LNV_SH + 512 * j + 4 * hf);
            const f32x4 o = v[2 * j + hf] * rstd * (a + 1.f) + b; w[2 * hf] = pk2(o.x, o.y); w[2 * hf + 1] = pk2(o.z, o.w); }
        *(GAS v4u*)(hrow + c) = (v4u){w[0], w[1], w[2], w[3]}; }
}

__device__ __forceinline__ void shift4(const bf16* P, unsigned eo, bool hp, bool hn, const float* mup, const float* mun, unsigned mo, float (&u)[4]) {
    const v2u xc = ldg<v2u>(P, eo * 2u); v2u xp = {0u, 0u}, xn = {0u, 0u};
    if (hp) xp = ldg<v2u>(P, (eo - DINP) * 2u); if (hn) xn = ldg<v2u>(P, (eo + DINP) * 2u);
    const f32x4 mp = ldg<f32x4>(mup, mo * 4u), mn = ldg<f32x4>(mun, mo * 4u);
    const float c[4] = {bflo(xc.x), bfhi(xc.x), bflo(xc.y), bfhi(xc.y)}, p[4] = {bflo(xp.x), bfhi(xp.x), bflo(xp.y), bfhi(xp.y)}, n[4] = {bflo(xn.x), bfhi(xn.x), bflo(xn.y), bfhi(xn.y)};
#pragma unroll
    for (int e = 0; e < 4; ++e) u[e] = c[e] + mp[e] * (p[e] - c[e]) + mn[e] * (n[e] - c[e]);
}
__device__ __forceinline__ void st4bf(void* base, unsigned eo, float a, float b, float c, float d) { v2u w; w.x = pk2(a, b); w.y = pk2(c, d); stg<v2u>(base, eo * 2u, w); }

__device__ __forceinline__ void rwkv_feat_item(Frame& F, int l, int item) {
    F.tid = ltid(); F.lane = F.tid & 63;
    int row0, seq_lo, seq_hi;
    if (item < 16) { const int b = item >> 3; seq_lo = M_LAT + b * NCTX; seq_hi = seq_lo + NCTX; row0 = seq_lo + (item & 7) * 32; }
    else { const int it = item - 16, b = it >> 8; seq_lo = b * SEQ; seq_hi = seq_lo + SEQ; row0 = seq_lo + (it & 255) * 32; }
    const bf16* P = (const bf16*)(F.ws + WS_P);
    LAS bf16* ACT = (LAS bf16*)F.lds;
    const float* mup = INP(I_MUP) + l * RWC; const float* mun = INP(I_MUN) + l * RWC;
    __syncthreads();
    {
#pragma unroll
      for (int k = 0; k < 4; ++k) { const int p = F.tid + NTHR * k;
        if (p < 32 * 52) { const int tok = p / 52, j = (p - tok * 52) * 8, row = row0 + tok; const bool hp = row > seq_lo, hn = row + 1 < seq_hi;
          const bf16* pr = P + (size_t)row * DINP + C_RWL + j;
          const v4u xc = *(const v4u*)pr; v4u xp = {0u, 0u, 0u, 0u}, xn = {0u, 0u, 0u, 0u};
          if (hp) xp = *(const v4u*)(pr - DINP); if (hn) xn = *(const v4u*)(pr + DINP);
          const f32x4 mp[2] = {*(const f32x4*)(mup + 3072 + j), *(const f32x4*)(mup + 3072 + j + 4)}, mn[2] = {*(const f32x4*)(mun + 3072 + j), *(const f32x4*)(mun + 3072 + j + 4)};
          unsigned o[4];
#pragma unroll
          for (int w = 0; w < 4; ++w) { float u[2];
#pragma unroll
              for (int e = 0; e < 2; ++e) { const int idx = 2 * w + e; const float c = e ? bfhi(xc[w]) : bflo(xc[w]), pv = e ? bfhi(xp[w]) : bflo(xp[w]), nv = e ? bfhi(xn[w]) : bflo(xn[w]);
                  float v = c + mp[idx >> 2][idx & 3] * (pv - c) + mn[idx >> 2][idx & 3] * (nv - c);
                  if (j < 128) v = tanhf_(v); else if (j >= 256) v = sigmoidf_(v);
                  u[e] = v; }
              o[w] = pk2(u[0], u[1]); }
          *(LAS v4u*)(ACT + tok * 424 + j) = (v4u){o[0], o[1], o[2], o[3]}; } } }
    __syncthreads();
    const int tok = F.lane & 31, hi = F.lane >> 5, row = row0 + tok;
    const bf16* W2T = (const bf16*)(F.wsw + WS_W2T); const bf16* A2T = (const bf16*)(F.wsw + WS_A2T); const bf16* G2T = (const bf16*)(F.wsw + WS_G2T);
    bf16* RWF = (bf16*)(F.ws + WS_RWF); const size_t RS = (size_t)M_TOT * 1024;
    const float* kkv = INP(I_KK) + l * 1024; const float* kav = INP(I_KA) + l * 1024; const float* rkv = INP(I_RK) + l * 1024;
    const float* w0f = INP(I_W0) + (size_t)(l * 2) * 1024; const float* a0f = INP(I_A0) + (size_t)(l * 2) * 1024;
    const LAS bf16* actl = ACT + tok * 424 + hi * 8;
    LAS unsigned char* TB = F.lds + 27136 + F.wave * 10880;
    LAS float* VB = (LAS float*)(F.lds + (F.wave < 4 ? 114176 + F.wave * 3328 : 131584 + (F.wave - 4) * 3328));
#define RF_LOADG(reg_, colbase) do { _Pragma("unroll") for (int i_ = 0; i_ < 3; ++i_) { const int p_ = F.lane + 64 * i_; reg_[i_] = (v4u){0u, 0u, 0u, 0u}; if (p_ < 136) { const int rr_ = p_ >> 2, cp_ = p_ & 3, gr_ = row0 - 1 + rr_; \
        if (gr_ >= seq_lo && gr_ < seq_hi) reg_[i_] = ldg<v4u>(P, ((unsigned)gr_ * DINP + (colbase) + 8 * cp_) * 2u); } } } while (0)
#define RF_STORET(ti, reg_) do { _Pragma("unroll") for (int i_ = 0; i_ < 3; ++i_) { const int p_ = F.lane + 64 * i_; if (p_ < 136) { const int rr_ = p_ >> 2, cp_ = p_ & 3; *(LAS v4u*)(TB + (ti) * 2720 + rr_ * 80 + cp_ * 16) = reg_[i_]; } } } while (0)
#define RF_SHIFT4(ti, g_, vb_, cc_, u_) do { const LAS unsigned char* q_ = TB + (ti) * 2720 + (tok + 1) * 80 + (8 * (g_) + 4 * hi) * 2; const v2u xc_ = *(const LAS v2u*)q_, xp_ = *(const LAS v2u*)(q_ - 80), xn_ = *(const LAS v2u*)(q_ + 80); \
        const f32x4 mp_ = *(const LAS f32x4*)(VB + (vb_) * 64 + (cc_)), mn_ = *(const LAS f32x4*)(VB + ((vb_) + 1) * 64 + (cc_)); \
        const float c_[4] = {bflo(xc_.x), bfhi(xc_.x), bflo(xc_.y), bfhi(xc_.y)}, pp_[4] = {bflo(xp_.x), bfhi(xp_.x), bflo(xp_.y), bfhi(xp_.y)}, nn_[4] = {bflo(xn_.x), bfhi(xn_.x), bflo(xn_.y), bfhi(xn_.y)}; \
        _Pragma("unroll") for (int e_ = 0; e_ < 4; ++e_) u_[e_] = c_[e_] + mp_[e_] * (pp_[e_] - c_[e_]) + mn_[e_] * (nn_[e_] - c_[e_]); } while (0)
#define RF_PUT(ti, o_) do { _Pragma("unroll") for (int g_ = 0; g_ < 4; ++g_) *(LAS v2u*)(TB + (ti) * 2720 + tok * 80 + (8 * g_ + 4 * hi) * 2) = o_[g_]; } while (0)
#define RF_FLUSH3(a0_, a1_, a2_, cblk_) do { asm volatile("s_waitcnt lgkmcnt(0)" ::: "memory"); \
        _Pragma("unroll") for (int t_ = 0; t_ < 3; ++t_) { const int arr_ = t_ == 0 ? (a0_) : (t_ == 1 ? (a1_) : (a2_)); \
            _Pragma("unroll") for (int i_ = 0; i_ < 2; ++i_) { const int p_ = F.lane + 64 * i_, rr_ = p_ >> 2, cp_ = p_ & 3; const v4u v_ = *(const LAS v4u*)(TB + t_ * 2720 + rr_ * 80 + cp_ * 16); \
                stg<v4u>(RWF + arr_ * RS, ((unsigned)(row0 + rr_) * 1024u + (cblk_) + 8 * cp_) * 2u, v_); } } \
        asm volatile("s_waitcnt lgkmcnt(0)" ::: "memory"); } while (0)
#pragma unroll 1
    for (int hh = 0; hh < 2; ++hh) {
        const int h = 2 * F.wave + hh, cbase = h * 64;
        float ssq = 0.f;
        { v4u t0[3], t1[3]; RF_LOADG(t0, C_RWK + cbase); RF_LOADG(t1, C_RWK + cbase + 32);
          const unsigned co = (cbase + F.lane) * 4u; float vv[13];
#pragma unroll
          for (int sct = 0; sct < 3; ++sct) { vv[2 * sct] = ldg<float>(mup, co + sct * 4096u); vv[2 * sct + 1] = ldg<float>(mun, co + sct * 4096u); }
          vv[6] = ldg<float>(kkv, co); vv[7] = ldg<float>(kav, co); vv[8] = ldg<float>(rkv, co); vv[9] = ldg<float>(a0f, co); vv[10] = ldg<float>(a0f, co + 4096u); vv[11] = ldg<float>(w0f, co); vv[12] = ldg<float>(w0f, co + 4096u);
          RF_STORET(0, t0); RF_STORET(1, t1);
#pragma unroll
          for (int q = 0; q < 13; ++q) VB[q * 64 + F.lane] = vv[q]; }
        asm volatile("s_waitcnt lgkmcnt(0)" ::: "memory");
#pragma unroll
        for (int bg = 0; bg < 8; ++bg) { const int cc = (bg >> 2) * 32 + 8 * (bg & 3) + 4 * hi; float uk[4];
            RF_SHIFT4(bg >> 2, bg & 3, 2, cc, uk); const f32x4 k4 = *(const LAS f32x4*)(VB + 6 * 64 + cc);
#pragma unroll
            for (int e = 0; e < 4; ++e) { const float q = uk[e] * k4[e]; ssq += q * q; } }
        ssq = half_swap_sum(ssq);
        const float rn = 1.f / fmaxf(sqrtf(ssq), 1e-12f);
        float sb = 0.f;
        asm volatile("s_waitcnt lgkmcnt(0)" ::: "memory");
#pragma unroll 1
        for (int blk = 0; blk < 2; ++blk) {
            const unsigned cblk = cbase + blk * 32, cha = cblk + tok;
            v4u gR[3], gK[3], gV[3];
            RF_LOADG(gR, C_RWR + cblk); RF_LOADG(gK, C_RWK + cblk); RF_LOADG(gV, C_RWV + cblk);
            bf16x8 wd[2][4], wg[10], wa[2][4];
#pragma unroll
            for (int d = 0; d < 2; ++d) {
#pragma unroll
                for (int ks = 0; ks < 4; ++ks) wd[d][ks] = ldg<bf16x8>(W2T, ((d * 1024 + cha) * 64 + ks * 16 + hi * 8) * 2u); }
#pragma unroll
            for (int ks = 0; ks < 10; ++ks) wg[ks] = ldg<bf16x8>(G2T, (cha * 192 + ks * 16 + hi * 8) * 2u);
#pragma unroll
            for (int d = 0; d < 2; ++d) {
#pragma unroll
                for (int ks = 0; ks < 4; ++ks) wa[d][ks] = ldg<bf16x8>(A2T, ((d * 1024 + cha) * 64 + ks * 16 + hi * 8) * 2u); }
#pragma unroll
            for (int d = 0; d < 2; ++d) { f32x16 aw = {};
#pragma unroll
                for (int ks = 0; ks < 4; ++ks) { const bf16x8 bw = *(const LAS bf16x8*)(actl + d * 64 + ks * 16);
                    aw = __builtin_amdgcn_mfma_f32_32x32x16_bf16(wd[d][ks], bw, aw, 0, 0, 0); }
                v2u o[4];
#pragma unroll
                for (int g = 0; g < 4; ++g) { const f32x4 w0 = *(const LAS f32x4*)(VB + (11 + d) * 64 + blk * 32 + 8 * g + 4 * hi); float e4[4];
#pragma unroll
                    for (int e = 0; e < 4; ++e) e4[e] = 0.60653065971f * sigmoidf_(w0[e] + aw[4 * g + e]);
                    o[g].x = pk2(e4[0], e4[1]); o[g].y = pk2(e4[2], e4[3]); }
                RF_PUT(d, o); }
            { f32x16 ag = {};
#pragma unroll
              for (int ks = 0; ks < 10; ++ks) { const bf16x8 bg_ = *(const LAS bf16x8*)(actl + 256 + ks * 16);
                  ag = __builtin_amdgcn_mfma_f32_32x32x16_bf16(wg[ks], bg_, ag, 0, 0, 0); }
              v2u o[4];
#pragma unroll
              for (int g = 0; g < 4; ++g) { o[g].x = pk2(ag[4 * g], ag[4 * g + 1]); o[g].y = pk2(ag[4 * g + 2], ag[4 * g + 3]); }
              RF_PUT(2, o); }
            RF_FLUSH3(4, 5, 8, cblk);
            RF_STORET(0, gR); RF_STORET(1, gK); RF_STORET(2, gV);
            { f32x16 aaf = {}, aab = {};
#pragma unroll
              for (int ks = 0; ks < 4; ++ks) { const bf16x8 baf = *(const LAS bf16x8*)(actl + 128 + ks * 16), bab = *(const LAS bf16x8*)(actl + 192 + ks * 16);
                  aaf = __builtin_amdgcn_mfma_f32_32x32x16_bf16(wa[0][ks], baf, aaf, 0, 0, 0); aab = __builtin_amdgcn_mfma_f32_32x32x16_bf16(wa[1][ks], bab, aab, 0, 0, 0); }
              v2u oR[4], oK[4], oV[4], oKK[4], oAF[4], oAB[4];
              asm volatile("s_waitcnt lgkmcnt(0)" ::: "memory");
#pragma unroll
              for (int g = 0; g < 4; ++g) { const int cc = blk * 32 + 8 * g + 4 * hi; float ur[4], uk[4], uv[4];
                  RF_SHIFT4(0, g, 0, cc, ur); RF_SHIFT4(1, g, 2, cc, uk); RF_SHIFT4(2, g, 4, cc, uv);
                  const f32x4 a0a = *(const LAS f32x4*)(VB + 9 * 64 + cc), a0b = *(const LAS f32x4*)(VB + 10 * 64 + cc), kk4 = *(const LAS f32x4*)(VB + 6 * 64 + cc), ka4 = *(const LAS f32x4*)(VB + 7 * 64 + cc), rk4 = *(const LAS f32x4*)(VB + 8 * 64 + cc);
                  float af[4], ab[4], kk[4];
#pragma unroll
                  for (int e = 0; e < 4; ++e) { const int r = 4 * g + e;
                      af[e] = sigmoidf_(a0a[e] + aaf[r]); ab[e] = sigmoidf_(a0b[e] + aab[r]); kk[e] = uk[e] * kk4[e] * rn;
                      const float kdf = uk[e] * (1.f + (af[e] - 1.f) * ka4[e]), kdb = uk[e] * (1.f + (ab[e] - 1.f) * ka4[e]);
                      sb += ur[e] * rk4[e] * (kdf + kdb); }
                  oR[g].x = pk2(ur[0], ur[1]); oR[g].y = pk2(ur[2], ur[3]); oK[g].x = pk2(uk[0], uk[1]); oK[g].y = pk2(uk[2], uk[3]); oV[g].x = pk2(uv[0], uv[1]); oV[g].y = pk2(uv[2], uv[3]);
                  oKK[g].x = pk2(kk[0], kk[1]); oKK[g].y = pk2(kk[2], kk[3]); oAF[g].x = pk2(af[0], af[1]); oAF[g].y = pk2(af[2], af[3]); oAB[g].x = pk2(ab[0], ab[1]); oAB[g].y = pk2(ab[2], ab[3]); }
              asm volatile("s_waitcnt lgkmcnt(0)" ::: "memory");
              RF_PUT(0, oR); RF_PUT(1, oK); RF_PUT(2, oV); RF_FLUSH3(0, 1, 2, cblk);
              RF_PUT(0, oKK); RF_PUT(1, oAF); RF_PUT(2, oAB); RF_FLUSH3(3, 6, 7, cblk); }
        }
        sb = half_swap_sum(sb);
        if (hi == 0) ((float*)(F.ws + WS_SB))[(size_t)row * 16 + h] = sb;
    }
#undef RF_LOADG
#undef RF_STORET
#undef RF_SHIFT4
#undef RF_PUT
#undef RF_FLUSH3
}

__device__ __forceinline__ float gelu_tanh(float x) { return 0.5f * x * (1.f + tanhf_(0.7978845608028654f * (x + 0.044715f * x * x * x))); }
template <bool PASS3>
__device__ __forceinline__ void lru_item(Frame& F, int l, int item) {
    F.tid = ltid(); F.lane = F.tid & 63;
    const int sc = item >> 3, nb = item & 7, b = sc / NCH, ch = sc % NCH;
    int row0, seq_lo, seq_hi;
    if (ch < 8) { seq_lo = M_LAT + b * NCTX; seq_hi = seq_lo + NCTX; row0 = seq_lo + ch * 32; }
    else { seq_lo = b * SEQ; seq_hi = seq_lo + SEQ; row0 = seq_lo + (ch - 8) * 32; }
    const bf16* P = (const bf16*)(F.ws + WS_P);
    LAS float* U = (LAS float*)F.lds;
    LAS bf16* UA = (LAS bf16*)(F.lds + 16384);
    LAS float* AB = (LAS float*)(F.lds + 32768);
    __syncthreads();
    { const int tok = F.tid >> 4, c8 = (F.tid & 15) * 8, cg = nb * 128 + c8; float acc[8];
      const float* cb = INP(I_CONVB) + l * 1024 + cg;
#pragma unroll
      for (int e = 0; e < 8; ++e) acc[e] = cb[e];
#pragma unroll
      for (int j = 0; j < 4; ++j) { const int r = row0 + tok - 2 + j;
          if (r >= seq_lo && r < seq_hi) { const v4u x = *(const v4u*)(P + (size_t)r * DINP + C_LRUX + cg); const float* cw = INP(I_CONVW) + (size_t)(l * 4 + j) * 1024 + cg;
#pragma unroll
              for (int w = 0; w < 4; ++w) { acc[2 * w] += cw[2 * w] * bflo(x[w]); acc[2 * w + 1] += cw[2 * w + 1] * bfhi(x[w]); } } }
      *(LAS f32x4*)(U + tok * 128 + c8) = (f32x4){acc[0], acc[1], acc[2], acc[3]}; *(LAS f32x4*)(U + tok * 128 + c8 + 4) = (f32x4){acc[4], acc[5], acc[6], acc[7]};
      v4u o; o.x = pk2(acc[0], acc[1]); o.y = pk2(acc[2], acc[3]); o.z = pk2(acc[4], acc[5]); o.w = pk2(acc[6], acc[7]);
      *(LAS v4u*)(UA + tok * 136 + c8) = o; }
    __syncthreads();
    { const int dir = F.wave >> 2, cq = F.wave & 3, l32 = F.lane & 31, hi = F.lane >> 5, chn = cq * 32 + l32, cg = nb * 128 + chn;
      const bf16* Wr = (const bf16*)(F.wsw + WS_WLRU) + ((size_t)(dir * 2 + 0) * 8 + nb) * 16384 + (size_t)chn * 128;
      const bf16* Wi = (const bf16*)(F.wsw + WS_WLRU) + ((size_t)(dir * 2 + 1) * 8 + nb) * 16384 + (size_t)chn * 128;
      f32x16 accr = {}, acci = {};
#pragma unroll
      for (int ks = 0; ks < 8; ++ks) { const int ko = ks * 16 + hi * 8;
          const bf16x8 a = *(const LAS bf16x8*)(UA + l32 * 136 + ko); const bf16x8 br = *(const bf16x8*)(Wr + ko), bi = *(const bf16x8*)(Wi + ko);
          accr = __builtin_amdgcn_mfma_f32_32x32x16_bf16(a, br, accr, 0, 0, 0); acci = __builtin_amdgcn_mfma_f32_32x32x16_bf16(a, bi, acci, 0, 0, 0); }
      const float ba = INP(I_LBA)[(l * 2 + dir) * 1024 + cg], bi_ = INP(I_LBI)[(l * 2 + dir) * 1024 + cg], sp = softplusf_(-INP(I_LAM)[(l * 2 + dir) * 1024 + cg]);
#pragma unroll
      for (int r = 0; r < 16; ++r) { const int tok = att::crow(r, hi); const float u = U[tok * 128 + chn];
          const float rg = sigmoidf_(accr[r] + ba), ig = sigmoidf_(acci[r] + bi_), la = -8.f * rg * sp, a = __expf(la), x2 = 2.f * la;
          const float em = x2 * (1.f + x2 * (0.5f + x2 * (0.16666667f + x2 * (0.041666668f + x2 * (0.0083333338f + x2 * 0.0013888889f)))));
          const float bc = __builtin_amdgcn_sqrtf(x2 < -0.5f ? 1.f - a * a : -em) * (ig * u);
          AB[(dir * 2 + 0) * 4096 + tok * 128 + chn] = a; AB[(dir * 2 + 1) * 4096 + tok * 128 + chn] = bc; } }
    __syncthreads();
    if (F.tid < 256) { const int dir = F.tid >> 7, chn = F.tid & 127, cg = nb * 128 + chn; const size_t ci = ((size_t)(dir * 2 + b) * NCH + ch) * 1024 + cg;
        LAS float* Aa = AB + (dir * 2) * 4096 + chn; LAS float* Bb = AB + (dir * 2 + 1) * 4096 + chn;
        if (!PASS3) { float h = 0.f, ap = 1.f;
#pragma unroll 8
            for (int s = 0; s < 32; ++s) { const int tok = dir ? 31 - s : s; const float a = Aa[tok * 128]; h = a * h + Bb[tok * 128]; ap *= a;
                if (s == 0 && dir == 1 && ch == 7) ((float*)(F.ws + WS_QUIRK))[b * 1024 + cg] = h; }
            ((float*)(F.ws + WS_CA))[ci] = ap; ((float*)(F.ws + WS_CB))[ci] = h;
        } else { float h = ((const float*)(F.ws + WS_HIN))[ci];
#pragma unroll 8
            for (int s = 0; s < 32; ++s) { const int tok = dir ? 31 - s : s; h = Aa[tok * 128] * h + Bb[tok * 128]; Bb[tok * 128] = h; } } }
    if (PASS3) { __syncthreads();
        const int tok = F.tid >> 4, c8 = (F.tid & 15) * 8, cg = nb * 128 + c8, row = row0 + tok;
        const v4u y = *(const v4u*)(P + (size_t)row * DINP + C_LRUY + cg); float o[8];
#pragma unroll
        for (int w = 0; w < 4; ++w) { const float h0 = AB[4096 + tok * 128 + c8 + 2 * w] + AB[3 * 4096 + tok * 128 + c8 + 2 * w], h1 = AB[4096 + tok * 128 + c8 + 2 * w + 1] + AB[3 * 4096 + tok * 128 + c8 + 2 * w + 1];
            o[2 * w] = h0 * gelu_tanh(bflo(y[w])); o[2 * w + 1] = h1 * gelu_tanh(bfhi(y[w])); }
        v4u ov; ov.x = pk2(o[0], o[1]); ov.y = pk2(o[2], o[3]); ov.z = pk2(o[4], o[5]); ov.w = pk2(o[6], o[7]);
        *(v4u*)((bf16*)(F.ws + WS_MIX) + (size_t)row * DM + 1024 + cg) = ov; }
}
template <bool PASS3>
__device__ __forceinline__ void lru_items(Frame& F, int l, int i0, int i1, int st, bool skipctx) {
    F.tid = ltid(); F.lane = F.tid & 63;
    int it = i0; while (it < i1 && skipctx && ((it >> 3) % NCH) < 8) it += st;
    if (it >= i1) return;
    const int nb = it & 7;
    const bf16* P = (const bf16*)(F.ws + WS_P);
    LAS float* U = (LAS float*)F.lds; LAS bf16* UA = (LAS bf16*)(F.lds + 16384); LAS float* AB = (LAS float*)(F.lds + 32768);
    const int tokc = F.tid >> 4, c8 = (F.tid & 15) * 8, cgc = nb * 128 + c8;
    const int dir = F.wave >> 2, cq = F.wave & 3, l32 = F.lane & 31, hi = F.lane >> 5, chn = cq * 32 + l32, cg = nb * 128 + chn;
    f32x4 cbv[2], cwv[4][2];
#pragma unroll
    for (int q = 0; q < 2; ++q) { cbv[q] = *(const f32x4*)(INP(I_CONVB) + l * 1024 + cgc + 4 * q);
#pragma unroll
        for (int j = 0; j < 4; ++j) cwv[j][q] = *(const f32x4*)(INP(I_CONVW) + (size_t)(l * 4 + j) * 1024 + cgc + 4 * q); }
    bf16x8 wr[8], wi[8];
    { const bf16* Wr = (const bf16*)(F.wsw + WS_WLRU) + ((size_t)(dir * 2 + 0) * 8 + nb) * 16384 + (size_t)chn * 128;
      const bf16* Wi = (const bf16*)(F.wsw + WS_WLRU) + ((size_t)(dir * 2 + 1) * 8 + nb) * 16384 + (size_t)chn * 128;
#pragma unroll
      for (int ks = 0; ks < 8; ++ks) { wr[ks] = *(const bf16x8*)(Wr + ks * 16 + hi * 8); wi[ks] = *(const bf16x8*)(Wi + ks * 16 + hi * 8); } }
    const float ba = INP(I_LBA)[(l * 2 + dir) * 1024 + cg], bi_ = INP(I_LBI)[(l * 2 + dir) * 1024 + cg], sp = softplusf_(-INP(I_LAM)[(l * 2 + dir) * 1024 + cg]);
    v4u xr[4];
#define LRU_LOADX(it_) do { const int sc_ = (it_) >> 3, b_ = sc_ / NCH, ch_ = sc_ % NCH; const int lo_ = ch_ < 8 ? M_LAT + b_ * NCTX : b_ * SEQ, hi_ = lo_ + (ch_ < 8 ? NCTX : SEQ), r0_ = lo_ + (ch_ < 8 ? ch_ : ch_ - 8) * 32; \
        _Pragma("unroll") for (int j_ = 0; j_ < 4; ++j_) { const int r_ = r0_ + tokc - 2 + j_; xr[j_] = (v4u){0u, 0u, 0u, 0u}; if (r_ >= lo_ && r_ < hi_) xr[j_] = *(const v4u*)(P + (size_t)r_ * DINP + C_LRUX + cgc); } } while (0)
    LRU_LOADX(it);
#pragma unroll 1
    for (;;) {
        const int sc = it >> 3, b = sc / NCH, ch = sc % NCH;
        const int row0 = ch < 8 ? M_LAT + b * NCTX + ch * 32 : b * SEQ + (ch - 8) * 32;
        __syncthreads();
        { float acc[8];
#pragma unroll
          for (int e = 0; e < 8; ++e) acc[e] = cbv[e >> 2][e & 3];
#pragma unroll
          for (int j = 0; j < 4; ++j) {
#pragma unroll
              for (int w = 0; w < 4; ++w) { acc[2 * w] += cwv[j][(2 * w) >> 2][(2 * w) & 3] * bflo(xr[j][w]); acc[2 * w + 1] += cwv[j][(2 * w + 1) >> 2][(2 * w + 1) & 3] * bfhi(xr[j][w]); } }
          *(LAS f32x4*)(U + tokc * 128 + c8) = (f32x4){acc[0], acc[1], acc[2], acc[3]}; *(LAS f32x4*)(U + tokc * 128 + c8 + 4) = (f32x4){acc[4], acc[5], acc[6], acc[7]};
          v4u o; o.x = pk2(acc[0], acc[1]); o.y = pk2(acc[2], acc[3]); o.z = pk2(acc[4], acc[5]); o.w = pk2(acc[6], acc[7]);
          *(LAS v4u*)(UA + tokc * 136 + c8) = o; }
        int itn = it + st; while (itn < i1 && skipctx && ((itn >> 3) % NCH) < 8) itn += st;
        if (itn < i1) LRU_LOADX(itn);
        __syncthreads();
        { f32x16 accr = {}, acci = {};
#pragma unroll
          for (int ks = 0; ks < 8; ++ks) { const bf16x8 a = *(const LAS bf16x8*)(UA + l32 * 136 + ks * 16 + hi * 8);
              accr = __builtin_amdgcn_mfma_f32_32x32x16_bf16(a, wr[ks], accr, 0, 0, 0); acci = __builtin_amdgcn_mfma_f32_32x32x16_bf16(a, wi[ks], acci, 0, 0, 0); }
#pragma unroll
          for (int r = 0; r < 16; ++r) { const int tok = att::crow(r, hi); const float u = U[tok * 128 + chn];
              const float rg = sigmoidf_(accr[r] + ba), ig = sigmoidf_(acci[r] + bi_), la = -8.f * rg * sp, a = __expf(la), x2 = 2.f * la;
              const float em = x2 * (1.f + x2 * (0.5f + x2 * (0.16666667f + x2 * (0.041666668f + x2 * (0.0083333338f + x2 * 0.0013888889f)))));
              const float bc = __builtin_amdgcn_sqrtf(x2 < -0.5f ? 1.f - a * a : -em) * (ig * u);
              AB[(dir * 2 + 0) * 4096 + tok * 128 + chn] = a; AB[(dir * 2 + 1) * 4096 + tok * 128 + chn] = bc; } }
        __syncthreads();
        if (F.tid < 256) { const int dr = F.tid >> 7, cn = F.tid & 127, cgs = nb * 128 + cn; const size_t ci = ((size_t)(dr * 2 + b) * NCH + ch) * 1024 + cgs;
            LAS float* Aa = AB + (dr * 2) * 4096 + cn; LAS float* Bb = AB + (dr * 2 + 1) * 4096 + cn;
            if (!PASS3) { float h = 0.f, ap = 1.f;
#pragma unroll 8
                for (int s = 0; s < 32; ++s) { const int tok = dr ? 31 - s : s; const float a = Aa[tok * 128]; h = a * h + Bb[tok * 128]; ap *= a;
                    if (s == 0 && dr == 1 && ch == 7) ((float*)(F.ws + WS_QUIRK))[b * 1024 + cgs] = h; }
                ((float*)(F.ws + WS_CA))[ci] = ap; ((float*)(F.ws + WS_CB))[ci] = h;
            } else { float h = ((const float*)(F.ws + WS_HIN))[ci];
#pragma unroll 8
                for (int s = 0; s < 32; ++s) { const int tok = dr ? 31 - s : s; h = Aa[tok * 128] * h + Bb[tok * 128]; Bb[tok * 128] = h; } } }
        if (PASS3) { __syncthreads();
            const int cgo = nb * 128 + c8, row = row0 + tokc;
            const v4u y = *(const v4u*)(P + (size_t)row * DINP + C_LRUY + cgo); float o[8];
#pragma unroll
            for (int w = 0; w < 4; ++w) { const float h0 = AB[4096 + tokc * 128 + c8 + 2 * w] + AB[3 * 4096 + tokc * 128 + c8 + 2 * w], h1 = AB[4096 + tokc * 128 + c8 + 2 * w + 1] + AB[3 * 4096 + tokc * 128 + c8 + 2 * w + 1];
                o[2 * w] = h0 * gelu_tanh(bflo(y[w])); o[2 * w + 1] = h1 * gelu_tanh(bfhi(y[w])); }
            v4u ov; ov.x = pk2(o[0], o[1]); ov.y = pk2(o[2], o[3]); ov.z = pk2(o[4], o[5]); ov.w = pk2(o[6], o[7]);
            *(v4u*)((bf16*)(F.ws + WS_MIX) + (size_t)row * DM + 1024 + cgo) = ov; }
        if (itn >= i1) break;
        it = itn;
    }
#undef LRU_LOADX
}
__device__ __forceinline__ void lru_carry(Frame& F, int blk) {
    F.tid = ltid(); F.lane = F.tid & 63;
    const int gid = blk * NTHR + F.tid; if (gid >= 4096) return;
    const int dir = gid >> 11, b = (gid >> 10) & 1, cg = gid & 1023;
    gcfl CA = (gcfl)((const float*)(F.ws + WS_CA) + ((size_t)(dir * 2 + b) * NCH) * 1024 + cg); gcfl CB = (gcfl)((const float*)(F.ws + WS_CB) + ((size_t)(dir * 2 + b) * NCH) * 1024 + cg);
    gflp HIN = (gflp)((float*)(F.ws + WS_HIN) + ((size_t)(dir * 2 + b) * NCH) * 1024 + cg);
    float h = 0.f;
#define LC_RUN(cstart, count, step) do { _Pragma("unroll 1") for (int base_ = 0; base_ < (count); base_ += 33) { float a_[33], b_[33]; \
        _Pragma("unroll") for (int i_ = 0; i_ < 33; ++i_) { a_[i_] = 0.f; b_[i_] = 0.f; if (base_ + i_ < (count)) { const int c_ = (cstart) + (step) * (base_ + i_); a_[i_] = CA[(size_t)c_ * 1024]; b_[i_] = CB[(size_t)c_ * 1024]; } } \
        _Pragma("unroll") for (int i_ = 0; i_ < 33; ++i_) { if (base_ + i_ < (count)) { const int c_ = (cstart) + (step) * (base_ + i_); HIN[(size_t)c_ * 1024] = h; h = a_[i_] * h + b_[i_]; } } } } while (0)
    if (dir == 0) LC_RUN(0, NCH, 1);
    else { LC_RUN(7, 8, -1);
        h = ((const float*)(F.ws + WS_QUIRK))[b * 1024 + cg];
        LC_RUN(NCH - 1, NCH - 8, -1); }
#undef LC_RUN
}

__device__ __forceinline__ void rope_table(Frame& F) {
    const int i = F.vcu * NTHR + F.tid; if (i >= 2048) return;
    const int pos = i >> 4, f = i & 15; float s, c; sincosf((float)pos * exp2f(-(float)f * (13.287712379549449f / 16.f)), &s, &c);
    float* t = (float*)(F.ws + WS_ROPE); t[i] = c; t[2048 + i] = s;
}
__device__ __forceinline__ void row_prep(Frame& F, int row) {
    F.tid = ltid(); F.lane = F.tid & 63;
    bf16* pr = (bf16*)(F.ws + WS_P) + (size_t)row * DINP; const int lane = F.lane;
    const bool lat = row < M_LAT; const int t = row & (SEQ - 1); const float prow = (float)(t >> 6), pcol = (float)(t & 63);
    { const v4u a = *(const v4u*)(pr + C_QA + lane * 16), b = *(const v4u*)(pr + C_QA + lane * 16 + 8); float ss = 0.f;
#pragma unroll
      for (int w = 0; w < 4; ++w) { const float x0 = bflo(a[w]), x1 = bfhi(a[w]), x2 = bflo(b[w]), x3 = bfhi(b[w]); ss += x0 * x0 + x1 * x1 + x2 * x2 + x3 * x3; }
      ss = wave_sum(ss); if (lane == 0) ((float*)(F.ws + WS_RSQ))[row] = 1.f / sqrtf(ss * (1.f / 1024.f) + RMS_EPS); }
    { const v4u a = *(const v4u*)(pr + C_KVA + lane * 8); float ss = 0.f;
#pragma unroll
      for (int w = 0; w < 4; ++w) { const float x0 = bflo(a[w]), x1 = bfhi(a[w]); ss += x0 * x0 + x1 * x1; }
      ss = wave_sum(ss); if (lane == 0) ((float*)(F.ws + WS_RSKV))[row] = 1.f / sqrtf(ss * (1.f / 512.f) + RMS_EPS); }
    bf16* kr = (bf16*)(F.ws + WS_KR) + (size_t)row * 64;
    if (lat) {
        { const int part = lane >> 5, sub = lane & 31;
          const float inv = exp2f(-(float)sub * (13.287712379549449f / 32.f)); float sn, cs; sincosf((part ? pcol : prow) * inv, &sn, &cs);
          LAS float* tb = (LAS float*)(F.lds + F.wave * 512); tb[lane] = cs; tb[64 + lane] = sn;
          asm volatile("s_waitcnt lgkmcnt(0)" ::: "memory");
#pragma unroll
          for (int i = 0; i < 2; ++i) { const int t = lane + 64 * i; if (t < 80) { const int unit = t >> 2, q = t & 3, hd = unit >> 1, pt = unit & 1;
              bf16* qb = pr + (hd < 8 ? C_SWAQ + hd * 128 : C_SWAK + (hd - 8) * 128) + pt * 64 + 8 * q;
              const v4u a = *(const v4u*)qb, b = *(const v4u*)(qb + 32);
              const f32x4 c0 = *(const LAS f32x4*)(tb + pt * 32 + 8 * q), c1 = *(const LAS f32x4*)(tb + pt * 32 + 8 * q + 4), s0 = *(const LAS f32x4*)(tb + 64 + pt * 32 + 8 * q), s1 = *(const LAS f32x4*)(tb + 64 + pt * 32 + 8 * q + 4);
              v4u oa, ob;
#pragma unroll
              for (int w = 0; w < 4; ++w) { const float cl = w < 2 ? c0[2 * w] : c1[2 * w - 4], ch = w < 2 ? c0[2 * w + 1] : c1[2 * w - 3], sl = w < 2 ? s0[2 * w] : s1[2 * w - 4], sh = w < 2 ? s0[2 * w + 1] : s1[2 * w - 3];
                  const float x1l = bflo(a[w]), x1h = bfhi(a[w]), x2l = bflo(b[w]), x2h = bfhi(b[w]);
                  oa[w] = pk2(x1l * cl - x2l * sl, x1h * ch - x2h * sh); ob[w] = pk2(x2l * cl + x1l * sl, x2h * ch + x1h * sh); }
              *(v4u*)qb = oa; *(v4u*)(qb + 32) = ob; } }
          asm volatile("s_waitcnt lgkmcnt(0)" ::: "memory"); }
        if (lane < 32) { const int part = lane >> 4, i = lane & 15; const bf16* src = pr + C_KR + part * 32;
          const float inv = exp2f(-(float)i * (13.287712379549449f / 16.f)); float s, c; sincosf((part ? pcol : prow) * inv, &s, &c);
          const float x1 = bf2f(src[i]), x2 = bf2f(src[i + 16]);
          kr[part * 32 + i] = (bf16)f2bf(x1 * c - x2 * s); kr[part * 32 + i + 16] = (bf16)f2bf(x2 * c + x1 * s); }
    } else kr[lane] = pr[C_KR + lane];
}

__device__ __forceinline__ float allred16(float x) { return row_sum16(x); }
__device__ __forceinline__ int scan_row(int s, int dir, int b) {
    if (s < NCTX) return M_LAT + b * NCTX + (dir ? NCTX - 1 - s : s);
    const int t = s - NCTX; return b * SEQ + (dir ? SEQ - 1 - t : t);
}
__device__ __forceinline__ void rwkv_scan(Frame& F, int l, int chain) {
    F.tid = ltid(); F.lane = F.tid & 63;
    const int dir = chain >> 5, b = (chain >> 4) & 1, h = chain & 15;
    constexpr int CT = 24, NCHK = (NCTX + SEQ) / CT, STEPF = 392, BUFF = CT * STEPF;
    LAS float* buf = (LAS float*)F.lds; LAS float* ybuf = (LAS float*)(F.lds + 3 * BUFF * 4);
    gcbf RWF = (gcbf)(F.ws + WS_RWF); const size_t RS = (size_t)M_TOT * 1024;
    gflp YS = (gflp)(F.ws + WS_YS) + (size_t)dir * M_TOT * 1024;
    const bool cmp = F.wave < 4; const int lt = F.tid - 256, lst = lt >> 4, lq = lt & 15, lc = h * 64 + 4 * lq;
    const f32x4 ka4 = *(const GAS f32x4*)((gcfl)INP(I_KA) + l * 1024 + (cmp ? 0 : lc));
    v2u gr[2], gk[2], gv[2], gkk[2], ge[2], ga[2];
#pragma unroll
    for (int u = 0; u < 2; ++u) { gr[u] = (v2u){0u, 0u}; gk[u] = gr[u]; gv[u] = gr[u]; gkk[u] = gr[u]; ge[u] = gr[u]; ga[u] = gr[u]; }
#define RW_LOAD(c) do { if (!cmp) { _Pragma("unroll") for (int u_ = 0; u_ < 2; ++u_) { const int s_ = lst + 16 * u_; if (s_ < CT) { const size_t o_ = (size_t)scan_row((c) * CT + s_, dir, b) * 1024 + lc; \
        gr[u_] = *(const GAS v2u*)(RWF + 0 * RS + o_); gk[u_] = *(const GAS v2u*)(RWF + 1 * RS + o_); gv[u_] = *(const GAS v2u*)(RWF + 2 * RS + o_); \
        gkk[u_] = *(const GAS v2u*)(RWF + 3 * RS + o_); ge[u_] = *(const GAS v2u*)(RWF + (4 + dir) * RS + o_); ga[u_] = *(const GAS v2u*)(RWF + (6 + dir) * RS + o_); } } } } while (0)
#define RW_WRITE(bi) do { if (!cmp) { _Pragma("unroll") for (int u_ = 0; u_ < 2; ++u_) { const int s_ = lst + 16 * u_; if (s_ < CT) { LAS float* d_ = buf + (bi) * BUFF + s_ * STEPF + 4 * lq; \
        const float r_[4] = {bflo(gr[u_].x), bfhi(gr[u_].x), bflo(gr[u_].y), bfhi(gr[u_].y)}, k_[4] = {bflo(gk[u_].x), bfhi(gk[u_].x), bflo(gk[u_].y), bfhi(gk[u_].y)}, v_[4] = {bflo(gv[u_].x), bfhi(gv[u_].x), bflo(gv[u_].y), bfhi(gv[u_].y)}; \
        const float q_[4] = {bflo(gkk[u_].x), bfhi(gkk[u_].x), bflo(gkk[u_].y), bfhi(gkk[u_].y)}, e_[4] = {bflo(ge[u_].x), bfhi(ge[u_].x), bflo(ge[u_].y), bfhi(ge[u_].y)}, a_[4] = {bflo(ga[u_].x), bfhi(ga[u_].x), bflo(ga[u_].y), bfhi(ga[u_].y)}; \
        f32x4 w4, kd4, kk4, b4, wr4, v4; float sbr = 0.f, skr = 0.f; \
        _Pragma("unroll") for (int e = 0; e < 4; ++e) { w4[e] = __expf(-e_[e]); kd4[e] = k_[e] * (1.f + (a_[e] - 1.f) * ka4[e]); kk4[e] = q_[e]; b4[e] = q_[e] * a_[e]; wr4[e] = w4[e] * r_[e]; v4[e] = v_[e]; sbr += b4[e] * r_[e]; skr += kd4[e] * r_[e]; } \
        sbr = row_sum16(sbr); skr = row_sum16(skr); \
        *(LAS f32x4*)(d_) = w4; *(LAS f32x4*)(d_ + 64) = kd4; *(LAS f32x4*)(d_ + 128) = kk4; *(LAS f32x4*)(d_ + 192) = b4; *(LAS f32x4*)(d_ + 256) = wr4; *(LAS f32x4*)(d_ + 320) = v4; \
        if (lq == 0) *(LAS f32x2*)(buf + (bi) * BUFF + s_ * STEPF + 384) = (f32x2){sbr, skr}; } } } } while (0)
#define RW_FLUSH(c) do { if (!cmp) { _Pragma("unroll") for (int u_ = 0; u_ < 2; ++u_) { const int s_ = lst + 16 * u_; if (s_ < CT) { const f32x4 y_ = *(const LAS f32x4*)(ybuf + ((c) & 1) * (CT * 64) + s_ * 64 + 4 * lq); \
        *(GAS f32x4*)(YS + (size_t)scan_row((c) * CT + s_, dir, b) * 1024 + lc) = y_; } } } } while (0)
    __syncthreads();
    RW_LOAD(0); RW_WRITE(0); RW_LOAD(1); RW_WRITE(1); RW_LOAD(2);
    __syncthreads();
    const int kg = F.lane & 7, rg = F.lane >> 3, r0 = 16 * (F.wave & 3) + 2 * rg;
    f32x2 St[8];
#pragma unroll
    for (int i = 0; i < 8; ++i) St[i] = (f32x2){0.f, 0.f};
    int bc = 0, bw = 2;
#pragma unroll 1
    for (int c = 0; c < NCHK; ++c) {
        if (c + 2 < NCHK) { RW_WRITE(bw); if (c + 3 < NCHK) RW_LOAD(c + 3); }
        if (c > 0) RW_FLUSH(c - 1);
        if (cmp) {
        const LAS float* bb = buf + bc * BUFF + 8 * kg; const LAS float* vb = buf + bc * BUFF + 320 + r0; const LAS float* sb = buf + bc * BUFF + 384;
        LAS float* yb = ybuf + (c & 1) * (CT * 64) + r0;
        f32x4 w4[2], kd4[2], kk4[2], b4[2], wr4[2];
#pragma unroll
        for (int q = 0; q < 2; ++q) { w4[q] = *(const LAS f32x4*)(bb + 4 * q); kd4[q] = *(const LAS f32x4*)(bb + 64 + 4 * q); kk4[q] = *(const LAS f32x4*)(bb + 128 + 4 * q); b4[q] = *(const LAS f32x4*)(bb + 192 + 4 * q); wr4[q] = *(const LAS f32x4*)(bb + 256 + 4 * q); }
        f32x2 v2 = *(const LAS f32x2*)(vb), s2 = *(const LAS f32x2*)(sb);
#pragma unroll
        for (int st = 0; st < CT; ++st) {
            const int sn = (st + 1 < CT ? st + 1 : st) * STEPF;
            f32x4 nw4[2], nkd4[2], nkk4[2], nb4[2], nwr4[2];
#pragma unroll
            for (int q = 0; q < 2; ++q) { nw4[q] = *(const LAS f32x4*)(bb + sn + 4 * q); nkd4[q] = *(const LAS f32x4*)(bb + sn + 64 + 4 * q); nkk4[q] = *(const LAS f32x4*)(bb + sn + 128 + 4 * q); nb4[q] = *(const LAS f32x4*)(bb + sn + 192 + 4 * q); nwr4[q] = *(const LAS f32x4*)(bb + sn + 256 + 4 * q); }
            const f32x2 nv2 = *(const LAS f32x2*)(vb + sn), ns2 = *(const LAS f32x2*)(sb + sn);
#define PR(x, e) ((((e) >> 1) & 1) ? (f32x2){(x)[(e) >> 2][2], (x)[(e) >> 2][3]} : (f32x2){(x)[(e) >> 2][0], (x)[(e) >> 2][1]})
            f32x2 p, z, tpb, tzb;
            asm("v_pk_mul_f32 %0, %4, %12 op_sel:[0,0] op_sel_hi:[1,0]\n\tv_pk_mul_f32 %1, %4, %16 op_sel:[0,0] op_sel_hi:[1,0]\n\tv_pk_mul_f32 %2, %8, %14 op_sel:[0,0] op_sel_hi:[1,0]\n\tv_pk_mul_f32 %3, %8, %18 op_sel:[0,0] op_sel_hi:[1,0]\n\tv_pk_fma_f32 %0, %5, %12, %0 op_sel:[0,1,0] op_sel_hi:[1,1,1]\n\tv_pk_fma_f32 %1, %5, %16, %1 op_sel:[0,1,0] op_sel_hi:[1,1,1]\n\tv_pk_fma_f32 %2, %9, %14, %2 op_sel:[0,1,0] op_sel_hi:[1,1,1]\n\tv_pk_fma_f32 %3, %9, %18, %3 op_sel:[0,1,0] op_sel_hi:[1,1,1]\n\tv_pk_fma_f32 %0, %6, %13, %0 op_sel:[0,0,0] op_sel_hi:[1,0,1]\n\tv_pk_fma_f32 %1, %6, %17, %1 op_sel:[0,0,0] op_sel_hi:[1,0,1]\n\tv_pk_fma_f32 %2, %10, %15, %2 op_sel:[0,0,0] op_sel_hi:[1,0,1]\n\tv_pk_fma_f32 %3, %10, %19, %3 op_sel:[0,0,0] op_sel_hi:[1,0,1]\n\tv_pk_fma_f32 %0, %7, %13, %0 op_sel:[0,1,0] op_sel_hi:[1,1,1]\n\tv_pk_fma_f32 %1, %7, %17, %1 op_sel:[0,1,0] op_sel_hi:[1,1,1]\n\tv_pk_fma_f32 %2, %11, %15, %2 op_sel:[0,1,0] op_sel_hi:[1,1,1]\n\tv_pk_fma_f32 %3, %11, %19, %3 op_sel:[0,1,0] op_sel_hi:[1,1,1]\n\tv_pk_add_f32 %0, %0, %2\n\tv_pk_add_f32 %1, %1, %3\n\tv_pk_mul_f32 %4, %4, %20 op_sel:[0,0] op_sel_hi:[1,0]\n\tv_pk_mul_f32 %5, %5, %20 op_sel:[0,1] op_sel_hi:[1,1]\n\tv_pk_mul_f32 %6, %6, %21 op_sel:[0,0] op_sel_hi:[1,0]\n\tv_pk_mul_f32 %7, %7, %21 op_sel:[0,1] op_sel_hi:[1,1]\n\tv_pk_mul_f32 %8, %8, %22 op_sel:[0,0] op_sel_hi:[1,0]\n\tv_pk_mul_f32 %9, %9, %22 op_sel:[0,1] op_sel_hi:[1,1]\n\tv_pk_mul_f32 %10, %10, %23 op_sel:[0,0] op_sel_hi:[1,0]\n\tv_pk_mul_f32 %11, %11, %23 op_sel:[0,1] op_sel_hi:[1,1]\n\tv_pk_fma_f32 %4, %28, %24, %4 op_sel:[0,0,0] op_sel_hi:[1,0,1]\n\tv_pk_fma_f32 %5, %28, %24, %5 op_sel:[0,1,0] op_sel_hi:[1,1,1]\n\tv_pk_fma_f32 %6, %28, %25, %6 op_sel:[0,0,0] op_sel_hi:[1,0,1]\n\tv_pk_fma_f32 %7, %28, %25, %7 op_sel:[0,1,0] op_sel_hi:[1,1,1]\n\tv_pk_fma_f32 %8, %28, %26, %8 op_sel:[0,0,0] op_sel_hi:[1,0,1]\n\tv_pk_fma_f32 %9, %28, %26, %9 op_sel:[0,1,0] op_sel_hi:[1,1,1]\n\tv_pk_fma_f32 %10, %28, %27, %10 op_sel:[0,0,0] op_sel_hi:[1,0,1]\n\tv_pk_fma_f32 %11, %28, %27, %11 op_sel:[0,1,0] op_sel_hi:[1,1,1]"
                : "=&v"(p), "=&v"(z), "=&v"(tpb), "=&v"(tzb), "+v"(St[0]), "+v"(St[1]), "+v"(St[2]), "+v"(St[3]), "+v"(St[4]), "+v"(St[5]), "+v"(St[6]), "+v"(St[7])
                : "v"(PR(kk4, 0)), "v"(PR(kk4, 2)), "v"(PR(kk4, 4)), "v"(PR(kk4, 6)), "v"(PR(wr4, 0)), "v"(PR(wr4, 2)), "v"(PR(wr4, 4)), "v"(PR(wr4, 6)),
                  "v"(PR(w4, 0)), "v"(PR(w4, 2)), "v"(PR(w4, 4)), "v"(PR(w4, 6)), "v"(PR(kd4, 0)), "v"(PR(kd4, 2)), "v"(PR(kd4, 4)), "v"(PR(kd4, 6)), "v"(v2));
            float p0 = p.x, p1 = p.y, z0 = z.x, z1 = z.y;
#define D4(ctl) "v_add_f32_dpp %0, %0, %0 " ctl " row_mask:0xf bank_mask:0xf\n\tv_add_f32_dpp %1, %1, %1 " ctl " row_mask:0xf bank_mask:0xf\n\tv_add_f32_dpp %2, %2, %2 " ctl " row_mask:0xf bank_mask:0xf\n\tv_add_f32_dpp %3, %3, %3 " ctl " row_mask:0xf bank_mask:0xf\n\t"
            asm volatile("s_nop 1\n\t" D4("quad_perm:[1,0,3,2]") D4("quad_perm:[2,3,0,1]") D4("row_half_mirror") "s_nop 0"
                : "+v"(p0), "+v"(p1), "+v"(z0), "+v"(z1));
#undef D4
            const f32x2 pp = {p0, p1}, zz = {z0, z1};
            { f32x2 y;
              asm("v_pk_fma_f32 %0, %9, %11, %10 op_sel:[0,0,0] op_sel_hi:[1,0,1] neg_lo:[1,0,0] neg_hi:[1,0,0]\n\tv_pk_fma_f32 %0, %12, %11, %0 op_sel:[0,1,0] op_sel_hi:[1,1,1]\n\tv_pk_fma_f32 %1, %9, %13, %1 op_sel:[0,0,0] op_sel_hi:[1,0,1] neg_lo:[1,0,0] neg_hi:[1,0,0]\n\tv_pk_fma_f32 %2, %9, %13, %2 op_sel:[0,1,0] op_sel_hi:[1,1,1] neg_lo:[1,0,0] neg_hi:[1,0,0]\n\tv_pk_fma_f32 %3, %9, %14, %3 op_sel:[0,0,0] op_sel_hi:[1,0,1] neg_lo:[1,0,0] neg_hi:[1,0,0]\n\tv_pk_fma_f32 %4, %9, %14, %4 op_sel:[0,1,0] op_sel_hi:[1,1,1] neg_lo:[1,0,0] neg_hi:[1,0,0]\n\tv_pk_fma_f32 %5, %9, %15, %5 op_sel:[0,0,0] op_sel_hi:[1,0,1] neg_lo:[1,0,0] neg_hi:[1,0,0]\n\tv_pk_fma_f32 %6, %9, %15, %6 op_sel:[0,1,0] op_sel_hi:[1,1,1] neg_lo:[1,0,0] neg_hi:[1,0,0]\n\tv_pk_fma_f32 %7, %9, %16, %7 op_sel:[0,0,0] op_sel_hi:[1,0,1] neg_lo:[1,0,0] neg_hi:[1,0,0]\n\tv_pk_fma_f32 %8, %9, %16, %8 op_sel:[0,1,0] op_sel_hi:[1,1,1] neg_lo:[1,0,0] neg_hi:[1,0,0]"
                : "=&v"(y), "+v"(St[0]), "+v"(St[1]), "+v"(St[2]), "+v"(St[3]), "+v"(St[4]), "+v"(St[5]), "+v"(St[6]), "+v"(St[7])
                : "v"(pp), "v"(zz), "v"(s2), "v"(v2), "v"(PR(b4, 0)), "v"(PR(b4, 2)), "v"(PR(b4, 4)), "v"(PR(b4, 6)));
              *(LAS f32x2*)(yb + st * 64) = y; }
#undef PR
#pragma unroll
            for (int q = 0; q < 2; ++q) { w4[q] = nw4[q]; kd4[q] = nkd4[q]; kk4[q] = nkk4[q]; b4[q] = nb4[q]; wr4[q] = nwr4[q]; }
            v2 = nv2; s2 = ns2;
        }
        }
        __syncthreads();
        bc = bc == 2 ? 0 : bc + 1; bw = bw == 2 ? 0 : bw + 1;
    }
    RW_FLUSH(NCHK - 1);
#undef RW_LOAD
#undef RW_WRITE
#undef RW_FLUSH
}
__device__ __forceinline__ void rwkv_out_row(Frame& F, int l, int row) {
    F.tid = ltid(); F.lane = F.tid & 63;
    const int c0 = F.lane * 16; const float* yf = (const float*)(F.ws + WS_YS) + (size_t)row * 1024 + c0; const float* yb = yf + (size_t)M_TOT * 1024;
    float y[16]; float s = 0.f;
#pragma unroll
    for (int j = 0; j < 4; ++j) { const f32x4 a = __builtin_nontemporal_load((const f32x4*)(yf + 4 * j)), b = __builtin_nontemporal_load((const f32x4*)(yb + 4 * j));
#pragma unroll
        for (int e = 0; e < 4; ++e) { y[4 * j + e] = a[e] + b[e]; s += y[4 * j + e]; } }
    s = quad_sum(s); const float mu = s * (1.f / 64.f); float q = 0.f;
#pragma unroll
    for (int e = 0; e < 16; ++e) { y[e] -= mu; q += y[e] * y[e]; }
    q = quad_sum(q); const float rstd = 1.f / sqrtf(q * (1.f / 64.f) + GN_EPS);
    const bf16* RWF = (const bf16*)(F.ws + WS_RWF); const size_t RS = (size_t)M_TOT * 1024, o = (size_t)row * 1024 + c0;
    const float sbv = ((const float*)(F.ws + WS_SB))[(size_t)row * 16 + (F.lane >> 2)];
    const float* lg = INP(I_LNG) + l * 1024 + c0; const float* lb = INP(I_LNB) + l * 1024 + c0;
    bf16* dst = (bf16*)(F.ws + WS_MIX) + (size_t)row * DM + 3072 + c0;
#pragma unroll
    for (int hf = 0; hf < 2; ++hf) { const v4u vv = *(const v4u*)(RWF + 2 * RS + o + 8 * hf), gg = *(const v4u*)(RWF + 8 * RS + o + 8 * hf); float r[8];
#pragma unroll
        for (int w = 0; w < 4; ++w) { const int e = 8 * hf + 2 * w;
            r[2 * w] = (y[e] * rstd * lg[e] + lb[e] + sbv * bflo(vv[w])) * bflo(gg[w]); r[2 * w + 1] = (y[e + 1] * rstd * lg[e + 1] + lb[e + 1] + sbv * bfhi(vv[w])) * bfhi(gg[w]); }
        v4u ov; ov.x = pk2(r[0], r[1]); ov.y = pk2(r[2], r[3]); ov.z = pk2(r[4], r[5]); ov.w = pk2(r[6], r[7]); *(v4u*)(dst + 8 * hf) = ov; }
}

#ifndef W_OUT_K0
#define W_OUT_K0 1536
#endif
#ifndef W_OUT_K1
#define W_OUT_K1 3072
#endif
struct MlaTiles { gcbf KV; gcbf KR; int ctx_row0, lat_row0, h;
    __device__ __forceinline__ att::Tile operator()(int j) const { const int row = j < 4 ? ctx_row0 + 64 * j : lat_row0 + 64 * (j - 4);
        att::Tile t; t.kn = KV + (size_t)row * 2048 + h * 256; t.v = t.kn + 128; t.kr = KR + (size_t)row * 64; t.mtype = 0; t.krel0 = 0; return t; } };
struct SwaTiles { gcbf P; int blk_row0, ctx_row0, kvh, nwin, has_prev, has_next;
    __device__ __forceinline__ att::Tile operator()(int j) const { att::Tile t; int row; t.mtype = 0; t.krel0 = 0;
        if (j >= nwin) row = ctx_row0 + 64 * (j - nwin);
        else if (j < 2) row = blk_row0 + 64 * j;
        else if (has_prev && j < 4) { row = blk_row0 - 128 + 64 * (j - 2); t.mtype = 1; t.krel0 = -128 + 64 * (j - 2); }
        else { const int sub = j - 2 - 2 * has_prev; row = blk_row0 + 128 + 64 * sub; t.mtype = 2; t.krel0 = 128 + 64 * sub; }
        t.kn = P + (size_t)row * DINP + C_SWAK + kvh * 128; t.v = P + (size_t)row * DINP + C_SWAV + kvh * 128; t.kr = nullptr; return t; } };

#ifndef MLA_SDEPTH
#define MLA_SDEPTH 1
#endif
__device__ __forceinline__ void mla_item(Frame& F, int b, int h, int qb, bool ctxq) {
    F.tid = ltid(); F.lane = F.tid & 63;
    const int r32 = F.lane & 31; const int t = qb * 256 + F.wave * 32 + r32;
    const int roww0 = ctxq ? M_LAT + b * NCTX + F.wave * 32 : b * SEQ + qb * 256 + F.wave * 32;
    gcbf Qw = (gcbf)(F.ws + WS_Q) + (size_t)(roww0 + r32) * 1536 + h * 192;
    MlaTiles ts{(gcbf)(F.ws + WS_KV), (gcbf)(F.ws + WS_KR), M_LAT + b * NCTX, b * SEQ, h};
    gbfp Ow = (gbfp)(F.ws + WS_MIX) + (size_t)roww0 * DM + 2048 + h * 128;
    att::attn_body<192, 2048, 2048, false, false, MLA_SDEPTH>(Qw, ctxq ? 0 : 1, t >> 6, t & 63, (gcfl)(F.ws + WS_ROPE), 0, 0.f, ts, ctxq ? 4 : 132, Ow, (LAS char*)F.lds);
}
__device__ __forceinline__ void swa_item(Frame& F, int l, int b, int n, int kvh, int half, bool ctxq, int hq_ctx) {
    F.tid = ltid(); F.lane = F.tid & 63;
    const int r32 = F.lane & 31; gcbf P = (gcbf)(F.ws + WS_P);
    int hq, qi, roww0, t;
    if (ctxq) { hq = hq_ctx; kvh = hq >> 2; qi = 0; roww0 = M_LAT + b * NCTX + F.wave * 32; t = 0; }
    else { hq = kvh * 4 + 2 * half + (F.wave >> 2); qi = (F.wave & 3) * 32 + r32; roww0 = b * SEQ + n * 128 + (F.wave & 3) * 32; t = n * 128 + qi; }
    gcbf Qw = P + (size_t)(roww0 + r32) * DINP + C_SWAQ + hq * 128;
    SwaTiles ts; ts.P = P; ts.blk_row0 = b * SEQ + n * 128; ts.ctx_row0 = M_LAT + b * NCTX; ts.kvh = kvh;
    ts.has_prev = (!ctxq && n > 0) ? 1 : 0; ts.has_next = (!ctxq && n < SEQ / 128 - 1) ? 1 : 0; ts.nwin = ctxq ? 0 : 2 + 2 * ts.has_prev + 2 * ts.has_next;
    gbfp Ow = (gbfp)(F.ws + WS_MIX) + (size_t)roww0 * DM + hq * 128;
    const float sink_l2 = INP(I_SINK)[l * 8 + hq] * 1.4426950408889634f;
    att::attn_body<128, DINP, DINP, true, true, 2>(Qw, 0, 0, 0, (gcfl)nullptr, qi, sink_l2, ts, ts.nwin + 4, Ow, (LAS char*)F.lds);
}

#ifndef DBG_PHASES
#define DBG_PHASES 0xfffff
#endif
#define PH(n) ((DBG_PHASES >> (n)) & 1)
#ifndef DUP_PHASES
#define DUP_PHASES 0
#endif
#define REP(n) _Pragma("unroll") for (int rep_ = 0; rep_ < (((DUP_PHASES >> (n)) & 1) ? 2 : 1); ++rep_)
__global__ void __launch_bounds__(NTHR, 2) mk_fwd(Args args) {
    extern __shared__ __attribute__((aligned(16))) unsigned char lds[];
    Frame F;
    F.lds = (LAS unsigned char*)lds;
    F.tid = threadIdx.x; F.lane = F.tid & 63; F.wave = __builtin_amdgcn_readfirstlane(F.tid >> 6);
    F.G = gridDim.x; { const int bx = blockIdx.x; F.vcu = (F.G % 8 == 0) ? (bx % 8) * (F.G / 8) + bx / 8 : bx; }
    F.gw = F.vcu * NWAVES + F.wave; F.NGW = F.G * NWAVES;
    F.ws = args.ws; F.out = args.out; F.ctl = (gu32*)(args.ws + WS_CTL);
    F.A = (const __attribute__((address_space(4))) Args*)__builtin_amdgcn_kernarg_segment_ptr();
    for (int u = F.tid; u < (LDS_BYTES - LDSCTL_OFF) / 4; u += NTHR) ((LAS unsigned*)(F.lds + LDSCTL_OFF))[u] = 0u;
    __syncthreads();
    XcdBarrier bar = xcd_barrier_post((unsigned*)(args.ws + WS_CTL) + 4096, (volatile LAS unsigned*)(F.lds + MISC_OFF) + 8);
    const bool rwkv_blk = (blockIdx.x & 3) == 0;
    XcdBarrier bar2; bar2.bar = (unsigned*)(args.ws + WS_CTL) + 8192; bar2.x = 0; bar2.st = (volatile LAS unsigned*)(F.lds + MISC_OFF) + 12; bar2.nparts = gridDim.x - ((gridDim.x + 3) >> 2);
    if (!rwkv_blk) { const unsigned np_ = bar2.nparts; bar2 = xcd_barrier_post((unsigned*)(args.ws + WS_CTL) + 8192, (volatile LAS unsigned*)(F.lds + MISC_OFF) + 12); bar2.nparts = np_; }
#define SUB_BAR() do { bar2.bar = launder(bar2.bar); bar2.x = launder(bar2.x); xcd_barrier(bar2); F.ws = launder_g(F.ws); F.wsw = F.ws + (size_t)lcur * WSET_STRIDE; F.A = launder(F.A); F.tid = ltid(); F.lane = F.tid & 63; } while (0)
#define GRID_BAR() do { bar.bar = launder(bar.bar); bar.x = launder(bar.x); xcd_barrier(bar); F.ws = launder_g(F.ws); F.wsw = F.ws + (size_t)lcur * WSET_STRIDE; F.A = launder(F.A); F.tid = ltid(); F.lane = F.tid & 63; } while (0)
    const int bx = blockIdx.x; int lcur = 0; F.wsw = F.ws;
    bf16* H = (bf16*)(F.ws + WS_H); xres_t* X = (xres_t*)(F.ws + WS_X);

    REP(0) if (PH(0)) { mod_partials(F);
    convert_weights(F, 0, F.gw, F.NGW); }
    GRID_BAR();
    if (PH(1)) { mod_reduce(F); rope_table(F); }
    GRID_BAR();

#pragma unroll 1
    for (int l = 0; l < 2; ++l) {
        lcur = l; F.wsw = F.ws + (size_t)l * WSET_STRIDE;
        const bool wctx = (l == 0);
        const int MO = wctx ? M_TOT : M_LAT;
        if (PH(2) && l == 0) {
            int cs = -1;
            for (int row = F.gw; row < M_TOT; row += F.NGW) { const int s = row_s(row);
                if (s != cs) { __syncthreads(); ln_stage(F, LNV_SC, mod_ptr(F, 0, s, 1)); ln_stage(F, LNV_SH, mod_ptr(F, 0, s, 0)); __syncthreads(); cs = s; }
                const float* xs = row < M_LAT ? INP(I_X) + (size_t)row * DM : INP(I_CTX) + (size_t)(row - M_LAT) * DM;
                ln_row<0>(F, xs, nullptr, nullptr, true, H + (size_t)row * DM); }
            __syncthreads();
        }
        GRID_BAR();
        REP(3) if (PH(3)) { pg8::Gemm g{H, (const bf16*)(F.wsw + WS_WIN), M_TOT, DINP, DM, DM, DM}; pg8::StaticOrder S; S.init(M_TOT, DINP, F.G, bx);
          pg8::EpiBf16<0> E{(bf16*)(F.ws + WS_P), DINP, nullptr};
          pg8::gemm_phase<pg8::EpiBf16<0>, pg8::StaticOrder, true, true>(F.lds, g, S, E); }
        GRID_BAR();
        REP(4) if (PH(4)) for (int it = F.vcu; it < 528; it += F.G) rwkv_feat_item(F, l, it);
        REP(5) if (PH(5)) { if (F.G == 256) { if (F.vcu < 16) lru_items<false>(F, l, F.vcu, 64, 16, false);
                                              else lru_items<false>(F, l, 64 + F.vcu - 16, 2 * NCH * 8, 240, false); }
                            else for (int it = F.vcu; it < 2 * NCH * 8; it += F.G) lru_item<false>(F, l, it); }
        __syncthreads();
        if (PH(6)) for (int row = F.gw; row < M_TOT; row += F.NGW) row_prep(F, row);
        GRID_BAR();
        REP(8) if (rwkv_blk) { const int nrw = (F.G + 3) >> 2; REP(18) if (PH(8)) for (int chain = bx >> 2; chain < 64; chain += nrw) rwkv_scan(F, l, chain); }
        else REP(19) { const int x8 = bx & 7, naw = F.G - ((F.G + 3) >> 2);
            const int aw = (F.G == 256) ? ((x8 < 4 ? x8 - 1 : x8 - 2) * 32 + (bx >> 3)) : ((bx >> 2) * 3 + (bx & 3) - 1);
            if (PH(7) && aw >= naw - 8) lru_carry(F, aw - (naw - 8));
            if (PH(7)) { pg8::Gemm g{(const bf16*)(F.ws + WS_P) + C_QA, (const bf16*)(F.wsw + WS_WQB), M_TOT, 1536, 1024, DINP, 1024}; pg8::StaticOrder S; S.init(M_TOT, 1536, naw, aw);
              pg8::EpiBf16<2> E{(bf16*)(F.ws + WS_Q), 1536, (const float*)(F.ws + WS_RSQ)};
              pg8::gemm_phase<pg8::EpiBf16<2>, pg8::StaticOrder, true, true>(F.lds, g, S, E); }
            if (PH(7)) { pg8::Gemm g{(const bf16*)(F.ws + WS_P) + C_KVA, (const bf16*)(F.wsw + WS_WKVB), M_TOT, 2048, 512, DINP, 512}; pg8::StaticOrder S; S.init(M_TOT, 2048, naw, aw);
              pg8::EpiBf16<2> E{(bf16*)(F.ws + WS_KV), 2048, (const float*)(F.ws + WS_RSKV)};
              pg8::gemm_phase<pg8::EpiBf16<2>, pg8::StaticOrder, true, true>(F.lds, g, S, E); }
            SUB_BAR();
            if (PH(9)) for (int it = aw; it < 512; it += naw) mla_item(F, it >> 8, (it >> 5) & 7, it & 31, false);
            if (PH(9) && wctx) for (int it = aw; it < 16; it += naw) mla_item(F, it >> 3, it & 7, 0, true);
            if (PH(10)) for (int it = aw; it < 512; it += naw) swa_item(F, l, it >> 8, (it >> 2) & 63, (it >> 1) & 1, it & 1, false, 0);
            if (PH(10) && wctx) for (int it = aw; it < 16; it += naw) swa_item(F, l, it >> 3, 0, 0, 0, true, it & 7);
            if (PH(11)) { if (naw == 192) { const int i0 = aw < 128 ? aw : 1280 + aw - 128, st_ = aw < 128 ? 128 : 64, i1 = aw < 128 ? 1280 : 2 * NCH * 8;
                                            lru_items<true>(F, l, i0, i1, st_, !wctx); }
                          else for (int it = aw; it < 2 * NCH * 8; it += naw) { if (!wctx && ((it >> 3) % NCH) < 8) continue; lru_item<true>(F, l, it); } }
            if (l == 0) { __syncthreads(); convert_weights(F, 1, aw * NWAVES + F.wave, naw * NWAVES); }
            const int k1 = l ? W_OUT_K1 : W_OUT_K0;
            if (k1 > 0) { SUB_BAR();
                pg8::Gemm g{(const bf16*)(F.ws + WS_MIX), (const bf16*)(F.wsw + WS_WOUT), M_LAT, DM, k1, DM, DM}; pg8::StaticOrder S; S.init(M_LAT, DM, naw, aw);
                pg8::EpiBf16<0> E{(bf16*)(F.ws + WS_Y1), DM, nullptr};
                pg8::gemm_phase<pg8::EpiBf16<0>, pg8::StaticOrder, true, true>(F.lds, g, S, E); }
        }
        GRID_BAR();
        REP(12) if (PH(12)) for (int row = F.gw; row < MO; row += F.NGW) rwkv_out_row(F, l, row);
        GRID_BAR();
        REP(13) if (PH(13)) {
          const int k1 = l ? W_OUT_K1 : W_OUT_K0;
          if (k1 == 0) { pg8::Gemm g{(const bf16*)(F.ws + WS_MIX), (const bf16*)(F.wsw + WS_WOUT), M_LAT, DM, DM, DM, DM}; pg8::StaticOrder S; S.init(M_LAT, DM, F.G, bx);
            pg8::EpiBf16<0> E{(bf16*)(F.ws + WS_Y1), DM, nullptr};
            pg8::gemm_phase<pg8::EpiBf16<0>, pg8::StaticOrder, true, true>(F.lds, g, S, E); }
          else { pg8::Gemm g{(const bf16*)(F.ws + WS_MIX) + k1, (const bf16*)(F.wsw + WS_WOUT) + k1, M_LAT, DM, DM - k1, DM, DM}; pg8::StaticOrder S; S.init(M_LAT, DM, F.G, bx);
            pg8::EpiBf16<3> E{(bf16*)(F.ws + WS_Y1), DM, nullptr};
            pg8::gemm_phase<pg8::EpiBf16<3>, pg8::StaticOrder, true, true>(F.lds, g, S, E); }
          if (wctx) {
              pg8::Gemm g2{(const bf16*)(F.ws + WS_MIX) + (size_t)M_LAT * DM, (const bf16*)(F.wsw + WS_WOUT), M_CTX, DM, DM / 8, DM, DM}; pg8::SplitOrder S2; S2.init(M_CTX, DM, DM / 8, bx);
              pg8::EpiF32 E2{(float*)(F.ws + WS_YP), DM, (size_t)M_CTX * DM};
              pg8::gemm_phase<pg8::EpiF32, pg8::SplitOrder, true, true>(F.lds, g2, S2, E2); } }
        GRID_BAR();
        if (PH(14)) { int cs = -1;
          for (int row = F.gw; row < MO; row += F.NGW) { const int s = row_s(row);
            if (s != cs) { __syncthreads(); if (cs < 0) { ln_stage(F, LNV_G, INP(I_LN1G) + l * DM); ln_stage(F, LNV_B, INP(I_LN1B) + l * DM); }
                ln_stage(F, LNV_GA, mod_ptr(F, l, s, 2)); ln_stage(F, LNV_SC, mod_ptr(F, l, s, 4)); ln_stage(F, LNV_SH, mod_ptr(F, l, s, 3)); __syncthreads(); cs = s; }
            bf16* yrow = (bf16*)(F.ws + WS_Y1) + (size_t)row * DM;
            if (row >= M_LAT) sum_partials_row(F, (const float*)(F.ws + WS_YP) + (size_t)(row - M_LAT) * DM, (size_t)M_CTX * DM, yrow);
            if (l == 0) { const float* xs = row < M_LAT ? INP(I_X) + (size_t)row * DM : INP(I_CTX) + (size_t)(row - M_LAT) * DM;
                ln_row<1, false, XH16>(F, xs, yrow, X + (size_t)row * DM, true, H + (size_t)row * DM); }
            else ln_row<1, XH16, XH16>(F, X + (size_t)row * DM, yrow, X + (size_t)row * DM, true, H + (size_t)row * DM); }
          __syncthreads(); }
        GRID_BAR();
        REP(15) if (PH(15)) { pg8::Gemm g{H, (const bf16*)(F.wsw + WS_WFF1), MO, DFF, DM, DM, DM}; pg8::StaticOrder S; S.init(MO, DFF, F.G, bx);
          pg8::EpiBf16<1> E{(bf16*)(F.ws + WS_HID), DFF, nullptr};
          pg8::gemm_phase<pg8::EpiBf16<1>, pg8::StaticOrder, true, true>(F.lds, g, S, E); }
        GRID_BAR();
        REP(16) if (PH(16)) { pg8::Gemm g{(const bf16*)(F.ws + WS_HID), (const bf16*)(F.wsw + WS_WFF2), M_LAT, DM, DFF, DFF, DFF}; pg8::StaticOrder S; S.init(M_LAT, DM, F.G, bx);
          pg8::EpiBf16<0> E{(bf16*)(F.ws + WS_Y2), DM, nullptr};
          pg8::gemm_phase<pg8::EpiBf16<0>, pg8::StaticOrder, true, true>(F.lds, g, S, E);
          if (wctx) {
              pg8::Gemm g2{(const bf16*)(F.ws + WS_HID) + (size_t)M_LAT * DFF, (const bf16*)(F.wsw + WS_WFF2), M_CTX, DM, DFF / 8, DFF, DFF}; pg8::SplitOrder S2; S2.init(M_CTX, DM, DFF / 8, bx);
              pg8::EpiF32 E2{(float*)(F.ws + WS_YP), DM, (size_t)M_CTX * DM};
              pg8::gemm_phase<pg8::EpiF32, pg8::SplitOrder, true, true>(F.lds, g2, S2, E2); } }
        GRID_BAR();
        if (!PH(17)) {} else if (l == 0) { int cs = -1;
            for (int row = F.gw; row < M_TOT; row += F.NGW) { const int s = row_s(row);
                if (s != cs) { __syncthreads(); if (cs < 0) { ln_stage(F, LNV_G, INP(I_LN2G)); ln_stage(F, LNV_B, INP(I_LN2B)); }
                    ln_stage(F, LNV_GA, mod_ptr(F, 0, s, 5)); ln_stage(F, LNV_SC, mod_ptr(F, 1, s, 1)); ln_stage(F, LNV_SH, mod_ptr(F, 1, s, 0)); __syncthreads(); cs = s; }
                bf16* yrow = (bf16*)(F.ws + WS_Y2) + (size_t)row * DM;
                if (row >= M_LAT) sum_partials_row(F, (const float*)(F.ws + WS_YP) + (size_t)(row - M_LAT) * DM, (size_t)M_CTX * DM, yrow);
                ln_row<1, XH16, XH16>(F, X + (size_t)row * DM, yrow, X + (size_t)row * DM, true, H + (size_t)row * DM); }
            __syncthreads();
        } else { int cs = -1;
            for (int row = F.gw; row < M_LAT; row += F.NGW) { const int s = row_s(row);
                if (s != cs) { __syncthreads(); if (cs < 0) { ln_stage(F, LNV_G, INP(I_LN2G) + DM); ln_stage(F, LNV_B, INP(I_LN2B) + DM); }
                    ln_stage(F, LNV_GA, mod_ptr(F, 1, s, 5)); __syncthreads(); cs = s; }
                ln_row<1, XH16, false>(F, X + (size_t)row * DM, (const bf16*)(F.ws + WS_Y2) + (size_t)row * DM, F.out + (size_t)row * DM, false, nullptr); }
        }
    }
}

extern "C" void kernel_launch(void* const* d_in, const int* in_sizes, int n_in, void* d_out, int out_size, void* d_ws, size_t ws_size, hipStream_t stream) {
    static int grid = 0;
    if (grid == 0) {
        if (n_in != 38 || out_size != M_LAT * DM || ws_size < WS_END) { fprintf(stderr, "kernel_launch: unexpected shapes: n_in %d out %d ws %zu (need %zu)\n", n_in, out_size, ws_size, (size_t)WS_END); grid = -1; return; }
        int dev = 0, cus = 0, per_cu = 0;
        if (hipGetDevice(&dev) != hipSuccess || hipDeviceGetAttribute(&cus, hipDeviceAttributeMultiprocessorCount, dev) != hipSuccess) { grid = -1; return; }
        if (hipFuncSetAttribute((const void*)mk_fwd, hipFuncAttributeMaxDynamicSharedMemorySize, LDS_BYTES) != hipSuccess) { fprintf(stderr, "kernel_launch: hipFuncSetAttribute failed\n"); grid = -1; return; }
        if (hipOccupancyMaxActiveBlocksPerMultiprocessor(&per_cu, (const void*)mk_fwd, NTHR, LDS_BYTES) != hipSuccess || per_cu < 1) fprintf(stderr, "kernel_launch: occupancy query says %d\n", per_cu);
        (void)hipGetLastError();
        grid = cus;
    }
    if (grid < 0) return;
    if (hipMemsetAsync((char*)d_ws + WS_CTL, 0, CTL_ZERO_BYTES, stream) != hipSuccess) return;
    Args a{};
    for (int i = 0; i < 38; ++i) a.in[i] = (const float*)d_in[i];
    a.out = (float*)d_out; a.ws = (unsigned char*)d_ws;
    hipLaunchKernelGGL(mk_fwd, dim3(grid), dim3(NTHR), LDS_BYTES, stream, a);
    const hipError_t le = hipPeekAtLastError();
    if (le != hipSuccess) fprintf(stderr, "kernel_launch: launch failed: %s\n", hipGetErrorName(le));
}
```
